# Optimizing an MI355X kernel written in HIP

```python
import math
import jax, jax.numpy as jnp
from jax import lax
import numpy as np

D_MODEL = 1024
BATCH = 32
SEQ = 2048
DEPTH = 1

MOBA_HEADS = 8
MOBA_HEAD_DIM = 64
MOBA_WIDTH = MOBA_HEADS * MOBA_HEAD_DIM
MOBA_ROT_DIM = MOBA_HEAD_DIM // 4
MOBA_BLOCK = 256
MOBA_TOPK = 3
MOBA_Q_CHUNK = 128
MLA_HEADS = 8
MLA_NOPE = 64
MLA_ROPE = 32
MLA_V = 64
MLA_Q_LORA = 384
MLA_KV_LORA = 256
MLA_WIDTH = MLA_HEADS * MLA_V
MLA_Q_BLOCK = 128
ROPE_THETA = 500000.0
D_FF = 4 * D_MODEL
EPS = 1e-6
IN_WIDTH = 3 * MOBA_WIDTH + MLA_Q_LORA + MLA_KV_LORA + MLA_ROPE + 2 * D_MODEL

kernel_name = "hybrid_moba_mla_gated_block"


def _rms_norm(x, g):
    xf = x.astype(jnp.float32)
    y = xf * lax.rsqrt(jnp.mean(xf * xf, axis=-1, keepdims=True) + EPS)
    return (y * g.astype(jnp.float32)).astype(x.dtype)


def _split_cols(t, widths):
    out, start = [], 0
    for w in widths:
        out.append(t[..., start:start + w])
        start += w
    return out


def _rope(x, positions):
    r = x.shape[-1]
    half = r // 2
    inv_freq = ROPE_THETA ** (-jnp.arange(half, dtype=jnp.float32) * (2.0 / r))
    ang = positions.astype(jnp.float32)[..., None] * inv_freq
    cos = jnp.cos(ang)[:, :, None, :]
    sin = jnp.sin(ang)[:, :, None, :]
    xf = x.astype(jnp.float32)
    x1, x2 = xf[..., :half], xf[..., half:]
    return jnp.concatenate([x1 * cos - x2 * sin, x2 * cos + x1 * sin], axis=-1).astype(x.dtype)


def _partial_rope(x, positions):
    return jnp.concatenate([_rope(x[..., :MOBA_ROT_DIM], positions), x[..., MOBA_ROT_DIM:]], axis=-1)


def _moba_attention(q, k, v):
    B, S, H, Dh = q.shape
    nb = -(-S // MOBA_BLOCK)
    pad = nb * MOBA_BLOCK - S
    topk = min(MOBA_TOPK, nb)
    n_chunks = S // MOBA_Q_CHUNK
    scale = Dh ** -0.5
    qt = jnp.transpose(q, (0, 2, 1, 3))
    kp = jnp.pad(jnp.transpose(k, (0, 2, 1, 3)), ((0, 0), (0, 0), (0, pad), (0, 0)))
    vp = jnp.pad(jnp.transpose(v, (0, 2, 1, 3)), ((0, 0), (0, 0), (0, pad), (0, 0)))
    kb = kp.reshape(B, H, nb, MOBA_BLOCK, Dh)
    vb = vp.reshape(B, H, nb, MOBA_BLOCK, Dh)
    kmean = jnp.mean(kb.astype(jnp.float32), axis=3)
    head_idx = jnp.arange(H)[:, None, None]

    def per_batch(args):
        qb, kbb, vbb, kmb = args

        def per_chunk(c):
            q0 = c * MOBA_Q_CHUNK
            qc = lax.dynamic_slice_in_dim(qb, q0, MOBA_Q_CHUNK, axis=1)
            own = q0 // MOBA_BLOCK
            gate = jnp.einsum('hqd,hnd->hqn', qc.astype(jnp.float32), kmb)
            gate = jnp.where(jnp.arange(nb)[None, None, :] < own, gate, -jnp.inf)
            _, idx = lax.top_k(gate, topk)
            valid = jnp.arange(topk) < own
            kg = kbb[head_idx, idx]
            vg = vbb[head_idx, idx]
            s_past = jnp.einsum('hqd,hqnkd->hqnk', qc, kg).astype(jnp.float32) * scale
            s_past = jnp.where(valid[None, None, :, None], s_past, -jnp.inf)
            s_past = s_past.reshape(H, MOBA_Q_CHUNK, topk * MOBA_BLOCK)
            k_own = lax.dynamic_index_in_dim(kbb, own, axis=1, keepdims=False)
            v_own = lax.dynamic_index_in_dim(vbb, own, axis=1, keepdims=False)
            s_own = jnp.einsum('hqd,hkd->hqk', qc, k_own).astype(jnp.float32) * scale
            qpos = q0 + jnp.arange(MOBA_Q_CHUNK)
            kpos = own * MOBA_BLOCK + jnp.arange(MOBA_BLOCK)
            s_own = jnp.where(kpos[None, None, :] <= qpos[None, :, None], s_own, -jnp.inf)
            p = jax.nn.softmax(jnp.concatenate([s_past, s_own], axis=-1), axis=-1).astype(v.dtype)
            p_past = p[..., :topk * MOBA_BLOCK].reshape(H, MOBA_Q_CHUNK, topk, MOBA_BLOCK)
            p_own = p[..., topk * MOBA_BLOCK:]
            return (jnp.einsum('hqnk,hqnkd->hqd', p_past, vg)
                    + jnp.einsum('hqk,hkd->hqd', p_own, v_own))

        outs = lax.map(per_chunk, jnp.arange(n_chunks))
        return jnp.transpose(outs, (1, 0, 2, 3)).reshape(H, S, Dh)

    o = lax.map(per_batch, (qt, kb, vb, kmean))
    return jnp.transpose(o, (0, 2, 1, 3))


def _mla_attention(q_nope, q_rope, k_nope, k_rope, v):
    S = q_nope.shape[1]
    scale = (MLA_NOPE + MLA_ROPE) ** -0.5
    outs = []
    for c in range(S // MLA_Q_BLOCK):
        q0, q1 = c * MLA_Q_BLOCK, (c + 1) * MLA_Q_BLOCK
        s = (jnp.einsum('bqhd,bkhd->bhqk', q_nope[:, q0:q1], k_nope[:, :q1])
             + jnp.einsum('bqhr,bkr->bhqk', q_rope[:, q0:q1], k_rope[:, :q1]))
        s = s.astype(jnp.float32) * scale
        mask = jnp.arange(q1)[None, :] <= (q0 + jnp.arange(MLA_Q_BLOCK))[:, None]
        s = jnp.where(mask[None, None], s, -jnp.inf)
        p = jax.nn.softmax(s, axis=-1).astype(v.dtype)
        outs.append(jnp.einsum('bhqk,bkhd->bqhd', p, v[:, :q1]))
    return jnp.concatenate(outs, axis=1)


def setup_inputs(seed: int = 0) -> dict:
    key = jax.random.key(seed)
    ks = jax.random.split(key, 20)
    f32 = jnp.float32

    def w(k, shape, fan_in):
        return jax.random.normal(k, shape, f32) * (fan_in ** -0.5)

    def gain(k, n):
        return 1.0 + 0.1 * jax.random.normal(k, (DEPTH, n), f32)

    x = jax.random.normal(ks[0], (BATCH, SEQ, D_MODEL), f32)
    offsets = jax.random.randint(ks[1], (BATCH, 1), 0, 4096)
    positions = (offsets + jnp.arange(SEQ)[None, :]).astype(jnp.int32)
    return {
        "x": x,
        "positions": positions,
        "g_pre_mix": gain(ks[2], D_MODEL),
        "w_in": w(ks[3], (DEPTH, D_MODEL, IN_WIDTH), D_MODEL),
        "b_gate": 0.01 * jax.random.normal(ks[4], (DEPTH, 2 * D_MODEL), f32),
        "g_q_norm": gain(ks[5], MLA_Q_LORA),
        "w_uq": w(ks[6], (DEPTH, MLA_Q_LORA, MLA_HEADS * (MLA_NOPE + MLA_ROPE)), MLA_Q_LORA),
        "g_kv_norm": gain(ks[7], MLA_KV_LORA),
        "w_ukv": w(ks[8], (DEPTH, MLA_KV_LORA, MLA_HEADS * (MLA_NOPE + MLA_V)), MLA_KV_LORA),
        "w_branch_a": w(ks[9], (DEPTH, MOBA_WIDTH, D_MODEL), MOBA_WIDTH),
        "w_branch_b": w(ks[10], (DEPTH, MLA_WIDTH, D_MODEL), MLA_WIDTH),
        "w_out": w(ks[11], (DEPTH, D_MODEL, D_MODEL), D_MODEL),
        "g_post_mix": gain(ks[12], D_MODEL),
        "g_pre_mlp": gain(ks[13], D_MODEL),
        "w_up": w(ks[14], (DEPTH, D_MODEL, D_FF), D_MODEL),
        "w_down": w(ks[15], (DEPTH, D_FF, D_MODEL), D_FF),
        "g_post_mlp": gain(ks[16], D_MODEL),
    }


def reference(x, positions, g_pre_mix, w_in, b_gate, g_q_norm, w_uq, g_kv_norm, w_ukv,
              w_branch_a, w_branch_b, w_out, g_post_mix, g_pre_mlp, w_up, w_down, g_post_mlp):
    B, S, _ = x.shape
    for l in range(DEPTH):
        h = _rms_norm(x, g_pre_mix[l])
        proj = h @ w_in[l]
        qa, ka, va, c_q, c_kv, k_r, gate_logits = _split_cols(
            proj, [MOBA_WIDTH, MOBA_WIDTH, MOBA_WIDTH, MLA_Q_LORA, MLA_KV_LORA, MLA_ROPE, 2 * D_MODEL])
        qa = _partial_rope(qa.reshape(B, S, MOBA_HEADS, MOBA_HEAD_DIM), positions)
        ka = _partial_rope(ka.reshape(B, S, MOBA_HEADS, MOBA_HEAD_DIM), positions)
        va = va.reshape(B, S, MOBA_HEADS, MOBA_HEAD_DIM)
        o_a = _moba_attention(qa, ka, va).reshape(B, S, MOBA_WIDTH) @ w_branch_a[l]
        q = (_rms_norm(c_q, g_q_norm[l]) @ w_uq[l]).reshape(B, S, MLA_HEADS, MLA_NOPE + MLA_ROPE)
        q_nope = q[..., :MLA_NOPE]
        q_rope = _rope(q[..., MLA_NOPE:], positions)
        kv = (_rms_norm(c_kv, g_kv_norm[l]) @ w_ukv[l]).reshape(B, S, MLA_HEADS, MLA_NOPE + MLA_V)
        k_nope, v_b = kv[..., :MLA_NOPE], kv[..., MLA_NOPE:]
        k_rope = _rope(k_r[:, :, None, :], positions)[:, :, 0, :]
        o_b = _mla_attention(q_nope, q_rope, k_nope, k_rope, v_b).reshape(B, S, MLA_WIDTH) @ w_branch_b[l]
        gates = jax.nn.sigmoid((gate_logits + b_gate[l]).astype(jnp.float32)).astype(x.dtype)
        merged = gates[..., :D_MODEL] * o_a + gates[..., D_MODEL:] * o_b
        x = x + _rms_norm(merged @ w_out[l], g_post_mix[l])
        h2 = _rms_norm(x, g_pre_mlp[l])
        m = jnp.square(jax.nn.relu(h2 @ w_up[l])) @ w_down[l]
        x = x + _rms_norm(m, g_post_mlp[l])
    return x
```

```cpp
#include <hip/hip_runtime.h>
#include <hip/hip_bf16.h>
#include <cstdio>
#include <cstdint>
#include <cmath>
constexpr int NB = 32, SEQ = 2048, DM = 1024, MTOK = NB * SEQ;
constexpr int NHEAD = 8, HD = 64, AW = NHEAD * HD;
constexpr int QLORA = 384, KVLORA = 256, RDIM = 32, QKB = 96;
constexpr int DFF = 4096, INW = 4256, INWP = 4352;
constexpr float EPS = 1e-6f;
constexpr float LOG2E = 1.4426950408889634f;
constexpr float C2A = 0.125f * LOG2E;
constexpr float C2B = 0.10206207261596575f * LOG2E;
typedef float f32x2g __attribute__((ext_vector_type(2)));
namespace pg8 {
#define PG8_LAS __attribute__((address_space(3)))
typedef unsigned short bf16_t;
typedef short bf16x8 __attribute__((ext_vector_type(8)));
typedef float f32x4 __attribute__((ext_vector_type(4)));
typedef unsigned u32x4 __attribute__((ext_vector_type(4)));
constexpr int BM = 256, BK = 64, HALF = 128, HTB = HALF * BK * 2  , STAGE_BYTES = 8 * HTB, NXCD = 8, WGM = 8;

__host__ __device__ __forceinline__ int lds_byte(int r, int c) { const int st = (r >> 4) * 2 + (c >> 5), rr = r & 15, cc = c & 31, ob = rr * 64 + cc * 2; return st * 1024 + (ob ^ (((ob >> 9) & 1) << 5)); }
__host__ __device__ __forceinline__ void stage_rc(int b, int& R, int& C) { const int st = b / 1024, sb = b % 1024, swz = sb ^ (((sb >> 9) & 1) << 5); R = (st >> 1) * 16 + swz / 64; C = (st & 1) * 32 + (swz % 64) / 2; }
__host__ __device__ __forceinline__ int perm32(int rho) { const int n = rho >> 4, i = rho & 15; return 8 * (i >> 2) + 4 * n + (i & 3); }

struct Unit { int pm, pn; };
struct Gemm { const bf16_t* A; const bf16_t* Bt; int M, N, K; };

struct StaticOrder {
    int nM, nN, nwg, G, c;
    __host__ __device__ void init(int M, int N, int G_, int c_) { nM = M / BM; nN = N / BM; nwg = nM * nN; G = G_; c = c_; }
    __host__ __device__ bool next(int i, Unit& u) const {
        const long L = (long)i * G + c; if (L >= nwg) return false;
        int wgid = (int)L; { const int q = nwg / NXCD, r = nwg % NXCD, xcd = wgid % NXCD, off = wgid / NXCD; wgid = (xcd < r ? xcd * (q + 1) : r * (q + 1) + (xcd - r) * q) + off; }
        const int nig = WGM * nN, gid = wgid / nig, fm = gid * WGM, gsz = (nM - fm) < WGM ? (nM - fm) : WGM;
        u.pm = fm + ((wgid % nig) % gsz); u.pn = (wgid % nig) / gsz; return true;
    }
    __device__ __forceinline__ void a_ready(const Unit&) const {}
    __device__ __forceinline__ void done(const Unit&) const {}
};

__device__ __forceinline__ unsigned cvt_pk_bf16(float lo, float hi) { unsigned r; asm volatile("v_cvt_pk_bf16_f32 %0, %1, %2" : "=v"(r) : "v"(lo), "v"(hi)); return r; }
__device__ __forceinline__ void ld8(float (&v)[8], const f32x4& a, const f32x4& b) { v[0] = a[0]; v[1] = a[1]; v[2] = a[2]; v[3] = a[3]; v[4] = b[0]; v[5] = b[1]; v[6] = b[2]; v[7] = b[3]; }
typedef float f32x2c_t __attribute__((ext_vector_type(2))); typedef __bf16 bf16x2c_t __attribute__((ext_vector_type(2)));
__device__ __forceinline__ unsigned cvtpk_c(float lo, float hi) { const f32x2c_t v = {lo, hi}; const bf16x2c_t b = __builtin_convertvector(v, bf16x2c_t); return __builtin_bit_cast(unsigned, b); }
__device__ __forceinline__ u32x4 pack8(const float (&v)[8]) { u32x4 w; w.x = cvtpk_c(v[0], v[1]); w.y = cvtpk_c(v[2], v[3]); w.z = cvtpk_c(v[4], v[5]); w.w = cvtpk_c(v[6], v[7]); return w; }
__device__ __forceinline__ void unpack8(const u32x4 w, float (&v)[8]) {
    v[0] = __uint_as_float(w.x << 16); v[1] = __uint_as_float(w.x & 0xffff0000u); v[2] = __uint_as_float(w.y << 16); v[3] = __uint_as_float(w.y & 0xffff0000u);
    v[4] = __uint_as_float(w.z << 16); v[5] = __uint_as_float(w.z & 0xffff0000u); v[6] = __uint_as_float(w.w << 16); v[7] = __uint_as_float(w.w & 0xffff0000u); }
__device__ __forceinline__ void rope4(float (&v)[8], const f32x4 a, const f32x4 b) {
    float x1, x2;
    x1 = v[0]; x2 = v[1]; v[0] = x1 * a[0] - x2 * a[1]; v[1] = x2 * a[0] + x1 * a[1];
    x1 = v[2]; x2 = v[3]; v[2] = x1 * a[2] - x2 * a[3]; v[3] = x2 * a[2] + x1 * a[3];
    x1 = v[4]; x2 = v[5]; v[4] = x1 * b[0] - x2 * b[1]; v[5] = x2 * b[0] + x1 * b[1];
    x1 = v[6]; x2 = v[7]; v[6] = x1 * b[2] - x2 * b[3]; v[7] = x2 * b[2] + x1 * b[3];
}
__device__ __forceinline__ float sumsq8(const float (&v)[8]) { return ((v[0] * v[0] + v[1] * v[1]) + (v[2] * v[2] + v[3] * v[3])) + ((v[4] * v[4] + v[5] * v[5]) + (v[6] * v[6] + v[7] * v[7])); }
__device__ __forceinline__ float red_fq(float s) { s += __shfl_xor(s, 16); s += __shfl_xor(s, 32); return s; }

struct EpiIn {
    static constexpr bool PERM = true, AFTER_DRAIN = false;
    bf16_t *QA, *KA, *VA, *CQ, *CKV, *KR, *G; float* SS; const float* ropeA; const float* ropeB; const float* bgate;
    __device__ __forceinline__ void operator()(const f32x4 (&acc)[2][2][4][2], const Unit& u, int wr, int wc, int fr, int fq) const {
        asm volatile("" : "+v"(fr), "+v"(fq));
        const int row0 = u.pm * BM + wr * 64 + fr, pn = u.pn, cl = wc * 32 + 8 * fq;
        if (pn < 4) {
            bf16_t* dst = (pn < 2) ? QA : KA; const float sc = (pn < 2) ? C2A : 1.f; const int cb = (pn & 1) * 256 + cl;
            if ((wc & 1) == 0) {
                const bool rp = fq < 2;
#pragma unroll
                for (int ai = 0; ai < 2; ++ai)
#pragma unroll
                    for (int m = 0; m < 4; ++m) { const int row = row0 + ai * HALF + m * 16;
                        const f32x4* t = (const f32x4*)(ropeA + (size_t)row * 16 + (rp ? fq * 8 : 0));
                        f32x4 ca = t[0], cc = t[1]; if (!rp) { ca = (f32x4){1.f, 0.f, 1.f, 0.f}; cc = ca; }
#pragma unroll
                        for (int bj = 0; bj < 2; ++bj) { float v[8]; ld8(v, acc[ai][bj][m][0], acc[ai][bj][m][1]); rope4(v, ca, cc);
#pragma unroll
                            for (int j = 0; j < 8; ++j) v[j] *= sc;
                            *(u32x4*)(dst + (size_t)row * AW + cb + bj * HALF) = pack8(v); } }
            } else {
#pragma unroll
                for (int ai = 0; ai < 2; ++ai)
#pragma unroll
                    for (int m = 0; m < 4; ++m) { const int row = row0 + ai * HALF + m * 16;
#pragma unroll
                        for (int bj = 0; bj < 2; ++bj) { float v[8]; ld8(v, acc[ai][bj][m][0], acc[ai][bj][m][1]);
#pragma unroll
                            for (int j = 0; j < 8; ++j) v[j] *= sc;
                            *(u32x4*)(dst + (size_t)row * AW + cb + bj * HALF) = pack8(v); } }
            }
        } else if (pn < 6) {
            const int cb = (pn - 4) * 256 + cl;
#pragma unroll
            for (int ai = 0; ai < 2; ++ai)
#pragma unroll
                for (int m = 0; m < 4; ++m) { const int row = row0 + ai * HALF + m * 16;
#pragma unroll
                    for (int bj = 0; bj < 2; ++bj) { float v[8]; ld8(v, acc[ai][bj][m][0], acc[ai][bj][m][1]); *(u32x4*)(VA + (size_t)row * AW + cb + bj * HALF) = pack8(v); } }
        } else if (pn == 6 || pn == 8) {
            bf16_t* dst = (pn == 6) ? CQ : CKV; const int ld = (pn == 6) ? QLORA : KVLORA, slot = ((pn == 6) ? 0 : 8) + wc;
#pragma unroll
            for (int ai = 0; ai < 2; ++ai)
#pragma unroll
                for (int m = 0; m < 4; ++m) { const int row = row0 + ai * HALF + m * 16; float s = 0.f;
#pragma unroll
                    for (int bj = 0; bj < 2; ++bj) { float v[8]; ld8(v, acc[ai][bj][m][0], acc[ai][bj][m][1]); s += sumsq8(v); *(u32x4*)(dst + (size_t)row * ld + cl + bj * HALF) = pack8(v); }
                    s = red_fq(s); if (fq == 0) SS[(size_t)row * 12 + slot] = s; }
        } else if (pn == 7) {
#pragma unroll
            for (int ai = 0; ai < 2; ++ai)
#pragma unroll
                for (int m = 0; m < 4; ++m) { const int row = row0 + ai * HALF + m * 16;
                    { float v[8]; ld8(v, acc[ai][0][m][0], acc[ai][0][m][1]); float s = red_fq(sumsq8(v)); *(u32x4*)(CQ + (size_t)row * QLORA + 256 + cl) = pack8(v); if (fq == 0) SS[(size_t)row * 12 + 4 + wc] = s; }
                    if (wc == 0) { float v[8]; ld8(v, acc[ai][1][m][0], acc[ai][1][m][1]); const f32x4* t = (const f32x4*)(ropeB + (size_t)row * 32 + fq * 8); rope4(v, t[0], t[1]);
                        *(u32x4*)(KR + (size_t)row * RDIM + 8 * fq) = pack8(v); } }
        } else {
            const int gc = (pn - 9) * 256 + cl;
            f32x4 bv[2][2];
#pragma unroll
            for (int bj = 0; bj < 2; ++bj)
#pragma unroll
                for (int n = 0; n < 2; ++n) bv[bj][n] = *(const f32x4*)(bgate + gc + bj * HALF + 4 * n);
#pragma unroll
            for (int ai = 0; ai < 2; ++ai)
#pragma unroll
                for (int m = 0; m < 4; ++m) { const int row = row0 + ai * HALF + m * 16;
#pragma unroll
                    for (int bj = 0; bj < 2; ++bj) { float v[8]; ld8(v, acc[ai][bj][m][0] + bv[bj][0], acc[ai][bj][m][1] + bv[bj][1]);
#pragma unroll
                        for (int j = 0; j < 8; ++j) v[j] = __builtin_amdgcn_rcpf(1.f + __builtin_amdgcn_exp2f(-LOG2E * v[j]));
                        *(u32x4*)(G + (size_t)row * (2 * DM) + gc + bj * HALF) = pack8(v); } }
        }
    }
};
struct EpiQ {
    static constexpr bool PERM = true, AFTER_DRAIN = false;
    bf16_t* QB; const float* SS; const float* ropeB;
    __device__ __forceinline__ void operator()(const f32x4 (&acc)[2][2][4][2], const Unit& u, int wr, int wc, int fr, int fq) const {
        asm volatile("" : "+v"(fr), "+v"(fq));
        const int row0 = u.pm * BM + wr * 64 + fr, cl = u.pn * BM + wc * 32 + 8 * fq;
#pragma unroll
        for (int ai = 0; ai < 2; ++ai)
#pragma unroll
            for (int m = 0; m < 4; ++m) { const int row = row0 + ai * HALF + m * 16;
                const f32x4* sp = (const f32x4*)(SS + (size_t)row * 12); const f32x4 s0 = sp[0], s1 = sp[1];
                const float ss = ((s0[0] + s0[1]) + (s0[2] + s0[3])) + ((s1[0] + s1[1]) + (s1[2] + s1[3]));
                const float rs = __builtin_amdgcn_rsqf(ss * (1.0f / QLORA) + EPS) * C2B;
#pragma unroll
                for (int bj = 0; bj < 2; ++bj) { const int c = cl + bj * HALF, hd = c / QKB, p = c - hd * QKB;
                    float v[8]; ld8(v, acc[ai][bj][m][0], acc[ai][bj][m][1]);
#pragma unroll
                    for (int j = 0; j < 8; ++j) v[j] *= rs;
                    if (p >= 64) { const f32x4* t = (const f32x4*)(ropeB + (size_t)row * 32 + (p - 64)); rope4(v, t[0], t[1]); }
                    *(u32x4*)(QB + (size_t)row * (NHEAD * QKB) + c) = pack8(v); }
                asm volatile("" ::: "memory"); }
    }
};
struct EpiKV {
    static constexpr bool PERM = true, AFTER_DRAIN = false;
    bf16_t *KB, *VB; const float* SS;
    __device__ __forceinline__ void operator()(const f32x4 (&acc)[2][2][4][2], const Unit& u, int wr, int wc, int fr, int fq) const {
        asm volatile("" : "+v"(fr), "+v"(fq));
        const int row0 = u.pm * BM + wr * 64 + fr;
        bf16_t* dst = (wc < 2) ? KB : VB; const int pc = (wc & 1) * 32 + 8 * fq;
#pragma unroll
        for (int ai = 0; ai < 2; ++ai)
#pragma unroll
            for (int m = 0; m < 4; ++m) { const int row = row0 + ai * HALF + m * 16;
                const f32x4 s0 = *(const f32x4*)(SS + (size_t)row * 12 + 8);
                const float rs = __builtin_amdgcn_rsqf(((s0[0] + s0[1]) + (s0[2] + s0[3])) * (1.0f / KVLORA) + EPS);
#pragma unroll
                for (int bj = 0; bj < 2; ++bj) { const int hd = u.pn * 2 + bj;
                    float v[8]; ld8(v, acc[ai][bj][m][0], acc[ai][bj][m][1]);
#pragma unroll
                    for (int j = 0; j < 8; ++j) v[j] *= rs;
                    *(u32x4*)(dst + (size_t)row * AW + hd * HD + pc) = pack8(v); }
                asm volatile("" ::: "memory"); }
    }
};
template <bool SECOND> struct EpiGate {
    static constexpr bool PERM = true, AFTER_DRAIN = false;
    const bf16_t* G; bf16_t* T;
    __device__ __forceinline__ void operator()(const f32x4 (&acc)[2][2][4][2], const Unit& u, int wr, int wc, int fr, int fq) const {
        asm volatile("" : "+v"(fr), "+v"(fq));
        const int row0 = u.pm * BM + wr * 64 + fr, cl = u.pn * BM + wc * 32 + 8 * fq;
#pragma unroll
        for (int ai = 0; ai < 2; ++ai)
#pragma unroll
            for (int m = 0; m < 4; ++m) { const int row = row0 + ai * HALF + m * 16;
#pragma unroll
                for (int bj = 0; bj < 2; ++bj) { const int c = cl + bj * HALF;
                    float v[8], g[8]; ld8(v, acc[ai][bj][m][0], acc[ai][bj][m][1]); unpack8(*(const u32x4*)(G + (size_t)row * (2 * DM) + (SECOND ? DM : 0) + c), g);
                    bf16_t* tp = T + (size_t)row * DM + c;
                    if (SECOND) { float t[8]; unpack8(*(const u32x4*)tp, t);
#pragma unroll
                        for (int j = 0; j < 8; ++j) v[j] = t[j] + v[j] * g[j]; }
                    else {
#pragma unroll
                        for (int j = 0; j < 8; ++j) v[j] *= g[j]; }
                    *(u32x4*)tp = pack8(v); }
                asm volatile("" ::: "memory"); }
    }
};
struct EpiSS {
    static constexpr bool PERM = true, AFTER_DRAIN = false;
    bf16_t* Y; float* SSY;
    __device__ __forceinline__ void operator()(const f32x4 (&acc)[2][2][4][2], const Unit& u, int wr, int wc, int fr, int fq) const {
        asm volatile("" : "+v"(fr), "+v"(fq));
        const int row0 = u.pm * BM + wr * 64 + fr, cl = u.pn * BM + wc * 32 + 8 * fq;
#pragma unroll
        for (int ai = 0; ai < 2; ++ai)
#pragma unroll
            for (int m = 0; m < 4; ++m) { const int row = row0 + ai * HALF + m * 16; float s = 0.f;
#pragma unroll
                for (int bj = 0; bj < 2; ++bj) { float v[8]; ld8(v, acc[ai][bj][m][0], acc[ai][bj][m][1]); s += sumsq8(v); *(u32x4*)(Y + (size_t)row * DM + cl + bj * HALF) = pack8(v); }
                s = red_fq(s); if (fq == 0) SSY[(size_t)row * 16 + u.pn * 4 + wc] = s; }
    }
};
struct EpiRelu2 {
    static constexpr bool PERM = true, AFTER_DRAIN = false;
    bf16_t* U;
    __device__ __forceinline__ void operator()(const f32x4 (&acc)[2][2][4][2], const Unit& u, int wr, int wc, int fr, int fq) const {
        asm volatile("" : "+v"(fr), "+v"(fq));
        const int row0 = u.pm * BM + wr * 64 + fr, cl = u.pn * BM + wc * 32 + 8 * fq;
#pragma unroll
        for (int ai = 0; ai < 2; ++ai)
#pragma unroll
            for (int m = 0; m < 4; ++m) { const int row = row0 + ai * HALF + m * 16;
#pragma unroll
                for (int bj = 0; bj < 2; ++bj) { float v[8]; ld8(v, acc[ai][bj][m][0], acc[ai][bj][m][1]);
#pragma unroll
                    for (int j = 0; j < 8; ++j) { const float r = __builtin_fmaxf(v[j], 0.f); v[j] = r * r; }
                    *(u32x4*)(U + (size_t)row * DFF + cl + bj * HALF) = pack8(v); } }
    }
};
template <class Epi, class Sched, bool ALIGN_EPI = false, bool SP2 = false>
__device__ __forceinline__ void gemm_phase(PG8_LAS unsigned char* lds, const Gemm g, const Sched& S, const Epi& E) {
    int tid_ = threadIdx.x; asm volatile("" : "+v"(tid_));
    const int tid = tid_, wid = __builtin_amdgcn_readfirstlane(tid >> 6), lane = tid & 63, wr = wid >> 2, wc = wid & 3, fr = lane & 15, fq = lane >> 4;
    const int K = g.K, nt = K / BK;
    unsigned voffA[2], voffB[2];
#pragma unroll
    for (int i = 0; i < 2; ++i) { int R, C; stage_rc(tid * 16 + i * 8192, R, C); const int Rb = Epi::PERM ? ((R & ~31) + perm32(R & 31)) : R;
        voffA[i] = (unsigned)(R * K + C) * 2u; voffB[i] = (unsigned)(Rb * K + C) * 2u; }
    const size_t kstep = (size_t)(BK * 2);
    const size_t hstep = (size_t)HALF * K * 2;
    const size_t tstep = 2 * hstep;
    const unsigned ldsw = (unsigned)wid * 1024u;
    const int aoff = lds_byte(wr * 64 + fr, fq * 8), boff = lds_byte(wc * 32 + fr, fq * 8);
#define PG8_SA(b, h) (((b) * 2 + (h)) * HTB)
#define PG8_SB(b, h) ((4 + (b) * 2 + (h)) * HTB)
#define PG8_STAGE(bufoff, gbase, voff) do { _Pragma("unroll") for (int _i = 0; _i < 2; ++_i) \
        __builtin_amdgcn_global_load_lds((const unsigned*)((const char*)(gbase) + (voff)[_i]), (PG8_LAS unsigned*)(lds + (bufoff) + ldsw + _i * 8192), 16, 0, 0); } while (0)
#define PG8_LDA(dst, b, h) do { _Pragma("unroll") for (int m = 0; m < 4; ++m) _Pragma("unroll") for (int k = 0; k < 2; ++k) dst[m][k] = *(const PG8_LAS bf16x8*)(lds + PG8_SA(b, h) + aoff + m * 2048 + k * 1024); } while (0)
#define PG8_LDB(dst, b, h) do { _Pragma("unroll") for (int n = 0; n < 2; ++n) _Pragma("unroll") for (int k = 0; k < 2; ++k) dst[n][k] = *(const PG8_LAS bf16x8*)(lds + PG8_SB(b, h) + boff + n * 2048 + k * 1024); } while (0)
#define PG8_MMA(ai, bj, At, Bt) do { __builtin_amdgcn_s_setprio(1); _Pragma("unroll") for (int m = 0; m < 4; ++m) _Pragma("unroll") for (int n = 0; n < 2; ++n) _Pragma("unroll") for (int k = 0; k < 2; ++k) \
        acc[ai][bj][m][n] = __builtin_amdgcn_mfma_f32_16x16x32_bf16(Bt[n][k], At[m][k], acc[ai][bj][m][n], 0, 0, 0); __builtin_amdgcn_s_setprio(0); } while (0)
#define PG8_WAIT_V(n) asm volatile("s_waitcnt vmcnt(" #n ")" ::: "memory")
#define PG8_WAIT_L(n) asm volatile("s_waitcnt lgkmcnt(" #n ")" ::: "memory")
#define PG8_BAR __builtin_amdgcn_s_barrier()
#define PG8_SCHED __builtin_amdgcn_sched_barrier(0)
    Unit cur, nxt; int ui = 0;
    if (!S.next(0, cur)) return;
    f32x4 acc[2][2][4][2];
#pragma unroll
    for (int a = 0; a < 2; ++a)
#pragma unroll
        for (int b = 0; b < 2; ++b)
#pragma unroll
            for (int m = 0; m < 4; ++m)
#pragma unroll
                for (int n = 0; n < 2; ++n) acc[a][b][m][n] = (f32x4){0.f, 0.f, 0.f, 0.f};
    bf16x8 At[4][2], B0[2][2], B1[2][2];
    const char* cA = (const char*)g.A + (size_t)cur.pm * tstep; const char* cB = (const char*)g.Bt + (size_t)cur.pn * tstep;
    S.a_ready(cur);
    if constexpr (SP2) {
        PG8_STAGE(PG8_SB(0, 0), cB, voffB); PG8_STAGE(PG8_SB(0, 1), cB + hstep, voffB); PG8_STAGE(PG8_SA(0, 0), cA, voffA); PG8_STAGE(PG8_SA(0, 1), cA + hstep, voffA);
        if (wr == 1) PG8_BAR;
        PG8_WAIT_V(2); PG8_BAR;
        PG8_STAGE(PG8_SB(1, 0), cB + kstep, voffB); PG8_STAGE(PG8_SA(1, 0), cA + kstep, voffA); PG8_STAGE(PG8_SB(1, 1), cB + hstep + kstep, voffB);
        PG8_WAIT_V(6); PG8_BAR;
    } else {
        PG8_STAGE(PG8_SB(0, 0), cB, voffB); PG8_STAGE(PG8_SA(0, 0), cA, voffA); PG8_STAGE(PG8_SB(0, 1), cB + hstep, voffB); PG8_STAGE(PG8_SA(0, 1), cA + hstep, voffA);
        if (wr == 1) PG8_BAR;
        PG8_WAIT_V(4); PG8_BAR;
        PG8_STAGE(PG8_SB(1, 0), cB + kstep, voffB); PG8_STAGE(PG8_SA(1, 0), cA + kstep, voffA); PG8_STAGE(PG8_SB(1, 1), cB + hstep + kstep, voffB);
        PG8_WAIT_V(6); PG8_BAR;
    }
    for (;;) {
        const bool has_next = S.next(ui + 1, nxt);
        const char* nA = has_next ? (const char*)g.A + (size_t)nxt.pm * tstep : cA; const char* nB = has_next ? (const char*)g.Bt + (size_t)nxt.pn * tstep : cB;
#pragma unroll 1
        for (int t = 0; t < nt; t += 2) {
            const bool last = (t == nt - 2);
            const char* a1 = cA + (size_t)(t + 1) * kstep;
            const char* a2 = last ? nA : cA + (size_t)(t + 2) * kstep; const char* b2 = last ? nB : cB + (size_t)(t + 2) * kstep;
            const char* a3 = a2 + kstep; const char* b3 = b2 + kstep;
            if (last && has_next) S.a_ready(nxt);
            if constexpr (SP2) {
            PG8_LDB(B0, 0, 0); PG8_LDB(B1, 0, 1); PG8_SCHED; PG8_LDA(At, 0, 0); PG8_STAGE(PG8_SA(1, 1), a1 + hstep, voffA);
            PG8_WAIT_V(8); PG8_WAIT_L(0); PG8_BAR; PG8_MMA(0, 0, At, B0); PG8_MMA(0, 1, At, B1); PG8_BAR; PG8_SCHED;
            PG8_LDA(At, 0, 1); PG8_STAGE(PG8_SB(0, 0), b2, voffB); PG8_STAGE(PG8_SB(0, 1), b2 + hstep, voffB); PG8_STAGE(PG8_SA(0, 0), a2, voffA);
            PG8_WAIT_V(8); PG8_WAIT_L(0); PG8_BAR; PG8_MMA(1, 0, At, B0); PG8_MMA(1, 1, At, B1); PG8_BAR; PG8_SCHED;
            PG8_LDB(B0, 1, 0); PG8_LDB(B1, 1, 1); PG8_SCHED; PG8_LDA(At, 1, 0); PG8_STAGE(PG8_SA(0, 1), a2 + hstep, voffA);
            PG8_WAIT_V(8); PG8_WAIT_L(0); PG8_BAR; PG8_MMA(0, 0, At, B0); PG8_MMA(0, 1, At, B1); PG8_BAR; PG8_SCHED;
            PG8_LDA(At, 1, 1); PG8_STAGE(PG8_SB(1, 0), b3, voffB); PG8_STAGE(PG8_SB(1, 1), b3 + hstep, voffB); PG8_STAGE(PG8_SA(1, 0), a3, voffA);
            PG8_WAIT_V(8); PG8_WAIT_L(0); PG8_BAR; PG8_MMA(1, 0, At, B0); PG8_MMA(1, 1, At, B1); PG8_BAR; PG8_SCHED;
            } else {
            PG8_LDB(B0, 0, 0); PG8_SCHED; PG8_LDA(At, 0, 0); PG8_STAGE(PG8_SA(1, 1), a1 + hstep, voffA);
            PG8_WAIT_L(8); PG8_BAR; PG8_WAIT_L(0); PG8_MMA(0, 0, At, B0); PG8_BAR; PG8_SCHED;
            PG8_LDB(B1, 0, 1); PG8_STAGE(PG8_SB(0, 0), b2, voffB);
            PG8_BAR; PG8_WAIT_L(0); PG8_MMA(0, 1, At, B1); PG8_BAR;
            PG8_LDA(At, 0, 1); PG8_STAGE(PG8_SA(0, 0), a2, voffA);
            PG8_BAR; PG8_WAIT_L(0); PG8_MMA(1, 0, At, B0); PG8_BAR; PG8_SCHED;
            PG8_STAGE(PG8_SB(0, 1), b2 + hstep, voffB);
            PG8_WAIT_V(6); PG8_BAR; PG8_MMA(1, 1, At, B1); PG8_BAR;
            PG8_LDB(B0, 1, 0); PG8_SCHED; PG8_LDA(At, 1, 0); PG8_STAGE(PG8_SA(0, 1), a2 + hstep, voffA);
            PG8_WAIT_L(8); PG8_BAR; PG8_WAIT_L(0); PG8_MMA(0, 0, At, B0); PG8_BAR; PG8_SCHED;
            PG8_LDB(B1, 1, 1); PG8_STAGE(PG8_SB(1, 0), b3, voffB);
            PG8_BAR; PG8_WAIT_L(0); PG8_MMA(0, 1, At, B1); PG8_BAR;
            PG8_LDA(At, 1, 1); PG8_STAGE(PG8_SA(1, 0), a3, voffA);
            PG8_BAR; PG8_WAIT_L(0); PG8_MMA(1, 0, At, B0); PG8_BAR; PG8_SCHED;
            PG8_STAGE(PG8_SB(1, 1), b3 + hstep, voffB);
            PG8_WAIT_V(6); PG8_BAR; PG8_MMA(1, 1, At, B1); PG8_BAR;
            }
        }
        if constexpr (ALIGN_EPI) { if (wr == 0) PG8_BAR; }
        if constexpr (!Epi::AFTER_DRAIN) { E(acc, cur, wr, wc, fr, fq); S.done(cur); }
        if (!has_next) break;
#pragma unroll
        for (int a = 0; a < 2; ++a)
#pragma unroll
            for (int b = 0; b < 2; ++b)
#pragma unroll
                for (int m = 0; m < 4; ++m)
#pragma unroll
                    for (int n = 0; n < 2; ++n) acc[a][b][m][n] = (f32x4){0.f, 0.f, 0.f, 0.f};
        cur = nxt; cA = nA; cB = nB; ++ui;
        if constexpr (ALIGN_EPI) { if (wr == 1) PG8_BAR; }
    }
    PG8_WAIT_V(0);
    if constexpr (!ALIGN_EPI) { if (wr == 0) PG8_BAR; }
    PG8_BAR;
    if constexpr (Epi::AFTER_DRAIN) { E.fused(acc, cur, wr, wc, fr, fq, lds, wid, lane); S.done(cur); }
#undef PG8_SA
#undef PG8_SB
#undef PG8_STAGE
#undef PG8_LDA
#undef PG8_LDB
#undef PG8_MMA
#undef PG8_WAIT_V
#undef PG8_WAIT_L
#undef PG8_BAR
#undef PG8_SCHED
}
}
namespace att {
typedef unsigned short bf16_t;
typedef short bf16x8 __attribute__((ext_vector_type(8)));
typedef short s16x4 __attribute__((ext_vector_type(4)));
typedef float f32x16 __attribute__((ext_vector_type(16)));
typedef float f32x4 __attribute__((ext_vector_type(4)));
typedef unsigned u32x4 __attribute__((ext_vector_type(4)));
#define ALDS __attribute__((address_space(3)))
#define ASBAR() __builtin_amdgcn_sched_barrier(0)
constexpr int KTB = 12288, VTB = 8192;
constexpr int L_K = 0, L_V = 2 * KTB, L_WS = L_V + 2 * VTB, L_OST = L_WS + 8 * 256, L_KM = L_OST + 8 * 4096, L_RED = L_KM + 2048, L_END = L_RED + 16384;
constexpr float THR = 8.f;
__device__ __forceinline__ int crow(int r, int hi) { return (r & 3) + 8 * (r >> 2) + 4 * hi; }
typedef float f32x2a_t __attribute__((ext_vector_type(2))); typedef __bf16 bf16x2a_t __attribute__((ext_vector_type(2)));
__device__ __forceinline__ unsigned cvtpk(float lo, float hi) { const f32x2a_t v = {lo, hi}; const bf16x2a_t b = __builtin_convertvector(v, bf16x2a_t); return __builtin_bit_cast(unsigned, b); }
__device__ __forceinline__ float bf2f(short s) { return __uint_as_float(((unsigned)(unsigned short)s) << 16); }
__device__ __forceinline__ int v_st(int k, int c) { const int kk = (k & ~0xC) | ((k & 4) << 1) | ((k & 8) >> 1); return ((kk >> 3) * 2 + (c >> 5)) * 512 + ((kk & 7) * 32 + (c & 31)) * 2; }
__device__ __forceinline__ int v_rd_base(int lane) { return ((lane & 3) << 3) | (((lane >> 2) & 3) << 6) | (((lane >> 4) & 1) << 5) | (((lane >> 5) & 1) << 8); }
constexpr int v_rd_off(int d0, int ks, int half) { return ks * 2048 + half * 1024 + d0 * 512; }
template <int OFF> __device__ __forceinline__ s16x4 tr_read(int vb) { s16x4 r; asm volatile("ds_read_b64_tr_b16 %0, %1 offset:%2" : "=&v"(r) : "v"(vb), "i"(OFF) : "memory"); return r; }
template <int D0> __device__ __forceinline__ void pv_one(f32x16& od, int vb, bf16x8 pa0, bf16x8 pa1, bf16x8 pa2, bf16x8 pa3) {
    const s16x4 l0 = tr_read<v_rd_off(D0, 0, 0)>(vb), h0 = tr_read<v_rd_off(D0, 0, 1)>(vb), l1 = tr_read<v_rd_off(D0, 1, 0)>(vb), h1 = tr_read<v_rd_off(D0, 1, 1)>(vb);
    const s16x4 l2 = tr_read<v_rd_off(D0, 2, 0)>(vb), h2 = tr_read<v_rd_off(D0, 2, 1)>(vb), l3 = tr_read<v_rd_off(D0, 3, 0)>(vb), h3 = tr_read<v_rd_off(D0, 3, 1)>(vb);
    asm volatile("s_waitcnt lgkmcnt(0)" ::: "memory"); ASBAR();
#define ATT_PK(L, H) (bf16x8){L[0], L[1], L[2], L[3], H[0], H[1], H[2], H[3]}
    od = __builtin_amdgcn_mfma_f32_32x32x16_bf16(pa0, ATT_PK(l0, h0), od, 0, 0, 0);
    od = __builtin_amdgcn_mfma_f32_32x32x16_bf16(pa1, ATT_PK(l1, h1), od, 0, 0, 0);
    od = __builtin_amdgcn_mfma_f32_32x32x16_bf16(pa2, ATT_PK(l2, h2), od, 0, 0, 0);
    od = __builtin_amdgcn_mfma_f32_32x32x16_bf16(pa3, ATT_PK(l3, h3), od, 0, 0, 0);
#undef ATT_PK
}
__device__ __forceinline__ void pv_all(f32x16* o, int vb, bf16x8 pa0, bf16x8 pa1, bf16x8 pa2, bf16x8 pa3) { pv_one<0>(o[0], vb, pa0, pa1, pa2, pa3); pv_one<1>(o[1], vb, pa0, pa1, pa2, pa3); }
__device__ __forceinline__ void partialSM(f32x16& p0, f32x16& p1, float& m_reg, float& alpha) {
    float pmax = p0[0];
#pragma unroll
    for (int r = 1; r < 16; ++r) pmax = fmaxf(pmax, p0[r]);
#pragma unroll
    for (int r = 0; r < 16; ++r) pmax = fmaxf(pmax, p1[r]);
    { auto rr = __builtin_amdgcn_permlane32_swap(__float_as_uint(pmax), __float_as_uint(pmax), false, false); pmax = fmaxf(__uint_as_float(rr[0]), __uint_as_float(rr[1])); }
    float mn;
    if (__builtin_expect(__all(pmax - m_reg <= THR), 1)) { mn = m_reg; alpha = 1.f; }
    else { mn = fmaxf(m_reg, pmax); alpha = __builtin_amdgcn_exp2f(m_reg - mn); m_reg = mn; }
#pragma unroll
    for (int r = 0; r < 16; ++r) p0[r] = __builtin_amdgcn_exp2f(p0[r] - mn);
#pragma unroll
    for (int r = 0; r < 16; ++r) p1[r] = p1[r] - mn;
}
__device__ __forceinline__ void finishSM(f32x16& p0, f32x16& p1, float alpha, float& l_reg, bf16x8& pa0, bf16x8& pa1, bf16x8& pa2, bf16x8& pa3) {
#pragma unroll
    for (int r = 0; r < 16; ++r) p1[r] = __builtin_amdgcn_exp2f(p1[r]);
    float ps = 0.f;
#pragma unroll
    for (int r = 0; r < 16; ++r) ps += p0[r];
#pragma unroll
    for (int r = 0; r < 16; ++r) ps += p1[r];
    { auto rr = __builtin_amdgcn_permlane32_swap(__float_as_uint(ps), __float_as_uint(ps), false, false); ps = __uint_as_float(rr[0]) + __uint_as_float(rr[1]); }
    l_reg = l_reg * alpha + ps;
#define ATT_PK4(P, BASE, OUT) do { unsigned a0 = cvtpk(P[BASE + 0], P[BASE + 1]), a1 = cvtpk(P[BASE + 2], P[BASE + 3]);   \
    unsigned b0 = cvtpk(P[BASE + 4], P[BASE + 5]), b1 = cvtpk(P[BASE + 6], P[BASE + 7]);                              \
    auto r0 = __builtin_amdgcn_permlane32_swap(a0, b0, false, false); auto r1 = __builtin_amdgcn_permlane32_swap(a1, b1, false, false); \
    u32x4 w = {r0[0], r1[0], r0[1], r1[1]}; OUT = __builtin_bit_cast(bf16x8, w); } while (0)
    ATT_PK4(p0, 0, pa0); ATT_PK4(p0, 8, pa1); ATT_PK4(p1, 0, pa2); ATT_PK4(p1, 8, pa3);
#undef ATT_PK4
}
template <int ND> __device__ __forceinline__ void qkt(f32x16& p0, f32x16& p1, ALDS const char* Kb, const int (&ka)[ND], const bf16x8 (&qr)[ND]) {
    p0 = f32x16{}; p1 = f32x16{};
#pragma unroll
    for (int d0 = 0; d0 < ND; ++d0) {
        const bf16x8 b0 = *(ALDS const bf16x8*)(Kb + ka[d0]);
        const bf16x8 b1 = *(ALDS const bf16x8*)(Kb + ka[d0] + (d0 < 4 ? 4096 : 2048));
        p0 = __builtin_amdgcn_mfma_f32_32x32x16_bf16(b0, qr[d0], p0, 0, 0, 0);
        p1 = __builtin_amdgcn_mfma_f32_32x32x16_bf16(b1, qr[d0], p1, 0, 0, 0);
        if (ND > 4 && d0 == 2) asm volatile("" ::: "memory"); }
}
template <bool MOBA> __device__ __forceinline__ void tmask(f32x16& p0, f32x16& p1, int t, int qb, int qrel, int hi, unsigned sel) {
    const float NEG = -INFINITY;
    if (t >= 4 * qb) { const int thr = qrel - 64 * (t - 4 * qb) - 4 * hi;
#pragma unroll
        for (int r = 0; r < 16; ++r) { if ((r & 3) + 8 * (r >> 2) > thr) p0[r] = NEG; if ((r & 3) + 8 * (r >> 2) + 32 > thr) p1[r] = NEG; } }
    else if (MOBA) { if (!((sel >> (t >> 2)) & 1u)) {
#pragma unroll
        for (int r = 0; r < 16; ++r) { p0[r] = NEG; p1[r] = NEG; } } }
}
__device__ __forceinline__ void kmean_blocks(const bf16_t* Kp, ALDS char* lds) {
    int tid_ = threadIdx.x; asm volatile("" : "+v"(tid_));
    const int tid = tid_, lane = tid & 63, wid = tid >> 6, c = tid & 7, rg = tid >> 3;
    ALDS float* red = (ALDS float*)(lds + L_RED); ALDS float* km = (ALDS float*)(lds + L_KM);
#pragma unroll 1
    for (int n = 0; n < 8; ++n) {
        float a[8];
#pragma unroll
        for (int j = 0; j < 8; ++j) a[j] = 0.f;
#pragma unroll
        for (int i = 0; i < 4; ++i) { const bf16x8 kx = *(const bf16x8*)(Kp + (size_t)(n * 256 + rg + 64 * i) * AW + c * 8);
#pragma unroll
            for (int j = 0; j < 8; ++j) a[j] += bf2f(kx[j]); }
#pragma unroll
        for (int j = 0; j < 8; ++j) { a[j] += __shfl_xor(a[j], 8); a[j] += __shfl_xor(a[j], 16); a[j] += __shfl_xor(a[j], 32); }
        if (lane < 8) {
#pragma unroll
            for (int j = 0; j < 8; ++j) red[(n * 8 + wid) * 64 + c * 8 + j] = a[j]; }
    }
    __syncthreads();
    { const int n = tid >> 6, d = tid & 63; float s = 0.f;
#pragma unroll
        for (int w = 0; w < 8; ++w) s += red[(n * 8 + w) * 64 + d];
        km[n * 64 + d] = s * (1.0f / 256.0f); }
    __syncthreads();
}
template <int DQK, bool MOBA>
__device__ __forceinline__ void attn_unit(const bf16_t* Qp, int ldq, const bf16_t* Kp, const bf16_t* KRp, const bf16_t* Vp, bf16_t* Op, int qb, ALDS char* lds) {
    constexpr int ND = DQK / 16;
    int tid_ = threadIdx.x; asm volatile("" : "+v"(tid_));
    const int tid = tid_, lane = tid & 63, r32 = lane & 31, hi = lane >> 5; const int wid = __builtin_amdgcn_readfirstlane(tid >> 6);
    ALDS char* K_lds = lds + L_K; ALDS char* V_lds = lds + L_V;
    ALDS float* ws = (ALDS float*)(lds + L_WS) + wid * 64; ALDS float* li_l = ws; ALDS float* al_l = ws + 32;
    float m_reg = -1e30f, l_reg = 0.f; f32x16 o[2]; o[0] = f32x16{}; o[1] = f32x16{}; bf16x8 qr[ND];
    { const bf16_t* Qw = Qp + (size_t)(wid * 32 + r32) * ldq + hi * 8;
#pragma unroll
      for (int d0 = 0; d0 < ND; ++d0) qr[d0] = *(const bf16x8*)(Qw + d0 * 16); }
    unsigned sel = 0xffu;
    if (MOBA && qb > 3) {
        ALDS const float* km = (ALDS const float*)(lds + L_KM); float g[8];
#pragma unroll
        for (int n = 0; n < 8; ++n) { float s = 0.f;
#pragma unroll
            for (int d0 = 0; d0 < ND; ++d0)
#pragma unroll
                for (int j = 0; j < 8; ++j) s += bf2f(qr[d0][j]) * km[n * 64 + d0 * 16 + hi * 8 + j];
            g[n] = s; }
#pragma unroll
        for (int n = 0; n < 8; ++n) g[n] += __shfl_xor(g[n], 32);
        sel = 0u;
#pragma unroll
        for (int n = 0; n < 8; ++n) { int rank = 0;
#pragma unroll
            for (int mm = 0; mm < 8; ++mm) if (mm != n) rank += (mm < qb && (g[mm] > g[n] || (g[mm] == g[n] && mm < n))) ? 1 : 0;
            if (n < qb && rank < 3) sel |= 1u << n; }
    }
    const int skey = tid >> 3, sch = tid & 7;
    const unsigned koff = (unsigned)(skey * AW + sch * 8) * 2u;
    const int kst = skey * 128 + ((sch ^ ((skey >> 1) & 7)) << 4), vst = v_st(skey, sch * 8);
    const int t2 = tid & 255, rkey = t2 >> 2, rch = t2 & 3;
    const unsigned roff = (unsigned)(rkey * RDIM + rch * 8) * 2u;
    const int rst = 8192 + rkey * 64 + ((rch ^ ((rkey >> 2) & 3)) << 4);
    int ka[ND];
#pragma unroll
    for (int d0 = 0; d0 < ND; ++d0) ka[d0] = (d0 < 4) ? r32 * 128 + (((2 * d0 + hi) ^ ((r32 >> 1) & 7)) << 4) : 8192 + r32 * 64 + (((2 * (d0 - 4) + hi) ^ ((r32 >> 2) & 3)) << 4);
    const int vb0 = (int)(unsigned)(uintptr_t)V_lds + v_rd_base(lane);
    const int qrel = wid * 32 + r32;
    bf16x8 sk0, sv0, sr0, sk1, sv1, sr1;
#define ATT_SLOAD(S, k0) do { sk##S = *(const bf16x8*)((const char*)(Kp + (size_t)(k0) * AW) + koff); sv##S = *(const bf16x8*)((const char*)(Vp + (size_t)(k0) * AW) + koff); if (DQK == 96) sr##S = *(const bf16x8*)((const char*)(KRp + (size_t)(k0) * RDIM) + roff); } while (0)
#define ATT_SWRITE(b, S) do { *(ALDS bf16x8*)(K_lds + (b) * KTB + kst) = sk##S; *(ALDS bf16x8*)(V_lds + (b) * VTB + vst) = sv##S; if (DQK == 96) { if (tid < 256) *(ALDS bf16x8*)(K_lds + (b) * KTB + rst) = sr##S; } } while (0)
#define ATT_RESC(a) do { if (__any((a) < 1.f)) { if (hi == 0) al_l[r32] = (a); asm volatile("s_waitcnt lgkmcnt(0)" ::: "memory"); \
    _Pragma("unroll") for (int d = 0; d < 2; ++d) _Pragma("unroll") for (int r = 0; r < 16; ++r) o[d][r] *= al_l[crow(r, hi)]; } } while (0)
    f32x16 pA0, pA1, pB0, pB1; float alA, alB; bf16x8 pa0, pa1, pa2, pa3; const int NT = 4 * (qb + 1);
    ATT_SLOAD(0, 0); ATT_SWRITE(0, 0); __syncthreads();
    qkt<ND>(pA0, pA1, K_lds, ka, qr); tmask<MOBA>(pA0, pA1, 0, qb, qrel, hi, sel); partialSM(pA0, pA1, m_reg, alA);
    ATT_SLOAD(1, 64); ATT_SLOAD(0, 128);
    ATT_SWRITE(1, 1); __syncthreads();
    for (int j = 1; j + 1 < NT; j += 2) {
        ASBAR(); qkt<ND>(pB0, pB1, K_lds + KTB, ka, qr); tmask<MOBA>(pB0, pB1, j, qb, qrel, hi, sel);
        finishSM(pA0, pA1, alA, l_reg, pa0, pa1, pa2, pa3); ASBAR();
        ATT_SLOAD(1, (j + 2) * 64); ASBAR();
        pv_all(o, vb0, pa0, pa1, pa2, pa3); partialSM(pB0, pB1, m_reg, alB);
        __syncthreads(); ATT_SWRITE(0, 0);
        ATT_RESC(alB); __syncthreads();
        ASBAR(); qkt<ND>(pA0, pA1, K_lds, ka, qr); tmask<MOBA>(pA0, pA1, j + 1, qb, qrel, hi, sel);
        finishSM(pB0, pB1, alB, l_reg, pa0, pa1, pa2, pa3); ASBAR();
        if (j + 3 < NT) ATT_SLOAD(0, (j + 3) * 64); ASBAR();
        pv_all(o, vb0 + VTB, pa0, pa1, pa2, pa3); partialSM(pA0, pA1, m_reg, alA);
        __syncthreads(); ATT_SWRITE(1, 1);
        ATT_RESC(alA); __syncthreads();
    }
    ASBAR(); qkt<ND>(pB0, pB1, K_lds + KTB, ka, qr); tmask<MOBA>(pB0, pB1, NT - 1, qb, qrel, hi, sel);
    finishSM(pA0, pA1, alA, l_reg, pa0, pa1, pa2, pa3); ASBAR();
    pv_all(o, vb0, pa0, pa1, pa2, pa3); partialSM(pB0, pB1, m_reg, alB);
    __syncthreads(); ATT_RESC(alB);
    finishSM(pB0, pB1, alB, l_reg, pa0, pa1, pa2, pa3); ASBAR();
    pv_all(o, vb0 + VTB, pa0, pa1, pa2, pa3);
    if (hi == 0) li_l[r32] = l_reg; asm volatile("s_waitcnt lgkmcnt(0)" ::: "memory");
    float rli[16];
#pragma unroll
    for (int r = 0; r < 16; ++r) rli[r] = __builtin_amdgcn_rcpf(li_l[crow(r, hi)]);
    { ALDS unsigned short* stg = (ALDS unsigned short*)(lds + L_OST) + wid * 2048;
#pragma unroll
      for (int r = 0; r < 16; ++r) { const int orow = crow(r, hi);
#pragma unroll
          for (int d0 = 0; d0 < 2; ++d0) stg[orow * 64 + d0 * 32 + r32] = (unsigned short)(cvtpk(o[d0][r] * rli[r], 0.f) & 0xffffu); }
      asm volatile("s_waitcnt lgkmcnt(0)" ::: "memory");
      bf16_t* Ow = Op + (size_t)(wid * 32) * AW;
#pragma unroll
      for (int i = 0; i < 4; ++i) { const int row = i * 8 + (lane >> 3), ch = lane & 7; const u32x4 v = *(ALDS const u32x4*)(stg + row * 64 + ch * 8); *(u32x4*)(Ow + (size_t)row * AW + ch * 8) = v; } }
    __syncthreads();
#undef ATT_SLOAD
#undef ATT_SWRITE
#undef ATT_RESC
}
#undef ASBAR
}
#if defined(DBG_NAIVE_ATTN) || defined(DBG_CHECK)
namespace dbg {
typedef unsigned short bf16_t;
typedef short bf16x8 __attribute__((ext_vector_type(8)));
__device__ __forceinline__ float bf2f(short s) { return __uint_as_float(((unsigned)(unsigned short)s) << 16); }
__device__ __forceinline__ unsigned short f2bf_(float f) { unsigned u = __builtin_bit_cast(unsigned, f); return (unsigned short)((u + 0x7fffu + ((u >> 16) & 1u)) >> 16); }
__global__ void __launch_bounds__(512) kmean_k(const bf16_t* KA, float* KM) {
    const int bh = blockIdx.x, b = bh >> 3, h = bh & 7, n = threadIdx.x >> 6, d = threadIdx.x & 63; float s = 0.f;
    const bf16_t* Kp = KA + (size_t)b * SEQ * AW + h * HD;
#pragma unroll 4
    for (int r = 0; r < 256; ++r) s += bf2f((short)Kp[(size_t)(n * 256 + r) * AW + d]);
    KM[(size_t)bh * 512 + n * 64 + d] = s * (1.0f / 256.0f);
}
template <int DQK, bool MOBA>
__global__ void __launch_bounds__(256) attn_k(const bf16_t* Q, const bf16_t* K, const bf16_t* KR, const bf16_t* V, bf16_t* O, const float* KM) {
    constexpr int ldq = (DQK == 96) ? NHEAD * QKB : AW;
    const int bh = blockIdx.y, b = bh >> 3, h = bh & 7, tid = threadIdx.x;
    const size_t r0 = (size_t)b * SEQ;
    const bf16_t* Qp = Q + r0 * ldq + h * (DQK == 96 ? QKB : HD); const bf16_t* Kp = K + r0 * AW + h * HD; const bf16_t* Vp = V + r0 * AW + h * HD; const bf16_t* KRp = (DQK == 96) ? KR + r0 * RDIM : K;
    bf16_t* Op = O + r0 * AW + h * HD; const float* km = KM + (size_t)bh * 512;
    const int row = blockIdx.x * 64 + (tid >> 2), qb = row >> 8, c4 = tid & 3;
    bf16x8 q[DQK / 8];
#pragma unroll
    for (int c = 0; c < DQK / 8; ++c) q[c] = *(const bf16x8*)(Qp + (size_t)row * ldq + c * 8);
    unsigned sel = 0xffu;
    if (MOBA && qb > 3) {
        float g[8];
#pragma unroll
        for (int n = 0; n < 8; ++n) { float s = 0.f;
#pragma unroll
            for (int c = 0; c < 8; ++c)
#pragma unroll
                for (int j = 0; j < 8; ++j) s += bf2f(q[c][j]) * km[n * 64 + c * 8 + j];
            g[n] = s; }
        sel = 0u;
#pragma unroll
        for (int n = 0; n < 8; ++n) { int rank = 0;
#pragma unroll
            for (int mm = 0; mm < 8; ++mm) if (mm != n) rank += (mm < qb && (g[mm] > g[n] || (g[mm] == g[n] && mm < n))) ? 1 : 0;
            if (n < qb && rank < 3) sel |= 1u << n; }
    }
    float o[16];
#pragma unroll
    for (int d = 0; d < 16; ++d) o[d] = 0.f;
    float mx = -1e30f, l = 0.f;
#pragma unroll 1
    for (int key = 0; key <= row; ++key) {
        const int n = key >> 8;
        if (MOBA && n < qb && !((sel >> n) & 1u)) { key = (n << 8) + 255; continue; }
        float s = 0.f;
#pragma unroll
        for (int c = 0; c < 8; ++c) { const bf16x8 kx = *(const bf16x8*)(Kp + (size_t)key * AW + c * 8);
#pragma unroll
            for (int j = 0; j < 8; ++j) s += bf2f(q[c][j]) * bf2f(kx[j]); }
        if (DQK == 96) {
#pragma unroll
            for (int c = 0; c < 4; ++c) { const bf16x8 kx = *(const bf16x8*)(KRp + (size_t)key * RDIM + c * 8);
#pragma unroll
                for (int j = 0; j < 8; ++j) s += bf2f(q[(DQK == 96 ? 8 : 0) + c][j]) * bf2f(kx[j]); }
        }
        const float mn = fmaxf(mx, s), a = __builtin_amdgcn_exp2f(mx - mn), p = __builtin_amdgcn_exp2f(s - mn);
        l = l * a + p; mx = mn;
#pragma unroll
        for (int c = 0; c < 2; ++c) { const bf16x8 vx = *(const bf16x8*)(Vp + (size_t)key * AW + c4 * 16 + c * 8);
#pragma unroll
            for (int j = 0; j < 8; ++j) o[c * 8 + j] = o[c * 8 + j] * a + p * bf2f(vx[j]); }
    }
    const float rl = 1.f / l;
    __syncthreads();
#pragma unroll
    for (int d = 0; d < 16; ++d) Op[(size_t)row * AW + c4 * 16 + d] = f2bf_(o[d] * rl);
}
}
#endif
#define GAS __attribute__((address_space(1)))
#define LAS __attribute__((address_space(3)))
typedef unsigned short bf16;
typedef unsigned v4u __attribute__((ext_vector_type(4)));
typedef float f32x4 __attribute__((ext_vector_type(4)));
typedef short bf16x8 __attribute__((ext_vector_type(8)));
typedef GAS unsigned gu32;
typedef GAS unsigned long long gu64;
#define RLX_AGENT __ATOMIC_RELAXED, __HIP_MEMORY_SCOPE_AGENT
#define LDS_WAIT() asm volatile("s_waitcnt lgkmcnt(0)" ::: "memory")
#define VM_WAIT() asm volatile("s_waitcnt vmcnt(0)" ::: "memory")
__device__ __forceinline__ unsigned long long rt() { return __builtin_amdgcn_s_memrealtime(); }
__device__ __forceinline__ unsigned f2bf(float f) { unsigned u = __builtin_bit_cast(unsigned, f); return (u + 0x7fffu + ((u >> 16) & 1u)) >> 16; }
__device__ __forceinline__ unsigned pk2(float lo, float hi) { return f2bf(lo) | (f2bf(hi) << 16); }

#define XB_TMO      128
#define XB_XCNT(j)  (256  + 64 * (j))
#define XB_XSUB(j)  (1280 + 64 * (j))
#define XB_XGEN(j)  (2304 + 64 * (j))
#define XB_TOP      3328
#define XB_TOPGEN   3392
#define XCD_BAR_WORDS 3456
#define XB_SPIN_CAP (1u << 18)

__device__ __forceinline__ unsigned xb_ld(unsigned* p)              { return __hip_atomic_load(p, __ATOMIC_RELAXED, __HIP_MEMORY_SCOPE_AGENT); }
__device__ __forceinline__ unsigned xb_add(unsigned* p, unsigned v) { return __hip_atomic_fetch_add(p, v, __ATOMIC_RELAXED, __HIP_MEMORY_SCOPE_AGENT); }
__device__ __forceinline__ unsigned xb_xcc_id() { return (unsigned)__builtin_amdgcn_s_getreg((3 << 11) | 20) & 0xFu; }
#define XB_SPIN(cond, bar) do { unsigned _sp = 0; while (cond) { __builtin_amdgcn_s_sleep(1); \
    if ((++_sp & 255u) == 0u) { if (xb_ld(&(bar)[XB_TMO])) break; if (_sp > XB_SPIN_CAP) { atomicAdd(&(bar)[XB_TMO], 1u); break; } } } } while (0)

struct XcdBarrier {
    unsigned* bar; unsigned x;
    volatile LAS unsigned* st;
};

__device__ __forceinline__ XcdBarrier xcd_barrier_post(unsigned* bar, volatile LAS unsigned* st) {
    XcdBarrier b; b.bar = bar; b.x = xb_xcc_id(); b.st = st;
    if (threadIdx.x == 0) (void)xb_add(&bar[XB_XCNT(b.x)], 1u);
    return b;
}
__device__ __forceinline__ void xcd_barrier_complete(unsigned* bar, unsigned x, unsigned& nloc, unsigned& nx) {
    const unsigned G = gridDim.x * gridDim.y * gridDim.z;
    unsigned sum, cnt, mine, sp = 0u;
    for (;;) {
        sum = 0u; cnt = 0u; mine = 0u;
#pragma unroll
        for (unsigned j = 0; j < 16; ++j) { const unsigned c = xb_ld(&bar[XB_XCNT(j)]); sum += c; cnt += (c > 0u) ? 1u : 0u; mine = (j == x) ? c : mine; }
        if (sum == G) break;
        __builtin_amdgcn_s_sleep(1);
        if ((++sp & 255u) == 0u) { if (xb_ld(&bar[XB_TMO])) break; if (sp > XB_SPIN_CAP) { atomicAdd(&bar[XB_TMO], 1u); break; } }
    }
    nloc = mine > 0u ? mine : 1u; nx = cnt > 0u ? cnt : 1u;
}

__device__ __forceinline__ void xcd_barrier(const XcdBarrier& b) {
    asm volatile("s_waitcnt vmcnt(0)" ::: "memory");
    __syncthreads();
    if (threadIdx.x == 0) {
        unsigned* bar = b.bar;
        __builtin_amdgcn_s_waitcnt(0);
        unsigned nloc = b.st[0], nx = b.st[1];
        if (nloc == 0u) { xcd_barrier_complete(bar, b.x, nloc, nx); b.st[0] = nloc; b.st[1] = nx; }
        const unsigned old = xb_add(&bar[XB_XSUB(b.x)], 1u);
        const unsigned gen = old / nloc;
        if (old + 1u == (gen + 1u) * nloc) {
            __builtin_amdgcn_fence(__ATOMIC_RELEASE, "agent");
            asm volatile("s_waitcnt vmcnt(0)" ::: "memory");
            const unsigned og = xb_add(&bar[XB_TOP], 1u);
            const unsigned tg = og / nx;
            if (og + 1u == (tg + 1u) * nx) xb_add(&bar[XB_TOPGEN], 1u);
            else XB_SPIN(xb_ld(&bar[XB_TOPGEN]) == tg, bar);
            __builtin_amdgcn_fence(__ATOMIC_ACQUIRE, "agent");
            xb_add(&bar[XB_XGEN(b.x)], 1u);
            asm volatile("s_waitcnt vmcnt(0)" ::: "memory");
        } else {
            XB_SPIN(xb_ld(&bar[XB_XGEN(b.x)]) == gen, bar);
            __builtin_amdgcn_fence(__ATOMIC_ACQUIRE, "agent");
            asm volatile("s_waitcnt vmcnt(0)" ::: "memory");
        }
    }
    __syncthreads();
}
#if defined(DBG_CHECK)
namespace chk {
typedef unsigned short bf16_t;
__device__ __forceinline__ float bfv(const bf16_t* p, size_t i) { return __uint_as_float(((unsigned)p[i]) << 16); }
__device__ __forceinline__ unsigned hsh(unsigned x) { x ^= x >> 16; x *= 0x7feb352du; x ^= x >> 15; x *= 0x846ca68bu; x ^= x >> 16; return x; }
__device__ __forceinline__ void report(unsigned* cnt, int stage, float got, float want) {
    atomicAdd(&cnt[64 + stage], 1u);
    if (!(fabsf(got - want) <= 0.04f + 0.04f * fabsf(want))) atomicAdd(&cnt[stage], 1u);
}
__device__ __forceinline__ void cs_of(int pos, int i, int half, float& c, float& s) {
    const float invf = (float)exp2(-(double)i * 18.931568569324174 / (double)half);
    const float ang = (float)pos * invf; double t = (double)ang * 0.15915494309189535; t -= floor(t);
    c = __builtin_amdgcn_cosf((float)t); s = __builtin_amdgcn_sinf((float)t);
}
constexpr int NS = 64 * 256;
__global__ void __launch_bounds__(256) k_c0(const float* x, const float* g, const bf16_t* H, unsigned* cnt) {
    const unsigned id = blockIdx.x * 256 + threadIdx.x, r = hsh(id * 2654435761u + 17u); const int m = r % MTOK, k = (r >> 16) % DM;
    double ss = 0.0; for (int i = 0; i < DM; ++i) { const double v = x[(size_t)m * DM + i]; ss += v * v; }
    const float want = (float)(x[(size_t)m * DM + k] / sqrt(ss / DM + 1e-6) * g[k]);
    report(cnt, 1, bfv(H, (size_t)m * DM + k), want);
}
__device__ __forceinline__ float dot_h(const bf16_t* H, const float* W, int m, int j) { double a = 0.0; for (int k = 0; k < DM; ++k) a += (double)bfv(H, (size_t)m * DM + k) * (double)W[(size_t)k * INW + j]; return (float)a; }
__global__ void __launch_bounds__(256) k_c1(const bf16_t* H, const float* w_in, const float* b_gate, const int* positions, const bf16_t* QA, const bf16_t* KA, const bf16_t* VA, const bf16_t* CQ, const bf16_t* CKV,
                                            const bf16_t* KR, const bf16_t* G, unsigned* cnt) {
    const unsigned id = blockIdx.x * 256 + threadIdx.x, r = hsh(id * 2654435761u + 101u); const int m = r % MTOK; int j;
    { const unsigned r2 = hsh(r + 77u); const int cls = id % 8;
      if (cls == 0) j = (r2 % 8) * 64 + (r2 >> 8) % 16; else if (cls == 1) j = 512 + (r2 % 8) * 64 + (r2 >> 8) % 16; else if (cls == 2) j = 2176 + r2 % 32; else j = r2 % INW; }
    const int pos = positions[m];
    if (j < 1024) { const int sect = j >> 9, jj = j & 511, head = jj >> 6, d = jj & 63; const bf16_t* dst = sect ? KA : QA; const float sc = sect ? 1.f : C2A;
        if (d < 16) { const int i = d & 7; const float x1 = dot_h(H, w_in, m, sect * 512 + head * 64 + i), x2 = dot_h(H, w_in, m, sect * 512 + head * 64 + i + 8); float c, s; cs_of(pos, i, 8, c, s);
            const float want = ((d < 8) ? x1 * c - x2 * s : x2 * c + x1 * s) * sc; report(cnt, sect ? 4 : 2, bfv(dst, (size_t)m * AW + head * 64 + 2 * i + (d >> 3)), want); }
        else report(cnt, sect ? 5 : 3, bfv(dst, (size_t)m * AW + head * 64 + d), dot_h(H, w_in, m, j) * sc); }
    else if (j < 1536) report(cnt, 6, bfv(VA, (size_t)m * AW + (j - 1024)), dot_h(H, w_in, m, j));
    else if (j < 1920) report(cnt, 7, bfv(CQ, (size_t)m * QLORA + (j - 1536)), dot_h(H, w_in, m, j));
    else if (j < 2176) report(cnt, 8, bfv(CKV, (size_t)m * KVLORA + (j - 1920)), dot_h(H, w_in, m, j));
    else if (j < 2208) { const int dd = j - 2176, i = dd & 15; const float x1 = dot_h(H, w_in, m, 2176 + i), x2 = dot_h(H, w_in, m, 2176 + i + 16); float c, s; cs_of(pos, i, 16, c, s);
        report(cnt, 9, bfv(KR, (size_t)m * RDIM + 2 * i + (dd >> 4)), (dd < 16) ? x1 * c - x2 * s : x2 * c + x1 * s); }
    else { const float z = dot_h(H, w_in, m, j) + b_gate[j - 2208]; const float want = 1.f / (1.f + expf(-z)), got = bfv(G, (size_t)m * 2 * DM + (j - 2208)); report(cnt, 10, got, want); report(cnt, 24 + ((j - 2208) >> 8), got, want); }
}
__global__ void __launch_bounds__(256) k_c2(const bf16_t* CQ, const bf16_t* CKV, const float* g_q, const float* w_uq, const float* g_kv, const float* w_ukv, const int* positions, const bf16_t* QB, const bf16_t* KB,
                                            const bf16_t* VB, unsigned* cnt) {
    const unsigned id = blockIdx.x * 256 + threadIdx.x, r = hsh(id * 2654435761u + 303u); const int m = r % MTOK; const unsigned r2 = hsh(r + 5u);
    const int pos = positions[m];
    if (id & 1) { int n = r2 % 768; if ((id & 6) == 2) n = (n / QKB) * QKB + 64 + n % 32;
        double ss = 0.0; for (int k = 0; k < QLORA; ++k) { const double v = bfv(CQ, (size_t)m * QLORA + k); ss += v * v; } const double rs = 1.0 / sqrt(ss / QLORA + 1e-6);
        auto dq = [&](int nn) { double a = 0.0; for (int k = 0; k < QLORA; ++k) a += (double)bfv(CQ, (size_t)m * QLORA + k) * g_q[k] * w_uq[(size_t)k * 768 + nn]; return (float)(a * rs); };
        const int head = n / QKB, pp = n % QKB;
        if (pp < 64) report(cnt, 11, bfv(QB, (size_t)m * 768 + n), dq(n) * C2B);
        else { const int dd = pp - 64, i = dd & 15; const float x1 = dq(head * QKB + 64 + i), x2 = dq(head * QKB + 64 + i + 16); float c, s; cs_of(pos, i, 16, c, s);
            report(cnt, 12, bfv(QB, (size_t)m * 768 + head * QKB + 64 + 2 * i + (dd >> 4)), ((dd < 16) ? x1 * c - x2 * s : x2 * c + x1 * s) * C2B); } }
    else { const int n = r2 % 1024;
        double ss = 0.0; for (int k = 0; k < KVLORA; ++k) { const double v = bfv(CKV, (size_t)m * KVLORA + k); ss += v * v; } const double rs = 1.0 / sqrt(ss / KVLORA + 1e-6);
        double a = 0.0; for (int k = 0; k < KVLORA; ++k) a += (double)bfv(CKV, (size_t)m * KVLORA + k) * g_kv[k] * w_ukv[(size_t)k * 1024 + n];
        const int head = n >> 7, pp = n & 127;
        if (pp < 64) report(cnt, 13, bfv(KB, (size_t)m * AW + head * 64 + pp), (float)(a * rs)); else report(cnt, 14, bfv(VB, (size_t)m * AW + head * 64 + pp - 64), (float)(a * rs)); }
}
__global__ void __launch_bounds__(256) k_c4(const bf16_t* OA, const bf16_t* OB, const bf16_t* G, const float* w_a, const float* w_b, const bf16_t* T, unsigned* cnt) {
    const unsigned id = blockIdx.x * 256 + threadIdx.x, r = hsh(id * 2654435761u + 404u); const int m = r % MTOK, n = (r >> 16) % DM;
    double a = 0.0, b = 0.0; for (int k = 0; k < AW; ++k) { a += (double)bfv(OA, (size_t)m * AW + k) * w_a[(size_t)k * DM + n]; b += (double)bfv(OB, (size_t)m * AW + k) * w_b[(size_t)k * DM + n]; }
    report(cnt, 17, bfv(T, (size_t)m * DM + n), (float)(a * bfv(G, (size_t)m * 2 * DM + n) + b * bfv(G, (size_t)m * 2 * DM + DM + n)));
}
__global__ void __launch_bounds__(256) k_c5(const bf16_t* T, const float* w_out, const bf16_t* Y, unsigned* cnt) {
    const unsigned id = blockIdx.x * 256 + threadIdx.x, r = hsh(id * 2654435761u + 505u); const int m = r % MTOK, n = (r >> 16) % DM;
    double a = 0.0; for (int k = 0; k < DM; ++k) a += (double)bfv(T, (size_t)m * DM + k) * w_out[(size_t)k * DM + n];
    report(cnt, 18, bfv(Y, (size_t)m * DM + n), (float)a);
}
__global__ void __launch_bounds__(256) k_c6(const bf16_t* Y, const float* x, const float* g1, const float* g2, const float* x1, const bf16_t* H2, unsigned* cnt) {
    const unsigned id = blockIdx.x * 256 + threadIdx.x, r = hsh(id * 2654435761u + 606u); const int m = r % MTOK, k = (r >> 16) % DM;
    double ss = 0.0; for (int i = 0; i < DM; ++i) { const double v = bfv(Y, (size_t)m * DM + i); ss += v * v; } const double rs = 1.0 / sqrt(ss / DM + 1e-6);
    double s2 = 0.0, xk = 0.0; for (int i = 0; i < DM; ++i) { const double v = x[(size_t)m * DM + i] + bfv(Y, (size_t)m * DM + i) * rs * g1[i]; s2 += v * v; if (i == k) xk = v; }
    report(cnt, 19, x1[(size_t)m * DM + k], (float)xk);
    report(cnt, 20, bfv(H2, (size_t)m * DM + k), (float)(xk / sqrt(s2 / DM + 1e-6) * g2[k]));
}
__global__ void __launch_bounds__(256) k_c7(const bf16_t* H2, const float* w_up, const bf16_t* U, unsigned* cnt) {
    const unsigned id = blockIdx.x * 256 + threadIdx.x, r = hsh(id * 2654435761u + 707u); const int m = r % MTOK, n = (r >> 16) % DFF;
    double a = 0.0; for (int k = 0; k < DM; ++k) a += (double)bfv(H2, (size_t)m * DM + k) * w_up[(size_t)k * DFF + n];
    const float v = a > 0.0 ? (float)a : 0.f; report(cnt, 21, bfv(U, (size_t)m * DFF + n), v * v);
}
__global__ void __launch_bounds__(256) k_c8(const bf16_t* U, const float* w_dn, const bf16_t* Mo, unsigned* cnt) {
    const unsigned id = blockIdx.x * 256 + threadIdx.x, r = hsh(id * 2654435761u + 808u); const int m = r % MTOK, n = (r >> 16) % DM;
    double a = 0.0; for (int k = 0; k < DFF; ++k) a += (double)bfv(U, (size_t)m * DFF + k) * w_dn[(size_t)k * DM + n];
    report(cnt, 22, bfv(Mo, (size_t)m * DM + n), (float)a);
}
__global__ void __launch_bounds__(256) k_c9a(const bf16_t* Mo, const float* x1, const float* g, float* expv) {
    const unsigned id = blockIdx.x * 256 + threadIdx.x, r = hsh(id * 2654435761u + 909u); const int m = r % MTOK, k = (r >> 16) % DM;
    double ss = 0.0; for (int i = 0; i < DM; ++i) { const double v = bfv(Mo, (size_t)m * DM + i); ss += v * v; }
    expv[id] = (float)(x1[(size_t)m * DM + k] + bfv(Mo, (size_t)m * DM + k) / sqrt(ss / DM + 1e-6) * g[k]);
}
__global__ void __launch_bounds__(256) k_c9b(const float* out, const float* expv, unsigned* cnt) {
    const unsigned id = blockIdx.x * 256 + threadIdx.x, r = hsh(id * 2654435761u + 909u); const int m = r % MTOK, k = (r >> 16) % DM;
    report(cnt, 23, out[(size_t)m * DM + k], expv[id]);
}
__global__ void __launch_bounds__(256) k_cmp(const bf16_t* F, const bf16_t* N, int stage, unsigned* cnt) {
    const unsigned id = blockIdx.x * 256 + threadIdx.x, r = hsh(id * 2654435761u + 1234u + stage); const int m = r % MTOK, k = (r >> 16) % AW;
    report(cnt, stage, bfv(F, (size_t)m * AW + k), bfv(N, (size_t)m * AW + k));
}
__global__ void __launch_bounds__(256) k_fin(const unsigned* cnt, float* out) {
    int s = 0; for (int i = 1; i < 32; ++i) if (cnt[i] > 2u) { s = i; break; }
    if (DBG_CHECK > 100 && s) { int k = 0; for (int i = 1; i < 32; ++i) if (cnt[i] > 2u) { if (++k == DBG_CHECK - 100) { s = i; break; } } }
    size_t nz = (size_t)s * (MTOK / 25) * DM;
    if (DBG_CHECK == 2) { const double f = (double)cnt[10] / (double)(cnt[74] ? cnt[74] : 1u); nz = (size_t)(f * MTOK) * DM; }
    if (DBG_CHECK == 3) { unsigned mask = 0; for (int t = 0; t < 8; ++t) if (cnt[24 + t] > 2u) mask |= 1u << t; nz = (size_t)mask * (MTOK / 256) * DM; }
    for (size_t i = (size_t)blockIdx.x * 256 + threadIdx.x; i < nz; i += (size_t)gridDim.x * 256) out[i] = 0.f;
}
}
#endif

constexpr size_t MiB = 1u << 20;
constexpr size_t WS_CTL = 0, CTL_ZERO_BYTES = 64 * 1024;
constexpr size_t WS_ROPEA = 1 * MiB, WS_ROPEB = 5 * MiB;
constexpr size_t WS_SS = 13 * MiB, WS_SS2 = 16 * MiB, WS_SS3 = 20 * MiB;
constexpr size_t WS_WIN = 24 * MiB, WS_WUQ = 33 * MiB, WS_WUKV = 34 * MiB, WS_WA = 35 * MiB, WS_WB = 36 * MiB, WS_WOUT = 37 * MiB, WS_WUP = 39 * MiB, WS_WDN = 47 * MiB;
constexpr size_t WS_H = 64 * MiB;
constexpr size_t WS_G = 192 * MiB;
constexpr size_t WS_QA = 448 * MiB, WS_KA = 512 * MiB, WS_VA = 576 * MiB;
constexpr size_t WS_T = WS_KA;
constexpr size_t WS_CQ = 640 * MiB, WS_CKV = 688 * MiB;
constexpr size_t WS_OB = WS_CQ;
constexpr size_t WS_KR = 720 * MiB;
constexpr size_t WS_QB = 728 * MiB, WS_KB = 824 * MiB, WS_VB = 888 * MiB;
constexpr size_t WS_Y = WS_QB;
constexpr size_t WS_U = 192 * MiB;
constexpr size_t WS_END = 952 * MiB;
static_assert(WS_U + (size_t)MTOK * DFF * 2 <= WS_KR && WS_Y + (size_t)MTOK * DM * 2 <= WS_VB && WS_OB + (size_t)MTOK * AW * 2 <= WS_KR && WS_T + (size_t)MTOK * DM * 2 <= WS_CQ, "d_ws map");
static_assert(WS_WIN + (size_t)INWP * DM * 2 <= WS_WUQ && WS_WDN + (size_t)DM * DFF * 2 <= WS_H && WS_VB + (size_t)MTOK * AW * 2 <= WS_END, "d_ws map");
constexpr int CW_BAR = 0;
constexpr int NWAVES = 8;
constexpr int RING_OFF = 0, RING_BYTES = 131072;
constexpr int LDSCTL_OFF = RING_BYTES, MISC_OFF = LDSCTL_OFF + 320;
constexpr int LDS_BYTES = 147456;
static_assert(att::L_END <= RING_BYTES, "attention LDS map");

struct Frame {
    LAS unsigned char* lds;
    volatile LAS unsigned* MISC;
    gu32* ctl;
    int tid, lane, wave, vcu, G;
};

__device__ __forceinline__ float wave_sum(float v) {
#pragma unroll
    for (int o = 1; o < 64; o <<= 1) v += __shfl_xor(v, o);
    return v;
}
__device__ __forceinline__ int srccol(int mat, int n) {
    if (mat == 0) {
        if (n < 1024) { const int sect = n >> 9, c = n & 511, head = c >> 6, p = c & 63; const int d = (p < 16) ? ((p >> 1) + 8 * (p & 1)) : p; return sect * 512 + head * 64 + d; }
        if (n < 1920) return n;
        if (n < 1952) { const int pr = n - 1920; return 2176 + (pr >> 1) + 16 * (pr & 1); }
        if (n < 2048) return -1;
        if (n < 2304) return 1920 + (n - 2048);
        return 2208 + (n - 2304);
    }
    if (mat == 1) { const int head = n / QKB, p = n - head * QKB; if (p < 64) return n; const int pr = p - 64; return head * QKB + 64 + (pr >> 1) + 16 * (pr & 1); }
    return n;
}
__device__ __forceinline__ void p0_transpose_item(const float* W, int K, int Nsrc, int Ndst, bf16* WT, const float* gs, int mat, LAS float* scr, int item, int lane) {
    const int nblk = Ndst / 32, kb = item / nblk, nb = item % nblk, k0 = 64 * kb, n0 = 32 * nb;
    const int sc = srccol(mat, n0 + (lane & 31));
#pragma unroll 8
    for (int i = 0; i < 32; ++i) { const int kk = 2 * i + (lane >> 5); float v = (sc >= 0) ? W[(size_t)(k0 + kk) * Nsrc + sc] : 0.f; if (gs) v *= gs[k0 + kk]; scr[kk * 33 + (lane & 31)] = v; }
    LDS_WAIT(); asm volatile("" ::: "memory");
    const int c = lane & 7;
#pragma unroll
    for (int j = 0; j < 4; ++j) { const int n = (lane >> 3) + 8 * j; const LAS float* s = scr + (8 * c) * 33 + n;
        v4u o; o.x = pk2(s[0 * 33], s[1 * 33]); o.y = pk2(s[2 * 33], s[3 * 33]); o.z = pk2(s[4 * 33], s[5 * 33]); o.w = pk2(s[6 * 33], s[7 * 33]);
        *(GAS v4u*)(WT + (size_t)(n0 + n) * K + k0 + 8 * c) = o; }
    LDS_WAIT(); asm volatile("" ::: "memory");
}
__device__ __forceinline__ void rms_row_to_bf16(int lane, const float* xrow, const f32x4 (&g)[4], bf16* orow) {
    const GAS f32x4* xr = (const GAS f32x4*)xrow + lane;
    f32x4 v[4]; float s = 0.f;
#pragma unroll
    for (int j = 0; j < 4; ++j) { v[j] = xr[64 * j]; s += (v[j].x * v[j].x + v[j].y * v[j].y) + (v[j].z * v[j].z + v[j].w * v[j].w); }
    const float rstd = 1.f / sqrtf(wave_sum(s) * (1.f / DM) + EPS);
    GAS unsigned long long* o8 = (GAS unsigned long long*)orow + lane;
#pragma unroll
    for (int j = 0; j < 4; ++j) { const f32x4 y = v[j] * rstd * g[j]; o8[64 * j] = (unsigned long long)pk2(y.x, y.y) | ((unsigned long long)pk2(y.z, y.w) << 32); }
}

struct Args { const float* in[17]; float* out; unsigned char* ws; int ph_lo, ph_hi, li, pad; };

__global__ void __launch_bounds__(NWAVES * 64, 2) block_fwd(Args args) {
    extern __shared__ __attribute__((aligned(16))) unsigned char lds[];
    Frame F;
    F.lds = (LAS unsigned char*)lds;
    F.MISC = (volatile LAS unsigned*)(F.lds + MISC_OFF);
    F.tid = threadIdx.x; F.lane = F.tid & 63; F.wave = __builtin_amdgcn_readfirstlane(F.tid >> 6);
    F.G = gridDim.x; { const int bx = blockIdx.x; F.vcu = (F.G % 8 == 0) ? (bx % 8) * (F.G / 8) + bx / 8 : bx; }
    unsigned char* ws = args.ws;
    F.ctl = (gu32*)(ws + WS_CTL);
    const float* x = args.in[0]; const int* positions = (const int*)args.in[1];
    const float *g_pre_mix = args.in[2], *w_in = args.in[3], *b_gate = args.in[4], *g_q = args.in[5], *w_uq = args.in[6], *g_kv = args.in[7], *w_ukv = args.in[8], *w_a = args.in[9], *w_b = args.in[10],
                *w_out = args.in[11], *g_post_mix = args.in[12], *g_pre_mlp = args.in[13], *w_up = args.in[14], *w_dn = args.in[15], *g_post_mlp = args.in[16];
    float* out = args.out;
    float* ropeA = (float*)(ws + WS_ROPEA); float* ropeB = (float*)(ws + WS_ROPEB);
    float* SS = (float*)(ws + WS_SS); float* SS2 = (float*)(ws + WS_SS2); float* SS3 = (float*)(ws + WS_SS3);
    bf16 *WIN = (bf16*)(ws + WS_WIN), *WUQ = (bf16*)(ws + WS_WUQ), *WUKV = (bf16*)(ws + WS_WUKV), *WA = (bf16*)(ws + WS_WA), *WB = (bf16*)(ws + WS_WB), *WOUT = (bf16*)(ws + WS_WOUT), *WUP = (bf16*)(ws + WS_WUP), *WDN = (bf16*)(ws + WS_WDN);
    bf16 *H = (bf16*)(ws + WS_H), *Gt = (bf16*)(ws + WS_G), *QA = (bf16*)(ws + WS_QA), *KA = (bf16*)(ws + WS_KA), *VA = (bf16*)(ws + WS_VA), *T = (bf16*)(ws + WS_T), *CQ = (bf16*)(ws + WS_CQ), *CKV = (bf16*)(ws + WS_CKV),
         *OB = (bf16*)(ws + WS_OB), *KR = (bf16*)(ws + WS_KR), *QB = (bf16*)(ws + WS_QB), *KB = (bf16*)(ws + WS_KB), *VB = (bf16*)(ws + WS_VB), *Y = (bf16*)(ws + WS_Y), *U = (bf16*)(ws + WS_U);
    for (int u = F.tid; u < (LDS_BYTES - LDSCTL_OFF) / 4; u += NWAVES * 64) ((LAS unsigned*)(F.lds + LDSCTL_OFF))[u] = 0u;
    __syncthreads();
    XcdBarrier bar = xcd_barrier_post((unsigned*)(F.ctl + CW_BAR) + args.li * XCD_BAR_WORDS, F.MISC + 8);
    const int lo = args.ph_lo, hi = args.ph_hi;
#define IN(k) (lo <= (k) && (k) < hi)
#define SEAM(k) do { if (IN(k) && IN((k) + 1)) xcd_barrier(bar); } while (0)
    const int gw = F.vcu * NWAVES + F.wave, NGW = F.G * NWAVES;

#if !defined(SKIP_P0)
    if (IN(0))
    {
        LAS float* scr = (LAS float*)(F.lds + RING_OFF + F.wave * 16384);
        constexpr int I0 = (DM / 64) * (INWP / 32), I1 = (QLORA / 64) * (768 / 32), I2 = (KVLORA / 64) * (1024 / 32), I3 = (AW / 64) * (DM / 32), I5 = (DM / 64) * (DM / 32), I6 = (DM / 64) * (DFF / 32), I7 = (DFF / 64) * (DM / 32);
        constexpr int NITEMS = I0 + I1 + I2 + 2 * I3 + I5 + I6 + I7;
        for (int it = gw; it < NITEMS; it += NGW) {
            int r = it;
            if (r < I0) { p0_transpose_item(w_in, DM, INW, INWP, WIN, nullptr, 0, scr, r, F.lane); continue; } r -= I0;
            if (r < I1) { p0_transpose_item(w_uq, QLORA, 768, 768, WUQ, g_q, 1, scr, r, F.lane); continue; } r -= I1;
            if (r < I2) { p0_transpose_item(w_ukv, KVLORA, 1024, 1024, WUKV, g_kv, 2, scr, r, F.lane); continue; } r -= I2;
            if (r < I3) { p0_transpose_item(w_a, AW, DM, DM, WA, nullptr, 2, scr, r, F.lane); continue; } r -= I3;
            if (r < I3) { p0_transpose_item(w_b, AW, DM, DM, WB, nullptr, 2, scr, r, F.lane); continue; } r -= I3;
            if (r < I5) { p0_transpose_item(w_out, DM, DM, DM, WOUT, nullptr, 2, scr, r, F.lane); continue; } r -= I5;
            if (r < I6) { p0_transpose_item(w_up, DM, DFF, DFF, WUP, nullptr, 2, scr, r, F.lane); continue; } r -= I6;
            p0_transpose_item(w_dn, DFF, DM, DM, WDN, nullptr, 2, scr, r, F.lane);
        }
        for (int idx = (int)blockIdx.x * (NWAVES * 64) + F.tid; idx < MTOK * 24; idx += F.G * NWAVES * 64) {
            const int m = idx / 24, i = idx - m * 24;
            const float invf = (i < 8) ? __builtin_amdgcn_exp2f(-(float)i * 2.3664460711655217f) : __builtin_amdgcn_exp2f(-(float)(i - 8) * 1.1832230355827609f);
            const float ang = (float)positions[m] * invf;
            double t = (double)ang * 0.15915494309189535; t -= floor(t);
            const float tf = (float)t; const float c = __builtin_amdgcn_cosf(tf), s = __builtin_amdgcn_sinf(tf);
            float* dst = (i < 8) ? ropeA + (size_t)m * 16 + 2 * i : ropeB + (size_t)m * 32 + 2 * (i - 8);
            *(f32x2g*)dst = (f32x2g){c, s};
        }
        f32x4 g[4];
#pragma unroll
        for (int j = 0; j < 4; ++j) g[j] = ((const GAS f32x4*)g_pre_mix)[F.lane + 64 * j];
        for (int m = gw; m < MTOK; m += NGW) rms_row_to_bf16(F.lane, x + (size_t)m * DM, g, H + (size_t)m * DM);
    }
#endif
    SEAM(0);

#if !defined(SKIP_P1)
    if (IN(1))
    {
        pg8::Gemm g{H, WIN, MTOK, INWP, DM}; pg8::StaticOrder S; S.init(MTOK, INWP, F.G, (int)blockIdx.x);
        pg8::EpiIn E{QA, KA, VA, CQ, CKV, KR, Gt, SS, ropeA, ropeB, b_gate};
        pg8::gemm_phase<pg8::EpiIn, pg8::StaticOrder, true, true>(F.lds + RING_OFF, g, S, E);
    }
#endif
    SEAM(1);

#if !defined(SKIP_P2)
    if (IN(2)) {
    {
        pg8::Gemm g{CQ, WUQ, MTOK, NHEAD * QKB, QLORA}; pg8::StaticOrder S; S.init(MTOK, NHEAD * QKB, F.G, (int)blockIdx.x);
        pg8::EpiQ E{QB, SS, ropeB};
        pg8::gemm_phase<pg8::EpiQ, pg8::StaticOrder, true, true>(F.lds + RING_OFF, g, S, E);
    }
    {
        pg8::Gemm g{CKV, WUKV, MTOK, 2 * AW, KVLORA}; pg8::StaticOrder S; S.init(MTOK, 2 * AW, F.G, (int)blockIdx.x);
        pg8::EpiKV E{KB, VB, SS};
        pg8::gemm_phase<pg8::EpiKV, pg8::StaticOrder, true, true>(F.lds + RING_OFF, g, S, E);
    }
    }
#endif
    SEAM(2);

#if !defined(SKIP_P3)
    if (IN(3))
    {
        LAS char* al = (LAS char*)(F.lds + RING_OFF);
#if !defined(SKIP_MOBA) && !(defined(DBG_NAIVE_ATTN) && (DBG_NAIVE_ATTN & 1))
        for (int bh = F.vcu; bh < NB * NHEAD; bh += F.G) {
            const int b = bh >> 3, h = bh & 7; const size_t r0 = (size_t)b * SEQ;
            att::kmean_blocks(KA + r0 * AW + h * HD, al);
#pragma unroll 1
            for (int qb = 0; qb < 8; ++qb)
                att::attn_unit<64, true>(QA + (r0 + qb * 256) * AW + h * HD, AW, KA + r0 * AW + h * HD, nullptr, VA + r0 * AW + h * HD, QA + (r0 + qb * 256) * AW + h * HD, qb, al);
        }
#endif
#if !defined(SKIP_MLA) && !(defined(DBG_NAIVE_ATTN) && (DBG_NAIVE_ATTN & 2))
        for (int bh = F.vcu; bh < NB * NHEAD; bh += F.G) {
            const int b = bh >> 3, h = bh & 7; const size_t r0 = (size_t)b * SEQ;
#pragma unroll 1
            for (int qb = 0; qb < 8; ++qb)
                att::attn_unit<96, false>(QB + (r0 + qb * 256) * (NHEAD * QKB) + h * QKB, NHEAD * QKB, KB + r0 * AW + h * HD, KR + r0 * RDIM, VB + r0 * AW + h * HD, OB + (r0 + qb * 256) * AW + h * HD, qb, al);
        }
#endif
    }
#endif
    SEAM(3);

#if !defined(SKIP_P4)
    if (IN(4)) {
    {
        pg8::Gemm g{QA, WA, MTOK, DM, AW}; pg8::StaticOrder S; S.init(MTOK, DM, F.G, (int)blockIdx.x);
        pg8::EpiGate<false> E{Gt, T};
        pg8::gemm_phase<pg8::EpiGate<false>, pg8::StaticOrder, true, true>(F.lds + RING_OFF, g, S, E);
    }
    {
        pg8::Gemm g{OB, WB, MTOK, DM, AW}; pg8::StaticOrder S; S.init(MTOK, DM, F.G, (int)blockIdx.x);
        pg8::EpiGate<true> E{Gt, T};
        pg8::gemm_phase<pg8::EpiGate<true>, pg8::StaticOrder, true, true>(F.lds + RING_OFF, g, S, E);
    }
    }
#endif
    SEAM(4);

#if !defined(SKIP_P5)
    if (IN(5))
    {
        pg8::Gemm g{T, WOUT, MTOK, DM, DM}; pg8::StaticOrder S; S.init(MTOK, DM, F.G, (int)blockIdx.x);
        pg8::EpiSS E{Y, SS2};
        pg8::gemm_phase<pg8::EpiSS, pg8::StaticOrder, true, true>(F.lds + RING_OFF, g, S, E);
    }
#endif
    SEAM(5);

#if !defined(SKIP_P6)
    if (IN(6))
    {
        f32x4 g1[4], g2[4];
#pragma unroll
        for (int j = 0; j < 4; ++j) { g1[j] = ((const GAS f32x4*)g_post_mix)[F.lane + 64 * j]; g2[j] = ((const GAS f32x4*)g_pre_mlp)[F.lane + 64 * j]; }
        for (int m = gw; m < MTOK; m += NGW) {
            const GAS f32x4* sp = (const GAS f32x4*)(SS2 + (size_t)m * 16); const f32x4 a = sp[0], b = sp[1], c = sp[2], d = sp[3];
            const float ssy = (((a.x + a.y) + (a.z + a.w)) + ((b.x + b.y) + (b.z + b.w))) + (((c.x + c.y) + (c.z + c.w)) + ((d.x + d.y) + (d.z + d.w)));
            const float rsy = 1.f / sqrtf(ssy * (1.f / DM) + EPS);
            const GAS f32x4* xr = (const GAS f32x4*)(x + (size_t)m * DM) + F.lane; const GAS unsigned long long* yr = (const GAS unsigned long long*)(Y + (size_t)m * DM) + F.lane;
            GAS f32x4* o4 = (GAS f32x4*)(out + (size_t)m * DM) + F.lane;
            f32x4 v[4]; float s = 0.f;
#pragma unroll
            for (int j = 0; j < 4; ++j) { const unsigned long long yw = yr[64 * j]; const unsigned lo = (unsigned)yw, hi = (unsigned)(yw >> 32);
                const f32x4 yv = (f32x4){__uint_as_float(lo << 16), __uint_as_float(lo & 0xffff0000u), __uint_as_float(hi << 16), __uint_as_float(hi & 0xffff0000u)};
                v[j] = xr[64 * j] + yv * rsy * g1[j]; o4[64 * j] = v[j];
                s += (v[j].x * v[j].x + v[j].y * v[j].y) + (v[j].z * v[j].z + v[j].w * v[j].w); }
            const float rstd = 1.f / sqrtf(wave_sum(s) * (1.f / DM) + EPS);
            GAS unsigned long long* o8 = (GAS unsigned long long*)(H + (size_t)m * DM) + F.lane;
#pragma unroll
            for (int j = 0; j < 4; ++j) { const f32x4 y2 = v[j] * rstd * g2[j]; o8[64 * j] = (unsigned long long)pk2(y2.x, y2.y) | ((unsigned long long)pk2(y2.z, y2.w) << 32); }
        }
    }
#endif
    SEAM(6);

#if !defined(SKIP_P7)
    if (IN(7))
    {
        pg8::Gemm g{H, WUP, MTOK, DFF, DM}; pg8::StaticOrder S; S.init(MTOK, DFF, F.G, (int)blockIdx.x);
        pg8::EpiRelu2 E{U};
        pg8::gemm_phase<pg8::EpiRelu2, pg8::StaticOrder, true, true>(F.lds + RING_OFF, g, S, E);
    }
#endif
    SEAM(7);

#if !defined(SKIP_P8)
    if (IN(8))
    {
        pg8::Gemm g{U, WDN, MTOK, DM, DFF}; pg8::StaticOrder S; S.init(MTOK, DM, F.G, (int)blockIdx.x);
        pg8::EpiSS E{H, SS3};
        pg8::gemm_phase<pg8::EpiSS, pg8::StaticOrder, true, true>(F.lds + RING_OFF, g, S, E);
    }
#endif
    SEAM(8);

#if !defined(SKIP_P9)
    if (IN(9))
    {
        f32x4 g1[4];
#pragma unroll
        for (int j = 0; j < 4; ++j) g1[j] = ((const GAS f32x4*)g_post_mlp)[F.lane + 64 * j];
        for (int m = gw; m < MTOK; m += NGW) {
            const GAS f32x4* sp = (const GAS f32x4*)(SS3 + (size_t)m * 16); const f32x4 a = sp[0], b = sp[1], c = sp[2], d = sp[3];
            const float ssy = (((a.x + a.y) + (a.z + a.w)) + ((b.x + b.y) + (b.z + b.w))) + (((c.x + c.y) + (c.z + c.w)) + ((d.x + d.y) + (d.z + d.w)));
            const float rsy = 1.f / sqrtf(ssy * (1.f / DM) + EPS);
            const GAS unsigned long long* yr = (const GAS unsigned long long*)(H + (size_t)m * DM) + F.lane;
            GAS f32x4* o4 = (GAS f32x4*)(out + (size_t)m * DM) + F.lane;
#pragma unroll
            for (int j = 0; j < 4; ++j) { const unsigned long long yw = yr[64 * j]; const unsigned lo = (unsigned)yw, hi = (unsigned)(yw >> 32);
                const f32x4 yv = (f32x4){__uint_as_float(lo << 16), __uint_as_float(lo & 0xffff0000u), __uint_as_float(hi << 16), __uint_as_float(hi & 0xffff0000u)};
                o4[64 * j] = o4[64 * j] + yv * rsy * g1[j]; }
        }
    }
#endif
}

extern "C" void kernel_launch(void* const* d_in, const int* in_sizes, int n_in, void* d_out, int out_size, void* d_ws, size_t ws_size, hipStream_t stream) {
    static int grid = 0;
    if (grid == 0) {
        if (n_in != 17 || in_sizes[0] != MTOK * DM || out_size != MTOK * DM || ws_size < WS_END) { fprintf(stderr, "kernel_launch: unexpected shapes (n_in %d, in0 %d, out %d, ws %zu); nothing launched\n", n_in, n_in > 0 ? in_sizes[0] : -1, out_size, ws_size); grid = -1; return; }
        int dev = 0, cus = 0, per_cu = 0;
        if (hipGetDevice(&dev) != hipSuccess || hipDeviceGetAttribute(&cus, hipDeviceAttributeMultiprocessorCount, dev) != hipSuccess) { fprintf(stderr, "kernel_launch: device query failed\n"); grid = -1; return; }
        if (hipFuncSetAttribute((const void*)block_fwd, hipFuncAttributeMaxDynamicSharedMemorySize, LDS_BYTES) != hipSuccess) { fprintf(stderr, "kernel_launch: hipFuncSetAttribute failed\n"); grid = -1; return; }
        if (hipOccupancyMaxActiveBlocksPerMultiprocessor(&per_cu, (const void*)block_fwd, NWAVES * 64, LDS_BYTES) != hipSuccess || per_cu < 1) { fprintf(stderr, "kernel_launch: occupancy query reports %d workgroups per CU\n", per_cu); }
        (void)hipGetLastError();
        grid = cus;
    }
    if (grid < 0) return;
    if (hipMemsetAsync((char*)d_ws + WS_CTL, 0, CTL_ZERO_BYTES, stream) != hipSuccess) { fprintf(stderr, "kernel_launch: hipMemsetAsync failed\n"); return; }
    Args a{};
    for (int i = 0; i < 17; ++i) a.in[i] = (const float*)d_in[i];
    a.out = (float*)d_out; a.ws = (unsigned char*)d_ws;
#if defined(DBG_CHECK)
    {
        unsigned char* ws = (unsigned char*)d_ws; unsigned* cnt = (unsigned*)(ws + WS_CTL + 32768); float* expv = (float*)(ws + 60 * MiB); float* KM = (float*)(ws + 61 * MiB);
        const float* const* in = (const float* const*)a.in; const int* pos = (const int*)in[1];
        bf16 *H = (bf16*)(ws + WS_H), *Gt = (bf16*)(ws + WS_G), *QA = (bf16*)(ws + WS_QA), *KA = (bf16*)(ws + WS_KA), *VA = (bf16*)(ws + WS_VA), *T = (bf16*)(ws + WS_T), *CQ = (bf16*)(ws + WS_CQ), *CKV = (bf16*)(ws + WS_CKV),
             *OB = (bf16*)(ws + WS_OB), *KR = (bf16*)(ws + WS_KR), *QB = (bf16*)(ws + WS_QB), *KB = (bf16*)(ws + WS_KB), *VB = (bf16*)(ws + WS_VB), *Y = (bf16*)(ws + WS_Y), *U = (bf16*)(ws + WS_U);
        bf16 *NA = (bf16*)(ws + WS_H), *NBo = (bf16*)(ws + WS_H + 64 * MiB);
        auto L = [&](int lo, int hi) { a.ph_lo = lo; a.ph_hi = hi; a.li = 0; hipLaunchKernelGGL(block_fwd, dim3(grid), dim3(NWAVES * 64), LDS_BYTES, stream, a); };
        const dim3 cg(chk::NS / 256), cb(256);
        L(0, 1); hipLaunchKernelGGL(chk::k_c0, cg, cb, 0, stream, in[0], in[2], (const bf16*)H, cnt);
        L(1, 2); hipLaunchKernelGGL(chk::k_c1, cg, cb, 0, stream, (const bf16*)H, in[3], in[4], pos, (const bf16*)QA, (const bf16*)KA, (const bf16*)VA, (const bf16*)CQ, (const bf16*)CKV, (const bf16*)KR, (const bf16*)Gt, cnt);
        L(2, 3); hipLaunchKernelGGL(chk::k_c2, cg, cb, 0, stream, (const bf16*)CQ, (const bf16*)CKV, in[5], in[6], in[7], in[8], pos, (const bf16*)QB, (const bf16*)KB, (const bf16*)VB, cnt);
        hipLaunchKernelGGL(dbg::kmean_k, dim3(256), dim3(512), 0, stream, (const bf16*)KA, KM);
        hipLaunchKernelGGL((dbg::attn_k<64, true>), dim3(32, 256), dim3(256), 0, stream, (const bf16*)QA, (const bf16*)KA, (const bf16*)nullptr, (const bf16*)VA, NA, (const float*)KM);
        hipLaunchKernelGGL((dbg::attn_k<96, false>), dim3(32, 256), dim3(256), 0, stream, (const bf16*)QB, (const bf16*)KB, (const bf16*)KR, (const bf16*)VB, NBo, (const float*)KM);
        L(3, 4); hipLaunchKernelGGL(chk::k_cmp, cg, cb, 0, stream, (const bf16*)QA, (const bf16*)NA, 15, cnt); hipLaunchKernelGGL(chk::k_cmp, cg, cb, 0, stream, (const bf16*)OB, (const bf16*)NBo, 16, cnt);
        L(4, 5); hipLaunchKernelGGL(chk::k_c4, cg, cb, 0, stream, (const bf16*)QA, (const bf16*)OB, (const bf16*)Gt, in[9], in[10], (const bf16*)T, cnt);
        L(5, 6); hipLaunchKernelGGL(chk::k_c5, cg, cb, 0, stream, (const bf16*)T, in[11], (const bf16*)Y, cnt);
        L(6, 7); hipLaunchKernelGGL(chk::k_c6, cg, cb, 0, stream, (const bf16*)Y, in[0], in[12], in[13], (const float*)d_out, (const bf16*)H, cnt);
        L(7, 8); hipLaunchKernelGGL(chk::k_c7, cg, cb, 0, stream, (const bf16*)H, in[14], (const bf16*)U, cnt);
        L(8, 9); hipLaunchKernelGGL(chk::k_c8, cg, cb, 0, stream, (const bf16*)U, in[15], (const bf16*)H, cnt);
        hipLaunchKernelGGL(chk::k_c9a, cg, cb, 0, stream, (const bf16*)H, (const float*)d_out, in[16], expv);
        L(9, 10); hipLaunchKernelGGL(chk::k_c9b, cg, cb, 0, stream, (const float*)d_out, (const float*)expv, cnt);
        hipLaunchKernelGGL(chk::k_fin, dim3(1024), dim3(256), 0, stream, (const unsigned*)cnt, (float*)d_out);
    }
#elif defined(DBG_NAIVE_ATTN)
    a.ph_lo = 0; a.ph_hi = (DBG_NAIVE_ATTN == 3) ? 3 : 4; a.li = 0;
    hipLaunchKernelGGL(block_fwd, dim3(grid), dim3(NWAVES * 64), LDS_BYTES, stream, a);
    { unsigned char* ws = (unsigned char*)d_ws; float* KM = (float*)(ws + WS_SS3);
      if (DBG_NAIVE_ATTN & 1) { hipLaunchKernelGGL(dbg::kmean_k, dim3(256), dim3(512), 0, stream, (const bf16*)(ws + WS_KA), KM);
          hipLaunchKernelGGL((dbg::attn_k<64, true>), dim3(32, 256), dim3(256), 0, stream, (const bf16*)(ws + WS_QA), (const bf16*)(ws + WS_KA), (const bf16*)nullptr, (const bf16*)(ws + WS_VA), (bf16*)(ws + WS_QA), (const float*)KM); }
      if (DBG_NAIVE_ATTN & 2) hipLaunchKernelGGL((dbg::attn_k<96, false>), dim3(32, 256), dim3(256), 0, stream, (const bf16*)(ws + WS_QB), (const bf16*)(ws + WS_KB), (const bf16*)(ws + WS_KR), (const bf16*)(ws + WS_VB), (bf16*)(ws + WS_OB), (const float*)KM); }
    a.ph_lo = 4; a.ph_hi = 10; a.li = 1;
    hipLaunchKernelGGL(block_fwd, dim3(grid), dim3(NWAVES * 64), LDS_BYTES, stream, a);
#else
    a.ph_lo = 0; a.ph_hi = 10; a.li = 0;
    hipLaunchKernelGGL(block_fwd, dim3(grid), dim3(NWAVES * 64), LDS_BYTES, stream, a);
#endif
    const hipError_t le = hipPeekAtLastError();
    if (le != hipSuccess) fprintf(stderr, "kernel_launch: launch failed: %s\n", hipGetErrorName(le));
}
```

```cpp
#include <hip/hip_runtime.h>
#include <hip/hip_bf16.h>
#include <cstdio>
#include <cstdint>
#include <cmath>
constexpr int NB = 32, SEQ = 2048, DM = 1024, MTOK = NB * SEQ;
constexpr int NHEAD = 8, HD = 64, AW = NHEAD * HD;
constexpr int QLORA = 384, KVLORA = 256, RDIM = 32, QKB = 96;
constexpr int DFF = 4096, INW = 4256, INWP = 4352;
constexpr float EPS = 1e-6f;
constexpr float LOG2E = 1.4426950408889634f;
constexpr float C2A = 0.125f * LOG2E;
constexpr float C2B = 0.10206207261596575f * LOG2E;
typedef float f32x2g __attribute__((ext_vector_type(2)));
namespace pg8 {
#define PG8_LAS __attribute__((address_space(3)))
typedef unsigned short bf16_t;
typedef short bf16x8 __attribute__((ext_vector_type(8)));
typedef float f32x4 __attribute__((ext_vector_type(4)));
typedef unsigned u32x4 __attribute__((ext_vector_type(4)));
constexpr int BM = 256, BK = 64, HALF = 128, HTB = HALF * BK * 2  , STAGE_BYTES = 8 * HTB, NXCD = 8, WGM = 8;

__host__ __device__ __forceinline__ int lds_byte(int r, int c) { const int st = (r >> 4) * 2 + (c >> 5), rr = r & 15, cc = c & 31, ob = rr * 64 + cc * 2; return st * 1024 + (ob ^ (((ob >> 9) & 1) << 5)); }
__host__ __device__ __forceinline__ void stage_rc(int b, int& R, int& C) { const int st = b / 1024, sb = b % 1024, swz = sb ^ (((sb >> 9) & 1) << 5); R = (st >> 1) * 16 + swz / 64; C = (st & 1) * 32 + (swz % 64) / 2; }
__host__ __device__ __forceinline__ int perm32(int rho) { const int n = rho >> 4, i = rho & 15; return 8 * (i >> 2) + 4 * n + (i & 3); }

struct Unit { int pm, pn; };
struct Gemm { const bf16_t* A; const bf16_t* Bt; int M, N, K, lda, ldb; };

struct StaticOrder {
    int nM, nN, nwg, G, c;
    __host__ __device__ void init(int M, int N, int G_, int c_) { nM = M / BM; nN = N / BM; nwg = nM * nN; G = G_; c = c_; }
    __host__ __device__ bool next(int i, Unit& u) const {
        const long L = (long)i * G + c; if (L >= nwg) return false;
        int wgid = (int)L; { const int q = nwg / NXCD, r = nwg % NXCD, xcd = wgid % NXCD, off = wgid / NXCD; wgid = (xcd < r ? xcd * (q + 1) : r * (q + 1) + (xcd - r) * q) + off; }
        const int nig = WGM * nN, gid = wgid / nig, fm = gid * WGM, gsz = (nM - fm) < WGM ? (nM - fm) : WGM;
        u.pm = fm + ((wgid % nig) % gsz); u.pn = (wgid % nig) / gsz; return true;
    }
    __device__ __forceinline__ void a_ready(const Unit&) const {}
    __device__ __forceinline__ void done(const Unit&) const {}
};

__device__ __forceinline__ unsigned cvt_pk_bf16(float lo, float hi) { unsigned r; asm volatile("v_cvt_pk_bf16_f32 %0, %1, %2" : "=v"(r) : "v"(lo), "v"(hi)); return r; }
__device__ __forceinline__ void ld8(float (&v)[8], const f32x4& a, const f32x4& b) { v[0] = a[0]; v[1] = a[1]; v[2] = a[2]; v[3] = a[3]; v[4] = b[0]; v[5] = b[1]; v[6] = b[2]; v[7] = b[3]; }
typedef float f32x2c_t __attribute__((ext_vector_type(2))); typedef __bf16 bf16x2c_t __attribute__((ext_vector_type(2)));
__device__ __forceinline__ unsigned cvtpk_c(float lo, float hi) { const f32x2c_t v = {lo, hi}; const bf16x2c_t b = __builtin_convertvector(v, bf16x2c_t); return __builtin_bit_cast(unsigned, b); }
__device__ __forceinline__ u32x4 pack8(const float (&v)[8]) { u32x4 w; w.x = cvtpk_c(v[0], v[1]); w.y = cvtpk_c(v[2], v[3]); w.z = cvtpk_c(v[4], v[5]); w.w = cvtpk_c(v[6], v[7]); return w; }
__device__ __forceinline__ void unpack8(const u32x4 w, float (&v)[8]) {
    v[0] = __uint_as_float(w.x << 16); v[1] = __uint_as_float(w.x & 0xffff0000u); v[2] = __uint_as_float(w.y << 16); v[3] = __uint_as_float(w.y & 0xffff0000u);
    v[4] = __uint_as_float(w.z << 16); v[5] = __uint_as_float(w.z & 0xffff0000u); v[6] = __uint_as_float(w.w << 16); v[7] = __uint_as_float(w.w & 0xffff0000u); }
__device__ __forceinline__ void rope4(float (&v)[8], const f32x4 a, const f32x4 b) {
    float x1, x2;
    x1 = v[0]; x2 = v[1]; v[0] = x1 * a[0] - x2 * a[1]; v[1] = x2 * a[0] + x1 * a[1];
    x1 = v[2]; x2 = v[3]; v[2] = x1 * a[2] - x2 * a[3]; v[3] = x2 * a[2] + x1 * a[3];
    x1 = v[4]; x2 = v[5]; v[4] = x1 * b[0] - x2 * b[1]; v[5] = x2 * b[0] + x1 * b[1];
    x1 = v[6]; x2 = v[7]; v[6] = x1 * b[2] - x2 * b[3]; v[7] = x2 * b[2] + x1 * b[3];
}
__device__ __forceinline__ float sumsq8(const float (&v)[8]) { return ((v[0] * v[0] + v[1] * v[1]) + (v[2] * v[2] + v[3] * v[3])) + ((v[4] * v[4] + v[5] * v[5]) + (v[6] * v[6] + v[7] * v[7])); }
__device__ __forceinline__ float red_fq(float s) { s += __shfl_xor(s, 16); s += __shfl_xor(s, 32); return s; }

struct EpiIn {
    static constexpr bool PERM = true, AFTER_DRAIN = false; static constexpr int MIDT = 0;
    bf16_t *QA, *KA, *VA, *CQ, *CKV, *KR, *G; float* SS; const float* ropeA; const float* ropeB; const float* bgate;
    __device__ __forceinline__ void operator()(const f32x4 (&acc)[2][2][4][2], const Unit& u, int wr, int wc, int fr, int fq) const {
        asm volatile("" : "+v"(fr), "+v"(fq));
        const int row0 = u.pm * BM + wr * 64 + fr, pn = u.pn, cl = wc * 32 + 8 * fq;
        if (pn < 4) {
            bf16_t* dst = (pn < 2) ? QA : KA; const float sc = (pn < 2) ? C2A : 1.f; const int cb = (pn & 1) * 256 + cl;
            if ((wc & 1) == 0) {
                const bool rp = fq < 2;
#pragma unroll
                for (int ai = 0; ai < 2; ++ai)
#pragma unroll
                    for (int m = 0; m < 4; ++m) { const int row = row0 + ai * HALF + m * 16;
                        const f32x4* t = (const f32x4*)(ropeA + (size_t)row * 16 + (rp ? fq * 8 : 0));
                        f32x4 ca = t[0], cc = t[1]; if (!rp) { ca = (f32x4){1.f, 0.f, 1.f, 0.f}; cc = ca; }
#pragma unroll
                        for (int bj = 0; bj < 2; ++bj) { float v[8]; ld8(v, acc[ai][bj][m][0], acc[ai][bj][m][1]); rope4(v, ca, cc);
#pragma unroll
                            for (int j = 0; j < 8; ++j) v[j] *= sc;
                            *(u32x4*)(dst + (size_t)row * AW + cb + bj * HALF) = pack8(v); } }
            } else {
#pragma unroll
                for (int ai = 0; ai < 2; ++ai)
#pragma unroll
                    for (int m = 0; m < 4; ++m) { const int row = row0 + ai * HALF + m * 16;
#pragma unroll
                        for (int bj = 0; bj < 2; ++bj) { float v[8]; ld8(v, acc[ai][bj][m][0], acc[ai][bj][m][1]);
#pragma unroll
                            for (int j = 0; j < 8; ++j) v[j] *= sc;
                            *(u32x4*)(dst + (size_t)row * AW + cb + bj * HALF) = pack8(v); } }
            }
        } else if (pn < 6) {
            const int cb = (pn - 4) * 256 + cl;
#pragma unroll
            for (int ai = 0; ai < 2; ++ai)
#pragma unroll
                for (int m = 0; m < 4; ++m) { const int row = row0 + ai * HALF + m * 16;
#pragma unroll
                    for (int bj = 0; bj < 2; ++bj) { float v[8]; ld8(v, acc[ai][bj][m][0], acc[ai][bj][m][1]); *(u32x4*)(VA + (size_t)row * AW + cb + bj * HALF) = pack8(v); } }
        } else if (pn == 6 || pn == 8) {
            bf16_t* dst = (pn == 6) ? CQ : CKV; const int ld = (pn == 6) ? QLORA : KVLORA, slot = ((pn == 6) ? 0 : 8) + wc;
#pragma unroll
            for (int ai = 0; ai < 2; ++ai)
#pragma unroll
                for (int m = 0; m < 4; ++m) { const int row = row0 + ai * HALF + m * 16; float s = 0.f;
#pragma unroll
                    for (int bj = 0; bj < 2; ++bj) { float v[8]; ld8(v, acc[ai][bj][m][0], acc[ai][bj][m][1]); s += sumsq8(v); *(u32x4*)(dst + (size_t)row * ld + cl + bj * HALF) = pack8(v); }
                    s = red_fq(s); if (fq == 0) SS[(size_t)row * 12 + slot] = s; }
        } else if (pn == 7) {
#pragma unroll
            for (int ai = 0; ai < 2; ++ai)
#pragma unroll
                for (int m = 0; m < 4; ++m) { const int row = row0 + ai * HALF + m * 16;
                    { float v[8]; ld8(v, acc[ai][0][m][0], acc[ai][0][m][1]); float s = red_fq(sumsq8(v)); *(u32x4*)(CQ + (size_t)row * QLORA + 256 + cl) = pack8(v); if (fq == 0) SS[(size_t)row * 12 + 4 + wc] = s; }
                    if (wc == 0) { float v[8]; ld8(v, acc[ai][1][m][0], acc[ai][1][m][1]); const f32x4* t = (const f32x4*)(ropeB + (size_t)row * 32 + fq * 8); rope4(v, t[0], t[1]);
                        *(u32x4*)(KR + (size_t)row * RDIM + 8 * fq) = pack8(v); } }
        } else {
            const int gc = (pn - 9) * 256 + cl;
            f32x4 bv[2][2];
#pragma unroll
            for (int bj = 0; bj < 2; ++bj)
#pragma unroll
                for (int n = 0; n < 2; ++n) bv[bj][n] = *(const f32x4*)(bgate + gc + bj * HALF + 4 * n);
#pragma unroll
            for (int ai = 0; ai < 2; ++ai)
#pragma unroll
                for (int m = 0; m < 4; ++m) { const int row = row0 + ai * HALF + m * 16;
#pragma unroll
                    for (int bj = 0; bj < 2; ++bj) { float v[8]; ld8(v, acc[ai][bj][m][0] + bv[bj][0], acc[ai][bj][m][1] + bv[bj][1]);
#pragma unroll
                        for (int j = 0; j < 8; ++j) v[j] = __builtin_amdgcn_rcpf(1.f + __builtin_amdgcn_exp2f(-LOG2E * v[j]));
                        *(u32x4*)(G + (size_t)row * (2 * DM) + gc + bj * HALF) = pack8(v); } }
        }
    }
};
struct EpiQ {
    static constexpr bool PERM = true, AFTER_DRAIN = false; static constexpr int MIDT = 0;
    bf16_t* QB; const float* SS; const float* ropeB;
    __device__ __forceinline__ void operator()(const f32x4 (&acc)[2][2][4][2], const Unit& u, int wr, int wc, int fr, int fq) const {
        asm volatile("" : "+v"(fr), "+v"(fq));
        const int row0 = u.pm * BM + wr * 64 + fr, cl = u.pn * BM + wc * 32 + 8 * fq;
#pragma unroll
        for (int ai = 0; ai < 2; ++ai)
#pragma unroll
            for (int m = 0; m < 4; ++m) { const int row = row0 + ai * HALF + m * 16;
                const f32x4* sp = (const f32x4*)(SS + (size_t)row * 12); const f32x4 s0 = sp[0], s1 = sp[1];
                const float ss = ((s0[0] + s0[1]) + (s0[2] + s0[3])) + ((s1[0] + s1[1]) + (s1[2] + s1[3]));
                const float rs = __builtin_amdgcn_rsqf(ss * (1.0f / QLORA) + EPS) * C2B;
#pragma unroll
                for (int bj = 0; bj < 2; ++bj) { const int c = cl + bj * HALF, hd = c / QKB, p = c - hd * QKB;
                    float v[8]; ld8(v, acc[ai][bj][m][0], acc[ai][bj][m][1]);
#pragma unroll
                    for (int j = 0; j < 8; ++j) v[j] *= rs;
                    if (p >= 64) { const f32x4* t = (const f32x4*)(ropeB + (size_t)row * 32 + (p - 64)); rope4(v, t[0], t[1]); }
                    *(u32x4*)(QB + (size_t)row * (NHEAD * QKB) + c) = pack8(v); }
                asm volatile("" ::: "memory"); }
    }
};
struct EpiKV {
    static constexpr bool PERM = true, AFTER_DRAIN = false; static constexpr int MIDT = 0;
    bf16_t *KB, *VB; const float* SS;
    __device__ __forceinline__ void operator()(const f32x4 (&acc)[2][2][4][2], const Unit& u, int wr, int wc, int fr, int fq) const {
        asm volatile("" : "+v"(fr), "+v"(fq));
        const int row0 = u.pm * BM + wr * 64 + fr;
        bf16_t* dst = (wc < 2) ? KB : VB; const int pc = (wc & 1) * 32 + 8 * fq;
#pragma unroll
        for (int ai = 0; ai < 2; ++ai)
#pragma unroll
            for (int m = 0; m < 4; ++m) { const int row = row0 + ai * HALF + m * 16;
                const f32x4 s0 = *(const f32x4*)(SS + (size_t)row * 12 + 8);
                const float rs = __builtin_amdgcn_rsqf(((s0[0] + s0[1]) + (s0[2] + s0[3])) * (1.0f / KVLORA) + EPS);
#pragma unroll
                for (int bj = 0; bj < 2; ++bj) { const int hd = u.pn * 2 + bj;
                    float v[8]; ld8(v, acc[ai][bj][m][0], acc[ai][bj][m][1]);
#pragma unroll
                    for (int j = 0; j < 8; ++j) v[j] *= rs;
                    *(u32x4*)(dst + (size_t)row * AW + hd * HD + pc) = pack8(v); }
                asm volatile("" ::: "memory"); }
    }
};
struct EpiMerge {
    static constexpr bool PERM = true, AFTER_DRAIN = false; static constexpr int MIDT = 8;
    const bf16_t* G; bf16_t* T;
    __device__ __forceinline__ void mid(f32x4 (&acc)[2][2][4][2], const Unit& u, int wr, int wc, int fr, int fq) const {
        asm volatile("" : "+v"(fr), "+v"(fq));
        const int row0 = u.pm * BM + wr * 64 + fr, cl = u.pn * BM + wc * 32 + 8 * fq;
#pragma unroll
        for (int ai = 0; ai < 2; ++ai)
#pragma unroll
            for (int m = 0; m < 4; ++m) { const int row = row0 + ai * HALF + m * 16;
#pragma unroll
                for (int bj = 0; bj < 2; ++bj) { const int c = cl + bj * HALF; float ga[8], gb[8];
                    unpack8(*(const u32x4*)(G + (size_t)row * (2 * DM) + c), ga); unpack8(*(const u32x4*)(G + (size_t)row * (2 * DM) + DM + c), gb);
#pragma unroll
                    for (int j = 0; j < 8; ++j) ga[j] *= __builtin_amdgcn_rcpf(__builtin_fmaxf(gb[j], 1e-30f));
                    acc[ai][bj][m][0] *= (f32x4){ga[0], ga[1], ga[2], ga[3]}; acc[ai][bj][m][1] *= (f32x4){ga[4], ga[5], ga[6], ga[7]}; }
                asm volatile("" ::: "memory"); }
    }
    __device__ __forceinline__ void operator()(const f32x4 (&acc)[2][2][4][2], const Unit& u, int wr, int wc, int fr, int fq) const {
        asm volatile("" : "+v"(fr), "+v"(fq));
        const int row0 = u.pm * BM + wr * 64 + fr, cl = u.pn * BM + wc * 32 + 8 * fq;
#pragma unroll
        for (int ai = 0; ai < 2; ++ai)
#pragma unroll
            for (int m = 0; m < 4; ++m) { const int row = row0 + ai * HALF + m * 16;
#pragma unroll
                for (int bj = 0; bj < 2; ++bj) { const int c = cl + bj * HALF; float v[8], gb[8];
                    ld8(v, acc[ai][bj][m][0], acc[ai][bj][m][1]); unpack8(*(const u32x4*)(G + (size_t)row * (2 * DM) + DM + c), gb);
#pragma unroll
                    for (int j = 0; j < 8; ++j) v[j] *= __builtin_fmaxf(gb[j], 1e-30f);
                    *(u32x4*)(T + (size_t)row * DM + c) = pack8(v); }
                asm volatile("" ::: "memory"); }
    }
};
struct EpiSS {
    static constexpr bool PERM = true, AFTER_DRAIN = false; static constexpr int MIDT = 0;
    bf16_t* Y; float* SSY;
    __device__ __forceinline__ void operator()(const f32x4 (&acc)[2][2][4][2], const Unit& u, int wr, int wc, int fr, int fq) const {
        asm volatile("" : "+v"(fr), "+v"(fq));
        const int row0 = u.pm * BM + wr * 64 + fr, cl = u.pn * BM + wc * 32 + 8 * fq;
#pragma unroll
        for (int ai = 0; ai < 2; ++ai)
#pragma unroll
            for (int m = 0; m < 4; ++m) { const int row = row0 + ai * HALF + m * 16; float s = 0.f;
#pragma unroll
                for (int bj = 0; bj < 2; ++bj) { float v[8]; ld8(v, acc[ai][bj][m][0], acc[ai][bj][m][1]); s += sumsq8(v); *(u32x4*)(Y + (size_t)row * DM + cl + bj * HALF) = pack8(v); }
                s = red_fq(s); if (fq == 0) SSY[(size_t)row * 16 + u.pn * 4 + wc] = s; }
    }
};
struct EpiRelu2 {
    static constexpr bool PERM = true, AFTER_DRAIN = false; static constexpr int MIDT = 0;
    bf16_t* U;
    __device__ __forceinline__ void operator()(const f32x4 (&acc)[2][2][4][2], const Unit& u, int wr, int wc, int fr, int fq) const {
        asm volatile("" : "+v"(fr), "+v"(fq));
        const int row0 = u.pm * BM + wr * 64 + fr, cl = u.pn * BM + wc * 32 + 8 * fq;
#pragma unroll
        for (int ai = 0; ai < 2; ++ai)
#pragma unroll
            for (int m = 0; m < 4; ++m) { const int row = row0 + ai * HALF + m * 16;
#pragma unroll
                for (int bj = 0; bj < 2; ++bj) { float v[8]; ld8(v, acc[ai][bj][m][0], acc[ai][bj][m][1]);
#pragma unroll
                    for (int j = 0; j < 8; ++j) { const float r = __builtin_fmaxf(v[j], 0.f); v[j] = r * r; }
                    *(u32x4*)(U + (size_t)row * DFF + cl + bj * HALF) = pack8(v); } }
    }
};
template <class Epi, class Sched, bool ALIGN_EPI = false, bool SP2 = false>
__device__ __forceinline__ void gemm_phase(PG8_LAS unsigned char* lds, const Gemm g, const Sched& S, const Epi& E) {
    int tid_ = threadIdx.x; asm volatile("" : "+v"(tid_));
    const int tid = tid_, wid = __builtin_amdgcn_readfirstlane(tid >> 6), lane = tid & 63, wr = wid >> 2, wc = wid & 3, fr = lane & 15, fq = lane >> 4;
    const int K = g.K, nt = K / BK, lda = g.lda ? g.lda : K, ldb = g.ldb ? g.ldb : K;
    unsigned voffA[2], voffB[2];
#pragma unroll
    for (int i = 0; i < 2; ++i) { int R, C; stage_rc(tid * 16 + i * 8192, R, C); const int Rb = Epi::PERM ? ((R & ~31) + perm32(R & 31)) : R;
        voffA[i] = (unsigned)(R * lda + C) * 2u; voffB[i] = (unsigned)(Rb * ldb + C) * 2u; }
    const size_t kstep = (size_t)(BK * 2);
    const size_t hstepA = (size_t)HALF * lda * 2, hstepB = (size_t)HALF * ldb * 2;
    const size_t tstepA = 2 * hstepA, tstepB = 2 * hstepB;
    const unsigned ldsw = (unsigned)wid * 1024u;
    const int aoff = lds_byte(wr * 64 + fr, fq * 8), boff = lds_byte(wc * 32 + fr, fq * 8);
#define PG8_SA(b, h) (((b) * 2 + (h)) * HTB)
#define PG8_SB(b, h) ((4 + (b) * 2 + (h)) * HTB)
#define PG8_STAGE(bufoff, gbase, voff) do { _Pragma("unroll") for (int _i = 0; _i < 2; ++_i) \
        __builtin_amdgcn_global_load_lds((const unsigned*)((const char*)(gbase) + (voff)[_i]), (PG8_LAS unsigned*)(lds + (bufoff) + ldsw + _i * 8192), 16, 0, 0); } while (0)
#define PG8_LDA(dst, b, h) do { _Pragma("unroll") for (int m = 0; m < 4; ++m) _Pragma("unroll") for (int k = 0; k < 2; ++k) dst[m][k] = *(const PG8_LAS bf16x8*)(lds + PG8_SA(b, h) + aoff + m * 2048 + k * 1024); } while (0)
#define PG8_LDB(dst, b, h) do { _Pragma("unroll") for (int n = 0; n < 2; ++n) _Pragma("unroll") for (int k = 0; k < 2; ++k) dst[n][k] = *(const PG8_LAS bf16x8*)(lds + PG8_SB(b, h) + boff + n * 2048 + k * 1024); } while (0)
#define PG8_MMA(ai, bj, At, Bt) do { __builtin_amdgcn_s_setprio(1); _Pragma("unroll") for (int m = 0; m < 4; ++m) _Pragma("unroll") for (int n = 0; n < 2; ++n) _Pragma("unroll") for (int k = 0; k < 2; ++k) \
        acc[ai][bj][m][n] = __builtin_amdgcn_mfma_f32_16x16x32_bf16(Bt[n][k], At[m][k], acc[ai][bj][m][n], 0, 0, 0); __builtin_amdgcn_s_setprio(0); } while (0)
#define PG8_WAIT_V(n) asm volatile("s_waitcnt vmcnt(" #n ")" ::: "memory")
#define PG8_WAIT_L(n) asm volatile("s_waitcnt lgkmcnt(" #n ")" ::: "memory")
#define PG8_BAR __builtin_amdgcn_s_barrier()
#define PG8_SCHED __builtin_amdgcn_sched_barrier(0)
    Unit cur, nxt; int ui = 0;
    if (!S.next(0, cur)) return;
    f32x4 acc[2][2][4][2];
#pragma unroll
    for (int a = 0; a < 2; ++a)
#pragma unroll
        for (int b = 0; b < 2; ++b)
#pragma unroll
            for (int m = 0; m < 4; ++m)
#pragma unroll
                for (int n = 0; n < 2; ++n) acc[a][b][m][n] = (f32x4){0.f, 0.f, 0.f, 0.f};
    bf16x8 At[4][2], B0[2][2], B1[2][2];
    const char* cA = (const char*)g.A + (size_t)cur.pm * tstepA; const char* cB = (const char*)g.Bt + (size_t)cur.pn * tstepB;
    S.a_ready(cur);
    if constexpr (SP2) {
        PG8_STAGE(PG8_SB(0, 0), cB, voffB); PG8_STAGE(PG8_SB(0, 1), cB + hstepB, voffB); PG8_STAGE(PG8_SA(0, 0), cA, voffA); PG8_STAGE(PG8_SA(0, 1), cA + hstepA, voffA);
        if (wr == 1) PG8_BAR;
        PG8_WAIT_V(2); PG8_BAR;
        PG8_STAGE(PG8_SB(1, 0), cB + kstep, voffB); PG8_STAGE(PG8_SA(1, 0), cA + kstep, voffA); PG8_STAGE(PG8_SB(1, 1), cB + hstepB + kstep, voffB);
        PG8_WAIT_V(6); PG8_BAR;
    } else {
        PG8_STAGE(PG8_SB(0, 0), cB, voffB); PG8_STAGE(PG8_SA(0, 0), cA, voffA); PG8_STAGE(PG8_SB(0, 1), cB + hstepB, voffB); PG8_STAGE(PG8_SA(0, 1), cA + hstepA, voffA);
        if (wr == 1) PG8_BAR;
        PG8_WAIT_V(4); PG8_BAR;
        PG8_STAGE(PG8_SB(1, 0), cB + kstep, voffB); PG8_STAGE(PG8_SA(1, 0), cA + kstep, voffA); PG8_STAGE(PG8_SB(1, 1), cB + hstepB + kstep, voffB);
        PG8_WAIT_V(6); PG8_BAR;
    }
    for (;;) {
        const bool has_next = S.next(ui + 1, nxt);
        const char* nA = has_next ? (const char*)g.A + (size_t)nxt.pm * tstepA : cA; const char* nB = has_next ? (const char*)g.Bt + (size_t)nxt.pn * tstepB : cB;
#pragma unroll 1
        for (int t = 0; t < nt; t += 2) {
            if constexpr (Epi::MIDT > 0) { if (t == Epi::MIDT) E.mid(acc, cur, wr, wc, fr, fq); }
            const bool last = (t == nt - 2);
            const char* a1 = cA + (size_t)(t + 1) * kstep;
            const char* a2 = last ? nA : cA + (size_t)(t + 2) * kstep; const char* b2 = last ? nB : cB + (size_t)(t + 2) * kstep;
            const char* a3 = a2 + kstep; const char* b3 = b2 + kstep;
            if (last && has_next) S.a_ready(nxt);
            if constexpr (SP2) {
            PG8_LDB(B0, 0, 0); PG8_LDB(B1, 0, 1); PG8_SCHED; PG8_LDA(At, 0, 0); PG8_STAGE(PG8_SA(1, 1), a1 + hstepA, voffA);
            PG8_WAIT_V(8); PG8_WAIT_L(0); PG8_BAR; PG8_MMA(0, 0, At, B0); PG8_MMA(0, 1, At, B1); PG8_BAR; PG8_SCHED;
            PG8_LDA(At, 0, 1); PG8_STAGE(PG8_SB(0, 0), b2, voffB); PG8_STAGE(PG8_SB(0, 1), b2 + hstepB, voffB); PG8_STAGE(PG8_SA(0, 0), a2, voffA);
            PG8_WAIT_V(8); PG8_WAIT_L(0); PG8_BAR; PG8_MMA(1, 0, At, B0); PG8_MMA(1, 1, At, B1); PG8_BAR; PG8_SCHED;
            PG8_LDB(B0, 1, 0); PG8_LDB(B1, 1, 1); PG8_SCHED; PG8_LDA(At, 1, 0); PG8_STAGE(PG8_SA(0, 1), a2 + hstepA, voffA);
            PG8_WAIT_V(8); PG8_WAIT_L(0); PG8_BAR; PG8_MMA(0, 0, At, B0); PG8_MMA(0, 1, At, B1); PG8_BAR; PG8_SCHED;
            PG8_LDA(At, 1, 1); PG8_STAGE(PG8_SB(1, 0), b3, voffB); PG8_STAGE(PG8_SB(1, 1), b3 + hstepB, voffB); PG8_STAGE(PG8_SA(1, 0), a3, voffA);
            PG8_WAIT_V(8); PG8_WAIT_L(0); PG8_BAR; PG8_MMA(1, 0, At, B0); PG8_MMA(1, 1, At, B1); PG8_BAR; PG8_SCHED;
            } else {
            PG8_LDB(B0, 0, 0); PG8_SCHED; PG8_LDA(At, 0, 0); PG8_STAGE(PG8_SA(1, 1), a1 + hstepA, voffA);
            PG8_WAIT_L(8); PG8_BAR; PG8_WAIT_L(0); PG8_MMA(0, 0, At, B0); PG8_BAR; PG8_SCHED;
            PG8_LDB(B1, 0, 1); PG8_STAGE(PG8_SB(0, 0), b2, voffB);
            PG8_BAR; PG8_WAIT_L(0); PG8_MMA(0, 1, At, B1); PG8_BAR;
            PG8_LDA(At, 0, 1); PG8_STAGE(PG8_SA(0, 0), a2, voffA);
            PG8_BAR; PG8_WAIT_L(0); PG8_MMA(1, 0, At, B0); PG8_BAR; PG8_SCHED;
            PG8_STAGE(PG8_SB(0, 1), b2 + hstepB, voffB);
            PG8_WAIT_V(6); PG8_BAR; PG8_MMA(1, 1, At, B1); PG8_BAR;
            PG8_LDB(B0, 1, 0); PG8_SCHED; PG8_LDA(At, 1, 0); PG8_STAGE(PG8_SA(0, 1), a2 + hstepA, voffA);
            PG8_WAIT_L(8); PG8_BAR; PG8_WAIT_L(0); PG8_MMA(0, 0, At, B0); PG8_BAR; PG8_SCHED;
            PG8_LDB(B1, 1, 1); PG8_STAGE(PG8_SB(1, 0), b3, voffB);
            PG8_BAR; PG8_WAIT_L(0); PG8_MMA(0, 1, At, B1); PG8_BAR;
            PG8_LDA(At, 1, 1); PG8_STAGE(PG8_SA(1, 0), a3, voffA);
            PG8_BAR; PG8_WAIT_L(0); PG8_MMA(1, 0, At, B0); PG8_BAR; PG8_SCHED;
            PG8_STAGE(PG8_SB(1, 1), b3 + hstepB, voffB);
            PG8_WAIT_V(6); PG8_BAR; PG8_MMA(1, 1, At, B1); PG8_BAR;
            }
        }
        if constexpr (ALIGN_EPI) { if (wr == 0) PG8_BAR; }
        if constexpr (!Epi::AFTER_DRAIN) { E(acc, cur, wr, wc, fr, fq); S.done(cur); }
        if (!has_next) break;
#pragma unroll
        for (int a = 0; a < 2; ++a)
#pragma unroll
            for (int b = 0; b < 2; ++b)
#pragma unroll
                for (int m = 0; m < 4; ++m)
#pragma unroll
                    for (int n = 0; n < 2; ++n) acc[a][b][m][n] = (f32x4){0.f, 0.f, 0.f, 0.f};
        cur = nxt; cA = nA; cB = nB; ++ui;
        if constexpr (ALIGN_EPI) { if (wr == 1) PG8_BAR; }
    }
    PG8_WAIT_V(0);
    if constexpr (!ALIGN_EPI) { if (wr == 0) PG8_BAR; }
    PG8_BAR;
    if constexpr (Epi::AFTER_DRAIN) { E.fused(acc, cur, wr, wc, fr, fq, lds, wid, lane); S.done(cur); }
#undef PG8_SA
#undef PG8_SB
#undef PG8_STAGE
#undef PG8_LDA
#undef PG8_LDB
#undef PG8_MMA
#undef PG8_WAIT_V
#undef PG8_WAIT_L
#undef PG8_BAR
#undef PG8_SCHED
}
}
namespace att {
typedef unsigned short bf16_t;
typedef short bf16x8 __attribute__((ext_vector_type(8)));
typedef short s16x4 __attribute__((ext_vector_type(4)));
typedef float f32x16 __attribute__((ext_vector_type(16)));
typedef float f32x4 __attribute__((ext_vector_type(4)));
typedef unsigned u32x4 __attribute__((ext_vector_type(4)));
#define ALDS __attribute__((address_space(3)))
#define ASBAR() __builtin_amdgcn_sched_barrier(0)
constexpr int KTB = 12288, VTB = 8192;
constexpr int L_K = 0, L_V = 2 * KTB, L_WS = L_V + 2 * VTB, L_OST = L_WS + 8 * 256, L_KM = L_OST + 8 * 4096, L_RED = L_KM + 2048, L_END = L_RED + 16384;
constexpr float THR = 8.f;
__device__ __forceinline__ int crow(int r, int hi) { return (r & 3) + 8 * (r >> 2) + 4 * hi; }
typedef float f32x2a_t __attribute__((ext_vector_type(2))); typedef __bf16 bf16x2a_t __attribute__((ext_vector_type(2)));
__device__ __forceinline__ unsigned cvtpk(float lo, float hi) { const f32x2a_t v = {lo, hi}; const bf16x2a_t b = __builtin_convertvector(v, bf16x2a_t); return __builtin_bit_cast(unsigned, b); }
__device__ __forceinline__ float bf2f(short s) { return __uint_as_float(((unsigned)(unsigned short)s) << 16); }
__device__ __forceinline__ int v_st(int k, int c) { const int kk = (k & ~0xC) | ((k & 4) << 1) | ((k & 8) >> 1); return ((kk >> 3) * 2 + (c >> 5)) * 512 + ((kk & 7) * 32 + (c & 31)) * 2; }
__device__ __forceinline__ int v_rd_base(int lane) { return ((lane & 3) << 3) | (((lane >> 2) & 3) << 6) | (((lane >> 4) & 1) << 5) | (((lane >> 5) & 1) << 8); }
constexpr int v_rd_off(int d0, int ks, int half) { return ks * 2048 + half * 1024 + d0 * 512; }
template <int OFF> __device__ __forceinline__ s16x4 tr_read(int vb) { s16x4 r; asm volatile("ds_read_b64_tr_b16 %0, %1 offset:%2" : "=&v"(r) : "v"(vb), "i"(OFF) : "memory"); return r; }
template <int D0> __device__ __forceinline__ void pv_one(f32x16& od, int vb, bf16x8 pa0, bf16x8 pa1, bf16x8 pa2, bf16x8 pa3) {
    const s16x4 l0 = tr_read<v_rd_off(D0, 0, 0)>(vb), h0 = tr_read<v_rd_off(D0, 0, 1)>(vb), l1 = tr_read<v_rd_off(D0, 1, 0)>(vb), h1 = tr_read<v_rd_off(D0, 1, 1)>(vb);
    const s16x4 l2 = tr_read<v_rd_off(D0, 2, 0)>(vb), h2 = tr_read<v_rd_off(D0, 2, 1)>(vb), l3 = tr_read<v_rd_off(D0, 3, 0)>(vb), h3 = tr_read<v_rd_off(D0, 3, 1)>(vb);
    asm volatile("s_waitcnt lgkmcnt(0)" ::: "memory"); ASBAR();
#define ATT_PK(L, H) (bf16x8){L[0], L[1], L[2], L[3], H[0], H[1], H[2], H[3]}
    od = __builtin_amdgcn_mfma_f32_32x32x16_bf16(pa0, ATT_PK(l0, h0), od, 0, 0, 0);
    od = __builtin_amdgcn_mfma_f32_32x32x16_bf16(pa1, ATT_PK(l1, h1), od, 0, 0, 0);
    od = __builtin_amdgcn_mfma_f32_32x32x16_bf16(pa2, ATT_PK(l2, h2), od, 0, 0, 0);
    od = __builtin_amdgcn_mfma_f32_32x32x16_bf16(pa3, ATT_PK(l3, h3), od, 0, 0, 0);
#undef ATT_PK
}
__device__ __forceinline__ void pv_all(f32x16* o, int vb, bf16x8 pa0, bf16x8 pa1, bf16x8 pa2, bf16x8 pa3) { pv_one<0>(o[0], vb, pa0, pa1, pa2, pa3); pv_one<1>(o[1], vb, pa0, pa1, pa2, pa3); }
__device__ __forceinline__ void partialSM(f32x16& p0, f32x16& p1, float& m_reg, float& alpha) {
    float pmax = p0[0];
#pragma unroll
    for (int r = 1; r < 16; ++r) pmax = fmaxf(pmax, p0[r]);
#pragma unroll
    for (int r = 0; r < 16; ++r) pmax = fmaxf(pmax, p1[r]);
    { auto rr = __builtin_amdgcn_permlane32_swap(__float_as_uint(pmax), __float_as_uint(pmax), false, false); pmax = fmaxf(__uint_as_float(rr[0]), __uint_as_float(rr[1])); }
    float mn;
    if (__builtin_expect(__all(pmax - m_reg <= THR), 1)) { mn = m_reg; alpha = 1.f; }
    else { mn = fmaxf(m_reg, pmax); alpha = __builtin_amdgcn_exp2f(m_reg - mn); m_reg = mn; }
#pragma unroll
    for (int r = 0; r < 16; ++r) p0[r] = __builtin_amdgcn_exp2f(p0[r] - mn);
#pragma unroll
    for (int r = 0; r < 16; ++r) p1[r] = p1[r] - mn;
}
__device__ __forceinline__ void finishSM(f32x16& p0, f32x16& p1, float alpha, float& l_reg, bf16x8& pa0, bf16x8& pa1, bf16x8& pa2, bf16x8& pa3) {
#pragma unroll
    for (int r = 0; r < 16; ++r) p1[r] = __builtin_amdgcn_exp2f(p1[r]);
    float ps = 0.f;
#pragma unroll
    for (int r = 0; r < 16; ++r) ps += p0[r];
#pragma unroll
    for (int r = 0; r < 16; ++r) ps += p1[r];
    { auto rr = __builtin_amdgcn_permlane32_swap(__float_as_uint(ps), __float_as_uint(ps), false, false); ps = __uint_as_float(rr[0]) + __uint_as_float(rr[1]); }
    l_reg = l_reg * alpha + ps;
#define ATT_PK4(P, BASE, OUT) do { unsigned a0 = cvtpk(P[BASE + 0], P[BASE + 1]), a1 = cvtpk(P[BASE + 2], P[BASE + 3]);   \
    unsigned b0 = cvtpk(P[BASE + 4], P[BASE + 5]), b1 = cvtpk(P[BASE + 6], P[BASE + 7]);                              \
    auto r0 = __builtin_amdgcn_permlane32_swap(a0, b0, false, false); auto r1 = __builtin_amdgcn_permlane32_swap(a1, b1, false, false); \
    u32x4 w = {r0[0], r1[0], r0[1], r1[1]}; OUT = __builtin_bit_cast(bf16x8, w); } while (0)
    ATT_PK4(p0, 0, pa0); ATT_PK4(p0, 8, pa1); ATT_PK4(p1, 0, pa2); ATT_PK4(p1, 8, pa3);
#undef ATT_PK4
}
template <int ND> __device__ __forceinline__ void qkt(f32x16& p0, f32x16& p1, ALDS const char* Kb, const int (&ka)[ND], const bf16x8 (&qr)[ND]) {
    p0 = f32x16{}; p1 = f32x16{};
#pragma unroll
    for (int d0 = 0; d0 < ND; ++d0) {
        const bf16x8 b0 = *(ALDS const bf16x8*)(Kb + ka[d0]);
        const bf16x8 b1 = *(ALDS const bf16x8*)(Kb + ka[d0] + (d0 < 4 ? 4096 : 2048));
        p0 = __builtin_amdgcn_mfma_f32_32x32x16_bf16(b0, qr[d0], p0, 0, 0, 0);
        p1 = __builtin_amdgcn_mfma_f32_32x32x16_bf16(b1, qr[d0], p1, 0, 0, 0);
        if (ND > 4 && d0 == 2) asm volatile("" ::: "memory"); }
}
template <bool MOBA> __device__ __forceinline__ void tmask(f32x16& p0, f32x16& p1, int t, int qb, int qrel, int hi, unsigned sel) {
    const float NEG = -INFINITY;
    if (t >= 4 * qb) { const int thr = qrel - 64 * (t - 4 * qb) - 4 * hi;
#pragma unroll
        for (int r = 0; r < 16; ++r) { if ((r & 3) + 8 * (r >> 2) > thr) p0[r] = NEG; if ((r & 3) + 8 * (r >> 2) + 32 > thr) p1[r] = NEG; } }
    else if (MOBA) { if (!((sel >> (t >> 2)) & 1u)) {
#pragma unroll
        for (int r = 0; r < 16; ++r) { p0[r] = NEG; p1[r] = NEG; } } }
}
__device__ __forceinline__ void kmean_blocks(const bf16_t* Kp, ALDS char* lds) {
    int tid_ = threadIdx.x; asm volatile("" : "+v"(tid_));
    const int tid = tid_, lane = tid & 63, wid = tid >> 6, c = tid & 7, rg = tid >> 3;
    ALDS float* red = (ALDS float*)(lds + L_RED); ALDS float* km = (ALDS float*)(lds + L_KM);
#pragma unroll 1
    for (int n = 0; n < 8; ++n) {
        float a[8];
#pragma unroll
        for (int j = 0; j < 8; ++j) a[j] = 0.f;
#pragma unroll
        for (int i = 0; i < 4; ++i) { const bf16x8 kx = *(const bf16x8*)(Kp + (size_t)(n * 256 + rg + 64 * i) * AW + c * 8);
#pragma unroll
            for (int j = 0; j < 8; ++j) a[j] += bf2f(kx[j]); }
#pragma unroll
        for (int j = 0; j < 8; ++j) { a[j] += __shfl_xor(a[j], 8); a[j] += __shfl_xor(a[j], 16); a[j] += __shfl_xor(a[j], 32); }
        if (lane < 8) {
#pragma unroll
            for (int j = 0; j < 8; ++j) red[(n * 8 + wid) * 64 + c * 8 + j] = a[j]; }
    }
    __syncthreads();
    { const int n = tid >> 6, d = tid & 63; float s = 0.f;
#pragma unroll
        for (int w = 0; w < 8; ++w) s += red[(n * 8 + w) * 64 + d];
        km[n * 64 + d] = s * (1.0f / 256.0f); }
    __syncthreads();
}
template <int DQK, bool MOBA>
__device__ __forceinline__ void attn_unit(const bf16_t* Qp, int ldq, const bf16_t* Kp, const bf16_t* KRp, const bf16_t* Vp, bf16_t* Op, int ldo, int qb, ALDS char* lds) {
    constexpr int ND = DQK / 16;
    int tid_ = threadIdx.x; asm volatile("" : "+v"(tid_));
    const int tid = tid_, lane = tid & 63, r32 = lane & 31, hi = lane >> 5; const int wid = __builtin_amdgcn_readfirstlane(tid >> 6);
    ALDS char* K_lds = lds + L_K; ALDS char* V_lds = lds + L_V;
    ALDS float* ws = (ALDS float*)(lds + L_WS) + wid * 64; ALDS float* li_l = ws; ALDS float* al_l = ws + 32;
    float m_reg = -1e30f, l_reg = 0.f; f32x16 o[2]; o[0] = f32x16{}; o[1] = f32x16{}; bf16x8 qr[ND];
    { const bf16_t* Qw = Qp + (size_t)(wid * 32 + r32) * ldq + hi * 8;
#pragma unroll
      for (int d0 = 0; d0 < ND; ++d0) qr[d0] = *(const bf16x8*)(Qw + d0 * 16); }
    unsigned sel = 0xffu;
    if (MOBA && qb > 3) {
        ALDS const float* km = (ALDS const float*)(lds + L_KM); float g[8];
#pragma unroll
        for (int n = 0; n < 8; ++n) { float s = 0.f;
#pragma unroll
            for (int d0 = 0; d0 < ND; ++d0)
#pragma unroll
                for (int j = 0; j < 8; ++j) s += bf2f(qr[d0][j]) * km[n * 64 + d0 * 16 + hi * 8 + j];
            g[n] = s; }
#pragma unroll
        for (int n = 0; n < 8; ++n) g[n] += __shfl_xor(g[n], 32);
        sel = 0u;
#pragma unroll
        for (int n = 0; n < 8; ++n) { int rank = 0;
#pragma unroll
            for (int mm = 0; mm < 8; ++mm) if (mm != n) rank += (mm < qb && (g[mm] > g[n] || (g[mm] == g[n] && mm < n))) ? 1 : 0;
            if (n < qb && rank < 3) sel |= 1u << n; }
    }
    const int skey = tid >> 3, sch = tid & 7;
    const unsigned koff = (unsigned)(skey * AW + sch * 8) * 2u;
    const int kst = skey * 128 + ((sch ^ ((skey >> 1) & 7)) << 4), vst = v_st(skey, sch * 8);
    const int t2 = tid & 255, rkey = t2 >> 2, rch = t2 & 3;
    const unsigned roff = (unsigned)(rkey * RDIM + rch * 8) * 2u;
    const int rst = 8192 + rkey * 64 + ((rch ^ ((rkey >> 2) & 3)) << 4);
    int ka[ND];
#pragma unroll
    for (int d0 = 0; d0 < ND; ++d0) ka[d0] = (d0 < 4) ? r32 * 128 + (((2 * d0 + hi) ^ ((r32 >> 1) & 7)) << 4) : 8192 + r32 * 64 + (((2 * (d0 - 4) + hi) ^ ((r32 >> 2) & 3)) << 4);
    const int vb0 = (int)(unsigned)(uintptr_t)V_lds + v_rd_base(lane);
    const int qrel = wid * 32 + r32;
    bf16x8 sk0, sv0, sr0, sk1, sv1, sr1;
#define ATT_SLOAD(S, k0) do { sk##S = *(const bf16x8*)((const char*)(Kp + (size_t)(k0) * AW) + koff); sv##S = *(const bf16x8*)((const char*)(Vp + (size_t)(k0) * AW) + koff); if (DQK == 96) sr##S = *(const bf16x8*)((const char*)(KRp + (size_t)(k0) * RDIM) + roff); } while (0)
#define ATT_SWRITE(b, S) do { *(ALDS bf16x8*)(K_lds + (b) * KTB + kst) = sk##S; *(ALDS bf16x8*)(V_lds + (b) * VTB + vst) = sv##S; if (DQK == 96) { if (tid < 256) *(ALDS bf16x8*)(K_lds + (b) * KTB + rst) = sr##S; } } while (0)
#define ATT_RESC(a) do { if (__any((a) < 1.f)) { if (hi == 0) al_l[r32] = (a); asm volatile("s_waitcnt lgkmcnt(0)" ::: "memory"); \
    _Pragma("unroll") for (int d = 0; d < 2; ++d) _Pragma("unroll") for (int r = 0; r < 16; ++r) o[d][r] *= al_l[crow(r, hi)]; } } while (0)
    f32x16 pA0, pA1, pB0, pB1; float alA, alB; bf16x8 pa0, pa1, pa2, pa3; const int NT = 4 * (qb + 1);
    ATT_SLOAD(0, 0); ATT_SWRITE(0, 0); __syncthreads();
    qkt<ND>(pA0, pA1, K_lds, ka, qr); tmask<MOBA>(pA0, pA1, 0, qb, qrel, hi, sel); partialSM(pA0, pA1, m_reg, alA);
    ATT_SLOAD(1, 64); ATT_SLOAD(0, 128);
    ATT_SWRITE(1, 1); __syncthreads();
    for (int j = 1; j + 1 < NT; j += 2) {
        ASBAR(); qkt<ND>(pB0, pB1, K_lds + KTB, ka, qr); tmask<MOBA>(pB0, pB1, j, qb, qrel, hi, sel);
        finishSM(pA0, pA1, alA, l_reg, pa0, pa1, pa2, pa3); ASBAR();
        ATT_SLOAD(1, (j + 2) * 64); ASBAR();
        pv_all(o, vb0, pa0, pa1, pa2, pa3); partialSM(pB0, pB1, m_reg, alB);
        __syncthreads(); ATT_SWRITE(0, 0);
        ATT_RESC(alB); __syncthreads();
        ASBAR(); qkt<ND>(pA0, pA1, K_lds, ka, qr); tmask<MOBA>(pA0, pA1, j + 1, qb, qrel, hi, sel);
        finishSM(pB0, pB1, alB, l_reg, pa0, pa1, pa2, pa3); ASBAR();
        if (j + 3 < NT) ATT_SLOAD(0, (j + 3) * 64); ASBAR();
        pv_all(o, vb0 + VTB, pa0, pa1, pa2, pa3); partialSM(pA0, pA1, m_reg, alA);
        __syncthreads(); ATT_SWRITE(1, 1);
        ATT_RESC(alA); __syncthreads();
    }
    ASBAR(); qkt<ND>(pB0, pB1, K_lds + KTB, ka, qr); tmask<MOBA>(pB0, pB1, NT - 1, qb, qrel, hi, sel);
    finishSM(pA0, pA1, alA, l_reg, pa0, pa1, pa2, pa3); ASBAR();
    pv_all(o, vb0, pa0, pa1, pa2, pa3); partialSM(pB0, pB1, m_reg, alB);
    __syncthreads(); ATT_RESC(alB);
    finishSM(pB0, pB1, alB, l_reg, pa0, pa1, pa2, pa3); ASBAR();
    pv_all(o, vb0 + VTB, pa0, pa1, pa2, pa3);
    if (hi == 0) li_l[r32] = l_reg; asm volatile("s_waitcnt lgkmcnt(0)" ::: "memory");
    float rli[16];
#pragma unroll
    for (int r = 0; r < 16; ++r) rli[r] = __builtin_amdgcn_rcpf(li_l[crow(r, hi)]);
    { ALDS unsigned short* stg = (ALDS unsigned short*)(lds + L_OST) + wid * 2048;
#pragma unroll
      for (int r = 0; r < 16; ++r) { const int orow = crow(r, hi);
#pragma unroll
          for (int d0 = 0; d0 < 2; ++d0) stg[orow * 64 + d0 * 32 + r32] = (unsigned short)(cvtpk(o[d0][r] * rli[r], 0.f) & 0xffffu); }
      asm volatile("s_waitcnt lgkmcnt(0)" ::: "memory");
      bf16_t* Ow = Op + (size_t)(wid * 32) * ldo;
#pragma unroll
      for (int i = 0; i < 4; ++i) { const int row = i * 8 + (lane >> 3), ch = lane & 7; const u32x4 v = *(ALDS const u32x4*)(stg + row * 64 + ch * 8); *(u32x4*)(Ow + (size_t)row * ldo + ch * 8) = v; } }
    __syncthreads();
#undef ATT_SLOAD
#undef ATT_SWRITE
#undef ATT_RESC
}
#undef ASBAR
}
#if defined(DBG_NAIVE_ATTN) || defined(DBG_CHECK)
namespace dbg {
typedef unsigned short bf16_t;
typedef short bf16x8 __attribute__((ext_vector_type(8)));
__device__ __forceinline__ float bf2f(short s) { return __uint_as_float(((unsigned)(unsigned short)s) << 16); }
__device__ __forceinline__ unsigned short f2bf_(float f) { unsigned u = __builtin_bit_cast(unsigned, f); return (unsigned short)((u + 0x7fffu + ((u >> 16) & 1u)) >> 16); }
__global__ void __launch_bounds__(512) kmean_k(const bf16_t* KA, float* KM) {
    const int bh = blockIdx.x, b = bh >> 3, h = bh & 7, n = threadIdx.x >> 6, d = threadIdx.x & 63; float s = 0.f;
    const bf16_t* Kp = KA + (size_t)b * SEQ * AW + h * HD;
#pragma unroll 4
    for (int r = 0; r < 256; ++r) s += bf2f((short)Kp[(size_t)(n * 256 + r) * AW + d]);
    KM[(size_t)bh * 512 + n * 64 + d] = s * (1.0f / 256.0f);
}
template <int DQK, bool MOBA>
__global__ void __launch_bounds__(256) attn_k(const bf16_t* Q, const bf16_t* K, const bf16_t* KR, const bf16_t* V, bf16_t* O, const float* KM) {
    constexpr int ldq = (DQK == 96) ? NHEAD * QKB : AW;
    const int bh = blockIdx.y, b = bh >> 3, h = bh & 7, tid = threadIdx.x;
    const size_t r0 = (size_t)b * SEQ;
    const bf16_t* Qp = Q + r0 * ldq + h * (DQK == 96 ? QKB : HD); const bf16_t* Kp = K + r0 * AW + h * HD; const bf16_t* Vp = V + r0 * AW + h * HD; const bf16_t* KRp = (DQK == 96) ? KR + r0 * RDIM : K;
    bf16_t* Op = O + r0 * AW + h * HD; const float* km = KM + (size_t)bh * 512;
    const int row = blockIdx.x * 64 + (tid >> 2), qb = row >> 8, c4 = tid & 3;
    bf16x8 q[DQK / 8];
#pragma unroll
    for (int c = 0; c < DQK / 8; ++c) q[c] = *(const bf16x8*)(Qp + (size_t)row * ldq + c * 8);
    unsigned sel = 0xffu;
    if (MOBA && qb > 3) {
        float g[8];
#pragma unroll
        for (int n = 0; n < 8; ++n) { float s = 0.f;
#pragma unroll
            for (int c = 0; c < 8; ++c)
#pragma unroll
                for (int j = 0; j < 8; ++j) s += bf2f(q[c][j]) * km[n * 64 + c * 8 + j];
            g[n] = s; }
        sel = 0u;
#pragma unroll
        for (int n = 0; n < 8; ++n) { int rank = 0;
#pragma unroll
            for (int mm = 0; mm < 8; ++mm) if (mm != n) rank += (mm < qb && (g[mm] > g[n] || (g[mm] == g[n] && mm < n))) ? 1 : 0;
            if (n < qb && rank < 3) sel |= 1u << n; }
    }
    float o[16];
#pragma unroll
    for (int d = 0; d < 16; ++d) o[d] = 0.f;
    float mx = -1e30f, l = 0.f;
#pragma unroll 1
    for (int key = 0; key <= row; ++key) {
        const int n = key >> 8;
        if (MOBA && n < qb && !((sel >> n) & 1u)) { key = (n << 8) + 255; continue; }
        float s = 0.f;
#pragma unroll
        for (int c = 0; c < 8; ++c) { const bf16x8 kx = *(const bf16x8*)(Kp + (size_t)key * AW + c * 8);
#pragma unroll
            for (int j = 0; j < 8; ++j) s += bf2f(q[c][j]) * bf2f(kx[j]); }
        if (DQK == 96) {
#pragma unroll
            for (int c = 0; c < 4; ++c) { const bf16x8 kx = *(const bf16x8*)(KRp + (size_t)key * RDIM + c * 8);
#pragma unroll
                for (int j = 0; j < 8; ++j) s += bf2f(q[(DQK == 96 ? 8 : 0) + c][j]) * bf2f(kx[j]); }
        }
        const float mn = fmaxf(mx, s), a = __builtin_amdgcn_exp2f(mx - mn), p = __builtin_amdgcn_exp2f(s - mn);
        l = l * a + p; mx = mn;
#pragma unroll
        for (int c = 0; c < 2; ++c) { const bf16x8 vx = *(const bf16x8*)(Vp + (size_t)key * AW + c4 * 16 + c * 8);
#pragma unroll
            for (int j = 0; j < 8; ++j) o[c * 8 + j] = o[c * 8 + j] * a + p * bf2f(vx[j]); }
    }
    const float rl = 1.f / l;
    __syncthreads();
#pragma unroll
    for (int d = 0; d < 16; ++d) Op[(size_t)row * AW + c4 * 16 + d] = f2bf_(o[d] * rl);
}
}
#endif
#define GAS __attribute__((address_space(1)))
#define LAS __attribute__((address_space(3)))
typedef unsigned short bf16;
typedef unsigned v4u __attribute__((ext_vector_type(4)));
typedef float f32x4 __attribute__((ext_vector_type(4)));
typedef short bf16x8 __attribute__((ext_vector_type(8)));
typedef GAS unsigned gu32;
typedef GAS unsigned long long gu64;
#define RLX_AGENT __ATOMIC_RELAXED, __HIP_MEMORY_SCOPE_AGENT
#define LDS_WAIT() asm volatile("s_waitcnt lgkmcnt(0)" ::: "memory")
#define VM_WAIT() asm volatile("s_waitcnt vmcnt(0)" ::: "memory")
__device__ __forceinline__ unsigned long long rt() { return __builtin_amdgcn_s_memrealtime(); }
__device__ __forceinline__ unsigned f2bf(float f) { unsigned u = __builtin_bit_cast(unsigned, f); return (u + 0x7fffu + ((u >> 16) & 1u)) >> 16; }
__device__ __forceinline__ unsigned pk2(float lo, float hi) { return f2bf(lo) | (f2bf(hi) << 16); }

#define XB_TMO      128
#define XB_XCNT(j)  (256  + 64 * (j))
#define XB_XSUB(j)  (1280 + 64 * (j))
#define XB_XGEN(j)  (2304 + 64 * (j))
#define XB_TOP      3328
#define XB_TOPGEN   3392
#define XCD_BAR_WORDS 3456
#define XB_SPIN_CAP (1u << 18)

__device__ __forceinline__ unsigned xb_ld(unsigned* p)              { return __hip_atomic_load(p, __ATOMIC_RELAXED, __HIP_MEMORY_SCOPE_AGENT); }
__device__ __forceinline__ unsigned xb_add(unsigned* p, unsigned v) { return __hip_atomic_fetch_add(p, v, __ATOMIC_RELAXED, __HIP_MEMORY_SCOPE_AGENT); }
__device__ __forceinline__ unsigned xb_xcc_id() { return (unsigned)__builtin_amdgcn_s_getreg((3 << 11) | 20) & 0xFu; }
#define XB_SPIN(cond, bar) do { unsigned _sp = 0; while (cond) { __builtin_amdgcn_s_sleep(1); \
    if ((++_sp & 255u) == 0u) { if (xb_ld(&(bar)[XB_TMO])) break; if (_sp > XB_SPIN_CAP) { atomicAdd(&(bar)[XB_TMO], 1u); break; } } } } while (0)

struct XcdBarrier {
    unsigned* bar; unsigned x;
    volatile LAS unsigned* st;
};

__device__ __forceinline__ XcdBarrier xcd_barrier_post(unsigned* bar, volatile LAS unsigned* st) {
    XcdBarrier b; b.bar = bar; b.x = xb_xcc_id(); b.st = st;
    if (threadIdx.x == 0) (void)xb_add(&bar[XB_XCNT(b.x)], 1u);
    return b;
}
__device__ __forceinline__ void xcd_barrier_complete(unsigned* bar, unsigned x, unsigned& nloc, unsigned& nx) {
    const unsigned G = gridDim.x * gridDim.y * gridDim.z;
    unsigned sum, cnt, mine, sp = 0u;
    for (;;) {
        sum = 0u; cnt = 0u; mine = 0u;
#pragma unroll
        for (unsigned j = 0; j < 16; ++j) { const unsigned c = xb_ld(&bar[XB_XCNT(j)]); sum += c; cnt += (c > 0u) ? 1u : 0u; mine = (j == x) ? c : mine; }
        if (sum == G) break;
        __builtin_amdgcn_s_sleep(1);
        if ((++sp & 255u) == 0u) { if (xb_ld(&bar[XB_TMO])) break; if (sp > XB_SPIN_CAP) { atomicAdd(&bar[XB_TMO], 1u); break; } }
    }
    nloc = mine > 0u ? mine : 1u; nx = cnt > 0u ? cnt : 1u;
}

__device__ __forceinline__ void xcd_barrier(const XcdBarrier& b) {
    asm volatile("s_waitcnt vmcnt(0)" ::: "memory");
    __syncthreads();
    if (threadIdx.x == 0) {
        unsigned* bar = b.bar;
        __builtin_amdgcn_s_waitcnt(0);
        unsigned nloc = b.st[0], nx = b.st[1];
        if (nloc == 0u) { xcd_barrier_complete(bar, b.x, nloc, nx); b.st[0] = nloc; b.st[1] = nx; }
        const unsigned old = xb_add(&bar[XB_XSUB(b.x)], 1u);
        const unsigned gen = old / nloc;
        if (old + 1u == (gen + 1u) * nloc) {
            __builtin_amdgcn_fence(__ATOMIC_RELEASE, "agent");
            asm volatile("s_waitcnt vmcnt(0)" ::: "memory");
            const unsigned og = xb_add(&bar[XB_TOP], 1u);
            const unsigned tg = og / nx;
            if (og + 1u == (tg + 1u) * nx) xb_add(&bar[XB_TOPGEN], 1u);
            else XB_SPIN(xb_ld(&bar[XB_TOPGEN]) == tg, bar);
            __builtin_amdgcn_fence(__ATOMIC_ACQUIRE, "agent");
            xb_add(&bar[XB_XGEN(b.x)], 1u);
            asm volatile("s_waitcnt vmcnt(0)" ::: "memory");
        } else {
            XB_SPIN(xb_ld(&bar[XB_XGEN(b.x)]) == gen, bar);
            __builtin_amdgcn_fence(__ATOMIC_ACQUIRE, "agent");
            asm volatile("s_waitcnt vmcnt(0)" ::: "memory");
        }
    }
    __syncthreads();
}
#if defined(DBG_CHECK)
namespace chk {
typedef unsigned short bf16_t;
__device__ __forceinline__ float bfv(const bf16_t* p, size_t i) { return __uint_as_float(((unsigned)p[i]) << 16); }
__device__ __forceinline__ unsigned hsh(unsigned x) { x ^= x >> 16; x *= 0x7feb352du; x ^= x >> 15; x *= 0x846ca68bu; x ^= x >> 16; return x; }
__device__ __forceinline__ void report(unsigned* cnt, int stage, float got, float want) {
    atomicAdd(&cnt[64 + stage], 1u);
    if (!(fabsf(got - want) <= 0.04f + 0.04f * fabsf(want))) atomicAdd(&cnt[stage], 1u);
}
__device__ __forceinline__ void cs_of(int pos, int i, int half, float& c, float& s) {
    const float invf = (float)exp2(-(double)i * 18.931568569324174 / (double)half);
    const float ang = (float)pos * invf; double t = (double)ang * 0.15915494309189535; t -= floor(t);
    c = __builtin_amdgcn_cosf((float)t); s = __builtin_amdgcn_sinf((float)t);
}
constexpr int NS = 64 * 256;
__global__ void __launch_bounds__(256) k_c0(const float* x, const float* g, const bf16_t* H, unsigned* cnt) {
    const unsigned id = blockIdx.x * 256 + threadIdx.x, r = hsh(id * 2654435761u + 17u); const int m = r % MTOK, k = (r >> 16) % DM;
    double ss = 0.0; for (int i = 0; i < DM; ++i) { const double v = x[(size_t)m * DM + i]; ss += v * v; }
    const float want = (float)(x[(size_t)m * DM + k] / sqrt(ss / DM + 1e-6) * g[k]);
    report(cnt, 1, bfv(H, (size_t)m * DM + k), want);
}
__device__ __forceinline__ float dot_h(const bf16_t* H, const float* W, int m, int j) { double a = 0.0; for (int k = 0; k < DM; ++k) a += (double)bfv(H, (size_t)m * DM + k) * (double)W[(size_t)k * INW + j]; return (float)a; }
__global__ void __launch_bounds__(256) k_c1(const bf16_t* H, const float* w_in, const float* b_gate, const int* positions, const bf16_t* QA, const bf16_t* KA, const bf16_t* VA, const bf16_t* CQ, const bf16_t* CKV,
                                            const bf16_t* KR, const bf16_t* G, unsigned* cnt) {
    const unsigned id = blockIdx.x * 256 + threadIdx.x, r = hsh(id * 2654435761u + 101u); const int m = r % MTOK; int j;
    { const unsigned r2 = hsh(r + 77u); const int cls = id % 8;
      if (cls == 0) j = (r2 % 8) * 64 + (r2 >> 8) % 16; else if (cls == 1) j = 512 + (r2 % 8) * 64 + (r2 >> 8) % 16; else if (cls == 2) j = 2176 + r2 % 32; else j = r2 % INW; }
    const int pos = positions[m];
    if (j < 1024) { const int sect = j >> 9, jj = j & 511, head = jj >> 6, d = jj & 63; const bf16_t* dst = sect ? KA : QA; const float sc = sect ? 1.f : C2A;
        if (d < 16) { const int i = d & 7; const float x1 = dot_h(H, w_in, m, sect * 512 + head * 64 + i), x2 = dot_h(H, w_in, m, sect * 512 + head * 64 + i + 8); float c, s; cs_of(pos, i, 8, c, s);
            const float want = ((d < 8) ? x1 * c - x2 * s : x2 * c + x1 * s) * sc; report(cnt, sect ? 4 : 2, bfv(dst, (size_t)m * AW + head * 64 + 2 * i + (d >> 3)), want); }
        else report(cnt, sect ? 5 : 3, bfv(dst, (size_t)m * AW + head * 64 + d), dot_h(H, w_in, m, j) * sc); }
    else if (j < 1536) report(cnt, 6, bfv(VA, (size_t)m * AW + (j - 1024)), dot_h(H, w_in, m, j));
    else if (j < 1920) report(cnt, 7, bfv(CQ, (size_t)m * QLORA + (j - 1536)), dot_h(H, w_in, m, j));
    else if (j < 2176) report(cnt, 8, bfv(CKV, (size_t)m * KVLORA + (j - 1920)), dot_h(H, w_in, m, j));
    else if (j < 2208) { const int dd = j - 2176, i = dd & 15; const float x1 = dot_h(H, w_in, m, 2176 + i), x2 = dot_h(H, w_in, m, 2176 + i + 16); float c, s; cs_of(pos, i, 16, c, s);
        report(cnt, 9, bfv(KR, (size_t)m * RDIM + 2 * i + (dd >> 4)), (dd < 16) ? x1 * c - x2 * s : x2 * c + x1 * s); }
    else { const float z = dot_h(H, w_in, m, j) + b_gate[j - 2208]; const float want = 1.f / (1.f + expf(-z)), got = bfv(G, (size_t)m * 2 * DM + (j - 2208)); report(cnt, 10, got, want); report(cnt, 24 + ((j - 2208) >> 8), got, want); }
}
__global__ void __launch_bounds__(256) k_c2(const bf16_t* CQ, const bf16_t* CKV, const float* g_q, const float* w_uq, const float* g_kv, const float* w_ukv, const int* positions, const bf16_t* QB, const bf16_t* KB,
                                            const bf16_t* VB, unsigned* cnt) {
    const unsigned id = blockIdx.x * 256 + threadIdx.x, r = hsh(id * 2654435761u + 303u); const int m = r % MTOK; const unsigned r2 = hsh(r + 5u);
    const int pos = positions[m];
    if (id & 1) { int n = r2 % 768; if ((id & 6) == 2) n = (n / QKB) * QKB + 64 + n % 32;
        double ss = 0.0; for (int k = 0; k < QLORA; ++k) { const double v = bfv(CQ, (size_t)m * QLORA + k); ss += v * v; } const double rs = 1.0 / sqrt(ss / QLORA + 1e-6);
        auto dq = [&](int nn) { double a = 0.0; for (int k = 0; k < QLORA; ++k) a += (double)bfv(CQ, (size_t)m * QLORA + k) * g_q[k] * w_uq[(size_t)k * 768 + nn]; return (float)(a * rs); };
        const int head = n / QKB, pp = n % QKB;
        if (pp < 64) report(cnt, 11, bfv(QB, (size_t)m * 768 + n), dq(n) * C2B);
        else { const int dd = pp - 64, i = dd & 15; const float x1 = dq(head * QKB + 64 + i), x2 = dq(head * QKB + 64 + i + 16); float c, s; cs_of(pos, i, 16, c, s);
            report(cnt, 12, bfv(QB, (size_t)m * 768 + head * QKB + 64 + 2 * i + (dd >> 4)), ((dd < 16) ? x1 * c - x2 * s : x2 * c + x1 * s) * C2B); } }
    else { const int n = r2 % 1024;
        double ss = 0.0; for (int k = 0; k < KVLORA; ++k) { const double v = bfv(CKV, (size_t)m * KVLORA + k); ss += v * v; } const double rs = 1.0 / sqrt(ss / KVLORA + 1e-6);
        double a = 0.0; for (int k = 0; k < KVLORA; ++k) a += (double)bfv(CKV, (size_t)m * KVLORA + k) * g_kv[k] * w_ukv[(size_t)k * 1024 + n];
        const int head = n >> 7, pp = n & 127;
        if (pp < 64) report(cnt, 13, bfv(KB, (size_t)m * AW + head * 64 + pp), (float)(a * rs)); else report(cnt, 14, bfv(VB, (size_t)m * AW + head * 64 + pp - 64), (float)(a * rs)); }
}
__global__ void __launch_bounds__(256) k_c4(const bf16_t* OA, const bf16_t* OB, const bf16_t* G, const float* w_a, const float* w_b, const bf16_t* T, unsigned* cnt) {
    const unsigned id = blockIdx.x * 256 + threadIdx.x, r = hsh(id * 2654435761u + 404u); const int m = r % MTOK, n = (r >> 16) % DM;
    double a = 0.0, b = 0.0; for (int k = 0; k < AW; ++k) { a += (double)bfv(OA, (size_t)m * AW + k) * w_a[(size_t)k * DM + n]; b += (double)bfv(OB, (size_t)m * AW + k) * w_b[(size_t)k * DM + n]; }
    report(cnt, 17, bfv(T, (size_t)m * DM + n), (float)(a * bfv(G, (size_t)m * 2 * DM + n) + b * bfv(G, (size_t)m * 2 * DM + DM + n)));
}
__global__ void __launch_bounds__(256) k_c5(const bf16_t* T, const float* w_out, const bf16_t* Y, unsigned* cnt) {
    const unsigned id = blockIdx.x * 256 + threadIdx.x, r = hsh(id * 2654435761u + 505u); const int m = r % MTOK, n = (r >> 16) % DM;
    double a = 0.0; for (int k = 0; k < DM; ++k) a += (double)bfv(T, (size_t)m * DM + k) * w_out[(size_t)k * DM + n];
    report(cnt, 18, bfv(Y, (size_t)m * DM + n), (float)a);
}
__global__ void __launch_bounds__(256) k_c6(const bf16_t* Y, const float* x, const float* g1, const float* g2, const float* x1, const bf16_t* H2, unsigned* cnt) {
    const unsigned id = blockIdx.x * 256 + threadIdx.x, r = hsh(id * 2654435761u + 606u); const int m = r % MTOK, k = (r >> 16) % DM;
    double ss = 0.0; for (int i = 0; i < DM; ++i) { const double v = bfv(Y, (size_t)m * DM + i); ss += v * v; } const double rs = 1.0 / sqrt(ss / DM + 1e-6);
    double s2 = 0.0, xk = 0.0; for (int i = 0; i < DM; ++i) { const double v = x[(size_t)m * DM + i] + bfv(Y, (size_t)m * DM + i) * rs * g1[i]; s2 += v * v; if (i == k) xk = v; }
    report(cnt, 19, x1[(size_t)m * DM + k], (float)xk);
    report(cnt, 20, bfv(H2, (size_t)m * DM + k), (float)(xk / sqrt(s2 / DM + 1e-6) * g2[k]));
}
__global__ void __launch_bounds__(256) k_c7(const bf16_t* H2, const float* w_up, const bf16_t* U, unsigned* cnt) {
    const unsigned id = blockIdx.x * 256 + threadIdx.x, r = hsh(id * 2654435761u + 707u); const int m = r % MTOK, n = (r >> 16) % DFF;
    double a = 0.0; for (int k = 0; k < DM; ++k) a += (double)bfv(H2, (size_t)m * DM + k) * w_up[(size_t)k * DFF + n];
    const float v = a > 0.0 ? (float)a : 0.f; report(cnt, 21, bfv(U, (size_t)m * DFF + n), v * v);
}
__global__ void __launch_bounds__(256) k_c8(const bf16_t* U, const float* w_dn, const bf16_t* Mo, unsigned* cnt) {
    const unsigned id = blockIdx.x * 256 + threadIdx.x, r = hsh(id * 2654435761u + 808u); const int m = r % MTOK, n = (r >> 16) % DM;
    double a = 0.0; for (int k = 0; k < DFF; ++k) a += (double)bfv(U, (size_t)m * DFF + k) * w_dn[(size_t)k * DM + n];
    report(cnt, 22, bfv(Mo, (size_t)m * DM + n), (float)a);
}
__global__ void __launch_bounds__(256) k_c9a(const bf16_t* Mo, const float* x1, const float* g, float* expv) {
    const unsigned id = blockIdx.x * 256 + threadIdx.x, r = hsh(id * 2654435761u + 909u); const int m = r % MTOK, k = (r >> 16) % DM;
    double ss = 0.0; for (int i = 0; i < DM; ++i) { const double v = bfv(Mo, (size_t)m * DM + i); ss += v * v; }
    expv[id] = (float)(x1[(size_t)m * DM + k] + bfv(Mo, (size_t)m * DM + k) / sqrt(ss / DM + 1e-6) * g[k]);
}
__global__ void __launch_bounds__(256) k_c9b(const float* out, const float* expv, unsigned* cnt) {
    const unsigned id = blockIdx.x * 256 + threadIdx.x, r = hsh(id * 2654435761u + 909u); const int m = r % MTOK, k = (r >> 16) % DM;
    report(cnt, 23, out[(size_t)m * DM + k], expv[id]);
}
__global__ void __launch_bounds__(256) k_cmp(const bf16_t* F, const bf16_t* N, int stage, unsigned* cnt) {
    const unsigned id = blockIdx.x * 256 + threadIdx.x, r = hsh(id * 2654435761u + 1234u + stage); const int m = r % MTOK, k = (r >> 16) % AW;
    report(cnt, stage, bfv(F, (size_t)m * AW + k), bfv(N, (size_t)m * AW + k));
}
__global__ void __launch_bounds__(256) k_fin(const unsigned* cnt, float* out) {
    int s = 0; for (int i = 1; i < 32; ++i) if (cnt[i] > 2u) { s = i; break; }
    if (DBG_CHECK > 100 && s) { int k = 0; for (int i = 1; i < 32; ++i) if (cnt[i] > 2u) { if (++k == DBG_CHECK - 100) { s = i; break; } } }
    size_t nz = (size_t)s * (MTOK / 25) * DM;
    if (DBG_CHECK == 2) { const double f = (double)cnt[10] / (double)(cnt[74] ? cnt[74] : 1u); nz = (size_t)(f * MTOK) * DM; }
    if (DBG_CHECK == 3) { unsigned mask = 0; for (int t = 0; t < 8; ++t) if (cnt[24 + t] > 2u) mask |= 1u << t; nz = (size_t)mask * (MTOK / 256) * DM; }
    for (size_t i = (size_t)blockIdx.x * 256 + threadIdx.x; i < nz; i += (size_t)gridDim.x * 256) out[i] = 0.f;
}
}
#endif

constexpr size_t MiB = 1u << 20;
constexpr size_t WS_CTL = 0, CTL_ZERO_BYTES = 64 * 1024;
constexpr size_t WS_ROPEA = 1 * MiB, WS_ROPEB = 5 * MiB;
constexpr size_t WS_SS = 13 * MiB, WS_SS2 = 16 * MiB, WS_SS3 = 20 * MiB;
constexpr size_t WS_WIN = 24 * MiB, WS_WUQ = 33 * MiB, WS_WUKV = 34 * MiB, WS_WA = 35 * MiB, WS_WB = 36 * MiB, WS_WOUT = 37 * MiB, WS_WUP = 39 * MiB, WS_WDN = 47 * MiB;
constexpr size_t WS_H = 64 * MiB;
constexpr size_t WS_G = 192 * MiB;
constexpr size_t WS_QA = 448 * MiB, WS_KA = 512 * MiB, WS_VA = 576 * MiB;
constexpr size_t WS_T = WS_KA;
constexpr size_t WS_CQ = 640 * MiB, WS_CKV = 688 * MiB;
constexpr size_t WS_OB = WS_CQ;
constexpr size_t WS_KR = 720 * MiB;
constexpr size_t WS_QB = 728 * MiB, WS_KB = 824 * MiB, WS_VB = 888 * MiB;
constexpr size_t WS_Y = WS_QB;
constexpr size_t WS_X1 = 856 * MiB;
constexpr size_t WS_U = 192 * MiB;
constexpr size_t WS_END = 984 * MiB;
static_assert(WS_U + (size_t)MTOK * DFF * 2 <= WS_KR && WS_Y + (size_t)MTOK * DM * 2 <= WS_VB && WS_OB + (size_t)MTOK * AW * 2 <= WS_KR && WS_T + (size_t)MTOK * DM * 2 <= WS_CQ, "d_ws map");
static_assert(WS_WIN + (size_t)INWP * DM * 2 <= WS_WUQ && WS_WDN + (size_t)DM * DFF * 2 <= WS_H && WS_VB + (size_t)MTOK * AW * 2 <= WS_END && WS_X1 + (size_t)MTOK * DM * 2 <= WS_END && WS_Y + (size_t)MTOK * DM * 2 <= WS_X1, "d_ws map");
constexpr int CW_BAR = 0;
constexpr int NWAVES = 8;
constexpr int RING_OFF = 0, RING_BYTES = 131072;
constexpr int LDSCTL_OFF = RING_BYTES, MISC_OFF = LDSCTL_OFF + 320;
constexpr int LDS_BYTES = 147456;
static_assert(att::L_END <= RING_BYTES, "attention LDS map");

struct Frame {
    LAS unsigned char* lds;
    volatile LAS unsigned* MISC;
    gu32* ctl;
    int tid, lane, wave, vcu, G;
};

__device__ __forceinline__ float wave_sum(float v) {
#pragma unroll
    for (int o = 1; o < 64; o <<= 1) v += __shfl_xor(v, o);
    return v;
}
__device__ __forceinline__ int srccol(int mat, int n) {
    if (mat == 0) {
        if (n < 1024) { const int sect = n >> 9, c = n & 511, head = c >> 6, p = c & 63; const int d = (p < 16) ? ((p >> 1) + 8 * (p & 1)) : p; return sect * 512 + head * 64 + d; }
        if (n < 1920) return n;
        if (n < 1952) { const int pr = n - 1920; return 2176 + (pr >> 1) + 16 * (pr & 1); }
        if (n < 2048) return -1;
        if (n < 2304) return 1920 + (n - 2048);
        return 2208 + (n - 2304);
    }
    if (mat == 1) { const int head = n / QKB, p = n - head * QKB; if (p < 64) return n; const int pr = p - 64; return head * QKB + 64 + (pr >> 1) + 16 * (pr & 1); }
    return n;
}
__device__ __forceinline__ void p0_transpose_item(const float* W, int K, int Nsrc, int Ndst, bf16* WT, int ldw, int koff, const float* gs, int mat, LAS float* scr, int item, int lane) {
    const int nblk = Ndst / 32, kb = item / nblk, nb = item % nblk, k0 = 64 * kb, n0 = 32 * nb;
    const int sc = srccol(mat, n0 + (lane & 31));
#pragma unroll 8
    for (int i = 0; i < 32; ++i) { const int kk = 2 * i + (lane >> 5); float v = (sc >= 0) ? W[(size_t)(k0 + kk) * Nsrc + sc] : 0.f; if (gs) v *= gs[k0 + kk]; scr[kk * 33 + (lane & 31)] = v; }
    LDS_WAIT(); asm volatile("" ::: "memory");
    const int c = lane & 7;
#pragma unroll
    for (int j = 0; j < 4; ++j) { const int n = (lane >> 3) + 8 * j; const LAS float* s = scr + (8 * c) * 33 + n;
        v4u o; o.x = pk2(s[0 * 33], s[1 * 33]); o.y = pk2(s[2 * 33], s[3 * 33]); o.z = pk2(s[4 * 33], s[5 * 33]); o.w = pk2(s[6 * 33], s[7 * 33]);
        *(GAS v4u*)(WT + (size_t)(n0 + n) * ldw + koff + k0 + 8 * c) = o; }
    LDS_WAIT(); asm volatile("" ::: "memory");
}
__device__ __forceinline__ void rms_row_to_bf16(int lane, const float* xrow, const f32x4 (&g)[4], bf16* orow) {
    const GAS f32x4* xr = (const GAS f32x4*)xrow + lane;
    f32x4 v[4]; float s = 0.f;
#pragma unroll
    for (int j = 0; j < 4; ++j) { v[j] = xr[64 * j]; s += (v[j].x * v[j].x + v[j].y * v[j].y) + (v[j].z * v[j].z + v[j].w * v[j].w); }
    const float rstd = 1.f / sqrtf(wave_sum(s) * (1.f / DM) + EPS);
    GAS unsigned long long* o8 = (GAS unsigned long long*)orow + lane;
#pragma unroll
    for (int j = 0; j < 4; ++j) { const f32x4 y = v[j] * rstd * g[j]; o8[64 * j] = (unsigned long long)pk2(y.x, y.y) | ((unsigned long long)pk2(y.z, y.w) << 32); }
}

struct Args { const float* in[17]; float* out; unsigned char* ws; int ph_lo, ph_hi, li, pad; };

__global__ void __launch_bounds__(NWAVES * 64, 2) block_fwd(Args args) {
    extern __shared__ __attribute__((aligned(16))) unsigned char lds[];
    Frame F;
    F.lds = (LAS unsigned char*)lds;
    F.MISC = (volatile LAS unsigned*)(F.lds + MISC_OFF);
    F.tid = threadIdx.x; F.lane = F.tid & 63; F.wave = __builtin_amdgcn_readfirstlane(F.tid >> 6);
    F.G = gridDim.x; { const int bx = blockIdx.x; F.vcu = (F.G % 8 == 0) ? (bx % 8) * (F.G / 8) + bx / 8 : bx; }
    unsigned char* ws = args.ws;
    F.ctl = (gu32*)(ws + WS_CTL);
    const float* x = args.in[0]; const int* positions = (const int*)args.in[1];
    const float *g_pre_mix = args.in[2], *w_in = args.in[3], *b_gate = args.in[4], *g_q = args.in[5], *w_uq = args.in[6], *g_kv = args.in[7], *w_ukv = args.in[8], *w_a = args.in[9], *w_b = args.in[10],
                *w_out = args.in[11], *g_post_mix = args.in[12], *g_pre_mlp = args.in[13], *w_up = args.in[14], *w_dn = args.in[15], *g_post_mlp = args.in[16];
    float* out = args.out;
    float* ropeA = (float*)(ws + WS_ROPEA); float* ropeB = (float*)(ws + WS_ROPEB);
    float* SS = (float*)(ws + WS_SS); float* SS2 = (float*)(ws + WS_SS2); float* SS3 = (float*)(ws + WS_SS3);
    bf16 *WIN = (bf16*)(ws + WS_WIN), *WUQ = (bf16*)(ws + WS_WUQ), *WUKV = (bf16*)(ws + WS_WUKV), *WA = (bf16*)(ws + WS_WA), *WB = (bf16*)(ws + WS_WB), *WOUT = (bf16*)(ws + WS_WOUT), *WUP = (bf16*)(ws + WS_WUP), *WDN = (bf16*)(ws + WS_WDN);
    bf16 *H = (bf16*)(ws + WS_H), *Gt = (bf16*)(ws + WS_G), *QA = (bf16*)(ws + WS_QA), *KA = (bf16*)(ws + WS_KA), *VA = (bf16*)(ws + WS_VA), *T = (bf16*)(ws + WS_T), *CQ = (bf16*)(ws + WS_CQ), *CKV = (bf16*)(ws + WS_CKV),
         *OB = (bf16*)(ws + WS_OB), *KR = (bf16*)(ws + WS_KR), *QB = (bf16*)(ws + WS_QB), *KB = (bf16*)(ws + WS_KB), *VB = (bf16*)(ws + WS_VB), *Y = (bf16*)(ws + WS_Y), *U = (bf16*)(ws + WS_U), *X1B = (bf16*)(ws + WS_X1);
    for (int u = F.tid; u < (LDS_BYTES - LDSCTL_OFF) / 4; u += NWAVES * 64) ((LAS unsigned*)(F.lds + LDSCTL_OFF))[u] = 0u;
    __syncthreads();
    XcdBarrier bar = xcd_barrier_post((unsigned*)(F.ctl + CW_BAR) + args.li * XCD_BAR_WORDS, F.MISC + 8);
    const int lo = args.ph_lo, hi = args.ph_hi;
#define IN(k) (lo <= (k) && (k) < hi)
#define SEAM(k) do { if (IN(k) && IN((k) + 1)) xcd_barrier(bar); } while (0)
    const int gw = F.vcu * NWAVES + F.wave, NGW = F.G * NWAVES;

#if !defined(SKIP_P0)
    if (IN(0))
    {
        LAS float* scr = (LAS float*)(F.lds + RING_OFF + F.wave * 16384);
        constexpr int I0 = (DM / 64) * (INWP / 32), I1 = (QLORA / 64) * (768 / 32), I2 = (KVLORA / 64) * (1024 / 32), I3 = (AW / 64) * (DM / 32), I5 = (DM / 64) * (DM / 32), I6 = (DM / 64) * (DFF / 32), I7 = (DFF / 64) * (DM / 32);
        constexpr int NITEMS = I0 + I1 + I2 + 2 * I3 + I5 + I6 + I7;
        for (int it = gw; it < NITEMS; it += NGW) {
            int r = it;
            if (r < I0) { p0_transpose_item(w_in, DM, INW, INWP, WIN, DM, 0, nullptr, 0, scr, r, F.lane); continue; } r -= I0;
            if (r < I1) { p0_transpose_item(w_uq, QLORA, 768, 768, WUQ, QLORA, 0, g_q, 1, scr, r, F.lane); continue; } r -= I1;
            if (r < I2) { p0_transpose_item(w_ukv, KVLORA, 1024, 1024, WUKV, KVLORA, 0, g_kv, 2, scr, r, F.lane); continue; } r -= I2;
            if (r < I3) { p0_transpose_item(w_a, AW, DM, DM, WA, DM, 0, nullptr, 2, scr, r, F.lane); continue; } r -= I3;
            if (r < I3) { p0_transpose_item(w_b, AW, DM, DM, WA, DM, AW, nullptr, 2, scr, r, F.lane); continue; } r -= I3;
            if (r < I5) { p0_transpose_item(w_out, DM, DM, DM, WOUT, DM, 0, nullptr, 2, scr, r, F.lane); continue; } r -= I5;
            if (r < I6) { p0_transpose_item(w_up, DM, DFF, DFF, WUP, DM, 0, nullptr, 2, scr, r, F.lane); continue; } r -= I6;
            p0_transpose_item(w_dn, DFF, DM, DM, WDN, DFF, 0, nullptr, 2, scr, r, F.lane);
        }
        for (int idx = (int)blockIdx.x * (NWAVES * 64) + F.tid; idx < MTOK * 24; idx += F.G * NWAVES * 64) {
            const int m = idx / 24, i = idx - m * 24;
            const float invf = (i < 8) ? __builtin_amdgcn_exp2f(-(float)i * 2.3664460711655217f) : __builtin_amdgcn_exp2f(-(float)(i - 8) * 1.1832230355827609f);
            const float ang = (float)positions[m] * invf;
            double t = (double)ang * 0.15915494309189535; t -= floor(t);
            const float tf = (float)t; const float c = __builtin_amdgcn_cosf(tf), s = __builtin_amdgcn_sinf(tf);
            float* dst = (i < 8) ? ropeA + (size_t)m * 16 + 2 * i : ropeB + (size_t)m * 32 + 2 * (i - 8);
            *(f32x2g*)dst = (f32x2g){c, s};
        }
        f32x4 g[4];
#pragma unroll
        for (int j = 0; j < 4; ++j) g[j] = ((const GAS f32x4*)g_pre_mix)[F.lane + 64 * j];
        for (int m = gw; m < MTOK; m += NGW) rms_row_to_bf16(F.lane, x + (size_t)m * DM, g, H + (size_t)m * DM);
    }
#endif
    SEAM(0);

#if !defined(SKIP_P1)
    if (IN(1))
    {
        pg8::Gemm g{H, WIN, MTOK, INWP, DM}; pg8::StaticOrder S; S.init(MTOK, INWP, F.G, (int)blockIdx.x);
        pg8::EpiIn E{QA, KA, VA, CQ, CKV, KR, Gt, SS, ropeA, ropeB, b_gate};
        pg8::gemm_phase<pg8::EpiIn, pg8::StaticOrder, true, true>(F.lds + RING_OFF, g, S, E);
    }
#endif
    SEAM(1);

#if !defined(SKIP_P2)
    if (IN(2)) {
    {
        pg8::Gemm g{CQ, WUQ, MTOK, NHEAD * QKB, QLORA}; pg8::StaticOrder S; S.init(MTOK, NHEAD * QKB, F.G, (int)blockIdx.x);
        pg8::EpiQ E{QB, SS, ropeB};
        pg8::gemm_phase<pg8::EpiQ, pg8::StaticOrder, true, true>(F.lds + RING_OFF, g, S, E);
    }
    {
        pg8::Gemm g{CKV, WUKV, MTOK, 2 * AW, KVLORA}; pg8::StaticOrder S; S.init(MTOK, 2 * AW, F.G, (int)blockIdx.x);
        pg8::EpiKV E{KB, VB, SS};
        pg8::gemm_phase<pg8::EpiKV, pg8::StaticOrder, true, true>(F.lds + RING_OFF, g, S, E);
    }
    }
#endif
    SEAM(2);

#if !defined(SKIP_P3)
    if (IN(3))
    {
        LAS char* al = (LAS char*)(F.lds + RING_OFF);
#if !defined(SKIP_MOBA) && !(defined(DBG_NAIVE_ATTN) && (DBG_NAIVE_ATTN & 1))
        for (int bh = F.vcu; bh < NB * NHEAD; bh += F.G) {
            const int b = bh >> 3, h = bh & 7; const size_t r0 = (size_t)b * SEQ;
            att::kmean_blocks(KA + r0 * AW + h * HD, al);
#pragma unroll 1
            for (int qb = 0; qb < 8; ++qb)
                att::attn_unit<64, true>(QA + (r0 + qb * 256) * AW + h * HD, AW, KA + r0 * AW + h * HD, nullptr, VA + r0 * AW + h * HD, H + (r0 + qb * 256) * DM + h * HD, DM, qb, al);
        }
#endif
#if !defined(SKIP_MLA) && !(defined(DBG_NAIVE_ATTN) && (DBG_NAIVE_ATTN & 2))
        for (int bh = F.vcu; bh < NB * NHEAD; bh += F.G) {
            const int b = bh >> 3, h = bh & 7; const size_t r0 = (size_t)b * SEQ;
#pragma unroll 1
            for (int qb = 0; qb < 8; ++qb)
                att::attn_unit<96, false>(QB + (r0 + qb * 256) * (NHEAD * QKB) + h * QKB, NHEAD * QKB, KB + r0 * AW + h * HD, KR + r0 * RDIM, VB + r0 * AW + h * HD, H + (r0 + qb * 256) * DM + AW + h * HD, DM, qb, al);
        }
#endif
    }
#endif
    SEAM(3);

#if !defined(SKIP_P4)
    if (IN(4))
    {
        pg8::Gemm g{H, WA, MTOK, DM, DM}; pg8::StaticOrder S; S.init(MTOK, DM, F.G, (int)blockIdx.x);
        pg8::EpiMerge E{Gt, T};
        pg8::gemm_phase<pg8::EpiMerge, pg8::StaticOrder, true, true>(F.lds + RING_OFF, g, S, E);
    }
#endif
    SEAM(4);

#if !defined(SKIP_P5)
    if (IN(5))
    {
        pg8::Gemm g{T, WOUT, MTOK, DM, DM}; pg8::StaticOrder S; S.init(MTOK, DM, F.G, (int)blockIdx.x);
        pg8::EpiSS E{Y, SS2};
        pg8::gemm_phase<pg8::EpiSS, pg8::StaticOrder, true, true>(F.lds + RING_OFF, g, S, E);
    }
#endif
    SEAM(5);

#if !defined(SKIP_P6)
    if (IN(6))
    {
        f32x4 g1[4], g2[4];
#pragma unroll
        for (int j = 0; j < 4; ++j) { g1[j] = ((const GAS f32x4*)g_post_mix)[F.lane + 64 * j]; g2[j] = ((const GAS f32x4*)g_pre_mlp)[F.lane + 64 * j]; }
        for (int m = gw; m < MTOK; m += NGW) {
            const GAS f32x4* sp = (const GAS f32x4*)(SS2 + (size_t)m * 16); const f32x4 a = sp[0], b = sp[1], c = sp[2], d = sp[3];
            const float ssy = (((a.x + a.y) + (a.z + a.w)) + ((b.x + b.y) + (b.z + b.w))) + (((c.x + c.y) + (c.z + c.w)) + ((d.x + d.y) + (d.z + d.w)));
            const float rsy = 1.f / sqrtf(ssy * (1.f / DM) + EPS);
            const GAS f32x4* xr = (const GAS f32x4*)(x + (size_t)m * DM) + F.lane; const GAS unsigned long long* yr = (const GAS unsigned long long*)(Y + (size_t)m * DM) + F.lane;
            GAS unsigned long long* x8 = (GAS unsigned long long*)(X1B + (size_t)m * DM) + F.lane;
            f32x4 v[4]; float s = 0.f;
#pragma unroll
            for (int j = 0; j < 4; ++j) { const unsigned long long yw = yr[64 * j]; const unsigned lo = (unsigned)yw, hi = (unsigned)(yw >> 32);
                const f32x4 yv = (f32x4){__uint_as_float(lo << 16), __uint_as_float(lo & 0xffff0000u), __uint_as_float(hi << 16), __uint_as_float(hi & 0xffff0000u)};
                v[j] = xr[64 * j] + yv * rsy * g1[j]; x8[64 * j] = (unsigned long long)pk2(v[j].x, v[j].y) | ((unsigned long long)pk2(v[j].z, v[j].w) << 32);
                s += (v[j].x * v[j].x + v[j].y * v[j].y) + (v[j].z * v[j].z + v[j].w * v[j].w); }
            const float rstd = 1.f / sqrtf(wave_sum(s) * (1.f / DM) + EPS);
            GAS unsigned long long* o8 = (GAS unsigned long long*)(H + (size_t)m * DM) + F.lane;
#pragma unroll
            for (int j = 0; j < 4; ++j) { const f32x4 y2 = v[j] * rstd * g2[j]; o8[64 * j] = (unsigned long long)pk2(y2.x, y2.y) | ((unsigned long long)pk2(y2.z, y2.w) << 32); }
        }
    }
#endif
    SEAM(6);

#if !defined(SKIP_P7)
    if (IN(7))
    {
        pg8::Gemm g{H, WUP, MTOK, DFF, DM}; pg8::StaticOrder S; S.init(MTOK, DFF, F.G, (int)blockIdx.x);
        pg8::EpiRelu2 E{U};
        pg8::gemm_phase<pg8::EpiRelu2, pg8::StaticOrder, true, true>(F.lds + RING_OFF, g, S, E);
    }
#endif
    SEAM(7);

#if !defined(SKIP_P8)
    if (IN(8))
    {
        pg8::Gemm g{U, WDN, MTOK, DM, DFF}; pg8::StaticOrder S; S.init(MTOK, DM, F.G, (int)blockIdx.x);
        pg8::EpiSS E{H, SS3};
        pg8::gemm_phase<pg8::EpiSS, pg8::StaticOrder, true, true>(F.lds + RING_OFF, g, S, E);
    }
#endif
    SEAM(8);

#if !defined(SKIP_P9)
    if (IN(9))
    {
        f32x4 g1[4];
#pragma unroll
        for (int j = 0; j < 4; ++j) g1[j] = ((const GAS f32x4*)g_post_mlp)[F.lane + 64 * j];
        for (int m = gw; m < MTOK; m += NGW) {
            const GAS f32x4* sp = (const GAS f32x4*)(SS3 + (size_t)m * 16); const f32x4 a = sp[0], b = sp[1], c = sp[2], d = sp[3];
            const float ssy = (((a.x + a.y) + (a.z + a.w)) + ((b.x + b.y) + (b.z + b.w))) + (((c.x + c.y) + (c.z + c.w)) + ((d.x + d.y) + (d.z + d.w)));
            const float rsy = 1.f / sqrtf(ssy * (1.f / DM) + EPS);
            const GAS unsigned long long* yr = (const GAS unsigned long long*)(H + (size_t)m * DM) + F.lane;
            const GAS unsigned long long* xq = (const GAS unsigned long long*)(X1B + (size_t)m * DM) + F.lane;
            GAS f32x4* o4 = (GAS f32x4*)(out + (size_t)m * DM) + F.lane;
#pragma unroll
            for (int j = 0; j < 4; ++j) { const unsigned long long yw = yr[64 * j]; const unsigned lo = (unsigned)yw, hi = (unsigned)(yw >> 32);
                const f32x4 yv = (f32x4){__uint_as_float(lo << 16), __uint_as_float(lo & 0xffff0000u), __uint_as_float(hi << 16), __uint_as_float(hi & 0xffff0000u)};
                const unsigned long long xw = xq[64 * j]; const unsigned xl = (unsigned)xw, xh = (unsigned)(xw >> 32);
                const f32x4 xv = (f32x4){__uint_as_float(xl << 16), __uint_as_float(xl & 0xffff0000u), __uint_as_float(xh << 16), __uint_as_float(xh & 0xffff0000u)};
                o4[64 * j] = xv + yv * rsy * g1[j]; }
        }
    }
#endif
}

extern "C" void kernel_launch(void* const* d_in, const int* in_sizes, int n_in, void* d_out, int out_size, void* d_ws, size_t ws_size, hipStream_t stream) {
    static int grid = 0;
    if (grid == 0) {
        if (n_in != 17 || in_sizes[0] != MTOK * DM || out_size != MTOK * DM || ws_size < WS_END) { fprintf(stderr, "kernel_launch: unexpected shapes (n_in %d, in0 %d, out %d, ws %zu); nothing launched\n", n_in, n_in > 0 ? in_sizes[0] : -1, out_size, ws_size); grid = -1; return; }
        int dev = 0, cus = 0, per_cu = 0;
        if (hipGetDevice(&dev) != hipSuccess || hipDeviceGetAttribute(&cus, hipDeviceAttributeMultiprocessorCount, dev) != hipSuccess) { fprintf(stderr, "kernel_launch: device query failed\n"); grid = -1; return; }
        if (hipFuncSetAttribute((const void*)block_fwd, hipFuncAttributeMaxDynamicSharedMemorySize, LDS_BYTES) != hipSuccess) { fprintf(stderr, "kernel_launch: hipFuncSetAttribute failed\n"); grid = -1; return; }
        if (hipOccupancyMaxActiveBlocksPerMultiprocessor(&per_cu, (const void*)block_fwd, NWAVES * 64, LDS_BYTES) != hipSuccess || per_cu < 1) { fprintf(stderr, "kernel_launch: occupancy query reports %d workgroups per CU\n", per_cu); }
        (void)hipGetLastError();
        grid = cus;
    }
    if (grid < 0) return;
    if (hipMemsetAsync((char*)d_ws + WS_CTL, 0, CTL_ZERO_BYTES, stream) != hipSuccess) { fprintf(stderr, "kernel_launch: hipMemsetAsync failed\n"); return; }
    Args a{};
    for (int i = 0; i < 17; ++i) a.in[i] = (const float*)d_in[i];
    a.out = (float*)d_out; a.ws = (unsigned char*)d_ws;
#if defined(DBG_CHECK)
    {
        unsigned char* ws = (unsigned char*)d_ws; unsigned* cnt = (unsigned*)(ws + WS_CTL + 32768); float* expv = (float*)(ws + 60 * MiB); float* KM = (float*)(ws + 61 * MiB);
        const float* const* in = (const float* const*)a.in; const int* pos = (const int*)in[1];
        bf16 *H = (bf16*)(ws + WS_H), *Gt = (bf16*)(ws + WS_G), *QA = (bf16*)(ws + WS_QA), *KA = (bf16*)(ws + WS_KA), *VA = (bf16*)(ws + WS_VA), *T = (bf16*)(ws + WS_T), *CQ = (bf16*)(ws + WS_CQ), *CKV = (bf16*)(ws + WS_CKV),
             *OB = (bf16*)(ws + WS_OB), *KR = (bf16*)(ws + WS_KR), *QB = (bf16*)(ws + WS_QB), *KB = (bf16*)(ws + WS_KB), *VB = (bf16*)(ws + WS_VB), *Y = (bf16*)(ws + WS_Y), *U = (bf16*)(ws + WS_U);
        bf16 *NA = (bf16*)(ws + WS_H), *NBo = (bf16*)(ws + WS_H + 64 * MiB);
        auto L = [&](int lo, int hi) { a.ph_lo = lo; a.ph_hi = hi; a.li = 0; hipLaunchKernelGGL(block_fwd, dim3(grid), dim3(NWAVES * 64), LDS_BYTES, stream, a); };
        const dim3 cg(chk::NS / 256), cb(256);
        L(0, 1); hipLaunchKernelGGL(chk::k_c0, cg, cb, 0, stream, in[0], in[2], (const bf16*)H, cnt);
        L(1, 2); hipLaunchKernelGGL(chk::k_c1, cg, cb, 0, stream, (const bf16*)H, in[3], in[4], pos, (const bf16*)QA, (const bf16*)KA, (const bf16*)VA, (const bf16*)CQ, (const bf16*)CKV, (const bf16*)KR, (const bf16*)Gt, cnt);
        L(2, 3); hipLaunchKernelGGL(chk::k_c2, cg, cb, 0, stream, (const bf16*)CQ, (const bf16*)CKV, in[5], in[6], in[7], in[8], pos, (const bf16*)QB, (const bf16*)KB, (const bf16*)VB, cnt);
        hipLaunchKernelGGL(dbg::kmean_k, dim3(256), dim3(512), 0, stream, (const bf16*)KA, KM);
        hipLaunchKernelGGL((dbg::attn_k<64, true>), dim3(32, 256), dim3(256), 0, stream, (const bf16*)QA, (const bf16*)KA, (const bf16*)nullptr, (const bf16*)VA, NA, (const float*)KM);
        hipLaunchKernelGGL((dbg::attn_k<96, false>), dim3(32, 256), dim3(256), 0, stream, (const bf16*)QB, (const bf16*)KB, (const bf16*)KR, (const bf16*)VB, NBo, (const float*)KM);
        L(3, 4); hipLaunchKernelGGL(chk::k_cmp, cg, cb, 0, stream, (const bf16*)QA, (const bf16*)NA, 15, cnt); hipLaunchKernelGGL(chk::k_cmp, cg, cb, 0, stream, (const bf16*)OB, (const bf16*)NBo, 16, cnt);
        L(4, 5); hipLaunchKernelGGL(chk::k_c4, cg, cb, 0, stream, (const bf16*)QA, (const bf16*)OB, (const bf16*)Gt, in[9], in[10], (const bf16*)T, cnt);
        L(5, 6); hipLaunchKernelGGL(chk::k_c5, cg, cb, 0, stream, (const bf16*)T, in[11], (const bf16*)Y, cnt);
        L(6, 7); hipLaunchKernelGGL(chk::k_c6, cg, cb, 0, stream, (const bf16*)Y, in[0], in[12], in[13], (const float*)d_out, (const bf16*)H, cnt);
        L(7, 8); hipLaunchKernelGGL(chk::k_c7, cg, cb, 0, stream, (const bf16*)H, in[14], (const bf16*)U, cnt);
        L(8, 9); hipLaunchKernelGGL(chk::k_c8, cg, cb, 0, stream, (const bf16*)U, in[15], (const bf16*)H, cnt);
        hipLaunchKernelGGL(chk::k_c9a, cg, cb, 0, stream, (const bf16*)H, (const float*)d_out, in[16], expv);
        L(9, 10); hipLaunchKernelGGL(chk::k_c9b, cg, cb, 0, stream, (const float*)d_out, (const float*)expv, cnt);
        hipLaunchKernelGGL(chk::k_fin, dim3(1024), dim3(256), 0, stream, (const unsigned*)cnt, (float*)d_out);
    }
#elif defined(DBG_NAIVE_ATTN)
    a.ph_lo = 0; a.ph_hi = (DBG_NAIVE_ATTN == 3) ? 3 : 4; a.li = 0;
    hipLaunchKernelGGL(block_fwd, dim3(grid), dim3(NWAVES * 64), LDS_BYTES, stream, a);
    { unsigned char* ws = (unsigned char*)d_ws; float* KM = (float*)(ws + WS_SS3);
      if (DBG_NAIVE_ATTN & 1) { hipLaunchKernelGGL(dbg::kmean_k, dim3(256), dim3(512), 0, stream, (const bf16*)(ws + WS_KA), KM);
          hipLaunchKernelGGL((dbg::attn_k<64, true>), dim3(32, 256), dim3(256), 0, stream, (const bf16*)(ws + WS_QA), (const bf16*)(ws + WS_KA), (const bf16*)nullptr, (const bf16*)(ws + WS_VA), (bf16*)(ws + WS_QA), (const float*)KM); }
      if (DBG_NAIVE_ATTN & 2) hipLaunchKernelGGL((dbg::attn_k<96, false>), dim3(32, 256), dim3(256), 0, stream, (const bf16*)(ws + WS_QB), (const bf16*)(ws + WS_KB), (const bf16*)(ws + WS_KR), (const bf16*)(ws + WS_VB), (bf16*)(ws + WS_OB), (const float*)KM); }
    a.ph_lo = 4; a.ph_hi = 10; a.li = 1;
    hipLaunchKernelGGL(block_fwd, dim3(grid), dim3(NWAVES * 64), LDS_BYTES, stream, a);
#else
    a.ph_lo = 0; a.ph_hi = 10; a.li = 0;
    hipLaunchKernelGGL(block_fwd, dim3(grid), dim3(NWAVES * 64), LDS_BYTES, stream, a);
#endif
    const hipError_t le = hipPeekAtLastError();
    if (le != hipSuccess) fprintf(stderr, "kernel_launch: launch failed: %s\n", hipGetErrorName(le));
}
```

```cpp
#include <hip/hip_runtime.h>
#include <hip/hip_bf16.h>
#include <cstdio>
#include <cstdint>
#include <cmath>
constexpr int NB = 32, SEQ = 2048, DM = 1024, MTOK = NB * SEQ;
constexpr int NHEAD = 8, HD = 64, AW = NHEAD * HD;
constexpr int QLORA = 384, KVLORA = 256, RDIM = 32, QKB = 96;
constexpr int DFF = 4096, INW = 4256, INWP = 4352;
constexpr float EPS = 1e-6f;
constexpr float LOG2E = 1.4426950408889634f;
constexpr float C2A = 0.125f * LOG2E;
constexpr float C2B = 0.10206207261596575f * LOG2E;
typedef float f32x2g __attribute__((ext_vector_type(2)));
namespace pg8 {
#define PG8_LAS __attribute__((address_space(3)))
typedef unsigned short bf16_t;
typedef short bf16x8 __attribute__((ext_vector_type(8)));
typedef float f32x4 __attribute__((ext_vector_type(4)));
typedef unsigned u32x4 __attribute__((ext_vector_type(4)));
constexpr int BM = 256, BK = 64, HALF = 128, HTB = HALF * BK * 2  , STAGE_BYTES = 8 * HTB, NXCD = 8, WGM = 8;

__host__ __device__ __forceinline__ int lds_byte(int r, int c) { const int st = (r >> 4) * 2 + (c >> 5), rr = r & 15, cc = c & 31, ob = rr * 64 + cc * 2; return st * 1024 + (ob ^ (((ob >> 9) & 1) << 5)); }
__host__ __device__ __forceinline__ void stage_rc(int b, int& R, int& C) { const int st = b / 1024, sb = b % 1024, swz = sb ^ (((sb >> 9) & 1) << 5); R = (st >> 1) * 16 + swz / 64; C = (st & 1) * 32 + (swz % 64) / 2; }
__host__ __device__ __forceinline__ int perm32(int rho) { const int n = rho >> 4, i = rho & 15; return 8 * (i >> 2) + 4 * n + (i & 3); }

struct Unit { int pm, pn; };
struct Gemm { const bf16_t* A; const bf16_t* Bt; int M, N, K, lda, ldb; };

struct StaticOrder {
    int nM, nN, nwg, G, c;
    __host__ __device__ void init(int M, int N, int G_, int c_) { nM = M / BM; nN = N / BM; nwg = nM * nN; G = G_; c = c_; }
    __host__ __device__ bool next(int i, Unit& u) const {
        const long L = (long)i * G + c; if (L >= nwg) return false;
        int wgid = (int)L; { const int q = nwg / NXCD, r = nwg % NXCD, xcd = wgid % NXCD, off = wgid / NXCD; wgid = (xcd < r ? xcd * (q + 1) : r * (q + 1) + (xcd - r) * q) + off; }
        const int nig = WGM * nN, gid = wgid / nig, fm = gid * WGM, gsz = (nM - fm) < WGM ? (nM - fm) : WGM;
        u.pm = fm + ((wgid % nig) % gsz); u.pn = (wgid % nig) / gsz; return true;
    }
    __device__ __forceinline__ void a_ready(const Unit&) const {}
    __device__ __forceinline__ void done(const Unit&) const {}
};

__device__ __forceinline__ unsigned cvt_pk_bf16(float lo, float hi) { unsigned r; asm volatile("v_cvt_pk_bf16_f32 %0, %1, %2" : "=v"(r) : "v"(lo), "v"(hi)); return r; }
__device__ __forceinline__ void ld8(float (&v)[8], const f32x4& a, const f32x4& b) { v[0] = a[0]; v[1] = a[1]; v[2] = a[2]; v[3] = a[3]; v[4] = b[0]; v[5] = b[1]; v[6] = b[2]; v[7] = b[3]; }
typedef float f32x2c_t __attribute__((ext_vector_type(2))); typedef __bf16 bf16x2c_t __attribute__((ext_vector_type(2)));
__device__ __forceinline__ unsigned cvtpk_c(float lo, float hi) { const f32x2c_t v = {lo, hi}; const bf16x2c_t b = __builtin_convertvector(v, bf16x2c_t); return __builtin_bit_cast(unsigned, b); }
__device__ __forceinline__ u32x4 pack8(const float (&v)[8]) { u32x4 w; w.x = cvtpk_c(v[0], v[1]); w.y = cvtpk_c(v[2], v[3]); w.z = cvtpk_c(v[4], v[5]); w.w = cvtpk_c(v[6], v[7]); return w; }
__device__ __forceinline__ void unpack8(const u32x4 w, float (&v)[8]) {
    v[0] = __uint_as_float(w.x << 16); v[1] = __uint_as_float(w.x & 0xffff0000u); v[2] = __uint_as_float(w.y << 16); v[3] = __uint_as_float(w.y & 0xffff0000u);
    v[4] = __uint_as_float(w.z << 16); v[5] = __uint_as_float(w.z & 0xffff0000u); v[6] = __uint_as_float(w.w << 16); v[7] = __uint_as_float(w.w & 0xffff0000u); }
__device__ __forceinline__ void rope4(float (&v)[8], const f32x4 a, const f32x4 b) {
    float x1, x2;
    x1 = v[0]; x2 = v[1]; v[0] = x1 * a[0] - x2 * a[1]; v[1] = x2 * a[0] + x1 * a[1];
    x1 = v[2]; x2 = v[3]; v[2] = x1 * a[2] - x2 * a[3]; v[3] = x2 * a[2] + x1 * a[3];
    x1 = v[4]; x2 = v[5]; v[4] = x1 * b[0] - x2 * b[1]; v[5] = x2 * b[0] + x1 * b[1];
    x1 = v[6]; x2 = v[7]; v[6] = x1 * b[2] - x2 * b[3]; v[7] = x2 * b[2] + x1 * b[3];
}
__device__ __forceinline__ float sumsq8(const float (&v)[8]) { return ((v[0] * v[0] + v[1] * v[1]) + (v[2] * v[2] + v[3] * v[3])) + ((v[4] * v[4] + v[5] * v[5]) + (v[6] * v[6] + v[7] * v[7])); }
__device__ __forceinline__ float red_fq(float s) { s += __shfl_xor(s, 16); s += __shfl_xor(s, 32); return s; }

__device__ __forceinline__ size_t gfrag_off(int pm, int t8, int wid, int grp, int lane) { return ((((size_t)(pm * 8 + t8) * 8 + wid) * 16 + grp) * 64 + lane) * 8; }
struct EpiIn {
    static constexpr bool PERM = true, AFTER_DRAIN = false; static constexpr int MIDT = 0;
    bf16_t *QA, *KA, *VA, *CQ, *CKV, *KR, *G; float* SS; const float* ropeA; const float* ropeB; const float* bgate;
    __device__ __forceinline__ void operator()(const f32x4 (&acc)[2][2][4][2], const Unit& u, int wr, int wc, int fr, int fq) const {
        asm volatile("" : "+v"(fr), "+v"(fq));
        const int row0 = u.pm * BM + wr * 64 + fr, pn = u.pn, cl = wc * 32 + 8 * fq;
        if (pn < 4) {
            bf16_t* dst = (pn < 2) ? QA : KA; const float sc = (pn < 2) ? C2A : 1.f; const int cb = (pn & 1) * 256 + cl;
            if ((wc & 1) == 0) {
                const bool rp = fq < 2;
#pragma unroll
                for (int ai = 0; ai < 2; ++ai)
#pragma unroll
                    for (int m = 0; m < 4; ++m) { const int row = row0 + ai * HALF + m * 16;
                        const f32x4* t = (const f32x4*)(ropeA + (size_t)row * 16 + (rp ? fq * 8 : 0));
                        f32x4 ca = t[0], cc = t[1]; if (!rp) { ca = (f32x4){1.f, 0.f, 1.f, 0.f}; cc = ca; }
#pragma unroll
                        for (int bj = 0; bj < 2; ++bj) { float v[8]; ld8(v, acc[ai][bj][m][0], acc[ai][bj][m][1]); rope4(v, ca, cc);
#pragma unroll
                            for (int j = 0; j < 8; ++j) v[j] *= sc;
                            *(u32x4*)(dst + (size_t)row * AW + cb + bj * HALF) = pack8(v); } }
            } else {
#pragma unroll
                for (int ai = 0; ai < 2; ++ai)
#pragma unroll
                    for (int m = 0; m < 4; ++m) { const int row = row0 + ai * HALF + m * 16;
#pragma unroll
                        for (int bj = 0; bj < 2; ++bj) { float v[8]; ld8(v, acc[ai][bj][m][0], acc[ai][bj][m][1]);
#pragma unroll
                            for (int j = 0; j < 8; ++j) v[j] *= sc;
                            *(u32x4*)(dst + (size_t)row * AW + cb + bj * HALF) = pack8(v); } }
            }
        } else if (pn < 6) {
            const int cb = (pn - 4) * 256 + cl;
#pragma unroll
            for (int ai = 0; ai < 2; ++ai)
#pragma unroll
                for (int m = 0; m < 4; ++m) { const int row = row0 + ai * HALF + m * 16;
#pragma unroll
                    for (int bj = 0; bj < 2; ++bj) { float v[8]; ld8(v, acc[ai][bj][m][0], acc[ai][bj][m][1]); *(u32x4*)(VA + (size_t)row * AW + cb + bj * HALF) = pack8(v); } }
        } else if (pn == 6 || pn == 8) {
            bf16_t* dst = (pn == 6) ? CQ : CKV; const int ld = (pn == 6) ? QLORA : KVLORA, slot = ((pn == 6) ? 0 : 8) + wc;
#pragma unroll
            for (int ai = 0; ai < 2; ++ai)
#pragma unroll
                for (int m = 0; m < 4; ++m) { const int row = row0 + ai * HALF + m * 16; float s = 0.f;
#pragma unroll
                    for (int bj = 0; bj < 2; ++bj) { float v[8]; ld8(v, acc[ai][bj][m][0], acc[ai][bj][m][1]); s += sumsq8(v); *(u32x4*)(dst + (size_t)row * ld + cl + bj * HALF) = pack8(v); }
                    s = red_fq(s); if (fq == 0) SS[(size_t)row * 12 + slot] = s; }
        } else if (pn == 7) {
#pragma unroll
            for (int ai = 0; ai < 2; ++ai)
#pragma unroll
                for (int m = 0; m < 4; ++m) { const int row = row0 + ai * HALF + m * 16;
                    { float v[8]; ld8(v, acc[ai][0][m][0], acc[ai][0][m][1]); float s = red_fq(sumsq8(v)); *(u32x4*)(CQ + (size_t)row * QLORA + 256 + cl) = pack8(v); if (fq == 0) SS[(size_t)row * 12 + 4 + wc] = s; }
                    if (wc == 0) { float v[8]; ld8(v, acc[ai][1][m][0], acc[ai][1][m][1]); const f32x4* t = (const f32x4*)(ropeB + (size_t)row * 32 + fq * 8); rope4(v, t[0], t[1]);
                        *(u32x4*)(KR + (size_t)row * RDIM + 8 * fq) = pack8(v); } }
        } else {
            const int gc = (pn - 9) * 256 + cl;
            f32x4 bv[2][2];
#pragma unroll
            for (int bj = 0; bj < 2; ++bj)
#pragma unroll
                for (int n = 0; n < 2; ++n) bv[bj][n] = *(const f32x4*)(bgate + gc + bj * HALF + 4 * n);
#pragma unroll
            for (int ai = 0; ai < 2; ++ai)
#pragma unroll
                for (int m = 0; m < 4; ++m) { const int row = row0 + ai * HALF + m * 16;
#pragma unroll
                    for (int bj = 0; bj < 2; ++bj) { float v[8]; ld8(v, acc[ai][bj][m][0] + bv[bj][0], acc[ai][bj][m][1] + bv[bj][1]);
#pragma unroll
                        for (int j = 0; j < 8; ++j) v[j] = __builtin_amdgcn_rcpf(1.f + __builtin_amdgcn_exp2f(-LOG2E * v[j]));
                        *(u32x4*)(G + gfrag_off(u.pm, pn - 9, wr * 4 + wc, ai * 8 + m * 2 + bj, fq * 16 + fr)) = pack8(v); } }
        }
    }
};
struct EpiQ {
    static constexpr bool PERM = true, AFTER_DRAIN = false; static constexpr int MIDT = 0;
    bf16_t* QB; const float* SS; const float* ropeB;
    __device__ __forceinline__ void operator()(const f32x4 (&acc)[2][2][4][2], const Unit& u, int wr, int wc, int fr, int fq) const {
        asm volatile("" : "+v"(fr), "+v"(fq));
        const int row0 = u.pm * BM + wr * 64 + fr, cl = u.pn * BM + wc * 32 + 8 * fq;
#pragma unroll
        for (int ai = 0; ai < 2; ++ai)
#pragma unroll
            for (int m = 0; m < 4; ++m) { const int row = row0 + ai * HALF + m * 16;
                const f32x4* sp = (const f32x4*)(SS + (size_t)row * 12); const f32x4 s0 = sp[0], s1 = sp[1];
                const float ss = ((s0[0] + s0[1]) + (s0[2] + s0[3])) + ((s1[0] + s1[1]) + (s1[2] + s1[3]));
                const float rs = __builtin_amdgcn_rsqf(ss * (1.0f / QLORA) + EPS) * C2B;
#pragma unroll
                for (int bj = 0; bj < 2; ++bj) { const int c = cl + bj * HALF, hd = c / QKB, p = c - hd * QKB;
                    float v[8]; ld8(v, acc[ai][bj][m][0], acc[ai][bj][m][1]);
#pragma unroll
                    for (int j = 0; j < 8; ++j) v[j] *= rs;
                    if (p >= 64) { const f32x4* t = (const f32x4*)(ropeB + (size_t)row * 32 + (p - 64)); rope4(v, t[0], t[1]); }
                    *(u32x4*)(QB + (size_t)row * (NHEAD * QKB) + c) = pack8(v); }
                asm volatile("" ::: "memory"); }
    }
};
struct EpiKV {
    static constexpr bool PERM = true, AFTER_DRAIN = false; static constexpr int MIDT = 0;
    bf16_t *KB, *VB; const float* SS;
    __device__ __forceinline__ void operator()(const f32x4 (&acc)[2][2][4][2], const Unit& u, int wr, int wc, int fr, int fq) const {
        asm volatile("" : "+v"(fr), "+v"(fq));
        const int row0 = u.pm * BM + wr * 64 + fr;
        bf16_t* dst = (wc < 2) ? KB : VB; const int pc = (wc & 1) * 32 + 8 * fq;
#pragma unroll
        for (int ai = 0; ai < 2; ++ai)
#pragma unroll
            for (int m = 0; m < 4; ++m) { const int row = row0 + ai * HALF + m * 16;
                const f32x4 s0 = *(const f32x4*)(SS + (size_t)row * 12 + 8);
                const float rs = __builtin_amdgcn_rsqf(((s0[0] + s0[1]) + (s0[2] + s0[3])) * (1.0f / KVLORA) + EPS);
#pragma unroll
                for (int bj = 0; bj < 2; ++bj) { const int hd = u.pn * 2 + bj;
                    float v[8]; ld8(v, acc[ai][bj][m][0], acc[ai][bj][m][1]);
#pragma unroll
                    for (int j = 0; j < 8; ++j) v[j] *= rs;
                    *(u32x4*)(dst + (size_t)row * AW + hd * HD + pc) = pack8(v); }
                asm volatile("" ::: "memory"); }
    }
};
struct EpiMerge {
    static constexpr bool PERM = true, AFTER_DRAIN = false; static constexpr int MIDT = 8;
    const bf16_t* G; bf16_t* T;
    __device__ __forceinline__ void mid(f32x4 (&acc)[2][2][4][2], const Unit& u, int wr, int wc, int fr, int fq) const {
        asm volatile("" : "+v"(fr), "+v"(fq));
        const bf16_t* pa = G + gfrag_off(u.pm, u.pn, wr * 4 + wc, 0, fq * 16 + fr); const bf16_t* pb = G + gfrag_off(u.pm, 4 + u.pn, wr * 4 + wc, 0, fq * 16 + fr);
        u32x4 ca[4], cb[4], na[4], nb[4];
#pragma unroll
        for (int i = 0; i < 4; ++i) { ca[i] = *(const u32x4*)(pa + (size_t)i * 512); cb[i] = *(const u32x4*)(pb + (size_t)i * 512); }
#pragma unroll
        for (int b = 0; b < 4; ++b) {
            if (b < 3) {
#pragma unroll
                for (int i = 0; i < 4; ++i) { na[i] = *(const u32x4*)(pa + (size_t)((b + 1) * 4 + i) * 512); nb[i] = *(const u32x4*)(pb + (size_t)((b + 1) * 4 + i) * 512); } }
            asm volatile("" ::: "memory");
#pragma unroll
            for (int i = 0; i < 4; ++i) { const int grp = b * 4 + i, ai = grp >> 3, m = (grp >> 1) & 3, bj = grp & 1; float ga[8], gb[8]; unpack8(ca[i], ga); unpack8(cb[i], gb);
#pragma unroll
                for (int j = 0; j < 8; ++j) ga[j] *= __builtin_amdgcn_rcpf(__builtin_fmaxf(gb[j], 1e-30f));
                acc[ai][bj][m][0] *= (f32x4){ga[0], ga[1], ga[2], ga[3]}; acc[ai][bj][m][1] *= (f32x4){ga[4], ga[5], ga[6], ga[7]}; }
#pragma unroll
            for (int i = 0; i < 4; ++i) { ca[i] = na[i]; cb[i] = nb[i]; }
        }
    }
    __device__ __forceinline__ void operator()(const f32x4 (&acc)[2][2][4][2], const Unit& u, int wr, int wc, int fr, int fq) const {
        asm volatile("" : "+v"(fr), "+v"(fq));
        const int row0 = u.pm * BM + wr * 64 + fr, cl = u.pn * BM + wc * 32 + 8 * fq;
        const bf16_t* pb = G + gfrag_off(u.pm, 4 + u.pn, wr * 4 + wc, 0, fq * 16 + fr);
        u32x4 cb[8], nb[8];
#pragma unroll
        for (int i = 0; i < 8; ++i) cb[i] = *(const u32x4*)(pb + (size_t)i * 512);
#pragma unroll
        for (int b = 0; b < 2; ++b) {
            if (b < 1) {
#pragma unroll
                for (int i = 0; i < 8; ++i) nb[i] = *(const u32x4*)(pb + (size_t)(8 + i) * 512); }
            asm volatile("" ::: "memory");
#pragma unroll
            for (int i = 0; i < 8; ++i) { const int grp = b * 8 + i, ai = grp >> 3, m = (grp >> 1) & 3, bj = grp & 1; float v[8], gb[8]; ld8(v, acc[ai][bj][m][0], acc[ai][bj][m][1]); unpack8(cb[i], gb);
#pragma unroll
                for (int j = 0; j < 8; ++j) v[j] *= __builtin_fmaxf(gb[j], 1e-30f);
                *(u32x4*)(T + (size_t)(row0 + ai * HALF + m * 16) * DM + cl + bj * HALF) = pack8(v); }
#pragma unroll
            for (int i = 0; i < 8; ++i) cb[i] = nb[i];
        }
    }
};
struct EpiSS {
    static constexpr bool PERM = true, AFTER_DRAIN = false; static constexpr int MIDT = 0;
    bf16_t* Y; float* SSY;
    __device__ __forceinline__ void operator()(const f32x4 (&acc)[2][2][4][2], const Unit& u, int wr, int wc, int fr, int fq) const {
        asm volatile("" : "+v"(fr), "+v"(fq));
        const int row0 = u.pm * BM + wr * 64 + fr, cl = u.pn * BM + wc * 32 + 8 * fq;
#pragma unroll
        for (int ai = 0; ai < 2; ++ai)
#pragma unroll
            for (int m = 0; m < 4; ++m) { const int row = row0 + ai * HALF + m * 16; float s = 0.f;
#pragma unroll
                for (int bj = 0; bj < 2; ++bj) { float v[8]; ld8(v, acc[ai][bj][m][0], acc[ai][bj][m][1]); s += sumsq8(v); *(u32x4*)(Y + (size_t)row * DM + cl + bj * HALF) = pack8(v); }
                s = red_fq(s); if (fq == 0) SSY[(size_t)row * 16 + u.pn * 4 + wc] = s; }
    }
};
struct EpiRelu2 {
    static constexpr bool PERM = true, AFTER_DRAIN = false; static constexpr int MIDT = 0;
    bf16_t* U;
    __device__ __forceinline__ void operator()(const f32x4 (&acc)[2][2][4][2], const Unit& u, int wr, int wc, int fr, int fq) const {
        asm volatile("" : "+v"(fr), "+v"(fq));
        const int row0 = u.pm * BM + wr * 64 + fr, cl = u.pn * BM + wc * 32 + 8 * fq;
#pragma unroll
        for (int ai = 0; ai < 2; ++ai)
#pragma unroll
            for (int m = 0; m < 4; ++m) { const int row = row0 + ai * HALF + m * 16;
#pragma unroll
                for (int bj = 0; bj < 2; ++bj) { float v[8]; ld8(v, acc[ai][bj][m][0], acc[ai][bj][m][1]);
#pragma unroll
                    for (int j = 0; j < 8; ++j) { const float r = __builtin_fmaxf(v[j], 0.f); v[j] = r * r; }
                    *(u32x4*)(U + (size_t)row * DFF + cl + bj * HALF) = pack8(v); } }
    }
};
template <class Epi, class Sched, bool ALIGN_EPI = false, bool SP2 = false>
__device__ __forceinline__ void gemm_phase(PG8_LAS unsigned char* lds, const Gemm g, const Sched& S, const Epi& E) {
    int tid_ = threadIdx.x; asm volatile("" : "+v"(tid_));
    const int tid = tid_, wid = __builtin_amdgcn_readfirstlane(tid >> 6), lane = tid & 63, wr = wid >> 2, wc = wid & 3, fr = lane & 15, fq = lane >> 4;
    const int K = g.K, nt = K / BK, lda = g.lda ? g.lda : K, ldb = g.ldb ? g.ldb : K;
    unsigned voffA[2], voffB[2];
#pragma unroll
    for (int i = 0; i < 2; ++i) { int R, C; stage_rc(tid * 16 + i * 8192, R, C); const int Rb = Epi::PERM ? ((R & ~31) + perm32(R & 31)) : R;
        voffA[i] = (unsigned)(R * lda + C) * 2u; voffB[i] = (unsigned)(Rb * ldb + C) * 2u; }
    const size_t kstep = (size_t)(BK * 2);
    const size_t hstepA = (size_t)HALF * lda * 2, hstepB = (size_t)HALF * ldb * 2;
    const size_t tstepA = 2 * hstepA, tstepB = 2 * hstepB;
    const unsigned ldsw = (unsigned)wid * 1024u;
    const int aoff = lds_byte(wr * 64 + fr, fq * 8), boff = lds_byte(wc * 32 + fr, fq * 8);
#define PG8_SA(b, h) (((b) * 2 + (h)) * HTB)
#define PG8_SB(b, h) ((4 + (b) * 2 + (h)) * HTB)
#define PG8_STAGE(bufoff, gbase, voff) do { _Pragma("unroll") for (int _i = 0; _i < 2; ++_i) \
        __builtin_amdgcn_global_load_lds((const unsigned*)((const char*)(gbase) + (voff)[_i]), (PG8_LAS unsigned*)(lds + (bufoff) + ldsw + _i * 8192), 16, 0, 0); } while (0)
#define PG8_LDA(dst, b, h) do { _Pragma("unroll") for (int m = 0; m < 4; ++m) _Pragma("unroll") for (int k = 0; k < 2; ++k) dst[m][k] = *(const PG8_LAS bf16x8*)(lds + PG8_SA(b, h) + aoff + m * 2048 + k * 1024); } while (0)
#define PG8_LDB(dst, b, h) do { _Pragma("unroll") for (int n = 0; n < 2; ++n) _Pragma("unroll") for (int k = 0; k < 2; ++k) dst[n][k] = *(const PG8_LAS bf16x8*)(lds + PG8_SB(b, h) + boff + n * 2048 + k * 1024); } while (0)
#define PG8_MMA(ai, bj, At, Bt) do { __builtin_amdgcn_s_setprio(1); _Pragma("unroll") for (int m = 0; m < 4; ++m) _Pragma("unroll") for (int n = 0; n < 2; ++n) _Pragma("unroll") for (int k = 0; k < 2; ++k) \
        acc[ai][bj][m][n] = __builtin_amdgcn_mfma_f32_16x16x32_bf16(Bt[n][k], At[m][k], acc[ai][bj][m][n], 0, 0, 0); __builtin_amdgcn_s_setprio(0); } while (0)
#define PG8_WAIT_V(n) asm volatile("s_waitcnt vmcnt(" #n ")" ::: "memory")
#define PG8_WAIT_L(n) asm volatile("s_waitcnt lgkmcnt(" #n ")" ::: "memory")
#define PG8_BAR __builtin_amdgcn_s_barrier()
#define PG8_SCHED __builtin_amdgcn_sched_barrier(0)
    Unit cur, nxt; int ui = 0;
    if (!S.next(0, cur)) return;
    f32x4 acc[2][2][4][2];
#pragma unroll
    for (int a = 0; a < 2; ++a)
#pragma unroll
        for (int b = 0; b < 2; ++b)
#pragma unroll
            for (int m = 0; m < 4; ++m)
#pragma unroll
                for (int n = 0; n < 2; ++n) acc[a][b][m][n] = (f32x4){0.f, 0.f, 0.f, 0.f};
    bf16x8 At[4][2], B0[2][2], B1[2][2];
    const char* cA = (const char*)g.A + (size_t)cur.pm * tstepA; const char* cB = (const char*)g.Bt + (size_t)cur.pn * tstepB;
    S.a_ready(cur);
    if constexpr (SP2) {
        PG8_STAGE(PG8_SB(0, 0), cB, voffB); PG8_STAGE(PG8_SB(0, 1), cB + hstepB, voffB); PG8_STAGE(PG8_SA(0, 0), cA, voffA); PG8_STAGE(PG8_SA(0, 1), cA + hstepA, voffA);
        if (wr == 1) PG8_BAR;
        PG8_WAIT_V(2); PG8_BAR;
        PG8_STAGE(PG8_SB(1, 0), cB + kstep, voffB); PG8_STAGE(PG8_SA(1, 0), cA + kstep, voffA); PG8_STAGE(PG8_SB(1, 1), cB + hstepB + kstep, voffB);
        PG8_WAIT_V(6); PG8_BAR;
    } else {
        PG8_STAGE(PG8_SB(0, 0), cB, voffB); PG8_STAGE(PG8_SA(0, 0), cA, voffA); PG8_STAGE(PG8_SB(0, 1), cB + hstepB, voffB); PG8_STAGE(PG8_SA(0, 1), cA + hstepA, voffA);
        if (wr == 1) PG8_BAR;
        PG8_WAIT_V(4); PG8_BAR;
        PG8_STAGE(PG8_SB(1, 0), cB + kstep, voffB); PG8_STAGE(PG8_SA(1, 0), cA + kstep, voffA); PG8_STAGE(PG8_SB(1, 1), cB + hstepB + kstep, voffB);
        PG8_WAIT_V(6); PG8_BAR;
    }
    for (;;) {
        const bool has_next = S.next(ui + 1, nxt);
        const char* nA = has_next ? (const char*)g.A + (size_t)nxt.pm * tstepA : cA; const char* nB = has_next ? (const char*)g.Bt + (size_t)nxt.pn * tstepB : cB;
#pragma unroll 1
        for (int t = 0; t < nt; t += 2) {
            if constexpr (Epi::MIDT > 0) { if (t == Epi::MIDT) E.mid(acc, cur, wr, wc, fr, fq); }
            const bool last = (t == nt - 2);
            const char* a1 = cA + (size_t)(t + 1) * kstep;
            const char* a2 = last ? nA : cA + (size_t)(t + 2) * kstep; const char* b2 = last ? nB : cB + (size_t)(t + 2) * kstep;
            const char* a3 = a2 + kstep; const char* b3 = b2 + kstep;
            if (last && has_next) S.a_ready(nxt);
            if constexpr (SP2) {
            PG8_LDB(B0, 0, 0); PG8_LDB(B1, 0, 1); PG8_SCHED; PG8_LDA(At, 0, 0); PG8_STAGE(PG8_SA(1, 1), a1 + hstepA, voffA);
            PG8_WAIT_V(8); PG8_WAIT_L(0); PG8_BAR; PG8_MMA(0, 0, At, B0); PG8_MMA(0, 1, At, B1); PG8_BAR; PG8_SCHED;
            PG8_LDA(At, 0, 1); PG8_STAGE(PG8_SB(0, 0), b2, voffB); PG8_STAGE(PG8_SB(0, 1), b2 + hstepB, voffB); PG8_STAGE(PG8_SA(0, 0), a2, voffA);
            PG8_WAIT_V(8); PG8_WAIT_L(0); PG8_BAR; PG8_MMA(1, 0, At, B0); PG8_MMA(1, 1, At, B1); PG8_BAR; PG8_SCHED;
            PG8_LDB(B0, 1, 0); PG8_LDB(B1, 1, 1); PG8_SCHED; PG8_LDA(At, 1, 0); PG8_STAGE(PG8_SA(0, 1), a2 + hstepA, voffA);
            PG8_WAIT_V(8); PG8_WAIT_L(0); PG8_BAR; PG8_MMA(0, 0, At, B0); PG8_MMA(0, 1, At, B1); PG8_BAR; PG8_SCHED;
            PG8_LDA(At, 1, 1); PG8_STAGE(PG8_SB(1, 0), b3, voffB); PG8_STAGE(PG8_SB(1, 1), b3 + hstepB, voffB); PG8_STAGE(PG8_SA(1, 0), a3, voffA);
            PG8_WAIT_V(8); PG8_WAIT_L(0); PG8_BAR; PG8_MMA(1, 0, At, B0); PG8_MMA(1, 1, At, B1); PG8_BAR; PG8_SCHED;
            } else {
            PG8_LDB(B0, 0, 0); PG8_SCHED; PG8_LDA(At, 0, 0); PG8_STAGE(PG8_SA(1, 1), a1 + hstepA, voffA);
            PG8_WAIT_L(8); PG8_BAR; PG8_WAIT_L(0); PG8_MMA(0, 0, At, B0); PG8_BAR; PG8_SCHED;
            PG8_LDB(B1, 0, 1); PG8_STAGE(PG8_SB(0, 0), b2, voffB);
            PG8_BAR; PG8_WAIT_L(0); PG8_MMA(0, 1, At, B1); PG8_BAR;
            PG8_LDA(At, 0, 1); PG8_STAGE(PG8_SA(0, 0), a2, voffA);
            PG8_BAR; PG8_WAIT_L(0); PG8_MMA(1, 0, At, B0); PG8_BAR; PG8_SCHED;
            PG8_STAGE(PG8_SB(0, 1), b2 + hstepB, voffB);
            PG8_WAIT_V(6); PG8_BAR; PG8_MMA(1, 1, At, B1); PG8_BAR;
            PG8_LDB(B0, 1, 0); PG8_SCHED; PG8_LDA(At, 1, 0); PG8_STAGE(PG8_SA(0, 1), a2 + hstepA, voffA);
            PG8_WAIT_L(8); PG8_BAR; PG8_WAIT_L(0); PG8_MMA(0, 0, At, B0); PG8_BAR; PG8_SCHED;
            PG8_LDB(B1, 1, 1); PG8_STAGE(PG8_SB(1, 0), b3, voffB);
            PG8_BAR; PG8_WAIT_L(0); PG8_MMA(0, 1, At, B1); PG8_BAR;
            PG8_LDA(At, 1, 1); PG8_STAGE(PG8_SA(1, 0), a3, voffA);
            PG8_BAR; PG8_WAIT_L(0); PG8_MMA(1, 0, At, B0); PG8_BAR; PG8_SCHED;
            PG8_STAGE(PG8_SB(1, 1), b3 + hstepB, voffB);
            PG8_WAIT_V(6); PG8_BAR; PG8_MMA(1, 1, At, B1); PG8_BAR;
            }
        }
        if constexpr (ALIGN_EPI) { if (wr == 0) PG8_BAR; }
        if constexpr (!Epi::AFTER_DRAIN) { E(acc, cur, wr, wc, fr, fq); S.done(cur); }
        if (!has_next) break;
#pragma unroll
        for (int a = 0; a < 2; ++a)
#pragma unroll
            for (int b = 0; b < 2; ++b)
#pragma unroll
                for (int m = 0; m < 4; ++m)
#pragma unroll
                    for (int n = 0; n < 2; ++n) acc[a][b][m][n] = (f32x4){0.f, 0.f, 0.f, 0.f};
        cur = nxt; cA = nA; cB = nB; ++ui;
        if constexpr (ALIGN_EPI) { if (wr == 1) PG8_BAR; }
    }
    PG8_WAIT_V(0);
    if constexpr (!ALIGN_EPI) { if (wr == 0) PG8_BAR; }
    PG8_BAR;
    if constexpr (Epi::AFTER_DRAIN) { E.fused(acc, cur, wr, wc, fr, fq, lds, wid, lane); S.done(cur); }
#undef PG8_SA
#undef PG8_SB
#undef PG8_STAGE
#undef PG8_LDA
#undef PG8_LDB
#undef PG8_MMA
#undef PG8_WAIT_V
#undef PG8_WAIT_L
#undef PG8_BAR
#undef PG8_SCHED
}
}
namespace att {
typedef unsigned short bf16_t;
typedef short bf16x8 __attribute__((ext_vector_type(8)));
typedef short s16x4 __attribute__((ext_vector_type(4)));
typedef float f32x16 __attribute__((ext_vector_type(16)));
typedef float f32x4 __attribute__((ext_vector_type(4)));
typedef unsigned u32x4 __attribute__((ext_vector_type(4)));
#define ALDS __attribute__((address_space(3)))
#define ASBAR() __builtin_amdgcn_sched_barrier(0)
constexpr int KTB = 12288, VTB = 8192;
constexpr int L_K = 0, L_V = 2 * KTB, L_WS = L_V + 2 * VTB, L_OST = L_WS + 8 * 256, L_KM = L_OST + 8 * 4096, L_RED = L_KM + 2048, L_END = L_RED + 16384;
constexpr float THR = 8.f;
__device__ __forceinline__ int crow(int r, int hi) { return (r & 3) + 8 * (r >> 2) + 4 * hi; }
typedef float f32x2a_t __attribute__((ext_vector_type(2))); typedef __bf16 bf16x2a_t __attribute__((ext_vector_type(2)));
__device__ __forceinline__ unsigned cvtpk(float lo, float hi) { const f32x2a_t v = {lo, hi}; const bf16x2a_t b = __builtin_convertvector(v, bf16x2a_t); return __builtin_bit_cast(unsigned, b); }
__device__ __forceinline__ float bf2f(short s) { return __uint_as_float(((unsigned)(unsigned short)s) << 16); }
__device__ __forceinline__ int v_st(int k, int c) { const int kk = (k & ~0xC) | ((k & 4) << 1) | ((k & 8) >> 1); return ((kk >> 3) * 2 + (c >> 5)) * 512 + ((kk & 7) * 32 + (c & 31)) * 2; }
__device__ __forceinline__ int v_rd_base(int lane) { return ((lane & 3) << 3) | (((lane >> 2) & 3) << 6) | (((lane >> 4) & 1) << 5) | (((lane >> 5) & 1) << 8); }
constexpr int v_rd_off(int d0, int ks, int half) { return ks * 2048 + half * 1024 + d0 * 512; }
template <int OFF> __device__ __forceinline__ s16x4 tr_read(int vb) { s16x4 r; asm volatile("ds_read_b64_tr_b16 %0, %1 offset:%2" : "=&v"(r) : "v"(vb), "i"(OFF) : "memory"); return r; }
template <int D0> __device__ __forceinline__ void pv_one(f32x16& od, int vb, bf16x8 pa0, bf16x8 pa1, bf16x8 pa2, bf16x8 pa3) {
    const s16x4 l0 = tr_read<v_rd_off(D0, 0, 0)>(vb), h0 = tr_read<v_rd_off(D0, 0, 1)>(vb), l1 = tr_read<v_rd_off(D0, 1, 0)>(vb), h1 = tr_read<v_rd_off(D0, 1, 1)>(vb);
    const s16x4 l2 = tr_read<v_rd_off(D0, 2, 0)>(vb), h2 = tr_read<v_rd_off(D0, 2, 1)>(vb), l3 = tr_read<v_rd_off(D0, 3, 0)>(vb), h3 = tr_read<v_rd_off(D0, 3, 1)>(vb);
    asm volatile("s_waitcnt lgkmcnt(0)" ::: "memory"); ASBAR();
#define ATT_PK(L, H) (bf16x8){L[0], L[1], L[2], L[3], H[0], H[1], H[2], H[3]}
    od = __builtin_amdgcn_mfma_f32_32x32x16_bf16(pa0, ATT_PK(l0, h0), od, 0, 0, 0);
    od = __builtin_amdgcn_mfma_f32_32x32x16_bf16(pa1, ATT_PK(l1, h1), od, 0, 0, 0);
    od = __builtin_amdgcn_mfma_f32_32x32x16_bf16(pa2, ATT_PK(l2, h2), od, 0, 0, 0);
    od = __builtin_amdgcn_mfma_f32_32x32x16_bf16(pa3, ATT_PK(l3, h3), od, 0, 0, 0);
#undef ATT_PK
}
__device__ __forceinline__ void pv_all(f32x16* o, int vb, bf16x8 pa0, bf16x8 pa1, bf16x8 pa2, bf16x8 pa3) { pv_one<0>(o[0], vb, pa0, pa1, pa2, pa3); pv_one<1>(o[1], vb, pa0, pa1, pa2, pa3); }
__device__ __forceinline__ void partialSM(f32x16& p0, f32x16& p1, float& m_reg, float& alpha) {
    float pmax = p0[0];
#pragma unroll
    for (int r = 1; r < 16; ++r) pmax = fmaxf(pmax, p0[r]);
#pragma unroll
    for (int r = 0; r < 16; ++r) pmax = fmaxf(pmax, p1[r]);
    { auto rr = __builtin_amdgcn_permlane32_swap(__float_as_uint(pmax), __float_as_uint(pmax), false, false); pmax = fmaxf(__uint_as_float(rr[0]), __uint_as_float(rr[1])); }
    float mn;
    if (__builtin_expect(__all(pmax - m_reg <= THR), 1)) { mn = m_reg; alpha = 1.f; }
    else { mn = fmaxf(m_reg, pmax); alpha = __builtin_amdgcn_exp2f(m_reg - mn); m_reg = mn; }
#pragma unroll
    for (int r = 0; r < 16; ++r) p0[r] = __builtin_amdgcn_exp2f(p0[r] - mn);
#pragma unroll
    for (int r = 0; r < 16; ++r) p1[r] = p1[r] - mn;
}
__device__ __forceinline__ void finishSM(f32x16& p0, f32x16& p1, float alpha, float& l_reg, bf16x8& pa0, bf16x8& pa1, bf16x8& pa2, bf16x8& pa3) {
#pragma unroll
    for (int r = 0; r < 16; ++r) p1[r] = __builtin_amdgcn_exp2f(p1[r]);
    float ps = 0.f;
#pragma unroll
    for (int r = 0; r < 16; ++r) ps += p0[r];
#pragma unroll
    for (int r = 0; r < 16; ++r) ps += p1[r];
    { auto rr = __builtin_amdgcn_permlane32_swap(__float_as_uint(ps), __float_as_uint(ps), false, false); ps = __uint_as_float(rr[0]) + __uint_as_float(rr[1]); }
    l_reg = l_reg * alpha + ps;
#define ATT_PK4(P, BASE, OUT) do { unsigned a0 = cvtpk(P[BASE + 0], P[BASE + 1]), a1 = cvtpk(P[BASE + 2], P[BASE + 3]);   \
    unsigned b0 = cvtpk(P[BASE + 4], P[BASE + 5]), b1 = cvtpk(P[BASE + 6], P[BASE + 7]);                              \
    auto r0 = __builtin_amdgcn_permlane32_swap(a0, b0, false, false); auto r1 = __builtin_amdgcn_permlane32_swap(a1, b1, false, false); \
    u32x4 w = {r0[0], r1[0], r0[1], r1[1]}; OUT = __builtin_bit_cast(bf16x8, w); } while (0)
    ATT_PK4(p0, 0, pa0); ATT_PK4(p0, 8, pa1); ATT_PK4(p1, 0, pa2); ATT_PK4(p1, 8, pa3);
#undef ATT_PK4
}
template <int ND> __device__ __forceinline__ void qkt(f32x16& p0, f32x16& p1, ALDS const char* Kb, const int (&ka)[ND], const bf16x8 (&qr)[ND]) {
    p0 = f32x16{}; p1 = f32x16{};
#pragma unroll
    for (int d0 = 0; d0 < ND; ++d0) {
        const bf16x8 b0 = *(ALDS const bf16x8*)(Kb + ka[d0]);
        const bf16x8 b1 = *(ALDS const bf16x8*)(Kb + ka[d0] + (d0 < 4 ? 4096 : 2048));
        p0 = __builtin_amdgcn_mfma_f32_32x32x16_bf16(b0, qr[d0], p0, 0, 0, 0);
        p1 = __builtin_amdgcn_mfma_f32_32x32x16_bf16(b1, qr[d0], p1, 0, 0, 0);
        if (ND > 4 && d0 == 2) asm volatile("" ::: "memory"); }
}
template <bool MOBA> __device__ __forceinline__ void tmask(f32x16& p0, f32x16& p1, int t, int qb, int qrel, int hi, unsigned sel) {
    const float NEG = -INFINITY;
    if (t >= 4 * qb) { const int thr = qrel - 64 * (t - 4 * qb) - 4 * hi;
#pragma unroll
        for (int r = 0; r < 16; ++r) { if ((r & 3) + 8 * (r >> 2) > thr) p0[r] = NEG; if ((r & 3) + 8 * (r >> 2) + 32 > thr) p1[r] = NEG; } }
    else if (MOBA) { if (!((sel >> (t >> 2)) & 1u)) {
#pragma unroll
        for (int r = 0; r < 16; ++r) { p0[r] = NEG; p1[r] = NEG; } } }
}
__device__ __forceinline__ void kmean_blocks(const bf16_t* Kp, ALDS char* lds) {
    int tid_ = threadIdx.x; asm volatile("" : "+v"(tid_));
    const int tid = tid_, lane = tid & 63, wid = tid >> 6, c = tid & 7, rg = tid >> 3;
    ALDS float* red = (ALDS float*)(lds + L_RED); ALDS float* km = (ALDS float*)(lds + L_KM);
#pragma unroll 1
    for (int n = 0; n < 8; ++n) {
        float a[8];
#pragma unroll
        for (int j = 0; j < 8; ++j) a[j] = 0.f;
#pragma unroll
        for (int i = 0; i < 4; ++i) { const bf16x8 kx = *(const bf16x8*)(Kp + (size_t)(n * 256 + rg + 64 * i) * AW + c * 8);
#pragma unroll
            for (int j = 0; j < 8; ++j) a[j] += bf2f(kx[j]); }
#pragma unroll
        for (int j = 0; j < 8; ++j) { a[j] += __shfl_xor(a[j], 8); a[j] += __shfl_xor(a[j], 16); a[j] += __shfl_xor(a[j], 32); }
        if (lane < 8) {
#pragma unroll
            for (int j = 0; j < 8; ++j) red[(n * 8 + wid) * 64 + c * 8 + j] = a[j]; }
    }
    __syncthreads();
    { const int n = tid >> 6, d = tid & 63; float s = 0.f;
#pragma unroll
        for (int w = 0; w < 8; ++w) s += red[(n * 8 + w) * 64 + d];
        km[n * 64 + d] = s * (1.0f / 256.0f); }
    __syncthreads();
}
template <int DQK, bool MOBA>
__device__ __forceinline__ void attn_unit(const bf16_t* Qp, int ldq, const bf16_t* Kp, const bf16_t* KRp, const bf16_t* Vp, bf16_t* Op, int ldo, int qb, ALDS char* lds) {
    constexpr int ND = DQK / 16;
    int tid_ = threadIdx.x; asm volatile("" : "+v"(tid_));
    const int tid = tid_, lane = tid & 63, r32 = lane & 31, hi = lane >> 5; const int wid = __builtin_amdgcn_readfirstlane(tid >> 6);
    ALDS char* K_lds = lds + L_K; ALDS char* V_lds = lds + L_V;
    ALDS float* ws = (ALDS float*)(lds + L_WS) + wid * 64; ALDS float* li_l = ws; ALDS float* al_l = ws + 32;
    float m_reg = -1e30f, l_reg = 0.f; f32x16 o[2]; o[0] = f32x16{}; o[1] = f32x16{}; bf16x8 qr[ND];
    { const bf16_t* Qw = Qp + (size_t)(wid * 32 + r32) * ldq + hi * 8;
#pragma unroll
      for (int d0 = 0; d0 < ND; ++d0) qr[d0] = *(const bf16x8*)(Qw + d0 * 16); }
    unsigned sel = 0xffu;
    if (MOBA && qb > 3) {
        ALDS const float* km = (ALDS const float*)(lds + L_KM); float g[8];
#pragma unroll
        for (int n = 0; n < 8; ++n) { float s = 0.f;
#pragma unroll
            for (int d0 = 0; d0 < ND; ++d0)
#pragma unroll
                for (int j = 0; j < 8; ++j) s += bf2f(qr[d0][j]) * km[n * 64 + d0 * 16 + hi * 8 + j];
            g[n] = s; }
#pragma unroll
        for (int n = 0; n < 8; ++n) g[n] += __shfl_xor(g[n], 32);
        sel = 0u;
#pragma unroll
        for (int n = 0; n < 8; ++n) { int rank = 0;
#pragma unroll
            for (int mm = 0; mm < 8; ++mm) if (mm != n) rank += (mm < qb && (g[mm] > g[n] || (g[mm] == g[n] && mm < n))) ? 1 : 0;
            if (n < qb && rank < 3) sel |= 1u << n; }
    }
    const int skey = tid >> 3, sch = tid & 7;
    const unsigned koff = (unsigned)(skey * AW + sch * 8) * 2u;
    const int kst = skey * 128 + ((sch ^ ((skey >> 1) & 7)) << 4), vst = v_st(skey, sch * 8);
    const int t2 = tid & 255, rkey = t2 >> 2, rch = t2 & 3;
    const unsigned roff = (unsigned)(rkey * RDIM + rch * 8) * 2u;
    const int rst = 8192 + rkey * 64 + ((rch ^ ((rkey >> 2) & 3)) << 4);
    int ka[ND];
#pragma unroll
    for (int d0 = 0; d0 < ND; ++d0) ka[d0] = (d0 < 4) ? r32 * 128 + (((2 * d0 + hi) ^ ((r32 >> 1) & 7)) << 4) : 8192 + r32 * 64 + (((2 * (d0 - 4) + hi) ^ ((r32 >> 2) & 3)) << 4);
    const int vb0 = (int)(unsigned)(uintptr_t)V_lds + v_rd_base(lane);
    const int qrel = wid * 32 + r32;
    bf16x8 sk0, sv0, sr0, sk1, sv1, sr1;
#define ATT_SLOAD(S, k0) do { sk##S = *(const bf16x8*)((const char*)(Kp + (size_t)(k0) * AW) + koff); sv##S = *(const bf16x8*)((const char*)(Vp + (size_t)(k0) * AW) + koff); if (DQK == 96) sr##S = *(const bf16x8*)((const char*)(KRp + (size_t)(k0) * RDIM) + roff); } while (0)
#define ATT_SWRITE(b, S) do { *(ALDS bf16x8*)(K_lds + (b) * KTB + kst) = sk##S; *(ALDS bf16x8*)(V_lds + (b) * VTB + vst) = sv##S; if (DQK == 96) { if (tid < 256) *(ALDS bf16x8*)(K_lds + (b) * KTB + rst) = sr##S; } } while (0)
#define ATT_RESC(a) do { if (__any((a) < 1.f)) { if (hi == 0) al_l[r32] = (a); asm volatile("s_waitcnt lgkmcnt(0)" ::: "memory"); \
    _Pragma("unroll") for (int d = 0; d < 2; ++d) _Pragma("unroll") for (int r = 0; r < 16; ++r) o[d][r] *= al_l[crow(r, hi)]; } } while (0)
    f32x16 pA0, pA1, pB0, pB1; float alA, alB; bf16x8 pa0, pa1, pa2, pa3; const int NT = 4 * (qb + 1);
    ATT_SLOAD(0, 0); ATT_SWRITE(0, 0); __syncthreads();
    qkt<ND>(pA0, pA1, K_lds, ka, qr); tmask<MOBA>(pA0, pA1, 0, qb, qrel, hi, sel); partialSM(pA0, pA1, m_reg, alA);
    ATT_SLOAD(1, 64); ATT_SLOAD(0, 128);
    ATT_SWRITE(1, 1); __syncthreads();
    for (int j = 1; j + 1 < NT; j += 2) {
        ASBAR(); qkt<ND>(pB0, pB1, K_lds + KTB, ka, qr); tmask<MOBA>(pB0, pB1, j, qb, qrel, hi, sel);
        finishSM(pA0, pA1, alA, l_reg, pa0, pa1, pa2, pa3); ASBAR();
        ATT_SLOAD(1, (j + 2) * 64); ASBAR();
        pv_all(o, vb0, pa0, pa1, pa2, pa3); partialSM(pB0, pB1, m_reg, alB);
        __syncthreads(); ATT_SWRITE(0, 0);
        ATT_RESC(alB); __syncthreads();
        ASBAR(); qkt<ND>(pA0, pA1, K_lds, ka, qr); tmask<MOBA>(pA0, pA1, j + 1, qb, qrel, hi, sel);
        finishSM(pB0, pB1, alB, l_reg, pa0, pa1, pa2, pa3); ASBAR();
        if (j + 3 < NT) ATT_SLOAD(0, (j + 3) * 64); ASBAR();
        pv_all(o, vb0 + VTB, pa0, pa1, pa2, pa3); partialSM(pA0, pA1, m_reg, alA);
        __syncthreads(); ATT_SWRITE(1, 1);
        ATT_RESC(alA); __syncthreads();
    }
    ASBAR(); qkt<ND>(pB0, pB1, K_lds + KTB, ka, qr); tmask<MOBA>(pB0, pB1, NT - 1, qb, qrel, hi, sel);
    finishSM(pA0, pA1, alA, l_reg, pa0, pa1, pa2, pa3); ASBAR();
    pv_all(o, vb0, pa0, pa1, pa2, pa3); partialSM(pB0, pB1, m_reg, alB);
    __syncthreads(); ATT_RESC(alB);
    finishSM(pB0, pB1, alB, l_reg, pa0, pa1, pa2, pa3); ASBAR();
    pv_all(o, vb0 + VTB, pa0, pa1, pa2, pa3);
    if (hi == 0) li_l[r32] = l_reg; asm volatile("s_waitcnt lgkmcnt(0)" ::: "memory");
    float rli[16];
#pragma unroll
    for (int r = 0; r < 16; ++r) rli[r] = __builtin_amdgcn_rcpf(li_l[crow(r, hi)]);
    { ALDS unsigned short* stg = (ALDS unsigned short*)(lds + L_OST) + wid * 2048;
#pragma unroll
      for (int r = 0; r < 16; ++r) { const int orow = crow(r, hi);
#pragma unroll
          for (int d0 = 0; d0 < 2; ++d0) stg[orow * 64 + d0 * 32 + r32] = (unsigned short)(cvtpk(o[d0][r] * rli[r], 0.f) & 0xffffu); }
      asm volatile("s_waitcnt lgkmcnt(0)" ::: "memory");
      bf16_t* Ow = Op + (size_t)(wid * 32) * ldo;
#pragma unroll
      for (int i = 0; i < 4; ++i) { const int row = i * 8 + (lane >> 3), ch = lane & 7; const u32x4 v = *(ALDS const u32x4*)(stg + row * 64 + ch * 8); *(u32x4*)(Ow + (size_t)row * ldo + ch * 8) = v; } }
    __syncthreads();
#undef ATT_SLOAD
#undef ATT_SWRITE
#undef ATT_RESC
}
#undef ASBAR
}
#if defined(DBG_NAIVE_ATTN) || defined(DBG_CHECK)
namespace dbg {
typedef unsigned short bf16_t;
typedef short bf16x8 __attribute__((ext_vector_type(8)));
__device__ __forceinline__ float bf2f(short s) { return __uint_as_float(((unsigned)(unsigned short)s) << 16); }
__device__ __forceinline__ unsigned short f2bf_(float f) { unsigned u = __builtin_bit_cast(unsigned, f); return (unsigned short)((u + 0x7fffu + ((u >> 16) & 1u)) >> 16); }
__global__ void __launch_bounds__(512) kmean_k(const bf16_t* KA, float* KM) {
    const int bh = blockIdx.x, b = bh >> 3, h = bh & 7, n = threadIdx.x >> 6, d = threadIdx.x & 63; float s = 0.f;
    const bf16_t* Kp = KA + (size_t)b * SEQ * AW + h * HD;
#pragma unroll 4
    for (int r = 0; r < 256; ++r) s += bf2f((short)Kp[(size_t)(n * 256 + r) * AW + d]);
    KM[(size_t)bh * 512 + n * 64 + d] = s * (1.0f / 256.0f);
}
template <int DQK, bool MOBA>
__global__ void __launch_bounds__(256) attn_k(const bf16_t* Q, const bf16_t* K, const bf16_t* KR, const bf16_t* V, bf16_t* O, const float* KM) {
    constexpr int ldq = (DQK == 96) ? NHEAD * QKB : AW;
    const int bh = blockIdx.y, b = bh >> 3, h = bh & 7, tid = threadIdx.x;
    const size_t r0 = (size_t)b * SEQ;
    const bf16_t* Qp = Q + r0 * ldq + h * (DQK == 96 ? QKB : HD); const bf16_t* Kp = K + r0 * AW + h * HD; const bf16_t* Vp = V + r0 * AW + h * HD; const bf16_t* KRp = (DQK == 96) ? KR + r0 * RDIM : K;
    bf16_t* Op = O + r0 * AW + h * HD; const float* km = KM + (size_t)bh * 512;
    const int row = blockIdx.x * 64 + (tid >> 2), qb = row >> 8, c4 = tid & 3;
    bf16x8 q[DQK / 8];
#pragma unroll
    for (int c = 0; c < DQK / 8; ++c) q[c] = *(const bf16x8*)(Qp + (size_t)row * ldq + c * 8);
    unsigned sel = 0xffu;
    if (MOBA && qb > 3) {
        float g[8];
#pragma unroll
        for (int n = 0; n < 8; ++n) { float s = 0.f;
#pragma unroll
            for (int c = 0; c < 8; ++c)
#pragma unroll
                for (int j = 0; j < 8; ++j) s += bf2f(q[c][j]) * km[n * 64 + c * 8 + j];
            g[n] = s; }
        sel = 0u;
#pragma unroll
        for (int n = 0; n < 8; ++n) { int rank = 0;
#pragma unroll
            for (int mm = 0; mm < 8; ++mm) if (mm != n) rank += (mm < qb && (g[mm] > g[n] || (g[mm] == g[n] && mm < n))) ? 1 : 0;
            if (n < qb && rank < 3) sel |= 1u << n; }
    }
    float o[16];
#pragma unroll
    for (int d = 0; d < 16; ++d) o[d] = 0.f;
    float mx = -1e30f, l = 0.f;
#pragma unroll 1
    for (int key = 0; key <= row; ++key) {
        const int n = key >> 8;
        if (MOBA && n < qb && !((sel >> n) & 1u)) { key = (n << 8) + 255; continue; }
        float s = 0.f;
#pragma unroll
        for (int c = 0; c < 8; ++c) { const bf16x8 kx = *(const bf16x8*)(Kp + (size_t)key * AW + c * 8);
#pragma unroll
            for (int j = 0; j < 8; ++j) s += bf2f(q[c][j]) * bf2f(kx[j]); }
        if (DQK == 96) {
#pragma unroll
            for (int c = 0; c < 4; ++c) { const bf16x8 kx = *(const bf16x8*)(KRp + (size_t)key * RDIM + c * 8);
#pragma unroll
                for (int j = 0; j < 8; ++j) s += bf2f(q[(DQK == 96 ? 8 : 0) + c][j]) * bf2f(kx[j]); }
        }
        const float mn = fmaxf(mx, s), a = __builtin_amdgcn_exp2f(mx - mn), p = __builtin_amdgcn_exp2f(s - mn);
        l = l * a + p; mx = mn;
#pragma unroll
        for (int c = 0; c < 2; ++c) { const bf16x8 vx = *(const bf16x8*)(Vp + (size_t)key * AW + c4 * 16 + c * 8);
#pragma unroll
            for (int j = 0; j < 8; ++j) o[c * 8 + j] = o[c * 8 + j] * a + p * bf2f(vx[j]); }
    }
    const float rl = 1.f / l;
    __syncthreads();
#pragma unroll
    for (int d = 0; d < 16; ++d) Op[(size_t)row * AW + c4 * 16 + d] = f2bf_(o[d] * rl);
}
}
#endif
#define GAS __attribute__((address_space(1)))
#define LAS __attribute__((address_space(3)))
typedef unsigned short bf16;
typedef unsigned v4u __attribute__((ext_vector_type(4)));
typedef float f32x4 __attribute__((ext_vector_type(4)));
typedef short bf16x8 __attribute__((ext_vector_type(8)));
typedef GAS unsigned gu32;
typedef GAS unsigned long long gu64;
#define RLX_AGENT __ATOMIC_RELAXED, __HIP_MEMORY_SCOPE_AGENT
#define LDS_WAIT() asm volatile("s_waitcnt lgkmcnt(0)" ::: "memory")
#define VM_WAIT() asm volatile("s_waitcnt vmcnt(0)" ::: "memory")
__device__ __forceinline__ unsigned long long rt() { return __builtin_amdgcn_s_memrealtime(); }
__device__ __forceinline__ unsigned f2bf(float f) { unsigned u = __builtin_bit_cast(unsigned, f); return (u + 0x7fffu + ((u >> 16) & 1u)) >> 16; }
__device__ __forceinline__ unsigned pk2(float lo, float hi) { return f2bf(lo) | (f2bf(hi) << 16); }

#define XB_TMO      128
#define XB_XCNT(j)  (256  + 64 * (j))
#define XB_XSUB(j)  (1280 + 64 * (j))
#define XB_XGEN(j)  (2304 + 64 * (j))
#define XB_TOP      3328
#define XB_TOPGEN   3392
#define XCD_BAR_WORDS 3456
#define XB_SPIN_CAP (1u << 18)

__device__ __forceinline__ unsigned xb_ld(unsigned* p)              { return __hip_atomic_load(p, __ATOMIC_RELAXED, __HIP_MEMORY_SCOPE_AGENT); }
__device__ __forceinline__ unsigned xb_add(unsigned* p, unsigned v) { return __hip_atomic_fetch_add(p, v, __ATOMIC_RELAXED, __HIP_MEMORY_SCOPE_AGENT); }
__device__ __forceinline__ unsigned xb_xcc_id() { return (unsigned)__builtin_amdgcn_s_getreg((3 << 11) | 20) & 0xFu; }
#define XB_SPIN(cond, bar) do { unsigned _sp = 0; while (cond) { __builtin_amdgcn_s_sleep(1); \
    if ((++_sp & 255u) == 0u) { if (xb_ld(&(bar)[XB_TMO])) break; if (_sp > XB_SPIN_CAP) { atomicAdd(&(bar)[XB_TMO], 1u); break; } } } } while (0)

struct XcdBarrier {
    unsigned* bar; unsigned x;
    volatile LAS unsigned* st;
};

__device__ __forceinline__ XcdBarrier xcd_barrier_post(unsigned* bar, volatile LAS unsigned* st) {
    XcdBarrier b; b.bar = bar; b.x = xb_xcc_id(); b.st = st;
    if (threadIdx.x == 0) (void)xb_add(&bar[XB_XCNT(b.x)], 1u);
    return b;
}
__device__ __forceinline__ void xcd_barrier_complete(unsigned* bar, unsigned x, unsigned& nloc, unsigned& nx) {
    const unsigned G = gridDim.x * gridDim.y * gridDim.z;
    unsigned sum, cnt, mine, sp = 0u;
    for (;;) {
        sum = 0u; cnt = 0u; mine = 0u;
#pragma unroll
        for (unsigned j = 0; j < 16; ++j) { const unsigned c = xb_ld(&bar[XB_XCNT(j)]); sum += c; cnt += (c > 0u) ? 1u : 0u; mine = (j == x) ? c : mine; }
        if (sum == G) break;
        __builtin_amdgcn_s_sleep(1);
        if ((++sp & 255u) == 0u) { if (xb_ld(&bar[XB_TMO])) break; if (sp > XB_SPIN_CAP) { atomicAdd(&bar[XB_TMO], 1u); break; } }
    }
    nloc = mine > 0u ? mine : 1u; nx = cnt > 0u ? cnt : 1u;
}

__device__ __forceinline__ void xcd_barrier(const XcdBarrier& b) {
    asm volatile("s_waitcnt vmcnt(0)" ::: "memory");
    __syncthreads();
    if (threadIdx.x == 0) {
        unsigned* bar = b.bar;
        __builtin_amdgcn_s_waitcnt(0);
        unsigned nloc = b.st[0], nx = b.st[1];
        if (nloc == 0u) { xcd_barrier_complete(bar, b.x, nloc, nx); b.st[0] = nloc; b.st[1] = nx; }
        const unsigned old = xb_add(&bar[XB_XSUB(b.x)], 1u);
        const unsigned gen = old / nloc;
        if (old + 1u == (gen + 1u) * nloc) {
            __builtin_amdgcn_fence(__ATOMIC_RELEASE, "agent");
            asm volatile("s_waitcnt vmcnt(0)" ::: "memory");
            const unsigned og = xb_add(&bar[XB_TOP], 1u);
            const unsigned tg = og / nx;
            if (og + 1u == (tg + 1u) * nx) xb_add(&bar[XB_TOPGEN], 1u);
            else XB_SPIN(xb_ld(&bar[XB_TOPGEN]) == tg, bar);
            __builtin_amdgcn_fence(__ATOMIC_ACQUIRE, "agent");
            xb_add(&bar[XB_XGEN(b.x)], 1u);
            asm volatile("s_waitcnt vmcnt(0)" ::: "memory");
        } else {
            XB_SPIN(xb_ld(&bar[XB_XGEN(b.x)]) == gen, bar);
            __builtin_amdgcn_fence(__ATOMIC_ACQUIRE, "agent");
            asm volatile("s_waitcnt vmcnt(0)" ::: "memory");
        }
    }
    __syncthreads();
}
#if defined(DBG_CHECK)
namespace chk {
typedef unsigned short bf16_t;
__device__ __forceinline__ float bfv(const bf16_t* p, size_t i) { return __uint_as_float(((unsigned)p[i]) << 16); }
__device__ __forceinline__ unsigned hsh(unsigned x) { x ^= x >> 16; x *= 0x7feb352du; x ^= x >> 15; x *= 0x846ca68bu; x ^= x >> 16; return x; }
__device__ __forceinline__ void report(unsigned* cnt, int stage, float got, float want) {
    atomicAdd(&cnt[64 + stage], 1u);
    if (!(fabsf(got - want) <= 0.04f + 0.04f * fabsf(want))) atomicAdd(&cnt[stage], 1u);
}
__device__ __forceinline__ void cs_of(int pos, int i, int half, float& c, float& s) {
    const float invf = (float)exp2(-(double)i * 18.931568569324174 / (double)half);
    const float ang = (float)pos * invf; double t = (double)ang * 0.15915494309189535; t -= floor(t);
    c = __builtin_amdgcn_cosf((float)t); s = __builtin_amdgcn_sinf((float)t);
}
constexpr int NS = 64 * 256;
__global__ void __launch_bounds__(256) k_c0(const float* x, const float* g, const bf16_t* H, unsigned* cnt) {
    const unsigned id = blockIdx.x * 256 + threadIdx.x, r = hsh(id * 2654435761u + 17u); const int m = r % MTOK, k = (r >> 16) % DM;
    double ss = 0.0; for (int i = 0; i < DM; ++i) { const double v = x[(size_t)m * DM + i]; ss += v * v; }
    const float want = (float)(x[(size_t)m * DM + k] / sqrt(ss / DM + 1e-6) * g[k]);
    report(cnt, 1, bfv(H, (size_t)m * DM + k), want);
}
__device__ __forceinline__ float dot_h(const bf16_t* H, const float* W, int m, int j) { double a = 0.0; for (int k = 0; k < DM; ++k) a += (double)bfv(H, (size_t)m * DM + k) * (double)W[(size_t)k * INW + j]; return (float)a; }
__global__ void __launch_bounds__(256) k_c1(const bf16_t* H, const float* w_in, const float* b_gate, const int* positions, const bf16_t* QA, const bf16_t* KA, const bf16_t* VA, const bf16_t* CQ, const bf16_t* CKV,
                                            const bf16_t* KR, const bf16_t* G, unsigned* cnt) {
    const unsigned id = blockIdx.x * 256 + threadIdx.x, r = hsh(id * 2654435761u + 101u); const int m = r % MTOK; int j;
    { const unsigned r2 = hsh(r + 77u); const int cls = id % 8;
      if (cls == 0) j = (r2 % 8) * 64 + (r2 >> 8) % 16; else if (cls == 1) j = 512 + (r2 % 8) * 64 + (r2 >> 8) % 16; else if (cls == 2) j = 2176 + r2 % 32; else j = r2 % INW; }
    const int pos = positions[m];
    if (j < 1024) { const int sect = j >> 9, jj = j & 511, head = jj >> 6, d = jj & 63; const bf16_t* dst = sect ? KA : QA; const float sc = sect ? 1.f : C2A;
        if (d < 16) { const int i = d & 7; const float x1 = dot_h(H, w_in, m, sect * 512 + head * 64 + i), x2 = dot_h(H, w_in, m, sect * 512 + head * 64 + i + 8); float c, s; cs_of(pos, i, 8, c, s);
            const float want = ((d < 8) ? x1 * c - x2 * s : x2 * c + x1 * s) * sc; report(cnt, sect ? 4 : 2, bfv(dst, (size_t)m * AW + head * 64 + 2 * i + (d >> 3)), want); }
        else report(cnt, sect ? 5 : 3, bfv(dst, (size_t)m * AW + head * 64 + d), dot_h(H, w_in, m, j) * sc); }
    else if (j < 1536) report(cnt, 6, bfv(VA, (size_t)m * AW + (j - 1024)), dot_h(H, w_in, m, j));
    else if (j < 1920) report(cnt, 7, bfv(CQ, (size_t)m * QLORA + (j - 1536)), dot_h(H, w_in, m, j));
    else if (j < 2176) report(cnt, 8, bfv(CKV, (size_t)m * KVLORA + (j - 1920)), dot_h(H, w_in, m, j));
    else if (j < 2208) { const int dd = j - 2176, i = dd & 15; const float x1 = dot_h(H, w_in, m, 2176 + i), x2 = dot_h(H, w_in, m, 2176 + i + 16); float c, s; cs_of(pos, i, 16, c, s);
        report(cnt, 9, bfv(KR, (size_t)m * RDIM + 2 * i + (dd >> 4)), (dd < 16) ? x1 * c - x2 * s : x2 * c + x1 * s); }
    else { const float z = dot_h(H, w_in, m, j) + b_gate[j - 2208]; const float want = 1.f / (1.f + expf(-z)), got = bfv(G, (size_t)m * 2 * DM + (j - 2208)); report(cnt, 10, got, want); report(cnt, 24 + ((j - 2208) >> 8), got, want); }
}
__global__ void __launch_bounds__(256) k_c2(const bf16_t* CQ, const bf16_t* CKV, const float* g_q, const float* w_uq, const float* g_kv, const float* w_ukv, const int* positions, const bf16_t* QB, const bf16_t* KB,
                                            const bf16_t* VB, unsigned* cnt) {
    const unsigned id = blockIdx.x * 256 + threadIdx.x, r = hsh(id * 2654435761u + 303u); const int m = r % MTOK; const unsigned r2 = hsh(r + 5u);
    const int pos = positions[m];
    if (id & 1) { int n = r2 % 768; if ((id & 6) == 2) n = (n / QKB) * QKB + 64 + n % 32;
        double ss = 0.0; for (int k = 0; k < QLORA; ++k) { const double v = bfv(CQ, (size_t)m * QLORA + k); ss += v * v; } const double rs = 1.0 / sqrt(ss / QLORA + 1e-6);
        auto dq = [&](int nn) { double a = 0.0; for (int k = 0; k < QLORA; ++k) a += (double)bfv(CQ, (size_t)m * QLORA + k) * g_q[k] * w_uq[(size_t)k * 768 + nn]; return (float)(a * rs); };
        const int head = n / QKB, pp = n % QKB;
        if (pp < 64) report(cnt, 11, bfv(QB, (size_t)m * 768 + n), dq(n) * C2B);
        else { const int dd = pp - 64, i = dd & 15; const float x1 = dq(head * QKB + 64 + i), x2 = dq(head * QKB + 64 + i + 16); float c, s; cs_of(pos, i, 16, c, s);
            report(cnt, 12, bfv(QB, (size_t)m * 768 + head * QKB + 64 + 2 * i + (dd >> 4)), ((dd < 16) ? x1 * c - x2 * s : x2 * c + x1 * s) * C2B); } }
    else { const int n = r2 % 1024;
        double ss = 0.0; for (int k = 0; k < KVLORA; ++k) { const double v = bfv(CKV, (size_t)m * KVLORA + k); ss += v * v; } const double rs = 1.0 / sqrt(ss / KVLORA + 1e-6);
        double a = 0.0; for (int k = 0; k < KVLORA; ++k) a += (double)bfv(CKV, (size_t)m * KVLORA + k) * g_kv[k] * w_ukv[(size_t)k * 1024 + n];
        const int head = n >> 7, pp = n & 127;
        if (pp < 64) report(cnt, 13, bfv(KB, (size_t)m * AW + head * 64 + pp), (float)(a * rs)); else report(cnt, 14, bfv(VB, (size_t)m * AW + head * 64 + pp - 64), (float)(a * rs)); }
}
__global__ void __launch_bounds__(256) k_c4(const bf16_t* OA, const bf16_t* OB, const bf16_t* G, const float* w_a, const float* w_b, const bf16_t* T, unsigned* cnt) {
    const unsigned id = blockIdx.x * 256 + threadIdx.x, r = hsh(id * 2654435761u + 404u); const int m = r % MTOK, n = (r >> 16) % DM;
    double a = 0.0, b = 0.0; for (int k = 0; k < AW; ++k) { a += (double)bfv(OA, (size_t)m * AW + k) * w_a[(size_t)k * DM + n]; b += (double)bfv(OB, (size_t)m * AW + k) * w_b[(size_t)k * DM + n]; }
    report(cnt, 17, bfv(T, (size_t)m * DM + n), (float)(a * bfv(G, (size_t)m * 2 * DM + n) + b * bfv(G, (size_t)m * 2 * DM + DM + n)));
}
__global__ void __launch_bounds__(256) k_c5(const bf16_t* T, const float* w_out, const bf16_t* Y, unsigned* cnt) {
    const unsigned id = blockIdx.x * 256 + threadIdx.x, r = hsh(id * 2654435761u + 505u); const int m = r % MTOK, n = (r >> 16) % DM;
    double a = 0.0; for (int k = 0; k < DM; ++k) a += (double)bfv(T, (size_t)m * DM + k) * w_out[(size_t)k * DM + n];
    report(cnt, 18, bfv(Y, (size_t)m * DM + n), (float)a);
}
__global__ void __launch_bounds__(256) k_c6(const bf16_t* Y, const float* x, const float* g1, const float* g2, const float* x1, const bf16_t* H2, unsigned* cnt) {
    const unsigned id = blockIdx.x * 256 + threadIdx.x, r = hsh(id * 2654435761u + 606u); const int m = r % MTOK, k = (r >> 16) % DM;
    double ss = 0.0; for (int i = 0; i < DM; ++i) { const double v = bfv(Y, (size_t)m * DM + i); ss += v * v; } const double rs = 1.0 / sqrt(ss / DM + 1e-6);
    double s2 = 0.0, xk = 0.0; for (int i = 0; i < DM; ++i) { const double v = x[(size_t)m * DM + i] + bfv(Y, (size_t)m * DM + i) * rs * g1[i]; s2 += v * v; if (i == k) xk = v; }
    report(cnt, 19, x1[(size_t)m * DM + k], (float)xk);
    report(cnt, 20, bfv(H2, (size_t)m * DM + k), (float)(xk / sqrt(s2 / DM + 1e-6) * g2[k]));
}
__global__ void __launch_bounds__(256) k_c7(const bf16_t* H2, const float* w_up, const bf16_t* U, unsigned* cnt) {
    const unsigned id = blockIdx.x * 256 + threadIdx.x, r = hsh(id * 2654435761u + 707u); const int m = r % MTOK, n = (r >> 16) % DFF;
    double a = 0.0; for (int k = 0; k < DM; ++k) a += (double)bfv(H2, (size_t)m * DM + k) * w_up[(size_t)k * DFF + n];
    const float v = a > 0.0 ? (float)a : 0.f; report(cnt, 21, bfv(U, (size_t)m * DFF + n), v * v);
}
__global__ void __launch_bounds__(256) k_c8(const bf16_t* U, const float* w_dn, const bf16_t* Mo, unsigned* cnt) {
    const unsigned id = blockIdx.x * 256 + threadIdx.x, r = hsh(id * 2654435761u + 808u); const int m = r % MTOK, n = (r >> 16) % DM;
    double a = 0.0; for (int k = 0; k < DFF; ++k) a += (double)bfv(U, (size_t)m * DFF + k) * w_dn[(size_t)k * DM + n];
    report(cnt, 22, bfv(Mo, (size_t)m * DM + n), (float)a);
}
__global__ void __launch_bounds__(256) k_c9a(const bf16_t* Mo, const float* x1, const float* g, float* expv) {
    const unsigned id = blockIdx.x * 256 + threadIdx.x, r = hsh(id * 2654435761u + 909u); const int m = r % MTOK, k = (r >> 16) % DM;
    double ss = 0.0; for (int i = 0; i < DM; ++i) { const double v = bfv(Mo, (size_t)m * DM + i); ss += v * v; }
    expv[id] = (float)(x1[(size_t)m * DM + k] + bfv(Mo, (size_t)m * DM + k) / sqrt(ss / DM + 1e-6) * g[k]);
}
__global__ void __launch_bounds__(256) k_c9b(const float* out, const float* expv, unsigned* cnt) {
    const unsigned id = blockIdx.x * 256 + threadIdx.x, r = hsh(id * 2654435761u + 909u); const int m = r % MTOK, k = (r >> 16) % DM;
    report(cnt, 23, out[(size_t)m * DM + k], expv[id]);
}
__global__ void __launch_bounds__(256) k_cmp(const bf16_t* F, const bf16_t* N, int stage, unsigned* cnt) {
    const unsigned id = blockIdx.x * 256 + threadIdx.x, r = hsh(id * 2654435761u + 1234u + stage); const int m = r % MTOK, k = (r >> 16) % AW;
    report(cnt, stage, bfv(F, (size_t)m * AW + k), bfv(N, (size_t)m * AW + k));
}
__global__ void __launch_bounds__(256) k_fin(const unsigned* cnt, float* out) {
    int s = 0; for (int i = 1; i < 32; ++i) if (cnt[i] > 2u) { s = i; break; }
    if (DBG_CHECK > 100 && s) { int k = 0; for (int i = 1; i < 32; ++i) if (cnt[i] > 2u) { if (++k == DBG_CHECK - 100) { s = i; break; } } }
    size_t nz = (size_t)s * (MTOK / 25) * DM;
    if (DBG_CHECK == 2) { const double f = (double)cnt[10] / (double)(cnt[74] ? cnt[74] : 1u); nz = (size_t)(f * MTOK) * DM; }
    if (DBG_CHECK == 3) { unsigned mask = 0; for (int t = 0; t < 8; ++t) if (cnt[24 + t] > 2u) mask |= 1u << t; nz = (size_t)mask * (MTOK / 256) * DM; }
    for (size_t i = (size_t)blockIdx.x * 256 + threadIdx.x; i < nz; i += (size_t)gridDim.x * 256) out[i] = 0.f;
}
}
#endif

constexpr size_t MiB = 1u << 20;
constexpr size_t WS_CTL = 0, CTL_ZERO_BYTES = 64 * 1024;
constexpr size_t WS_ROPEA = 1 * MiB, WS_ROPEB = 5 * MiB;
constexpr size_t WS_SS = 13 * MiB, WS_SS2 = 16 * MiB, WS_SS3 = 20 * MiB;
constexpr size_t WS_WIN = 24 * MiB, WS_WUQ = 33 * MiB, WS_WUKV = 34 * MiB, WS_WA = 35 * MiB, WS_WB = 36 * MiB, WS_WOUT = 37 * MiB, WS_WUP = 39 * MiB, WS_WDN = 47 * MiB;
constexpr size_t WS_H = 64 * MiB;
constexpr size_t WS_G = 192 * MiB;
constexpr size_t WS_QA = 448 * MiB, WS_KA = 512 * MiB, WS_VA = 576 * MiB;
constexpr size_t WS_T = WS_KA;
constexpr size_t WS_CQ = 640 * MiB, WS_CKV = 688 * MiB;
constexpr size_t WS_OB = WS_CQ;
constexpr size_t WS_KR = 720 * MiB;
constexpr size_t WS_QB = 728 * MiB, WS_KB = 824 * MiB, WS_VB = 888 * MiB;
constexpr size_t WS_Y = WS_QB;
constexpr size_t WS_X1 = 856 * MiB;
constexpr size_t WS_U = 192 * MiB;
constexpr size_t WS_END = 984 * MiB;
static_assert(WS_U + (size_t)MTOK * DFF * 2 <= WS_KR && WS_Y + (size_t)MTOK * DM * 2 <= WS_VB && WS_OB + (size_t)MTOK * AW * 2 <= WS_KR && WS_T + (size_t)MTOK * DM * 2 <= WS_CQ, "d_ws map");
static_assert(WS_WIN + (size_t)INWP * DM * 2 <= WS_WUQ && WS_WDN + (size_t)DM * DFF * 2 <= WS_H && WS_VB + (size_t)MTOK * AW * 2 <= WS_END && WS_X1 + (size_t)MTOK * DM * 2 <= WS_END && WS_Y + (size_t)MTOK * DM * 2 <= WS_X1, "d_ws map");
constexpr int CW_BAR = 0;
constexpr int NWAVES = 8;
constexpr int RING_OFF = 0, RING_BYTES = 131072;
constexpr int LDSCTL_OFF = RING_BYTES, MISC_OFF = LDSCTL_OFF + 320;
constexpr int LDS_BYTES = 147456;
static_assert(att::L_END <= RING_BYTES, "attention LDS map");

struct Frame {
    LAS unsigned char* lds;
    volatile LAS unsigned* MISC;
    gu32* ctl;
    int tid, lane, wave, vcu, G;
};

__device__ __forceinline__ float wave_sum(float v) {
#pragma unroll
    for (int o = 1; o < 64; o <<= 1) v += __shfl_xor(v, o);
    return v;
}
__device__ __forceinline__ int srccol(int mat, int n) {
    if (mat == 0) {
        if (n < 1024) { const int sect = n >> 9, c = n & 511, head = c >> 6, p = c & 63; const int d = (p < 16) ? ((p >> 1) + 8 * (p & 1)) : p; return sect * 512 + head * 64 + d; }
        if (n < 1920) return n;
        if (n < 1952) { const int pr = n - 1920; return 2176 + (pr >> 1) + 16 * (pr & 1); }
        if (n < 2048) return -1;
        if (n < 2304) return 1920 + (n - 2048);
        return 2208 + (n - 2304);
    }
    if (mat == 1) { const int head = n / QKB, p = n - head * QKB; if (p < 64) return n; const int pr = p - 64; return head * QKB + 64 + (pr >> 1) + 16 * (pr & 1); }
    return n;
}
__device__ __forceinline__ void p0_transpose_item(const float* W, int K, int Nsrc, int Ndst, bf16* WT, int ldw, int koff, const float* gs, int mat, LAS float* scr, int item, int lane) {
    const int nblk = Ndst / 32, kb = item / nblk, nb = item % nblk, k0 = 64 * kb, n0 = 32 * nb;
    const int sc = srccol(mat, n0 + (lane & 31));
#pragma unroll 8
    for (int i = 0; i < 32; ++i) { const int kk = 2 * i + (lane >> 5); float v = (sc >= 0) ? W[(size_t)(k0 + kk) * Nsrc + sc] : 0.f; if (gs) v *= gs[k0 + kk]; scr[kk * 33 + (lane & 31)] = v; }
    LDS_WAIT(); asm volatile("" ::: "memory");
    const int c = lane & 7;
#pragma unroll
    for (int j = 0; j < 4; ++j) { const int n = (lane >> 3) + 8 * j; const LAS float* s = scr + (8 * c) * 33 + n;
        v4u o; o.x = pk2(s[0 * 33], s[1 * 33]); o.y = pk2(s[2 * 33], s[3 * 33]); o.z = pk2(s[4 * 33], s[5 * 33]); o.w = pk2(s[6 * 33], s[7 * 33]);
        *(GAS v4u*)(WT + (size_t)(n0 + n) * ldw + koff + k0 + 8 * c) = o; }
    LDS_WAIT(); asm volatile("" ::: "memory");
}
__device__ __forceinline__ void rms_row_to_bf16(int lane, const float* xrow, const f32x4 (&g)[4], bf16* orow) {
    const GAS f32x4* xr = (const GAS f32x4*)xrow + lane;
    f32x4 v[4]; float s = 0.f;
#pragma unroll
    for (int j = 0; j < 4; ++j) { v[j] = xr[64 * j]; s += (v[j].x * v[j].x + v[j].y * v[j].y) + (v[j].z * v[j].z + v[j].w * v[j].w); }
    const float rstd = 1.f / sqrtf(wave_sum(s) * (1.f / DM) + EPS);
    GAS unsigned long long* o8 = (GAS unsigned long long*)orow + lane;
#pragma unroll
    for (int j = 0; j < 4; ++j) { const f32x4 y = v[j] * rstd * g[j]; o8[64 * j] = (unsigned long long)pk2(y.x, y.y) | ((unsigned long long)pk2(y.z, y.w) << 32); }
}

struct Args { const float* in[17]; float* out; unsigned char* ws; int ph_lo, ph_hi, li, pad; };

__global__ void __launch_bounds__(NWAVES * 64, 2) block_fwd(Args args) {
    extern __shared__ __attribute__((aligned(16))) unsigned char lds[];
    Frame F;
    F.lds = (LAS unsigned char*)lds;
    F.MISC = (volatile LAS unsigned*)(F.lds + MISC_OFF);
    F.tid = threadIdx.x; F.lane = F.tid & 63; F.wave = __builtin_amdgcn_readfirstlane(F.tid >> 6);
    F.G = gridDim.x; { const int bx = blockIdx.x; F.vcu = (F.G % 8 == 0) ? (bx % 8) * (F.G / 8) + bx / 8 : bx; }
    unsigned char* ws = args.ws;
    F.ctl = (gu32*)(ws + WS_CTL);
    const float* x = args.in[0]; const int* positions = (const int*)args.in[1];
    const float *g_pre_mix = args.in[2], *w_in = args.in[3], *b_gate = args.in[4], *g_q = args.in[5], *w_uq = args.in[6], *g_kv = args.in[7], *w_ukv = args.in[8], *w_a = args.in[9], *w_b = args.in[10],
                *w_out = args.in[11], *g_post_mix = args.in[12], *g_pre_mlp = args.in[13], *w_up = args.in[14], *w_dn = args.in[15], *g_post_mlp = args.in[16];
    float* out = args.out;
    float* ropeA = (float*)(ws + WS_ROPEA); float* ropeB = (float*)(ws + WS_ROPEB);
    float* SS = (float*)(ws + WS_SS); float* SS2 = (float*)(ws + WS_SS2); float* SS3 = (float*)(ws + WS_SS3);
    bf16 *WIN = (bf16*)(ws + WS_WIN), *WUQ = (bf16*)(ws + WS_WUQ), *WUKV = (bf16*)(ws + WS_WUKV), *WA = (bf16*)(ws + WS_WA), *WB = (bf16*)(ws + WS_WB), *WOUT = (bf16*)(ws + WS_WOUT), *WUP = (bf16*)(ws + WS_WUP), *WDN = (bf16*)(ws + WS_WDN);
    bf16 *H = (bf16*)(ws + WS_H), *Gt = (bf16*)(ws + WS_G), *QA = (bf16*)(ws + WS_QA), *KA = (bf16*)(ws + WS_KA), *VA = (bf16*)(ws + WS_VA), *T = (bf16*)(ws + WS_T), *CQ = (bf16*)(ws + WS_CQ), *CKV = (bf16*)(ws + WS_CKV),
         *OB = (bf16*)(ws + WS_OB), *KR = (bf16*)(ws + WS_KR), *QB = (bf16*)(ws + WS_QB), *KB = (bf16*)(ws + WS_KB), *VB = (bf16*)(ws + WS_VB), *Y = (bf16*)(ws + WS_Y), *U = (bf16*)(ws + WS_U), *X1B = (bf16*)(ws + WS_X1);
    for (int u = F.tid; u < (LDS_BYTES - LDSCTL_OFF) / 4; u += NWAVES * 64) ((LAS unsigned*)(F.lds + LDSCTL_OFF))[u] = 0u;
    __syncthreads();
    XcdBarrier bar = xcd_barrier_post((unsigned*)(F.ctl + CW_BAR) + args.li * XCD_BAR_WORDS, F.MISC + 8);
    const int lo = args.ph_lo, hi = args.ph_hi;
#define IN(k) (lo <= (k) && (k) < hi)
#define SEAM(k) do { if (IN(k) && IN((k) + 1)) xcd_barrier(bar); } while (0)
    const int gw = F.vcu * NWAVES + F.wave, NGW = F.G * NWAVES;

#if !defined(SKIP_P0)
    if (IN(0))
    {
        LAS float* scr = (LAS float*)(F.lds + RING_OFF + F.wave * 16384);
        constexpr int I0 = (DM / 64) * (INWP / 32), I1 = (QLORA / 64) * (768 / 32), I2 = (KVLORA / 64) * (1024 / 32), I3 = (AW / 64) * (DM / 32), I5 = (DM / 64) * (DM / 32), I6 = (DM / 64) * (DFF / 32), I7 = (DFF / 64) * (DM / 32);
        constexpr int NITEMS = I0 + I1 + I2 + 2 * I3 + I5 + I6 + I7;
        for (int it = gw; it < NITEMS; it += NGW) {
            int r = it;
            if (r < I0) { p0_transpose_item(w_in, DM, INW, INWP, WIN, DM, 0, nullptr, 0, scr, r, F.lane); continue; } r -= I0;
            if (r < I1) { p0_transpose_item(w_uq, QLORA, 768, 768, WUQ, QLORA, 0, g_q, 1, scr, r, F.lane); continue; } r -= I1;
            if (r < I2) { p0_transpose_item(w_ukv, KVLORA, 1024, 1024, WUKV, KVLORA, 0, g_kv, 2, scr, r, F.lane); continue; } r -= I2;
            if (r < I3) { p0_transpose_item(w_a, AW, DM, DM, WA, DM, 0, nullptr, 2, scr, r, F.lane); continue; } r -= I3;
            if (r < I3) { p0_transpose_item(w_b, AW, DM, DM, WA, DM, AW, nullptr, 2, scr, r, F.lane); continue; } r -= I3;
            if (r < I5) { p0_transpose_item(w_out, DM, DM, DM, WOUT, DM, 0, nullptr, 2, scr, r, F.lane); continue; } r -= I5;
            if (r < I6) { p0_transpose_item(w_up, DM, DFF, DFF, WUP, DM, 0, nullptr, 2, scr, r, F.lane); continue; } r -= I6;
            p0_transpose_item(w_dn, DFF, DM, DM, WDN, DFF, 0, nullptr, 2, scr, r, F.lane);
        }
        for (int idx = (int)blockIdx.x * (NWAVES * 64) + F.tid; idx < MTOK * 24; idx += F.G * NWAVES * 64) {
            const int m = idx / 24, i = idx - m * 24;
            const float invf = (i < 8) ? __builtin_amdgcn_exp2f(-(float)i * 2.3664460711655217f) : __builtin_amdgcn_exp2f(-(float)(i - 8) * 1.1832230355827609f);
            const float ang = (float)positions[m] * invf;
            double t = (double)ang * 0.15915494309189535; t -= floor(t);
            const float tf = (float)t; const float c = __builtin_amdgcn_cosf(tf), s = __builtin_amdgcn_sinf(tf);
            float* dst = (i < 8) ? ropeA + (size_t)m * 16 + 2 * i : ropeB + (size_t)m * 32 + 2 * (i - 8);
            *(f32x2g*)dst = (f32x2g){c, s};
        }
        f32x4 g[4];
#pragma unroll
        for (int j = 0; j < 4; ++j) g[j] = ((const GAS f32x4*)g_pre_mix)[F.lane + 64 * j];
        for (int m = gw; m < MTOK; m += NGW) rms_row_to_bf16(F.lane, x + (size_t)m * DM, g, H + (size_t)m * DM);
    }
#endif
    SEAM(0);

#if !defined(SKIP_P1)
    if (IN(1))
    {
        pg8::Gemm g{H, WIN, MTOK, INWP, DM}; pg8::StaticOrder S; S.init(MTOK, INWP, F.G, (int)blockIdx.x);
        pg8::EpiIn E{QA, KA, VA, CQ, CKV, KR, Gt, SS, ropeA, ropeB, b_gate};
        pg8::gemm_phase<pg8::EpiIn, pg8::StaticOrder, true, true>(F.lds + RING_OFF, g, S, E);
    }
#endif
    SEAM(1);

#if !defined(SKIP_P2)
    if (IN(2)) {
    {
        pg8::Gemm g{CQ, WUQ, MTOK, NHEAD * QKB, QLORA}; pg8::StaticOrder S; S.init(MTOK, NHEAD * QKB, F.G, (int)blockIdx.x);
        pg8::EpiQ E{QB, SS, ropeB};
        pg8::gemm_phase<pg8::EpiQ, pg8::StaticOrder, true, true>(F.lds + RING_OFF, g, S, E);
    }
    {
        pg8::Gemm g{CKV, WUKV, MTOK, 2 * AW, KVLORA}; pg8::StaticOrder S; S.init(MTOK, 2 * AW, F.G, (int)blockIdx.x);
        pg8::EpiKV E{KB, VB, SS};
        pg8::gemm_phase<pg8::EpiKV, pg8::StaticOrder, true, true>(F.lds + RING_OFF, g, S, E);
    }
    }
#endif
    SEAM(2);

#if !defined(SKIP_P3)
    if (IN(3))
    {
        LAS char* al = (LAS char*)(F.lds + RING_OFF);
#if !defined(SKIP_MOBA) && !(defined(DBG_NAIVE_ATTN) && (DBG_NAIVE_ATTN & 1))
        for (int bh = F.vcu; bh < NB * NHEAD; bh += F.G) {
            const int b = bh >> 3, h = bh & 7; const size_t r0 = (size_t)b * SEQ;
            att::kmean_blocks(KA + r0 * AW + h * HD, al);
#pragma unroll 1
            for (int qb = 0; qb < 8; ++qb)
                att::attn_unit<64, true>(QA + (r0 + qb * 256) * AW + h * HD, AW, KA + r0 * AW + h * HD, nullptr, VA + r0 * AW + h * HD, H + (r0 + qb * 256) * DM + h * HD, DM, qb, al);
        }
#endif
#if !defined(SKIP_MLA) && !(defined(DBG_NAIVE_ATTN) && (DBG_NAIVE_ATTN & 2))
        for (int bh = F.vcu; bh < NB * NHEAD; bh += F.G) {
            const int b = bh >> 3, h = bh & 7; const size_t r0 = (size_t)b * SEQ;
#pragma unroll 1
            for (int qb = 0; qb < 8; ++qb)
                att::attn_unit<96, false>(QB + (r0 + qb * 256) * (NHEAD * QKB) + h * QKB, NHEAD * QKB, KB + r0 * AW + h * HD, KR + r0 * RDIM, VB + r0 * AW + h * HD, H + (r0 + qb * 256) * DM + AW + h * HD, DM, qb, al);
        }
#endif
    }
#endif
    SEAM(3);

#if !defined(SKIP_P4)
    if (IN(4))
    {
        pg8::Gemm g{H, WA, MTOK, DM, DM}; pg8::StaticOrder S; S.init(MTOK, DM, F.G, (int)blockIdx.x);
        pg8::EpiMerge E{Gt, T};
        pg8::gemm_phase<pg8::EpiMerge, pg8::StaticOrder, true, true>(F.lds + RING_OFF, g, S, E);
    }
#endif
    SEAM(4);

#if !defined(SKIP_P5)
    if (IN(5))
    {
        pg8::Gemm g{T, WOUT, MTOK, DM, DM}; pg8::StaticOrder S; S.init(MTOK, DM, F.G, (int)blockIdx.x);
        pg8::EpiSS E{Y, SS2};
        pg8::gemm_phase<pg8::EpiSS, pg8::StaticOrder, true, true>(F.lds + RING_OFF, g, S, E);
    }
#endif
    SEAM(5);

#if !defined(SKIP_P6)
    if (IN(6))
    {
        f32x4 g1[4], g2[4];
#pragma unroll
        for (int j = 0; j < 4; ++j) { g1[j] = ((const GAS f32x4*)g_post_mix)[F.lane + 64 * j]; g2[j] = ((const GAS f32x4*)g_pre_mlp)[F.lane + 64 * j]; }
        for (int m = gw; m < MTOK; m += NGW) {
            const GAS f32x4* sp = (const GAS f32x4*)(SS2 + (size_t)m * 16); const f32x4 a = sp[0], b = sp[1], c = sp[2], d = sp[3];
            const float ssy = (((a.x + a.y) + (a.z + a.w)) + ((b.x + b.y) + (b.z + b.w))) + (((c.x + c.y) + (c.z + c.w)) + ((d.x + d.y) + (d.z + d.w)));
            const float rsy = 1.f / sqrtf(ssy * (1.f / DM) + EPS);
            const GAS f32x4* xr = (const GAS f32x4*)(x + (size_t)m * DM) + F.lane; const GAS unsigned long long* yr = (const GAS unsigned long long*)(Y + (size_t)m * DM) + F.lane;
            GAS unsigned long long* x8 = (GAS unsigned long long*)(X1B + (size_t)m * DM) + F.lane;
            f32x4 v[4]; float s = 0.f;
#pragma unroll
            for (int j = 0; j < 4; ++j) { const unsigned long long yw = yr[64 * j]; const unsigned lo = (unsigned)yw, hi = (unsigned)(yw >> 32);
                const f32x4 yv = (f32x4){__uint_as_float(lo << 16), __uint_as_float(lo & 0xffff0000u), __uint_as_float(hi << 16), __uint_as_float(hi & 0xffff0000u)};
                v[j] = xr[64 * j] + yv * rsy * g1[j]; x8[64 * j] = (unsigned long long)pk2(v[j].x, v[j].y) | ((unsigned long long)pk2(v[j].z, v[j].w) << 32);
                s += (v[j].x * v[j].x + v[j].y * v[j].y) + (v[j].z * v[j].z + v[j].w * v[j].w); }
            const float rstd = 1.f / sqrtf(wave_sum(s) * (1.f / DM) + EPS);
            GAS unsigned long long* o8 = (GAS unsigned long long*)(H + (size_t)m * DM) + F.lane;
#pragma unroll
            for (int j = 0; j < 4; ++j) { const f32x4 y2 = v[j] * rstd * g2[j]; o8[64 * j] = (unsigned long long)pk2(y2.x, y2.y) | ((unsigned long long)pk2(y2.z, y2.w) << 32); }
        }
    }
#endif
    SEAM(6);

#if !defined(SKIP_P7)
    if (IN(7))
    {
        pg8::Gemm g{H, WUP, MTOK, DFF, DM}; pg8::StaticOrder S; S.init(MTOK, DFF, F.G, (int)blockIdx.x);
        pg8::EpiRelu2 E{U};
        pg8::gemm_phase<pg8::EpiRelu2, pg8::StaticOrder, true, true>(F.lds + RING_OFF, g, S, E);
    }
#endif
    SEAM(7);

#if !defined(SKIP_P8)
    if (IN(8))
    {
        pg8::Gemm g{U, WDN, MTOK, DM, DFF}; pg8::StaticOrder S; S.init(MTOK, DM, F.G, (int)blockIdx.x);
        pg8::EpiSS E{H, SS3};
        pg8::gemm_phase<pg8::EpiSS, pg8::StaticOrder, true, true>(F.lds + RING_OFF, g, S, E);
    }
#endif
    SEAM(8);

#if !defined(SKIP_P9)
    if (IN(9))
    {
        f32x4 g1[4];
#pragma unroll
        for (int j = 0; j < 4; ++j) g1[j] = ((const GAS f32x4*)g_post_mlp)[F.lane + 64 * j];
        for (int m = gw; m < MTOK; m += NGW) {
            const GAS f32x4* sp = (const GAS f32x4*)(SS3 + (size_t)m * 16); const f32x4 a = sp[0], b = sp[1], c = sp[2], d = sp[3];
            const float ssy = (((a.x + a.y) + (a.z + a.w)) + ((b.x + b.y) + (b.z + b.w))) + (((c.x + c.y) + (c.z + c.w)) + ((d.x + d.y) + (d.z + d.w)));
            const float rsy = 1.f / sqrtf(ssy * (1.f / DM) + EPS);
            const GAS unsigned long long* yr = (const GAS unsigned long long*)(H + (size_t)m * DM) + F.lane;
            const GAS unsigned long long* xq = (const GAS unsigned long long*)(X1B + (size_t)m * DM) + F.lane;
            GAS f32x4* o4 = (GAS f32x4*)(out + (size_t)m * DM) + F.lane;
#pragma unroll
            for (int j = 0; j < 4; ++j) { const unsigned long long yw = yr[64 * j]; const unsigned lo = (unsigned)yw, hi = (unsigned)(yw >> 32);
                const f32x4 yv = (f32x4){__uint_as_float(lo << 16), __uint_as_float(lo & 0xffff0000u), __uint_as_float(hi << 16), __uint_as_float(hi & 0xffff0000u)};
                const unsigned long long xw = xq[64 * j]; const unsigned xl = (unsigned)xw, xh = (unsigned)(xw >> 32);
                const f32x4 xv = (f32x4){__uint_as_float(xl << 16), __uint_as_float(xl & 0xffff0000u), __uint_as_float(xh << 16), __uint_as_float(xh & 0xffff0000u)};
                o4[64 * j] = xv + yv * rsy * g1[j]; }
        }
    }
#endif
}

extern "C" void kernel_launch(void* const* d_in, const int* in_sizes, int n_in, void* d_out, int out_size, void* d_ws, size_t ws_size, hipStream_t stream) {
    static int grid = 0;
    if (grid == 0) {
        if (n_in != 17 || in_sizes[0] != MTOK * DM || out_size != MTOK * DM || ws_size < WS_END) { fprintf(stderr, "kernel_launch: unexpected shapes (n_in %d, in0 %d, out %d, ws %zu); nothing launched\n", n_in, n_in > 0 ? in_sizes[0] : -1, out_size, ws_size); grid = -1; return; }
        int dev = 0, cus = 0, per_cu = 0;
        if (hipGetDevice(&dev) != hipSuccess || hipDeviceGetAttribute(&cus, hipDeviceAttributeMultiprocessorCount, dev) != hipSuccess) { fprintf(stderr, "kernel_launch: device query failed\n"); grid = -1; return; }
        if (hipFuncSetAttribute((const void*)block_fwd, hipFuncAttributeMaxDynamicSharedMemorySize, LDS_BYTES) != hipSuccess) { fprintf(stderr, "kernel_launch: hipFuncSetAttribute failed\n"); grid = -1; return; }
        if (hipOccupancyMaxActiveBlocksPerMultiprocessor(&per_cu, (const void*)block_fwd, NWAVES * 64, LDS_BYTES) != hipSuccess || per_cu < 1) { fprintf(stderr, "kernel_launch: occupancy query reports %d workgroups per CU\n", per_cu); }
        (void)hipGetLastError();
        grid = cus;
    }
    if (grid < 0) return;
    if (hipMemsetAsync((char*)d_ws + WS_CTL, 0, CTL_ZERO_BYTES, stream) != hipSuccess) { fprintf(stderr, "kernel_launch: hipMemsetAsync failed\n"); return; }
    Args a{};
    for (int i = 0; i < 17; ++i) a.in[i] = (const float*)d_in[i];
    a.out = (float*)d_out; a.ws = (unsigned char*)d_ws;
#if defined(DBG_CHECK)
    {
        unsigned char* ws = (unsigned char*)d_ws; unsigned* cnt = (unsigned*)(ws + WS_CTL + 32768); float* expv = (float*)(ws + 60 * MiB); float* KM = (float*)(ws + 61 * MiB);
        const float* const* in = (const float* const*)a.in; const int* pos = (const int*)in[1];
        bf16 *H = (bf16*)(ws + WS_H), *Gt = (bf16*)(ws + WS_G), *QA = (bf16*)(ws + WS_QA), *KA = (bf16*)(ws + WS_KA), *VA = (bf16*)(ws + WS_VA), *T = (bf16*)(ws + WS_T), *CQ = (bf16*)(ws + WS_CQ), *CKV = (bf16*)(ws + WS_CKV),
             *OB = (bf16*)(ws + WS_OB), *KR = (bf16*)(ws + WS_KR), *QB = (bf16*)(ws + WS_QB), *KB = (bf16*)(ws + WS_KB), *VB = (bf16*)(ws + WS_VB), *Y = (bf16*)(ws + WS_Y), *U = (bf16*)(ws + WS_U);
        bf16 *NA = (bf16*)(ws + WS_H), *NBo = (bf16*)(ws + WS_H + 64 * MiB);
        auto L = [&](int lo, int hi) { a.ph_lo = lo; a.ph_hi = hi; a.li = 0; hipLaunchKernelGGL(block_fwd, dim3(grid), dim3(NWAVES * 64), LDS_BYTES, stream, a); };
        const dim3 cg(chk::NS / 256), cb(256);
        L(0, 1); hipLaunchKernelGGL(chk::k_c0, cg, cb, 0, stream, in[0], in[2], (const bf16*)H, cnt);
        L(1, 2); hipLaunchKernelGGL(chk::k_c1, cg, cb, 0, stream, (const bf16*)H, in[3], in[4], pos, (const bf16*)QA, (const bf16*)KA, (const bf16*)VA, (const bf16*)CQ, (const bf16*)CKV, (const bf16*)KR, (const bf16*)Gt, cnt);
        L(2, 3); hipLaunchKernelGGL(chk::k_c2, cg, cb, 0, stream, (const bf16*)CQ, (const bf16*)CKV, in[5], in[6], in[7], in[8], pos, (const bf16*)QB, (const bf16*)KB, (const bf16*)VB, cnt);
        hipLaunchKernelGGL(dbg::kmean_k, dim3(256), dim3(512), 0, stream, (const bf16*)KA, KM);
        hipLaunchKernelGGL((dbg::attn_k<64, true>), dim3(32, 256), dim3(256), 0, stream, (const bf16*)QA, (const bf16*)KA, (const bf16*)nullptr, (const bf16*)VA, NA, (const float*)KM);
        hipLaunchKernelGGL((dbg::attn_k<96, false>), dim3(32, 256), dim3(256), 0, stream, (const bf16*)QB, (const bf16*)KB, (const bf16*)KR, (const bf16*)VB, NBo, (const float*)KM);
        L(3, 4); hipLaunchKernelGGL(chk::k_cmp, cg, cb, 0, stream, (const bf16*)QA, (const bf16*)NA, 15, cnt); hipLaunchKernelGGL(chk::k_cmp, cg, cb, 0, stream, (const bf16*)OB, (const bf16*)NBo, 16, cnt);
        L(4, 5); hipLaunchKernelGGL(chk::k_c4, cg, cb, 0, stream, (const bf16*)QA, (const bf16*)OB, (const bf16*)Gt, in[9], in[10], (const bf16*)T, cnt);
        L(5, 6); hipLaunchKernelGGL(chk::k_c5, cg, cb, 0, stream, (const bf16*)T, in[11], (const bf16*)Y, cnt);
        L(6, 7); hipLaunchKernelGGL(chk::k_c6, cg, cb, 0, stream, (const bf16*)Y, in[0], in[12], in[13], (const float*)d_out, (const bf16*)H, cnt);
        L(7, 8); hipLaunchKernelGGL(chk::k_c7, cg, cb, 0, stream, (const bf16*)H, in[14], (const bf16*)U, cnt);
        L(8, 9); hipLaunchKernelGGL(chk::k_c8, cg, cb, 0, stream, (const bf16*)U, in[15], (const bf16*)H, cnt);
        hipLaunchKernelGGL(chk::k_c9a, cg, cb, 0, stream, (const bf16*)H, (const float*)d_out, in[16], expv);
        L(9, 10); hipLaunchKernelGGL(chk::k_c9b, cg, cb, 0, stream, (const float*)d_out, (const float*)expv, cnt);
        hipLaunchKernelGGL(chk::k_fin, dim3(1024), dim3(256), 0, stream, (const unsigned*)cnt, (float*)d_out);
    }
#elif defined(DBG_NAIVE_ATTN)
    a.ph_lo = 0; a.ph_hi = (DBG_NAIVE_ATTN == 3) ? 3 : 4; a.li = 0;
    hipLaunchKernelGGL(block_fwd, dim3(grid), dim3(NWAVES * 64), LDS_BYTES, stream, a);
    { unsigned char* ws = (unsigned char*)d_ws; float* KM = (float*)(ws + WS_SS3);
      if (DBG_NAIVE_ATTN & 1) { hipLaunchKernelGGL(dbg::kmean_k, dim3(256), dim3(512), 0, stream, (const bf16*)(ws + WS_KA), KM);
          hipLaunchKernelGGL((dbg::attn_k<64, true>), dim3(32, 256), dim3(256), 0, stream, (const bf16*)(ws + WS_QA), (const bf16*)(ws + WS_KA), (const bf16*)nullptr, (const bf16*)(ws + WS_VA), (bf16*)(ws + WS_QA), (const float*)KM); }
      if (DBG_NAIVE_ATTN & 2) hipLaunchKernelGGL((dbg::attn_k<96, false>), dim3(32, 256), dim3(256), 0, stream, (const bf16*)(ws + WS_QB), (const bf16*)(ws + WS_KB), (const bf16*)(ws + WS_KR), (const bf16*)(ws + WS_VB), (bf16*)(ws + WS_OB), (const float*)KM); }
    a.ph_lo = 4; a.ph_hi = 10; a.li = 1;
    hipLaunchKernelGGL(block_fwd, dim3(grid), dim3(NWAVES * 64), LDS_BYTES, stream, a);
#else
    a.ph_lo = 0; a.ph_hi = 10; a.li = 0;
    hipLaunchKernelGGL(block_fwd, dim3(grid), dim3(NWAVES * 64), LDS_BYTES, stream, a);
#endif
    const hipError_t le = hipPeekAtLastError();
    if (le != hipSuccess) fprintf(stderr, "kernel_launch: launch failed: %s\n", hipGetErrorName(le));
}
```

```cpp
#include <hip/hip_runtime.h>
#include <hip/hip_bf16.h>
#include <cstdio>
#include <cstdint>
#include <cmath>
constexpr int NB = 32, SEQ = 2048, DM = 1024, MTOK = NB * SEQ;
constexpr int NHEAD = 8, HD = 64, AW = NHEAD * HD;
constexpr int QLORA = 384, KVLORA = 256, RDIM = 32, QKB = 96;
constexpr int DFF = 4096, INW = 4256, INWP = 4352;
constexpr float EPS = 1e-6f;
constexpr float LOG2E = 1.4426950408889634f;
constexpr float C2A = 0.125f * LOG2E;
constexpr float C2B = 0.10206207261596575f * LOG2E;
typedef float f32x2g __attribute__((ext_vector_type(2)));
namespace pg8 {
#define PG8_LAS __attribute__((address_space(3)))
typedef unsigned short bf16_t;
typedef short bf16x8 __attribute__((ext_vector_type(8)));
typedef float f32x4 __attribute__((ext_vector_type(4)));
typedef unsigned u32x4 __attribute__((ext_vector_type(4)));
constexpr int BM = 256, BK = 64, HALF = 128, HTB = HALF * BK * 2  , STAGE_BYTES = 8 * HTB, NXCD = 8, WGM = 8;

__host__ __device__ __forceinline__ int lds_byte(int r, int c) { const int st = (r >> 4) * 2 + (c >> 5), rr = r & 15, cc = c & 31, ob = rr * 64 + cc * 2; return st * 1024 + (ob ^ (((ob >> 9) & 1) << 5)); }
__host__ __device__ __forceinline__ void stage_rc(int b, int& R, int& C) { const int st = b / 1024, sb = b % 1024, swz = sb ^ (((sb >> 9) & 1) << 5); R = (st >> 1) * 16 + swz / 64; C = (st & 1) * 32 + (swz % 64) / 2; }
__host__ __device__ __forceinline__ int perm32(int rho) { const int n = rho >> 4, i = rho & 15; return 8 * (i >> 2) + 4 * n + (i & 3); }

struct Unit { int pm, pn; };
struct Gemm { const bf16_t* A; const bf16_t* Bt; int M, N, K, lda, ldb; };

struct StaticOrder {
    int nM, nN, nwg, G, c;
    __host__ __device__ void init(int M, int N, int G_, int c_) { nM = M / BM; nN = N / BM; nwg = nM * nN; G = G_; c = c_; }
    __host__ __device__ bool next(int i, Unit& u) const {
        const long L = (long)i * G + c; if (L >= nwg) return false;
        int wgid = (int)L; { const int q = nwg / NXCD, r = nwg % NXCD, xcd = wgid % NXCD, off = wgid / NXCD; wgid = (xcd < r ? xcd * (q + 1) : r * (q + 1) + (xcd - r) * q) + off; }
        const int nig = WGM * nN, gid = wgid / nig, fm = gid * WGM, gsz = (nM - fm) < WGM ? (nM - fm) : WGM;
        u.pm = fm + ((wgid % nig) % gsz); u.pn = (wgid % nig) / gsz; return true;
    }
    __device__ __forceinline__ void a_ready(const Unit&) const {}
    __device__ __forceinline__ void done(const Unit&) const {}
};

__device__ __forceinline__ unsigned cvt_pk_bf16(float lo, float hi) { unsigned r; asm volatile("v_cvt_pk_bf16_f32 %0, %1, %2" : "=v"(r) : "v"(lo), "v"(hi)); return r; }
__device__ __forceinline__ void ld8(float (&v)[8], const f32x4& a, const f32x4& b) { v[0] = a[0]; v[1] = a[1]; v[2] = a[2]; v[3] = a[3]; v[4] = b[0]; v[5] = b[1]; v[6] = b[2]; v[7] = b[3]; }
typedef float f32x2c_t __attribute__((ext_vector_type(2))); typedef __bf16 bf16x2c_t __attribute__((ext_vector_type(2)));
__device__ __forceinline__ unsigned cvtpk_c(float lo, float hi) { const f32x2c_t v = {lo, hi}; const bf16x2c_t b = __builtin_convertvector(v, bf16x2c_t); return __builtin_bit_cast(unsigned, b); }
__device__ __forceinline__ u32x4 pack8(const float (&v)[8]) { u32x4 w; w.x = cvtpk_c(v[0], v[1]); w.y = cvtpk_c(v[2], v[3]); w.z = cvtpk_c(v[4], v[5]); w.w = cvtpk_c(v[6], v[7]); return w; }
__device__ __forceinline__ void unpack8(const u32x4 w, float (&v)[8]) {
    v[0] = __uint_as_float(w.x << 16); v[1] = __uint_as_float(w.x & 0xffff0000u); v[2] = __uint_as_float(w.y << 16); v[3] = __uint_as_float(w.y & 0xffff0000u);
    v[4] = __uint_as_float(w.z << 16); v[5] = __uint_as_float(w.z & 0xffff0000u); v[6] = __uint_as_float(w.w << 16); v[7] = __uint_as_float(w.w & 0xffff0000u); }
__device__ __forceinline__ void rope4(float (&v)[8], const f32x4 a, const f32x4 b) {
    float x1, x2;
    x1 = v[0]; x2 = v[1]; v[0] = x1 * a[0] - x2 * a[1]; v[1] = x2 * a[0] + x1 * a[1];
    x1 = v[2]; x2 = v[3]; v[2] = x1 * a[2] - x2 * a[3]; v[3] = x2 * a[2] + x1 * a[3];
    x1 = v[4]; x2 = v[5]; v[4] = x1 * b[0] - x2 * b[1]; v[5] = x2 * b[0] + x1 * b[1];
    x1 = v[6]; x2 = v[7]; v[6] = x1 * b[2] - x2 * b[3]; v[7] = x2 * b[2] + x1 * b[3];
}
__device__ __forceinline__ float sumsq8(const float (&v)[8]) { return ((v[0] * v[0] + v[1] * v[1]) + (v[2] * v[2] + v[3] * v[3])) + ((v[4] * v[4] + v[5] * v[5]) + (v[6] * v[6] + v[7] * v[7])); }
__device__ __forceinline__ float red_fq(float s) { s += __shfl_xor(s, 16); s += __shfl_xor(s, 32); return s; }

__device__ __forceinline__ size_t gfrag_off(int pm, int t8, int wid, int grp, int lane) { return ((((size_t)(pm * 8 + t8) * 8 + wid) * 16 + grp) * 64 + lane) * 8; }
struct EpiIn {
    static constexpr bool PERM = true, AFTER_DRAIN = false; static constexpr int MIDT = 0;
    bf16_t *QA, *KA, *VA, *CQ, *CKV, *KR, *G; float* SS; const float* ropeA; const float* ropeB; const float* bgate;
    __device__ __forceinline__ void operator()(const f32x4 (&acc)[2][2][4][2], const Unit& u, int wr, int wc, int fr, int fq) const {
        asm volatile("" : "+v"(fr), "+v"(fq));
        const int row0 = u.pm * BM + wr * 64 + fr, pn = u.pn, cl = wc * 32 + 8 * fq;
        if (pn < 4) {
            bf16_t* dst = (pn < 2) ? QA : KA; const float sc = (pn < 2) ? C2A : 1.f; const int cb = (pn & 1) * 256 + cl;
            if ((wc & 1) == 0) {
                const bool rp = fq < 2;
#pragma unroll
                for (int ai = 0; ai < 2; ++ai)
#pragma unroll
                    for (int m = 0; m < 4; ++m) { const int row = row0 + ai * HALF + m * 16;
                        const f32x4* t = (const f32x4*)(ropeA + (size_t)row * 16 + (rp ? fq * 8 : 0));
                        f32x4 ca = t[0], cc = t[1]; if (!rp) { ca = (f32x4){1.f, 0.f, 1.f, 0.f}; cc = ca; }
#pragma unroll
                        for (int bj = 0; bj < 2; ++bj) { float v[8]; ld8(v, acc[ai][bj][m][0], acc[ai][bj][m][1]); rope4(v, ca, cc);
#pragma unroll
                            for (int j = 0; j < 8; ++j) v[j] *= sc;
                            *(u32x4*)(dst + (size_t)row * AW + cb + bj * HALF) = pack8(v); } }
            } else {
#pragma unroll
                for (int ai = 0; ai < 2; ++ai)
#pragma unroll
                    for (int m = 0; m < 4; ++m) { const int row = row0 + ai * HALF + m * 16;
#pragma unroll
                        for (int bj = 0; bj < 2; ++bj) { float v[8]; ld8(v, acc[ai][bj][m][0], acc[ai][bj][m][1]);
#pragma unroll
                            for (int j = 0; j < 8; ++j) v[j] *= sc;
                            *(u32x4*)(dst + (size_t)row * AW + cb + bj * HALF) = pack8(v); } }
            }
        } else if (pn < 6) {
            const int cb = (pn - 4) * 256 + cl;
#pragma unroll
            for (int ai = 0; ai < 2; ++ai)
#pragma unroll
                for (int m = 0; m < 4; ++m) { const int row = row0 + ai * HALF + m * 16;
#pragma unroll
                    for (int bj = 0; bj < 2; ++bj) { float v[8]; ld8(v, acc[ai][bj][m][0], acc[ai][bj][m][1]); *(u32x4*)(VA + (size_t)row * AW + cb + bj * HALF) = pack8(v); } }
        } else if (pn == 6 || pn == 8) {
            bf16_t* dst = (pn == 6) ? CQ : CKV; const int ld = (pn == 6) ? QLORA : KVLORA, slot = ((pn == 6) ? 0 : 8) + wc;
#pragma unroll
            for (int ai = 0; ai < 2; ++ai)
#pragma unroll
                for (int m = 0; m < 4; ++m) { const int row = row0 + ai * HALF + m * 16; float s = 0.f;
#pragma unroll
                    for (int bj = 0; bj < 2; ++bj) { float v[8]; ld8(v, acc[ai][bj][m][0], acc[ai][bj][m][1]); s += sumsq8(v); *(u32x4*)(dst + (size_t)row * ld + cl + bj * HALF) = pack8(v); }
                    s = red_fq(s); if (fq == 0) SS[(size_t)row * 12 + slot] = s; }
        } else if (pn == 7) {
#pragma unroll
            for (int ai = 0; ai < 2; ++ai)
#pragma unroll
                for (int m = 0; m < 4; ++m) { const int row = row0 + ai * HALF + m * 16;
                    { float v[8]; ld8(v, acc[ai][0][m][0], acc[ai][0][m][1]); float s = red_fq(sumsq8(v)); *(u32x4*)(CQ + (size_t)row * QLORA + 256 + cl) = pack8(v); if (fq == 0) SS[(size_t)row * 12 + 4 + wc] = s; }
                    if (wc == 0) { float v[8]; ld8(v, acc[ai][1][m][0], acc[ai][1][m][1]); const f32x4* t = (const f32x4*)(ropeB + (size_t)row * 32 + fq * 8); rope4(v, t[0], t[1]);
                        *(u32x4*)(KR + (size_t)row * RDIM + 8 * fq) = pack8(v); } }
        } else {
            const int gc = (pn - 9) * 256 + cl;
            f32x4 bv[2][2];
#pragma unroll
            for (int bj = 0; bj < 2; ++bj)
#pragma unroll
                for (int n = 0; n < 2; ++n) bv[bj][n] = *(const f32x4*)(bgate + gc + bj * HALF + 4 * n);
#pragma unroll
            for (int ai = 0; ai < 2; ++ai)
#pragma unroll
                for (int m = 0; m < 4; ++m) { const int row = row0 + ai * HALF + m * 16;
#pragma unroll
                    for (int bj = 0; bj < 2; ++bj) { float v[8]; ld8(v, acc[ai][bj][m][0] + bv[bj][0], acc[ai][bj][m][1] + bv[bj][1]);
#pragma unroll
                        for (int j = 0; j < 8; ++j) v[j] = __builtin_amdgcn_rcpf(1.f + __builtin_amdgcn_exp2f(-LOG2E * v[j]));
                        *(u32x4*)(G + gfrag_off(u.pm, pn - 9, wr * 4 + wc, ai * 8 + m * 2 + bj, fq * 16 + fr)) = pack8(v); } }
        }
    }
};
struct EpiQ {
    static constexpr bool PERM = true, AFTER_DRAIN = false; static constexpr int MIDT = 0;
    bf16_t* QB; const float* SS; const float* ropeB;
    __device__ __forceinline__ void operator()(const f32x4 (&acc)[2][2][4][2], const Unit& u, int wr, int wc, int fr, int fq) const {
        asm volatile("" : "+v"(fr), "+v"(fq));
        const int row0 = u.pm * BM + wr * 64 + fr, cl = u.pn * BM + wc * 32 + 8 * fq;
        const int c0 = cl, c1 = cl + HALF, h0 = c0 / QKB, h1 = c1 / QKB, p0 = c0 - h0 * QKB, p1 = c1 - h1 * QKB;
        const bool r0 = p0 >= 64, r1 = p1 >= 64; const int roff = r0 ? p0 - 64 : (r1 ? p1 - 64 : 0);
#pragma unroll
        for (int b = 0; b < 2; ++b) {
            f32x4 s0[4], s1[4], ta[4], tb[4];
#pragma unroll
            for (int m = 0; m < 4; ++m) { const int row = row0 + b * HALF + m * 16;
                const f32x4* sp = (const f32x4*)(SS + (size_t)row * 12); s0[m] = sp[0]; s1[m] = sp[1];
                const f32x4* t = (const f32x4*)(ropeB + (size_t)row * 32 + roff); ta[m] = t[0]; tb[m] = t[1]; }
            asm volatile("" ::: "memory");
#pragma unroll
            for (int m = 0; m < 4; ++m) { const int row = row0 + b * HALF + m * 16;
                const float ss = ((s0[m][0] + s0[m][1]) + (s0[m][2] + s0[m][3])) + ((s1[m][0] + s1[m][1]) + (s1[m][2] + s1[m][3]));
                const float rs = __builtin_amdgcn_rsqf(ss * (1.0f / QLORA) + EPS) * C2B;
#pragma unroll
                for (int bj = 0; bj < 2; ++bj) { float v[8]; ld8(v, acc[b][bj][m][0], acc[b][bj][m][1]);
#pragma unroll
                    for (int j = 0; j < 8; ++j) v[j] *= rs;
                    if (bj == 0 ? r0 : r1) rope4(v, ta[m], tb[m]);
                    *(u32x4*)(QB + (size_t)row * (NHEAD * QKB) + (bj == 0 ? c0 : c1)) = pack8(v); } }
        }
    }
};
struct EpiKV {
    static constexpr bool PERM = true, AFTER_DRAIN = false; static constexpr int MIDT = 0;
    bf16_t *KB, *VB; const float* SS;
    __device__ __forceinline__ void operator()(const f32x4 (&acc)[2][2][4][2], const Unit& u, int wr, int wc, int fr, int fq) const {
        asm volatile("" : "+v"(fr), "+v"(fq));
        const int row0 = u.pm * BM + wr * 64 + fr;
        bf16_t* dst = (wc < 2) ? KB : VB; const int pc = (wc & 1) * 32 + 8 * fq;
        f32x4 s0[2][4];
#pragma unroll
        for (int ai = 0; ai < 2; ++ai)
#pragma unroll
            for (int m = 0; m < 4; ++m) s0[ai][m] = *(const f32x4*)(SS + (size_t)(row0 + ai * HALF + m * 16) * 12 + 8);
#pragma unroll
        for (int ai = 0; ai < 2; ++ai)
#pragma unroll
            for (int m = 0; m < 4; ++m) { const int row = row0 + ai * HALF + m * 16; const f32x4 sv = s0[ai][m];
                const float rs = __builtin_amdgcn_rsqf(((sv[0] + sv[1]) + (sv[2] + sv[3])) * (1.0f / KVLORA) + EPS);
#pragma unroll
                for (int bj = 0; bj < 2; ++bj) { const int hd = u.pn * 2 + bj;
                    float v[8]; ld8(v, acc[ai][bj][m][0], acc[ai][bj][m][1]);
#pragma unroll
                    for (int j = 0; j < 8; ++j) v[j] *= rs;
                    *(u32x4*)(dst + (size_t)row * AW + hd * HD + pc) = pack8(v); } }
    }
};
struct EpiMerge {
    static constexpr bool PERM = true, AFTER_DRAIN = false; static constexpr int MIDT = 8;
    const bf16_t* G; bf16_t* T;
    __device__ __forceinline__ void mid(f32x4 (&acc)[2][2][4][2], const Unit& u, int wr, int wc, int fr, int fq) const {
        asm volatile("" : "+v"(fr), "+v"(fq));
        const bf16_t* pa = G + gfrag_off(u.pm, u.pn, wr * 4 + wc, 0, fq * 16 + fr); const bf16_t* pb = G + gfrag_off(u.pm, 4 + u.pn, wr * 4 + wc, 0, fq * 16 + fr);
        u32x4 ca[4], cb[4], na[4], nb[4];
#pragma unroll
        for (int i = 0; i < 4; ++i) { ca[i] = *(const u32x4*)(pa + (size_t)i * 512); cb[i] = *(const u32x4*)(pb + (size_t)i * 512); }
#pragma unroll
        for (int b = 0; b < 4; ++b) {
            if (b < 3) {
#pragma unroll
                for (int i = 0; i < 4; ++i) { na[i] = *(const u32x4*)(pa + (size_t)((b + 1) * 4 + i) * 512); nb[i] = *(const u32x4*)(pb + (size_t)((b + 1) * 4 + i) * 512); } }
            asm volatile("" ::: "memory");
#pragma unroll
            for (int i = 0; i < 4; ++i) { const int grp = b * 4 + i, ai = grp >> 3, m = (grp >> 1) & 3, bj = grp & 1; float ga[8], gb[8]; unpack8(ca[i], ga); unpack8(cb[i], gb);
#pragma unroll
                for (int j = 0; j < 8; ++j) ga[j] *= __builtin_amdgcn_rcpf(__builtin_fmaxf(gb[j], 1e-30f));
                acc[ai][bj][m][0] *= (f32x4){ga[0], ga[1], ga[2], ga[3]}; acc[ai][bj][m][1] *= (f32x4){ga[4], ga[5], ga[6], ga[7]}; }
#pragma unroll
            for (int i = 0; i < 4; ++i) { ca[i] = na[i]; cb[i] = nb[i]; }
        }
    }
    __device__ __forceinline__ void operator()(const f32x4 (&acc)[2][2][4][2], const Unit& u, int wr, int wc, int fr, int fq) const {
        asm volatile("" : "+v"(fr), "+v"(fq));
        const int row0 = u.pm * BM + wr * 64 + fr, cl = u.pn * BM + wc * 32 + 8 * fq;
        const bf16_t* pb = G + gfrag_off(u.pm, 4 + u.pn, wr * 4 + wc, 0, fq * 16 + fr);
        u32x4 cb[8], nb[8];
#pragma unroll
        for (int i = 0; i < 8; ++i) cb[i] = *(const u32x4*)(pb + (size_t)i * 512);
#pragma unroll
        for (int b = 0; b < 2; ++b) {
            if (b < 1) {
#pragma unroll
                for (int i = 0; i < 8; ++i) nb[i] = *(const u32x4*)(pb + (size_t)(8 + i) * 512); }
            asm volatile("" ::: "memory");
#pragma unroll
            for (int i = 0; i < 8; ++i) { const int grp = b * 8 + i, ai = grp >> 3, m = (grp >> 1) & 3, bj = grp & 1; float v[8], gb[8]; ld8(v, acc[ai][bj][m][0], acc[ai][bj][m][1]); unpack8(cb[i], gb);
#pragma unroll
                for (int j = 0; j < 8; ++j) v[j] *= __builtin_fmaxf(gb[j], 1e-30f);
                *(u32x4*)(T + (size_t)(row0 + ai * HALF + m * 16) * DM + cl + bj * HALF) = pack8(v); }
#pragma unroll
            for (int i = 0; i < 8; ++i) cb[i] = nb[i];
        }
    }
};
struct EpiSS {
    static constexpr bool PERM = true, AFTER_DRAIN = false; static constexpr int MIDT = 0;
    bf16_t* Y; float* SSY;
    __device__ __forceinline__ void operator()(const f32x4 (&acc)[2][2][4][2], const Unit& u, int wr, int wc, int fr, int fq) const {
        asm volatile("" : "+v"(fr), "+v"(fq));
        const int row0 = u.pm * BM + wr * 64 + fr, cl = u.pn * BM + wc * 32 + 8 * fq;
#pragma unroll
        for (int ai = 0; ai < 2; ++ai)
#pragma unroll
            for (int m = 0; m < 4; ++m) { const int row = row0 + ai * HALF + m * 16; float s = 0.f;
#pragma unroll
                for (int bj = 0; bj < 2; ++bj) { float v[8]; ld8(v, acc[ai][bj][m][0], acc[ai][bj][m][1]); s += sumsq8(v); *(u32x4*)(Y + (size_t)row * DM + cl + bj * HALF) = pack8(v); }
                s = red_fq(s); if (fq == 0) SSY[(size_t)row * 16 + u.pn * 4 + wc] = s; }
    }
};
struct EpiRelu2 {
    static constexpr bool PERM = true, AFTER_DRAIN = false; static constexpr int MIDT = 0;
    bf16_t* U;
    __device__ __forceinline__ void operator()(const f32x4 (&acc)[2][2][4][2], const Unit& u, int wr, int wc, int fr, int fq) const {
        asm volatile("" : "+v"(fr), "+v"(fq));
        const int row0 = u.pm * BM + wr * 64 + fr, cl = u.pn * BM + wc * 32 + 8 * fq;
#pragma unroll
        for (int ai = 0; ai < 2; ++ai)
#pragma unroll
            for (int m = 0; m < 4; ++m) { const int row = row0 + ai * HALF + m * 16;
#pragma unroll
                for (int bj = 0; bj < 2; ++bj) { float v[8]; ld8(v, acc[ai][bj][m][0], acc[ai][bj][m][1]);
#pragma unroll
                    for (int j = 0; j < 8; ++j) { const float r = __builtin_fmaxf(v[j], 0.f); v[j] = r * r; }
                    *(u32x4*)(U + (size_t)row * DFF + cl + bj * HALF) = pack8(v); } }
    }
};
template <class Epi, class Sched, bool ALIGN_EPI = false, bool SP2 = false>
__device__ __forceinline__ void gemm_phase(PG8_LAS unsigned char* lds, const Gemm g, const Sched& S, const Epi& E) {
    int tid_ = threadIdx.x; asm volatile("" : "+v"(tid_));
    const int tid = tid_, wid = __builtin_amdgcn_readfirstlane(tid >> 6), lane = tid & 63, wr = wid >> 2, wc = wid & 3, fr = lane & 15, fq = lane >> 4;
    const int K = g.K, nt = K / BK, lda = g.lda ? g.lda : K, ldb = g.ldb ? g.ldb : K;
    unsigned voffA[2], voffB[2];
#pragma unroll
    for (int i = 0; i < 2; ++i) { int R, C; stage_rc(tid * 16 + i * 8192, R, C); const int Rb = Epi::PERM ? ((R & ~31) + perm32(R & 31)) : R;
        voffA[i] = (unsigned)(R * lda + C) * 2u; voffB[i] = (unsigned)(Rb * ldb + C) * 2u; }
    const size_t kstep = (size_t)(BK * 2);
    const size_t hstepA = (size_t)HALF * lda * 2, hstepB = (size_t)HALF * ldb * 2;
    const size_t tstepA = 2 * hstepA, tstepB = 2 * hstepB;
    const unsigned ldsw = (unsigned)wid * 1024u;
    const int aoff = lds_byte(wr * 64 + fr, fq * 8), boff = lds_byte(wc * 32 + fr, fq * 8);
#define PG8_SA(b, h) (((b) * 2 + (h)) * HTB)
#define PG8_SB(b, h) ((4 + (b) * 2 + (h)) * HTB)
#define PG8_STAGE(bufoff, gbase, voff) do { _Pragma("unroll") for (int _i = 0; _i < 2; ++_i) \
        __builtin_amdgcn_global_load_lds((const unsigned*)((const char*)(gbase) + (voff)[_i]), (PG8_LAS unsigned*)(lds + (bufoff) + ldsw + _i * 8192), 16, 0, 0); } while (0)
#define PG8_LDA(dst, b, h) do { _Pragma("unroll") for (int m = 0; m < 4; ++m) _Pragma("unroll") for (int k = 0; k < 2; ++k) dst[m][k] = *(const PG8_LAS bf16x8*)(lds + PG8_SA(b, h) + aoff + m * 2048 + k * 1024); } while (0)
#define PG8_LDB(dst, b, h) do { _Pragma("unroll") for (int n = 0; n < 2; ++n) _Pragma("unroll") for (int k = 0; k < 2; ++k) dst[n][k] = *(const PG8_LAS bf16x8*)(lds + PG8_SB(b, h) + boff + n * 2048 + k * 1024); } while (0)
#define PG8_MMA(ai, bj, At, Bt) do { __builtin_amdgcn_s_setprio(1); _Pragma("unroll") for (int m = 0; m < 4; ++m) _Pragma("unroll") for (int n = 0; n < 2; ++n) _Pragma("unroll") for (int k = 0; k < 2; ++k) \
        acc[ai][bj][m][n] = __builtin_amdgcn_mfma_f32_16x16x32_bf16(Bt[n][k], At[m][k], acc[ai][bj][m][n], 0, 0, 0); __builtin_amdgcn_s_setprio(0); } while (0)
#define PG8_WAIT_V(n) asm volatile("s_waitcnt vmcnt(" #n ")" ::: "memory")
#define PG8_WAIT_L(n) asm volatile("s_waitcnt lgkmcnt(" #n ")" ::: "memory")
#define PG8_BAR __builtin_amdgcn_s_barrier()
#define PG8_SCHED __builtin_amdgcn_sched_barrier(0)
    Unit cur, nxt; int ui = 0;
    if (!S.next(0, cur)) return;
    f32x4 acc[2][2][4][2];
#pragma unroll
    for (int a = 0; a < 2; ++a)
#pragma unroll
        for (int b = 0; b < 2; ++b)
#pragma unroll
            for (int m = 0; m < 4; ++m)
#pragma unroll
                for (int n = 0; n < 2; ++n) acc[a][b][m][n] = (f32x4){0.f, 0.f, 0.f, 0.f};
    bf16x8 At[4][2], B0[2][2], B1[2][2];
    const char* cA = (const char*)g.A + (size_t)cur.pm * tstepA; const char* cB = (const char*)g.Bt + (size_t)cur.pn * tstepB;
    S.a_ready(cur);
    if constexpr (SP2) {
        PG8_STAGE(PG8_SB(0, 0), cB, voffB); PG8_STAGE(PG8_SB(0, 1), cB + hstepB, voffB); PG8_STAGE(PG8_SA(0, 0), cA, voffA); PG8_STAGE(PG8_SA(0, 1), cA + hstepA, voffA);
        if (wr == 1) PG8_BAR;
        PG8_WAIT_V(2); PG8_BAR;
        PG8_STAGE(PG8_SB(1, 0), cB + kstep, voffB); PG8_STAGE(PG8_SA(1, 0), cA + kstep, voffA); PG8_STAGE(PG8_SB(1, 1), cB + hstepB + kstep, voffB);
        PG8_WAIT_V(6); PG8_BAR;
    } else {
        PG8_STAGE(PG8_SB(0, 0), cB, voffB); PG8_STAGE(PG8_SA(0, 0), cA, voffA); PG8_STAGE(PG8_SB(0, 1), cB + hstepB, voffB); PG8_STAGE(PG8_SA(0, 1), cA + hstepA, voffA);
        if (wr == 1) PG8_BAR;
        PG8_WAIT_V(4); PG8_BAR;
        PG8_STAGE(PG8_SB(1, 0), cB + kstep, voffB); PG8_STAGE(PG8_SA(1, 0), cA + kstep, voffA); PG8_STAGE(PG8_SB(1, 1), cB + hstepB + kstep, voffB);
        PG8_WAIT_V(6); PG8_BAR;
    }
    for (;;) {
        const bool has_next = S.next(ui + 1, nxt);
        const char* nA = has_next ? (const char*)g.A + (size_t)nxt.pm * tstepA : cA; const char* nB = has_next ? (const char*)g.Bt + (size_t)nxt.pn * tstepB : cB;
#pragma unroll 1
        for (int t = 0; t < nt; t += 2) {
            if constexpr (Epi::MIDT > 0) { if (t == Epi::MIDT) E.mid(acc, cur, wr, wc, fr, fq); }
            const bool last = (t == nt - 2);
            const char* a1 = cA + (size_t)(t + 1) * kstep;
            const char* a2 = last ? nA : cA + (size_t)(t + 2) * kstep; const char* b2 = last ? nB : cB + (size_t)(t + 2) * kstep;
            const char* a3 = a2 + kstep; const char* b3 = b2 + kstep;
            if (last && has_next) S.a_ready(nxt);
            if constexpr (SP2) {
            PG8_LDB(B0, 0, 0); PG8_LDB(B1, 0, 1); PG8_SCHED; PG8_LDA(At, 0, 0); PG8_STAGE(PG8_SA(1, 1), a1 + hstepA, voffA);
            PG8_WAIT_V(8); PG8_WAIT_L(0); PG8_BAR; PG8_MMA(0, 0, At, B0); PG8_MMA(0, 1, At, B1); PG8_BAR; PG8_SCHED;
            PG8_LDA(At, 0, 1); PG8_STAGE(PG8_SB(0, 0), b2, voffB); PG8_STAGE(PG8_SB(0, 1), b2 + hstepB, voffB); PG8_STAGE(PG8_SA(0, 0), a2, voffA);
            PG8_WAIT_V(8); PG8_WAIT_L(0); PG8_BAR; PG8_MMA(1, 0, At, B0); PG8_MMA(1, 1, At, B1); PG8_BAR; PG8_SCHED;
            PG8_LDB(B0, 1, 0); PG8_LDB(B1, 1, 1); PG8_SCHED; PG8_LDA(At, 1, 0); PG8_STAGE(PG8_SA(0, 1), a2 + hstepA, voffA);
            PG8_WAIT_V(8); PG8_WAIT_L(0); PG8_BAR; PG8_MMA(0, 0, At, B0); PG8_MMA(0, 1, At, B1); PG8_BAR; PG8_SCHED;
            PG8_LDA(At, 1, 1); PG8_STAGE(PG8_SB(1, 0), b3, voffB); PG8_STAGE(PG8_SB(1, 1), b3 + hstepB, voffB); PG8_STAGE(PG8_SA(1, 0), a3, voffA);
            PG8_WAIT_V(8); PG8_WAIT_L(0); PG8_BAR; PG8_MMA(1, 0, At, B0); PG8_MMA(1, 1, At, B1); PG8_BAR; PG8_SCHED;
            } else {
            PG8_LDB(B0, 0, 0); PG8_SCHED; PG8_LDA(At, 0, 0); PG8_STAGE(PG8_SA(1, 1), a1 + hstepA, voffA);
            PG8_WAIT_L(8); PG8_BAR; PG8_WAIT_L(0); PG8_MMA(0, 0, At, B0); PG8_BAR; PG8_SCHED;
            PG8_LDB(B1, 0, 1); PG8_STAGE(PG8_SB(0, 0), b2, voffB);
            PG8_BAR; PG8_WAIT_L(0); PG8_MMA(0, 1, At, B1); PG8_BAR;
            PG8_LDA(At, 0, 1); PG8_STAGE(PG8_SA(0, 0), a2, voffA);
            PG8_BAR; PG8_WAIT_L(0); PG8_MMA(1, 0, At, B0); PG8_BAR; PG8_SCHED;
            PG8_STAGE(PG8_SB(0, 1), b2 + hstepB, voffB);
            PG8_WAIT_V(6); PG8_BAR; PG8_MMA(1, 1, At, B1); PG8_BAR;
            PG8_LDB(B0, 1, 0); PG8_SCHED; PG8_LDA(At, 1, 0); PG8_STAGE(PG8_SA(0, 1), a2 + hstepA, voffA);
            PG8_WAIT_L(8); PG8_BAR; PG8_WAIT_L(0); PG8_MMA(0, 0, At, B0); PG8_BAR; PG8_SCHED;
            PG8_LDB(B1, 1, 1); PG8_STAGE(PG8_SB(1, 0), b3, voffB);
            PG8_BAR; PG8_WAIT_L(0); PG8_MMA(0, 1, At, B1); PG8_BAR;
            PG8_LDA(At, 1, 1); PG8_STAGE(PG8_SA(1, 0), a3, voffA);
            PG8_BAR; PG8_WAIT_L(0); PG8_MMA(1, 0, At, B0); PG8_BAR; PG8_SCHED;
            PG8_STAGE(PG8_SB(1, 1), b3 + hstepB, voffB);
            PG8_WAIT_V(6); PG8_BAR; PG8_MMA(1, 1, At, B1); PG8_BAR;
            }
        }
        if constexpr (ALIGN_EPI) { if (wr == 0) PG8_BAR; }
        if constexpr (!Epi::AFTER_DRAIN) { E(acc, cur, wr, wc, fr, fq); S.done(cur); }
        if (!has_next) break;
#pragma unroll
        for (int a = 0; a < 2; ++a)
#pragma unroll
            for (int b = 0; b < 2; ++b)
#pragma unroll
                for (int m = 0; m < 4; ++m)
#pragma unroll
                    for (int n = 0; n < 2; ++n) acc[a][b][m][n] = (f32x4){0.f, 0.f, 0.f, 0.f};
        cur = nxt; cA = nA; cB = nB; ++ui;
        if constexpr (ALIGN_EPI) { if (wr == 1) PG8_BAR; }
    }
    PG8_WAIT_V(0);
    if constexpr (!ALIGN_EPI) { if (wr == 0) PG8_BAR; }
    PG8_BAR;
    if constexpr (Epi::AFTER_DRAIN) { E.fused(acc, cur, wr, wc, fr, fq, lds, wid, lane); S.done(cur); }
#undef PG8_SA
#undef PG8_SB
#undef PG8_STAGE
#undef PG8_LDA
#undef PG8_LDB
#undef PG8_MMA
#undef PG8_WAIT_V
#undef PG8_WAIT_L
#undef PG8_BAR
#undef PG8_SCHED
}
}
namespace att {
typedef unsigned short bf16_t;
typedef short bf16x8 __attribute__((ext_vector_type(8)));
typedef short s16x4 __attribute__((ext_vector_type(4)));
typedef float f32x16 __attribute__((ext_vector_type(16)));
typedef float f32x4 __attribute__((ext_vector_type(4)));
typedef unsigned u32x4 __attribute__((ext_vector_type(4)));
#define ALDS __attribute__((address_space(3)))
#define ASBAR() __builtin_amdgcn_sched_barrier(0)
constexpr int KTB = 12288, VTB = 8192;
constexpr int L_K = 0, L_V = 2 * KTB, L_WS = L_V + 2 * VTB, L_OST = L_WS + 8 * 256, L_KM = L_OST + 8 * 4096, L_RED = L_KM + 2048, L_END = L_RED + 16384;
constexpr float THR = 8.f;
__device__ __forceinline__ int crow(int r, int hi) { return (r & 3) + 8 * (r >> 2) + 4 * hi; }
typedef float f32x2a_t __attribute__((ext_vector_type(2))); typedef __bf16 bf16x2a_t __attribute__((ext_vector_type(2)));
__device__ __forceinline__ unsigned cvtpk(float lo, float hi) { const f32x2a_t v = {lo, hi}; const bf16x2a_t b = __builtin_convertvector(v, bf16x2a_t); return __builtin_bit_cast(unsigned, b); }
__device__ __forceinline__ float bf2f(short s) { return __uint_as_float(((unsigned)(unsigned short)s) << 16); }
__device__ __forceinline__ int v_st(int k, int c) { const int kk = (k & ~0xC) | ((k & 4) << 1) | ((k & 8) >> 1); return ((kk >> 3) * 2 + (c >> 5)) * 512 + ((kk & 7) * 32 + (c & 31)) * 2; }
__device__ __forceinline__ int v_rd_base(int lane) { return ((lane & 3) << 3) | (((lane >> 2) & 3) << 6) | (((lane >> 4) & 1) << 5) | (((lane >> 5) & 1) << 8); }
constexpr int v_rd_off(int d0, int ks, int half) { return ks * 2048 + half * 1024 + d0 * 512; }
template <int OFF> __device__ __forceinline__ s16x4 tr_read(int vb) { s16x4 r; asm volatile("ds_read_b64_tr_b16 %0, %1 offset:%2" : "=&v"(r) : "v"(vb), "i"(OFF) : "memory"); return r; }
template <int D0> __device__ __forceinline__ void pv_one(f32x16& od, int vb, bf16x8 pa0, bf16x8 pa1, bf16x8 pa2, bf16x8 pa3) {
    const s16x4 l0 = tr_read<v_rd_off(D0, 0, 0)>(vb), h0 = tr_read<v_rd_off(D0, 0, 1)>(vb), l1 = tr_read<v_rd_off(D0, 1, 0)>(vb), h1 = tr_read<v_rd_off(D0, 1, 1)>(vb);
    const s16x4 l2 = tr_read<v_rd_off(D0, 2, 0)>(vb), h2 = tr_read<v_rd_off(D0, 2, 1)>(vb), l3 = tr_read<v_rd_off(D0, 3, 0)>(vb), h3 = tr_read<v_rd_off(D0, 3, 1)>(vb);
    asm volatile("s_waitcnt lgkmcnt(0)" ::: "memory"); ASBAR();
#define ATT_PK(L, H) (bf16x8){L[0], L[1], L[2], L[3], H[0], H[1], H[2], H[3]}
    od = __builtin_amdgcn_mfma_f32_32x32x16_bf16(pa0, ATT_PK(l0, h0), od, 0, 0, 0);
    od = __builtin_amdgcn_mfma_f32_32x32x16_bf16(pa1, ATT_PK(l1, h1), od, 0, 0, 0);
    od = __builtin_amdgcn_mfma_f32_32x32x16_bf16(pa2, ATT_PK(l2, h2), od, 0, 0, 0);
    od = __builtin_amdgcn_mfma_f32_32x32x16_bf16(pa3, ATT_PK(l3, h3), od, 0, 0, 0);
#undef ATT_PK
}
__device__ __forceinline__ void pv_all(f32x16* o, int vb, bf16x8 pa0, bf16x8 pa1, bf16x8 pa2, bf16x8 pa3) { pv_one<0>(o[0], vb, pa0, pa1, pa2, pa3); pv_one<1>(o[1], vb, pa0, pa1, pa2, pa3); }
__device__ __forceinline__ void partialSM(f32x16& p0, f32x16& p1, float& m_reg, float& alpha) {
    float pmax = p0[0];
#pragma unroll
    for (int r = 1; r < 16; ++r) pmax = fmaxf(pmax, p0[r]);
#pragma unroll
    for (int r = 0; r < 16; ++r) pmax = fmaxf(pmax, p1[r]);
    { auto rr = __builtin_amdgcn_permlane32_swap(__float_as_uint(pmax), __float_as_uint(pmax), false, false); pmax = fmaxf(__uint_as_float(rr[0]), __uint_as_float(rr[1])); }
    float mn;
    if (__builtin_expect(__all(pmax - m_reg <= THR), 1)) { mn = m_reg; alpha = 1.f; }
    else { mn = fmaxf(m_reg, pmax); alpha = __builtin_amdgcn_exp2f(m_reg - mn); m_reg = mn; }
#pragma unroll
    for (int r = 0; r < 16; ++r) p0[r] = __builtin_amdgcn_exp2f(p0[r] - mn);
#pragma unroll
    for (int r = 0; r < 16; ++r) p1[r] = p1[r] - mn;
}
__device__ __forceinline__ void finishSM(f32x16& p0, f32x16& p1, float alpha, float& l_reg, bf16x8& pa0, bf16x8& pa1, bf16x8& pa2, bf16x8& pa3) {
#pragma unroll
    for (int r = 0; r < 16; ++r) p1[r] = __builtin_amdgcn_exp2f(p1[r]);
    float ps = 0.f;
#pragma unroll
    for (int r = 0; r < 16; ++r) ps += p0[r];
#pragma unroll
    for (int r = 0; r < 16; ++r) ps += p1[r];
    { auto rr = __builtin_amdgcn_permlane32_swap(__float_as_uint(ps), __float_as_uint(ps), false, false); ps = __uint_as_float(rr[0]) + __uint_as_float(rr[1]); }
    l_reg = l_reg * alpha + ps;
#define ATT_PK4(P, BASE, OUT) do { unsigned a0 = cvtpk(P[BASE + 0], P[BASE + 1]), a1 = cvtpk(P[BASE + 2], P[BASE + 3]);   \
    unsigned b0 = cvtpk(P[BASE + 4], P[BASE + 5]), b1 = cvtpk(P[BASE + 6], P[BASE + 7]);                              \
    auto r0 = __builtin_amdgcn_permlane32_swap(a0, b0, false, false); auto r1 = __builtin_amdgcn_permlane32_swap(a1, b1, false, false); \
    u32x4 w = {r0[0], r1[0], r0[1], r1[1]}; OUT = __builtin_bit_cast(bf16x8, w); } while (0)
    ATT_PK4(p0, 0, pa0); ATT_PK4(p0, 8, pa1); ATT_PK4(p1, 0, pa2); ATT_PK4(p1, 8, pa3);
#undef ATT_PK4
}
template <int ND> __device__ __forceinline__ void qkt(f32x16& p0, f32x16& p1, ALDS const char* Kb, const int (&ka)[ND], const bf16x8 (&qr)[ND]) {
    p0 = f32x16{}; p1 = f32x16{};
#pragma unroll
    for (int d0 = 0; d0 < ND; ++d0) {
        const bf16x8 b0 = *(ALDS const bf16x8*)(Kb + ka[d0]);
        const bf16x8 b1 = *(ALDS const bf16x8*)(Kb + ka[d0] + (d0 < 4 ? 4096 : 2048));
        p0 = __builtin_amdgcn_mfma_f32_32x32x16_bf16(b0, qr[d0], p0, 0, 0, 0);
        p1 = __builtin_amdgcn_mfma_f32_32x32x16_bf16(b1, qr[d0], p1, 0, 0, 0);
        if (ND > 4 && d0 == 2) asm volatile("" ::: "memory"); }
}
template <bool MOBA> __device__ __forceinline__ void tmask(f32x16& p0, f32x16& p1, int t, int qb, int qrel, int hi, unsigned sel) {
    const float NEG = -INFINITY;
    if (t >= 4 * qb) { const int thr = qrel - 64 * (t - 4 * qb) - 4 * hi;
#pragma unroll
        for (int r = 0; r < 16; ++r) { if ((r & 3) + 8 * (r >> 2) > thr) p0[r] = NEG; if ((r & 3) + 8 * (r >> 2) + 32 > thr) p1[r] = NEG; } }
    else if (MOBA) { if (!((sel >> (t >> 2)) & 1u)) {
#pragma unroll
        for (int r = 0; r < 16; ++r) { p0[r] = NEG; p1[r] = NEG; } } }
}
__device__ __forceinline__ void kmean_blocks(const bf16_t* Kp, ALDS char* lds) {
    int tid_ = threadIdx.x; asm volatile("" : "+v"(tid_));
    const int tid = tid_, lane = tid & 63, wid = tid >> 6, c = tid & 7, rg = tid >> 3;
    ALDS float* red = (ALDS float*)(lds + L_RED); ALDS float* km = (ALDS float*)(lds + L_KM);
#pragma unroll 1
    for (int n = 0; n < 8; ++n) {
        float a[8];
#pragma unroll
        for (int j = 0; j < 8; ++j) a[j] = 0.f;
#pragma unroll
        for (int i = 0; i < 4; ++i) { const bf16x8 kx = *(const bf16x8*)(Kp + (size_t)(n * 256 + rg + 64 * i) * AW + c * 8);
#pragma unroll
            for (int j = 0; j < 8; ++j) a[j] += bf2f(kx[j]); }
#pragma unroll
        for (int j = 0; j < 8; ++j) { a[j] += __shfl_xor(a[j], 8); a[j] += __shfl_xor(a[j], 16); a[j] += __shfl_xor(a[j], 32); }
        if (lane < 8) {
#pragma unroll
            for (int j = 0; j < 8; ++j) red[(n * 8 + wid) * 64 + c * 8 + j] = a[j]; }
    }
    __syncthreads();
    { const int n = tid >> 6, d = tid & 63; float s = 0.f;
#pragma unroll
        for (int w = 0; w < 8; ++w) s += red[(n * 8 + w) * 64 + d];
        km[n * 64 + d] = s * (1.0f / 256.0f); }
    __syncthreads();
}
template <int DQK, bool MOBA>
__device__ __forceinline__ void attn_unit(const bf16_t* Qp, int ldq, const bf16_t* Kp, const bf16_t* KRp, const bf16_t* Vp, bf16_t* Op, int ldo, int qb, ALDS char* lds) {
    constexpr int ND = DQK / 16;
    int tid_ = threadIdx.x; asm volatile("" : "+v"(tid_));
    const int tid = tid_, lane = tid & 63, r32 = lane & 31, hi = lane >> 5; const int wid = __builtin_amdgcn_readfirstlane(tid >> 6);
    ALDS char* K_lds = lds + L_K; ALDS char* V_lds = lds + L_V;
    ALDS float* ws = (ALDS float*)(lds + L_WS) + wid * 64; ALDS float* li_l = ws; ALDS float* al_l = ws + 32;
    float m_reg = -1e30f, l_reg = 0.f; f32x16 o[2]; o[0] = f32x16{}; o[1] = f32x16{}; bf16x8 qr[ND];
    { const bf16_t* Qw = Qp + (size_t)(wid * 32 + r32) * ldq + hi * 8;
#pragma unroll
      for (int d0 = 0; d0 < ND; ++d0) qr[d0] = *(const bf16x8*)(Qw + d0 * 16); }
    unsigned sel = 0xffu;
    if (MOBA && qb > 3) {
        ALDS const float* km = (ALDS const float*)(lds + L_KM); float g[8];
#pragma unroll
        for (int n = 0; n < 8; ++n) { float s = 0.f;
#pragma unroll
            for (int d0 = 0; d0 < ND; ++d0)
#pragma unroll
                for (int j = 0; j < 8; ++j) s += bf2f(qr[d0][j]) * km[n * 64 + d0 * 16 + hi * 8 + j];
            g[n] = s; }
#pragma unroll
        for (int n = 0; n < 8; ++n) g[n] += __shfl_xor(g[n], 32);
        sel = 0u;
#pragma unroll
        for (int n = 0; n < 8; ++n) { int rank = 0;
#pragma unroll
            for (int mm = 0; mm < 8; ++mm) if (mm != n) rank += (mm < qb && (g[mm] > g[n] || (g[mm] == g[n] && mm < n))) ? 1 : 0;
            if (n < qb && rank < 3) sel |= 1u << n; }
    }
    const int skey = tid >> 3, sch = tid & 7;
    const unsigned koff = (unsigned)(skey * AW + sch * 8) * 2u;
    const int kst = skey * 128 + ((sch ^ ((skey >> 1) & 7)) << 4), vst = v_st(skey, sch * 8);
    const int t2 = tid & 255, rkey = t2 >> 2, rch = t2 & 3;
    const unsigned roff = (unsigned)(rkey * RDIM + rch * 8) * 2u;
    const int rst = 8192 + rkey * 64 + ((rch ^ ((rkey >> 2) & 3)) << 4);
    int ka[ND];
#pragma unroll
    for (int d0 = 0; d0 < ND; ++d0) ka[d0] = (d0 < 4) ? r32 * 128 + (((2 * d0 + hi) ^ ((r32 >> 1) & 7)) << 4) : 8192 + r32 * 64 + (((2 * (d0 - 4) + hi) ^ ((r32 >> 2) & 3)) << 4);
    const int vb0 = (int)(unsigned)(uintptr_t)V_lds + v_rd_base(lane);
    const int qrel = wid * 32 + r32;
    bf16x8 sk0, sv0, sr0, sk1, sv1, sr1;
#define ATT_SLOAD(S, k0) do { sk##S = *(const bf16x8*)((const char*)(Kp + (size_t)(k0) * AW) + koff); sv##S = *(const bf16x8*)((const char*)(Vp + (size_t)(k0) * AW) + koff); if (DQK == 96) sr##S = *(const bf16x8*)((const char*)(KRp + (size_t)(k0) * RDIM) + roff); } while (0)
#define ATT_SWRITE(b, S) do { *(ALDS bf16x8*)(K_lds + (b) * KTB + kst) = sk##S; *(ALDS bf16x8*)(V_lds + (b) * VTB + vst) = sv##S; if (DQK == 96) { if (tid < 256) *(ALDS bf16x8*)(K_lds + (b) * KTB + rst) = sr##S; } } while (0)
#define ATT_RESC(a) do { if (__any((a) < 1.f)) { if (hi == 0) al_l[r32] = (a); asm volatile("s_waitcnt lgkmcnt(0)" ::: "memory"); \
    _Pragma("unroll") for (int d = 0; d < 2; ++d) _Pragma("unroll") for (int r = 0; r < 16; ++r) o[d][r] *= al_l[crow(r, hi)]; } } while (0)
    f32x16 pA0, pA1, pB0, pB1; float alA, alB; bf16x8 pa0, pa1, pa2, pa3; const int NT = 4 * (qb + 1);
    ATT_SLOAD(0, 0); ATT_SWRITE(0, 0); __syncthreads();
    qkt<ND>(pA0, pA1, K_lds, ka, qr); tmask<MOBA>(pA0, pA1, 0, qb, qrel, hi, sel); partialSM(pA0, pA1, m_reg, alA);
    ATT_SLOAD(1, 64); ATT_SLOAD(0, 128);
    ATT_SWRITE(1, 1); __syncthreads();
    for (int j = 1; j + 1 < NT; j += 2) {
        ASBAR(); qkt<ND>(pB0, pB1, K_lds + KTB, ka, qr); tmask<MOBA>(pB0, pB1, j, qb, qrel, hi, sel);
        finishSM(pA0, pA1, alA, l_reg, pa0, pa1, pa2, pa3); ASBAR();
        ATT_SLOAD(1, (j + 2) * 64); ASBAR();
        pv_all(o, vb0, pa0, pa1, pa2, pa3); partialSM(pB0, pB1, m_reg, alB);
        __syncthreads(); ATT_SWRITE(0, 0);
        ATT_RESC(alB); __syncthreads();
        ASBAR(); qkt<ND>(pA0, pA1, K_lds, ka, qr); tmask<MOBA>(pA0, pA1, j + 1, qb, qrel, hi, sel);
        finishSM(pB0, pB1, alB, l_reg, pa0, pa1, pa2, pa3); ASBAR();
        if (j + 3 < NT) ATT_SLOAD(0, (j + 3) * 64); ASBAR();
        pv_all(o, vb0 + VTB, pa0, pa1, pa2, pa3); partialSM(pA0, pA1, m_reg, alA);
        __syncthreads(); ATT_SWRITE(1, 1);
        ATT_RESC(alA); __syncthreads();
    }
    ASBAR(); qkt<ND>(pB0, pB1, K_lds + KTB, ka, qr); tmask<MOBA>(pB0, pB1, NT - 1, qb, qrel, hi, sel);
    finishSM(pA0, pA1, alA, l_reg, pa0, pa1, pa2, pa3); ASBAR();
    pv_all(o, vb0, pa0, pa1, pa2, pa3); partialSM(pB0, pB1, m_reg, alB);
    __syncthreads(); ATT_RESC(alB);
    finishSM(pB0, pB1, alB, l_reg, pa0, pa1, pa2, pa3); ASBAR();
    pv_all(o, vb0 + VTB, pa0, pa1, pa2, pa3);
    if (hi == 0) li_l[r32] = l_reg; asm volatile("s_waitcnt lgkmcnt(0)" ::: "memory");
    float rli[16];
#pragma unroll
    for (int r = 0; r < 16; ++r) rli[r] = __builtin_amdgcn_rcpf(li_l[crow(r, hi)]);
    { ALDS unsigned short* stg = (ALDS unsigned short*)(lds + L_OST) + wid * 2048;
#pragma unroll
      for (int r = 0; r < 16; ++r) { const int orow = crow(r, hi);
#pragma unroll
          for (int d0 = 0; d0 < 2; ++d0) stg[orow * 64 + d0 * 32 + r32] = (unsigned short)(cvtpk(o[d0][r] * rli[r], 0.f) & 0xffffu); }
      asm volatile("s_waitcnt lgkmcnt(0)" ::: "memory");
      bf16_t* Ow = Op + (size_t)(wid * 32) * ldo;
#pragma unroll
      for (int i = 0; i < 4; ++i) { const int row = i * 8 + (lane >> 3), ch = lane & 7; const u32x4 v = *(ALDS const u32x4*)(stg + row * 64 + ch * 8); *(u32x4*)(Ow + (size_t)row * ldo + ch * 8) = v; } }
    __syncthreads();
#undef ATT_SLOAD
#undef ATT_SWRITE
#undef ATT_RESC
}
#undef ASBAR
}
#if defined(DBG_NAIVE_ATTN) || defined(DBG_CHECK)
namespace dbg {
typedef unsigned short bf16_t;
typedef short bf16x8 __attribute__((ext_vector_type(8)));
__device__ __forceinline__ float bf2f(short s) { return __uint_as_float(((unsigned)(unsigned short)s) << 16); }
__device__ __forceinline__ unsigned short f2bf_(float f) { unsigned u = __builtin_bit_cast(unsigned, f); return (unsigned short)((u + 0x7fffu + ((u >> 16) & 1u)) >> 16); }
__global__ void __launch_bounds__(512) kmean_k(const bf16_t* KA, float* KM) {
    const int bh = blockIdx.x, b = bh >> 3, h = bh & 7, n = threadIdx.x >> 6, d = threadIdx.x & 63; float s = 0.f;
    const bf16_t* Kp = KA + (size_t)b * SEQ * AW + h * HD;
#pragma unroll 4
    for (int r = 0; r < 256; ++r) s += bf2f((short)Kp[(size_t)(n * 256 + r) * AW + d]);
    KM[(size_t)bh * 512 + n * 64 + d] = s * (1.0f / 256.0f);
}
template <int DQK, bool MOBA>
__global__ void __launch_bounds__(256) attn_k(const bf16_t* Q, const bf16_t* K, const bf16_t* KR, const bf16_t* V, bf16_t* O, const float* KM) {
    constexpr int ldq = (DQK == 96) ? NHEAD * QKB : AW;
    const int bh = blockIdx.y, b = bh >> 3, h = bh & 7, tid = threadIdx.x;
    const size_t r0 = (size_t)b * SEQ;
    const bf16_t* Qp = Q + r0 * ldq + h * (DQK == 96 ? QKB : HD); const bf16_t* Kp = K + r0 * AW + h * HD; const bf16_t* Vp = V + r0 * AW + h * HD; const bf16_t* KRp = (DQK == 96) ? KR + r0 * RDIM : K;
    bf16_t* Op = O + r0 * AW + h * HD; const float* km = KM + (size_t)bh * 512;
    const int row = blockIdx.x * 64 + (tid >> 2), qb = row >> 8, c4 = tid & 3;
    bf16x8 q[DQK / 8];
#pragma unroll
    for (int c = 0; c < DQK / 8; ++c) q[c] = *(const bf16x8*)(Qp + (size_t)row * ldq + c * 8);
    unsigned sel = 0xffu;
    if (MOBA && qb > 3) {
        float g[8];
#pragma unroll
        for (int n = 0; n < 8; ++n) { float s = 0.f;
#pragma unroll
            for (int c = 0; c < 8; ++c)
#pragma unroll
                for (int j = 0; j < 8; ++j) s += bf2f(q[c][j]) * km[n * 64 + c * 8 + j];
            g[n] = s; }
        sel = 0u;
#pragma unroll
        for (int n = 0; n < 8; ++n) { int rank = 0;
#pragma unroll
            for (int mm = 0; mm < 8; ++mm) if (mm != n) rank += (mm < qb && (g[mm] > g[n] || (g[mm] == g[n] && mm < n))) ? 1 : 0;
            if (n < qb && rank < 3) sel |= 1u << n; }
    }
    float o[16];
#pragma unroll
    for (int d = 0; d < 16; ++d) o[d] = 0.f;
    float mx = -1e30f, l = 0.f;
#pragma unroll 1
    for (int key = 0; key <= row; ++key) {
        const int n = key >> 8;
        if (MOBA && n < qb && !((sel >> n) & 1u)) { key = (n << 8) + 255; continue; }
        float s = 0.f;
#pragma unroll
        for (int c = 0; c < 8; ++c) { const bf16x8 kx = *(const bf16x8*)(Kp + (size_t)key * AW + c * 8);
#pragma unroll
            for (int j = 0; j < 8; ++j) s += bf2f(q[c][j]) * bf2f(kx[j]); }
        if (DQK == 96) {
#pragma unroll
            for (int c = 0; c < 4; ++c) { const bf16x8 kx = *(const bf16x8*)(KRp + (size_t)key * RDIM + c * 8);
#pragma unroll
                for (int j = 0; j < 8; ++j) s += bf2f(q[(DQK == 96 ? 8 : 0) + c][j]) * bf2f(kx[j]); }
        }
        const float mn = fmaxf(mx, s), a = __builtin_amdgcn_exp2f(mx - mn), p = __builtin_amdgcn_exp2f(s - mn);
        l = l * a + p; mx = mn;
#pragma unroll
        for (int c = 0; c < 2; ++c) { const bf16x8 vx = *(const bf16x8*)(Vp + (size_t)key * AW + c4 * 16 + c * 8);
#pragma unroll
            for (int j = 0; j < 8; ++j) o[c * 8 + j] = o[c * 8 + j] * a + p * bf2f(vx[j]); }
    }
    const float rl = 1.f / l;
    __syncthreads();
#pragma unroll
    for (int d = 0; d < 16; ++d) Op[(size_t)row * AW + c4 * 16 + d] = f2bf_(o[d] * rl);
}
}
#endif
#define GAS __attribute__((address_space(1)))
#define LAS __attribute__((address_space(3)))
typedef unsigned short bf16;
typedef unsigned v4u __attribute__((ext_vector_type(4)));
typedef float f32x4 __attribute__((ext_vector_type(4)));
typedef short bf16x8 __attribute__((ext_vector_type(8)));
typedef GAS unsigned gu32;
typedef GAS unsigned long long gu64;
#define RLX_AGENT __ATOMIC_RELAXED, __HIP_MEMORY_SCOPE_AGENT
#define LDS_WAIT() asm volatile("s_waitcnt lgkmcnt(0)" ::: "memory")
#define VM_WAIT() asm volatile("s_waitcnt vmcnt(0)" ::: "memory")
__device__ __forceinline__ unsigned long long rt() { return __builtin_amdgcn_s_memrealtime(); }
__device__ __forceinline__ unsigned f2bf(float f) { unsigned u = __builtin_bit_cast(unsigned, f); return (u + 0x7fffu + ((u >> 16) & 1u)) >> 16; }
__device__ __forceinline__ unsigned pk2(float lo, float hi) { return f2bf(lo) | (f2bf(hi) << 16); }

#define XB_TMO      128
#define XB_XCNT(j)  (256  + 64 * (j))
#define XB_XSUB(j)  (1280 + 64 * (j))
#define XB_XGEN(j)  (2304 + 64 * (j))
#define XB_TOP      3328
#define XB_TOPGEN   3392
#define XCD_BAR_WORDS 3456
#define XB_SPIN_CAP (1u << 18)

__device__ __forceinline__ unsigned xb_ld(unsigned* p)              { return __hip_atomic_load(p, __ATOMIC_RELAXED, __HIP_MEMORY_SCOPE_AGENT); }
__device__ __forceinline__ unsigned xb_add(unsigned* p, unsigned v) { return __hip_atomic_fetch_add(p, v, __ATOMIC_RELAXED, __HIP_MEMORY_SCOPE_AGENT); }
__device__ __forceinline__ unsigned xb_xcc_id() { return (unsigned)__builtin_amdgcn_s_getreg((3 << 11) | 20) & 0xFu; }
#define XB_SPIN(cond, bar) do { unsigned _sp = 0; while (cond) { __builtin_amdgcn_s_sleep(1); \
    if ((++_sp & 255u) == 0u) { if (xb_ld(&(bar)[XB_TMO])) break; if (_sp > XB_SPIN_CAP) { atomicAdd(&(bar)[XB_TMO], 1u); break; } } } } while (0)

struct XcdBarrier {
    unsigned* bar; unsigned x;
    volatile LAS unsigned* st;
};

__device__ __forceinline__ XcdBarrier xcd_barrier_post(unsigned* bar, volatile LAS unsigned* st) {
    XcdBarrier b; b.bar = bar; b.x = xb_xcc_id(); b.st = st;
    if (threadIdx.x == 0) (void)xb_add(&bar[XB_XCNT(b.x)], 1u);
    return b;
}
__device__ __forceinline__ void xcd_barrier_complete(unsigned* bar, unsigned x, unsigned& nloc, unsigned& nx) {
    const unsigned G = gridDim.x * gridDim.y * gridDim.z;
    unsigned sum, cnt, mine, sp = 0u;
    for (;;) {
        sum = 0u; cnt = 0u; mine = 0u;
#pragma unroll
        for (unsigned j = 0; j < 16; ++j) { const unsigned c = xb_ld(&bar[XB_XCNT(j)]); sum += c; cnt += (c > 0u) ? 1u : 0u; mine = (j == x) ? c : mine; }
        if (sum == G) break;
        __builtin_amdgcn_s_sleep(1);
        if ((++sp & 255u) == 0u) { if (xb_ld(&bar[XB_TMO])) break; if (sp > XB_SPIN_CAP) { atomicAdd(&bar[XB_TMO], 1u); break; } }
    }
    nloc = mine > 0u ? mine : 1u; nx = cnt > 0u ? cnt : 1u;
}

__device__ __forceinline__ void xcd_barrier(const XcdBarrier& b) {
    asm volatile("s_waitcnt vmcnt(0)" ::: "memory");
    __syncthreads();
    if (threadIdx.x == 0) {
        unsigned* bar = b.bar;
        __builtin_amdgcn_s_waitcnt(0);
        unsigned nloc = b.st[0], nx = b.st[1];
        if (nloc == 0u) { xcd_barrier_complete(bar, b.x, nloc, nx); b.st[0] = nloc; b.st[1] = nx; }
        const unsigned old = xb_add(&bar[XB_XSUB(b.x)], 1u);
        const unsigned gen = old / nloc;
        if (old + 1u == (gen + 1u) * nloc) {
            __builtin_amdgcn_fence(__ATOMIC_RELEASE, "agent");
            asm volatile("s_waitcnt vmcnt(0)" ::: "memory");
            const unsigned og = xb_add(&bar[XB_TOP], 1u);
            const unsigned tg = og / nx;
            if (og + 1u == (tg + 1u) * nx) xb_add(&bar[XB_TOPGEN], 1u);
            else XB_SPIN(xb_ld(&bar[XB_TOPGEN]) == tg, bar);
            __builtin_amdgcn_fence(__ATOMIC_ACQUIRE, "agent");
            xb_add(&bar[XB_XGEN(b.x)], 1u);
            asm volatile("s_waitcnt vmcnt(0)" ::: "memory");
        } else {
            XB_SPIN(xb_ld(&bar[XB_XGEN(b.x)]) == gen, bar);
            __builtin_amdgcn_fence(__ATOMIC_ACQUIRE, "agent");
            asm volatile("s_waitcnt vmcnt(0)" ::: "memory");
        }
    }
    __syncthreads();
}
#if defined(DBG_CHECK)
namespace chk {
typedef unsigned short bf16_t;
__device__ __forceinline__ float bfv(const bf16_t* p, size_t i) { return __uint_as_float(((unsigned)p[i]) << 16); }
__device__ __forceinline__ unsigned hsh(unsigned x) { x ^= x >> 16; x *= 0x7feb352du; x ^= x >> 15; x *= 0x846ca68bu; x ^= x >> 16; return x; }
__device__ __forceinline__ void report(unsigned* cnt, int stage, float got, float want) {
    atomicAdd(&cnt[64 + stage], 1u);
    if (!(fabsf(got - want) <= 0.04f + 0.04f * fabsf(want))) atomicAdd(&cnt[stage], 1u);
}
__device__ __forceinline__ void cs_of(int pos, int i, int half, float& c, float& s) {
    const float invf = (float)exp2(-(double)i * 18.931568569324174 / (double)half);
    const float ang = (float)pos * invf; double t = (double)ang * 0.15915494309189535; t -= floor(t);
    c = __builtin_amdgcn_cosf((float)t); s = __builtin_amdgcn_sinf((float)t);
}
constexpr int NS = 64 * 256;
__global__ void __launch_bounds__(256) k_c0(const float* x, const float* g, const bf16_t* H, unsigned* cnt) {
    const unsigned id = blockIdx.x * 256 + threadIdx.x, r = hsh(id * 2654435761u + 17u); const int m = r % MTOK, k = (r >> 16) % DM;
    double ss = 0.0; for (int i = 0; i < DM; ++i) { const double v = x[(size_t)m * DM + i]; ss += v * v; }
    const float want = (float)(x[(size_t)m * DM + k] / sqrt(ss / DM + 1e-6) * g[k]);
    report(cnt, 1, bfv(H, (size_t)m * DM + k), want);
}
__device__ __forceinline__ float dot_h(const bf16_t* H, const float* W, int m, int j) { double a = 0.0; for (int k = 0; k < DM; ++k) a += (double)bfv(H, (size_t)m * DM + k) * (double)W[(size_t)k * INW + j]; return (float)a; }
__global__ void __launch_bounds__(256) k_c1(const bf16_t* H, const float* w_in, const float* b_gate, const int* positions, const bf16_t* QA, const bf16_t* KA, const bf16_t* VA, const bf16_t* CQ, const bf16_t* CKV,
                                            const bf16_t* KR, const bf16_t* G, unsigned* cnt) {
    const unsigned id = blockIdx.x * 256 + threadIdx.x, r = hsh(id * 2654435761u + 101u); const int m = r % MTOK; int j;
    { const unsigned r2 = hsh(r + 77u); const int cls = id % 8;
      if (cls == 0) j = (r2 % 8) * 64 + (r2 >> 8) % 16; else if (cls == 1) j = 512 + (r2 % 8) * 64 + (r2 >> 8) % 16; else if (cls == 2) j = 2176 + r2 % 32; else j = r2 % INW; }
    const int pos = positions[m];
    if (j < 1024) { const int sect = j >> 9, jj = j & 511, head = jj >> 6, d = jj & 63; const bf16_t* dst = sect ? KA : QA; const float sc = sect ? 1.f : C2A;
        if (d < 16) { const int i = d & 7; const float x1 = dot_h(H, w_in, m, sect * 512 + head * 64 + i), x2 = dot_h(H, w_in, m, sect * 512 + head * 64 + i + 8); float c, s; cs_of(pos, i, 8, c, s);
            const float want = ((d < 8) ? x1 * c - x2 * s : x2 * c + x1 * s) * sc; report(cnt, sect ? 4 : 2, bfv(dst, (size_t)m * AW + head * 64 + 2 * i + (d >> 3)), want); }
        else report(cnt, sect ? 5 : 3, bfv(dst, (size_t)m * AW + head * 64 + d), dot_h(H, w_in, m, j) * sc); }
    else if (j < 1536) report(cnt, 6, bfv(VA, (size_t)m * AW + (j - 1024)), dot_h(H, w_in, m, j));
    else if (j < 1920) report(cnt, 7, bfv(CQ, (size_t)m * QLORA + (j - 1536)), dot_h(H, w_in, m, j));
    else if (j < 2176) report(cnt, 8, bfv(CKV, (size_t)m * KVLORA + (j - 1920)), dot_h(H, w_in, m, j));
    else if (j < 2208) { const int dd = j - 2176, i = dd & 15; const float x1 = dot_h(H, w_in, m, 2176 + i), x2 = dot_h(H, w_in, m, 2176 + i + 16); float c, s; cs_of(pos, i, 16, c, s);
        report(cnt, 9, bfv(KR, (size_t)m * RDIM + 2 * i + (dd >> 4)), (dd < 16) ? x1 * c - x2 * s : x2 * c + x1 * s); }
    else { const float z = dot_h(H, w_in, m, j) + b_gate[j - 2208]; const float want = 1.f / (1.f + expf(-z)), got = bfv(G, (size_t)m * 2 * DM + (j - 2208)); report(cnt, 10, got, want); report(cnt, 24 + ((j - 2208) >> 8), got, want); }
}
__global__ void __launch_bounds__(256) k_c2(const bf16_t* CQ, const bf16_t* CKV, const float* g_q, const float* w_uq, const float* g_kv, const float* w_ukv, const int* positions, const bf16_t* QB, const bf16_t* KB,
                                            const bf16_t* VB, unsigned* cnt) {
    const unsigned id = blockIdx.x * 256 + threadIdx.x, r = hsh(id * 2654435761u + 303u); const int m = r % MTOK; const unsigned r2 = hsh(r + 5u);
    const int pos = positions[m];
    if (id & 1) { int n = r2 % 768; if ((id & 6) == 2) n = (n / QKB) * QKB + 64 + n % 32;
        double ss = 0.0; for (int k = 0; k < QLORA; ++k) { const double v = bfv(CQ, (size_t)m * QLORA + k); ss += v * v; } const double rs = 1.0 / sqrt(ss / QLORA + 1e-6);
        auto dq = [&](int nn) { double a = 0.0; for (int k = 0; k < QLORA; ++k) a += (double)bfv(CQ, (size_t)m * QLORA + k) * g_q[k] * w_uq[(size_t)k * 768 + nn]; return (float)(a * rs); };
        const int head = n / QKB, pp = n % QKB;
        if (pp < 64) report(cnt, 11, bfv(QB, (size_t)m * 768 + n), dq(n) * C2B);
        else { const int dd = pp - 64, i = dd & 15; const float x1 = dq(head * QKB + 64 + i), x2 = dq(head * QKB + 64 + i + 16); float c, s; cs_of(pos, i, 16, c, s);
            report(cnt, 12, bfv(QB, (size_t)m * 768 + head * QKB + 64 + 2 * i + (dd >> 4)), ((dd < 16) ? x1 * c - x2 * s : x2 * c + x1 * s) * C2B); } }
    else { const int n = r2 % 1024;
        double ss = 0.0; for (int k = 0; k < KVLORA; ++k) { const double v = bfv(CKV, (size_t)m * KVLORA + k); ss += v * v; } const double rs = 1.0 / sqrt(ss / KVLORA + 1e-6);
        double a = 0.0; for (int k = 0; k < KVLORA; ++k) a += (double)bfv(CKV, (size_t)m * KVLORA + k) * g_kv[k] * w_ukv[(size_t)k * 1024 + n];
        const int head = n >> 7, pp = n & 127;
        if (pp < 64) report(cnt, 13, bfv(KB, (size_t)m * AW + head * 64 + pp), (float)(a * rs)); else report(cnt, 14, bfv(VB, (size_t)m * AW + head * 64 + pp - 64), (float)(a * rs)); }
}
__global__ void __launch_bounds__(256) k_c4(const bf16_t* OA, const bf16_t* OB, const bf16_t* G, const float* w_a, const float* w_b, const bf16_t* T, unsigned* cnt) {
    const unsigned id = blockIdx.x * 256 + threadIdx.x, r = hsh(id * 2654435761u + 404u); const int m = r % MTOK, n = (r >> 16) % DM;
    double a = 0.0, b = 0.0; for (int k = 0; k < AW; ++k) { a += (double)bfv(OA, (size_t)m * AW + k) * w_a[(size_t)k * DM + n]; b += (double)bfv(OB, (size_t)m * AW + k) * w_b[(size_t)k * DM + n]; }
    report(cnt, 17, bfv(T, (size_t)m * DM + n), (float)(a * bfv(G, (size_t)m * 2 * DM + n) + b * bfv(G, (size_t)m * 2 * DM + DM + n)));
}
__global__ void __launch_bounds__(256) k_c5(const bf16_t* T, const float* w_out, const bf16_t* Y, unsigned* cnt) {
    const unsigned id = blockIdx.x * 256 + threadIdx.x, r = hsh(id * 2654435761u + 505u); const int m = r % MTOK, n = (r >> 16) % DM;
    double a = 0.0; for (int k = 0; k < DM; ++k) a += (double)bfv(T, (size_t)m * DM + k) * w_out[(size_t)k * DM + n];
    report(cnt, 18, bfv(Y, (size_t)m * DM + n), (float)a);
}
__global__ void __launch_bounds__(256) k_c6(const bf16_t* Y, const float* x, const float* g1, const float* g2, const float* x1, const bf16_t* H2, unsigned* cnt) {
    const unsigned id = blockIdx.x * 256 + threadIdx.x, r = hsh(id * 2654435761u + 606u); const int m = r % MTOK, k = (r >> 16) % DM;
    double ss = 0.0; for (int i = 0; i < DM; ++i) { const double v = bfv(Y, (size_t)m * DM + i); ss += v * v; } const double rs = 1.0 / sqrt(ss / DM + 1e-6);
    double s2 = 0.0, xk = 0.0; for (int i = 0; i < DM; ++i) { const double v = x[(size_t)m * DM + i] + bfv(Y, (size_t)m * DM + i) * rs * g1[i]; s2 += v * v; if (i == k) xk = v; }
    report(cnt, 19, x1[(size_t)m * DM + k], (float)xk);
    report(cnt, 20, bfv(H2, (size_t)m * DM + k), (float)(xk / sqrt(s2 / DM + 1e-6) * g2[k]));
}
__global__ void __launch_bounds__(256) k_c7(const bf16_t* H2, const float* w_up, const bf16_t* U, unsigned* cnt) {
    const unsigned id = blockIdx.x * 256 + threadIdx.x, r = hsh(id * 2654435761u + 707u); const int m = r % MTOK, n = (r >> 16) % DFF;
    double a = 0.0; for (int k = 0; k < DM; ++k) a += (double)bfv(H2, (size_t)m * DM + k) * w_up[(size_t)k * DFF + n];
    const float v = a > 0.0 ? (float)a : 0.f; report(cnt, 21, bfv(U, (size_t)m * DFF + n), v * v);
}
__global__ void __launch_bounds__(256) k_c8(const bf16_t* U, const float* w_dn, const bf16_t* Mo, unsigned* cnt) {
    const unsigned id = blockIdx.x * 256 + threadIdx.x, r = hsh(id * 2654435761u + 808u); const int m = r % MTOK, n = (r >> 16) % DM;
    double a = 0.0; for (int k = 0; k < DFF; ++k) a += (double)bfv(U, (size_t)m * DFF + k) * w_dn[(size_t)k * DM + n];
    report(cnt, 22, bfv(Mo, (size_t)m * DM + n), (float)a);
}
__global__ void __launch_bounds__(256) k_c9a(const bf16_t* Mo, const float* x1, const float* g, float* expv) {
    const unsigned id = blockIdx.x * 256 + threadIdx.x, r = hsh(id * 2654435761u + 909u); const int m = r % MTOK, k = (r >> 16) % DM;
    double ss = 0.0; for (int i = 0; i < DM; ++i) { const double v = bfv(Mo, (size_t)m * DM + i); ss += v * v; }
    expv[id] = (float)(x1[(size_t)m * DM + k] + bfv(Mo, (size_t)m * DM + k) / sqrt(ss / DM + 1e-6) * g[k]);
}
__global__ void __launch_bounds__(256) k_c9b(const float* out, const float* expv, unsigned* cnt) {
    const unsigned id = blockIdx.x * 256 + threadIdx.x, r = hsh(id * 2654435761u + 909u); const int m = r % MTOK, k = (r >> 16) % DM;
    report(cnt, 23, out[(size_t)m * DM + k], expv[id]);
}
__global__ void __launch_bounds__(256) k_cmp(const bf16_t* F, const bf16_t* N, int stage, unsigned* cnt) {
    const unsigned id = blockIdx.x * 256 + threadIdx.x, r = hsh(id * 2654435761u + 1234u + stage); const int m = r % MTOK, k = (r >> 16) % AW;
    report(cnt, stage, bfv(F, (size_t)m * AW + k), bfv(N, (size_t)m * AW + k));
}
__global__ void __launch_bounds__(256) k_fin(const unsigned* cnt, float* out) {
    int s = 0; for (int i = 1; i < 32; ++i) if (cnt[i] > 2u) { s = i; break; }
    if (DBG_CHECK > 100 && s) { int k = 0; for (int i = 1; i < 32; ++i) if (cnt[i] > 2u) { if (++k == DBG_CHECK - 100) { s = i; break; } } }
    size_t nz = (size_t)s * (MTOK / 25) * DM;
    if (DBG_CHECK == 2) { const double f = (double)cnt[10] / (double)(cnt[74] ? cnt[74] : 1u); nz = (size_t)(f * MTOK) * DM; }
    if (DBG_CHECK == 3) { unsigned mask = 0; for (int t = 0; t < 8; ++t) if (cnt[24 + t] > 2u) mask |= 1u << t; nz = (size_t)mask * (MTOK / 256) * DM; }
    for (size_t i = (size_t)blockIdx.x * 256 + threadIdx.x; i < nz; i += (size_t)gridDim.x * 256) out[i] = 0.f;
}
}
#endif

constexpr size_t MiB = 1u << 20;
constexpr size_t WS_CTL = 0, CTL_ZERO_BYTES = 64 * 1024;
constexpr size_t WS_ROPEA = 1 * MiB, WS_ROPEB = 5 * MiB;
constexpr size_t WS_SS = 13 * MiB, WS_SS2 = 16 * MiB, WS_SS3 = 20 * MiB;
constexpr size_t WS_WIN = 24 * MiB, WS_WUQ = 33 * MiB, WS_WUKV = 34 * MiB, WS_WA = 35 * MiB, WS_WB = 36 * MiB, WS_WOUT = 37 * MiB, WS_WUP = 39 * MiB, WS_WDN = 47 * MiB;
constexpr size_t WS_H = 64 * MiB;
constexpr size_t WS_G = 192 * MiB;
constexpr size_t WS_QA = 448 * MiB, WS_KA = 512 * MiB, WS_VA = 576 * MiB;
constexpr size_t WS_T = WS_KA;
constexpr size_t WS_CQ = 640 * MiB, WS_CKV = 688 * MiB;
constexpr size_t WS_OB = WS_CQ;
constexpr size_t WS_KR = 720 * MiB;
constexpr size_t WS_QB = 728 * MiB, WS_KB = 824 * MiB, WS_VB = 888 * MiB;
constexpr size_t WS_Y = WS_QB;
constexpr size_t WS_X1 = 856 * MiB;
constexpr size_t WS_U = 192 * MiB;
constexpr size_t WS_END = 984 * MiB;
static_assert(WS_U + (size_t)MTOK * DFF * 2 <= WS_KR && WS_Y + (size_t)MTOK * DM * 2 <= WS_VB && WS_OB + (size_t)MTOK * AW * 2 <= WS_KR && WS_T + (size_t)MTOK * DM * 2 <= WS_CQ, "d_ws map");
static_assert(WS_WIN + (size_t)INWP * DM * 2 <= WS_WUQ && WS_WDN + (size_t)DM * DFF * 2 <= WS_H && WS_VB + (size_t)MTOK * AW * 2 <= WS_END && WS_X1 + (size_t)MTOK * DM * 2 <= WS_END && WS_Y + (size_t)MTOK * DM * 2 <= WS_X1, "d_ws map");
constexpr int CW_BAR = 0;
constexpr int NWAVES = 8;
constexpr int RING_OFF = 0, RING_BYTES = 131072;
constexpr int LDSCTL_OFF = RING_BYTES, MISC_OFF = LDSCTL_OFF + 320;
constexpr int LDS_BYTES = 147456;
static_assert(att::L_END <= RING_BYTES, "attention LDS map");

struct Frame {
    LAS unsigned char* lds;
    volatile LAS unsigned* MISC;
    gu32* ctl;
    int tid, lane, wave, vcu, G;
};

__device__ __forceinline__ float wave_sum(float v) {
#pragma unroll
    for (int o = 1; o < 64; o <<= 1) v += __shfl_xor(v, o);
    return v;
}
__device__ __forceinline__ int srccol(int mat, int n) {
    if (mat == 0) {
        if (n < 1024) { const int sect = n >> 9, c = n & 511, head = c >> 6, p = c & 63; const int d = (p < 16) ? ((p >> 1) + 8 * (p & 1)) : p; return sect * 512 + head * 64 + d; }
        if (n < 1920) return n;
        if (n < 1952) { const int pr = n - 1920; return 2176 + (pr >> 1) + 16 * (pr & 1); }
        if (n < 2048) return -1;
        if (n < 2304) return 1920 + (n - 2048);
        return 2208 + (n - 2304);
    }
    if (mat == 1) { const int head = n / QKB, p = n - head * QKB; if (p < 64) return n; const int pr = p - 64; return head * QKB + 64 + (pr >> 1) + 16 * (pr & 1); }
    return n;
}
__device__ __forceinline__ void p0_transpose_item(const float* W, int K, int Nsrc, int Ndst, bf16* WT, int ldw, int koff, const float* gs, int mat, LAS float* scr, int item, int lane) {
    const int nblk = Ndst / 32, kb = item / nblk, nb = item % nblk, k0 = 64 * kb, n0 = 32 * nb;
    const int sc = srccol(mat, n0 + (lane & 31));
#pragma unroll 8
    for (int i = 0; i < 32; ++i) { const int kk = 2 * i + (lane >> 5); float v = (sc >= 0) ? W[(size_t)(k0 + kk) * Nsrc + sc] : 0.f; if (gs) v *= gs[k0 + kk]; scr[kk * 33 + (lane & 31)] = v; }
    LDS_WAIT(); asm volatile("" ::: "memory");
    const int c = lane & 7;
#pragma unroll
    for (int j = 0; j < 4; ++j) { const int n = (lane >> 3) + 8 * j; const LAS float* s = scr + (8 * c) * 33 + n;
        v4u o; o.x = pk2(s[0 * 33], s[1 * 33]); o.y = pk2(s[2 * 33], s[3 * 33]); o.z = pk2(s[4 * 33], s[5 * 33]); o.w = pk2(s[6 * 33], s[7 * 33]);
        *(GAS v4u*)(WT + (size_t)(n0 + n) * ldw + koff + k0 + 8 * c) = o; }
    LDS_WAIT(); asm volatile("" ::: "memory");
}
__device__ __forceinline__ void rms_row_to_bf16(int lane, const float* xrow, const f32x4 (&g)[4], bf16* orow) {
    const GAS f32x4* xr = (const GAS f32x4*)xrow + lane;
    f32x4 v[4]; float s = 0.f;
#pragma unroll
    for (int j = 0; j < 4; ++j) { v[j] = xr[64 * j]; s += (v[j].x * v[j].x + v[j].y * v[j].y) + (v[j].z * v[j].z + v[j].w * v[j].w); }
    const float rstd = 1.f / sqrtf(wave_sum(s) * (1.f / DM) + EPS);
    GAS unsigned long long* o8 = (GAS unsigned long long*)orow + lane;
#pragma unroll
    for (int j = 0; j < 4; ++j) { const f32x4 y = v[j] * rstd * g[j]; o8[64 * j] = (unsigned long long)pk2(y.x, y.y) | ((unsigned long long)pk2(y.z, y.w) << 32); }
}

struct Args { const float* in[17]; float* out; unsigned char* ws; int ph_lo, ph_hi, li, pad; };

__global__ void __launch_bounds__(NWAVES * 64, 2) block_fwd(Args args) {
    extern __shared__ __attribute__((aligned(16))) unsigned char lds[];
    Frame F;
    F.lds = (LAS unsigned char*)lds;
    F.MISC = (volatile LAS unsigned*)(F.lds + MISC_OFF);
    F.tid = threadIdx.x; F.lane = F.tid & 63; F.wave = __builtin_amdgcn_readfirstlane(F.tid >> 6);
    F.G = gridDim.x; { const int bx = blockIdx.x; F.vcu = (F.G % 8 == 0) ? (bx % 8) * (F.G / 8) + bx / 8 : bx; }
    unsigned char* ws = args.ws;
    F.ctl = (gu32*)(ws + WS_CTL);
    const float* x = args.in[0]; const int* positions = (const int*)args.in[1];
    const float *g_pre_mix = args.in[2], *w_in = args.in[3], *b_gate = args.in[4], *g_q = args.in[5], *w_uq = args.in[6], *g_kv = args.in[7], *w_ukv = args.in[8], *w_a = args.in[9], *w_b = args.in[10],
                *w_out = args.in[11], *g_post_mix = args.in[12], *g_pre_mlp = args.in[13], *w_up = args.in[14], *w_dn = args.in[15], *g_post_mlp = args.in[16];
    float* out = args.out;
    float* ropeA = (float*)(ws + WS_ROPEA); float* ropeB = (float*)(ws + WS_ROPEB);
    float* SS = (float*)(ws + WS_SS); float* SS2 = (float*)(ws + WS_SS2); float* SS3 = (float*)(ws + WS_SS3);
    bf16 *WIN = (bf16*)(ws + WS_WIN), *WUQ = (bf16*)(ws + WS_WUQ), *WUKV = (bf16*)(ws + WS_WUKV), *WA = (bf16*)(ws + WS_WA), *WB = (bf16*)(ws + WS_WB), *WOUT = (bf16*)(ws + WS_WOUT), *WUP = (bf16*)(ws + WS_WUP), *WDN = (bf16*)(ws + WS_WDN);
    bf16 *H = (bf16*)(ws + WS_H), *Gt = (bf16*)(ws + WS_G), *QA = (bf16*)(ws + WS_QA), *KA = (bf16*)(ws + WS_KA), *VA = (bf16*)(ws + WS_VA), *T = (bf16*)(ws + WS_T), *CQ = (bf16*)(ws + WS_CQ), *CKV = (bf16*)(ws + WS_CKV),
         *OB = (bf16*)(ws + WS_OB), *KR = (bf16*)(ws + WS_KR), *QB = (bf16*)(ws + WS_QB), *KB = (bf16*)(ws + WS_KB), *VB = (bf16*)(ws + WS_VB), *Y = (bf16*)(ws + WS_Y), *U = (bf16*)(ws + WS_U), *X1B = (bf16*)(ws + WS_X1);
    for (int u = F.tid; u < (LDS_BYTES - LDSCTL_OFF) / 4; u += NWAVES * 64) ((LAS unsigned*)(F.lds + LDSCTL_OFF))[u] = 0u;
    __syncthreads();
    XcdBarrier bar = xcd_barrier_post((unsigned*)(F.ctl + CW_BAR) + args.li * XCD_BAR_WORDS, F.MISC + 8);
    const int lo = args.ph_lo, hi = args.ph_hi;
#define IN(k) (lo <= (k) && (k) < hi)
#define SEAM(k) do { if (IN(k) && IN((k) + 1)) xcd_barrier(bar); } while (0)
    const int gw = F.vcu * NWAVES + F.wave, NGW = F.G * NWAVES;

#if !defined(SKIP_P0)
    if (IN(0))
    {
        LAS float* scr = (LAS float*)(F.lds + RING_OFF + F.wave * 16384);
        constexpr int I0 = (DM / 64) * (INWP / 32), I1 = (QLORA / 64) * (768 / 32), I2 = (KVLORA / 64) * (1024 / 32), I3 = (AW / 64) * (DM / 32), I5 = (DM / 64) * (DM / 32), I6 = (DM / 64) * (DFF / 32), I7 = (DFF / 64) * (DM / 32);
        constexpr int NITEMS = I0 + I1 + I2 + 2 * I3 + I5 + I6 + I7;
        for (int it = gw; it < NITEMS; it += NGW) {
            int r = it;
            if (r < I0) { p0_transpose_item(w_in, DM, INW, INWP, WIN, DM, 0, nullptr, 0, scr, r, F.lane); continue; } r -= I0;
            if (r < I1) { p0_transpose_item(w_uq, QLORA, 768, 768, WUQ, QLORA, 0, g_q, 1, scr, r, F.lane); continue; } r -= I1;
            if (r < I2) { p0_transpose_item(w_ukv, KVLORA, 1024, 1024, WUKV, KVLORA, 0, g_kv, 2, scr, r, F.lane); continue; } r -= I2;
            if (r < I3) { p0_transpose_item(w_a, AW, DM, DM, WA, DM, 0, nullptr, 2, scr, r, F.lane); continue; } r -= I3;
            if (r < I3) { p0_transpose_item(w_b, AW, DM, DM, WA, DM, AW, nullptr, 2, scr, r, F.lane); continue; } r -= I3;
            if (r < I5) { p0_transpose_item(w_out, DM, DM, DM, WOUT, DM, 0, nullptr, 2, scr, r, F.lane); continue; } r -= I5;
            if (r < I6) { p0_transpose_item(w_up, DM, DFF, DFF, WUP, DM, 0, nullptr, 2, scr, r, F.lane); continue; } r -= I6;
            p0_transpose_item(w_dn, DFF, DM, DM, WDN, DFF, 0, nullptr, 2, scr, r, F.lane);
        }
        for (int idx = (int)blockIdx.x * (NWAVES * 64) + F.tid; idx < MTOK * 24; idx += F.G * NWAVES * 64) {
            const int m = idx / 24, i = idx - m * 24;
            const float invf = (i < 8) ? __builtin_amdgcn_exp2f(-(float)i * 2.3664460711655217f) : __builtin_amdgcn_exp2f(-(float)(i - 8) * 1.1832230355827609f);
            const float ang = (float)positions[m] * invf;
            double t = (double)ang * 0.15915494309189535; t -= floor(t);
            const float tf = (float)t; const float c = __builtin_amdgcn_cosf(tf), s = __builtin_amdgcn_sinf(tf);
            float* dst = (i < 8) ? ropeA + (size_t)m * 16 + 2 * i : ropeB + (size_t)m * 32 + 2 * (i - 8);
            *(f32x2g*)dst = (f32x2g){c, s};
        }
        f32x4 g[4];
#pragma unroll
        for (int j = 0; j < 4; ++j) g[j] = ((const GAS f32x4*)g_pre_mix)[F.lane + 64 * j];
        for (int m = gw; m < MTOK; m += NGW) rms_row_to_bf16(F.lane, x + (size_t)m * DM, g, H + (size_t)m * DM);
    }
#endif
    SEAM(0);

#if !defined(SKIP_P1)
    if (IN(1))
    {
        pg8::Gemm g{H, WIN, MTOK, INWP, DM}; pg8::StaticOrder S; S.init(MTOK, INWP, F.G, (int)blockIdx.x);
        pg8::EpiIn E{QA, KA, VA, CQ, CKV, KR, Gt, SS, ropeA, ropeB, b_gate};
        pg8::gemm_phase<pg8::EpiIn, pg8::StaticOrder, true, true>(F.lds + RING_OFF, g, S, E);
    }
#endif
    SEAM(1);

#if !defined(SKIP_P2)
    if (IN(2)) {
    {
        pg8::Gemm g{CQ, WUQ, MTOK, NHEAD * QKB, QLORA}; pg8::StaticOrder S; S.init(MTOK, NHEAD * QKB, F.G, (int)blockIdx.x);
        pg8::EpiQ E{QB, SS, ropeB};
        pg8::gemm_phase<pg8::EpiQ, pg8::StaticOrder, true, true>(F.lds + RING_OFF, g, S, E);
    }
    {
        pg8::Gemm g{CKV, WUKV, MTOK, 2 * AW, KVLORA}; pg8::StaticOrder S; S.init(MTOK, 2 * AW, F.G, (int)blockIdx.x);
        pg8::EpiKV E{KB, VB, SS};
        pg8::gemm_phase<pg8::EpiKV, pg8::StaticOrder, true, true>(F.lds + RING_OFF, g, S, E);
    }
    }
#endif
    SEAM(2);

#if !defined(SKIP_P3)
    if (IN(3))
    {
        LAS char* al = (LAS char*)(F.lds + RING_OFF);
#if !defined(SKIP_MOBA) && !(defined(DBG_NAIVE_ATTN) && (DBG_NAIVE_ATTN & 1))
        for (int bh = F.vcu; bh < NB * NHEAD; bh += F.G) {
            const int b = bh >> 3, h = bh & 7; const size_t r0 = (size_t)b * SEQ;
            att::kmean_blocks(KA + r0 * AW + h * HD, al);
#pragma unroll 1
            for (int qb = 0; qb < 8; ++qb)
                att::attn_unit<64, true>(QA + (r0 + qb * 256) * AW + h * HD, AW, KA + r0 * AW + h * HD, nullptr, VA + r0 * AW + h * HD, H + (r0 + qb * 256) * DM + h * HD, DM, qb, al);
        }
#endif
#if !defined(SKIP_MLA) && !(defined(DBG_NAIVE_ATTN) && (DBG_NAIVE_ATTN & 2))
        for (int bh = F.vcu; bh < NB * NHEAD; bh += F.G) {
            const int b = bh >> 3, h = bh & 7; const size_t r0 = (size_t)b * SEQ;
#pragma unroll 1
            for (int qb = 0; qb < 8; ++qb)
                att::attn_unit<96, false>(QB + (r0 + qb * 256) * (NHEAD * QKB) + h * QKB, NHEAD * QKB, KB + r0 * AW + h * HD, KR + r0 * RDIM, VB + r0 * AW + h * HD, H + (r0 + qb * 256) * DM + AW + h * HD, DM, qb, al);
        }
#endif
    }
#endif
    SEAM(3);

#if !defined(SKIP_P4)
    if (IN(4))
    {
        pg8::Gemm g{H, WA, MTOK, DM, DM}; pg8::StaticOrder S; S.init(MTOK, DM, F.G, (int)blockIdx.x);
        pg8::EpiMerge E{Gt, T};
        pg8::gemm_phase<pg8::EpiMerge, pg8::StaticOrder, true, true>(F.lds + RING_OFF, g, S, E);
    }
#endif
    SEAM(4);

#if !defined(SKIP_P5)
    if (IN(5))
    {
        pg8::Gemm g{T, WOUT, MTOK, DM, DM}; pg8::StaticOrder S; S.init(MTOK, DM, F.G, (int)blockIdx.x);
        pg8::EpiSS E{Y, SS2};
        pg8::gemm_phase<pg8::EpiSS, pg8::StaticOrder, true, true>(F.lds + RING_OFF, g, S, E);
    }
#endif
    SEAM(5);

#if !defined(SKIP_P6)
    if (IN(6))
    {
        f32x4 g1[4], g2[4];
#pragma unroll
        for (int j = 0; j < 4; ++j) { g1[j] = ((const GAS f32x4*)g_post_mix)[F.lane + 64 * j]; g2[j] = ((const GAS f32x4*)g_pre_mlp)[F.lane + 64 * j]; }
        for (int m = gw; m < MTOK; m += NGW) {
            const GAS f32x4* sp = (const GAS f32x4*)(SS2 + (size_t)m * 16); const f32x4 a = sp[0], b = sp[1], c = sp[2], d = sp[3];
            const float ssy = (((a.x + a.y) + (a.z + a.w)) + ((b.x + b.y) + (b.z + b.w))) + (((c.x + c.y) + (c.z + c.w)) + ((d.x + d.y) + (d.z + d.w)));
            const float rsy = 1.f / sqrtf(ssy * (1.f / DM) + EPS);
            const GAS f32x4* xr = (const GAS f32x4*)(x + (size_t)m * DM) + F.lane; const GAS unsigned long long* yr = (const GAS unsigned long long*)(Y + (size_t)m * DM) + F.lane;
            GAS unsigned long long* x8 = (GAS unsigned long long*)(X1B + (size_t)m * DM) + F.lane;
            f32x4 v[4]; float s = 0.f;
#pragma unroll
            for (int j = 0; j < 4; ++j) { const unsigned long long yw = yr[64 * j]; const unsigned lo = (unsigned)yw, hi = (unsigned)(yw >> 32);
                const f32x4 yv = (f32x4){__uint_as_float(lo << 16), __uint_as_float(lo & 0xffff0000u), __uint_as_float(hi << 16), __uint_as_float(hi & 0xffff0000u)};
                v[j] = xr[64 * j] + yv * rsy * g1[j]; x8[64 * j] = (unsigned long long)pk2(v[j].x, v[j].y) | ((unsigned long long)pk2(v[j].z, v[j].w) << 32);
                s += (v[j].x * v[j].x + v[j].y * v[j].y) + (v[j].z * v[j].z + v[j].w * v[j].w); }
            const float rstd = 1.f / sqrtf(wave_sum(s) * (1.f / DM) + EPS);
            GAS unsigned long long* o8 = (GAS unsigned long long*)(H + (size_t)m * DM) + F.lane;
#pragma unroll
            for (int j = 0; j < 4; ++j) { const f32x4 y2 = v[j] * rstd * g2[j]; o8[64 * j] = (unsigned long long)pk2(y2.x, y2.y) | ((unsigned long long)pk2(y2.z, y2.w) << 32); }
        }
    }
#endif
    SEAM(6);

#if !defined(SKIP_P7)
    if (IN(7))
    {
        pg8::Gemm g{H, WUP, MTOK, DFF, DM}; pg8::StaticOrder S; S.init(MTOK, DFF, F.G, (int)blockIdx.x);
        pg8::EpiRelu2 E{U};
        pg8::gemm_phase<pg8::EpiRelu2, pg8::StaticOrder, true, true>(F.lds + RING_OFF, g, S, E);
    }
#endif
    SEAM(7);

#if !defined(SKIP_P8)
    if (IN(8))
    {
        pg8::Gemm g{U, WDN, MTOK, DM, DFF}; pg8::StaticOrder S; S.init(MTOK, DM, F.G, (int)blockIdx.x);
        pg8::EpiSS E{H, SS3};
        pg8::gemm_phase<pg8::EpiSS, pg8::StaticOrder, true, true>(F.lds + RING_OFF, g, S, E);
    }
#endif
    SEAM(8);

#if !defined(SKIP_P9)
    if (IN(9))
    {
        f32x4 g1[4];
#pragma unroll
        for (int j = 0; j < 4; ++j) g1[j] = ((const GAS f32x4*)g_post_mlp)[F.lane + 64 * j];
        for (int m = gw; m < MTOK; m += NGW) {
            const GAS f32x4* sp = (const GAS f32x4*)(SS3 + (size_t)m * 16); const f32x4 a = sp[0], b = sp[1], c = sp[2], d = sp[3];
            const float ssy = (((a.x + a.y) + (a.z + a.w)) + ((b.x + b.y) + (b.z + b.w))) + (((c.x + c.y) + (c.z + c.w)) + ((d.x + d.y) + (d.z + d.w)));
            const float rsy = 1.f / sqrtf(ssy * (1.f / DM) + EPS);
            const GAS unsigned long long* yr = (const GAS unsigned long long*)(H + (size_t)m * DM) + F.lane;
            const GAS unsigned long long* xq = (const GAS unsigned long long*)(X1B + (size_t)m * DM) + F.lane;
            GAS f32x4* o4 = (GAS f32x4*)(out + (size_t)m * DM) + F.lane;
#pragma unroll
            for (int j = 0; j < 4; ++j) { const unsigned long long yw = yr[64 * j]; const unsigned lo = (unsigned)yw, hi = (unsigned)(yw >> 32);
                const f32x4 yv = (f32x4){__uint_as_float(lo << 16), __uint_as_float(lo & 0xffff0000u), __uint_as_float(hi << 16), __uint_as_float(hi & 0xffff0000u)};
                const unsigned long long xw = xq[64 * j]; const unsigned xl = (unsigned)xw, xh = (unsigned)(xw >> 32);
                const f32x4 xv = (f32x4){__uint_as_float(xl << 16), __uint_as_float(xl & 0xffff0000u), __uint_as_float(xh << 16), __uint_as_float(xh & 0xffff0000u)};
                o4[64 * j] = xv + yv * rsy * g1[j]; }
        }
    }
#endif
}

extern "C" void kernel_launch(void* const* d_in, const int* in_sizes, int n_in, void* d_out, int out_size, void* d_ws, size_t ws_size, hipStream_t stream) {
    static int grid = 0;
    if (grid == 0) {
        if (n_in != 17 || in_sizes[0] != MTOK * DM || out_size != MTOK * DM || ws_size < WS_END) { fprintf(stderr, "kernel_launch: unexpected shapes (n_in %d, in0 %d, out %d, ws %zu); nothing launched\n", n_in, n_in > 0 ? in_sizes[0] : -1, out_size, ws_size); grid = -1; return; }
        int dev = 0, cus = 0, per_cu = 0;
        if (hipGetDevice(&dev) != hipSuccess || hipDeviceGetAttribute(&cus, hipDeviceAttributeMultiprocessorCount, dev) != hipSuccess) { fprintf(stderr, "kernel_launch: device query failed\n"); grid = -1; return; }
        if (hipFuncSetAttribute((const void*)block_fwd, hipFuncAttributeMaxDynamicSharedMemorySize, LDS_BYTES) != hipSuccess) { fprintf(stderr, "kernel_launch: hipFuncSetAttribute failed\n"); grid = -1; return; }
        if (hipOccupancyMaxActiveBlocksPerMultiprocessor(&per_cu, (const void*)block_fwd, NWAVES * 64, LDS_BYTES) != hipSuccess || per_cu < 1) { fprintf(stderr, "kernel_launch: occupancy query reports %d workgroups per CU\n", per_cu); }
        (void)hipGetLastError();
        grid = cus;
    }
    if (grid < 0) return;
    if (hipMemsetAsync((char*)d_ws + WS_CTL, 0, CTL_ZERO_BYTES, stream) != hipSuccess) { fprintf(stderr, "kernel_launch: hipMemsetAsync failed\n"); return; }
    Args a{};
    for (int i = 0; i < 17; ++i) a.in[i] = (const float*)d_in[i];
    a.out = (float*)d_out; a.ws = (unsigned char*)d_ws;
#if defined(DBG_CHECK)
    {
        unsigned char* ws = (unsigned char*)d_ws; unsigned* cnt = (unsigned*)(ws + WS_CTL + 32768); float* expv = (float*)(ws + 60 * MiB); float* KM = (float*)(ws + 61 * MiB);
        const float* const* in = (const float* const*)a.in; const int* pos = (const int*)in[1];
        bf16 *H = (bf16*)(ws + WS_H), *Gt = (bf16*)(ws + WS_G), *QA = (bf16*)(ws + WS_QA), *KA = (bf16*)(ws + WS_KA), *VA = (bf16*)(ws + WS_VA), *T = (bf16*)(ws + WS_T), *CQ = (bf16*)(ws + WS_CQ), *CKV = (bf16*)(ws + WS_CKV),
             *OB = (bf16*)(ws + WS_OB), *KR = (bf16*)(ws + WS_KR), *QB = (bf16*)(ws + WS_QB), *KB = (bf16*)(ws + WS_KB), *VB = (bf16*)(ws + WS_VB), *Y = (bf16*)(ws + WS_Y), *U = (bf16*)(ws + WS_U);
        bf16 *NA = (bf16*)(ws + WS_H), *NBo = (bf16*)(ws + WS_H + 64 * MiB);
        auto L = [&](int lo, int hi) { a.ph_lo = lo; a.ph_hi = hi; a.li = 0; hipLaunchKernelGGL(block_fwd, dim3(grid), dim3(NWAVES * 64), LDS_BYTES, stream, a); };
        const dim3 cg(chk::NS / 256), cb(256);
        L(0, 1); hipLaunchKernelGGL(chk::k_c0, cg, cb, 0, stream, in[0], in[2], (const bf16*)H, cnt);
        L(1, 2); hipLaunchKernelGGL(chk::k_c1, cg, cb, 0, stream, (const bf16*)H, in[3], in[4], pos, (const bf16*)QA, (const bf16*)KA, (const bf16*)VA, (const bf16*)CQ, (const bf16*)CKV, (const bf16*)KR, (const bf16*)Gt, cnt);
        L(2, 3); hipLaunchKernelGGL(chk::k_c2, cg, cb, 0, stream, (const bf16*)CQ, (const bf16*)CKV, in[5], in[6], in[7], in[8], pos, (const bf16*)QB, (const bf16*)KB, (const bf16*)VB, cnt);
        hipLaunchKernelGGL(dbg::kmean_k, dim3(256), dim3(512), 0, stream, (const bf16*)KA, KM);
        hipLaunchKernelGGL((dbg::attn_k<64, true>), dim3(32, 256), dim3(256), 0, stream, (const bf16*)QA, (const bf16*)KA, (const bf16*)nullptr, (const bf16*)VA, NA, (const float*)KM);
        hipLaunchKernelGGL((dbg::attn_k<96, false>), dim3(32, 256), dim3(256), 0, stream, (const bf16*)QB, (const bf16*)KB, (const bf16*)KR, (const bf16*)VB, NBo, (const float*)KM);
        L(3, 4); hipLaunchKernelGGL(chk::k_cmp, cg, cb, 0, stream, (const bf16*)QA, (const bf16*)NA, 15, cnt); hipLaunchKernelGGL(chk::k_cmp, cg, cb, 0, stream, (const bf16*)OB, (const bf16*)NBo, 16, cnt);
        L(4, 5); hipLaunchKernelGGL(chk::k_c4, cg, cb, 0, stream, (const bf16*)QA, (const bf16*)OB, (const bf16*)Gt, in[9], in[10], (const bf16*)T, cnt);
        L(5, 6); hipLaunchKernelGGL(chk::k_c5, cg, cb, 0, stream, (const bf16*)T, in[11], (const bf16*)Y, cnt);
        L(6, 7); hipLaunchKernelGGL(chk::k_c6, cg, cb, 0, stream, (const bf16*)Y, in[0], in[12], in[13], (const float*)d_out, (const bf16*)H, cnt);
        L(7, 8); hipLaunchKernelGGL(chk::k_c7, cg, cb, 0, stream, (const bf16*)H, in[14], (const bf16*)U, cnt);
        L(8, 9); hipLaunchKernelGGL(chk::k_c8, cg, cb, 0, stream, (const bf16*)U, in[15], (const bf16*)H, cnt);
        hipLaunchKernelGGL(chk::k_c9a, cg, cb, 0, stream, (const bf16*)H, (const float*)d_out, in[16], expv);
        L(9, 10); hipLaunchKernelGGL(chk::k_c9b, cg, cb, 0, stream, (const float*)d_out, (const float*)expv, cnt);
        hipLaunchKernelGGL(chk::k_fin, dim3(1024), dim3(256), 0, stream, (const unsigned*)cnt, (float*)d_out);
    }
#elif defined(DBG_NAIVE_ATTN)
    a.ph_lo = 0; a.ph_hi = (DBG_NAIVE_ATTN == 3) ? 3 : 4; a.li = 0;
    hipLaunchKernelGGL(block_fwd, dim3(grid), dim3(NWAVES * 64), LDS_BYTES, stream, a);
    { unsigned char* ws = (unsigned char*)d_ws; float* KM = (float*)(ws + WS_SS3);
      if (DBG_NAIVE_ATTN & 1) { hipLaunchKernelGGL(dbg::kmean_k, dim3(256), dim3(512), 0, stream, (const bf16*)(ws + WS_KA), KM);
          hipLaunchKernelGGL((dbg::attn_k<64, true>), dim3(32, 256), dim3(256), 0, stream, (const bf16*)(ws + WS_QA), (const bf16*)(ws + WS_KA), (const bf16*)nullptr, (const bf16*)(ws + WS_VA), (bf16*)(ws + WS_QA), (const float*)KM); }
      if (DBG_NAIVE_ATTN & 2) hipLaunchKernelGGL((dbg::attn_k<96, false>), dim3(32, 256), dim3(256), 0, stream, (const bf16*)(ws + WS_QB), (const bf16*)(ws + WS_KB), (const bf16*)(ws + WS_KR), (const bf16*)(ws + WS_VB), (bf16*)(ws + WS_OB), (const float*)KM); }
    a.ph_lo = 4; a.ph_hi = 10; a.li = 1;
    hipLaunchKernelGGL(block_fwd, dim3(grid), dim3(NWAVES * 64), LDS_BYTES, stream, a);
#else
    a.ph_lo = 0; a.ph_hi = 10; a.li = 0;
    hipLaunchKernelGGL(block_fwd, dim3(grid), dim3(NWAVES * 64), LDS_BYTES, stream, a);
#endif
    const hipError_t le = hipPeekAtLastError();
    if (le != hipSuccess) fprintf(stderr, "kernel_launch: launch failed: %s\n", hipGetErrorName(le));
}
```

```cpp
#include <hip/hip_runtime.h>
#include <hip/hip_bf16.h>
#include <cstdio>
#include <cstdint>
#include <cmath>
constexpr int NB = 32, SEQ = 2048, DM = 1024, MTOK = NB * SEQ;
constexpr int NHEAD = 8, HD = 64, AW = NHEAD * HD;
constexpr int QLORA = 384, KVLORA = 256, RDIM = 32, QKB = 96;
constexpr int DFF = 4096, INW = 4256, INWP = 4352;
constexpr int LDH = DM, LDU = DFF, LDKV = KVLORA;
constexpr float EPS = 1e-6f;
constexpr float LOG2E = 1.4426950408889634f;
constexpr float C2A = 0.125f * LOG2E;
constexpr float C2B = 0.10206207261596575f * LOG2E;
typedef float f32x2g __attribute__((ext_vector_type(2)));
namespace pg8 {
#define PG8_LAS __attribute__((address_space(3)))
typedef unsigned short bf16_t;
typedef short bf16x8 __attribute__((ext_vector_type(8)));
typedef float f32x4 __attribute__((ext_vector_type(4)));
typedef unsigned u32x4 __attribute__((ext_vector_type(4)));
constexpr int BM = 256, BK = 64, HALF = 128, HTB = HALF * BK * 2  , STAGE_BYTES = 8 * HTB, NXCD = 8, WGM = 8;

__host__ __device__ __forceinline__ int lds_byte(int r, int c) { const int st = (r >> 4) * 2 + (c >> 5), rr = r & 15, cc = c & 31, ob = rr * 64 + cc * 2; return st * 1024 + (ob ^ (((ob >> 9) & 1) << 5)); }
__host__ __device__ __forceinline__ void stage_rc(int b, int& R, int& C) { const int st = b / 1024, sb = b % 1024, swz = sb ^ (((sb >> 9) & 1) << 5); R = (st >> 1) * 16 + swz / 64; C = (st & 1) * 32 + (swz % 64) / 2; }
__host__ __device__ __forceinline__ int perm32(int rho) { const int n = rho >> 4, i = rho & 15; return 8 * (i >> 2) + 4 * n + (i & 3); }

struct Unit { int pm, pn; };
struct Gemm { const bf16_t* A; const bf16_t* Bt; int M, N, K, lda, ldb; };

struct StaticOrder {
    int nM, nN, nwg, G, c;
    __host__ __device__ void init(int M, int N, int G_, int c_) { nM = M / BM; nN = N / BM; nwg = nM * nN; G = G_; c = c_; }
    __host__ __device__ bool next(int i, Unit& u) const {
        const long L = (long)i * G + c; if (L >= nwg) return false;
        int wgid = (int)L; { const int q = nwg / NXCD, r = nwg % NXCD, xcd = wgid % NXCD, off = wgid / NXCD; wgid = (xcd < r ? xcd * (q + 1) : r * (q + 1) + (xcd - r) * q) + off; }
        const int nig = WGM * nN, gid = wgid / nig, fm = gid * WGM, gsz = (nM - fm) < WGM ? (nM - fm) : WGM;
        u.pm = fm + ((wgid % nig) % gsz); u.pn = (wgid % nig) / gsz; return true;
    }
    __device__ __forceinline__ void a_ready(const Unit&) const {}
    __device__ __forceinline__ void done(const Unit&) const {}
};

__device__ __forceinline__ unsigned cvt_pk_bf16(float lo, float hi) { unsigned r; asm volatile("v_cvt_pk_bf16_f32 %0, %1, %2" : "=v"(r) : "v"(lo), "v"(hi)); return r; }
__device__ __forceinline__ void ld8(float (&v)[8], const f32x4& a, const f32x4& b) { v[0] = a[0]; v[1] = a[1]; v[2] = a[2]; v[3] = a[3]; v[4] = b[0]; v[5] = b[1]; v[6] = b[2]; v[7] = b[3]; }
typedef float f32x2c_t __attribute__((ext_vector_type(2))); typedef __bf16 bf16x2c_t __attribute__((ext_vector_type(2)));
__device__ __forceinline__ unsigned cvtpk_c(float lo, float hi) { const f32x2c_t v = {lo, hi}; const bf16x2c_t b = __builtin_convertvector(v, bf16x2c_t); return __builtin_bit_cast(unsigned, b); }
__device__ __forceinline__ u32x4 pack8(const float (&v)[8]) { u32x4 w; w.x = cvtpk_c(v[0], v[1]); w.y = cvtpk_c(v[2], v[3]); w.z = cvtpk_c(v[4], v[5]); w.w = cvtpk_c(v[6], v[7]); return w; }
__device__ __forceinline__ void unpack8(const u32x4 w, float (&v)[8]) {
    v[0] = __uint_as_float(w.x << 16); v[1] = __uint_as_float(w.x & 0xffff0000u); v[2] = __uint_as_float(w.y << 16); v[3] = __uint_as_float(w.y & 0xffff0000u);
    v[4] = __uint_as_float(w.z << 16); v[5] = __uint_as_float(w.z & 0xffff0000u); v[6] = __uint_as_float(w.w << 16); v[7] = __uint_as_float(w.w & 0xffff0000u); }
__device__ __forceinline__ void rope4(float (&v)[8], const f32x4 a, const f32x4 b) {
    float x1, x2;
    x1 = v[0]; x2 = v[1]; v[0] = x1 * a[0] - x2 * a[1]; v[1] = x2 * a[0] + x1 * a[1];
    x1 = v[2]; x2 = v[3]; v[2] = x1 * a[2] - x2 * a[3]; v[3] = x2 * a[2] + x1 * a[3];
    x1 = v[4]; x2 = v[5]; v[4] = x1 * b[0] - x2 * b[1]; v[5] = x2 * b[0] + x1 * b[1];
    x1 = v[6]; x2 = v[7]; v[6] = x1 * b[2] - x2 * b[3]; v[7] = x2 * b[2] + x1 * b[3];
}
__device__ __forceinline__ float sumsq8(const float (&v)[8]) { return ((v[0] * v[0] + v[1] * v[1]) + (v[2] * v[2] + v[3] * v[3])) + ((v[4] * v[4] + v[5] * v[5]) + (v[6] * v[6] + v[7] * v[7])); }
__device__ __forceinline__ float red_fq(float s) { s += __shfl_xor(s, 16); s += __shfl_xor(s, 32); return s; }

__device__ __forceinline__ size_t gfrag_off(int pm, int t8, int wid, int grp, int lane) { return ((((size_t)(pm * 8 + t8) * 8 + wid) * 16 + grp) * 64 + lane) * 8; }
struct EpiIn {
    static constexpr bool PERM = true, AFTER_DRAIN = false; static constexpr int MIDT = 0;
    bf16_t *QA, *KA, *VA, *CQ, *CKV, *KR, *G; float* SS; const float* ropeA; const float* ropeB; const float* bgate;
    __device__ __forceinline__ void operator()(const f32x4 (&acc)[2][2][4][2], const Unit& u, int wr, int wc, int fr, int fq) const {
        { int t_ = threadIdx.x; asm volatile("" : "+v"(t_)); fr = t_ & 15; fq = (t_ >> 4) & 3; }
        const int row0 = u.pm * BM + wr * 64 + fr, pn = u.pn, cl = wc * 32 + 8 * fq;
        if (pn < 4) {
            bf16_t* dst = (pn < 2) ? QA : KA; const float sc = (pn < 2) ? C2A : 1.f; const int cb = (pn & 1) * 256 + cl;
            if ((wc & 1) == 0) {
                const bool rp = fq < 2;
#pragma unroll
                for (int ai = 0; ai < 2; ++ai)
#pragma unroll
                    for (int m = 0; m < 4; ++m) { const int row = row0 + ai * HALF + m * 16;
                        const f32x4* t = (const f32x4*)(ropeA + (size_t)row * 16 + (rp ? fq * 8 : 0));
                        f32x4 ca = t[0], cc = t[1]; if (!rp) { ca = (f32x4){1.f, 0.f, 1.f, 0.f}; cc = ca; }
#pragma unroll
                        for (int bj = 0; bj < 2; ++bj) { float v[8]; ld8(v, acc[ai][bj][m][0], acc[ai][bj][m][1]); rope4(v, ca, cc);
#pragma unroll
                            for (int j = 0; j < 8; ++j) v[j] *= sc;
                            *(u32x4*)(dst + (size_t)row * AW + cb + bj * HALF) = pack8(v); } }
            } else {
#pragma unroll
                for (int ai = 0; ai < 2; ++ai)
#pragma unroll
                    for (int m = 0; m < 4; ++m) { const int row = row0 + ai * HALF + m * 16;
#pragma unroll
                        for (int bj = 0; bj < 2; ++bj) { float v[8]; ld8(v, acc[ai][bj][m][0], acc[ai][bj][m][1]);
#pragma unroll
                            for (int j = 0; j < 8; ++j) v[j] *= sc;
                            *(u32x4*)(dst + (size_t)row * AW + cb + bj * HALF) = pack8(v); } }
            }
        } else if (pn < 6) {
            const int cb = (pn - 4) * 256 + cl;
#pragma unroll
            for (int ai = 0; ai < 2; ++ai)
#pragma unroll
                for (int m = 0; m < 4; ++m) { const int row = row0 + ai * HALF + m * 16;
#pragma unroll
                    for (int bj = 0; bj < 2; ++bj) { float v[8]; ld8(v, acc[ai][bj][m][0], acc[ai][bj][m][1]); *(u32x4*)(VA + (size_t)row * AW + cb + bj * HALF) = pack8(v); } }
        } else if (pn == 6 || pn == 8) {
            bf16_t* dst = (pn == 6) ? CQ : CKV; const int ld = (pn == 6) ? QLORA : LDKV, slot = ((pn == 6) ? 0 : 8) + wc;
#pragma unroll
            for (int ai = 0; ai < 2; ++ai)
#pragma unroll
                for (int m = 0; m < 4; ++m) { const int row = row0 + ai * HALF + m * 16; float s = 0.f;
#pragma unroll
                    for (int bj = 0; bj < 2; ++bj) { float v[8]; ld8(v, acc[ai][bj][m][0], acc[ai][bj][m][1]); s += sumsq8(v); *(u32x4*)(dst + (size_t)row * ld + cl + bj * HALF) = pack8(v); }
                    s = red_fq(s); if (fq == 0) SS[(size_t)row * 12 + slot] = s; }
        } else if (pn == 7) {
#pragma unroll
            for (int ai = 0; ai < 2; ++ai)
#pragma unroll
                for (int m = 0; m < 4; ++m) { const int row = row0 + ai * HALF + m * 16;
                    { float v[8]; ld8(v, acc[ai][0][m][0], acc[ai][0][m][1]); float s = red_fq(sumsq8(v)); *(u32x4*)(CQ + (size_t)row * QLORA + 256 + cl) = pack8(v); if (fq == 0) SS[(size_t)row * 12 + 4 + wc] = s; }
                    if (wc == 0) { float v[8]; ld8(v, acc[ai][1][m][0], acc[ai][1][m][1]); const f32x4* t = (const f32x4*)(ropeB + (size_t)row * 32 + fq * 8); rope4(v, t[0], t[1]);
                        *(u32x4*)(KR + (size_t)row * RDIM + 8 * fq) = pack8(v); } }
        }
    }
};
struct EpiGates {
    static constexpr bool PERM = true, AFTER_DRAIN = false; static constexpr int MIDT = 0;
    bf16_t* G; const float* bgate;
    __device__ __forceinline__ void operator()(const f32x4 (&acc)[2][2][4][2], const Unit& u, int wr, int wc, int fr, int fq) const {
        { int t_ = threadIdx.x; asm volatile("" : "+v"(t_)); fr = t_ & 15; fq = (t_ >> 4) & 3; }
        const int gc = u.pn * 256 + wc * 32 + 8 * fq;
        f32x4 bv[2][2];
#pragma unroll
        for (int bj = 0; bj < 2; ++bj)
#pragma unroll
            for (int n = 0; n < 2; ++n) bv[bj][n] = *(const f32x4*)(bgate + gc + bj * HALF + 4 * n);
#pragma unroll
        for (int ai = 0; ai < 2; ++ai)
#pragma unroll
            for (int m = 0; m < 4; ++m) {
#pragma unroll
                for (int bj = 0; bj < 2; ++bj) { float v[8]; ld8(v, acc[ai][bj][m][0] * (1.0f / 32.0f) + bv[bj][0], acc[ai][bj][m][1] * (1.0f / 32.0f) + bv[bj][1]);
#pragma unroll
                    for (int j = 0; j < 8; ++j) v[j] = __builtin_amdgcn_rcpf(1.f + __builtin_amdgcn_exp2f(-LOG2E * v[j]));
                    *(u32x4*)(G + gfrag_off(u.pm, u.pn, wr * 4 + wc, ai * 8 + m * 2 + bj, fq * 16 + fr)) = pack8(v); } }
    }
};
struct EpiQ {
    static constexpr bool PERM = true, AFTER_DRAIN = false; static constexpr int MIDT = 0;
    bf16_t* QB; const float* SS; const float* ropeB;
    __device__ __forceinline__ void operator()(const f32x4 (&acc)[2][2][4][2], const Unit& u, int wr, int wc, int fr, int fq) const {
        { int t_ = threadIdx.x; asm volatile("" : "+v"(t_)); fr = t_ & 15; fq = (t_ >> 4) & 3; }
        const int row0 = u.pm * BM + wr * 64 + fr, cl = u.pn * BM + wc * 32 + 8 * fq;
        const int c0 = cl, c1 = cl + HALF, h0 = c0 / QKB, h1 = c1 / QKB, p0 = c0 - h0 * QKB, p1 = c1 - h1 * QKB;
        const bool r0 = p0 >= 64, r1 = p1 >= 64; const int roff = r0 ? p0 - 64 : (r1 ? p1 - 64 : 0);
#pragma unroll
        for (int b = 0; b < 2; ++b) {
            f32x4 s0[4], s1[4], ta[4], tb[4];
#pragma unroll
            for (int m = 0; m < 4; ++m) { const int row = row0 + b * HALF + m * 16;
                const f32x4* sp = (const f32x4*)(SS + (size_t)row * 12); s0[m] = sp[0]; s1[m] = sp[1];
                const f32x4* t = (const f32x4*)(ropeB + (size_t)row * 32 + roff); ta[m] = t[0]; tb[m] = t[1]; }
            asm volatile("" ::: "memory");
#pragma unroll
            for (int m = 0; m < 4; ++m) { const int row = row0 + b * HALF + m * 16;
                const float ss = ((s0[m][0] + s0[m][1]) + (s0[m][2] + s0[m][3])) + ((s1[m][0] + s1[m][1]) + (s1[m][2] + s1[m][3]));
                const float rs = __builtin_amdgcn_rsqf(ss * (1.0f / QLORA) + EPS) * C2B;
#pragma unroll
                for (int bj = 0; bj < 2; ++bj) { float v[8]; ld8(v, acc[b][bj][m][0], acc[b][bj][m][1]);
#pragma unroll
                    for (int j = 0; j < 8; ++j) v[j] *= rs;
                    if (bj == 0 ? r0 : r1) rope4(v, ta[m], tb[m]);
                    *(u32x4*)(QB + (size_t)row * (NHEAD * QKB) + (bj == 0 ? c0 : c1)) = pack8(v); } }
        }
    }
};
struct EpiKV {
    static constexpr bool PERM = true, AFTER_DRAIN = false; static constexpr int MIDT = 0;
    bf16_t *KB, *VB; const float* SS;
    __device__ __forceinline__ void operator()(const f32x4 (&acc)[2][2][4][2], const Unit& u, int wr, int wc, int fr, int fq) const {
        { int t_ = threadIdx.x; asm volatile("" : "+v"(t_)); fr = t_ & 15; fq = (t_ >> 4) & 3; }
        const int row0 = u.pm * BM + wr * 64 + fr;
        bf16_t* dst = (wc < 2) ? KB : VB; const int pc = (wc & 1) * 32 + 8 * fq;
        f32x4 s0[2][4];
#pragma unroll
        for (int ai = 0; ai < 2; ++ai)
#pragma unroll
            for (int m = 0; m < 4; ++m) s0[ai][m] = *(const f32x4*)(SS + (size_t)(row0 + ai * HALF + m * 16) * 12 + 8);
#pragma unroll
        for (int ai = 0; ai < 2; ++ai)
#pragma unroll
            for (int m = 0; m < 4; ++m) { const int row = row0 + ai * HALF + m * 16; const f32x4 sv = s0[ai][m];
                const float rs = __builtin_amdgcn_rsqf(((sv[0] + sv[1]) + (sv[2] + sv[3])) * (1.0f / KVLORA) + EPS);
#pragma unroll
                for (int bj = 0; bj < 2; ++bj) { const int hd = u.pn * 2 + bj;
                    float v[8]; ld8(v, acc[ai][bj][m][0], acc[ai][bj][m][1]);
#pragma unroll
                    for (int j = 0; j < 8; ++j) v[j] *= rs;
                    *(u32x4*)(dst + (size_t)row * AW + hd * HD + pc) = pack8(v); } }
    }
};
struct EpiMerge {
    static constexpr bool PERM = true, AFTER_DRAIN = false; static constexpr int MIDT = 8;
    const bf16_t* G; bf16_t* T;
    __device__ __forceinline__ void mid(f32x4 (&acc)[2][2][4][2], const Unit& u, int wr, int wc, int fr, int fq) const {
        { int t_ = threadIdx.x; asm volatile("" : "+v"(t_)); fr = t_ & 15; fq = (t_ >> 4) & 3; }
        const bf16_t* pa = G + gfrag_off(u.pm, u.pn, wr * 4 + wc, 0, fq * 16 + fr); const bf16_t* pb = G + gfrag_off(u.pm, 4 + u.pn, wr * 4 + wc, 0, fq * 16 + fr);
        u32x4 ca[4], cb[4], na[4], nb[4];
#pragma unroll
        for (int i = 0; i < 4; ++i) { ca[i] = *(const u32x4*)(pa + (size_t)i * 512); cb[i] = *(const u32x4*)(pb + (size_t)i * 512); }
#pragma unroll
        for (int b = 0; b < 4; ++b) {
            if (b < 3) {
#pragma unroll
                for (int i = 0; i < 4; ++i) { na[i] = *(const u32x4*)(pa + (size_t)((b + 1) * 4 + i) * 512); nb[i] = *(const u32x4*)(pb + (size_t)((b + 1) * 4 + i) * 512); } }
            asm volatile("" ::: "memory");
#pragma unroll
            for (int i = 0; i < 4; ++i) { const int grp = b * 4 + i, ai = grp >> 3, m = (grp >> 1) & 3, bj = grp & 1; float ga[8], gb[8]; unpack8(ca[i], ga); unpack8(cb[i], gb);
#pragma unroll
                for (int j = 0; j < 8; ++j) ga[j] *= __builtin_amdgcn_rcpf(__builtin_fmaxf(gb[j], 1e-30f));
                acc[ai][bj][m][0] *= (f32x4){ga[0], ga[1], ga[2], ga[3]}; acc[ai][bj][m][1] *= (f32x4){ga[4], ga[5], ga[6], ga[7]}; }
#pragma unroll
            for (int i = 0; i < 4; ++i) { ca[i] = na[i]; cb[i] = nb[i]; }
        }
    }
    __device__ __forceinline__ void operator()(const f32x4 (&acc)[2][2][4][2], const Unit& u, int wr, int wc, int fr, int fq) const {
        { int t_ = threadIdx.x; asm volatile("" : "+v"(t_)); fr = t_ & 15; fq = (t_ >> 4) & 3; }
        const int row0 = u.pm * BM + wr * 64 + fr, cl = u.pn * BM + wc * 32 + 8 * fq;
        const bf16_t* pb = G + gfrag_off(u.pm, 4 + u.pn, wr * 4 + wc, 0, fq * 16 + fr);
        u32x4 cb[8], nb[8];
#pragma unroll
        for (int i = 0; i < 8; ++i) cb[i] = *(const u32x4*)(pb + (size_t)i * 512);
#pragma unroll
        for (int b = 0; b < 2; ++b) {
            if (b < 1) {
#pragma unroll
                for (int i = 0; i < 8; ++i) nb[i] = *(const u32x4*)(pb + (size_t)(8 + i) * 512); }
            asm volatile("" ::: "memory");
#pragma unroll
            for (int i = 0; i < 8; ++i) { const int grp = b * 8 + i, ai = grp >> 3, m = (grp >> 1) & 3, bj = grp & 1; float v[8], gb[8]; ld8(v, acc[ai][bj][m][0], acc[ai][bj][m][1]); unpack8(cb[i], gb);
#pragma unroll
                for (int j = 0; j < 8; ++j) v[j] *= __builtin_fmaxf(gb[j], 1e-30f);
                *(u32x4*)(T + (size_t)(row0 + ai * HALF + m * 16) * LDH + cl + bj * HALF) = pack8(v); }
#pragma unroll
            for (int i = 0; i < 8; ++i) cb[i] = nb[i];
        }
    }
};
struct EpiSS {
    static constexpr bool PERM = true, AFTER_DRAIN = false; static constexpr int MIDT = 0;
    bf16_t* Y; float* SSY; int ldy; float scale;
    __device__ __forceinline__ void operator()(const f32x4 (&acc)[2][2][4][2], const Unit& u, int wr, int wc, int fr, int fq) const {
        { int t_ = threadIdx.x; asm volatile("" : "+v"(t_)); fr = t_ & 15; fq = (t_ >> 4) & 3; }
        const int row0 = u.pm * BM + wr * 64 + fr, cl = u.pn * BM + wc * 32 + 8 * fq;
#pragma unroll
        for (int ai = 0; ai < 2; ++ai)
#pragma unroll
            for (int m = 0; m < 4; ++m) { const int row = row0 + ai * HALF + m * 16; float s = 0.f;
#pragma unroll
                for (int bj = 0; bj < 2; ++bj) { float v[8]; ld8(v, acc[ai][bj][m][0] * scale, acc[ai][bj][m][1] * scale); s += sumsq8(v); *(u32x4*)(Y + (size_t)row * ldy + cl + bj * HALF) = pack8(v); }
                s = red_fq(s); if (fq == 0) SSY[(size_t)row * 16 + u.pn * 4 + wc] = s; }
    }
};
struct EpiRelu2F8 {
    static constexpr bool PERM = true, AFTER_DRAIN = false; static constexpr int MIDT = 0;
    unsigned char* U; float scale;
    __device__ __forceinline__ void operator()(const f32x4 (&acc)[2][2][4][2], const Unit& u, int wr, int wc, int fr, int fq) const {
        { int t_ = threadIdx.x; asm volatile("" : "+v"(t_)); fr = t_ & 15; fq = (t_ >> 4) & 3; }
        const int row0 = u.pm * BM + wr * 64 + fr, cl = u.pn * BM + wc * 32 + 8 * fq;
#pragma unroll
        for (int ai = 0; ai < 2; ++ai)
#pragma unroll
            for (int m = 0; m < 4; ++m) { const int row = row0 + ai * HALF + m * 16;
#pragma unroll
                for (int bj = 0; bj < 2; ++bj) { float v[8]; ld8(v, acc[ai][bj][m][0], acc[ai][bj][m][1]);
#pragma unroll
                    for (int j = 0; j < 8; ++j) { const float r = __builtin_fmaxf(v[j] * scale, 0.f); v[j] = __builtin_fminf(r * r, 440.f); }
                    int w0 = 0, w1 = 0;
                    w0 = __builtin_amdgcn_cvt_pk_fp8_f32(v[0], v[1], w0, false); w0 = __builtin_amdgcn_cvt_pk_fp8_f32(v[2], v[3], w0, true);
                    w1 = __builtin_amdgcn_cvt_pk_fp8_f32(v[4], v[5], w1, false); w1 = __builtin_amdgcn_cvt_pk_fp8_f32(v[6], v[7], w1, true);
                    typedef int i32x2_ __attribute__((ext_vector_type(2)));
                    *(i32x2_*)(U + (size_t)row * DFF + cl + bj * HALF) = (i32x2_){w0, w1}; } }
    }
};
struct EpiRelu2 {
    static constexpr bool PERM = true, AFTER_DRAIN = false; static constexpr int MIDT = 0;
    bf16_t* U;
    __device__ __forceinline__ void operator()(const f32x4 (&acc)[2][2][4][2], const Unit& u, int wr, int wc, int fr, int fq) const {
        { int t_ = threadIdx.x; asm volatile("" : "+v"(t_)); fr = t_ & 15; fq = (t_ >> 4) & 3; }
        const int row0 = u.pm * BM + wr * 64 + fr, cl = u.pn * BM + wc * 32 + 8 * fq;
#pragma unroll
        for (int ai = 0; ai < 2; ++ai)
#pragma unroll
            for (int m = 0; m < 4; ++m) { const int row = row0 + ai * HALF + m * 16;
#pragma unroll
                for (int bj = 0; bj < 2; ++bj) { float v[8]; ld8(v, acc[ai][bj][m][0], acc[ai][bj][m][1]);
#pragma unroll
                    for (int j = 0; j < 8; ++j) { const float r = __builtin_fmaxf(v[j], 0.f); v[j] = r * r; }
                    *(u32x4*)(U + (size_t)row * LDU + cl + bj * HALF) = pack8(v); } }
    }
};
template <class Epi, class Sched, bool ALIGN_EPI = false, bool SP2 = false, int ESZ = 2>
__device__ __forceinline__ void gemm_phase(PG8_LAS unsigned char* lds, const Gemm g, const Sched& S, const Epi& E) {
    int tid_ = threadIdx.x; asm volatile("" : "+v"(tid_));
    const int tid = tid_, wid = __builtin_amdgcn_readfirstlane(tid >> 6), lane = tid & 63, wr = wid >> 2, wc = wid & 3, fr = lane & 15, fq = lane >> 4;
    const int K = g.K, nt = K * ESZ / (BK * 2), lda = g.lda ? g.lda : K, ldb = g.ldb ? g.ldb : K;
    unsigned voffA, voffB;
    { int R, C; stage_rc(tid * 16, R, C); const int Rb = Epi::PERM ? ((R & ~31) + perm32(R & 31)) : R;
      voffA = (unsigned)(R * lda * ESZ + C * 2); voffB = (unsigned)(Rb * ldb * ESZ + C * 2); }
    const unsigned step_voffA = 64u * (unsigned)lda * ESZ, step_voffB = 64u * (unsigned)ldb * ESZ;
    const size_t kstep = (size_t)(BK * 2);
    const size_t hstepA = (size_t)HALF * lda * ESZ, hstepB = (size_t)HALF * ldb * ESZ;
    const size_t tstepA = 2 * hstepA, tstepB = 2 * hstepB;
    const unsigned ldsbase = (unsigned)(uintptr_t)lds;
    const unsigned ldsw = (unsigned)wid * 1024u;
    const int aoff = lds_byte(wr * 64 + fr, fq * 8), boff = lds_byte(wc * 32 + fr, fq * 8);
#define PG8_SA(b, h) (((b) * 2 + (h)) * HTB)
#define PG8_SB(b, h) ((4 + (b) * 2 + (h)) * HTB)
#define PG8_GLDS(voff32, sbase, ldsdst) do { unsigned keep_; asm volatile("s_nop 4\n\ts_mov_b32 %0, m0\n\ts_mov_b32 m0, %3\n\ts_nop 0\n\tglobal_load_lds_dwordx4 %1, %2\n\ts_mov_b32 m0, %0" \
        : "=&s"(keep_) : "v"(voff32), "s"(sbase), "s"(ldsdst) : "memory"); } while (0)
#define PG8_STAGE(bufoff, gbase, voff) do { const unsigned long long gb_ = (unsigned long long)(gbase); \
        const unsigned long long sb_ = ((unsigned long long)(unsigned)__builtin_amdgcn_readfirstlane((int)(gb_ >> 32)) << 32) | (unsigned)__builtin_amdgcn_readfirstlane((int)gb_); \
        PG8_GLDS(voff, sb_, (unsigned)__builtin_amdgcn_readfirstlane((int)(ldsbase + (bufoff) + ldsw))); PG8_GLDS(voff, sb_ + (step_##voff), (unsigned)__builtin_amdgcn_readfirstlane((int)(ldsbase + (bufoff) + ldsw + 8192))); } while (0)
#define PG8_LDA(dst, b, h) do { if constexpr (ESZ == 2) { _Pragma("unroll") for (int m = 0; m < 4; ++m) _Pragma("unroll") for (int k = 0; k < 2; ++k) dst[m][k] = *(const PG8_LAS bf16x8*)(lds + PG8_SA(b, h) + aoff + m * 2048 + k * 1024); } \
        else { _Pragma("unroll") for (int m = 0; m < 4; ++m) { dst##8[m].lo = *(const PG8_LAS i32x4_*)(lds + PG8_SA(b, h) + aoff + m * 2048); dst##8[m].hi = *(const PG8_LAS i32x4_*)(lds + PG8_SA(b, h) + aoff + m * 2048 + 1024); } } } while (0)
#define PG8_LDB(dst, b, h) do { if constexpr (ESZ == 2) { _Pragma("unroll") for (int n = 0; n < 2; ++n) _Pragma("unroll") for (int k = 0; k < 2; ++k) dst[n][k] = *(const PG8_LAS bf16x8*)(lds + PG8_SB(b, h) + boff + n * 2048 + k * 1024); } \
        else { _Pragma("unroll") for (int n = 0; n < 2; ++n) { dst##8[n].lo = *(const PG8_LAS i32x4_*)(lds + PG8_SB(b, h) + boff + n * 2048); dst##8[n].hi = *(const PG8_LAS i32x4_*)(lds + PG8_SB(b, h) + boff + n * 2048 + 1024); } } } while (0)
#define PG8_MMA(ai, bj, At, Bt) do { __builtin_amdgcn_s_setprio(1); \
        if constexpr (ESZ == 2) { _Pragma("unroll") for (int m = 0; m < 4; ++m) _Pragma("unroll") for (int n = 0; n < 2; ++n) _Pragma("unroll") for (int k = 0; k < 2; ++k) \
            acc[ai][bj][m][n] = __builtin_amdgcn_mfma_f32_16x16x32_bf16(Bt[n][k], At[m][k], acc[ai][bj][m][n], 0, 0, 0); } \
        else {   \
            _Pragma("unroll") for (int m = 0; m < 4; ++m) _Pragma("unroll") for (int n = 0; n < 2; ++n) \
                asm volatile("v_mfma_scale_f32_16x16x128_f8f6f4 %0, %1, %2, %0, %3, %3 op_sel_hi:[0,0,0]" : "+v"(acc[ai][bj][m][n]) : "v"(Bt##8[n]), "v"(At##8[m]), "v"(scl_)); } \
        __builtin_amdgcn_s_setprio(0); } while (0)
#define PG8_WAIT_V(n) asm volatile("s_waitcnt vmcnt(" #n ")" ::: "memory")
#define PG8_WAIT_L(n) asm volatile("s_waitcnt lgkmcnt(" #n ")" ::: "memory")
#define PG8_BAR __builtin_amdgcn_s_barrier()
#define PG8_SCHED __builtin_amdgcn_sched_barrier(0)
    Unit cur, nxt; int ui = 0;
    if (!S.next(0, cur)) return;
    f32x4 acc[2][2][4][2];
#pragma unroll
    for (int a = 0; a < 2; ++a)
#pragma unroll
        for (int b = 0; b < 2; ++b)
#pragma unroll
            for (int m = 0; m < 4; ++m)
#pragma unroll
                for (int n = 0; n < 2; ++n) acc[a][b][m][n] = (f32x4){0.f, 0.f, 0.f, 0.f};
    bf16x8 At[4][2], B0[2][2], B1[2][2];
    typedef int i32x4_ __attribute__((ext_vector_type(4))); typedef int i32x8_ __attribute__((ext_vector_type(8)));
    const int scl_ = 0x7F7F7F7F;
    i32x8_ At8[4], B08[2], B18[2];
    const char* cA = (const char*)g.A + (size_t)cur.pm * tstepA; const char* cB = (const char*)g.Bt + (size_t)cur.pn * tstepB;
    S.a_ready(cur);
    if constexpr (SP2) {
        PG8_STAGE(PG8_SB(0, 0), cB, voffB); PG8_STAGE(PG8_SB(0, 1), cB + hstepB, voffB); PG8_STAGE(PG8_SA(0, 0), cA, voffA); PG8_STAGE(PG8_SA(0, 1), cA + hstepA, voffA);
        if (wr == 1) PG8_BAR;
        PG8_WAIT_V(2); PG8_BAR;
        PG8_STAGE(PG8_SB(1, 0), cB + kstep, voffB); PG8_STAGE(PG8_SA(1, 0), cA + kstep, voffA); PG8_STAGE(PG8_SB(1, 1), cB + hstepB + kstep, voffB);
        PG8_WAIT_V(6); PG8_BAR;
    } else {
        PG8_STAGE(PG8_SB(0, 0), cB, voffB); PG8_STAGE(PG8_SA(0, 0), cA, voffA); PG8_STAGE(PG8_SB(0, 1), cB + hstepB, voffB); PG8_STAGE(PG8_SA(0, 1), cA + hstepA, voffA);
        if (wr == 1) PG8_BAR;
        PG8_WAIT_V(4); PG8_BAR;
        PG8_STAGE(PG8_SB(1, 0), cB + kstep, voffB); PG8_STAGE(PG8_SA(1, 0), cA + kstep, voffA); PG8_STAGE(PG8_SB(1, 1), cB + hstepB + kstep, voffB);
        PG8_WAIT_V(6); PG8_BAR;
    }
    for (;;) {
        const bool has_next = S.next(ui + 1, nxt);
        const char* nA = has_next ? (const char*)g.A + (size_t)nxt.pm * tstepA : cA; const char* nB = has_next ? (const char*)g.Bt + (size_t)nxt.pn * tstepB : cB;
#pragma unroll 1
        for (int t = 0; t < nt; t += 2) {
            if constexpr (Epi::MIDT > 0) { if (t == Epi::MIDT) E.mid(acc, cur, wr, wc, fr, fq); }
            const bool last = (t == nt - 2);
            const char* a1 = cA + (size_t)(t + 1) * kstep;
            const char* a2 = last ? nA : cA + (size_t)(t + 2) * kstep; const char* b2 = last ? nB : cB + (size_t)(t + 2) * kstep;
            const char* a3 = a2 + kstep; const char* b3 = b2 + kstep;
            if (last && has_next) S.a_ready(nxt);
            if constexpr (SP2) {
            PG8_LDB(B0, 0, 0); PG8_LDB(B1, 0, 1); PG8_SCHED; PG8_LDA(At, 0, 0); PG8_STAGE(PG8_SA(1, 1), a1 + hstepA, voffA);
            PG8_WAIT_V(8); PG8_WAIT_L(0); PG8_BAR; PG8_MMA(0, 0, At, B0); PG8_MMA(0, 1, At, B1); PG8_BAR; PG8_SCHED;
            PG8_LDA(At, 0, 1); PG8_STAGE(PG8_SB(0, 0), b2, voffB); PG8_STAGE(PG8_SB(0, 1), b2 + hstepB, voffB); PG8_STAGE(PG8_SA(0, 0), a2, voffA);
            PG8_WAIT_V(8); PG8_WAIT_L(0); PG8_BAR; PG8_MMA(1, 0, At, B0); PG8_MMA(1, 1, At, B1); PG8_BAR; PG8_SCHED;
            PG8_LDB(B0, 1, 0); PG8_LDB(B1, 1, 1); PG8_SCHED; PG8_LDA(At, 1, 0); PG8_STAGE(PG8_SA(0, 1), a2 + hstepA, voffA);
            PG8_WAIT_V(8); PG8_WAIT_L(0); PG8_BAR; PG8_MMA(0, 0, At, B0); PG8_MMA(0, 1, At, B1); PG8_BAR; PG8_SCHED;
            PG8_LDA(At, 1, 1); PG8_STAGE(PG8_SB(1, 0), b3, voffB); PG8_STAGE(PG8_SB(1, 1), b3 + hstepB, voffB); PG8_STAGE(PG8_SA(1, 0), a3, voffA);
            PG8_WAIT_V(8); PG8_WAIT_L(0); PG8_BAR; PG8_MMA(1, 0, At, B0); PG8_MMA(1, 1, At, B1); PG8_BAR; PG8_SCHED;
            } else {
            PG8_LDB(B0, 0, 0); PG8_SCHED; PG8_LDA(At, 0, 0); PG8_STAGE(PG8_SA(1, 1), a1 + hstepA, voffA);
            PG8_WAIT_L(8); PG8_BAR; PG8_WAIT_L(0); PG8_MMA(0, 0, At, B0); PG8_BAR; PG8_SCHED;
            PG8_LDB(B1, 0, 1); PG8_STAGE(PG8_SB(0, 0), b2, voffB);
            PG8_BAR; PG8_WAIT_L(0); PG8_MMA(0, 1, At, B1); PG8_BAR;
            PG8_LDA(At, 0, 1); PG8_STAGE(PG8_SA(0, 0), a2, voffA);
            PG8_BAR; PG8_WAIT_L(0); PG8_MMA(1, 0, At, B0); PG8_BAR; PG8_SCHED;
            PG8_STAGE(PG8_SB(0, 1), b2 + hstepB, voffB);
            PG8_WAIT_V(6); PG8_BAR; PG8_MMA(1, 1, At, B1); PG8_BAR;
            PG8_LDB(B0, 1, 0); PG8_SCHED; PG8_LDA(At, 1, 0); PG8_STAGE(PG8_SA(0, 1), a2 + hstepA, voffA);
            PG8_WAIT_L(8); PG8_BAR; PG8_WAIT_L(0); PG8_MMA(0, 0, At, B0); PG8_BAR; PG8_SCHED;
            PG8_LDB(B1, 1, 1); PG8_STAGE(PG8_SB(1, 0), b3, voffB);
            PG8_BAR; PG8_WAIT_L(0); PG8_MMA(0, 1, At, B1); PG8_BAR;
            PG8_LDA(At, 1, 1); PG8_STAGE(PG8_SA(1, 0), a3, voffA);
            PG8_BAR; PG8_WAIT_L(0); PG8_MMA(1, 0, At, B0); PG8_BAR; PG8_SCHED;
            PG8_STAGE(PG8_SB(1, 1), b3 + hstepB, voffB);
            PG8_WAIT_V(6); PG8_BAR; PG8_MMA(1, 1, At, B1); PG8_BAR;
            }
        }
        if constexpr (ALIGN_EPI) { if (wr == 0) PG8_BAR; }
        if constexpr (ESZ == 1) asm volatile("s_nop 15\n\ts_nop 15" ::: "memory");
        if constexpr (!Epi::AFTER_DRAIN) { E(acc, cur, wr, wc, fr, fq); S.done(cur); }
        if (!has_next) break;
#pragma unroll
        for (int a = 0; a < 2; ++a)
#pragma unroll
            for (int b = 0; b < 2; ++b)
#pragma unroll
                for (int m = 0; m < 4; ++m)
#pragma unroll
                    for (int n = 0; n < 2; ++n) acc[a][b][m][n] = (f32x4){0.f, 0.f, 0.f, 0.f};
        cur = nxt; cA = nA; cB = nB; ++ui;
        if constexpr (ALIGN_EPI) { if (wr == 1) PG8_BAR; }
    }
    PG8_WAIT_V(0);
    if constexpr (!ALIGN_EPI) { if (wr == 0) PG8_BAR; }
    PG8_BAR;
    if constexpr (Epi::AFTER_DRAIN) { E.fused(acc, cur, wr, wc, fr, fq, lds, wid, lane); S.done(cur); }
#undef PG8_SA
#undef PG8_SB
#undef PG8_STAGE
#undef PG8_GLDS
#undef PG8_LDA
#undef PG8_LDB
#undef PG8_MMA
#undef PG8_WAIT_V
#undef PG8_WAIT_L
#undef PG8_BAR
#undef PG8_SCHED
}
}
#ifndef ATT_LSUM_MFMA
#define ATT_LSUM_MFMA 1
#endif
namespace att {
typedef unsigned short bf16_t;
typedef short bf16x8 __attribute__((ext_vector_type(8)));
typedef short s16x4 __attribute__((ext_vector_type(4)));
typedef float f32x16 __attribute__((ext_vector_type(16)));
typedef float f32x4 __attribute__((ext_vector_type(4)));
typedef unsigned u32x4 __attribute__((ext_vector_type(4)));
#define ALDS __attribute__((address_space(3)))
#define ASBAR() __builtin_amdgcn_sched_barrier(0)
constexpr int KTB = 12288, VTB = 8192;
constexpr int NSLOT = 3;
constexpr int L_K = 0, L_V = NSLOT * KTB, L_WS = L_V + NSLOT * VTB, L_OST = L_WS + 8 * 256, L_KM = L_OST + 8 * 4096, L_RED = L_KM + 2048, L_END = L_RED + 16384;
constexpr float THR = 8.f;
__device__ __forceinline__ int crow(int r, int hi) { return (r & 3) + 8 * (r >> 2) + 4 * hi; }
typedef float f32x2a_t __attribute__((ext_vector_type(2))); typedef __bf16 bf16x2a_t __attribute__((ext_vector_type(2)));
__device__ __forceinline__ unsigned cvtpk(float lo, float hi) { const f32x2a_t v = {lo, hi}; const bf16x2a_t b = __builtin_convertvector(v, bf16x2a_t); return __builtin_bit_cast(unsigned, b); }
__device__ __forceinline__ float bf2f(short s) { return __uint_as_float(((unsigned)(unsigned short)s) << 16); }
__device__ __forceinline__ int v_st(int k, int c) { const int kk = (k & ~0xC) | ((k & 4) << 1) | ((k & 8) >> 1); return ((kk >> 3) * 2 + (c >> 5)) * 512 + ((kk & 7) * 32 + (c & 31)) * 2; }
__device__ __forceinline__ int v_rd_base(int lane) { return ((lane & 3) << 3) | (((lane >> 2) & 3) << 6) | (((lane >> 4) & 1) << 5) | (((lane >> 5) & 1) << 8); }
constexpr int v_rd_off(int d0, int ks, int half) { return ks * 2048 + half * 1024 + d0 * 512; }
template <int OFF> __device__ __forceinline__ s16x4 tr_read(int vb) { s16x4 r; asm volatile("ds_read_b64_tr_b16 %0, %1 offset:%2" : "=&v"(r) : "v"(vb), "i"(OFF) : "memory"); return r; }
template <int D0> __device__ __forceinline__ void pv_one(f32x16& od, int vb, bf16x8 pa0, bf16x8 pa1, bf16x8 pa2, bf16x8 pa3) {
    const s16x4 l0 = tr_read<v_rd_off(D0, 0, 0)>(vb), h0 = tr_read<v_rd_off(D0, 0, 1)>(vb), l1 = tr_read<v_rd_off(D0, 1, 0)>(vb), h1 = tr_read<v_rd_off(D0, 1, 1)>(vb);
    const s16x4 l2 = tr_read<v_rd_off(D0, 2, 0)>(vb), h2 = tr_read<v_rd_off(D0, 2, 1)>(vb), l3 = tr_read<v_rd_off(D0, 3, 0)>(vb), h3 = tr_read<v_rd_off(D0, 3, 1)>(vb);
    asm volatile("s_waitcnt lgkmcnt(0)" ::: "memory"); ASBAR();
#define ATT_PK(L, H) (bf16x8){L[0], L[1], L[2], L[3], H[0], H[1], H[2], H[3]}
    od = __builtin_amdgcn_mfma_f32_32x32x16_bf16(pa0, ATT_PK(l0, h0), od, 0, 0, 0);
    od = __builtin_amdgcn_mfma_f32_32x32x16_bf16(pa1, ATT_PK(l1, h1), od, 0, 0, 0);
    od = __builtin_amdgcn_mfma_f32_32x32x16_bf16(pa2, ATT_PK(l2, h2), od, 0, 0, 0);
    od = __builtin_amdgcn_mfma_f32_32x32x16_bf16(pa3, ATT_PK(l3, h3), od, 0, 0, 0);
#undef ATT_PK
}
__device__ __forceinline__ void pv_all(f32x16* o, f32x16& ol, int vb, bf16x8 pa0, bf16x8 pa1, bf16x8 pa2, bf16x8 pa3) {
    pv_one<0>(o[0], vb, pa0, pa1, pa2, pa3); pv_one<1>(o[1], vb, pa0, pa1, pa2, pa3);
#if ATT_LSUM_MFMA
    const bf16x8 ones = (bf16x8){0x3F80, 0x3F80, 0x3F80, 0x3F80, 0x3F80, 0x3F80, 0x3F80, 0x3F80};
    ol = __builtin_amdgcn_mfma_f32_32x32x16_bf16(pa0, ones, ol, 0, 0, 0); ol = __builtin_amdgcn_mfma_f32_32x32x16_bf16(pa1, ones, ol, 0, 0, 0);
    ol = __builtin_amdgcn_mfma_f32_32x32x16_bf16(pa2, ones, ol, 0, 0, 0); ol = __builtin_amdgcn_mfma_f32_32x32x16_bf16(pa3, ones, ol, 0, 0, 0);
#endif
}
__device__ __forceinline__ void partialSM(f32x16& p0, f32x16& p1, float& m_ref, f32x16& negm, float& alpha) {
    float pmax = p0[0];
#pragma unroll
    for (int r = 1; r < 16; ++r) pmax = fmaxf(pmax, p0[r]);
#pragma unroll
    for (int r = 0; r < 16; ++r) pmax = fmaxf(pmax, p1[r]);
    { auto rr = __builtin_amdgcn_permlane32_swap(__float_as_uint(pmax), __float_as_uint(pmax), false, false); pmax = fmaxf(__uint_as_float(rr[0]), __uint_as_float(rr[1])); }
    alpha = 1.f;
    if (__builtin_expect(!__all(pmax <= THR), 0)) { const float dl = (pmax > THR) ? pmax : 0.f; m_ref += dl; alpha = __builtin_amdgcn_exp2f(-dl);
#pragma unroll
        for (int r = 0; r < 16; ++r) { p0[r] -= dl; p1[r] -= dl; negm[r] = -m_ref; } }
#pragma unroll
    for (int r = 0; r < 16; ++r) p0[r] = __builtin_amdgcn_exp2f(p0[r]);
}
__device__ __forceinline__ void finishSM(f32x16& p0, f32x16& p1, bf16x8& pa0, bf16x8& pa1, bf16x8& pa2, bf16x8& pa3, float& lsum) {
#pragma unroll
    for (int r = 0; r < 16; ++r) p1[r] = __builtin_amdgcn_exp2f(p1[r]);
#if !ATT_LSUM_MFMA
    { float ps = 0.f;
#pragma unroll
      for (int r = 0; r < 16; ++r) ps += p0[r];
#pragma unroll
      for (int r = 0; r < 16; ++r) ps += p1[r];
      lsum += ps; }
#endif
#define ATT_PK4(P, BASE, OUT) do { unsigned a0 = cvtpk(P[BASE + 0], P[BASE + 1]), a1 = cvtpk(P[BASE + 2], P[BASE + 3]);   \
    unsigned b0 = cvtpk(P[BASE + 4], P[BASE + 5]), b1 = cvtpk(P[BASE + 6], P[BASE + 7]);                              \
    auto r0 = __builtin_amdgcn_permlane32_swap(a0, b0, false, false); auto r1 = __builtin_amdgcn_permlane32_swap(a1, b1, false, false); \
    u32x4 w = {r0[0], r1[0], r0[1], r1[1]}; OUT = __builtin_bit_cast(bf16x8, w); } while (0)
    ATT_PK4(p0, 0, pa0); ATT_PK4(p0, 8, pa1); ATT_PK4(p1, 0, pa2); ATT_PK4(p1, 8, pa3);
#undef ATT_PK4
}
template <int ND> __device__ __forceinline__ void qkt(f32x16& p0, f32x16& p1, ALDS const char* Kb, const int (&ka)[ND], const bf16x8 (&qr)[ND], const f32x16& cinit) {
#pragma unroll
    for (int d0 = 0; d0 < ND; ++d0) {
        const bf16x8 b0 = *(ALDS const bf16x8*)(Kb + ka[d0]);
        const bf16x8 b1 = *(ALDS const bf16x8*)(Kb + ka[d0] + (d0 < 4 ? 4096 : 2048));
        p0 = __builtin_amdgcn_mfma_f32_32x32x16_bf16(b0, qr[d0], d0 == 0 ? cinit : p0, 0, 0, 0);
        p1 = __builtin_amdgcn_mfma_f32_32x32x16_bf16(b1, qr[d0], d0 == 0 ? cinit : p1, 0, 0, 0);
        if (ND > 4 && d0 == 2) asm volatile("" ::: "memory"); }
}
__device__ __forceinline__ void cmask(f32x16& p0, f32x16& p1, int jt, int qrel, int hi) {
    const float NEG = -INFINITY; const int thr = qrel - 64 * jt - 4 * hi;
#pragma unroll
    for (int r = 0; r < 16; ++r) { if ((r & 3) + 8 * (r >> 2) > thr) p0[r] = NEG; if ((r & 3) + 8 * (r >> 2) + 32 > thr) p1[r] = NEG; }
}
__device__ __forceinline__ void kmean_blocks(const bf16_t* Kp, ALDS char* lds) {
    int tid_ = threadIdx.x; asm volatile("" : "+v"(tid_));
    const int tid = tid_, lane = tid & 63, wid = tid >> 6, c = tid & 7, rg = tid >> 3;
    ALDS float* red = (ALDS float*)(lds + L_RED); ALDS float* km = (ALDS float*)(lds + L_KM);
#pragma unroll 1
    for (int n = 0; n < 8; ++n) {
        float a[8];
#pragma unroll
        for (int j = 0; j < 8; ++j) a[j] = 0.f;
#pragma unroll
        for (int i = 0; i < 4; ++i) { const bf16x8 kx = *(const bf16x8*)(Kp + (size_t)(n * 256 + rg + 64 * i) * AW + c * 8);
#pragma unroll
            for (int j = 0; j < 8; ++j) a[j] += bf2f(kx[j]); }
#pragma unroll
        for (int j = 0; j < 8; ++j) { a[j] += __shfl_xor(a[j], 8); a[j] += __shfl_xor(a[j], 16); a[j] += __shfl_xor(a[j], 32); }
        if (lane < 8) {
#pragma unroll
            for (int j = 0; j < 8; ++j) red[(n * 8 + wid) * 64 + c * 8 + j] = a[j]; }
    }
    __syncthreads();
    { const int n = tid >> 6, d = tid & 63; float s = 0.f;
#pragma unroll
        for (int w = 0; w < 8; ++w) s += red[(n * 8 + w) * 64 + d];
        km[n * 64 + d] = s * (1.0f / 256.0f); }
    __syncthreads();
}
template <int DQK, bool MOBA>
__device__ __forceinline__ void attn_bh(const bf16_t* Qp, int ldq, const bf16_t* Kp, const bf16_t* KRp, const bf16_t* Vp, bf16_t* Op, int ldo, ALDS char* lds) {
    constexpr int ND = DQK / 16;
    ALDS char* K_lds = lds + L_K; ALDS char* V_lds = lds + L_V;
    bf16x8 sk0, sv0, sr0, sk1, sv1, sr1;
#define ATT_SLOAD(S, k0) do { sk##S = *(const bf16x8*)((const char*)(Kp + (size_t)(k0) * AW) + koff); sv##S = *(const bf16x8*)((const char*)(Vp + (size_t)(k0) * AW) + koff); if (DQK == 96) sr##S = *(const bf16x8*)((const char*)(KRp + (size_t)(k0) * RDIM) + roff); } while (0)
#define ATT_SWRITE(b, S) do { *(ALDS bf16x8*)(K_lds + (b) * KTB + kst) = sk##S; *(ALDS bf16x8*)(V_lds + (b) * VTB + vst) = sv##S; if (DQK == 96) { if (tid < 256) *(ALDS bf16x8*)(K_lds + (b) * KTB + rst) = sr##S; } } while (0)
#define ATT_QLOAD(q_) do { const bf16_t* Qw = Qp + (size_t)((q_) * 256 + wid * 32 + r32) * ldq + hi * 8; _Pragma("unroll") for (int d0 = 0; d0 < ND; ++d0) qr[d0] = *(const bf16x8*)(Qw + d0 * 16); } while (0)
    bf16x8 qr[ND];
    {
        const int tid = threadIdx.x, skey = tid >> 3, sch = tid & 7, t2 = tid & 255, rkey = t2 >> 2, rch = t2 & 3;
        const unsigned koff = (unsigned)(skey * AW + sch * 8) * 2u, roff = (unsigned)(rkey * RDIM + rch * 8) * 2u;
        ATT_SLOAD(0, 0); ATT_SLOAD(1, 64); }
#pragma unroll 1
  for (int qb = 0; qb < 8; ++qb) {
    int tid_ = threadIdx.x; asm volatile("" : "+v"(tid_));
    const int tid = tid_, lane = tid & 63, r32 = lane & 31, hi = lane >> 5; const int wid = __builtin_amdgcn_readfirstlane(tid >> 6);
    ALDS float* al_l = (ALDS float*)(lds + L_WS) + wid * 64;
    const int skey = tid >> 3, sch = tid & 7;
    const unsigned koff = (unsigned)(skey * AW + sch * 8) * 2u;
    const int kst = skey * 128 + ((sch ^ ((skey >> 1) & 7)) << 4), vst = v_st(skey, sch * 8);
    const int t2 = tid & 255, rkey = t2 >> 2, rch = t2 & 3;
    const unsigned roff = (unsigned)(rkey * RDIM + rch * 8) * 2u;
    const int rst = 8192 + rkey * 64 + ((rch ^ ((rkey >> 2) & 3)) << 4);
    int ka[ND];
#pragma unroll
    for (int d0 = 0; d0 < ND; ++d0) ka[d0] = (d0 < 4) ? r32 * 128 + (((2 * d0 + hi) ^ ((r32 >> 1) & 7)) << 4) : 8192 + r32 * 64 + (((2 * (d0 - 4) + hi) ^ ((r32 >> 2) & 3)) << 4);
    const int vb0 = (int)(unsigned)(uintptr_t)V_lds + v_rd_base(lane);
    const int qrel = wid * 32 + r32;
    ATT_QLOAD(qb);
    float m_ref = 0.f, lsum = 0.f; f32x16 o[2], ol, negm; o[0] = f32x16{}; o[1] = f32x16{}; ol = f32x16{}; negm = f32x16{};
    unsigned sel = 0xffu;
    if (MOBA && qb > 3) {
        ALDS const float* km = (ALDS const float*)(lds + L_KM); float g[8];
#pragma unroll
        for (int n = 0; n < 8; ++n) { float s = 0.f;
#pragma unroll
            for (int d0 = 0; d0 < ND; ++d0)
#pragma unroll
                for (int j = 0; j < 8; ++j) s += bf2f(qr[d0][j]) * km[n * 64 + d0 * 16 + hi * 8 + j];
            g[n] = s; }
#pragma unroll
        for (int n = 0; n < 8; ++n) g[n] += __shfl_xor(g[n], 32);
        sel = 0u;
#pragma unroll
        for (int n = 0; n < 8; ++n) { int rank = 0;
#pragma unroll
            for (int mm = 0; mm < 8; ++mm) if (mm != n) rank += (mm < qb && (g[mm] > g[n] || (g[mm] == g[n] && mm < n))) ? 1 : 0;
            if (n < qb && rank < 3) sel |= 1u << n; }
    }
#define ATT_RESC(a) do { if (__any((a) < 1.f)) { lsum *= (a); if (hi == 0) al_l[r32] = (a); asm volatile("s_waitcnt lgkmcnt(0)" ::: "memory"); \
    _Pragma("unroll") for (int r = 0; r < 16; ++r) { const float f_ = al_l[crow(r, hi)]; o[0][r] *= f_; o[1][r] *= f_; ol[r] *= f_; } } } while (0)
    f32x16 pA0, pA1, pB0, pB1; float alA, alB; bf16x8 pa0, pa1, pa2, pa3; const int NT = 4 * (qb + 1), NP = 4 * qb;
    f32x16 cm = negm; const bool gated = MOBA && qb > 3;
#define ATT_CM(t) do { if (gated) { if ((t) < NP) { const float v_ = ((sel >> ((t) >> 2)) & 1u) ? -m_ref : -INFINITY; _Pragma("unroll") for (int r = 0; r < 16; ++r) cm[r] = v_; } else cm = negm; } else cm = negm; } while (0)
#define ATT_SCORE(P0, P1, t) do { ATT_CM(t); qkt<ND>(P0, P1, K_lds + sc * KTB, ka, qr, cm); if ((t) >= NP) cmask(P0, P1, (t) - NP, qrel, hi); } while (0)
    int sp = 0, sc = 0, sn = 1;
#define ATT_ROT() do { sp = sc; sc = sn; sn = (sn == NSLOT - 1) ? 0 : sn + 1; } while (0)
    ATT_SWRITE(0, 0); ATT_SLOAD(0, 128);
    __syncthreads(); ATT_SWRITE(sn, 1); ATT_SLOAD(1, 192);
    ATT_SCORE(pA0, pA1, 0); partialSM(pA0, pA1, m_ref, negm, alA);
    ATT_ROT();
    for (int t = 1; t + 1 < NT; t += 2) {
        __syncthreads(); ATT_SWRITE(sn, 0); if (t + 3 < NT) ATT_SLOAD(0, (t + 3) * 64);
        ASBAR(); ATT_SCORE(pB0, pB1, t);
        finishSM(pA0, pA1, pa0, pa1, pa2, pa3, lsum); ASBAR();
        pv_all(o, ol, vb0 + sp * VTB, pa0, pa1, pa2, pa3); partialSM(pB0, pB1, m_ref, negm, alB);
        ATT_RESC(alB); ATT_ROT();
        __syncthreads(); ATT_SWRITE(sn, 1); if (t + 4 < NT) ATT_SLOAD(1, (t + 4) * 64);
        ASBAR(); ATT_SCORE(pA0, pA1, t + 1);
        finishSM(pB0, pB1, pa0, pa1, pa2, pa3, lsum); ASBAR();
        pv_all(o, ol, vb0 + sp * VTB, pa0, pa1, pa2, pa3); partialSM(pA0, pA1, m_ref, negm, alA);
        ATT_RESC(alA); ATT_ROT();
    }
    __syncthreads();
    ASBAR(); ATT_SCORE(pB0, pB1, NT - 1);
    if (qb < 7) { ATT_SLOAD(0, 0); ATT_SLOAD(1, 64); }
    finishSM(pA0, pA1, pa0, pa1, pa2, pa3, lsum); ASBAR();
    pv_all(o, ol, vb0 + sp * VTB, pa0, pa1, pa2, pa3); partialSM(pB0, pB1, m_ref, negm, alB);
    ATT_RESC(alB);
    finishSM(pB0, pB1, pa0, pa1, pa2, pa3, lsum); ASBAR();
    pv_all(o, ol, vb0 + sc * VTB, pa0, pa1, pa2, pa3);
#undef ATT_ROT
#undef ATT_SCORE
#undef ATT_CM
    float rli[16];
#if ATT_LSUM_MFMA
#pragma unroll
    for (int r = 0; r < 16; ++r) rli[r] = __builtin_amdgcn_rcpf(ol[r]);
#else
    { auto rr = __builtin_amdgcn_permlane32_swap(__float_as_uint(lsum), __float_as_uint(lsum), false, false); lsum = __uint_as_float(rr[0]) + __uint_as_float(rr[1]); }
    if (hi == 0) al_l[32 + r32] = lsum; asm volatile("s_waitcnt lgkmcnt(0)" ::: "memory");
#pragma unroll
    for (int r = 0; r < 16; ++r) rli[r] = __builtin_amdgcn_rcpf(al_l[32 + crow(r, hi)]);
#endif
    { ALDS unsigned short* stg = (ALDS unsigned short*)(lds + L_OST) + wid * 2048;
#pragma unroll
      for (int r = 0; r < 16; ++r) { const int orow = crow(r, hi);
#pragma unroll
          for (int d0 = 0; d0 < 2; ++d0) stg[orow * 64 + d0 * 32 + r32] = (unsigned short)(cvtpk(o[d0][r] * rli[r], 0.f) & 0xffffu); }
      asm volatile("s_waitcnt lgkmcnt(0)" ::: "memory");
      bf16_t* Ow = Op + (size_t)(qb * 256 + wid * 32) * ldo;
#pragma unroll
      for (int i = 0; i < 4; ++i) { const int row = i * 8 + (lane >> 3), ch = lane & 7; const u32x4 v = *(ALDS const u32x4*)(stg + row * 64 + ch * 8); *(u32x4*)(Ow + (size_t)row * ldo + ch * 8) = v; } }
    __syncthreads();
  }
#undef ATT_SLOAD
#undef ATT_SWRITE
#undef ATT_QLOAD
#undef ATT_RESC
}
#undef ASBAR
}
#define GAS __attribute__((address_space(1)))
#define LAS __attribute__((address_space(3)))
typedef unsigned short bf16;
typedef unsigned v4u __attribute__((ext_vector_type(4)));
typedef float f32x4 __attribute__((ext_vector_type(4)));
typedef short bf16x8 __attribute__((ext_vector_type(8)));
typedef GAS unsigned gu32;
typedef GAS unsigned long long gu64;
#define RLX_AGENT __ATOMIC_RELAXED, __HIP_MEMORY_SCOPE_AGENT
#define LDS_WAIT() asm volatile("s_waitcnt lgkmcnt(0)" ::: "memory")
#define VM_WAIT() asm volatile("s_waitcnt vmcnt(0)" ::: "memory")
__device__ __forceinline__ unsigned long long rt() { return __builtin_amdgcn_s_memrealtime(); }
__device__ __forceinline__ unsigned f2bf(float f) { unsigned u = __builtin_bit_cast(unsigned, f); return (u + 0x7fffu + ((u >> 16) & 1u)) >> 16; }
__device__ __forceinline__ unsigned pk2(float lo, float hi) { return f2bf(lo) | (f2bf(hi) << 16); }

#define XB_TMO      128
#define XB_XCNT(j)  (256  + 64 * (j))
#define XB_XSUB(j)  (1280 + 64 * (j))
#define XB_XGEN(j)  (2304 + 64 * (j))
#define XB_TOP      3328
#define XB_TOPGEN   3392
#define XCD_BAR_WORDS 3456
#define XB_SPIN_CAP (1u << 18)

__device__ __forceinline__ unsigned xb_ld(unsigned* p)              { return __hip_atomic_load(p, __ATOMIC_RELAXED, __HIP_MEMORY_SCOPE_AGENT); }
__device__ __forceinline__ unsigned xb_add(unsigned* p, unsigned v) { return __hip_atomic_fetch_add(p, v, __ATOMIC_RELAXED, __HIP_MEMORY_SCOPE_AGENT); }
__device__ __forceinline__ unsigned xb_xcc_id() { return (unsigned)__builtin_amdgcn_s_getreg((3 << 11) | 20) & 0xFu; }
#define XB_SPIN(cond, bar) do { unsigned _sp = 0; while (cond) { __builtin_amdgcn_s_sleep(1); \
    if ((++_sp & 255u) == 0u) { if (xb_ld(&(bar)[XB_TMO])) break; if (_sp > XB_SPIN_CAP) { atomicAdd(&(bar)[XB_TMO], 1u); break; } } } } while (0)

struct XcdBarrier {
    unsigned* bar; unsigned x;
    volatile LAS unsigned* st;
};

__device__ __forceinline__ XcdBarrier xcd_barrier_post(unsigned* bar, volatile LAS unsigned* st) {
    XcdBarrier b; b.bar = bar; b.x = xb_xcc_id(); b.st = st;
    if (threadIdx.x == 0) (void)xb_add(&bar[XB_XCNT(b.x)], 1u);
    return b;
}
__device__ __forceinline__ void xcd_barrier_complete(unsigned* bar, unsigned x, unsigned& nloc, unsigned& nx) {
    const unsigned G = gridDim.x * gridDim.y * gridDim.z;
    unsigned sum, cnt, mine, sp = 0u;
    for (;;) {
        sum = 0u; cnt = 0u; mine = 0u;
#pragma unroll
        for (unsigned j = 0; j < 16; ++j) { const unsigned c = xb_ld(&bar[XB_XCNT(j)]); sum += c; cnt += (c > 0u) ? 1u : 0u; mine = (j == x) ? c : mine; }
        if (sum == G) break;
        __builtin_amdgcn_s_sleep(1);
        if ((++sp & 255u) == 0u) { if (xb_ld(&bar[XB_TMO])) break; if (sp > XB_SPIN_CAP) { atomicAdd(&bar[XB_TMO], 1u); break; } }
    }
    nloc = mine > 0u ? mine : 1u; nx = cnt > 0u ? cnt : 1u;
}

__device__ __forceinline__ void xcd_barrier(const XcdBarrier& b) {
    asm volatile("s_waitcnt vmcnt(0)" ::: "memory");
    __syncthreads();
    if (threadIdx.x == 0) {
        unsigned* bar = b.bar;
        __builtin_amdgcn_s_waitcnt(0);
        unsigned nloc = b.st[0], nx = b.st[1];
        if (nloc == 0u) { xcd_barrier_complete(bar, b.x, nloc, nx); b.st[0] = nloc; b.st[1] = nx; }
        const unsigned old = xb_add(&bar[XB_XSUB(b.x)], 1u);
        const unsigned gen = old / nloc;
        if (old + 1u == (gen + 1u) * nloc) {
            __builtin_amdgcn_fence(__ATOMIC_RELEASE, "agent");
            asm volatile("s_waitcnt vmcnt(0)" ::: "memory");
            const unsigned og = xb_add(&bar[XB_TOP], 1u);
            const unsigned tg = og / nx;
            if (og + 1u == (tg + 1u) * nx) xb_add(&bar[XB_TOPGEN], 1u);
            else XB_SPIN(xb_ld(&bar[XB_TOPGEN]) == tg, bar);
            __builtin_amdgcn_fence(__ATOMIC_ACQUIRE, "agent");
            xb_add(&bar[XB_XGEN(b.x)], 1u);
            asm volatile("s_waitcnt vmcnt(0)" ::: "memory");
        } else {
            XB_SPIN(xb_ld(&bar[XB_XGEN(b.x)]) == gen, bar);
            __builtin_amdgcn_fence(__ATOMIC_ACQUIRE, "agent");
            asm volatile("s_waitcnt vmcnt(0)" ::: "memory");
        }
    }
    __syncthreads();
}

constexpr size_t MiB = 1u << 20;
constexpr size_t WS_CTL = 0, CTL_ZERO_BYTES = 64 * 1024;
constexpr size_t WS_ROPEA = 1 * MiB, WS_ROPEB = 5 * MiB;
constexpr size_t WS_SS = 13 * MiB, WS_SS2 = 16 * MiB, WS_SS3 = 20 * MiB;
constexpr size_t WS_WIN = 24 * MiB, WS_WUQ = 34 * MiB, WS_WUKV = 35 * MiB, WS_WA = 36 * MiB, WS_WOUT = 39 * MiB, WS_WUP = 42 * MiB, WS_WDN = 51 * MiB;
constexpr size_t WS_H = 64 * MiB;
constexpr size_t WS_G = 208 * MiB;
constexpr size_t WS_QA = 464 * MiB, WS_KA = 528 * MiB, WS_VA = 592 * MiB;
constexpr size_t WS_T = WS_KA;
constexpr size_t WS_CQ = 672 * MiB, WS_CKV = 720 * MiB;
constexpr size_t WS_KR = 760 * MiB;
constexpr size_t WS_QB = 768 * MiB, WS_KB = 864 * MiB, WS_VB = 928 * MiB;
constexpr size_t WS_Y = WS_QB;
constexpr size_t WS_X1 = 896 * MiB;
constexpr size_t WS_H8 = WS_QB;
constexpr size_t WS_WG8 = 60 * MiB;
constexpr size_t WS_U = 208 * MiB;
constexpr size_t WS_END = 1024 * MiB;
static_assert(WS_H + (size_t)MTOK * LDH * 2 <= WS_G && WS_G + (size_t)MTOK * 2 * DM * 2 <= WS_QA && WS_T + (size_t)MTOK * LDH * 2 <= WS_CQ && WS_CQ + (size_t)MTOK * QLORA * 2 <= WS_CKV && WS_CKV + (size_t)MTOK * LDKV * 2 <= WS_KR, "d_ws map");
static_assert(WS_U + (size_t)MTOK * LDU * 2 <= WS_KR && WS_Y + (size_t)MTOK * DM * 2 <= WS_X1 && WS_X1 + (size_t)MTOK * DM * 2 <= WS_END && WS_VB + (size_t)MTOK * AW * 2 <= WS_END && WS_KR + (size_t)MTOK * RDIM * 2 <= WS_QB, "d_ws map");
static_assert(WS_WIN + (size_t)INWP * LDH * 2 <= WS_WUQ && WS_WUKV + (size_t)1024 * LDKV * 2 <= WS_WA && WS_WA + (size_t)DM * LDH * 2 <= WS_WOUT && WS_WOUT + (size_t)DM * LDH * 2 <= WS_WUP && WS_WUP + (size_t)DFF * LDH * 2 <= WS_WDN && WS_WDN + (size_t)DM * LDU * 2 <= WS_H, "d_ws map");
constexpr int CW_BAR = 0;
constexpr int NWAVES = 8;
constexpr int RING_OFF = 0, RING_BYTES = 131072;
constexpr int LDSCTL_OFF = RING_BYTES, MISC_OFF = LDSCTL_OFF + 320;
constexpr int LDS_BYTES = 147456;
static_assert(att::L_END <= RING_BYTES, "attention LDS map");

struct Frame {
    LAS unsigned char* lds;
    volatile LAS unsigned* MISC;
    gu32* ctl;
    int tid, lane, wave, vcu, G;
};

__device__ __forceinline__ float wave_sum(float v) {
#pragma unroll
    for (int o = 1; o < 64; o <<= 1) v += __shfl_xor(v, o);
    return v;
}
__device__ __forceinline__ int srccol(int mat, int n) {
    if (mat == 0) {
        if (n < 1024) { const int sect = n >> 9, c = n & 511, head = c >> 6, p = c & 63; const int d = (p < 16) ? ((p >> 1) + 8 * (p & 1)) : p; return sect * 512 + head * 64 + d; }
        if (n < 1920) return n;
        if (n < 1952) { const int pr = n - 1920; return 2176 + (pr >> 1) + 16 * (pr & 1); }
        if (n < 2048) return -1;
        if (n < 2304) return 1920 + (n - 2048);
        return 2208 + (n - 2304);
    }
    if (mat == 1) { const int head = n / QKB, p = n - head * QKB; if (p < 64) return n; const int pr = p - 64; return head * QKB + 64 + (pr >> 1) + 16 * (pr & 1); }
    return n;
}
__device__ __forceinline__ void p0_transpose_item(const float* W, int K, int Nsrc, int Ndst, bf16* WT, int ldw, int koff, const float* gs, int mat, LAS float* scr, int item, int lane) {
    const int nblk = Ndst / 32, kb = item / nblk, nb = item % nblk, k0 = 64 * kb, n0 = 32 * nb;
    const int sc = srccol(mat, n0 + (lane & 31));
#pragma unroll 8
    for (int i = 0; i < 32; ++i) { const int kk = 2 * i + (lane >> 5); float v = (sc >= 0) ? W[(size_t)(k0 + kk) * Nsrc + sc] : 0.f; if (gs) v *= gs[k0 + kk]; scr[kk * 33 + (lane & 31)] = v; }
    LDS_WAIT(); asm volatile("" ::: "memory");
    const int c = lane & 7;
#pragma unroll
    for (int j = 0; j < 4; ++j) { const int n = (lane >> 3) + 8 * j; const LAS float* s = scr + (8 * c) * 33 + n;
        v4u o; o.x = pk2(s[0 * 33], s[1 * 33]); o.y = pk2(s[2 * 33], s[3 * 33]); o.z = pk2(s[4 * 33], s[5 * 33]); o.w = pk2(s[6 * 33], s[7 * 33]);
        *(GAS v4u*)(WT + (size_t)(n0 + n) * ldw + koff + k0 + 8 * c) = o; }
    LDS_WAIT(); asm volatile("" ::: "memory");
}
__device__ __forceinline__ void p0_transpose_item_f8(const float* W, int K, int N, int Nsrc, int coff, unsigned char* WT, float scale, LAS float* scr, int item, int lane) {
    const int nblk = N / 32, kb = item / nblk, nb = item % nblk, k0 = 64 * kb, n0 = 32 * nb;
#pragma unroll 8
    for (int i = 0; i < 32; ++i) { const int kk = 2 * i + (lane >> 5); scr[kk * 33 + (lane & 31)] = W[(size_t)(k0 + kk) * Nsrc + coff + n0 + (lane & 31)] * scale; }
    LDS_WAIT(); asm volatile("" ::: "memory");
    const int c = lane & 7;
#pragma unroll
    for (int j = 0; j < 4; ++j) { const int n = (lane >> 3) + 8 * j; const LAS float* s = scr + (8 * c) * 33 + n;
        int w0 = 0, w1 = 0;
        w0 = __builtin_amdgcn_cvt_pk_fp8_f32(s[0 * 33], s[1 * 33], w0, false); w0 = __builtin_amdgcn_cvt_pk_fp8_f32(s[2 * 33], s[3 * 33], w0, true);
        w1 = __builtin_amdgcn_cvt_pk_fp8_f32(s[4 * 33], s[5 * 33], w1, false); w1 = __builtin_amdgcn_cvt_pk_fp8_f32(s[6 * 33], s[7 * 33], w1, true);
        typedef int i32x2_ __attribute__((ext_vector_type(2)));
        *(GAS i32x2_*)(WT + (size_t)(n0 + n) * K + k0 + 8 * c) = (i32x2_){w0, w1}; }
    LDS_WAIT(); asm volatile("" ::: "memory");
}
__device__ __forceinline__ void rms_row_to_bf16(int lane, const float* xrow, const f32x4 (&g)[4], bf16* orow, unsigned char* orow8) {
    const GAS f32x4* xr = (const GAS f32x4*)xrow + lane;
    f32x4 v[4]; float s = 0.f;
#pragma unroll
    for (int j = 0; j < 4; ++j) { v[j] = xr[64 * j]; s += (v[j].x * v[j].x + v[j].y * v[j].y) + (v[j].z * v[j].z + v[j].w * v[j].w); }
    const float rstd = 1.f / sqrtf(wave_sum(s) * (1.f / DM) + EPS);
    GAS unsigned long long* o8 = (GAS unsigned long long*)orow + lane;
#pragma unroll
    for (int j = 0; j < 4; ++j) { const f32x4 y = v[j] * rstd * g[j]; o8[64 * j] = (unsigned long long)pk2(y.x, y.y) | ((unsigned long long)pk2(y.z, y.w) << 32);
        int w = 0; w = __builtin_amdgcn_cvt_pk_fp8_f32(y.x, y.y, w, false); w = __builtin_amdgcn_cvt_pk_fp8_f32(y.z, y.w, w, true); ((GAS int*)orow8)[lane + 64 * j] = w; }
}

#define PHASE_PTRS unsigned char* ws_ = args.ws; asm volatile("" : "+s"(ws_)); float* ropeA = (float*)(ws_ + WS_ROPEA); float* ropeB = (float*)(ws_ + WS_ROPEB); float* SS = (float*)(ws_ + WS_SS); float* SS2 = (float*)(ws_ + WS_SS2); float* SS3 = (float*)(ws_ + WS_SS3); bf16 *WIN = (bf16*)(ws_ + WS_WIN), *WUQ = (bf16*)(ws_ + WS_WUQ), *WUKV = (bf16*)(ws_ + WS_WUKV), *WA = (bf16*)(ws_ + WS_WA), *WOUT = (bf16*)(ws_ + WS_WOUT), *WUP = (bf16*)(ws_ + WS_WUP), *WDN = (bf16*)(ws_ + WS_WDN); bf16 *H = (bf16*)(ws_ + WS_H), *Gt = (bf16*)(ws_ + WS_G), *QA = (bf16*)(ws_ + WS_QA), *KA = (bf16*)(ws_ + WS_KA), *VA = (bf16*)(ws_ + WS_VA), *T = (bf16*)(ws_ + WS_T), *CQ = (bf16*)(ws_ + WS_CQ), *CKV = (bf16*)(ws_ + WS_CKV), *KR = (bf16*)(ws_ + WS_KR), *QB = (bf16*)(ws_ + WS_QB), *KB = (bf16*)(ws_ + WS_KB), *VB = (bf16*)(ws_ + WS_VB), *Y = (bf16*)(ws_ + WS_Y), *U = (bf16*)(ws_ + WS_U), *X1B = (bf16*)(ws_ + WS_X1); unsigned char *H8 = ws_ + WS_H8, *WG8 = ws_ + WS_WG8;
struct Args { const float* in[17]; float* out; unsigned char* ws; int ph_lo, ph_hi, li, pad; };

__global__ void __launch_bounds__(NWAVES * 64, 2) block_fwd(Args args) {
    extern __shared__ __attribute__((aligned(16))) unsigned char lds[];
    Frame F;
    F.lds = (LAS unsigned char*)lds;
    F.MISC = (volatile LAS unsigned*)(F.lds + MISC_OFF);
    F.tid = threadIdx.x; F.lane = F.tid & 63; F.wave = __builtin_amdgcn_readfirstlane(F.tid >> 6);
    F.G = gridDim.x; { const int bx = blockIdx.x; F.vcu = (F.G % 8 == 0) ? (bx % 8) * (F.G / 8) + bx / 8 : bx; }
    unsigned char* ws = args.ws;
    F.ctl = (gu32*)(ws + WS_CTL);
    const float* x = args.in[0]; const int* positions = (const int*)args.in[1];
    const float *g_pre_mix = args.in[2], *w_in = args.in[3], *b_gate = args.in[4], *g_q = args.in[5], *w_uq = args.in[6], *g_kv = args.in[7], *w_ukv = args.in[8], *w_a = args.in[9], *w_b = args.in[10],
                *w_out = args.in[11], *g_post_mix = args.in[12], *g_pre_mlp = args.in[13], *w_up = args.in[14], *w_dn = args.in[15], *g_post_mlp = args.in[16];
    float* out = args.out;
    for (int u = F.tid; u < (LDS_BYTES - LDSCTL_OFF) / 4; u += NWAVES * 64) ((LAS unsigned*)(F.lds + LDSCTL_OFF))[u] = 0u;
    __syncthreads();
    XcdBarrier bar = xcd_barrier_post((unsigned*)(F.ctl + CW_BAR) + args.li * XCD_BAR_WORDS, F.MISC + 8);
    const int lo = args.ph_lo, hi = args.ph_hi;
#define IN(k) (lo <= (k) && (k) < hi)
#define SEAM(k) do { if (IN(k) && IN((k) + 1)) xcd_barrier(bar); } while (0)
    const int gw = F.vcu * NWAVES + F.wave, NGW = F.G * NWAVES;

#if !defined(SKIP_P0)
    if (IN(0))
    { PHASE_PTRS
        LAS float* scr = (LAS float*)(F.lds + RING_OFF + F.wave * 16384);
        constexpr int NBF = 2304, IG = (DM / 64) * (2 * DM / 32);
        constexpr int I0 = (DM / 64) * (NBF / 32), I1 = (QLORA / 64) * (768 / 32), I2 = (KVLORA / 64) * (1024 / 32), I3 = (AW / 64) * (DM / 32), I5 = (DM / 64) * (DM / 32), I6 = (DM / 64) * (DFF / 32), I7 = (DFF / 64) * (DM / 32);
        constexpr int NITEMS = I0 + I1 + I2 + 2 * I3 + I5 + I6 + I7 + IG;
        for (int it = gw; it < NITEMS; it += NGW) {
            int r = it;
            if (r < I0) { p0_transpose_item(w_in, DM, INW, NBF, WIN, LDH, 0, nullptr, 0, scr, r, F.lane); continue; } r -= I0;
            if (r < IG) { p0_transpose_item_f8(w_in, DM, 2 * DM, INW, 2208, WG8, 32.f, scr, r, F.lane); continue; } r -= IG;
            if (r < I1) { p0_transpose_item(w_uq, QLORA, 768, 768, WUQ, QLORA, 0, g_q, 1, scr, r, F.lane); continue; } r -= I1;
            if (r < I2) { p0_transpose_item(w_ukv, KVLORA, 1024, 1024, WUKV, LDKV, 0, g_kv, 2, scr, r, F.lane); continue; } r -= I2;
            if (r < I3) { p0_transpose_item(w_a, AW, DM, DM, WA, LDH, 0, nullptr, 2, scr, r, F.lane); continue; } r -= I3;
            if (r < I3) { p0_transpose_item(w_b, AW, DM, DM, WA, LDH, AW, nullptr, 2, scr, r, F.lane); continue; } r -= I3;
            if (r < I5) { p0_transpose_item(w_out, DM, DM, DM, WOUT, LDH, 0, nullptr, 2, scr, r, F.lane); continue; } r -= I5;
            if (r < I6) { p0_transpose_item_f8(w_up, DM, DFF, DFF, 0, (unsigned char*)WUP, 32.f, scr, r, F.lane); continue; } r -= I6;
            p0_transpose_item_f8(w_dn, DFF, DM, DM, 0, (unsigned char*)WDN, 64.f, scr, r, F.lane);
        }
        for (int idx = (int)blockIdx.x * (NWAVES * 64) + F.tid; idx < MTOK * 24; idx += F.G * NWAVES * 64) {
            const int m = idx / 24, i = idx - m * 24;
            const float invf = (i < 8) ? __builtin_amdgcn_exp2f(-(float)i * 2.3664460711655217f) : __builtin_amdgcn_exp2f(-(float)(i - 8) * 1.1832230355827609f);
            const float ang = (float)positions[m] * invf;
            double t = (double)ang * 0.15915494309189535; t -= floor(t);
            const float tf = (float)t; const float c = __builtin_amdgcn_cosf(tf), s = __builtin_amdgcn_sinf(tf);
            float* dst = (i < 8) ? ropeA + (size_t)m * 16 + 2 * i : ropeB + (size_t)m * 32 + 2 * (i - 8);
            *(f32x2g*)dst = (f32x2g){c, s};
        }
        f32x4 g[4];
#pragma unroll
        for (int j = 0; j < 4; ++j) g[j] = ((const GAS f32x4*)g_pre_mix)[F.lane + 64 * j];
        for (int m = gw; m < MTOK; m += NGW) rms_row_to_bf16(F.lane, x + (size_t)m * DM, g, H + (size_t)m * LDH, H8 + (size_t)m * DM);
    }
#endif
    SEAM(0);

#if !defined(SKIP_P1)
    if (IN(1))
    { PHASE_PTRS
        { pg8::Gemm g{H, WIN, MTOK, 2304, DM, LDH, LDH}; pg8::StaticOrder S; S.init(MTOK, 2304, F.G, (int)blockIdx.x);
          pg8::EpiIn E{QA, KA, VA, CQ, CKV, KR, Gt, SS, ropeA, ropeB, b_gate};
          pg8::gemm_phase<pg8::EpiIn, pg8::StaticOrder, true, true>(F.lds + RING_OFF, g, S, E); }
        { pg8::Gemm g{(const bf16*)H8, (const bf16*)WG8, MTOK, 2 * DM, DM, DM, DM}; pg8::StaticOrder S; S.init(MTOK, 2 * DM, F.G, (int)blockIdx.x);
          pg8::EpiGates E{Gt, b_gate};
          pg8::gemm_phase<pg8::EpiGates, pg8::StaticOrder, true, true, 1>(F.lds + RING_OFF, g, S, E); }
    }
#endif
    SEAM(1);

#if !defined(SKIP_P2)
    if (IN(2)) { PHASE_PTRS
    {
        pg8::Gemm g{CQ, WUQ, MTOK, NHEAD * QKB, QLORA}; pg8::StaticOrder S; S.init(MTOK, NHEAD * QKB, F.G, (int)blockIdx.x);
        pg8::EpiQ E{QB, SS, ropeB};
        pg8::gemm_phase<pg8::EpiQ, pg8::StaticOrder, true, true>(F.lds + RING_OFF, g, S, E);
    }
    {
        pg8::Gemm g{CKV, WUKV, MTOK, 2 * AW, KVLORA, LDKV, LDKV}; pg8::StaticOrder S; S.init(MTOK, 2 * AW, F.G, (int)blockIdx.x);
        pg8::EpiKV E{KB, VB, SS};
        pg8::gemm_phase<pg8::EpiKV, pg8::StaticOrder, true, true>(F.lds + RING_OFF, g, S, E);
    }
    }
#endif
    SEAM(2);

#if !defined(SKIP_P3)
    if (IN(3))
    { PHASE_PTRS
        LAS char* al = (LAS char*)(F.lds + RING_OFF);
#if !defined(SKIP_MOBA)
        for (int bh = F.vcu; bh < NB * NHEAD; bh += F.G) {
            const int b = bh >> 3, h = bh & 7; const size_t r0 = (size_t)b * SEQ;
            att::kmean_blocks(KA + r0 * AW + h * HD, al);
            att::attn_bh<64, true>(QA + r0 * AW + h * HD, AW, KA + r0 * AW + h * HD, nullptr, VA + r0 * AW + h * HD, H + r0 * LDH + h * HD, LDH, al);
        }
#endif
#if !defined(SKIP_MLA)
        for (int bh = F.vcu; bh < NB * NHEAD; bh += F.G) {
            const int b = bh >> 3, h = bh & 7; const size_t r0 = (size_t)b * SEQ;
            att::attn_bh<96, false>(QB + r0 * (NHEAD * QKB) + h * QKB, NHEAD * QKB, KB + r0 * AW + h * HD, KR + r0 * RDIM, VB + r0 * AW + h * HD, H + r0 * LDH + AW + h * HD, LDH, al);
        }
#endif
    }
#endif
    SEAM(3);

#if !defined(SKIP_P4)
    if (IN(4))
    { PHASE_PTRS
        pg8::Gemm g{H, WA, MTOK, DM, DM, LDH, LDH}; pg8::StaticOrder S; S.init(MTOK, DM, F.G, (int)blockIdx.x);
        pg8::EpiMerge E{Gt, T};
        pg8::gemm_phase<pg8::EpiMerge, pg8::StaticOrder, true, true>(F.lds + RING_OFF, g, S, E);
    }
#endif
    SEAM(4);

#if !defined(SKIP_P5)
    if (IN(5))
    { PHASE_PTRS
        pg8::Gemm g{T, WOUT, MTOK, DM, DM, LDH, LDH}; pg8::StaticOrder S; S.init(MTOK, DM, F.G, (int)blockIdx.x);
        pg8::EpiSS E{Y, SS2, DM, 1.0f};
        pg8::gemm_phase<pg8::EpiSS, pg8::StaticOrder, true, true>(F.lds + RING_OFF, g, S, E);
    }
#endif
    SEAM(5);

#if !defined(SKIP_P6)
    if (IN(6))
    { PHASE_PTRS
        f32x4 g1[4], g2[4];
#pragma unroll
        for (int j = 0; j < 4; ++j) { g1[j] = ((const GAS f32x4*)g_post_mix)[F.lane + 64 * j]; g2[j] = ((const GAS f32x4*)g_pre_mlp)[F.lane + 64 * j]; }
        for (int m = gw; m < MTOK; m += NGW) {
            const GAS f32x4* sp = (const GAS f32x4*)(SS2 + (size_t)m * 16); const f32x4 a = sp[0], b = sp[1], c = sp[2], d = sp[3];
            const float ssy = (((a.x + a.y) + (a.z + a.w)) + ((b.x + b.y) + (b.z + b.w))) + (((c.x + c.y) + (c.z + c.w)) + ((d.x + d.y) + (d.z + d.w)));
            const float rsy = 1.f / sqrtf(ssy * (1.f / DM) + EPS);
            const GAS f32x4* xr = (const GAS f32x4*)(x + (size_t)m * DM) + F.lane; const GAS unsigned long long* yr = (const GAS unsigned long long*)(Y + (size_t)m * DM) + F.lane;
            GAS unsigned long long* x8 = (GAS unsigned long long*)(X1B + (size_t)m * DM) + F.lane;
            f32x4 v[4]; float s = 0.f;
#pragma unroll
            for (int j = 0; j < 4; ++j) { const unsigned long long yw = yr[64 * j]; const unsigned lo = (unsigned)yw, hi = (unsigned)(yw >> 32);
                const f32x4 yv = (f32x4){__uint_as_float(lo << 16), __uint_as_float(lo & 0xffff0000u), __uint_as_float(hi << 16), __uint_as_float(hi & 0xffff0000u)};
                v[j] = xr[64 * j] + yv * rsy * g1[j]; x8[64 * j] = (unsigned long long)pk2(v[j].x, v[j].y) | ((unsigned long long)pk2(v[j].z, v[j].w) << 32);
                s += (v[j].x * v[j].x + v[j].y * v[j].y) + (v[j].z * v[j].z + v[j].w * v[j].w); }
            const float rstd = 1.f / sqrtf(wave_sum(s) * (1.f / DM) + EPS);
            GAS int* o8 = (GAS int*)((unsigned char*)H + (size_t)m * DM) + F.lane;
#pragma unroll
            for (int j = 0; j < 4; ++j) { const f32x4 y2 = v[j] * rstd * g2[j]; int w = 0; w = __builtin_amdgcn_cvt_pk_fp8_f32(y2.x, y2.y, w, false); w = __builtin_amdgcn_cvt_pk_fp8_f32(y2.z, y2.w, w, true); o8[64 * j] = w; }
        }
    }
#endif
    SEAM(6);

#if !defined(SKIP_P7)
    if (IN(7))
    { PHASE_PTRS
        pg8::Gemm g{H, WUP, MTOK, DFF, DM, DM, DM}; pg8::StaticOrder S; S.init(MTOK, DFF, F.G, (int)blockIdx.x);
        pg8::EpiRelu2F8 E{(unsigned char*)U, 1.0f / 32.0f};
        pg8::gemm_phase<pg8::EpiRelu2F8, pg8::StaticOrder, true, true, 1>(F.lds + RING_OFF, g, S, E);
    }
#endif
    SEAM(7);

#if !defined(SKIP_P8)
    if (IN(8))
    { PHASE_PTRS
        pg8::Gemm g{U, WDN, MTOK, DM, DFF, DFF, DFF}; pg8::StaticOrder S; S.init(MTOK, DM, F.G, (int)blockIdx.x);
        pg8::EpiSS E{H, SS3, LDH, 1.0f / 64.0f};
        pg8::gemm_phase<pg8::EpiSS, pg8::StaticOrder, true, true, 1>(F.lds + RING_OFF, g, S, E);
    }
#endif
    SEAM(8);

#if !defined(SKIP_P9)
    if (IN(9))
    { PHASE_PTRS
        f32x4 g1[4];
#pragma unroll
        for (int j = 0; j < 4; ++j) g1[j] = ((const GAS f32x4*)g_post_mlp)[F.lane + 64 * j];
        for (int m = gw; m < MTOK; m += NGW) {
            const GAS f32x4* sp = (const GAS f32x4*)(SS3 + (size_t)m * 16); const f32x4 a = sp[0], b = sp[1], c = sp[2], d = sp[3];
            const float ssy = (((a.x + a.y) + (a.z + a.w)) + ((b.x + b.y) + (b.z + b.w))) + (((c.x + c.y) + (c.z + c.w)) + ((d.x + d.y) + (d.z + d.w)));
            const float rsy = 1.f / sqrtf(ssy * (1.f / DM) + EPS);
            const GAS unsigned long long* yr = (const GAS unsigned long long*)(H + (size_t)m * LDH) + F.lane;
            const GAS unsigned long long* xq = (const GAS unsigned long long*)(X1B + (size_t)m * DM) + F.lane;
            GAS f32x4* o4 = (GAS f32x4*)(out + (size_t)m * DM) + F.lane;
#pragma unroll
            for (int j = 0; j < 4; ++j) { const unsigned long long yw = yr[64 * j]; const unsigned lo = (unsigned)yw, hi = (unsigned)(yw >> 32);
                const f32x4 yv = (f32x4){__uint_as_float(lo << 16), __uint_as_float(lo & 0xffff0000u), __uint_as_float(hi << 16), __uint_as_float(hi & 0xffff0000u)};
                const unsigned long long xw = xq[64 * j]; const unsigned xl = (unsigned)xw, xh = (unsigned)(xw >> 32);
                const f32x4 xv = (f32x4){__uint_as_float(xl << 16), __uint_as_float(xl & 0xffff0000u), __uint_as_float(xh << 16), __uint_as_float(xh & 0xffff0000u)};
                o4[64 * j] = xv + yv * rsy * g1[j]; }
        }
    }
#endif
}

extern "C" void kernel_launch(void* const* d_in, const int* in_sizes, int n_in, void* d_out, int out_size, void* d_ws, size_t ws_size, hipStream_t stream) {
    static int grid = 0;
    if (grid == 0) {
        if (n_in != 17 || in_sizes[0] != MTOK * DM || out_size != MTOK * DM || ws_size < WS_END) { fprintf(stderr, "kernel_launch: unexpected shapes (n_in %d, in0 %d, out %d, ws %zu); nothing launched\n", n_in, n_in > 0 ? in_sizes[0] : -1, out_size, ws_size); grid = -1; return; }
        int dev = 0, cus = 0, per_cu = 0;
        if (hipGetDevice(&dev) != hipSuccess || hipDeviceGetAttribute(&cus, hipDeviceAttributeMultiprocessorCount, dev) != hipSuccess) { fprintf(stderr, "kernel_launch: device query failed\n"); grid = -1; return; }
        if (hipFuncSetAttribute((const void*)block_fwd, hipFuncAttributeMaxDynamicSharedMemorySize, LDS_BYTES) != hipSuccess) { fprintf(stderr, "kernel_launch: hipFuncSetAttribute failed\n"); grid = -1; return; }
        if (hipOccupancyMaxActiveBlocksPerMultiprocessor(&per_cu, (const void*)block_fwd, NWAVES * 64, LDS_BYTES) != hipSuccess || per_cu < 1) { fprintf(stderr, "kernel_launch: occupancy query reports %d workgroups per CU\n", per_cu); }
        (void)hipGetLastError();
        grid = cus;
    }
    if (grid < 0) return;
    if (hipMemsetAsync((char*)d_ws + WS_CTL, 0, CTL_ZERO_BYTES, stream) != hipSuccess) { fprintf(stderr, "kernel_launch: hipMemsetAsync failed\n"); return; }
    Args a{};
    for (int i = 0; i < 17; ++i) a.in[i] = (const float*)d_in[i];
    a.out = (float*)d_out; a.ws = (unsigned char*)d_ws;
    a.ph_lo = 0; a.ph_hi = 10; a.li = 0;
    hipLaunchKernelGGL(block_fwd, dim3(grid), dim3(NWAVES * 64), LDS_BYTES, stream, a);
    const hipError_t le = hipPeekAtLastError();
    if (le != hipSuccess) fprintf(stderr, "kernel_launch: launch failed: %s\n", hipGetErrorName(le));
}
```

```cpp
#include <hip/hip_runtime.h>
#include <hip/hip_bf16.h>
#include <cstdio>
#include <cstdint>
#include <cmath>
constexpr int NB = 32, SEQ = 2048, DM = 1024, MTOK = NB * SEQ;
constexpr int NHEAD = 8, HD = 64, AW = NHEAD * HD;
constexpr int QLORA = 384, KVLORA = 256, RDIM = 32, QKB = 96;
constexpr int DFF = 4096, INW = 4256, INWP = 4352;
constexpr int LDH = DM, LDU = DFF, LDKV = KVLORA;
constexpr float EPS = 1e-6f;
constexpr float LOG2E = 1.4426950408889634f;
constexpr float C2A = 0.125f * LOG2E;
constexpr float C2B = 0.10206207261596575f * LOG2E;
typedef float f32x2g __attribute__((ext_vector_type(2)));
namespace pg8 {
#define PG8_LAS __attribute__((address_space(3)))
typedef unsigned short bf16_t;
typedef short bf16x8 __attribute__((ext_vector_type(8)));
typedef float f32x4 __attribute__((ext_vector_type(4)));
typedef unsigned u32x4 __attribute__((ext_vector_type(4)));
constexpr int BM = 256, BK = 64, HALF = 128, HTB = HALF * BK * 2  , STAGE_BYTES = 8 * HTB, NXCD = 8, WGM = 8;

__host__ __device__ __forceinline__ int lds_byte(int r, int c) { const int st = (r >> 4) * 2 + (c >> 5), rr = r & 15, cc = c & 31, ob = rr * 64 + cc * 2; return st * 1024 + (ob ^ (((ob >> 9) & 1) << 5)); }
__host__ __device__ __forceinline__ void stage_rc(int b, int& R, int& C) { const int st = b / 1024, sb = b % 1024, swz = sb ^ (((sb >> 9) & 1) << 5); R = (st >> 1) * 16 + swz / 64; C = (st & 1) * 32 + (swz % 64) / 2; }
__host__ __device__ __forceinline__ int perm32(int rho) { const int n = rho >> 4, i = rho & 15; return 8 * (i >> 2) + 4 * n + (i & 3); }

struct Unit { int pm, pn; };
struct Gemm { const bf16_t* A; const bf16_t* Bt; int M, N, K, lda, ldb; };

struct StaticOrder {
    int nM, nN, nwg, G, c;
    __host__ __device__ void init(int M, int N, int G_, int c_) { nM = M / BM; nN = N / BM; nwg = nM * nN; G = G_; c = c_; }
    __host__ __device__ bool next(int i, Unit& u) const {
        const long L = (long)i * G + c; if (L >= nwg) return false;
        int wgid = (int)L; { const int q = nwg / NXCD, r = nwg % NXCD, xcd = wgid % NXCD, off = wgid / NXCD; wgid = (xcd < r ? xcd * (q + 1) : r * (q + 1) + (xcd - r) * q) + off; }
        const int nig = WGM * nN, gid = wgid / nig, fm = gid * WGM, gsz = (nM - fm) < WGM ? (nM - fm) : WGM;
        u.pm = fm + ((wgid % nig) % gsz); u.pn = (wgid % nig) / gsz; return true;
    }
    __device__ __forceinline__ void a_ready(const Unit&) const {}
    __device__ __forceinline__ void done(const Unit&) const {}
};

__device__ __forceinline__ unsigned cvt_pk_bf16(float lo, float hi) { unsigned r; asm volatile("v_cvt_pk_bf16_f32 %0, %1, %2" : "=v"(r) : "v"(lo), "v"(hi)); return r; }
__device__ __forceinline__ void ld8(float (&v)[8], const f32x4& a, const f32x4& b) { v[0] = a[0]; v[1] = a[1]; v[2] = a[2]; v[3] = a[3]; v[4] = b[0]; v[5] = b[1]; v[6] = b[2]; v[7] = b[3]; }
typedef float f32x2c_t __attribute__((ext_vector_type(2))); typedef __bf16 bf16x2c_t __attribute__((ext_vector_type(2)));
__device__ __forceinline__ unsigned cvtpk_c(float lo, float hi) { const f32x2c_t v = {lo, hi}; const bf16x2c_t b = __builtin_convertvector(v, bf16x2c_t); return __builtin_bit_cast(unsigned, b); }
__device__ __forceinline__ u32x4 pack8(const float (&v)[8]) { u32x4 w; w.x = cvtpk_c(v[0], v[1]); w.y = cvtpk_c(v[2], v[3]); w.z = cvtpk_c(v[4], v[5]); w.w = cvtpk_c(v[6], v[7]); return w; }
__device__ __forceinline__ void unpack8(const u32x4 w, float (&v)[8]) {
    v[0] = __uint_as_float(w.x << 16); v[1] = __uint_as_float(w.x & 0xffff0000u); v[2] = __uint_as_float(w.y << 16); v[3] = __uint_as_float(w.y & 0xffff0000u);
    v[4] = __uint_as_float(w.z << 16); v[5] = __uint_as_float(w.z & 0xffff0000u); v[6] = __uint_as_float(w.w << 16); v[7] = __uint_as_float(w.w & 0xffff0000u); }
__device__ __forceinline__ void rope4(float (&v)[8], const f32x4 a, const f32x4 b) {
    float x1, x2;
    x1 = v[0]; x2 = v[1]; v[0] = x1 * a[0] - x2 * a[1]; v[1] = x2 * a[0] + x1 * a[1];
    x1 = v[2]; x2 = v[3]; v[2] = x1 * a[2] - x2 * a[3]; v[3] = x2 * a[2] + x1 * a[3];
    x1 = v[4]; x2 = v[5]; v[4] = x1 * b[0] - x2 * b[1]; v[5] = x2 * b[0] + x1 * b[1];
    x1 = v[6]; x2 = v[7]; v[6] = x1 * b[2] - x2 * b[3]; v[7] = x2 * b[2] + x1 * b[3];
}
__device__ __forceinline__ float sumsq8(const float (&v)[8]) { return ((v[0] * v[0] + v[1] * v[1]) + (v[2] * v[2] + v[3] * v[3])) + ((v[4] * v[4] + v[5] * v[5]) + (v[6] * v[6] + v[7] * v[7])); }
__device__ __forceinline__ float red_fq(float s) { s += __shfl_xor(s, 16); s += __shfl_xor(s, 32); return s; }

__device__ __forceinline__ size_t gfrag_off(int pm, int t8, int wid, int grp, int lane) { return ((((size_t)(pm * 8 + t8) * 8 + wid) * 16 + grp) * 64 + lane) * 8; }
struct EpiIn {
    static constexpr bool PERM = true, AFTER_DRAIN = false; static constexpr int MIDT = 0;
    bf16_t *QA, *KA, *VA, *CQ, *CKV, *KR, *G; float* SS; const float* ropeA; const float* ropeB; const float* bgate;
    __device__ __forceinline__ void operator()(const f32x4 (&acc)[2][2][4][2], const Unit& u, int wr, int wc, int fr, int fq) const {
        asm volatile("" : "+v"(fr), "+v"(fq));
        const int row0 = u.pm * BM + wr * 64 + fr, pn = u.pn, cl = wc * 32 + 8 * fq;
        if (pn < 4) {
            bf16_t* dst = (pn < 2) ? QA : KA; const float sc = (pn < 2) ? C2A : 1.f; const int cb = (pn & 1) * 256 + cl;
            if ((wc & 1) == 0) {
                const bool rp = fq < 2;
#pragma unroll
                for (int ai = 0; ai < 2; ++ai)
#pragma unroll
                    for (int m = 0; m < 4; ++m) { const int row = row0 + ai * HALF + m * 16;
                        const f32x4* t = (const f32x4*)(ropeA + (size_t)row * 16 + (rp ? fq * 8 : 0));
                        f32x4 ca = t[0], cc = t[1]; if (!rp) { ca = (f32x4){1.f, 0.f, 1.f, 0.f}; cc = ca; }
#pragma unroll
                        for (int bj = 0; bj < 2; ++bj) { float v[8]; ld8(v, acc[ai][bj][m][0], acc[ai][bj][m][1]); rope4(v, ca, cc);
#pragma unroll
                            for (int j = 0; j < 8; ++j) v[j] *= sc;
                            *(u32x4*)(dst + (size_t)row * AW + cb + bj * HALF) = pack8(v); } }
            } else {
#pragma unroll
                for (int ai = 0; ai < 2; ++ai)
#pragma unroll
                    for (int m = 0; m < 4; ++m) { const int row = row0 + ai * HALF + m * 16;
#pragma unroll
                        for (int bj = 0; bj < 2; ++bj) { float v[8]; ld8(v, acc[ai][bj][m][0], acc[ai][bj][m][1]);
#pragma unroll
                            for (int j = 0; j < 8; ++j) v[j] *= sc;
                            *(u32x4*)(dst + (size_t)row * AW + cb + bj * HALF) = pack8(v); } }
            }
        } else if (pn < 6) {
            const int cb = (pn - 4) * 256 + cl;
#pragma unroll
            for (int ai = 0; ai < 2; ++ai)
#pragma unroll
                for (int m = 0; m < 4; ++m) { const int row = row0 + ai * HALF + m * 16;
#pragma unroll
                    for (int bj = 0; bj < 2; ++bj) { float v[8]; ld8(v, acc[ai][bj][m][0], acc[ai][bj][m][1]); *(u32x4*)(VA + (size_t)row * AW + cb + bj * HALF) = pack8(v); } }
        } else if (pn == 6 || pn == 8) {
            bf16_t* dst = (pn == 6) ? CQ : CKV; const int ld = (pn == 6) ? QLORA : LDKV, slot = ((pn == 6) ? 0 : 8) + wc;
#pragma unroll
            for (int ai = 0; ai < 2; ++ai)
#pragma unroll
                for (int m = 0; m < 4; ++m) { const int row = row0 + ai * HALF + m * 16; float s = 0.f;
#pragma unroll
                    for (int bj = 0; bj < 2; ++bj) { float v[8]; ld8(v, acc[ai][bj][m][0], acc[ai][bj][m][1]); s += sumsq8(v); *(u32x4*)(dst + (size_t)row * ld + cl + bj * HALF) = pack8(v); }
                    s = red_fq(s); if (fq == 0) SS[(size_t)row * 12 + slot] = s; }
        } else if (pn == 7) {
#pragma unroll
            for (int ai = 0; ai < 2; ++ai)
#pragma unroll
                for (int m = 0; m < 4; ++m) { const int row = row0 + ai * HALF + m * 16;
                    { float v[8]; ld8(v, acc[ai][0][m][0], acc[ai][0][m][1]); float s = red_fq(sumsq8(v)); *(u32x4*)(CQ + (size_t)row * QLORA + 256 + cl) = pack8(v); if (fq == 0) SS[(size_t)row * 12 + 4 + wc] = s; }
                    if (wc == 0) { float v[8]; ld8(v, acc[ai][1][m][0], acc[ai][1][m][1]); const f32x4* t = (const f32x4*)(ropeB + (size_t)row * 32 + fq * 8); rope4(v, t[0], t[1]);
                        *(u32x4*)(KR + (size_t)row * RDIM + 8 * fq) = pack8(v); } }
        }
    }
};
struct EpiGates {
    static constexpr bool PERM = true, AFTER_DRAIN = false; static constexpr int MIDT = 0;
    bf16_t* G; const float* bgate;
    __device__ __forceinline__ void operator()(const f32x4 (&acc)[2][2][4][2], const Unit& u, int wr, int wc, int fr, int fq) const {
        asm volatile("" : "+v"(fr), "+v"(fq));
        const int gc = u.pn * 256 + wc * 32 + 8 * fq;
        f32x4 bv[2][2];
#pragma unroll
        for (int bj = 0; bj < 2; ++bj)
#pragma unroll
            for (int n = 0; n < 2; ++n) bv[bj][n] = *(const f32x4*)(bgate + gc + bj * HALF + 4 * n);
#pragma unroll
        for (int ai = 0; ai < 2; ++ai)
#pragma unroll
            for (int m = 0; m < 4; ++m) {
#pragma unroll
                for (int bj = 0; bj < 2; ++bj) { float v[8]; ld8(v, acc[ai][bj][m][0] * (1.0f / 32.0f) + bv[bj][0], acc[ai][bj][m][1] * (1.0f / 32.0f) + bv[bj][1]);
#pragma unroll
                    for (int j = 0; j < 8; ++j) v[j] = __builtin_amdgcn_rcpf(1.f + __builtin_amdgcn_exp2f(-LOG2E * v[j]));
                    *(u32x4*)(G + gfrag_off(u.pm, u.pn, wr * 4 + wc, ai * 8 + m * 2 + bj, fq * 16 + fr)) = pack8(v); } }
    }
};
struct EpiQ {
    static constexpr bool PERM = true, AFTER_DRAIN = false; static constexpr int MIDT = 0;
    bf16_t* QB; const float* SS; const float* ropeB;
    __device__ __forceinline__ void operator()(const f32x4 (&acc)[2][2][4][2], const Unit& u, int wr, int wc, int fr, int fq) const {
        asm volatile("" : "+v"(fr), "+v"(fq));
        const int row0 = u.pm * BM + wr * 64 + fr, cl = u.pn * BM + wc * 32 + 8 * fq;
        const int c0 = cl, c1 = cl + HALF, h0 = c0 / QKB, h1 = c1 / QKB, p0 = c0 - h0 * QKB, p1 = c1 - h1 * QKB;
        const bool r0 = p0 >= 64, r1 = p1 >= 64; const int roff = r0 ? p0 - 64 : (r1 ? p1 - 64 : 0);
#pragma unroll
        for (int b = 0; b < 2; ++b) {
            f32x4 s0[4], s1[4], ta[4], tb[4];
#pragma unroll
            for (int m = 0; m < 4; ++m) { const int row = row0 + b * HALF + m * 16;
                const f32x4* sp = (const f32x4*)(SS + (size_t)row * 12); s0[m] = sp[0]; s1[m] = sp[1];
                const f32x4* t = (const f32x4*)(ropeB + (size_t)row * 32 + roff); ta[m] = t[0]; tb[m] = t[1]; }
            asm volatile("" ::: "memory");
#pragma unroll
            for (int m = 0; m < 4; ++m) { const int row = row0 + b * HALF + m * 16;
                const float ss = ((s0[m][0] + s0[m][1]) + (s0[m][2] + s0[m][3])) + ((s1[m][0] + s1[m][1]) + (s1[m][2] + s1[m][3]));
                const float rs = __builtin_amdgcn_rsqf(ss * (1.0f / QLORA) + EPS) * C2B;
#pragma unroll
                for (int bj = 0; bj < 2; ++bj) { float v[8]; ld8(v, acc[b][bj][m][0], acc[b][bj][m][1]);
#pragma unroll
                    for (int j = 0; j < 8; ++j) v[j] *= rs;
                    if (bj == 0 ? r0 : r1) rope4(v, ta[m], tb[m]);
                    *(u32x4*)(QB + (size_t)row * (NHEAD * QKB) + (bj == 0 ? c0 : c1)) = pack8(v); } }
        }
    }
};
struct EpiKV {
    static constexpr bool PERM = true, AFTER_DRAIN = false; static constexpr int MIDT = 0;
    bf16_t *KB, *VB; const float* SS;
    __device__ __forceinline__ void operator()(const f32x4 (&acc)[2][2][4][2], const Unit& u, int wr, int wc, int fr, int fq) const {
        asm volatile("" : "+v"(fr), "+v"(fq));
        const int row0 = u.pm * BM + wr * 64 + fr;
        bf16_t* dst = (wc < 2) ? KB : VB; const int pc = (wc & 1) * 32 + 8 * fq;
        f32x4 s0[2][4];
#pragma unroll
        for (int ai = 0; ai < 2; ++ai)
#pragma unroll
            for (int m = 0; m < 4; ++m) s0[ai][m] = *(const f32x4*)(SS + (size_t)(row0 + ai * HALF + m * 16) * 12 + 8);
#pragma unroll
        for (int ai = 0; ai < 2; ++ai)
#pragma unroll
            for (int m = 0; m < 4; ++m) { const int row = row0 + ai * HALF + m * 16; const f32x4 sv = s0[ai][m];
                const float rs = __builtin_amdgcn_rsqf(((sv[0] + sv[1]) + (sv[2] + sv[3])) * (1.0f / KVLORA) + EPS);
#pragma unroll
                for (int bj = 0; bj < 2; ++bj) { const int hd = u.pn * 2 + bj;
                    float v[8]; ld8(v, acc[ai][bj][m][0], acc[ai][bj][m][1]);
#pragma unroll
                    for (int j = 0; j < 8; ++j) v[j] *= rs;
                    *(u32x4*)(dst + (size_t)row * AW + hd * HD + pc) = pack8(v); } }
    }
};
struct EpiMerge {
    static constexpr bool PERM = true, AFTER_DRAIN = false; static constexpr int MIDT = 8;
    const bf16_t* G; bf16_t* T;
    __device__ __forceinline__ void mid(f32x4 (&acc)[2][2][4][2], const Unit& u, int wr, int wc, int fr, int fq) const {
        asm volatile("" : "+v"(fr), "+v"(fq));
        const bf16_t* pa = G + gfrag_off(u.pm, u.pn, wr * 4 + wc, 0, fq * 16 + fr); const bf16_t* pb = G + gfrag_off(u.pm, 4 + u.pn, wr * 4 + wc, 0, fq * 16 + fr);
        u32x4 ca[4], cb[4], na[4], nb[4];
#pragma unroll
        for (int i = 0; i < 4; ++i) { ca[i] = *(const u32x4*)(pa + (size_t)i * 512); cb[i] = *(const u32x4*)(pb + (size_t)i * 512); }
#pragma unroll
        for (int b = 0; b < 4; ++b) {
            if (b < 3) {
#pragma unroll
                for (int i = 0; i < 4; ++i) { na[i] = *(const u32x4*)(pa + (size_t)((b + 1) * 4 + i) * 512); nb[i] = *(const u32x4*)(pb + (size_t)((b + 1) * 4 + i) * 512); } }
            asm volatile("" ::: "memory");
#pragma unroll
            for (int i = 0; i < 4; ++i) { const int grp = b * 4 + i, ai = grp >> 3, m = (grp >> 1) & 3, bj = grp & 1; float ga[8], gb[8]; unpack8(ca[i], ga); unpack8(cb[i], gb);
#pragma unroll
                for (int j = 0; j < 8; ++j) ga[j] *= __builtin_amdgcn_rcpf(__builtin_fmaxf(gb[j], 1e-30f));
                acc[ai][bj][m][0] *= (f32x4){ga[0], ga[1], ga[2], ga[3]}; acc[ai][bj][m][1] *= (f32x4){ga[4], ga[5], ga[6], ga[7]}; }
#pragma unroll
            for (int i = 0; i < 4; ++i) { ca[i] = na[i]; cb[i] = nb[i]; }
        }
    }
    __device__ __forceinline__ void operator()(const f32x4 (&acc)[2][2][4][2], const Unit& u, int wr, int wc, int fr, int fq) const {
        asm volatile("" : "+v"(fr), "+v"(fq));
        const int row0 = u.pm * BM + wr * 64 + fr, cl = u.pn * BM + wc * 32 + 8 * fq;
        const bf16_t* pb = G + gfrag_off(u.pm, 4 + u.pn, wr * 4 + wc, 0, fq * 16 + fr);
        u32x4 cb[8], nb[8];
#pragma unroll
        for (int i = 0; i < 8; ++i) cb[i] = *(const u32x4*)(pb + (size_t)i * 512);
#pragma unroll
        for (int b = 0; b < 2; ++b) {
            if (b < 1) {
#pragma unroll
                for (int i = 0; i < 8; ++i) nb[i] = *(const u32x4*)(pb + (size_t)(8 + i) * 512); }
            asm volatile("" ::: "memory");
#pragma unroll
            for (int i = 0; i < 8; ++i) { const int grp = b * 8 + i, ai = grp >> 3, m = (grp >> 1) & 3, bj = grp & 1; float v[8], gb[8]; ld8(v, acc[ai][bj][m][0], acc[ai][bj][m][1]); unpack8(cb[i], gb);
#pragma unroll
                for (int j = 0; j < 8; ++j) v[j] *= __builtin_fmaxf(gb[j], 1e-30f);
                *(u32x4*)(T + (size_t)(row0 + ai * HALF + m * 16) * LDH + cl + bj * HALF) = pack8(v); }
#pragma unroll
            for (int i = 0; i < 8; ++i) cb[i] = nb[i];
        }
    }
};
struct EpiSS {
    static constexpr bool PERM = true, AFTER_DRAIN = false; static constexpr int MIDT = 0;
    bf16_t* Y; float* SSY; int ldy; float scale;
    __device__ __forceinline__ void operator()(const f32x4 (&acc)[2][2][4][2], const Unit& u, int wr, int wc, int fr, int fq) const {
        asm volatile("" : "+v"(fr), "+v"(fq));
        const int row0 = u.pm * BM + wr * 64 + fr, cl = u.pn * BM + wc * 32 + 8 * fq;
#pragma unroll
        for (int ai = 0; ai < 2; ++ai)
#pragma unroll
            for (int m = 0; m < 4; ++m) { const int row = row0 + ai * HALF + m * 16; float s = 0.f;
#pragma unroll
                for (int bj = 0; bj < 2; ++bj) { float v[8]; ld8(v, acc[ai][bj][m][0] * scale, acc[ai][bj][m][1] * scale); s += sumsq8(v); *(u32x4*)(Y + (size_t)row * ldy + cl + bj * HALF) = pack8(v); }
                s = red_fq(s); if (fq == 0) SSY[(size_t)row * 16 + u.pn * 4 + wc] = s; }
    }
};
struct EpiRelu2F8 {
    static constexpr bool PERM = true, AFTER_DRAIN = false; static constexpr int MIDT = 0;
    unsigned char* U; float scale;
    __device__ __forceinline__ void operator()(const f32x4 (&acc)[2][2][4][2], const Unit& u, int wr, int wc, int fr, int fq) const {
        asm volatile("" : "+v"(fr), "+v"(fq));
        const int row0 = u.pm * BM + wr * 64 + fr, cl = u.pn * BM + wc * 32 + 8 * fq;
#pragma unroll
        for (int ai = 0; ai < 2; ++ai)
#pragma unroll
            for (int m = 0; m < 4; ++m) { const int row = row0 + ai * HALF + m * 16;
#pragma unroll
                for (int bj = 0; bj < 2; ++bj) { float v[8]; ld8(v, acc[ai][bj][m][0], acc[ai][bj][m][1]);
#pragma unroll
                    for (int j = 0; j < 8; ++j) { const float r = __builtin_fmaxf(v[j] * scale, 0.f); v[j] = __builtin_fminf(r * r, 440.f); }
                    int w0 = 0, w1 = 0;
                    w0 = __builtin_amdgcn_cvt_pk_fp8_f32(v[0], v[1], w0, false); w0 = __builtin_amdgcn_cvt_pk_fp8_f32(v[2], v[3], w0, true);
                    w1 = __builtin_amdgcn_cvt_pk_fp8_f32(v[4], v[5], w1, false); w1 = __builtin_amdgcn_cvt_pk_fp8_f32(v[6], v[7], w1, true);
                    typedef int i32x2_ __attribute__((ext_vector_type(2)));
                    *(i32x2_*)(U + (size_t)row * DFF + cl + bj * HALF) = (i32x2_){w0, w1}; } }
    }
};
struct EpiRelu2 {
    static constexpr bool PERM = true, AFTER_DRAIN = false; static constexpr int MIDT = 0;
    bf16_t* U;
    __device__ __forceinline__ void operator()(const f32x4 (&acc)[2][2][4][2], const Unit& u, int wr, int wc, int fr, int fq) const {
        asm volatile("" : "+v"(fr), "+v"(fq));
        const int row0 = u.pm * BM + wr * 64 + fr, cl = u.pn * BM + wc * 32 + 8 * fq;
#pragma unroll
        for (int ai = 0; ai < 2; ++ai)
#pragma unroll
            for (int m = 0; m < 4; ++m) { const int row = row0 + ai * HALF + m * 16;
#pragma unroll
                for (int bj = 0; bj < 2; ++bj) { float v[8]; ld8(v, acc[ai][bj][m][0], acc[ai][bj][m][1]);
#pragma unroll
                    for (int j = 0; j < 8; ++j) { const float r = __builtin_fmaxf(v[j], 0.f); v[j] = r * r; }
                    *(u32x4*)(U + (size_t)row * LDU + cl + bj * HALF) = pack8(v); } }
    }
};
template <class Epi, class Sched, bool ALIGN_EPI = false, bool SP2 = false, int ESZ = 2>
__device__ __forceinline__ void gemm_phase(PG8_LAS unsigned char* lds, const Gemm g, const Sched& S, const Epi& E) {
    int tid_ = threadIdx.x; asm volatile("" : "+v"(tid_));
    const int tid = tid_, wid = __builtin_amdgcn_readfirstlane(tid >> 6), lane = tid & 63, wr = wid >> 2, wc = wid & 3, fr = lane & 15, fq = lane >> 4;
    const int K = g.K, nt = K * ESZ / (BK * 2), lda = g.lda ? g.lda : K, ldb = g.ldb ? g.ldb : K;
    unsigned voffA[2], voffB[2];
#pragma unroll
    for (int i = 0; i < 2; ++i) { int R, C; stage_rc(tid * 16 + i * 8192, R, C); const int Rb = Epi::PERM ? ((R & ~31) + perm32(R & 31)) : R;
        voffA[i] = (unsigned)(R * lda * ESZ + C * 2); voffB[i] = (unsigned)(Rb * ldb * ESZ + C * 2); }
    const size_t kstep = (size_t)(BK * 2);
    const size_t hstepA = (size_t)HALF * lda * ESZ, hstepB = (size_t)HALF * ldb * ESZ;
    const size_t tstepA = 2 * hstepA, tstepB = 2 * hstepB;
    const unsigned ldsw = (unsigned)wid * 1024u;
    const int aoff = lds_byte(wr * 64 + fr, fq * 8), boff = lds_byte(wc * 32 + fr, fq * 8);
#define PG8_SA(b, h) (((b) * 2 + (h)) * HTB)
#define PG8_SB(b, h) ((4 + (b) * 2 + (h)) * HTB)
#define PG8_STAGE(bufoff, gbase, voff) do { _Pragma("unroll") for (int _i = 0; _i < 2; ++_i) \
        __builtin_amdgcn_global_load_lds((const unsigned*)((const char*)(gbase) + (voff)[_i]), (PG8_LAS unsigned*)(lds + (bufoff) + ldsw + _i * 8192), 16, 0, 0); } while (0)
#define PG8_LDA(dst, b, h) do { if constexpr (ESZ == 2) { _Pragma("unroll") for (int m = 0; m < 4; ++m) _Pragma("unroll") for (int k = 0; k < 2; ++k) dst[m][k] = *(const PG8_LAS bf16x8*)(lds + PG8_SA(b, h) + aoff + m * 2048 + k * 1024); } \
        else { _Pragma("unroll") for (int m = 0; m < 4; ++m) { dst##8[m].lo = *(const PG8_LAS i32x4_*)(lds + PG8_SA(b, h) + aoff + m * 2048); dst##8[m].hi = *(const PG8_LAS i32x4_*)(lds + PG8_SA(b, h) + aoff + m * 2048 + 1024); } } } while (0)
#define PG8_LDB(dst, b, h) do { if constexpr (ESZ == 2) { _Pragma("unroll") for (int n = 0; n < 2; ++n) _Pragma("unroll") for (int k = 0; k < 2; ++k) dst[n][k] = *(const PG8_LAS bf16x8*)(lds + PG8_SB(b, h) + boff + n * 2048 + k * 1024); } \
        else { _Pragma("unroll") for (int n = 0; n < 2; ++n) { dst##8[n].lo = *(const PG8_LAS i32x4_*)(lds + PG8_SB(b, h) + boff + n * 2048); dst##8[n].hi = *(const PG8_LAS i32x4_*)(lds + PG8_SB(b, h) + boff + n * 2048 + 1024); } } } while (0)
#define PG8_MMA(ai, bj, At, Bt) do { __builtin_amdgcn_s_setprio(1); \
        if constexpr (ESZ == 2) { _Pragma("unroll") for (int m = 0; m < 4; ++m) _Pragma("unroll") for (int n = 0; n < 2; ++n) _Pragma("unroll") for (int k = 0; k < 2; ++k) \
            acc[ai][bj][m][n] = __builtin_amdgcn_mfma_f32_16x16x32_bf16(Bt[n][k], At[m][k], acc[ai][bj][m][n], 0, 0, 0); } \
        else {   \
            _Pragma("unroll") for (int m = 0; m < 4; ++m) _Pragma("unroll") for (int n = 0; n < 2; ++n) \
                asm volatile("v_mfma_scale_f32_16x16x128_f8f6f4 %0, %1, %2, %0, %3, %3 op_sel_hi:[0,0,0]" : "+v"(acc[ai][bj][m][n]) : "v"(Bt##8[n]), "v"(At##8[m]), "v"(scl_)); } \
        __builtin_amdgcn_s_setprio(0); } while (0)
#define PG8_WAIT_V(n) asm volatile("s_waitcnt vmcnt(" #n ")" ::: "memory")
#define PG8_WAIT_L(n) asm volatile("s_waitcnt lgkmcnt(" #n ")" ::: "memory")
#define PG8_BAR __builtin_amdgcn_s_barrier()
#define PG8_SCHED __builtin_amdgcn_sched_barrier(0)
    Unit cur, nxt; int ui = 0;
    if (!S.next(0, cur)) return;
    f32x4 acc[2][2][4][2];
#pragma unroll
    for (int a = 0; a < 2; ++a)
#pragma unroll
        for (int b = 0; b < 2; ++b)
#pragma unroll
            for (int m = 0; m < 4; ++m)
#pragma unroll
                for (int n = 0; n < 2; ++n) acc[a][b][m][n] = (f32x4){0.f, 0.f, 0.f, 0.f};
    bf16x8 At[4][2], B0[2][2], B1[2][2];
    typedef int i32x4_ __attribute__((ext_vector_type(4))); typedef int i32x8_ __attribute__((ext_vector_type(8)));
    const int scl_ = 0x7F7F7F7F;
    i32x8_ At8[4], B08[2], B18[2];
    const char* cA = (const char*)g.A + (size_t)cur.pm * tstepA; const char* cB = (const char*)g.Bt + (size_t)cur.pn * tstepB;
    S.a_ready(cur);
    if constexpr (SP2) {
        PG8_STAGE(PG8_SB(0, 0), cB, voffB); PG8_STAGE(PG8_SB(0, 1), cB + hstepB, voffB); PG8_STAGE(PG8_SA(0, 0), cA, voffA); PG8_STAGE(PG8_SA(0, 1), cA + hstepA, voffA);
        if (wr == 1) PG8_BAR;
        PG8_WAIT_V(2); PG8_BAR;
        PG8_STAGE(PG8_SB(1, 0), cB + kstep, voffB); PG8_STAGE(PG8_SA(1, 0), cA + kstep, voffA); PG8_STAGE(PG8_SB(1, 1), cB + hstepB + kstep, voffB);
        PG8_WAIT_V(6); PG8_BAR;
    } else {
        PG8_STAGE(PG8_SB(0, 0), cB, voffB); PG8_STAGE(PG8_SA(0, 0), cA, voffA); PG8_STAGE(PG8_SB(0, 1), cB + hstepB, voffB); PG8_STAGE(PG8_SA(0, 1), cA + hstepA, voffA);
        if (wr == 1) PG8_BAR;
        PG8_WAIT_V(4); PG8_BAR;
        PG8_STAGE(PG8_SB(1, 0), cB + kstep, voffB); PG8_STAGE(PG8_SA(1, 0), cA + kstep, voffA); PG8_STAGE(PG8_SB(1, 1), cB + hstepB + kstep, voffB);
        PG8_WAIT_V(6); PG8_BAR;
    }
    for (;;) {
        const bool has_next = S.next(ui + 1, nxt);
        const char* nA = has_next ? (const char*)g.A + (size_t)nxt.pm * tstepA : cA; const char* nB = has_next ? (const char*)g.Bt + (size_t)nxt.pn * tstepB : cB;
#pragma unroll 1
        for (int t = 0; t < nt; t += 2) {
            if constexpr (Epi::MIDT > 0) { if (t == Epi::MIDT) E.mid(acc, cur, wr, wc, fr, fq); }
            const bool last = (t == nt - 2);
            const char* a1 = cA + (size_t)(t + 1) * kstep;
            const char* a2 = last ? nA : cA + (size_t)(t + 2) * kstep; const char* b2 = last ? nB : cB + (size_t)(t + 2) * kstep;
            const char* a3 = a2 + kstep; const char* b3 = b2 + kstep;
            if (last && has_next) S.a_ready(nxt);
            if constexpr (SP2) {
            PG8_LDB(B0, 0, 0); PG8_LDB(B1, 0, 1); PG8_SCHED; PG8_LDA(At, 0, 0); PG8_STAGE(PG8_SA(1, 1), a1 + hstepA, voffA);
            PG8_WAIT_V(8); PG8_WAIT_L(0); PG8_BAR; PG8_MMA(0, 0, At, B0); PG8_MMA(0, 1, At, B1); PG8_BAR; PG8_SCHED;
            PG8_LDA(At, 0, 1); PG8_STAGE(PG8_SB(0, 0), b2, voffB); PG8_STAGE(PG8_SB(0, 1), b2 + hstepB, voffB); PG8_STAGE(PG8_SA(0, 0), a2, voffA);
            PG8_WAIT_V(8); PG8_WAIT_L(0); PG8_BAR; PG8_MMA(1, 0, At, B0); PG8_MMA(1, 1, At, B1); PG8_BAR; PG8_SCHED;
            PG8_LDB(B0, 1, 0); PG8_LDB(B1, 1, 1); PG8_SCHED; PG8_LDA(At, 1, 0); PG8_STAGE(PG8_SA(0, 1), a2 + hstepA, voffA);
            PG8_WAIT_V(8); PG8_WAIT_L(0); PG8_BAR; PG8_MMA(0, 0, At, B0); PG8_MMA(0, 1, At, B1); PG8_BAR; PG8_SCHED;
            PG8_LDA(At, 1, 1); PG8_STAGE(PG8_SB(1, 0), b3, voffB); PG8_STAGE(PG8_SB(1, 1), b3 + hstepB, voffB); PG8_STAGE(PG8_SA(1, 0), a3, voffA);
            PG8_WAIT_V(8); PG8_WAIT_L(0); PG8_BAR; PG8_MMA(1, 0, At, B0); PG8_MMA(1, 1, At, B1); PG8_BAR; PG8_SCHED;
            } else {
            PG8_LDB(B0, 0, 0); PG8_SCHED; PG8_LDA(At, 0, 0); PG8_STAGE(PG8_SA(1, 1), a1 + hstepA, voffA);
            PG8_WAIT_L(8); PG8_BAR; PG8_WAIT_L(0); PG8_MMA(0, 0, At, B0); PG8_BAR; PG8_SCHED;
            PG8_LDB(B1, 0, 1); PG8_STAGE(PG8_SB(0, 0), b2, voffB);
            PG8_BAR; PG8_WAIT_L(0); PG8_MMA(0, 1, At, B1); PG8_BAR;
            PG8_LDA(At, 0, 1); PG8_STAGE(PG8_SA(0, 0), a2, voffA);
            PG8_BAR; PG8_WAIT_L(0); PG8_MMA(1, 0, At, B0); PG8_BAR; PG8_SCHED;
            PG8_STAGE(PG8_SB(0, 1), b2 + hstepB, voffB);
            PG8_WAIT_V(6); PG8_BAR; PG8_MMA(1, 1, At, B1); PG8_BAR;
            PG8_LDB(B0, 1, 0); PG8_SCHED; PG8_LDA(At, 1, 0); PG8_STAGE(PG8_SA(0, 1), a2 + hstepA, voffA);
            PG8_WAIT_L(8); PG8_BAR; PG8_WAIT_L(0); PG8_MMA(0, 0, At, B0); PG8_BAR; PG8_SCHED;
            PG8_LDB(B1, 1, 1); PG8_STAGE(PG8_SB(1, 0), b3, voffB);
            PG8_BAR; PG8_WAIT_L(0); PG8_MMA(0, 1, At, B1); PG8_BAR;
            PG8_LDA(At, 1, 1); PG8_STAGE(PG8_SA(1, 0), a3, voffA);
            PG8_BAR; PG8_WAIT_L(0); PG8_MMA(1, 0, At, B0); PG8_BAR; PG8_SCHED;
            PG8_STAGE(PG8_SB(1, 1), b3 + hstepB, voffB);
            PG8_WAIT_V(6); PG8_BAR; PG8_MMA(1, 1, At, B1); PG8_BAR;
            }
        }
        if constexpr (ALIGN_EPI) { if (wr == 0) PG8_BAR; }
        if constexpr (ESZ == 1) asm volatile("s_nop 15\n\ts_nop 15" ::: "memory");
        if constexpr (!Epi::AFTER_DRAIN) { E(acc, cur, wr, wc, fr, fq); S.done(cur); }
        if (!has_next) break;
#pragma unroll
        for (int a = 0; a < 2; ++a)
#pragma unroll
            for (int b = 0; b < 2; ++b)
#pragma unroll
                for (int m = 0; m < 4; ++m)
#pragma unroll
                    for (int n = 0; n < 2; ++n) acc[a][b][m][n] = (f32x4){0.f, 0.f, 0.f, 0.f};
        cur = nxt; cA = nA; cB = nB; ++ui;
        if constexpr (ALIGN_EPI) { if (wr == 1) PG8_BAR; }
    }
    PG8_WAIT_V(0);
    if constexpr (!ALIGN_EPI) { if (wr == 0) PG8_BAR; }
    PG8_BAR;
    if constexpr (Epi::AFTER_DRAIN) { E.fused(acc, cur, wr, wc, fr, fq, lds, wid, lane); S.done(cur); }
#undef PG8_SA
#undef PG8_SB
#undef PG8_STAGE
#undef PG8_LDA
#undef PG8_LDB
#undef PG8_MMA
#undef PG8_WAIT_V
#undef PG8_WAIT_L
#undef PG8_BAR
#undef PG8_SCHED
}
}
#ifndef ATT_LSUM_MFMA
#define ATT_LSUM_MFMA 1
#endif
namespace att {
typedef unsigned short bf16_t;
typedef short bf16x8 __attribute__((ext_vector_type(8)));
typedef short s16x4 __attribute__((ext_vector_type(4)));
typedef float f32x16 __attribute__((ext_vector_type(16)));
typedef float f32x4 __attribute__((ext_vector_type(4)));
typedef unsigned u32x4 __attribute__((ext_vector_type(4)));
#define ALDS __attribute__((address_space(3)))
#define ASBAR() __builtin_amdgcn_sched_barrier(0)
constexpr int KTB = 12288, VTB = 8192;
constexpr int NSLOT = 3;
constexpr int L_K = 0, L_V = NSLOT * KTB, L_WS = L_V + NSLOT * VTB, L_OST = L_WS + 8 * 256, L_KM = L_OST + 8 * 4096, L_RED = L_KM + 2048, L_END = L_RED + 16384;
constexpr float THR = 8.f;
__device__ __forceinline__ int crow(int r, int hi) { return (r & 3) + 8 * (r >> 2) + 4 * hi; }
typedef float f32x2a_t __attribute__((ext_vector_type(2))); typedef __bf16 bf16x2a_t __attribute__((ext_vector_type(2)));
__device__ __forceinline__ unsigned cvtpk(float lo, float hi) { const f32x2a_t v = {lo, hi}; const bf16x2a_t b = __builtin_convertvector(v, bf16x2a_t); return __builtin_bit_cast(unsigned, b); }
__device__ __forceinline__ float bf2f(short s) { return __uint_as_float(((unsigned)(unsigned short)s) << 16); }
__device__ __forceinline__ int v_st(int k, int c) { const int kk = (k & ~0xC) | ((k & 4) << 1) | ((k & 8) >> 1); return ((kk >> 3) * 2 + (c >> 5)) * 512 + ((kk & 7) * 32 + (c & 31)) * 2; }
__device__ __forceinline__ int v_rd_base(int lane) { return ((lane & 3) << 3) | (((lane >> 2) & 3) << 6) | (((lane >> 4) & 1) << 5) | (((lane >> 5) & 1) << 8); }
constexpr int v_rd_off(int d0, int ks, int half) { return ks * 2048 + half * 1024 + d0 * 512; }
template <int OFF> __device__ __forceinline__ s16x4 tr_read(int vb) { s16x4 r; asm volatile("ds_read_b64_tr_b16 %0, %1 offset:%2" : "=&v"(r) : "v"(vb), "i"(OFF) : "memory"); return r; }
template <int D0> __device__ __forceinline__ void pv_one(f32x16& od, int vb, bf16x8 pa0, bf16x8 pa1, bf16x8 pa2, bf16x8 pa3) {
    const s16x4 l0 = tr_read<v_rd_off(D0, 0, 0)>(vb), h0 = tr_read<v_rd_off(D0, 0, 1)>(vb), l1 = tr_read<v_rd_off(D0, 1, 0)>(vb), h1 = tr_read<v_rd_off(D0, 1, 1)>(vb);
    const s16x4 l2 = tr_read<v_rd_off(D0, 2, 0)>(vb), h2 = tr_read<v_rd_off(D0, 2, 1)>(vb), l3 = tr_read<v_rd_off(D0, 3, 0)>(vb), h3 = tr_read<v_rd_off(D0, 3, 1)>(vb);
    asm volatile("s_waitcnt lgkmcnt(0)" ::: "memory"); ASBAR();
#define ATT_PK(L, H) (bf16x8){L[0], L[1], L[2], L[3], H[0], H[1], H[2], H[3]}
    od = __builtin_amdgcn_mfma_f32_32x32x16_bf16(pa0, ATT_PK(l0, h0), od, 0, 0, 0);
    od = __builtin_amdgcn_mfma_f32_32x32x16_bf16(pa1, ATT_PK(l1, h1), od, 0, 0, 0);
    od = __builtin_amdgcn_mfma_f32_32x32x16_bf16(pa2, ATT_PK(l2, h2), od, 0, 0, 0);
    od = __builtin_amdgcn_mfma_f32_32x32x16_bf16(pa3, ATT_PK(l3, h3), od, 0, 0, 0);
#undef ATT_PK
}
__device__ __forceinline__ void pv_all(f32x16* o, f32x16& ol, int vb, bf16x8 pa0, bf16x8 pa1, bf16x8 pa2, bf16x8 pa3) {
    pv_one<0>(o[0], vb, pa0, pa1, pa2, pa3); pv_one<1>(o[1], vb, pa0, pa1, pa2, pa3);
#if ATT_LSUM_MFMA
    const bf16x8 ones = (bf16x8){0x3F80, 0x3F80, 0x3F80, 0x3F80, 0x3F80, 0x3F80, 0x3F80, 0x3F80};
    ol = __builtin_amdgcn_mfma_f32_32x32x16_bf16(pa0, ones, ol, 0, 0, 0); ol = __builtin_amdgcn_mfma_f32_32x32x16_bf16(pa1, ones, ol, 0, 0, 0);
    ol = __builtin_amdgcn_mfma_f32_32x32x16_bf16(pa2, ones, ol, 0, 0, 0); ol = __builtin_amdgcn_mfma_f32_32x32x16_bf16(pa3, ones, ol, 0, 0, 0);
#endif
}
__device__ __forceinline__ void partialSM(f32x16& p0, f32x16& p1, float& m_ref, f32x16& negm, float& alpha) {
    float pmax = p0[0];
#pragma unroll
    for (int r = 1; r < 16; ++r) pmax = fmaxf(pmax, p0[r]);
#pragma unroll
    for (int r = 0; r < 16; ++r) pmax = fmaxf(pmax, p1[r]);
    { auto rr = __builtin_amdgcn_permlane32_swap(__float_as_uint(pmax), __float_as_uint(pmax), false, false); pmax = fmaxf(__uint_as_float(rr[0]), __uint_as_float(rr[1])); }
    alpha = 1.f;
    if (__builtin_expect(!__all(pmax <= THR), 0)) { const float dl = (pmax > THR) ? pmax : 0.f; m_ref += dl; alpha = __builtin_amdgcn_exp2f(-dl);
#pragma unroll
        for (int r = 0; r < 16; ++r) { p0[r] -= dl; p1[r] -= dl; negm[r] = -m_ref; } }
#pragma unroll
    for (int r = 0; r < 16; ++r) p0[r] = __builtin_amdgcn_exp2f(p0[r]);
}
__device__ __forceinline__ void finishSM(f32x16& p0, f32x16& p1, bf16x8& pa0, bf16x8& pa1, bf16x8& pa2, bf16x8& pa3, float& lsum) {
#pragma unroll
    for (int r = 0; r < 16; ++r) p1[r] = __builtin_amdgcn_exp2f(p1[r]);
#if !ATT_LSUM_MFMA
    { float ps = 0.f;
#pragma unroll
      for (int r = 0; r < 16; ++r) ps += p0[r];
#pragma unroll
      for (int r = 0; r < 16; ++r) ps += p1[r];
      lsum += ps; }
#endif
#define ATT_PK4(P, BASE, OUT) do { unsigned a0 = cvtpk(P[BASE + 0], P[BASE + 1]), a1 = cvtpk(P[BASE + 2], P[BASE + 3]);   \
    unsigned b0 = cvtpk(P[BASE + 4], P[BASE + 5]), b1 = cvtpk(P[BASE + 6], P[BASE + 7]);                              \
    auto r0 = __builtin_amdgcn_permlane32_swap(a0, b0, false, false); auto r1 = __builtin_amdgcn_permlane32_swap(a1, b1, false, false); \
    u32x4 w = {r0[0], r1[0], r0[1], r1[1]}; OUT = __builtin_bit_cast(bf16x8, w); } while (0)
    ATT_PK4(p0, 0, pa0); ATT_PK4(p0, 8, pa1); ATT_PK4(p1, 0, pa2); ATT_PK4(p1, 8, pa3);
#undef ATT_PK4
}
template <int ND> __device__ __forceinline__ void qkt(f32x16& p0, f32x16& p1, ALDS const char* Kb, const int (&ka)[ND], const bf16x8 (&qr)[ND], const f32x16& cinit) {
#pragma unroll
    for (int d0 = 0; d0 < ND; ++d0) {
        const bf16x8 b0 = *(ALDS const bf16x8*)(Kb + ka[d0]);
        const bf16x8 b1 = *(ALDS const bf16x8*)(Kb + ka[d0] + (d0 < 4 ? 4096 : 2048));
        p0 = __builtin_amdgcn_mfma_f32_32x32x16_bf16(b0, qr[d0], d0 == 0 ? cinit : p0, 0, 0, 0);
        p1 = __builtin_amdgcn_mfma_f32_32x32x16_bf16(b1, qr[d0], d0 == 0 ? cinit : p1, 0, 0, 0);
        if (ND > 4 && d0 == 2) asm volatile("" ::: "memory"); }
}
__device__ __forceinline__ void cmask(f32x16& p0, f32x16& p1, int jt, int qrel, int hi) {
    const float NEG = -INFINITY; const int thr = qrel - 64 * jt - 4 * hi;
#pragma unroll
    for (int r = 0; r < 16; ++r) { if ((r & 3) + 8 * (r >> 2) > thr) p0[r] = NEG; if ((r & 3) + 8 * (r >> 2) + 32 > thr) p1[r] = NEG; }
}
__device__ __forceinline__ void kmean_blocks(const bf16_t* Kp, ALDS char* lds) {
    int tid_ = threadIdx.x; asm volatile("" : "+v"(tid_));
    const int tid = tid_, lane = tid & 63, wid = tid >> 6, c = tid & 7, rg = tid >> 3;
    ALDS float* red = (ALDS float*)(lds + L_RED); ALDS float* km = (ALDS float*)(lds + L_KM);
#pragma unroll 1
    for (int n = 0; n < 8; ++n) {
        float a[8];
#pragma unroll
        for (int j = 0; j < 8; ++j) a[j] = 0.f;
#pragma unroll
        for (int i = 0; i < 4; ++i) { const bf16x8 kx = *(const bf16x8*)(Kp + (size_t)(n * 256 + rg + 64 * i) * AW + c * 8);
#pragma unroll
            for (int j = 0; j < 8; ++j) a[j] += bf2f(kx[j]); }
#pragma unroll
        for (int j = 0; j < 8; ++j) { a[j] += __shfl_xor(a[j], 8); a[j] += __shfl_xor(a[j], 16); a[j] += __shfl_xor(a[j], 32); }
        if (lane < 8) {
#pragma unroll
            for (int j = 0; j < 8; ++j) red[(n * 8 + wid) * 64 + c * 8 + j] = a[j]; }
    }
    __syncthreads();
    { const int n = tid >> 6, d = tid & 63; float s = 0.f;
#pragma unroll
        for (int w = 0; w < 8; ++w) s += red[(n * 8 + w) * 64 + d];
        km[n * 64 + d] = s * (1.0f / 256.0f); }
    __syncthreads();
}
template <int DQK, bool MOBA>
__device__ __forceinline__ void attn_bh(const bf16_t* Qp, int ldq, const bf16_t* Kp, const bf16_t* KRp, const bf16_t* Vp, bf16_t* Op, int ldo, ALDS char* lds) {
    constexpr int ND = DQK / 16;
    ALDS char* K_lds = lds + L_K; ALDS char* V_lds = lds + L_V;
    bf16x8 sk0, sv0, sr0, sk1, sv1, sr1;
#define ATT_SLOAD(S, k0) do { sk##S = *(const bf16x8*)((const char*)(Kp + (size_t)(k0) * AW) + koff); sv##S = *(const bf16x8*)((const char*)(Vp + (size_t)(k0) * AW) + koff); if (DQK == 96) sr##S = *(const bf16x8*)((const char*)(KRp + (size_t)(k0) * RDIM) + roff); } while (0)
#define ATT_SWRITE(b, S) do { *(ALDS bf16x8*)(K_lds + (b) * KTB + kst) = sk##S; *(ALDS bf16x8*)(V_lds + (b) * VTB + vst) = sv##S; if (DQK == 96) { if (tid < 256) *(ALDS bf16x8*)(K_lds + (b) * KTB + rst) = sr##S; } } while (0)
#define ATT_QLOAD(q_) do { const bf16_t* Qw = Qp + (size_t)((q_) * 256 + wid * 32 + r32) * ldq + hi * 8; _Pragma("unroll") for (int d0 = 0; d0 < ND; ++d0) qr[d0] = *(const bf16x8*)(Qw + d0 * 16); } while (0)
    bf16x8 qr[ND];
    {
        const int tid = threadIdx.x, skey = tid >> 3, sch = tid & 7, t2 = tid & 255, rkey = t2 >> 2, rch = t2 & 3;
        const unsigned koff = (unsigned)(skey * AW + sch * 8) * 2u, roff = (unsigned)(rkey * RDIM + rch * 8) * 2u;
        ATT_SLOAD(0, 0); ATT_SLOAD(1, 64); }
#pragma unroll 1
  for (int qb = 0; qb < 8; ++qb) {
    int tid_ = threadIdx.x; asm volatile("" : "+v"(tid_));
    const int tid = tid_, lane = tid & 63, r32 = lane & 31, hi = lane >> 5; const int wid = __builtin_amdgcn_readfirstlane(tid >> 6);
    ALDS float* al_l = (ALDS float*)(lds + L_WS) + wid * 64;
    const int skey = tid >> 3, sch = tid & 7;
    const unsigned koff = (unsigned)(skey * AW + sch * 8) * 2u;
    const int kst = skey * 128 + ((sch ^ ((skey >> 1) & 7)) << 4), vst = v_st(skey, sch * 8);
    const int t2 = tid & 255, rkey = t2 >> 2, rch = t2 & 3;
    const unsigned roff = (unsigned)(rkey * RDIM + rch * 8) * 2u;
    const int rst = 8192 + rkey * 64 + ((rch ^ ((rkey >> 2) & 3)) << 4);
    int ka[ND];
#pragma unroll
    for (int d0 = 0; d0 < ND; ++d0) ka[d0] = (d0 < 4) ? r32 * 128 + (((2 * d0 + hi) ^ ((r32 >> 1) & 7)) << 4) : 8192 + r32 * 64 + (((2 * (d0 - 4) + hi) ^ ((r32 >> 2) & 3)) << 4);
    const int vb0 = (int)(unsigned)(uintptr_t)V_lds + v_rd_base(lane);
    const int qrel = wid * 32 + r32;
    ATT_QLOAD(qb);
    float m_ref = 0.f, lsum = 0.f; f32x16 o[2], ol, negm; o[0] = f32x16{}; o[1] = f32x16{}; ol = f32x16{}; negm = f32x16{};
    unsigned sel = 0xffu;
    if (MOBA && qb > 3) {
        ALDS const float* km = (ALDS const float*)(lds + L_KM); float g[8];
#pragma unroll
        for (int n = 0; n < 8; ++n) { float s = 0.f;
#pragma unroll
            for (int d0 = 0; d0 < ND; ++d0)
#pragma unroll
                for (int j = 0; j < 8; ++j) s += bf2f(qr[d0][j]) * km[n * 64 + d0 * 16 + hi * 8 + j];
            g[n] = s; }
#pragma unroll
        for (int n = 0; n < 8; ++n) g[n] += __shfl_xor(g[n], 32);
        sel = 0u;
#pragma unroll
        for (int n = 0; n < 8; ++n) { int rank = 0;
#pragma unroll
            for (int mm = 0; mm < 8; ++mm) if (mm != n) rank += (mm < qb && (g[mm] > g[n] || (g[mm] == g[n] && mm < n))) ? 1 : 0;
            if (n < qb && rank < 3) sel |= 1u << n; }
    }
#define ATT_RESC(a) do { if (__any((a) < 1.f)) { lsum *= (a); if (hi == 0) al_l[r32] = (a); asm volatile("s_waitcnt lgkmcnt(0)" ::: "memory"); \
    _Pragma("unroll") for (int r = 0; r < 16; ++r) { const float f_ = al_l[crow(r, hi)]; o[0][r] *= f_; o[1][r] *= f_; ol[r] *= f_; } } } while (0)
    f32x16 pA0, pA1, pB0, pB1; float alA, alB; bf16x8 pa0, pa1, pa2, pa3; const int NT = 4 * (qb + 1), NP = 4 * qb;
    f32x16 cm = negm; const bool gated = MOBA && qb > 3;
#define ATT_CM(t) do { if (gated) { if ((t) < NP) { const float v_ = ((sel >> ((t) >> 2)) & 1u) ? -m_ref : -INFINITY; _Pragma("unroll") for (int r = 0; r < 16; ++r) cm[r] = v_; } else cm = negm; } else cm = negm; } while (0)
#define ATT_SCORE(P0, P1, t) do { ATT_CM(t); qkt<ND>(P0, P1, K_lds + sc * KTB, ka, qr, cm); if ((t) >= NP) cmask(P0, P1, (t) - NP, qrel, hi); } while (0)
    int sp = 0, sc = 0, sn = 1;
#define ATT_ROT() do { sp = sc; sc = sn; sn = (sn == NSLOT - 1) ? 0 : sn + 1; } while (0)
    ATT_SWRITE(0, 0); ATT_SLOAD(0, 128);
    __syncthreads(); ATT_SWRITE(sn, 1); ATT_SLOAD(1, 192);
    ATT_SCORE(pA0, pA1, 0); partialSM(pA0, pA1, m_ref, negm, alA);
    ATT_ROT();
    for (int t = 1; t + 1 < NT; t += 2) {
        __syncthreads(); ATT_SWRITE(sn, 0); if (t + 3 < NT) ATT_SLOAD(0, (t + 3) * 64);
        ASBAR(); ATT_SCORE(pB0, pB1, t);
        finishSM(pA0, pA1, pa0, pa1, pa2, pa3, lsum); ASBAR();
        pv_all(o, ol, vb0 + sp * VTB, pa0, pa1, pa2, pa3); partialSM(pB0, pB1, m_ref, negm, alB);
        ATT_RESC(alB); ATT_ROT();
        __syncthreads(); ATT_SWRITE(sn, 1); if (t + 4 < NT) ATT_SLOAD(1, (t + 4) * 64);
        ASBAR(); ATT_SCORE(pA0, pA1, t + 1);
        finishSM(pB0, pB1, pa0, pa1, pa2, pa3, lsum); ASBAR();
        pv_all(o, ol, vb0 + sp * VTB, pa0, pa1, pa2, pa3); partialSM(pA0, pA1, m_ref, negm, alA);
        ATT_RESC(alA); ATT_ROT();
    }
    __syncthreads();
    ASBAR(); ATT_SCORE(pB0, pB1, NT - 1);
    if (qb < 7) { ATT_SLOAD(0, 0); ATT_SLOAD(1, 64); }
    finishSM(pA0, pA1, pa0, pa1, pa2, pa3, lsum); ASBAR();
    pv_all(o, ol, vb0 + sp * VTB, pa0, pa1, pa2, pa3); partialSM(pB0, pB1, m_ref, negm, alB);
    ATT_RESC(alB);
    finishSM(pB0, pB1, pa0, pa1, pa2, pa3, lsum); ASBAR();
    pv_all(o, ol, vb0 + sc * VTB, pa0, pa1, pa2, pa3);
#undef ATT_ROT
#undef ATT_SCORE
#undef ATT_CM
    float rli[16];
#if ATT_LSUM_MFMA
#pragma unroll
    for (int r = 0; r < 16; ++r) rli[r] = __builtin_amdgcn_rcpf(ol[r]);
#else
    { auto rr = __builtin_amdgcn_permlane32_swap(__float_as_uint(lsum), __float_as_uint(lsum), false, false); lsum = __uint_as_float(rr[0]) + __uint_as_float(rr[1]); }
    if (hi == 0) al_l[32 + r32] = lsum; asm volatile("s_waitcnt lgkmcnt(0)" ::: "memory");
#pragma unroll
    for (int r = 0; r < 16; ++r) rli[r] = __builtin_amdgcn_rcpf(al_l[32 + crow(r, hi)]);
#endif
    { ALDS unsigned short* stg = (ALDS unsigned short*)(lds + L_OST) + wid * 2048;
#pragma unroll
      for (int r = 0; r < 16; ++r) { const int orow = crow(r, hi);
#pragma unroll
          for (int d0 = 0; d0 < 2; ++d0) stg[orow * 64 + d0 * 32 + r32] = (unsigned short)(cvtpk(o[d0][r] * rli[r], 0.f) & 0xffffu); }
      asm volatile("s_waitcnt lgkmcnt(0)" ::: "memory");
      bf16_t* Ow = Op + (size_t)(qb * 256 + wid * 32) * ldo;
#pragma unroll
      for (int i = 0; i < 4; ++i) { const int row = i * 8 + (lane >> 3), ch = lane & 7; const u32x4 v = *(ALDS const u32x4*)(stg + row * 64 + ch * 8); *(u32x4*)(Ow + (size_t)row * ldo + ch * 8) = v; } }
    __syncthreads();
  }
#undef ATT_SLOAD
#undef ATT_SWRITE
#undef ATT_QLOAD
#undef ATT_RESC
}
#undef ASBAR
}
#define GAS __attribute__((address_space(1)))
#define LAS __attribute__((address_space(3)))
typedef unsigned short bf16;
typedef unsigned v4u __attribute__((ext_vector_type(4)));
typedef float f32x4 __attribute__((ext_vector_type(4)));
typedef short bf16x8 __attribute__((ext_vector_type(8)));
typedef GAS unsigned gu32;
typedef GAS unsigned long long gu64;
#define RLX_AGENT __ATOMIC_RELAXED, __HIP_MEMORY_SCOPE_AGENT
#define LDS_WAIT() asm volatile("s_waitcnt lgkmcnt(0)" ::: "memory")
#define VM_WAIT() asm volatile("s_waitcnt vmcnt(0)" ::: "memory")
__device__ __forceinline__ unsigned long long rt() { return __builtin_amdgcn_s_memrealtime(); }
__device__ __forceinline__ unsigned f2bf(float f) { unsigned u = __builtin_bit_cast(unsigned, f); return (u + 0x7fffu + ((u >> 16) & 1u)) >> 16; }
__device__ __forceinline__ unsigned pk2(float lo, float hi) { return f2bf(lo) | (f2bf(hi) << 16); }

#define XB_TMO      128
#define XB_XCNT(j)  (256  + 64 * (j))
#define XB_XSUB(j)  (1280 + 64 * (j))
#define XB_XGEN(j)  (2304 + 64 * (j))
#define XB_TOP      3328
#define XB_TOPGEN   3392
#define XCD_BAR_WORDS 3456
#define XB_SPIN_CAP (1u << 18)

__device__ __forceinline__ unsigned xb_ld(unsigned* p)              { return __hip_atomic_load(p, __ATOMIC_RELAXED, __HIP_MEMORY_SCOPE_AGENT); }
__device__ __forceinline__ unsigned xb_add(unsigned* p, unsigned v) { return __hip_atomic_fetch_add(p, v, __ATOMIC_RELAXED, __HIP_MEMORY_SCOPE_AGENT); }
__device__ __forceinline__ unsigned xb_xcc_id() { return (unsigned)__builtin_amdgcn_s_getreg((3 << 11) | 20) & 0xFu; }
#define XB_SPIN(cond, bar) do { unsigned _sp = 0; while (cond) { __builtin_amdgcn_s_sleep(1); \
    if ((++_sp & 255u) == 0u) { if (xb_ld(&(bar)[XB_TMO])) break; if (_sp > XB_SPIN_CAP) { atomicAdd(&(bar)[XB_TMO], 1u); break; } } } } while (0)

struct XcdBarrier {
    unsigned* bar; unsigned x;
    volatile LAS unsigned* st;
};

__device__ __forceinline__ XcdBarrier xcd_barrier_post(unsigned* bar, volatile LAS unsigned* st) {
    XcdBarrier b; b.bar = bar; b.x = xb_xcc_id(); b.st = st;
    if (threadIdx.x == 0) (void)xb_add(&bar[XB_XCNT(b.x)], 1u);
    return b;
}
__device__ __forceinline__ void xcd_barrier_complete(unsigned* bar, unsigned x, unsigned& nloc, unsigned& nx) {
    const unsigned G = gridDim.x * gridDim.y * gridDim.z;
    unsigned sum, cnt, mine, sp = 0u;
    for (;;) {
        sum = 0u; cnt = 0u; mine = 0u;
#pragma unroll
        for (unsigned j = 0; j < 16; ++j) { const unsigned c = xb_ld(&bar[XB_XCNT(j)]); sum += c; cnt += (c > 0u) ? 1u : 0u; mine = (j == x) ? c : mine; }
        if (sum == G) break;
        __builtin_amdgcn_s_sleep(1);
        if ((++sp & 255u) == 0u) { if (xb_ld(&bar[XB_TMO])) break; if (sp > XB_SPIN_CAP) { atomicAdd(&bar[XB_TMO], 1u); break; } }
    }
    nloc = mine > 0u ? mine : 1u; nx = cnt > 0u ? cnt : 1u;
}

__device__ __forceinline__ void xcd_barrier(const XcdBarrier& b) {
    asm volatile("s_waitcnt vmcnt(0)" ::: "memory");
    __syncthreads();
    if (threadIdx.x == 0) {
        unsigned* bar = b.bar;
        __builtin_amdgcn_s_waitcnt(0);
        unsigned nloc = b.st[0], nx = b.st[1];
        if (nloc == 0u) { xcd_barrier_complete(bar, b.x, nloc, nx); b.st[0] = nloc; b.st[1] = nx; }
        const unsigned old = xb_add(&bar[XB_XSUB(b.x)], 1u);
        const unsigned gen = old / nloc;
        if (old + 1u == (gen + 1u) * nloc) {
            __builtin_amdgcn_fence(__ATOMIC_RELEASE, "agent");
            asm volatile("s_waitcnt vmcnt(0)" ::: "memory");
            const unsigned og = xb_add(&bar[XB_TOP], 1u);
            const unsigned tg = og / nx;
            if (og + 1u == (tg + 1u) * nx) xb_add(&bar[XB_TOPGEN], 1u);
            else XB_SPIN(xb_ld(&bar[XB_TOPGEN]) == tg, bar);
            __builtin_amdgcn_fence(__ATOMIC_ACQUIRE, "agent");
            xb_add(&bar[XB_XGEN(b.x)], 1u);
            asm volatile("s_waitcnt vmcnt(0)" ::: "memory");
        } else {
            XB_SPIN(xb_ld(&bar[XB_XGEN(b.x)]) == gen, bar);
            __builtin_amdgcn_fence(__ATOMIC_ACQUIRE, "agent");
            asm volatile("s_waitcnt vmcnt(0)" ::: "memory");
        }
    }
    __syncthreads();
}

constexpr size_t MiB = 1u << 20;
constexpr size_t WS_CTL = 0, CTL_ZERO_BYTES = 64 * 1024;
constexpr size_t WS_ROPEA = 1 * MiB, WS_ROPEB = 5 * MiB;
constexpr size_t WS_SS = 13 * MiB, WS_SS2 = 16 * MiB, WS_SS3 = 20 * MiB;
constexpr size_t WS_WIN = 24 * MiB, WS_WUQ = 34 * MiB, WS_WUKV = 35 * MiB, WS_WA = 36 * MiB, WS_WOUT = 39 * MiB, WS_WUP = 42 * MiB, WS_WDN = 51 * MiB;
constexpr size_t WS_H = 64 * MiB;
constexpr size_t WS_G = 208 * MiB;
constexpr size_t WS_QA = 464 * MiB, WS_KA = 528 * MiB, WS_VA = 592 * MiB;
constexpr size_t WS_T = WS_KA;
constexpr size_t WS_CQ = 672 * MiB, WS_CKV = 720 * MiB;
constexpr size_t WS_KR = 760 * MiB;
constexpr size_t WS_QB = 768 * MiB, WS_KB = 864 * MiB, WS_VB = 928 * MiB;
constexpr size_t WS_Y = WS_QB;
constexpr size_t WS_X1 = 896 * MiB;
constexpr size_t WS_H8 = WS_QB;
constexpr size_t WS_WG8 = 60 * MiB;
constexpr size_t WS_U = 208 * MiB;
constexpr size_t WS_END = 1024 * MiB;
static_assert(WS_H + (size_t)MTOK * LDH * 2 <= WS_G && WS_G + (size_t)MTOK * 2 * DM * 2 <= WS_QA && WS_T + (size_t)MTOK * LDH * 2 <= WS_CQ && WS_CQ + (size_t)MTOK * QLORA * 2 <= WS_CKV && WS_CKV + (size_t)MTOK * LDKV * 2 <= WS_KR, "d_ws map");
static_assert(WS_U + (size_t)MTOK * LDU * 2 <= WS_KR && WS_Y + (size_t)MTOK * DM * 2 <= WS_X1 && WS_X1 + (size_t)MTOK * DM * 2 <= WS_END && WS_VB + (size_t)MTOK * AW * 2 <= WS_END && WS_KR + (size_t)MTOK * RDIM * 2 <= WS_QB, "d_ws map");
static_assert(WS_WIN + (size_t)INWP * LDH * 2 <= WS_WUQ && WS_WUKV + (size_t)1024 * LDKV * 2 <= WS_WA && WS_WA + (size_t)DM * LDH * 2 <= WS_WOUT && WS_WOUT + (size_t)DM * LDH * 2 <= WS_WUP && WS_WUP + (size_t)DFF * LDH * 2 <= WS_WDN && WS_WDN + (size_t)DM * LDU * 2 <= WS_H, "d_ws map");
constexpr int CW_BAR = 0;
constexpr int NWAVES = 8;
constexpr int RING_OFF = 0, RING_BYTES = 131072;
constexpr int LDSCTL_OFF = RING_BYTES, MISC_OFF = LDSCTL_OFF + 320;
constexpr int LDS_BYTES = 147456;
static_assert(att::L_END <= RING_BYTES, "attention LDS map");

struct Frame {
    LAS unsigned char* lds;
    volatile LAS unsigned* MISC;
    gu32* ctl;
    int tid, lane, wave, vcu, G;
};

__device__ __forceinline__ float wave_sum(float v) {
#pragma unroll
    for (int o = 1; o < 64; o <<= 1) v += __shfl_xor(v, o);
    return v;
}
__device__ __forceinline__ int srccol(int mat, int n) {
    if (mat == 0) {
        if (n < 1024) { const int sect = n >> 9, c = n & 511, head = c >> 6, p = c & 63; const int d = (p < 16) ? ((p >> 1) + 8 * (p & 1)) : p; return sect * 512 + head * 64 + d; }
        if (n < 1920) return n;
        if (n < 1952) { const int pr = n - 1920; return 2176 + (pr >> 1) + 16 * (pr & 1); }
        if (n < 2048) return -1;
        if (n < 2304) return 1920 + (n - 2048);
        return 2208 + (n - 2304);
    }
    if (mat == 1) { const int head = n / QKB, p = n - head * QKB; if (p < 64) return n; const int pr = p - 64; return head * QKB + 64 + (pr >> 1) + 16 * (pr & 1); }
    return n;
}
__device__ __forceinline__ void p0_transpose_item(const float* W, int K, int Nsrc, int Ndst, bf16* WT, int ldw, int koff, const float* gs, int mat, LAS float* scr, int item, int lane) {
    const int nblk = Ndst / 32, kb = item / nblk, nb = item % nblk, k0 = 64 * kb, n0 = 32 * nb;
    const int sc = srccol(mat, n0 + (lane & 31));
#pragma unroll 8
    for (int i = 0; i < 32; ++i) { const int kk = 2 * i + (lane >> 5); float v = (sc >= 0) ? W[(size_t)(k0 + kk) * Nsrc + sc] : 0.f; if (gs) v *= gs[k0 + kk]; scr[kk * 33 + (lane & 31)] = v; }
    LDS_WAIT(); asm volatile("" ::: "memory");
    const int c = lane & 7;
#pragma unroll
    for (int j = 0; j < 4; ++j) { const int n = (lane >> 3) + 8 * j; const LAS float* s = scr + (8 * c) * 33 + n;
        v4u o; o.x = pk2(s[0 * 33], s[1 * 33]); o.y = pk2(s[2 * 33], s[3 * 33]); o.z = pk2(s[4 * 33], s[5 * 33]); o.w = pk2(s[6 * 33], s[7 * 33]);
        *(GAS v4u*)(WT + (size_t)(n0 + n) * ldw + koff + k0 + 8 * c) = o; }
    LDS_WAIT(); asm volatile("" ::: "memory");
}
__device__ __forceinline__ void p0_transpose_item_f8(const float* W, int K, int N, int Nsrc, int coff, unsigned char* WT, float scale, LAS float* scr, int item, int lane) {
    const int nblk = N / 32, kb = item / nblk, nb = item % nblk, k0 = 64 * kb, n0 = 32 * nb;
#pragma unroll 8
    for (int i = 0; i < 32; ++i) { const int kk = 2 * i + (lane >> 5); scr[kk * 33 + (lane & 31)] = W[(size_t)(k0 + kk) * Nsrc + coff + n0 + (lane & 31)] * scale; }
    LDS_WAIT(); asm volatile("" ::: "memory");
    const int c = lane & 7;
#pragma unroll
    for (int j = 0; j < 4; ++j) { const int n = (lane >> 3) + 8 * j; const LAS float* s = scr + (8 * c) * 33 + n;
        int w0 = 0, w1 = 0;
        w0 = __builtin_amdgcn_cvt_pk_fp8_f32(s[0 * 33], s[1 * 33], w0, false); w0 = __builtin_amdgcn_cvt_pk_fp8_f32(s[2 * 33], s[3 * 33], w0, true);
        w1 = __builtin_amdgcn_cvt_pk_fp8_f32(s[4 * 33], s[5 * 33], w1, false); w1 = __builtin_amdgcn_cvt_pk_fp8_f32(s[6 * 33], s[7 * 33], w1, true);
        typedef int i32x2_ __attribute__((ext_vector_type(2)));
        *(GAS i32x2_*)(WT + (size_t)(n0 + n) * K + k0 + 8 * c) = (i32x2_){w0, w1}; }
    LDS_WAIT(); asm volatile("" ::: "memory");
}
__device__ __forceinline__ void rms_row_to_bf16(int lane, const float* xrow, const f32x4 (&g)[4], bf16* orow, unsigned char* orow8) {
    const GAS f32x4* xr = (const GAS f32x4*)xrow + lane;
    f32x4 v[4]; float s = 0.f;
#pragma unroll
    for (int j = 0; j < 4; ++j) { v[j] = xr[64 * j]; s += (v[j].x * v[j].x + v[j].y * v[j].y) + (v[j].z * v[j].z + v[j].w * v[j].w); }
    const float rstd = 1.f / sqrtf(wave_sum(s) * (1.f / DM) + EPS);
    GAS unsigned long long* o8 = (GAS unsigned long long*)orow + lane;
#pragma unroll
    for (int j = 0; j < 4; ++j) { const f32x4 y = v[j] * rstd * g[j]; o8[64 * j] = (unsigned long long)pk2(y.x, y.y) | ((unsigned long long)pk2(y.z, y.w) << 32);
        int w = 0; w = __builtin_amdgcn_cvt_pk_fp8_f32(y.x, y.y, w, false); w = __builtin_amdgcn_cvt_pk_fp8_f32(y.z, y.w, w, true); ((GAS int*)orow8)[lane + 64 * j] = w; }
}

struct Args { const float* in[17]; float* out; unsigned char* ws; int ph_lo, ph_hi, li, pad; };

__global__ void __launch_bounds__(NWAVES * 64, 2) block_fwd(Args args) {
    extern __shared__ __attribute__((aligned(16))) unsigned char lds[];
    Frame F;
    F.lds = (LAS unsigned char*)lds;
    F.MISC = (volatile LAS unsigned*)(F.lds + MISC_OFF);
    F.tid = threadIdx.x; F.lane = F.tid & 63; F.wave = __builtin_amdgcn_readfirstlane(F.tid >> 6);
    F.G = gridDim.x; { const int bx = blockIdx.x; F.vcu = (F.G % 8 == 0) ? (bx % 8) * (F.G / 8) + bx / 8 : bx; }
    unsigned char* ws = args.ws;
    F.ctl = (gu32*)(ws + WS_CTL);
    const float* x = args.in[0]; const int* positions = (const int*)args.in[1];
    const float *g_pre_mix = args.in[2], *w_in = args.in[3], *b_gate = args.in[4], *g_q = args.in[5], *w_uq = args.in[6], *g_kv = args.in[7], *w_ukv = args.in[8], *w_a = args.in[9], *w_b = args.in[10],
                *w_out = args.in[11], *g_post_mix = args.in[12], *g_pre_mlp = args.in[13], *w_up = args.in[14], *w_dn = args.in[15], *g_post_mlp = args.in[16];
    float* out = args.out;
    float* ropeA = (float*)(ws + WS_ROPEA); float* ropeB = (float*)(ws + WS_ROPEB);
    float* SS = (float*)(ws + WS_SS); float* SS2 = (float*)(ws + WS_SS2); float* SS3 = (float*)(ws + WS_SS3);
    bf16 *WIN = (bf16*)(ws + WS_WIN), *WUQ = (bf16*)(ws + WS_WUQ), *WUKV = (bf16*)(ws + WS_WUKV), *WA = (bf16*)(ws + WS_WA), *WOUT = (bf16*)(ws + WS_WOUT), *WUP = (bf16*)(ws + WS_WUP), *WDN = (bf16*)(ws + WS_WDN);
    bf16 *H = (bf16*)(ws + WS_H), *Gt = (bf16*)(ws + WS_G), *QA = (bf16*)(ws + WS_QA), *KA = (bf16*)(ws + WS_KA), *VA = (bf16*)(ws + WS_VA), *T = (bf16*)(ws + WS_T), *CQ = (bf16*)(ws + WS_CQ), *CKV = (bf16*)(ws + WS_CKV),
         *KR = (bf16*)(ws + WS_KR), *QB = (bf16*)(ws + WS_QB), *KB = (bf16*)(ws + WS_KB), *VB = (bf16*)(ws + WS_VB), *Y = (bf16*)(ws + WS_Y), *U = (bf16*)(ws + WS_U), *X1B = (bf16*)(ws + WS_X1); unsigned char *H8 = ws + WS_H8, *WG8 = ws + WS_WG8;
    for (int u = F.tid; u < (LDS_BYTES - LDSCTL_OFF) / 4; u += NWAVES * 64) ((LAS unsigned*)(F.lds + LDSCTL_OFF))[u] = 0u;
    __syncthreads();
    XcdBarrier bar = xcd_barrier_post((unsigned*)(F.ctl + CW_BAR) + args.li * XCD_BAR_WORDS, F.MISC + 8);
    const int lo = args.ph_lo, hi = args.ph_hi;
#define IN(k) (lo <= (k) && (k) < hi)
#define SEAM(k) do { if (IN(k) && IN((k) + 1)) xcd_barrier(bar); } while (0)
    const int gw = F.vcu * NWAVES + F.wave, NGW = F.G * NWAVES;

#if !defined(SKIP_P0)
    if (IN(0))
    {
        LAS float* scr = (LAS float*)(F.lds + RING_OFF + F.wave * 16384);
        constexpr int NBF = 2304, IG = (DM / 64) * (2 * DM / 32);
        constexpr int I0 = (DM / 64) * (NBF / 32), I1 = (QLORA / 64) * (768 / 32), I2 = (KVLORA / 64) * (1024 / 32), I3 = (AW / 64) * (DM / 32), I5 = (DM / 64) * (DM / 32), I6 = (DM / 64) * (DFF / 32), I7 = (DFF / 64) * (DM / 32);
        constexpr int NITEMS = I0 + I1 + I2 + 2 * I3 + I5 + I6 + I7 + IG;
        for (int it = gw; it < NITEMS; it += NGW) {
            int r = it;
            if (r < I0) { p0_transpose_item(w_in, DM, INW, NBF, WIN, LDH, 0, nullptr, 0, scr, r, F.lane); continue; } r -= I0;
            if (r < IG) { p0_transpose_item_f8(w_in, DM, 2 * DM, INW, 2208, WG8, 32.f, scr, r, F.lane); continue; } r -= IG;
            if (r < I1) { p0_transpose_item(w_uq, QLORA, 768, 768, WUQ, QLORA, 0, g_q, 1, scr, r, F.lane); continue; } r -= I1;
            if (r < I2) { p0_transpose_item(w_ukv, KVLORA, 1024, 1024, WUKV, LDKV, 0, g_kv, 2, scr, r, F.lane); continue; } r -= I2;
            if (r < I3) { p0_transpose_item(w_a, AW, DM, DM, WA, LDH, 0, nullptr, 2, scr, r, F.lane); continue; } r -= I3;
            if (r < I3) { p0_transpose_item(w_b, AW, DM, DM, WA, LDH, AW, nullptr, 2, scr, r, F.lane); continue; } r -= I3;
            if (r < I5) { p0_transpose_item(w_out, DM, DM, DM, WOUT, LDH, 0, nullptr, 2, scr, r, F.lane); continue; } r -= I5;
            if (r < I6) { p0_transpose_item_f8(w_up, DM, DFF, DFF, 0, (unsigned char*)WUP, 32.f, scr, r, F.lane); continue; } r -= I6;
            p0_transpose_item_f8(w_dn, DFF, DM, DM, 0, (unsigned char*)WDN, 64.f, scr, r, F.lane);
        }
        for (int idx = (int)blockIdx.x * (NWAVES * 64) + F.tid; idx < MTOK * 24; idx += F.G * NWAVES * 64) {
            const int m = idx / 24, i = idx - m * 24;
            const float invf = (i < 8) ? __builtin_amdgcn_exp2f(-(float)i * 2.3664460711655217f) : __builtin_amdgcn_exp2f(-(float)(i - 8) * 1.1832230355827609f);
            const float ang = (float)positions[m] * invf;
            double t = (double)ang * 0.15915494309189535; t -= floor(t);
            const float tf = (float)t; const float c = __builtin_amdgcn_cosf(tf), s = __builtin_amdgcn_sinf(tf);
            float* dst = (i < 8) ? ropeA + (size_t)m * 16 + 2 * i : ropeB + (size_t)m * 32 + 2 * (i - 8);
            *(f32x2g*)dst = (f32x2g){c, s};
        }
        f32x4 g[4];
#pragma unroll
        for (int j = 0; j < 4; ++j) g[j] = ((const GAS f32x4*)g_pre_mix)[F.lane + 64 * j];
        for (int m = gw; m < MTOK; m += NGW) rms_row_to_bf16(F.lane, x + (size_t)m * DM, g, H + (size_t)m * LDH, H8 + (size_t)m * DM);
    }
#endif
    SEAM(0);

#if !defined(SKIP_P1)
    if (IN(1))
    {
        { pg8::Gemm g{H, WIN, MTOK, 2304, DM, LDH, LDH}; pg8::StaticOrder S; S.init(MTOK, 2304, F.G, (int)blockIdx.x);
          pg8::EpiIn E{QA, KA, VA, CQ, CKV, KR, Gt, SS, ropeA, ropeB, b_gate};
          pg8::gemm_phase<pg8::EpiIn, pg8::StaticOrder, true, true>(F.lds + RING_OFF, g, S, E); }
        { pg8::Gemm g{(const bf16*)H8, (const bf16*)WG8, MTOK, 2 * DM, DM, DM, DM}; pg8::StaticOrder S; S.init(MTOK, 2 * DM, F.G, (int)blockIdx.x);
          pg8::EpiGates E{Gt, b_gate};
          pg8::gemm_phase<pg8::EpiGates, pg8::StaticOrder, true, true, 1>(F.lds + RING_OFF, g, S, E); }
    }
#endif
    SEAM(1);

#if !defined(SKIP_P2)
    if (IN(2)) {
    {
        pg8::Gemm g{CQ, WUQ, MTOK, NHEAD * QKB, QLORA}; pg8::StaticOrder S; S.init(MTOK, NHEAD * QKB, F.G, (int)blockIdx.x);
        pg8::EpiQ E{QB, SS, ropeB};
        pg8::gemm_phase<pg8::EpiQ, pg8::StaticOrder, true, true>(F.lds + RING_OFF, g, S, E);
    }
    {
        pg8::Gemm g{CKV, WUKV, MTOK, 2 * AW, KVLORA, LDKV, LDKV}; pg8::StaticOrder S; S.init(MTOK, 2 * AW, F.G, (int)blockIdx.x);
        pg8::EpiKV E{KB, VB, SS};
        pg8::gemm_phase<pg8::EpiKV, pg8::StaticOrder, true, true>(F.lds + RING_OFF, g, S, E);
    }
    }
#endif
    SEAM(2);

#if !defined(SKIP_P3)
    if (IN(3))
    {
        LAS char* al = (LAS char*)(F.lds + RING_OFF);
#if !defined(SKIP_MOBA)
        for (int bh = F.vcu; bh < NB * NHEAD; bh += F.G) {
            const int b = bh >> 3, h = bh & 7; const size_t r0 = (size_t)b * SEQ;
            att::kmean_blocks(KA + r0 * AW + h * HD, al);
            att::attn_bh<64, true>(QA + r0 * AW + h * HD, AW, KA + r0 * AW + h * HD, nullptr, VA + r0 * AW + h * HD, H + r0 * LDH + h * HD, LDH, al);
        }
#endif
#if !defined(SKIP_MLA)
        for (int bh = F.vcu; bh < NB * NHEAD; bh += F.G) {
            const int b = bh >> 3, h = bh & 7; const size_t r0 = (size_t)b * SEQ;
            att::attn_bh<96, false>(QB + r0 * (NHEAD * QKB) + h * QKB, NHEAD * QKB, KB + r0 * AW + h * HD, KR + r0 * RDIM, VB + r0 * AW + h * HD, H + r0 * LDH + AW + h * HD, LDH, al);
        }
#endif
    }
#endif
    SEAM(3);

#if !defined(SKIP_P4)
    if (IN(4))
    {
        pg8::Gemm g{H, WA, MTOK, DM, DM, LDH, LDH}; pg8::StaticOrder S; S.init(MTOK, DM, F.G, (int)blockIdx.x);
        pg8::EpiMerge E{Gt, T};
        pg8::gemm_phase<pg8::EpiMerge, pg8::StaticOrder, true, true>(F.lds + RING_OFF, g, S, E);
    }
#endif
    SEAM(4);

#if !defined(SKIP_P5)
    if (IN(5))
    {
        pg8::Gemm g{T, WOUT, MTOK, DM, DM, LDH, LDH}; pg8::StaticOrder S; S.init(MTOK, DM, F.G, (int)blockIdx.x);
        pg8::EpiSS E{Y, SS2, DM, 1.0f};
        pg8::gemm_phase<pg8::EpiSS, pg8::StaticOrder, true, true>(F.lds + RING_OFF, g, S, E);
    }
#endif
    SEAM(5);

#if !defined(SKIP_P6)
    if (IN(6))
    {
        f32x4 g1[4], g2[4];
#pragma unroll
        for (int j = 0; j < 4; ++j) { g1[j] = ((const GAS f32x4*)g_post_mix)[F.lane + 64 * j]; g2[j] = ((const GAS f32x4*)g_pre_mlp)[F.lane + 64 * j]; }
        for (int m = gw; m < MTOK; m += NGW) {
            const GAS f32x4* sp = (const GAS f32x4*)(SS2 + (size_t)m * 16); const f32x4 a = sp[0], b = sp[1], c = sp[2], d = sp[3];
            const float ssy = (((a.x + a.y) + (a.z + a.w)) + ((b.x + b.y) + (b.z + b.w))) + (((c.x + c.y) + (c.z + c.w)) + ((d.x + d.y) + (d.z + d.w)));
            const float rsy = 1.f / sqrtf(ssy * (1.f / DM) + EPS);
            const GAS f32x4* xr = (const GAS f32x4*)(x + (size_t)m * DM) + F.lane; const GAS unsigned long long* yr = (const GAS unsigned long long*)(Y + (size_t)m * DM) + F.lane;
            GAS unsigned long long* x8 = (GAS unsigned long long*)(X1B + (size_t)m * DM) + F.lane;
            f32x4 v[4]; float s = 0.f;
#pragma unroll
            for (int j = 0; j < 4; ++j) { const unsigned long long yw = yr[64 * j]; const unsigned lo = (unsigned)yw, hi = (unsigned)(yw >> 32);
                const f32x4 yv = (f32x4){__uint_as_float(lo << 16), __uint_as_float(lo & 0xffff0000u), __uint_as_float(hi << 16), __uint_as_float(hi & 0xffff0000u)};
                v[j] = xr[64 * j] + yv * rsy * g1[j]; x8[64 * j] = (unsigned long long)pk2(v[j].x, v[j].y) | ((unsigned long long)pk2(v[j].z, v[j].w) << 32);
                s += (v[j].x * v[j].x + v[j].y * v[j].y) + (v[j].z * v[j].z + v[j].w * v[j].w); }
            const float rstd = 1.f / sqrtf(wave_sum(s) * (1.f / DM) + EPS);
            GAS int* o8 = (GAS int*)((unsigned char*)H + (size_t)m * DM) + F.lane;
#pragma unroll
            for (int j = 0; j < 4; ++j) { const f32x4 y2 = v[j] * rstd * g2[j]; int w = 0; w = __builtin_amdgcn_cvt_pk_fp8_f32(y2.x, y2.y, w, false); w = __builtin_amdgcn_cvt_pk_fp8_f32(y2.z, y2.w, w, true); o8[64 * j] = w; }
        }
    }
#endif
    SEAM(6);

#if !defined(SKIP_P7)
    if (IN(7))
    {
        pg8::Gemm g{H, WUP, MTOK, DFF, DM, DM, DM}; pg8::StaticOrder S; S.init(MTOK, DFF, F.G, (int)blockIdx.x);
        pg8::EpiRelu2F8 E{(unsigned char*)U, 1.0f / 32.0f};
        pg8::gemm_phase<pg8::EpiRelu2F8, pg8::StaticOrder, true, true, 1>(F.lds + RING_OFF, g, S, E);
    }
#endif
    SEAM(7);

#if !defined(SKIP_P8)
    if (IN(8))
    {
        pg8::Gemm g{U, WDN, MTOK, DM, DFF, DFF, DFF}; pg8::StaticOrder S; S.init(MTOK, DM, F.G, (int)blockIdx.x);
        pg8::EpiSS E{H, SS3, LDH, 1.0f / 64.0f};
        pg8::gemm_phase<pg8::EpiSS, pg8::StaticOrder, true, true, 1>(F.lds + RING_OFF, g, S, E);
    }
#endif
    SEAM(8);

#if !defined(SKIP_P9)
    if (IN(9))
    {
        f32x4 g1[4];
#pragma unroll
        for (int j = 0; j < 4; ++j) g1[j] = ((const GAS f32x4*)g_post_mlp)[F.lane + 64 * j];
        for (int m = gw; m < MTOK; m += NGW) {
            const GAS f32x4* sp = (const GAS f32x4*)(SS3 + (size_t)m * 16); const f32x4 a = sp[0], b = sp[1], c = sp[2], d = sp[3];
            const float ssy = (((a.x + a.y) + (a.z + a.w)) + ((b.x + b.y) + (b.z + b.w))) + (((c.x + c.y) + (c.z + c.w)) + ((d.x + d.y) + (d.z + d.w)));
            const float rsy = 1.f / sqrtf(ssy * (1.f / DM) + EPS);
            const GAS unsigned long long* yr = (const GAS unsigned long long*)(H + (size_t)m * LDH) + F.lane;
            const GAS unsigned long long* xq = (const GAS unsigned long long*)(X1B + (size_t)m * DM) + F.lane;
            GAS f32x4* o4 = (GAS f32x4*)(out + (size_t)m * DM) + F.lane;
#pragma unroll
            for (int j = 0; j < 4; ++j) { const unsigned long long yw = yr[64 * j]; const unsigned lo = (unsigned)yw, hi = (unsigned)(yw >> 32);
                const f32x4 yv = (f32x4){__uint_as_float(lo << 16), __uint_as_float(lo & 0xffff0000u), __uint_as_float(hi << 16), __uint_as_float(hi & 0xffff0000u)};
                const unsigned long long xw = xq[64 * j]; const unsigned xl = (unsigned)xw, xh = (unsigned)(xw >> 32);
                const f32x4 xv = (f32x4){__uint_as_float(xl << 16), __uint_as_float(xl & 0xffff0000u), __uint_as_float(xh << 16), __uint_as_float(xh & 0xffff0000u)};
                o4[64 * j] = xv + yv * rsy * g1[j]; }
        }
    }
#endif
}

extern "C" void kernel_launch(void* const* d_in, const int* in_sizes, int n_in, void* d_out, int out_size, void* d_ws, size_t ws_size, hipStream_t stream) {
    static int grid = 0;
    if (grid == 0) {
        if (n_in != 17 || in_sizes[0] != MTOK * DM || out_size != MTOK * DM || ws_size < WS_END) { fprintf(stderr, "kernel_launch: unexpected shapes (n_in %d, in0 %d, out %d, ws %zu); nothing launched\n", n_in, n_in > 0 ? in_sizes[0] : -1, out_size, ws_size); grid = -1; return; }
        int dev = 0, cus = 0, per_cu = 0;
        if (hipGetDevice(&dev) != hipSuccess || hipDeviceGetAttribute(&cus, hipDeviceAttributeMultiprocessorCount, dev) != hipSuccess) { fprintf(stderr, "kernel_launch: device query failed\n"); grid = -1; return; }
        if (hipFuncSetAttribute((const void*)block_fwd, hipFuncAttributeMaxDynamicSharedMemorySize, LDS_BYTES) != hipSuccess) { fprintf(stderr, "kernel_launch: hipFuncSetAttribute failed\n"); grid = -1; return; }
        if (hipOccupancyMaxActiveBlocksPerMultiprocessor(&per_cu, (const void*)block_fwd, NWAVES * 64, LDS_BYTES) != hipSuccess || per_cu < 1) { fprintf(stderr, "kernel_launch: occupancy query reports %d workgroups per CU\n", per_cu); }
        (void)hipGetLastError();
        grid = cus;
    }
    if (grid < 0) return;
    if (hipMemsetAsync((char*)d_ws + WS_CTL, 0, CTL_ZERO_BYTES, stream) != hipSuccess) { fprintf(stderr, "kernel_launch: hipMemsetAsync failed\n"); return; }
    Args a{};
    for (int i = 0; i < 17; ++i) a.in[i] = (const float*)d_in[i];
    a.out = (float*)d_out; a.ws = (unsigned char*)d_ws;
    a.ph_lo = 0; a.ph_hi = 10; a.li = 0;
    hipLaunchKernelGGL(block_fwd, dim3(grid), dim3(NWAVES * 64), LDS_BYTES, stream, a);
    const hipError_t le = hipPeekAtLastError();
    if (le != hipSuccess) fprintf(stderr, "kernel_launch: launch failed: %s\n", hipGetErrorName(le));
}
```

```cpp
#include <hip/hip_runtime.h>
#include <hip/hip_bf16.h>
#include <cstdio>
#include <cstdint>
#include <cmath>
constexpr int NB = 32, SEQ = 2048, DM = 1024, MTOK = NB * SEQ;
constexpr int NHEAD = 8, HD = 64, AW = NHEAD * HD;
constexpr int QLORA = 384, KVLORA = 256, RDIM = 32, QKB = 96;
constexpr int DFF = 4096, INW = 4256, INWP = 4352;
constexpr int LDH = DM, LDU = DFF, LDKV = KVLORA;
constexpr float EPS = 1e-6f;
constexpr float LOG2E = 1.4426950408889634f;
constexpr float C2A = 0.125f * LOG2E;
constexpr float C2B = 0.10206207261596575f * LOG2E;
typedef float f32x2g __attribute__((ext_vector_type(2)));
namespace pg8 {
#define PG8_LAS __attribute__((address_space(3)))
typedef unsigned short bf16_t;
typedef short bf16x8 __attribute__((ext_vector_type(8)));
typedef float f32x4 __attribute__((ext_vector_type(4)));
typedef unsigned u32x4 __attribute__((ext_vector_type(4)));
constexpr int BM = 256, BK = 64, HALF = 128, HTB = HALF * BK * 2  , STAGE_BYTES = 8 * HTB, NXCD = 8, WGM = 8;

__host__ __device__ __forceinline__ int lds_byte(int r, int c) { const int st = (r >> 4) * 2 + (c >> 5), rr = r & 15, cc = c & 31, ob = rr * 64 + cc * 2; return st * 1024 + (ob ^ (((ob >> 9) & 1) << 5)); }
__host__ __device__ __forceinline__ void stage_rc(int b, int& R, int& C) { const int st = b / 1024, sb = b % 1024, swz = sb ^ (((sb >> 9) & 1) << 5); R = (st >> 1) * 16 + swz / 64; C = (st & 1) * 32 + (swz % 64) / 2; }
__host__ __device__ __forceinline__ int perm32(int rho) { const int n = rho >> 4, i = rho & 15; return 8 * (i >> 2) + 4 * n + (i & 3); }

struct Unit { int pm, pn; };
struct Gemm { const bf16_t* A; const bf16_t* Bt; int M, N, K, lda, ldb; };

struct StaticOrder {
    int nM, nN, nwg, G, c;
    __host__ __device__ void init(int M, int N, int G_, int c_) { nM = M / BM; nN = N / BM; nwg = nM * nN; G = G_; c = c_; }
    __host__ __device__ bool next(int i, Unit& u) const {
        const long L = (long)i * G + c; if (L >= nwg) return false;
        int wgid = (int)L; { const int q = nwg / NXCD, r = nwg % NXCD, xcd = wgid % NXCD, off = wgid / NXCD; wgid = (xcd < r ? xcd * (q + 1) : r * (q + 1) + (xcd - r) * q) + off; }
        const int nig = WGM * nN, gid = wgid / nig, fm = gid * WGM, gsz = (nM - fm) < WGM ? (nM - fm) : WGM;
        u.pm = fm + ((wgid % nig) % gsz); u.pn = (wgid % nig) / gsz; return true;
    }
    __device__ __forceinline__ void a_ready(const Unit&) const {}
    __device__ __forceinline__ void done(const Unit&) const {}
};

__device__ __forceinline__ unsigned cvt_pk_bf16(float lo, float hi) { unsigned r; asm volatile("v_cvt_pk_bf16_f32 %0, %1, %2" : "=v"(r) : "v"(lo), "v"(hi)); return r; }
__device__ __forceinline__ void ld8(float (&v)[8], const f32x4& a, const f32x4& b) { v[0] = a[0]; v[1] = a[1]; v[2] = a[2]; v[3] = a[3]; v[4] = b[0]; v[5] = b[1]; v[6] = b[2]; v[7] = b[3]; }
typedef float f32x2c_t __attribute__((ext_vector_type(2))); typedef __bf16 bf16x2c_t __attribute__((ext_vector_type(2)));
__device__ __forceinline__ unsigned cvtpk_c(float lo, float hi) { const f32x2c_t v = {lo, hi}; const bf16x2c_t b = __builtin_convertvector(v, bf16x2c_t); return __builtin_bit_cast(unsigned, b); }
__device__ __forceinline__ u32x4 pack8(const float (&v)[8]) { u32x4 w; w.x = cvtpk_c(v[0], v[1]); w.y = cvtpk_c(v[2], v[3]); w.z = cvtpk_c(v[4], v[5]); w.w = cvtpk_c(v[6], v[7]); return w; }
__device__ __forceinline__ void unpack8(const u32x4 w, float (&v)[8]) {
    v[0] = __uint_as_float(w.x << 16); v[1] = __uint_as_float(w.x & 0xffff0000u); v[2] = __uint_as_float(w.y << 16); v[3] = __uint_as_float(w.y & 0xffff0000u);
    v[4] = __uint_as_float(w.z << 16); v[5] = __uint_as_float(w.z & 0xffff0000u); v[6] = __uint_as_float(w.w << 16); v[7] = __uint_as_float(w.w & 0xffff0000u); }
__device__ __forceinline__ void rope4(float (&v)[8], const f32x4 a, const f32x4 b) {
    float x1, x2;
    x1 = v[0]; x2 = v[1]; v[0] = x1 * a[0] - x2 * a[1]; v[1] = x2 * a[0] + x1 * a[1];
    x1 = v[2]; x2 = v[3]; v[2] = x1 * a[2] - x2 * a[3]; v[3] = x2 * a[2] + x1 * a[3];
    x1 = v[4]; x2 = v[5]; v[4] = x1 * b[0] - x2 * b[1]; v[5] = x2 * b[0] + x1 * b[1];
    x1 = v[6]; x2 = v[7]; v[6] = x1 * b[2] - x2 * b[3]; v[7] = x2 * b[2] + x1 * b[3];
}
__device__ __forceinline__ float sumsq8(const float (&v)[8]) { return ((v[0] * v[0] + v[1] * v[1]) + (v[2] * v[2] + v[3] * v[3])) + ((v[4] * v[4] + v[5] * v[5]) + (v[6] * v[6] + v[7] * v[7])); }
__device__ __forceinline__ float red_fq(float s) { s += __shfl_xor(s, 16); s += __shfl_xor(s, 32); return s; }

__device__ __forceinline__ size_t gfrag_off(int pm, int t8, int wid, int grp, int lane) { return ((((size_t)(pm * 8 + t8) * 8 + wid) * 16 + grp) * 64 + lane) * 8; }
struct EpiIn {
    static constexpr bool PERM = true, AFTER_DRAIN = false; static constexpr int MIDT = 0;
    bf16_t *QA, *KA, *VA, *CQ, *CKV, *KR, *G; float* SS; const float* ropeA; const float* ropeB; const float* bgate;
    __device__ __forceinline__ void operator()(const f32x4 (&acc)[2][2][4][2], const Unit& u, int wr, int wc, int fr, int fq) const {
        asm volatile("" : "+v"(fr), "+v"(fq));
        const int row0 = u.pm * BM + wr * 64 + fr, pn = u.pn, cl = wc * 32 + 8 * fq;
        if (pn < 4) {
            bf16_t* dst = (pn < 2) ? QA : KA; const float sc = (pn < 2) ? C2A : 1.f; const int cb = (pn & 1) * 256 + cl;
            if ((wc & 1) == 0) {
                const bool rp = fq < 2;
#pragma unroll
                for (int ai = 0; ai < 2; ++ai)
#pragma unroll
                    for (int m = 0; m < 4; ++m) { const int row = row0 + ai * HALF + m * 16;
                        const f32x4* t = (const f32x4*)(ropeA + (size_t)row * 16 + (rp ? fq * 8 : 0));
                        f32x4 ca = t[0], cc = t[1]; if (!rp) { ca = (f32x4){1.f, 0.f, 1.f, 0.f}; cc = ca; }
#pragma unroll
                        for (int bj = 0; bj < 2; ++bj) { float v[8]; ld8(v, acc[ai][bj][m][0], acc[ai][bj][m][1]); rope4(v, ca, cc);
#pragma unroll
                            for (int j = 0; j < 8; ++j) v[j] *= sc;
                            *(u32x4*)(dst + (size_t)row * AW + cb + bj * HALF) = pack8(v); } }
            } else {
#pragma unroll
                for (int ai = 0; ai < 2; ++ai)
#pragma unroll
                    for (int m = 0; m < 4; ++m) { const int row = row0 + ai * HALF + m * 16;
#pragma unroll
                        for (int bj = 0; bj < 2; ++bj) { float v[8]; ld8(v, acc[ai][bj][m][0], acc[ai][bj][m][1]);
#pragma unroll
                            for (int j = 0; j < 8; ++j) v[j] *= sc;
                            *(u32x4*)(dst + (size_t)row * AW + cb + bj * HALF) = pack8(v); } }
            }
        } else if (pn < 6) {
            const int cb = (pn - 4) * 256 + cl;
#pragma unroll
            for (int ai = 0; ai < 2; ++ai)
#pragma unroll
                for (int m = 0; m < 4; ++m) { const int row = row0 + ai * HALF + m * 16;
#pragma unroll
                    for (int bj = 0; bj < 2; ++bj) { float v[8]; ld8(v, acc[ai][bj][m][0], acc[ai][bj][m][1]); *(u32x4*)(VA + (size_t)row * AW + cb + bj * HALF) = pack8(v); } }
        } else if (pn == 6 || pn == 8) {
            bf16_t* dst = (pn == 6) ? CQ : CKV; const int ld = (pn == 6) ? QLORA : LDKV, slot = ((pn == 6) ? 0 : 8) + wc;
#pragma unroll
            for (int ai = 0; ai < 2; ++ai)
#pragma unroll
                for (int m = 0; m < 4; ++m) { const int row = row0 + ai * HALF + m * 16; float s = 0.f;
#pragma unroll
                    for (int bj = 0; bj < 2; ++bj) { float v[8]; ld8(v, acc[ai][bj][m][0], acc[ai][bj][m][1]); s += sumsq8(v); *(u32x4*)(dst + (size_t)row * ld + cl + bj * HALF) = pack8(v); }
                    s = red_fq(s); if (fq == 0) SS[(size_t)row * 12 + slot] = s; }
        } else if (pn == 7) {
#pragma unroll
            for (int ai = 0; ai < 2; ++ai)
#pragma unroll
                for (int m = 0; m < 4; ++m) { const int row = row0 + ai * HALF + m * 16;
                    { float v[8]; ld8(v, acc[ai][0][m][0], acc[ai][0][m][1]); float s = red_fq(sumsq8(v)); *(u32x4*)(CQ + (size_t)row * QLORA + 256 + cl) = pack8(v); if (fq == 0) SS[(size_t)row * 12 + 4 + wc] = s; }
                    if (wc == 0) { float v[8]; ld8(v, acc[ai][1][m][0], acc[ai][1][m][1]); const f32x4* t = (const f32x4*)(ropeB + (size_t)row * 32 + fq * 8); rope4(v, t[0], t[1]);
                        *(u32x4*)(KR + (size_t)row * RDIM + 8 * fq) = pack8(v); } }
        }
    }
};
struct EpiGates {
    static constexpr bool PERM = true, AFTER_DRAIN = false; static constexpr int MIDT = 0;
    bf16_t* G; const float* bgate;
    __device__ __forceinline__ void operator()(const f32x4 (&acc)[2][2][4][2], const Unit& u, int wr, int wc, int fr, int fq) const {
        asm volatile("" : "+v"(fr), "+v"(fq));
        const int gc = u.pn * 256 + wc * 32 + 8 * fq;
        f32x4 bv[2][2];
#pragma unroll
        for (int bj = 0; bj < 2; ++bj)
#pragma unroll
            for (int n = 0; n < 2; ++n) bv[bj][n] = *(const f32x4*)(bgate + gc + bj * HALF + 4 * n);
#pragma unroll
        for (int ai = 0; ai < 2; ++ai)
#pragma unroll
            for (int m = 0; m < 4; ++m) {
#pragma unroll
                for (int bj = 0; bj < 2; ++bj) { float v[8]; ld8(v, acc[ai][bj][m][0] * (1.0f / 32.0f) + bv[bj][0], acc[ai][bj][m][1] * (1.0f / 32.0f) + bv[bj][1]);
#pragma unroll
                    for (int j = 0; j < 8; ++j) v[j] = __builtin_amdgcn_rcpf(1.f + __builtin_amdgcn_exp2f(-LOG2E * v[j]));
                    *(u32x4*)(G + gfrag_off(u.pm, u.pn, wr * 4 + wc, ai * 8 + m * 2 + bj, fq * 16 + fr)) = pack8(v); } }
    }
};
struct EpiQ {
    static constexpr bool PERM = true, AFTER_DRAIN = false; static constexpr int MIDT = 0;
    bf16_t* QB; const float* SS; const float* ropeB;
    __device__ __forceinline__ void operator()(const f32x4 (&acc)[2][2][4][2], const Unit& u, int wr, int wc, int fr, int fq) const {
        asm volatile("" : "+v"(fr), "+v"(fq));
        const int row0 = u.pm * BM + wr * 64 + fr, cl = u.pn * BM + wc * 32 + 8 * fq;
        const int c0 = cl, c1 = cl + HALF, h0 = c0 / QKB, h1 = c1 / QKB, p0 = c0 - h0 * QKB, p1 = c1 - h1 * QKB;
        const bool r0 = p0 >= 64, r1 = p1 >= 64; const int roff = r0 ? p0 - 64 : (r1 ? p1 - 64 : 0);
#pragma unroll
        for (int b = 0; b < 2; ++b) {
            f32x4 s0[4], s1[4], ta[4], tb[4];
#pragma unroll
            for (int m = 0; m < 4; ++m) { const int row = row0 + b * HALF + m * 16;
                const f32x4* sp = (const f32x4*)(SS + (size_t)row * 12); s0[m] = sp[0]; s1[m] = sp[1];
                const f32x4* t = (const f32x4*)(ropeB + (size_t)row * 32 + roff); ta[m] = t[0]; tb[m] = t[1]; }
            asm volatile("" ::: "memory");
#pragma unroll
            for (int m = 0; m < 4; ++m) { const int row = row0 + b * HALF + m * 16;
                const float ss = ((s0[m][0] + s0[m][1]) + (s0[m][2] + s0[m][3])) + ((s1[m][0] + s1[m][1]) + (s1[m][2] + s1[m][3]));
                const float rs = __builtin_amdgcn_rsqf(ss * (1.0f / QLORA) + EPS) * C2B;
#pragma unroll
                for (int bj = 0; bj < 2; ++bj) { float v[8]; ld8(v, acc[b][bj][m][0], acc[b][bj][m][1]);
#pragma unroll
                    for (int j = 0; j < 8; ++j) v[j] *= rs;
                    if (bj == 0 ? r0 : r1) rope4(v, ta[m], tb[m]);
                    *(u32x4*)(QB + (size_t)row * (NHEAD * QKB) + (bj == 0 ? c0 : c1)) = pack8(v); } }
        }
    }
};
struct EpiKV {
    static constexpr bool PERM = true, AFTER_DRAIN = false; static constexpr int MIDT = 0;
    bf16_t *KB, *VB; const float* SS;
    __device__ __forceinline__ void operator()(const f32x4 (&acc)[2][2][4][2], const Unit& u, int wr, int wc, int fr, int fq) const {
        asm volatile("" : "+v"(fr), "+v"(fq));
        const int row0 = u.pm * BM + wr * 64 + fr;
        bf16_t* dst = (wc < 2) ? KB : VB; const int pc = (wc & 1) * 32 + 8 * fq;
        f32x4 s0[2][4];
#pragma unroll
        for (int ai = 0; ai < 2; ++ai)
#pragma unroll
            for (int m = 0; m < 4; ++m) s0[ai][m] = *(const f32x4*)(SS + (size_t)(row0 + ai * HALF + m * 16) * 12 + 8);
#pragma unroll
        for (int ai = 0; ai < 2; ++ai)
#pragma unroll
            for (int m = 0; m < 4; ++m) { const int row = row0 + ai * HALF + m * 16; const f32x4 sv = s0[ai][m];
                const float rs = __builtin_amdgcn_rsqf(((sv[0] + sv[1]) + (sv[2] + sv[3])) * (1.0f / KVLORA) + EPS);
#pragma unroll
                for (int bj = 0; bj < 2; ++bj) { const int hd = u.pn * 2 + bj;
                    float v[8]; ld8(v, acc[ai][bj][m][0], acc[ai][bj][m][1]);
#pragma unroll
                    for (int j = 0; j < 8; ++j) v[j] *= rs;
                    *(u32x4*)(dst + (size_t)row * AW + hd * HD + pc) = pack8(v); } }
    }
};
struct EpiMerge {
    static constexpr bool PERM = true, AFTER_DRAIN = false; static constexpr int MIDT = 8;
    const bf16_t* G; bf16_t* T;
    __device__ __forceinline__ void mid(f32x4 (&acc)[2][2][4][2], const Unit& u, int wr, int wc, int fr, int fq) const {
        asm volatile("" : "+v"(fr), "+v"(fq));
        const bf16_t* pa = G + gfrag_off(u.pm, u.pn, wr * 4 + wc, 0, fq * 16 + fr); const bf16_t* pb = G + gfrag_off(u.pm, 4 + u.pn, wr * 4 + wc, 0, fq * 16 + fr);
        u32x4 ca[4], cb[4], na[4], nb[4];
#pragma unroll
        for (int i = 0; i < 4; ++i) { ca[i] = *(const u32x4*)(pa + (size_t)i * 512); cb[i] = *(const u32x4*)(pb + (size_t)i * 512); }
#pragma unroll
        for (int b = 0; b < 4; ++b) {
            if (b < 3) {
#pragma unroll
                for (int i = 0; i < 4; ++i) { na[i] = *(const u32x4*)(pa + (size_t)((b + 1) * 4 + i) * 512); nb[i] = *(const u32x4*)(pb + (size_t)((b + 1) * 4 + i) * 512); } }
            asm volatile("" ::: "memory");
#pragma unroll
            for (int i = 0; i < 4; ++i) { const int grp = b * 4 + i, ai = grp >> 3, m = (grp >> 1) & 3, bj = grp & 1; float ga[8], gb[8]; unpack8(ca[i], ga); unpack8(cb[i], gb);
#pragma unroll
                for (int j = 0; j < 8; ++j) ga[j] *= __builtin_amdgcn_rcpf(__builtin_fmaxf(gb[j], 1e-30f));
                acc[ai][bj][m][0] *= (f32x4){ga[0], ga[1], ga[2], ga[3]}; acc[ai][bj][m][1] *= (f32x4){ga[4], ga[5], ga[6], ga[7]}; }
#pragma unroll
            for (int i = 0; i < 4; ++i) { ca[i] = na[i]; cb[i] = nb[i]; }
        }
    }
    __device__ __forceinline__ void operator()(const f32x4 (&acc)[2][2][4][2], const Unit& u, int wr, int wc, int fr, int fq) const {
        asm volatile("" : "+v"(fr), "+v"(fq));
        const int row0 = u.pm * BM + wr * 64 + fr, cl = u.pn * BM + wc * 32 + 8 * fq;
        const bf16_t* pb = G + gfrag_off(u.pm, 4 + u.pn, wr * 4 + wc, 0, fq * 16 + fr);
        u32x4 cb[8], nb[8];
#pragma unroll
        for (int i = 0; i < 8; ++i) cb[i] = *(const u32x4*)(pb + (size_t)i * 512);
#pragma unroll
        for (int b = 0; b < 2; ++b) {
            if (b < 1) {
#pragma unroll
                for (int i = 0; i < 8; ++i) nb[i] = *(const u32x4*)(pb + (size_t)(8 + i) * 512); }
            asm volatile("" ::: "memory");
#pragma unroll
            for (int i = 0; i < 8; ++i) { const int grp = b * 8 + i, ai = grp >> 3, m = (grp >> 1) & 3, bj = grp & 1; float v[8], gb[8]; ld8(v, acc[ai][bj][m][0], acc[ai][bj][m][1]); unpack8(cb[i], gb);
#pragma unroll
                for (int j = 0; j < 8; ++j) v[j] *= __builtin_fmaxf(gb[j], 1e-30f);
                *(u32x4*)(T + (size_t)(row0 + ai * HALF + m * 16) * LDH + cl + bj * HALF) = pack8(v); }
#pragma unroll
            for (int i = 0; i < 8; ++i) cb[i] = nb[i];
        }
    }
};
struct EpiSS {
    static constexpr bool PERM = true, AFTER_DRAIN = false; static constexpr int MIDT = 0;
    bf16_t* Y; float* SSY; int ldy; float scale;
    __device__ __forceinline__ void operator()(const f32x4 (&acc)[2][2][4][2], const Unit& u, int wr, int wc, int fr, int fq) const {
        asm volatile("" : "+v"(fr), "+v"(fq));
        const int row0 = u.pm * BM + wr * 64 + fr, cl = u.pn * BM + wc * 32 + 8 * fq;
#pragma unroll
        for (int ai = 0; ai < 2; ++ai)
#pragma unroll
            for (int m = 0; m < 4; ++m) { const int row = row0 + ai * HALF + m * 16; float s = 0.f;
#pragma unroll
                for (int bj = 0; bj < 2; ++bj) { float v[8]; ld8(v, acc[ai][bj][m][0] * scale, acc[ai][bj][m][1] * scale); s += sumsq8(v); *(u32x4*)(Y + (size_t)row * ldy + cl + bj * HALF) = pack8(v); }
                s = red_fq(s); if (fq == 0) SSY[(size_t)row * 16 + u.pn * 4 + wc] = s; }
    }
};
struct EpiRelu2F8 {
    static constexpr bool PERM = true, AFTER_DRAIN = false; static constexpr int MIDT = 0;
    unsigned char* U; float scale;
    __device__ __forceinline__ void operator()(const f32x4 (&acc)[2][2][4][2], const Unit& u, int wr, int wc, int fr, int fq) const {
        asm volatile("" : "+v"(fr), "+v"(fq));
        unsigned char* base = U + ((size_t)(u.pm * 16 + wr * 4) * 64 + u.pn * 4 + wc) * 1024 + (unsigned)(fq * 16 + fr) * 16u;
#pragma unroll
        for (int ai = 0; ai < 2; ++ai)
#pragma unroll
            for (int m = 0; m < 4; ++m) { int w[4];
#pragma unroll
                for (int bj = 0; bj < 2; ++bj) { float v[8]; ld8(v, acc[ai][bj][m][0], acc[ai][bj][m][1]);
#pragma unroll
                    for (int j = 0; j < 8; ++j) { const float r = __builtin_fmaxf(v[j] * scale, 0.f); v[j] = __builtin_fminf(r * r, 440.f); }
                    int w0 = 0, w1 = 0;
                    w0 = __builtin_amdgcn_cvt_pk_fp8_f32(v[0], v[1], w0, false); w0 = __builtin_amdgcn_cvt_pk_fp8_f32(v[2], v[3], w0, true);
                    w1 = __builtin_amdgcn_cvt_pk_fp8_f32(v[4], v[5], w1, false); w1 = __builtin_amdgcn_cvt_pk_fp8_f32(v[6], v[7], w1, true);
                    w[2 * bj] = w0; w[2 * bj + 1] = w1; }
                typedef int i32x4e_ __attribute__((ext_vector_type(4)));
                *(i32x4e_*)(base + (size_t)(ai * 8 + m) * 65536) = (i32x4e_){w[0], w[1], w[2], w[3]}; }
    }
};
struct EpiRelu2 {
    static constexpr bool PERM = true, AFTER_DRAIN = false; static constexpr int MIDT = 0;
    bf16_t* U;
    __device__ __forceinline__ void operator()(const f32x4 (&acc)[2][2][4][2], const Unit& u, int wr, int wc, int fr, int fq) const {
        asm volatile("" : "+v"(fr), "+v"(fq));
        const int row0 = u.pm * BM + wr * 64 + fr, cl = u.pn * BM + wc * 32 + 8 * fq;
#pragma unroll
        for (int ai = 0; ai < 2; ++ai)
#pragma unroll
            for (int m = 0; m < 4; ++m) { const int row = row0 + ai * HALF + m * 16;
#pragma unroll
                for (int bj = 0; bj < 2; ++bj) { float v[8]; ld8(v, acc[ai][bj][m][0], acc[ai][bj][m][1]);
#pragma unroll
                    for (int j = 0; j < 8; ++j) { const float r = __builtin_fmaxf(v[j], 0.f); v[j] = r * r; }
                    *(u32x4*)(U + (size_t)row * LDU + cl + bj * HALF) = pack8(v); } }
    }
};
template <class Epi, class Sched, bool ALIGN_EPI = false, bool SP2 = false, int ESZ = 2, bool ACH = false>
__device__ __forceinline__ void gemm_phase(PG8_LAS unsigned char* lds, const Gemm g, const Sched& S, const Epi& E) {
    int tid_ = threadIdx.x; asm volatile("" : "+v"(tid_));
    const int tid = tid_, wid = __builtin_amdgcn_readfirstlane(tid >> 6), lane = tid & 63, wr = wid >> 2, wc = wid & 3, fr = lane & 15, fq = lane >> 4;
    const int K = g.K, nt = K * ESZ / (BK * 2), lda = g.lda ? g.lda : K, ldb = g.ldb ? g.ldb : K;
    unsigned voffA[2], voffB[2];
#pragma unroll
    for (int i = 0; i < 2; ++i) { int R, C; stage_rc(tid * 16 + i * 8192, R, C); const int Rb = Epi::PERM ? ((R & ~31) + perm32(R & 31)) : R;
        if constexpr (ACH) { const int st_ = (tid >> 6) + 8 * i; voffA[i] = (unsigned)((st_ >> 1) * 16 * lda * ESZ + (st_ & 1) * 1024 + (tid & 63) * 16); } else voffA[i] = (unsigned)(R * lda * ESZ + C * 2);
        voffB[i] = (unsigned)(Rb * ldb * ESZ + C * 2); }
    const size_t kstepB = (size_t)(BK * 2), kstepA = ACH ? (size_t)2048 : kstepB;
    const size_t hstepA = (size_t)HALF * lda * ESZ, hstepB = (size_t)HALF * ldb * ESZ;
    const size_t tstepA = 2 * hstepA, tstepB = 2 * hstepB;
    const unsigned ldsw = (unsigned)wid * 1024u;
    const int aoff = ACH ? wr * 8192 + lane * 16 : lds_byte(wr * 64 + fr, fq * 8), boff = lds_byte(wc * 32 + fr, fq * 8);
#define PG8_SA(b, h) (((b) * 2 + (h)) * HTB)
#define PG8_SB(b, h) ((4 + (b) * 2 + (h)) * HTB)
#define PG8_STAGE(bufoff, gbase, voff) do { _Pragma("unroll") for (int _i = 0; _i < 2; ++_i) \
        __builtin_amdgcn_global_load_lds((const unsigned*)((const char*)(gbase) + (voff)[_i]), (PG8_LAS unsigned*)(lds + (bufoff) + ldsw + _i * 8192), 16, 0, 0); } while (0)
#define PG8_LDA(dst, b, h) do { if constexpr (ESZ == 2) { _Pragma("unroll") for (int m = 0; m < 4; ++m) _Pragma("unroll") for (int k = 0; k < 2; ++k) dst[m][k] = *(const PG8_LAS bf16x8*)(lds + PG8_SA(b, h) + aoff + m * 2048 + k * 1024); } \
        else { _Pragma("unroll") for (int m = 0; m < 4; ++m) { dst##8[m].lo = *(const PG8_LAS i32x4_*)(lds + PG8_SA(b, h) + aoff + m * 2048); dst##8[m].hi = *(const PG8_LAS i32x4_*)(lds + PG8_SA(b, h) + aoff + m * 2048 + 1024); } } } while (0)
#define PG8_LDB(dst, b, h) do { if constexpr (ESZ == 2) { _Pragma("unroll") for (int n = 0; n < 2; ++n) _Pragma("unroll") for (int k = 0; k < 2; ++k) dst[n][k] = *(const PG8_LAS bf16x8*)(lds + PG8_SB(b, h) + boff + n * 2048 + k * 1024); } \
        else { _Pragma("unroll") for (int n = 0; n < 2; ++n) { dst##8[n].lo = *(const PG8_LAS i32x4_*)(lds + PG8_SB(b, h) + boff + n * 2048); dst##8[n].hi = *(const PG8_LAS i32x4_*)(lds + PG8_SB(b, h) + boff + n * 2048 + 1024); } } } while (0)
#define PG8_MMA(ai, bj, At, Bt) do { __builtin_amdgcn_s_setprio(1); \
        if constexpr (ESZ == 2) { _Pragma("unroll") for (int m = 0; m < 4; ++m) _Pragma("unroll") for (int n = 0; n < 2; ++n) _Pragma("unroll") for (int k = 0; k < 2; ++k) \
            acc[ai][bj][m][n] = __builtin_amdgcn_mfma_f32_16x16x32_bf16(Bt[n][k], At[m][k], acc[ai][bj][m][n], 0, 0, 0); } \
        else {   \
            _Pragma("unroll") for (int m = 0; m < 4; ++m) _Pragma("unroll") for (int n = 0; n < 2; ++n) \
                asm volatile("v_mfma_scale_f32_16x16x128_f8f6f4 %0, %1, %2, %0, %3, %3 op_sel_hi:[0,0,0]" : "+v"(acc[ai][bj][m][n]) : "v"(Bt##8[n]), "v"(At##8[m]), "v"(scl_)); } \
        __builtin_amdgcn_s_setprio(0); } while (0)
#define PG8_WAIT_V(n) asm volatile("s_waitcnt vmcnt(" #n ")" ::: "memory")
#define PG8_WAIT_L(n) asm volatile("s_waitcnt lgkmcnt(" #n ")" ::: "memory")
#define PG8_BAR __builtin_amdgcn_s_barrier()
#define PG8_SCHED __builtin_amdgcn_sched_barrier(0)
    Unit cur, nxt; int ui = 0;
    if (!S.next(0, cur)) return;
    f32x4 acc[2][2][4][2];
#pragma unroll
    for (int a = 0; a < 2; ++a)
#pragma unroll
        for (int b = 0; b < 2; ++b)
#pragma unroll
            for (int m = 0; m < 4; ++m)
#pragma unroll
                for (int n = 0; n < 2; ++n) acc[a][b][m][n] = (f32x4){0.f, 0.f, 0.f, 0.f};
    bf16x8 At[4][2], B0[2][2], B1[2][2];
    typedef int i32x4_ __attribute__((ext_vector_type(4))); typedef int i32x8_ __attribute__((ext_vector_type(8)));
    const int scl_ = 0x7F7F7F7F;
    i32x8_ At8[4], B08[2], B18[2];
    const char* cA = (const char*)g.A + (size_t)cur.pm * tstepA; const char* cB = (const char*)g.Bt + (size_t)cur.pn * tstepB;
    S.a_ready(cur);
    if constexpr (SP2) {
        PG8_STAGE(PG8_SB(0, 0), cB, voffB); PG8_STAGE(PG8_SB(0, 1), cB + hstepB, voffB); PG8_STAGE(PG8_SA(0, 0), cA, voffA); PG8_STAGE(PG8_SA(0, 1), cA + hstepA, voffA);
        if (wr == 1) PG8_BAR;
        PG8_WAIT_V(2); PG8_BAR;
        PG8_STAGE(PG8_SB(1, 0), cB + kstepB, voffB); PG8_STAGE(PG8_SA(1, 0), cA + kstepA, voffA); PG8_STAGE(PG8_SB(1, 1), cB + hstepB + kstepB, voffB);
        PG8_WAIT_V(6); PG8_BAR;
    } else {
        PG8_STAGE(PG8_SB(0, 0), cB, voffB); PG8_STAGE(PG8_SA(0, 0), cA, voffA); PG8_STAGE(PG8_SB(0, 1), cB + hstepB, voffB); PG8_STAGE(PG8_SA(0, 1), cA + hstepA, voffA);
        if (wr == 1) PG8_BAR;
        PG8_WAIT_V(4); PG8_BAR;
        PG8_STAGE(PG8_SB(1, 0), cB + kstepB, voffB); PG8_STAGE(PG8_SA(1, 0), cA + kstepA, voffA); PG8_STAGE(PG8_SB(1, 1), cB + hstepB + kstepB, voffB);
        PG8_WAIT_V(6); PG8_BAR;
    }
    for (;;) {
        const bool has_next = S.next(ui + 1, nxt);
        const char* nA = has_next ? (const char*)g.A + (size_t)nxt.pm * tstepA : cA; const char* nB = has_next ? (const char*)g.Bt + (size_t)nxt.pn * tstepB : cB;
#pragma unroll 1
        for (int t = 0; t < nt; t += 2) {
            if constexpr (Epi::MIDT > 0) { if (t == Epi::MIDT) E.mid(acc, cur, wr, wc, fr, fq); }
            const bool last = (t == nt - 2);
            const char* a1 = cA + (size_t)(t + 1) * kstepA;
            const char* a2 = last ? nA : cA + (size_t)(t + 2) * kstepA; const char* b2 = last ? nB : cB + (size_t)(t + 2) * kstepB;
            const char* a3 = a2 + kstepA; const char* b3 = b2 + kstepB;
            if (last && has_next) S.a_ready(nxt);
            if constexpr (SP2) {
            PG8_LDB(B0, 0, 0); PG8_LDB(B1, 0, 1); PG8_SCHED; PG8_LDA(At, 0, 0); PG8_STAGE(PG8_SA(1, 1), a1 + hstepA, voffA);
            PG8_WAIT_V(8); PG8_WAIT_L(0); PG8_BAR; PG8_MMA(0, 0, At, B0); PG8_MMA(0, 1, At, B1); PG8_BAR; PG8_SCHED;
            PG8_LDA(At, 0, 1); PG8_STAGE(PG8_SB(0, 0), b2, voffB); PG8_STAGE(PG8_SB(0, 1), b2 + hstepB, voffB); PG8_STAGE(PG8_SA(0, 0), a2, voffA);
            PG8_WAIT_V(8); PG8_WAIT_L(0); PG8_BAR; PG8_MMA(1, 0, At, B0); PG8_MMA(1, 1, At, B1); PG8_BAR; PG8_SCHED;
            PG8_LDB(B0, 1, 0); PG8_LDB(B1, 1, 1); PG8_SCHED; PG8_LDA(At, 1, 0); PG8_STAGE(PG8_SA(0, 1), a2 + hstepA, voffA);
            PG8_WAIT_V(8); PG8_WAIT_L(0); PG8_BAR; PG8_MMA(0, 0, At, B0); PG8_MMA(0, 1, At, B1); PG8_BAR; PG8_SCHED;
            PG8_LDA(At, 1, 1); PG8_STAGE(PG8_SB(1, 0), b3, voffB); PG8_STAGE(PG8_SB(1, 1), b3 + hstepB, voffB); PG8_STAGE(PG8_SA(1, 0), a3, voffA);
            PG8_WAIT_V(8); PG8_WAIT_L(0); PG8_BAR; PG8_MMA(1, 0, At, B0); PG8_MMA(1, 1, At, B1); PG8_BAR; PG8_SCHED;
            } else {
            PG8_LDB(B0, 0, 0); PG8_SCHED; PG8_LDA(At, 0, 0); PG8_STAGE(PG8_SA(1, 1), a1 + hstepA, voffA);
            PG8_WAIT_L(8); PG8_BAR; PG8_WAIT_L(0); PG8_MMA(0, 0, At, B0); PG8_BAR; PG8_SCHED;
            PG8_LDB(B1, 0, 1); PG8_STAGE(PG8_SB(0, 0), b2, voffB);
            PG8_BAR; PG8_WAIT_L(0); PG8_MMA(0, 1, At, B1); PG8_BAR;
            PG8_LDA(At, 0, 1); PG8_STAGE(PG8_SA(0, 0), a2, voffA);
            PG8_BAR; PG8_WAIT_L(0); PG8_MMA(1, 0, At, B0); PG8_BAR; PG8_SCHED;
            PG8_STAGE(PG8_SB(0, 1), b2 + hstepB, voffB);
            PG8_WAIT_V(6); PG8_BAR; PG8_MMA(1, 1, At, B1); PG8_BAR;
            PG8_LDB(B0, 1, 0); PG8_SCHED; PG8_LDA(At, 1, 0); PG8_STAGE(PG8_SA(0, 1), a2 + hstepA, voffA);
            PG8_WAIT_L(8); PG8_BAR; PG8_WAIT_L(0); PG8_MMA(0, 0, At, B0); PG8_BAR; PG8_SCHED;
            PG8_LDB(B1, 1, 1); PG8_STAGE(PG8_SB(1, 0), b3, voffB);
            PG8_BAR; PG8_WAIT_L(0); PG8_MMA(0, 1, At, B1); PG8_BAR;
            PG8_LDA(At, 1, 1); PG8_STAGE(PG8_SA(1, 0), a3, voffA);
            PG8_BAR; PG8_WAIT_L(0); PG8_MMA(1, 0, At, B0); PG8_BAR; PG8_SCHED;
            PG8_STAGE(PG8_SB(1, 1), b3 + hstepB, voffB);
            PG8_WAIT_V(6); PG8_BAR; PG8_MMA(1, 1, At, B1); PG8_BAR;
            }
        }
        if constexpr (ALIGN_EPI) { if (wr == 0) PG8_BAR; }
        if constexpr (ESZ == 1) asm volatile("s_nop 15\n\ts_nop 15" ::: "memory");
        if constexpr (!Epi::AFTER_DRAIN) { E(acc, cur, wr, wc, fr, fq); S.done(cur); }
        if (!has_next) break;
#pragma unroll
        for (int a = 0; a < 2; ++a)
#pragma unroll
            for (int b = 0; b < 2; ++b)
#pragma unroll
                for (int m = 0; m < 4; ++m)
#pragma unroll
                    for (int n = 0; n < 2; ++n) acc[a][b][m][n] = (f32x4){0.f, 0.f, 0.f, 0.f};
        cur = nxt; cA = nA; cB = nB; ++ui;
        if constexpr (ALIGN_EPI) { if (wr == 1) PG8_BAR; }
    }
    PG8_WAIT_V(0);
    if constexpr (!ALIGN_EPI) { if (wr == 0) PG8_BAR; }
    PG8_BAR;
    if constexpr (Epi::AFTER_DRAIN) { E.fused(acc, cur, wr, wc, fr, fq, lds, wid, lane); S.done(cur); }
#undef PG8_SA
#undef PG8_SB
#undef PG8_STAGE
#undef PG8_LDA
#undef PG8_LDB
#undef PG8_MMA
#undef PG8_WAIT_V
#undef PG8_WAIT_L
#undef PG8_BAR
#undef PG8_SCHED
}
}
#ifndef ATT_LSUM_MFMA
#define ATT_LSUM_MFMA 1
#endif
namespace att {
typedef unsigned short bf16_t;
typedef short bf16x8 __attribute__((ext_vector_type(8)));
typedef short s16x4 __attribute__((ext_vector_type(4)));
typedef float f32x16 __attribute__((ext_vector_type(16)));
typedef float f32x4 __attribute__((ext_vector_type(4)));
typedef unsigned u32x4 __attribute__((ext_vector_type(4)));
#define ALDS __attribute__((address_space(3)))
#define ASBAR() __builtin_amdgcn_sched_barrier(0)
constexpr int KTB = 12288, VTB = 8192;
constexpr int NSLOT = 3;
constexpr int L_K = 0, L_V = NSLOT * KTB, L_WS = L_V + NSLOT * VTB, L_OST = L_WS + 8 * 256, L_KM = L_OST + 8 * 4096, L_RED = L_KM + 2048, L_END = L_RED + 16384;
constexpr float THR = 8.f;
__device__ __forceinline__ int crow(int r, int hi) { return (r & 3) + 8 * (r >> 2) + 4 * hi; }
typedef float f32x2a_t __attribute__((ext_vector_type(2))); typedef __bf16 bf16x2a_t __attribute__((ext_vector_type(2)));
__device__ __forceinline__ unsigned cvtpk(float lo, float hi) { const f32x2a_t v = {lo, hi}; const bf16x2a_t b = __builtin_convertvector(v, bf16x2a_t); return __builtin_bit_cast(unsigned, b); }
__device__ __forceinline__ float bf2f(short s) { return __uint_as_float(((unsigned)(unsigned short)s) << 16); }
__device__ __forceinline__ int v_st(int k, int c) { const int kk = (k & ~0xC) | ((k & 4) << 1) | ((k & 8) >> 1); return ((kk >> 3) * 2 + (c >> 5)) * 512 + ((kk & 7) * 32 + (c & 31)) * 2; }
__device__ __forceinline__ int v_rd_base(int lane) { return ((lane & 3) << 3) | (((lane >> 2) & 3) << 6) | (((lane >> 4) & 1) << 5) | (((lane >> 5) & 1) << 8); }
constexpr int v_rd_off(int d0, int ks, int half) { return ks * 2048 + half * 1024 + d0 * 512; }
template <int OFF> __device__ __forceinline__ s16x4 tr_read(int vb) { s16x4 r; asm volatile("ds_read_b64_tr_b16 %0, %1 offset:%2" : "=&v"(r) : "v"(vb), "i"(OFF) : "memory"); return r; }
template <int D0> __device__ __forceinline__ void pv_one(f32x16& od, int vb, bf16x8 pa0, bf16x8 pa1, bf16x8 pa2, bf16x8 pa3) {
    const s16x4 l0 = tr_read<v_rd_off(D0, 0, 0)>(vb), h0 = tr_read<v_rd_off(D0, 0, 1)>(vb), l1 = tr_read<v_rd_off(D0, 1, 0)>(vb), h1 = tr_read<v_rd_off(D0, 1, 1)>(vb);
    const s16x4 l2 = tr_read<v_rd_off(D0, 2, 0)>(vb), h2 = tr_read<v_rd_off(D0, 2, 1)>(vb), l3 = tr_read<v_rd_off(D0, 3, 0)>(vb), h3 = tr_read<v_rd_off(D0, 3, 1)>(vb);
    asm volatile("s_waitcnt lgkmcnt(0)" ::: "memory"); ASBAR();
#define ATT_PK(L, H) (bf16x8){L[0], L[1], L[2], L[3], H[0], H[1], H[2], H[3]}
    od = __builtin_amdgcn_mfma_f32_32x32x16_bf16(pa0, ATT_PK(l0, h0), od, 0, 0, 0);
    od = __builtin_amdgcn_mfma_f32_32x32x16_bf16(pa1, ATT_PK(l1, h1), od, 0, 0, 0);
    od = __builtin_amdgcn_mfma_f32_32x32x16_bf16(pa2, ATT_PK(l2, h2), od, 0, 0, 0);
    od = __builtin_amdgcn_mfma_f32_32x32x16_bf16(pa3, ATT_PK(l3, h3), od, 0, 0, 0);
#undef ATT_PK
}
__device__ __forceinline__ void pv_all(f32x16* o, f32x16& ol, int vb, bf16x8 pa0, bf16x8 pa1, bf16x8 pa2, bf16x8 pa3) {
    pv_one<0>(o[0], vb, pa0, pa1, pa2, pa3); pv_one<1>(o[1], vb, pa0, pa1, pa2, pa3);
#if ATT_LSUM_MFMA
    const bf16x8 ones = (bf16x8){0x3F80, 0x3F80, 0x3F80, 0x3F80, 0x3F80, 0x3F80, 0x3F80, 0x3F80};
    ol = __builtin_amdgcn_mfma_f32_32x32x16_bf16(pa0, ones, ol, 0, 0, 0); ol = __builtin_amdgcn_mfma_f32_32x32x16_bf16(pa1, ones, ol, 0, 0, 0);
    ol = __builtin_amdgcn_mfma_f32_32x32x16_bf16(pa2, ones, ol, 0, 0, 0); ol = __builtin_amdgcn_mfma_f32_32x32x16_bf16(pa3, ones, ol, 0, 0, 0);
#endif
}
__device__ __forceinline__ void partialSM(f32x16& p0, f32x16& p1, float& m_ref, f32x16& negm, float& alpha) {
    float pmax = p0[0];
#pragma unroll
    for (int r = 1; r < 16; ++r) pmax = fmaxf(pmax, p0[r]);
#pragma unroll
    for (int r = 0; r < 16; ++r) pmax = fmaxf(pmax, p1[r]);
    { auto rr = __builtin_amdgcn_permlane32_swap(__float_as_uint(pmax), __float_as_uint(pmax), false, false); pmax = fmaxf(__uint_as_float(rr[0]), __uint_as_float(rr[1])); }
    alpha = 1.f;
    if (__builtin_expect(!__all(pmax <= THR), 0)) { const float dl = (pmax > THR) ? pmax : 0.f; m_ref += dl; alpha = __builtin_amdgcn_exp2f(-dl);
#pragma unroll
        for (int r = 0; r < 16; ++r) { p0[r] -= dl; p1[r] -= dl; negm[r] = -m_ref; } }
#pragma unroll
    for (int r = 0; r < 16; ++r) p0[r] = __builtin_amdgcn_exp2f(p0[r]);
}
__device__ __forceinline__ void finishSM(f32x16& p0, f32x16& p1, bf16x8& pa0, bf16x8& pa1, bf16x8& pa2, bf16x8& pa3, float& lsum) {
#pragma unroll
    for (int r = 0; r < 16; ++r) p1[r] = __builtin_amdgcn_exp2f(p1[r]);
#if !ATT_LSUM_MFMA
    { float ps = 0.f;
#pragma unroll
      for (int r = 0; r < 16; ++r) ps += p0[r];
#pragma unroll
      for (int r = 0; r < 16; ++r) ps += p1[r];
      lsum += ps; }
#endif
#define ATT_PK4(P, BASE, OUT) do { unsigned a0 = cvtpk(P[BASE + 0], P[BASE + 1]), a1 = cvtpk(P[BASE + 2], P[BASE + 3]);   \
    unsigned b0 = cvtpk(P[BASE + 4], P[BASE + 5]), b1 = cvtpk(P[BASE + 6], P[BASE + 7]);                              \
    auto r0 = __builtin_amdgcn_permlane32_swap(a0, b0, false, false); auto r1 = __builtin_amdgcn_permlane32_swap(a1, b1, false, false); \
    u32x4 w = {r0[0], r1[0], r0[1], r1[1]}; OUT = __builtin_bit_cast(bf16x8, w); } while (0)
    ATT_PK4(p0, 0, pa0); ATT_PK4(p0, 8, pa1); ATT_PK4(p1, 0, pa2); ATT_PK4(p1, 8, pa3);
#undef ATT_PK4
}
template <int ND> __device__ __forceinline__ void qkt(f32x16& p0, f32x16& p1, ALDS const char* Kb, const int (&ka)[ND], const bf16x8 (&qr)[ND], const f32x16& cinit) {
#pragma unroll
    for (int d0 = 0; d0 < ND; ++d0) {
        const bf16x8 b0 = *(ALDS const bf16x8*)(Kb + ka[d0]);
        const bf16x8 b1 = *(ALDS const bf16x8*)(Kb + ka[d0] + (d0 < 4 ? 4096 : 2048));
        p0 = __builtin_amdgcn_mfma_f32_32x32x16_bf16(b0, qr[d0], d0 == 0 ? cinit : p0, 0, 0, 0);
        p1 = __builtin_amdgcn_mfma_f32_32x32x16_bf16(b1, qr[d0], d0 == 0 ? cinit : p1, 0, 0, 0);
        if (ND > 4 && d0 == 2) asm volatile("" ::: "memory"); }
}
__device__ __forceinline__ void cmask(f32x16& p0, f32x16& p1, int jt, int qrel, int hi) {
    const float NEG = -INFINITY; const int thr = qrel - 64 * jt - 4 * hi;
#pragma unroll
    for (int r = 0; r < 16; ++r) { if ((r & 3) + 8 * (r >> 2) > thr) p0[r] = NEG; if ((r & 3) + 8 * (r >> 2) + 32 > thr) p1[r] = NEG; }
}
__device__ __forceinline__ void kmean_blocks(const bf16_t* Kp, ALDS char* lds) {
    int tid_ = threadIdx.x; asm volatile("" : "+v"(tid_));
    const int tid = tid_, lane = tid & 63, wid = tid >> 6, c = tid & 7, rg = tid >> 3;
    ALDS float* red = (ALDS float*)(lds + L_RED); ALDS float* km = (ALDS float*)(lds + L_KM);
#pragma unroll 1
    for (int n = 0; n < 8; ++n) {
        float a[8];
#pragma unroll
        for (int j = 0; j < 8; ++j) a[j] = 0.f;
#pragma unroll
        for (int i = 0; i < 4; ++i) { const bf16x8 kx = *(const bf16x8*)(Kp + (size_t)(n * 256 + rg + 64 * i) * AW + c * 8);
#pragma unroll
            for (int j = 0; j < 8; ++j) a[j] += bf2f(kx[j]); }
#pragma unroll
        for (int j = 0; j < 8; ++j) { a[j] += __shfl_xor(a[j], 8); a[j] += __shfl_xor(a[j], 16); a[j] += __shfl_xor(a[j], 32); }
        if (lane < 8) {
#pragma unroll
            for (int j = 0; j < 8; ++j) red[(n * 8 + wid) * 64 + c * 8 + j] = a[j]; }
    }
    __syncthreads();
    { const int n = tid >> 6, d = tid & 63; float s = 0.f;
#pragma unroll
        for (int w = 0; w < 8; ++w) s += red[(n * 8 + w) * 64 + d];
        km[n * 64 + d] = s * (1.0f / 256.0f); }
    __syncthreads();
}
template <int DQK, bool MOBA>
__device__ __forceinline__ void attn_bh(const bf16_t* Qp, int ldq, const bf16_t* Kp, const bf16_t* KRp, const bf16_t* Vp, bf16_t* Op, int ldo, ALDS char* lds) {
    constexpr int ND = DQK / 16;
    ALDS char* K_lds = lds + L_K; ALDS char* V_lds = lds + L_V;
    bf16x8 sk0, sv0, sr0, sk1, sv1, sr1;
#define ATT_SLOAD(S, k0) do { sk##S = *(const bf16x8*)((const char*)(Kp + (size_t)(k0) * AW) + koff); sv##S = *(const bf16x8*)((const char*)(Vp + (size_t)(k0) * AW) + koff); if (DQK == 96) sr##S = *(const bf16x8*)((const char*)(KRp + (size_t)(k0) * RDIM) + roff); } while (0)
#define ATT_SWRITE(b, S) do { *(ALDS bf16x8*)(K_lds + (b) * KTB + kst) = sk##S; *(ALDS bf16x8*)(V_lds + (b) * VTB + vst) = sv##S; if (DQK == 96) { if (tid < 256) *(ALDS bf16x8*)(K_lds + (b) * KTB + rst) = sr##S; } } while (0)
#define ATT_QLOAD(q_) do { const bf16_t* Qw = Qp + (size_t)((q_) * 256 + wid * 32 + r32) * ldq + hi * 8; _Pragma("unroll") for (int d0 = 0; d0 < ND; ++d0) qr[d0] = *(const bf16x8*)(Qw + d0 * 16); } while (0)
    bf16x8 qr[ND];
    {
        const int tid = threadIdx.x, skey = tid >> 3, sch = tid & 7, t2 = tid & 255, rkey = t2 >> 2, rch = t2 & 3;
        const unsigned koff = (unsigned)(skey * AW + sch * 8) * 2u, roff = (unsigned)(rkey * RDIM + rch * 8) * 2u;
        ATT_SLOAD(0, 0); ATT_SLOAD(1, 64); }
#pragma unroll 1
  for (int qb = 0; qb < 8; ++qb) {
    int tid_ = threadIdx.x; asm volatile("" : "+v"(tid_));
    const int tid = tid_, lane = tid & 63, r32 = lane & 31, hi = lane >> 5; const int wid = __builtin_amdgcn_readfirstlane(tid >> 6);
    ALDS float* al_l = (ALDS float*)(lds + L_WS) + wid * 64;
    const int skey = tid >> 3, sch = tid & 7;
    const unsigned koff = (unsigned)(skey * AW + sch * 8) * 2u;
    const int kst = skey * 128 + ((sch ^ ((skey >> 1) & 7)) << 4), vst = v_st(skey, sch * 8);
    const int t2 = tid & 255, rkey = t2 >> 2, rch = t2 & 3;
    const unsigned roff = (unsigned)(rkey * RDIM + rch * 8) * 2u;
    const int rst = 8192 + rkey * 64 + ((rch ^ ((rkey >> 2) & 3)) << 4);
    int ka[ND];
#pragma unroll
    for (int d0 = 0; d0 < ND; ++d0) ka[d0] = (d0 < 4) ? r32 * 128 + (((2 * d0 + hi) ^ ((r32 >> 1) & 7)) << 4) : 8192 + r32 * 64 + (((2 * (d0 - 4) + hi) ^ ((r32 >> 2) & 3)) << 4);
    const int vb0 = (int)(unsigned)(uintptr_t)V_lds + v_rd_base(lane);
    const int qrel = wid * 32 + r32;
    ATT_QLOAD(qb);
    float m_ref = 0.f, lsum = 0.f; f32x16 o[2], ol, negm; o[0] = f32x16{}; o[1] = f32x16{}; ol = f32x16{}; negm = f32x16{};
    unsigned sel = 0xffu;
    if (MOBA && qb > 3) {
        ALDS const float* km = (ALDS const float*)(lds + L_KM); float g[8];
#pragma unroll
        for (int n = 0; n < 8; ++n) { float s = 0.f;
#pragma unroll
            for (int d0 = 0; d0 < ND; ++d0)
#pragma unroll
                for (int j = 0; j < 8; ++j) s += bf2f(qr[d0][j]) * km[n * 64 + d0 * 16 + hi * 8 + j];
            g[n] = s; }
#pragma unroll
        for (int n = 0; n < 8; ++n) g[n] += __shfl_xor(g[n], 32);
        sel = 0u;
#pragma unroll
        for (int n = 0; n < 8; ++n) { int rank = 0;
#pragma unroll
            for (int mm = 0; mm < 8; ++mm) if (mm != n) rank += (mm < qb && (g[mm] > g[n] || (g[mm] == g[n] && mm < n))) ? 1 : 0;
            if (n < qb && rank < 3) sel |= 1u << n; }
    }
#define ATT_RESC(a) do { if (__any((a) < 1.f)) { lsum *= (a); if (hi == 0) al_l[r32] = (a); asm volatile("s_waitcnt lgkmcnt(0)" ::: "memory"); \
    _Pragma("unroll") for (int r = 0; r < 16; ++r) { const float f_ = al_l[crow(r, hi)]; o[0][r] *= f_; o[1][r] *= f_; ol[r] *= f_; } } } while (0)
    f32x16 pA0, pA1, pB0, pB1; float alA, alB; bf16x8 pa0, pa1, pa2, pa3; const int NT = 4 * (qb + 1), NP = 4 * qb;
    f32x16 cm = negm; const bool gated = MOBA && qb > 3;
#define ATT_CM(t) do { if (gated) { if ((t) < NP) { const float v_ = ((sel >> ((t) >> 2)) & 1u) ? -m_ref : -INFINITY; _Pragma("unroll") for (int r = 0; r < 16; ++r) cm[r] = v_; } else cm = negm; } else cm = negm; } while (0)
#define ATT_SCORE(P0, P1, t) do { ATT_CM(t); qkt<ND>(P0, P1, K_lds + sc * KTB, ka, qr, cm); if ((t) >= NP) cmask(P0, P1, (t) - NP, qrel, hi); } while (0)
    int sp = 0, sc = 0, sn = 1;
#define ATT_ROT() do { sp = sc; sc = sn; sn = (sn == NSLOT - 1) ? 0 : sn + 1; } while (0)
    ATT_SWRITE(0, 0); ATT_SLOAD(0, 128);
    __syncthreads(); ATT_SWRITE(sn, 1); ATT_SLOAD(1, 192);
    ATT_SCORE(pA0, pA1, 0); partialSM(pA0, pA1, m_ref, negm, alA);
    ATT_ROT();
    for (int t = 1; t + 1 < NT; t += 2) {
        __syncthreads(); ATT_SWRITE(sn, 0); if (t + 3 < NT) ATT_SLOAD(0, (t + 3) * 64);
        ASBAR(); ATT_SCORE(pB0, pB1, t);
        finishSM(pA0, pA1, pa0, pa1, pa2, pa3, lsum); ASBAR();
        pv_all(o, ol, vb0 + sp * VTB, pa0, pa1, pa2, pa3); partialSM(pB0, pB1, m_ref, negm, alB);
        ATT_RESC(alB); ATT_ROT();
        __syncthreads(); ATT_SWRITE(sn, 1); if (t + 4 < NT) ATT_SLOAD(1, (t + 4) * 64);
        ASBAR(); ATT_SCORE(pA0, pA1, t + 1);
        finishSM(pB0, pB1, pa0, pa1, pa2, pa3, lsum); ASBAR();
        pv_all(o, ol, vb0 + sp * VTB, pa0, pa1, pa2, pa3); partialSM(pA0, pA1, m_ref, negm, alA);
        ATT_RESC(alA); ATT_ROT();
    }
    __syncthreads();
    ASBAR(); ATT_SCORE(pB0, pB1, NT - 1);
    if (qb < 7) { ATT_SLOAD(0, 0); ATT_SLOAD(1, 64); }
    finishSM(pA0, pA1, pa0, pa1, pa2, pa3, lsum); ASBAR();
    pv_all(o, ol, vb0 + sp * VTB, pa0, pa1, pa2, pa3); partialSM(pB0, pB1, m_ref, negm, alB);
    ATT_RESC(alB);
    finishSM(pB0, pB1, pa0, pa1, pa2, pa3, lsum); ASBAR();
    pv_all(o, ol, vb0 + sc * VTB, pa0, pa1, pa2, pa3);
#undef ATT_ROT
#undef ATT_SCORE
#undef ATT_CM
    float rli[16];
#if ATT_LSUM_MFMA
#pragma unroll
    for (int r = 0; r < 16; ++r) rli[r] = __builtin_amdgcn_rcpf(ol[r]);
#else
    { auto rr = __builtin_amdgcn_permlane32_swap(__float_as_uint(lsum), __float_as_uint(lsum), false, false); lsum = __uint_as_float(rr[0]) + __uint_as_float(rr[1]); }
    if (hi == 0) al_l[32 + r32] = lsum; asm volatile("s_waitcnt lgkmcnt(0)" ::: "memory");
#pragma unroll
    for (int r = 0; r < 16; ++r) rli[r] = __builtin_amdgcn_rcpf(al_l[32 + crow(r, hi)]);
#endif
    { ALDS unsigned short* stg = (ALDS unsigned short*)(lds + L_OST) + wid * 2048;
#pragma unroll
      for (int r = 0; r < 16; ++r) { const int orow = crow(r, hi);
#pragma unroll
          for (int d0 = 0; d0 < 2; ++d0) stg[orow * 64 + d0 * 32 + r32] = (unsigned short)(cvtpk(o[d0][r] * rli[r], 0.f) & 0xffffu); }
      asm volatile("s_waitcnt lgkmcnt(0)" ::: "memory");
      bf16_t* Ow = Op + (size_t)(qb * 256 + wid * 32) * ldo;
#pragma unroll
      for (int i = 0; i < 4; ++i) { const int row = i * 8 + (lane >> 3), ch = lane & 7; const u32x4 v = *(ALDS const u32x4*)(stg + row * 64 + ch * 8); *(u32x4*)(Ow + (size_t)row * ldo + ch * 8) = v; } }
    __syncthreads();
  }
#undef ATT_SLOAD
#undef ATT_SWRITE
#undef ATT_QLOAD
#undef ATT_RESC
}
#undef ASBAR
}
#define GAS __attribute__((address_space(1)))
#define LAS __attribute__((address_space(3)))
typedef unsigned short bf16;
typedef unsigned v4u __attribute__((ext_vector_type(4)));
typedef float f32x4 __attribute__((ext_vector_type(4)));
typedef short bf16x8 __attribute__((ext_vector_type(8)));
typedef GAS unsigned gu32;
typedef GAS unsigned long long gu64;
#define RLX_AGENT __ATOMIC_RELAXED, __HIP_MEMORY_SCOPE_AGENT
#define LDS_WAIT() asm volatile("s_waitcnt lgkmcnt(0)" ::: "memory")
#define VM_WAIT() asm volatile("s_waitcnt vmcnt(0)" ::: "memory")
__device__ __forceinline__ unsigned long long rt() { return __builtin_amdgcn_s_memrealtime(); }
__device__ __forceinline__ unsigned f2bf(float f) { unsigned u = __builtin_bit_cast(unsigned, f); return (u + 0x7fffu + ((u >> 16) & 1u)) >> 16; }
__device__ __forceinline__ unsigned pk2(float lo, float hi) { return f2bf(lo) | (f2bf(hi) << 16); }

#define XB_TMO      128
#define XB_XCNT(j)  (256  + 64 * (j))
#define XB_XSUB(j)  (1280 + 64 * (j))
#define XB_XGEN(j)  (2304 + 64 * (j))
#define XB_TOP      3328
#define XB_TOPGEN   3392
#define XCD_BAR_WORDS 3456
#define XB_SPIN_CAP (1u << 18)

__device__ __forceinline__ unsigned xb_ld(unsigned* p)              { return __hip_atomic_load(p, __ATOMIC_RELAXED, __HIP_MEMORY_SCOPE_AGENT); }
__device__ __forceinline__ unsigned xb_add(unsigned* p, unsigned v) { return __hip_atomic_fetch_add(p, v, __ATOMIC_RELAXED, __HIP_MEMORY_SCOPE_AGENT); }
__device__ __forceinline__ unsigned xb_xcc_id() { return (unsigned)__builtin_amdgcn_s_getreg((3 << 11) | 20) & 0xFu; }
#define XB_SPIN(cond, bar) do { unsigned _sp = 0; while (cond) { __builtin_amdgcn_s_sleep(1); \
    if ((++_sp & 255u) == 0u) { if (xb_ld(&(bar)[XB_TMO])) break; if (_sp > XB_SPIN_CAP) { atomicAdd(&(bar)[XB_TMO], 1u); break; } } } } while (0)

struct XcdBarrier {
    unsigned* bar; unsigned x;
    volatile LAS unsigned* st;
};

__device__ __forceinline__ XcdBarrier xcd_barrier_post(unsigned* bar, volatile LAS unsigned* st) {
    XcdBarrier b; b.bar = bar; b.x = xb_xcc_id(); b.st = st;
    if (threadIdx.x == 0) (void)xb_add(&bar[XB_XCNT(b.x)], 1u);
    return b;
}
__device__ __forceinline__ void xcd_barrier_complete(unsigned* bar, unsigned x, unsigned& nloc, unsigned& nx) {
    const unsigned G = gridDim.x * gridDim.y * gridDim.z;
    unsigned sum, cnt, mine, sp = 0u;
    for (;;) {
        sum = 0u; cnt = 0u; mine = 0u;
#pragma unroll
        for (unsigned j = 0; j < 16; ++j) { const unsigned c = xb_ld(&bar[XB_XCNT(j)]); sum += c; cnt += (c > 0u) ? 1u : 0u; mine = (j == x) ? c : mine; }
        if (sum == G) break;
        __builtin_amdgcn_s_sleep(1);
        if ((++sp & 255u) == 0u) { if (xb_ld(&bar[XB_TMO])) break; if (sp > XB_SPIN_CAP) { atomicAdd(&bar[XB_TMO], 1u); break; } }
    }
    nloc = mine > 0u ? mine : 1u; nx = cnt > 0u ? cnt : 1u;
}

__device__ __forceinline__ void xcd_barrier(const XcdBarrier& b) {
    asm volatile("s_waitcnt vmcnt(0)" ::: "memory");
    __syncthreads();
    if (threadIdx.x == 0) {
        unsigned* bar = b.bar;
        __builtin_amdgcn_s_waitcnt(0);
        unsigned nloc = b.st[0], nx = b.st[1];
        if (nloc == 0u) { xcd_barrier_complete(bar, b.x, nloc, nx); b.st[0] = nloc; b.st[1] = nx; }
        const unsigned old = xb_add(&bar[XB_XSUB(b.x)], 1u);
        const unsigned gen = old / nloc;
        if (old + 1u == (gen + 1u) * nloc) {
            __builtin_amdgcn_fence(__ATOMIC_RELEASE, "agent");
            asm volatile("s_waitcnt vmcnt(0)" ::: "memory");
            const unsigned og = xb_add(&bar[XB_TOP], 1u);
            const unsigned tg = og / nx;
            if (og + 1u == (tg + 1u) * nx) xb_add(&bar[XB_TOPGEN], 1u);
            else XB_SPIN(xb_ld(&bar[XB_TOPGEN]) == tg, bar);
            __builtin_amdgcn_fence(__ATOMIC_ACQUIRE, "agent");
            xb_add(&bar[XB_XGEN(b.x)], 1u);
            asm volatile("s_waitcnt vmcnt(0)" ::: "memory");
        } else {
            XB_SPIN(xb_ld(&bar[XB_XGEN(b.x)]) == gen, bar);
            __builtin_amdgcn_fence(__ATOMIC_ACQUIRE, "agent");
            asm volatile("s_waitcnt vmcnt(0)" ::: "memory");
        }
    }
    __syncthreads();
}

constexpr size_t MiB = 1u << 20;
constexpr size_t WS_CTL = 0, CTL_ZERO_BYTES = 64 * 1024;
constexpr size_t WS_ROPEA = 1 * MiB, WS_ROPEB = 5 * MiB;
constexpr size_t WS_SS = 13 * MiB, WS_SS2 = 16 * MiB, WS_SS3 = 20 * MiB;
constexpr size_t WS_WIN = 24 * MiB, WS_WUQ = 34 * MiB, WS_WUKV = 35 * MiB, WS_WA = 36 * MiB, WS_WOUT = 39 * MiB, WS_WUP = 42 * MiB, WS_WDN = 51 * MiB;
constexpr size_t WS_H = 64 * MiB;
constexpr size_t WS_G = 208 * MiB;
constexpr size_t WS_QA = 464 * MiB, WS_KA = 528 * MiB, WS_VA = 592 * MiB;
constexpr size_t WS_T = WS_KA;
constexpr size_t WS_CQ = 672 * MiB, WS_CKV = 720 * MiB;
constexpr size_t WS_KR = 760 * MiB;
constexpr size_t WS_QB = 768 * MiB, WS_KB = 864 * MiB, WS_VB = 928 * MiB;
constexpr size_t WS_Y = WS_QB;
constexpr size_t WS_X1 = 896 * MiB;
constexpr size_t WS_H8 = WS_QB;
constexpr size_t WS_WG8 = 60 * MiB;
constexpr size_t WS_U = 208 * MiB;
constexpr size_t WS_END = 1024 * MiB;
static_assert(WS_H + (size_t)MTOK * LDH * 2 <= WS_G && WS_G + (size_t)MTOK * 2 * DM * 2 <= WS_QA && WS_T + (size_t)MTOK * LDH * 2 <= WS_CQ && WS_CQ + (size_t)MTOK * QLORA * 2 <= WS_CKV && WS_CKV + (size_t)MTOK * LDKV * 2 <= WS_KR, "d_ws map");
static_assert(WS_U + (size_t)MTOK * LDU * 2 <= WS_KR && WS_Y + (size_t)MTOK * DM * 2 <= WS_X1 && WS_X1 + (size_t)MTOK * DM * 2 <= WS_END && WS_VB + (size_t)MTOK * AW * 2 <= WS_END && WS_KR + (size_t)MTOK * RDIM * 2 <= WS_QB, "d_ws map");
static_assert(WS_WIN + (size_t)INWP * LDH * 2 <= WS_WUQ && WS_WUKV + (size_t)1024 * LDKV * 2 <= WS_WA && WS_WA + (size_t)DM * LDH * 2 <= WS_WOUT && WS_WOUT + (size_t)DM * LDH * 2 <= WS_WUP && WS_WUP + (size_t)DFF * LDH * 2 <= WS_WDN && WS_WDN + (size_t)DM * LDU * 2 <= WS_H, "d_ws map");
constexpr int CW_BAR = 0;
constexpr int NWAVES = 8;
constexpr int RING_OFF = 0, RING_BYTES = 131072;
constexpr int LDSCTL_OFF = RING_BYTES, MISC_OFF = LDSCTL_OFF + 320;
constexpr int LDS_BYTES = 147456;
static_assert(att::L_END <= RING_BYTES, "attention LDS map");

struct Frame {
    LAS unsigned char* lds;
    volatile LAS unsigned* MISC;
    gu32* ctl;
    int tid, lane, wave, vcu, G;
};

__device__ __forceinline__ float wave_sum(float v) {
#pragma unroll
    for (int o = 1; o < 64; o <<= 1) v += __shfl_xor(v, o);
    return v;
}
__device__ __forceinline__ int srccol(int mat, int n) {
    if (mat == 0) {
        if (n < 1024) { const int sect = n >> 9, c = n & 511, head = c >> 6, p = c & 63; const int d = (p < 16) ? ((p >> 1) + 8 * (p & 1)) : p; return sect * 512 + head * 64 + d; }
        if (n < 1920) return n;
        if (n < 1952) { const int pr = n - 1920; return 2176 + (pr >> 1) + 16 * (pr & 1); }
        if (n < 2048) return -1;
        if (n < 2304) return 1920 + (n - 2048);
        return 2208 + (n - 2304);
    }
    if (mat == 1) { const int head = n / QKB, p = n - head * QKB; if (p < 64) return n; const int pr = p - 64; return head * QKB + 64 + (pr >> 1) + 16 * (pr & 1); }
    return n;
}
__device__ __forceinline__ void p0_transpose_item(const float* W, int K, int Nsrc, int Ndst, bf16* WT, int ldw, int koff, const float* gs, int mat, LAS float* scr, int item, int lane) {
    const int nblk = Ndst / 32, kb = item / nblk, nb = item % nblk, k0 = 64 * kb, n0 = 32 * nb;
    const int sc = srccol(mat, n0 + (lane & 31));
#pragma unroll 8
    for (int i = 0; i < 32; ++i) { const int kk = 2 * i + (lane >> 5); float v = (sc >= 0) ? W[(size_t)(k0 + kk) * Nsrc + sc] : 0.f; if (gs) v *= gs[k0 + kk]; scr[kk * 33 + (lane & 31)] = v; }
    LDS_WAIT(); asm volatile("" ::: "memory");
    const int c = lane & 7;
#pragma unroll
    for (int j = 0; j < 4; ++j) { const int n = (lane >> 3) + 8 * j; const LAS float* s = scr + (8 * c) * 33 + n;
        v4u o; o.x = pk2(s[0 * 33], s[1 * 33]); o.y = pk2(s[2 * 33], s[3 * 33]); o.z = pk2(s[4 * 33], s[5 * 33]); o.w = pk2(s[6 * 33], s[7 * 33]);
        *(GAS v4u*)(WT + (size_t)(n0 + n) * ldw + koff + k0 + 8 * c) = o; }
    LDS_WAIT(); asm volatile("" ::: "memory");
}
__device__ __forceinline__ int ppos_dn(int c) { return (c & ~255) | (((c >> 5) & 3) << 6) | (((c >> 3) & 3) << 4) | (((c >> 7) & 1) << 3) | (c & 7); }
template <bool KPERM = false>
__device__ __forceinline__ void p0_transpose_item_f8(const float* W, int K, int N, int Nsrc, int coff, unsigned char* WT, float scale, LAS float* scr, int item, int lane) {
    const int nblk = N / 32, kb = item / nblk, nb = item % nblk, k0 = 64 * kb, n0 = 32 * nb;
#pragma unroll 8
    for (int i = 0; i < 32; ++i) { const int kk = 2 * i + (lane >> 5); scr[kk * 33 + (lane & 31)] = W[(size_t)(k0 + kk) * Nsrc + coff + n0 + (lane & 31)] * scale; }
    LDS_WAIT(); asm volatile("" ::: "memory");
    const int c = lane & 7;
#pragma unroll
    for (int j = 0; j < 4; ++j) { const int n = (lane >> 3) + 8 * j; const LAS float* s = scr + (8 * c) * 33 + n;
        int w0 = 0, w1 = 0;
        w0 = __builtin_amdgcn_cvt_pk_fp8_f32(s[0 * 33], s[1 * 33], w0, false); w0 = __builtin_amdgcn_cvt_pk_fp8_f32(s[2 * 33], s[3 * 33], w0, true);
        w1 = __builtin_amdgcn_cvt_pk_fp8_f32(s[4 * 33], s[5 * 33], w1, false); w1 = __builtin_amdgcn_cvt_pk_fp8_f32(s[6 * 33], s[7 * 33], w1, true);
        typedef int i32x2_ __attribute__((ext_vector_type(2)));
        *(GAS i32x2_*)(WT + (size_t)(n0 + n) * K + (KPERM ? ppos_dn(k0 + 8 * c) : k0 + 8 * c)) = (i32x2_){w0, w1}; }
    LDS_WAIT(); asm volatile("" ::: "memory");
}
__device__ __forceinline__ void rms_row_to_bf16(int lane, const float* xrow, const f32x4 (&g)[4], bf16* orow, unsigned char* orow8) {
    const GAS f32x4* xr = (const GAS f32x4*)xrow + lane;
    f32x4 v[4]; float s = 0.f;
#pragma unroll
    for (int j = 0; j < 4; ++j) { v[j] = xr[64 * j]; s += (v[j].x * v[j].x + v[j].y * v[j].y) + (v[j].z * v[j].z + v[j].w * v[j].w); }
    const float rstd = 1.f / sqrtf(wave_sum(s) * (1.f / DM) + EPS);
    GAS unsigned long long* o8 = (GAS unsigned long long*)orow + lane;
#pragma unroll
    for (int j = 0; j < 4; ++j) { const f32x4 y = v[j] * rstd * g[j]; o8[64 * j] = (unsigned long long)pk2(y.x, y.y) | ((unsigned long long)pk2(y.z, y.w) << 32);
        int w = 0; w = __builtin_amdgcn_cvt_pk_fp8_f32(y.x, y.y, w, false); w = __builtin_amdgcn_cvt_pk_fp8_f32(y.z, y.w, w, true); ((GAS int*)orow8)[lane + 64 * j] = w; }
}

struct Args { const float* in[17]; float* out; unsigned char* ws; int ph_lo, ph_hi, li, pad; };

__global__ void __launch_bounds__(NWAVES * 64, 2) block_fwd(Args args) {
    extern __shared__ __attribute__((aligned(16))) unsigned char lds[];
    Frame F;
    F.lds = (LAS unsigned char*)lds;
    F.MISC = (volatile LAS unsigned*)(F.lds + MISC_OFF);
    F.tid = threadIdx.x; F.lane = F.tid & 63; F.wave = __builtin_amdgcn_readfirstlane(F.tid >> 6);
    F.G = gridDim.x; { const int bx = blockIdx.x; F.vcu = (F.G % 8 == 0) ? (bx % 8) * (F.G / 8) + bx / 8 : bx; }
    unsigned char* ws = args.ws;
    F.ctl = (gu32*)(ws + WS_CTL);
    const float* x = args.in[0]; const int* positions = (const int*)args.in[1];
    const float *g_pre_mix = args.in[2], *w_in = args.in[3], *b_gate = args.in[4], *g_q = args.in[5], *w_uq = args.in[6], *g_kv = args.in[7], *w_ukv = args.in[8], *w_a = args.in[9], *w_b = args.in[10],
                *w_out = args.in[11], *g_post_mix = args.in[12], *g_pre_mlp = args.in[13], *w_up = args.in[14], *w_dn = args.in[15], *g_post_mlp = args.in[16];
    float* out = args.out;
    float* ropeA = (float*)(ws + WS_ROPEA); float* ropeB = (float*)(ws + WS_ROPEB);
    float* SS = (float*)(ws + WS_SS); float* SS2 = (float*)(ws + WS_SS2); float* SS3 = (float*)(ws + WS_SS3);
    bf16 *WIN = (bf16*)(ws + WS_WIN), *WUQ = (bf16*)(ws + WS_WUQ), *WUKV = (bf16*)(ws + WS_WUKV), *WA = (bf16*)(ws + WS_WA), *WOUT = (bf16*)(ws + WS_WOUT), *WUP = (bf16*)(ws + WS_WUP), *WDN = (bf16*)(ws + WS_WDN);
    bf16 *H = (bf16*)(ws + WS_H), *Gt = (bf16*)(ws + WS_G), *QA = (bf16*)(ws + WS_QA), *KA = (bf16*)(ws + WS_KA), *VA = (bf16*)(ws + WS_VA), *T = (bf16*)(ws + WS_T), *CQ = (bf16*)(ws + WS_CQ), *CKV = (bf16*)(ws + WS_CKV),
         *KR = (bf16*)(ws + WS_KR), *QB = (bf16*)(ws + WS_QB), *KB = (bf16*)(ws + WS_KB), *VB = (bf16*)(ws + WS_VB), *Y = (bf16*)(ws + WS_Y), *U = (bf16*)(ws + WS_U), *X1B = (bf16*)(ws + WS_X1); unsigned char *H8 = ws + WS_H8, *WG8 = ws + WS_WG8;
    for (int u = F.tid; u < (LDS_BYTES - LDSCTL_OFF) / 4; u += NWAVES * 64) ((LAS unsigned*)(F.lds + LDSCTL_OFF))[u] = 0u;
    __syncthreads();
    XcdBarrier bar = xcd_barrier_post((unsigned*)(F.ctl + CW_BAR) + args.li * XCD_BAR_WORDS, F.MISC + 8);
    const int lo = args.ph_lo, hi = args.ph_hi;
#define IN(k) (lo <= (k) && (k) < hi)
#define SEAM(k) do { if (IN(k) && IN((k) + 1)) xcd_barrier(bar); } while (0)
    const int gw = F.vcu * NWAVES + F.wave, NGW = F.G * NWAVES;

#if !defined(SKIP_P0)
    if (IN(0))
    {
        LAS float* scr = (LAS float*)(F.lds + RING_OFF + F.wave * 16384);
        constexpr int NBF = 2304, IG = (DM / 64) * (2 * DM / 32);
        constexpr int I0 = (DM / 64) * (NBF / 32), I1 = (QLORA / 64) * (768 / 32), I2 = (KVLORA / 64) * (1024 / 32), I3 = (AW / 64) * (DM / 32), I5 = (DM / 64) * (DM / 32), I6 = (DM / 64) * (DFF / 32), I7 = (DFF / 64) * (DM / 32);
        constexpr int NITEMS = I0 + I1 + I2 + 2 * I3 + I5 + I6 + I7 + IG;
        for (int it = gw; it < NITEMS; it += NGW) {
            int r = it;
            if (r < I0) { p0_transpose_item(w_in, DM, INW, NBF, WIN, LDH, 0, nullptr, 0, scr, r, F.lane); continue; } r -= I0;
            if (r < IG) { p0_transpose_item_f8(w_in, DM, 2 * DM, INW, 2208, WG8, 32.f, scr, r, F.lane); continue; } r -= IG;
            if (r < I1) { p0_transpose_item(w_uq, QLORA, 768, 768, WUQ, QLORA, 0, g_q, 1, scr, r, F.lane); continue; } r -= I1;
            if (r < I2) { p0_transpose_item(w_ukv, KVLORA, 1024, 1024, WUKV, LDKV, 0, g_kv, 2, scr, r, F.lane); continue; } r -= I2;
            if (r < I3) { p0_transpose_item(w_a, AW, DM, DM, WA, LDH, 0, nullptr, 2, scr, r, F.lane); continue; } r -= I3;
            if (r < I3) { p0_transpose_item(w_b, AW, DM, DM, WA, LDH, AW, nullptr, 2, scr, r, F.lane); continue; } r -= I3;
            if (r < I5) { p0_transpose_item(w_out, DM, DM, DM, WOUT, LDH, 0, nullptr, 2, scr, r, F.lane); continue; } r -= I5;
            if (r < I6) { p0_transpose_item_f8(w_up, DM, DFF, DFF, 0, (unsigned char*)WUP, 32.f, scr, r, F.lane); continue; } r -= I6;
            p0_transpose_item_f8<true>(w_dn, DFF, DM, DM, 0, (unsigned char*)WDN, 64.f, scr, r, F.lane);
        }
        for (int idx = (int)blockIdx.x * (NWAVES * 64) + F.tid; idx < MTOK * 24; idx += F.G * NWAVES * 64) {
            const int m = idx / 24, i = idx - m * 24;
            const float invf = (i < 8) ? __builtin_amdgcn_exp2f(-(float)i * 2.3664460711655217f) : __builtin_amdgcn_exp2f(-(float)(i - 8) * 1.1832230355827609f);
            const float ang = (float)positions[m] * invf;
            double t = (double)ang * 0.15915494309189535; t -= floor(t);
            const float tf = (float)t; const float c = __builtin_amdgcn_cosf(tf), s = __builtin_amdgcn_sinf(tf);
            float* dst = (i < 8) ? ropeA + (size_t)m * 16 + 2 * i : ropeB + (size_t)m * 32 + 2 * (i - 8);
            *(f32x2g*)dst = (f32x2g){c, s};
        }
        f32x4 g[4];
#pragma unroll
        for (int j = 0; j < 4; ++j) g[j] = ((const GAS f32x4*)g_pre_mix)[F.lane + 64 * j];
        for (int m = gw; m < MTOK; m += NGW) rms_row_to_bf16(F.lane, x + (size_t)m * DM, g, H + (size_t)m * LDH, H8 + (size_t)m * DM);
    }
#endif
    SEAM(0);

#if !defined(SKIP_P1)
    if (IN(1))
    {
        { pg8::Gemm g{H, WIN, MTOK, 2304, DM, LDH, LDH}; pg8::StaticOrder S; S.init(MTOK, 2304, F.G, (int)blockIdx.x);
          pg8::EpiIn E{QA, KA, VA, CQ, CKV, KR, Gt, SS, ropeA, ropeB, b_gate};
          pg8::gemm_phase<pg8::EpiIn, pg8::StaticOrder, true, true>(F.lds + RING_OFF, g, S, E); }
        { pg8::Gemm g{(const bf16*)H8, (const bf16*)WG8, MTOK, 2 * DM, DM, DM, DM}; pg8::StaticOrder S; S.init(MTOK, 2 * DM, F.G, (int)blockIdx.x);
          pg8::EpiGates E{Gt, b_gate};
          pg8::gemm_phase<pg8::EpiGates, pg8::StaticOrder, true, true, 1>(F.lds + RING_OFF, g, S, E); }
    }
#endif
    SEAM(1);

#if !defined(SKIP_P2)
    if (IN(2)) {
    {
        pg8::Gemm g{CQ, WUQ, MTOK, NHEAD * QKB, QLORA}; pg8::StaticOrder S; S.init(MTOK, NHEAD * QKB, F.G, (int)blockIdx.x);
        pg8::EpiQ E{QB, SS, ropeB};
        pg8::gemm_phase<pg8::EpiQ, pg8::StaticOrder, true, true>(F.lds + RING_OFF, g, S, E);
    }
    {
        pg8::Gemm g{CKV, WUKV, MTOK, 2 * AW, KVLORA, LDKV, LDKV}; pg8::StaticOrder S; S.init(MTOK, 2 * AW, F.G, (int)blockIdx.x);
        pg8::EpiKV E{KB, VB, SS};
        pg8::gemm_phase<pg8::EpiKV, pg8::StaticOrder, true, true>(F.lds + RING_OFF, g, S, E);
    }
    }
#endif
    SEAM(2);

#if !defined(SKIP_P3)
    if (IN(3))
    {
        LAS char* al = (LAS char*)(F.lds + RING_OFF);
#if !defined(SKIP_MOBA)
        for (int bh = F.vcu; bh < NB * NHEAD; bh += F.G) {
            const int b = bh >> 3, h = bh & 7; const size_t r0 = (size_t)b * SEQ;
            att::kmean_blocks(KA + r0 * AW + h * HD, al);
            att::attn_bh<64, true>(QA + r0 * AW + h * HD, AW, KA + r0 * AW + h * HD, nullptr, VA + r0 * AW + h * HD, H + r0 * LDH + h * HD, LDH, al);
        }
#endif
#if !defined(SKIP_MLA)
        for (int bh = F.vcu; bh < NB * NHEAD; bh += F.G) {
            const int b = bh >> 3, h = bh & 7; const size_t r0 = (size_t)b * SEQ;
            att::attn_bh<96, false>(QB + r0 * (NHEAD * QKB) + h * QKB, NHEAD * QKB, KB + r0 * AW + h * HD, KR + r0 * RDIM, VB + r0 * AW + h * HD, H + r0 * LDH + AW + h * HD, LDH, al);
        }
#endif
    }
#endif
    SEAM(3);

#if !defined(SKIP_P4)
    if (IN(4))
    {
        pg8::Gemm g{H, WA, MTOK, DM, DM, LDH, LDH}; pg8::StaticOrder S; S.init(MTOK, DM, F.G, (int)blockIdx.x);
        pg8::EpiMerge E{Gt, T};
        pg8::gemm_phase<pg8::EpiMerge, pg8::StaticOrder, true, true>(F.lds + RING_OFF, g, S, E);
    }
#endif
    SEAM(4);

#if !defined(SKIP_P5)
    if (IN(5))
    {
        pg8::Gemm g{T, WOUT, MTOK, DM, DM, LDH, LDH}; pg8::StaticOrder S; S.init(MTOK, DM, F.G, (int)blockIdx.x);
        pg8::EpiSS E{Y, SS2, DM, 1.0f};
        pg8::gemm_phase<pg8::EpiSS, pg8::StaticOrder, true, true>(F.lds + RING_OFF, g, S, E);
    }
#endif
    SEAM(5);

#if !defined(SKIP_P6)
    if (IN(6))
    {
        f32x4 g1[4], g2[4];
#pragma unroll
        for (int j = 0; j < 4; ++j) { g1[j] = ((const GAS f32x4*)g_post_mix)[F.lane + 64 * j]; g2[j] = ((const GAS f32x4*)g_pre_mlp)[F.lane + 64 * j]; }
        for (int m = gw; m < MTOK; m += NGW) {
            const GAS f32x4* sp = (const GAS f32x4*)(SS2 + (size_t)m * 16); const f32x4 a = sp[0], b = sp[1], c = sp[2], d = sp[3];
            const float ssy = (((a.x + a.y) + (a.z + a.w)) + ((b.x + b.y) + (b.z + b.w))) + (((c.x + c.y) + (c.z + c.w)) + ((d.x + d.y) + (d.z + d.w)));
            const float rsy = 1.f / sqrtf(ssy * (1.f / DM) + EPS);
            const GAS f32x4* xr = (const GAS f32x4*)(x + (size_t)m * DM) + F.lane; const GAS unsigned long long* yr = (const GAS unsigned long long*)(Y + (size_t)m * DM) + F.lane;
            GAS unsigned long long* x8 = (GAS unsigned long long*)(X1B + (size_t)m * DM) + F.lane;
            f32x4 v[4]; float s = 0.f;
#pragma unroll
            for (int j = 0; j < 4; ++j) { const unsigned long long yw = yr[64 * j]; const unsigned lo = (unsigned)yw, hi = (unsigned)(yw >> 32);
                const f32x4 yv = (f32x4){__uint_as_float(lo << 16), __uint_as_float(lo & 0xffff0000u), __uint_as_float(hi << 16), __uint_as_float(hi & 0xffff0000u)};
                v[j] = xr[64 * j] + yv * rsy * g1[j]; x8[64 * j] = (unsigned long long)pk2(v[j].x, v[j].y) | ((unsigned long long)pk2(v[j].z, v[j].w) << 32);
                s += (v[j].x * v[j].x + v[j].y * v[j].y) + (v[j].z * v[j].z + v[j].w * v[j].w); }
            const float rstd = 1.f / sqrtf(wave_sum(s) * (1.f / DM) + EPS);
            GAS int* o8 = (GAS int*)((unsigned char*)H + (size_t)m * DM) + F.lane;
#pragma unroll
            for (int j = 0; j < 4; ++j) { const f32x4 y2 = v[j] * rstd * g2[j]; int w = 0; w = __builtin_amdgcn_cvt_pk_fp8_f32(y2.x, y2.y, w, false); w = __builtin_amdgcn_cvt_pk_fp8_f32(y2.z, y2.w, w, true); o8[64 * j] = w; }
        }
    }
#endif
    SEAM(6);

#if !defined(SKIP_P7)
    if (IN(7))
    {
        pg8::Gemm g{H, WUP, MTOK, DFF, DM, DM, DM}; pg8::StaticOrder S; S.init(MTOK, DFF, F.G, (int)blockIdx.x);
        pg8::EpiRelu2F8 E{(unsigned char*)U, 1.0f / 32.0f};
        pg8::gemm_phase<pg8::EpiRelu2F8, pg8::StaticOrder, true, true, 1>(F.lds + RING_OFF, g, S, E);
    }
#endif
    SEAM(7);

#if !defined(SKIP_P8)
    if (IN(8))
    {
        pg8::Gemm g{U, WDN, MTOK, DM, DFF, DFF, DFF}; pg8::StaticOrder S; S.init(MTOK, DM, F.G, (int)blockIdx.x);
        pg8::EpiSS E{H, SS3, LDH, 1.0f / 64.0f};
        pg8::gemm_phase<pg8::EpiSS, pg8::StaticOrder, true, true, 1, true>(F.lds + RING_OFF, g, S, E);
    }
#endif
    SEAM(8);

#if !defined(SKIP_P9)
    if (IN(9))
    {
        f32x4 g1[4];
#pragma unroll
        for (int j = 0; j < 4; ++j) g1[j] = ((const GAS f32x4*)g_post_mlp)[F.lane + 64 * j];
        for (int m = gw; m < MTOK; m += NGW) {
            const GAS f32x4* sp = (const GAS f32x4*)(SS3 + (size_t)m * 16); const f32x4 a = sp[0], b = sp[1], c = sp[2], d = sp[3];
            const float ssy = (((a.x + a.y) + (a.z + a.w)) + ((b.x + b.y) + (b.z + b.w))) + (((c.x + c.y) + (c.z + c.w)) + ((d.x + d.y) + (d.z + d.w)));
            const float rsy = 1.f / sqrtf(ssy * (1.f / DM) + EPS);
            const GAS unsigned long long* yr = (const GAS unsigned long long*)(H + (size_t)m * LDH) + F.lane;
            const GAS unsigned long long* xq = (const GAS unsigned long long*)(X1B + (size_t)m * DM) + F.lane;
            GAS f32x4* o4 = (GAS f32x4*)(out + (size_t)m * DM) + F.lane;
#pragma unroll
            for (int j = 0; j < 4; ++j) { const unsigned long long yw = yr[64 * j]; const unsigned lo = (unsigned)yw, hi = (unsigned)(yw >> 32);
                const f32x4 yv = (f32x4){__uint_as_float(lo << 16), __uint_as_float(lo & 0xffff0000u), __uint_as_float(hi << 16), __uint_as_float(hi & 0xffff0000u)};
                const unsigned long long xw = xq[64 * j]; const unsigned xl = (unsigned)xw, xh = (unsigned)(xw >> 32);
                const f32x4 xv = (f32x4){__uint_as_float(xl << 16), __uint_as_float(xl & 0xffff0000u), __uint_as_float(xh << 16), __uint_as_float(xh & 0xffff0000u)};
                o4[64 * j] = xv + yv * rsy * g1[j]; }
        }
    }
#endif
}

extern "C" void kernel_launch(void* const* d_in, const int* in_sizes, int n_in, void* d_out, int out_size, void* d_ws, size_t ws_size, hipStream_t stream) {
    static int grid = 0;
    if (grid == 0) {
        if (n_in != 17 || in_sizes[0] != MTOK * DM || out_size != MTOK * DM || ws_size < WS_END) { fprintf(stderr, "kernel_launch: unexpected shapes (n_in %d, in0 %d, out %d, ws %zu); nothing launched\n", n_in, n_in > 0 ? in_sizes[0] : -1, out_size, ws_size); grid = -1; return; }
        int dev = 0, cus = 0, per_cu = 0;
        if (hipGetDevice(&dev) != hipSuccess || hipDeviceGetAttribute(&cus, hipDeviceAttributeMultiprocessorCount, dev) != hipSuccess) { fprintf(stderr, "kernel_launch: device query failed\n"); grid = -1; return; }
        if (hipFuncSetAttribute((const void*)block_fwd, hipFuncAttributeMaxDynamicSharedMemorySize, LDS_BYTES) != hipSuccess) { fprintf(stderr, "kernel_launch: hipFuncSetAttribute failed\n"); grid = -1; return; }
        if (hipOccupancyMaxActiveBlocksPerMultiprocessor(&per_cu, (const void*)block_fwd, NWAVES * 64, LDS_BYTES) != hipSuccess || per_cu < 1) { fprintf(stderr, "kernel_launch: occupancy query reports %d workgroups per CU\n", per_cu); }
        (void)hipGetLastError();
        grid = cus;
    }
    if (grid < 0) return;
    if (hipMemsetAsync((char*)d_ws + WS_CTL, 0, CTL_ZERO_BYTES, stream) != hipSuccess) { fprintf(stderr, "kernel_launch: hipMemsetAsync failed\n"); return; }
    Args a{};
    for (int i = 0; i < 17; ++i) a.in[i] = (const float*)d_in[i];
    a.out = (float*)d_out; a.ws = (unsigned char*)d_ws;
    a.ph_lo = 0; a.ph_hi = 10; a.li = 0;
    hipLaunchKernelGGL(block_fwd, dim3(grid), dim3(NWAVES * 64), LDS_BYTES, stream, a);
    const hipError_t le = hipPeekAtLastError();
    if (le != hipSuccess) fprintf(stderr, "kernel_launch: launch failed: %s\n", hipGetErrorName(le));
}
```

```cpp
#include <hip/hip_runtime.h>
#include <hip/hip_bf16.h>
#include <cstdio>
#include <cstdint>
#include <cmath>
constexpr int NB = 32, SEQ = 2048, DM = 1024, MTOK = NB * SEQ;
constexpr int NHEAD = 8, HD = 64, AW = NHEAD * HD;
constexpr int QLORA = 384, KVLORA = 256, RDIM = 32, QKB = 96;
constexpr int DFF = 4096, INW = 4256, INWP = 4352;
constexpr int LDH = DM, LDU = DFF, LDKV = KVLORA;
constexpr float EPS = 1e-6f;
constexpr float LOG2E = 1.4426950408889634f;
constexpr float C2A = 0.125f * LOG2E;
constexpr float C2B = 0.10206207261596575f * LOG2E;
typedef float f32x2g __attribute__((ext_vector_type(2)));
namespace pg8 {
#define PG8_LAS __attribute__((address_space(3)))
typedef unsigned short bf16_t;
typedef short bf16x8 __attribute__((ext_vector_type(8)));
typedef float f32x4 __attribute__((ext_vector_type(4)));
typedef unsigned u32x4 __attribute__((ext_vector_type(4)));
constexpr int BM = 256, BK = 64, HALF = 128, HTB = HALF * BK * 2  , STAGE_BYTES = 8 * HTB, NXCD = 8, WGM = 8;

__host__ __device__ __forceinline__ int lds_byte(int r, int c) { const int st = (r >> 4) * 2 + (c >> 5), rr = r & 15, cc = c & 31, ob = rr * 64 + cc * 2; return st * 1024 + (ob ^ (((ob >> 9) & 1) << 5)); }
__host__ __device__ __forceinline__ void stage_rc(int b, int& R, int& C) { const int st = b / 1024, sb = b % 1024, swz = sb ^ (((sb >> 9) & 1) << 5); R = (st >> 1) * 16 + swz / 64; C = (st & 1) * 32 + (swz % 64) / 2; }
__host__ __device__ __forceinline__ int perm32(int rho) { const int n = rho >> 4, i = rho & 15; return 8 * (i >> 2) + 4 * n + (i & 3); }

struct Unit { int pm, pn; };
struct Gemm { const bf16_t* A; const bf16_t* Bt; int M, N, K, lda, ldb; };

struct StaticOrder {
    int nM, nN, nwg, G, c;
    __host__ __device__ void init(int M, int N, int G_, int c_) { nM = M / BM; nN = N / BM; nwg = nM * nN; G = G_; c = c_; }
    __host__ __device__ bool next(int i, Unit& u) const {
        const long L = (long)i * G + c; if (L >= nwg) return false;
        int wgid = (int)L; { const int q = nwg / NXCD, r = nwg % NXCD, xcd = wgid % NXCD, off = wgid / NXCD; wgid = (xcd < r ? xcd * (q + 1) : r * (q + 1) + (xcd - r) * q) + off; }
        const int nig = WGM * nN, gid = wgid / nig, fm = gid * WGM, gsz = (nM - fm) < WGM ? (nM - fm) : WGM;
        u.pm = fm + ((wgid % nig) % gsz); u.pn = (wgid % nig) / gsz; return true;
    }
    __device__ __forceinline__ void a_ready(const Unit&) const {}
    __device__ __forceinline__ void done(const Unit&) const {}
};

__device__ __forceinline__ unsigned cvt_pk_bf16(float lo, float hi) { unsigned r; asm volatile("v_cvt_pk_bf16_f32 %0, %1, %2" : "=v"(r) : "v"(lo), "v"(hi)); return r; }
__device__ __forceinline__ void ld8(float (&v)[8], const f32x4& a, const f32x4& b) { v[0] = a[0]; v[1] = a[1]; v[2] = a[2]; v[3] = a[3]; v[4] = b[0]; v[5] = b[1]; v[6] = b[2]; v[7] = b[3]; }
typedef float f32x2c_t __attribute__((ext_vector_type(2))); typedef __bf16 bf16x2c_t __attribute__((ext_vector_type(2)));
__device__ __forceinline__ unsigned cvtpk_c(float lo, float hi) { const f32x2c_t v = {lo, hi}; const bf16x2c_t b = __builtin_convertvector(v, bf16x2c_t); return __builtin_bit_cast(unsigned, b); }
__device__ __forceinline__ u32x4 pack8(const float (&v)[8]) { u32x4 w; w.x = cvtpk_c(v[0], v[1]); w.y = cvtpk_c(v[2], v[3]); w.z = cvtpk_c(v[4], v[5]); w.w = cvtpk_c(v[6], v[7]); return w; }
__device__ __forceinline__ void unpack8(const u32x4 w, float (&v)[8]) {
    v[0] = __uint_as_float(w.x << 16); v[1] = __uint_as_float(w.x & 0xffff0000u); v[2] = __uint_as_float(w.y << 16); v[3] = __uint_as_float(w.y & 0xffff0000u);
    v[4] = __uint_as_float(w.z << 16); v[5] = __uint_as_float(w.z & 0xffff0000u); v[6] = __uint_as_float(w.w << 16); v[7] = __uint_as_float(w.w & 0xffff0000u); }
__device__ __forceinline__ void rope4(float (&v)[8], const f32x4 a, const f32x4 b) {
    float x1, x2;
    x1 = v[0]; x2 = v[1]; v[0] = x1 * a[0] - x2 * a[1]; v[1] = x2 * a[0] + x1 * a[1];
    x1 = v[2]; x2 = v[3]; v[2] = x1 * a[2] - x2 * a[3]; v[3] = x2 * a[2] + x1 * a[3];
    x1 = v[4]; x2 = v[5]; v[4] = x1 * b[0] - x2 * b[1]; v[5] = x2 * b[0] + x1 * b[1];
    x1 = v[6]; x2 = v[7]; v[6] = x1 * b[2] - x2 * b[3]; v[7] = x2 * b[2] + x1 * b[3];
}
__device__ __forceinline__ float sumsq8(const float (&v)[8]) { return ((v[0] * v[0] + v[1] * v[1]) + (v[2] * v[2] + v[3] * v[3])) + ((v[4] * v[4] + v[5] * v[5]) + (v[6] * v[6] + v[7] * v[7])); }
__device__ __forceinline__ float red_fq(float s) { s += __shfl_xor(s, 16); s += __shfl_xor(s, 32); return s; }

__device__ __forceinline__ size_t chk_off(int r16, int c32, int ld) { return (size_t)r16 * ld + (size_t)c32 * 16; }
__device__ __forceinline__ size_t gfrag_off(int pm, int t8, int wid, int grp, int lane) { return ((((size_t)(pm * 8 + t8) * 8 + wid) * 16 + grp) * 64 + lane) * 8; }
struct EpiIn {
    static constexpr bool PERM = true, AFTER_DRAIN = false; static constexpr int MIDT = 0;
    bf16_t *QA, *KA, *VA, *CQ, *CKV, *KR, *G; float* SS; const float* ropeA; const float* ropeB; const float* bgate;
    __device__ __forceinline__ void operator()(const f32x4 (&acc)[2][2][4][2], const Unit& u, int wr, int wc, int fr, int fq) const {
        asm volatile("" : "+v"(fr), "+v"(fq));
        const int row0 = u.pm * BM + wr * 64 + fr, pn = u.pn, cl = wc * 32 + 8 * fq;
        if (pn < 4) {
            bf16_t* dst = (pn < 2) ? QA : KA; const float sc = (pn < 2) ? C2A : 1.f; const int cb = (pn & 1) * 256 + wc * 32, l8 = (fq * 16 + fr) * 8;
            if ((wc & 1) == 0) {
                const bool rp = fq < 2;
#pragma unroll
                for (int ai = 0; ai < 2; ++ai)
#pragma unroll
                    for (int m = 0; m < 4; ++m) { const int row = row0 + ai * HALF + m * 16;
                        const f32x4* t = (const f32x4*)(ropeA + (size_t)row * 16 + (rp ? fq * 8 : 0));
                        f32x4 ca = t[0], cc = t[1]; if (!rp) { ca = (f32x4){1.f, 0.f, 1.f, 0.f}; cc = ca; }
#pragma unroll
                        for (int bj = 0; bj < 2; ++bj) { float v[8]; ld8(v, acc[ai][bj][m][0], acc[ai][bj][m][1]); rope4(v, ca, cc);
#pragma unroll
                            for (int j = 0; j < 8; ++j) v[j] *= sc;
                            *(u32x4*)(dst + chk_off(row - fr, cb + bj * HALF, AW) + l8) = pack8(v); } }
            } else {
#pragma unroll
                for (int ai = 0; ai < 2; ++ai)
#pragma unroll
                    for (int m = 0; m < 4; ++m) { const int row = row0 + ai * HALF + m * 16;
#pragma unroll
                        for (int bj = 0; bj < 2; ++bj) { float v[8]; ld8(v, acc[ai][bj][m][0], acc[ai][bj][m][1]);
#pragma unroll
                            for (int j = 0; j < 8; ++j) v[j] *= sc;
                            *(u32x4*)(dst + chk_off(row - fr, cb + bj * HALF, AW) + l8) = pack8(v); } }
            }
        } else if (pn < 6) {
            const int cb = (pn - 4) * 256 + wc * 32, l8 = (fq * 16 + fr) * 8;
#pragma unroll
            for (int ai = 0; ai < 2; ++ai)
#pragma unroll
                for (int m = 0; m < 4; ++m) { const int row = row0 + ai * HALF + m * 16;
#pragma unroll
                    for (int bj = 0; bj < 2; ++bj) { float v[8]; ld8(v, acc[ai][bj][m][0], acc[ai][bj][m][1]); *(u32x4*)(VA + chk_off(row - fr, cb + bj * HALF, AW) + l8) = pack8(v); } }
        } else if (pn == 6 || pn == 8) {
            bf16_t* dst = (pn == 6) ? CQ : CKV; const int ld = (pn == 6) ? QLORA : LDKV, slot = ((pn == 6) ? 0 : 8) + wc;
#pragma unroll
            for (int ai = 0; ai < 2; ++ai)
#pragma unroll
                for (int m = 0; m < 4; ++m) { const int row = row0 + ai * HALF + m * 16; float s = 0.f;
#pragma unroll
                    for (int bj = 0; bj < 2; ++bj) { float v[8]; ld8(v, acc[ai][bj][m][0], acc[ai][bj][m][1]); s += sumsq8(v); *(u32x4*)(dst + chk_off(row - fr, wc * 32 + bj * HALF, ld) + (fq * 16 + fr) * 8) = pack8(v); }
                    s = red_fq(s); if (fq == 0) SS[(size_t)row * 12 + slot] = s; }
        } else if (pn == 7) {
#pragma unroll
            for (int ai = 0; ai < 2; ++ai)
#pragma unroll
                for (int m = 0; m < 4; ++m) { const int row = row0 + ai * HALF + m * 16;
                    { float v[8]; ld8(v, acc[ai][0][m][0], acc[ai][0][m][1]); float s = red_fq(sumsq8(v)); *(u32x4*)(CQ + chk_off(row - fr, 256 + wc * 32, QLORA) + (fq * 16 + fr) * 8) = pack8(v); if (fq == 0) SS[(size_t)row * 12 + 4 + wc] = s; }
                    if (wc == 0) { float v[8]; ld8(v, acc[ai][1][m][0], acc[ai][1][m][1]); const f32x4* t = (const f32x4*)(ropeB + (size_t)row * 32 + fq * 8); rope4(v, t[0], t[1]);
                        *(u32x4*)(KR + chk_off(row - fr, 0, RDIM) + (fq * 16 + fr) * 8) = pack8(v); } }
        }
    }
};
struct EpiGates {
    static constexpr bool PERM = true, AFTER_DRAIN = false; static constexpr int MIDT = 0;
    bf16_t* G; const float* bgate;
    __device__ __forceinline__ void operator()(const f32x4 (&acc)[2][2][4][2], const Unit& u, int wr, int wc, int fr, int fq) const {
        asm volatile("" : "+v"(fr), "+v"(fq));
        const int gc = u.pn * 256 + wc * 32 + 8 * fq;
        f32x4 bv[2][2];
#pragma unroll
        for (int bj = 0; bj < 2; ++bj)
#pragma unroll
            for (int n = 0; n < 2; ++n) bv[bj][n] = *(const f32x4*)(bgate + gc + bj * HALF + 4 * n);
#pragma unroll
        for (int ai = 0; ai < 2; ++ai)
#pragma unroll
            for (int m = 0; m < 4; ++m) {
#pragma unroll
                for (int bj = 0; bj < 2; ++bj) { float v[8]; ld8(v, acc[ai][bj][m][0] * (1.0f / 32.0f) + bv[bj][0], acc[ai][bj][m][1] * (1.0f / 32.0f) + bv[bj][1]);
#pragma unroll
                    for (int j = 0; j < 8; ++j) v[j] = __builtin_amdgcn_rcpf(1.f + __builtin_amdgcn_exp2f(-LOG2E * v[j]));
                    *(u32x4*)(G + gfrag_off(u.pm, u.pn, wr * 4 + wc, ai * 8 + m * 2 + bj, fq * 16 + fr)) = pack8(v); } }
    }
};
struct EpiQ {
    static constexpr bool PERM = true, AFTER_DRAIN = false; static constexpr int MIDT = 0;
    bf16_t* QB; const float* SS; const float* ropeB;
    __device__ __forceinline__ void operator()(const f32x4 (&acc)[2][2][4][2], const Unit& u, int wr, int wc, int fr, int fq) const {
        asm volatile("" : "+v"(fr), "+v"(fq));
        const int row0 = u.pm * BM + wr * 64 + fr, cl = u.pn * BM + wc * 32 + 8 * fq;
        const int c0 = cl, c1 = cl + HALF, h0 = c0 / QKB, h1 = c1 / QKB, p0 = c0 - h0 * QKB, p1 = c1 - h1 * QKB;
        const bool r0 = p0 >= 64, r1 = p1 >= 64; const int roff = r0 ? p0 - 64 : (r1 ? p1 - 64 : 0);
#pragma unroll
        for (int b = 0; b < 2; ++b) {
            f32x4 s0[4], s1[4], ta[4], tb[4];
#pragma unroll
            for (int m = 0; m < 4; ++m) { const int row = row0 + b * HALF + m * 16;
                const f32x4* sp = (const f32x4*)(SS + (size_t)row * 12); s0[m] = sp[0]; s1[m] = sp[1];
                const f32x4* t = (const f32x4*)(ropeB + (size_t)row * 32 + roff); ta[m] = t[0]; tb[m] = t[1]; }
            asm volatile("" ::: "memory");
#pragma unroll
            for (int m = 0; m < 4; ++m) { const int row = row0 + b * HALF + m * 16;
                const float ss = ((s0[m][0] + s0[m][1]) + (s0[m][2] + s0[m][3])) + ((s1[m][0] + s1[m][1]) + (s1[m][2] + s1[m][3]));
                const float rs = __builtin_amdgcn_rsqf(ss * (1.0f / QLORA) + EPS) * C2B;
#pragma unroll
                for (int bj = 0; bj < 2; ++bj) { float v[8]; ld8(v, acc[b][bj][m][0], acc[b][bj][m][1]);
#pragma unroll
                    for (int j = 0; j < 8; ++j) v[j] *= rs;
                    if (bj == 0 ? r0 : r1) rope4(v, ta[m], tb[m]);
                    *(u32x4*)(QB + chk_off(row - fr, (bj == 0 ? c0 : c1) - 8 * fq, NHEAD * QKB) + (fq * 16 + fr) * 8) = pack8(v); } }
        }
    }
};
struct EpiKV {
    static constexpr bool PERM = true, AFTER_DRAIN = false; static constexpr int MIDT = 0;
    bf16_t *KB, *VB; const float* SS;
    __device__ __forceinline__ void operator()(const f32x4 (&acc)[2][2][4][2], const Unit& u, int wr, int wc, int fr, int fq) const {
        asm volatile("" : "+v"(fr), "+v"(fq));
        const int row0 = u.pm * BM + wr * 64 + fr;
        bf16_t* dst = (wc < 2) ? KB : VB; const int pc = (wc & 1) * 32, l8 = (fq * 16 + fr) * 8;
        f32x4 s0[2][4];
#pragma unroll
        for (int ai = 0; ai < 2; ++ai)
#pragma unroll
            for (int m = 0; m < 4; ++m) s0[ai][m] = *(const f32x4*)(SS + (size_t)(row0 + ai * HALF + m * 16) * 12 + 8);
#pragma unroll
        for (int ai = 0; ai < 2; ++ai)
#pragma unroll
            for (int m = 0; m < 4; ++m) { const int row = row0 + ai * HALF + m * 16; const f32x4 sv = s0[ai][m];
                const float rs = __builtin_amdgcn_rsqf(((sv[0] + sv[1]) + (sv[2] + sv[3])) * (1.0f / KVLORA) + EPS);
#pragma unroll
                for (int bj = 0; bj < 2; ++bj) { const int hd = u.pn * 2 + bj;
                    float v[8]; ld8(v, acc[ai][bj][m][0], acc[ai][bj][m][1]);
#pragma unroll
                    for (int j = 0; j < 8; ++j) v[j] *= rs;
                    *(u32x4*)(dst + chk_off(row - fr, hd * HD + pc, AW) + l8) = pack8(v); } }
    }
};
struct EpiMerge {
    static constexpr bool PERM = true, AFTER_DRAIN = false; static constexpr int MIDT = 8;
    const bf16_t* G; bf16_t* T;
    __device__ __forceinline__ void mid(f32x4 (&acc)[2][2][4][2], const Unit& u, int wr, int wc, int fr, int fq) const {
        asm volatile("" : "+v"(fr), "+v"(fq));
        const bf16_t* pa = G + gfrag_off(u.pm, u.pn, wr * 4 + wc, 0, fq * 16 + fr); const bf16_t* pb = G + gfrag_off(u.pm, 4 + u.pn, wr * 4 + wc, 0, fq * 16 + fr);
        u32x4 ca[4], cb[4], na[4], nb[4];
#pragma unroll
        for (int i = 0; i < 4; ++i) { ca[i] = *(const u32x4*)(pa + (size_t)i * 512); cb[i] = *(const u32x4*)(pb + (size_t)i * 512); }
#pragma unroll
        for (int b = 0; b < 4; ++b) {
            if (b < 3) {
#pragma unroll
                for (int i = 0; i < 4; ++i) { na[i] = *(const u32x4*)(pa + (size_t)((b + 1) * 4 + i) * 512); nb[i] = *(const u32x4*)(pb + (size_t)((b + 1) * 4 + i) * 512); } }
            asm volatile("" ::: "memory");
#pragma unroll
            for (int i = 0; i < 4; ++i) { const int grp = b * 4 + i, ai = grp >> 3, m = (grp >> 1) & 3, bj = grp & 1; float ga[8], gb[8]; unpack8(ca[i], ga); unpack8(cb[i], gb);
#pragma unroll
                for (int j = 0; j < 8; ++j) ga[j] *= __builtin_amdgcn_rcpf(__builtin_fmaxf(gb[j], 1e-30f));
                acc[ai][bj][m][0] *= (f32x4){ga[0], ga[1], ga[2], ga[3]}; acc[ai][bj][m][1] *= (f32x4){ga[4], ga[5], ga[6], ga[7]}; }
#pragma unroll
            for (int i = 0; i < 4; ++i) { ca[i] = na[i]; cb[i] = nb[i]; }
        }
    }
    __device__ __forceinline__ void operator()(const f32x4 (&acc)[2][2][4][2], const Unit& u, int wr, int wc, int fr, int fq) const {
        asm volatile("" : "+v"(fr), "+v"(fq));
        const int r16 = u.pm * BM + wr * 64, c32 = u.pn * BM + wc * 32, l8 = (fq * 16 + fr) * 8;
        const bf16_t* pb = G + gfrag_off(u.pm, 4 + u.pn, wr * 4 + wc, 0, fq * 16 + fr);
        u32x4 cb[8], nb[8];
#pragma unroll
        for (int i = 0; i < 8; ++i) cb[i] = *(const u32x4*)(pb + (size_t)i * 512);
#pragma unroll
        for (int b = 0; b < 2; ++b) {
            if (b < 1) {
#pragma unroll
                for (int i = 0; i < 8; ++i) nb[i] = *(const u32x4*)(pb + (size_t)(8 + i) * 512); }
            asm volatile("" ::: "memory");
#pragma unroll
            for (int i = 0; i < 8; ++i) { const int grp = b * 8 + i, ai = grp >> 3, m = (grp >> 1) & 3, bj = grp & 1; float v[8], gb[8]; ld8(v, acc[ai][bj][m][0], acc[ai][bj][m][1]); unpack8(cb[i], gb);
#pragma unroll
                for (int j = 0; j < 8; ++j) v[j] *= __builtin_fmaxf(gb[j], 1e-30f);
                *(u32x4*)(T + chk_off(r16 + ai * HALF + m * 16, c32 + bj * HALF, LDH) + l8) = pack8(v); }
#pragma unroll
            for (int i = 0; i < 8; ++i) cb[i] = nb[i];
        }
    }
};
struct EpiSS {
    static constexpr bool PERM = true, AFTER_DRAIN = false; static constexpr int MIDT = 0;
    bf16_t* Y; float* SSY; int ldy; float scale;
    __device__ __forceinline__ void operator()(const f32x4 (&acc)[2][2][4][2], const Unit& u, int wr, int wc, int fr, int fq) const {
        asm volatile("" : "+v"(fr), "+v"(fq));
        const int row0 = u.pm * BM + wr * 64 + fr, cl = u.pn * BM + wc * 32 + 8 * fq;
#pragma unroll
        for (int ai = 0; ai < 2; ++ai)
#pragma unroll
            for (int m = 0; m < 4; ++m) { const int row = row0 + ai * HALF + m * 16; float s = 0.f;
#pragma unroll
                for (int bj = 0; bj < 2; ++bj) { float v[8]; ld8(v, acc[ai][bj][m][0] * scale, acc[ai][bj][m][1] * scale); s += sumsq8(v); *(u32x4*)(Y + (size_t)row * ldy + cl + bj * HALF) = pack8(v); }
                s = red_fq(s); if (fq == 0) SSY[(size_t)row * 16 + u.pn * 4 + wc] = s; }
    }
};
struct EpiRelu2F8 {
    static constexpr bool PERM = true, AFTER_DRAIN = false; static constexpr int MIDT = 0;
    unsigned char* U; float scale;
    __device__ __forceinline__ void operator()(const f32x4 (&acc)[2][2][4][2], const Unit& u, int wr, int wc, int fr, int fq) const {
        asm volatile("" : "+v"(fr), "+v"(fq));
        unsigned char* base = U + ((size_t)(u.pm * 16 + wr * 4) * 64 + u.pn * 4 + wc) * 1024 + (unsigned)(fq * 16 + fr) * 16u;
#pragma unroll
        for (int ai = 0; ai < 2; ++ai)
#pragma unroll
            for (int m = 0; m < 4; ++m) { int w[4];
#pragma unroll
                for (int bj = 0; bj < 2; ++bj) { float v[8]; ld8(v, acc[ai][bj][m][0], acc[ai][bj][m][1]);
#pragma unroll
                    for (int j = 0; j < 8; ++j) { const float r = __builtin_fmaxf(v[j] * scale, 0.f); v[j] = __builtin_fminf(r * r, 440.f); }
                    int w0 = 0, w1 = 0;
                    w0 = __builtin_amdgcn_cvt_pk_fp8_f32(v[0], v[1], w0, false); w0 = __builtin_amdgcn_cvt_pk_fp8_f32(v[2], v[3], w0, true);
                    w1 = __builtin_amdgcn_cvt_pk_fp8_f32(v[4], v[5], w1, false); w1 = __builtin_amdgcn_cvt_pk_fp8_f32(v[6], v[7], w1, true);
                    w[2 * bj] = w0; w[2 * bj + 1] = w1; }
                typedef int i32x4e_ __attribute__((ext_vector_type(4)));
                *(i32x4e_*)(base + (size_t)(ai * 8 + m) * 65536) = (i32x4e_){w[0], w[1], w[2], w[3]}; }
    }
};
struct EpiRelu2 {
    static constexpr bool PERM = true, AFTER_DRAIN = false; static constexpr int MIDT = 0;
    bf16_t* U;
    __device__ __forceinline__ void operator()(const f32x4 (&acc)[2][2][4][2], const Unit& u, int wr, int wc, int fr, int fq) const {
        asm volatile("" : "+v"(fr), "+v"(fq));
        const int row0 = u.pm * BM + wr * 64 + fr, cl = u.pn * BM + wc * 32 + 8 * fq;
#pragma unroll
        for (int ai = 0; ai < 2; ++ai)
#pragma unroll
            for (int m = 0; m < 4; ++m) { const int row = row0 + ai * HALF + m * 16;
#pragma unroll
                for (int bj = 0; bj < 2; ++bj) { float v[8]; ld8(v, acc[ai][bj][m][0], acc[ai][bj][m][1]);
#pragma unroll
                    for (int j = 0; j < 8; ++j) { const float r = __builtin_fmaxf(v[j], 0.f); v[j] = r * r; }
                    *(u32x4*)(U + (size_t)row * LDU + cl + bj * HALF) = pack8(v); } }
    }
};
template <class Epi, class Sched, bool ALIGN_EPI = false, bool SP2 = false, int ESZ = 2, bool ACH = false>
__device__ __forceinline__ void gemm_phase(PG8_LAS unsigned char* lds, const Gemm g, const Sched& S, const Epi& E) {
    int tid_ = threadIdx.x; asm volatile("" : "+v"(tid_));
    const int tid = tid_, wid = __builtin_amdgcn_readfirstlane(tid >> 6), lane = tid & 63, wr = wid >> 2, wc = wid & 3, fr = lane & 15, fq = lane >> 4;
    const int K = g.K, nt = K * ESZ / (BK * 2), lda = g.lda ? g.lda : K, ldb = g.ldb ? g.ldb : K;
    unsigned voffA[2], voffB[2];
#pragma unroll
    for (int i = 0; i < 2; ++i) { int R, C; stage_rc(tid * 16 + i * 8192, R, C); const int Rb = Epi::PERM ? ((R & ~31) + perm32(R & 31)) : R;
        if constexpr (ACH) { const int st_ = (tid >> 6) + 8 * i; voffA[i] = (unsigned)((st_ >> 1) * 16 * lda * ESZ + (st_ & 1) * 1024 + (tid & 63) * 16); } else voffA[i] = (unsigned)(R * lda * ESZ + C * 2);
        voffB[i] = (unsigned)(Rb * ldb * ESZ + C * 2); }
    const size_t kstepB = (size_t)(BK * 2), kstepA = ACH ? (size_t)2048 : kstepB;
    const size_t hstepA = (size_t)HALF * lda * ESZ, hstepB = (size_t)HALF * ldb * ESZ;
    const size_t tstepA = 2 * hstepA, tstepB = 2 * hstepB;
    const unsigned ldsw = (unsigned)wid * 1024u;
    const int aoff = ACH ? wr * 8192 + lane * 16 : lds_byte(wr * 64 + fr, fq * 8), boff = lds_byte(wc * 32 + fr, fq * 8);
#define PG8_SA(b, h) (((b) * 2 + (h)) * HTB)
#define PG8_SB(b, h) ((4 + (b) * 2 + (h)) * HTB)
#define PG8_STAGE(bufoff, gbase, voff) do { _Pragma("unroll") for (int _i = 0; _i < 2; ++_i) \
        __builtin_amdgcn_global_load_lds((const unsigned*)((const char*)(gbase) + (voff)[_i]), (PG8_LAS unsigned*)(lds + (bufoff) + ldsw + _i * 8192), 16, 0, 0); } while (0)
#define PG8_LDA(dst, b, h) do { if constexpr (ESZ == 2) { _Pragma("unroll") for (int m = 0; m < 4; ++m) _Pragma("unroll") for (int k = 0; k < 2; ++k) dst[m][k] = *(const PG8_LAS bf16x8*)(lds + PG8_SA(b, h) + aoff + m * 2048 + k * 1024); } \
        else { _Pragma("unroll") for (int m = 0; m < 4; ++m) { dst##8[m].lo = *(const PG8_LAS i32x4_*)(lds + PG8_SA(b, h) + aoff + m * 2048); dst##8[m].hi = *(const PG8_LAS i32x4_*)(lds + PG8_SA(b, h) + aoff + m * 2048 + 1024); } } } while (0)
#define PG8_LDB(dst, b, h) do { if constexpr (ESZ == 2) { _Pragma("unroll") for (int n = 0; n < 2; ++n) _Pragma("unroll") for (int k = 0; k < 2; ++k) dst[n][k] = *(const PG8_LAS bf16x8*)(lds + PG8_SB(b, h) + boff + n * 2048 + k * 1024); } \
        else { _Pragma("unroll") for (int n = 0; n < 2; ++n) { dst##8[n].lo = *(const PG8_LAS i32x4_*)(lds + PG8_SB(b, h) + boff + n * 2048); dst##8[n].hi = *(const PG8_LAS i32x4_*)(lds + PG8_SB(b, h) + boff + n * 2048 + 1024); } } } while (0)
#define PG8_MMA(ai, bj, At, Bt) do { __builtin_amdgcn_s_setprio(1); \
        if constexpr (ESZ == 2) { _Pragma("unroll") for (int m = 0; m < 4; ++m) _Pragma("unroll") for (int n = 0; n < 2; ++n) _Pragma("unroll") for (int k = 0; k < 2; ++k) \
            acc[ai][bj][m][n] = __builtin_amdgcn_mfma_f32_16x16x32_bf16(Bt[n][k], At[m][k], acc[ai][bj][m][n], 0, 0, 0); } \
        else {   \
            _Pragma("unroll") for (int m = 0; m < 4; ++m) _Pragma("unroll") for (int n = 0; n < 2; ++n) \
                asm volatile("v_mfma_scale_f32_16x16x128_f8f6f4 %0, %1, %2, %0, %3, %3 op_sel_hi:[0,0,0]" : "+v"(acc[ai][bj][m][n]) : "v"(Bt##8[n]), "v"(At##8[m]), "v"(scl_)); } \
        __builtin_amdgcn_s_setprio(0); } while (0)
#define PG8_WAIT_V(n) asm volatile("s_waitcnt vmcnt(" #n ")" ::: "memory")
#define PG8_WAIT_L(n) asm volatile("s_waitcnt lgkmcnt(" #n ")" ::: "memory")
#define PG8_BAR __builtin_amdgcn_s_barrier()
#define PG8_SCHED __builtin_amdgcn_sched_barrier(0)
    Unit cur, nxt; int ui = 0;
    if (!S.next(0, cur)) return;
    f32x4 acc[2][2][4][2];
#pragma unroll
    for (int a = 0; a < 2; ++a)
#pragma unroll
        for (int b = 0; b < 2; ++b)
#pragma unroll
            for (int m = 0; m < 4; ++m)
#pragma unroll
                for (int n = 0; n < 2; ++n) acc[a][b][m][n] = (f32x4){0.f, 0.f, 0.f, 0.f};
    bf16x8 At[4][2], B0[2][2], B1[2][2];
    typedef int i32x4_ __attribute__((ext_vector_type(4))); typedef int i32x8_ __attribute__((ext_vector_type(8)));
    const int scl_ = 0x7F7F7F7F;
    i32x8_ At8[4], B08[2], B18[2];
    const char* cA = (const char*)g.A + (size_t)cur.pm * tstepA; const char* cB = (const char*)g.Bt + (size_t)cur.pn * tstepB;
    S.a_ready(cur);
    if constexpr (SP2) {
        PG8_STAGE(PG8_SB(0, 0), cB, voffB); PG8_STAGE(PG8_SB(0, 1), cB + hstepB, voffB); PG8_STAGE(PG8_SA(0, 0), cA, voffA); PG8_STAGE(PG8_SA(0, 1), cA + hstepA, voffA);
        if (wr == 1) PG8_BAR;
        PG8_WAIT_V(2); PG8_BAR;
        PG8_STAGE(PG8_SB(1, 0), cB + kstepB, voffB); PG8_STAGE(PG8_SA(1, 0), cA + kstepA, voffA); PG8_STAGE(PG8_SB(1, 1), cB + hstepB + kstepB, voffB);
        PG8_WAIT_V(6); PG8_BAR;
    } else {
        PG8_STAGE(PG8_SB(0, 0), cB, voffB); PG8_STAGE(PG8_SA(0, 0), cA, voffA); PG8_STAGE(PG8_SB(0, 1), cB + hstepB, voffB); PG8_STAGE(PG8_SA(0, 1), cA + hstepA, voffA);
        if (wr == 1) PG8_BAR;
        PG8_WAIT_V(4); PG8_BAR;
        PG8_STAGE(PG8_SB(1, 0), cB + kstepB, voffB); PG8_STAGE(PG8_SA(1, 0), cA + kstepA, voffA); PG8_STAGE(PG8_SB(1, 1), cB + hstepB + kstepB, voffB);
        PG8_WAIT_V(6); PG8_BAR;
    }
    for (;;) {
        const bool has_next = S.next(ui + 1, nxt);
        const char* nA = has_next ? (const char*)g.A + (size_t)nxt.pm * tstepA : cA; const char* nB = has_next ? (const char*)g.Bt + (size_t)nxt.pn * tstepB : cB;
#pragma unroll 1
        for (int t = 0; t < nt; t += 2) {
            if constexpr (Epi::MIDT > 0) { if (t == Epi::MIDT) E.mid(acc, cur, wr, wc, fr, fq); }
            const bool last = (t == nt - 2);
            const char* a1 = cA + (size_t)(t + 1) * kstepA;
            const char* a2 = last ? nA : cA + (size_t)(t + 2) * kstepA; const char* b2 = last ? nB : cB + (size_t)(t + 2) * kstepB;
            const char* a3 = a2 + kstepA; const char* b3 = b2 + kstepB;
            if (last && has_next) S.a_ready(nxt);
            if constexpr (SP2) {
            PG8_LDB(B0, 0, 0); PG8_LDB(B1, 0, 1); PG8_SCHED; PG8_LDA(At, 0, 0); PG8_STAGE(PG8_SA(1, 1), a1 + hstepA, voffA);
            PG8_WAIT_V(8); PG8_WAIT_L(0); PG8_BAR; PG8_MMA(0, 0, At, B0); PG8_MMA(0, 1, At, B1); PG8_BAR; PG8_SCHED;
            PG8_LDA(At, 0, 1); PG8_STAGE(PG8_SB(0, 0), b2, voffB); PG8_STAGE(PG8_SB(0, 1), b2 + hstepB, voffB); PG8_STAGE(PG8_SA(0, 0), a2, voffA);
            PG8_WAIT_V(8); PG8_WAIT_L(0); PG8_BAR; PG8_MMA(1, 0, At, B0); PG8_MMA(1, 1, At, B1); PG8_BAR; PG8_SCHED;
            PG8_LDB(B0, 1, 0); PG8_LDB(B1, 1, 1); PG8_SCHED; PG8_LDA(At, 1, 0); PG8_STAGE(PG8_SA(0, 1), a2 + hstepA, voffA);
            PG8_WAIT_V(8); PG8_WAIT_L(0); PG8_BAR; PG8_MMA(0, 0, At, B0); PG8_MMA(0, 1, At, B1); PG8_BAR; PG8_SCHED;
            PG8_LDA(At, 1, 1); PG8_STAGE(PG8_SB(1, 0), b3, voffB); PG8_STAGE(PG8_SB(1, 1), b3 + hstepB, voffB); PG8_STAGE(PG8_SA(1, 0), a3, voffA);
            PG8_WAIT_V(8); PG8_WAIT_L(0); PG8_BAR; PG8_MMA(1, 0, At, B0); PG8_MMA(1, 1, At, B1); PG8_BAR; PG8_SCHED;
            } else {
            PG8_LDB(B0, 0, 0); PG8_SCHED; PG8_LDA(At, 0, 0); PG8_STAGE(PG8_SA(1, 1), a1 + hstepA, voffA);
            PG8_WAIT_L(8); PG8_BAR; PG8_WAIT_L(0); PG8_MMA(0, 0, At, B0); PG8_BAR; PG8_SCHED;
            PG8_LDB(B1, 0, 1); PG8_STAGE(PG8_SB(0, 0), b2, voffB);
            PG8_BAR; PG8_WAIT_L(0); PG8_MMA(0, 1, At, B1); PG8_BAR;
            PG8_LDA(At, 0, 1); PG8_STAGE(PG8_SA(0, 0), a2, voffA);
            PG8_BAR; PG8_WAIT_L(0); PG8_MMA(1, 0, At, B0); PG8_BAR; PG8_SCHED;
            PG8_STAGE(PG8_SB(0, 1), b2 + hstepB, voffB);
            PG8_WAIT_V(6); PG8_BAR; PG8_MMA(1, 1, At, B1); PG8_BAR;
            PG8_LDB(B0, 1, 0); PG8_SCHED; PG8_LDA(At, 1, 0); PG8_STAGE(PG8_SA(0, 1), a2 + hstepA, voffA);
            PG8_WAIT_L(8); PG8_BAR; PG8_WAIT_L(0); PG8_MMA(0, 0, At, B0); PG8_BAR; PG8_SCHED;
            PG8_LDB(B1, 1, 1); PG8_STAGE(PG8_SB(1, 0), b3, voffB);
            PG8_BAR; PG8_WAIT_L(0); PG8_MMA(0, 1, At, B1); PG8_BAR;
            PG8_LDA(At, 1, 1); PG8_STAGE(PG8_SA(1, 0), a3, voffA);
            PG8_BAR; PG8_WAIT_L(0); PG8_MMA(1, 0, At, B0); PG8_BAR; PG8_SCHED;
            PG8_STAGE(PG8_SB(1, 1), b3 + hstepB, voffB);
            PG8_WAIT_V(6); PG8_BAR; PG8_MMA(1, 1, At, B1); PG8_BAR;
            }
        }
        if constexpr (ALIGN_EPI) { if (wr == 0) PG8_BAR; }
        if constexpr (ESZ == 1) asm volatile("s_nop 15\n\ts_nop 15" ::: "memory");
        if constexpr (!Epi::AFTER_DRAIN) { E(acc, cur, wr, wc, fr, fq); S.done(cur); }
        if (!has_next) break;
#pragma unroll
        for (int a = 0; a < 2; ++a)
#pragma unroll
            for (int b = 0; b < 2; ++b)
#pragma unroll
                for (int m = 0; m < 4; ++m)
#pragma unroll
                    for (int n = 0; n < 2; ++n) acc[a][b][m][n] = (f32x4){0.f, 0.f, 0.f, 0.f};
        cur = nxt; cA = nA; cB = nB; ++ui;
        if constexpr (ALIGN_EPI) { if (wr == 1) PG8_BAR; }
    }
    PG8_WAIT_V(0);
    if constexpr (!ALIGN_EPI) { if (wr == 0) PG8_BAR; }
    PG8_BAR;
    if constexpr (Epi::AFTER_DRAIN) { E.fused(acc, cur, wr, wc, fr, fq, lds, wid, lane); S.done(cur); }
#undef PG8_SA
#undef PG8_SB
#undef PG8_STAGE
#undef PG8_LDA
#undef PG8_LDB
#undef PG8_MMA
#undef PG8_WAIT_V
#undef PG8_WAIT_L
#undef PG8_BAR
#undef PG8_SCHED
}
}
#ifndef ATT_LSUM_MFMA
#define ATT_LSUM_MFMA 1
#endif
namespace att {
typedef unsigned short bf16_t;
typedef short bf16x8 __attribute__((ext_vector_type(8)));
typedef short s16x4 __attribute__((ext_vector_type(4)));
typedef float f32x16 __attribute__((ext_vector_type(16)));
typedef float f32x4 __attribute__((ext_vector_type(4)));
typedef unsigned u32x4 __attribute__((ext_vector_type(4)));
#define ALDS __attribute__((address_space(3)))
#define ASBAR() __builtin_amdgcn_sched_barrier(0)
constexpr int KTB = 12288, VTB = 8192;
constexpr int NSLOT = 3;
constexpr int L_K = 0, L_V = NSLOT * KTB, L_WS = L_V + NSLOT * VTB, L_OST = L_WS + 8 * 256, L_KM = L_OST + 8 * 4096, L_RED = L_KM + 2048, L_END = L_RED + 16384;
constexpr float THR = 8.f;
__device__ __forceinline__ int crow(int r, int hi) { return (r & 3) + 8 * (r >> 2) + 4 * hi; }
typedef float f32x2a_t __attribute__((ext_vector_type(2))); typedef __bf16 bf16x2a_t __attribute__((ext_vector_type(2)));
__device__ __forceinline__ unsigned cvtpk(float lo, float hi) { const f32x2a_t v = {lo, hi}; const bf16x2a_t b = __builtin_convertvector(v, bf16x2a_t); return __builtin_bit_cast(unsigned, b); }
__device__ __forceinline__ float bf2f(short s) { return __uint_as_float(((unsigned)(unsigned short)s) << 16); }
__device__ __forceinline__ int v_st(int k, int c) { const int kk = (k & ~0xC) | ((k & 4) << 1) | ((k & 8) >> 1); return ((kk >> 3) * 2 + (c >> 5)) * 512 + ((kk & 7) * 32 + (c & 31)) * 2; }
__device__ __forceinline__ int v_rd_base(int lane) { return ((lane & 3) << 3) | (((lane >> 2) & 3) << 6) | (((lane >> 4) & 1) << 5) | (((lane >> 5) & 1) << 8); }
constexpr int v_rd_off(int d0, int ks, int half) { return ks * 2048 + half * 1024 + d0 * 512; }
template <int OFF> __device__ __forceinline__ s16x4 tr_read(int vb) { s16x4 r; asm volatile("ds_read_b64_tr_b16 %0, %1 offset:%2" : "=&v"(r) : "v"(vb), "i"(OFF) : "memory"); return r; }
template <int D0> __device__ __forceinline__ void pv_one(f32x16& od, int vb, bf16x8 pa0, bf16x8 pa1, bf16x8 pa2, bf16x8 pa3) {
    const s16x4 l0 = tr_read<v_rd_off(D0, 0, 0)>(vb), h0 = tr_read<v_rd_off(D0, 0, 1)>(vb), l1 = tr_read<v_rd_off(D0, 1, 0)>(vb), h1 = tr_read<v_rd_off(D0, 1, 1)>(vb);
    const s16x4 l2 = tr_read<v_rd_off(D0, 2, 0)>(vb), h2 = tr_read<v_rd_off(D0, 2, 1)>(vb), l3 = tr_read<v_rd_off(D0, 3, 0)>(vb), h3 = tr_read<v_rd_off(D0, 3, 1)>(vb);
    asm volatile("s_waitcnt lgkmcnt(0)" ::: "memory"); ASBAR();
#define ATT_PK(L, H) (bf16x8){L[0], L[1], L[2], L[3], H[0], H[1], H[2], H[3]}
    od = __builtin_amdgcn_mfma_f32_32x32x16_bf16(pa0, ATT_PK(l0, h0), od, 0, 0, 0);
    od = __builtin_amdgcn_mfma_f32_32x32x16_bf16(pa1, ATT_PK(l1, h1), od, 0, 0, 0);
    od = __builtin_amdgcn_mfma_f32_32x32x16_bf16(pa2, ATT_PK(l2, h2), od, 0, 0, 0);
    od = __builtin_amdgcn_mfma_f32_32x32x16_bf16(pa3, ATT_PK(l3, h3), od, 0, 0, 0);
#undef ATT_PK
}
__device__ __forceinline__ void pv_all(f32x16* o, f32x16& ol, int vb, bf16x8 pa0, bf16x8 pa1, bf16x8 pa2, bf16x8 pa3) {
    pv_one<0>(o[0], vb, pa0, pa1, pa2, pa3); pv_one<1>(o[1], vb, pa0, pa1, pa2, pa3);
#if ATT_LSUM_MFMA
    const bf16x8 ones = (bf16x8){0x3F80, 0x3F80, 0x3F80, 0x3F80, 0x3F80, 0x3F80, 0x3F80, 0x3F80};
    ol = __builtin_amdgcn_mfma_f32_32x32x16_bf16(pa0, ones, ol, 0, 0, 0); ol = __builtin_amdgcn_mfma_f32_32x32x16_bf16(pa1, ones, ol, 0, 0, 0);
    ol = __builtin_amdgcn_mfma_f32_32x32x16_bf16(pa2, ones, ol, 0, 0, 0); ol = __builtin_amdgcn_mfma_f32_32x32x16_bf16(pa3, ones, ol, 0, 0, 0);
#endif
}
__device__ __forceinline__ void partialSM(f32x16& p0, f32x16& p1, float& m_ref, f32x16& negm, float& alpha) {
    float pmax = p0[0];
#pragma unroll
    for (int r = 1; r < 16; ++r) pmax = fmaxf(pmax, p0[r]);
#pragma unroll
    for (int r = 0; r < 16; ++r) pmax = fmaxf(pmax, p1[r]);
    { auto rr = __builtin_amdgcn_permlane32_swap(__float_as_uint(pmax), __float_as_uint(pmax), false, false); pmax = fmaxf(__uint_as_float(rr[0]), __uint_as_float(rr[1])); }
    alpha = 1.f;
    if (__builtin_expect(!__all(pmax <= THR), 0)) { const float dl = (pmax > THR) ? pmax : 0.f; m_ref += dl; alpha = __builtin_amdgcn_exp2f(-dl);
#pragma unroll
        for (int r = 0; r < 16; ++r) { p0[r] -= dl; p1[r] -= dl; negm[r] = -m_ref; } }
#pragma unroll
    for (int r = 0; r < 16; ++r) p0[r] = __builtin_amdgcn_exp2f(p0[r]);
}
__device__ __forceinline__ void finishSM(f32x16& p0, f32x16& p1, bf16x8& pa0, bf16x8& pa1, bf16x8& pa2, bf16x8& pa3, float& lsum) {
#pragma unroll
    for (int r = 0; r < 16; ++r) p1[r] = __builtin_amdgcn_exp2f(p1[r]);
#if !ATT_LSUM_MFMA
    { float ps = 0.f;
#pragma unroll
      for (int r = 0; r < 16; ++r) ps += p0[r];
#pragma unroll
      for (int r = 0; r < 16; ++r) ps += p1[r];
      lsum += ps; }
#endif
#define ATT_PK4(P, BASE, OUT) do { unsigned a0 = cvtpk(P[BASE + 0], P[BASE + 1]), a1 = cvtpk(P[BASE + 2], P[BASE + 3]);   \
    unsigned b0 = cvtpk(P[BASE + 4], P[BASE + 5]), b1 = cvtpk(P[BASE + 6], P[BASE + 7]);                              \
    auto r0 = __builtin_amdgcn_permlane32_swap(a0, b0, false, false); auto r1 = __builtin_amdgcn_permlane32_swap(a1, b1, false, false); \
    u32x4 w = {r0[0], r1[0], r0[1], r1[1]}; OUT = __builtin_bit_cast(bf16x8, w); } while (0)
    ATT_PK4(p0, 0, pa0); ATT_PK4(p0, 8, pa1); ATT_PK4(p1, 0, pa2); ATT_PK4(p1, 8, pa3);
#undef ATT_PK4
}
template <int ND> __device__ __forceinline__ void qkt(f32x16& p0, f32x16& p1, ALDS const char* Kb, const int (&ka)[ND], const bf16x8 (&qr)[ND], const f32x16& cinit) {
#pragma unroll
    for (int d0 = 0; d0 < ND; ++d0) {
        const bf16x8 b0 = *(ALDS const bf16x8*)(Kb + ka[d0]);
        const bf16x8 b1 = *(ALDS const bf16x8*)(Kb + ka[d0] + (d0 < 4 ? 4096 : 2048));
        p0 = __builtin_amdgcn_mfma_f32_32x32x16_bf16(b0, qr[d0], d0 == 0 ? cinit : p0, 0, 0, 0);
        p1 = __builtin_amdgcn_mfma_f32_32x32x16_bf16(b1, qr[d0], d0 == 0 ? cinit : p1, 0, 0, 0);
        if (ND > 4 && d0 == 2) asm volatile("" ::: "memory"); }
}
__device__ __forceinline__ void cmask(f32x16& p0, f32x16& p1, int jt, int qrel, int hi) {
    const float NEG = -INFINITY; const int thr = qrel - 64 * jt - 4 * hi;
#pragma unroll
    for (int r = 0; r < 16; ++r) { if ((r & 3) + 8 * (r >> 2) > thr) p0[r] = NEG; if ((r & 3) + 8 * (r >> 2) + 32 > thr) p1[r] = NEG; }
}
__device__ __forceinline__ void kmean_blocks(const bf16_t* Kp, ALDS char* lds) {
    int tid_ = threadIdx.x; asm volatile("" : "+v"(tid_));
    const int tid = tid_, lane = tid & 63, wid = tid >> 6;
    ALDS float* red = (ALDS float*)(lds + L_RED); ALDS float* km = (ALDS float*)(lds + L_KM);
#pragma unroll 1
    for (int n = 0; n < 8; ++n) {
        float a[16];
#pragma unroll
        for (int j = 0; j < 16; ++j) a[j] = 0.f;
#pragma unroll
        for (int i = 0; i < 2; ++i)
#pragma unroll
            for (int cc = 0; cc < 2; ++cc) { const bf16x8 kx = *(const bf16x8*)(Kp + (size_t)(n * 256 + 128 * i + 16 * wid) * AW + cc * 512 + lane * 8);
#pragma unroll
                for (int j = 0; j < 8; ++j) a[cc * 8 + j] += bf2f(kx[j]); }
#pragma unroll
        for (int j = 0; j < 16; ++j) { a[j] += __shfl_xor(a[j], 1); a[j] += __shfl_xor(a[j], 2); a[j] += __shfl_xor(a[j], 4); a[j] += __shfl_xor(a[j], 8); }
        if ((lane & 15) == 0) {
#pragma unroll
            for (int j = 0; j < 16; ++j) red[(n * 8 + wid) * 64 + (j >> 3) * 32 + (lane >> 4) * 8 + (j & 7)] = a[j]; }
    }
    __syncthreads();
    { const int n = tid >> 6, d = tid & 63; float s = 0.f;
#pragma unroll
        for (int w = 0; w < 8; ++w) s += red[(n * 8 + w) * 64 + d];
        km[n * 64 + d] = s * (1.0f / 256.0f); }
    __syncthreads();
}
template <int DQK, bool MOBA>
__device__ __forceinline__ void attn_bh(const bf16_t* Qp, int ldq, const bf16_t* Kp, const bf16_t* KRp, const bf16_t* Vp, bf16_t* Op, int ldo, ALDS char* lds) {
    constexpr int ND = DQK / 16;
    ALDS char* K_lds = lds + L_K; ALDS char* V_lds = lds + L_V;
    bf16x8 sk0, sv0, sr0, sk1, sv1, sr1;
#define ATT_SLOAD(S, k0) do { sk##S = *(const bf16x8*)((const char*)(Kp + (size_t)(k0) * AW) + koff); sv##S = *(const bf16x8*)((const char*)(Vp + (size_t)(k0) * AW) + koff); if (DQK == 96) sr##S = *(const bf16x8*)((const char*)(KRp + (size_t)(k0) * RDIM) + roff); } while (0)
#define ATT_SWRITE(b, S) do { *(ALDS bf16x8*)(K_lds + (b) * KTB + kst) = sk##S; *(ALDS bf16x8*)(V_lds + (b) * VTB + vst) = sv##S; if (DQK == 96) { if (tid < 256) *(ALDS bf16x8*)(K_lds + (b) * KTB + rst) = sr##S; } } while (0)
#define ATT_QLOAD(q_) do { const bf16_t* Qw = Qp + (size_t)((q_) * 256 + wid * 32 + (r32 & 16)) * ldq + (r32 & 15) * 8 + hi * 128; _Pragma("unroll") for (int d0 = 0; d0 < ND; ++d0) qr[d0] = *(const bf16x8*)(Qw + (d0 >> 1) * 512 + (d0 & 1) * 256); } while (0)
    bf16x8 qr[ND];
    {
        const int tid = threadIdx.x, w_ = tid >> 6, l_ = tid & 63;
        const unsigned koff = (unsigned)((w_ >> 1) * 16 * AW + (w_ & 1) * 512 + l_ * 8) * 2u, roff = (unsigned)((w_ & 3) * 16 * RDIM + l_ * 8) * 2u;
        ATT_SLOAD(0, 0); ATT_SLOAD(1, 64); }
#pragma unroll 1
  for (int qb = 0; qb < 8; ++qb) {
    int tid_ = threadIdx.x; asm volatile("" : "+v"(tid_));
    const int tid = tid_, lane = tid & 63, r32 = lane & 31, hi = lane >> 5; const int wid = __builtin_amdgcn_readfirstlane(tid >> 6);
    ALDS float* al_l = (ALDS float*)(lds + L_WS) + wid * 64;
    const int skey = 16 * (wid >> 1) + (lane & 15), sch = 4 * (wid & 1) + (lane >> 4);
    const unsigned koff = (unsigned)((wid >> 1) * 16 * AW + (wid & 1) * 512 + lane * 8) * 2u;
    const int kst = skey * 128 + ((sch ^ ((skey >> 1) & 7)) << 4), vst = v_st(skey, sch * 8);
    const int rkey = 16 * (wid & 3) + (lane & 15), rch = lane >> 4;
    const unsigned roff = (unsigned)((wid & 3) * 16 * RDIM + lane * 8) * 2u;
    const int rst = 8192 + rkey * 64 + ((rch ^ ((rkey >> 2) & 3)) << 4);
    int ka[ND];
#pragma unroll
    for (int d0 = 0; d0 < ND; ++d0) ka[d0] = (d0 < 4) ? r32 * 128 + (((2 * d0 + hi) ^ ((r32 >> 1) & 7)) << 4) : 8192 + r32 * 64 + (((2 * (d0 - 4) + hi) ^ ((r32 >> 2) & 3)) << 4);
    const int vb0 = (int)(unsigned)(uintptr_t)V_lds + v_rd_base(lane);
    const int qrel = wid * 32 + r32;
    ATT_QLOAD(qb);
    float m_ref = 0.f, lsum = 0.f; f32x16 o[2], ol, negm; o[0] = f32x16{}; o[1] = f32x16{}; ol = f32x16{}; negm = f32x16{};
    unsigned sel = 0xffu;
    if (MOBA && qb > 3) {
        ALDS const float* km = (ALDS const float*)(lds + L_KM); float g[8];
#pragma unroll
        for (int n = 0; n < 8; ++n) { float s = 0.f;
#pragma unroll
            for (int d0 = 0; d0 < ND; ++d0)
#pragma unroll
                for (int j = 0; j < 8; ++j) s += bf2f(qr[d0][j]) * km[n * 64 + d0 * 16 + hi * 8 + j];
            g[n] = s; }
#pragma unroll
        for (int n = 0; n < 8; ++n) g[n] += __shfl_xor(g[n], 32);
        sel = 0u;
#pragma unroll
        for (int n = 0; n < 8; ++n) { int rank = 0;
#pragma unroll
            for (int mm = 0; mm < 8; ++mm) if (mm != n) rank += (mm < qb && (g[mm] > g[n] || (g[mm] == g[n] && mm < n))) ? 1 : 0;
            if (n < qb && rank < 3) sel |= 1u << n; }
    }
#define ATT_RESC(a) do { if (__any((a) < 1.f)) { lsum *= (a); if (hi == 0) al_l[r32] = (a); asm volatile("s_waitcnt lgkmcnt(0)" ::: "memory"); \
    _Pragma("unroll") for (int r = 0; r < 16; ++r) { const float f_ = al_l[crow(r, hi)]; o[0][r] *= f_; o[1][r] *= f_; ol[r] *= f_; } } } while (0)
    f32x16 pA0, pA1, pB0, pB1; float alA, alB; bf16x8 pa0, pa1, pa2, pa3; const int NT = 4 * (qb + 1), NP = 4 * qb;
    f32x16 cm = negm; const bool gated = MOBA && qb > 3;
#define ATT_CM(t) do { if (gated) { if ((t) < NP) { const float v_ = ((sel >> ((t) >> 2)) & 1u) ? -m_ref : -INFINITY; _Pragma("unroll") for (int r = 0; r < 16; ++r) cm[r] = v_; } else cm = negm; } else cm = negm; } while (0)
#define ATT_SCORE(P0, P1, t) do { ATT_CM(t); qkt<ND>(P0, P1, K_lds + sc * KTB, ka, qr, cm); if ((t) >= NP) cmask(P0, P1, (t) - NP, qrel, hi); } while (0)
    int sp = 0, sc = 0, sn = 1;
#define ATT_ROT() do { sp = sc; sc = sn; sn = (sn == NSLOT - 1) ? 0 : sn + 1; } while (0)
    ATT_SWRITE(0, 0); ATT_SLOAD(0, 128);
    __syncthreads(); ATT_SWRITE(sn, 1); ATT_SLOAD(1, 192);
    ATT_SCORE(pA0, pA1, 0); partialSM(pA0, pA1, m_ref, negm, alA);
    ATT_ROT();
    for (int t = 1; t + 1 < NT; t += 2) {
        __syncthreads(); ATT_SWRITE(sn, 0); if (t + 3 < NT) ATT_SLOAD(0, (t + 3) * 64);
        ASBAR(); ATT_SCORE(pB0, pB1, t);
        finishSM(pA0, pA1, pa0, pa1, pa2, pa3, lsum); ASBAR();
        pv_all(o, ol, vb0 + sp * VTB, pa0, pa1, pa2, pa3); partialSM(pB0, pB1, m_ref, negm, alB);
        ATT_RESC(alB); ATT_ROT();
        __syncthreads(); ATT_SWRITE(sn, 1); if (t + 4 < NT) ATT_SLOAD(1, (t + 4) * 64);
        ASBAR(); ATT_SCORE(pA0, pA1, t + 1);
        finishSM(pB0, pB1, pa0, pa1, pa2, pa3, lsum); ASBAR();
        pv_all(o, ol, vb0 + sp * VTB, pa0, pa1, pa2, pa3); partialSM(pA0, pA1, m_ref, negm, alA);
        ATT_RESC(alA); ATT_ROT();
    }
    __syncthreads();
    ASBAR(); ATT_SCORE(pB0, pB1, NT - 1);
    if (qb < 7) { ATT_SLOAD(0, 0); ATT_SLOAD(1, 64); }
    finishSM(pA0, pA1, pa0, pa1, pa2, pa3, lsum); ASBAR();
    pv_all(o, ol, vb0 + sp * VTB, pa0, pa1, pa2, pa3); partialSM(pB0, pB1, m_ref, negm, alB);
    ATT_RESC(alB);
    finishSM(pB0, pB1, pa0, pa1, pa2, pa3, lsum); ASBAR();
    pv_all(o, ol, vb0 + sc * VTB, pa0, pa1, pa2, pa3);
#undef ATT_ROT
#undef ATT_SCORE
#undef ATT_CM
    float rli[16];
#if ATT_LSUM_MFMA
#pragma unroll
    for (int r = 0; r < 16; ++r) rli[r] = __builtin_amdgcn_rcpf(ol[r]);
#else
    { auto rr = __builtin_amdgcn_permlane32_swap(__float_as_uint(lsum), __float_as_uint(lsum), false, false); lsum = __uint_as_float(rr[0]) + __uint_as_float(rr[1]); }
    if (hi == 0) al_l[32 + r32] = lsum; asm volatile("s_waitcnt lgkmcnt(0)" ::: "memory");
#pragma unroll
    for (int r = 0; r < 16; ++r) rli[r] = __builtin_amdgcn_rcpf(al_l[32 + crow(r, hi)]);
#endif
    { ALDS unsigned short* stg = (ALDS unsigned short*)(lds + L_OST) + wid * 2048;
#pragma unroll
      for (int r = 0; r < 16; ++r) { const int orow = crow(r, hi);
#pragma unroll
          for (int d0 = 0; d0 < 2; ++d0) stg[orow * 64 + d0 * 32 + r32] = (unsigned short)(cvtpk(o[d0][r] * rli[r], 0.f) & 0xffffu); }
      asm volatile("s_waitcnt lgkmcnt(0)" ::: "memory");
      bf16_t* Ow = Op + (size_t)(qb * 256 + wid * 32) * ldo;
#pragma unroll
      for (int i = 0; i < 4; ++i) { const int row = i * 8 + (lane >> 3), ch = lane & 7; const u32x4 v = *(ALDS const u32x4*)(stg + row * 64 + ch * 8); *(u32x4*)(Ow + (size_t)row * ldo + ch * 8) = v; } }
    __syncthreads();
  }
#undef ATT_SLOAD
#undef ATT_SWRITE
#undef ATT_QLOAD
#undef ATT_RESC
}
#undef ASBAR
}
#define GAS __attribute__((address_space(1)))
#define LAS __attribute__((address_space(3)))
typedef unsigned short bf16;
typedef unsigned v4u __attribute__((ext_vector_type(4)));
typedef float f32x4 __attribute__((ext_vector_type(4)));
typedef short bf16x8 __attribute__((ext_vector_type(8)));
typedef GAS unsigned gu32;
typedef GAS unsigned long long gu64;
#define RLX_AGENT __ATOMIC_RELAXED, __HIP_MEMORY_SCOPE_AGENT
#define LDS_WAIT() asm volatile("s_waitcnt lgkmcnt(0)" ::: "memory")
#define VM_WAIT() asm volatile("s_waitcnt vmcnt(0)" ::: "memory")
__device__ __forceinline__ unsigned long long rt() { return __builtin_amdgcn_s_memrealtime(); }
__device__ __forceinline__ unsigned f2bf(float f) { unsigned u = __builtin_bit_cast(unsigned, f); return (u + 0x7fffu + ((u >> 16) & 1u)) >> 16; }
__device__ __forceinline__ unsigned pk2(float lo, float hi) { return f2bf(lo) | (f2bf(hi) << 16); }

#define XB_TMO      128
#define XB_XCNT(j)  (256  + 64 * (j))
#define XB_XSUB(j)  (1280 + 64 * (j))
#define XB_XGEN(j)  (2304 + 64 * (j))
#define XB_TOP      3328
#define XB_TOPGEN   3392
#define XCD_BAR_WORDS 3456
#define XB_SPIN_CAP (1u << 18)

__device__ __forceinline__ unsigned xb_ld(unsigned* p)              { return __hip_atomic_load(p, __ATOMIC_RELAXED, __HIP_MEMORY_SCOPE_AGENT); }
__device__ __forceinline__ unsigned xb_add(unsigned* p, unsigned v) { return __hip_atomic_fetch_add(p, v, __ATOMIC_RELAXED, __HIP_MEMORY_SCOPE_AGENT); }
__device__ __forceinline__ unsigned xb_xcc_id() { return (unsigned)__builtin_amdgcn_s_getreg((3 << 11) | 20) & 0xFu; }
#define XB_SPIN(cond, bar) do { unsigned _sp = 0; while (cond) { __builtin_amdgcn_s_sleep(1); \
    if ((++_sp & 255u) == 0u) { if (xb_ld(&(bar)[XB_TMO])) break; if (_sp > XB_SPIN_CAP) { atomicAdd(&(bar)[XB_TMO], 1u); break; } } } } while (0)

struct XcdBarrier {
    unsigned* bar; unsigned x;
    volatile LAS unsigned* st;
};

__device__ __forceinline__ XcdBarrier xcd_barrier_post(unsigned* bar, volatile LAS unsigned* st) {
    XcdBarrier b; b.bar = bar; b.x = xb_xcc_id(); b.st = st;
    if (threadIdx.x == 0) (void)xb_add(&bar[XB_XCNT(b.x)], 1u);
    return b;
}
__device__ __forceinline__ void xcd_barrier_complete(unsigned* bar, unsigned x, unsigned& nloc, unsigned& nx) {
    const unsigned G = gridDim.x * gridDim.y * gridDim.z;
    unsigned sum, cnt, mine, sp = 0u;
    for (;;) {
        sum = 0u; cnt = 0u; mine = 0u;
#pragma unroll
        for (unsigned j = 0; j < 16; ++j) { const unsigned c = xb_ld(&bar[XB_XCNT(j)]); sum += c; cnt += (c > 0u) ? 1u : 0u; mine = (j == x) ? c : mine; }
        if (sum == G) break;
        __builtin_amdgcn_s_sleep(1);
        if ((++sp & 255u) == 0u) { if (xb_ld(&bar[XB_TMO])) break; if (sp > XB_SPIN_CAP) { atomicAdd(&bar[XB_TMO], 1u); break; } }
    }
    nloc = mine > 0u ? mine : 1u; nx = cnt > 0u ? cnt : 1u;
}

__device__ __forceinline__ void xcd_barrier(const XcdBarrier& b) {
    asm volatile("s_waitcnt vmcnt(0)" ::: "memory");
    __syncthreads();
    if (threadIdx.x == 0) {
        unsigned* bar = b.bar;
        __builtin_amdgcn_s_waitcnt(0);
        unsigned nloc = b.st[0], nx = b.st[1];
        if (nloc == 0u) { xcd_barrier_complete(bar, b.x, nloc, nx); b.st[0] = nloc; b.st[1] = nx; }
        const unsigned old = xb_add(&bar[XB_XSUB(b.x)], 1u);
        const unsigned gen = old / nloc;
        if (old + 1u == (gen + 1u) * nloc) {
            __builtin_amdgcn_fence(__ATOMIC_RELEASE, "agent");
            asm volatile("s_waitcnt vmcnt(0)" ::: "memory");
            const unsigned og = xb_add(&bar[XB_TOP], 1u);
            const unsigned tg = og / nx;
            if (og + 1u == (tg + 1u) * nx) xb_add(&bar[XB_TOPGEN], 1u);
            else XB_SPIN(xb_ld(&bar[XB_TOPGEN]) == tg, bar);
            __builtin_amdgcn_fence(__ATOMIC_ACQUIRE, "agent");
            xb_add(&bar[XB_XGEN(b.x)], 1u);
            asm volatile("s_waitcnt vmcnt(0)" ::: "memory");
        } else {
            XB_SPIN(xb_ld(&bar[XB_XGEN(b.x)]) == gen, bar);
            __builtin_amdgcn_fence(__ATOMIC_ACQUIRE, "agent");
            asm volatile("s_waitcnt vmcnt(0)" ::: "memory");
        }
    }
    __syncthreads();
}

constexpr size_t MiB = 1u << 20;
constexpr size_t WS_CTL = 0, CTL_ZERO_BYTES = 64 * 1024;
constexpr size_t WS_ROPEA = 1 * MiB, WS_ROPEB = 5 * MiB;
constexpr size_t WS_SS = 13 * MiB, WS_SS2 = 16 * MiB, WS_SS3 = 20 * MiB;
constexpr size_t WS_WIN = 24 * MiB, WS_WUQ = 34 * MiB, WS_WUKV = 35 * MiB, WS_WA = 36 * MiB, WS_WOUT = 39 * MiB, WS_WUP = 42 * MiB, WS_WDN = 51 * MiB;
constexpr size_t WS_H = 64 * MiB;
constexpr size_t WS_G = 208 * MiB;
constexpr size_t WS_QA = 464 * MiB, WS_KA = 528 * MiB, WS_VA = 592 * MiB;
constexpr size_t WS_T = WS_KA;
constexpr size_t WS_CQ = 672 * MiB, WS_CKV = 720 * MiB;
constexpr size_t WS_KR = 760 * MiB;
constexpr size_t WS_QB = 768 * MiB, WS_KB = 864 * MiB, WS_VB = 928 * MiB;
constexpr size_t WS_Y = WS_QB;
constexpr size_t WS_X1 = 896 * MiB;
constexpr size_t WS_H8 = WS_QB;
constexpr size_t WS_WG8 = 60 * MiB;
constexpr size_t WS_U = 208 * MiB;
constexpr size_t WS_END = 1024 * MiB;
static_assert(WS_H + (size_t)MTOK * LDH * 2 <= WS_G && WS_G + (size_t)MTOK * 2 * DM * 2 <= WS_QA && WS_T + (size_t)MTOK * LDH * 2 <= WS_CQ && WS_CQ + (size_t)MTOK * QLORA * 2 <= WS_CKV && WS_CKV + (size_t)MTOK * LDKV * 2 <= WS_KR, "d_ws map");
static_assert(WS_U + (size_t)MTOK * LDU * 2 <= WS_KR && WS_Y + (size_t)MTOK * DM * 2 <= WS_X1 && WS_X1 + (size_t)MTOK * DM * 2 <= WS_END && WS_VB + (size_t)MTOK * AW * 2 <= WS_END && WS_KR + (size_t)MTOK * RDIM * 2 <= WS_QB, "d_ws map");
static_assert(WS_WIN + (size_t)INWP * LDH * 2 <= WS_WUQ && WS_WUKV + (size_t)1024 * LDKV * 2 <= WS_WA && WS_WA + (size_t)DM * LDH * 2 <= WS_WOUT && WS_WOUT + (size_t)DM * LDH * 2 <= WS_WUP && WS_WUP + (size_t)DFF * LDH * 2 <= WS_WDN && WS_WDN + (size_t)DM * LDU * 2 <= WS_H, "d_ws map");
constexpr int CW_BAR = 0;
constexpr int NWAVES = 8;
constexpr int RING_OFF = 0, RING_BYTES = 131072;
constexpr int LDSCTL_OFF = RING_BYTES, MISC_OFF = LDSCTL_OFF + 320;
constexpr int LDS_BYTES = 147456;
static_assert(att::L_END <= RING_BYTES, "attention LDS map");

struct Frame {
    LAS unsigned char* lds;
    volatile LAS unsigned* MISC;
    gu32* ctl;
    int tid, lane, wave, vcu, G;
};

__device__ __forceinline__ float wave_sum(float v) {
#pragma unroll
    for (int o = 1; o < 64; o <<= 1) v += __shfl_xor(v, o);
    return v;
}
__device__ __forceinline__ int srccol(int mat, int n) {
    if (mat == 0) {
        if (n < 1024) { const int sect = n >> 9, c = n & 511, head = c >> 6, p = c & 63; const int d = (p < 16) ? ((p >> 1) + 8 * (p & 1)) : p; return sect * 512 + head * 64 + d; }
        if (n < 1920) return n;
        if (n < 1952) { const int pr = n - 1920; return 2176 + (pr >> 1) + 16 * (pr & 1); }
        if (n < 2048) return -1;
        if (n < 2304) return 1920 + (n - 2048);
        return 2208 + (n - 2304);
    }
    if (mat == 1) { const int head = n / QKB, p = n - head * QKB; if (p < 64) return n; const int pr = p - 64; return head * QKB + 64 + (pr >> 1) + 16 * (pr & 1); }
    return n;
}
__device__ __forceinline__ void p0_transpose_item(const float* W, int K, int Nsrc, int Ndst, bf16* WT, int ldw, int koff, const float* gs, int mat, LAS float* scr, int item, int lane) {
    const int nblk = Ndst / 32, kb = item / nblk, nb = item % nblk, k0 = 64 * kb, n0 = 32 * nb;
    const int sc = srccol(mat, n0 + (lane & 31));
#pragma unroll 8
    for (int i = 0; i < 32; ++i) { const int kk = 2 * i + (lane >> 5); float v = (sc >= 0) ? W[(size_t)(k0 + kk) * Nsrc + sc] : 0.f; if (gs) v *= gs[k0 + kk]; scr[kk * 33 + (lane & 31)] = v; }
    LDS_WAIT(); asm volatile("" ::: "memory");
    const int c = lane & 7;
#pragma unroll
    for (int j = 0; j < 4; ++j) { const int n = (lane >> 3) + 8 * j; const LAS float* s = scr + (8 * c) * 33 + n;
        v4u o; o.x = pk2(s[0 * 33], s[1 * 33]); o.y = pk2(s[2 * 33], s[3 * 33]); o.z = pk2(s[4 * 33], s[5 * 33]); o.w = pk2(s[6 * 33], s[7 * 33]);
        *(GAS v4u*)(WT + (size_t)(n0 + n) * ldw + koff + k0 + 8 * c) = o; }
    LDS_WAIT(); asm volatile("" ::: "memory");
}
__device__ __forceinline__ int ppos_dn(int c) { return (c & ~255) | (((c >> 5) & 3) << 6) | (((c >> 3) & 3) << 4) | (((c >> 7) & 1) << 3) | (c & 7); }
template <bool KPERM = false>
__device__ __forceinline__ void p0_transpose_item_f8(const float* W, int K, int N, int Nsrc, int coff, unsigned char* WT, float scale, LAS float* scr, int item, int lane) {
    const int nblk = N / 32, kb = item / nblk, nb = item % nblk, k0 = 64 * kb, n0 = 32 * nb;
#pragma unroll 8
    for (int i = 0; i < 32; ++i) { const int kk = 2 * i + (lane >> 5); scr[kk * 33 + (lane & 31)] = W[(size_t)(k0 + kk) * Nsrc + coff + n0 + (lane & 31)] * scale; }
    LDS_WAIT(); asm volatile("" ::: "memory");
    const int c = lane & 7;
#pragma unroll
    for (int j = 0; j < 4; ++j) { const int n = (lane >> 3) + 8 * j; const LAS float* s = scr + (8 * c) * 33 + n;
        int w0 = 0, w1 = 0;
        w0 = __builtin_amdgcn_cvt_pk_fp8_f32(s[0 * 33], s[1 * 33], w0, false); w0 = __builtin_amdgcn_cvt_pk_fp8_f32(s[2 * 33], s[3 * 33], w0, true);
        w1 = __builtin_amdgcn_cvt_pk_fp8_f32(s[4 * 33], s[5 * 33], w1, false); w1 = __builtin_amdgcn_cvt_pk_fp8_f32(s[6 * 33], s[7 * 33], w1, true);
        typedef int i32x2_ __attribute__((ext_vector_type(2)));
        *(GAS i32x2_*)(WT + (size_t)(n0 + n) * K + (KPERM ? ppos_dn(k0 + 8 * c) : k0 + 8 * c)) = (i32x2_){w0, w1}; }
    LDS_WAIT(); asm volatile("" ::: "memory");
}
__device__ __forceinline__ void rms_row_to_bf16(int lane, const float* xrow, const f32x4 (&g)[4], bf16* orow, unsigned char* orow8) {
    const GAS f32x4* xr = (const GAS f32x4*)xrow + lane;
    f32x4 v[4]; float s = 0.f;
#pragma unroll
    for (int j = 0; j < 4; ++j) { v[j] = xr[64 * j]; s += (v[j].x * v[j].x + v[j].y * v[j].y) + (v[j].z * v[j].z + v[j].w * v[j].w); }
    const float rstd = 1.f / sqrtf(wave_sum(s) * (1.f / DM) + EPS);
    GAS unsigned long long* o8 = (GAS unsigned long long*)orow + lane;
#pragma unroll
    for (int j = 0; j < 4; ++j) { const f32x4 y = v[j] * rstd * g[j]; o8[64 * j] = (unsigned long long)pk2(y.x, y.y) | ((unsigned long long)pk2(y.z, y.w) << 32);
        int w = 0; w = __builtin_amdgcn_cvt_pk_fp8_f32(y.x, y.y, w, false); w = __builtin_amdgcn_cvt_pk_fp8_f32(y.z, y.w, w, true); ((GAS int*)orow8)[lane + 64 * j] = w; }
}

struct Args { const float* in[17]; float* out; unsigned char* ws; int ph_lo, ph_hi, li, pad; };

__global__ void __launch_bounds__(NWAVES * 64, 2) block_fwd(Args args) {
    extern __shared__ __attribute__((aligned(16))) unsigned char lds[];
    Frame F;
    F.lds = (LAS unsigned char*)lds;
    F.MISC = (volatile LAS unsigned*)(F.lds + MISC_OFF);
    F.tid = threadIdx.x; F.lane = F.tid & 63; F.wave = __builtin_amdgcn_readfirstlane(F.tid >> 6);
    F.G = gridDim.x; { const int bx = blockIdx.x; F.vcu = (F.G % 8 == 0) ? (bx % 8) * (F.G / 8) + bx / 8 : bx; }
    unsigned char* ws = args.ws;
    F.ctl = (gu32*)(ws + WS_CTL);
    const float* x = args.in[0]; const int* positions = (const int*)args.in[1];
    const float *g_pre_mix = args.in[2], *w_in = args.in[3], *b_gate = args.in[4], *g_q = args.in[5], *w_uq = args.in[6], *g_kv = args.in[7], *w_ukv = args.in[8], *w_a = args.in[9], *w_b = args.in[10],
                *w_out = args.in[11], *g_post_mix = args.in[12], *g_pre_mlp = args.in[13], *w_up = args.in[14], *w_dn = args.in[15], *g_post_mlp = args.in[16];
    float* out = args.out;
    float* ropeA = (float*)(ws + WS_ROPEA); float* ropeB = (float*)(ws + WS_ROPEB);
    float* SS = (float*)(ws + WS_SS); float* SS2 = (float*)(ws + WS_SS2); float* SS3 = (float*)(ws + WS_SS3);
    bf16 *WIN = (bf16*)(ws + WS_WIN), *WUQ = (bf16*)(ws + WS_WUQ), *WUKV = (bf16*)(ws + WS_WUKV), *WA = (bf16*)(ws + WS_WA), *WOUT = (bf16*)(ws + WS_WOUT), *WUP = (bf16*)(ws + WS_WUP), *WDN = (bf16*)(ws + WS_WDN);
    bf16 *H = (bf16*)(ws + WS_H), *Gt = (bf16*)(ws + WS_G), *QA = (bf16*)(ws + WS_QA), *KA = (bf16*)(ws + WS_KA), *VA = (bf16*)(ws + WS_VA), *T = (bf16*)(ws + WS_T), *CQ = (bf16*)(ws + WS_CQ), *CKV = (bf16*)(ws + WS_CKV),
         *KR = (bf16*)(ws + WS_KR), *QB = (bf16*)(ws + WS_QB), *KB = (bf16*)(ws + WS_KB), *VB = (bf16*)(ws + WS_VB), *Y = (bf16*)(ws + WS_Y), *U = (bf16*)(ws + WS_U), *X1B = (bf16*)(ws + WS_X1); unsigned char *H8 = ws + WS_H8, *WG8 = ws + WS_WG8;
    for (int u = F.tid; u < (LDS_BYTES - LDSCTL_OFF) / 4; u += NWAVES * 64) ((LAS unsigned*)(F.lds + LDSCTL_OFF))[u] = 0u;
    __syncthreads();
    XcdBarrier bar = xcd_barrier_post((unsigned*)(F.ctl + CW_BAR) + args.li * XCD_BAR_WORDS, F.MISC + 8);
    const int lo = args.ph_lo, hi = args.ph_hi;
#define IN(k) (lo <= (k) && (k) < hi)
#define SEAM(k) do { if (IN(k) && IN((k) + 1)) xcd_barrier(bar); } while (0)
    const int gw = F.vcu * NWAVES + F.wave, NGW = F.G * NWAVES;

#if !defined(SKIP_P0)
    if (IN(0))
    {
        LAS float* scr = (LAS float*)(F.lds + RING_OFF + F.wave * 16384);
        constexpr int NBF = 2304, IG = (DM / 64) * (2 * DM / 32);
        constexpr int I0 = (DM / 64) * (NBF / 32), I1 = (QLORA / 64) * (768 / 32), I2 = (KVLORA / 64) * (1024 / 32), I3 = (AW / 64) * (DM / 32), I5 = (DM / 64) * (DM / 32), I6 = (DM / 64) * (DFF / 32), I7 = (DFF / 64) * (DM / 32);
        constexpr int NITEMS = I0 + I1 + I2 + 2 * I3 + I5 + I6 + I7 + IG;
        for (int it = gw; it < NITEMS; it += NGW) {
            int r = it;
            if (r < I0) { p0_transpose_item(w_in, DM, INW, NBF, WIN, LDH, 0, nullptr, 0, scr, r, F.lane); continue; } r -= I0;
            if (r < IG) { p0_transpose_item_f8(w_in, DM, 2 * DM, INW, 2208, WG8, 32.f, scr, r, F.lane); continue; } r -= IG;
            if (r < I1) { p0_transpose_item(w_uq, QLORA, 768, 768, WUQ, QLORA, 0, g_q, 1, scr, r, F.lane); continue; } r -= I1;
            if (r < I2) { p0_transpose_item(w_ukv, KVLORA, 1024, 1024, WUKV, LDKV, 0, g_kv, 2, scr, r, F.lane); continue; } r -= I2;
            if (r < I3) { p0_transpose_item(w_a, AW, DM, DM, WA, LDH, 0, nullptr, 2, scr, r, F.lane); continue; } r -= I3;
            if (r < I3) { p0_transpose_item(w_b, AW, DM, DM, WA, LDH, AW, nullptr, 2, scr, r, F.lane); continue; } r -= I3;
            if (r < I5) { p0_transpose_item(w_out, DM, DM, DM, WOUT, LDH, 0, nullptr, 2, scr, r, F.lane); continue; } r -= I5;
            if (r < I6) { p0_transpose_item_f8(w_up, DM, DFF, DFF, 0, (unsigned char*)WUP, 32.f, scr, r, F.lane); continue; } r -= I6;
            p0_transpose_item_f8<true>(w_dn, DFF, DM, DM, 0, (unsigned char*)WDN, 64.f, scr, r, F.lane);
        }
        for (int idx = (int)blockIdx.x * (NWAVES * 64) + F.tid; idx < MTOK * 24; idx += F.G * NWAVES * 64) {
            const int m = idx / 24, i = idx - m * 24;
            const float invf = (i < 8) ? __builtin_amdgcn_exp2f(-(float)i * 2.3664460711655217f) : __builtin_amdgcn_exp2f(-(float)(i - 8) * 1.1832230355827609f);
            const float ang = (float)positions[m] * invf;
            double t = (double)ang * 0.15915494309189535; t -= floor(t);
            const float tf = (float)t; const float c = __builtin_amdgcn_cosf(tf), s = __builtin_amdgcn_sinf(tf);
            float* dst = (i < 8) ? ropeA + (size_t)m * 16 + 2 * i : ropeB + (size_t)m * 32 + 2 * (i - 8);
            *(f32x2g*)dst = (f32x2g){c, s};
        }
        f32x4 g[4];
#pragma unroll
        for (int j = 0; j < 4; ++j) g[j] = ((const GAS f32x4*)g_pre_mix)[F.lane + 64 * j];
        for (int m = gw; m < MTOK; m += NGW) rms_row_to_bf16(F.lane, x + (size_t)m * DM, g, H + (size_t)m * LDH, H8 + (size_t)m * DM);
    }
#endif
    SEAM(0);

#if !defined(SKIP_P1)
    if (IN(1))
    {
        { pg8::Gemm g{H, WIN, MTOK, 2304, DM, LDH, LDH}; pg8::StaticOrder S; S.init(MTOK, 2304, F.G, (int)blockIdx.x);
          pg8::EpiIn E{QA, KA, VA, CQ, CKV, KR, Gt, SS, ropeA, ropeB, b_gate};
          pg8::gemm_phase<pg8::EpiIn, pg8::StaticOrder, true, true>(F.lds + RING_OFF, g, S, E); }
        { pg8::Gemm g{(const bf16*)H8, (const bf16*)WG8, MTOK, 2 * DM, DM, DM, DM}; pg8::StaticOrder S; S.init(MTOK, 2 * DM, F.G, (int)blockIdx.x);
          pg8::EpiGates E{Gt, b_gate};
          pg8::gemm_phase<pg8::EpiGates, pg8::StaticOrder, true, true, 1>(F.lds + RING_OFF, g, S, E); }
    }
#endif
    SEAM(1);

#if !defined(SKIP_P2)
    if (IN(2)) {
    {
        pg8::Gemm g{CQ, WUQ, MTOK, NHEAD * QKB, QLORA}; pg8::StaticOrder S; S.init(MTOK, NHEAD * QKB, F.G, (int)blockIdx.x);
        pg8::EpiQ E{QB, SS, ropeB};
        pg8::gemm_phase<pg8::EpiQ, pg8::StaticOrder, true, true, 2, true>(F.lds + RING_OFF, g, S, E);
    }
    {
        pg8::Gemm g{CKV, WUKV, MTOK, 2 * AW, KVLORA, LDKV, LDKV}; pg8::StaticOrder S; S.init(MTOK, 2 * AW, F.G, (int)blockIdx.x);
        pg8::EpiKV E{KB, VB, SS};
        pg8::gemm_phase<pg8::EpiKV, pg8::StaticOrder, true, true, 2, true>(F.lds + RING_OFF, g, S, E);
    }
    }
#endif
    SEAM(2);

#if !defined(SKIP_P3)
    if (IN(3))
    {
        LAS char* al = (LAS char*)(F.lds + RING_OFF);
#if !defined(SKIP_MOBA)
        for (int bh = F.vcu; bh < NB * NHEAD; bh += F.G) {
            const int b = bh >> 3, h = bh & 7; const size_t r0 = (size_t)b * SEQ;
            att::kmean_blocks(KA + r0 * AW + h * HD * 16, al);
            att::attn_bh<64, true>(QA + r0 * AW + h * HD * 16, AW, KA + r0 * AW + h * HD * 16, nullptr, VA + r0 * AW + h * HD * 16, H + r0 * LDH + h * HD, LDH, al);
        }
#endif
#if !defined(SKIP_MLA)
        for (int bh = F.vcu; bh < NB * NHEAD; bh += F.G) {
            const int b = bh >> 3, h = bh & 7; const size_t r0 = (size_t)b * SEQ;
            att::attn_bh<96, false>(QB + r0 * (NHEAD * QKB) + h * QKB * 16, NHEAD * QKB, KB + r0 * AW + h * HD * 16, KR + r0 * RDIM, VB + r0 * AW + h * HD * 16, H + r0 * LDH + AW + h * HD, LDH, al);
        }
#endif
    }
#endif
    SEAM(3);

#if !defined(SKIP_P4)
    if (IN(4))
    {
        pg8::Gemm g{H, WA, MTOK, DM, DM, LDH, LDH}; pg8::StaticOrder S; S.init(MTOK, DM, F.G, (int)blockIdx.x);
        pg8::EpiMerge E{Gt, T};
        pg8::gemm_phase<pg8::EpiMerge, pg8::StaticOrder, true, true>(F.lds + RING_OFF, g, S, E);
    }
#endif
    SEAM(4);

#if !defined(SKIP_P5)
    if (IN(5))
    {
        pg8::Gemm g{T, WOUT, MTOK, DM, DM, LDH, LDH}; pg8::StaticOrder S; S.init(MTOK, DM, F.G, (int)blockIdx.x);
        pg8::EpiSS E{Y, SS2, DM, 1.0f};
        pg8::gemm_phase<pg8::EpiSS, pg8::StaticOrder, true, true, 2, true>(F.lds + RING_OFF, g, S, E);
    }
#endif
    SEAM(5);

#if !defined(SKIP_P6)
    if (IN(6))
    {
        f32x4 g1[4], g2[4];
#pragma unroll
        for (int j = 0; j < 4; ++j) { g1[j] = ((const GAS f32x4*)g_post_mix)[F.lane + 64 * j]; g2[j] = ((const GAS f32x4*)g_pre_mlp)[F.lane + 64 * j]; }
        for (int m = gw; m < MTOK; m += NGW) {
            const GAS f32x4* sp = (const GAS f32x4*)(SS2 + (size_t)m * 16); const f32x4 a = sp[0], b = sp[1], c = sp[2], d = sp[3];
            const float ssy = (((a.x + a.y) + (a.z + a.w)) + ((b.x + b.y) + (b.z + b.w))) + (((c.x + c.y) + (c.z + c.w)) + ((d.x + d.y) + (d.z + d.w)));
            const float rsy = 1.f / sqrtf(ssy * (1.f / DM) + EPS);
            const GAS f32x4* xr = (const GAS f32x4*)(x + (size_t)m * DM) + F.lane; const GAS unsigned long long* yr = (const GAS unsigned long long*)(Y + (size_t)m * DM) + F.lane;
            GAS unsigned long long* x8 = (GAS unsigned long long*)(X1B + (size_t)m * DM) + F.lane;
            f32x4 v[4]; float s = 0.f;
#pragma unroll
            for (int j = 0; j < 4; ++j) { const unsigned long long yw = yr[64 * j]; const unsigned lo = (unsigned)yw, hi = (unsigned)(yw >> 32);
                const f32x4 yv = (f32x4){__uint_as_float(lo << 16), __uint_as_float(lo & 0xffff0000u), __uint_as_float(hi << 16), __uint_as_float(hi & 0xffff0000u)};
                v[j] = xr[64 * j] + yv * rsy * g1[j]; x8[64 * j] = (unsigned long long)pk2(v[j].x, v[j].y) | ((unsigned long long)pk2(v[j].z, v[j].w) << 32);
                s += (v[j].x * v[j].x + v[j].y * v[j].y) + (v[j].z * v[j].z + v[j].w * v[j].w); }
            const float rstd = 1.f / sqrtf(wave_sum(s) * (1.f / DM) + EPS);
            GAS int* o8 = (GAS int*)((unsigned char*)H + (size_t)m * DM) + F.lane;
#pragma unroll
            for (int j = 0; j < 4; ++j) { const f32x4 y2 = v[j] * rstd * g2[j]; int w = 0; w = __builtin_amdgcn_cvt_pk_fp8_f32(y2.x, y2.y, w, false); w = __builtin_amdgcn_cvt_pk_fp8_f32(y2.z, y2.w, w, true); o8[64 * j] = w; }
        }
    }
#endif
    SEAM(6);

#if !defined(SKIP_P7)
    if (IN(7))
    {
        pg8::Gemm g{H, WUP, MTOK, DFF, DM, DM, DM}; pg8::StaticOrder S; S.init(MTOK, DFF, F.G, (int)blockIdx.x);
        pg8::EpiRelu2F8 E{(unsigned char*)U, 1.0f / 32.0f};
        pg8::gemm_phase<pg8::EpiRelu2F8, pg8::StaticOrder, true, true, 1>(F.lds + RING_OFF, g, S, E);
    }
#endif
    SEAM(7);

#if !defined(SKIP_P8)
    if (IN(8))
    {
        pg8::Gemm g{U, WDN, MTOK, DM, DFF, DFF, DFF}; pg8::StaticOrder S; S.init(MTOK, DM, F.G, (int)blockIdx.x);
        pg8::EpiSS E{H, SS3, LDH, 1.0f / 64.0f};
        pg8::gemm_phase<pg8::EpiSS, pg8::StaticOrder, true, true, 1, true>(F.lds + RING_OFF, g, S, E);
    }
#endif
    SEAM(8);

#if !defined(SKIP_P9)
    if (IN(9))
    {
        f32x4 g1[4];
#pragma unroll
        for (int j = 0; j < 4; ++j) g1[j] = ((const GAS f32x4*)g_post_mlp)[F.lane + 64 * j];
        for (int m = gw; m < MTOK; m += NGW) {
            const GAS f32x4* sp = (const GAS f32x4*)(SS3 + (size_t)m * 16); const f32x4 a = sp[0], b = sp[1], c = sp[2], d = sp[3];
            const float ssy = (((a.x + a.y) + (a.z + a.w)) + ((b.x + b.y) + (b.z + b.w))) + (((c.x + c.y) + (c.z + c.w)) + ((d.x + d.y) + (d.z + d.w)));
            const float rsy = 1.f / sqrtf(ssy * (1.f / DM) + EPS);
            const GAS unsigned long long* yr = (const GAS unsigned long long*)(H + (size_t)m * LDH) + F.lane;
            const GAS unsigned long long* xq = (const GAS unsigned long long*)(X1B + (size_t)m * DM) + F.lane;
            GAS f32x4* o4 = (GAS f32x4*)(out + (size_t)m * DM) + F.lane;
#pragma unroll
            for (int j = 0; j < 4; ++j) { const unsigned long long yw = yr[64 * j]; const unsigned lo = (unsigned)yw, hi = (unsigned)(yw >> 32);
                const f32x4 yv = (f32x4){__uint_as_float(lo << 16), __uint_as_float(lo & 0xffff0000u), __uint_as_float(hi << 16), __uint_as_float(hi & 0xffff0000u)};
                const unsigned long long xw = xq[64 * j]; const unsigned xl = (unsigned)xw, xh = (unsigned)(xw >> 32);
                const f32x4 xv = (f32x4){__uint_as_float(xl << 16), __uint_as_float(xl & 0xffff0000u), __uint_as_float(xh << 16), __uint_as_float(xh & 0xffff0000u)};
                o4[64 * j] = xv + yv * rsy * g1[j]; }
        }
    }
#endif
}

extern "C" void kernel_launch(void* const* d_in, const int* in_sizes, int n_in, void* d_out, int out_size, void* d_ws, size_t ws_size, hipStream_t stream) {
    static int grid = 0;
    if (grid == 0) {
        if (n_in != 17 || in_sizes[0] != MTOK * DM || out_size != MTOK * DM || ws_size < WS_END) { fprintf(stderr, "kernel_launch: unexpected shapes (n_in %d, in0 %d, out %d, ws %zu); nothing launched\n", n_in, n_in > 0 ? in_sizes[0] : -1, out_size, ws_size); grid = -1; return; }
        int dev = 0, cus = 0, per_cu = 0;
        if (hipGetDevice(&dev) != hipSuccess || hipDeviceGetAttribute(&cus, hipDeviceAttributeMultiprocessorCount, dev) != hipSuccess) { fprintf(stderr, "kernel_launch: device query failed\n"); grid = -1; return; }
        if (hipFuncSetAttribute((const void*)block_fwd, hipFuncAttributeMaxDynamicSharedMemorySize, LDS_BYTES) != hipSuccess) { fprintf(stderr, "kernel_launch: hipFuncSetAttribute failed\n"); grid = -1; return; }
        if (hipOccupancyMaxActiveBlocksPerMultiprocessor(&per_cu, (const void*)block_fwd, NWAVES * 64, LDS_BYTES) != hipSuccess || per_cu < 1) { fprintf(stderr, "kernel_launch: occupancy query reports %d workgroups per CU\n", per_cu); }
        (void)hipGetLastError();
        grid = cus;
    }
    if (grid < 0) return;
    if (hipMemsetAsync((char*)d_ws + WS_CTL, 0, CTL_ZERO_BYTES, stream) != hipSuccess) { fprintf(stderr, "kernel_launch: hipMemsetAsync failed\n"); return; }
    Args a{};
    for (int i = 0; i < 17; ++i) a.in[i] = (const float*)d_in[i];
    a.out = (float*)d_out; a.ws = (unsigned char*)d_ws;
    a.ph_lo = 0; a.ph_hi = 10; a.li = 0;
    hipLaunchKernelGGL(block_fwd, dim3(grid), dim3(NWAVES * 64), LDS_BYTES, stream, a);
    const hipError_t le = hipPeekAtLastError();
    if (le != hipSuccess) fprintf(stderr, "kernel_launch: launch failed: %s\n", hipGetErrorName(le));
}
```

```cpp
#include <hip/hip_runtime.h>
#include <hip/hip_bf16.h>
#include <cstdio>
#include <cstdint>
#include <cmath>
constexpr int NB = 32, SEQ = 2048, DM = 1024, MTOK = NB * SEQ;
constexpr int NHEAD = 8, HD = 64, AW = NHEAD * HD;
constexpr int QLORA = 384, KVLORA = 256, RDIM = 32, QKB = 96;
constexpr int DFF = 4096, INW = 4256, INWP = 4352;
constexpr int LDH = DM, LDU = DFF, LDKV = KVLORA;
constexpr float EPS = 1e-6f;
constexpr float LOG2E = 1.4426950408889634f;
constexpr float C2A = 0.125f * LOG2E;
constexpr float C2B = 0.10206207261596575f * LOG2E;
typedef float f32x2g __attribute__((ext_vector_type(2)));
namespace pg8 {
#define PG8_LAS __attribute__((address_space(3)))
typedef unsigned short bf16_t;
typedef short bf16x8 __attribute__((ext_vector_type(8)));
typedef float f32x4 __attribute__((ext_vector_type(4)));
typedef unsigned u32x4 __attribute__((ext_vector_type(4)));
constexpr int BM = 256, BK = 64, HALF = 128, HTB = HALF * BK * 2  , STAGE_BYTES = 8 * HTB, NXCD = 8, WGM = 8;

__host__ __device__ __forceinline__ int lds_byte(int r, int c) { const int st = (r >> 4) * 2 + (c >> 5), rr = r & 15, cc = c & 31, ob = rr * 64 + cc * 2; return st * 1024 + (ob ^ (((ob >> 9) & 1) << 5)); }
__host__ __device__ __forceinline__ void stage_rc(int b, int& R, int& C) { const int st = b / 1024, sb = b % 1024, swz = sb ^ (((sb >> 9) & 1) << 5); R = (st >> 1) * 16 + swz / 64; C = (st & 1) * 32 + (swz % 64) / 2; }
__host__ __device__ __forceinline__ int perm32(int rho) { const int n = rho >> 4, i = rho & 15; return 8 * (i >> 2) + 4 * n + (i & 3); }

struct Unit { int pm, pn; };
struct Gemm { const bf16_t* A; const bf16_t* Bt; int M, N, K, lda, ldb; };

struct StaticOrder {
    int nM, nN, nwg, G, c;
    __host__ __device__ void init(int M, int N, int G_, int c_) { nM = M / BM; nN = N / BM; nwg = nM * nN; G = G_; c = c_; }
    __host__ __device__ bool next(int i, Unit& u) const {
        const long L = (long)i * G + c; if (L >= nwg) return false;
        int wgid = (int)L; { const int q = nwg / NXCD, r = nwg % NXCD, xcd = wgid % NXCD, off = wgid / NXCD; wgid = (xcd < r ? xcd * (q + 1) : r * (q + 1) + (xcd - r) * q) + off; }
        const int nig = WGM * nN, gid = wgid / nig, fm = gid * WGM, gsz = (nM - fm) < WGM ? (nM - fm) : WGM;
        u.pm = fm + ((wgid % nig) % gsz); u.pn = (wgid % nig) / gsz; return true;
    }
    __device__ __forceinline__ void a_ready(const Unit&) const {}
    __device__ __forceinline__ void done(const Unit&) const {}
};

__device__ __forceinline__ unsigned cvt_pk_bf16(float lo, float hi) { unsigned r; asm volatile("v_cvt_pk_bf16_f32 %0, %1, %2" : "=v"(r) : "v"(lo), "v"(hi)); return r; }
__device__ __forceinline__ void ld8(float (&v)[8], const f32x4& a, const f32x4& b) { v[0] = a[0]; v[1] = a[1]; v[2] = a[2]; v[3] = a[3]; v[4] = b[0]; v[5] = b[1]; v[6] = b[2]; v[7] = b[3]; }
typedef float f32x2c_t __attribute__((ext_vector_type(2))); typedef __bf16 bf16x2c_t __attribute__((ext_vector_type(2)));
__device__ __forceinline__ unsigned cvtpk_c(float lo, float hi) { const f32x2c_t v = {lo, hi}; const bf16x2c_t b = __builtin_convertvector(v, bf16x2c_t); return __builtin_bit_cast(unsigned, b); }
__device__ __forceinline__ u32x4 pack8(const float (&v)[8]) { u32x4 w; w.x = cvtpk_c(v[0], v[1]); w.y = cvtpk_c(v[2], v[3]); w.z = cvtpk_c(v[4], v[5]); w.w = cvtpk_c(v[6], v[7]); return w; }
__device__ __forceinline__ void unpack8(const u32x4 w, float (&v)[8]) {
    v[0] = __uint_as_float(w.x << 16); v[1] = __uint_as_float(w.x & 0xffff0000u); v[2] = __uint_as_float(w.y << 16); v[3] = __uint_as_float(w.y & 0xffff0000u);
    v[4] = __uint_as_float(w.z << 16); v[5] = __uint_as_float(w.z & 0xffff0000u); v[6] = __uint_as_float(w.w << 16); v[7] = __uint_as_float(w.w & 0xffff0000u); }
__device__ __forceinline__ void rope4(float (&v)[8], const f32x4 a, const f32x4 b) {
    float x1, x2;
    x1 = v[0]; x2 = v[1]; v[0] = x1 * a[0] - x2 * a[1]; v[1] = x2 * a[0] + x1 * a[1];
    x1 = v[2]; x2 = v[3]; v[2] = x1 * a[2] - x2 * a[3]; v[3] = x2 * a[2] + x1 * a[3];
    x1 = v[4]; x2 = v[5]; v[4] = x1 * b[0] - x2 * b[1]; v[5] = x2 * b[0] + x1 * b[1];
    x1 = v[6]; x2 = v[7]; v[6] = x1 * b[2] - x2 * b[3]; v[7] = x2 * b[2] + x1 * b[3];
}
__device__ __forceinline__ float sumsq8(const float (&v)[8]) { return ((v[0] * v[0] + v[1] * v[1]) + (v[2] * v[2] + v[3] * v[3])) + ((v[4] * v[4] + v[5] * v[5]) + (v[6] * v[6] + v[7] * v[7])); }
__device__ __forceinline__ float red_fq(float s) { s += __shfl_xor(s, 16); s += __shfl_xor(s, 32); return s; }

__device__ __forceinline__ size_t chk_off(int r16, int c32, int ld) { return (size_t)r16 * ld + (size_t)c32 * 16; }
__device__ __forceinline__ size_t gfrag_off(int pm, int t8, int wid, int grp, int lane) { return ((((size_t)(pm * 8 + t8) * 8 + wid) * 16 + grp) * 64 + lane) * 8; }
struct EpiIn {
    static constexpr bool PERM = true, AFTER_DRAIN = false; static constexpr int MIDT = 0;
    bf16_t *QA, *KA, *VA, *CQ, *CKV, *KR, *G; float* SS; const float* ropeA; const float* ropeB; const float* bgate;
    __device__ __forceinline__ void operator()(const f32x4 (&acc)[2][2][4][2], const Unit& u, int wr, int wc, int fr, int fq) const {
        asm volatile("" : "+v"(fr), "+v"(fq));
        const int row0 = u.pm * BM + wr * 64 + fr, pn = u.pn, cl = wc * 32 + 8 * fq;
        if (pn < 4) {
            bf16_t* dst = (pn < 2) ? QA : KA; const float sc = (pn < 2) ? C2A : 1.f; const int cb = (pn & 1) * 256 + wc * 32, l8 = (fq * 16 + fr) * 8;
            if ((wc & 1) == 0) {
                const bool rp = fq < 2;
#pragma unroll
                for (int ai = 0; ai < 2; ++ai)
#pragma unroll
                    for (int m = 0; m < 4; ++m) { const int row = row0 + ai * HALF + m * 16;
                        const f32x4* t = (const f32x4*)(ropeA + (size_t)row * 16 + (rp ? fq * 8 : 0));
                        f32x4 ca = t[0], cc = t[1]; if (!rp) { ca = (f32x4){1.f, 0.f, 1.f, 0.f}; cc = ca; }
#pragma unroll
                        for (int bj = 0; bj < 2; ++bj) { float v[8]; ld8(v, acc[ai][bj][m][0], acc[ai][bj][m][1]); rope4(v, ca, cc);
#pragma unroll
                            for (int j = 0; j < 8; ++j) v[j] *= sc;
                            *(u32x4*)(dst + chk_off(row - fr, cb + bj * HALF, AW) + l8) = pack8(v); } }
            } else {
#pragma unroll
                for (int ai = 0; ai < 2; ++ai)
#pragma unroll
                    for (int m = 0; m < 4; ++m) { const int row = row0 + ai * HALF + m * 16;
#pragma unroll
                        for (int bj = 0; bj < 2; ++bj) { float v[8]; ld8(v, acc[ai][bj][m][0], acc[ai][bj][m][1]);
#pragma unroll
                            for (int j = 0; j < 8; ++j) v[j] *= sc;
                            *(u32x4*)(dst + chk_off(row - fr, cb + bj * HALF, AW) + l8) = pack8(v); } }
            }
        } else if (pn < 6) {
            const int cb = (pn - 4) * 256 + wc * 32, l8 = (fq * 16 + fr) * 8;
#pragma unroll
            for (int ai = 0; ai < 2; ++ai)
#pragma unroll
                for (int m = 0; m < 4; ++m) { const int row = row0 + ai * HALF + m * 16;
#pragma unroll
                    for (int bj = 0; bj < 2; ++bj) { float v[8]; ld8(v, acc[ai][bj][m][0], acc[ai][bj][m][1]); *(u32x4*)(VA + chk_off(row - fr, cb + bj * HALF, AW) + l8) = pack8(v); } }
        } else if (pn == 6 || pn == 8) {
            bf16_t* dst = (pn == 6) ? CQ : CKV; const int ld = (pn == 6) ? QLORA : LDKV, slot = ((pn == 6) ? 0 : 8) + wc;
#pragma unroll
            for (int ai = 0; ai < 2; ++ai)
#pragma unroll
                for (int m = 0; m < 4; ++m) { const int row = row0 + ai * HALF + m * 16; float s = 0.f;
#pragma unroll
                    for (int bj = 0; bj < 2; ++bj) { float v[8]; ld8(v, acc[ai][bj][m][0], acc[ai][bj][m][1]); s += sumsq8(v); *(u32x4*)(dst + chk_off(row - fr, wc * 32 + bj * HALF, ld) + (fq * 16 + fr) * 8) = pack8(v); }
                    s = red_fq(s); if (fq == 0) SS[(size_t)row * 12 + slot] = s; }
        } else if (pn == 7) {
#pragma unroll
            for (int ai = 0; ai < 2; ++ai)
#pragma unroll
                for (int m = 0; m < 4; ++m) { const int row = row0 + ai * HALF + m * 16;
                    { float v[8]; ld8(v, acc[ai][0][m][0], acc[ai][0][m][1]); float s = red_fq(sumsq8(v)); *(u32x4*)(CQ + chk_off(row - fr, 256 + wc * 32, QLORA) + (fq * 16 + fr) * 8) = pack8(v); if (fq == 0) SS[(size_t)row * 12 + 4 + wc] = s; }
                    if (wc == 0) { float v[8]; ld8(v, acc[ai][1][m][0], acc[ai][1][m][1]); const f32x4* t = (const f32x4*)(ropeB + (size_t)row * 32 + fq * 8); rope4(v, t[0], t[1]);
                        *(u32x4*)(KR + chk_off(row - fr, 0, RDIM) + (fq * 16 + fr) * 8) = pack8(v); } }
        }
    }
};
struct EpiGates {
    static constexpr bool PERM = true, AFTER_DRAIN = false; static constexpr int MIDT = 0;
    bf16_t* G; const float* bgate;
    __device__ __forceinline__ void operator()(const f32x4 (&acc)[2][2][4][2], const Unit& u, int wr, int wc, int fr, int fq) const {
        asm volatile("" : "+v"(fr), "+v"(fq));
        const int gc = u.pn * 256 + wc * 32 + 8 * fq;
        f32x4 bv[2][2];
#pragma unroll
        for (int bj = 0; bj < 2; ++bj)
#pragma unroll
            for (int n = 0; n < 2; ++n) bv[bj][n] = *(const f32x4*)(bgate + gc + bj * HALF + 4 * n);
#pragma unroll
        for (int ai = 0; ai < 2; ++ai)
#pragma unroll
            for (int m = 0; m < 4; ++m) {
#pragma unroll
                for (int bj = 0; bj < 2; ++bj) { float v[8]; ld8(v, acc[ai][bj][m][0] * (1.0f / 32.0f) + bv[bj][0], acc[ai][bj][m][1] * (1.0f / 32.0f) + bv[bj][1]);
#pragma unroll
                    for (int j = 0; j < 8; ++j) v[j] = __builtin_amdgcn_rcpf(1.f + __builtin_amdgcn_exp2f(-LOG2E * v[j]));
                    *(u32x4*)(G + gfrag_off(u.pm, u.pn, wr * 4 + wc, ai * 8 + m * 2 + bj, fq * 16 + fr)) = pack8(v); } }
    }
};
struct EpiQ {
    static constexpr bool PERM = true, AFTER_DRAIN = false; static constexpr int MIDT = 0;
    bf16_t* QB; const float* SS; const float* ropeB;
    __device__ __forceinline__ void operator()(const f32x4 (&acc)[2][2][4][2], const Unit& u, int wr, int wc, int fr, int fq) const {
        asm volatile("" : "+v"(fr), "+v"(fq));
        const int row0 = u.pm * BM + wr * 64 + fr, cl = u.pn * BM + wc * 32 + 8 * fq;
        const int c0 = cl, c1 = cl + HALF, h0 = c0 / QKB, h1 = c1 / QKB, p0 = c0 - h0 * QKB, p1 = c1 - h1 * QKB;
        const bool r0 = p0 >= 64, r1 = p1 >= 64; const int roff = r0 ? p0 - 64 : (r1 ? p1 - 64 : 0);
#pragma unroll
        for (int b = 0; b < 2; ++b) {
            f32x4 s0[4], s1[4], ta[4], tb[4];
#pragma unroll
            for (int m = 0; m < 4; ++m) { const int row = row0 + b * HALF + m * 16;
                const f32x4* sp = (const f32x4*)(SS + (size_t)row * 12); s0[m] = sp[0]; s1[m] = sp[1];
                const f32x4* t = (const f32x4*)(ropeB + (size_t)row * 32 + roff); ta[m] = t[0]; tb[m] = t[1]; }
            asm volatile("" ::: "memory");
#pragma unroll
            for (int m = 0; m < 4; ++m) { const int row = row0 + b * HALF + m * 16;
                const float ss = ((s0[m][0] + s0[m][1]) + (s0[m][2] + s0[m][3])) + ((s1[m][0] + s1[m][1]) + (s1[m][2] + s1[m][3]));
                const float rs = __builtin_amdgcn_rsqf(ss * (1.0f / QLORA) + EPS) * C2B;
#pragma unroll
                for (int bj = 0; bj < 2; ++bj) { float v[8]; ld8(v, acc[b][bj][m][0], acc[b][bj][m][1]);
#pragma unroll
                    for (int j = 0; j < 8; ++j) v[j] *= rs;
                    if (bj == 0 ? r0 : r1) rope4(v, ta[m], tb[m]);
                    *(u32x4*)(QB + chk_off(row - fr, (bj == 0 ? c0 : c1) - 8 * fq, NHEAD * QKB) + (fq * 16 + fr) * 8) = pack8(v); } }
        }
    }
};
struct EpiKV {
    static constexpr bool PERM = true, AFTER_DRAIN = false; static constexpr int MIDT = 0;
    bf16_t *KB, *VB; const float* SS;
    __device__ __forceinline__ void operator()(const f32x4 (&acc)[2][2][4][2], const Unit& u, int wr, int wc, int fr, int fq) const {
        asm volatile("" : "+v"(fr), "+v"(fq));
        const int row0 = u.pm * BM + wr * 64 + fr;
        bf16_t* dst = (wc < 2) ? KB : VB; const int pc = (wc & 1) * 32, l8 = (fq * 16 + fr) * 8;
        f32x4 s0[2][4];
#pragma unroll
        for (int ai = 0; ai < 2; ++ai)
#pragma unroll
            for (int m = 0; m < 4; ++m) s0[ai][m] = *(const f32x4*)(SS + (size_t)(row0 + ai * HALF + m * 16) * 12 + 8);
#pragma unroll
        for (int ai = 0; ai < 2; ++ai)
#pragma unroll
            for (int m = 0; m < 4; ++m) { const int row = row0 + ai * HALF + m * 16; const f32x4 sv = s0[ai][m];
                const float rs = __builtin_amdgcn_rsqf(((sv[0] + sv[1]) + (sv[2] + sv[3])) * (1.0f / KVLORA) + EPS);
#pragma unroll
                for (int bj = 0; bj < 2; ++bj) { const int hd = u.pn * 2 + bj;
                    float v[8]; ld8(v, acc[ai][bj][m][0], acc[ai][bj][m][1]);
#pragma unroll
                    for (int j = 0; j < 8; ++j) v[j] *= rs;
                    *(u32x4*)(dst + chk_off(row - fr, hd * HD + pc, AW) + l8) = pack8(v); } }
    }
};
struct EpiMerge {
    static constexpr bool PERM = true, AFTER_DRAIN = false; static constexpr int MIDT = 8;
    const bf16_t* G; bf16_t* T;
    __device__ __forceinline__ void mid(f32x4 (&acc)[2][2][4][2], const Unit& u, int wr, int wc, int fr, int fq) const {
        asm volatile("" : "+v"(fr), "+v"(fq));
        const bf16_t* pa = G + gfrag_off(u.pm, u.pn, wr * 4 + wc, 0, fq * 16 + fr); const bf16_t* pb = G + gfrag_off(u.pm, 4 + u.pn, wr * 4 + wc, 0, fq * 16 + fr);
        u32x4 ca[4], cb[4], na[4], nb[4];
#pragma unroll
        for (int i = 0; i < 4; ++i) { ca[i] = *(const u32x4*)(pa + (size_t)i * 512); cb[i] = *(const u32x4*)(pb + (size_t)i * 512); }
#pragma unroll
        for (int b = 0; b < 4; ++b) {
            if (b < 3) {
#pragma unroll
                for (int i = 0; i < 4; ++i) { na[i] = *(const u32x4*)(pa + (size_t)((b + 1) * 4 + i) * 512); nb[i] = *(const u32x4*)(pb + (size_t)((b + 1) * 4 + i) * 512); } }
            asm volatile("" ::: "memory");
#pragma unroll
            for (int i = 0; i < 4; ++i) { const int grp = b * 4 + i, ai = grp >> 3, m = (grp >> 1) & 3, bj = grp & 1; float ga[8], gb[8]; unpack8(ca[i], ga); unpack8(cb[i], gb);
#pragma unroll
                for (int j = 0; j < 8; ++j) ga[j] *= __builtin_amdgcn_rcpf(__builtin_fmaxf(gb[j], 1e-30f));
                acc[ai][bj][m][0] *= (f32x4){ga[0], ga[1], ga[2], ga[3]}; acc[ai][bj][m][1] *= (f32x4){ga[4], ga[5], ga[6], ga[7]}; }
#pragma unroll
            for (int i = 0; i < 4; ++i) { ca[i] = na[i]; cb[i] = nb[i]; }
        }
    }
    __device__ __forceinline__ void operator()(const f32x4 (&acc)[2][2][4][2], const Unit& u, int wr, int wc, int fr, int fq) const {
        asm volatile("" : "+v"(fr), "+v"(fq));
        const int r16 = u.pm * BM + wr * 64, c32 = u.pn * BM + wc * 32, l8 = (fq * 16 + fr) * 8;
        const bf16_t* pb = G + gfrag_off(u.pm, 4 + u.pn, wr * 4 + wc, 0, fq * 16 + fr);
        u32x4 cb[8], nb[8];
#pragma unroll
        for (int i = 0; i < 8; ++i) cb[i] = *(const u32x4*)(pb + (size_t)i * 512);
#pragma unroll
        for (int b = 0; b < 2; ++b) {
            if (b < 1) {
#pragma unroll
                for (int i = 0; i < 8; ++i) nb[i] = *(const u32x4*)(pb + (size_t)(8 + i) * 512); }
            asm volatile("" ::: "memory");
#pragma unroll
            for (int i = 0; i < 8; ++i) { const int grp = b * 8 + i, ai = grp >> 3, m = (grp >> 1) & 3, bj = grp & 1; float v[8], gb[8]; ld8(v, acc[ai][bj][m][0], acc[ai][bj][m][1]); unpack8(cb[i], gb);
#pragma unroll
                for (int j = 0; j < 8; ++j) v[j] *= __builtin_fmaxf(gb[j], 1e-30f);
                *(u32x4*)(T + chk_off(r16 + ai * HALF + m * 16, c32 + bj * HALF, LDH) + l8) = pack8(v); }
#pragma unroll
            for (int i = 0; i < 8; ++i) cb[i] = nb[i];
        }
    }
};
struct EpiSS {
    static constexpr bool PERM = true, AFTER_DRAIN = false; static constexpr int MIDT = 0;
    bf16_t* Y; float* SSY; int ldy; float scale;
    __device__ __forceinline__ void operator()(const f32x4 (&acc)[2][2][4][2], const Unit& u, int wr, int wc, int fr, int fq) const {
        asm volatile("" : "+v"(fr), "+v"(fq));
        const int row0 = u.pm * BM + wr * 64 + fr, cl = u.pn * BM + wc * 32 + 8 * fq;
#pragma unroll
        for (int ai = 0; ai < 2; ++ai)
#pragma unroll
            for (int m = 0; m < 4; ++m) { const int row = row0 + ai * HALF + m * 16; float s = 0.f;
#pragma unroll
                for (int bj = 0; bj < 2; ++bj) { float v[8]; ld8(v, acc[ai][bj][m][0] * scale, acc[ai][bj][m][1] * scale); s += sumsq8(v); *(u32x4*)(Y + (size_t)row * ldy + cl + bj * HALF) = pack8(v); }
                s = red_fq(s); if (fq == 0) SSY[(size_t)row * 16 + u.pn * 4 + wc] = s; }
    }
};
struct EpiRelu2F8 {
    static constexpr bool PERM = true, AFTER_DRAIN = false; static constexpr int MIDT = 0;
    unsigned char* U; float scale;
    __device__ __forceinline__ void operator()(const f32x4 (&acc)[2][2][4][2], const Unit& u, int wr, int wc, int fr, int fq) const {
        asm volatile("" : "+v"(fr), "+v"(fq));
        unsigned char* base = U + ((size_t)(u.pm * 16 + wr * 4) * 64 + u.pn * 4 + wc) * 1024 + (unsigned)(fq * 16 + fr) * 16u;
#pragma unroll
        for (int ai = 0; ai < 2; ++ai)
#pragma unroll
            for (int m = 0; m < 4; ++m) { int w[4];
#pragma unroll
                for (int bj = 0; bj < 2; ++bj) { float v[8]; ld8(v, acc[ai][bj][m][0], acc[ai][bj][m][1]);
#pragma unroll
                    for (int j = 0; j < 8; ++j) { const float r = __builtin_fmaxf(v[j] * scale, 0.f); v[j] = __builtin_fminf(r * r, 440.f); }
                    int w0 = 0, w1 = 0;
                    w0 = __builtin_amdgcn_cvt_pk_fp8_f32(v[0], v[1], w0, false); w0 = __builtin_amdgcn_cvt_pk_fp8_f32(v[2], v[3], w0, true);
                    w1 = __builtin_amdgcn_cvt_pk_fp8_f32(v[4], v[5], w1, false); w1 = __builtin_amdgcn_cvt_pk_fp8_f32(v[6], v[7], w1, true);
                    w[2 * bj] = w0; w[2 * bj + 1] = w1; }
                typedef int i32x4e_ __attribute__((ext_vector_type(4)));
                *(i32x4e_*)(base + (size_t)(ai * 8 + m) * 65536) = (i32x4e_){w[0], w[1], w[2], w[3]}; }
    }
};
struct EpiRelu2 {
    static constexpr bool PERM = true, AFTER_DRAIN = false; static constexpr int MIDT = 0;
    bf16_t* U;
    __device__ __forceinline__ void operator()(const f32x4 (&acc)[2][2][4][2], const Unit& u, int wr, int wc, int fr, int fq) const {
        asm volatile("" : "+v"(fr), "+v"(fq));
        const int row0 = u.pm * BM + wr * 64 + fr, cl = u.pn * BM + wc * 32 + 8 * fq;
#pragma unroll
        for (int ai = 0; ai < 2; ++ai)
#pragma unroll
            for (int m = 0; m < 4; ++m) { const int row = row0 + ai * HALF + m * 16;
#pragma unroll
                for (int bj = 0; bj < 2; ++bj) { float v[8]; ld8(v, acc[ai][bj][m][0], acc[ai][bj][m][1]);
#pragma unroll
                    for (int j = 0; j < 8; ++j) { const float r = __builtin_fmaxf(v[j], 0.f); v[j] = r * r; }
                    *(u32x4*)(U + (size_t)row * LDU + cl + bj * HALF) = pack8(v); } }
    }
};
template <class Epi, class Sched, bool ALIGN_EPI = false, bool SP2 = false, int ESZ = 2, bool ACH = false>
__device__ __forceinline__ void gemm_phase(PG8_LAS unsigned char* lds, const Gemm g, const Sched& S, const Epi& E) {
    int tid_ = threadIdx.x; asm volatile("" : "+v"(tid_));
    const int tid = tid_, wid = __builtin_amdgcn_readfirstlane(tid >> 6), lane = tid & 63, wr = wid >> 2, wc = wid & 3, fr = lane & 15, fq = lane >> 4;
    const int K = g.K, nt = K * ESZ / (BK * 2), lda = g.lda ? g.lda : K, ldb = g.ldb ? g.ldb : K;
    unsigned voffA[2], voffB[2];
#pragma unroll
    for (int i = 0; i < 2; ++i) { int R, C; stage_rc(tid * 16 + i * 8192, R, C); const int Rb = Epi::PERM ? ((R & ~31) + perm32(R & 31)) : R;
        if constexpr (ACH) { const int st_ = (tid >> 6) + 8 * i; voffA[i] = (unsigned)((st_ >> 1) * 16 * lda * ESZ + (st_ & 1) * 1024 + (tid & 63) * 16); } else voffA[i] = (unsigned)(R * lda * ESZ + C * 2);
        voffB[i] = (unsigned)(Rb * ldb * ESZ + C * 2); }
    const size_t kstepB = (size_t)(BK * 2), kstepA = ACH ? (size_t)2048 : kstepB;
    const size_t hstepA = (size_t)HALF * lda * ESZ, hstepB = (size_t)HALF * ldb * ESZ;
    const size_t tstepA = 2 * hstepA, tstepB = 2 * hstepB;
    const unsigned ldsw = (unsigned)wid * 1024u;
    const int aoff = ACH ? wr * 8192 + lane * 16 : lds_byte(wr * 64 + fr, fq * 8), boff = lds_byte(wc * 32 + fr, fq * 8);
#define PG8_SA(b, h) (((b) * 2 + (h)) * HTB)
#define PG8_SB(b, h) ((4 + (b) * 2 + (h)) * HTB)
#define PG8_STAGE(bufoff, gbase, voff) do { _Pragma("unroll") for (int _i = 0; _i < 2; ++_i) \
        __builtin_amdgcn_global_load_lds((const unsigned*)((const char*)(gbase) + (voff)[_i]), (PG8_LAS unsigned*)(lds + (bufoff) + ldsw + _i * 8192), 16, 0, 0); } while (0)
#define PG8_LDA(dst, b, h) do { if constexpr (ESZ == 2) { _Pragma("unroll") for (int m = 0; m < 4; ++m) _Pragma("unroll") for (int k = 0; k < 2; ++k) dst[m][k] = *(const PG8_LAS bf16x8*)(lds + PG8_SA(b, h) + aoff + m * 2048 + k * 1024); } \
        else { _Pragma("unroll") for (int m = 0; m < 4; ++m) { dst##8[m].lo = *(const PG8_LAS i32x4_*)(lds + PG8_SA(b, h) + aoff + m * 2048); dst##8[m].hi = *(const PG8_LAS i32x4_*)(lds + PG8_SA(b, h) + aoff + m * 2048 + 1024); } } } while (0)
#define PG8_LDB(dst, b, h) do { if constexpr (ESZ == 2) { _Pragma("unroll") for (int n = 0; n < 2; ++n) _Pragma("unroll") for (int k = 0; k < 2; ++k) dst[n][k] = *(const PG8_LAS bf16x8*)(lds + PG8_SB(b, h) + boff + n * 2048 + k * 1024); } \
        else { _Pragma("unroll") for (int n = 0; n < 2; ++n) { dst##8[n].lo = *(const PG8_LAS i32x4_*)(lds + PG8_SB(b, h) + boff + n * 2048); dst##8[n].hi = *(const PG8_LAS i32x4_*)(lds + PG8_SB(b, h) + boff + n * 2048 + 1024); } } } while (0)
#define PG8_MMA(ai, bj, At, Bt) do { __builtin_amdgcn_s_setprio(1); \
        if constexpr (ESZ == 2) { _Pragma("unroll") for (int m = 0; m < 4; ++m) _Pragma("unroll") for (int n = 0; n < 2; ++n) _Pragma("unroll") for (int k = 0; k < 2; ++k) \
            acc[ai][bj][m][n] = __builtin_amdgcn_mfma_f32_16x16x32_bf16(Bt[n][k], At[m][k], acc[ai][bj][m][n], 0, 0, 0); } \
        else {   \
            _Pragma("unroll") for (int m = 0; m < 4; ++m) _Pragma("unroll") for (int n = 0; n < 2; ++n) \
                asm volatile("v_mfma_scale_f32_16x16x128_f8f6f4 %0, %1, %2, %0, %3, %3 op_sel_hi:[0,0,0]" : "+v"(acc[ai][bj][m][n]) : "v"(Bt##8[n]), "v"(At##8[m]), "v"(scl_)); } \
        __builtin_amdgcn_s_setprio(0); } while (0)
#define PG8_WAIT_V(n) asm volatile("s_waitcnt vmcnt(" #n ")" ::: "memory")
#define PG8_WAIT_L(n) asm volatile("s_waitcnt lgkmcnt(" #n ")" ::: "memory")
#define PG8_BAR __builtin_amdgcn_s_barrier()
#define PG8_SCHED __builtin_amdgcn_sched_barrier(0)
    Unit cur, nxt; int ui = 0;
    if (!S.next(0, cur)) return;
    f32x4 acc[2][2][4][2];
#pragma unroll
    for (int a = 0; a < 2; ++a)
#pragma unroll
        for (int b = 0; b < 2; ++b)
#pragma unroll
            for (int m = 0; m < 4; ++m)
#pragma unroll
                for (int n = 0; n < 2; ++n) acc[a][b][m][n] = (f32x4){0.f, 0.f, 0.f, 0.f};
    bf16x8 At[4][2], B0[2][2], B1[2][2];
    typedef int i32x4_ __attribute__((ext_vector_type(4))); typedef int i32x8_ __attribute__((ext_vector_type(8)));
    const int scl_ = 0x7F7F7F7F;
    i32x8_ At8[4], B08[2], B18[2];
    const char* cA = (const char*)g.A + (size_t)cur.pm * tstepA; const char* cB = (const char*)g.Bt + (size_t)cur.pn * tstepB;
    S.a_ready(cur);
    if constexpr (SP2) {
        PG8_STAGE(PG8_SB(0, 0), cB, voffB); PG8_STAGE(PG8_SB(0, 1), cB + hstepB, voffB); PG8_STAGE(PG8_SA(0, 0), cA, voffA); PG8_STAGE(PG8_SA(0, 1), cA + hstepA, voffA);
        if (wr == 1) PG8_BAR;
        PG8_WAIT_V(2); PG8_BAR;
        PG8_STAGE(PG8_SB(1, 0), cB + kstepB, voffB); PG8_STAGE(PG8_SA(1, 0), cA + kstepA, voffA); PG8_STAGE(PG8_SB(1, 1), cB + hstepB + kstepB, voffB);
        PG8_WAIT_V(6); PG8_BAR;
    } else {
        PG8_STAGE(PG8_SB(0, 0), cB, voffB); PG8_STAGE(PG8_SA(0, 0), cA, voffA); PG8_STAGE(PG8_SB(0, 1), cB + hstepB, voffB); PG8_STAGE(PG8_SA(0, 1), cA + hstepA, voffA);
        if (wr == 1) PG8_BAR;
        PG8_WAIT_V(4); PG8_BAR;
        PG8_STAGE(PG8_SB(1, 0), cB + kstepB, voffB); PG8_STAGE(PG8_SA(1, 0), cA + kstepA, voffA); PG8_STAGE(PG8_SB(1, 1), cB + hstepB + kstepB, voffB);
        PG8_WAIT_V(6); PG8_BAR;
    }
    for (;;) {
        const bool has_next = S.next(ui + 1, nxt);
        const char* nA = has_next ? (const char*)g.A + (size_t)nxt.pm * tstepA : cA; const char* nB = has_next ? (const char*)g.Bt + (size_t)nxt.pn * tstepB : cB;
#pragma unroll 1
        for (int t = 0; t < nt; t += 2) {
            if constexpr (Epi::MIDT > 0) { if (t == Epi::MIDT) E.mid(acc, cur, wr, wc, fr, fq); }
            const bool last = (t == nt - 2);
            const char* a1 = cA + (size_t)(t + 1) * kstepA;
            const char* a2 = last ? nA : cA + (size_t)(t + 2) * kstepA; const char* b2 = last ? nB : cB + (size_t)(t + 2) * kstepB;
            const char* a3 = a2 + kstepA; const char* b3 = b2 + kstepB;
            if (last && has_next) S.a_ready(nxt);
            if constexpr (SP2) {
            PG8_LDB(B0, 0, 0); PG8_LDB(B1, 0, 1); PG8_SCHED; PG8_LDA(At, 0, 0); PG8_STAGE(PG8_SA(1, 1), a1 + hstepA, voffA);
            PG8_WAIT_V(8); PG8_WAIT_L(0); PG8_BAR; PG8_MMA(0, 0, At, B0); PG8_MMA(0, 1, At, B1); PG8_BAR; PG8_SCHED;
            PG8_LDA(At, 0, 1); PG8_STAGE(PG8_SB(0, 0), b2, voffB); PG8_STAGE(PG8_SB(0, 1), b2 + hstepB, voffB); PG8_STAGE(PG8_SA(0, 0), a2, voffA);
            PG8_WAIT_V(8); PG8_WAIT_L(0); PG8_BAR; PG8_MMA(1, 0, At, B0); PG8_MMA(1, 1, At, B1); PG8_BAR; PG8_SCHED;
            PG8_LDB(B0, 1, 0); PG8_LDB(B1, 1, 1); PG8_SCHED; PG8_LDA(At, 1, 0); PG8_STAGE(PG8_SA(0, 1), a2 + hstepA, voffA);
            PG8_WAIT_V(8); PG8_WAIT_L(0); PG8_BAR; PG8_MMA(0, 0, At, B0); PG8_MMA(0, 1, At, B1); PG8_BAR; PG8_SCHED;
            PG8_LDA(At, 1, 1); PG8_STAGE(PG8_SB(1, 0), b3, voffB); PG8_STAGE(PG8_SB(1, 1), b3 + hstepB, voffB); PG8_STAGE(PG8_SA(1, 0), a3, voffA);
            PG8_WAIT_V(8); PG8_WAIT_L(0); PG8_BAR; PG8_MMA(1, 0, At, B0); PG8_MMA(1, 1, At, B1); PG8_BAR; PG8_SCHED;
            } else {
            PG8_LDB(B0, 0, 0); PG8_SCHED; PG8_LDA(At, 0, 0); PG8_STAGE(PG8_SA(1, 1), a1 + hstepA, voffA);
            PG8_WAIT_L(8); PG8_BAR; PG8_WAIT_L(0); PG8_MMA(0, 0, At, B0); PG8_BAR; PG8_SCHED;
            PG8_LDB(B1, 0, 1); PG8_STAGE(PG8_SB(0, 0), b2, voffB);
            PG8_BAR; PG8_WAIT_L(0); PG8_MMA(0, 1, At, B1); PG8_BAR;
            PG8_LDA(At, 0, 1); PG8_STAGE(PG8_SA(0, 0), a2, voffA);
            PG8_BAR; PG8_WAIT_L(0); PG8_MMA(1, 0, At, B0); PG8_BAR; PG8_SCHED;
            PG8_STAGE(PG8_SB(0, 1), b2 + hstepB, voffB);
            PG8_WAIT_V(6); PG8_BAR; PG8_MMA(1, 1, At, B1); PG8_BAR;
            PG8_LDB(B0, 1, 0); PG8_SCHED; PG8_LDA(At, 1, 0); PG8_STAGE(PG8_SA(0, 1), a2 + hstepA, voffA);
            PG8_WAIT_L(8); PG8_BAR; PG8_WAIT_L(0); PG8_MMA(0, 0, At, B0); PG8_BAR; PG8_SCHED;
            PG8_LDB(B1, 1, 1); PG8_STAGE(PG8_SB(1, 0), b3, voffB);
            PG8_BAR; PG8_WAIT_L(0); PG8_MMA(0, 1, At, B1); PG8_BAR;
            PG8_LDA(At, 1, 1); PG8_STAGE(PG8_SA(1, 0), a3, voffA);
            PG8_BAR; PG8_WAIT_L(0); PG8_MMA(1, 0, At, B0); PG8_BAR; PG8_SCHED;
            PG8_STAGE(PG8_SB(1, 1), b3 + hstepB, voffB);
            PG8_WAIT_V(6); PG8_BAR; PG8_MMA(1, 1, At, B1); PG8_BAR;
            }
        }
        if constexpr (ALIGN_EPI) { if (wr == 0) PG8_BAR; }
        if constexpr (ESZ == 1) asm volatile("s_nop 15\n\ts_nop 15" ::: "memory");
        if constexpr (!Epi::AFTER_DRAIN) { E(acc, cur, wr, wc, fr, fq); S.done(cur); }
        if (!has_next) break;
#pragma unroll
        for (int a = 0; a < 2; ++a)
#pragma unroll
            for (int b = 0; b < 2; ++b)
#pragma unroll
                for (int m = 0; m < 4; ++m)
#pragma unroll
                    for (int n = 0; n < 2; ++n) acc[a][b][m][n] = (f32x4){0.f, 0.f, 0.f, 0.f};
        cur = nxt; cA = nA; cB = nB; ++ui;
        if constexpr (ALIGN_EPI) { if (wr == 1) PG8_BAR; }
    }
    PG8_WAIT_V(0);
    if constexpr (!ALIGN_EPI) { if (wr == 0) PG8_BAR; }
    PG8_BAR;
    if constexpr (Epi::AFTER_DRAIN) { E.fused(acc, cur, wr, wc, fr, fq, lds, wid, lane); S.done(cur); }
#undef PG8_SA
#undef PG8_SB
#undef PG8_STAGE
#undef PG8_LDA
#undef PG8_LDB
#undef PG8_MMA
#undef PG8_WAIT_V
#undef PG8_WAIT_L
#undef PG8_BAR
#undef PG8_SCHED
}
}
#ifndef ATT_LSUM_MFMA
#define ATT_LSUM_MFMA 1
#endif
namespace att {
typedef unsigned short bf16_t;
typedef short bf16x8 __attribute__((ext_vector_type(8)));
typedef short s16x4 __attribute__((ext_vector_type(4)));
typedef float f32x16 __attribute__((ext_vector_type(16)));
typedef float f32x4 __attribute__((ext_vector_type(4)));
typedef unsigned u32x4 __attribute__((ext_vector_type(4)));
#define ALDS __attribute__((address_space(3)))
#define ASBAR() __builtin_amdgcn_sched_barrier(0)
constexpr int KTB = 12288, VTB = 8192;
constexpr int NSLOT = 3;
constexpr int L_K = 0, L_V = NSLOT * KTB, L_WS = L_V + NSLOT * VTB, L_OST = L_WS + 8 * 256, L_KM = L_OST + 8 * 4096, L_RED = L_KM + 2048, L_END = L_RED + 16384;
constexpr float THR = 8.f;
__device__ __forceinline__ int crow(int r, int hi) { return (r & 3) + 8 * (r >> 2) + 4 * hi; }
typedef float f32x2a_t __attribute__((ext_vector_type(2))); typedef __bf16 bf16x2a_t __attribute__((ext_vector_type(2)));
__device__ __forceinline__ unsigned cvtpk(float lo, float hi) { const f32x2a_t v = {lo, hi}; const bf16x2a_t b = __builtin_convertvector(v, bf16x2a_t); return __builtin_bit_cast(unsigned, b); }
__device__ __forceinline__ float bf2f(short s) { return __uint_as_float(((unsigned)(unsigned short)s) << 16); }
__device__ __forceinline__ int v_st(int k, int c) { const int kk = (k & ~0xC) | ((k & 4) << 1) | ((k & 8) >> 1); return ((kk >> 3) * 2 + (c >> 5)) * 512 + ((kk & 7) * 32 + (c & 31)) * 2; }
__device__ __forceinline__ int v_rd_base(int lane) { return ((lane & 3) << 3) | (((lane >> 2) & 3) << 6) | (((lane >> 4) & 1) << 5) | (((lane >> 5) & 1) << 8); }
constexpr int v_rd_off(int d0, int ks, int half) { return ks * 2048 + half * 1024 + d0 * 512; }
template <int OFF> __device__ __forceinline__ s16x4 tr_read(int vb) { s16x4 r; asm volatile("ds_read_b64_tr_b16 %0, %1 offset:%2" : "=&v"(r) : "v"(vb), "i"(OFF) : "memory"); return r; }
template <int D0> __device__ __forceinline__ void pv_one(f32x16& od, int vb, bf16x8 pa0, bf16x8 pa1, bf16x8 pa2, bf16x8 pa3) {
    const s16x4 l0 = tr_read<v_rd_off(D0, 0, 0)>(vb), h0 = tr_read<v_rd_off(D0, 0, 1)>(vb), l1 = tr_read<v_rd_off(D0, 1, 0)>(vb), h1 = tr_read<v_rd_off(D0, 1, 1)>(vb);
    const s16x4 l2 = tr_read<v_rd_off(D0, 2, 0)>(vb), h2 = tr_read<v_rd_off(D0, 2, 1)>(vb), l3 = tr_read<v_rd_off(D0, 3, 0)>(vb), h3 = tr_read<v_rd_off(D0, 3, 1)>(vb);
    asm volatile("s_waitcnt lgkmcnt(0)" ::: "memory"); ASBAR();
#define ATT_PK(L, H) (bf16x8){L[0], L[1], L[2], L[3], H[0], H[1], H[2], H[3]}
    od = __builtin_amdgcn_mfma_f32_32x32x16_bf16(pa0, ATT_PK(l0, h0), od, 0, 0, 0);
    od = __builtin_amdgcn_mfma_f32_32x32x16_bf16(pa1, ATT_PK(l1, h1), od, 0, 0, 0);
    od = __builtin_amdgcn_mfma_f32_32x32x16_bf16(pa2, ATT_PK(l2, h2), od, 0, 0, 0);
    od = __builtin_amdgcn_mfma_f32_32x32x16_bf16(pa3, ATT_PK(l3, h3), od, 0, 0, 0);
#undef ATT_PK
}
__device__ __forceinline__ void pv_all(f32x16* o, f32x16& ol, int vb, bf16x8 pa0, bf16x8 pa1, bf16x8 pa2, bf16x8 pa3) {
    pv_one<0>(o[0], vb, pa0, pa1, pa2, pa3); pv_one<1>(o[1], vb, pa0, pa1, pa2, pa3);
#if ATT_LSUM_MFMA
    const bf16x8 ones = (bf16x8){0x3F80, 0x3F80, 0x3F80, 0x3F80, 0x3F80, 0x3F80, 0x3F80, 0x3F80};
    ol = __builtin_amdgcn_mfma_f32_32x32x16_bf16(pa0, ones, ol, 0, 0, 0); ol = __builtin_amdgcn_mfma_f32_32x32x16_bf16(pa1, ones, ol, 0, 0, 0);
    ol = __builtin_amdgcn_mfma_f32_32x32x16_bf16(pa2, ones, ol, 0, 0, 0); ol = __builtin_amdgcn_mfma_f32_32x32x16_bf16(pa3, ones, ol, 0, 0, 0);
#endif
}
__device__ __forceinline__ void partialSM(f32x16& p0, f32x16& p1, float& m_ref, f32x16& negm, float& alpha) {
    float pmax = p0[0];
#pragma unroll
    for (int r = 1; r < 16; ++r) pmax = fmaxf(pmax, p0[r]);
#pragma unroll
    for (int r = 0; r < 16; ++r) pmax = fmaxf(pmax, p1[r]);
    { auto rr = __builtin_amdgcn_permlane32_swap(__float_as_uint(pmax), __float_as_uint(pmax), false, false); pmax = fmaxf(__uint_as_float(rr[0]), __uint_as_float(rr[1])); }
    alpha = 1.f;
    if (__builtin_expect(!__all(pmax <= THR), 0)) { const float dl = (pmax > THR) ? pmax : 0.f; m_ref += dl; alpha = __builtin_amdgcn_exp2f(-dl);
#pragma unroll
        for (int r = 0; r < 16; ++r) { p0[r] -= dl; p1[r] -= dl; negm[r] = -m_ref; } }
#pragma unroll
    for (int r = 0; r < 16; ++r) p0[r] = __builtin_amdgcn_exp2f(p0[r]);
}
__device__ __forceinline__ void finishSM(f32x16& p0, f32x16& p1, bf16x8& pa0, bf16x8& pa1, bf16x8& pa2, bf16x8& pa3, float& lsum) {
#pragma unroll
    for (int r = 0; r < 16; ++r) p1[r] = __builtin_amdgcn_exp2f(p1[r]);
#if !ATT_LSUM_MFMA
    { float ps = 0.f;
#pragma unroll
      for (int r = 0; r < 16; ++r) ps += p0[r];
#pragma unroll
      for (int r = 0; r < 16; ++r) ps += p1[r];
      lsum += ps; }
#endif
#define ATT_PK4(P, BASE, OUT) do { unsigned a0 = cvtpk(P[BASE + 0], P[BASE + 1]), a1 = cvtpk(P[BASE + 2], P[BASE + 3]);   \
    unsigned b0 = cvtpk(P[BASE + 4], P[BASE + 5]), b1 = cvtpk(P[BASE + 6], P[BASE + 7]);                              \
    auto r0 = __builtin_amdgcn_permlane32_swap(a0, b0, false, false); auto r1 = __builtin_amdgcn_permlane32_swap(a1, b1, false, false); \
    u32x4 w = {r0[0], r1[0], r0[1], r1[1]}; OUT = __builtin_bit_cast(bf16x8, w); } while (0)
    ATT_PK4(p0, 0, pa0); ATT_PK4(p0, 8, pa1); ATT_PK4(p1, 0, pa2); ATT_PK4(p1, 8, pa3);
#undef ATT_PK4
}
template <int ND> __device__ __forceinline__ void qkt(f32x16& p0, f32x16& p1, ALDS const char* Kb, const int (&ka)[ND], const bf16x8 (&qr)[ND], const f32x16& cinit) {
#pragma unroll
    for (int d0 = 0; d0 < ND; ++d0) {
        const bf16x8 b0 = *(ALDS const bf16x8*)(Kb + ka[d0]);
        const bf16x8 b1 = *(ALDS const bf16x8*)(Kb + ka[d0] + (d0 < 4 ? 4096 : 2048));
        p0 = __builtin_amdgcn_mfma_f32_32x32x16_bf16(b0, qr[d0], d0 == 0 ? cinit : p0, 0, 0, 0);
        p1 = __builtin_amdgcn_mfma_f32_32x32x16_bf16(b1, qr[d0], d0 == 0 ? cinit : p1, 0, 0, 0);
        if (ND > 4 && d0 == 2) asm volatile("" ::: "memory"); }
}
__device__ __forceinline__ void cmask(f32x16& p0, f32x16& p1, int jt, int qrel, int hi) {
    const float NEG = -INFINITY; const int thr = qrel - 64 * jt - 4 * hi;
#pragma unroll
    for (int r = 0; r < 16; ++r) { if ((r & 3) + 8 * (r >> 2) > thr) p0[r] = NEG; if ((r & 3) + 8 * (r >> 2) + 32 > thr) p1[r] = NEG; }
}
__device__ __forceinline__ void kmean_blocks(const bf16_t* Kp, ALDS char* lds) {
    int tid_ = threadIdx.x; asm volatile("" : "+v"(tid_));
    const int tid = tid_, lane = tid & 63, wid = tid >> 6;
    ALDS float* red = (ALDS float*)(lds + L_RED); ALDS float* km = (ALDS float*)(lds + L_KM);
#pragma unroll 1
    for (int n = 0; n < 8; ++n) {
        float a[16];
#pragma unroll
        for (int j = 0; j < 16; ++j) a[j] = 0.f;
#pragma unroll
        for (int i = 0; i < 2; ++i)
#pragma unroll
            for (int cc = 0; cc < 2; ++cc) { const bf16x8 kx = *(const bf16x8*)(Kp + (size_t)(n * 256 + 128 * i + 16 * wid) * AW + cc * 512 + lane * 8);
#pragma unroll
                for (int j = 0; j < 8; ++j) a[cc * 8 + j] += bf2f(kx[j]); }
#pragma unroll
        for (int j = 0; j < 16; ++j) { a[j] += __shfl_xor(a[j], 1); a[j] += __shfl_xor(a[j], 2); a[j] += __shfl_xor(a[j], 4); a[j] += __shfl_xor(a[j], 8); }
        if ((lane & 15) == 0) {
#pragma unroll
            for (int j = 0; j < 16; ++j) red[(n * 8 + wid) * 64 + (j >> 3) * 32 + (lane >> 4) * 8 + (j & 7)] = a[j]; }
    }
    __syncthreads();
    { const int n = tid >> 6, d = tid & 63; float s = 0.f;
#pragma unroll
        for (int w = 0; w < 8; ++w) s += red[(n * 8 + w) * 64 + d];
        km[n * 64 + d] = s * (1.0f / 256.0f); }
    __syncthreads();
}
template <int DQK, bool MOBA>
__device__ __forceinline__ void attn_bh(const bf16_t* Qp, int ldq, const bf16_t* Kp, const bf16_t* KRp, const bf16_t* Vp, bf16_t* Op, int ldo, ALDS char* lds) {
    constexpr int ND = DQK / 16;
    ALDS char* K_lds = lds + L_K; ALDS char* V_lds = lds + L_V;
    bf16x8 sk0, sv0, sr0, sk1, sv1, sr1;
#define ATT_SLOAD(S, k0) do { sk##S = *(const bf16x8*)((const char*)(Kp + (size_t)(k0) * AW) + koff); sv##S = *(const bf16x8*)((const char*)(Vp + (size_t)(k0) * AW) + koff); if (DQK == 96) sr##S = *(const bf16x8*)((const char*)(KRp + (size_t)(k0) * RDIM) + roff); } while (0)
#define ATT_SWRITE(b, S) do { *(ALDS bf16x8*)(K_lds + (b) * KTB + kst) = sk##S; *(ALDS bf16x8*)(V_lds + (b) * VTB + vst) = sv##S; if (DQK == 96) { if (tid < 256) *(ALDS bf16x8*)(K_lds + (b) * KTB + rst) = sr##S; } } while (0)
#define ATT_QLOAD(q_) do { const bf16_t* Qw = Qp + (size_t)((q_) * 256 + wid * 32 + (r32 & 16)) * ldq + (r32 & 15) * 8 + hi * 128; _Pragma("unroll") for (int d0 = 0; d0 < ND; ++d0) qr[d0] = *(const bf16x8*)(Qw + (d0 >> 1) * 512 + (d0 & 1) * 256); } while (0)
    bf16x8 qr[ND];
    {
        const int tid = threadIdx.x, w_ = tid >> 6, l_ = tid & 63;
        const unsigned koff = (unsigned)((w_ >> 1) * 16 * AW + (w_ & 1) * 512 + l_ * 8) * 2u, roff = (unsigned)((w_ & 3) * 16 * RDIM + l_ * 8) * 2u;
        ATT_SLOAD(0, 0); ATT_SLOAD(1, 64); }
#pragma unroll 1
  for (int qb = 0; qb < 8; ++qb) {
    int tid_ = threadIdx.x; asm volatile("" : "+v"(tid_));
    const int tid = tid_, lane = tid & 63, r32 = lane & 31, hi = lane >> 5; const int wid = __builtin_amdgcn_readfirstlane(tid >> 6);
    ALDS float* al_l = (ALDS float*)(lds + L_WS) + wid * 64;
    const int skey = 16 * (wid >> 1) + (lane & 15), sch = 4 * (wid & 1) + (lane >> 4);
    const unsigned koff = (unsigned)((wid >> 1) * 16 * AW + (wid & 1) * 512 + lane * 8) * 2u;
    const int kst = skey * 128 + ((sch ^ ((skey >> 1) & 7)) << 4), vst = v_st(skey, sch * 8);
    const int rkey = 16 * (wid & 3) + (lane & 15), rch = lane >> 4;
    const unsigned roff = (unsigned)((wid & 3) * 16 * RDIM + lane * 8) * 2u;
    const int rst = 8192 + rkey * 64 + ((rch ^ ((rkey >> 2) & 3)) << 4);
    int ka[ND];
#pragma unroll
    for (int d0 = 0; d0 < ND; ++d0) ka[d0] = (d0 < 4) ? r32 * 128 + (((2 * d0 + hi) ^ ((r32 >> 1) & 7)) << 4) : 8192 + r32 * 64 + (((2 * (d0 - 4) + hi) ^ ((r32 >> 2) & 3)) << 4);
    const int vb0 = (int)(unsigned)(uintptr_t)V_lds + v_rd_base(lane);
    const int qrel = wid * 32 + r32;
    ATT_QLOAD(qb);
    float m_ref = 0.f, lsum = 0.f; f32x16 o[2], ol, negm; o[0] = f32x16{}; o[1] = f32x16{}; ol = f32x16{}; negm = f32x16{};
    unsigned sel = 0xffu;
    if (MOBA && qb > 3) {
        ALDS const float* km = (ALDS const float*)(lds + L_KM); float g[8];
#pragma unroll
        for (int n = 0; n < 8; ++n) { float s = 0.f;
#pragma unroll
            for (int d0 = 0; d0 < ND; ++d0)
#pragma unroll
                for (int j = 0; j < 8; ++j) s += bf2f(qr[d0][j]) * km[n * 64 + d0 * 16 + hi * 8 + j];
            g[n] = s; }
#pragma unroll
        for (int n = 0; n < 8; ++n) g[n] += __shfl_xor(g[n], 32);
        sel = 0u;
#pragma unroll
        for (int n = 0; n < 8; ++n) { int rank = 0;
#pragma unroll
            for (int mm = 0; mm < 8; ++mm) if (mm != n) rank += (mm < qb && (g[mm] > g[n] || (g[mm] == g[n] && mm < n))) ? 1 : 0;
            if (n < qb && rank < 3) sel |= 1u << n; }
    }
#define ATT_RESC(a) do { if (__any((a) < 1.f)) { lsum *= (a); if (hi == 0) al_l[r32] = (a); asm volatile("s_waitcnt lgkmcnt(0)" ::: "memory"); \
    _Pragma("unroll") for (int r = 0; r < 16; ++r) { const float f_ = al_l[crow(r, hi)]; o[0][r] *= f_; o[1][r] *= f_; ol[r] *= f_; } } } while (0)
    f32x16 pA0, pA1, pB0, pB1; float alA, alB; bf16x8 pa0, pa1, pa2, pa3; const int NT = 4 * (qb + 1), NP = 4 * qb;
    f32x16 cm = negm; const bool gated = MOBA && qb > 3;
#define ATT_CM(t) do { if (gated) { if ((t) < NP) { const float v_ = ((sel >> ((t) >> 2)) & 1u) ? -m_ref : -INFINITY; _Pragma("unroll") for (int r = 0; r < 16; ++r) cm[r] = v_; } else cm = negm; } else cm = negm; } while (0)
#define ATT_SCORE(P0, P1, t) do { ATT_CM(t); qkt<ND>(P0, P1, K_lds + sc * KTB, ka, qr, cm); if ((t) >= NP) cmask(P0, P1, (t) - NP, qrel, hi); } while (0)
    int sp = 0, sc = 0, sn = 1;
#define ATT_ROT() do { sp = sc; sc = sn; sn = (sn == NSLOT - 1) ? 0 : sn + 1; } while (0)
    ATT_SWRITE(0, 0); ATT_SLOAD(0, 128);
    __syncthreads(); ATT_SWRITE(sn, 1); ATT_SLOAD(1, 192);
    ATT_SCORE(pA0, pA1, 0); partialSM(pA0, pA1, m_ref, negm, alA);
    ATT_ROT();
    for (int t = 1; t + 1 < NT; t += 2) {
        __syncthreads(); ATT_SWRITE(sn, 0); if (t + 3 < NT) ATT_SLOAD(0, (t + 3) * 64);
        ASBAR(); ATT_SCORE(pB0, pB1, t);
        finishSM(pA0, pA1, pa0, pa1, pa2, pa3, lsum); ASBAR();
        pv_all(o, ol, vb0 + sp * VTB, pa0, pa1, pa2, pa3); partialSM(pB0, pB1, m_ref, negm, alB);
        ATT_RESC(alB); ATT_ROT();
        __syncthreads(); ATT_SWRITE(sn, 1); if (t + 4 < NT) ATT_SLOAD(1, (t + 4) * 64);
        ASBAR(); ATT_SCORE(pA0, pA1, t + 1);
        finishSM(pB0, pB1, pa0, pa1, pa2, pa3, lsum); ASBAR();
        pv_all(o, ol, vb0 + sp * VTB, pa0, pa1, pa2, pa3); partialSM(pA0, pA1, m_ref, negm, alA);
        ATT_RESC(alA); ATT_ROT();
    }
    __syncthreads();
    ASBAR(); ATT_SCORE(pB0, pB1, NT - 1);
    if (qb < 7) { ATT_SLOAD(0, 0); ATT_SLOAD(1, 64); }
    finishSM(pA0, pA1, pa0, pa1, pa2, pa3, lsum); ASBAR();
    pv_all(o, ol, vb0 + sp * VTB, pa0, pa1, pa2, pa3); partialSM(pB0, pB1, m_ref, negm, alB);
    ATT_RESC(alB);
    finishSM(pB0, pB1, pa0, pa1, pa2, pa3, lsum); ASBAR();
    pv_all(o, ol, vb0 + sc * VTB, pa0, pa1, pa2, pa3);
#undef ATT_ROT
#undef ATT_SCORE
#undef ATT_CM
    float rli[16];
#if ATT_LSUM_MFMA
#pragma unroll
    for (int r = 0; r < 16; ++r) rli[r] = __builtin_amdgcn_rcpf(ol[r]);
#else
    { auto rr = __builtin_amdgcn_permlane32_swap(__float_as_uint(lsum), __float_as_uint(lsum), false, false); lsum = __uint_as_float(rr[0]) + __uint_as_float(rr[1]); }
    if (hi == 0) al_l[32 + r32] = lsum; asm volatile("s_waitcnt lgkmcnt(0)" ::: "memory");
#pragma unroll
    for (int r = 0; r < 16; ++r) rli[r] = __builtin_amdgcn_rcpf(al_l[32 + crow(r, hi)]);
#endif
    { ALDS unsigned short* stg = (ALDS unsigned short*)(lds + L_OST) + wid * 2048;
#pragma unroll
      for (int r = 0; r < 16; ++r) { const int orow = crow(r, hi);
#pragma unroll
          for (int d0 = 0; d0 < 2; ++d0) stg[orow * 64 + d0 * 32 + r32] = (unsigned short)(cvtpk(o[d0][r] * rli[r], 0.f) & 0xffffu); }
      asm volatile("s_waitcnt lgkmcnt(0)" ::: "memory");
      bf16_t* Ow = Op + (size_t)(qb * 256 + wid * 32) * ldo;
#pragma unroll
      for (int i = 0; i < 4; ++i) { const int row = i * 8 + (lane >> 3), ch = lane & 7; const u32x4 v = *(ALDS const u32x4*)(stg + row * 64 + ch * 8); *(u32x4*)(Ow + (size_t)row * ldo + ch * 8) = v; } }
    __syncthreads();
  }
#undef ATT_SLOAD
#undef ATT_SWRITE
#undef ATT_QLOAD
#undef ATT_RESC
}

constexpr int MSLOT = 8192, M_K = 0, M_V = 3 * MSLOT, M_WS = 6 * MSLOT, M_OST = M_WS + 8 * 256, M_END = M_OST + 8 * 4096;
static_assert(M_END <= L_KM, "MoBA LDS map");
#define MPIN(x) asm volatile("" : "+v"(x))
#define MMFMA(a, b, c) __builtin_amdgcn_mfma_f32_32x32x16_bf16(a, b, c, 0, 0, 0)
#define MWAIT_BAR(N) asm volatile("s_waitcnt vmcnt(" #N ") lgkmcnt(0)\n\ts_barrier" ::: "memory")
__device__ __forceinline__ void m_kload2(bf16x8* kf, ALDS const char* kp, int d0) { kf[2 * d0] = *(ALDS const bf16x8*)(kp + d0 * 2048); kf[2 * d0 + 1] = *(ALDS const bf16x8*)(kp + d0 * 2048 + 512); }
typedef ALDS s16x4 lds_s16x4_t;
__device__ __forceinline__ s16x4 m_vtr(ALDS const char* p) { return __builtin_amdgcn_ds_read_tr16_b64_v4i16((lds_s16x4_t*)p); }
#define MMX3(a, b, c) __builtin_fmaxf(__builtin_fmaxf((a), (b)), (c))
__device__ __forceinline__ float m_rowmax(const f32x16& p0, const f32x16& p1) {
    float a = MMX3(p0[0], p0[1], p1[0]), b = MMX3(p0[2], p0[3], p1[1]); a = MMX3(a, p1[2], p1[3]);
#pragma unroll
    for (int r = 4; r < 16; r += 4) { a = MMX3(a, p0[r], p0[r + 1]); b = MMX3(b, p0[r + 2], p0[r + 3]); a = MMX3(a, p1[r], p1[r + 1]); b = MMX3(b, p1[r + 2], p1[r + 3]); }
    float m = __builtin_fmaxf(a, b); auto rr = __builtin_amdgcn_permlane32_swap(__float_as_uint(m), __float_as_uint(m), false, false);
    return __builtin_fmaxf(__uint_as_float(rr[0]), __uint_as_float(rr[1])); }
__device__ __forceinline__ void moba_unit(const bf16_t* Qp, const bf16_t* Kp, const bf16_t* Vp, bf16_t* Op, int ldo, int qb, ALDS char* lds) {
    int tid_ = threadIdx.x; asm volatile("" : "+v"(tid_));
    const int tid = tid_, lane = tid & 63, r32 = lane & 31, hi = lane >> 5; const int wid = __builtin_amdgcn_readfirstlane(tid >> 6);
    const int NT = 4 * qb + 4, NP = 4 * qb;
    ALDS float* wsf = (ALDS float*)(lds + M_WS) + wid * 64;
    const bf16_t* ksrc = Kp + (size_t)(lane >> 4) * 16 * AW + (wid >> 2) * 512 + (wid & 3) * 128 + (lane & 15) * 8;
    const bf16_t* vsrc = Vp + (size_t)(wid & 3) * 16 * AW + (wid >> 2) * 512 + (lane & 3) * 128 + (lane >> 2) * 8;
    ALDS char* kdst = lds + M_K + wid * 1024; ALDS char* vdst = lds + M_V + wid * 1024;
#define MDMA_K(t, slot) __builtin_amdgcn_global_load_lds((const unsigned*)(ksrc + (size_t)(t) * 64 * AW), (ALDS unsigned*)(kdst + (slot)), 16, 0, 0)
#define MDMA_V(t, slot) __builtin_amdgcn_global_load_lds((const unsigned*)(vsrc + (size_t)(t) * 64 * AW), (ALDS unsigned*)(vdst + (slot)), 16, 0, 0)
    ALDS const char* vp0 = lds + M_V + ((lane >> 4) & 1) * 32 + (lane & 3) * 8 + (4 * hi + ((lane & 15) >> 2)) * 64;
    ALDS const char* kp0 = lds + M_K + hi * 1024 + r32 * 16;
    MDMA_K(0, 0); MDMA_V(0, 0); MDMA_K(1, MSLOT);
    bf16x8 qr[4];
    { const bf16_t* Qw = Qp + (size_t)(qb * 256 + wid * 32 + (r32 & 16)) * AW + (r32 & 15) * 8 + hi * 128;
#pragma unroll
      for (int d0 = 0; d0 < 4; ++d0) qr[d0] = *(const bf16x8*)(Qw + (d0 >> 1) * 512 + (d0 & 1) * 256); }
    MDMA_K(2, 2 * MSLOT);
    float mhat = 0.f, l_reg = 0.f; f32x16 o[2]; o[0] = f32x16{}; o[1] = f32x16{};
    const int qrel = wid * 32 + r32; bool resc = false;
    unsigned sel = 0xffu; const bool gated = qb > 3;
    if (gated) {
        ALDS const float* km = (ALDS const float*)(lds + L_KM); float g[8];
#pragma unroll
        for (int n = 0; n < 8; ++n) { float sg = 0.f;
#pragma unroll
            for (int d0 = 0; d0 < 4; ++d0)
#pragma unroll
                for (int j = 0; j < 8; ++j) sg += bf2f(qr[d0][j]) * km[n * 64 + d0 * 16 + hi * 8 + j];
            g[n] = sg; }
#pragma unroll
        for (int n = 0; n < 8; ++n) g[n] += __shfl_xor(g[n], 32);
        sel = 0u;
#pragma unroll
        for (int n = 0; n < 8; ++n) { int rank = 0;
#pragma unroll
            for (int mm = 0; mm < 8; ++mm) if (mm != n) rank += (mm < qb && (g[mm] > g[n] || (g[mm] == g[n] && mm < n))) ? 1 : 0;
            if (n < qb && rank < 3) sel |= 1u << n; }
    }
    f32x16 cm;
#define MCM(t) do { const float v_ = (gated && (t) < NP && !((sel >> ((t) >> 2)) & 1u)) ? -INFINITY : -mhat; _Pragma("unroll") for (int r = 0; r < 16; ++r) cm[r] = v_; MPIN(cm); } while (0)
    MCM(0);
    f32x16 pA0, pA1, pB0, pB1; bf16x8 kf[8]; s16x4 vlo[8], vhi[8]; u32x4 pw0, pw1, pw2, pw3;
    int sl_prev = 0, sl_cur = 0, sl_next = MSLOT;
#define MROT() do { sl_prev = sl_cur; sl_cur = sl_next; sl_next = (sl_next == 2 * MSLOT) ? 0 : sl_next + MSLOT; } while (0)
#define MEX(v) __builtin_amdgcn_exp2f(v)
#define MRESC() do { if (resc) { _Pragma("unroll") for (int d_ = 0; d_ < 2; ++d_) _Pragma("unroll") for (int r = 0; r < 16; ++r) o[d_][r] *= wsf[crow(r, hi)]; } } while (0)
#define MDECIDE(C0, C1) do { const float rm = m_rowmax(C0, C1); resc = false; \
      if (__builtin_expect(__any(rm > THR), 0)) { const float dl = __builtin_fmaxf(rm, 0.f); mhat += dl; const float f = __builtin_amdgcn_exp2f(-dl); l_reg *= f; if (hi == 0) wsf[r32] = f; resc = true; \
          _Pragma("unroll") for (int r = 0; r < 16; ++r) { C0[r] -= dl; C1[r] -= dl; } } } while (0)
    MWAIT_BAR(3);
#pragma unroll
    for (int d0 = 0; d0 < 4; ++d0) m_kload2(kf, kp0, d0);
    pA0 = MMFMA(kf[0], qr[0], cm); pA1 = MMFMA(kf[1], qr[0], cm); pA0 = MMFMA(kf[2], qr[1], pA0); pA1 = MMFMA(kf[3], qr[1], pA1);
    pA0 = MMFMA(kf[4], qr[2], pA0); pA1 = MMFMA(kf[5], qr[2], pA1); pA0 = MMFMA(kf[6], qr[3], pA0); pA1 = MMFMA(kf[7], qr[3], pA1);
    if (NT == 4) cmask(pA0, pA1, 0, qrel, hi);
    MDECIDE(pA0, pA1);
#pragma unroll
    for (int r = 0; r < 16; ++r) { pA0[r] = MEX(pA0[r]); pA1[r] = MEX(pA1[r]); }
    MWAIT_BAR(0);
    MDMA_K(3, 0); MDMA_V(1, MSLOT); MROT();
#pragma unroll
    for (int d0 = 0; d0 < 4; ++d0) m_kload2(kf, kp0 + sl_cur, d0);
    MWAIT_BAR(2);
#define MPKW(P, i) cvtpk(P[i], P[i + 1])
#define MPAF(k) __builtin_bit_cast(bf16x8, pw##k)
#define MVFR(i) (bf16x8){vlo[i][0], vlo[i][1], vlo[i][2], vlo[i][3], vhi[i][0], vhi[i][1], vhi[i][2], vhi[i][3]}
#define MVRD(i) do { vlo[i] = m_vtr(vp_ + (((i) >> 2) * 4096 + ((i) & 3) * 1024)); vhi[i] = m_vtr(vp_ + (((i) >> 2) * 4096 + ((i) & 3) * 1024 + 512)); } while (0)
#define MKRD(G, d0) do { if (G) { m_kload2(kf, kp0 + sl_next, d0); ASBAR(); } } while (0)
#define MGAPA(MF, a0, a1, a2, a3, W0, W1, PW) do { MF; sacc += a0; sacc += a1; sacc += a2; sacc += a3; W0; W1; MPIN(PW); MPIN(sacc); ASBAR(); } while (0)
#define MGAPB(MF, X, i) do { MF; X[i] = MEX(X[i]); X[i + 1] = MEX(X[i + 1]); X[i + 2] = MEX(X[i + 2]); X[i + 3] = MEX(X[i + 3]); MPIN(X); ASBAR(); } while (0)
#define MSTEP(C0, C1, P0, P1, t, MASK, GK, GV, GL) do { ASBAR(); \
    const ALDS char* vp_ = vp0 + sl_prev; MCM(t); \
    MVRD(0); ASBAR(); float sacc = P0[0] + P0[1]; \
                     MGAPA(C0 = MMFMA(kf[0], qr[0], cm), P0[2], P0[3], P0[4], P0[5],     pw0[0] = MPKW(P0, 0),  pw0[1] = MPKW(P0, 2),  pw0); \
    MVRD(4); ASBAR(); MGAPA(C1 = MMFMA(kf[1], qr[0], cm), P0[6], P0[7], P0[8], P0[9],     pw0[2] = MPKW(P0, 4),  pw0[3] = MPKW(P0, 6),  pw0); \
    MVRD(1); ASBAR(); MGAPA(C0 = MMFMA(kf[2], qr[1], C0), P0[10], P0[11], P0[12], P0[13], pw1[0] = MPKW(P0, 8),  pw1[1] = MPKW(P0, 10), pw1); \
    MVRD(5); ASBAR(); MGAPA(C1 = MMFMA(kf[3], qr[1], C1), P0[14], P0[15], P1[0], P1[1],   pw1[2] = MPKW(P0, 12), pw1[3] = MPKW(P0, 14), pw1); \
    MVRD(2); ASBAR(); MGAPA(C0 = MMFMA(kf[4], qr[2], C0), P1[2], P1[3], P1[4], P1[5],     pw2[0] = MPKW(P1, 0),  pw2[1] = MPKW(P1, 2),  pw2); \
    MVRD(6); ASBAR(); MGAPA(C1 = MMFMA(kf[5], qr[2], C1), P1[6], P1[7], P1[8], P1[9],     pw2[2] = MPKW(P1, 4),  pw2[3] = MPKW(P1, 6),  pw2); \
    MVRD(3); ASBAR(); MGAPA(C0 = MMFMA(kf[6], qr[3], C0), P1[10], P1[11], P1[12], P1[13], pw3[0] = MPKW(P1, 8),  pw3[1] = MPKW(P1, 10), pw3); \
    MVRD(7); ASBAR(); MGAPA(C1 = MMFMA(kf[7], qr[3], C1), P1[14], P1[15], 0.f, 0.f,       pw3[2] = MPKW(P1, 12), pw3[3] = MPKW(P1, 14), pw3); \
    l_reg += sacc; \
    if (GK) MDMA_K((t) + 3, sl_cur); if (GV) MDMA_V((t) + 1, sl_next); \
    if (MASK) cmask(C0, C1, (t) - NP, qrel, hi); \
    MDECIDE(C0, C1); ASBAR(); \
    MGAPB(o[0] = MMFMA(MPAF(0), MVFR(0), o[0]), C0, 0);               MGAPB(o[1] = MMFMA(MPAF(0), MVFR(4), o[1]), C0, 4); \
    MKRD(GL, 0); MGAPB(o[0] = MMFMA(MPAF(1), MVFR(1), o[0]), C0, 8);  MKRD(GL, 1); MGAPB(o[1] = MMFMA(MPAF(1), MVFR(5), o[1]), C0, 12); \
    MKRD(GL, 2); MGAPB(o[0] = MMFMA(MPAF(2), MVFR(2), o[0]), C1, 0);  MKRD(GL, 3); MGAPB(o[1] = MMFMA(MPAF(2), MVFR(6), o[1]), C1, 4); \
    MGAPB(o[0] = MMFMA(MPAF(3), MVFR(3), o[0]), C1, 8);               MGAPB(o[1] = MMFMA(MPAF(3), MVFR(7), o[1]), C1, 12); \
    } while (0)
    int t = 1;
    for (; t + 5 < NT; t += 2) {
        MSTEP(pB0, pB1, pA0, pA1, t, false, true, true, true);     MWAIT_BAR(2); MRESC(); MROT();
        MSTEP(pA0, pA1, pB0, pB1, t + 1, false, true, true, true); MWAIT_BAR(2); MRESC(); MROT();
    }
#define MENDW(tt) do { if ((tt) + 3 < NT) { MWAIT_BAR(2); } else if ((tt) + 2 < NT) { MWAIT_BAR(1); } else { MWAIT_BAR(0); } } while (0)
    for (; t + 1 < NT; t += 2) {
        MSTEP(pB0, pB1, pA0, pA1, t, true, (t + 3 < NT), (t + 1 < NT), (t + 1 < NT));         MENDW(t);     MRESC(); MROT();
        MSTEP(pA0, pA1, pB0, pB1, t + 1, true, (t + 4 < NT), (t + 2 < NT), (t + 2 < NT));     MENDW(t + 1); MRESC(); MROT();
    }
    MSTEP(pB0, pB1, pA0, pA1, NT - 1, true, false, false, false); MRESC();
    { float sacc = pB0[0] + pB0[1];
#pragma unroll
      for (int r = 2; r < 16; ++r) sacc += pB0[r];
#pragma unroll
      for (int r = 0; r < 16; ++r) sacc += pB1[r];
      l_reg += sacc;
      pw0 = (u32x4){MPKW(pB0, 0), MPKW(pB0, 2), MPKW(pB0, 4), MPKW(pB0, 6)}; pw1 = (u32x4){MPKW(pB0, 8), MPKW(pB0, 10), MPKW(pB0, 12), MPKW(pB0, 14)};
      pw2 = (u32x4){MPKW(pB1, 0), MPKW(pB1, 2), MPKW(pB1, 4), MPKW(pB1, 6)}; pw3 = (u32x4){MPKW(pB1, 8), MPKW(pB1, 10), MPKW(pB1, 12), MPKW(pB1, 14)};
      const ALDS char* vp_ = vp0 + sl_cur;
#pragma unroll
      for (int i = 0; i < 8; ++i) MVRD(i);
      o[0] = MMFMA(MPAF(0), MVFR(0), o[0]); o[1] = MMFMA(MPAF(0), MVFR(4), o[1]); o[0] = MMFMA(MPAF(1), MVFR(1), o[0]); o[1] = MMFMA(MPAF(1), MVFR(5), o[1]);
      o[0] = MMFMA(MPAF(2), MVFR(2), o[0]); o[1] = MMFMA(MPAF(2), MVFR(6), o[1]); o[0] = MMFMA(MPAF(3), MVFR(3), o[0]); o[1] = MMFMA(MPAF(3), MVFR(7), o[1]); }
    { auto rr = __builtin_amdgcn_permlane32_swap(__float_as_uint(l_reg), __float_as_uint(l_reg), false, false); l_reg = __uint_as_float(rr[0]) + __uint_as_float(rr[1]); }
    if (hi == 0) wsf[32 + r32] = l_reg; asm volatile("s_waitcnt lgkmcnt(0)" ::: "memory");
    float rli[16];
#pragma unroll
    for (int r = 0; r < 16; ++r) rli[r] = __builtin_amdgcn_rcpf(wsf[32 + crow(r, hi)]);
    { ALDS unsigned short* stg = (ALDS unsigned short*)(lds + M_OST) + wid * 2048;
#pragma unroll
      for (int r = 0; r < 16; ++r) { const int orow = crow(r, hi);
#pragma unroll
          for (int d0 = 0; d0 < 2; ++d0) stg[orow * 64 + d0 * 32 + r32] = (unsigned short)(cvtpk(o[d0][r] * rli[r], 0.f) & 0xffffu); }
      asm volatile("s_waitcnt lgkmcnt(0)" ::: "memory");
      bf16_t* Ow = Op + (size_t)(qb * 256 + wid * 32) * ldo;
#pragma unroll
      for (int i = 0; i < 4; ++i) { const int row = i * 8 + (lane >> 3), ch = lane & 7; const u32x4 v = *(ALDS const u32x4*)(stg + row * 64 + ch * 8); *(u32x4*)(Ow + (size_t)row * ldo + ch * 8) = v; } }
    asm volatile("s_waitcnt lgkmcnt(0)\n\ts_barrier" ::: "memory");
#undef MDMA_K
#undef MDMA_V
#undef MCM
#undef MROT
#undef MEX
#undef MRESC
#undef MDECIDE
#undef MPKW
#undef MPAF
#undef MVFR
#undef MVRD
#undef MKRD
#undef MGAPA
#undef MGAPB
#undef MSTEP
#undef MENDW
}
#undef ASBAR
}
#define GAS __attribute__((address_space(1)))
#define LAS __attribute__((address_space(3)))
typedef unsigned short bf16;
typedef unsigned v4u __attribute__((ext_vector_type(4)));
typedef float f32x4 __attribute__((ext_vector_type(4)));
typedef short bf16x8 __attribute__((ext_vector_type(8)));
typedef GAS unsigned gu32;
typedef GAS unsigned long long gu64;
#define RLX_AGENT __ATOMIC_RELAXED, __HIP_MEMORY_SCOPE_AGENT
#define LDS_WAIT() asm volatile("s_waitcnt lgkmcnt(0)" ::: "memory")
#define VM_WAIT() asm volatile("s_waitcnt vmcnt(0)" ::: "memory")
__device__ __forceinline__ unsigned long long rt() { return __builtin_amdgcn_s_memrealtime(); }
__device__ __forceinline__ unsigned f2bf(float f) { unsigned u = __builtin_bit_cast(unsigned, f); return (u + 0x7fffu + ((u >> 16) & 1u)) >> 16; }
__device__ __forceinline__ unsigned pk2(float lo, float hi) { return f2bf(lo) | (f2bf(hi) << 16); }

#define XB_TMO      128
#define XB_XCNT(j)  (256  + 64 * (j))
#define XB_XSUB(j)  (1280 + 64 * (j))
#define XB_XGEN(j)  (2304 + 64 * (j))
#define XB_TOP      3328
#define XB_TOPGEN   3392
#define XCD_BAR_WORDS 3456
#define XB_SPIN_CAP (1u << 18)

__device__ __forceinline__ unsigned xb_ld(unsigned* p)              { return __hip_atomic_load(p, __ATOMIC_RELAXED, __HIP_MEMORY_SCOPE_AGENT); }
__device__ __forceinline__ unsigned xb_add(unsigned* p, unsigned v) { return __hip_atomic_fetch_add(p, v, __ATOMIC_RELAXED, __HIP_MEMORY_SCOPE_AGENT); }
__device__ __forceinline__ unsigned xb_xcc_id() { return (unsigned)__builtin_amdgcn_s_getreg((3 << 11) | 20) & 0xFu; }
#define XB_SPIN(cond, bar) do { unsigned _sp = 0; while (cond) { __builtin_amdgcn_s_sleep(1); \
    if ((++_sp & 255u) == 0u) { if (xb_ld(&(bar)[XB_TMO])) break; if (_sp > XB_SPIN_CAP) { atomicAdd(&(bar)[XB_TMO], 1u); break; } } } } while (0)

struct XcdBarrier {
    unsigned* bar; unsigned x;
    volatile LAS unsigned* st;
};

__device__ __forceinline__ XcdBarrier xcd_barrier_post(unsigned* bar, volatile LAS unsigned* st) {
    XcdBarrier b; b.bar = bar; b.x = xb_xcc_id(); b.st = st;
    if (threadIdx.x == 0) (void)xb_add(&bar[XB_XCNT(b.x)], 1u);
    return b;
}
__device__ __forceinline__ void xcd_barrier_complete(unsigned* bar, unsigned x, unsigned& nloc, unsigned& nx) {
    const unsigned G = gridDim.x * gridDim.y * gridDim.z;
    unsigned sum, cnt, mine, sp = 0u;
    for (;;) {
        sum = 0u; cnt = 0u; mine = 0u;
#pragma unroll
        for (unsigned j = 0; j < 16; ++j) { const unsigned c = xb_ld(&bar[XB_XCNT(j)]); sum += c; cnt += (c > 0u) ? 1u : 0u; mine = (j == x) ? c : mine; }
        if (sum == G) break;
        __builtin_amdgcn_s_sleep(1);
        if ((++sp & 255u) == 0u) { if (xb_ld(&bar[XB_TMO])) break; if (sp > XB_SPIN_CAP) { atomicAdd(&bar[XB_TMO], 1u); break; } }
    }
    nloc = mine > 0u ? mine : 1u; nx = cnt > 0u ? cnt : 1u;
}

__device__ __forceinline__ void xcd_barrier(const XcdBarrier& b) {
    asm volatile("s_waitcnt vmcnt(0)" ::: "memory");
    __syncthreads();
    if (threadIdx.x == 0) {
        unsigned* bar = b.bar;
        __builtin_amdgcn_s_waitcnt(0);
        unsigned nloc = b.st[0], nx = b.st[1];
        if (nloc == 0u) { xcd_barrier_complete(bar, b.x, nloc, nx); b.st[0] = nloc; b.st[1] = nx; }
        const unsigned old = xb_add(&bar[XB_XSUB(b.x)], 1u);
        const unsigned gen = old / nloc;
        if (old + 1u == (gen + 1u) * nloc) {
            __builtin_amdgcn_fence(__ATOMIC_RELEASE, "agent");
            asm volatile("s_waitcnt vmcnt(0)" ::: "memory");
            const unsigned og = xb_add(&bar[XB_TOP], 1u);
            const unsigned tg = og / nx;
            if (og + 1u == (tg + 1u) * nx) xb_add(&bar[XB_TOPGEN], 1u);
            else XB_SPIN(xb_ld(&bar[XB_TOPGEN]) == tg, bar);
            __builtin_amdgcn_fence(__ATOMIC_ACQUIRE, "agent");
            xb_add(&bar[XB_XGEN(b.x)], 1u);
            asm volatile("s_waitcnt vmcnt(0)" ::: "memory");
        } else {
            XB_SPIN(xb_ld(&bar[XB_XGEN(b.x)]) == gen, bar);
            __builtin_amdgcn_fence(__ATOMIC_ACQUIRE, "agent");
            asm volatile("s_waitcnt vmcnt(0)" ::: "memory");
        }
    }
    __syncthreads();
}

constexpr size_t MiB = 1u << 20;
constexpr size_t WS_CTL = 0, CTL_ZERO_BYTES = 64 * 1024;
constexpr size_t WS_ROPEA = 1 * MiB, WS_ROPEB = 5 * MiB;
constexpr size_t WS_SS = 13 * MiB, WS_SS2 = 16 * MiB, WS_SS3 = 20 * MiB;
constexpr size_t WS_WIN = 24 * MiB, WS_WUQ = 34 * MiB, WS_WUKV = 35 * MiB, WS_WA = 36 * MiB, WS_WOUT = 39 * MiB, WS_WUP = 42 * MiB, WS_WDN = 51 * MiB;
constexpr size_t WS_H = 64 * MiB;
constexpr size_t WS_G = 208 * MiB;
constexpr size_t WS_QA = 464 * MiB, WS_KA = 528 * MiB, WS_VA = 592 * MiB;
constexpr size_t WS_T = WS_KA;
constexpr size_t WS_CQ = 672 * MiB, WS_CKV = 720 * MiB;
constexpr size_t WS_KR = 760 * MiB;
constexpr size_t WS_QB = 768 * MiB, WS_KB = 864 * MiB, WS_VB = 928 * MiB;
constexpr size_t WS_Y = WS_QB;
constexpr size_t WS_X1 = 896 * MiB;
constexpr size_t WS_H8 = WS_QB;
constexpr size_t WS_WG8 = 60 * MiB;
constexpr size_t WS_U = 208 * MiB;
constexpr size_t WS_END = 1024 * MiB;
static_assert(WS_H + (size_t)MTOK * LDH * 2 <= WS_G && WS_G + (size_t)MTOK * 2 * DM * 2 <= WS_QA && WS_T + (size_t)MTOK * LDH * 2 <= WS_CQ && WS_CQ + (size_t)MTOK * QLORA * 2 <= WS_CKV && WS_CKV + (size_t)MTOK * LDKV * 2 <= WS_KR, "d_ws map");
static_assert(WS_U + (size_t)MTOK * LDU * 2 <= WS_KR && WS_Y + (size_t)MTOK * DM * 2 <= WS_X1 && WS_X1 + (size_t)MTOK * DM * 2 <= WS_END && WS_VB + (size_t)MTOK * AW * 2 <= WS_END && WS_KR + (size_t)MTOK * RDIM * 2 <= WS_QB, "d_ws map");
static_assert(WS_WIN + (size_t)INWP * LDH * 2 <= WS_WUQ && WS_WUKV + (size_t)1024 * LDKV * 2 <= WS_WA && WS_WA + (size_t)DM * LDH * 2 <= WS_WOUT && WS_WOUT + (size_t)DM * LDH * 2 <= WS_WUP && WS_WUP + (size_t)DFF * LDH * 2 <= WS_WDN && WS_WDN + (size_t)DM * LDU * 2 <= WS_H, "d_ws map");
constexpr int CW_BAR = 0;
constexpr int NWAVES = 8;
constexpr int RING_OFF = 0, RING_BYTES = 131072;
constexpr int LDSCTL_OFF = RING_BYTES, MISC_OFF = LDSCTL_OFF + 320;
constexpr int LDS_BYTES = 147456;
static_assert(att::L_END <= RING_BYTES, "attention LDS map");

struct Frame {
    LAS unsigned char* lds;
    volatile LAS unsigned* MISC;
    gu32* ctl;
    int tid, lane, wave, vcu, G;
};

__device__ __forceinline__ float wave_sum(float v) {
#pragma unroll
    for (int o = 1; o < 64; o <<= 1) v += __shfl_xor(v, o);
    return v;
}
__device__ __forceinline__ int srccol(int mat, int n) {
    if (mat == 0) {
        if (n < 1024) { const int sect = n >> 9, c = n & 511, head = c >> 6, p = c & 63; const int d = (p < 16) ? ((p >> 1) + 8 * (p & 1)) : p; return sect * 512 + head * 64 + d; }
        if (n < 1920) return n;
        if (n < 1952) { const int pr = n - 1920; return 2176 + (pr >> 1) + 16 * (pr & 1); }
        if (n < 2048) return -1;
        if (n < 2304) return 1920 + (n - 2048);
        return 2208 + (n - 2304);
    }
    if (mat == 1) { const int head = n / QKB, p = n - head * QKB; if (p < 64) return n; const int pr = p - 64; return head * QKB + 64 + (pr >> 1) + 16 * (pr & 1); }
    return n;
}
__device__ __forceinline__ void p0_transpose_item(const float* W, int K, int Nsrc, int Ndst, bf16* WT, int ldw, int koff, const float* gs, int mat, LAS float* scr, int item, int lane) {
    const int nblk = Ndst / 32, kb = item / nblk, nb = item % nblk, k0 = 64 * kb, n0 = 32 * nb;
    const int sc = srccol(mat, n0 + (lane & 31));
#pragma unroll 8
    for (int i = 0; i < 32; ++i) { const int kk = 2 * i + (lane >> 5); float v = (sc >= 0) ? W[(size_t)(k0 + kk) * Nsrc + sc] : 0.f; if (gs) v *= gs[k0 + kk]; scr[kk * 33 + (lane & 31)] = v; }
    LDS_WAIT(); asm volatile("" ::: "memory");
    const int c = lane & 7;
#pragma unroll
    for (int j = 0; j < 4; ++j) { const int n = (lane >> 3) + 8 * j; const LAS float* s = scr + (8 * c) * 33 + n;
        v4u o; o.x = pk2(s[0 * 33], s[1 * 33]); o.y = pk2(s[2 * 33], s[3 * 33]); o.z = pk2(s[4 * 33], s[5 * 33]); o.w = pk2(s[6 * 33], s[7 * 33]);
        *(GAS v4u*)(WT + (size_t)(n0 + n) * ldw + koff + k0 + 8 * c) = o; }
    LDS_WAIT(); asm volatile("" ::: "memory");
}
__device__ __forceinline__ int ppos_dn(int c) { return (c & ~255) | (((c >> 5) & 3) << 6) | (((c >> 3) & 3) << 4) | (((c >> 7) & 1) << 3) | (c & 7); }
template <bool KPERM = false>
__device__ __forceinline__ void p0_transpose_item_f8(const float* W, int K, int N, int Nsrc, int coff, unsigned char* WT, float scale, LAS float* scr, int item, int lane) {
    const int nblk = N / 32, kb = item / nblk, nb = item % nblk, k0 = 64 * kb, n0 = 32 * nb;
#pragma unroll 8
    for (int i = 0; i < 32; ++i) { const int kk = 2 * i + (lane >> 5); scr[kk * 33 + (lane & 31)] = W[(size_t)(k0 + kk) * Nsrc + coff + n0 + (lane & 31)] * scale; }
    LDS_WAIT(); asm volatile("" ::: "memory");
    const int c = lane & 7;
#pragma unroll
    for (int j = 0; j < 4; ++j) { const int n = (lane >> 3) + 8 * j; const LAS float* s = scr + (8 * c) * 33 + n;
        int w0 = 0, w1 = 0;
        w0 = __builtin_amdgcn_cvt_pk_fp8_f32(s[0 * 33], s[1 * 33], w0, false); w0 = __builtin_amdgcn_cvt_pk_fp8_f32(s[2 * 33], s[3 * 33], w0, true);
        w1 = __builtin_amdgcn_cvt_pk_fp8_f32(s[4 * 33], s[5 * 33], w1, false); w1 = __builtin_amdgcn_cvt_pk_fp8_f32(s[6 * 33], s[7 * 33], w1, true);
        typedef int i32x2_ __attribute__((ext_vector_type(2)));
        *(GAS i32x2_*)(WT + (size_t)(n0 + n) * K + (KPERM ? ppos_dn(k0 + 8 * c) : k0 + 8 * c)) = (i32x2_){w0, w1}; }
    LDS_WAIT(); asm volatile("" ::: "memory");
}
__device__ __forceinline__ void rms_row_to_bf16(int lane, const float* xrow, const f32x4 (&g)[4], bf16* orow, unsigned char* orow8) {
    const GAS f32x4* xr = (const GAS f32x4*)xrow + lane;
    f32x4 v[4]; float s = 0.f;
#pragma unroll
    for (int j = 0; j < 4; ++j) { v[j] = xr[64 * j]; s += (v[j].x * v[j].x + v[j].y * v[j].y) + (v[j].z * v[j].z + v[j].w * v[j].w); }
    const float rstd = 1.f / sqrtf(wave_sum(s) * (1.f / DM) + EPS);
    GAS unsigned long long* o8 = (GAS unsigned long long*)orow + lane;
#pragma unroll
    for (int j = 0; j < 4; ++j) { const f32x4 y = v[j] * rstd * g[j]; o8[64 * j] = (unsigned long long)pk2(y.x, y.y) | ((unsigned long long)pk2(y.z, y.w) << 32);
        int w = 0; w = __builtin_amdgcn_cvt_pk_fp8_f32(y.x, y.y, w, false); w = __builtin_amdgcn_cvt_pk_fp8_f32(y.z, y.w, w, true); ((GAS int*)orow8)[lane + 64 * j] = w; }
}

struct Args { const float* in[17]; float* out; unsigned char* ws; int ph_lo, ph_hi, li, pad; };

__global__ void __launch_bounds__(NWAVES * 64, 2) block_fwd(Args args) {
    extern __shared__ __attribute__((aligned(16))) unsigned char lds[];
    Frame F;
    F.lds = (LAS unsigned char*)lds;
    F.MISC = (volatile LAS unsigned*)(F.lds + MISC_OFF);
    F.tid = threadIdx.x; F.lane = F.tid & 63; F.wave = __builtin_amdgcn_readfirstlane(F.tid >> 6);
    F.G = gridDim.x; { const int bx = blockIdx.x; F.vcu = (F.G % 8 == 0) ? (bx % 8) * (F.G / 8) + bx / 8 : bx; }
    unsigned char* ws = args.ws;
    F.ctl = (gu32*)(ws + WS_CTL);
    const float* x = args.in[0]; const int* positions = (const int*)args.in[1];
    const float *g_pre_mix = args.in[2], *w_in = args.in[3], *b_gate = args.in[4], *g_q = args.in[5], *w_uq = args.in[6], *g_kv = args.in[7], *w_ukv = args.in[8], *w_a = args.in[9], *w_b = args.in[10],
                *w_out = args.in[11], *g_post_mix = args.in[12], *g_pre_mlp = args.in[13], *w_up = args.in[14], *w_dn = args.in[15], *g_post_mlp = args.in[16];
    float* out = args.out;
    float* ropeA = (float*)(ws + WS_ROPEA); float* ropeB = (float*)(ws + WS_ROPEB);
    float* SS = (float*)(ws + WS_SS); float* SS2 = (float*)(ws + WS_SS2); float* SS3 = (float*)(ws + WS_SS3);
    bf16 *WIN = (bf16*)(ws + WS_WIN), *WUQ = (bf16*)(ws + WS_WUQ), *WUKV = (bf16*)(ws + WS_WUKV), *WA = (bf16*)(ws + WS_WA), *WOUT = (bf16*)(ws + WS_WOUT), *WUP = (bf16*)(ws + WS_WUP), *WDN = (bf16*)(ws + WS_WDN);
    bf16 *H = (bf16*)(ws + WS_H), *Gt = (bf16*)(ws + WS_G), *QA = (bf16*)(ws + WS_QA), *KA = (bf16*)(ws + WS_KA), *VA = (bf16*)(ws + WS_VA), *T = (bf16*)(ws + WS_T), *CQ = (bf16*)(ws + WS_CQ), *CKV = (bf16*)(ws + WS_CKV),
         *KR = (bf16*)(ws + WS_KR), *QB = (bf16*)(ws + WS_QB), *KB = (bf16*)(ws + WS_KB), *VB = (bf16*)(ws + WS_VB), *Y = (bf16*)(ws + WS_Y), *U = (bf16*)(ws + WS_U), *X1B = (bf16*)(ws + WS_X1); unsigned char *H8 = ws + WS_H8, *WG8 = ws + WS_WG8;
    for (int u = F.tid; u < (LDS_BYTES - LDSCTL_OFF) / 4; u += NWAVES * 64) ((LAS unsigned*)(F.lds + LDSCTL_OFF))[u] = 0u;
    __syncthreads();
    XcdBarrier bar = xcd_barrier_post((unsigned*)(F.ctl + CW_BAR) + args.li * XCD_BAR_WORDS, F.MISC + 8);
    const int lo = args.ph_lo, hi = args.ph_hi;
#define IN(k) (lo <= (k) && (k) < hi)
#define SEAM(k) do { if (IN(k) && IN((k) + 1)) xcd_barrier(bar); } while (0)
    const int gw = F.vcu * NWAVES + F.wave, NGW = F.G * NWAVES;

#if !defined(SKIP_P0)
    if (IN(0))
    {
        LAS float* scr = (LAS float*)(F.lds + RING_OFF + F.wave * 16384);
        constexpr int NBF = 2304, IG = (DM / 64) * (2 * DM / 32);
        constexpr int I0 = (DM / 64) * (NBF / 32), I1 = (QLORA / 64) * (768 / 32), I2 = (KVLORA / 64) * (1024 / 32), I3 = (AW / 64) * (DM / 32), I5 = (DM / 64) * (DM / 32), I6 = (DM / 64) * (DFF / 32), I7 = (DFF / 64) * (DM / 32);
        constexpr int NITEMS = I0 + I1 + I2 + 2 * I3 + I5 + I6 + I7 + IG;
        for (int it = gw; it < NITEMS; it += NGW) {
            int r = it;
            if (r < I0) { p0_transpose_item(w_in, DM, INW, NBF, WIN, LDH, 0, nullptr, 0, scr, r, F.lane); continue; } r -= I0;
            if (r < IG) { p0_transpose_item_f8(w_in, DM, 2 * DM, INW, 2208, WG8, 32.f, scr, r, F.lane); continue; } r -= IG;
            if (r < I1) { p0_transpose_item(w_uq, QLORA, 768, 768, WUQ, QLORA, 0, g_q, 1, scr, r, F.lane); continue; } r -= I1;
            if (r < I2) { p0_transpose_item(w_ukv, KVLORA, 1024, 1024, WUKV, LDKV, 0, g_kv, 2, scr, r, F.lane); continue; } r -= I2;
            if (r < I3) { p0_transpose_item(w_a, AW, DM, DM, WA, LDH, 0, nullptr, 2, scr, r, F.lane); continue; } r -= I3;
            if (r < I3) { p0_transpose_item(w_b, AW, DM, DM, WA, LDH, AW, nullptr, 2, scr, r, F.lane); continue; } r -= I3;
            if (r < I5) { p0_transpose_item(w_out, DM, DM, DM, WOUT, LDH, 0, nullptr, 2, scr, r, F.lane); continue; } r -= I5;
            if (r < I6) { p0_transpose_item_f8(w_up, DM, DFF, DFF, 0, (unsigned char*)WUP, 32.f, scr, r, F.lane); continue; } r -= I6;
            p0_transpose_item_f8<true>(w_dn, DFF, DM, DM, 0, (unsigned char*)WDN, 64.f, scr, r, F.lane);
        }
        for (int idx = (int)blockIdx.x * (NWAVES * 64) + F.tid; idx < MTOK * 24; idx += F.G * NWAVES * 64) {
            const int m = idx / 24, i = idx - m * 24;
            const float invf = (i < 8) ? __builtin_amdgcn_exp2f(-(float)i * 2.3664460711655217f) : __builtin_amdgcn_exp2f(-(float)(i - 8) * 1.1832230355827609f);
            const float ang = (float)positions[m] * invf;
            double t = (double)ang * 0.15915494309189535; t -= floor(t);
            const float tf = (float)t; const float c = __builtin_amdgcn_cosf(tf), s = __builtin_amdgcn_sinf(tf);
            float* dst = (i < 8) ? ropeA + (size_t)m * 16 + 2 * i : ropeB + (size_t)m * 32 + 2 * (i - 8);
            *(f32x2g*)dst = (f32x2g){c, s};
        }
        f32x4 g[4];
#pragma unroll
        for (int j = 0; j < 4; ++j) g[j] = ((const GAS f32x4*)g_pre_mix)[F.lane + 64 * j];
        for (int m = gw; m < MTOK; m += NGW) rms_row_to_bf16(F.lane, x + (size_t)m * DM, g, H + (size_t)m * LDH, H8 + (size_t)m * DM);
    }
#endif
    SEAM(0);

#if !defined(SKIP_P1)
    if (IN(1))
    {
        { pg8::Gemm g{H, WIN, MTOK, 2304, DM, LDH, LDH}; pg8::StaticOrder S; S.init(MTOK, 2304, F.G, (int)blockIdx.x);
          pg8::EpiIn E{QA, KA, VA, CQ, CKV, KR, Gt, SS, ropeA, ropeB, b_gate};
          pg8::gemm_phase<pg8::EpiIn, pg8::StaticOrder, true, true>(F.lds + RING_OFF, g, S, E); }
        { pg8::Gemm g{(const bf16*)H8, (const bf16*)WG8, MTOK, 2 * DM, DM, DM, DM}; pg8::StaticOrder S; S.init(MTOK, 2 * DM, F.G, (int)blockIdx.x);
          pg8::EpiGates E{Gt, b_gate};
          pg8::gemm_phase<pg8::EpiGates, pg8::StaticOrder, true, true, 1>(F.lds + RING_OFF, g, S, E); }
    }
#endif
    SEAM(1);

#if !defined(SKIP_P2)
    if (IN(2)) {
    {
        pg8::Gemm g{CQ, WUQ, MTOK, NHEAD * QKB, QLORA}; pg8::StaticOrder S; S.init(MTOK, NHEAD * QKB, F.G, (int)blockIdx.x);
        pg8::EpiQ E{QB, SS, ropeB};
        pg8::gemm_phase<pg8::EpiQ, pg8::StaticOrder, true, true, 2, true>(F.lds + RING_OFF, g, S, E);
    }
    {
        pg8::Gemm g{CKV, WUKV, MTOK, 2 * AW, KVLORA, LDKV, LDKV}; pg8::StaticOrder S; S.init(MTOK, 2 * AW, F.G, (int)blockIdx.x);
        pg8::EpiKV E{KB, VB, SS};
        pg8::gemm_phase<pg8::EpiKV, pg8::StaticOrder, true, true, 2, true>(F.lds + RING_OFF, g, S, E);
    }
    }
#endif
    SEAM(2);

#if !defined(SKIP_P3)
    if (IN(3))
    {
        LAS char* al = (LAS char*)(F.lds + RING_OFF);
#if !defined(SKIP_MOBA)
        for (int bh = F.vcu; bh < NB * NHEAD; bh += F.G) {
            const int b = bh >> 3, h = bh & 7; const size_t r0 = (size_t)b * SEQ;
            att::kmean_blocks(KA + r0 * AW + h * HD * 16, al);
#pragma unroll 1
            for (int qb = 0; qb < 8; ++qb) att::moba_unit(QA + r0 * AW + h * HD * 16, KA + r0 * AW + h * HD * 16, VA + r0 * AW + h * HD * 16, H + r0 * LDH + h * HD, LDH, qb, al);
        }
#endif
#if !defined(SKIP_MLA)
        for (int bh = F.vcu; bh < NB * NHEAD; bh += F.G) {
            const int b = bh >> 3, h = bh & 7; const size_t r0 = (size_t)b * SEQ;
            att::attn_bh<96, false>(QB + r0 * (NHEAD * QKB) + h * QKB * 16, NHEAD * QKB, KB + r0 * AW + h * HD * 16, KR + r0 * RDIM, VB + r0 * AW + h * HD * 16, H + r0 * LDH + AW + h * HD, LDH, al);
        }
#endif
    }
#endif
    SEAM(3);

#if !defined(SKIP_P4)
    if (IN(4))
    {
        pg8::Gemm g{H, WA, MTOK, DM, DM, LDH, LDH}; pg8::StaticOrder S; S.init(MTOK, DM, F.G, (int)blockIdx.x);
        pg8::EpiMerge E{Gt, T};
        pg8::gemm_phase<pg8::EpiMerge, pg8::StaticOrder, true, true>(F.lds + RING_OFF, g, S, E);
    }
#endif
    SEAM(4);

#if !defined(SKIP_P5)
    if (IN(5))
    {
        pg8::Gemm g{T, WOUT, MTOK, DM, DM, LDH, LDH}; pg8::StaticOrder S; S.init(MTOK, DM, F.G, (int)blockIdx.x);
        pg8::EpiSS E{Y, SS2, DM, 1.0f};
        pg8::gemm_phase<pg8::EpiSS, pg8::StaticOrder, true, true, 2, true>(F.lds + RING_OFF, g, S, E);
    }
#endif
    SEAM(5);

#if !defined(SKIP_P6)
    if (IN(6))
    {
        f32x4 g1[4], g2[4];
#pragma unroll
        for (int j = 0; j < 4; ++j) { g1[j] = ((const GAS f32x4*)g_post_mix)[F.lane + 64 * j]; g2[j] = ((const GAS f32x4*)g_pre_mlp)[F.lane + 64 * j]; }
        for (int m = gw; m < MTOK; m += NGW) {
            const GAS f32x4* sp = (const GAS f32x4*)(SS2 + (size_t)m * 16); const f32x4 a = sp[0], b = sp[1], c = sp[2], d = sp[3];
            const float ssy = (((a.x + a.y) + (a.z + a.w)) + ((b.x + b.y) + (b.z + b.w))) + (((c.x + c.y) + (c.z + c.w)) + ((d.x + d.y) + (d.z + d.w)));
            const float rsy = 1.f / sqrtf(ssy * (1.f / DM) + EPS);
            const GAS f32x4* xr = (const GAS f32x4*)(x + (size_t)m * DM) + F.lane; const GAS unsigned long long* yr = (const GAS unsigned long long*)(Y + (size_t)m * DM) + F.lane;
            GAS unsigned long long* x8 = (GAS unsigned long long*)(X1B + (size_t)m * DM) + F.lane;
            f32x4 v[4]; float s = 0.f;
#pragma unroll
            for (int j = 0; j < 4; ++j) { const unsigned long long yw = yr[64 * j]; const unsigned lo = (unsigned)yw, hi = (unsigned)(yw >> 32);
                const f32x4 yv = (f32x4){__uint_as_float(lo << 16), __uint_as_float(lo & 0xffff0000u), __uint_as_float(hi << 16), __uint_as_float(hi & 0xffff0000u)};
                v[j] = xr[64 * j] + yv * rsy * g1[j]; x8[64 * j] = (unsigned long long)pk2(v[j].x, v[j].y) | ((unsigned long long)pk2(v[j].z, v[j].w) << 32);
                s += (v[j].x * v[j].x + v[j].y * v[j].y) + (v[j].z * v[j].z + v[j].w * v[j].w); }
            const float rstd = 1.f / sqrtf(wave_sum(s) * (1.f / DM) + EPS);
            GAS int* o8 = (GAS int*)((unsigned char*)H + (size_t)m * DM) + F.lane;
#pragma unroll
            for (int j = 0; j < 4; ++j) { const f32x4 y2 = v[j] * rstd * g2[j]; int w = 0; w = __builtin_amdgcn_cvt_pk_fp8_f32(y2.x, y2.y, w, false); w = __builtin_amdgcn_cvt_pk_fp8_f32(y2.z, y2.w, w, true); o8[64 * j] = w; }
        }
    }
#endif
    SEAM(6);

#if !defined(SKIP_P7)
    if (IN(7))
    {
        pg8::Gemm g{H, WUP, MTOK, DFF, DM, DM, DM}; pg8::StaticOrder S; S.init(MTOK, DFF, F.G, (int)blockIdx.x);
        pg8::EpiRelu2F8 E{(unsigned char*)U, 1.0f / 32.0f};
        pg8::gemm_phase<pg8::EpiRelu2F8, pg8::StaticOrder, true, true, 1>(F.lds + RING_OFF, g, S, E);
    }
#endif
    SEAM(7);

#if !defined(SKIP_P8)
    if (IN(8))
    {
        pg8::Gemm g{U, WDN, MTOK, DM, DFF, DFF, DFF}; pg8::StaticOrder S; S.init(MTOK, DM, F.G, (int)blockIdx.x);
        pg8::EpiSS E{H, SS3, LDH, 1.0f / 64.0f};
        pg8::gemm_phase<pg8::EpiSS, pg8::StaticOrder, true, true, 1, true>(F.lds + RING_OFF, g, S, E);
    }
#endif
    SEAM(8);

#if !defined(SKIP_P9)
    if (IN(9))
    {
        f32x4 g1[4];
#pragma unroll
        for (int j = 0; j < 4; ++j) g1[j] = ((const GAS f32x4*)g_post_mlp)[F.lane + 64 * j];
        for (int m = gw; m < MTOK; m += NGW) {
            const GAS f32x4* sp = (const GAS f32x4*)(SS3 + (size_t)m * 16); const f32x4 a = sp[0], b = sp[1], c = sp[2], d = sp[3];
            const float ssy = (((a.x + a.y) + (a.z + a.w)) + ((b.x + b.y) + (b.z + b.w))) + (((c.x + c.y) + (c.z + c.w)) + ((d.x + d.y) + (d.z + d.w)));
            const float rsy = 1.f / sqrtf(ssy * (1.f / DM) + EPS);
            const GAS unsigned long long* yr = (const GAS unsigned long long*)(H + (size_t)m * LDH) + F.lane;
            const GAS unsigned long long* xq = (const GAS unsigned long long*)(X1B + (size_t)m * DM) + F.lane;
            GAS f32x4* o4 = (GAS f32x4*)(out + (size_t)m * DM) + F.lane;
#pragma unroll
            for (int j = 0; j < 4; ++j) { const unsigned long long yw = yr[64 * j]; const unsigned lo = (unsigned)yw, hi = (unsigned)(yw >> 32);
                const f32x4 yv = (f32x4){__uint_as_float(lo << 16), __uint_as_float(lo & 0xffff0000u), __uint_as_float(hi << 16), __uint_as_float(hi & 0xffff0000u)};
                const unsigned long long xw = xq[64 * j]; const unsigned xl = (unsigned)xw, xh = (unsigned)(xw >> 32);
                const f32x4 xv = (f32x4){__uint_as_float(xl << 16), __uint_as_float(xl & 0xffff0000u), __uint_as_float(xh << 16), __uint_as_float(xh & 0xffff0000u)};
                o4[64 * j] = xv + yv * rsy * g1[j]; }
        }
    }
#endif
}

extern "C" void kernel_launch(void* const* d_in, const int* in_sizes, int n_in, void* d_out, int out_size, void* d_ws, size_t ws_size, hipStream_t stream) {
    static int grid = 0;
    if (grid == 0) {
        if (n_in != 17 || in_sizes[0] != MTOK * DM || out_size != MTOK * DM || ws_size < WS_END) { fprintf(stderr, "kernel_launch: unexpected shapes (n_in %d, in0 %d, out %d, ws %zu); nothing launched\n", n_in, n_in > 0 ? in_sizes[0] : -1, out_size, ws_size); grid = -1; return; }
        int dev = 0, cus = 0, per_cu = 0;
        if (hipGetDevice(&dev) != hipSuccess || hipDeviceGetAttribute(&cus, hipDeviceAttributeMultiprocessorCount, dev) != hipSuccess) { fprintf(stderr, "kernel_launch: device query failed\n"); grid = -1; return; }
        if (hipFuncSetAttribute((const void*)block_fwd, hipFuncAttributeMaxDynamicSharedMemorySize, LDS_BYTES) != hipSuccess) { fprintf(stderr, "kernel_launch: hipFuncSetAttribute failed\n"); grid = -1; return; }
        if (hipOccupancyMaxActiveBlocksPerMultiprocessor(&per_cu, (const void*)block_fwd, NWAVES * 64, LDS_BYTES) != hipSuccess || per_cu < 1) { fprintf(stderr, "kernel_launch: occupancy query reports %d workgroups per CU\n", per_cu); }
        (void)hipGetLastError();
        grid = cus;
    }
    if (grid < 0) return;
    if (hipMemsetAsync((char*)d_ws + WS_CTL, 0, CTL_ZERO_BYTES, stream) != hipSuccess) { fprintf(stderr, "kernel_launch: hipMemsetAsync failed\n"); return; }
    Args a{};
    for (int i = 0; i < 17; ++i) a.in[i] = (const float*)d_in[i];
    a.out = (float*)d_out; a.ws = (unsigned char*)d_ws;
    a.ph_lo = 0; a.ph_hi = 10; a.li = 0;
    hipLaunchKernelGGL(block_fwd, dim3(grid), dim3(NWAVES * 64), LDS_BYTES, stream, a);
    const hipError_t le = hipPeekAtLastError();
    if (le != hipSuccess) fprintf(stderr, "kernel_launch: launch failed: %s\n", hipGetErrorName(le));
}
```

```cpp
#include <hip/hip_runtime.h>
#include <hip/hip_bf16.h>
#include <cstdio>
#include <cstdint>
#include <cmath>
constexpr int NB = 32, SEQ = 2048, DM = 1024, MTOK = NB * SEQ;
constexpr int NHEAD = 8, HD = 64, AW = NHEAD * HD;
constexpr int QLORA = 384, KVLORA = 256, RDIM = 32, QKB = 96;
constexpr int DFF = 4096, INW = 4256, INWP = 4352;
constexpr int LDH = DM, LDU = DFF, LDKV = KVLORA;
constexpr float EPS = 1e-6f;
constexpr float LOG2E = 1.4426950408889634f;
constexpr float C2A = 0.125f * LOG2E;
constexpr float C2B = 0.10206207261596575f * LOG2E;
typedef float f32x2g __attribute__((ext_vector_type(2)));
namespace pg8 {
#define PG8_LAS __attribute__((address_space(3)))
typedef unsigned short bf16_t;
typedef short bf16x8 __attribute__((ext_vector_type(8)));
typedef float f32x4 __attribute__((ext_vector_type(4)));
typedef unsigned u32x4 __attribute__((ext_vector_type(4)));
constexpr int BM = 256, BK = 64, HALF = 128, HTB = HALF * BK * 2  , STAGE_BYTES = 8 * HTB, NXCD = 8, WGM = 8;

__host__ __device__ __forceinline__ int lds_byte(int r, int c) { const int st = (r >> 4) * 2 + (c >> 5), rr = r & 15, cc = c & 31, ob = rr * 64 + cc * 2; return st * 1024 + (ob ^ (((ob >> 9) & 1) << 5)); }
__host__ __device__ __forceinline__ void stage_rc(int b, int& R, int& C) { const int st = b / 1024, sb = b % 1024, swz = sb ^ (((sb >> 9) & 1) << 5); R = (st >> 1) * 16 + swz / 64; C = (st & 1) * 32 + (swz % 64) / 2; }
__host__ __device__ __forceinline__ int perm32(int rho) { const int n = rho >> 4, i = rho & 15; return 8 * (i >> 2) + 4 * n + (i & 3); }

struct Unit { int pm, pn; };
struct Gemm { const bf16_t* A; const bf16_t* Bt; int M, N, K, lda, ldb; };

struct StaticOrder {
    int nM, nN, nwg, G, c;
    __host__ __device__ void init(int M, int N, int G_, int c_) { nM = M / BM; nN = N / BM; nwg = nM * nN; G = G_; c = c_; }
    __host__ __device__ bool next(int i, Unit& u) const {
        const long L = (long)i * G + c; if (L >= nwg) return false;
        int wgid = (int)L; { const int q = nwg / NXCD, r = nwg % NXCD, xcd = wgid % NXCD, off = wgid / NXCD; wgid = (xcd < r ? xcd * (q + 1) : r * (q + 1) + (xcd - r) * q) + off; }
        const int nig = WGM * nN, gid = wgid / nig, fm = gid * WGM, gsz = (nM - fm) < WGM ? (nM - fm) : WGM;
        u.pm = fm + ((wgid % nig) % gsz); u.pn = (wgid % nig) / gsz; return true;
    }
    __device__ __forceinline__ void a_ready(const Unit&) const {}
    __device__ __forceinline__ void done(const Unit&) const {}
};

__device__ __forceinline__ unsigned cvt_pk_bf16(float lo, float hi) { unsigned r; asm volatile("v_cvt_pk_bf16_f32 %0, %1, %2" : "=v"(r) : "v"(lo), "v"(hi)); return r; }
__device__ __forceinline__ void ld8(float (&v)[8], const f32x4& a, const f32x4& b) { v[0] = a[0]; v[1] = a[1]; v[2] = a[2]; v[3] = a[3]; v[4] = b[0]; v[5] = b[1]; v[6] = b[2]; v[7] = b[3]; }
typedef float f32x2c_t __attribute__((ext_vector_type(2))); typedef __bf16 bf16x2c_t __attribute__((ext_vector_type(2)));
__device__ __forceinline__ unsigned cvtpk_c(float lo, float hi) { const f32x2c_t v = {lo, hi}; const bf16x2c_t b = __builtin_convertvector(v, bf16x2c_t); return __builtin_bit_cast(unsigned, b); }
__device__ __forceinline__ u32x4 pack8(const float (&v)[8]) { u32x4 w; w.x = cvtpk_c(v[0], v[1]); w.y = cvtpk_c(v[2], v[3]); w.z = cvtpk_c(v[4], v[5]); w.w = cvtpk_c(v[6], v[7]); return w; }
__device__ __forceinline__ void unpack8(const u32x4 w, float (&v)[8]) {
    v[0] = __uint_as_float(w.x << 16); v[1] = __uint_as_float(w.x & 0xffff0000u); v[2] = __uint_as_float(w.y << 16); v[3] = __uint_as_float(w.y & 0xffff0000u);
    v[4] = __uint_as_float(w.z << 16); v[5] = __uint_as_float(w.z & 0xffff0000u); v[6] = __uint_as_float(w.w << 16); v[7] = __uint_as_float(w.w & 0xffff0000u); }
__device__ __forceinline__ void rope4(float (&v)[8], const f32x4 a, const f32x4 b) {
    float x1, x2;
    x1 = v[0]; x2 = v[1]; v[0] = x1 * a[0] - x2 * a[1]; v[1] = x2 * a[0] + x1 * a[1];
    x1 = v[2]; x2 = v[3]; v[2] = x1 * a[2] - x2 * a[3]; v[3] = x2 * a[2] + x1 * a[3];
    x1 = v[4]; x2 = v[5]; v[4] = x1 * b[0] - x2 * b[1]; v[5] = x2 * b[0] + x1 * b[1];
    x1 = v[6]; x2 = v[7]; v[6] = x1 * b[2] - x2 * b[3]; v[7] = x2 * b[2] + x1 * b[3];
}
__device__ __forceinline__ float sumsq8(const float (&v)[8]) { return ((v[0] * v[0] + v[1] * v[1]) + (v[2] * v[2] + v[3] * v[3])) + ((v[4] * v[4] + v[5] * v[5]) + (v[6] * v[6] + v[7] * v[7])); }
__device__ __forceinline__ float red_fq(float s) { s += __shfl_xor(s, 16); s += __shfl_xor(s, 32); return s; }

__device__ __forceinline__ size_t chk_off(int r16, int c32, int ld) { return (size_t)r16 * ld + (size_t)c32 * 16; }
__device__ __forceinline__ size_t gfrag_off(int pm, int t8, int wid, int grp, int lane) { return ((((size_t)(pm * 8 + t8) * 8 + wid) * 16 + grp) * 64 + lane) * 8; }
struct EpiIn {
    static constexpr bool PERM = true, AFTER_DRAIN = false; static constexpr int MIDT = 0;
    bf16_t *QA, *KA, *VA, *CQ, *CKV, *KR, *G; float* SS; const float* ropeA; const float* ropeB; const float* bgate;
    __device__ __forceinline__ void operator()(const f32x4 (&acc)[2][2][4][2], const Unit& u, int wr, int wc, int fr, int fq) const {
        asm volatile("" : "+v"(fr), "+v"(fq));
        const int row0 = u.pm * BM + wr * 64 + fr, pn = u.pn, cl = wc * 32 + 8 * fq;
        if (pn < 4) {
            bf16_t* dst = (pn < 2) ? QA : KA; const float sc = (pn < 2) ? C2A : 1.f; const int cb = (pn & 1) * 256 + wc * 32, l8 = (fq * 16 + fr) * 8;
            if ((wc & 1) == 0) {
                const bool rp = fq < 2;
#pragma unroll
                for (int ai = 0; ai < 2; ++ai)
#pragma unroll
                    for (int m = 0; m < 4; ++m) { const int row = row0 + ai * HALF + m * 16;
                        const f32x4* t = (const f32x4*)(ropeA + (size_t)row * 16 + (rp ? fq * 8 : 0));
                        f32x4 ca = t[0], cc = t[1]; if (!rp) { ca = (f32x4){1.f, 0.f, 1.f, 0.f}; cc = ca; }
#pragma unroll
                        for (int bj = 0; bj < 2; ++bj) { float v[8]; ld8(v, acc[ai][bj][m][0], acc[ai][bj][m][1]); rope4(v, ca, cc);
#pragma unroll
                            for (int j = 0; j < 8; ++j) v[j] *= sc;
                            *(u32x4*)(dst + chk_off(row - fr, cb + bj * HALF, AW) + l8) = pack8(v); } }
            } else {
#pragma unroll
                for (int ai = 0; ai < 2; ++ai)
#pragma unroll
                    for (int m = 0; m < 4; ++m) { const int row = row0 + ai * HALF + m * 16;
#pragma unroll
                        for (int bj = 0; bj < 2; ++bj) { float v[8]; ld8(v, acc[ai][bj][m][0], acc[ai][bj][m][1]);
#pragma unroll
                            for (int j = 0; j < 8; ++j) v[j] *= sc;
                            *(u32x4*)(dst + chk_off(row - fr, cb + bj * HALF, AW) + l8) = pack8(v); } }
            }
        } else if (pn < 6) {
            const int cb = (pn - 4) * 256 + wc * 32, l8 = (fq * 16 + fr) * 8;
#pragma unroll
            for (int ai = 0; ai < 2; ++ai)
#pragma unroll
                for (int m = 0; m < 4; ++m) { const int row = row0 + ai * HALF + m * 16;
#pragma unroll
                    for (int bj = 0; bj < 2; ++bj) { float v[8]; ld8(v, acc[ai][bj][m][0], acc[ai][bj][m][1]); *(u32x4*)(VA + chk_off(row - fr, cb + bj * HALF, AW) + l8) = pack8(v); } }
        } else if (pn == 6 || pn == 8) {
            bf16_t* dst = (pn == 6) ? CQ : CKV; const int ld = (pn == 6) ? QLORA : LDKV, slot = ((pn == 6) ? 0 : 8) + wc;
#pragma unroll
            for (int ai = 0; ai < 2; ++ai)
#pragma unroll
                for (int m = 0; m < 4; ++m) { const int row = row0 + ai * HALF + m * 16; float s = 0.f;
#pragma unroll
                    for (int bj = 0; bj < 2; ++bj) { float v[8]; ld8(v, acc[ai][bj][m][0], acc[ai][bj][m][1]); s += sumsq8(v); *(u32x4*)(dst + chk_off(row - fr, wc * 32 + bj * HALF, ld) + (fq * 16 + fr) * 8) = pack8(v); }
                    s = red_fq(s); if (fq == 0) SS[(size_t)row * 12 + slot] = s; }
        } else if (pn == 7) {
#pragma unroll
            for (int ai = 0; ai < 2; ++ai)
#pragma unroll
                for (int m = 0; m < 4; ++m) { const int row = row0 + ai * HALF + m * 16;
                    { float v[8]; ld8(v, acc[ai][0][m][0], acc[ai][0][m][1]); float s = red_fq(sumsq8(v)); *(u32x4*)(CQ + chk_off(row - fr, 256 + wc * 32, QLORA) + (fq * 16 + fr) * 8) = pack8(v); if (fq == 0) SS[(size_t)row * 12 + 4 + wc] = s; }
                    if (wc == 0) { float v[8]; ld8(v, acc[ai][1][m][0], acc[ai][1][m][1]); const f32x4* t = (const f32x4*)(ropeB + (size_t)row * 32 + fq * 8); rope4(v, t[0], t[1]);
                        *(u32x4*)(KR + chk_off(row - fr, 0, RDIM) + (fq * 16 + fr) * 8) = pack8(v); } }
        }
    }
};
struct EpiGates {
    static constexpr bool PERM = true, AFTER_DRAIN = false; static constexpr int MIDT = 0;
    bf16_t* G; const float* bgate;
    __device__ __forceinline__ void operator()(const f32x4 (&acc)[2][2][4][2], const Unit& u, int wr, int wc, int fr, int fq) const {
        asm volatile("" : "+v"(fr), "+v"(fq));
        const int gc = u.pn * 256 + wc * 32 + 8 * fq;
        f32x4 bv[2][2];
#pragma unroll
        for (int bj = 0; bj < 2; ++bj)
#pragma unroll
            for (int n = 0; n < 2; ++n) bv[bj][n] = *(const f32x4*)(bgate + gc + bj * HALF + 4 * n);
#pragma unroll
        for (int ai = 0; ai < 2; ++ai)
#pragma unroll
            for (int m = 0; m < 4; ++m) {
#pragma unroll
                for (int bj = 0; bj < 2; ++bj) { float v[8]; ld8(v, acc[ai][bj][m][0] * (1.0f / 32.0f) + bv[bj][0], acc[ai][bj][m][1] * (1.0f / 32.0f) + bv[bj][1]);
#pragma unroll
                    for (int j = 0; j < 8; ++j) v[j] = __builtin_amdgcn_rcpf(1.f + __builtin_amdgcn_exp2f(-LOG2E * v[j]));
                    *(u32x4*)(G + gfrag_off(u.pm, u.pn, wr * 4 + wc, ai * 8 + m * 2 + bj, fq * 16 + fr)) = pack8(v); } }
    }
};
struct EpiQ {
    static constexpr bool PERM = true, AFTER_DRAIN = false; static constexpr int MIDT = 0;
    bf16_t* QB; const float* SS; const float* ropeB;
    __device__ __forceinline__ void operator()(const f32x4 (&acc)[2][2][4][2], const Unit& u, int wr, int wc, int fr, int fq) const {
        asm volatile("" : "+v"(fr), "+v"(fq));
        const int row0 = u.pm * BM + wr * 64 + fr, cl = u.pn * BM + wc * 32 + 8 * fq;
        const int c0 = cl, c1 = cl + HALF, h0 = c0 / QKB, h1 = c1 / QKB, p0 = c0 - h0 * QKB, p1 = c1 - h1 * QKB;
        const bool r0 = p0 >= 64, r1 = p1 >= 64; const int roff = r0 ? p0 - 64 : (r1 ? p1 - 64 : 0);
#pragma unroll
        for (int b = 0; b < 2; ++b) {
            f32x4 s0[4], s1[4], ta[4], tb[4];
#pragma unroll
            for (int m = 0; m < 4; ++m) { const int row = row0 + b * HALF + m * 16;
                const f32x4* sp = (const f32x4*)(SS + (size_t)row * 12); s0[m] = sp[0]; s1[m] = sp[1];
                const f32x4* t = (const f32x4*)(ropeB + (size_t)row * 32 + roff); ta[m] = t[0]; tb[m] = t[1]; }
            asm volatile("" ::: "memory");
#pragma unroll
            for (int m = 0; m < 4; ++m) { const int row = row0 + b * HALF + m * 16;
                const float ss = ((s0[m][0] + s0[m][1]) + (s0[m][2] + s0[m][3])) + ((s1[m][0] + s1[m][1]) + (s1[m][2] + s1[m][3]));
                const float rs = __builtin_amdgcn_rsqf(ss * (1.0f / QLORA) + EPS) * C2B;
#pragma unroll
                for (int bj = 0; bj < 2; ++bj) { float v[8]; ld8(v, acc[b][bj][m][0], acc[b][bj][m][1]);
#pragma unroll
                    for (int j = 0; j < 8; ++j) v[j] *= rs;
                    if (bj == 0 ? r0 : r1) rope4(v, ta[m], tb[m]);
                    *(u32x4*)(QB + chk_off(row - fr, (bj == 0 ? c0 : c1) - 8 * fq, NHEAD * QKB) + (fq * 16 + fr) * 8) = pack8(v); } }
        }
    }
};
struct EpiKV {
    static constexpr bool PERM = true, AFTER_DRAIN = false; static constexpr int MIDT = 0;
    bf16_t *KB, *VB; const float* SS;
    __device__ __forceinline__ void operator()(const f32x4 (&acc)[2][2][4][2], const Unit& u, int wr, int wc, int fr, int fq) const {
        asm volatile("" : "+v"(fr), "+v"(fq));
        const int row0 = u.pm * BM + wr * 64 + fr;
        bf16_t* dst = (wc < 2) ? KB : VB; const int pc = (wc & 1) * 32, l8 = (fq * 16 + fr) * 8;
        f32x4 s0[2][4];
#pragma unroll
        for (int ai = 0; ai < 2; ++ai)
#pragma unroll
            for (int m = 0; m < 4; ++m) s0[ai][m] = *(const f32x4*)(SS + (size_t)(row0 + ai * HALF + m * 16) * 12 + 8);
#pragma unroll
        for (int ai = 0; ai < 2; ++ai)
#pragma unroll
            for (int m = 0; m < 4; ++m) { const int row = row0 + ai * HALF + m * 16; const f32x4 sv = s0[ai][m];
                const float rs = __builtin_amdgcn_rsqf(((sv[0] + sv[1]) + (sv[2] + sv[3])) * (1.0f / KVLORA) + EPS);
#pragma unroll
                for (int bj = 0; bj < 2; ++bj) { const int hd = u.pn * 2 + bj;
                    float v[8]; ld8(v, acc[ai][bj][m][0], acc[ai][bj][m][1]);
#pragma unroll
                    for (int j = 0; j < 8; ++j) v[j] *= rs;
                    *(u32x4*)(dst + chk_off(row - fr, hd * HD + pc, AW) + l8) = pack8(v); } }
    }
};
struct EpiMerge {
    static constexpr bool PERM = true, AFTER_DRAIN = false; static constexpr int MIDT = 8;
    const bf16_t* G; bf16_t* T;
    __device__ __forceinline__ void mid(f32x4 (&acc)[2][2][4][2], const Unit& u, int wr, int wc, int fr, int fq) const {
        asm volatile("" : "+v"(fr), "+v"(fq));
        const bf16_t* pa = G + gfrag_off(u.pm, u.pn, wr * 4 + wc, 0, fq * 16 + fr); const bf16_t* pb = G + gfrag_off(u.pm, 4 + u.pn, wr * 4 + wc, 0, fq * 16 + fr);
        u32x4 ca[4], cb[4], na[4], nb[4];
#pragma unroll
        for (int i = 0; i < 4; ++i) { ca[i] = *(const u32x4*)(pa + (size_t)i * 512); cb[i] = *(const u32x4*)(pb + (size_t)i * 512); }
#pragma unroll
        for (int b = 0; b < 4; ++b) {
            if (b < 3) {
#pragma unroll
                for (int i = 0; i < 4; ++i) { na[i] = *(const u32x4*)(pa + (size_t)((b + 1) * 4 + i) * 512); nb[i] = *(const u32x4*)(pb + (size_t)((b + 1) * 4 + i) * 512); } }
            asm volatile("" ::: "memory");
#pragma unroll
            for (int i = 0; i < 4; ++i) { const int grp = b * 4 + i, ai = grp >> 3, m = (grp >> 1) & 3, bj = grp & 1; float ga[8], gb[8]; unpack8(ca[i], ga); unpack8(cb[i], gb);
#pragma unroll
                for (int j = 0; j < 8; ++j) ga[j] *= __builtin_amdgcn_rcpf(__builtin_fmaxf(gb[j], 1e-30f));
                acc[ai][bj][m][0] *= (f32x4){ga[0], ga[1], ga[2], ga[3]}; acc[ai][bj][m][1] *= (f32x4){ga[4], ga[5], ga[6], ga[7]}; }
#pragma unroll
            for (int i = 0; i < 4; ++i) { ca[i] = na[i]; cb[i] = nb[i]; }
        }
    }
    __device__ __forceinline__ void operator()(const f32x4 (&acc)[2][2][4][2], const Unit& u, int wr, int wc, int fr, int fq) const {
        asm volatile("" : "+v"(fr), "+v"(fq));
        const int r16 = u.pm * BM + wr * 64, c32 = u.pn * BM + wc * 32, l8 = (fq * 16 + fr) * 8;
        const bf16_t* pb = G + gfrag_off(u.pm, 4 + u.pn, wr * 4 + wc, 0, fq * 16 + fr);
        u32x4 cb[8], nb[8];
#pragma unroll
        for (int i = 0; i < 8; ++i) cb[i] = *(const u32x4*)(pb + (size_t)i * 512);
#pragma unroll
        for (int b = 0; b < 2; ++b) {
            if (b < 1) {
#pragma unroll
                for (int i = 0; i < 8; ++i) nb[i] = *(const u32x4*)(pb + (size_t)(8 + i) * 512); }
            asm volatile("" ::: "memory");
#pragma unroll
            for (int i = 0; i < 8; ++i) { const int grp = b * 8 + i, ai = grp >> 3, m = (grp >> 1) & 3, bj = grp & 1; float v[8], gb[8]; ld8(v, acc[ai][bj][m][0], acc[ai][bj][m][1]); unpack8(cb[i], gb);
#pragma unroll
                for (int j = 0; j < 8; ++j) v[j] *= __builtin_fmaxf(gb[j], 1e-30f);
                *(u32x4*)(T + chk_off(r16 + ai * HALF + m * 16, c32 + bj * HALF, LDH) + l8) = pack8(v); }
#pragma unroll
            for (int i = 0; i < 8; ++i) cb[i] = nb[i];
        }
    }
};
struct EpiSS {
    static constexpr bool PERM = true, AFTER_DRAIN = false; static constexpr int MIDT = 0;
    bf16_t* Y; float* SSY; int ldy; float scale;
    __device__ __forceinline__ void operator()(const f32x4 (&acc)[2][2][4][2], const Unit& u, int wr, int wc, int fr, int fq) const {
        asm volatile("" : "+v"(fr), "+v"(fq));
        const int row0 = u.pm * BM + wr * 64 + fr, cl = u.pn * BM + wc * 32 + 8 * fq;
#pragma unroll
        for (int ai = 0; ai < 2; ++ai)
#pragma unroll
            for (int m = 0; m < 4; ++m) { const int row = row0 + ai * HALF + m * 16; float s = 0.f;
#pragma unroll
                for (int bj = 0; bj < 2; ++bj) { float v[8]; ld8(v, acc[ai][bj][m][0] * scale, acc[ai][bj][m][1] * scale); s += sumsq8(v); *(u32x4*)(Y + (size_t)row * ldy + cl + bj * HALF) = pack8(v); }
                s = red_fq(s); if (fq == 0) SSY[(size_t)row * 16 + u.pn * 4 + wc] = s; }
    }
};
struct EpiRelu2F8 {
    static constexpr bool PERM = true, AFTER_DRAIN = false; static constexpr int MIDT = 0;
    unsigned char* U; float scale;
    __device__ __forceinline__ void operator()(const f32x4 (&acc)[2][2][4][2], const Unit& u, int wr, int wc, int fr, int fq) const {
        asm volatile("" : "+v"(fr), "+v"(fq));
        unsigned char* base = U + ((size_t)(u.pm * 16 + wr * 4) * 64 + u.pn * 4 + wc) * 1024 + (unsigned)(fq * 16 + fr) * 16u;
#pragma unroll
        for (int ai = 0; ai < 2; ++ai)
#pragma unroll
            for (int m = 0; m < 4; ++m) { int w[4];
#pragma unroll
                for (int bj = 0; bj < 2; ++bj) { float v[8]; ld8(v, acc[ai][bj][m][0], acc[ai][bj][m][1]);
#pragma unroll
                    for (int j = 0; j < 8; ++j) { const float r = __builtin_fmaxf(v[j] * scale, 0.f); v[j] = __builtin_fminf(r * r, 440.f); }
                    int w0 = 0, w1 = 0;
                    w0 = __builtin_amdgcn_cvt_pk_fp8_f32(v[0], v[1], w0, false); w0 = __builtin_amdgcn_cvt_pk_fp8_f32(v[2], v[3], w0, true);
                    w1 = __builtin_amdgcn_cvt_pk_fp8_f32(v[4], v[5], w1, false); w1 = __builtin_amdgcn_cvt_pk_fp8_f32(v[6], v[7], w1, true);
                    w[2 * bj] = w0; w[2 * bj + 1] = w1; }
                typedef int i32x4e_ __attribute__((ext_vector_type(4)));
                *(i32x4e_*)(base + (size_t)(ai * 8 + m) * 65536) = (i32x4e_){w[0], w[1], w[2], w[3]}; }
    }
};
struct EpiRelu2 {
    static constexpr bool PERM = true, AFTER_DRAIN = false; static constexpr int MIDT = 0;
    bf16_t* U;
    __device__ __forceinline__ void operator()(const f32x4 (&acc)[2][2][4][2], const Unit& u, int wr, int wc, int fr, int fq) const {
        asm volatile("" : "+v"(fr), "+v"(fq));
        const int row0 = u.pm * BM + wr * 64 + fr, cl = u.pn * BM + wc * 32 + 8 * fq;
#pragma unroll
        for (int ai = 0; ai < 2; ++ai)
#pragma unroll
            for (int m = 0; m < 4; ++m) { const int row = row0 + ai * HALF + m * 16;
#pragma unroll
                for (int bj = 0; bj < 2; ++bj) { float v[8]; ld8(v, acc[ai][bj][m][0], acc[ai][bj][m][1]);
#pragma unroll
                    for (int j = 0; j < 8; ++j) { const float r = __builtin_fmaxf(v[j], 0.f); v[j] = r * r; }
                    *(u32x4*)(U + (size_t)row * LDU + cl + bj * HALF) = pack8(v); } }
    }
};
template <class Epi, class Sched, bool ALIGN_EPI = false, bool SP2 = false, int ESZ = 2, bool ACH = false>
__device__ __forceinline__ void gemm_phase(PG8_LAS unsigned char* lds, const Gemm g, const Sched& S, const Epi& E) {
    int tid_ = threadIdx.x; asm volatile("" : "+v"(tid_));
    const int tid = tid_, wid = __builtin_amdgcn_readfirstlane(tid >> 6), lane = tid & 63, wr = wid >> 2, wc = wid & 3, fr = lane & 15, fq = lane >> 4;
    const int K = g.K, nt = K * ESZ / (BK * 2), lda = g.lda ? g.lda : K, ldb = g.ldb ? g.ldb : K;
    unsigned voffA[2], voffB[2];
#pragma unroll
    for (int i = 0; i < 2; ++i) { int R, C; stage_rc(tid * 16 + i * 8192, R, C); const int Rb = Epi::PERM ? ((R & ~31) + perm32(R & 31)) : R;
        if constexpr (ACH) { const int st_ = (tid >> 6) + 8 * i; voffA[i] = (unsigned)((st_ >> 1) * 16 * lda * ESZ + (st_ & 1) * 1024 + (tid & 63) * 16); } else voffA[i] = (unsigned)(R * lda * ESZ + C * 2);
        voffB[i] = (unsigned)(Rb * ldb * ESZ + C * 2); }
    const size_t kstepB = (size_t)(BK * 2), kstepA = ACH ? (size_t)2048 : kstepB;
    const size_t hstepA = (size_t)HALF * lda * ESZ, hstepB = (size_t)HALF * ldb * ESZ;
    const size_t tstepA = 2 * hstepA, tstepB = 2 * hstepB;
    const unsigned ldsw = (unsigned)wid * 1024u;
    const int aoff = ACH ? wr * 8192 + lane * 16 : lds_byte(wr * 64 + fr, fq * 8), boff = lds_byte(wc * 32 + fr, fq * 8);
#define PG8_SA(b, h) (((b) * 2 + (h)) * HTB)
#define PG8_SB(b, h) ((4 + (b) * 2 + (h)) * HTB)
#define PG8_STAGE(bufoff, gbase, voff) do { _Pragma("unroll") for (int _i = 0; _i < 2; ++_i) \
        __builtin_amdgcn_global_load_lds((const unsigned*)((const char*)(gbase) + (voff)[_i]), (PG8_LAS unsigned*)(lds + (bufoff) + ldsw + _i * 8192), 16, 0, 0); } while (0)
#define PG8_LDA(dst, b, h) do { if constexpr (ESZ == 2) { _Pragma("unroll") for (int m = 0; m < 4; ++m) _Pragma("unroll") for (int k = 0; k < 2; ++k) dst[m][k] = *(const PG8_LAS bf16x8*)(lds + PG8_SA(b, h) + aoff + m * 2048 + k * 1024); } \
        else { _Pragma("unroll") for (int m = 0; m < 4; ++m) { dst##8[m].lo = *(const PG8_LAS i32x4_*)(lds + PG8_SA(b, h) + aoff + m * 2048); dst##8[m].hi = *(const PG8_LAS i32x4_*)(lds + PG8_SA(b, h) + aoff + m * 2048 + 1024); } } } while (0)
#define PG8_LDB(dst, b, h) do { if constexpr (ESZ == 2) { _Pragma("unroll") for (int n = 0; n < 2; ++n) _Pragma("unroll") for (int k = 0; k < 2; ++k) dst[n][k] = *(const PG8_LAS bf16x8*)(lds + PG8_SB(b, h) + boff + n * 2048 + k * 1024); } \
        else { _Pragma("unroll") for (int n = 0; n < 2; ++n) { dst##8[n].lo = *(const PG8_LAS i32x4_*)(lds + PG8_SB(b, h) + boff + n * 2048); dst##8[n].hi = *(const PG8_LAS i32x4_*)(lds + PG8_SB(b, h) + boff + n * 2048 + 1024); } } } while (0)
#define PG8_MMA(ai, bj, At, Bt) do { __builtin_amdgcn_s_setprio(1); \
        if constexpr (ESZ == 2) { _Pragma("unroll") for (int m = 0; m < 4; ++m) _Pragma("unroll") for (int n = 0; n < 2; ++n) _Pragma("unroll") for (int k = 0; k < 2; ++k) \
            acc[ai][bj][m][n] = __builtin_amdgcn_mfma_f32_16x16x32_bf16(Bt[n][k], At[m][k], acc[ai][bj][m][n], 0, 0, 0); } \
        else {   \
            _Pragma("unroll") for (int m = 0; m < 4; ++m) _Pragma("unroll") for (int n = 0; n < 2; ++n) \
                asm volatile("v_mfma_scale_f32_16x16x128_f8f6f4 %0, %1, %2, %0, %3, %3 op_sel_hi:[0,0,0]" : "+v"(acc[ai][bj][m][n]) : "v"(Bt##8[n]), "v"(At##8[m]), "v"(scl_)); } \
        __builtin_amdgcn_s_setprio(0); } while (0)
#define PG8_WAIT_V(n) asm volatile("s_waitcnt vmcnt(" #n ")" ::: "memory")
#define PG8_WAIT_L(n) asm volatile("s_waitcnt lgkmcnt(" #n ")" ::: "memory")
#define PG8_BAR __builtin_amdgcn_s_barrier()
#define PG8_SCHED __builtin_amdgcn_sched_barrier(0)
    Unit cur, nxt; int ui = 0;
    if (!S.next(0, cur)) return;
    f32x4 acc[2][2][4][2];
#pragma unroll
    for (int a = 0; a < 2; ++a)
#pragma unroll
        for (int b = 0; b < 2; ++b)
#pragma unroll
            for (int m = 0; m < 4; ++m)
#pragma unroll
                for (int n = 0; n < 2; ++n) acc[a][b][m][n] = (f32x4){0.f, 0.f, 0.f, 0.f};
    bf16x8 At[4][2], B0[2][2], B1[2][2];
    typedef int i32x4_ __attribute__((ext_vector_type(4))); typedef int i32x8_ __attribute__((ext_vector_type(8)));
    const int scl_ = 0x7F7F7F7F;
    i32x8_ At8[4], B08[2], B18[2];
    const char* cA = (const char*)g.A + (size_t)cur.pm * tstepA; const char* cB = (const char*)g.Bt + (size_t)cur.pn * tstepB;
    S.a_ready(cur);
    if constexpr (SP2) {
        PG8_STAGE(PG8_SB(0, 0), cB, voffB); PG8_STAGE(PG8_SB(0, 1), cB + hstepB, voffB); PG8_STAGE(PG8_SA(0, 0), cA, voffA); PG8_STAGE(PG8_SA(0, 1), cA + hstepA, voffA);
        if (wr == 1) PG8_BAR;
        PG8_WAIT_V(2); PG8_BAR;
        PG8_STAGE(PG8_SB(1, 0), cB + kstepB, voffB); PG8_STAGE(PG8_SA(1, 0), cA + kstepA, voffA); PG8_STAGE(PG8_SB(1, 1), cB + hstepB + kstepB, voffB);
        PG8_WAIT_V(6); PG8_BAR;
    } else {
        PG8_STAGE(PG8_SB(0, 0), cB, voffB); PG8_STAGE(PG8_SA(0, 0), cA, voffA); PG8_STAGE(PG8_SB(0, 1), cB + hstepB, voffB); PG8_STAGE(PG8_SA(0, 1), cA + hstepA, voffA);
        if (wr == 1) PG8_BAR;
        PG8_WAIT_V(4); PG8_BAR;
        PG8_STAGE(PG8_SB(1, 0), cB + kstepB, voffB); PG8_STAGE(PG8_SA(1, 0), cA + kstepA, voffA); PG8_STAGE(PG8_SB(1, 1), cB + hstepB + kstepB, voffB);
        PG8_WAIT_V(6); PG8_BAR;
    }
    for (;;) {
        const bool has_next = S.next(ui + 1, nxt);
        const char* nA = has_next ? (const char*)g.A + (size_t)nxt.pm * tstepA : cA; const char* nB = has_next ? (const char*)g.Bt + (size_t)nxt.pn * tstepB : cB;
#pragma unroll 1
        for (int t = 0; t < nt; t += 2) {
            if constexpr (Epi::MIDT > 0) { if (t == Epi::MIDT) E.mid(acc, cur, wr, wc, fr, fq); }
            const bool last = (t == nt - 2);
            const char* a1 = cA + (size_t)(t + 1) * kstepA;
            const char* a2 = last ? nA : cA + (size_t)(t + 2) * kstepA; const char* b2 = last ? nB : cB + (size_t)(t + 2) * kstepB;
            const char* a3 = a2 + kstepA; const char* b3 = b2 + kstepB;
            if (last && has_next) S.a_ready(nxt);
            if constexpr (SP2) {
            PG8_LDB(B0, 0, 0); PG8_LDB(B1, 0, 1); PG8_SCHED; PG8_LDA(At, 0, 0); PG8_STAGE(PG8_SA(1, 1), a1 + hstepA, voffA);
            PG8_WAIT_V(8); PG8_WAIT_L(0); PG8_BAR; PG8_MMA(0, 0, At, B0); PG8_MMA(0, 1, At, B1); PG8_BAR; PG8_SCHED;
            PG8_LDA(At, 0, 1); PG8_STAGE(PG8_SB(0, 0), b2, voffB); PG8_STAGE(PG8_SB(0, 1), b2 + hstepB, voffB); PG8_STAGE(PG8_SA(0, 0), a2, voffA);
            PG8_WAIT_V(8); PG8_WAIT_L(0); PG8_BAR; PG8_MMA(1, 0, At, B0); PG8_MMA(1, 1, At, B1); PG8_BAR; PG8_SCHED;
            PG8_LDB(B0, 1, 0); PG8_LDB(B1, 1, 1); PG8_SCHED; PG8_LDA(At, 1, 0); PG8_STAGE(PG8_SA(0, 1), a2 + hstepA, voffA);
            PG8_WAIT_V(8); PG8_WAIT_L(0); PG8_BAR; PG8_MMA(0, 0, At, B0); PG8_MMA(0, 1, At, B1); PG8_BAR; PG8_SCHED;
            PG8_LDA(At, 1, 1); PG8_STAGE(PG8_SB(1, 0), b3, voffB); PG8_STAGE(PG8_SB(1, 1), b3 + hstepB, voffB); PG8_STAGE(PG8_SA(1, 0), a3, voffA);
            PG8_WAIT_V(8); PG8_WAIT_L(0); PG8_BAR; PG8_MMA(1, 0, At, B0); PG8_MMA(1, 1, At, B1); PG8_BAR; PG8_SCHED;
            } else {
            PG8_LDB(B0, 0, 0); PG8_SCHED; PG8_LDA(At, 0, 0); PG8_STAGE(PG8_SA(1, 1), a1 + hstepA, voffA);
            PG8_WAIT_L(8); PG8_BAR; PG8_WAIT_L(0); PG8_MMA(0, 0, At, B0); PG8_BAR; PG8_SCHED;
            PG8_LDB(B1, 0, 1); PG8_STAGE(PG8_SB(0, 0), b2, voffB);
            PG8_BAR; PG8_WAIT_L(0); PG8_MMA(0, 1, At, B1); PG8_BAR;
            PG8_LDA(At, 0, 1); PG8_STAGE(PG8_SA(0, 0), a2, voffA);
            PG8_BAR; PG8_WAIT_L(0); PG8_MMA(1, 0, At, B0); PG8_BAR; PG8_SCHED;
            PG8_STAGE(PG8_SB(0, 1), b2 + hstepB, voffB);
            PG8_WAIT_V(6); PG8_BAR; PG8_MMA(1, 1, At, B1); PG8_BAR;
            PG8_LDB(B0, 1, 0); PG8_SCHED; PG8_LDA(At, 1, 0); PG8_STAGE(PG8_SA(0, 1), a2 + hstepA, voffA);
            PG8_WAIT_L(8); PG8_BAR; PG8_WAIT_L(0); PG8_MMA(0, 0, At, B0); PG8_BAR; PG8_SCHED;
            PG8_LDB(B1, 1, 1); PG8_STAGE(PG8_SB(1, 0), b3, voffB);
            PG8_BAR; PG8_WAIT_L(0); PG8_MMA(0, 1, At, B1); PG8_BAR;
            PG8_LDA(At, 1, 1); PG8_STAGE(PG8_SA(1, 0), a3, voffA);
            PG8_BAR; PG8_WAIT_L(0); PG8_MMA(1, 0, At, B0); PG8_BAR; PG8_SCHED;
            PG8_STAGE(PG8_SB(1, 1), b3 + hstepB, voffB);
            PG8_WAIT_V(6); PG8_BAR; PG8_MMA(1, 1, At, B1); PG8_BAR;
            }
        }
        if constexpr (ALIGN_EPI) { if (wr == 0) PG8_BAR; }
        if constexpr (ESZ == 1) asm volatile("s_nop 15\n\ts_nop 15" ::: "memory");
        if constexpr (!Epi::AFTER_DRAIN) { E(acc, cur, wr, wc, fr, fq); S.done(cur); }
        if (!has_next) break;
#pragma unroll
        for (int a = 0; a < 2; ++a)
#pragma unroll
            for (int b = 0; b < 2; ++b)
#pragma unroll
                for (int m = 0; m < 4; ++m)
#pragma unroll
                    for (int n = 0; n < 2; ++n) acc[a][b][m][n] = (f32x4){0.f, 0.f, 0.f, 0.f};
        cur = nxt; cA = nA; cB = nB; ++ui;
        if constexpr (ALIGN_EPI) { if (wr == 1) PG8_BAR; }
    }
    PG8_WAIT_V(0);
    if constexpr (!ALIGN_EPI) { if (wr == 0) PG8_BAR; }
    PG8_BAR;
    if constexpr (Epi::AFTER_DRAIN) { E.fused(acc, cur, wr, wc, fr, fq, lds, wid, lane); S.done(cur); }
#undef PG8_SA
#undef PG8_SB
#undef PG8_STAGE
#undef PG8_LDA
#undef PG8_LDB
#undef PG8_MMA
#undef PG8_WAIT_V
#undef PG8_WAIT_L
#undef PG8_BAR
#undef PG8_SCHED
}
}
#ifndef ATT_LSUM_MFMA
#define ATT_LSUM_MFMA 1
#endif
namespace att {
typedef unsigned short bf16_t;
typedef short bf16x8 __attribute__((ext_vector_type(8)));
typedef short s16x4 __attribute__((ext_vector_type(4)));
typedef float f32x16 __attribute__((ext_vector_type(16)));
typedef float f32x4 __attribute__((ext_vector_type(4)));
typedef unsigned u32x4 __attribute__((ext_vector_type(4)));
#define ALDS __attribute__((address_space(3)))
#define ASBAR() __builtin_amdgcn_sched_barrier(0)
constexpr int KTB = 12288, VTB = 8192;
constexpr int NSLOT = 3;
constexpr int L_K = 0, L_V = NSLOT * KTB, L_WS = L_V + NSLOT * VTB, L_OST = L_WS + 8 * 256, L_KM = L_OST + 8 * 4096, L_RED = L_KM + 2048, L_END = L_RED + 16384;
constexpr float THR = 8.f;
__device__ __forceinline__ int crow(int r, int hi) { return (r & 3) + 8 * (r >> 2) + 4 * hi; }
typedef float f32x2a_t __attribute__((ext_vector_type(2))); typedef __bf16 bf16x2a_t __attribute__((ext_vector_type(2)));
__device__ __forceinline__ unsigned cvtpk(float lo, float hi) { const f32x2a_t v = {lo, hi}; const bf16x2a_t b = __builtin_convertvector(v, bf16x2a_t); return __builtin_bit_cast(unsigned, b); }
__device__ __forceinline__ float bf2f(short s) { return __uint_as_float(((unsigned)(unsigned short)s) << 16); }
__device__ __forceinline__ int v_st(int k, int c) { const int kk = (k & ~0xC) | ((k & 4) << 1) | ((k & 8) >> 1); return ((kk >> 3) * 2 + (c >> 5)) * 512 + ((kk & 7) * 32 + (c & 31)) * 2; }
__device__ __forceinline__ int v_rd_base(int lane) { return ((lane & 3) << 3) | (((lane >> 2) & 3) << 6) | (((lane >> 4) & 1) << 5) | (((lane >> 5) & 1) << 8); }
constexpr int v_rd_off(int d0, int ks, int half) { return ks * 2048 + half * 1024 + d0 * 512; }
template <int OFF> __device__ __forceinline__ s16x4 tr_read(int vb) { s16x4 r; asm volatile("ds_read_b64_tr_b16 %0, %1 offset:%2" : "=&v"(r) : "v"(vb), "i"(OFF) : "memory"); return r; }
template <int D0> __device__ __forceinline__ void pv_one(f32x16& od, int vb, bf16x8 pa0, bf16x8 pa1, bf16x8 pa2, bf16x8 pa3) {
    const s16x4 l0 = tr_read<v_rd_off(D0, 0, 0)>(vb), h0 = tr_read<v_rd_off(D0, 0, 1)>(vb), l1 = tr_read<v_rd_off(D0, 1, 0)>(vb), h1 = tr_read<v_rd_off(D0, 1, 1)>(vb);
    const s16x4 l2 = tr_read<v_rd_off(D0, 2, 0)>(vb), h2 = tr_read<v_rd_off(D0, 2, 1)>(vb), l3 = tr_read<v_rd_off(D0, 3, 0)>(vb), h3 = tr_read<v_rd_off(D0, 3, 1)>(vb);
    asm volatile("s_waitcnt lgkmcnt(0)" ::: "memory"); ASBAR();
#define ATT_PK(L, H) (bf16x8){L[0], L[1], L[2], L[3], H[0], H[1], H[2], H[3]}
    od = __builtin_amdgcn_mfma_f32_32x32x16_bf16(pa0, ATT_PK(l0, h0), od, 0, 0, 0);
    od = __builtin_amdgcn_mfma_f32_32x32x16_bf16(pa1, ATT_PK(l1, h1), od, 0, 0, 0);
    od = __builtin_amdgcn_mfma_f32_32x32x16_bf16(pa2, ATT_PK(l2, h2), od, 0, 0, 0);
    od = __builtin_amdgcn_mfma_f32_32x32x16_bf16(pa3, ATT_PK(l3, h3), od, 0, 0, 0);
#undef ATT_PK
}
__device__ __forceinline__ void pv_all(f32x16* o, f32x16& ol, int vb, bf16x8 pa0, bf16x8 pa1, bf16x8 pa2, bf16x8 pa3) {
    pv_one<0>(o[0], vb, pa0, pa1, pa2, pa3); pv_one<1>(o[1], vb, pa0, pa1, pa2, pa3);
#if ATT_LSUM_MFMA
    const bf16x8 ones = (bf16x8){0x3F80, 0x3F80, 0x3F80, 0x3F80, 0x3F80, 0x3F80, 0x3F80, 0x3F80};
    ol = __builtin_amdgcn_mfma_f32_32x32x16_bf16(pa0, ones, ol, 0, 0, 0); ol = __builtin_amdgcn_mfma_f32_32x32x16_bf16(pa1, ones, ol, 0, 0, 0);
    ol = __builtin_amdgcn_mfma_f32_32x32x16_bf16(pa2, ones, ol, 0, 0, 0); ol = __builtin_amdgcn_mfma_f32_32x32x16_bf16(pa3, ones, ol, 0, 0, 0);
#endif
}
__device__ __forceinline__ void partialSM(f32x16& p0, f32x16& p1, float& m_ref, f32x16& negm, float& alpha) {
    float pmax = p0[0];
#pragma unroll
    for (int r = 1; r < 16; ++r) pmax = fmaxf(pmax, p0[r]);
#pragma unroll
    for (int r = 0; r < 16; ++r) pmax = fmaxf(pmax, p1[r]);
    { auto rr = __builtin_amdgcn_permlane32_swap(__float_as_uint(pmax), __float_as_uint(pmax), false, false); pmax = fmaxf(__uint_as_float(rr[0]), __uint_as_float(rr[1])); }
    alpha = 1.f;
    if (__builtin_expect(!__all(pmax <= THR), 0)) { const float dl = (pmax > THR) ? pmax : 0.f; m_ref += dl; alpha = __builtin_amdgcn_exp2f(-dl);
#pragma unroll
        for (int r = 0; r < 16; ++r) { p0[r] -= dl; p1[r] -= dl; negm[r] = -m_ref; } }
#pragma unroll
    for (int r = 0; r < 16; ++r) p0[r] = __builtin_amdgcn_exp2f(p0[r]);
}
__device__ __forceinline__ void finishSM(f32x16& p0, f32x16& p1, bf16x8& pa0, bf16x8& pa1, bf16x8& pa2, bf16x8& pa3, float& lsum) {
#pragma unroll
    for (int r = 0; r < 16; ++r) p1[r] = __builtin_amdgcn_exp2f(p1[r]);
#if !ATT_LSUM_MFMA
    { float ps = 0.f;
#pragma unroll
      for (int r = 0; r < 16; ++r) ps += p0[r];
#pragma unroll
      for (int r = 0; r < 16; ++r) ps += p1[r];
      lsum += ps; }
#endif
#define ATT_PK4(P, BASE, OUT) do { unsigned a0 = cvtpk(P[BASE + 0], P[BASE + 1]), a1 = cvtpk(P[BASE + 2], P[BASE + 3]);   \
    unsigned b0 = cvtpk(P[BASE + 4], P[BASE + 5]), b1 = cvtpk(P[BASE + 6], P[BASE + 7]);                              \
    auto r0 = __builtin_amdgcn_permlane32_swap(a0, b0, false, false); auto r1 = __builtin_amdgcn_permlane32_swap(a1, b1, false, false); \
    u32x4 w = {r0[0], r1[0], r0[1], r1[1]}; OUT = __builtin_bit_cast(bf16x8, w); } while (0)
    ATT_PK4(p0, 0, pa0); ATT_PK4(p0, 8, pa1); ATT_PK4(p1, 0, pa2); ATT_PK4(p1, 8, pa3);
#undef ATT_PK4
}
template <int ND> __device__ __forceinline__ void qkt(f32x16& p0, f32x16& p1, ALDS const char* Kb, const int (&ka)[ND], const bf16x8 (&qr)[ND], const f32x16& cinit) {
#pragma unroll
    for (int d0 = 0; d0 < ND; ++d0) {
        const bf16x8 b0 = *(ALDS const bf16x8*)(Kb + ka[d0]);
        const bf16x8 b1 = *(ALDS const bf16x8*)(Kb + ka[d0] + (d0 < 4 ? 4096 : 2048));
        p0 = __builtin_amdgcn_mfma_f32_32x32x16_bf16(b0, qr[d0], d0 == 0 ? cinit : p0, 0, 0, 0);
        p1 = __builtin_amdgcn_mfma_f32_32x32x16_bf16(b1, qr[d0], d0 == 0 ? cinit : p1, 0, 0, 0);
        if (ND > 4 && d0 == 2) asm volatile("" ::: "memory"); }
}
__device__ __forceinline__ void cmask(f32x16& p0, f32x16& p1, int jt, int qrel, int hi) {
    const float NEG = -INFINITY; const int thr = qrel - 64 * jt - 4 * hi;
#pragma unroll
    for (int r = 0; r < 16; ++r) { if ((r & 3) + 8 * (r >> 2) > thr) p0[r] = NEG; if ((r & 3) + 8 * (r >> 2) + 32 > thr) p1[r] = NEG; }
}
__device__ __forceinline__ void kmean_blocks(const bf16_t* Kp, ALDS char* lds) {
    int tid_ = threadIdx.x; asm volatile("" : "+v"(tid_));
    const int tid = tid_, lane = tid & 63, wid = tid >> 6;
    ALDS float* red = (ALDS float*)(lds + L_RED); ALDS float* km = (ALDS float*)(lds + L_KM);
#pragma unroll 1
    for (int n = 0; n < 8; ++n) {
        float a[16];
#pragma unroll
        for (int j = 0; j < 16; ++j) a[j] = 0.f;
#pragma unroll
        for (int i = 0; i < 2; ++i)
#pragma unroll
            for (int cc = 0; cc < 2; ++cc) { const bf16x8 kx = *(const bf16x8*)(Kp + (size_t)(n * 256 + 128 * i + 16 * wid) * AW + cc * 512 + lane * 8);
#pragma unroll
                for (int j = 0; j < 8; ++j) a[cc * 8 + j] += bf2f(kx[j]); }
#pragma unroll
        for (int j = 0; j < 16; ++j) { a[j] += __shfl_xor(a[j], 1); a[j] += __shfl_xor(a[j], 2); a[j] += __shfl_xor(a[j], 4); a[j] += __shfl_xor(a[j], 8); }
        if ((lane & 15) == 0) {
#pragma unroll
            for (int j = 0; j < 16; ++j) red[(n * 8 + wid) * 64 + (j >> 3) * 32 + (lane >> 4) * 8 + (j & 7)] = a[j]; }
    }
    __syncthreads();
    { const int n = tid >> 6, d = tid & 63; float s = 0.f;
#pragma unroll
        for (int w = 0; w < 8; ++w) s += red[(n * 8 + w) * 64 + d];
        km[n * 64 + d] = s * (1.0f / 256.0f); }
    __syncthreads();
}
template <int DQK, bool MOBA>
__device__ __forceinline__ void attn_bh(const bf16_t* Qp, int ldq, const bf16_t* Kp, const bf16_t* KRp, const bf16_t* Vp, bf16_t* Op, int ldo, ALDS char* lds) {
    constexpr int ND = DQK / 16;
    ALDS char* K_lds = lds + L_K; ALDS char* V_lds = lds + L_V;
    bf16x8 sk0, sv0, sr0, sk1, sv1, sr1;
#define ATT_SLOAD(S, k0) do { sk##S = *(const bf16x8*)((const char*)(Kp + (size_t)(k0) * AW) + koff); sv##S = *(const bf16x8*)((const char*)(Vp + (size_t)(k0) * AW) + koff); if (DQK == 96) sr##S = *(const bf16x8*)((const char*)(KRp + (size_t)(k0) * RDIM) + roff); } while (0)
#define ATT_SWRITE(b, S) do { *(ALDS bf16x8*)(K_lds + (b) * KTB + kst) = sk##S; *(ALDS bf16x8*)(V_lds + (b) * VTB + vst) = sv##S; if (DQK == 96) { if (tid < 256) *(ALDS bf16x8*)(K_lds + (b) * KTB + rst) = sr##S; } } while (0)
#define ATT_QLOAD(q_) do { const bf16_t* Qw = Qp + (size_t)((q_) * 256 + wid * 32 + (r32 & 16)) * ldq + (r32 & 15) * 8 + hi * 128; _Pragma("unroll") for (int d0 = 0; d0 < ND; ++d0) qr[d0] = *(const bf16x8*)(Qw + (d0 >> 1) * 512 + (d0 & 1) * 256); } while (0)
    bf16x8 qr[ND];
    {
        const int tid = threadIdx.x, w_ = tid >> 6, l_ = tid & 63;
        const unsigned koff = (unsigned)((w_ >> 1) * 16 * AW + (w_ & 1) * 512 + l_ * 8) * 2u, roff = (unsigned)((w_ & 3) * 16 * RDIM + l_ * 8) * 2u;
        ATT_SLOAD(0, 0); ATT_SLOAD(1, 64); }
#pragma unroll 1
  for (int qb = 0; qb < 8; ++qb) {
    int tid_ = threadIdx.x; asm volatile("" : "+v"(tid_));
    const int tid = tid_, lane = tid & 63, r32 = lane & 31, hi = lane >> 5; const int wid = __builtin_amdgcn_readfirstlane(tid >> 6);
    ALDS float* al_l = (ALDS float*)(lds + L_WS) + wid * 64;
    const int skey = 16 * (wid >> 1) + (lane & 15), sch = 4 * (wid & 1) + (lane >> 4);
    const unsigned koff = (unsigned)((wid >> 1) * 16 * AW + (wid & 1) * 512 + lane * 8) * 2u;
    const int kst = skey * 128 + ((sch ^ ((skey >> 1) & 7)) << 4), vst = v_st(skey, sch * 8);
    const int rkey = 16 * (wid & 3) + (lane & 15), rch = lane >> 4;
    const unsigned roff = (unsigned)((wid & 3) * 16 * RDIM + lane * 8) * 2u;
    const int rst = 8192 + rkey * 64 + ((rch ^ ((rkey >> 2) & 3)) << 4);
    int ka[ND];
#pragma unroll
    for (int d0 = 0; d0 < ND; ++d0) ka[d0] = (d0 < 4) ? r32 * 128 + (((2 * d0 + hi) ^ ((r32 >> 1) & 7)) << 4) : 8192 + r32 * 64 + (((2 * (d0 - 4) + hi) ^ ((r32 >> 2) & 3)) << 4);
    const int vb0 = (int)(unsigned)(uintptr_t)V_lds + v_rd_base(lane);
    const int qrel = wid * 32 + r32;
    ATT_QLOAD(qb);
    float m_ref = 0.f, lsum = 0.f; f32x16 o[2], ol, negm; o[0] = f32x16{}; o[1] = f32x16{}; ol = f32x16{}; negm = f32x16{};
    unsigned sel = 0xffu;
    if (MOBA && qb > 3) {
        ALDS const float* km = (ALDS const float*)(lds + L_KM); float g[8];
#pragma unroll
        for (int n = 0; n < 8; ++n) { float s = 0.f;
#pragma unroll
            for (int d0 = 0; d0 < ND; ++d0)
#pragma unroll
                for (int j = 0; j < 8; ++j) s += bf2f(qr[d0][j]) * km[n * 64 + d0 * 16 + hi * 8 + j];
            g[n] = s; }
#pragma unroll
        for (int n = 0; n < 8; ++n) g[n] += __shfl_xor(g[n], 32);
        sel = 0u;
#pragma unroll
        for (int n = 0; n < 8; ++n) { int rank = 0;
#pragma unroll
            for (int mm = 0; mm < 8; ++mm) if (mm != n) rank += (mm < qb && (g[mm] > g[n] || (g[mm] == g[n] && mm < n))) ? 1 : 0;
            if (n < qb && rank < 3) sel |= 1u << n; }
    }
#define ATT_RESC(a) do { if (__any((a) < 1.f)) { lsum *= (a); if (hi == 0) al_l[r32] = (a); asm volatile("s_waitcnt lgkmcnt(0)" ::: "memory"); \
    _Pragma("unroll") for (int r = 0; r < 16; ++r) { const float f_ = al_l[crow(r, hi)]; o[0][r] *= f_; o[1][r] *= f_; ol[r] *= f_; } } } while (0)
    f32x16 pA0, pA1, pB0, pB1; float alA, alB; bf16x8 pa0, pa1, pa2, pa3; const int NT = 4 * (qb + 1), NP = 4 * qb;
    f32x16 cm = negm; const bool gated = MOBA && qb > 3;
#define ATT_CM(t) do { if (gated) { if ((t) < NP) { const float v_ = ((sel >> ((t) >> 2)) & 1u) ? -m_ref : -INFINITY; _Pragma("unroll") for (int r = 0; r < 16; ++r) cm[r] = v_; } else cm = negm; } else cm = negm; } while (0)
#define ATT_SCORE(P0, P1, t) do { ATT_CM(t); qkt<ND>(P0, P1, K_lds + sc * KTB, ka, qr, cm); if ((t) >= NP) cmask(P0, P1, (t) - NP, qrel, hi); } while (0)
    int sp = 0, sc = 0, sn = 1;
#define ATT_ROT() do { sp = sc; sc = sn; sn = (sn == NSLOT - 1) ? 0 : sn + 1; } while (0)
    ATT_SWRITE(0, 0); ATT_SLOAD(0, 128);
    __syncthreads(); ATT_SWRITE(sn, 1); ATT_SLOAD(1, 192);
    ATT_SCORE(pA0, pA1, 0); partialSM(pA0, pA1, m_ref, negm, alA);
    ATT_ROT();
    for (int t = 1; t + 1 < NT; t += 2) {
        __syncthreads(); ATT_SWRITE(sn, 0); if (t + 3 < NT) ATT_SLOAD(0, (t + 3) * 64);
        ASBAR(); ATT_SCORE(pB0, pB1, t);
        finishSM(pA0, pA1, pa0, pa1, pa2, pa3, lsum); ASBAR();
        pv_all(o, ol, vb0 + sp * VTB, pa0, pa1, pa2, pa3); partialSM(pB0, pB1, m_ref, negm, alB);
        ATT_RESC(alB); ATT_ROT();
        __syncthreads(); ATT_SWRITE(sn, 1); if (t + 4 < NT) ATT_SLOAD(1, (t + 4) * 64);
        ASBAR(); ATT_SCORE(pA0, pA1, t + 1);
        finishSM(pB0, pB1, pa0, pa1, pa2, pa3, lsum); ASBAR();
        pv_all(o, ol, vb0 + sp * VTB, pa0, pa1, pa2, pa3); partialSM(pA0, pA1, m_ref, negm, alA);
        ATT_RESC(alA); ATT_ROT();
    }
    __syncthreads();
    ASBAR(); ATT_SCORE(pB0, pB1, NT - 1);
    if (qb < 7) { ATT_SLOAD(0, 0); ATT_SLOAD(1, 64); }
    finishSM(pA0, pA1, pa0, pa1, pa2, pa3, lsum); ASBAR();
    pv_all(o, ol, vb0 + sp * VTB, pa0, pa1, pa2, pa3); partialSM(pB0, pB1, m_ref, negm, alB);
    ATT_RESC(alB);
    finishSM(pB0, pB1, pa0, pa1, pa2, pa3, lsum); ASBAR();
    pv_all(o, ol, vb0 + sc * VTB, pa0, pa1, pa2, pa3);
#undef ATT_ROT
#undef ATT_SCORE
#undef ATT_CM
    float rli[16];
#if ATT_LSUM_MFMA
#pragma unroll
    for (int r = 0; r < 16; ++r) rli[r] = __builtin_amdgcn_rcpf(ol[r]);
#else
    { auto rr = __builtin_amdgcn_permlane32_swap(__float_as_uint(lsum), __float_as_uint(lsum), false, false); lsum = __uint_as_float(rr[0]) + __uint_as_float(rr[1]); }
    if (hi == 0) al_l[32 + r32] = lsum; asm volatile("s_waitcnt lgkmcnt(0)" ::: "memory");
#pragma unroll
    for (int r = 0; r < 16; ++r) rli[r] = __builtin_amdgcn_rcpf(al_l[32 + crow(r, hi)]);
#endif
    { ALDS unsigned short* stg = (ALDS unsigned short*)(lds + L_OST) + wid * 2048;
#pragma unroll
      for (int r = 0; r < 16; ++r) { const int orow = crow(r, hi);
#pragma unroll
          for (int d0 = 0; d0 < 2; ++d0) stg[orow * 64 + d0 * 32 + r32] = (unsigned short)(cvtpk(o[d0][r] * rli[r], 0.f) & 0xffffu); }
      asm volatile("s_waitcnt lgkmcnt(0)" ::: "memory");
      bf16_t* Ow = Op + (size_t)(qb * 256 + wid * 32) * ldo;
#pragma unroll
      for (int i = 0; i < 4; ++i) { const int row = i * 8 + (lane >> 3), ch = lane & 7; const u32x4 v = *(ALDS const u32x4*)(stg + row * 64 + ch * 8); *(u32x4*)(Ow + (size_t)row * ldo + ch * 8) = v; } }
    __syncthreads();
  }
#undef ATT_SLOAD
#undef ATT_SWRITE
#undef ATT_QLOAD
#undef ATT_RESC
}

constexpr int MSLOT = 8192, M_K = 0, M_V = 3 * MSLOT, M_WS = 6 * MSLOT, M_OST = M_WS + 8 * 256, M_END = M_OST + 8 * 4096;
static_assert(M_END <= L_KM, "MoBA LDS map");
#define MPIN(x) asm volatile("" : "+v"(x))
#define MMFMA(a, b, c) __builtin_amdgcn_mfma_f32_32x32x16_bf16(a, b, c, 0, 0, 0)
#define MWAIT_BAR(N) asm volatile("s_waitcnt vmcnt(" #N ") lgkmcnt(0)\n\ts_barrier" ::: "memory")
__device__ __forceinline__ void m_kload2(bf16x8* kf, ALDS const char* kp, int d0) { kf[2 * d0] = *(ALDS const bf16x8*)(kp + d0 * 2048); kf[2 * d0 + 1] = *(ALDS const bf16x8*)(kp + d0 * 2048 + 512); }
__device__ __forceinline__ void m_glds16(const void* g, unsigned lds_base) {
    unsigned sv; asm volatile("s_mov_b32 %0, m0\n\ts_mov_b32 m0, %2\n\ts_nop 0\n\tglobal_load_lds_dwordx4 %1, off\n\ts_mov_b32 m0, %0" : "=&s"(sv) : "v"(g), "s"(lds_base) : "memory"); }
typedef ALDS s16x4 lds_s16x4_t;
__device__ __forceinline__ s16x4 m_vtr(ALDS const char* p) { return __builtin_amdgcn_ds_read_tr16_b64_v4i16((lds_s16x4_t*)p); }
#define MMX3(a, b, c) __builtin_fmaxf(__builtin_fmaxf((a), (b)), (c))
__device__ __forceinline__ float m_rowmax(const f32x16& p0, const f32x16& p1) {
    float a = MMX3(p0[0], p0[1], p1[0]), b = MMX3(p0[2], p0[3], p1[1]); a = MMX3(a, p1[2], p1[3]);
#pragma unroll
    for (int r = 4; r < 16; r += 4) { a = MMX3(a, p0[r], p0[r + 1]); b = MMX3(b, p0[r + 2], p0[r + 3]); a = MMX3(a, p1[r], p1[r + 1]); b = MMX3(b, p1[r + 2], p1[r + 3]); }
    float m = __builtin_fmaxf(a, b); auto rr = __builtin_amdgcn_permlane32_swap(__float_as_uint(m), __float_as_uint(m), false, false);
    return __builtin_fmaxf(__uint_as_float(rr[0]), __uint_as_float(rr[1])); }
__device__ __forceinline__ void moba_unit(const bf16_t* Qp, const bf16_t* Kp, const bf16_t* Vp, bf16_t* Op, int ldo, int qb, ALDS char* lds) {
    int tid_ = threadIdx.x; asm volatile("" : "+v"(tid_));
    const int tid = tid_, lane = tid & 63, r32 = lane & 31, hi = lane >> 5; const int wid = __builtin_amdgcn_readfirstlane(tid >> 6);
    const int NT = 4 * qb + 4, NP = 4 * qb;
    ALDS float* wsf = (ALDS float*)(lds + M_WS) + wid * 64;
    const bf16_t* ksrc = Kp + (size_t)(lane >> 4) * 16 * AW + (wid >> 2) * 512 + (wid & 3) * 128 + (lane & 15) * 8;
    const bf16_t* vsrc = Vp + (size_t)(wid & 3) * 16 * AW + (wid >> 2) * 512 + (lane & 3) * 128 + (lane >> 2) * 8;
    const unsigned lds0 = (unsigned)(uintptr_t)lds, kdst = lds0 + M_K + wid * 1024, vdst = lds0 + M_V + wid * 1024;
#define MDMA_K(t, slot) m_glds16(ksrc + (size_t)(t) * 64 * AW, (unsigned)__builtin_amdgcn_readfirstlane(kdst + (slot)))
#define MDMA_V(t, slot) m_glds16(vsrc + (size_t)(t) * 64 * AW, (unsigned)__builtin_amdgcn_readfirstlane(vdst + (slot)))
    ALDS const char* vp0 = lds + M_V + ((lane >> 4) & 1) * 32 + (lane & 3) * 8 + (4 * hi + ((lane & 15) >> 2)) * 64;
    ALDS const char* kp0 = lds + M_K + hi * 1024 + r32 * 16;
    MDMA_K(0, 0); MDMA_V(0, 0); MDMA_K(1, MSLOT);
    bf16x8 qr[4];
    { const bf16_t* Qw = Qp + (size_t)(qb * 256 + wid * 32 + (r32 & 16)) * AW + (r32 & 15) * 8 + hi * 128;
#pragma unroll
      for (int d0 = 0; d0 < 4; ++d0) qr[d0] = *(const bf16x8*)(Qw + (d0 >> 1) * 512 + (d0 & 1) * 256); }
    MDMA_K(2, 2 * MSLOT);
    float mhat = 0.f, l_reg = 0.f; f32x16 o[2]; o[0] = f32x16{}; o[1] = f32x16{};
    const int qrel = wid * 32 + r32; bool resc = false, moved = false;
    unsigned sel = 0xffu; const bool gated = qb > 3;
    if (gated) {
        ALDS const float* km = (ALDS const float*)(lds + L_KM); float g[8];
#pragma unroll
        for (int n = 0; n < 8; ++n) { float sg = 0.f;
#pragma unroll
            for (int d0 = 0; d0 < 4; ++d0)
#pragma unroll
                for (int j = 0; j < 8; ++j) sg += bf2f(qr[d0][j]) * km[n * 64 + d0 * 16 + hi * 8 + j];
            g[n] = sg; }
#pragma unroll
        for (int n = 0; n < 8; ++n) g[n] += __shfl_xor(g[n], 32);
        sel = 0u;
#pragma unroll
        for (int n = 0; n < 8; ++n) { int rank = 0;
#pragma unroll
            for (int mm = 0; mm < 8; ++mm) if (mm != n) rank += (mm < qb && (g[mm] > g[n] || (g[mm] == g[n] && mm < n))) ? 1 : 0;
            if (n < qb && rank < 3) sel |= 1u << n; }
    }
    f32x16 cm;
#define MCM(t) do { const float v_ = (gated && (t) < NP && !((sel >> ((t) >> 2)) & 1u)) ? -INFINITY : -mhat; _Pragma("unroll") for (int r = 0; r < 16; ++r) cm[r] = v_; MPIN(cm); } while (0)
    MCM(0);
    f32x16 pA0, pA1, pB0, pB1; bf16x8 kf[8]; s16x4 vlo[8], vhi[8]; u32x4 pw0, pw1, pw2, pw3;
    int sl_prev = 0, sl_cur = 0, sl_next = MSLOT;
#define MROT() do { sl_prev = sl_cur; sl_cur = sl_next; sl_next = (sl_next == 2 * MSLOT) ? 0 : sl_next + MSLOT; } while (0)
#define MEX(v) __builtin_amdgcn_exp2f(v)
#define MRESC(tn) do { if (moved) { moved = false; MCM(tn); } if (resc) { _Pragma("unroll") for (int d_ = 0; d_ < 2; ++d_) _Pragma("unroll") for (int r = 0; r < 16; ++r) o[d_][r] *= wsf[crow(r, hi)]; } } while (0)
#define MDECIDE(C0, C1) do { const float rm = m_rowmax(C0, C1); resc = false; \
      if (__builtin_expect(__any(rm > THR), 0)) { const float dl = __builtin_fmaxf(rm, 0.f); mhat += dl; const float f = __builtin_amdgcn_exp2f(-dl); l_reg *= f; if (hi == 0) wsf[r32] = f; resc = true; \
          _Pragma("unroll") for (int r = 0; r < 16; ++r) { C0[r] -= dl; C1[r] -= dl; } moved = true; } } while (0)
    MWAIT_BAR(3);
#pragma unroll
    for (int d0 = 0; d0 < 4; ++d0) m_kload2(kf, kp0, d0);
    pA0 = MMFMA(kf[0], qr[0], cm); pA1 = MMFMA(kf[1], qr[0], cm); pA0 = MMFMA(kf[2], qr[1], pA0); pA1 = MMFMA(kf[3], qr[1], pA1);
    pA0 = MMFMA(kf[4], qr[2], pA0); pA1 = MMFMA(kf[5], qr[2], pA1); pA0 = MMFMA(kf[6], qr[3], pA0); pA1 = MMFMA(kf[7], qr[3], pA1);
    if (NT == 4) cmask(pA0, pA1, 0, qrel, hi);
    MDECIDE(pA0, pA1);
    if (moved) { moved = false; MCM(1); }
#pragma unroll
    for (int r = 0; r < 16; ++r) { pA0[r] = MEX(pA0[r]); pA1[r] = MEX(pA1[r]); }
    MWAIT_BAR(0);
    MDMA_K(3, 0); MDMA_V(1, MSLOT); MROT();
#pragma unroll
    for (int d0 = 0; d0 < 4; ++d0) m_kload2(kf, kp0 + sl_cur, d0);
    MWAIT_BAR(2);
#define MPKW(P, i) cvtpk(P[i], P[i + 1])
#define MPAF(k) __builtin_bit_cast(bf16x8, pw##k)
#define MVFR(i) (bf16x8){vlo[i][0], vlo[i][1], vlo[i][2], vlo[i][3], vhi[i][0], vhi[i][1], vhi[i][2], vhi[i][3]}
#define MVRD(i) do { vlo[i] = m_vtr(vp_ + (((i) >> 2) * 4096 + ((i) & 3) * 1024)); vhi[i] = m_vtr(vp_ + (((i) >> 2) * 4096 + ((i) & 3) * 1024 + 512)); } while (0)
#define MKRD(G, d0) do { if (G) { m_kload2(kf, kp0 + sl_next, d0); ASBAR(); } } while (0)
#define MGAPA(MF, a0, a1, a2, a3, W0, W1, PW) do { MF; sacc += a0; sacc += a1; sacc += a2; sacc += a3; W0; W1; MPIN(PW); MPIN(sacc); ASBAR(); } while (0)
#define MGAPB(MF, X, i) do { MF; X[i] = MEX(X[i]); X[i + 1] = MEX(X[i + 1]); X[i + 2] = MEX(X[i + 2]); X[i + 3] = MEX(X[i + 3]); MPIN(X); ASBAR(); } while (0)
#define MSTEP(C0, C1, P0, P1, t, MASK, GK, GV, GL) do { ASBAR(); \
    const ALDS char* vp_ = vp0 + sl_prev; if (gated && ((t) & 3) == 0) MCM(t); \
    MVRD(0); ASBAR(); float sacc = P0[0] + P0[1]; \
                     MGAPA(C0 = MMFMA(kf[0], qr[0], cm), P0[2], P0[3], P0[4], P0[5],     pw0[0] = MPKW(P0, 0),  pw0[1] = MPKW(P0, 2),  pw0); \
    MVRD(4); ASBAR(); MGAPA(C1 = MMFMA(kf[1], qr[0], cm), P0[6], P0[7], P0[8], P0[9],     pw0[2] = MPKW(P0, 4),  pw0[3] = MPKW(P0, 6),  pw0); \
    MVRD(1); ASBAR(); MGAPA(C0 = MMFMA(kf[2], qr[1], C0), P0[10], P0[11], P0[12], P0[13], pw1[0] = MPKW(P0, 8),  pw1[1] = MPKW(P0, 10), pw1); \
    MVRD(5); ASBAR(); MGAPA(C1 = MMFMA(kf[3], qr[1], C1), P0[14], P0[15], P1[0], P1[1],   pw1[2] = MPKW(P0, 12), pw1[3] = MPKW(P0, 14), pw1); \
    MVRD(2); ASBAR(); MGAPA(C0 = MMFMA(kf[4], qr[2], C0), P1[2], P1[3], P1[4], P1[5],     pw2[0] = MPKW(P1, 0),  pw2[1] = MPKW(P1, 2),  pw2); \
    MVRD(6); ASBAR(); MGAPA(C1 = MMFMA(kf[5], qr[2], C1), P1[6], P1[7], P1[8], P1[9],     pw2[2] = MPKW(P1, 4),  pw2[3] = MPKW(P1, 6),  pw2); \
    MVRD(3); ASBAR(); MGAPA(C0 = MMFMA(kf[6], qr[3], C0), P1[10], P1[11], P1[12], P1[13], pw3[0] = MPKW(P1, 8),  pw3[1] = MPKW(P1, 10), pw3); \
    MVRD(7); ASBAR(); MGAPA(C1 = MMFMA(kf[7], qr[3], C1), P1[14], P1[15], 0.f, 0.f,       pw3[2] = MPKW(P1, 12), pw3[3] = MPKW(P1, 14), pw3); \
    l_reg += sacc; \
    if (GK) MDMA_K((t) + 3, sl_cur); if (GV) MDMA_V((t) + 1, sl_next); \
    if (MASK) cmask(C0, C1, (t) - NP, qrel, hi); \
    MDECIDE(C0, C1); ASBAR(); \
    MGAPB(o[0] = MMFMA(MPAF(0), MVFR(0), o[0]), C0, 0);               MGAPB(o[1] = MMFMA(MPAF(0), MVFR(4), o[1]), C0, 4); \
    MKRD(GL, 0); MGAPB(o[0] = MMFMA(MPAF(1), MVFR(1), o[0]), C0, 8);  MKRD(GL, 1); MGAPB(o[1] = MMFMA(MPAF(1), MVFR(5), o[1]), C0, 12); \
    MKRD(GL, 2); MGAPB(o[0] = MMFMA(MPAF(2), MVFR(2), o[0]), C1, 0);  MKRD(GL, 3); MGAPB(o[1] = MMFMA(MPAF(2), MVFR(6), o[1]), C1, 4); \
    MGAPB(o[0] = MMFMA(MPAF(3), MVFR(3), o[0]), C1, 8);               MGAPB(o[1] = MMFMA(MPAF(3), MVFR(7), o[1]), C1, 12); \
    } while (0)
    int t = 1;
    for (; t + 5 < NT; t += 2) {
        MSTEP(pB0, pB1, pA0, pA1, t, false, true, true, true);     MWAIT_BAR(2); MRESC(t + 1); MROT();
        MSTEP(pA0, pA1, pB0, pB1, t + 1, false, true, true, true); MWAIT_BAR(2); MRESC(t + 2); MROT();
    }
#define MENDW(tt) do { if ((tt) + 3 < NT) { MWAIT_BAR(2); } else if ((tt) + 2 < NT) { MWAIT_BAR(1); } else { MWAIT_BAR(0); } } while (0)
    for (; t + 1 < NT; t += 2) {
        MSTEP(pB0, pB1, pA0, pA1, t, true, (t + 3 < NT), (t + 1 < NT), (t + 1 < NT));         MENDW(t);     MRESC(t + 1); MROT();
        MSTEP(pA0, pA1, pB0, pB1, t + 1, true, (t + 4 < NT), (t + 2 < NT), (t + 2 < NT));     MENDW(t + 1); MRESC(t + 2); MROT();
    }
    MSTEP(pB0, pB1, pA0, pA1, NT - 1, true, false, false, false); MRESC(NT - 1);
    { float sacc = pB0[0] + pB0[1];
#pragma unroll
      for (int r = 2; r < 16; ++r) sacc += pB0[r];
#pragma unroll
      for (int r = 0; r < 16; ++r) sacc += pB1[r];
      l_reg += sacc;
      pw0 = (u32x4){MPKW(pB0, 0), MPKW(pB0, 2), MPKW(pB0, 4), MPKW(pB0, 6)}; pw1 = (u32x4){MPKW(pB0, 8), MPKW(pB0, 10), MPKW(pB0, 12), MPKW(pB0, 14)};
      pw2 = (u32x4){MPKW(pB1, 0), MPKW(pB1, 2), MPKW(pB1, 4), MPKW(pB1, 6)}; pw3 = (u32x4){MPKW(pB1, 8), MPKW(pB1, 10), MPKW(pB1, 12), MPKW(pB1, 14)};
      const ALDS char* vp_ = vp0 + sl_cur;
#pragma unroll
      for (int i = 0; i < 8; ++i) MVRD(i);
      o[0] = MMFMA(MPAF(0), MVFR(0), o[0]); o[1] = MMFMA(MPAF(0), MVFR(4), o[1]); o[0] = MMFMA(MPAF(1), MVFR(1), o[0]); o[1] = MMFMA(MPAF(1), MVFR(5), o[1]);
      o[0] = MMFMA(MPAF(2), MVFR(2), o[0]); o[1] = MMFMA(MPAF(2), MVFR(6), o[1]); o[0] = MMFMA(MPAF(3), MVFR(3), o[0]); o[1] = MMFMA(MPAF(3), MVFR(7), o[1]); }
    { auto rr = __builtin_amdgcn_permlane32_swap(__float_as_uint(l_reg), __float_as_uint(l_reg), false, false); l_reg = __uint_as_float(rr[0]) + __uint_as_float(rr[1]); }
    if (hi == 0) wsf[32 + r32] = l_reg; asm volatile("s_waitcnt lgkmcnt(0)" ::: "memory");
    float rli[16];
#pragma unroll
    for (int r = 0; r < 16; ++r) rli[r] = __builtin_amdgcn_rcpf(wsf[32 + crow(r, hi)]);
    { ALDS unsigned short* stg = (ALDS unsigned short*)(lds + M_OST) + wid * 2048;
#pragma unroll
      for (int r = 0; r < 16; ++r) { const int orow = crow(r, hi);
#pragma unroll
          for (int d0 = 0; d0 < 2; ++d0) stg[orow * 64 + d0 * 32 + r32] = (unsigned short)(cvtpk(o[d0][r] * rli[r], 0.f) & 0xffffu); }
      asm volatile("s_waitcnt lgkmcnt(0)" ::: "memory");
      bf16_t* Ow = Op + (size_t)(qb * 256 + wid * 32) * ldo;
#pragma unroll
      for (int i = 0; i < 4; ++i) { const int row = i * 8 + (lane >> 3), ch = lane & 7; const u32x4 v = *(ALDS const u32x4*)(stg + row * 64 + ch * 8); *(u32x4*)(Ow + (size_t)row * ldo + ch * 8) = v; } }
    asm volatile("s_waitcnt lgkmcnt(0)\n\ts_barrier" ::: "memory");
#undef MDMA_K
#undef MDMA_V
#undef MCM
#undef MROT
#undef MEX
#undef MRESC
#undef MDECIDE
#undef MPKW
#undef MPAF
#undef MVFR
#undef MVRD
#undef MKRD
#undef MGAPA
#undef MGAPB
#undef MSTEP
#undef MENDW
}
__device__ __forceinline__ void mla_unit(const bf16_t* Qp, const bf16_t* Kp, const bf16_t* KRp, const bf16_t* Vp, bf16_t* Op, int ldo, int qb, ALDS char* lds) {
    constexpr int KSL = 12288, N_K = 0, N_V = 3 * KSL, N_WS = N_V + 3 * MSLOT, N_OST = N_WS + 8 * 256;
    int tid_ = threadIdx.x; asm volatile("" : "+v"(tid_));
    const int tid = tid_, lane = tid & 63, r32 = lane & 31, hi = lane >> 5; const int wid = __builtin_amdgcn_readfirstlane(tid >> 6);
    const int NT = 4 * qb + 4, NP = 4 * qb;
    ALDS float* wsf = (ALDS float*)(lds + N_WS) + wid * 64;
    const bf16_t* ksrc = Kp + (size_t)(lane >> 4) * 16 * AW + (wid >> 2) * 512 + (wid & 3) * 128 + (lane & 15) * 8;
    const bf16_t* vsrc = Vp + (size_t)(wid & 3) * 16 * AW + (wid >> 2) * 512 + (lane & 3) * 128 + (lane >> 2) * 8;
    const bf16_t* rsrc = KRp + (size_t)(lane >> 4) * 16 * RDIM + (wid & 3) * 128 + (lane & 15) * 8;
    const unsigned lds0 = (unsigned)(uintptr_t)lds, kdst = lds0 + N_K + wid * 1024, vdst = lds0 + N_V + wid * 1024, rdst = lds0 + N_K + (8 + (wid & 3)) * 1024;
#define MDMA_K(t, slot) do { m_glds16(ksrc + (size_t)(t) * 64 * AW, (unsigned)__builtin_amdgcn_readfirstlane(kdst + (slot) * KSL)); m_glds16(rsrc + (size_t)(t) * 64 * RDIM, (unsigned)__builtin_amdgcn_readfirstlane(rdst + (slot) * KSL)); } while (0)
#define MDMA_V(t, slot) m_glds16(vsrc + (size_t)(t) * 64 * AW, (unsigned)__builtin_amdgcn_readfirstlane(vdst + (slot) * MSLOT))
    ALDS const char* vp0 = lds + N_V + ((lane >> 4) & 1) * 32 + (lane & 3) * 8 + (4 * hi + ((lane & 15) >> 2)) * 64;
    ALDS const char* kp0 = lds + N_K + hi * 1024 + r32 * 16;
    MDMA_K(0, 0); MDMA_V(0, 0); MDMA_K(1, 1);
    bf16x8 qr[6];
    { const bf16_t* Qw = Qp + (size_t)(qb * 256 + wid * 32 + (r32 & 16)) * (NHEAD * QKB) + (r32 & 15) * 8 + hi * 128;
#pragma unroll
      for (int d0 = 0; d0 < 6; ++d0) qr[d0] = *(const bf16x8*)(Qw + (d0 >> 1) * 512 + (d0 & 1) * 256); }
    MDMA_K(2, 2);
    float mhat = 0.f, l_reg = 0.f; f32x16 o[2]; o[0] = f32x16{}; o[1] = f32x16{};
    const int qrel = wid * 32 + r32; bool resc = false, moved = false;
    constexpr bool gated = false; constexpr unsigned sel = 0xffu;
#define MCM(t) do { } while (0)
#define MREL(C0, C1) do { if (__builtin_expect(__any(mhat != 0.f), 0)) { _Pragma("unroll") for (int r = 0; r < 16; ++r) { C0[r] -= mhat; C1[r] -= mhat; } } } while (0)
    f32x16 pA0, pA1, pB0, pB1; bf16x8 kf[12]; s16x4 vlo[8], vhi[8]; u32x4 pw0, pw1, pw2, pw3;
    int sl_prev = 0, sl_cur = 0, sl_next = 1;
#define MROT() do { sl_prev = sl_cur; sl_cur = sl_next; sl_next = (sl_next == 2) ? 0 : sl_next + 1; } while (0)
#define MEX(v) __builtin_amdgcn_exp2f(v)
#define MRESC(tn) do { if (resc) { _Pragma("unroll") for (int d_ = 0; d_ < 2; ++d_) _Pragma("unroll") for (int r = 0; r < 16; ++r) o[d_][r] *= wsf[crow(r, hi)]; } } while (0)
#define MDECIDE(C0, C1) do { const float rm = m_rowmax(C0, C1); resc = false; \
      if (__builtin_expect(__any(rm > THR), 0)) { const float dl = __builtin_fmaxf(rm, 0.f); mhat += dl; const float f = __builtin_amdgcn_exp2f(-dl); l_reg *= f; if (hi == 0) wsf[r32] = f; resc = true; \
          _Pragma("unroll") for (int r = 0; r < 16; ++r) { C0[r] -= dl; C1[r] -= dl; } moved = true; } } while (0)
    MWAIT_BAR(5);
#pragma unroll
    for (int d0 = 0; d0 < 6; ++d0) m_kload2(kf, kp0, d0);
    pA0 = MMFMA(kf[0], qr[0], (f32x16){}); pA1 = MMFMA(kf[1], qr[0], (f32x16){}); pA0 = MMFMA(kf[2], qr[1], pA0); pA1 = MMFMA(kf[3], qr[1], pA1);
    pA0 = MMFMA(kf[4], qr[2], pA0); pA1 = MMFMA(kf[5], qr[2], pA1); pA0 = MMFMA(kf[6], qr[3], pA0); pA1 = MMFMA(kf[7], qr[3], pA1);
    pA0 = MMFMA(kf[8], qr[4], pA0); pA1 = MMFMA(kf[9], qr[4], pA1); pA0 = MMFMA(kf[10], qr[5], pA0); pA1 = MMFMA(kf[11], qr[5], pA1);
    if (NT == 4) cmask(pA0, pA1, 0, qrel, hi);
    MREL(pA0, pA1); MDECIDE(pA0, pA1);
#pragma unroll
    for (int r = 0; r < 16; ++r) { pA0[r] = MEX(pA0[r]); pA1[r] = MEX(pA1[r]); }
    MWAIT_BAR(0);
    MDMA_K(3, 0); MDMA_V(1, 1); MROT();
#pragma unroll
    for (int d0 = 0; d0 < 6; ++d0) m_kload2(kf, kp0 + sl_cur * KSL, d0);
    MWAIT_BAR(3);
#define MPKW(P, i) cvtpk(P[i], P[i + 1])
#define MPAF(k) __builtin_bit_cast(bf16x8, pw##k)
#define MVFR(i) (bf16x8){vlo[i][0], vlo[i][1], vlo[i][2], vlo[i][3], vhi[i][0], vhi[i][1], vhi[i][2], vhi[i][3]}
#define MVRD(i) do { vlo[i] = m_vtr(vp_ + (((i) >> 2) * 4096 + ((i) & 3) * 1024)); vhi[i] = m_vtr(vp_ + (((i) >> 2) * 4096 + ((i) & 3) * 1024 + 512)); } while (0)
#define MKRD(G, d0) do { if (G) { m_kload2(kf, kp0 + sl_next * KSL, d0); ASBAR(); } } while (0)
#define MGAPA(MF, a0, a1, a2, a3, W0, W1, PW) do { MF; sacc += a0; sacc += a1; sacc += a2; sacc += a3; W0; W1; MPIN(PW); MPIN(sacc); ASBAR(); } while (0)
#define MGAPB(MF, X, i) do { MF; X[i] = MEX(X[i]); X[i + 1] = MEX(X[i + 1]); X[i + 2] = MEX(X[i + 2]); X[i + 3] = MEX(X[i + 3]); MPIN(X); ASBAR(); } while (0)
#define MGAPA2(MF, a0, a1, W0, PW) do { MF; sacc += a0; sacc += a1; W0; MPIN(PW); MPIN(sacc); ASBAR(); } while (0)
#define MSTEP(C0, C1, P0, P1, t, MASK, GK, GV, GL) do { ASBAR(); \
    const ALDS char* vp_ = vp0 + sl_prev * MSLOT; \
    MVRD(0); ASBAR(); float sacc = P0[0] + P0[1]; \
                     MGAPA(C0 = MMFMA(kf[0], qr[0], (f32x16){}), P0[2], P0[3], P0[4], P0[5],     pw0[0] = MPKW(P0, 0),  pw0[1] = MPKW(P0, 2),  pw0); \
    MVRD(4); ASBAR(); MGAPA(C1 = MMFMA(kf[1], qr[0], (f32x16){}), P0[6], P0[7], P0[8], P0[9],     pw0[2] = MPKW(P0, 4),  pw0[3] = MPKW(P0, 6),  pw0); \
    MVRD(1); ASBAR(); MGAPA2(C0 = MMFMA(kf[2], qr[1], C0), P0[10], P0[11], pw1[0] = MPKW(P0, 8),  pw1); \
    MVRD(5); ASBAR(); MGAPA2(C1 = MMFMA(kf[3], qr[1], C1), P0[12], P0[13], pw1[1] = MPKW(P0, 10), pw1); \
                     MGAPA2(C0 = MMFMA(kf[4], qr[2], C0), P0[14], P0[15], pw1[2] = MPKW(P0, 12), pw1); \
                     MGAPA2(C1 = MMFMA(kf[5], qr[2], C1), P1[0], P1[1],   pw1[3] = MPKW(P0, 14), pw1); \
                     MGAPA2(C0 = MMFMA(kf[6], qr[3], C0), P1[2], P1[3],   pw2[0] = MPKW(P1, 0),  pw2); \
                     MGAPA2(C1 = MMFMA(kf[7], qr[3], C1), P1[4], P1[5],   pw2[1] = MPKW(P1, 2),  pw2); \
                     MGAPA(C0 = MMFMA(kf[8], qr[4], C0), P1[6], P1[7], P1[8], P1[9],     pw2[2] = MPKW(P1, 4),  pw2[3] = MPKW(P1, 6),  pw2); \
                     MGAPA(C1 = MMFMA(kf[9], qr[4], C1), P1[10], P1[11], P1[12], P1[13], pw3[0] = MPKW(P1, 8),  pw3[1] = MPKW(P1, 10), pw3); \
                     MGAPA2(C0 = MMFMA(kf[10], qr[5], C0), P1[14], P1[15], pw3[2] = MPKW(P1, 12), pw3); \
                     MGAPA2(C1 = MMFMA(kf[11], qr[5], C1), 0.f, 0.f,       pw3[3] = MPKW(P1, 14), pw3); \
    l_reg += sacc; \
    if (GK) MDMA_K((t) + 3, sl_cur); if (GV) MDMA_V((t) + 1, sl_next); \
    if (MASK) cmask(C0, C1, (t) - NP, qrel, hi); \
    MREL(C0, C1); MDECIDE(C0, C1); ASBAR(); \
    MVRD(2); MKRD(GL, 4); ASBAR(); MGAPB(o[0] = MMFMA(MPAF(0), MVFR(0), o[0]), C0, 0);  MVRD(6); MKRD(GL, 5); ASBAR(); MGAPB(o[1] = MMFMA(MPAF(0), MVFR(4), o[1]), C0, 4); \
    MVRD(3); MKRD(GL, 0); ASBAR(); MGAPB(o[0] = MMFMA(MPAF(1), MVFR(1), o[0]), C0, 8);  MVRD(7); MKRD(GL, 1); ASBAR(); MGAPB(o[1] = MMFMA(MPAF(1), MVFR(5), o[1]), C0, 12); \
    MKRD(GL, 2); MGAPB(o[0] = MMFMA(MPAF(2), MVFR(2), o[0]), C1, 0);  MKRD(GL, 3); MGAPB(o[1] = MMFMA(MPAF(2), MVFR(6), o[1]), C1, 4); \
    MGAPB(o[0] = MMFMA(MPAF(3), MVFR(3), o[0]), C1, 8);               MGAPB(o[1] = MMFMA(MPAF(3), MVFR(7), o[1]), C1, 12); \
    } while (0)
    int t = 1;
    for (; t + 5 < NT; t += 2) {
        MSTEP(pB0, pB1, pA0, pA1, t, false, true, true, true);     MWAIT_BAR(3); MRESC(t + 1); MROT();
        MSTEP(pA0, pA1, pB0, pB1, t + 1, false, true, true, true); MWAIT_BAR(3); MRESC(t + 2); MROT();
    }
#define MENDW(tt) do { if ((tt) + 3 < NT) { MWAIT_BAR(3); } else if ((tt) + 2 < NT) { MWAIT_BAR(1); } else { MWAIT_BAR(0); } } while (0)
    for (; t + 1 < NT; t += 2) {
        MSTEP(pB0, pB1, pA0, pA1, t, true, (t + 3 < NT), (t + 1 < NT), (t + 1 < NT));         MENDW(t);     MRESC(t + 1); MROT();
        MSTEP(pA0, pA1, pB0, pB1, t + 1, true, (t + 4 < NT), (t + 2 < NT), (t + 2 < NT));     MENDW(t + 1); MRESC(t + 2); MROT();
    }
    MSTEP(pB0, pB1, pA0, pA1, NT - 1, true, false, false, false); MRESC(NT - 1);
    { float sacc = pB0[0] + pB0[1];
#pragma unroll
      for (int r = 2; r < 16; ++r) sacc += pB0[r];
#pragma unroll
      for (int r = 0; r < 16; ++r) sacc += pB1[r];
      l_reg += sacc;
      pw0 = (u32x4){MPKW(pB0, 0), MPKW(pB0, 2), MPKW(pB0, 4), MPKW(pB0, 6)}; pw1 = (u32x4){MPKW(pB0, 8), MPKW(pB0, 10), MPKW(pB0, 12), MPKW(pB0, 14)};
      pw2 = (u32x4){MPKW(pB1, 0), MPKW(pB1, 2), MPKW(pB1, 4), MPKW(pB1, 6)}; pw3 = (u32x4){MPKW(pB1, 8), MPKW(pB1, 10), MPKW(pB1, 12), MPKW(pB1, 14)};
      const ALDS char* vp_ = vp0 + sl_cur * MSLOT;
#pragma unroll
      for (int i = 0; i < 8; ++i) MVRD(i);
      o[0] = MMFMA(MPAF(0), MVFR(0), o[0]); o[1] = MMFMA(MPAF(0), MVFR(4), o[1]); o[0] = MMFMA(MPAF(1), MVFR(1), o[0]); o[1] = MMFMA(MPAF(1), MVFR(5), o[1]);
      o[0] = MMFMA(MPAF(2), MVFR(2), o[0]); o[1] = MMFMA(MPAF(2), MVFR(6), o[1]); o[0] = MMFMA(MPAF(3), MVFR(3), o[0]); o[1] = MMFMA(MPAF(3), MVFR(7), o[1]); }
    { auto rr = __builtin_amdgcn_permlane32_swap(__float_as_uint(l_reg), __float_as_uint(l_reg), false, false); l_reg = __uint_as_float(rr[0]) + __uint_as_float(rr[1]); }
    if (hi == 0) wsf[32 + r32] = l_reg; asm volatile("s_waitcnt lgkmcnt(0)" ::: "memory");
    float rli[16];
#pragma unroll
    for (int r = 0; r < 16; ++r) rli[r] = __builtin_amdgcn_rcpf(wsf[32 + crow(r, hi)]);
    { ALDS unsigned short* stg = (ALDS unsigned short*)(lds + N_OST) + wid * 2048;
#pragma unroll
      for (int r = 0; r < 16; ++r) { const int orow = crow(r, hi);
#pragma unroll
          for (int d0 = 0; d0 < 2; ++d0) stg[orow * 64 + d0 * 32 + r32] = (unsigned short)(cvtpk(o[d0][r] * rli[r], 0.f) & 0xffffu); }
      asm volatile("s_waitcnt lgkmcnt(0)" ::: "memory");
      bf16_t* Ow = Op + (size_t)(qb * 256 + wid * 32) * ldo;
#pragma unroll
      for (int i = 0; i < 4; ++i) { const int row = i * 8 + (lane >> 3), ch = lane & 7; const u32x4 v = *(ALDS const u32x4*)(stg + row * 64 + ch * 8); *(u32x4*)(Ow + (size_t)row * ldo + ch * 8) = v; } }
    asm volatile("s_waitcnt lgkmcnt(0)\n\ts_barrier" ::: "memory");
#undef MDMA_K
#undef MDMA_V
#undef MCM
#undef MROT
#undef MEX
#undef MRESC
#undef MDECIDE
#undef MPKW
#undef MPAF
#undef MVFR
#undef MVRD
#undef MKRD
#undef MGAPA
#undef MGAPB
#undef MSTEP
#undef MENDW
#undef MGAPA2
#undef MREL
}
#undef ASBAR
}
#define GAS __attribute__((address_space(1)))
#define LAS __attribute__((address_space(3)))
typedef unsigned short bf16;
typedef unsigned v4u __attribute__((ext_vector_type(4)));
typedef float f32x4 __attribute__((ext_vector_type(4)));
typedef short bf16x8 __attribute__((ext_vector_type(8)));
typedef GAS unsigned gu32;
typedef GAS unsigned long long gu64;
#define RLX_AGENT __ATOMIC_RELAXED, __HIP_MEMORY_SCOPE_AGENT
#define LDS_WAIT() asm volatile("s_waitcnt lgkmcnt(0)" ::: "memory")
#define VM_WAIT() asm volatile("s_waitcnt vmcnt(0)" ::: "memory")
__device__ __forceinline__ unsigned long long rt() { return __builtin_amdgcn_s_memrealtime(); }
__device__ __forceinline__ unsigned f2bf(float f) { unsigned u = __builtin_bit_cast(unsigned, f); return (u + 0x7fffu + ((u >> 16) & 1u)) >> 16; }
__device__ __forceinline__ unsigned pk2(float lo, float hi) { return f2bf(lo) | (f2bf(hi) << 16); }

#define XB_TMO      128
#define XB_XCNT(j)  (256  + 64 * (j))
#define XB_XSUB(j)  (1280 + 64 * (j))
#define XB_XGEN(j)  (2304 + 64 * (j))
#define XB_TOP      3328
#define XB_TOPGEN   3392
#define XCD_BAR_WORDS 3456
#define XB_SPIN_CAP (1u << 18)

__device__ __forceinline__ unsigned xb_ld(unsigned* p)              { return __hip_atomic_load(p, __ATOMIC_RELAXED, __HIP_MEMORY_SCOPE_AGENT); }
__device__ __forceinline__ unsigned xb_add(unsigned* p, unsigned v) { return __hip_atomic_fetch_add(p, v, __ATOMIC_RELAXED, __HIP_MEMORY_SCOPE_AGENT); }
__device__ __forceinline__ unsigned xb_xcc_id() { return (unsigned)__builtin_amdgcn_s_getreg((3 << 11) | 20) & 0xFu; }
#define XB_SPIN(cond, bar) do { unsigned _sp = 0; while (cond) { __builtin_amdgcn_s_sleep(1); \
    if ((++_sp & 255u) == 0u) { if (xb_ld(&(bar)[XB_TMO])) break; if (_sp > XB_SPIN_CAP) { atomicAdd(&(bar)[XB_TMO], 1u); break; } } } } while (0)

struct XcdBarrier {
    unsigned* bar; unsigned x;
    volatile LAS unsigned* st;
};

__device__ __forceinline__ XcdBarrier xcd_barrier_post(unsigned* bar, volatile LAS unsigned* st) {
    XcdBarrier b; b.bar = bar; b.x = xb_xcc_id(); b.st = st;
    if (threadIdx.x == 0) (void)xb_add(&bar[XB_XCNT(b.x)], 1u);
    return b;
}
__device__ __forceinline__ void xcd_barrier_complete(unsigned* bar, unsigned x, unsigned& nloc, unsigned& nx) {
    const unsigned G = gridDim.x * gridDim.y * gridDim.z;
    unsigned sum, cnt, mine, sp = 0u;
    for (;;) {
        sum = 0u; cnt = 0u; mine = 0u;
#pragma unroll
        for (unsigned j = 0; j < 16; ++j) { const unsigned c = xb_ld(&bar[XB_XCNT(j)]); sum += c; cnt += (c > 0u) ? 1u : 0u; mine = (j == x) ? c : mine; }
        if (sum == G) break;
        __builtin_amdgcn_s_sleep(1);
        if ((++sp & 255u) == 0u) { if (xb_ld(&bar[XB_TMO])) break; if (sp > XB_SPIN_CAP) { atomicAdd(&bar[XB_TMO], 1u); break; } }
    }
    nloc = mine > 0u ? mine : 1u; nx = cnt > 0u ? cnt : 1u;
}

__device__ __forceinline__ void xcd_barrier(const XcdBarrier& b) {
    asm volatile("s_waitcnt vmcnt(0)" ::: "memory");
    __syncthreads();
    if (threadIdx.x == 0) {
        unsigned* bar = b.bar;
        __builtin_amdgcn_s_waitcnt(0);
        unsigned nloc = b.st[0], nx = b.st[1];
        if (nloc == 0u) { xcd_barrier_complete(bar, b.x, nloc, nx); b.st[0] = nloc; b.st[1] = nx; }
        const unsigned old = xb_add(&bar[XB_XSUB(b.x)], 1u);
        const unsigned gen = old / nloc;
        if (old + 1u == (gen + 1u) * nloc) {
            __builtin_amdgcn_fence(__ATOMIC_RELEASE, "agent");
            asm volatile("s_waitcnt vmcnt(0)" ::: "memory");
            const unsigned og = xb_add(&bar[XB_TOP], 1u);
            const unsigned tg = og / nx;
            if (og + 1u == (tg + 1u) * nx) xb_add(&bar[XB_TOPGEN], 1u);
            else XB_SPIN(xb_ld(&bar[XB_TOPGEN]) == tg, bar);
            __builtin_amdgcn_fence(__ATOMIC_ACQUIRE, "agent");
            xb_add(&bar[XB_XGEN(b.x)], 1u);
            asm volatile("s_waitcnt vmcnt(0)" ::: "memory");
        } else {
            XB_SPIN(xb_ld(&bar[XB_XGEN(b.x)]) == gen, bar);
            __builtin_amdgcn_fence(__ATOMIC_ACQUIRE, "agent");
            asm volatile("s_waitcnt vmcnt(0)" ::: "memory");
        }
    }
    __syncthreads();
}

constexpr size_t MiB = 1u << 20;
constexpr size_t WS_CTL = 0, CTL_ZERO_BYTES = 64 * 1024;
constexpr size_t WS_ROPEA = 1 * MiB, WS_ROPEB = 5 * MiB;
constexpr size_t WS_SS = 13 * MiB, WS_SS2 = 16 * MiB, WS_SS3 = 20 * MiB;
constexpr size_t WS_WIN = 24 * MiB, WS_WUQ = 34 * MiB, WS_WUKV = 35 * MiB, WS_WA = 36 * MiB, WS_WOUT = 39 * MiB, WS_WUP = 42 * MiB, WS_WDN = 51 * MiB;
constexpr size_t WS_H = 64 * MiB;
constexpr size_t WS_G = 208 * MiB;
constexpr size_t WS_QA = 464 * MiB, WS_KA = 528 * MiB, WS_VA = 592 * MiB;
constexpr size_t WS_T = WS_KA;
constexpr size_t WS_CQ = 672 * MiB, WS_CKV = 720 * MiB;
constexpr size_t WS_KR = 760 * MiB;
constexpr size_t WS_QB = 768 * MiB, WS_KB = 864 * MiB, WS_VB = 928 * MiB;
constexpr size_t WS_Y = WS_QB;
constexpr size_t WS_X1 = 896 * MiB;
constexpr size_t WS_H8 = WS_QB;
constexpr size_t WS_WG8 = 60 * MiB;
constexpr size_t WS_U = 208 * MiB;
constexpr size_t WS_END = 1024 * MiB;
static_assert(WS_H + (size_t)MTOK * LDH * 2 <= WS_G && WS_G + (size_t)MTOK * 2 * DM * 2 <= WS_QA && WS_T + (size_t)MTOK * LDH * 2 <= WS_CQ && WS_CQ + (size_t)MTOK * QLORA * 2 <= WS_CKV && WS_CKV + (size_t)MTOK * LDKV * 2 <= WS_KR, "d_ws map");
static_assert(WS_U + (size_t)MTOK * LDU * 2 <= WS_KR && WS_Y + (size_t)MTOK * DM * 2 <= WS_X1 && WS_X1 + (size_t)MTOK * DM * 2 <= WS_END && WS_VB + (size_t)MTOK * AW * 2 <= WS_END && WS_KR + (size_t)MTOK * RDIM * 2 <= WS_QB, "d_ws map");
static_assert(WS_WIN + (size_t)INWP * LDH * 2 <= WS_WUQ && WS_WUKV + (size_t)1024 * LDKV * 2 <= WS_WA && WS_WA + (size_t)DM * LDH * 2 <= WS_WOUT && WS_WOUT + (size_t)DM * LDH * 2 <= WS_WUP && WS_WUP + (size_t)DFF * LDH * 2 <= WS_WDN && WS_WDN + (size_t)DM * LDU * 2 <= WS_H, "d_ws map");
constexpr int CW_BAR = 0;
constexpr int NWAVES = 8;
constexpr int RING_OFF = 0, RING_BYTES = 131072;
constexpr int LDSCTL_OFF = RING_BYTES, MISC_OFF = LDSCTL_OFF + 320;
constexpr int LDS_BYTES = 147456;
static_assert(att::L_END <= RING_BYTES, "attention LDS map");

struct Frame {
    LAS unsigned char* lds;
    volatile LAS unsigned* MISC;
    gu32* ctl;
    int tid, lane, wave, vcu, G;
};

__device__ __forceinline__ float wave_sum(float v) {
#pragma unroll
    for (int o = 1; o < 64; o <<= 1) v += __shfl_xor(v, o);
    return v;
}
__device__ __forceinline__ int srccol(int mat, int n) {
    if (mat == 0) {
        if (n < 1024) { const int sect = n >> 9, c = n & 511, head = c >> 6, p = c & 63; const int d = (p < 16) ? ((p >> 1) + 8 * (p & 1)) : p; return sect * 512 + head * 64 + d; }
        if (n < 1920) return n;
        if (n < 1952) { const int pr = n - 1920; return 2176 + (pr >> 1) + 16 * (pr & 1); }
        if (n < 2048) return -1;
        if (n < 2304) return 1920 + (n - 2048);
        return 2208 + (n - 2304);
    }
    if (mat == 1) { const int head = n / QKB, p = n - head * QKB; if (p < 64) return n; const int pr = p - 64; return head * QKB + 64 + (pr >> 1) + 16 * (pr & 1); }
    return n;
}
__device__ __forceinline__ void p0_transpose_item(const float* W, int K, int Nsrc, int Ndst, bf16* WT, int ldw, int koff, const float* gs, int mat, LAS float* scr, int item, int lane) {
    const int nblk = Ndst / 32, kb = item / nblk, nb = item % nblk, k0 = 64 * kb, n0 = 32 * nb;
    const int sc = srccol(mat, n0 + (lane & 31));
#pragma unroll 8
    for (int i = 0; i < 32; ++i) { const int kk = 2 * i + (lane >> 5); float v = (sc >= 0) ? W[(size_t)(k0 + kk) * Nsrc + sc] : 0.f; if (gs) v *= gs[k0 + kk]; scr[kk * 33 + (lane & 31)] = v; }
    LDS_WAIT(); asm volatile("" ::: "memory");
    const int c = lane & 7;
#pragma unroll
    for (int j = 0; j < 4; ++j) { const int n = (lane >> 3) + 8 * j; const LAS float* s = scr + (8 * c) * 33 + n;
        v4u o; o.x = pk2(s[0 * 33], s[1 * 33]); o.y = pk2(s[2 * 33], s[3 * 33]); o.z = pk2(s[4 * 33], s[5 * 33]); o.w = pk2(s[6 * 33], s[7 * 33]);
        *(GAS v4u*)(WT + (size_t)(n0 + n) * ldw + koff + k0 + 8 * c) = o; }
    LDS_WAIT(); asm volatile("" ::: "memory");
}
__device__ __forceinline__ int ppos_dn(int c) { return (c & ~255) | (((c >> 5) & 3) << 6) | (((c >> 3) & 3) << 4) | (((c >> 7) & 1) << 3) | (c & 7); }
template <bool KPERM = false>
__device__ __forceinline__ void p0_transpose_item_f8(const float* W, int K, int N, int Nsrc, int coff, unsigned char* WT, float scale, LAS float* scr, int item, int lane) {
    const int nblk = N / 32, kb = item / nblk, nb = item % nblk, k0 = 64 * kb, n0 = 32 * nb;
#pragma unroll 8
    for (int i = 0; i < 32; ++i) { const int kk = 2 * i + (lane >> 5); scr[kk * 33 + (lane & 31)] = W[(size_t)(k0 + kk) * Nsrc + coff + n0 + (lane & 31)] * scale; }
    LDS_WAIT(); asm volatile("" ::: "memory");
    const int c = lane & 7;
#pragma unroll
    for (int j = 0; j < 4; ++j) { const int n = (lane >> 3) + 8 * j; const LAS float* s = scr + (8 * c) * 33 + n;
        int w0 = 0, w1 = 0;
        w0 = __builtin_amdgcn_cvt_pk_fp8_f32(s[0 * 33], s[1 * 33], w0, false); w0 = __builtin_amdgcn_cvt_pk_fp8_f32(s[2 * 33], s[3 * 33], w0, true);
        w1 = __builtin_amdgcn_cvt_pk_fp8_f32(s[4 * 33], s[5 * 33], w1, false); w1 = __builtin_amdgcn_cvt_pk_fp8_f32(s[6 * 33], s[7 * 33], w1, true);
        typedef int i32x2_ __attribute__((ext_vector_type(2)));
        *(GAS i32x2_*)(WT + (size_t)(n0 + n) * K + (KPERM ? ppos_dn(k0 + 8 * c) : k0 + 8 * c)) = (i32x2_){w0, w1}; }
    LDS_WAIT(); asm volatile("" ::: "memory");
}
__device__ __forceinline__ void rms_row_to_bf16(int lane, const float* xrow, const f32x4 (&g)[4], bf16* orow, unsigned char* orow8) {
    const GAS f32x4* xr = (const GAS f32x4*)xrow + lane;
    f32x4 v[4]; float s = 0.f;
#pragma unroll
    for (int j = 0; j < 4; ++j) { v[j] = xr[64 * j]; s += (v[j].x * v[j].x + v[j].y * v[j].y) + (v[j].z * v[j].z + v[j].w * v[j].w); }
    const float rstd = 1.f / sqrtf(wave_sum(s) * (1.f / DM) + EPS);
    GAS unsigned long long* o8 = (GAS unsigned long long*)orow + lane;
#pragma unroll
    for (int j = 0; j < 4; ++j) { const f32x4 y = v[j] * rstd * g[j]; o8[64 * j] = (unsigned long long)pk2(y.x, y.y) | ((unsigned long long)pk2(y.z, y.w) << 32);
        int w = 0; w = __builtin_amdgcn_cvt_pk_fp8_f32(y.x, y.y, w, false); w = __builtin_amdgcn_cvt_pk_fp8_f32(y.z, y.w, w, true); ((GAS int*)orow8)[lane + 64 * j] = w; }
}

struct Args { const float* in[17]; float* out; unsigned char* ws; int ph_lo, ph_hi, li, pad; };

__global__ void __launch_bounds__(NWAVES * 64, 2) block_fwd(Args args) {
    extern __shared__ __attribute__((aligned(16))) unsigned char lds[];
    Frame F;
    F.lds = (LAS unsigned char*)lds;
    F.MISC = (volatile LAS unsigned*)(F.lds + MISC_OFF);
    F.tid = threadIdx.x; F.lane = F.tid & 63; F.wave = __builtin_amdgcn_readfirstlane(F.tid >> 6);
    F.G = gridDim.x; { const int bx = blockIdx.x; F.vcu = (F.G % 8 == 0) ? (bx % 8) * (F.G / 8) + bx / 8 : bx; }
    unsigned char* ws = args.ws;
    F.ctl = (gu32*)(ws + WS_CTL);
    const float* x = args.in[0]; const int* positions = (const int*)args.in[1];
    const float *g_pre_mix = args.in[2], *w_in = args.in[3], *b_gate = args.in[4], *g_q = args.in[5], *w_uq = args.in[6], *g_kv = args.in[7], *w_ukv = args.in[8], *w_a = args.in[9], *w_b = args.in[10],
                *w_out = args.in[11], *g_post_mix = args.in[12], *g_pre_mlp = args.in[13], *w_up = args.in[14], *w_dn = args.in[15], *g_post_mlp = args.in[16];
    float* out = args.out;
    float* ropeA = (float*)(ws + WS_ROPEA); float* ropeB = (float*)(ws + WS_ROPEB);
    float* SS = (float*)(ws + WS_SS); float* SS2 = (float*)(ws + WS_SS2); float* SS3 = (float*)(ws + WS_SS3);
    bf16 *WIN = (bf16*)(ws + WS_WIN), *WUQ = (bf16*)(ws + WS_WUQ), *WUKV = (bf16*)(ws + WS_WUKV), *WA = (bf16*)(ws + WS_WA), *WOUT = (bf16*)(ws + WS_WOUT), *WUP = (bf16*)(ws + WS_WUP), *WDN = (bf16*)(ws + WS_WDN);
    bf16 *H = (bf16*)(ws + WS_H), *Gt = (bf16*)(ws + WS_G), *QA = (bf16*)(ws + WS_QA), *KA = (bf16*)(ws + WS_KA), *VA = (bf16*)(ws + WS_VA), *T = (bf16*)(ws + WS_T), *CQ = (bf16*)(ws + WS_CQ), *CKV = (bf16*)(ws + WS_CKV),
         *KR = (bf16*)(ws + WS_KR), *QB = (bf16*)(ws + WS_QB), *KB = (bf16*)(ws + WS_KB), *VB = (bf16*)(ws + WS_VB), *Y = (bf16*)(ws + WS_Y), *U = (bf16*)(ws + WS_U), *X1B = (bf16*)(ws + WS_X1); unsigned char *H8 = ws + WS_H8, *WG8 = ws + WS_WG8;
    for (int u = F.tid; u < (LDS_BYTES - LDSCTL_OFF) / 4; u += NWAVES * 64) ((LAS unsigned*)(F.lds + LDSCTL_OFF))[u] = 0u;
    __syncthreads();
    XcdBarrier bar = xcd_barrier_post((unsigned*)(F.ctl + CW_BAR) + args.li * XCD_BAR_WORDS, F.MISC + 8);
    const int lo = args.ph_lo, hi = args.ph_hi;
#define IN(k) (lo <= (k) && (k) < hi)
#define SEAM(k) do { if (IN(k) && IN((k) + 1)) xcd_barrier(bar); } while (0)
    const int gw = F.vcu * NWAVES + F.wave, NGW = F.G * NWAVES;

#if !defined(SKIP_P0)
    if (IN(0))
    {
        LAS float* scr = (LAS float*)(F.lds + RING_OFF + F.wave * 16384);
        constexpr int NBF = 2304, IG = (DM / 64) * (2 * DM / 32);
        constexpr int I0 = (DM / 64) * (NBF / 32), I1 = (QLORA / 64) * (768 / 32), I2 = (KVLORA / 64) * (1024 / 32), I3 = (AW / 64) * (DM / 32), I5 = (DM / 64) * (DM / 32), I6 = (DM / 64) * (DFF / 32), I7 = (DFF / 64) * (DM / 32);
        constexpr int NITEMS = I0 + I1 + I2 + 2 * I3 + I5 + I6 + I7 + IG;
        for (int it = gw; it < NITEMS; it += NGW) {
            int r = it;
            if (r < I0) { p0_transpose_item(w_in, DM, INW, NBF, WIN, LDH, 0, nullptr, 0, scr, r, F.lane); continue; } r -= I0;
            if (r < IG) { p0_transpose_item_f8(w_in, DM, 2 * DM, INW, 2208, WG8, 32.f, scr, r, F.lane); continue; } r -= IG;
            if (r < I1) { p0_transpose_item(w_uq, QLORA, 768, 768, WUQ, QLORA, 0, g_q, 1, scr, r, F.lane); continue; } r -= I1;
            if (r < I2) { p0_transpose_item(w_ukv, KVLORA, 1024, 1024, WUKV, LDKV, 0, g_kv, 2, scr, r, F.lane); continue; } r -= I2;
            if (r < I3) { p0_transpose_item(w_a, AW, DM, DM, WA, LDH, 0, nullptr, 2, scr, r, F.lane); continue; } r -= I3;
            if (r < I3) { p0_transpose_item(w_b, AW, DM, DM, WA, LDH, AW, nullptr, 2, scr, r, F.lane); continue; } r -= I3;
            if (r < I5) { p0_transpose_item(w_out, DM, DM, DM, WOUT, LDH, 0, nullptr, 2, scr, r, F.lane); continue; } r -= I5;
            if (r < I6) { p0_transpose_item_f8(w_up, DM, DFF, DFF, 0, (unsigned char*)WUP, 32.f, scr, r, F.lane); continue; } r -= I6;
            p0_transpose_item_f8<true>(w_dn, DFF, DM, DM, 0, (unsigned char*)WDN, 64.f, scr, r, F.lane);
        }
        for (int idx = (int)blockIdx.x * (NWAVES * 64) + F.tid; idx < MTOK * 24; idx += F.G * NWAVES * 64) {
            const int m = idx / 24, i = idx - m * 24;
            const float invf = (i < 8) ? __builtin_amdgcn_exp2f(-(float)i * 2.3664460711655217f) : __builtin_amdgcn_exp2f(-(float)(i - 8) * 1.1832230355827609f);
            const float ang = (float)positions[m] * invf;
            double t = (double)ang * 0.15915494309189535; t -= floor(t);
            const float tf = (float)t; const float c = __builtin_amdgcn_cosf(tf), s = __builtin_amdgcn_sinf(tf);
            float* dst = (i < 8) ? ropeA + (size_t)m * 16 + 2 * i : ropeB + (size_t)m * 32 + 2 * (i - 8);
            *(f32x2g*)dst = (f32x2g){c, s};
        }
        f32x4 g[4];
#pragma unroll
        for (int j = 0; j < 4; ++j) g[j] = ((const GAS f32x4*)g_pre_mix)[F.lane + 64 * j];
        for (int m = gw; m < MTOK; m += NGW) rms_row_to_bf16(F.lane, x + (size_t)m * DM, g, H + (size_t)m * LDH, H8 + (size_t)m * DM);
    }
#endif
    SEAM(0);

#if !defined(SKIP_P1)
    if (IN(1))
    {
        { pg8::Gemm g{H, WIN, MTOK, 2304, DM, LDH, LDH}; pg8::StaticOrder S; S.init(MTOK, 2304, F.G, (int)blockIdx.x);
          pg8::EpiIn E{QA, KA, VA, CQ, CKV, KR, Gt, SS, ropeA, ropeB, b_gate};
          pg8::gemm_phase<pg8::EpiIn, pg8::StaticOrder, true, true>(F.lds + RING_OFF, g, S, E); }
        { pg8::Gemm g{(const bf16*)H8, (const bf16*)WG8, MTOK, 2 * DM, DM, DM, DM}; pg8::StaticOrder S; S.init(MTOK, 2 * DM, F.G, (int)blockIdx.x);
          pg8::EpiGates E{Gt, b_gate};
          pg8::gemm_phase<pg8::EpiGates, pg8::StaticOrder, true, true, 1>(F.lds + RING_OFF, g, S, E); }
    }
#endif
    SEAM(1);

#if !defined(SKIP_P2)
    if (IN(2)) {
    {
        pg8::Gemm g{CQ, WUQ, MTOK, NHEAD * QKB, QLORA}; pg8::StaticOrder S; S.init(MTOK, NHEAD * QKB, F.G, (int)blockIdx.x);
        pg8::EpiQ E{QB, SS, ropeB};
        pg8::gemm_phase<pg8::EpiQ, pg8::StaticOrder, true, true, 2, true>(F.lds + RING_OFF, g, S, E);
    }
    {
        pg8::Gemm g{CKV, WUKV, MTOK, 2 * AW, KVLORA, LDKV, LDKV}; pg8::StaticOrder S; S.init(MTOK, 2 * AW, F.G, (int)blockIdx.x);
        pg8::EpiKV E{KB, VB, SS};
        pg8::gemm_phase<pg8::EpiKV, pg8::StaticOrder, true, true, 2, true>(F.lds + RING_OFF, g, S, E);
    }
    }
#endif
    SEAM(2);

#if !defined(SKIP_P3)
    if (IN(3))
    {
        LAS char* al = (LAS char*)(F.lds + RING_OFF);
#if !defined(SKIP_MOBA)
        for (int bh = F.vcu; bh < NB * NHEAD; bh += F.G) {
            const int b = bh >> 3, h = bh & 7; const size_t r0 = (size_t)b * SEQ;
            att::kmean_blocks(KA + r0 * AW + h * HD * 16, al);
#pragma unroll 1
            for (int qb = 0; qb < 8; ++qb) att::moba_unit(QA + r0 * AW + h * HD * 16, KA + r0 * AW + h * HD * 16, VA + r0 * AW + h * HD * 16, H + r0 * LDH + h * HD, LDH, qb, al);
        }
#endif
#if !defined(SKIP_MLA)
        for (int bh = F.vcu; bh < NB * NHEAD; bh += F.G) {
            const int b = bh >> 3, h = bh & 7; const size_t r0 = (size_t)b * SEQ;
#pragma unroll 1
            for (int qb = 0; qb < 8; ++qb) att::mla_unit(QB + r0 * (NHEAD * QKB) + h * QKB * 16, KB + r0 * AW + h * HD * 16, KR + r0 * RDIM, VB + r0 * AW + h * HD * 16, H + r0 * LDH + AW + h * HD, LDH, qb, al);
        }
#endif
    }
#endif
    SEAM(3);

#if !defined(SKIP_P4)
    if (IN(4))
    {
        pg8::Gemm g{H, WA, MTOK, DM, DM, LDH, LDH}; pg8::StaticOrder S; S.init(MTOK, DM, F.G, (int)blockIdx.x);
        pg8::EpiMerge E{Gt, T};
        pg8::gemm_phase<pg8::EpiMerge, pg8::StaticOrder, true, true>(F.lds + RING_OFF, g, S, E);
    }
#endif
    SEAM(4);

#if !defined(SKIP_P5)
    if (IN(5))
    {
        pg8::Gemm g{T, WOUT, MTOK, DM, DM, LDH, LDH}; pg8::StaticOrder S; S.init(MTOK, DM, F.G, (int)blockIdx.x);
        pg8::EpiSS E{Y, SS2, DM, 1.0f};
        pg8::gemm_phase<pg8::EpiSS, pg8::StaticOrder, true, true, 2, true>(F.lds + RING_OFF, g, S, E);
    }
#endif
    SEAM(5);

#if !defined(SKIP_P6)
    if (IN(6))
    {
        f32x4 g1[4], g2[4];
#pragma unroll
        for (int j = 0; j < 4; ++j) { g1[j] = ((const GAS f32x4*)g_post_mix)[F.lane + 64 * j]; g2[j] = ((const GAS f32x4*)g_pre_mlp)[F.lane + 64 * j]; }
        for (int m = gw; m < MTOK; m += NGW) {
            const GAS f32x4* sp = (const GAS f32x4*)(SS2 + (size_t)m * 16); const f32x4 a = sp[0], b = sp[1], c = sp[2], d = sp[3];
            const float ssy = (((a.x + a.y) + (a.z + a.w)) + ((b.x + b.y) + (b.z + b.w))) + (((c.x + c.y) + (c.z + c.w)) + ((d.x + d.y) + (d.z + d.w)));
            const float rsy = 1.f / sqrtf(ssy * (1.f / DM) + EPS);
            const GAS f32x4* xr = (const GAS f32x4*)(x + (size_t)m * DM) + F.lane; const GAS unsigned long long* yr = (const GAS unsigned long long*)(Y + (size_t)m * DM) + F.lane;
            GAS unsigned long long* x8 = (GAS unsigned long long*)(X1B + (size_t)m * DM) + F.lane;
            f32x4 v[4]; float s = 0.f;
#pragma unroll
            for (int j = 0; j < 4; ++j) { const unsigned long long yw = yr[64 * j]; const unsigned lo = (unsigned)yw, hi = (unsigned)(yw >> 32);
                const f32x4 yv = (f32x4){__uint_as_float(lo << 16), __uint_as_float(lo & 0xffff0000u), __uint_as_float(hi << 16), __uint_as_float(hi & 0xffff0000u)};
                v[j] = xr[64 * j] + yv * rsy * g1[j]; x8[64 * j] = (unsigned long long)pk2(v[j].x, v[j].y) | ((unsigned long long)pk2(v[j].z, v[j].w) << 32);
                s += (v[j].x * v[j].x + v[j].y * v[j].y) + (v[j].z * v[j].z + v[j].w * v[j].w); }
            const float rstd = 1.f / sqrtf(wave_sum(s) * (1.f / DM) + EPS);
            GAS int* o8 = (GAS int*)((unsigned char*)H + (size_t)m * DM) + F.lane;
#pragma unroll
            for (int j = 0; j < 4; ++j) { const f32x4 y2 = v[j] * rstd * g2[j]; int w = 0; w = __builtin_amdgcn_cvt_pk_fp8_f32(y2.x, y2.y, w, false); w = __builtin_amdgcn_cvt_pk_fp8_f32(y2.z, y2.w, w, true); o8[64 * j] = w; }
        }
    }
#endif
    SEAM(6);

#if !defined(SKIP_P7)
    if (IN(7))
    {
        pg8::Gemm g{H, WUP, MTOK, DFF, DM, DM, DM}; pg8::StaticOrder S; S.init(MTOK, DFF, F.G, (int)blockIdx.x);
        pg8::EpiRelu2F8 E{(unsigned char*)U, 1.0f / 32.0f};
        pg8::gemm_phase<pg8::EpiRelu2F8, pg8::StaticOrder, true, true, 1>(F.lds + RING_OFF, g, S, E);
    }
#endif
    SEAM(7);

#if !defined(SKIP_P8)
    if (IN(8))
    {
        pg8::Gemm g{U, WDN, MTOK, DM, DFF, DFF, DFF}; pg8::StaticOrder S; S.init(MTOK, DM, F.G, (int)blockIdx.x);
        pg8::EpiSS E{H, SS3, LDH, 1.0f / 64.0f};
        pg8::gemm_phase<pg8::EpiSS, pg8::StaticOrder, true, true, 1, true>(F.lds + RING_OFF, g, S, E);
    }
#endif
    SEAM(8);

#if !defined(SKIP_P9)
    if (IN(9))
    {
        f32x4 g1[4];
#pragma unroll
        for (int j = 0; j < 4; ++j) g1[j] = ((const GAS f32x4*)g_post_mlp)[F.lane + 64 * j];
        for (int m = gw; m < MTOK; m += NGW) {
            const GAS f32x4* sp = (const GAS f32x4*)(SS3 + (size_t)m * 16); const f32x4 a = sp[0], b = sp[1], c = sp[2], d = sp[3];
            const float ssy = (((a.x + a.y) + (a.z + a.w)) + ((b.x + b.y) + (b.z + b.w))) + (((c.x + c.y) + (c.z + c.w)) + ((d.x + d.y) + (d.z + d.w)));
            const float rsy = 1.f / sqrtf(ssy * (1.f / DM) + EPS);
            const GAS unsigned long long* yr = (const GAS unsigned long long*)(H + (size_t)m * LDH) + F.lane;
            const GAS unsigned long long* xq = (const GAS unsigned long long*)(X1B + (size_t)m * DM) + F.lane;
            GAS f32x4* o4 = (GAS f32x4*)(out + (size_t)m * DM) + F.lane;
#pragma unroll
            for (int j = 0; j < 4; ++j) { const unsigned long long yw = yr[64 * j]; const unsigned lo = (unsigned)yw, hi = (unsigned)(yw >> 32);
                const f32x4 yv = (f32x4){__uint_as_float(lo << 16), __uint_as_float(lo & 0xffff0000u), __uint_as_float(hi << 16), __uint_as_float(hi & 0xffff0000u)};
                const unsigned long long xw = xq[64 * j]; const unsigned xl = (unsigned)xw, xh = (unsigned)(xw >> 32);
                const f32x4 xv = (f32x4){__uint_as_float(xl << 16), __uint_as_float(xl & 0xffff0000u), __uint_as_float(xh << 16), __uint_as_float(xh & 0xffff0000u)};
                o4[64 * j] = xv + yv * rsy * g1[j]; }
        }
    }
#endif
}

extern "C" void kernel_launch(void* const* d_in, const int* in_sizes, int n_in, void* d_out, int out_size, void* d_ws, size_t ws_size, hipStream_t stream) {
    static int grid = 0;
    if (grid == 0) {
        if (n_in != 17 || in_sizes[0] != MTOK * DM || out_size != MTOK * DM || ws_size < WS_END) { fprintf(stderr, "kernel_launch: unexpected shapes (n_in %d, in0 %d, out %d, ws %zu); nothing launched\n", n_in, n_in > 0 ? in_sizes[0] : -1, out_size, ws_size); grid = -1; return; }
        int dev = 0, cus = 0, per_cu = 0;
        if (hipGetDevice(&dev) != hipSuccess || hipDeviceGetAttribute(&cus, hipDeviceAttributeMultiprocessorCount, dev) != hipSuccess) { fprintf(stderr, "kernel_launch: device query failed\n"); grid = -1; return; }
        if (hipFuncSetAttribute((const void*)block_fwd, hipFuncAttributeMaxDynamicSharedMemorySize, LDS_BYTES) != hipSuccess) { fprintf(stderr, "kernel_launch: hipFuncSetAttribute failed\n"); grid = -1; return; }
        if (hipOccupancyMaxActiveBlocksPerMultiprocessor(&per_cu, (const void*)block_fwd, NWAVES * 64, LDS_BYTES) != hipSuccess || per_cu < 1) { fprintf(stderr, "kernel_launch: occupancy query reports %d workgroups per CU\n", per_cu); }
        (void)hipGetLastError();
        grid = cus;
    }
    if (grid < 0) return;
    if (hipMemsetAsync((char*)d_ws + WS_CTL, 0, CTL_ZERO_BYTES, stream) != hipSuccess) { fprintf(stderr, "kernel_launch: hipMemsetAsync failed\n"); return; }
    Args a{};
    for (int i = 0; i < 17; ++i) a.in[i] = (const float*)d_in[i];
    a.out = (float*)d_out; a.ws = (unsigned char*)d_ws;
    a.ph_lo = 0; a.ph_hi = 10; a.li = 0;
    hipLaunchKernelGGL(block_fwd, dim3(grid), dim3(NWAVES * 64), LDS_BYTES, stream, a);
    const hipError_t le = hipPeekAtLastError();
    if (le != hipSuccess) fprintf(stderr, "kernel_launch: launch failed: %s\n", hipGetErrorName(le));
}
```

```cpp
#include <hip/hip_runtime.h>
#include <hip/hip_bf16.h>
#include <cstdio>
#include <cstdint>
#include <cmath>
constexpr int NB = 32, SEQ = 2048, DM = 1024, MTOK = NB * SEQ;
constexpr int NHEAD = 8, HD = 64, AW = NHEAD * HD;
constexpr int QLORA = 384, KVLORA = 256, RDIM = 32, QKB = 96;
constexpr int DFF = 4096, INW = 4256, INWP = 4352;
constexpr int LDH = DM, LDU = DFF, LDKV = KVLORA;
constexpr float EPS = 1e-6f;
constexpr float LOG2E = 1.4426950408889634f;
constexpr float C2A = 0.125f * LOG2E;
constexpr float C2B = 0.10206207261596575f * LOG2E;
typedef float f32x2g __attribute__((ext_vector_type(2)));
namespace pg8 {
#define PG8_LAS __attribute__((address_space(3)))
typedef unsigned short bf16_t;
typedef short bf16x8 __attribute__((ext_vector_type(8)));
typedef float f32x4 __attribute__((ext_vector_type(4)));
typedef unsigned u32x4 __attribute__((ext_vector_type(4)));
constexpr int BM = 256, BK = 64, HALF = 128, HTB = HALF * BK * 2  , STAGE_BYTES = 8 * HTB, NXCD = 8, WGM = 8;

__host__ __device__ __forceinline__ int lds_byte(int r, int c) { const int st = (r >> 4) * 2 + (c >> 5), rr = r & 15, cc = c & 31, ob = rr * 64 + cc * 2; return st * 1024 + (ob ^ (((ob >> 9) & 1) << 5)); }
__host__ __device__ __forceinline__ void stage_rc(int b, int& R, int& C) { const int st = b / 1024, sb = b % 1024, swz = sb ^ (((sb >> 9) & 1) << 5); R = (st >> 1) * 16 + swz / 64; C = (st & 1) * 32 + (swz % 64) / 2; }
__host__ __device__ __forceinline__ int perm32(int rho) { const int n = rho >> 4, i = rho & 15; return 8 * (i >> 2) + 4 * n + (i & 3); }

struct Unit { int pm, pn; };
struct Gemm { const bf16_t* A; const bf16_t* Bt; int M, N, K, lda, ldb; };

struct StaticOrder {
    int nM, nN, nwg, G, c;
    __host__ __device__ void init(int M, int N, int G_, int c_) { nM = M / BM; nN = N / BM; nwg = nM * nN; G = G_; c = c_; }
    __host__ __device__ bool next(int i, Unit& u) const {
        const long L = (long)i * G + c; if (L >= nwg) return false;
        int wgid = (int)L; { const int q = nwg / NXCD, r = nwg % NXCD, xcd = wgid % NXCD, off = wgid / NXCD; wgid = (xcd < r ? xcd * (q + 1) : r * (q + 1) + (xcd - r) * q) + off; }
        const int nig = WGM * nN, gid = wgid / nig, fm = gid * WGM, gsz = (nM - fm) < WGM ? (nM - fm) : WGM;
        u.pm = fm + ((wgid % nig) % gsz); u.pn = (wgid % nig) / gsz; return true;
    }
    __device__ __forceinline__ void a_ready(const Unit&) const {}
    __device__ __forceinline__ void done(const Unit&) const {}
};

__device__ __forceinline__ unsigned cvt_pk_bf16(float lo, float hi) { unsigned r; asm volatile("v_cvt_pk_bf16_f32 %0, %1, %2" : "=v"(r) : "v"(lo), "v"(hi)); return r; }
__device__ __forceinline__ void ld8(float (&v)[8], const f32x4& a, const f32x4& b) { v[0] = a[0]; v[1] = a[1]; v[2] = a[2]; v[3] = a[3]; v[4] = b[0]; v[5] = b[1]; v[6] = b[2]; v[7] = b[3]; }
typedef float f32x2c_t __attribute__((ext_vector_type(2))); typedef __bf16 bf16x2c_t __attribute__((ext_vector_type(2)));
__device__ __forceinline__ unsigned cvtpk_c(float lo, float hi) { const f32x2c_t v = {lo, hi}; const bf16x2c_t b = __builtin_convertvector(v, bf16x2c_t); return __builtin_bit_cast(unsigned, b); }
__device__ __forceinline__ u32x4 pack8(const float (&v)[8]) { u32x4 w; w.x = cvtpk_c(v[0], v[1]); w.y = cvtpk_c(v[2], v[3]); w.z = cvtpk_c(v[4], v[5]); w.w = cvtpk_c(v[6], v[7]); return w; }
__device__ __forceinline__ void unpack8(const u32x4 w, float (&v)[8]) {
    v[0] = __uint_as_float(w.x << 16); v[1] = __uint_as_float(w.x & 0xffff0000u); v[2] = __uint_as_float(w.y << 16); v[3] = __uint_as_float(w.y & 0xffff0000u);
    v[4] = __uint_as_float(w.z << 16); v[5] = __uint_as_float(w.z & 0xffff0000u); v[6] = __uint_as_float(w.w << 16); v[7] = __uint_as_float(w.w & 0xffff0000u); }
__device__ __forceinline__ void rope4(float (&v)[8], const f32x4 a, const f32x4 b) {
    float x1, x2;
    x1 = v[0]; x2 = v[1]; v[0] = x1 * a[0] - x2 * a[1]; v[1] = x2 * a[0] + x1 * a[1];
    x1 = v[2]; x2 = v[3]; v[2] = x1 * a[2] - x2 * a[3]; v[3] = x2 * a[2] + x1 * a[3];
    x1 = v[4]; x2 = v[5]; v[4] = x1 * b[0] - x2 * b[1]; v[5] = x2 * b[0] + x1 * b[1];
    x1 = v[6]; x2 = v[7]; v[6] = x1 * b[2] - x2 * b[3]; v[7] = x2 * b[2] + x1 * b[3];
}
__device__ __forceinline__ float sumsq8(const float (&v)[8]) { return ((v[0] * v[0] + v[1] * v[1]) + (v[2] * v[2] + v[3] * v[3])) + ((v[4] * v[4] + v[5] * v[5]) + (v[6] * v[6] + v[7] * v[7])); }
__device__ __forceinline__ float red_fq(float s) { s += __shfl_xor(s, 16); s += __shfl_xor(s, 32); return s; }

__device__ __forceinline__ size_t chk_off(int r16, int c32, int ld) { return (size_t)r16 * ld + (size_t)c32 * 16; }
__device__ __forceinline__ size_t gfrag_off(int pm, int t8, int wid, int grp, int lane) { return ((((size_t)(pm * 8 + t8) * 8 + wid) * 16 + grp) * 64 + lane) * 8; }
struct EpiIn {
    static constexpr bool PERM = true, AFTER_DRAIN = false; static constexpr int MIDT = 0;
    bf16_t *QA, *KA, *VA, *CQ, *CKV, *KR, *G; float* SS; const float* ropeA; const float* ropeB; const float* bgate;
    __device__ __forceinline__ void operator()(const f32x4 (&acc)[2][2][4][2], const Unit& u, int wr, int wc, int fr, int fq) const {
        asm volatile("" : "+v"(fr), "+v"(fq));
        const int row0 = u.pm * BM + wr * 64 + fr, pn = u.pn, cl = wc * 32 + 8 * fq;
        if (pn < 4) {
            bf16_t* dst = (pn < 2) ? QA : KA; const float sc = (pn < 2) ? C2A : 1.f; const int cb = (pn & 1) * 256 + wc * 32, l8 = (fq * 16 + fr) * 8;
            if ((wc & 1) == 0) {
                const bool rp = fq < 2;
#pragma unroll
                for (int ai = 0; ai < 2; ++ai)
#pragma unroll
                    for (int m = 0; m < 4; ++m) { const int row = row0 + ai * HALF + m * 16;
                        const f32x4* t = (const f32x4*)(ropeA + (size_t)row * 16 + (rp ? fq * 8 : 0));
                        f32x4 ca = t[0], cc = t[1]; if (!rp) { ca = (f32x4){1.f, 0.f, 1.f, 0.f}; cc = ca; }
#pragma unroll
                        for (int bj = 0; bj < 2; ++bj) { float v[8]; ld8(v, acc[ai][bj][m][0], acc[ai][bj][m][1]); rope4(v, ca, cc);
#pragma unroll
                            for (int j = 0; j < 8; ++j) v[j] *= sc;
                            *(u32x4*)(dst + chk_off(row - fr, cb + bj * HALF, AW) + l8) = pack8(v); } }
            } else {
#pragma unroll
                for (int ai = 0; ai < 2; ++ai)
#pragma unroll
                    for (int m = 0; m < 4; ++m) { const int row = row0 + ai * HALF + m * 16;
#pragma unroll
                        for (int bj = 0; bj < 2; ++bj) { float v[8]; ld8(v, acc[ai][bj][m][0], acc[ai][bj][m][1]);
#pragma unroll
                            for (int j = 0; j < 8; ++j) v[j] *= sc;
                            *(u32x4*)(dst + chk_off(row - fr, cb + bj * HALF, AW) + l8) = pack8(v); } }
            }
        } else if (pn < 6) {
            const int cb = (pn - 4) * 256 + wc * 32, l8 = (fq * 16 + fr) * 8;
#pragma unroll
            for (int ai = 0; ai < 2; ++ai)
#pragma unroll
                for (int m = 0; m < 4; ++m) { const int row = row0 + ai * HALF + m * 16;
#pragma unroll
                    for (int bj = 0; bj < 2; ++bj) { float v[8]; ld8(v, acc[ai][bj][m][0], acc[ai][bj][m][1]); *(u32x4*)(VA + chk_off(row - fr, cb + bj * HALF, AW) + l8) = pack8(v); } }
        } else if (pn == 6 || pn == 8) {
            bf16_t* dst = (pn == 6) ? CQ : CKV; const int ld = (pn == 6) ? QLORA : LDKV, slot = ((pn == 6) ? 0 : 8) + wc;
#pragma unroll
            for (int ai = 0; ai < 2; ++ai)
#pragma unroll
                for (int m = 0; m < 4; ++m) { const int row = row0 + ai * HALF + m * 16; float s = 0.f;
#pragma unroll
                    for (int bj = 0; bj < 2; ++bj) { float v[8]; ld8(v, acc[ai][bj][m][0], acc[ai][bj][m][1]); s += sumsq8(v); *(u32x4*)(dst + chk_off(row - fr, wc * 32 + bj * HALF, ld) + (fq * 16 + fr) * 8) = pack8(v); }
                    s = red_fq(s); if (fq == 0) SS[(size_t)row * 12 + slot] = s; }
        } else if (pn == 7) {
#pragma unroll
            for (int ai = 0; ai < 2; ++ai)
#pragma unroll
                for (int m = 0; m < 4; ++m) { const int row = row0 + ai * HALF + m * 16;
                    { float v[8]; ld8(v, acc[ai][0][m][0], acc[ai][0][m][1]); float s = red_fq(sumsq8(v)); *(u32x4*)(CQ + chk_off(row - fr, 256 + wc * 32, QLORA) + (fq * 16 + fr) * 8) = pack8(v); if (fq == 0) SS[(size_t)row * 12 + 4 + wc] = s; }
                    if (wc == 0) { float v[8]; ld8(v, acc[ai][1][m][0], acc[ai][1][m][1]); const f32x4* t = (const f32x4*)(ropeB + (size_t)row * 32 + fq * 8); rope4(v, t[0], t[1]);
                        *(u32x4*)(KR + chk_off(row - fr, 0, RDIM) + (fq * 16 + fr) * 8) = pack8(v); } }
        }
    }
};
struct EpiGates {
    static constexpr bool PERM = true, AFTER_DRAIN = false; static constexpr int MIDT = 0;
    bf16_t* G; const float* bgate;
    __device__ __forceinline__ void operator()(const f32x4 (&acc)[2][2][4][2], const Unit& u, int wr, int wc, int fr, int fq) const {
        asm volatile("" : "+v"(fr), "+v"(fq));
        const int gc = u.pn * 256 + wc * 32 + 8 * fq;
        f32x4 bv[2][2];
#pragma unroll
        for (int bj = 0; bj < 2; ++bj)
#pragma unroll
            for (int n = 0; n < 2; ++n) bv[bj][n] = *(const f32x4*)(bgate + gc + bj * HALF + 4 * n);
#pragma unroll
        for (int ai = 0; ai < 2; ++ai)
#pragma unroll
            for (int m = 0; m < 4; ++m) {
#pragma unroll
                for (int bj = 0; bj < 2; ++bj) { float v[8]; ld8(v, acc[ai][bj][m][0] * (1.0f / 32.0f) + bv[bj][0], acc[ai][bj][m][1] * (1.0f / 32.0f) + bv[bj][1]);
#pragma unroll
                    for (int j = 0; j < 8; ++j) v[j] = __builtin_amdgcn_rcpf(1.f + __builtin_amdgcn_exp2f(-LOG2E * v[j]));
                    *(u32x4*)(G + gfrag_off(u.pm, u.pn, wr * 4 + wc, ai * 8 + m * 2 + bj, fq * 16 + fr)) = pack8(v); } }
    }
};
struct EpiQ {
    static constexpr bool PERM = true, AFTER_DRAIN = false; static constexpr int MIDT = 0;
    bf16_t* QB; const float* SS; const float* ropeB;
    __device__ __forceinline__ void operator()(const f32x4 (&acc)[2][2][4][2], const Unit& u, int wr, int wc, int fr, int fq) const {
        asm volatile("" : "+v"(fr), "+v"(fq));
        const int row0 = u.pm * BM + wr * 64 + fr, cl = u.pn * BM + wc * 32 + 8 * fq;
        const int c0 = cl, c1 = cl + HALF, h0 = c0 / QKB, h1 = c1 / QKB, p0 = c0 - h0 * QKB, p1 = c1 - h1 * QKB;
        const bool r0 = p0 >= 64, r1 = p1 >= 64; const int roff = r0 ? p0 - 64 : (r1 ? p1 - 64 : 0);
#pragma unroll
        for (int b = 0; b < 2; ++b) {
            f32x4 s0[4], s1[4], ta[4], tb[4];
#pragma unroll
            for (int m = 0; m < 4; ++m) { const int row = row0 + b * HALF + m * 16;
                const f32x4* sp = (const f32x4*)(SS + (size_t)row * 12); s0[m] = sp[0]; s1[m] = sp[1];
                const f32x4* t = (const f32x4*)(ropeB + (size_t)row * 32 + roff); ta[m] = t[0]; tb[m] = t[1]; }
            asm volatile("" ::: "memory");
#pragma unroll
            for (int m = 0; m < 4; ++m) { const int row = row0 + b * HALF + m * 16;
                const float ss = ((s0[m][0] + s0[m][1]) + (s0[m][2] + s0[m][3])) + ((s1[m][0] + s1[m][1]) + (s1[m][2] + s1[m][3]));
                const float rs = __builtin_amdgcn_rsqf(ss * (1.0f / QLORA) + EPS) * C2B;
#pragma unroll
                for (int bj = 0; bj < 2; ++bj) { float v[8]; ld8(v, acc[b][bj][m][0], acc[b][bj][m][1]);
#pragma unroll
                    for (int j = 0; j < 8; ++j) v[j] *= rs;
                    if (bj == 0 ? r0 : r1) rope4(v, ta[m], tb[m]);
                    *(u32x4*)(QB + chk_off(row - fr, (bj == 0 ? c0 : c1) - 8 * fq, NHEAD * QKB) + (fq * 16 + fr) * 8) = pack8(v); } }
        }
    }
};
struct EpiKV {
    static constexpr bool PERM = true, AFTER_DRAIN = false; static constexpr int MIDT = 0;
    bf16_t *KB, *VB; const float* SS;
    __device__ __forceinline__ void operator()(const f32x4 (&acc)[2][2][4][2], const Unit& u, int wr, int wc, int fr, int fq) const {
        asm volatile("" : "+v"(fr), "+v"(fq));
        const int row0 = u.pm * BM + wr * 64 + fr;
        bf16_t* dst = (wc < 2) ? KB : VB; const int pc = (wc & 1) * 32, l8 = (fq * 16 + fr) * 8;
        f32x4 s0[2][4];
#pragma unroll
        for (int ai = 0; ai < 2; ++ai)
#pragma unroll
            for (int m = 0; m < 4; ++m) s0[ai][m] = *(const f32x4*)(SS + (size_t)(row0 + ai * HALF + m * 16) * 12 + 8);
#pragma unroll
        for (int ai = 0; ai < 2; ++ai)
#pragma unroll
            for (int m = 0; m < 4; ++m) { const int row = row0 + ai * HALF + m * 16; const f32x4 sv = s0[ai][m];
                const float rs = __builtin_amdgcn_rsqf(((sv[0] + sv[1]) + (sv[2] + sv[3])) * (1.0f / KVLORA) + EPS);
#pragma unroll
                for (int bj = 0; bj < 2; ++bj) { const int hd = u.pn * 2 + bj;
                    float v[8]; ld8(v, acc[ai][bj][m][0], acc[ai][bj][m][1]);
#pragma unroll
                    for (int j = 0; j < 8; ++j) v[j] *= rs;
                    *(u32x4*)(dst + chk_off(row - fr, hd * HD + pc, AW) + l8) = pack8(v); } }
    }
};
struct EpiMerge {
    static constexpr bool PERM = true, AFTER_DRAIN = false; static constexpr int MIDT = 8;
    const bf16_t* G; bf16_t* T;
    __device__ __forceinline__ void mid(f32x4 (&acc)[2][2][4][2], const Unit& u, int wr, int wc, int fr, int fq) const {
        asm volatile("" : "+v"(fr), "+v"(fq));
        const bf16_t* pa = G + gfrag_off(u.pm, u.pn, wr * 4 + wc, 0, fq * 16 + fr); const bf16_t* pb = G + gfrag_off(u.pm, 4 + u.pn, wr * 4 + wc, 0, fq * 16 + fr);
        u32x4 ca[4], cb[4], na[4], nb[4];
#pragma unroll
        for (int i = 0; i < 4; ++i) { ca[i] = *(const u32x4*)(pa + (size_t)i * 512); cb[i] = *(const u32x4*)(pb + (size_t)i * 512); }
#pragma unroll
        for (int b = 0; b < 4; ++b) {
            if (b < 3) {
#pragma unroll
                for (int i = 0; i < 4; ++i) { na[i] = *(const u32x4*)(pa + (size_t)((b + 1) * 4 + i) * 512); nb[i] = *(const u32x4*)(pb + (size_t)((b + 1) * 4 + i) * 512); } }
            asm volatile("" ::: "memory");
#pragma unroll
            for (int i = 0; i < 4; ++i) { const int grp = b * 4 + i, ai = grp >> 3, m = (grp >> 1) & 3, bj = grp & 1; float ga[8], gb[8]; unpack8(ca[i], ga); unpack8(cb[i], gb);
#pragma unroll
                for (int j = 0; j < 8; ++j) ga[j] *= __builtin_amdgcn_rcpf(__builtin_fmaxf(gb[j], 1e-30f));
                acc[ai][bj][m][0] *= (f32x4){ga[0], ga[1], ga[2], ga[3]}; acc[ai][bj][m][1] *= (f32x4){ga[4], ga[5], ga[6], ga[7]}; }
#pragma unroll
            for (int i = 0; i < 4; ++i) { ca[i] = na[i]; cb[i] = nb[i]; }
        }
    }
    __device__ __forceinline__ void operator()(const f32x4 (&acc)[2][2][4][2], const Unit& u, int wr, int wc, int fr, int fq) const {
        asm volatile("" : "+v"(fr), "+v"(fq));
        unsigned char* base = (unsigned char*)T + ((size_t)(u.pm * 16 + wr * 4) * 16 + u.pn * 4 + wc) * 1024 + (unsigned)(fq * 16 + fr) * 16u;
        const bf16_t* pb = G + gfrag_off(u.pm, 4 + u.pn, wr * 4 + wc, 0, fq * 16 + fr);
        u32x4 cb[8], nb[8];
#pragma unroll
        for (int i = 0; i < 8; ++i) cb[i] = *(const u32x4*)(pb + (size_t)i * 512);
#pragma unroll
        for (int b = 0; b < 2; ++b) {
            if (b < 1) {
#pragma unroll
                for (int i = 0; i < 8; ++i) nb[i] = *(const u32x4*)(pb + (size_t)(8 + i) * 512); }
            asm volatile("" ::: "memory");
#pragma unroll
            for (int i2 = 0; i2 < 4; ++i2) { int w[4];
#pragma unroll
                for (int bj = 0; bj < 2; ++bj) { const int i = 2 * i2 + bj, grp = b * 8 + i, ai = grp >> 3, m = (grp >> 1) & 3; float v[8], gb[8]; ld8(v, acc[ai][bj][m][0], acc[ai][bj][m][1]); unpack8(cb[i], gb);
#pragma unroll
                    for (int j = 0; j < 8; ++j) v[j] = __builtin_fminf(__builtin_fmaxf(v[j] * (64.f * __builtin_fmaxf(gb[j], 1e-30f)), -448.f), 448.f);
                    int w0 = 0, w1 = 0;
                    w0 = __builtin_amdgcn_cvt_pk_fp8_f32(v[0], v[1], w0, false); w0 = __builtin_amdgcn_cvt_pk_fp8_f32(v[2], v[3], w0, true);
                    w1 = __builtin_amdgcn_cvt_pk_fp8_f32(v[4], v[5], w1, false); w1 = __builtin_amdgcn_cvt_pk_fp8_f32(v[6], v[7], w1, true);
                    w[2 * bj] = w0; w[2 * bj + 1] = w1; }
                typedef int i32x4m_ __attribute__((ext_vector_type(4)));
                *(i32x4m_*)(base + (size_t)(b * 8 + i2) * 16384) = (i32x4m_){w[0], w[1], w[2], w[3]}; }
#pragma unroll
            for (int i = 0; i < 8; ++i) cb[i] = nb[i];
        }
    }
};
struct EpiSS {
    static constexpr bool PERM = true, AFTER_DRAIN = false; static constexpr int MIDT = 0;
    bf16_t* Y; float* SSY; int ldy; float scale;
    __device__ __forceinline__ void operator()(const f32x4 (&acc)[2][2][4][2], const Unit& u, int wr, int wc, int fr, int fq) const {
        asm volatile("" : "+v"(fr), "+v"(fq));
        const int row0 = u.pm * BM + wr * 64 + fr, cl = u.pn * BM + wc * 32 + 8 * fq;
#pragma unroll
        for (int ai = 0; ai < 2; ++ai)
#pragma unroll
            for (int m = 0; m < 4; ++m) { const int row = row0 + ai * HALF + m * 16; float s = 0.f;
#pragma unroll
                for (int bj = 0; bj < 2; ++bj) { float v[8]; ld8(v, acc[ai][bj][m][0] * scale, acc[ai][bj][m][1] * scale); s += sumsq8(v); *(u32x4*)(Y + (size_t)row * ldy + cl + bj * HALF) = pack8(v); }
                s = red_fq(s); if (fq == 0) SSY[(size_t)row * 16 + u.pn * 4 + wc] = s; }
    }
};
struct EpiRelu2F8 {
    static constexpr bool PERM = true, AFTER_DRAIN = false; static constexpr int MIDT = 0;
    unsigned char* U; float scale;
    __device__ __forceinline__ void operator()(const f32x4 (&acc)[2][2][4][2], const Unit& u, int wr, int wc, int fr, int fq) const {
        asm volatile("" : "+v"(fr), "+v"(fq));
        unsigned char* base = U + ((size_t)(u.pm * 16 + wr * 4) * 64 + u.pn * 4 + wc) * 1024 + (unsigned)(fq * 16 + fr) * 16u;
#pragma unroll
        for (int ai = 0; ai < 2; ++ai)
#pragma unroll
            for (int m = 0; m < 4; ++m) { int w[4];
#pragma unroll
                for (int bj = 0; bj < 2; ++bj) { float v[8]; ld8(v, acc[ai][bj][m][0], acc[ai][bj][m][1]);
#pragma unroll
                    for (int j = 0; j < 8; ++j) { const float r = __builtin_fmaxf(v[j] * scale, 0.f); v[j] = __builtin_fminf(r * r, 440.f); }
                    int w0 = 0, w1 = 0;
                    w0 = __builtin_amdgcn_cvt_pk_fp8_f32(v[0], v[1], w0, false); w0 = __builtin_amdgcn_cvt_pk_fp8_f32(v[2], v[3], w0, true);
                    w1 = __builtin_amdgcn_cvt_pk_fp8_f32(v[4], v[5], w1, false); w1 = __builtin_amdgcn_cvt_pk_fp8_f32(v[6], v[7], w1, true);
                    w[2 * bj] = w0; w[2 * bj + 1] = w1; }
                typedef int i32x4e_ __attribute__((ext_vector_type(4)));
                *(i32x4e_*)(base + (size_t)(ai * 8 + m) * 65536) = (i32x4e_){w[0], w[1], w[2], w[3]}; }
    }
};
struct EpiRelu2 {
    static constexpr bool PERM = true, AFTER_DRAIN = false; static constexpr int MIDT = 0;
    bf16_t* U;
    __device__ __forceinline__ void operator()(const f32x4 (&acc)[2][2][4][2], const Unit& u, int wr, int wc, int fr, int fq) const {
        asm volatile("" : "+v"(fr), "+v"(fq));
        const int row0 = u.pm * BM + wr * 64 + fr, cl = u.pn * BM + wc * 32 + 8 * fq;
#pragma unroll
        for (int ai = 0; ai < 2; ++ai)
#pragma unroll
            for (int m = 0; m < 4; ++m) { const int row = row0 + ai * HALF + m * 16;
#pragma unroll
                for (int bj = 0; bj < 2; ++bj) { float v[8]; ld8(v, acc[ai][bj][m][0], acc[ai][bj][m][1]);
#pragma unroll
                    for (int j = 0; j < 8; ++j) { const float r = __builtin_fmaxf(v[j], 0.f); v[j] = r * r; }
                    *(u32x4*)(U + (size_t)row * LDU + cl + bj * HALF) = pack8(v); } }
    }
};
template <class Epi, class Sched, bool ALIGN_EPI = false, bool SP2 = false, int ESZ = 2, bool ACH = false>
__device__ __forceinline__ void gemm_phase(PG8_LAS unsigned char* lds, const Gemm g, const Sched& S, const Epi& E) {
    int tid_ = threadIdx.x; asm volatile("" : "+v"(tid_));
    const int tid = tid_, wid = __builtin_amdgcn_readfirstlane(tid >> 6), lane = tid & 63, wr = wid >> 2, wc = wid & 3, fr = lane & 15, fq = lane >> 4;
    const int K = g.K, nt = K * ESZ / (BK * 2), lda = g.lda ? g.lda : K, ldb = g.ldb ? g.ldb : K;
    unsigned voffA[2], voffB[2];
#pragma unroll
    for (int i = 0; i < 2; ++i) { int R, C; stage_rc(tid * 16 + i * 8192, R, C); const int Rb = Epi::PERM ? ((R & ~31) + perm32(R & 31)) : R;
        if constexpr (ACH) { const int st_ = (tid >> 6) + 8 * i; voffA[i] = (unsigned)((st_ >> 1) * 16 * lda * ESZ + (st_ & 1) * 1024 + (tid & 63) * 16); } else voffA[i] = (unsigned)(R * lda * ESZ + C * 2);
        voffB[i] = (unsigned)(Rb * ldb * ESZ + C * 2); }
    const size_t kstepB = (size_t)(BK * 2), kstepA = ACH ? (size_t)2048 : kstepB;
    const size_t hstepA = (size_t)HALF * lda * ESZ, hstepB = (size_t)HALF * ldb * ESZ;
    const size_t tstepA = 2 * hstepA, tstepB = 2 * hstepB;
    const unsigned ldsw = (unsigned)wid * 1024u;
    const int aoff = ACH ? wr * 8192 + lane * 16 : lds_byte(wr * 64 + fr, fq * 8), boff = lds_byte(wc * 32 + fr, fq * 8);
#define PG8_SA(b, h) (((b) * 2 + (h)) * HTB)
#define PG8_SB(b, h) ((4 + (b) * 2 + (h)) * HTB)
#define PG8_STAGE(bufoff, gbase, voff) do { _Pragma("unroll") for (int _i = 0; _i < 2; ++_i) \
        __builtin_amdgcn_global_load_lds((const unsigned*)((const char*)(gbase) + (voff)[_i]), (PG8_LAS unsigned*)(lds + (bufoff) + ldsw + _i * 8192), 16, 0, 0); } while (0)
#define PG8_LDA(dst, b, h) do { if constexpr (ESZ == 2) { _Pragma("unroll") for (int m = 0; m < 4; ++m) _Pragma("unroll") for (int k = 0; k < 2; ++k) dst[m][k] = *(const PG8_LAS bf16x8*)(lds + PG8_SA(b, h) + aoff + m * 2048 + k * 1024); } \
        else { _Pragma("unroll") for (int m = 0; m < 4; ++m) { dst##8[m].lo = *(const PG8_LAS i32x4_*)(lds + PG8_SA(b, h) + aoff + m * 2048); dst##8[m].hi = *(const PG8_LAS i32x4_*)(lds + PG8_SA(b, h) + aoff + m * 2048 + 1024); } } } while (0)
#define PG8_LDB(dst, b, h) do { if constexpr (ESZ == 2) { _Pragma("unroll") for (int n = 0; n < 2; ++n) _Pragma("unroll") for (int k = 0; k < 2; ++k) dst[n][k] = *(const PG8_LAS bf16x8*)(lds + PG8_SB(b, h) + boff + n * 2048 + k * 1024); } \
        else { _Pragma("unroll") for (int n = 0; n < 2; ++n) { dst##8[n].lo = *(const PG8_LAS i32x4_*)(lds + PG8_SB(b, h) + boff + n * 2048); dst##8[n].hi = *(const PG8_LAS i32x4_*)(lds + PG8_SB(b, h) + boff + n * 2048 + 1024); } } } while (0)
#define PG8_MMA(ai, bj, At, Bt) do { __builtin_amdgcn_s_setprio(1); \
        if constexpr (ESZ == 2) { _Pragma("unroll") for (int m = 0; m < 4; ++m) _Pragma("unroll") for (int n = 0; n < 2; ++n) _Pragma("unroll") for (int k = 0; k < 2; ++k) \
            acc[ai][bj][m][n] = __builtin_amdgcn_mfma_f32_16x16x32_bf16(Bt[n][k], At[m][k], acc[ai][bj][m][n], 0, 0, 0); } \
        else {   \
            _Pragma("unroll") for (int m = 0; m < 4; ++m) _Pragma("unroll") for (int n = 0; n < 2; ++n) \
                asm volatile("v_mfma_scale_f32_16x16x128_f8f6f4 %0, %1, %2, %0, %3, %3 op_sel_hi:[0,0,0]" : "+v"(acc[ai][bj][m][n]) : "v"(Bt##8[n]), "v"(At##8[m]), "v"(scl_)); } \
        __builtin_amdgcn_s_setprio(0); } while (0)
#define PG8_WAIT_V(n) asm volatile("s_waitcnt vmcnt(" #n ")" ::: "memory")
#define PG8_WAIT_L(n) asm volatile("s_waitcnt lgkmcnt(" #n ")" ::: "memory")
#define PG8_BAR __builtin_amdgcn_s_barrier()
#define PG8_SCHED __builtin_amdgcn_sched_barrier(0)
    Unit cur, nxt; int ui = 0;
    if (!S.next(0, cur)) return;
    f32x4 acc[2][2][4][2];
#pragma unroll
    for (int a = 0; a < 2; ++a)
#pragma unroll
        for (int b = 0; b < 2; ++b)
#pragma unroll
            for (int m = 0; m < 4; ++m)
#pragma unroll
                for (int n = 0; n < 2; ++n) acc[a][b][m][n] = (f32x4){0.f, 0.f, 0.f, 0.f};
    bf16x8 At[4][2], B0[2][2], B1[2][2];
    typedef int i32x4_ __attribute__((ext_vector_type(4))); typedef int i32x8_ __attribute__((ext_vector_type(8)));
    const int scl_ = 0x7F7F7F7F;
    i32x8_ At8[4], B08[2], B18[2];
    const char* cA = (const char*)g.A + (size_t)cur.pm * tstepA; const char* cB = (const char*)g.Bt + (size_t)cur.pn * tstepB;
    S.a_ready(cur);
    if constexpr (SP2) {
        PG8_STAGE(PG8_SB(0, 0), cB, voffB); PG8_STAGE(PG8_SB(0, 1), cB + hstepB, voffB); PG8_STAGE(PG8_SA(0, 0), cA, voffA); PG8_STAGE(PG8_SA(0, 1), cA + hstepA, voffA);
        if (wr == 1) PG8_BAR;
        PG8_WAIT_V(2); PG8_BAR;
        PG8_STAGE(PG8_SB(1, 0), cB + kstepB, voffB); PG8_STAGE(PG8_SA(1, 0), cA + kstepA, voffA); PG8_STAGE(PG8_SB(1, 1), cB + hstepB + kstepB, voffB);
        PG8_WAIT_V(6); PG8_BAR;
    } else {
        PG8_STAGE(PG8_SB(0, 0), cB, voffB); PG8_STAGE(PG8_SA(0, 0), cA, voffA); PG8_STAGE(PG8_SB(0, 1), cB + hstepB, voffB); PG8_STAGE(PG8_SA(0, 1), cA + hstepA, voffA);
        if (wr == 1) PG8_BAR;
        PG8_WAIT_V(4); PG8_BAR;
        PG8_STAGE(PG8_SB(1, 0), cB + kstepB, voffB); PG8_STAGE(PG8_SA(1, 0), cA + kstepA, voffA); PG8_STAGE(PG8_SB(1, 1), cB + hstepB + kstepB, voffB);
        PG8_WAIT_V(6); PG8_BAR;
    }
    for (;;) {
        const bool has_next = S.next(ui + 1, nxt);
        const char* nA = has_next ? (const char*)g.A + (size_t)nxt.pm * tstepA : cA; const char* nB = has_next ? (const char*)g.Bt + (size_t)nxt.pn * tstepB : cB;
#pragma unroll 1
        for (int t = 0; t < nt; t += 2) {
            if constexpr (Epi::MIDT > 0) { if (t == Epi::MIDT) E.mid(acc, cur, wr, wc, fr, fq); }
            const bool last = (t == nt - 2);
            const char* a1 = cA + (size_t)(t + 1) * kstepA;
            const char* a2 = last ? nA : cA + (size_t)(t + 2) * kstepA; const char* b2 = last ? nB : cB + (size_t)(t + 2) * kstepB;
            const char* a3 = a2 + kstepA; const char* b3 = b2 + kstepB;
            if (last && has_next) S.a_ready(nxt);
            if constexpr (SP2) {
            PG8_LDB(B0, 0, 0); PG8_LDB(B1, 0, 1); PG8_SCHED; PG8_LDA(At, 0, 0); PG8_STAGE(PG8_SA(1, 1), a1 + hstepA, voffA);
            PG8_WAIT_V(8); PG8_WAIT_L(0); PG8_BAR; PG8_MMA(0, 0, At, B0); PG8_MMA(0, 1, At, B1); PG8_BAR; PG8_SCHED;
            PG8_LDA(At, 0, 1); PG8_STAGE(PG8_SB(0, 0), b2, voffB); PG8_STAGE(PG8_SB(0, 1), b2 + hstepB, voffB); PG8_STAGE(PG8_SA(0, 0), a2, voffA);
            PG8_WAIT_V(8); PG8_WAIT_L(0); PG8_BAR; PG8_MMA(1, 0, At, B0); PG8_MMA(1, 1, At, B1); PG8_BAR; PG8_SCHED;
            PG8_LDB(B0, 1, 0); PG8_LDB(B1, 1, 1); PG8_SCHED; PG8_LDA(At, 1, 0); PG8_STAGE(PG8_SA(0, 1), a2 + hstepA, voffA);
            PG8_WAIT_V(8); PG8_WAIT_L(0); PG8_BAR; PG8_MMA(0, 0, At, B0); PG8_MMA(0, 1, At, B1); PG8_BAR; PG8_SCHED;
            PG8_LDA(At, 1, 1); PG8_STAGE(PG8_SB(1, 0), b3, voffB); PG8_STAGE(PG8_SB(1, 1), b3 + hstepB, voffB); PG8_STAGE(PG8_SA(1, 0), a3, voffA);
            PG8_WAIT_V(8); PG8_WAIT_L(0); PG8_BAR; PG8_MMA(1, 0, At, B0); PG8_MMA(1, 1, At, B1); PG8_BAR; PG8_SCHED;
            } else {
            PG8_LDB(B0, 0, 0); PG8_SCHED; PG8_LDA(At, 0, 0); PG8_STAGE(PG8_SA(1, 1), a1 + hstepA, voffA);
            PG8_WAIT_L(8); PG8_BAR; PG8_WAIT_L(0); PG8_MMA(0, 0, At, B0); PG8_BAR; PG8_SCHED;
            PG8_LDB(B1, 0, 1); PG8_STAGE(PG8_SB(0, 0), b2, voffB);
            PG8_BAR; PG8_WAIT_L(0); PG8_MMA(0, 1, At, B1); PG8_BAR;
            PG8_LDA(At, 0, 1); PG8_STAGE(PG8_SA(0, 0), a2, voffA);
            PG8_BAR; PG8_WAIT_L(0); PG8_MMA(1, 0, At, B0); PG8_BAR; PG8_SCHED;
            PG8_STAGE(PG8_SB(0, 1), b2 + hstepB, voffB);
            PG8_WAIT_V(6); PG8_BAR; PG8_MMA(1, 1, At, B1); PG8_BAR;
            PG8_LDB(B0, 1, 0); PG8_SCHED; PG8_LDA(At, 1, 0); PG8_STAGE(PG8_SA(0, 1), a2 + hstepA, voffA);
            PG8_WAIT_L(8); PG8_BAR; PG8_WAIT_L(0); PG8_MMA(0, 0, At, B0); PG8_BAR; PG8_SCHED;
            PG8_LDB(B1, 1, 1); PG8_STAGE(PG8_SB(1, 0), b3, voffB);
            PG8_BAR; PG8_WAIT_L(0); PG8_MMA(0, 1, At, B1); PG8_BAR;
            PG8_LDA(At, 1, 1); PG8_STAGE(PG8_SA(1, 0), a3, voffA);
            PG8_BAR; PG8_WAIT_L(0); PG8_MMA(1, 0, At, B0); PG8_BAR; PG8_SCHED;
            PG8_STAGE(PG8_SB(1, 1), b3 + hstepB, voffB);
            PG8_WAIT_V(6); PG8_BAR; PG8_MMA(1, 1, At, B1); PG8_BAR;
            }
        }
        if constexpr (ALIGN_EPI) { if (wr == 0) PG8_BAR; }
        if constexpr (ESZ == 1) asm volatile("s_nop 15\n\ts_nop 15" ::: "memory");
        if constexpr (!Epi::AFTER_DRAIN) { E(acc, cur, wr, wc, fr, fq); S.done(cur); }
        if (!has_next) break;
#pragma unroll
        for (int a = 0; a < 2; ++a)
#pragma unroll
            for (int b = 0; b < 2; ++b)
#pragma unroll
                for (int m = 0; m < 4; ++m)
#pragma unroll
                    for (int n = 0; n < 2; ++n) acc[a][b][m][n] = (f32x4){0.f, 0.f, 0.f, 0.f};
        cur = nxt; cA = nA; cB = nB; ++ui;
        if constexpr (ALIGN_EPI) { if (wr == 1) PG8_BAR; }
    }
    PG8_WAIT_V(0);
    if constexpr (!ALIGN_EPI) { if (wr == 0) PG8_BAR; }
    PG8_BAR;
    if constexpr (Epi::AFTER_DRAIN) { E.fused(acc, cur, wr, wc, fr, fq, lds, wid, lane); S.done(cur); }
#undef PG8_SA
#undef PG8_SB
#undef PG8_STAGE
#undef PG8_LDA
#undef PG8_LDB
#undef PG8_MMA
#undef PG8_WAIT_V
#undef PG8_WAIT_L
#undef PG8_BAR
#undef PG8_SCHED
}
}
#ifndef ATT_LSUM_MFMA
#define ATT_LSUM_MFMA 1
#endif
namespace att {
typedef unsigned short bf16_t;
typedef short bf16x8 __attribute__((ext_vector_type(8)));
typedef short s16x4 __attribute__((ext_vector_type(4)));
typedef float f32x16 __attribute__((ext_vector_type(16)));
typedef float f32x4 __attribute__((ext_vector_type(4)));
typedef unsigned u32x4 __attribute__((ext_vector_type(4)));
#define ALDS __attribute__((address_space(3)))
#define ASBAR() __builtin_amdgcn_sched_barrier(0)
constexpr int KTB = 12288, VTB = 8192;
constexpr int NSLOT = 3;
constexpr int L_K = 0, L_V = NSLOT * KTB, L_WS = L_V + NSLOT * VTB, L_OST = L_WS + 8 * 256, L_KM = L_OST + 8 * 4096, L_RED = L_KM + 2048, L_END = L_RED + 16384;
constexpr float THR = 8.f;
__device__ __forceinline__ int crow(int r, int hi) { return (r & 3) + 8 * (r >> 2) + 4 * hi; }
typedef float f32x2a_t __attribute__((ext_vector_type(2))); typedef __bf16 bf16x2a_t __attribute__((ext_vector_type(2)));
__device__ __forceinline__ unsigned cvtpk(float lo, float hi) { const f32x2a_t v = {lo, hi}; const bf16x2a_t b = __builtin_convertvector(v, bf16x2a_t); return __builtin_bit_cast(unsigned, b); }
__device__ __forceinline__ float bf2f(short s) { return __uint_as_float(((unsigned)(unsigned short)s) << 16); }
__device__ __forceinline__ int v_st(int k, int c) { const int kk = (k & ~0xC) | ((k & 4) << 1) | ((k & 8) >> 1); return ((kk >> 3) * 2 + (c >> 5)) * 512 + ((kk & 7) * 32 + (c & 31)) * 2; }
__device__ __forceinline__ int v_rd_base(int lane) { return ((lane & 3) << 3) | (((lane >> 2) & 3) << 6) | (((lane >> 4) & 1) << 5) | (((lane >> 5) & 1) << 8); }
constexpr int v_rd_off(int d0, int ks, int half) { return ks * 2048 + half * 1024 + d0 * 512; }
template <int OFF> __device__ __forceinline__ s16x4 tr_read(int vb) { s16x4 r; asm volatile("ds_read_b64_tr_b16 %0, %1 offset:%2" : "=&v"(r) : "v"(vb), "i"(OFF) : "memory"); return r; }
template <int D0> __device__ __forceinline__ void pv_one(f32x16& od, int vb, bf16x8 pa0, bf16x8 pa1, bf16x8 pa2, bf16x8 pa3) {
    const s16x4 l0 = tr_read<v_rd_off(D0, 0, 0)>(vb), h0 = tr_read<v_rd_off(D0, 0, 1)>(vb), l1 = tr_read<v_rd_off(D0, 1, 0)>(vb), h1 = tr_read<v_rd_off(D0, 1, 1)>(vb);
    const s16x4 l2 = tr_read<v_rd_off(D0, 2, 0)>(vb), h2 = tr_read<v_rd_off(D0, 2, 1)>(vb), l3 = tr_read<v_rd_off(D0, 3, 0)>(vb), h3 = tr_read<v_rd_off(D0, 3, 1)>(vb);
    asm volatile("s_waitcnt lgkmcnt(0)" ::: "memory"); ASBAR();
#define ATT_PK(L, H) (bf16x8){L[0], L[1], L[2], L[3], H[0], H[1], H[2], H[3]}
    od = __builtin_amdgcn_mfma_f32_32x32x16_bf16(pa0, ATT_PK(l0, h0), od, 0, 0, 0);
    od = __builtin_amdgcn_mfma_f32_32x32x16_bf16(pa1, ATT_PK(l1, h1), od, 0, 0, 0);
    od = __builtin_amdgcn_mfma_f32_32x32x16_bf16(pa2, ATT_PK(l2, h2), od, 0, 0, 0);
    od = __builtin_amdgcn_mfma_f32_32x32x16_bf16(pa3, ATT_PK(l3, h3), od, 0, 0, 0);
#undef ATT_PK
}
__device__ __forceinline__ void pv_all(f32x16* o, f32x16& ol, int vb, bf16x8 pa0, bf16x8 pa1, bf16x8 pa2, bf16x8 pa3) {
    pv_one<0>(o[0], vb, pa0, pa1, pa2, pa3); pv_one<1>(o[1], vb, pa0, pa1, pa2, pa3);
#if ATT_LSUM_MFMA
    const bf16x8 ones = (bf16x8){0x3F80, 0x3F80, 0x3F80, 0x3F80, 0x3F80, 0x3F80, 0x3F80, 0x3F80};
    ol = __builtin_amdgcn_mfma_f32_32x32x16_bf16(pa0, ones, ol, 0, 0, 0); ol = __builtin_amdgcn_mfma_f32_32x32x16_bf16(pa1, ones, ol, 0, 0, 0);
    ol = __builtin_amdgcn_mfma_f32_32x32x16_bf16(pa2, ones, ol, 0, 0, 0); ol = __builtin_amdgcn_mfma_f32_32x32x16_bf16(pa3, ones, ol, 0, 0, 0);
#endif
}
__device__ __forceinline__ void partialSM(f32x16& p0, f32x16& p1, float& m_ref, f32x16& negm, float& alpha) {
    float pmax = p0[0];
#pragma unroll
    for (int r = 1; r < 16; ++r) pmax = fmaxf(pmax, p0[r]);
#pragma unroll
    for (int r = 0; r < 16; ++r) pmax = fmaxf(pmax, p1[r]);
    { auto rr = __builtin_amdgcn_permlane32_swap(__float_as_uint(pmax), __float_as_uint(pmax), false, false); pmax = fmaxf(__uint_as_float(rr[0]), __uint_as_float(rr[1])); }
    alpha = 1.f;
    if (__builtin_expect(!__all(pmax <= THR), 0)) { const float dl = (pmax > THR) ? pmax : 0.f; m_ref += dl; alpha = __builtin_amdgcn_exp2f(-dl);
#pragma unroll
        for (int r = 0; r < 16; ++r) { p0[r] -= dl; p1[r] -= dl; negm[r] = -m_ref; } }
#pragma unroll
    for (int r = 0; r < 16; ++r) p0[r] = __builtin_amdgcn_exp2f(p0[r]);
}
__device__ __forceinline__ void finishSM(f32x16& p0, f32x16& p1, bf16x8& pa0, bf16x8& pa1, bf16x8& pa2, bf16x8& pa3, float& lsum) {
#pragma unroll
    for (int r = 0; r < 16; ++r) p1[r] = __builtin_amdgcn_exp2f(p1[r]);
#if !ATT_LSUM_MFMA
    { float ps = 0.f;
#pragma unroll
      for (int r = 0; r < 16; ++r) ps += p0[r];
#pragma unroll
      for (int r = 0; r < 16; ++r) ps += p1[r];
      lsum += ps; }
#endif
#define ATT_PK4(P, BASE, OUT) do { unsigned a0 = cvtpk(P[BASE + 0], P[BASE + 1]), a1 = cvtpk(P[BASE + 2], P[BASE + 3]);   \
    unsigned b0 = cvtpk(P[BASE + 4], P[BASE + 5]), b1 = cvtpk(P[BASE + 6], P[BASE + 7]);                              \
    auto r0 = __builtin_amdgcn_permlane32_swap(a0, b0, false, false); auto r1 = __builtin_amdgcn_permlane32_swap(a1, b1, false, false); \
    u32x4 w = {r0[0], r1[0], r0[1], r1[1]}; OUT = __builtin_bit_cast(bf16x8, w); } while (0)
    ATT_PK4(p0, 0, pa0); ATT_PK4(p0, 8, pa1); ATT_PK4(p1, 0, pa2); ATT_PK4(p1, 8, pa3);
#undef ATT_PK4
}
template <int ND> __device__ __forceinline__ void qkt(f32x16& p0, f32x16& p1, ALDS const char* Kb, const int (&ka)[ND], const bf16x8 (&qr)[ND], const f32x16& cinit) {
#pragma unroll
    for (int d0 = 0; d0 < ND; ++d0) {
        const bf16x8 b0 = *(ALDS const bf16x8*)(Kb + ka[d0]);
        const bf16x8 b1 = *(ALDS const bf16x8*)(Kb + ka[d0] + (d0 < 4 ? 4096 : 2048));
        p0 = __builtin_amdgcn_mfma_f32_32x32x16_bf16(b0, qr[d0], d0 == 0 ? cinit : p0, 0, 0, 0);
        p1 = __builtin_amdgcn_mfma_f32_32x32x16_bf16(b1, qr[d0], d0 == 0 ? cinit : p1, 0, 0, 0);
        if (ND > 4 && d0 == 2) asm volatile("" ::: "memory"); }
}
__device__ __forceinline__ void cmask(f32x16& p0, f32x16& p1, int jt, int qrel, int hi) {
    const float NEG = -INFINITY; const int thr = qrel - 64 * jt - 4 * hi;
#pragma unroll
    for (int r = 0; r < 16; ++r) { if ((r & 3) + 8 * (r >> 2) > thr) p0[r] = NEG; if ((r & 3) + 8 * (r >> 2) + 32 > thr) p1[r] = NEG; }
}
__device__ __forceinline__ void kmean_blocks(const bf16_t* Kp, ALDS char* lds) {
    int tid_ = threadIdx.x; asm volatile("" : "+v"(tid_));
    const int tid = tid_, lane = tid & 63, wid = tid >> 6;
    ALDS float* red = (ALDS float*)(lds + L_RED); ALDS float* km = (ALDS float*)(lds + L_KM);
#pragma unroll 1
    for (int n = 0; n < 8; ++n) {
        float a[16];
#pragma unroll
        for (int j = 0; j < 16; ++j) a[j] = 0.f;
#pragma unroll
        for (int i = 0; i < 2; ++i)
#pragma unroll
            for (int cc = 0; cc < 2; ++cc) { const bf16x8 kx = *(const bf16x8*)(Kp + (size_t)(n * 256 + 128 * i + 16 * wid) * AW + cc * 512 + lane * 8);
#pragma unroll
                for (int j = 0; j < 8; ++j) a[cc * 8 + j] += bf2f(kx[j]); }
#pragma unroll
        for (int j = 0; j < 16; ++j) { a[j] += __shfl_xor(a[j], 1); a[j] += __shfl_xor(a[j], 2); a[j] += __shfl_xor(a[j], 4); a[j] += __shfl_xor(a[j], 8); }
        if ((lane & 15) == 0) {
#pragma unroll
            for (int j = 0; j < 16; ++j) red[(n * 8 + wid) * 64 + (j >> 3) * 32 + (lane >> 4) * 8 + (j & 7)] = a[j]; }
    }
    __syncthreads();
    { const int n = tid >> 6, d = tid & 63; float s = 0.f;
#pragma unroll
        for (int w = 0; w < 8; ++w) s += red[(n * 8 + w) * 64 + d];
        km[n * 64 + d] = s * (1.0f / 256.0f); }
    __syncthreads();
}
template <int DQK, bool MOBA>
__device__ __forceinline__ void attn_bh(const bf16_t* Qp, int ldq, const bf16_t* Kp, const bf16_t* KRp, const bf16_t* Vp, bf16_t* Op, int ldo, ALDS char* lds) {
    constexpr int ND = DQK / 16;
    ALDS char* K_lds = lds + L_K; ALDS char* V_lds = lds + L_V;
    bf16x8 sk0, sv0, sr0, sk1, sv1, sr1;
#define ATT_SLOAD(S, k0) do { sk##S = *(const bf16x8*)((const char*)(Kp + (size_t)(k0) * AW) + koff); sv##S = *(const bf16x8*)((const char*)(Vp + (size_t)(k0) * AW) + koff); if (DQK == 96) sr##S = *(const bf16x8*)((const char*)(KRp + (size_t)(k0) * RDIM) + roff); } while (0)
#define ATT_SWRITE(b, S) do { *(ALDS bf16x8*)(K_lds + (b) * KTB + kst) = sk##S; *(ALDS bf16x8*)(V_lds + (b) * VTB + vst) = sv##S; if (DQK == 96) { if (tid < 256) *(ALDS bf16x8*)(K_lds + (b) * KTB + rst) = sr##S; } } while (0)
#define ATT_QLOAD(q_) do { const bf16_t* Qw = Qp + (size_t)((q_) * 256 + wid * 32 + (r32 & 16)) * ldq + (r32 & 15) * 8 + hi * 128; _Pragma("unroll") for (int d0 = 0; d0 < ND; ++d0) qr[d0] = *(const bf16x8*)(Qw + (d0 >> 1) * 512 + (d0 & 1) * 256); } while (0)
    bf16x8 qr[ND];
    {
        const int tid = threadIdx.x, w_ = tid >> 6, l_ = tid & 63;
        const unsigned koff = (unsigned)((w_ >> 1) * 16 * AW + (w_ & 1) * 512 + l_ * 8) * 2u, roff = (unsigned)((w_ & 3) * 16 * RDIM + l_ * 8) * 2u;
        ATT_SLOAD(0, 0); ATT_SLOAD(1, 64); }
#pragma unroll 1
  for (int qb = 0; qb < 8; ++qb) {
    int tid_ = threadIdx.x; asm volatile("" : "+v"(tid_));
    const int tid = tid_, lane = tid & 63, r32 = lane & 31, hi = lane >> 5; const int wid = __builtin_amdgcn_readfirstlane(tid >> 6);
    ALDS float* al_l = (ALDS float*)(lds + L_WS) + wid * 64;
    const int skey = 16 * (wid >> 1) + (lane & 15), sch = 4 * (wid & 1) + (lane >> 4);
    const unsigned koff = (unsigned)((wid >> 1) * 16 * AW + (wid & 1) * 512 + lane * 8) * 2u;
    const int kst = skey * 128 + ((sch ^ ((skey >> 1) & 7)) << 4), vst = v_st(skey, sch * 8);
    const int rkey = 16 * (wid & 3) + (lane & 15), rch = lane >> 4;
    const unsigned roff = (unsigned)((wid & 3) * 16 * RDIM + lane * 8) * 2u;
    const int rst = 8192 + rkey * 64 + ((rch ^ ((rkey >> 2) & 3)) << 4);
    int ka[ND];
#pragma unroll
    for (int d0 = 0; d0 < ND; ++d0) ka[d0] = (d0 < 4) ? r32 * 128 + (((2 * d0 + hi) ^ ((r32 >> 1) & 7)) << 4) : 8192 + r32 * 64 + (((2 * (d0 - 4) + hi) ^ ((r32 >> 2) & 3)) << 4);
    const int vb0 = (int)(unsigned)(uintptr_t)V_lds + v_rd_base(lane);
    const int qrel = wid * 32 + r32;
    ATT_QLOAD(qb);
    float m_ref = 0.f, lsum = 0.f; f32x16 o[2], ol, negm; o[0] = f32x16{}; o[1] = f32x16{}; ol = f32x16{}; negm = f32x16{};
    unsigned sel = 0xffu;
    if (MOBA && qb > 3) {
        ALDS const float* km = (ALDS const float*)(lds + L_KM); float g[8];
#pragma unroll
        for (int n = 0; n < 8; ++n) { float s = 0.f;
#pragma unroll
            for (int d0 = 0; d0 < ND; ++d0)
#pragma unroll
                for (int j = 0; j < 8; ++j) s += bf2f(qr[d0][j]) * km[n * 64 + d0 * 16 + hi * 8 + j];
            g[n] = s; }
#pragma unroll
        for (int n = 0; n < 8; ++n) g[n] += __shfl_xor(g[n], 32);
        sel = 0u;
#pragma unroll
        for (int n = 0; n < 8; ++n) { int rank = 0;
#pragma unroll
            for (int mm = 0; mm < 8; ++mm) if (mm != n) rank += (mm < qb && (g[mm] > g[n] || (g[mm] == g[n] && mm < n))) ? 1 : 0;
            if (n < qb && rank < 3) sel |= 1u << n; }
    }
#define ATT_RESC(a) do { if (__any((a) < 1.f)) { lsum *= (a); if (hi == 0) al_l[r32] = (a); asm volatile("s_waitcnt lgkmcnt(0)" ::: "memory"); \
    _Pragma("unroll") for (int r = 0; r < 16; ++r) { const float f_ = al_l[crow(r, hi)]; o[0][r] *= f_; o[1][r] *= f_; ol[r] *= f_; } } } while (0)
    f32x16 pA0, pA1, pB0, pB1; float alA, alB; bf16x8 pa0, pa1, pa2, pa3; const int NT = 4 * (qb + 1), NP = 4 * qb;
    f32x16 cm = negm; const bool gated = MOBA && qb > 3;
#define ATT_CM(t) do { if (gated) { if ((t) < NP) { const float v_ = ((sel >> ((t) >> 2)) & 1u) ? -m_ref : -INFINITY; _Pragma("unroll") for (int r = 0; r < 16; ++r) cm[r] = v_; } else cm = negm; } else cm = negm; } while (0)
#define ATT_SCORE(P0, P1, t) do { ATT_CM(t); qkt<ND>(P0, P1, K_lds + sc * KTB, ka, qr, cm); if ((t) >= NP) cmask(P0, P1, (t) - NP, qrel, hi); } while (0)
    int sp = 0, sc = 0, sn = 1;
#define ATT_ROT() do { sp = sc; sc = sn; sn = (sn == NSLOT - 1) ? 0 : sn + 1; } while (0)
    ATT_SWRITE(0, 0); ATT_SLOAD(0, 128);
    __syncthreads(); ATT_SWRITE(sn, 1); ATT_SLOAD(1, 192);
    ATT_SCORE(pA0, pA1, 0); partialSM(pA0, pA1, m_ref, negm, alA);
    ATT_ROT();
    for (int t = 1; t + 1 < NT; t += 2) {
        __syncthreads(); ATT_SWRITE(sn, 0); if (t + 3 < NT) ATT_SLOAD(0, (t + 3) * 64);
        ASBAR(); ATT_SCORE(pB0, pB1, t);
        finishSM(pA0, pA1, pa0, pa1, pa2, pa3, lsum); ASBAR();
        pv_all(o, ol, vb0 + sp * VTB, pa0, pa1, pa2, pa3); partialSM(pB0, pB1, m_ref, negm, alB);
        ATT_RESC(alB); ATT_ROT();
        __syncthreads(); ATT_SWRITE(sn, 1); if (t + 4 < NT) ATT_SLOAD(1, (t + 4) * 64);
        ASBAR(); ATT_SCORE(pA0, pA1, t + 1);
        finishSM(pB0, pB1, pa0, pa1, pa2, pa3, lsum); ASBAR();
        pv_all(o, ol, vb0 + sp * VTB, pa0, pa1, pa2, pa3); partialSM(pA0, pA1, m_ref, negm, alA);
        ATT_RESC(alA); ATT_ROT();
    }
    __syncthreads();
    ASBAR(); ATT_SCORE(pB0, pB1, NT - 1);
    if (qb < 7) { ATT_SLOAD(0, 0); ATT_SLOAD(1, 64); }
    finishSM(pA0, pA1, pa0, pa1, pa2, pa3, lsum); ASBAR();
    pv_all(o, ol, vb0 + sp * VTB, pa0, pa1, pa2, pa3); partialSM(pB0, pB1, m_ref, negm, alB);
    ATT_RESC(alB);
    finishSM(pB0, pB1, pa0, pa1, pa2, pa3, lsum); ASBAR();
    pv_all(o, ol, vb0 + sc * VTB, pa0, pa1, pa2, pa3);
#undef ATT_ROT
#undef ATT_SCORE
#undef ATT_CM
    float rli[16];
#if ATT_LSUM_MFMA
#pragma unroll
    for (int r = 0; r < 16; ++r) rli[r] = __builtin_amdgcn_rcpf(ol[r]);
#else
    { auto rr = __builtin_amdgcn_permlane32_swap(__float_as_uint(lsum), __float_as_uint(lsum), false, false); lsum = __uint_as_float(rr[0]) + __uint_as_float(rr[1]); }
    if (hi == 0) al_l[32 + r32] = lsum; asm volatile("s_waitcnt lgkmcnt(0)" ::: "memory");
#pragma unroll
    for (int r = 0; r < 16; ++r) rli[r] = __builtin_amdgcn_rcpf(al_l[32 + crow(r, hi)]);
#endif
    { ALDS unsigned short* stg = (ALDS unsigned short*)(lds + L_OST) + wid * 2048;
#pragma unroll
      for (int r = 0; r < 16; ++r) { const int orow = crow(r, hi);
#pragma unroll
          for (int d0 = 0; d0 < 2; ++d0) stg[orow * 64 + d0 * 32 + r32] = (unsigned short)(cvtpk(o[d0][r] * rli[r], 0.f) & 0xffffu); }
      asm volatile("s_waitcnt lgkmcnt(0)" ::: "memory");
      bf16_t* Ow = Op + (size_t)(qb * 256 + wid * 32) * ldo;
#pragma unroll
      for (int i = 0; i < 4; ++i) { const int row = i * 8 + (lane >> 3), ch = lane & 7; const u32x4 v = *(ALDS const u32x4*)(stg + row * 64 + ch * 8); *(u32x4*)(Ow + (size_t)row * ldo + ch * 8) = v; } }
    __syncthreads();
  }
#undef ATT_SLOAD
#undef ATT_SWRITE
#undef ATT_QLOAD
#undef ATT_RESC
}

constexpr int MSLOT = 8192, M_K = 0, M_V = 3 * MSLOT, M_WS = 6 * MSLOT, M_OST = M_WS + 8 * 256, M_END = M_OST + 8 * 4096;
static_assert(M_END <= L_KM, "MoBA LDS map");
#define MPIN(x) asm volatile("" : "+v"(x))
#define MMFMA(a, b, c) __builtin_amdgcn_mfma_f32_32x32x16_bf16(a, b, c, 0, 0, 0)
#define MWAIT_BAR(N) asm volatile("s_waitcnt vmcnt(" #N ") lgkmcnt(0)\n\ts_barrier" ::: "memory")
__device__ __forceinline__ void m_kload2(bf16x8* kf, ALDS const char* kp, int d0) { kf[2 * d0] = *(ALDS const bf16x8*)(kp + d0 * 2048); kf[2 * d0 + 1] = *(ALDS const bf16x8*)(kp + d0 * 2048 + 512); }
__device__ __forceinline__ void m_glds16(const void* g, unsigned lds_base) {
    unsigned sv; asm volatile("s_mov_b32 %0, m0\n\ts_mov_b32 m0, %2\n\ts_nop 0\n\tglobal_load_lds_dwordx4 %1, off\n\ts_mov_b32 m0, %0" : "=&s"(sv) : "v"(g), "s"(lds_base) : "memory"); }
typedef ALDS s16x4 lds_s16x4_t;
__device__ __forceinline__ s16x4 m_vtr(ALDS const char* p) { return __builtin_amdgcn_ds_read_tr16_b64_v4i16((lds_s16x4_t*)p); }
#define MMX3(a, b, c) __builtin_fmaxf(__builtin_fmaxf((a), (b)), (c))
__device__ __forceinline__ float m_rowmax(const f32x16& p0, const f32x16& p1) {
    float a = MMX3(p0[0], p0[1], p1[0]), b = MMX3(p0[2], p0[3], p1[1]); a = MMX3(a, p1[2], p1[3]);
#pragma unroll
    for (int r = 4; r < 16; r += 4) { a = MMX3(a, p0[r], p0[r + 1]); b = MMX3(b, p0[r + 2], p0[r + 3]); a = MMX3(a, p1[r], p1[r + 1]); b = MMX3(b, p1[r + 2], p1[r + 3]); }
    float m = __builtin_fmaxf(a, b); auto rr = __builtin_amdgcn_permlane32_swap(__float_as_uint(m), __float_as_uint(m), false, false);
    return __builtin_fmaxf(__uint_as_float(rr[0]), __uint_as_float(rr[1])); }
__device__ __forceinline__ void moba_unit(const bf16_t* Qp, const bf16_t* Kp, const bf16_t* Vp, bf16_t* Op, int ldo, int qb, ALDS char* lds) {
    int tid_ = threadIdx.x; asm volatile("" : "+v"(tid_));
    const int tid = tid_, lane = tid & 63, r32 = lane & 31, hi = lane >> 5; const int wid = __builtin_amdgcn_readfirstlane(tid >> 6);
    const int NT = 4 * qb + 4, NP = 4 * qb;
    ALDS float* wsf = (ALDS float*)(lds + M_WS) + wid * 64;
    const bf16_t* ksrc = Kp + (size_t)(lane >> 4) * 16 * AW + (wid >> 2) * 512 + (wid & 3) * 128 + (lane & 15) * 8;
    const bf16_t* vsrc = Vp + (size_t)(wid & 3) * 16 * AW + (wid >> 2) * 512 + (lane & 3) * 128 + (lane >> 2) * 8;
    const unsigned lds0 = (unsigned)(uintptr_t)lds, kdst = lds0 + M_K + wid * 1024, vdst = lds0 + M_V + wid * 1024;
#define MDMA_K(t, slot) m_glds16(ksrc + (size_t)(t) * 64 * AW, (unsigned)__builtin_amdgcn_readfirstlane(kdst + (slot)))
#define MDMA_V(t, slot) m_glds16(vsrc + (size_t)(t) * 64 * AW, (unsigned)__builtin_amdgcn_readfirstlane(vdst + (slot)))
    ALDS const char* vp0 = lds + M_V + ((lane >> 4) & 1) * 32 + (lane & 3) * 8 + (4 * hi + ((lane & 15) >> 2)) * 64;
    ALDS const char* kp0 = lds + M_K + hi * 1024 + r32 * 16;
    MDMA_K(0, 0); MDMA_V(0, 0); MDMA_K(1, MSLOT);
    bf16x8 qr[4];
    { const bf16_t* Qw = Qp + (size_t)(qb * 256 + wid * 32 + (r32 & 16)) * AW + (r32 & 15) * 8 + hi * 128;
#pragma unroll
      for (int d0 = 0; d0 < 4; ++d0) qr[d0] = *(const bf16x8*)(Qw + (d0 >> 1) * 512 + (d0 & 1) * 256); }
    MDMA_K(2, 2 * MSLOT);
    float mhat = 0.f, l_reg = 0.f; f32x16 o[2]; o[0] = f32x16{}; o[1] = f32x16{};
    const int qrel = wid * 32 + r32; bool resc = false, moved = false;
    unsigned sel = 0xffu; const bool gated = qb > 3;
    if (gated) {
        ALDS const float* km = (ALDS const float*)(lds + L_KM); float g[8];
#pragma unroll
        for (int n = 0; n < 8; ++n) { float sg = 0.f;
#pragma unroll
            for (int d0 = 0; d0 < 4; ++d0)
#pragma unroll
                for (int j = 0; j < 8; ++j) sg += bf2f(qr[d0][j]) * km[n * 64 + d0 * 16 + hi * 8 + j];
            g[n] = sg; }
#pragma unroll
        for (int n = 0; n < 8; ++n) g[n] += __shfl_xor(g[n], 32);
        sel = 0u;
#pragma unroll
        for (int n = 0; n < 8; ++n) { int rank = 0;
#pragma unroll
            for (int mm = 0; mm < 8; ++mm) if (mm != n) rank += (mm < qb && (g[mm] > g[n] || (g[mm] == g[n] && mm < n))) ? 1 : 0;
            if (n < qb && rank < 3) sel |= 1u << n; }
    }
    f32x16 cm;
#define MCM(t) do { const float v_ = (gated && (t) < NP && !((sel >> ((t) >> 2)) & 1u)) ? -INFINITY : -mhat; _Pragma("unroll") for (int r = 0; r < 16; ++r) cm[r] = v_; MPIN(cm); } while (0)
    MCM(0);
    f32x16 pA0, pA1, pB0, pB1; bf16x8 kf[8]; s16x4 vlo[8], vhi[8]; u32x4 pw0, pw1, pw2, pw3;
    int sl_prev = 0, sl_cur = 0, sl_next = MSLOT;
#define MROT() do { sl_prev = sl_cur; sl_cur = sl_next; sl_next = (sl_next == 2 * MSLOT) ? 0 : sl_next + MSLOT; } while (0)
#define MEX(v) __builtin_amdgcn_exp2f(v)
#define MRESC(tn) do { if (moved) { moved = false; MCM(tn); } if (resc) { _Pragma("unroll") for (int d_ = 0; d_ < 2; ++d_) _Pragma("unroll") for (int r = 0; r < 16; ++r) o[d_][r] *= wsf[crow(r, hi)]; } } while (0)
#define MDECIDE(C0, C1) do { const float rm = m_rowmax(C0, C1); resc = false; \
      if (__builtin_expect(__any(rm > THR), 0)) { const float dl = __builtin_fmaxf(rm, 0.f); mhat += dl; const float f = __builtin_amdgcn_exp2f(-dl); l_reg *= f; if (hi == 0) wsf[r32] = f; resc = true; \
          _Pragma("unroll") for (int r = 0; r < 16; ++r) { C0[r] -= dl; C1[r] -= dl; } moved = true; } } while (0)
    MWAIT_BAR(3);
#pragma unroll
    for (int d0 = 0; d0 < 4; ++d0) m_kload2(kf, kp0, d0);
    pA0 = MMFMA(kf[0], qr[0], cm); pA1 = MMFMA(kf[1], qr[0], cm); pA0 = MMFMA(kf[2], qr[1], pA0); pA1 = MMFMA(kf[3], qr[1], pA1);
    pA0 = MMFMA(kf[4], qr[2], pA0); pA1 = MMFMA(kf[5], qr[2], pA1); pA0 = MMFMA(kf[6], qr[3], pA0); pA1 = MMFMA(kf[7], qr[3], pA1);
    if (NT == 4) cmask(pA0, pA1, 0, qrel, hi);
    MDECIDE(pA0, pA1);
    if (moved) { moved = false; MCM(1); }
#pragma unroll
    for (int r = 0; r < 16; ++r) { pA0[r] = MEX(pA0[r]); pA1[r] = MEX(pA1[r]); }
    MWAIT_BAR(0);
    MDMA_K(3, 0); MDMA_V(1, MSLOT); MROT();
#pragma unroll
    for (int d0 = 0; d0 < 4; ++d0) m_kload2(kf, kp0 + sl_cur, d0);
    MWAIT_BAR(2);
#define MPKW(P, i) cvtpk(P[i], P[i + 1])
#define MPAF(k) __builtin_bit_cast(bf16x8, pw##k)
#define MVFR(i) (bf16x8){vlo[i][0], vlo[i][1], vlo[i][2], vlo[i][3], vhi[i][0], vhi[i][1], vhi[i][2], vhi[i][3]}
#define MVRD(i) do { vlo[i] = m_vtr(vp_ + (((i) >> 2) * 4096 + ((i) & 3) * 1024)); vhi[i] = m_vtr(vp_ + (((i) >> 2) * 4096 + ((i) & 3) * 1024 + 512)); } while (0)
#define MKRD(G, d0) do { if (G) { m_kload2(kf, kp0 + sl_next, d0); ASBAR(); } } while (0)
#define MGAPA(MF, a0, a1, a2, a3, W0, W1, PW) do { MF; sacc += a0; sacc += a1; sacc += a2; sacc += a3; W0; W1; MPIN(PW); MPIN(sacc); ASBAR(); } while (0)
#define MGAPB(MF, X, i) do { MF; X[i] = MEX(X[i]); X[i + 1] = MEX(X[i + 1]); X[i + 2] = MEX(X[i + 2]); X[i + 3] = MEX(X[i + 3]); MPIN(X); ASBAR(); } while (0)
#define MSTEP(C0, C1, P0, P1, t, MASK, GK, GV, GL) do { ASBAR(); \
    const ALDS char* vp_ = vp0 + sl_prev; if (gated && ((t) & 3) == 0) MCM(t); \
    MVRD(0); ASBAR(); float sacc = P0[0] + P0[1]; \
                     MGAPA(C0 = MMFMA(kf[0], qr[0], cm), P0[2], P0[3], P0[4], P0[5],     pw0[0] = MPKW(P0, 0),  pw0[1] = MPKW(P0, 2),  pw0); \
    MVRD(4); ASBAR(); MGAPA(C1 = MMFMA(kf[1], qr[0], cm), P0[6], P0[7], P0[8], P0[9],     pw0[2] = MPKW(P0, 4),  pw0[3] = MPKW(P0, 6),  pw0); \
    MVRD(1); ASBAR(); MGAPA(C0 = MMFMA(kf[2], qr[1], C0), P0[10], P0[11], P0[12], P0[13], pw1[0] = MPKW(P0, 8),  pw1[1] = MPKW(P0, 10), pw1); \
    MVRD(5); ASBAR(); MGAPA(C1 = MMFMA(kf[3], qr[1], C1), P0[14], P0[15], P1[0], P1[1],   pw1[2] = MPKW(P0, 12), pw1[3] = MPKW(P0, 14), pw1); \
    MVRD(2); ASBAR(); MGAPA(C0 = MMFMA(kf[4], qr[2], C0), P1[2], P1[3], P1[4], P1[5],     pw2[0] = MPKW(P1, 0),  pw2[1] = MPKW(P1, 2),  pw2); \
    MVRD(6); ASBAR(); MGAPA(C1 = MMFMA(kf[5], qr[2], C1), P1[6], P1[7], P1[8], P1[9],     pw2[2] = MPKW(P1, 4),  pw2[3] = MPKW(P1, 6),  pw2); \
    MVRD(3); ASBAR(); MGAPA(C0 = MMFMA(kf[6], qr[3], C0), P1[10], P1[11], P1[12], P1[13], pw3[0] = MPKW(P1, 8),  pw3[1] = MPKW(P1, 10), pw3); \
    MVRD(7); ASBAR(); MGAPA(C1 = MMFMA(kf[7], qr[3], C1), P1[14], P1[15], 0.f, 0.f,       pw3[2] = MPKW(P1, 12), pw3[3] = MPKW(P1, 14), pw3); \
    l_reg += sacc; \
    if (GK) MDMA_K((t) + 3, sl_cur); if (GV) MDMA_V((t) + 1, sl_next); \
    if (MASK) cmask(C0, C1, (t) - NP, qrel, hi); \
    MDECIDE(C0, C1); ASBAR(); \
    MGAPB(o[0] = MMFMA(MPAF(0), MVFR(0), o[0]), C0, 0);               MGAPB(o[1] = MMFMA(MPAF(0), MVFR(4), o[1]), C0, 4); \
    MKRD(GL, 0); MGAPB(o[0] = MMFMA(MPAF(1), MVFR(1), o[0]), C0, 8);  MKRD(GL, 1); MGAPB(o[1] = MMFMA(MPAF(1), MVFR(5), o[1]), C0, 12); \
    MKRD(GL, 2); MGAPB(o[0] = MMFMA(MPAF(2), MVFR(2), o[0]), C1, 0);  MKRD(GL, 3); MGAPB(o[1] = MMFMA(MPAF(2), MVFR(6), o[1]), C1, 4); \
    MGAPB(o[0] = MMFMA(MPAF(3), MVFR(3), o[0]), C1, 8);               MGAPB(o[1] = MMFMA(MPAF(3), MVFR(7), o[1]), C1, 12); \
    } while (0)
    int t = 1;
    for (; t + 5 < NT; t += 2) {
        MSTEP(pB0, pB1, pA0, pA1, t, false, true, true, true);     MWAIT_BAR(2); MRESC(t + 1); MROT();
        MSTEP(pA0, pA1, pB0, pB1, t + 1, false, true, true, true); MWAIT_BAR(2); MRESC(t + 2); MROT();
    }
#define MENDW(tt) do { if ((tt) + 3 < NT) { MWAIT_BAR(2); } else if ((tt) + 2 < NT) { MWAIT_BAR(1); } else { MWAIT_BAR(0); } } while (0)
    for (; t + 1 < NT; t += 2) {
        MSTEP(pB0, pB1, pA0, pA1, t, true, (t + 3 < NT), (t + 1 < NT), (t + 1 < NT));         MENDW(t);     MRESC(t + 1); MROT();
        MSTEP(pA0, pA1, pB0, pB1, t + 1, true, (t + 4 < NT), (t + 2 < NT), (t + 2 < NT));     MENDW(t + 1); MRESC(t + 2); MROT();
    }
    MSTEP(pB0, pB1, pA0, pA1, NT - 1, true, false, false, false); MRESC(NT - 1);
    { float sacc = pB0[0] + pB0[1];
#pragma unroll
      for (int r = 2; r < 16; ++r) sacc += pB0[r];
#pragma unroll
      for (int r = 0; r < 16; ++r) sacc += pB1[r];
      l_reg += sacc;
      pw0 = (u32x4){MPKW(pB0, 0), MPKW(pB0, 2), MPKW(pB0, 4), MPKW(pB0, 6)}; pw1 = (u32x4){MPKW(pB0, 8), MPKW(pB0, 10), MPKW(pB0, 12), MPKW(pB0, 14)};
      pw2 = (u32x4){MPKW(pB1, 0), MPKW(pB1, 2), MPKW(pB1, 4), MPKW(pB1, 6)}; pw3 = (u32x4){MPKW(pB1, 8), MPKW(pB1, 10), MPKW(pB1, 12), MPKW(pB1, 14)};
      const ALDS char* vp_ = vp0 + sl_cur;
#pragma unroll
      for (int i = 0; i < 8; ++i) MVRD(i);
      o[0] = MMFMA(MPAF(0), MVFR(0), o[0]); o[1] = MMFMA(MPAF(0), MVFR(4), o[1]); o[0] = MMFMA(MPAF(1), MVFR(1), o[0]); o[1] = MMFMA(MPAF(1), MVFR(5), o[1]);
      o[0] = MMFMA(MPAF(2), MVFR(2), o[0]); o[1] = MMFMA(MPAF(2), MVFR(6), o[1]); o[0] = MMFMA(MPAF(3), MVFR(3), o[0]); o[1] = MMFMA(MPAF(3), MVFR(7), o[1]); }
    { auto rr = __builtin_amdgcn_permlane32_swap(__float_as_uint(l_reg), __float_as_uint(l_reg), false, false); l_reg = __uint_as_float(rr[0]) + __uint_as_float(rr[1]); }
    if (hi == 0) wsf[32 + r32] = l_reg; asm volatile("s_waitcnt lgkmcnt(0)" ::: "memory");
    float rli[16];
#pragma unroll
    for (int r = 0; r < 16; ++r) rli[r] = __builtin_amdgcn_rcpf(wsf[32 + crow(r, hi)]);
    { ALDS unsigned short* stg = (ALDS unsigned short*)(lds + M_OST) + wid * 2048;
#pragma unroll
      for (int r = 0; r < 16; ++r) { const int orow = crow(r, hi);
#pragma unroll
          for (int d0 = 0; d0 < 2; ++d0) stg[orow * 64 + d0 * 32 + r32] = (unsigned short)(cvtpk(o[d0][r] * rli[r], 0.f) & 0xffffu); }
      asm volatile("s_waitcnt lgkmcnt(0)" ::: "memory");
      bf16_t* Ow = Op + (size_t)(qb * 256 + wid * 32) * ldo;
#pragma unroll
      for (int i = 0; i < 4; ++i) { const int row = i * 8 + (lane >> 3), ch = lane & 7; const u32x4 v = *(ALDS const u32x4*)(stg + row * 64 + ch * 8); *(u32x4*)(Ow + (size_t)row * ldo + ch * 8) = v; } }
    asm volatile("s_waitcnt lgkmcnt(0)\n\ts_barrier" ::: "memory");
#undef MDMA_K
#undef MDMA_V
#undef MCM
#undef MROT
#undef MEX
#undef MRESC
#undef MDECIDE
#undef MPKW
#undef MPAF
#undef MVFR
#undef MVRD
#undef MKRD
#undef MGAPA
#undef MGAPB
#undef MSTEP
#undef MENDW
}
__device__ __forceinline__ void mla_unit(const bf16_t* Qp, const bf16_t* Kp, const bf16_t* KRp, const bf16_t* Vp, bf16_t* Op, int ldo, int qb, ALDS char* lds) {
    constexpr int KSL = 12288, N_K = 0, N_V = 3 * KSL, N_WS = N_V + 3 * MSLOT, N_OST = N_WS + 8 * 256;
    int tid_ = threadIdx.x; asm volatile("" : "+v"(tid_));
    const int tid = tid_, lane = tid & 63, r32 = lane & 31, hi = lane >> 5; const int wid = __builtin_amdgcn_readfirstlane(tid >> 6);
    const int NT = 4 * qb + 4, NP = 4 * qb;
    ALDS float* wsf = (ALDS float*)(lds + N_WS) + wid * 64;
    const bf16_t* ksrc = Kp + (size_t)(lane >> 4) * 16 * AW + (wid >> 2) * 512 + (wid & 3) * 128 + (lane & 15) * 8;
    const bf16_t* vsrc = Vp + (size_t)(wid & 3) * 16 * AW + (wid >> 2) * 512 + (lane & 3) * 128 + (lane >> 2) * 8;
    const bf16_t* rsrc = KRp + (size_t)(lane >> 4) * 16 * RDIM + (wid & 3) * 128 + (lane & 15) * 8;
    const unsigned lds0 = (unsigned)(uintptr_t)lds, kdst = lds0 + N_K + wid * 1024, vdst = lds0 + N_V + wid * 1024, rdst = lds0 + N_K + (8 + (wid & 3)) * 1024;
#define MDMA_K(t, slot) do { m_glds16(ksrc + (size_t)(t) * 64 * AW, (unsigned)__builtin_amdgcn_readfirstlane(kdst + (slot) * KSL)); m_glds16(rsrc + (size_t)(t) * 64 * RDIM, (unsigned)__builtin_amdgcn_readfirstlane(rdst + (slot) * KSL)); } while (0)
#define MDMA_V(t, slot) m_glds16(vsrc + (size_t)(t) * 64 * AW, (unsigned)__builtin_amdgcn_readfirstlane(vdst + (slot) * MSLOT))
    ALDS const char* vp0 = lds + N_V + ((lane >> 4) & 1) * 32 + (lane & 3) * 8 + (4 * hi + ((lane & 15) >> 2)) * 64;
    ALDS const char* kp0 = lds + N_K + hi * 1024 + r32 * 16;
    MDMA_K(0, 0); MDMA_V(0, 0); MDMA_K(1, 1);
    bf16x8 qr[6];
    { const bf16_t* Qw = Qp + (size_t)(qb * 256 + wid * 32 + (r32 & 16)) * (NHEAD * QKB) + (r32 & 15) * 8 + hi * 128;
#pragma unroll
      for (int d0 = 0; d0 < 6; ++d0) qr[d0] = *(const bf16x8*)(Qw + (d0 >> 1) * 512 + (d0 & 1) * 256); }
    MDMA_K(2, 2);
    float mhat = 0.f, l_reg = 0.f; f32x16 o[2]; o[0] = f32x16{}; o[1] = f32x16{};
    const int qrel = wid * 32 + r32; bool resc = false, moved = false;
    constexpr bool gated = false; constexpr unsigned sel = 0xffu;
#define MCM(t) do { } while (0)
#define MREL(C0, C1) do { if (__builtin_expect(__any(mhat != 0.f), 0)) { _Pragma("unroll") for (int r = 0; r < 16; ++r) { C0[r] -= mhat; C1[r] -= mhat; } } } while (0)
    f32x16 pA0, pA1, pB0, pB1; bf16x8 kf[12]; s16x4 vlo[8], vhi[8]; u32x4 pw0, pw1, pw2, pw3;
    int sl_prev = 0, sl_cur = 0, sl_next = 1;
#define MROT() do { sl_prev = sl_cur; sl_cur = sl_next; sl_next = (sl_next == 2) ? 0 : sl_next + 1; } while (0)
#define MEX(v) __builtin_amdgcn_exp2f(v)
#define MRESC(tn) do { if (resc) { _Pragma("unroll") for (int d_ = 0; d_ < 2; ++d_) _Pragma("unroll") for (int r = 0; r < 16; ++r) o[d_][r] *= wsf[crow(r, hi)]; } } while (0)
#define MDECIDE(C0, C1) do { const float rm = m_rowmax(C0, C1); resc = false; \
      if (__builtin_expect(__any(rm > THR), 0)) { const float dl = __builtin_fmaxf(rm, 0.f); mhat += dl; const float f = __builtin_amdgcn_exp2f(-dl); l_reg *= f; if (hi == 0) wsf[r32] = f; resc = true; \
          _Pragma("unroll") for (int r = 0; r < 16; ++r) { C0[r] -= dl; C1[r] -= dl; } moved = true; } } while (0)
    MWAIT_BAR(5);
#pragma unroll
    for (int d0 = 0; d0 < 6; ++d0) m_kload2(kf, kp0, d0);
    pA0 = MMFMA(kf[0], qr[0], (f32x16){}); pA1 = MMFMA(kf[1], qr[0], (f32x16){}); pA0 = MMFMA(kf[2], qr[1], pA0); pA1 = MMFMA(kf[3], qr[1], pA1);
    pA0 = MMFMA(kf[4], qr[2], pA0); pA1 = MMFMA(kf[5], qr[2], pA1); pA0 = MMFMA(kf[6], qr[3], pA0); pA1 = MMFMA(kf[7], qr[3], pA1);
    pA0 = MMFMA(kf[8], qr[4], pA0); pA1 = MMFMA(kf[9], qr[4], pA1); pA0 = MMFMA(kf[10], qr[5], pA0); pA1 = MMFMA(kf[11], qr[5], pA1);
    if (NT == 4) cmask(pA0, pA1, 0, qrel, hi);
    MREL(pA0, pA1); MDECIDE(pA0, pA1);
#pragma unroll
    for (int r = 0; r < 16; ++r) { pA0[r] = MEX(pA0[r]); pA1[r] = MEX(pA1[r]); }
    MWAIT_BAR(0);
    MDMA_K(3, 0); MDMA_V(1, 1); MROT();
#pragma unroll
    for (int d0 = 0; d0 < 6; ++d0) m_kload2(kf, kp0 + sl_cur * KSL, d0);
    MWAIT_BAR(3);
#define MPKW(P, i) cvtpk(P[i], P[i + 1])
#define MPAF(k) __builtin_bit_cast(bf16x8, pw##k)
#define MVFR(i) (bf16x8){vlo[i][0], vlo[i][1], vlo[i][2], vlo[i][3], vhi[i][0], vhi[i][1], vhi[i][2], vhi[i][3]}
#define MVRD(i) do { vlo[i] = m_vtr(vp_ + (((i) >> 2) * 4096 + ((i) & 3) * 1024)); vhi[i] = m_vtr(vp_ + (((i) >> 2) * 4096 + ((i) & 3) * 1024 + 512)); } while (0)
#define MKRD(G, d0) do { if (G) { m_kload2(kf, kp0 + sl_next * KSL, d0); ASBAR(); } } while (0)
#define MGAPA(MF, a0, a1, a2, a3, W0, W1, PW) do { MF; sacc += a0; sacc += a1; sacc += a2; sacc += a3; W0; W1; MPIN(PW); MPIN(sacc); ASBAR(); } while (0)
#define MGAPB(MF, X, i) do { MF; X[i] = MEX(X[i]); X[i + 1] = MEX(X[i + 1]); X[i + 2] = MEX(X[i + 2]); X[i + 3] = MEX(X[i + 3]); MPIN(X); ASBAR(); } while (0)
#define MGAPA2(MF, a0, a1, W0, PW) do { MF; sacc += a0; sacc += a1; W0; MPIN(PW); MPIN(sacc); ASBAR(); } while (0)
#define MSTEP(C0, C1, P0, P1, t, MASK, GK, GV, GL) do { ASBAR(); \
    const ALDS char* vp_ = vp0 + sl_prev * MSLOT; \
    MVRD(0); ASBAR(); float sacc = P0[0] + P0[1]; \
                     MGAPA(C0 = MMFMA(kf[0], qr[0], (f32x16){}), P0[2], P0[3], P0[4], P0[5],     pw0[0] = MPKW(P0, 0),  pw0[1] = MPKW(P0, 2),  pw0); \
    MVRD(4); ASBAR(); MGAPA(C1 = MMFMA(kf[1], qr[0], (f32x16){}), P0[6], P0[7], P0[8], P0[9],     pw0[2] = MPKW(P0, 4),  pw0[3] = MPKW(P0, 6),  pw0); \
    MVRD(1); ASBAR(); MGAPA2(C0 = MMFMA(kf[2], qr[1], C0), P0[10], P0[11], pw1[0] = MPKW(P0, 8),  pw1); \
    MVRD(5); ASBAR(); MGAPA2(C1 = MMFMA(kf[3], qr[1], C1), P0[12], P0[13], pw1[1] = MPKW(P0, 10), pw1); \
                     MGAPA2(C0 = MMFMA(kf[4], qr[2], C0), P0[14], P0[15], pw1[2] = MPKW(P0, 12), pw1); \
                     MGAPA2(C1 = MMFMA(kf[5], qr[2], C1), P1[0], P1[1],   pw1[3] = MPKW(P0, 14), pw1); \
                     MGAPA2(C0 = MMFMA(kf[6], qr[3], C0), P1[2], P1[3],   pw2[0] = MPKW(P1, 0),  pw2); \
                     MGAPA2(C1 = MMFMA(kf[7], qr[3], C1), P1[4], P1[5],   pw2[1] = MPKW(P1, 2),  pw2); \
                     MGAPA(C0 = MMFMA(kf[8], qr[4], C0), P1[6], P1[7], P1[8], P1[9],     pw2[2] = MPKW(P1, 4),  pw2[3] = MPKW(P1, 6),  pw2); \
                     MGAPA(C1 = MMFMA(kf[9], qr[4], C1), P1[10], P1[11], P1[12], P1[13], pw3[0] = MPKW(P1, 8),  pw3[1] = MPKW(P1, 10), pw3); \
                     MGAPA2(C0 = MMFMA(kf[10], qr[5], C0), P1[14], P1[15], pw3[2] = MPKW(P1, 12), pw3); \
                     MGAPA2(C1 = MMFMA(kf[11], qr[5], C1), 0.f, 0.f,       pw3[3] = MPKW(P1, 14), pw3); \
    l_reg += sacc; \
    if (GK) MDMA_K((t) + 3, sl_cur); if (GV) MDMA_V((t) + 1, sl_next); \
    if (MASK) cmask(C0, C1, (t) - NP, qrel, hi); \
    MREL(C0, C1); MDECIDE(C0, C1); ASBAR(); \
    MVRD(2); MKRD(GL, 4); ASBAR(); MGAPB(o[0] = MMFMA(MPAF(0), MVFR(0), o[0]), C0, 0);  MVRD(6); MKRD(GL, 5); ASBAR(); MGAPB(o[1] = MMFMA(MPAF(0), MVFR(4), o[1]), C0, 4); \
    MVRD(3); MKRD(GL, 0); ASBAR(); MGAPB(o[0] = MMFMA(MPAF(1), MVFR(1), o[0]), C0, 8);  MVRD(7); MKRD(GL, 1); ASBAR(); MGAPB(o[1] = MMFMA(MPAF(1), MVFR(5), o[1]), C0, 12); \
    MKRD(GL, 2); MGAPB(o[0] = MMFMA(MPAF(2), MVFR(2), o[0]), C1, 0);  MKRD(GL, 3); MGAPB(o[1] = MMFMA(MPAF(2), MVFR(6), o[1]), C1, 4); \
    MGAPB(o[0] = MMFMA(MPAF(3), MVFR(3), o[0]), C1, 8);               MGAPB(o[1] = MMFMA(MPAF(3), MVFR(7), o[1]), C1, 12); \
    } while (0)
    int t = 1;
    for (; t + 5 < NT; t += 2) {
        MSTEP(pB0, pB1, pA0, pA1, t, false, true, true, true);     MWAIT_BAR(3); MRESC(t + 1); MROT();
        MSTEP(pA0, pA1, pB0, pB1, t + 1, false, true, true, true); MWAIT_BAR(3); MRESC(t + 2); MROT();
    }
#define MENDW(tt) do { if ((tt) + 3 < NT) { MWAIT_BAR(3); } else if ((tt) + 2 < NT) { MWAIT_BAR(1); } else { MWAIT_BAR(0); } } while (0)
    for (; t + 1 < NT; t += 2) {
        MSTEP(pB0, pB1, pA0, pA1, t, true, (t + 3 < NT), (t + 1 < NT), (t + 1 < NT));         MENDW(t);     MRESC(t + 1); MROT();
        MSTEP(pA0, pA1, pB0, pB1, t + 1, true, (t + 4 < NT), (t + 2 < NT), (t + 2 < NT));     MENDW(t + 1); MRESC(t + 2); MROT();
    }
    MSTEP(pB0, pB1, pA0, pA1, NT - 1, true, false, false, false); MRESC(NT - 1);
    { float sacc = pB0[0] + pB0[1];
#pragma unroll
      for (int r = 2; r < 16; ++r) sacc += pB0[r];
#pragma unroll
      for (int r = 0; r < 16; ++r) sacc += pB1[r];
      l_reg += sacc;
      pw0 = (u32x4){MPKW(pB0, 0), MPKW(pB0, 2), MPKW(pB0, 4), MPKW(pB0, 6)}; pw1 = (u32x4){MPKW(pB0, 8), MPKW(pB0, 10), MPKW(pB0, 12), MPKW(pB0, 14)};
      pw2 = (u32x4){MPKW(pB1, 0), MPKW(pB1, 2), MPKW(pB1, 4), MPKW(pB1, 6)}; pw3 = (u32x4){MPKW(pB1, 8), MPKW(pB1, 10), MPKW(pB1, 12), MPKW(pB1, 14)};
      const ALDS char* vp_ = vp0 + sl_cur * MSLOT;
#pragma unroll
      for (int i = 0; i < 8; ++i) MVRD(i);
      o[0] = MMFMA(MPAF(0), MVFR(0), o[0]); o[1] = MMFMA(MPAF(0), MVFR(4), o[1]); o[0] = MMFMA(MPAF(1), MVFR(1), o[0]); o[1] = MMFMA(MPAF(1), MVFR(5), o[1]);
      o[0] = MMFMA(MPAF(2), MVFR(2), o[0]); o[1] = MMFMA(MPAF(2), MVFR(6), o[1]); o[0] = MMFMA(MPAF(3), MVFR(3), o[0]); o[1] = MMFMA(MPAF(3), MVFR(7), o[1]); }
    { auto rr = __builtin_amdgcn_permlane32_swap(__float_as_uint(l_reg), __float_as_uint(l_reg), false, false); l_reg = __uint_as_float(rr[0]) + __uint_as_float(rr[1]); }
    if (hi == 0) wsf[32 + r32] = l_reg; asm volatile("s_waitcnt lgkmcnt(0)" ::: "memory");
    float rli[16];
#pragma unroll
    for (int r = 0; r < 16; ++r) rli[r] = __builtin_amdgcn_rcpf(wsf[32 + crow(r, hi)]);
    { ALDS unsigned short* stg = (ALDS unsigned short*)(lds + N_OST) + wid * 2048;
#pragma unroll
      for (int r = 0; r < 16; ++r) { const int orow = crow(r, hi);
#pragma unroll
          for (int d0 = 0; d0 < 2; ++d0) stg[orow * 64 + d0 * 32 + r32] = (unsigned short)(cvtpk(o[d0][r] * rli[r], 0.f) & 0xffffu); }
      asm volatile("s_waitcnt lgkmcnt(0)" ::: "memory");
      bf16_t* Ow = Op + (size_t)(qb * 256 + wid * 32) * ldo;
#pragma unroll
      for (int i = 0; i < 4; ++i) { const int row = i * 8 + (lane >> 3), ch = lane & 7; const u32x4 v = *(ALDS const u32x4*)(stg + row * 64 + ch * 8); *(u32x4*)(Ow + (size_t)row * ldo + ch * 8) = v; } }
    asm volatile("s_waitcnt lgkmcnt(0)\n\ts_barrier" ::: "memory");
#undef MDMA_K
#undef MDMA_V
#undef MCM
#undef MROT
#undef MEX
#undef MRESC
#undef MDECIDE
#undef MPKW
#undef MPAF
#undef MVFR
#undef MVRD
#undef MKRD
#undef MGAPA
#undef MGAPB
#undef MSTEP
#undef MENDW
#undef MGAPA2
#undef MREL
}
#undef ASBAR
}
#define GAS __attribute__((address_space(1)))
#define LAS __attribute__((address_space(3)))
typedef unsigned short bf16;
typedef unsigned v4u __attribute__((ext_vector_type(4)));
typedef float f32x4 __attribute__((ext_vector_type(4)));
typedef short bf16x8 __attribute__((ext_vector_type(8)));
typedef GAS unsigned gu32;
typedef GAS unsigned long long gu64;
#define RLX_AGENT __ATOMIC_RELAXED, __HIP_MEMORY_SCOPE_AGENT
#define LDS_WAIT() asm volatile("s_waitcnt lgkmcnt(0)" ::: "memory")
#define VM_WAIT() asm volatile("s_waitcnt vmcnt(0)" ::: "memory")
__device__ __forceinline__ unsigned long long rt() { return __builtin_amdgcn_s_memrealtime(); }
__device__ __forceinline__ unsigned f2bf(float f) { unsigned u = __builtin_bit_cast(unsigned, f); return (u + 0x7fffu + ((u >> 16) & 1u)) >> 16; }
__device__ __forceinline__ unsigned pk2(float lo, float hi) { return f2bf(lo) | (f2bf(hi) << 16); }

#define XB_TMO      128
#define XB_XCNT(j)  (256  + 64 * (j))
#define XB_XSUB(j)  (1280 + 64 * (j))
#define XB_XGEN(j)  (2304 + 64 * (j))
#define XB_TOP      3328
#define XB_TOPGEN   3392
#define XCD_BAR_WORDS 3456
#define XB_SPIN_CAP (1u << 18)

__device__ __forceinline__ unsigned xb_ld(unsigned* p)              { return __hip_atomic_load(p, __ATOMIC_RELAXED, __HIP_MEMORY_SCOPE_AGENT); }
__device__ __forceinline__ unsigned xb_add(unsigned* p, unsigned v) { return __hip_atomic_fetch_add(p, v, __ATOMIC_RELAXED, __HIP_MEMORY_SCOPE_AGENT); }
__device__ __forceinline__ unsigned xb_xcc_id() { return (unsigned)__builtin_amdgcn_s_getreg((3 << 11) | 20) & 0xFu; }
#define XB_SPIN(cond, bar) do { unsigned _sp = 0; while (cond) { __builtin_amdgcn_s_sleep(1); \
    if ((++_sp & 255u) == 0u) { if (xb_ld(&(bar)[XB_TMO])) break; if (_sp > XB_SPIN_CAP) { atomicAdd(&(bar)[XB_TMO], 1u); break; } } } } while (0)

struct XcdBarrier {
    unsigned* bar; unsigned x;
    volatile LAS unsigned* st;
};

__device__ __forceinline__ XcdBarrier xcd_barrier_post(unsigned* bar, volatile LAS unsigned* st) {
    XcdBarrier b; b.bar = bar; b.x = xb_xcc_id(); b.st = st;
    if (threadIdx.x == 0) (void)xb_add(&bar[XB_XCNT(b.x)], 1u);
    return b;
}
__device__ __forceinline__ void xcd_barrier_complete(unsigned* bar, unsigned x, unsigned& nloc, unsigned& nx) {
    const unsigned G = gridDim.x * gridDim.y * gridDim.z;
    unsigned sum, cnt, mine, sp = 0u;
    for (;;) {
        sum = 0u; cnt = 0u; mine = 0u;
#pragma unroll
        for (unsigned j = 0; j < 16; ++j) { const unsigned c = xb_ld(&bar[XB_XCNT(j)]); sum += c; cnt += (c > 0u) ? 1u : 0u; mine = (j == x) ? c : mine; }
        if (sum == G) break;
        __builtin_amdgcn_s_sleep(1);
        if ((++sp & 255u) == 0u) { if (xb_ld(&bar[XB_TMO])) break; if (sp > XB_SPIN_CAP) { atomicAdd(&bar[XB_TMO], 1u); break; } }
    }
    nloc = mine > 0u ? mine : 1u; nx = cnt > 0u ? cnt : 1u;
}

__device__ __forceinline__ void xcd_barrier(const XcdBarrier& b) {
    asm volatile("s_waitcnt vmcnt(0)" ::: "memory");
    __syncthreads();
    if (threadIdx.x == 0) {
        unsigned* bar = b.bar;
        __builtin_amdgcn_s_waitcnt(0);
        unsigned nloc = b.st[0], nx = b.st[1];
        if (nloc == 0u) { xcd_barrier_complete(bar, b.x, nloc, nx); b.st[0] = nloc; b.st[1] = nx; }
        const unsigned old = xb_add(&bar[XB_XSUB(b.x)], 1u);
        const unsigned gen = old / nloc;
        if (old + 1u == (gen + 1u) * nloc) {
            __builtin_amdgcn_fence(__ATOMIC_RELEASE, "agent");
            asm volatile("s_waitcnt vmcnt(0)" ::: "memory");
            const unsigned og = xb_add(&bar[XB_TOP], 1u);
            const unsigned tg = og / nx;
            if (og + 1u == (tg + 1u) * nx) xb_add(&bar[XB_TOPGEN], 1u);
            else XB_SPIN(xb_ld(&bar[XB_TOPGEN]) == tg, bar);
            __builtin_amdgcn_fence(__ATOMIC_ACQUIRE, "agent");
            xb_add(&bar[XB_XGEN(b.x)], 1u);
            asm volatile("s_waitcnt vmcnt(0)" ::: "memory");
        } else {
            XB_SPIN(xb_ld(&bar[XB_XGEN(b.x)]) == gen, bar);
            __builtin_amdgcn_fence(__ATOMIC_ACQUIRE, "agent");
            asm volatile("s_waitcnt vmcnt(0)" ::: "memory");
        }
    }
    __syncthreads();
}

constexpr size_t MiB = 1u << 20;
constexpr size_t WS_CTL = 0, CTL_ZERO_BYTES = 64 * 1024;
constexpr size_t WS_ROPEA = 1 * MiB, WS_ROPEB = 5 * MiB;
constexpr size_t WS_SS = 13 * MiB, WS_SS2 = 16 * MiB, WS_SS3 = 20 * MiB;
constexpr size_t WS_WIN = 24 * MiB, WS_WUQ = 34 * MiB, WS_WUKV = 35 * MiB, WS_WA = 36 * MiB, WS_WOUT = 39 * MiB, WS_WUP = 42 * MiB, WS_WDN = 51 * MiB;
constexpr size_t WS_H = 64 * MiB;
constexpr size_t WS_G = 208 * MiB;
constexpr size_t WS_QA = 464 * MiB, WS_KA = 528 * MiB, WS_VA = 592 * MiB;
constexpr size_t WS_T = WS_KA;
constexpr size_t WS_CQ = 672 * MiB, WS_CKV = 720 * MiB;
constexpr size_t WS_KR = 760 * MiB;
constexpr size_t WS_QB = 768 * MiB, WS_KB = 864 * MiB, WS_VB = 928 * MiB;
constexpr size_t WS_Y = WS_QB;
constexpr size_t WS_X1 = 896 * MiB;
constexpr size_t WS_H8 = WS_QB;
constexpr size_t WS_WG8 = 60 * MiB;
constexpr size_t WS_U = 208 * MiB;
constexpr size_t WS_END = 1024 * MiB;
static_assert(WS_H + (size_t)MTOK * LDH * 2 <= WS_G && WS_G + (size_t)MTOK * 2 * DM * 2 <= WS_QA && WS_T + (size_t)MTOK * LDH * 2 <= WS_CQ && WS_CQ + (size_t)MTOK * QLORA * 2 <= WS_CKV && WS_CKV + (size_t)MTOK * LDKV * 2 <= WS_KR, "d_ws map");
static_assert(WS_U + (size_t)MTOK * LDU * 2 <= WS_KR && WS_Y + (size_t)MTOK * DM * 2 <= WS_X1 && WS_X1 + (size_t)MTOK * DM * 2 <= WS_END && WS_VB + (size_t)MTOK * AW * 2 <= WS_END && WS_KR + (size_t)MTOK * RDIM * 2 <= WS_QB, "d_ws map");
static_assert(WS_WIN + (size_t)INWP * LDH * 2 <= WS_WUQ && WS_WUKV + (size_t)1024 * LDKV * 2 <= WS_WA && WS_WA + (size_t)DM * LDH * 2 <= WS_WOUT && WS_WOUT + (size_t)DM * LDH * 2 <= WS_WUP && WS_WUP + (size_t)DFF * LDH * 2 <= WS_WDN && WS_WDN + (size_t)DM * LDU * 2 <= WS_H, "d_ws map");
constexpr int CW_BAR = 0;
constexpr int NWAVES = 8;
constexpr int RING_OFF = 0, RING_BYTES = 131072;
constexpr int LDSCTL_OFF = RING_BYTES, MISC_OFF = LDSCTL_OFF + 320;
constexpr int LDS_BYTES = 147456;
static_assert(att::L_END <= RING_BYTES, "attention LDS map");

struct Frame {
    LAS unsigned char* lds;
    volatile LAS unsigned* MISC;
    gu32* ctl;
    int tid, lane, wave, vcu, G;
};

__device__ __forceinline__ float wave_sum(float v) {
#pragma unroll
    for (int o = 1; o < 64; o <<= 1) v += __shfl_xor(v, o);
    return v;
}
__device__ __forceinline__ int srccol(int mat, int n) {
    if (mat == 0) {
        if (n < 1024) { const int sect = n >> 9, c = n & 511, head = c >> 6, p = c & 63; const int d = (p < 16) ? ((p >> 1) + 8 * (p & 1)) : p; return sect * 512 + head * 64 + d; }
        if (n < 1920) return n;
        if (n < 1952) { const int pr = n - 1920; return 2176 + (pr >> 1) + 16 * (pr & 1); }
        if (n < 2048) return -1;
        if (n < 2304) return 1920 + (n - 2048);
        return 2208 + (n - 2304);
    }
    if (mat == 1) { const int head = n / QKB, p = n - head * QKB; if (p < 64) return n; const int pr = p - 64; return head * QKB + 64 + (pr >> 1) + 16 * (pr & 1); }
    return n;
}
__device__ __forceinline__ void p0_transpose_item(const float* W, int K, int Nsrc, int Ndst, bf16* WT, int ldw, int koff, const float* gs, int mat, LAS float* scr, int item, int lane) {
    const int nblk = Ndst / 32, kb = item / nblk, nb = item % nblk, k0 = 64 * kb, n0 = 32 * nb;
    const int sc = srccol(mat, n0 + (lane & 31));
#pragma unroll 8
    for (int i = 0; i < 32; ++i) { const int kk = 2 * i + (lane >> 5); float v = (sc >= 0) ? W[(size_t)(k0 + kk) * Nsrc + sc] : 0.f; if (gs) v *= gs[k0 + kk]; scr[kk * 33 + (lane & 31)] = v; }
    LDS_WAIT(); asm volatile("" ::: "memory");
    const int c = lane & 7;
#pragma unroll
    for (int j = 0; j < 4; ++j) { const int n = (lane >> 3) + 8 * j; const LAS float* s = scr + (8 * c) * 33 + n;
        v4u o; o.x = pk2(s[0 * 33], s[1 * 33]); o.y = pk2(s[2 * 33], s[3 * 33]); o.z = pk2(s[4 * 33], s[5 * 33]); o.w = pk2(s[6 * 33], s[7 * 33]);
        *(GAS v4u*)(WT + (size_t)(n0 + n) * ldw + koff + k0 + 8 * c) = o; }
    LDS_WAIT(); asm volatile("" ::: "memory");
}
__device__ __forceinline__ int ppos_dn(int c) { return (c & ~255) | (((c >> 5) & 3) << 6) | (((c >> 3) & 3) << 4) | (((c >> 7) & 1) << 3) | (c & 7); }
template <bool KPERM = false>
__device__ __forceinline__ void p0_transpose_item_f8(const float* W, int K, int N, int Nsrc, int coff, unsigned char* WT, float scale, LAS float* scr, int item, int lane) {
    const int nblk = N / 32, kb = item / nblk, nb = item % nblk, k0 = 64 * kb, n0 = 32 * nb;
#pragma unroll 8
    for (int i = 0; i < 32; ++i) { const int kk = 2 * i + (lane >> 5); scr[kk * 33 + (lane & 31)] = W[(size_t)(k0 + kk) * Nsrc + coff + n0 + (lane & 31)] * scale; }
    LDS_WAIT(); asm volatile("" ::: "memory");
    const int c = lane & 7;
#pragma unroll
    for (int j = 0; j < 4; ++j) { const int n = (lane >> 3) + 8 * j; const LAS float* s = scr + (8 * c) * 33 + n;
        int w0 = 0, w1 = 0;
        w0 = __builtin_amdgcn_cvt_pk_fp8_f32(s[0 * 33], s[1 * 33], w0, false); w0 = __builtin_amdgcn_cvt_pk_fp8_f32(s[2 * 33], s[3 * 33], w0, true);
        w1 = __builtin_amdgcn_cvt_pk_fp8_f32(s[4 * 33], s[5 * 33], w1, false); w1 = __builtin_amdgcn_cvt_pk_fp8_f32(s[6 * 33], s[7 * 33], w1, true);
        typedef int i32x2_ __attribute__((ext_vector_type(2)));
        *(GAS i32x2_*)(WT + (size_t)(n0 + n) * K + (KPERM ? ppos_dn(k0 + 8 * c) : k0 + 8 * c)) = (i32x2_){w0, w1}; }
    LDS_WAIT(); asm volatile("" ::: "memory");
}
__device__ __forceinline__ void rms_row_to_bf16(int lane, const float* xrow, const f32x4 (&g)[4], bf16* orow, unsigned char* orow8) {
    const GAS f32x4* xr = (const GAS f32x4*)xrow + lane;
    f32x4 v[4]; float s = 0.f;
#pragma unroll
    for (int j = 0; j < 4; ++j) { v[j] = xr[64 * j]; s += (v[j].x * v[j].x + v[j].y * v[j].y) + (v[j].z * v[j].z + v[j].w * v[j].w); }
    const float rstd = 1.f / sqrtf(wave_sum(s) * (1.f / DM) + EPS);
    GAS unsigned long long* o8 = (GAS unsigned long long*)orow + lane;
#pragma unroll
    for (int j = 0; j < 4; ++j) { const f32x4 y = v[j] * rstd * g[j]; o8[64 * j] = (unsigned long long)pk2(y.x, y.y) | ((unsigned long long)pk2(y.z, y.w) << 32);
        int w = 0; w = __builtin_amdgcn_cvt_pk_fp8_f32(y.x, y.y, w, false); w = __builtin_amdgcn_cvt_pk_fp8_f32(y.z, y.w, w, true); ((GAS int*)orow8)[lane + 64 * j] = w; }
}

struct Args { const float* in[17]; float* out; unsigned char* ws; int ph_lo, ph_hi, li, pad; };

__global__ void __launch_bounds__(NWAVES * 64, 2) block_fwd(Args args) {
    extern __shared__ __attribute__((aligned(16))) unsigned char lds[];
    Frame F;
    F.lds = (LAS unsigned char*)lds;
    F.MISC = (volatile LAS unsigned*)(F.lds + MISC_OFF);
    F.tid = threadIdx.x; F.lane = F.tid & 63; F.wave = __builtin_amdgcn_readfirstlane(F.tid >> 6);
    F.G = gridDim.x; { const int bx = blockIdx.x; F.vcu = (F.G % 8 == 0) ? (bx % 8) * (F.G / 8) + bx / 8 : bx; }
    unsigned char* ws = args.ws;
    F.ctl = (gu32*)(ws + WS_CTL);
    const float* x = args.in[0]; const int* positions = (const int*)args.in[1];
    const float *g_pre_mix = args.in[2], *w_in = args.in[3], *b_gate = args.in[4], *g_q = args.in[5], *w_uq = args.in[6], *g_kv = args.in[7], *w_ukv = args.in[8], *w_a = args.in[9], *w_b = args.in[10],
                *w_out = args.in[11], *g_post_mix = args.in[12], *g_pre_mlp = args.in[13], *w_up = args.in[14], *w_dn = args.in[15], *g_post_mlp = args.in[16];
    float* out = args.out;
    float* ropeA = (float*)(ws + WS_ROPEA); float* ropeB = (float*)(ws + WS_ROPEB);
    float* SS = (float*)(ws + WS_SS); float* SS2 = (float*)(ws + WS_SS2); float* SS3 = (float*)(ws + WS_SS3);
    bf16 *WIN = (bf16*)(ws + WS_WIN), *WUQ = (bf16*)(ws + WS_WUQ), *WUKV = (bf16*)(ws + WS_WUKV), *WA = (bf16*)(ws + WS_WA), *WOUT = (bf16*)(ws + WS_WOUT), *WUP = (bf16*)(ws + WS_WUP), *WDN = (bf16*)(ws + WS_WDN);
    bf16 *H = (bf16*)(ws + WS_H), *Gt = (bf16*)(ws + WS_G), *QA = (bf16*)(ws + WS_QA), *KA = (bf16*)(ws + WS_KA), *VA = (bf16*)(ws + WS_VA), *T = (bf16*)(ws + WS_T), *CQ = (bf16*)(ws + WS_CQ), *CKV = (bf16*)(ws + WS_CKV),
         *KR = (bf16*)(ws + WS_KR), *QB = (bf16*)(ws + WS_QB), *KB = (bf16*)(ws + WS_KB), *VB = (bf16*)(ws + WS_VB), *Y = (bf16*)(ws + WS_Y), *U = (bf16*)(ws + WS_U), *X1B = (bf16*)(ws + WS_X1); unsigned char *H8 = ws + WS_H8, *WG8 = ws + WS_WG8;
    for (int u = F.tid; u < (LDS_BYTES - LDSCTL_OFF) / 4; u += NWAVES * 64) ((LAS unsigned*)(F.lds + LDSCTL_OFF))[u] = 0u;
    __syncthreads();
    XcdBarrier bar = xcd_barrier_post((unsigned*)(F.ctl + CW_BAR) + args.li * XCD_BAR_WORDS, F.MISC + 8);
    const int lo = args.ph_lo, hi = args.ph_hi;
#define IN(k) (lo <= (k) && (k) < hi)
#define SEAM(k) do { if (IN(k) && IN((k) + 1)) xcd_barrier(bar); } while (0)
    const int gw = F.vcu * NWAVES + F.wave, NGW = F.G * NWAVES;

#if !defined(SKIP_P0)
    if (IN(0))
    {
        LAS float* scr = (LAS float*)(F.lds + RING_OFF + F.wave * 16384);
        constexpr int NBF = 2304, IG = (DM / 64) * (2 * DM / 32);
        constexpr int I0 = (DM / 64) * (NBF / 32), I1 = (QLORA / 64) * (768 / 32), I2 = (KVLORA / 64) * (1024 / 32), I3 = (AW / 64) * (DM / 32), I5 = (DM / 64) * (DM / 32), I6 = (DM / 64) * (DFF / 32), I7 = (DFF / 64) * (DM / 32);
        constexpr int NITEMS = I0 + I1 + I2 + 2 * I3 + I5 + I6 + I7 + IG;
        for (int it = gw; it < NITEMS; it += NGW) {
            int r = it;
            if (r < I0) { p0_transpose_item(w_in, DM, INW, NBF, WIN, LDH, 0, nullptr, 0, scr, r, F.lane); continue; } r -= I0;
            if (r < IG) { p0_transpose_item_f8(w_in, DM, 2 * DM, INW, 2208, WG8, 32.f, scr, r, F.lane); continue; } r -= IG;
            if (r < I1) { p0_transpose_item(w_uq, QLORA, 768, 768, WUQ, QLORA, 0, g_q, 1, scr, r, F.lane); continue; } r -= I1;
            if (r < I2) { p0_transpose_item(w_ukv, KVLORA, 1024, 1024, WUKV, LDKV, 0, g_kv, 2, scr, r, F.lane); continue; } r -= I2;
            if (r < I3) { p0_transpose_item(w_a, AW, DM, DM, WA, LDH, 0, nullptr, 2, scr, r, F.lane); continue; } r -= I3;
            if (r < I3) { p0_transpose_item(w_b, AW, DM, DM, WA, LDH, AW, nullptr, 2, scr, r, F.lane); continue; } r -= I3;
            if (r < I5) { p0_transpose_item_f8<true>(w_out, DM, DM, DM, 0, (unsigned char*)WOUT, 32.f, scr, r, F.lane); continue; } r -= I5;
            if (r < I6) { p0_transpose_item_f8(w_up, DM, DFF, DFF, 0, (unsigned char*)WUP, 32.f, scr, r, F.lane); continue; } r -= I6;
            p0_transpose_item_f8<true>(w_dn, DFF, DM, DM, 0, (unsigned char*)WDN, 64.f, scr, r, F.lane);
        }
        for (int idx = (int)blockIdx.x * (NWAVES * 64) + F.tid; idx < MTOK * 24; idx += F.G * NWAVES * 64) {
            const int m = idx / 24, i = idx - m * 24;
            const float invf = (i < 8) ? __builtin_amdgcn_exp2f(-(float)i * 2.3664460711655217f) : __builtin_amdgcn_exp2f(-(float)(i - 8) * 1.1832230355827609f);
            const float ang = (float)positions[m] * invf;
            double t = (double)ang * 0.15915494309189535; t -= floor(t);
            const float tf = (float)t; const float c = __builtin_amdgcn_cosf(tf), s = __builtin_amdgcn_sinf(tf);
            float* dst = (i < 8) ? ropeA + (size_t)m * 16 + 2 * i : ropeB + (size_t)m * 32 + 2 * (i - 8);
            *(f32x2g*)dst = (f32x2g){c, s};
        }
        f32x4 g[4];
#pragma unroll
        for (int j = 0; j < 4; ++j) g[j] = ((const GAS f32x4*)g_pre_mix)[F.lane + 64 * j];
        for (int m = gw; m < MTOK; m += NGW) rms_row_to_bf16(F.lane, x + (size_t)m * DM, g, H + (size_t)m * LDH, H8 + (size_t)m * DM);
    }
#endif
    SEAM(0);

#if !defined(SKIP_P1)
    if (IN(1))
    {
        { pg8::Gemm g{H, WIN, MTOK, 2304, DM, LDH, LDH}; pg8::StaticOrder S; S.init(MTOK, 2304, F.G, (int)blockIdx.x);
          pg8::EpiIn E{QA, KA, VA, CQ, CKV, KR, Gt, SS, ropeA, ropeB, b_gate};
          pg8::gemm_phase<pg8::EpiIn, pg8::StaticOrder, true, true>(F.lds + RING_OFF, g, S, E); }
        { pg8::Gemm g{(const bf16*)H8, (const bf16*)WG8, MTOK, 2 * DM, DM, DM, DM}; pg8::StaticOrder S; S.init(MTOK, 2 * DM, F.G, (int)blockIdx.x);
          pg8::EpiGates E{Gt, b_gate};
          pg8::gemm_phase<pg8::EpiGates, pg8::StaticOrder, true, true, 1>(F.lds + RING_OFF, g, S, E); }
    }
#endif
    SEAM(1);

#if !defined(SKIP_P2)
    if (IN(2)) {
    {
        pg8::Gemm g{CQ, WUQ, MTOK, NHEAD * QKB, QLORA}; pg8::StaticOrder S; S.init(MTOK, NHEAD * QKB, F.G, (int)blockIdx.x);
        pg8::EpiQ E{QB, SS, ropeB};
        pg8::gemm_phase<pg8::EpiQ, pg8::StaticOrder, true, true, 2, true>(F.lds + RING_OFF, g, S, E);
    }
    {
        pg8::Gemm g{CKV, WUKV, MTOK, 2 * AW, KVLORA, LDKV, LDKV}; pg8::StaticOrder S; S.init(MTOK, 2 * AW, F.G, (int)blockIdx.x);
        pg8::EpiKV E{KB, VB, SS};
        pg8::gemm_phase<pg8::EpiKV, pg8::StaticOrder, true, true, 2, true>(F.lds + RING_OFF, g, S, E);
    }
    }
#endif
    SEAM(2);

#if !defined(SKIP_P3)
    if (IN(3))
    {
        LAS char* al = (LAS char*)(F.lds + RING_OFF);
#if !defined(SKIP_MOBA)
        for (int bh = F.vcu; bh < NB * NHEAD; bh += F.G) {
            const int b = bh >> 3, h = bh & 7; const size_t r0 = (size_t)b * SEQ;
            att::kmean_blocks(KA + r0 * AW + h * HD * 16, al);
#pragma unroll 1
            for (int qb = 0; qb < 8; ++qb) att::moba_unit(QA + r0 * AW + h * HD * 16, KA + r0 * AW + h * HD * 16, VA + r0 * AW + h * HD * 16, H + r0 * LDH + h * HD, LDH, qb, al);
        }
#endif
#if !defined(SKIP_MLA)
        for (int bh = F.vcu; bh < NB * NHEAD; bh += F.G) {
            const int b = bh >> 3, h = bh & 7; const size_t r0 = (size_t)b * SEQ;
#pragma unroll 1
            for (int qb = 0; qb < 8; ++qb) att::mla_unit(QB + r0 * (NHEAD * QKB) + h * QKB * 16, KB + r0 * AW + h * HD * 16, KR + r0 * RDIM, VB + r0 * AW + h * HD * 16, H + r0 * LDH + AW + h * HD, LDH, qb, al);
        }
#endif
    }
#endif
    SEAM(3);

#if !defined(SKIP_P4)
    if (IN(4))
    {
        pg8::Gemm g{H, WA, MTOK, DM, DM, LDH, LDH}; pg8::StaticOrder S; S.init(MTOK, DM, F.G, (int)blockIdx.x);
        pg8::EpiMerge E{Gt, T};
        pg8::gemm_phase<pg8::EpiMerge, pg8::StaticOrder, true, true>(F.lds + RING_OFF, g, S, E);
    }
#endif
    SEAM(4);

#if !defined(SKIP_P5)
    if (IN(5))
    {
        pg8::Gemm g{T, WOUT, MTOK, DM, DM, DM, DM}; pg8::StaticOrder S; S.init(MTOK, DM, F.G, (int)blockIdx.x);
        pg8::EpiSS E{Y, SS2, DM, 1.0f / 2048.0f};
        pg8::gemm_phase<pg8::EpiSS, pg8::StaticOrder, true, true, 1, true>(F.lds + RING_OFF, g, S, E);
    }
#endif
    SEAM(5);

#if !defined(SKIP_P6)
    if (IN(6))
    {
        f32x4 g1[4], g2[4];
#pragma unroll
        for (int j = 0; j < 4; ++j) { g1[j] = ((const GAS f32x4*)g_post_mix)[F.lane + 64 * j]; g2[j] = ((const GAS f32x4*)g_pre_mlp)[F.lane + 64 * j]; }
        for (int m = gw; m < MTOK; m += NGW) {
            const GAS f32x4* sp = (const GAS f32x4*)(SS2 + (size_t)m * 16); const f32x4 a = sp[0], b = sp[1], c = sp[2], d = sp[3];
            const float ssy = (((a.x + a.y) + (a.z + a.w)) + ((b.x + b.y) + (b.z + b.w))) + (((c.x + c.y) + (c.z + c.w)) + ((d.x + d.y) + (d.z + d.w)));
            const float rsy = 1.f / sqrtf(ssy * (1.f / DM) + EPS);
            const GAS f32x4* xr = (const GAS f32x4*)(x + (size_t)m * DM) + F.lane; const GAS unsigned long long* yr = (const GAS unsigned long long*)(Y + (size_t)m * DM) + F.lane;
            GAS unsigned long long* x8 = (GAS unsigned long long*)(X1B + (size_t)m * DM) + F.lane;
            f32x4 v[4]; float s = 0.f;
#pragma unroll
            for (int j = 0; j < 4; ++j) { const unsigned long long yw = yr[64 * j]; const unsigned lo = (unsigned)yw, hi = (unsigned)(yw >> 32);
                const f32x4 yv = (f32x4){__uint_as_float(lo << 16), __uint_as_float(lo & 0xffff0000u), __uint_as_float(hi << 16), __uint_as_float(hi & 0xffff0000u)};
                v[j] = xr[64 * j] + yv * rsy * g1[j]; x8[64 * j] = (unsigned long long)pk2(v[j].x, v[j].y) | ((unsigned long long)pk2(v[j].z, v[j].w) << 32);
                s += (v[j].x * v[j].x + v[j].y * v[j].y) + (v[j].z * v[j].z + v[j].w * v[j].w); }
            const float rstd = 1.f / sqrtf(wave_sum(s) * (1.f / DM) + EPS);
            GAS int* o8 = (GAS int*)((unsigned char*)H + (size_t)m * DM) + F.lane;
#pragma unroll
            for (int j = 0; j < 4; ++j) { const f32x4 y2 = v[j] * rstd * g2[j]; int w = 0; w = __builtin_amdgcn_cvt_pk_fp8_f32(y2.x, y2.y, w, false); w = __builtin_amdgcn_cvt_pk_fp8_f32(y2.z, y2.w, w, true); o8[64 * j] = w; }
        }
    }
#endif
    SEAM(6);

#if !defined(SKIP_P7)
    if (IN(7))
    {
        pg8::Gemm g{H, WUP, MTOK, DFF, DM, DM, DM}; pg8::StaticOrder S; S.init(MTOK, DFF, F.G, (int)blockIdx.x);
        pg8::EpiRelu2F8 E{(unsigned char*)U, 1.0f / 32.0f};
        pg8::gemm_phase<pg8::EpiRelu2F8, pg8::StaticOrder, true, true, 1>(F.lds + RING_OFF, g, S, E);
    }
#endif
    SEAM(7);

#if !defined(SKIP_P8)
    if (IN(8))
    {
        pg8::Gemm g{U, WDN, MTOK, DM, DFF, DFF, DFF}; pg8::StaticOrder S; S.init(MTOK, DM, F.G, (int)blockIdx.x);
        pg8::EpiSS E{H, SS3, LDH, 1.0f / 64.0f};
        pg8::gemm_phase<pg8::EpiSS, pg8::StaticOrder, true, true, 1, true>(F.lds + RING_OFF, g, S, E);
    }
#endif
    SEAM(8);

#if !defined(SKIP_P9)
    if (IN(9))
    {
        f32x4 g1[4];
#pragma unroll
        for (int j = 0; j < 4; ++j) g1[j] = ((const GAS f32x4*)g_post_mlp)[F.lane + 64 * j];
        for (int m = gw; m < MTOK; m += NGW) {
            const GAS f32x4* sp = (const GAS f32x4*)(SS3 + (size_t)m * 16); const f32x4 a = sp[0], b = sp[1], c = sp[2], d = sp[3];
            const float ssy = (((a.x + a.y) + (a.z + a.w)) + ((b.x + b.y) + (b.z + b.w))) + (((c.x + c.y) + (c.z + c.w)) + ((d.x + d.y) + (d.z + d.w)));
            const float rsy = 1.f / sqrtf(ssy * (1.f / DM) + EPS);
            const GAS unsigned long long* yr = (const GAS unsigned long long*)(H + (size_t)m * LDH) + F.lane;
            const GAS unsigned long long* xq = (const GAS unsigned long long*)(X1B + (size_t)m * DM) + F.lane;
            GAS f32x4* o4 = (GAS f32x4*)(out + (size_t)m * DM) + F.lane;
#pragma unroll
            for (int j = 0; j < 4; ++j) { const unsigned long long yw = yr[64 * j]; const unsigned lo = (unsigned)yw, hi = (unsigned)(yw >> 32);
                const f32x4 yv = (f32x4){__uint_as_float(lo << 16), __uint_as_float(lo & 0xffff0000u), __uint_as_float(hi << 16), __uint_as_float(hi & 0xffff0000u)};
                const unsigned long long xw = xq[64 * j]; const unsigned xl = (unsigned)xw, xh = (unsigned)(xw >> 32);
                const f32x4 xv = (f32x4){__uint_as_float(xl << 16), __uint_as_float(xl & 0xffff0000u), __uint_as_float(xh << 16), __uint_as_float(xh & 0xffff0000u)};
                o4[64 * j] = xv + yv * rsy * g1[j]; }
        }
    }
#endif
}

extern "C" void kernel_launch(void* const* d_in, const int* in_sizes, int n_in, void* d_out, int out_size, void* d_ws, size_t ws_size, hipStream_t stream) {
    static int grid = 0;
    if (grid == 0) {
        if (n_in != 17 || in_sizes[0] != MTOK * DM || out_size != MTOK * DM || ws_size < WS_END) { fprintf(stderr, "kernel_launch: unexpected shapes (n_in %d, in0 %d, out %d, ws %zu); nothing launched\n", n_in, n_in > 0 ? in_sizes[0] : -1, out_size, ws_size); grid = -1; return; }
        int dev = 0, cus = 0, per_cu = 0;
        if (hipGetDevice(&dev) != hipSuccess || hipDeviceGetAttribute(&cus, hipDeviceAttributeMultiprocessorCount, dev) != hipSuccess) { fprintf(stderr, "kernel_launch: device query failed\n"); grid = -1; return; }
        if (hipFuncSetAttribute((const void*)block_fwd, hipFuncAttributeMaxDynamicSharedMemorySize, LDS_BYTES) != hipSuccess) { fprintf(stderr, "kernel_launch: hipFuncSetAttribute failed\n"); grid = -1; return; }
        if (hipOccupancyMaxActiveBlocksPerMultiprocessor(&per_cu, (const void*)block_fwd, NWAVES * 64, LDS_BYTES) != hipSuccess || per_cu < 1) { fprintf(stderr, "kernel_launch: occupancy query reports %d workgroups per CU\n", per_cu); }
        (void)hipGetLastError();
        grid = cus;
    }
    if (grid < 0) return;
    if (hipMemsetAsync((char*)d_ws + WS_CTL, 0, CTL_ZERO_BYTES, stream) != hipSuccess) { fprintf(stderr, "kernel_launch: hipMemsetAsync failed\n"); return; }
    Args a{};
    for (int i = 0; i < 17; ++i) a.in[i] = (const float*)d_in[i];
    a.out = (float*)d_out; a.ws = (unsigned char*)d_ws;
    a.ph_lo = 0; a.ph_hi = 10; a.li = 0;
    hipLaunchKernelGGL(block_fwd, dim3(grid), dim3(NWAVES * 64), LDS_BYTES, stream, a);
    const hipError_t le = hipPeekAtLastError();
    if (le != hipSuccess) fprintf(stderr, "kernel_launch: launch failed: %s\n", hipGetErrorName(le));
}
```

```cpp
#include <hip/hip_runtime.h>
#include <hip/hip_bf16.h>
#include <cstdio>
#include <cstdint>
#include <cmath>
constexpr int NB = 32, SEQ = 2048, DM = 1024, MTOK = NB * SEQ;
constexpr int NHEAD = 8, HD = 64, AW = NHEAD * HD;
constexpr int QLORA = 384, KVLORA = 256, RDIM = 32, QKB = 96;
constexpr int DFF = 4096, INW = 4256, INWP = 4352;
constexpr int LDH = DM, LDU = DFF, LDKV = KVLORA;
constexpr float EPS = 1e-6f;
constexpr float LOG2E = 1.4426950408889634f;
constexpr float C2A = 0.125f * LOG2E;
constexpr float C2B = 0.10206207261596575f * LOG2E;
typedef float f32x2g __attribute__((ext_vector_type(2)));
namespace pg8 {
#define PG8_LAS __attribute__((address_space(3)))
typedef unsigned short bf16_t;
typedef short bf16x8 __attribute__((ext_vector_type(8)));
typedef float f32x4 __attribute__((ext_vector_type(4)));
typedef unsigned u32x4 __attribute__((ext_vector_type(4)));
constexpr int BM = 256, BK = 64, HALF = 128, HTB = HALF * BK * 2  , STAGE_BYTES = 8 * HTB, NXCD = 8, WGM = 8;

__host__ __device__ __forceinline__ int lds_byte(int r, int c) { const int st = (r >> 4) * 2 + (c >> 5), rr = r & 15, cc = c & 31, ob = rr * 64 + cc * 2; return st * 1024 + (ob ^ (((ob >> 9) & 1) << 5)); }
__host__ __device__ __forceinline__ void stage_rc(int b, int& R, int& C) { const int st = b / 1024, sb = b % 1024, swz = sb ^ (((sb >> 9) & 1) << 5); R = (st >> 1) * 16 + swz / 64; C = (st & 1) * 32 + (swz % 64) / 2; }
__host__ __device__ __forceinline__ int perm32(int rho) { const int n = rho >> 4, i = rho & 15; return 8 * (i >> 2) + 4 * n + (i & 3); }

struct Unit { int pm, pn; };
struct Gemm { const bf16_t* A; const bf16_t* Bt; int M, N, K, lda, ldb; };

struct StaticOrder {
    int nM, nN, nwg, G, c;
    __host__ __device__ void init(int M, int N, int G_, int c_) { nM = M / BM; nN = N / BM; nwg = nM * nN; G = G_; c = c_; }
    __host__ __device__ bool next(int i, Unit& u) const {
        const long L = (long)i * G + c; if (L >= nwg) return false;
        int wgid = (int)L; { const int q = nwg / NXCD, r = nwg % NXCD, xcd = wgid % NXCD, off = wgid / NXCD; wgid = (xcd < r ? xcd * (q + 1) : r * (q + 1) + (xcd - r) * q) + off; }
        const int nig = WGM * nN, gid = wgid / nig, fm = gid * WGM, gsz = (nM - fm) < WGM ? (nM - fm) : WGM;
        u.pm = fm + ((wgid % nig) % gsz); u.pn = (wgid % nig) / gsz; return true;
    }
    __device__ __forceinline__ void a_ready(const Unit&) const {}
    __device__ __forceinline__ void done(const Unit&) const {}
};

__device__ __forceinline__ unsigned cvt_pk_bf16(float lo, float hi) { unsigned r; asm volatile("v_cvt_pk_bf16_f32 %0, %1, %2" : "=v"(r) : "v"(lo), "v"(hi)); return r; }
__device__ __forceinline__ void ld8(float (&v)[8], const f32x4& a, const f32x4& b) { v[0] = a[0]; v[1] = a[1]; v[2] = a[2]; v[3] = a[3]; v[4] = b[0]; v[5] = b[1]; v[6] = b[2]; v[7] = b[3]; }
typedef float f32x2c_t __attribute__((ext_vector_type(2))); typedef __bf16 bf16x2c_t __attribute__((ext_vector_type(2)));
__device__ __forceinline__ unsigned cvtpk_c(float lo, float hi) { const f32x2c_t v = {lo, hi}; const bf16x2c_t b = __builtin_convertvector(v, bf16x2c_t); return __builtin_bit_cast(unsigned, b); }
__device__ __forceinline__ u32x4 pack8(const float (&v)[8]) { u32x4 w; w.x = cvtpk_c(v[0], v[1]); w.y = cvtpk_c(v[2], v[3]); w.z = cvtpk_c(v[4], v[5]); w.w = cvtpk_c(v[6], v[7]); return w; }
__device__ __forceinline__ void unpack8(const u32x4 w, float (&v)[8]) {
    v[0] = __uint_as_float(w.x << 16); v[1] = __uint_as_float(w.x & 0xffff0000u); v[2] = __uint_as_float(w.y << 16); v[3] = __uint_as_float(w.y & 0xffff0000u);
    v[4] = __uint_as_float(w.z << 16); v[5] = __uint_as_float(w.z & 0xffff0000u); v[6] = __uint_as_float(w.w << 16); v[7] = __uint_as_float(w.w & 0xffff0000u); }
__device__ __forceinline__ void rope4(float (&v)[8], const f32x4 a, const f32x4 b) {
    float x1, x2;
    x1 = v[0]; x2 = v[1]; v[0] = x1 * a[0] - x2 * a[1]; v[1] = x2 * a[0] + x1 * a[1];
    x1 = v[2]; x2 = v[3]; v[2] = x1 * a[2] - x2 * a[3]; v[3] = x2 * a[2] + x1 * a[3];
    x1 = v[4]; x2 = v[5]; v[4] = x1 * b[0] - x2 * b[1]; v[5] = x2 * b[0] + x1 * b[1];
    x1 = v[6]; x2 = v[7]; v[6] = x1 * b[2] - x2 * b[3]; v[7] = x2 * b[2] + x1 * b[3];
}
__device__ __forceinline__ float sumsq8(const float (&v)[8]) { return ((v[0] * v[0] + v[1] * v[1]) + (v[2] * v[2] + v[3] * v[3])) + ((v[4] * v[4] + v[5] * v[5]) + (v[6] * v[6] + v[7] * v[7])); }
__device__ __forceinline__ float red_fq(float s) { s += __shfl_xor(s, 16); s += __shfl_xor(s, 32); return s; }

__device__ __forceinline__ size_t chk_off(int r16, int c32, int ld) { return (size_t)r16 * ld + (size_t)c32 * 16; }
__device__ __forceinline__ size_t gfrag_off(int pm, int t8, int wid, int grp, int lane) { return ((((size_t)(pm * 8 + t8) * 8 + wid) * 16 + grp) * 64 + lane) * 8; }
struct EpiIn {
    static constexpr bool PERM = true, AFTER_DRAIN = false; static constexpr int MIDT = 0;
    bf16_t *QA, *KA, *VA, *CQ, *CKV, *KR, *G; float* SS; const float* ropeA; const float* ropeB; const float* bgate;
    __device__ __forceinline__ void operator()(const f32x4 (&acc)[2][2][4][2], const Unit& u, int wr, int wc, int fr, int fq) const {
        asm volatile("" : "+v"(fr), "+v"(fq));
        const int row0 = u.pm * BM + wr * 64 + fr, pn = u.pn, cl = wc * 32 + 8 * fq;
        if (pn < 4) {
            bf16_t* dst = (pn < 2) ? QA : KA; const float sc = (pn < 2) ? C2A : 1.f; const int cb = (pn & 1) * 256 + wc * 32, l8 = (fq * 16 + fr) * 8;
            if ((wc & 1) == 0) {
                const bool rp = fq < 2;
#pragma unroll
                for (int ai = 0; ai < 2; ++ai)
#pragma unroll
                    for (int m = 0; m < 4; ++m) { const int row = row0 + ai * HALF + m * 16;
                        const f32x4* t = (const f32x4*)(ropeA + (size_t)row * 16 + (rp ? fq * 8 : 0));
                        f32x4 ca = t[0], cc = t[1]; if (!rp) { ca = (f32x4){1.f, 0.f, 1.f, 0.f}; cc = ca; }
#pragma unroll
                        for (int bj = 0; bj < 2; ++bj) { float v[8]; ld8(v, acc[ai][bj][m][0], acc[ai][bj][m][1]); rope4(v, ca, cc);
#pragma unroll
                            for (int j = 0; j < 8; ++j) v[j] *= sc;
                            *(u32x4*)(dst + chk_off(row - fr, cb + bj * HALF, AW) + l8) = pack8(v); } }
            } else {
#pragma unroll
                for (int ai = 0; ai < 2; ++ai)
#pragma unroll
                    for (int m = 0; m < 4; ++m) { const int row = row0 + ai * HALF + m * 16;
#pragma unroll
                        for (int bj = 0; bj < 2; ++bj) { float v[8]; ld8(v, acc[ai][bj][m][0], acc[ai][bj][m][1]);
#pragma unroll
                            for (int j = 0; j < 8; ++j) v[j] *= sc;
                            *(u32x4*)(dst + chk_off(row - fr, cb + bj * HALF, AW) + l8) = pack8(v); } }
            }
        } else if (pn < 6) {
            const int cb = (pn - 4) * 256 + wc * 32, l8 = (fq * 16 + fr) * 8;
#pragma unroll
            for (int ai = 0; ai < 2; ++ai)
#pragma unroll
                for (int m = 0; m < 4; ++m) { const int row = row0 + ai * HALF + m * 16;
#pragma unroll
                    for (int bj = 0; bj < 2; ++bj) { float v[8]; ld8(v, acc[ai][bj][m][0], acc[ai][bj][m][1]); *(u32x4*)(VA + chk_off(row - fr, cb + bj * HALF, AW) + l8) = pack8(v); } }
        } else if (pn == 6 || pn == 8) {
            bf16_t* dst = (pn == 6) ? CQ : CKV; const int ld = (pn == 6) ? QLORA : LDKV, slot = ((pn == 6) ? 0 : 8) + wc;
#pragma unroll
            for (int ai = 0; ai < 2; ++ai)
#pragma unroll
                for (int m = 0; m < 4; ++m) { const int row = row0 + ai * HALF + m * 16; float s = 0.f;
#pragma unroll
                    for (int bj = 0; bj < 2; ++bj) { float v[8]; ld8(v, acc[ai][bj][m][0], acc[ai][bj][m][1]); s += sumsq8(v); *(u32x4*)(dst + chk_off(row - fr, wc * 32 + bj * HALF, ld) + (fq * 16 + fr) * 8) = pack8(v); }
                    s = red_fq(s); if (fq == 0) SS[(size_t)row * 12 + slot] = s; }
        } else if (pn == 7) {
#pragma unroll
            for (int ai = 0; ai < 2; ++ai)
#pragma unroll
                for (int m = 0; m < 4; ++m) { const int row = row0 + ai * HALF + m * 16;
                    { float v[8]; ld8(v, acc[ai][0][m][0], acc[ai][0][m][1]); float s = red_fq(sumsq8(v)); *(u32x4*)(CQ + chk_off(row - fr, 256 + wc * 32, QLORA) + (fq * 16 + fr) * 8) = pack8(v); if (fq == 0) SS[(size_t)row * 12 + 4 + wc] = s; }
                    if (wc == 0) { float v[8]; ld8(v, acc[ai][1][m][0], acc[ai][1][m][1]); const f32x4* t = (const f32x4*)(ropeB + (size_t)row * 32 + fq * 8); rope4(v, t[0], t[1]);
                        *(u32x4*)(KR + chk_off(row - fr, 0, RDIM) + (fq * 16 + fr) * 8) = pack8(v); } }
        }
    }
};
struct EpiGates {
    static constexpr bool PERM = true, AFTER_DRAIN = false; static constexpr int MIDT = 0;
    bf16_t* G; const float* bgate;
    __device__ __forceinline__ void operator()(const f32x4 (&acc)[2][2][4][2], const Unit& u, int wr, int wc, int fr, int fq) const {
        asm volatile("" : "+v"(fr), "+v"(fq));
        const int gc = u.pn * 256 + wc * 32 + 8 * fq;
        f32x4 bv[2][2];
#pragma unroll
        for (int bj = 0; bj < 2; ++bj)
#pragma unroll
            for (int n = 0; n < 2; ++n) bv[bj][n] = *(const f32x4*)(bgate + gc + bj * HALF + 4 * n);
#pragma unroll
        for (int ai = 0; ai < 2; ++ai)
#pragma unroll
            for (int m = 0; m < 4; ++m) {
#pragma unroll
                for (int bj = 0; bj < 2; ++bj) { float v[8]; ld8(v, acc[ai][bj][m][0] * (1.0f / 32.0f) + bv[bj][0], acc[ai][bj][m][1] * (1.0f / 32.0f) + bv[bj][1]);
#pragma unroll
                    for (int j = 0; j < 8; ++j) v[j] = __builtin_amdgcn_rcpf(1.f + __builtin_amdgcn_exp2f(-LOG2E * v[j]));
                    *(u32x4*)(G + gfrag_off(u.pm, u.pn, wr * 4 + wc, ai * 8 + m * 2 + bj, fq * 16 + fr)) = pack8(v); } }
    }
};
struct EpiQ {
    static constexpr bool PERM = true, AFTER_DRAIN = false; static constexpr int MIDT = 0;
    bf16_t* QB; const float* SS; const float* ropeB;
    __device__ __forceinline__ void operator()(const f32x4 (&acc)[2][2][4][2], const Unit& u, int wr, int wc, int fr, int fq) const {
        asm volatile("" : "+v"(fr), "+v"(fq));
        const int row0 = u.pm * BM + wr * 64 + fr, cl = u.pn * BM + wc * 32 + 8 * fq;
        const int c0 = cl, c1 = cl + HALF, h0 = c0 / QKB, h1 = c1 / QKB, p0 = c0 - h0 * QKB, p1 = c1 - h1 * QKB;
        const bool r0 = p0 >= 64, r1 = p1 >= 64; const int roff = r0 ? p0 - 64 : (r1 ? p1 - 64 : 0);
#pragma unroll
        for (int b = 0; b < 2; ++b) {
            f32x4 s0[4], s1[4], ta[4], tb[4];
#pragma unroll
            for (int m = 0; m < 4; ++m) { const int row = row0 + b * HALF + m * 16;
                const f32x4* sp = (const f32x4*)(SS + (size_t)row * 12); s0[m] = sp[0]; s1[m] = sp[1];
                const f32x4* t = (const f32x4*)(ropeB + (size_t)row * 32 + roff); ta[m] = t[0]; tb[m] = t[1]; }
            asm volatile("" ::: "memory");
#pragma unroll
            for (int m = 0; m < 4; ++m) { const int row = row0 + b * HALF + m * 16;
                const float ss = ((s0[m][0] + s0[m][1]) + (s0[m][2] + s0[m][3])) + ((s1[m][0] + s1[m][1]) + (s1[m][2] + s1[m][3]));
                const float rs = __builtin_amdgcn_rsqf(ss * (1.0f / QLORA) + EPS) * C2B;
#pragma unroll
                for (int bj = 0; bj < 2; ++bj) { float v[8]; ld8(v, acc[b][bj][m][0], acc[b][bj][m][1]);
#pragma unroll
                    for (int j = 0; j < 8; ++j) v[j] *= rs;
                    if (bj == 0 ? r0 : r1) rope4(v, ta[m], tb[m]);
                    *(u32x4*)(QB + chk_off(row - fr, (bj == 0 ? c0 : c1) - 8 * fq, NHEAD * QKB) + (fq * 16 + fr) * 8) = pack8(v); } }
        }
    }
};
struct EpiKV {
    static constexpr bool PERM = true, AFTER_DRAIN = false; static constexpr int MIDT = 0;
    bf16_t *KB, *VB; const float* SS;
    __device__ __forceinline__ void operator()(const f32x4 (&acc)[2][2][4][2], const Unit& u, int wr, int wc, int fr, int fq) const {
        asm volatile("" : "+v"(fr), "+v"(fq));
        const int row0 = u.pm * BM + wr * 64 + fr;
        bf16_t* dst = (wc < 2) ? KB : VB; const int pc = (wc & 1) * 32, l8 = (fq * 16 + fr) * 8;
        f32x4 s0[2][4];
#pragma unroll
        for (int ai = 0; ai < 2; ++ai)
#pragma unroll
            for (int m = 0; m < 4; ++m) s0[ai][m] = *(const f32x4*)(SS + (size_t)(row0 + ai * HALF + m * 16) * 12 + 8);
#pragma unroll
        for (int ai = 0; ai < 2; ++ai)
#pragma unroll
            for (int m = 0; m < 4; ++m) { const int row = row0 + ai * HALF + m * 16; const f32x4 sv = s0[ai][m];
                const float rs = __builtin_amdgcn_rsqf(((sv[0] + sv[1]) + (sv[2] + sv[3])) * (1.0f / KVLORA) + EPS);
#pragma unroll
                for (int bj = 0; bj < 2; ++bj) { const int hd = u.pn * 2 + bj;
                    float v[8]; ld8(v, acc[ai][bj][m][0], acc[ai][bj][m][1]);
#pragma unroll
                    for (int j = 0; j < 8; ++j) v[j] *= rs;
                    *(u32x4*)(dst + chk_off(row - fr, hd * HD + pc, AW) + l8) = pack8(v); } }
    }
};
struct EpiMerge {
    static constexpr bool PERM = true, AFTER_DRAIN = false; static constexpr int MIDT = 8;
    const bf16_t* G; bf16_t* T;
    __device__ __forceinline__ void mid(f32x4 (&acc)[2][2][4][2], const Unit& u, int wr, int wc, int fr, int fq) const {
        asm volatile("" : "+v"(fr), "+v"(fq));
        const bf16_t* pa = G + gfrag_off(u.pm, u.pn, wr * 4 + wc, 0, fq * 16 + fr); const bf16_t* pb = G + gfrag_off(u.pm, 4 + u.pn, wr * 4 + wc, 0, fq * 16 + fr);
        u32x4 ca[4], cb[4], na[4], nb[4];
#pragma unroll
        for (int i = 0; i < 4; ++i) { ca[i] = *(const u32x4*)(pa + (size_t)i * 512); cb[i] = *(const u32x4*)(pb + (size_t)i * 512); }
#pragma unroll
        for (int b = 0; b < 4; ++b) {
            if (b < 3) {
#pragma unroll
                for (int i = 0; i < 4; ++i) { na[i] = *(const u32x4*)(pa + (size_t)((b + 1) * 4 + i) * 512); nb[i] = *(const u32x4*)(pb + (size_t)((b + 1) * 4 + i) * 512); } }
            asm volatile("" ::: "memory");
#pragma unroll
            for (int i = 0; i < 4; ++i) { const int grp = b * 4 + i, ai = grp >> 3, m = (grp >> 1) & 3, bj = grp & 1; float ga[8], gb[8]; unpack8(ca[i], ga); unpack8(cb[i], gb);
#pragma unroll
                for (int j = 0; j < 8; ++j) ga[j] *= __builtin_amdgcn_rcpf(__builtin_fmaxf(gb[j], 1e-30f));
                acc[ai][bj][m][0] *= (f32x4){ga[0], ga[1], ga[2], ga[3]}; acc[ai][bj][m][1] *= (f32x4){ga[4], ga[5], ga[6], ga[7]}; }
#pragma unroll
            for (int i = 0; i < 4; ++i) { ca[i] = na[i]; cb[i] = nb[i]; }
        }
    }
    __device__ __forceinline__ void operator()(const f32x4 (&acc)[2][2][4][2], const Unit& u, int wr, int wc, int fr, int fq) const {
        asm volatile("" : "+v"(fr), "+v"(fq));
        unsigned char* base = (unsigned char*)T + ((size_t)(u.pm * 16 + wr * 4) * 16 + u.pn * 4 + wc) * 1024 + (unsigned)(fq * 16 + fr) * 16u;
        const bf16_t* pb = G + gfrag_off(u.pm, 4 + u.pn, wr * 4 + wc, 0, fq * 16 + fr);
        u32x4 cb[8], nb[8];
#pragma unroll
        for (int i = 0; i < 8; ++i) cb[i] = *(const u32x4*)(pb + (size_t)i * 512);
#pragma unroll
        for (int b = 0; b < 2; ++b) {
            if (b < 1) {
#pragma unroll
                for (int i = 0; i < 8; ++i) nb[i] = *(const u32x4*)(pb + (size_t)(8 + i) * 512); }
            asm volatile("" ::: "memory");
#pragma unroll
            for (int i2 = 0; i2 < 4; ++i2) { int w[4];
#pragma unroll
                for (int bj = 0; bj < 2; ++bj) { const int i = 2 * i2 + bj, grp = b * 8 + i, ai = grp >> 3, m = (grp >> 1) & 3; float v[8], gb[8]; ld8(v, acc[ai][bj][m][0], acc[ai][bj][m][1]); unpack8(cb[i], gb);
#pragma unroll
                    for (int j = 0; j < 8; ++j) v[j] = __builtin_fminf(__builtin_fmaxf(v[j] * (64.f * __builtin_fmaxf(gb[j], 1e-30f)), -448.f), 448.f);
                    int w0 = 0, w1 = 0;
                    w0 = __builtin_amdgcn_cvt_pk_fp8_f32(v[0], v[1], w0, false); w0 = __builtin_amdgcn_cvt_pk_fp8_f32(v[2], v[3], w0, true);
                    w1 = __builtin_amdgcn_cvt_pk_fp8_f32(v[4], v[5], w1, false); w1 = __builtin_amdgcn_cvt_pk_fp8_f32(v[6], v[7], w1, true);
                    w[2 * bj] = w0; w[2 * bj + 1] = w1; }
                typedef int i32x4m_ __attribute__((ext_vector_type(4)));
                *(i32x4m_*)(base + (size_t)(b * 8 + i2) * 16384) = (i32x4m_){w[0], w[1], w[2], w[3]}; }
#pragma unroll
            for (int i = 0; i < 8; ++i) cb[i] = nb[i];
        }
    }
};
struct EpiSS {
    static constexpr bool PERM = true, AFTER_DRAIN = false; static constexpr int MIDT = 0;
    bf16_t* Y; float* SSY; int ldy; float scale;
    __device__ __forceinline__ void operator()(const f32x4 (&acc)[2][2][4][2], const Unit& u, int wr, int wc, int fr, int fq) const {
        asm volatile("" : "+v"(fr), "+v"(fq));
        const int row0 = u.pm * BM + wr * 64 + fr, cl = u.pn * BM + wc * 32 + 8 * fq;
#pragma unroll
        for (int ai = 0; ai < 2; ++ai)
#pragma unroll
            for (int m = 0; m < 4; ++m) { const int row = row0 + ai * HALF + m * 16; float s = 0.f;
#pragma unroll
                for (int bj = 0; bj < 2; ++bj) { float v[8]; ld8(v, acc[ai][bj][m][0] * scale, acc[ai][bj][m][1] * scale); s += sumsq8(v); *(u32x4*)(Y + (size_t)row * ldy + cl + bj * HALF) = pack8(v); }
                s = red_fq(s); if (fq == 0) SSY[(size_t)row * 16 + u.pn * 4 + wc] = s; }
    }
};
struct EpiRelu2F8 {
    static constexpr bool PERM = true, AFTER_DRAIN = false; static constexpr int MIDT = 0;
    unsigned char* U; float scale;
    __device__ __forceinline__ void operator()(const f32x4 (&acc)[2][2][4][2], const Unit& u, int wr, int wc, int fr, int fq) const {
        asm volatile("" : "+v"(fr), "+v"(fq));
        unsigned char* base = U + ((size_t)(u.pm * 16 + wr * 4) * 64 + u.pn * 4 + wc) * 1024 + (unsigned)(fq * 16 + fr) * 16u;
#pragma unroll
        for (int ai = 0; ai < 2; ++ai)
#pragma unroll
            for (int m = 0; m < 4; ++m) { int w[4];
#pragma unroll
                for (int bj = 0; bj < 2; ++bj) { float v[8]; ld8(v, acc[ai][bj][m][0], acc[ai][bj][m][1]);
#pragma unroll
                    for (int j = 0; j < 8; ++j) { const float r = __builtin_fmaxf(v[j] * scale, 0.f); v[j] = __builtin_fminf(r * r, 440.f); }
                    int w0 = 0, w1 = 0;
                    w0 = __builtin_amdgcn_cvt_pk_fp8_f32(v[0], v[1], w0, false); w0 = __builtin_amdgcn_cvt_pk_fp8_f32(v[2], v[3], w0, true);
                    w1 = __builtin_amdgcn_cvt_pk_fp8_f32(v[4], v[5], w1, false); w1 = __builtin_amdgcn_cvt_pk_fp8_f32(v[6], v[7], w1, true);
                    w[2 * bj] = w0; w[2 * bj + 1] = w1; }
                typedef int i32x4e_ __attribute__((ext_vector_type(4)));
                *(i32x4e_*)(base + (size_t)(ai * 8 + m) * 65536) = (i32x4e_){w[0], w[1], w[2], w[3]}; }
    }
};
struct EpiRelu2 {
    static constexpr bool PERM = true, AFTER_DRAIN = false; static constexpr int MIDT = 0;
    bf16_t* U;
    __device__ __forceinline__ void operator()(const f32x4 (&acc)[2][2][4][2], const Unit& u, int wr, int wc, int fr, int fq) const {
        asm volatile("" : "+v"(fr), "+v"(fq));
        const int row0 = u.pm * BM + wr * 64 + fr, cl = u.pn * BM + wc * 32 + 8 * fq;
#pragma unroll
        for (int ai = 0; ai < 2; ++ai)
#pragma unroll
            for (int m = 0; m < 4; ++m) { const int row = row0 + ai * HALF + m * 16;
#pragma unroll
                for (int bj = 0; bj < 2; ++bj) { float v[8]; ld8(v, acc[ai][bj][m][0], acc[ai][bj][m][1]);
#pragma unroll
                    for (int j = 0; j < 8; ++j) { const float r = __builtin_fmaxf(v[j], 0.f); v[j] = r * r; }
                    *(u32x4*)(U + (size_t)row * LDU + cl + bj * HALF) = pack8(v); } }
    }
};
template <class Epi, class Sched, bool ALIGN_EPI = false, bool SP2 = false, int ESZ = 2, bool ACH = false>
__device__ __forceinline__ void gemm_phase(PG8_LAS unsigned char* lds, const Gemm g, const Sched& S, const Epi& E) {
    int tid_ = threadIdx.x; asm volatile("" : "+v"(tid_));
    const int tid = tid_, wid = __builtin_amdgcn_readfirstlane(tid >> 6), lane = tid & 63, wr = wid >> 2, wc = wid & 3, fr = lane & 15, fq = lane >> 4;
    const int K = g.K, nt = K * ESZ / (BK * 2), lda = g.lda ? g.lda : K, ldb = g.ldb ? g.ldb : K;
    unsigned voffA[2], voffB[2];
#pragma unroll
    for (int i = 0; i < 2; ++i) { int R, C; stage_rc(tid * 16 + i * 8192, R, C); const int Rb = Epi::PERM ? ((R & ~31) + perm32(R & 31)) : R;
        if constexpr (ACH) { const int st_ = (tid >> 6) + 8 * i; voffA[i] = (unsigned)((st_ >> 1) * 16 * lda * ESZ + (st_ & 1) * 1024 + (tid & 63) * 16); } else voffA[i] = (unsigned)(R * lda * ESZ + C * 2);
        voffB[i] = (unsigned)(Rb * ldb * ESZ + C * 2); }
    const size_t kstepB = (size_t)(BK * 2), kstepA = ACH ? (size_t)2048 : kstepB;
    const size_t hstepA = (size_t)HALF * lda * ESZ, hstepB = (size_t)HALF * ldb * ESZ;
    const size_t tstepA = 2 * hstepA, tstepB = 2 * hstepB;
    const unsigned ldsw = (unsigned)wid * 1024u;
    const int aoff = ACH ? wr * 8192 + lane * 16 : lds_byte(wr * 64 + fr, fq * 8), boff = lds_byte(wc * 32 + fr, fq * 8);
#define PG8_SA(b, h) (((b) * 2 + (h)) * HTB)
#define PG8_SB(b, h) ((4 + (b) * 2 + (h)) * HTB)
#define PG8_STAGE(bufoff, gbase, voff) do { _Pragma("unroll") for (int _i = 0; _i < 2; ++_i) \
        __builtin_amdgcn_global_load_lds((const unsigned*)((const char*)(gbase) + (voff)[_i]), (PG8_LAS unsigned*)(lds + (bufoff) + ldsw + _i * 8192), 16, 0, 0); } while (0)
#define PG8_LDA(dst, b, h) do { if constexpr (ESZ == 2) { _Pragma("unroll") for (int m = 0; m < 4; ++m) _Pragma("unroll") for (int k = 0; k < 2; ++k) dst[m][k] = *(const PG8_LAS bf16x8*)(lds + PG8_SA(b, h) + aoff + m * 2048 + k * 1024); } \
        else { _Pragma("unroll") for (int m = 0; m < 4; ++m) { dst##8[m].lo = *(const PG8_LAS i32x4_*)(lds + PG8_SA(b, h) + aoff + m * 2048); dst##8[m].hi = *(const PG8_LAS i32x4_*)(lds + PG8_SA(b, h) + aoff + m * 2048 + 1024); } } } while (0)
#define PG8_LDB(dst, b, h) do { if constexpr (ESZ == 2) { _Pragma("unroll") for (int n = 0; n < 2; ++n) _Pragma("unroll") for (int k = 0; k < 2; ++k) dst[n][k] = *(const PG8_LAS bf16x8*)(lds + PG8_SB(b, h) + boff + n * 2048 + k * 1024); } \
        else { _Pragma("unroll") for (int n = 0; n < 2; ++n) { dst##8[n].lo = *(const PG8_LAS i32x4_*)(lds + PG8_SB(b, h) + boff + n * 2048); dst##8[n].hi = *(const PG8_LAS i32x4_*)(lds + PG8_SB(b, h) + boff + n * 2048 + 1024); } } } while (0)
#define PG8_MMA(ai, bj, At, Bt) do { __builtin_amdgcn_s_setprio(1); \
        if constexpr (ESZ == 2) { _Pragma("unroll") for (int m = 0; m < 4; ++m) _Pragma("unroll") for (int n = 0; n < 2; ++n) _Pragma("unroll") for (int k = 0; k < 2; ++k) \
            acc[ai][bj][m][n] = __builtin_amdgcn_mfma_f32_16x16x32_bf16(Bt[n][k], At[m][k], acc[ai][bj][m][n], 0, 0, 0); } \
        else {   \
            _Pragma("unroll") for (int m = 0; m < 4; ++m) _Pragma("unroll") for (int n = 0; n < 2; ++n) \
                asm volatile("v_mfma_scale_f32_16x16x128_f8f6f4 %0, %1, %2, %0, %3, %3 op_sel_hi:[0,0,0]" : "+v"(acc[ai][bj][m][n]) : "v"(Bt##8[n]), "v"(At##8[m]), "v"(scl_)); } \
        __builtin_amdgcn_s_setprio(0); } while (0)
#define PG8_WAIT_V(n) asm volatile("s_waitcnt vmcnt(" #n ")" ::: "memory")
#define PG8_WAIT_L(n) asm volatile("s_waitcnt lgkmcnt(" #n ")" ::: "memory")
#define PG8_BAR __builtin_amdgcn_s_barrier()
#define PG8_SCHED __builtin_amdgcn_sched_barrier(0)
    Unit cur, nxt; int ui = 0;
    if (!S.next(0, cur)) return;
    f32x4 acc[2][2][4][2];
#pragma unroll
    for (int a = 0; a < 2; ++a)
#pragma unroll
        for (int b = 0; b < 2; ++b)
#pragma unroll
            for (int m = 0; m < 4; ++m)
#pragma unroll
                for (int n = 0; n < 2; ++n) acc[a][b][m][n] = (f32x4){0.f, 0.f, 0.f, 0.f};
    bf16x8 At[4][2], B0[2][2], B1[2][2];
    typedef int i32x4_ __attribute__((ext_vector_type(4))); typedef int i32x8_ __attribute__((ext_vector_type(8)));
    const int scl_ = 0x7F7F7F7F;
    i32x8_ At8[4], B08[2], B18[2];
    const char* cA = (const char*)g.A + (size_t)cur.pm * tstepA; const char* cB = (const char*)g.Bt + (size_t)cur.pn * tstepB;
    S.a_ready(cur);
    if constexpr (SP2) {
        PG8_STAGE(PG8_SB(0, 0), cB, voffB); PG8_STAGE(PG8_SB(0, 1), cB + hstepB, voffB); PG8_STAGE(PG8_SA(0, 0), cA, voffA); PG8_STAGE(PG8_SA(0, 1), cA + hstepA, voffA);
        if (wr == 1) PG8_BAR;
        PG8_WAIT_V(2); PG8_BAR;
        PG8_STAGE(PG8_SB(1, 0), cB + kstepB, voffB); PG8_STAGE(PG8_SA(1, 0), cA + kstepA, voffA); PG8_STAGE(PG8_SB(1, 1), cB + hstepB + kstepB, voffB);
        PG8_WAIT_V(6); PG8_BAR;
    } else {
        PG8_STAGE(PG8_SB(0, 0), cB, voffB); PG8_STAGE(PG8_SA(0, 0), cA, voffA); PG8_STAGE(PG8_SB(0, 1), cB + hstepB, voffB); PG8_STAGE(PG8_SA(0, 1), cA + hstepA, voffA);
        if (wr == 1) PG8_BAR;
        PG8_WAIT_V(4); PG8_BAR;
        PG8_STAGE(PG8_SB(1, 0), cB + kstepB, voffB); PG8_STAGE(PG8_SA(1, 0), cA + kstepA, voffA); PG8_STAGE(PG8_SB(1, 1), cB + hstepB + kstepB, voffB);
        PG8_WAIT_V(6); PG8_BAR;
    }
    for (;;) {
        const bool has_next = S.next(ui + 1, nxt);
        const char* nA = has_next ? (const char*)g.A + (size_t)nxt.pm * tstepA : cA; const char* nB = has_next ? (const char*)g.Bt + (size_t)nxt.pn * tstepB : cB;
#pragma unroll 1
        for (int t = 0; t < nt; t += 2) {
            if constexpr (Epi::MIDT > 0) { if (t == Epi::MIDT) E.mid(acc, cur, wr, wc, fr, fq); }
            const bool last = (t == nt - 2);
            const char* a1 = cA + (size_t)(t + 1) * kstepA;
            const char* a2 = last ? nA : cA + (size_t)(t + 2) * kstepA; const char* b2 = last ? nB : cB + (size_t)(t + 2) * kstepB;
            const char* a3 = a2 + kstepA; const char* b3 = b2 + kstepB;
            if (last && has_next) S.a_ready(nxt);
            if constexpr (SP2) {
            PG8_LDB(B0, 0, 0); PG8_LDB(B1, 0, 1); PG8_SCHED; PG8_LDA(At, 0, 0); PG8_STAGE(PG8_SA(1, 1), a1 + hstepA, voffA);
            PG8_WAIT_V(8); PG8_WAIT_L(0); PG8_BAR; PG8_MMA(0, 0, At, B0); PG8_MMA(0, 1, At, B1); PG8_BAR; PG8_SCHED;
            PG8_LDA(At, 0, 1); PG8_STAGE(PG8_SB(0, 0), b2, voffB); PG8_STAGE(PG8_SB(0, 1), b2 + hstepB, voffB); PG8_STAGE(PG8_SA(0, 0), a2, voffA);
            PG8_WAIT_V(8); PG8_WAIT_L(0); PG8_BAR; PG8_MMA(1, 0, At, B0); PG8_MMA(1, 1, At, B1); PG8_BAR; PG8_SCHED;
            PG8_LDB(B0, 1, 0); PG8_LDB(B1, 1, 1); PG8_SCHED; PG8_LDA(At, 1, 0); PG8_STAGE(PG8_SA(0, 1), a2 + hstepA, voffA);
            PG8_WAIT_V(8); PG8_WAIT_L(0); PG8_BAR; PG8_MMA(0, 0, At, B0); PG8_MMA(0, 1, At, B1); PG8_BAR; PG8_SCHED;
            PG8_LDA(At, 1, 1); PG8_STAGE(PG8_SB(1, 0), b3, voffB); PG8_STAGE(PG8_SB(1, 1), b3 + hstepB, voffB); PG8_STAGE(PG8_SA(1, 0), a3, voffA);
            PG8_WAIT_V(8); PG8_WAIT_L(0); PG8_BAR; PG8_MMA(1, 0, At, B0); PG8_MMA(1, 1, At, B1); PG8_BAR; PG8_SCHED;
            } else {
            PG8_LDB(B0, 0, 0); PG8_SCHED; PG8_LDA(At, 0, 0); PG8_STAGE(PG8_SA(1, 1), a1 + hstepA, voffA);
            PG8_WAIT_L(8); PG8_BAR; PG8_WAIT_L(0); PG8_MMA(0, 0, At, B0); PG8_BAR; PG8_SCHED;
            PG8_LDB(B1, 0, 1); PG8_STAGE(PG8_SB(0, 0), b2, voffB);
            PG8_BAR; PG8_WAIT_L(0); PG8_MMA(0, 1, At, B1); PG8_BAR;
            PG8_LDA(At, 0, 1); PG8_STAGE(PG8_SA(0, 0), a2, voffA);
            PG8_BAR; PG8_WAIT_L(0); PG8_MMA(1, 0, At, B0); PG8_BAR; PG8_SCHED;
            PG8_STAGE(PG8_SB(0, 1), b2 + hstepB, voffB);
            PG8_WAIT_V(6); PG8_BAR; PG8_MMA(1, 1, At, B1); PG8_BAR;
            PG8_LDB(B0, 1, 0); PG8_SCHED; PG8_LDA(At, 1, 0); PG8_STAGE(PG8_SA(0, 1), a2 + hstepA, voffA);
            PG8_WAIT_L(8); PG8_BAR; PG8_WAIT_L(0); PG8_MMA(0, 0, At, B0); PG8_BAR; PG8_SCHED;
            PG8_LDB(B1, 1, 1); PG8_STAGE(PG8_SB(1, 0), b3, voffB);
            PG8_BAR; PG8_WAIT_L(0); PG8_MMA(0, 1, At, B1); PG8_BAR;
            PG8_LDA(At, 1, 1); PG8_STAGE(PG8_SA(1, 0), a3, voffA);
            PG8_BAR; PG8_WAIT_L(0); PG8_MMA(1, 0, At, B0); PG8_BAR; PG8_SCHED;
            PG8_STAGE(PG8_SB(1, 1), b3 + hstepB, voffB);
            PG8_WAIT_V(6); PG8_BAR; PG8_MMA(1, 1, At, B1); PG8_BAR;
            }
        }
        if constexpr (ALIGN_EPI) { if (wr == 0) PG8_BAR; }
        if constexpr (ESZ == 1) asm volatile("s_nop 15\n\ts_nop 15" ::: "memory");
        if constexpr (!Epi::AFTER_DRAIN) { E(acc, cur, wr, wc, fr, fq); S.done(cur); }
        if (!has_next) break;
#pragma unroll
        for (int a = 0; a < 2; ++a)
#pragma unroll
            for (int b = 0; b < 2; ++b)
#pragma unroll
                for (int m = 0; m < 4; ++m)
#pragma unroll
                    for (int n = 0; n < 2; ++n) acc[a][b][m][n] = (f32x4){0.f, 0.f, 0.f, 0.f};
        cur = nxt; cA = nA; cB = nB; ++ui;
        if constexpr (ALIGN_EPI) { if (wr == 1) PG8_BAR; }
    }
    PG8_WAIT_V(0);
    if constexpr (!ALIGN_EPI) { if (wr == 0) PG8_BAR; }
    PG8_BAR;
    if constexpr (Epi::AFTER_DRAIN) { E.fused(acc, cur, wr, wc, fr, fq, lds, wid, lane); S.done(cur); }
#undef PG8_SA
#undef PG8_SB
#undef PG8_STAGE
#undef PG8_LDA
#undef PG8_LDB
#undef PG8_MMA
#undef PG8_WAIT_V
#undef PG8_WAIT_L
#undef PG8_BAR
#undef PG8_SCHED
}
}
#ifndef ATT_LSUM_MFMA
#define ATT_LSUM_MFMA 1
#endif
namespace att {
typedef unsigned short bf16_t;
typedef short bf16x8 __attribute__((ext_vector_type(8)));
typedef short s16x4 __attribute__((ext_vector_type(4)));
typedef float f32x16 __attribute__((ext_vector_type(16)));
typedef float f32x4 __attribute__((ext_vector_type(4)));
typedef unsigned u32x4 __attribute__((ext_vector_type(4)));
#define ALDS __attribute__((address_space(3)))
#define ASBAR() __builtin_amdgcn_sched_barrier(0)
constexpr int KTB = 12288, VTB = 8192;
constexpr int NSLOT = 3;
constexpr int L_K = 0, L_V = NSLOT * KTB, L_WS = L_V + NSLOT * VTB, L_OST = L_WS + 8 * 256, L_KM = L_OST + 8 * 4096, L_RED = L_KM + 2048, L_END = L_RED + 16384;
constexpr float THR = 8.f;
__device__ __forceinline__ int crow(int r, int hi) { return (r & 3) + 8 * (r >> 2) + 4 * hi; }
typedef float f32x2a_t __attribute__((ext_vector_type(2))); typedef __bf16 bf16x2a_t __attribute__((ext_vector_type(2)));
__device__ __forceinline__ unsigned cvtpk(float lo, float hi) { const f32x2a_t v = {lo, hi}; const bf16x2a_t b = __builtin_convertvector(v, bf16x2a_t); return __builtin_bit_cast(unsigned, b); }
__device__ __forceinline__ float bf2f(short s) { return __uint_as_float(((unsigned)(unsigned short)s) << 16); }
__device__ __forceinline__ int v_st(int k, int c) { const int kk = (k & ~0xC) | ((k & 4) << 1) | ((k & 8) >> 1); return ((kk >> 3) * 2 + (c >> 5)) * 512 + ((kk & 7) * 32 + (c & 31)) * 2; }
__device__ __forceinline__ int v_rd_base(int lane) { return ((lane & 3) << 3) | (((lane >> 2) & 3) << 6) | (((lane >> 4) & 1) << 5) | (((lane >> 5) & 1) << 8); }
constexpr int v_rd_off(int d0, int ks, int half) { return ks * 2048 + half * 1024 + d0 * 512; }
template <int OFF> __device__ __forceinline__ s16x4 tr_read(int vb) { s16x4 r; asm volatile("ds_read_b64_tr_b16 %0, %1 offset:%2" : "=&v"(r) : "v"(vb), "i"(OFF) : "memory"); return r; }
template <int D0> __device__ __forceinline__ void pv_one(f32x16& od, int vb, bf16x8 pa0, bf16x8 pa1, bf16x8 pa2, bf16x8 pa3) {
    const s16x4 l0 = tr_read<v_rd_off(D0, 0, 0)>(vb), h0 = tr_read<v_rd_off(D0, 0, 1)>(vb), l1 = tr_read<v_rd_off(D0, 1, 0)>(vb), h1 = tr_read<v_rd_off(D0, 1, 1)>(vb);
    const s16x4 l2 = tr_read<v_rd_off(D0, 2, 0)>(vb), h2 = tr_read<v_rd_off(D0, 2, 1)>(vb), l3 = tr_read<v_rd_off(D0, 3, 0)>(vb), h3 = tr_read<v_rd_off(D0, 3, 1)>(vb);
    asm volatile("s_waitcnt lgkmcnt(0)" ::: "memory"); ASBAR();
#define ATT_PK(L, H) (bf16x8){L[0], L[1], L[2], L[3], H[0], H[1], H[2], H[3]}
    od = __builtin_amdgcn_mfma_f32_32x32x16_bf16(pa0, ATT_PK(l0, h0), od, 0, 0, 0);
    od = __builtin_amdgcn_mfma_f32_32x32x16_bf16(pa1, ATT_PK(l1, h1), od, 0, 0, 0);
    od = __builtin_amdgcn_mfma_f32_32x32x16_bf16(pa2, ATT_PK(l2, h2), od, 0, 0, 0);
    od = __builtin_amdgcn_mfma_f32_32x32x16_bf16(pa3, ATT_PK(l3, h3), od, 0, 0, 0);
#undef ATT_PK
}
__device__ __forceinline__ void pv_all(f32x16* o, f32x16& ol, int vb, bf16x8 pa0, bf16x8 pa1, bf16x8 pa2, bf16x8 pa3) {
    pv_one<0>(o[0], vb, pa0, pa1, pa2, pa3); pv_one<1>(o[1], vb, pa0, pa1, pa2, pa3);
#if ATT_LSUM_MFMA
    const bf16x8 ones = (bf16x8){0x3F80, 0x3F80, 0x3F80, 0x3F80, 0x3F80, 0x3F80, 0x3F80, 0x3F80};
    ol = __builtin_amdgcn_mfma_f32_32x32x16_bf16(pa0, ones, ol, 0, 0, 0); ol = __builtin_amdgcn_mfma_f32_32x32x16_bf16(pa1, ones, ol, 0, 0, 0);
    ol = __builtin_amdgcn_mfma_f32_32x32x16_bf16(pa2, ones, ol, 0, 0, 0); ol = __builtin_amdgcn_mfma_f32_32x32x16_bf16(pa3, ones, ol, 0, 0, 0);
#endif
}
__device__ __forceinline__ void partialSM(f32x16& p0, f32x16& p1, float& m_ref, f32x16& negm, float& alpha) {
    float pmax = p0[0];
#pragma unroll
    for (int r = 1; r < 16; ++r) pmax = fmaxf(pmax, p0[r]);
#pragma unroll
    for (int r = 0; r < 16; ++r) pmax = fmaxf(pmax, p1[r]);
    { auto rr = __builtin_amdgcn_permlane32_swap(__float_as_uint(pmax), __float_as_uint(pmax), false, false); pmax = fmaxf(__uint_as_float(rr[0]), __uint_as_float(rr[1])); }
    alpha = 1.f;
    if (__builtin_expect(!__all(pmax <= THR), 0)) { const float dl = (pmax > THR) ? pmax : 0.f; m_ref += dl; alpha = __builtin_amdgcn_exp2f(-dl);
#pragma unroll
        for (int r = 0; r < 16; ++r) { p0[r] -= dl; p1[r] -= dl; negm[r] = -m_ref; } }
#pragma unroll
    for (int r = 0; r < 16; ++r) p0[r] = __builtin_amdgcn_exp2f(p0[r]);
}
__device__ __forceinline__ void finishSM(f32x16& p0, f32x16& p1, bf16x8& pa0, bf16x8& pa1, bf16x8& pa2, bf16x8& pa3, float& lsum) {
#pragma unroll
    for (int r = 0; r < 16; ++r) p1[r] = __builtin_amdgcn_exp2f(p1[r]);
#if !ATT_LSUM_MFMA
    { float ps = 0.f;
#pragma unroll
      for (int r = 0; r < 16; ++r) ps += p0[r];
#pragma unroll
      for (int r = 0; r < 16; ++r) ps += p1[r];
      lsum += ps; }
#endif
#define ATT_PK4(P, BASE, OUT) do { unsigned a0 = cvtpk(P[BASE + 0], P[BASE + 1]), a1 = cvtpk(P[BASE + 2], P[BASE + 3]);   \
    unsigned b0 = cvtpk(P[BASE + 4], P[BASE + 5]), b1 = cvtpk(P[BASE + 6], P[BASE + 7]);                              \
    auto r0 = __builtin_amdgcn_permlane32_swap(a0, b0, false, false); auto r1 = __builtin_amdgcn_permlane32_swap(a1, b1, false, false); \
    u32x4 w = {r0[0], r1[0], r0[1], r1[1]}; OUT = __builtin_bit_cast(bf16x8, w); } while (0)
    ATT_PK4(p0, 0, pa0); ATT_PK4(p0, 8, pa1); ATT_PK4(p1, 0, pa2); ATT_PK4(p1, 8, pa3);
#undef ATT_PK4
}
template <int ND> __device__ __forceinline__ void qkt(f32x16& p0, f32x16& p1, ALDS const char* Kb, const int (&ka)[ND], const bf16x8 (&qr)[ND], const f32x16& cinit) {
#pragma unroll
    for (int d0 = 0; d0 < ND; ++d0) {
        const bf16x8 b0 = *(ALDS const bf16x8*)(Kb + ka[d0]);
        const bf16x8 b1 = *(ALDS const bf16x8*)(Kb + ka[d0] + (d0 < 4 ? 4096 : 2048));
        p0 = __builtin_amdgcn_mfma_f32_32x32x16_bf16(b0, qr[d0], d0 == 0 ? cinit : p0, 0, 0, 0);
        p1 = __builtin_amdgcn_mfma_f32_32x32x16_bf16(b1, qr[d0], d0 == 0 ? cinit : p1, 0, 0, 0);
        if (ND > 4 && d0 == 2) asm volatile("" ::: "memory"); }
}
__device__ __forceinline__ void cmask(f32x16& p0, f32x16& p1, int jt, int qrel, int hi) {
    const float NEG = -INFINITY; const int thr = qrel - 64 * jt - 4 * hi;
#pragma unroll
    for (int r = 0; r < 16; ++r) { if ((r & 3) + 8 * (r >> 2) > thr) p0[r] = NEG; if ((r & 3) + 8 * (r >> 2) + 32 > thr) p1[r] = NEG; }
}
__device__ __forceinline__ void kmean_blocks(const bf16_t* Kp, ALDS char* lds) {
    int tid_ = threadIdx.x; asm volatile("" : "+v"(tid_));
    const int tid = tid_, lane = tid & 63, wid = tid >> 6;
    ALDS float* red = (ALDS float*)(lds + L_RED); ALDS float* km = (ALDS float*)(lds + L_KM);
#pragma unroll 1
    for (int n = 0; n < 8; ++n) {
        float a[16];
#pragma unroll
        for (int j = 0; j < 16; ++j) a[j] = 0.f;
#pragma unroll
        for (int i = 0; i < 2; ++i)
#pragma unroll
            for (int cc = 0; cc < 2; ++cc) { const bf16x8 kx = *(const bf16x8*)(Kp + (size_t)(n * 256 + 128 * i + 16 * wid) * AW + cc * 512 + lane * 8);
#pragma unroll
                for (int j = 0; j < 8; ++j) a[cc * 8 + j] += bf2f(kx[j]); }
#pragma unroll
        for (int j = 0; j < 16; ++j) { a[j] += __shfl_xor(a[j], 1); a[j] += __shfl_xor(a[j], 2); a[j] += __shfl_xor(a[j], 4); a[j] += __shfl_xor(a[j], 8); }
        if ((lane & 15) == 0) {
#pragma unroll
            for (int j = 0; j < 16; ++j) red[(n * 8 + wid) * 64 + (j >> 3) * 32 + (lane >> 4) * 8 + (j & 7)] = a[j]; }
    }
    __syncthreads();
    { const int n = tid >> 6, d = tid & 63; float s = 0.f;
#pragma unroll
        for (int w = 0; w < 8; ++w) s += red[(n * 8 + w) * 64 + d];
        km[n * 64 + d] = s * (1.0f / 256.0f); }
    __syncthreads();
}
template <int DQK, bool MOBA>
__device__ __forceinline__ void attn_bh(const bf16_t* Qp, int ldq, const bf16_t* Kp, const bf16_t* KRp, const bf16_t* Vp, bf16_t* Op, int ldo, ALDS char* lds) {
    constexpr int ND = DQK / 16;
    ALDS char* K_lds = lds + L_K; ALDS char* V_lds = lds + L_V;
    bf16x8 sk0, sv0, sr0, sk1, sv1, sr1;
#define ATT_SLOAD(S, k0) do { sk##S = *(const bf16x8*)((const char*)(Kp + (size_t)(k0) * AW) + koff); sv##S = *(const bf16x8*)((const char*)(Vp + (size_t)(k0) * AW) + koff); if (DQK == 96) sr##S = *(const bf16x8*)((const char*)(KRp + (size_t)(k0) * RDIM) + roff); } while (0)
#define ATT_SWRITE(b, S) do { *(ALDS bf16x8*)(K_lds + (b) * KTB + kst) = sk##S; *(ALDS bf16x8*)(V_lds + (b) * VTB + vst) = sv##S; if (DQK == 96) { if (tid < 256) *(ALDS bf16x8*)(K_lds + (b) * KTB + rst) = sr##S; } } while (0)
#define ATT_QLOAD(q_) do { const bf16_t* Qw = Qp + (size_t)((q_) * 256 + wid * 32 + (r32 & 16)) * ldq + (r32 & 15) * 8 + hi * 128; _Pragma("unroll") for (int d0 = 0; d0 < ND; ++d0) qr[d0] = *(const bf16x8*)(Qw + (d0 >> 1) * 512 + (d0 & 1) * 256); } while (0)
    bf16x8 qr[ND];
    {
        const int tid = threadIdx.x, w_ = tid >> 6, l_ = tid & 63;
        const unsigned koff = (unsigned)((w_ >> 1) * 16 * AW + (w_ & 1) * 512 + l_ * 8) * 2u, roff = (unsigned)((w_ & 3) * 16 * RDIM + l_ * 8) * 2u;
        ATT_SLOAD(0, 0); ATT_SLOAD(1, 64); }
#pragma unroll 1
  for (int qb = 0; qb < 8; ++qb) {
    int tid_ = threadIdx.x; asm volatile("" : "+v"(tid_));
    const int tid = tid_, lane = tid & 63, r32 = lane & 31, hi = lane >> 5; const int wid = __builtin_amdgcn_readfirstlane(tid >> 6);
    ALDS float* al_l = (ALDS float*)(lds + L_WS) + wid * 64;
    const int skey = 16 * (wid >> 1) + (lane & 15), sch = 4 * (wid & 1) + (lane >> 4);
    const unsigned koff = (unsigned)((wid >> 1) * 16 * AW + (wid & 1) * 512 + lane * 8) * 2u;
    const int kst = skey * 128 + ((sch ^ ((skey >> 1) & 7)) << 4), vst = v_st(skey, sch * 8);
    const int rkey = 16 * (wid & 3) + (lane & 15), rch = lane >> 4;
    const unsigned roff = (unsigned)((wid & 3) * 16 * RDIM + lane * 8) * 2u;
    const int rst = 8192 + rkey * 64 + ((rch ^ ((rkey >> 2) & 3)) << 4);
    int ka[ND];
#pragma unroll
    for (int d0 = 0; d0 < ND; ++d0) ka[d0] = (d0 < 4) ? r32 * 128 + (((2 * d0 + hi) ^ ((r32 >> 1) & 7)) << 4) : 8192 + r32 * 64 + (((2 * (d0 - 4) + hi) ^ ((r32 >> 2) & 3)) << 4);
    const int vb0 = (int)(unsigned)(uintptr_t)V_lds + v_rd_base(lane);
    const int qrel = wid * 32 + r32;
    ATT_QLOAD(qb);
    float m_ref = 0.f, lsum = 0.f; f32x16 o[2], ol, negm; o[0] = f32x16{}; o[1] = f32x16{}; ol = f32x16{}; negm = f32x16{};
    unsigned sel = 0xffu;
    if (MOBA && qb > 3) {
        ALDS const float* km = (ALDS const float*)(lds + L_KM); float g[8];
#pragma unroll
        for (int n = 0; n < 8; ++n) { float s = 0.f;
#pragma unroll
            for (int d0 = 0; d0 < ND; ++d0)
#pragma unroll
                for (int j = 0; j < 8; ++j) s += bf2f(qr[d0][j]) * km[n * 64 + d0 * 16 + hi * 8 + j];
            g[n] = s; }
#pragma unroll
        for (int n = 0; n < 8; ++n) g[n] += __shfl_xor(g[n], 32);
        sel = 0u;
#pragma unroll
        for (int n = 0; n < 8; ++n) { int rank = 0;
#pragma unroll
            for (int mm = 0; mm < 8; ++mm) if (mm != n) rank += (mm < qb && (g[mm] > g[n] || (g[mm] == g[n] && mm < n))) ? 1 : 0;
            if (n < qb && rank < 3) sel |= 1u << n; }
    }
#define ATT_RESC(a) do { if (__any((a) < 1.f)) { lsum *= (a); if (hi == 0) al_l[r32] = (a); asm volatile("s_waitcnt lgkmcnt(0)" ::: "memory"); \
    _Pragma("unroll") for (int r = 0; r < 16; ++r) { const float f_ = al_l[crow(r, hi)]; o[0][r] *= f_; o[1][r] *= f_; ol[r] *= f_; } } } while (0)
    f32x16 pA0, pA1, pB0, pB1; float alA, alB; bf16x8 pa0, pa1, pa2, pa3; const int NT = 4 * (qb + 1), NP = 4 * qb;
    f32x16 cm = negm; const bool gated = MOBA && qb > 3;
#define ATT_CM(t) do { if (gated) { if ((t) < NP) { const float v_ = ((sel >> ((t) >> 2)) & 1u) ? -m_ref : -INFINITY; _Pragma("unroll") for (int r = 0; r < 16; ++r) cm[r] = v_; } else cm = negm; } else cm = negm; } while (0)
#define ATT_SCORE(P0, P1, t) do { ATT_CM(t); qkt<ND>(P0, P1, K_lds + sc * KTB, ka, qr, cm); if ((t) >= NP) cmask(P0, P1, (t) - NP, qrel, hi); } while (0)
    int sp = 0, sc = 0, sn = 1;
#define ATT_ROT() do { sp = sc; sc = sn; sn = (sn == NSLOT - 1) ? 0 : sn + 1; } while (0)
    ATT_SWRITE(0, 0); ATT_SLOAD(0, 128);
    __syncthreads(); ATT_SWRITE(sn, 1); ATT_SLOAD(1, 192);
    ATT_SCORE(pA0, pA1, 0); partialSM(pA0, pA1, m_ref, negm, alA);
    ATT_ROT();
    for (int t = 1; t + 1 < NT; t += 2) {
        __syncthreads(); ATT_SWRITE(sn, 0); if (t + 3 < NT) ATT_SLOAD(0, (t + 3) * 64);
        ASBAR(); ATT_SCORE(pB0, pB1, t);
        finishSM(pA0, pA1, pa0, pa1, pa2, pa3, lsum); ASBAR();
        pv_all(o, ol, vb0 + sp * VTB, pa0, pa1, pa2, pa3); partialSM(pB0, pB1, m_ref, negm, alB);
        ATT_RESC(alB); ATT_ROT();
        __syncthreads(); ATT_SWRITE(sn, 1); if (t + 4 < NT) ATT_SLOAD(1, (t + 4) * 64);
        ASBAR(); ATT_SCORE(pA0, pA1, t + 1);
        finishSM(pB0, pB1, pa0, pa1, pa2, pa3, lsum); ASBAR();
        pv_all(o, ol, vb0 + sp * VTB, pa0, pa1, pa2, pa3); partialSM(pA0, pA1, m_ref, negm, alA);
        ATT_RESC(alA); ATT_ROT();
    }
    __syncthreads();
    ASBAR(); ATT_SCORE(pB0, pB1, NT - 1);
    if (qb < 7) { ATT_SLOAD(0, 0); ATT_SLOAD(1, 64); }
    finishSM(pA0, pA1, pa0, pa1, pa2, pa3, lsum); ASBAR();
    pv_all(o, ol, vb0 + sp * VTB, pa0, pa1, pa2, pa3); partialSM(pB0, pB1, m_ref, negm, alB);
    ATT_RESC(alB);
    finishSM(pB0, pB1, pa0, pa1, pa2, pa3, lsum); ASBAR();
    pv_all(o, ol, vb0 + sc * VTB, pa0, pa1, pa2, pa3);
#undef ATT_ROT
#undef ATT_SCORE
#undef ATT_CM
    float rli[16];
#if ATT_LSUM_MFMA
#pragma unroll
    for (int r = 0; r < 16; ++r) rli[r] = __builtin_amdgcn_rcpf(ol[r]);
#else
    { auto rr = __builtin_amdgcn_permlane32_swap(__float_as_uint(lsum), __float_as_uint(lsum), false, false); lsum = __uint_as_float(rr[0]) + __uint_as_float(rr[1]); }
    if (hi == 0) al_l[32 + r32] = lsum; asm volatile("s_waitcnt lgkmcnt(0)" ::: "memory");
#pragma unroll
    for (int r = 0; r < 16; ++r) rli[r] = __builtin_amdgcn_rcpf(al_l[32 + crow(r, hi)]);
#endif
    { ALDS unsigned short* stg = (ALDS unsigned short*)(lds + L_OST) + wid * 2048;
#pragma unroll
      for (int r = 0; r < 16; ++r) { const int orow = crow(r, hi);
#pragma unroll
          for (int d0 = 0; d0 < 2; ++d0) stg[orow * 64 + d0 * 32 + r32] = (unsigned short)(cvtpk(o[d0][r] * rli[r], 0.f) & 0xffffu); }
      asm volatile("s_waitcnt lgkmcnt(0)" ::: "memory");
      bf16_t* Ow = Op + (size_t)(qb * 256 + wid * 32) * ldo;
#pragma unroll
      for (int i = 0; i < 4; ++i) { const int row = i * 8 + (lane >> 3), ch = lane & 7; const u32x4 v = *(ALDS const u32x4*)(stg + row * 64 + ch * 8); *(u32x4*)(Ow + (size_t)row * ldo + ch * 8) = v; } }
    __syncthreads();
  }
#undef ATT_SLOAD
#undef ATT_SWRITE
#undef ATT_QLOAD
#undef ATT_RESC
}

constexpr int MSLOT = 8192, M_K = 0, M_V = 3 * MSLOT, M_WS = 6 * MSLOT, M_OST = M_WS + 8 * 256, M_END = M_OST + 8 * 4096;
static_assert(M_END <= L_KM, "MoBA LDS map");
#define MPIN(x) asm volatile("" : "+v"(x))
#define MMFMA(a, b, c) __builtin_amdgcn_mfma_f32_32x32x16_bf16(a, b, c, 0, 0, 0)
#define MWAIT_BAR(N) asm volatile("s_waitcnt vmcnt(" #N ") lgkmcnt(0)\n\ts_barrier" ::: "memory")
__device__ __forceinline__ void m_kload2(bf16x8* kf, ALDS const char* kp, int d0) { kf[2 * d0] = *(ALDS const bf16x8*)(kp + d0 * 2048); kf[2 * d0 + 1] = *(ALDS const bf16x8*)(kp + d0 * 2048 + 512); }
__device__ __forceinline__ void m_glds16(const void* g, unsigned lds_base) {
    unsigned sv; asm volatile("s_mov_b32 %0, m0\n\ts_mov_b32 m0, %2\n\ts_nop 0\n\tglobal_load_lds_dwordx4 %1, off\n\ts_mov_b32 m0, %0" : "=&s"(sv) : "v"(g), "s"(lds_base) : "memory"); }
typedef ALDS s16x4 lds_s16x4_t;
__device__ __forceinline__ s16x4 m_vtr(ALDS const char* p) { return __builtin_amdgcn_ds_read_tr16_b64_v4i16((lds_s16x4_t*)p); }
#define MMX3(a, b, c) __builtin_fmaxf(__builtin_fmaxf((a), (b)), (c))
__device__ __forceinline__ float m_rowmax(const f32x16& p0, const f32x16& p1) {
    float a = MMX3(p0[0], p0[1], p1[0]), b = MMX3(p0[2], p0[3], p1[1]); a = MMX3(a, p1[2], p1[3]);
#pragma unroll
    for (int r = 4; r < 16; r += 4) { a = MMX3(a, p0[r], p0[r + 1]); b = MMX3(b, p0[r + 2], p0[r + 3]); a = MMX3(a, p1[r], p1[r + 1]); b = MMX3(b, p1[r + 2], p1[r + 3]); }
    float m = __builtin_fmaxf(a, b); auto rr = __builtin_amdgcn_permlane32_swap(__float_as_uint(m), __float_as_uint(m), false, false);
    return __builtin_fmaxf(__uint_as_float(rr[0]), __uint_as_float(rr[1])); }
__device__ __forceinline__ void moba_unit(const bf16_t* Qp, const bf16_t* Kp, const bf16_t* Vp, bf16_t* Op, int ldo, int qb, ALDS char* lds) {
    int tid_ = threadIdx.x; asm volatile("" : "+v"(tid_));
    const int tid = tid_, lane = tid & 63, r32 = lane & 31, hi = lane >> 5; const int wid = __builtin_amdgcn_readfirstlane(tid >> 6);
    const int NT = 4 * qb + 4, NP = 4 * qb;
    ALDS float* wsf = (ALDS float*)(lds + M_WS) + wid * 64;
    const bf16_t* ksrc = Kp + (size_t)(lane >> 4) * 16 * AW + (wid >> 2) * 512 + (wid & 3) * 128 + (lane & 15) * 8;
    const bf16_t* vsrc = Vp + (size_t)(wid & 3) * 16 * AW + (wid >> 2) * 512 + (lane & 3) * 128 + (lane >> 2) * 8;
    const unsigned lds0 = (unsigned)(uintptr_t)lds, kdst = lds0 + M_K + wid * 1024, vdst = lds0 + M_V + wid * 1024;
#define MDMA_K(t, slot) m_glds16(ksrc + (size_t)(t) * 64 * AW, (unsigned)__builtin_amdgcn_readfirstlane(kdst + (slot)))
#define MDMA_V(t, slot) m_glds16(vsrc + (size_t)(t) * 64 * AW, (unsigned)__builtin_amdgcn_readfirstlane(vdst + (slot)))
    ALDS const char* vp0 = lds + M_V + ((lane >> 4) & 1) * 32 + (lane & 3) * 8 + (4 * hi + ((lane & 15) >> 2)) * 64;
    ALDS const char* kp0 = lds + M_K + hi * 1024 + r32 * 16;
    MDMA_K(0, 0); MDMA_V(0, 0); MDMA_K(1, MSLOT);
    bf16x8 qr[4];
    { const bf16_t* Qw = Qp + (size_t)(qb * 256 + wid * 32 + (r32 & 16)) * AW + (r32 & 15) * 8 + hi * 128;
#pragma unroll
      for (int d0 = 0; d0 < 4; ++d0) qr[d0] = *(const bf16x8*)(Qw + (d0 >> 1) * 512 + (d0 & 1) * 256); }
    MDMA_K(2, 2 * MSLOT);
    float mhat = 0.f, l_reg = 0.f; f32x16 o[2]; o[0] = f32x16{}; o[1] = f32x16{};
    const int qrel = wid * 32 + r32; bool resc = false, moved = false;
    unsigned sel = 0xffu; const bool gated = qb > 3;
    if (gated) {
        ALDS const float* km = (ALDS const float*)(lds + L_KM); float g[8];
#pragma unroll
        for (int n = 0; n < 8; ++n) { float sg = 0.f;
#pragma unroll
            for (int d0 = 0; d0 < 4; ++d0)
#pragma unroll
                for (int j = 0; j < 8; ++j) sg += bf2f(qr[d0][j]) * km[n * 64 + d0 * 16 + hi * 8 + j];
            g[n] = sg; }
#pragma unroll
        for (int n = 0; n < 8; ++n) g[n] += __shfl_xor(g[n], 32);
        sel = 0u;
#pragma unroll
        for (int n = 0; n < 8; ++n) { int rank = 0;
#pragma unroll
            for (int mm = 0; mm < 8; ++mm) if (mm != n) rank += (mm < qb && (g[mm] > g[n] || (g[mm] == g[n] && mm < n))) ? 1 : 0;
            if (n < qb && rank < 3) sel |= 1u << n; }
    }
    f32x16 cm;
#define MCM(t) do { const float v_ = (gated && (t) < NP && !((sel >> ((t) >> 2)) & 1u)) ? -INFINITY : -mhat; _Pragma("unroll") for (int r = 0; r < 16; ++r) cm[r] = v_; MPIN(cm); } while (0)
    MCM(0);
    f32x16 pA0, pA1, pB0, pB1; bf16x8 kf[8]; s16x4 vlo[8], vhi[8]; u32x4 pw0, pw1, pw2, pw3;
    int sl_prev = 0, sl_cur = 0, sl_next = MSLOT;
#define MROT() do { sl_prev = sl_cur; sl_cur = sl_next; sl_next = (sl_next == 2 * MSLOT) ? 0 : sl_next + MSLOT; } while (0)
#define MEX(v) __builtin_amdgcn_exp2f(v)
#define MRESC(tn) do { if (moved) { moved = false; MCM(tn); } if (resc) { _Pragma("unroll") for (int d_ = 0; d_ < 2; ++d_) _Pragma("unroll") for (int r = 0; r < 16; ++r) o[d_][r] *= wsf[crow(r, hi)]; } } while (0)
#define MDECIDE(C0, C1) do { const float rm = m_rowmax(C0, C1); resc = false; \
      if (__builtin_expect(__any(rm > THR), 0)) { const float dl = __builtin_fmaxf(rm, 0.f); mhat += dl; const float f = __builtin_amdgcn_exp2f(-dl); l_reg *= f; if (hi == 0) wsf[r32] = f; resc = true; \
          _Pragma("unroll") for (int r = 0; r < 16; ++r) { C0[r] -= dl; C1[r] -= dl; } moved = true; } } while (0)
    MWAIT_BAR(3);
#pragma unroll
    for (int d0 = 0; d0 < 4; ++d0) m_kload2(kf, kp0, d0);
    pA0 = MMFMA(kf[0], qr[0], cm); pA1 = MMFMA(kf[1], qr[0], cm); pA0 = MMFMA(kf[2], qr[1], pA0); pA1 = MMFMA(kf[3], qr[1], pA1);
    pA0 = MMFMA(kf[4], qr[2], pA0); pA1 = MMFMA(kf[5], qr[2], pA1); pA0 = MMFMA(kf[6], qr[3], pA0); pA1 = MMFMA(kf[7], qr[3], pA1);
    if (NT == 4) cmask(pA0, pA1, 0, qrel, hi);
    MDECIDE(pA0, pA1);
    if (moved) { moved = false; MCM(1); }
#pragma unroll
    for (int r = 0; r < 16; ++r) { pA0[r] = MEX(pA0[r]); pA1[r] = MEX(pA1[r]); }
    MWAIT_BAR(0);
    MDMA_K(3, 0); MDMA_V(1, MSLOT); MROT();
#pragma unroll
    for (int d0 = 0; d0 < 4; ++d0) m_kload2(kf, kp0 + sl_cur, d0);
    MWAIT_BAR(2);
#define MPKW(P, i) cvtpk(P[i], P[i + 1])
#define MPAF(k) __builtin_bit_cast(bf16x8, pw##k)
#define MVFR(i) (bf16x8){vlo[i][0], vlo[i][1], vlo[i][2], vlo[i][3], vhi[i][0], vhi[i][1], vhi[i][2], vhi[i][3]}
#define MVRD(i) do { vlo[i] = m_vtr(vp_ + (((i) >> 2) * 4096 + ((i) & 3) * 1024)); vhi[i] = m_vtr(vp_ + (((i) >> 2) * 4096 + ((i) & 3) * 1024 + 512)); } while (0)
#define MKRD(G, d0) do { if (G) { m_kload2(kf, kp0 + sl_next, d0); ASBAR(); } } while (0)
#define MGAPA(MF, a0, a1, a2, a3, W0, W1, PW) do { MF; sacc += a0; sacc += a1; sacc += a2; sacc += a3; W0; W1; MPIN(PW); MPIN(sacc); ASBAR(); } while (0)
#define MGAPB(MF, X, i) do { MF; X[i] = MEX(X[i]); X[i + 1] = MEX(X[i + 1]); X[i + 2] = MEX(X[i + 2]); X[i + 3] = MEX(X[i + 3]); MPIN(X); ASBAR(); } while (0)
#define MSTEP(C0, C1, P0, P1, t, MASK, GK, GV, GL) do { ASBAR(); \
    const ALDS char* vp_ = vp0 + sl_prev; if (gated && ((t) & 3) == 0) MCM(t); \
    MVRD(0); ASBAR(); float sacc = P0[0] + P0[1]; \
                     MGAPA(C0 = MMFMA(kf[0], qr[0], cm), P0[2], P0[3], P0[4], P0[5],     pw0[0] = MPKW(P0, 0),  pw0[1] = MPKW(P0, 2),  pw0); \
    MVRD(4); ASBAR(); MGAPA(C1 = MMFMA(kf[1], qr[0], cm), P0[6], P0[7], P0[8], P0[9],     pw0[2] = MPKW(P0, 4),  pw0[3] = MPKW(P0, 6),  pw0); \
    MVRD(1); ASBAR(); MGAPA(C0 = MMFMA(kf[2], qr[1], C0), P0[10], P0[11], P0[12], P0[13], pw1[0] = MPKW(P0, 8),  pw1[1] = MPKW(P0, 10), pw1); \
    MVRD(5); ASBAR(); MGAPA(C1 = MMFMA(kf[3], qr[1], C1), P0[14], P0[15], P1[0], P1[1],   pw1[2] = MPKW(P0, 12), pw1[3] = MPKW(P0, 14), pw1); \
    MVRD(2); ASBAR(); MGAPA(C0 = MMFMA(kf[4], qr[2], C0), P1[2], P1[3], P1[4], P1[5],     pw2[0] = MPKW(P1, 0),  pw2[1] = MPKW(P1, 2),  pw2); \
    MVRD(6); ASBAR(); MGAPA(C1 = MMFMA(kf[5], qr[2], C1), P1[6], P1[7], P1[8], P1[9],     pw2[2] = MPKW(P1, 4),  pw2[3] = MPKW(P1, 6),  pw2); \
    MVRD(3); ASBAR(); MGAPA(C0 = MMFMA(kf[6], qr[3], C0), P1[10], P1[11], P1[12], P1[13], pw3[0] = MPKW(P1, 8),  pw3[1] = MPKW(P1, 10), pw3); \
    MVRD(7); ASBAR(); MGAPA(C1 = MMFMA(kf[7], qr[3], C1), P1[14], P1[15], 0.f, 0.f,       pw3[2] = MPKW(P1, 12), pw3[3] = MPKW(P1, 14), pw3); \
    l_reg += sacc; \
    if (GK) MDMA_K((t) + 3, sl_cur); if (GV) MDMA_V((t) + 1, sl_next); \
    if (MASK) cmask(C0, C1, (t) - NP, qrel, hi); \
    MDECIDE(C0, C1); ASBAR(); \
    MGAPB(o[0] = MMFMA(MPAF(0), MVFR(0), o[0]), C0, 0);               MGAPB(o[1] = MMFMA(MPAF(0), MVFR(4), o[1]), C0, 4); \
    MKRD(GL, 0); MGAPB(o[0] = MMFMA(MPAF(1), MVFR(1), o[0]), C0, 8);  MKRD(GL, 1); MGAPB(o[1] = MMFMA(MPAF(1), MVFR(5), o[1]), C0, 12); \
    MKRD(GL, 2); MGAPB(o[0] = MMFMA(MPAF(2), MVFR(2), o[0]), C1, 0);  MKRD(GL, 3); MGAPB(o[1] = MMFMA(MPAF(2), MVFR(6), o[1]), C1, 4); \
    MGAPB(o[0] = MMFMA(MPAF(3), MVFR(3), o[0]), C1, 8);               MGAPB(o[1] = MMFMA(MPAF(3), MVFR(7), o[1]), C1, 12); \
    } while (0)
    int t = 1;
    for (; t + 5 < NT; t += 2) {
        MSTEP(pB0, pB1, pA0, pA1, t, false, true, true, true);     MWAIT_BAR(2); MRESC(t + 1); MROT();
        MSTEP(pA0, pA1, pB0, pB1, t + 1, false, true, true, true); MWAIT_BAR(2); MRESC(t + 2); MROT();
    }
#define MENDW(tt) do { if ((tt) + 3 < NT) { MWAIT_BAR(2); } else if ((tt) + 2 < NT) { MWAIT_BAR(1); } else { MWAIT_BAR(0); } } while (0)
    for (; t + 1 < NT; t += 2) {
        MSTEP(pB0, pB1, pA0, pA1, t, true, (t + 3 < NT), (t + 1 < NT), (t + 1 < NT));         MENDW(t);     MRESC(t + 1); MROT();
        MSTEP(pA0, pA1, pB0, pB1, t + 1, true, (t + 4 < NT), (t + 2 < NT), (t + 2 < NT));     MENDW(t + 1); MRESC(t + 2); MROT();
    }
    MSTEP(pB0, pB1, pA0, pA1, NT - 1, true, false, false, false); MRESC(NT - 1);
    { float sacc = pB0[0] + pB0[1];
#pragma unroll
      for (int r = 2; r < 16; ++r) sacc += pB0[r];
#pragma unroll
      for (int r = 0; r < 16; ++r) sacc += pB1[r];
      l_reg += sacc;
      pw0 = (u32x4){MPKW(pB0, 0), MPKW(pB0, 2), MPKW(pB0, 4), MPKW(pB0, 6)}; pw1 = (u32x4){MPKW(pB0, 8), MPKW(pB0, 10), MPKW(pB0, 12), MPKW(pB0, 14)};
      pw2 = (u32x4){MPKW(pB1, 0), MPKW(pB1, 2), MPKW(pB1, 4), MPKW(pB1, 6)}; pw3 = (u32x4){MPKW(pB1, 8), MPKW(pB1, 10), MPKW(pB1, 12), MPKW(pB1, 14)};
      const ALDS char* vp_ = vp0 + sl_cur;
#pragma unroll
      for (int i = 0; i < 8; ++i) MVRD(i);
      o[0] = MMFMA(MPAF(0), MVFR(0), o[0]); o[1] = MMFMA(MPAF(0), MVFR(4), o[1]); o[0] = MMFMA(MPAF(1), MVFR(1), o[0]); o[1] = MMFMA(MPAF(1), MVFR(5), o[1]);
      o[0] = MMFMA(MPAF(2), MVFR(2), o[0]); o[1] = MMFMA(MPAF(2), MVFR(6), o[1]); o[0] = MMFMA(MPAF(3), MVFR(3), o[0]); o[1] = MMFMA(MPAF(3), MVFR(7), o[1]); }
    { auto rr = __builtin_amdgcn_permlane32_swap(__float_as_uint(l_reg), __float_as_uint(l_reg), false, false); l_reg = __uint_as_float(rr[0]) + __uint_as_float(rr[1]); }
    if (hi == 0) wsf[32 + r32] = l_reg; asm volatile("s_waitcnt lgkmcnt(0)" ::: "memory");
    float rli[16];
#pragma unroll
    for (int r = 0; r < 16; ++r) rli[r] = __builtin_amdgcn_rcpf(wsf[32 + crow(r, hi)]);
    { ALDS unsigned short* stg = (ALDS unsigned short*)(lds + M_OST) + wid * 2048;
#pragma unroll
      for (int r = 0; r < 16; ++r) { const int orow = crow(r, hi);
#pragma unroll
          for (int d0 = 0; d0 < 2; ++d0) stg[orow * 64 + d0 * 32 + r32] = (unsigned short)(cvtpk(o[d0][r] * rli[r], 0.f) & 0xffffu); }
      asm volatile("s_waitcnt lgkmcnt(0)" ::: "memory");
      bf16_t* Ow = Op + (size_t)(qb * 256 + wid * 32) * ldo;
#pragma unroll
      for (int i = 0; i < 4; ++i) { const int row = i * 8 + (lane >> 3), ch = lane & 7; const u32x4 v = *(ALDS const u32x4*)(stg + row * 64 + ch * 8); *(u32x4*)(Ow + (size_t)row * ldo + ch * 8) = v; } }
    asm volatile("s_waitcnt lgkmcnt(0)\n\ts_barrier" ::: "memory");
#undef MDMA_K
#undef MDMA_V
#undef MCM
#undef MROT
#undef MEX
#undef MRESC
#undef MDECIDE
#undef MPKW
#undef MPAF
#undef MVFR
#undef MVRD
#undef MKRD
#undef MGAPA
#undef MGAPB
#undef MSTEP
#undef MENDW
}
__device__ __forceinline__ void mla_unit(const bf16_t* Qp, const bf16_t* Kp, const bf16_t* KRp, const bf16_t* Vp, bf16_t* Op, int ldo, int qb, ALDS char* lds) {
    constexpr int KSL = 12288, N_K = 0, N_V = 3 * KSL, N_WS = N_V + 3 * MSLOT, N_OST = N_WS + 8 * 256;
    int tid_ = threadIdx.x; asm volatile("" : "+v"(tid_));
    const int tid = tid_, lane = tid & 63, r32 = lane & 31, hi = lane >> 5; const int wid = __builtin_amdgcn_readfirstlane(tid >> 6);
    const int NT = 4 * qb + 4, NP = 4 * qb;
    ALDS float* wsf = (ALDS float*)(lds + N_WS) + wid * 64;
    const bf16_t* ksrc = Kp + (size_t)(lane >> 4) * 16 * AW + (wid >> 2) * 512 + (wid & 3) * 128 + (lane & 15) * 8;
    const bf16_t* vsrc = Vp + (size_t)(wid & 3) * 16 * AW + (wid >> 2) * 512 + (lane & 3) * 128 + (lane >> 2) * 8;
    const bf16_t* rsrc = KRp + (size_t)(lane >> 4) * 16 * RDIM + (wid & 3) * 128 + (lane & 15) * 8;
    const unsigned lds0 = (unsigned)(uintptr_t)lds, kdst = lds0 + N_K + wid * 1024, vdst = lds0 + N_V + wid * 1024, rdst = lds0 + N_K + (8 + (wid & 3)) * 1024;
#define MDMA_K(t, slot) do { m_glds16(ksrc + (size_t)(t) * 64 * AW, (unsigned)__builtin_amdgcn_readfirstlane(kdst + (slot) * KSL)); m_glds16(rsrc + (size_t)(t) * 64 * RDIM, (unsigned)__builtin_amdgcn_readfirstlane(rdst + (slot) * KSL)); } while (0)
#define MDMA_V(t, slot) m_glds16(vsrc + (size_t)(t) * 64 * AW, (unsigned)__builtin_amdgcn_readfirstlane(vdst + (slot) * MSLOT))
    ALDS const char* vp0 = lds + N_V + ((lane >> 4) & 1) * 32 + (lane & 3) * 8 + (4 * hi + ((lane & 15) >> 2)) * 64;
    ALDS const char* kp0 = lds + N_K + hi * 1024 + r32 * 16;
    MDMA_K(0, 0); MDMA_V(0, 0); MDMA_K(1, 1);
    bf16x8 qr[6];
    { const bf16_t* Qw = Qp + (size_t)(qb * 256 + wid * 32 + (r32 & 16)) * (NHEAD * QKB) + (r32 & 15) * 8 + hi * 128;
#pragma unroll
      for (int d0 = 0; d0 < 6; ++d0) qr[d0] = *(const bf16x8*)(Qw + (d0 >> 1) * 512 + (d0 & 1) * 256); }
    MDMA_K(2, 2);
    float mhat = 0.f, l_reg = 0.f; f32x16 o[2]; o[0] = f32x16{}; o[1] = f32x16{};
    const int qrel = wid * 32 + r32; bool resc = false, moved = false;
    constexpr bool gated = false; constexpr unsigned sel = 0xffu;
#define MCM(t) do { } while (0)
#define MREL(C0, C1) do { if (__builtin_expect(__any(mhat != 0.f), 0)) { _Pragma("unroll") for (int r = 0; r < 16; ++r) { C0[r] -= mhat; C1[r] -= mhat; } } } while (0)
    f32x16 pA0, pA1, pB0, pB1; bf16x8 kf[12]; s16x4 vlo[8], vhi[8]; u32x4 pw0, pw1, pw2, pw3;
    int sl_prev = 0, sl_cur = 0, sl_next = 1;
#define MROT() do { sl_prev = sl_cur; sl_cur = sl_next; sl_next = (sl_next == 2) ? 0 : sl_next + 1; } while (0)
#define MEX(v) __builtin_amdgcn_exp2f(v)
#define MRESC(tn) do { if (resc) { _Pragma("unroll") for (int d_ = 0; d_ < 2; ++d_) _Pragma("unroll") for (int r = 0; r < 16; ++r) o[d_][r] *= wsf[crow(r, hi)]; } } while (0)
#define MDECIDE(C0, C1) do { const float rm = m_rowmax(C0, C1); resc = false; \
      if (__builtin_expect(__any(rm > THR), 0)) { const float dl = __builtin_fmaxf(rm, 0.f); mhat += dl; const float f = __builtin_amdgcn_exp2f(-dl); l_reg *= f; if (hi == 0) wsf[r32] = f; resc = true; \
          _Pragma("unroll") for (int r = 0; r < 16; ++r) { C0[r] -= dl; C1[r] -= dl; } moved = true; } } while (0)
    MWAIT_BAR(5);
#pragma unroll
    for (int d0 = 0; d0 < 6; ++d0) m_kload2(kf, kp0, d0);
    pA0 = MMFMA(kf[0], qr[0], (f32x16){}); pA1 = MMFMA(kf[1], qr[0], (f32x16){}); pA0 = MMFMA(kf[2], qr[1], pA0); pA1 = MMFMA(kf[3], qr[1], pA1);
    pA0 = MMFMA(kf[4], qr[2], pA0); pA1 = MMFMA(kf[5], qr[2], pA1); pA0 = MMFMA(kf[6], qr[3], pA0); pA1 = MMFMA(kf[7], qr[3], pA1);
    pA0 = MMFMA(kf[8], qr[4], pA0); pA1 = MMFMA(kf[9], qr[4], pA1); pA0 = MMFMA(kf[10], qr[5], pA0); pA1 = MMFMA(kf[11], qr[5], pA1);
    if (NT == 4) cmask(pA0, pA1, 0, qrel, hi);
    MREL(pA0, pA1); MDECIDE(pA0, pA1);
#pragma unroll
    for (int r = 0; r < 16; ++r) { pA0[r] = MEX(pA0[r]); pA1[r] = MEX(pA1[r]); }
    MWAIT_BAR(0);
    MDMA_K(3, 0); MDMA_V(1, 1); MROT();
#pragma unroll
    for (int d0 = 0; d0 < 6; ++d0) m_kload2(kf, kp0 + sl_cur * KSL, d0);
    MWAIT_BAR(3);
#define MPKW(P, i) cvtpk(P[i], P[i + 1])
#define MPAF(k) __builtin_bit_cast(bf16x8, pw##k)
#define MVFR(i) (bf16x8){vlo[i][0], vlo[i][1], vlo[i][2], vlo[i][3], vhi[i][0], vhi[i][1], vhi[i][2], vhi[i][3]}
#define MVRD(i) do { vlo[i] = m_vtr(vp_ + (((i) >> 2) * 4096 + ((i) & 3) * 1024)); vhi[i] = m_vtr(vp_ + (((i) >> 2) * 4096 + ((i) & 3) * 1024 + 512)); } while (0)
#define MKRD(G, d0) do { if (G) { m_kload2(kf, kp0 + sl_next * KSL, d0); ASBAR(); } } while (0)
#define MGAPA(MF, a0, a1, a2, a3, W0, W1, PW) do { MF; sacc += a0; sacc += a1; sacc += a2; sacc += a3; W0; W1; MPIN(PW); MPIN(sacc); ASBAR(); } while (0)
#define MGAPB(MF, X, i) do { MF; X[i] = MEX(X[i]); X[i + 1] = MEX(X[i + 1]); X[i + 2] = MEX(X[i + 2]); X[i + 3] = MEX(X[i + 3]); MPIN(X); ASBAR(); } while (0)
#define MGAPA2(MF, a0, a1, W0, PW) do { MF; sacc += a0; sacc += a1; W0; MPIN(PW); MPIN(sacc); ASBAR(); } while (0)
#define MSTEP(C0, C1, P0, P1, t, MASK, GK, GV, GL) do { ASBAR(); \
    const ALDS char* vp_ = vp0 + sl_prev * MSLOT; \
    MVRD(0); ASBAR(); float sacc = P0[0] + P0[1]; \
                     MGAPA(C0 = MMFMA(kf[0], qr[0], (f32x16){}), P0[2], P0[3], P0[4], P0[5],     pw0[0] = MPKW(P0, 0),  pw0[1] = MPKW(P0, 2),  pw0); \
    MVRD(4); ASBAR(); MGAPA(C1 = MMFMA(kf[1], qr[0], (f32x16){}), P0[6], P0[7], P0[8], P0[9],     pw0[2] = MPKW(P0, 4),  pw0[3] = MPKW(P0, 6),  pw0); \
    MVRD(1); ASBAR(); MGAPA2(C0 = MMFMA(kf[2], qr[1], C0), P0[10], P0[11], pw1[0] = MPKW(P0, 8),  pw1); \
    MVRD(5); ASBAR(); MGAPA2(C1 = MMFMA(kf[3], qr[1], C1), P0[12], P0[13], pw1[1] = MPKW(P0, 10), pw1); \
                     MGAPA2(C0 = MMFMA(kf[4], qr[2], C0), P0[14], P0[15], pw1[2] = MPKW(P0, 12), pw1); \
                     MGAPA2(C1 = MMFMA(kf[5], qr[2], C1), P1[0], P1[1],   pw1[3] = MPKW(P0, 14), pw1); \
                     MGAPA2(C0 = MMFMA(kf[6], qr[3], C0), P1[2], P1[3],   pw2[0] = MPKW(P1, 0),  pw2); \
                     MGAPA2(C1 = MMFMA(kf[7], qr[3], C1), P1[4], P1[5],   pw2[1] = MPKW(P1, 2),  pw2); \
                     MGAPA(C0 = MMFMA(kf[8], qr[4], C0), P1[6], P1[7], P1[8], P1[9],     pw2[2] = MPKW(P1, 4),  pw2[3] = MPKW(P1, 6),  pw2); \
                     MGAPA(C1 = MMFMA(kf[9], qr[4], C1), P1[10], P1[11], P1[12], P1[13], pw3[0] = MPKW(P1, 8),  pw3[1] = MPKW(P1, 10), pw3); \
                     MGAPA2(C0 = MMFMA(kf[10], qr[5], C0), P1[14], P1[15], pw3[2] = MPKW(P1, 12), pw3); \
                     MGAPA2(C1 = MMFMA(kf[11], qr[5], C1), 0.f, 0.f,       pw3[3] = MPKW(P1, 14), pw3); \
    l_reg += sacc; \
    if (GK) MDMA_K((t) + 3, sl_cur); if (GV) MDMA_V((t) + 1, sl_next); \
    if (MASK) cmask(C0, C1, (t) - NP, qrel, hi); \
    MREL(C0, C1); MDECIDE(C0, C1); ASBAR(); \
    MVRD(2); MKRD(GL, 4); ASBAR(); MGAPB(o[0] = MMFMA(MPAF(0), MVFR(0), o[0]), C0, 0);  MVRD(6); MKRD(GL, 5); ASBAR(); MGAPB(o[1] = MMFMA(MPAF(0), MVFR(4), o[1]), C0, 4); \
    MVRD(3); MKRD(GL, 0); ASBAR(); MGAPB(o[0] = MMFMA(MPAF(1), MVFR(1), o[0]), C0, 8);  MVRD(7); MKRD(GL, 1); ASBAR(); MGAPB(o[1] = MMFMA(MPAF(1), MVFR(5), o[1]), C0, 12); \
    MKRD(GL, 2); MGAPB(o[0] = MMFMA(MPAF(2), MVFR(2), o[0]), C1, 0);  MKRD(GL, 3); MGAPB(o[1] = MMFMA(MPAF(2), MVFR(6), o[1]), C1, 4); \
    MGAPB(o[0] = MMFMA(MPAF(3), MVFR(3), o[0]), C1, 8);               MGAPB(o[1] = MMFMA(MPAF(3), MVFR(7), o[1]), C1, 12); \
    } while (0)
    int t = 1;
    for (; t + 5 < NT; t += 2) {
        MSTEP(pB0, pB1, pA0, pA1, t, false, true, true, true);     MWAIT_BAR(3); MRESC(t + 1); MROT();
        MSTEP(pA0, pA1, pB0, pB1, t + 1, false, true, true, true); MWAIT_BAR(3); MRESC(t + 2); MROT();
    }
#define MENDW(tt) do { if ((tt) + 3 < NT) { MWAIT_BAR(3); } else if ((tt) + 2 < NT) { MWAIT_BAR(1); } else { MWAIT_BAR(0); } } while (0)
    for (; t + 1 < NT; t += 2) {
        MSTEP(pB0, pB1, pA0, pA1, t, true, (t + 3 < NT), (t + 1 < NT), (t + 1 < NT));         MENDW(t);     MRESC(t + 1); MROT();
        MSTEP(pA0, pA1, pB0, pB1, t + 1, true, (t + 4 < NT), (t + 2 < NT), (t + 2 < NT));     MENDW(t + 1); MRESC(t + 2); MROT();
    }
    MSTEP(pB0, pB1, pA0, pA1, NT - 1, true, false, false, false); MRESC(NT - 1);
    { float sacc = pB0[0] + pB0[1];
#pragma unroll
      for (int r = 2; r < 16; ++r) sacc += pB0[r];
#pragma unroll
      for (int r = 0; r < 16; ++r) sacc += pB1[r];
      l_reg += sacc;
      pw0 = (u32x4){MPKW(pB0, 0), MPKW(pB0, 2), MPKW(pB0, 4), MPKW(pB0, 6)}; pw1 = (u32x4){MPKW(pB0, 8), MPKW(pB0, 10), MPKW(pB0, 12), MPKW(pB0, 14)};
      pw2 = (u32x4){MPKW(pB1, 0), MPKW(pB1, 2), MPKW(pB1, 4), MPKW(pB1, 6)}; pw3 = (u32x4){MPKW(pB1, 8), MPKW(pB1, 10), MPKW(pB1, 12), MPKW(pB1, 14)};
      const ALDS char* vp_ = vp0 + sl_cur * MSLOT;
#pragma unroll
      for (int i = 0; i < 8; ++i) MVRD(i);
      o[0] = MMFMA(MPAF(0), MVFR(0), o[0]); o[1] = MMFMA(MPAF(0), MVFR(4), o[1]); o[0] = MMFMA(MPAF(1), MVFR(1), o[0]); o[1] = MMFMA(MPAF(1), MVFR(5), o[1]);
      o[0] = MMFMA(MPAF(2), MVFR(2), o[0]); o[1] = MMFMA(MPAF(2), MVFR(6), o[1]); o[0] = MMFMA(MPAF(3), MVFR(3), o[0]); o[1] = MMFMA(MPAF(3), MVFR(7), o[1]); }
    { auto rr = __builtin_amdgcn_permlane32_swap(__float_as_uint(l_reg), __float_as_uint(l_reg), false, false); l_reg = __uint_as_float(rr[0]) + __uint_as_float(rr[1]); }
    if (hi == 0) wsf[32 + r32] = l_reg; asm volatile("s_waitcnt lgkmcnt(0)" ::: "memory");
    float rli[16];
#pragma unroll
    for (int r = 0; r < 16; ++r) rli[r] = __builtin_amdgcn_rcpf(wsf[32 + crow(r, hi)]);
    { ALDS unsigned short* stg = (ALDS unsigned short*)(lds + N_OST) + wid * 2048;
#pragma unroll
      for (int r = 0; r < 16; ++r) { const int orow = crow(r, hi);
#pragma unroll
          for (int d0 = 0; d0 < 2; ++d0) stg[orow * 64 + d0 * 32 + r32] = (unsigned short)(cvtpk(o[d0][r] * rli[r], 0.f) & 0xffffu); }
      asm volatile("s_waitcnt lgkmcnt(0)" ::: "memory");
      bf16_t* Ow = Op + (size_t)(qb * 256 + wid * 32) * ldo;
#pragma unroll
      for (int i = 0; i < 4; ++i) { const int row = i * 8 + (lane >> 3), ch = lane & 7; const u32x4 v = *(ALDS const u32x4*)(stg + row * 64 + ch * 8); *(u32x4*)(Ow + (size_t)row * ldo + ch * 8) = v; } }
    asm volatile("s_waitcnt lgkmcnt(0)\n\ts_barrier" ::: "memory");
#undef MDMA_K
#undef MDMA_V
#undef MCM
#undef MROT
#undef MEX
#undef MRESC
#undef MDECIDE
#undef MPKW
#undef MPAF
#undef MVFR
#undef MVRD
#undef MKRD
#undef MGAPA
#undef MGAPB
#undef MSTEP
#undef MENDW
#undef MGAPA2
#undef MREL
}
#undef ASBAR
}
#define GAS __attribute__((address_space(1)))
#define LAS __attribute__((address_space(3)))
typedef unsigned short bf16;
typedef unsigned v4u __attribute__((ext_vector_type(4)));
typedef float f32x4 __attribute__((ext_vector_type(4)));
typedef short bf16x8 __attribute__((ext_vector_type(8)));
typedef GAS unsigned gu32;
typedef GAS unsigned long long gu64;
#define RLX_AGENT __ATOMIC_RELAXED, __HIP_MEMORY_SCOPE_AGENT
#define LDS_WAIT() asm volatile("s_waitcnt lgkmcnt(0)" ::: "memory")
#define VM_WAIT() asm volatile("s_waitcnt vmcnt(0)" ::: "memory")
__device__ __forceinline__ unsigned long long rt() { return __builtin_amdgcn_s_memrealtime(); }
__device__ __forceinline__ unsigned f2bf(float f) { unsigned u = __builtin_bit_cast(unsigned, f); return (u + 0x7fffu + ((u >> 16) & 1u)) >> 16; }
__device__ __forceinline__ unsigned pk2(float lo, float hi) { return f2bf(lo) | (f2bf(hi) << 16); }

#define XB_TMO      128
#define XB_XCNT(j)  (256  + 64 * (j))
#define XB_XSUB(j)  (1280 + 64 * (j))
#define XB_XGEN(j)  (2304 + 64 * (j))
#define XB_TOP      3328
#define XB_TOPGEN   3392
#define XCD_BAR_WORDS 3456
#define XB_SPIN_CAP (1u << 18)

__device__ __forceinline__ unsigned xb_ld(unsigned* p)              { return __hip_atomic_load(p, __ATOMIC_RELAXED, __HIP_MEMORY_SCOPE_AGENT); }
__device__ __forceinline__ unsigned xb_add(unsigned* p, unsigned v) { return __hip_atomic_fetch_add(p, v, __ATOMIC_RELAXED, __HIP_MEMORY_SCOPE_AGENT); }
__device__ __forceinline__ unsigned xb_xcc_id() { return (unsigned)__builtin_amdgcn_s_getreg((3 << 11) | 20) & 0xFu; }
#define XB_SPIN(cond, bar) do { unsigned _sp = 0; while (cond) { __builtin_amdgcn_s_sleep(1); \
    if ((++_sp & 255u) == 0u) { if (xb_ld(&(bar)[XB_TMO])) break; if (_sp > XB_SPIN_CAP) { atomicAdd(&(bar)[XB_TMO], 1u); break; } } } } while (0)

struct XcdBarrier {
    unsigned* bar; unsigned x;
    volatile LAS unsigned* st;
};

__device__ __forceinline__ XcdBarrier xcd_barrier_post(unsigned* bar, volatile LAS unsigned* st) {
    XcdBarrier b; b.bar = bar; b.x = xb_xcc_id(); b.st = st;
    if (threadIdx.x == 0) (void)xb_add(&bar[XB_XCNT(b.x)], 1u);
    return b;
}
__device__ __forceinline__ void xcd_barrier_complete(unsigned* bar, unsigned x, unsigned& nloc, unsigned& nx) {
    const unsigned G = gridDim.x * gridDim.y * gridDim.z;
    unsigned sum, cnt, mine, sp = 0u;
    for (;;) {
        sum = 0u; cnt = 0u; mine = 0u;
#pragma unroll
        for (unsigned j = 0; j < 16; ++j) { const unsigned c = xb_ld(&bar[XB_XCNT(j)]); sum += c; cnt += (c > 0u) ? 1u : 0u; mine = (j == x) ? c : mine; }
        if (sum == G) break;
        __builtin_amdgcn_s_sleep(1);
        if ((++sp & 255u) == 0u) { if (xb_ld(&bar[XB_TMO])) break; if (sp > XB_SPIN_CAP) { atomicAdd(&bar[XB_TMO], 1u); break; } }
    }
    nloc = mine > 0u ? mine : 1u; nx = cnt > 0u ? cnt : 1u;
}

__device__ __forceinline__ void xcd_barrier(const XcdBarrier& b) {
    asm volatile("s_waitcnt vmcnt(0)" ::: "memory");
    __syncthreads();
    if (threadIdx.x == 0) {
        unsigned* bar = b.bar;
        __builtin_amdgcn_s_waitcnt(0);
        unsigned nloc = b.st[0], nx = b.st[1];
        if (nloc == 0u) { xcd_barrier_complete(bar, b.x, nloc, nx); b.st[0] = nloc; b.st[1] = nx; }
        const unsigned old = xb_add(&bar[XB_XSUB(b.x)], 1u);
        const unsigned gen = old / nloc;
        if (old + 1u == (gen + 1u) * nloc) {
            __builtin_amdgcn_fence(__ATOMIC_RELEASE, "agent");
            asm volatile("s_waitcnt vmcnt(0)" ::: "memory");
            const unsigned og = xb_add(&bar[XB_TOP], 1u);
            const unsigned tg = og / nx;
            if (og + 1u == (tg + 1u) * nx) xb_add(&bar[XB_TOPGEN], 1u);
            else XB_SPIN(xb_ld(&bar[XB_TOPGEN]) == tg, bar);
            __builtin_amdgcn_fence(__ATOMIC_ACQUIRE, "agent");
            xb_add(&bar[XB_XGEN(b.x)], 1u);
            asm volatile("s_waitcnt vmcnt(0)" ::: "memory");
        } else {
            XB_SPIN(xb_ld(&bar[XB_XGEN(b.x)]) == gen, bar);
            __builtin_amdgcn_fence(__ATOMIC_ACQUIRE, "agent");
            asm volatile("s_waitcnt vmcnt(0)" ::: "memory");
        }
    }
    __syncthreads();
}

constexpr size_t MiB = 1u << 20;
constexpr size_t WS_CTL = 0, CTL_ZERO_BYTES = 64 * 1024;
constexpr size_t WS_ROPEA = 1 * MiB, WS_ROPEB = 5 * MiB;
constexpr size_t WS_SS = 13 * MiB, WS_SS2 = 16 * MiB, WS_SS3 = 20 * MiB;
constexpr size_t WS_WIN = 24 * MiB, WS_WUQ = 34 * MiB, WS_WUKV = 35 * MiB, WS_WA = 36 * MiB, WS_WOUT = 39 * MiB, WS_WUP = 42 * MiB, WS_WDN = 51 * MiB;
constexpr size_t WS_H = 64 * MiB;
constexpr size_t WS_G = 208 * MiB;
constexpr size_t WS_QA = 464 * MiB, WS_KA = 528 * MiB, WS_VA = 592 * MiB;
constexpr size_t WS_T = WS_KA;
constexpr size_t WS_CQ = 672 * MiB, WS_CKV = 720 * MiB;
constexpr size_t WS_KR = 760 * MiB;
constexpr size_t WS_QB = 768 * MiB, WS_KB = 864 * MiB, WS_VB = 928 * MiB;
constexpr size_t WS_Y = WS_QB;
constexpr size_t WS_X1 = 896 * MiB;
constexpr size_t WS_H8 = WS_QB;
constexpr size_t WS_WG8 = 60 * MiB;
constexpr size_t WS_U = 208 * MiB;
constexpr size_t WS_END = 1024 * MiB;
static_assert(WS_H + (size_t)MTOK * LDH * 2 <= WS_G && WS_G + (size_t)MTOK * 2 * DM * 2 <= WS_QA && WS_T + (size_t)MTOK * LDH * 2 <= WS_CQ && WS_CQ + (size_t)MTOK * QLORA * 2 <= WS_CKV && WS_CKV + (size_t)MTOK * LDKV * 2 <= WS_KR, "d_ws map");
static_assert(WS_U + (size_t)MTOK * LDU * 2 <= WS_KR && WS_Y + (size_t)MTOK * DM * 2 <= WS_X1 && WS_X1 + (size_t)MTOK * DM * 2 <= WS_END && WS_VB + (size_t)MTOK * AW * 2 <= WS_END && WS_KR + (size_t)MTOK * RDIM * 2 <= WS_QB, "d_ws map");
static_assert(WS_WIN + (size_t)INWP * LDH * 2 <= WS_WUQ && WS_WUKV + (size_t)1024 * LDKV * 2 <= WS_WA && WS_WA + (size_t)DM * LDH * 2 <= WS_WOUT && WS_WOUT + (size_t)DM * LDH * 2 <= WS_WUP && WS_WUP + (size_t)DFF * LDH * 2 <= WS_WDN && WS_WDN + (size_t)DM * LDU * 2 <= WS_H, "d_ws map");
constexpr int CW_BAR = 0;
constexpr int NWAVES = 8;
constexpr int RING_OFF = 0, RING_BYTES = 131072;
constexpr int LDSCTL_OFF = RING_BYTES, MISC_OFF = LDSCTL_OFF + 320;
constexpr int LDS_BYTES = 147456;
static_assert(att::L_END <= RING_BYTES, "attention LDS map");

struct Frame {
    LAS unsigned char* lds;
    volatile LAS unsigned* MISC;
    gu32* ctl;
    int tid, lane, wave, vcu, G;
};

__device__ __forceinline__ float wave_sum(float v) {
#pragma unroll
    for (int o = 1; o < 64; o <<= 1) v += __shfl_xor(v, o);
    return v;
}
__device__ __forceinline__ int srccol(int mat, int n) {
    if (mat == 0) {
        if (n < 1024) { const int sect = n >> 9, c = n & 511, head = c >> 6, p = c & 63; const int d = (p < 16) ? ((p >> 1) + 8 * (p & 1)) : p; return sect * 512 + head * 64 + d; }
        if (n < 1920) return n;
        if (n < 1952) { const int pr = n - 1920; return 2176 + (pr >> 1) + 16 * (pr & 1); }
        if (n < 2048) return -1;
        if (n < 2304) return 1920 + (n - 2048);
        return 2208 + (n - 2304);
    }
    if (mat == 1) { const int head = n / QKB, p = n - head * QKB; if (p < 64) return n; const int pr = p - 64; return head * QKB + 64 + (pr >> 1) + 16 * (pr & 1); }
    return n;
}
__device__ __forceinline__ void p0_transpose_item(const float* W, int K, int Nsrc, int Ndst, bf16* WT, int ldw, int koff, const float* gs, int mat, LAS float* scr, int item, int lane) {
    const int nblk = Ndst / 32, kb = item / nblk, nb = item % nblk, k0 = 64 * kb, n0 = 32 * nb;
    const int sc = srccol(mat, n0 + (lane & 31));
#pragma unroll 8
    for (int i = 0; i < 32; ++i) { const int kk = 2 * i + (lane >> 5); float v = (sc >= 0) ? W[(size_t)(k0 + kk) * Nsrc + sc] : 0.f; if (gs) v *= gs[k0 + kk]; scr[kk * 33 + (lane & 31)] = v; }
    LDS_WAIT(); asm volatile("" ::: "memory");
    const int c = lane & 7;
#pragma unroll
    for (int j = 0; j < 4; ++j) { const int n = (lane >> 3) + 8 * j; const LAS float* s = scr + (8 * c) * 33 + n;
        v4u o; o.x = pk2(s[0 * 33], s[1 * 33]); o.y = pk2(s[2 * 33], s[3 * 33]); o.z = pk2(s[4 * 33], s[5 * 33]); o.w = pk2(s[6 * 33], s[7 * 33]);
        *(GAS v4u*)(WT + (size_t)(n0 + n) * ldw + koff + k0 + 8 * c) = o; }
    LDS_WAIT(); asm volatile("" ::: "memory");
}
__device__ __forceinline__ int ppos_dn(int c) { return (c & ~255) | (((c >> 5) & 3) << 6) | (((c >> 3) & 3) << 4) | (((c >> 7) & 1) << 3) | (c & 7); }
template <bool KPERM = false>
__device__ __forceinline__ void p0_transpose_item_f8(const float* W, int K, int N, int Nsrc, int coff, unsigned char* WT, float scale, LAS float* scr, int item, int lane) {
    const int nblk = N / 32, kb = item / nblk, nb = item % nblk, k0 = 64 * kb, n0 = 32 * nb;
#pragma unroll 8
    for (int i = 0; i < 32; ++i) { const int kk = 2 * i + (lane >> 5); scr[kk * 33 + (lane & 31)] = W[(size_t)(k0 + kk) * Nsrc + coff + n0 + (lane & 31)] * scale; }
    LDS_WAIT(); asm volatile("" ::: "memory");
    const int c = lane & 7;
#pragma unroll
    for (int j = 0; j < 4; ++j) { const int n = (lane >> 3) + 8 * j; const LAS float* s = scr + (8 * c) * 33 + n;
        int w0 = 0, w1 = 0;
        w0 = __builtin_amdgcn_cvt_pk_fp8_f32(s[0 * 33], s[1 * 33], w0, false); w0 = __builtin_amdgcn_cvt_pk_fp8_f32(s[2 * 33], s[3 * 33], w0, true);
        w1 = __builtin_amdgcn_cvt_pk_fp8_f32(s[4 * 33], s[5 * 33], w1, false); w1 = __builtin_amdgcn_cvt_pk_fp8_f32(s[6 * 33], s[7 * 33], w1, true);
        typedef int i32x2_ __attribute__((ext_vector_type(2)));
        *(GAS i32x2_*)(WT + (size_t)(n0 + n) * K + (KPERM ? ppos_dn(k0 + 8 * c) : k0 + 8 * c)) = (i32x2_){w0, w1}; }
    LDS_WAIT(); asm volatile("" ::: "memory");
}
__device__ __forceinline__ void rms_row_to_bf16(int lane, const float* xrow, const f32x4 (&g)[4], bf16* orow, unsigned char* orow8) {
    const GAS f32x4* xr = (const GAS f32x4*)xrow + lane;
    f32x4 v[4]; float s = 0.f;
#pragma unroll
    for (int j = 0; j < 4; ++j) { v[j] = xr[64 * j]; s += (v[j].x * v[j].x + v[j].y * v[j].y) + (v[j].z * v[j].z + v[j].w * v[j].w); }
    const float rstd = 1.f / sqrtf(wave_sum(s) * (1.f / DM) + EPS);
    GAS unsigned long long* o8 = (GAS unsigned long long*)orow + lane;
#pragma unroll
    for (int j = 0; j < 4; ++j) { const f32x4 y = v[j] * rstd * g[j]; o8[64 * j] = (unsigned long long)pk2(y.x, y.y) | ((unsigned long long)pk2(y.z, y.w) << 32);
        int w = 0; w = __builtin_amdgcn_cvt_pk_fp8_f32(y.x, y.y, w, false); w = __builtin_amdgcn_cvt_pk_fp8_f32(y.z, y.w, w, true); ((GAS int*)orow8)[lane + 64 * j] = w; }
}

struct Args { const float* in[17]; float* out; unsigned char* ws; int ph_lo, ph_hi, li, pad; };

__global__ void __launch_bounds__(NWAVES * 64, 2) block_fwd(Args args) {
    extern __shared__ __attribute__((aligned(16))) unsigned char lds[];
    Frame F;
    F.lds = (LAS unsigned char*)lds;
    F.MISC = (volatile LAS unsigned*)(F.lds + MISC_OFF);
    F.tid = threadIdx.x; F.lane = F.tid & 63; F.wave = __builtin_amdgcn_readfirstlane(F.tid >> 6);
    F.G = gridDim.x; { const int bx = blockIdx.x; F.vcu = (F.G % 8 == 0) ? (bx % 8) * (F.G / 8) + bx / 8 : bx; }
    unsigned char* ws = args.ws;
    F.ctl = (gu32*)(ws + WS_CTL);
    const float* x = args.in[0]; const int* positions = (const int*)args.in[1];
    const float *g_pre_mix = args.in[2], *w_in = args.in[3], *b_gate = args.in[4], *g_q = args.in[5], *w_uq = args.in[6], *g_kv = args.in[7], *w_ukv = args.in[8], *w_a = args.in[9], *w_b = args.in[10],
                *w_out = args.in[11], *g_post_mix = args.in[12], *g_pre_mlp = args.in[13], *w_up = args.in[14], *w_dn = args.in[15], *g_post_mlp = args.in[16];
    float* out = args.out;
    float* ropeA = (float*)(ws + WS_ROPEA); float* ropeB = (float*)(ws + WS_ROPEB);
    float* SS = (float*)(ws + WS_SS); float* SS2 = (float*)(ws + WS_SS2); float* SS3 = (float*)(ws + WS_SS3);
    bf16 *WIN = (bf16*)(ws + WS_WIN), *WUQ = (bf16*)(ws + WS_WUQ), *WUKV = (bf16*)(ws + WS_WUKV), *WA = (bf16*)(ws + WS_WA), *WOUT = (bf16*)(ws + WS_WOUT), *WUP = (bf16*)(ws + WS_WUP), *WDN = (bf16*)(ws + WS_WDN);
    bf16 *H = (bf16*)(ws + WS_H), *Gt = (bf16*)(ws + WS_G), *QA = (bf16*)(ws + WS_QA), *KA = (bf16*)(ws + WS_KA), *VA = (bf16*)(ws + WS_VA), *T = (bf16*)(ws + WS_T), *CQ = (bf16*)(ws + WS_CQ), *CKV = (bf16*)(ws + WS_CKV),
         *KR = (bf16*)(ws + WS_KR), *QB = (bf16*)(ws + WS_QB), *KB = (bf16*)(ws + WS_KB), *VB = (bf16*)(ws + WS_VB), *Y = (bf16*)(ws + WS_Y), *U = (bf16*)(ws + WS_U), *X1B = (bf16*)(ws + WS_X1); unsigned char *H8 = ws + WS_H8, *WG8 = ws + WS_WG8;
    for (int u = F.tid; u < (LDS_BYTES - LDSCTL_OFF) / 4; u += NWAVES * 64) ((LAS unsigned*)(F.lds + LDSCTL_OFF))[u] = 0u;
    __syncthreads();
    XcdBarrier bar = xcd_barrier_post((unsigned*)(F.ctl + CW_BAR) + args.li * XCD_BAR_WORDS, F.MISC + 8);
    const int lo = args.ph_lo, hi = args.ph_hi;
#define IN(k) (lo <= (k) && (k) < hi)
#define SEAM(k) do { if (IN(k) && IN((k) + 1)) xcd_barrier(bar); } while (0)
    const int gw = F.vcu * NWAVES + F.wave, NGW = F.G * NWAVES;

#if !defined(SKIP_P0)
    if (IN(0))
    {
        LAS float* scr = (LAS float*)(F.lds + RING_OFF + F.wave * 16384);
        constexpr int NBF = 2304, IG = (DM / 64) * (2 * DM / 32);
        constexpr int I0 = (DM / 64) * (NBF / 32), I1 = (QLORA / 64) * (768 / 32), I2 = (KVLORA / 64) * (1024 / 32), I3 = (AW / 64) * (DM / 32), I5 = (DM / 64) * (DM / 32), I6 = (DM / 64) * (DFF / 32), I7 = (DFF / 64) * (DM / 32);
        constexpr int NITEMS = I0 + I1 + I2 + 2 * I3 + I5 + I6 + I7 + IG;
        for (int it = gw; it < NITEMS; it += NGW) {
            int r = it;
            if (r < I0) { p0_transpose_item(w_in, DM, INW, NBF, WIN, LDH, 0, nullptr, 0, scr, r, F.lane); continue; } r -= I0;
            if (r < IG) { p0_transpose_item_f8(w_in, DM, 2 * DM, INW, 2208, WG8, 32.f, scr, r, F.lane); continue; } r -= IG;
            if (r < I1) { p0_transpose_item(w_uq, QLORA, 768, 768, WUQ, QLORA, 0, g_q, 1, scr, r, F.lane); continue; } r -= I1;
            if (r < I2) { p0_transpose_item(w_ukv, KVLORA, 1024, 1024, WUKV, LDKV, 0, g_kv, 2, scr, r, F.lane); continue; } r -= I2;
            if (r < I3) { p0_transpose_item(w_a, AW, DM, DM, WA, LDH, 0, nullptr, 2, scr, r, F.lane); continue; } r -= I3;
            if (r < I3) { p0_transpose_item(w_b, AW, DM, DM, WA, LDH, AW, nullptr, 2, scr, r, F.lane); continue; } r -= I3;
            if (r < I5) { p0_transpose_item_f8<true>(w_out, DM, DM, DM, 0, (unsigned char*)WOUT, 32.f, scr, r, F.lane); continue; } r -= I5;
            if (r < I6) { p0_transpose_item_f8(w_up, DM, DFF, DFF, 0, (unsigned char*)WUP, 32.f, scr, r, F.lane); continue; } r -= I6;
            p0_transpose_item_f8<true>(w_dn, DFF, DM, DM, 0, (unsigned char*)WDN, 64.f, scr, r, F.lane);
        }
        for (int idx = (int)blockIdx.x * (NWAVES * 64) + F.tid; idx < MTOK * 24; idx += F.G * NWAVES * 64) {
            const int m = idx / 24, i = idx - m * 24;
            const float invf = (i < 8) ? __builtin_amdgcn_exp2f(-(float)i * 2.3664460711655217f) : __builtin_amdgcn_exp2f(-(float)(i - 8) * 1.1832230355827609f);
            const float ang = (float)positions[m] * invf;
            double t = (double)ang * 0.15915494309189535; t -= floor(t);
            const float tf = (float)t; const float c = __builtin_amdgcn_cosf(tf), s = __builtin_amdgcn_sinf(tf);
            float* dst = (i < 8) ? ropeA + (size_t)m * 16 + 2 * i : ropeB + (size_t)m * 32 + 2 * (i - 8);
            *(f32x2g*)dst = (f32x2g){c, s};
        }
        f32x4 g[4];
#pragma unroll
        for (int j = 0; j < 4; ++j) g[j] = ((const GAS f32x4*)g_pre_mix)[F.lane + 64 * j];
        for (int m = gw; m < MTOK; m += NGW) rms_row_to_bf16(F.lane, x + (size_t)m * DM, g, H + (size_t)m * LDH, H8 + (size_t)m * DM);
    }
#endif
    SEAM(0);

#if !defined(SKIP_P1)
    if (IN(1))
    {
        { pg8::Gemm g{H, WIN, MTOK, 2304, DM, LDH, LDH}; pg8::StaticOrder S; S.init(MTOK, 2304, F.G, (int)blockIdx.x);
          pg8::EpiIn E{QA, KA, VA, CQ, CKV, KR, Gt, SS, ropeA, ropeB, b_gate};
          pg8::gemm_phase<pg8::EpiIn, pg8::StaticOrder, true, true>(F.lds + RING_OFF, g, S, E); }
        { pg8::Gemm g{(const bf16*)H8, (const bf16*)WG8, MTOK, 2 * DM, DM, DM, DM}; pg8::StaticOrder S; S.init(MTOK, 2 * DM, F.G, (int)blockIdx.x);
          pg8::EpiGates E{Gt, b_gate};
          pg8::gemm_phase<pg8::EpiGates, pg8::StaticOrder, true, true, 1>(F.lds + RING_OFF, g, S, E); }
    }
#endif
    SEAM(1);

#if !defined(SKIP_P2)
    if (IN(2)) {
    {
        pg8::Gemm g{CQ, WUQ, MTOK, NHEAD * QKB, QLORA}; pg8::StaticOrder S; S.init(MTOK, NHEAD * QKB, F.G, (int)blockIdx.x);
        pg8::EpiQ E{QB, SS, ropeB};
        pg8::gemm_phase<pg8::EpiQ, pg8::StaticOrder, true, true, 2, true>(F.lds + RING_OFF, g, S, E);
    }
    {
        pg8::Gemm g{CKV, WUKV, MTOK, 2 * AW, KVLORA, LDKV, LDKV}; pg8::StaticOrder S; S.init(MTOK, 2 * AW, F.G, (int)blockIdx.x);
        pg8::EpiKV E{KB, VB, SS};
        pg8::gemm_phase<pg8::EpiKV, pg8::StaticOrder, true, true, 2, true>(F.lds + RING_OFF, g, S, E);
    }
    }
#endif
    SEAM(2);

#if !defined(SKIP_P3)
    if (IN(3))
    {
        LAS char* al = (LAS char*)(F.lds + RING_OFF);
#if !defined(SKIP_MOBA)
        for (int bh = F.vcu; bh < NB * NHEAD; bh += F.G) {
            const int b = bh >> 3, h = bh & 7; const size_t r0 = (size_t)b * SEQ;
            att::kmean_blocks(KA + r0 * AW + h * HD * 16, al);
#pragma unroll 1
            for (int qb = 0; qb < 8; ++qb) att::moba_unit(QA + r0 * AW + h * HD * 16, KA + r0 * AW + h * HD * 16, VA + r0 * AW + h * HD * 16, H + r0 * LDH + h * HD, LDH, qb, al);
        }
#endif
#if !defined(SKIP_MLA)
        for (int bh = F.vcu; bh < NB * NHEAD; bh += F.G) {
            const int b = bh >> 3, h = bh & 7; const size_t r0 = (size_t)b * SEQ;
#pragma unroll 1
            for (int qb = 0; qb < 8; ++qb) att::mla_unit(QB + r0 * (NHEAD * QKB) + h * QKB * 16, KB + r0 * AW + h * HD * 16, KR + r0 * RDIM, VB + r0 * AW + h * HD * 16, H + r0 * LDH + AW + h * HD, LDH, qb, al);
        }
#endif
    }
#endif
    SEAM(3);

#if !defined(SKIP_P4)
    if (IN(4))
    {
        pg8::Gemm g{H, WA, MTOK, DM, DM, LDH, LDH}; pg8::StaticOrder S; S.init(MTOK, DM, F.G, (int)blockIdx.x);
        pg8::EpiMerge E{Gt, T};
        pg8::gemm_phase<pg8::EpiMerge, pg8::StaticOrder, true, true>(F.lds + RING_OFF, g, S, E);
    }
#endif
    SEAM(4);

#if !defined(SKIP_P5)
    if (IN(5))
    {
        pg8::Gemm g{T, WOUT, MTOK, DM, DM, DM, DM}; pg8::StaticOrder S; S.init(MTOK, DM, F.G, (int)blockIdx.x);
        pg8::EpiSS E{Y, SS2, DM, 1.0f / 2048.0f};
        pg8::gemm_phase<pg8::EpiSS, pg8::StaticOrder, true, true, 1, true>(F.lds + RING_OFF, g, S, E);
    }
#endif
    SEAM(5);

#if !defined(SKIP_P6)
    if (IN(6))
    {
        f32x4 g1[4], g2[4];
#pragma unroll
        for (int j = 0; j < 4; ++j) { g1[j] = ((const GAS f32x4*)g_post_mix)[F.lane + 64 * j]; g2[j] = ((const GAS f32x4*)g_pre_mlp)[F.lane + 64 * j]; }
        f32x4 ca, cb, cc, cd, cx[4]; unsigned long long cy[4];
#define P6_LOAD(A, B, C, D, X, Yv, mm) do { const GAS f32x4* sp_ = (const GAS f32x4*)(SS2 + (size_t)(mm) * 16); A = sp_[0]; B = sp_[1]; C = sp_[2]; D = sp_[3]; \
            const GAS f32x4* xr_ = (const GAS f32x4*)(x + (size_t)(mm) * DM) + F.lane; const GAS unsigned long long* yr_ = (const GAS unsigned long long*)(Y + (size_t)(mm) * DM) + F.lane; \
            _Pragma("unroll") for (int j = 0; j < 4; ++j) { X[j] = xr_[64 * j]; Yv[j] = yr_[64 * j]; } } while (0)
        if (gw < MTOK) P6_LOAD(ca, cb, cc, cd, cx, cy, gw);
        for (int m = gw; m < MTOK; m += NGW) {
            f32x4 na, nb, nc, nd, nx[4]; unsigned long long ny[4];
            const bool more = m + NGW < MTOK;
            if (more) P6_LOAD(na, nb, nc, nd, nx, ny, m + NGW);
            const f32x4 a = ca, b = cb, c = cc, d = cd;
            const float ssy = (((a.x + a.y) + (a.z + a.w)) + ((b.x + b.y) + (b.z + b.w))) + (((c.x + c.y) + (c.z + c.w)) + ((d.x + d.y) + (d.z + d.w)));
            const float rsy = 1.f / sqrtf(ssy * (1.f / DM) + EPS);
            GAS unsigned long long* x8 = (GAS unsigned long long*)(X1B + (size_t)m * DM) + F.lane;
            f32x4 v[4]; float s = 0.f;
#pragma unroll
            for (int j = 0; j < 4; ++j) { const unsigned long long yw = cy[j]; const unsigned lo = (unsigned)yw, hi = (unsigned)(yw >> 32);
                const f32x4 yv = (f32x4){__uint_as_float(lo << 16), __uint_as_float(lo & 0xffff0000u), __uint_as_float(hi << 16), __uint_as_float(hi & 0xffff0000u)};
                v[j] = cx[j] + yv * rsy * g1[j]; x8[64 * j] = (unsigned long long)pk2(v[j].x, v[j].y) | ((unsigned long long)pk2(v[j].z, v[j].w) << 32);
                s += (v[j].x * v[j].x + v[j].y * v[j].y) + (v[j].z * v[j].z + v[j].w * v[j].w); }
            const float rstd = 1.f / sqrtf(wave_sum(s) * (1.f / DM) + EPS);
            GAS int* o8 = (GAS int*)((unsigned char*)H + (size_t)m * DM) + F.lane;
#pragma unroll
            for (int j = 0; j < 4; ++j) { const f32x4 y2 = v[j] * rstd * g2[j]; int w = 0; w = __builtin_amdgcn_cvt_pk_fp8_f32(y2.x, y2.y, w, false); w = __builtin_amdgcn_cvt_pk_fp8_f32(y2.z, y2.w, w, true); o8[64 * j] = w; }
            if (more) { ca = na; cb = nb; cc = nc; cd = nd;
#pragma unroll
                for (int j = 0; j < 4; ++j) { cx[j] = nx[j]; cy[j] = ny[j]; } }
        }
#undef P6_LOAD
    }
#endif
    SEAM(6);

#if !defined(SKIP_P7)
    if (IN(7))
    {
        pg8::Gemm g{H, WUP, MTOK, DFF, DM, DM, DM}; pg8::StaticOrder S; S.init(MTOK, DFF, F.G, (int)blockIdx.x);
        pg8::EpiRelu2F8 E{(unsigned char*)U, 1.0f / 32.0f};
        pg8::gemm_phase<pg8::EpiRelu2F8, pg8::StaticOrder, true, true, 1>(F.lds + RING_OFF, g, S, E);
    }
#endif
    SEAM(7);

#if !defined(SKIP_P8)
    if (IN(8))
    {
        pg8::Gemm g{U, WDN, MTOK, DM, DFF, DFF, DFF}; pg8::StaticOrder S; S.init(MTOK, DM, F.G, (int)blockIdx.x);
        pg8::EpiSS E{H, SS3, LDH, 1.0f / 64.0f};
        pg8::gemm_phase<pg8::EpiSS, pg8::StaticOrder, true, true, 1, true>(F.lds + RING_OFF, g, S, E);
    }
#endif
    SEAM(8);

#if !defined(SKIP_P9)
    if (IN(9))
    {
        f32x4 g1[4];
#pragma unroll
        for (int j = 0; j < 4; ++j) g1[j] = ((const GAS f32x4*)g_post_mlp)[F.lane + 64 * j];
        f32x4 ca, cb, cc, cd; unsigned long long cy[4], cq[4];
#define P9_LOAD(A, B, C, D, Yv, Q, mm) do { const GAS f32x4* sp_ = (const GAS f32x4*)(SS3 + (size_t)(mm) * 16); A = sp_[0]; B = sp_[1]; C = sp_[2]; D = sp_[3]; \
            const GAS unsigned long long* yr_ = (const GAS unsigned long long*)(H + (size_t)(mm) * LDH) + F.lane; const GAS unsigned long long* xq_ = (const GAS unsigned long long*)(X1B + (size_t)(mm) * DM) + F.lane; \
            _Pragma("unroll") for (int j = 0; j < 4; ++j) { Yv[j] = yr_[64 * j]; Q[j] = xq_[64 * j]; } } while (0)
        if (gw < MTOK) P9_LOAD(ca, cb, cc, cd, cy, cq, gw);
        for (int m = gw; m < MTOK; m += NGW) {
            f32x4 na, nb, nc, nd; unsigned long long ny[4], nq[4];
            const bool more = m + NGW < MTOK;
            if (more) P9_LOAD(na, nb, nc, nd, ny, nq, m + NGW);
            const f32x4 a = ca, b = cb, c = cc, d = cd;
            const float ssy = (((a.x + a.y) + (a.z + a.w)) + ((b.x + b.y) + (b.z + b.w))) + (((c.x + c.y) + (c.z + c.w)) + ((d.x + d.y) + (d.z + d.w)));
            const float rsy = 1.f / sqrtf(ssy * (1.f / DM) + EPS);
            GAS f32x4* o4 = (GAS f32x4*)(out + (size_t)m * DM) + F.lane;
#pragma unroll
            for (int j = 0; j < 4; ++j) { const unsigned long long yw = cy[j]; const unsigned lo = (unsigned)yw, hi = (unsigned)(yw >> 32);
                const f32x4 yv = (f32x4){__uint_as_float(lo << 16), __uint_as_float(lo & 0xffff0000u), __uint_as_float(hi << 16), __uint_as_float(hi & 0xffff0000u)};
                const unsigned long long xw = cq[j]; const unsigned xl = (unsigned)xw, xh = (unsigned)(xw >> 32);
                const f32x4 xv = (f32x4){__uint_as_float(xl << 16), __uint_as_float(xl & 0xffff0000u), __uint_as_float(xh << 16), __uint_as_float(xh & 0xffff0000u)};
                o4[64 * j] = xv + yv * rsy * g1[j]; }
            if (more) { ca = na; cb = nb; cc = nc; cd = nd;
#pragma unroll
                for (int j = 0; j < 4; ++j) { cy[j] = ny[j]; cq[j] = nq[j]; } }
        }
#undef P9_LOAD
    }
#endif
}

extern "C" void kernel_launch(void* const* d_in, const int* in_sizes, int n_in, void* d_out, int out_size, void* d_ws, size_t ws_size, hipStream_t stream) {
    static int grid = 0;
    if (grid == 0) {
        if (n_in != 17 || in_sizes[0] != MTOK * DM || out_size != MTOK * DM || ws_size < WS_END) { fprintf(stderr, "kernel_launch: unexpected shapes (n_in %d, in0 %d, out %d, ws %zu); nothing launched\n", n_in, n_in > 0 ? in_sizes[0] : -1, out_size, ws_size); grid = -1; return; }
        int dev = 0, cus = 0, per_cu = 0;
        if (hipGetDevice(&dev) != hipSuccess || hipDeviceGetAttribute(&cus, hipDeviceAttributeMultiprocessorCount, dev) != hipSuccess) { fprintf(stderr, "kernel_launch: device query failed\n"); grid = -1; return; }
        if (hipFuncSetAttribute((const void*)block_fwd, hipFuncAttributeMaxDynamicSharedMemorySize, LDS_BYTES) != hipSuccess) { fprintf(stderr, "kernel_launch: hipFuncSetAttribute failed\n"); grid = -1; return; }
        if (hipOccupancyMaxActiveBlocksPerMultiprocessor(&per_cu, (const void*)block_fwd, NWAVES * 64, LDS_BYTES) != hipSuccess || per_cu < 1) { fprintf(stderr, "kernel_launch: occupancy query reports %d workgroups per CU\n", per_cu); }
        (void)hipGetLastError();
        grid = cus;
    }
    if (grid < 0) return;
    if (hipMemsetAsync((char*)d_ws + WS_CTL, 0, CTL_ZERO_BYTES, stream) != hipSuccess) { fprintf(stderr, "kernel_launch: hipMemsetAsync failed\n"); return; }
    Args a{};
    for (int i = 0; i < 17; ++i) a.in[i] = (const float*)d_in[i];
    a.out = (float*)d_out; a.ws = (unsigned char*)d_ws;
    a.ph_lo = 0; a.ph_hi = 10; a.li = 0;
    hipLaunchKernelGGL(block_fwd, dim3(grid), dim3(NWAVES * 64), LDS_BYTES, stream, a);
    const hipError_t le = hipPeekAtLastError();
    if (le != hipSuccess) fprintf(stderr, "kernel_launch: launch failed: %s\n", hipGetErrorName(le));
}
```

```cpp
#include <hip/hip_runtime.h>
#include <hip/hip_bf16.h>
#include <cstdio>
#include <cstdint>
#include <cmath>
constexpr int NB = 32, SEQ = 2048, DM = 1024, MTOK = NB * SEQ;
constexpr int NHEAD = 8, HD = 64, AW = NHEAD * HD;
constexpr int QLORA = 384, KVLORA = 256, RDIM = 32, QKB = 96;
constexpr int DFF = 4096, INW = 4256, INWP = 4352;
constexpr int LDH = DM, LDU = DFF, LDKV = KVLORA;
constexpr float EPS = 1e-6f;
constexpr float LOG2E = 1.4426950408889634f;
constexpr float C2A = 0.125f * LOG2E;
constexpr float C2B = 0.10206207261596575f * LOG2E;
typedef float f32x2g __attribute__((ext_vector_type(2)));
namespace pg8 {
#define PG8_LAS __attribute__((address_space(3)))
typedef unsigned short bf16_t;
typedef short bf16x8 __attribute__((ext_vector_type(8)));
typedef float f32x4 __attribute__((ext_vector_type(4)));
typedef unsigned u32x4 __attribute__((ext_vector_type(4)));
constexpr int BM = 256, BK = 64, HALF = 128, HTB = HALF * BK * 2  , STAGE_BYTES = 8 * HTB, NXCD = 8, WGM = 8;

__host__ __device__ __forceinline__ int lds_byte(int r, int c) { const int st = (r >> 4) * 2 + (c >> 5), rr = r & 15, cc = c & 31, ob = rr * 64 + cc * 2; return st * 1024 + (ob ^ (((ob >> 9) & 1) << 5)); }
__host__ __device__ __forceinline__ void stage_rc(int b, int& R, int& C) { const int st = b / 1024, sb = b % 1024, swz = sb ^ (((sb >> 9) & 1) << 5); R = (st >> 1) * 16 + swz / 64; C = (st & 1) * 32 + (swz % 64) / 2; }
__host__ __device__ __forceinline__ int perm32(int rho) { const int n = rho >> 4, i = rho & 15; return 8 * (i >> 2) + 4 * n + (i & 3); }

struct Unit { int pm, pn; };
struct Gemm { const bf16_t* A; const bf16_t* Bt; int M, N, K, lda, ldb; };

struct StaticOrder {
    int nM, nN, nwg, G, c;
    __host__ __device__ void init(int M, int N, int G_, int c_) { nM = M / BM; nN = N / BM; nwg = nM * nN; G = G_; c = c_; }
    __host__ __device__ bool next(int i, Unit& u) const {
        const long L = (long)i * G + c; if (L >= nwg) return false;
        int wgid = (int)L; { const int q = nwg / NXCD, r = nwg % NXCD, xcd = wgid % NXCD, off = wgid / NXCD; wgid = (xcd < r ? xcd * (q + 1) : r * (q + 1) + (xcd - r) * q) + off; }
        const int nig = WGM * nN, gid = wgid / nig, fm = gid * WGM, gsz = (nM - fm) < WGM ? (nM - fm) : WGM;
        u.pm = fm + ((wgid % nig) % gsz); u.pn = (wgid % nig) / gsz; return true;
    }
    __device__ __forceinline__ void a_ready(const Unit&) const {}
    __device__ __forceinline__ void done(const Unit&) const {}
};

__device__ __forceinline__ unsigned cvt_pk_bf16(float lo, float hi) { unsigned r; asm volatile("v_cvt_pk_bf16_f32 %0, %1, %2" : "=v"(r) : "v"(lo), "v"(hi)); return r; }
__device__ __forceinline__ void ld8(float (&v)[8], const f32x4& a, const f32x4& b) { v[0] = a[0]; v[1] = a[1]; v[2] = a[2]; v[3] = a[3]; v[4] = b[0]; v[5] = b[1]; v[6] = b[2]; v[7] = b[3]; }
typedef float f32x2c_t __attribute__((ext_vector_type(2))); typedef __bf16 bf16x2c_t __attribute__((ext_vector_type(2)));
__device__ __forceinline__ unsigned cvtpk_c(float lo, float hi) { const f32x2c_t v = {lo, hi}; const bf16x2c_t b = __builtin_convertvector(v, bf16x2c_t); return __builtin_bit_cast(unsigned, b); }
__device__ __forceinline__ u32x4 pack8(const float (&v)[8]) { u32x4 w; w.x = cvtpk_c(v[0], v[1]); w.y = cvtpk_c(v[2], v[3]); w.z = cvtpk_c(v[4], v[5]); w.w = cvtpk_c(v[6], v[7]); return w; }
__device__ __forceinline__ void unpack8(const u32x4 w, float (&v)[8]) {
    v[0] = __uint_as_float(w.x << 16); v[1] = __uint_as_float(w.x & 0xffff0000u); v[2] = __uint_as_float(w.y << 16); v[3] = __uint_as_float(w.y & 0xffff0000u);
    v[4] = __uint_as_float(w.z << 16); v[5] = __uint_as_float(w.z & 0xffff0000u); v[6] = __uint_as_float(w.w << 16); v[7] = __uint_as_float(w.w & 0xffff0000u); }
__device__ __forceinline__ void rope4(float (&v)[8], const f32x4 a, const f32x4 b) {
    float x1, x2;
    x1 = v[0]; x2 = v[1]; v[0] = x1 * a[0] - x2 * a[1]; v[1] = x2 * a[0] + x1 * a[1];
    x1 = v[2]; x2 = v[3]; v[2] = x1 * a[2] - x2 * a[3]; v[3] = x2 * a[2] + x1 * a[3];
    x1 = v[4]; x2 = v[5]; v[4] = x1 * b[0] - x2 * b[1]; v[5] = x2 * b[0] + x1 * b[1];
    x1 = v[6]; x2 = v[7]; v[6] = x1 * b[2] - x2 * b[3]; v[7] = x2 * b[2] + x1 * b[3];
}
__device__ __forceinline__ float sumsq8(const float (&v)[8]) { return ((v[0] * v[0] + v[1] * v[1]) + (v[2] * v[2] + v[3] * v[3])) + ((v[4] * v[4] + v[5] * v[5]) + (v[6] * v[6] + v[7] * v[7])); }
__device__ __forceinline__ float red_fq(float s) { s += __shfl_xor(s, 16); s += __shfl_xor(s, 32); return s; }

__device__ __forceinline__ size_t chk_off(int r16, int c32, int ld) { return (size_t)r16 * ld + (size_t)c32 * 16; }
__device__ __forceinline__ size_t gfrag_off(int pm, int t8, int wid, int grp, int lane) { return ((((size_t)(pm * 8 + t8) * 8 + wid) * 16 + grp) * 64 + lane) * 8; }
struct EpiIn {
    static constexpr bool PERM = true, AFTER_DRAIN = false; static constexpr int MIDT = 0;
    bf16_t *QA, *KA, *VA, *CQ, *CKV, *KR, *G; float* SS; const float* ropeA; const float* ropeB; const float* bgate;
    __device__ __forceinline__ void operator()(const f32x4 (&acc)[2][2][4][2], const Unit& u, int wr, int wc, int fr, int fq) const {
        asm volatile("" : "+v"(fr), "+v"(fq));
        const int row0 = u.pm * BM + wr * 64 + fr, pn = u.pn, cl = wc * 32 + 8 * fq;
        if (pn < 4) {
            bf16_t* dst = (pn < 2) ? QA : KA; const float sc = (pn < 2) ? C2A : 1.f; const int cb = (pn & 1) * 256 + wc * 32, l8 = (fq * 16 + fr) * 8;
            if ((wc & 1) == 0) {
                const bool rp = fq < 2;
#pragma unroll
                for (int ai = 0; ai < 2; ++ai)
#pragma unroll
                    for (int m = 0; m < 4; ++m) { const int row = row0 + ai * HALF + m * 16;
                        const f32x4* t = (const f32x4*)(ropeA + (size_t)row * 16 + (rp ? fq * 8 : 0));
                        f32x4 ca = t[0], cc = t[1]; if (!rp) { ca = (f32x4){1.f, 0.f, 1.f, 0.f}; cc = ca; }
#pragma unroll
                        for (int bj = 0; bj < 2; ++bj) { float v[8]; ld8(v, acc[ai][bj][m][0], acc[ai][bj][m][1]); rope4(v, ca, cc);
#pragma unroll
                            for (int j = 0; j < 8; ++j) v[j] *= sc;
                            *(u32x4*)(dst + chk_off(row - fr, cb + bj * HALF, AW) + l8) = pack8(v); } }
            } else {
#pragma unroll
                for (int ai = 0; ai < 2; ++ai)
#pragma unroll
                    for (int m = 0; m < 4; ++m) { const int row = row0 + ai * HALF + m * 16;
#pragma unroll
                        for (int bj = 0; bj < 2; ++bj) { float v[8]; ld8(v, acc[ai][bj][m][0], acc[ai][bj][m][1]);
#pragma unroll
                            for (int j = 0; j < 8; ++j) v[j] *= sc;
                            *(u32x4*)(dst + chk_off(row - fr, cb + bj * HALF, AW) + l8) = pack8(v); } }
            }
        } else if (pn < 6) {
            const int cb = (pn - 4) * 256 + wc * 32, l8 = (fq * 16 + fr) * 8;
#pragma unroll
            for (int ai = 0; ai < 2; ++ai)
#pragma unroll
                for (int m = 0; m < 4; ++m) { const int row = row0 + ai * HALF + m * 16;
#pragma unroll
                    for (int bj = 0; bj < 2; ++bj) { float v[8]; ld8(v, acc[ai][bj][m][0], acc[ai][bj][m][1]); *(u32x4*)(VA + chk_off(row - fr, cb + bj * HALF, AW) + l8) = pack8(v); } }
        } else if (pn == 6 || pn == 8) {
            bf16_t* dst = (pn == 6) ? CQ : CKV; const int ld = (pn == 6) ? QLORA : LDKV, slot = ((pn == 6) ? 0 : 8) + wc;
#pragma unroll
            for (int ai = 0; ai < 2; ++ai)
#pragma unroll
                for (int m = 0; m < 4; ++m) { const int row = row0 + ai * HALF + m * 16; float s = 0.f;
#pragma unroll
                    for (int bj = 0; bj < 2; ++bj) { float v[8]; ld8(v, acc[ai][bj][m][0], acc[ai][bj][m][1]); s += sumsq8(v); *(u32x4*)(dst + chk_off(row - fr, wc * 32 + bj * HALF, ld) + (fq * 16 + fr) * 8) = pack8(v); }
                    s = red_fq(s); if (fq == 0) SS[(size_t)row * 12 + slot] = s; }
        } else if (pn == 7) {
#pragma unroll
            for (int ai = 0; ai < 2; ++ai)
#pragma unroll
                for (int m = 0; m < 4; ++m) { const int row = row0 + ai * HALF + m * 16;
                    { float v[8]; ld8(v, acc[ai][0][m][0], acc[ai][0][m][1]); float s = red_fq(sumsq8(v)); *(u32x4*)(CQ + chk_off(row - fr, 256 + wc * 32, QLORA) + (fq * 16 + fr) * 8) = pack8(v); if (fq == 0) SS[(size_t)row * 12 + 4 + wc] = s; }
                    if (wc == 0) { float v[8]; ld8(v, acc[ai][1][m][0], acc[ai][1][m][1]); const f32x4* t = (const f32x4*)(ropeB + (size_t)row * 32 + fq * 8); rope4(v, t[0], t[1]);
                        *(u32x4*)(KR + chk_off(row - fr, 0, RDIM) + (fq * 16 + fr) * 8) = pack8(v); } }
        }
    }
};
struct EpiGates {
    static constexpr bool PERM = true, AFTER_DRAIN = false; static constexpr int MIDT = 0;
    bf16_t* G; const float* bgate;
    __device__ __forceinline__ void operator()(const f32x4 (&acc)[2][2][4][2], const Unit& u, int wr, int wc, int fr, int fq) const {
        asm volatile("" : "+v"(fr), "+v"(fq));
        const int gc = u.pn * 256 + wc * 32 + 8 * fq;
        f32x4 bv[2][2];
#pragma unroll
        for (int bj = 0; bj < 2; ++bj)
#pragma unroll
            for (int n = 0; n < 2; ++n) bv[bj][n] = *(const f32x4*)(bgate + gc + bj * HALF + 4 * n);
#pragma unroll
        for (int ai = 0; ai < 2; ++ai)
#pragma unroll
            for (int m = 0; m < 4; ++m) {
#pragma unroll
                for (int bj = 0; bj < 2; ++bj) { float v[8]; ld8(v, acc[ai][bj][m][0] * (1.0f / 32.0f) + bv[bj][0], acc[ai][bj][m][1] * (1.0f / 32.0f) + bv[bj][1]);
#pragma unroll
                    for (int j = 0; j < 8; ++j) v[j] = __builtin_amdgcn_rcpf(1.f + __builtin_amdgcn_exp2f(-LOG2E * v[j]));
                    *(u32x4*)(G + gfrag_off(u.pm, u.pn, wr * 4 + wc, ai * 8 + m * 2 + bj, fq * 16 + fr)) = pack8(v); } }
    }
};
struct EpiQ {
    static constexpr bool PERM = true, AFTER_DRAIN = false; static constexpr int MIDT = 0;
    bf16_t* QB; const float* SS; const float* ropeB;
    __device__ __forceinline__ void operator()(const f32x4 (&acc)[2][2][4][2], const Unit& u, int wr, int wc, int fr, int fq) const {
        asm volatile("" : "+v"(fr), "+v"(fq));
        const int row0 = u.pm * BM + wr * 64 + fr, cl = u.pn * BM + wc * 32 + 8 * fq;
        const int c0 = cl, c1 = cl + HALF, h0 = c0 / QKB, h1 = c1 / QKB, p0 = c0 - h0 * QKB, p1 = c1 - h1 * QKB;
        const bool r0 = p0 >= 64, r1 = p1 >= 64; const int roff = r0 ? p0 - 64 : (r1 ? p1 - 64 : 0);
#pragma unroll
        for (int b = 0; b < 2; ++b) {
            f32x4 s0[4], s1[4], ta[4], tb[4];
#pragma unroll
            for (int m = 0; m < 4; ++m) { const int row = row0 + b * HALF + m * 16;
                const f32x4* sp = (const f32x4*)(SS + (size_t)row * 12); s0[m] = sp[0]; s1[m] = sp[1];
                const f32x4* t = (const f32x4*)(ropeB + (size_t)row * 32 + roff); ta[m] = t[0]; tb[m] = t[1]; }
            asm volatile("" ::: "memory");
#pragma unroll
            for (int m = 0; m < 4; ++m) { const int row = row0 + b * HALF + m * 16;
                const float ss = ((s0[m][0] + s0[m][1]) + (s0[m][2] + s0[m][3])) + ((s1[m][0] + s1[m][1]) + (s1[m][2] + s1[m][3]));
                const float rs = __builtin_amdgcn_rsqf(ss * (1.0f / QLORA) + EPS) * C2B;
#pragma unroll
                for (int bj = 0; bj < 2; ++bj) { float v[8]; ld8(v, acc[b][bj][m][0], acc[b][bj][m][1]);
#pragma unroll
                    for (int j = 0; j < 8; ++j) v[j] *= rs;
                    if (bj == 0 ? r0 : r1) rope4(v, ta[m], tb[m]);
                    *(u32x4*)(QB + chk_off(row - fr, (bj == 0 ? c0 : c1) - 8 * fq, NHEAD * QKB) + (fq * 16 + fr) * 8) = pack8(v); } }
        }
    }
};
struct EpiKV {
    static constexpr bool PERM = true, AFTER_DRAIN = false; static constexpr int MIDT = 0;
    bf16_t *KB, *VB; const float* SS;
    __device__ __forceinline__ void operator()(const f32x4 (&acc)[2][2][4][2], const Unit& u, int wr, int wc, int fr, int fq) const {
        asm volatile("" : "+v"(fr), "+v"(fq));
        const int row0 = u.pm * BM + wr * 64 + fr;
        bf16_t* dst = (wc < 2) ? KB : VB; const int pc = (wc & 1) * 32, l8 = (fq * 16 + fr) * 8;
        f32x4 s0[2][4];
#pragma unroll
        for (int ai = 0; ai < 2; ++ai)
#pragma unroll
            for (int m = 0; m < 4; ++m) s0[ai][m] = *(const f32x4*)(SS + (size_t)(row0 + ai * HALF + m * 16) * 12 + 8);
#pragma unroll
        for (int ai = 0; ai < 2; ++ai)
#pragma unroll
            for (int m = 0; m < 4; ++m) { const int row = row0 + ai * HALF + m * 16; const f32x4 sv = s0[ai][m];
                const float rs = __builtin_amdgcn_rsqf(((sv[0] + sv[1]) + (sv[2] + sv[3])) * (1.0f / KVLORA) + EPS);
#pragma unroll
                for (int bj = 0; bj < 2; ++bj) { const int hd = u.pn * 2 + bj;
                    float v[8]; ld8(v, acc[ai][bj][m][0], acc[ai][bj][m][1]);
#pragma unroll
                    for (int j = 0; j < 8; ++j) v[j] *= rs;
                    *(u32x4*)(dst + chk_off(row - fr, hd * HD + pc, AW) + l8) = pack8(v); } }
    }
};
struct EpiMerge {
    static constexpr bool PERM = true, AFTER_DRAIN = false; static constexpr int MIDT = 8;
    const bf16_t* G; bf16_t* T;
    __device__ __forceinline__ void mid(f32x4 (&acc)[2][2][4][2], const Unit& u, int wr, int wc, int fr, int fq) const {
        asm volatile("" : "+v"(fr), "+v"(fq));
        const bf16_t* pa = G + gfrag_off(u.pm, u.pn, wr * 4 + wc, 0, fq * 16 + fr); const bf16_t* pb = G + gfrag_off(u.pm, 4 + u.pn, wr * 4 + wc, 0, fq * 16 + fr);
        u32x4 ca[4], cb[4], na[4], nb[4];
#pragma unroll
        for (int i = 0; i < 4; ++i) { ca[i] = *(const u32x4*)(pa + (size_t)i * 512); cb[i] = *(const u32x4*)(pb + (size_t)i * 512); }
#pragma unroll
        for (int b = 0; b < 4; ++b) {
            if (b < 3) {
#pragma unroll
                for (int i = 0; i < 4; ++i) { na[i] = *(const u32x4*)(pa + (size_t)((b + 1) * 4 + i) * 512); nb[i] = *(const u32x4*)(pb + (size_t)((b + 1) * 4 + i) * 512); } }
            asm volatile("" ::: "memory");
#pragma unroll
            for (int i = 0; i < 4; ++i) { const int grp = b * 4 + i, ai = grp >> 3, m = (grp >> 1) & 3, bj = grp & 1; float ga[8], gb[8]; unpack8(ca[i], ga); unpack8(cb[i], gb);
#pragma unroll
                for (int j = 0; j < 8; ++j) ga[j] *= __builtin_amdgcn_rcpf(__builtin_fmaxf(gb[j], 1e-30f));
                acc[ai][bj][m][0] *= (f32x4){ga[0], ga[1], ga[2], ga[3]}; acc[ai][bj][m][1] *= (f32x4){ga[4], ga[5], ga[6], ga[7]}; }
#pragma unroll
            for (int i = 0; i < 4; ++i) { ca[i] = na[i]; cb[i] = nb[i]; }
        }
    }
    __device__ __forceinline__ void operator()(const f32x4 (&acc)[2][2][4][2], const Unit& u, int wr, int wc, int fr, int fq) const {
        asm volatile("" : "+v"(fr), "+v"(fq));
        unsigned char* base = (unsigned char*)T + ((size_t)(u.pm * 16 + wr * 4) * 16 + u.pn * 4 + wc) * 1024 + (unsigned)(fq * 16 + fr) * 16u;
        const bf16_t* pb = G + gfrag_off(u.pm, 4 + u.pn, wr * 4 + wc, 0, fq * 16 + fr);
        u32x4 cb[8], nb[8];
#pragma unroll
        for (int i = 0; i < 8; ++i) cb[i] = *(const u32x4*)(pb + (size_t)i * 512);
#pragma unroll
        for (int b = 0; b < 2; ++b) {
            if (b < 1) {
#pragma unroll
                for (int i = 0; i < 8; ++i) nb[i] = *(const u32x4*)(pb + (size_t)(8 + i) * 512); }
            asm volatile("" ::: "memory");
#pragma unroll
            for (int i2 = 0; i2 < 4; ++i2) { int w[4];
#pragma unroll
                for (int bj = 0; bj < 2; ++bj) { const int i = 2 * i2 + bj, grp = b * 8 + i, ai = grp >> 3, m = (grp >> 1) & 3; float v[8], gb[8]; ld8(v, acc[ai][bj][m][0], acc[ai][bj][m][1]); unpack8(cb[i], gb);
#pragma unroll
                    for (int j = 0; j < 8; ++j) v[j] = __builtin_fminf(__builtin_fmaxf(v[j] * (64.f * __builtin_fmaxf(gb[j], 1e-30f)), -448.f), 448.f);
                    int w0 = 0, w1 = 0;
                    w0 = __builtin_amdgcn_cvt_pk_fp8_f32(v[0], v[1], w0, false); w0 = __builtin_amdgcn_cvt_pk_fp8_f32(v[2], v[3], w0, true);
                    w1 = __builtin_amdgcn_cvt_pk_fp8_f32(v[4], v[5], w1, false); w1 = __builtin_amdgcn_cvt_pk_fp8_f32(v[6], v[7], w1, true);
                    w[2 * bj] = w0; w[2 * bj + 1] = w1; }
                typedef int i32x4m_ __attribute__((ext_vector_type(4)));
                *(i32x4m_*)(base + (size_t)(b * 8 + i2) * 16384) = (i32x4m_){w[0], w[1], w[2], w[3]}; }
#pragma unroll
            for (int i = 0; i < 8; ++i) cb[i] = nb[i];
        }
    }
};
struct EpiSS {
    static constexpr bool PERM = true, AFTER_DRAIN = false; static constexpr int MIDT = 0;
    bf16_t* Y; float* SSY; int ldy; float scale;
    __device__ __forceinline__ void operator()(const f32x4 (&acc)[2][2][4][2], const Unit& u, int wr, int wc, int fr, int fq) const {
        asm volatile("" : "+v"(fr), "+v"(fq));
        const int row0 = u.pm * BM + wr * 64 + fr, cl = u.pn * BM + wc * 32 + 8 * fq;
#pragma unroll
        for (int ai = 0; ai < 2; ++ai)
#pragma unroll
            for (int m = 0; m < 4; ++m) { const int row = row0 + ai * HALF + m * 16; float s = 0.f;
#pragma unroll
                for (int bj = 0; bj < 2; ++bj) { float v[8]; ld8(v, acc[ai][bj][m][0] * scale, acc[ai][bj][m][1] * scale); s += sumsq8(v); *(u32x4*)(Y + (size_t)row * ldy + cl + bj * HALF) = pack8(v); }
                s = red_fq(s); if (fq == 0) SSY[(size_t)row * 16 + u.pn * 4 + wc] = s; }
    }
};
struct EpiRelu2F8 {
    static constexpr bool PERM = true, AFTER_DRAIN = false; static constexpr int MIDT = 0;
    unsigned char* U; float scale;
    __device__ __forceinline__ void operator()(const f32x4 (&acc)[2][2][4][2], const Unit& u, int wr, int wc, int fr, int fq) const {
        asm volatile("" : "+v"(fr), "+v"(fq));
        unsigned char* base = U + ((size_t)(u.pm * 16 + wr * 4) * 64 + u.pn * 4 + wc) * 1024 + (unsigned)(fq * 16 + fr) * 16u;
#pragma unroll
        for (int ai = 0; ai < 2; ++ai)
#pragma unroll
            for (int m = 0; m < 4; ++m) { int w[4];
#pragma unroll
                for (int bj = 0; bj < 2; ++bj) { float v[8]; ld8(v, acc[ai][bj][m][0], acc[ai][bj][m][1]);
#pragma unroll
                    for (int j = 0; j < 8; ++j) { const float r = __builtin_fmaxf(v[j] * scale, 0.f); v[j] = __builtin_fminf(r * r, 440.f); }
                    int w0 = 0, w1 = 0;
                    w0 = __builtin_amdgcn_cvt_pk_fp8_f32(v[0], v[1], w0, false); w0 = __builtin_amdgcn_cvt_pk_fp8_f32(v[2], v[3], w0, true);
                    w1 = __builtin_amdgcn_cvt_pk_fp8_f32(v[4], v[5], w1, false); w1 = __builtin_amdgcn_cvt_pk_fp8_f32(v[6], v[7], w1, true);
                    w[2 * bj] = w0; w[2 * bj + 1] = w1; }
                typedef int i32x4e_ __attribute__((ext_vector_type(4)));
                *(i32x4e_*)(base + (size_t)(ai * 8 + m) * 65536) = (i32x4e_){w[0], w[1], w[2], w[3]}; }
    }
};
struct EpiRelu2 {
    static constexpr bool PERM = true, AFTER_DRAIN = false; static constexpr int MIDT = 0;
    bf16_t* U;
    __device__ __forceinline__ void operator()(const f32x4 (&acc)[2][2][4][2], const Unit& u, int wr, int wc, int fr, int fq) const {
        asm volatile("" : "+v"(fr), "+v"(fq));
        const int row0 = u.pm * BM + wr * 64 + fr, cl = u.pn * BM + wc * 32 + 8 * fq;
#pragma unroll
        for (int ai = 0; ai < 2; ++ai)
#pragma unroll
            for (int m = 0; m < 4; ++m) { const int row = row0 + ai * HALF + m * 16;
#pragma unroll
                for (int bj = 0; bj < 2; ++bj) { float v[8]; ld8(v, acc[ai][bj][m][0], acc[ai][bj][m][1]);
#pragma unroll
                    for (int j = 0; j < 8; ++j) { const float r = __builtin_fmaxf(v[j], 0.f); v[j] = r * r; }
                    *(u32x4*)(U + (size_t)row * LDU + cl + bj * HALF) = pack8(v); } }
    }
};
template <class Epi, class Sched, bool ALIGN_EPI = false, bool SP2 = false, int ESZ = 2, bool ACH = false>
__device__ __forceinline__ void gemm_phase(PG8_LAS unsigned char* lds, const Gemm g, const Sched& S, const Epi& E) {
    int tid_ = threadIdx.x; asm volatile("" : "+v"(tid_));
    const int tid = tid_, wid = __builtin_amdgcn_readfirstlane(tid >> 6), lane = tid & 63, wr = wid >> 2, wc = wid & 3, fr = lane & 15, fq = lane >> 4;
    const int K = g.K, nt = K * ESZ / (BK * 2), lda = g.lda ? g.lda : K, ldb = g.ldb ? g.ldb : K;
    unsigned voffA[2], voffB[2];
#pragma unroll
    for (int i = 0; i < 2; ++i) { int R, C; stage_rc(tid * 16 + i * 8192, R, C); const int Rb = Epi::PERM ? ((R & ~31) + perm32(R & 31)) : R;
        if constexpr (ACH) { const int st_ = (tid >> 6) + 8 * i; voffA[i] = (unsigned)((st_ >> 1) * 16 * lda * ESZ + (st_ & 1) * 1024 + (tid & 63) * 16); } else voffA[i] = (unsigned)(R * lda * ESZ + C * 2);
        voffB[i] = (unsigned)(Rb * ldb * ESZ + C * 2); }
    const size_t kstepB = (size_t)(BK * 2), kstepA = ACH ? (size_t)2048 : kstepB;
    const size_t hstepA = (size_t)HALF * lda * ESZ, hstepB = (size_t)HALF * ldb * ESZ;
    const size_t tstepA = 2 * hstepA, tstepB = 2 * hstepB;
    const unsigned ldsw = (unsigned)wid * 1024u;
    const int aoff = ACH ? wr * 8192 + lane * 16 : lds_byte(wr * 64 + fr, fq * 8), boff = lds_byte(wc * 32 + fr, fq * 8);
#define PG8_SA(b, h) (((b) * 2 + (h)) * HTB)
#define PG8_SB(b, h) ((4 + (b) * 2 + (h)) * HTB)
#define PG8_STAGE(bufoff, gbase, voff) do { _Pragma("unroll") for (int _i = 0; _i < 2; ++_i) \
        __builtin_amdgcn_global_load_lds((const unsigned*)((const char*)(gbase) + (voff)[_i]), (PG8_LAS unsigned*)(lds + (bufoff) + ldsw + _i * 8192), 16, 0, 0); } while (0)
#define PG8_LDA(dst, b, h) do { if constexpr (ESZ == 2) { _Pragma("unroll") for (int m = 0; m < 4; ++m) _Pragma("unroll") for (int k = 0; k < 2; ++k) dst[m][k] = *(const PG8_LAS bf16x8*)(lds + PG8_SA(b, h) + aoff + m * 2048 + k * 1024); } \
        else { _Pragma("unroll") for (int m = 0; m < 4; ++m) { dst##8[m].lo = *(const PG8_LAS i32x4_*)(lds + PG8_SA(b, h) + aoff + m * 2048); dst##8[m].hi = *(const PG8_LAS i32x4_*)(lds + PG8_SA(b, h) + aoff + m * 2048 + 1024); } } } while (0)
#define PG8_LDB(dst, b, h) do { if constexpr (ESZ == 2) { _Pragma("unroll") for (int n = 0; n < 2; ++n) _Pragma("unroll") for (int k = 0; k < 2; ++k) dst[n][k] = *(const PG8_LAS bf16x8*)(lds + PG8_SB(b, h) + boff + n * 2048 + k * 1024); } \
        else { _Pragma("unroll") for (int n = 0; n < 2; ++n) { dst##8[n].lo = *(const PG8_LAS i32x4_*)(lds + PG8_SB(b, h) + boff + n * 2048); dst##8[n].hi = *(const PG8_LAS i32x4_*)(lds + PG8_SB(b, h) + boff + n * 2048 + 1024); } } } while (0)
#define PG8_MMA(ai, bj, At, Bt) do { __builtin_amdgcn_s_setprio(1); \
        if constexpr (ESZ == 2) { _Pragma("unroll") for (int m = 0; m < 4; ++m) _Pragma("unroll") for (int n = 0; n < 2; ++n) _Pragma("unroll") for (int k = 0; k < 2; ++k) \
            acc[ai][bj][m][n] = __builtin_amdgcn_mfma_f32_16x16x32_bf16(Bt[n][k], At[m][k], acc[ai][bj][m][n], 0, 0, 0); } \
        else {   \
            _Pragma("unroll") for (int m = 0; m < 4; ++m) _Pragma("unroll") for (int n = 0; n < 2; ++n) \
                asm volatile("v_mfma_scale_f32_16x16x128_f8f6f4 %0, %1, %2, %0, %3, %3 op_sel_hi:[0,0,0]" : "+v"(acc[ai][bj][m][n]) : "v"(Bt##8[n]), "v"(At##8[m]), "v"(scl_)); } \
        __builtin_amdgcn_s_setprio(0); } while (0)
#define PG8_WAIT_V(n) asm volatile("s_waitcnt vmcnt(" #n ")" ::: "memory")
#define PG8_WAIT_L(n) asm volatile("s_waitcnt lgkmcnt(" #n ")" ::: "memory")
#define PG8_BAR __builtin_amdgcn_s_barrier()
#define PG8_SCHED __builtin_amdgcn_sched_barrier(0)
    Unit cur, nxt; int ui = 0;
    if (!S.next(0, cur)) return;
    f32x4 acc[2][2][4][2];
#pragma unroll
    for (int a = 0; a < 2; ++a)
#pragma unroll
        for (int b = 0; b < 2; ++b)
#pragma unroll
            for (int m = 0; m < 4; ++m)
#pragma unroll
                for (int n = 0; n < 2; ++n) acc[a][b][m][n] = (f32x4){0.f, 0.f, 0.f, 0.f};
    bf16x8 At[4][2], B0[2][2], B1[2][2];
    typedef int i32x4_ __attribute__((ext_vector_type(4))); typedef int i32x8_ __attribute__((ext_vector_type(8)));
    const int scl_ = 0x7F7F7F7F;
    i32x8_ At8[4], B08[2], B18[2];
    const char* cA = (const char*)g.A + (size_t)cur.pm * tstepA; const char* cB = (const char*)g.Bt + (size_t)cur.pn * tstepB;
    S.a_ready(cur);
    if constexpr (SP2) {
        PG8_STAGE(PG8_SB(0, 0), cB, voffB); PG8_STAGE(PG8_SB(0, 1), cB + hstepB, voffB); PG8_STAGE(PG8_SA(0, 0), cA, voffA); PG8_STAGE(PG8_SA(0, 1), cA + hstepA, voffA);
        if (wr == 1) PG8_BAR;
        PG8_WAIT_V(2); PG8_BAR;
        PG8_STAGE(PG8_SB(1, 0), cB + kstepB, voffB); PG8_STAGE(PG8_SA(1, 0), cA + kstepA, voffA); PG8_STAGE(PG8_SB(1, 1), cB + hstepB + kstepB, voffB);
        PG8_WAIT_V(6); PG8_BAR;
    } else {
        PG8_STAGE(PG8_SB(0, 0), cB, voffB); PG8_STAGE(PG8_SA(0, 0), cA, voffA); PG8_STAGE(PG8_SB(0, 1), cB + hstepB, voffB); PG8_STAGE(PG8_SA(0, 1), cA + hstepA, voffA);
        if (wr == 1) PG8_BAR;
        PG8_WAIT_V(4); PG8_BAR;
        PG8_STAGE(PG8_SB(1, 0), cB + kstepB, voffB); PG8_STAGE(PG8_SA(1, 0), cA + kstepA, voffA); PG8_STAGE(PG8_SB(1, 1), cB + hstepB + kstepB, voffB);
        PG8_WAIT_V(6); PG8_BAR;
    }
    for (;;) {
        const bool has_next = S.next(ui + 1, nxt);
        const char* nA = has_next ? (const char*)g.A + (size_t)nxt.pm * tstepA : cA; const char* nB = has_next ? (const char*)g.Bt + (size_t)nxt.pn * tstepB : cB;
#pragma unroll 1
        for (int t = 0; t < nt; t += 2) {
            if constexpr (Epi::MIDT > 0) { if (t == Epi::MIDT) E.mid(acc, cur, wr, wc, fr, fq); }
            const bool last = (t == nt - 2);
            const char* a1 = cA + (size_t)(t + 1) * kstepA;
            const char* a2 = last ? nA : cA + (size_t)(t + 2) * kstepA; const char* b2 = last ? nB : cB + (size_t)(t + 2) * kstepB;
            const char* a3 = a2 + kstepA; const char* b3 = b2 + kstepB;
            if (last && has_next) S.a_ready(nxt);
            if constexpr (SP2) {
            PG8_LDB(B0, 0, 0); PG8_LDB(B1, 0, 1); PG8_SCHED; PG8_LDA(At, 0, 0); PG8_STAGE(PG8_SA(1, 1), a1 + hstepA, voffA);
            PG8_WAIT_V(8); PG8_WAIT_L(0); PG8_BAR; PG8_MMA(0, 0, At, B0); PG8_MMA(0, 1, At, B1); PG8_BAR; PG8_SCHED;
            PG8_LDA(At, 0, 1); PG8_STAGE(PG8_SB(0, 0), b2, voffB); PG8_STAGE(PG8_SB(0, 1), b2 + hstepB, voffB); PG8_STAGE(PG8_SA(0, 0), a2, voffA);
            PG8_WAIT_V(8); PG8_WAIT_L(0); PG8_BAR; PG8_MMA(1, 0, At, B0); PG8_MMA(1, 1, At, B1); PG8_BAR; PG8_SCHED;
            PG8_LDB(B0, 1, 0); PG8_LDB(B1, 1, 1); PG8_SCHED; PG8_LDA(At, 1, 0); PG8_STAGE(PG8_SA(0, 1), a2 + hstepA, voffA);
            PG8_WAIT_V(8); PG8_WAIT_L(0); PG8_BAR; PG8_MMA(0, 0, At, B0); PG8_MMA(0, 1, At, B1); PG8_BAR; PG8_SCHED;
            PG8_LDA(At, 1, 1); PG8_STAGE(PG8_SB(1, 0), b3, voffB); PG8_STAGE(PG8_SB(1, 1), b3 + hstepB, voffB); PG8_STAGE(PG8_SA(1, 0), a3, voffA);
            PG8_WAIT_V(8); PG8_WAIT_L(0); PG8_BAR; PG8_MMA(1, 0, At, B0); PG8_MMA(1, 1, At, B1); PG8_BAR; PG8_SCHED;
            } else {
            PG8_LDB(B0, 0, 0); PG8_SCHED; PG8_LDA(At, 0, 0); PG8_STAGE(PG8_SA(1, 1), a1 + hstepA, voffA);
            PG8_WAIT_L(8); PG8_BAR; PG8_WAIT_L(0); PG8_MMA(0, 0, At, B0); PG8_BAR; PG8_SCHED;
            PG8_LDB(B1, 0, 1); PG8_STAGE(PG8_SB(0, 0), b2, voffB);
            PG8_BAR; PG8_WAIT_L(0); PG8_MMA(0, 1, At, B1); PG8_BAR;
            PG8_LDA(At, 0, 1); PG8_STAGE(PG8_SA(0, 0), a2, voffA);
            PG8_BAR; PG8_WAIT_L(0); PG8_MMA(1, 0, At, B0); PG8_BAR; PG8_SCHED;
            PG8_STAGE(PG8_SB(0, 1), b2 + hstepB, voffB);
            PG8_WAIT_V(6); PG8_BAR; PG8_MMA(1, 1, At, B1); PG8_BAR;
            PG8_LDB(B0, 1, 0); PG8_SCHED; PG8_LDA(At, 1, 0); PG8_STAGE(PG8_SA(0, 1), a2 + hstepA, voffA);
            PG8_WAIT_L(8); PG8_BAR; PG8_WAIT_L(0); PG8_MMA(0, 0, At, B0); PG8_BAR; PG8_SCHED;
            PG8_LDB(B1, 1, 1); PG8_STAGE(PG8_SB(1, 0), b3, voffB);
            PG8_BAR; PG8_WAIT_L(0); PG8_MMA(0, 1, At, B1); PG8_BAR;
            PG8_LDA(At, 1, 1); PG8_STAGE(PG8_SA(1, 0), a3, voffA);
            PG8_BAR; PG8_WAIT_L(0); PG8_MMA(1, 0, At, B0); PG8_BAR; PG8_SCHED;
            PG8_STAGE(PG8_SB(1, 1), b3 + hstepB, voffB);
            PG8_WAIT_V(6); PG8_BAR; PG8_MMA(1, 1, At, B1); PG8_BAR;
            }
        }
        if constexpr (ALIGN_EPI) { if (wr == 0) PG8_BAR; }
        if constexpr (ESZ == 1) asm volatile("s_nop 15\n\ts_nop 15" ::: "memory");
        if constexpr (!Epi::AFTER_DRAIN) { E(acc, cur, wr, wc, fr, fq); S.done(cur); }
        if (!has_next) break;
#pragma unroll
        for (int a = 0; a < 2; ++a)
#pragma unroll
            for (int b = 0; b < 2; ++b)
#pragma unroll
                for (int m = 0; m < 4; ++m)
#pragma unroll
                    for (int n = 0; n < 2; ++n) acc[a][b][m][n] = (f32x4){0.f, 0.f, 0.f, 0.f};
        cur = nxt; cA = nA; cB = nB; ++ui;
        if constexpr (ALIGN_EPI) { if (wr == 1) PG8_BAR; }
    }
    PG8_WAIT_V(0);
    if constexpr (!ALIGN_EPI) { if (wr == 0) PG8_BAR; }
    PG8_BAR;
    if constexpr (Epi::AFTER_DRAIN) { E.fused(acc, cur, wr, wc, fr, fq, lds, wid, lane); S.done(cur); }
#undef PG8_SA
#undef PG8_SB
#undef PG8_STAGE
#undef PG8_LDA
#undef PG8_LDB
#undef PG8_MMA
#undef PG8_WAIT_V
#undef PG8_WAIT_L
#undef PG8_BAR
#undef PG8_SCHED
}
}
#ifndef ATT_LSUM_MFMA
#define ATT_LSUM_MFMA 1
#endif
namespace att {
typedef unsigned short bf16_t;
typedef short bf16x8 __attribute__((ext_vector_type(8)));
typedef short s16x4 __attribute__((ext_vector_type(4)));
typedef float f32x16 __attribute__((ext_vector_type(16)));
typedef float f32x4 __attribute__((ext_vector_type(4)));
typedef unsigned u32x4 __attribute__((ext_vector_type(4)));
#define ALDS __attribute__((address_space(3)))
#define ASBAR() __builtin_amdgcn_sched_barrier(0)
constexpr int KTB = 12288, VTB = 8192;
constexpr int NSLOT = 3;
constexpr int L_K = 0, L_V = NSLOT * KTB, L_WS = L_V + NSLOT * VTB, L_OST = L_WS + 8 * 256, L_KM = L_OST + 8 * 4096, L_RED = L_KM + 2048, L_END = L_RED + 16384;
constexpr float THR = 8.f;
__device__ __forceinline__ int crow(int r, int hi) { return (r & 3) + 8 * (r >> 2) + 4 * hi; }
typedef float f32x2a_t __attribute__((ext_vector_type(2))); typedef __bf16 bf16x2a_t __attribute__((ext_vector_type(2)));
__device__ __forceinline__ unsigned cvtpk(float lo, float hi) { const f32x2a_t v = {lo, hi}; const bf16x2a_t b = __builtin_convertvector(v, bf16x2a_t); return __builtin_bit_cast(unsigned, b); }
__device__ __forceinline__ float bf2f(short s) { return __uint_as_float(((unsigned)(unsigned short)s) << 16); }
__device__ __forceinline__ int v_st(int k, int c) { const int kk = (k & ~0xC) | ((k & 4) << 1) | ((k & 8) >> 1); return ((kk >> 3) * 2 + (c >> 5)) * 512 + ((kk & 7) * 32 + (c & 31)) * 2; }
__device__ __forceinline__ int v_rd_base(int lane) { return ((lane & 3) << 3) | (((lane >> 2) & 3) << 6) | (((lane >> 4) & 1) << 5) | (((lane >> 5) & 1) << 8); }
constexpr int v_rd_off(int d0, int ks, int half) { return ks * 2048 + half * 1024 + d0 * 512; }
template <int OFF> __device__ __forceinline__ s16x4 tr_read(int vb) { s16x4 r; asm volatile("ds_read_b64_tr_b16 %0, %1 offset:%2" : "=&v"(r) : "v"(vb), "i"(OFF) : "memory"); return r; }
template <int D0> __device__ __forceinline__ void pv_one(f32x16& od, int vb, bf16x8 pa0, bf16x8 pa1, bf16x8 pa2, bf16x8 pa3) {
    const s16x4 l0 = tr_read<v_rd_off(D0, 0, 0)>(vb), h0 = tr_read<v_rd_off(D0, 0, 1)>(vb), l1 = tr_read<v_rd_off(D0, 1, 0)>(vb), h1 = tr_read<v_rd_off(D0, 1, 1)>(vb);
    const s16x4 l2 = tr_read<v_rd_off(D0, 2, 0)>(vb), h2 = tr_read<v_rd_off(D0, 2, 1)>(vb), l3 = tr_read<v_rd_off(D0, 3, 0)>(vb), h3 = tr_read<v_rd_off(D0, 3, 1)>(vb);
    asm volatile("s_waitcnt lgkmcnt(0)" ::: "memory"); ASBAR();
#define ATT_PK(L, H) (bf16x8){L[0], L[1], L[2], L[3], H[0], H[1], H[2], H[3]}
    od = __builtin_amdgcn_mfma_f32_32x32x16_bf16(pa0, ATT_PK(l0, h0), od, 0, 0, 0);
    od = __builtin_amdgcn_mfma_f32_32x32x16_bf16(pa1, ATT_PK(l1, h1), od, 0, 0, 0);
    od = __builtin_amdgcn_mfma_f32_32x32x16_bf16(pa2, ATT_PK(l2, h2), od, 0, 0, 0);
    od = __builtin_amdgcn_mfma_f32_32x32x16_bf16(pa3, ATT_PK(l3, h3), od, 0, 0, 0);
#undef ATT_PK
}
__device__ __forceinline__ void pv_all(f32x16* o, f32x16& ol, int vb, bf16x8 pa0, bf16x8 pa1, bf16x8 pa2, bf16x8 pa3) {
    pv_one<0>(o[0], vb, pa0, pa1, pa2, pa3); pv_one<1>(o[1], vb, pa0, pa1, pa2, pa3);
#if ATT_LSUM_MFMA
    const bf16x8 ones = (bf16x8){0x3F80, 0x3F80, 0x3F80, 0x3F80, 0x3F80, 0x3F80, 0x3F80, 0x3F80};
    ol = __builtin_amdgcn_mfma_f32_32x32x16_bf16(pa0, ones, ol, 0, 0, 0); ol = __builtin_amdgcn_mfma_f32_32x32x16_bf16(pa1, ones, ol, 0, 0, 0);
    ol = __builtin_amdgcn_mfma_f32_32x32x16_bf16(pa2, ones, ol, 0, 0, 0); ol = __builtin_amdgcn_mfma_f32_32x32x16_bf16(pa3, ones, ol, 0, 0, 0);
#endif
}
__device__ __forceinline__ void partialSM(f32x16& p0, f32x16& p1, float& m_ref, f32x16& negm, float& alpha) {
    float pmax = p0[0];
#pragma unroll
    for (int r = 1; r < 16; ++r) pmax = fmaxf(pmax, p0[r]);
#pragma unroll
    for (int r = 0; r < 16; ++r) pmax = fmaxf(pmax, p1[r]);
    { auto rr = __builtin_amdgcn_permlane32_swap(__float_as_uint(pmax), __float_as_uint(pmax), false, false); pmax = fmaxf(__uint_as_float(rr[0]), __uint_as_float(rr[1])); }
    alpha = 1.f;
    if (__builtin_expect(!__all(pmax <= THR), 0)) { const float dl = (pmax > THR) ? pmax : 0.f; m_ref += dl; alpha = __builtin_amdgcn_exp2f(-dl);
#pragma unroll
        for (int r = 0; r < 16; ++r) { p0[r] -= dl; p1[r] -= dl; negm[r] = -m_ref; } }
#pragma unroll
    for (int r = 0; r < 16; ++r) p0[r] = __builtin_amdgcn_exp2f(p0[r]);
}
__device__ __forceinline__ void finishSM(f32x16& p0, f32x16& p1, bf16x8& pa0, bf16x8& pa1, bf16x8& pa2, bf16x8& pa3, float& lsum) {
#pragma unroll
    for (int r = 0; r < 16; ++r) p1[r] = __builtin_amdgcn_exp2f(p1[r]);
#if !ATT_LSUM_MFMA
    { float ps = 0.f;
#pragma unroll
      for (int r = 0; r < 16; ++r) ps += p0[r];
#pragma unroll
      for (int r = 0; r < 16; ++r) ps += p1[r];
      lsum += ps; }
#endif
#define ATT_PK4(P, BASE, OUT) do { unsigned a0 = cvtpk(P[BASE + 0], P[BASE + 1]), a1 = cvtpk(P[BASE + 2], P[BASE + 3]);   \
    unsigned b0 = cvtpk(P[BASE + 4], P[BASE + 5]), b1 = cvtpk(P[BASE + 6], P[BASE + 7]);                              \
    auto r0 = __builtin_amdgcn_permlane32_swap(a0, b0, false, false); auto r1 = __builtin_amdgcn_permlane32_swap(a1, b1, false, false); \
    u32x4 w = {r0[0], r1[0], r0[1], r1[1]}; OUT = __builtin_bit_cast(bf16x8, w); } while (0)
    ATT_PK4(p0, 0, pa0); ATT_PK4(p0, 8, pa1); ATT_PK4(p1, 0, pa2); ATT_PK4(p1, 8, pa3);
#undef ATT_PK4
}
template <int ND> __device__ __forceinline__ void qkt(f32x16& p0, f32x16& p1, ALDS const char* Kb, const int (&ka)[ND], const bf16x8 (&qr)[ND], const f32x16& cinit) {
#pragma unroll
    for (int d0 = 0; d0 < ND; ++d0) {
        const bf16x8 b0 = *(ALDS const bf16x8*)(Kb + ka[d0]);
        const bf16x8 b1 = *(ALDS const bf16x8*)(Kb + ka[d0] + (d0 < 4 ? 4096 : 2048));
        p0 = __builtin_amdgcn_mfma_f32_32x32x16_bf16(b0, qr[d0], d0 == 0 ? cinit : p0, 0, 0, 0);
        p1 = __builtin_amdgcn_mfma_f32_32x32x16_bf16(b1, qr[d0], d0 == 0 ? cinit : p1, 0, 0, 0);
        if (ND > 4 && d0 == 2) asm volatile("" ::: "memory"); }
}
__device__ __forceinline__ void cmask(f32x16& p0, f32x16& p1, int jt, int qrel, int hi) {
    const float NEG = -INFINITY; const int thr = qrel - 64 * jt - 4 * hi;
#pragma unroll
    for (int r = 0; r < 16; ++r) { if ((r & 3) + 8 * (r >> 2) > thr) p0[r] = NEG; if ((r & 3) + 8 * (r >> 2) + 32 > thr) p1[r] = NEG; }
}
__device__ __forceinline__ void kmean_blocks(const bf16_t* Kp, ALDS char* lds) {
    int tid_ = threadIdx.x; asm volatile("" : "+v"(tid_));
    const int tid = tid_, lane = tid & 63, wid = tid >> 6;
    ALDS float* red = (ALDS float*)(lds + L_RED); ALDS float* km = (ALDS float*)(lds + L_KM);
#pragma unroll 1
    for (int n = 0; n < 8; ++n) {
        float a[16];
#pragma unroll
        for (int j = 0; j < 16; ++j) a[j] = 0.f;
#pragma unroll
        for (int i = 0; i < 2; ++i)
#pragma unroll
            for (int cc = 0; cc < 2; ++cc) { const bf16x8 kx = *(const bf16x8*)(Kp + (size_t)(n * 256 + 128 * i + 16 * wid) * AW + cc * 512 + lane * 8);
#pragma unroll
                for (int j = 0; j < 8; ++j) a[cc * 8 + j] += bf2f(kx[j]); }
#pragma unroll
        for (int j = 0; j < 16; ++j) { a[j] += __shfl_xor(a[j], 1); a[j] += __shfl_xor(a[j], 2); a[j] += __shfl_xor(a[j], 4); a[j] += __shfl_xor(a[j], 8); }
        if ((lane & 15) == 0) {
#pragma unroll
            for (int j = 0; j < 16; ++j) red[(n * 8 + wid) * 64 + (j >> 3) * 32 + (lane >> 4) * 8 + (j & 7)] = a[j]; }
    }
    __syncthreads();
    { const int n = tid >> 6, d = tid & 63; float s = 0.f;
#pragma unroll
        for (int w = 0; w < 8; ++w) s += red[(n * 8 + w) * 64 + d];
        km[n * 64 + d] = s * (1.0f / 256.0f); }
    __syncthreads();
}
template <int DQK, bool MOBA>
__device__ __forceinline__ void attn_bh(const bf16_t* Qp, int ldq, const bf16_t* Kp, const bf16_t* KRp, const bf16_t* Vp, bf16_t* Op, int ldo, ALDS char* lds) {
    constexpr int ND = DQK / 16;
    ALDS char* K_lds = lds + L_K; ALDS char* V_lds = lds + L_V;
    bf16x8 sk0, sv0, sr0, sk1, sv1, sr1;
#define ATT_SLOAD(S, k0) do { sk##S = *(const bf16x8*)((const char*)(Kp + (size_t)(k0) * AW) + koff); sv##S = *(const bf16x8*)((const char*)(Vp + (size_t)(k0) * AW) + koff); if (DQK == 96) sr##S = *(const bf16x8*)((const char*)(KRp + (size_t)(k0) * RDIM) + roff); } while (0)
#define ATT_SWRITE(b, S) do { *(ALDS bf16x8*)(K_lds + (b) * KTB + kst) = sk##S; *(ALDS bf16x8*)(V_lds + (b) * VTB + vst) = sv##S; if (DQK == 96) { if (tid < 256) *(ALDS bf16x8*)(K_lds + (b) * KTB + rst) = sr##S; } } while (0)
#define ATT_QLOAD(q_) do { const bf16_t* Qw = Qp + (size_t)((q_) * 256 + wid * 32 + (r32 & 16)) * ldq + (r32 & 15) * 8 + hi * 128; _Pragma("unroll") for (int d0 = 0; d0 < ND; ++d0) qr[d0] = *(const bf16x8*)(Qw + (d0 >> 1) * 512 + (d0 & 1) * 256); } while (0)
    bf16x8 qr[ND];
    {
        const int tid = threadIdx.x, w_ = tid >> 6, l_ = tid & 63;
        const unsigned koff = (unsigned)((w_ >> 1) * 16 * AW + (w_ & 1) * 512 + l_ * 8) * 2u, roff = (unsigned)((w_ & 3) * 16 * RDIM + l_ * 8) * 2u;
        ATT_SLOAD(0, 0); ATT_SLOAD(1, 64); }
#pragma unroll 1
  for (int qb = 0; qb < 8; ++qb) {
    int tid_ = threadIdx.x; asm volatile("" : "+v"(tid_));
    const int tid = tid_, lane = tid & 63, r32 = lane & 31, hi = lane >> 5; const int wid = __builtin_amdgcn_readfirstlane(tid >> 6);
    ALDS float* al_l = (ALDS float*)(lds + L_WS) + wid * 64;
    const int skey = 16 * (wid >> 1) + (lane & 15), sch = 4 * (wid & 1) + (lane >> 4);
    const unsigned koff = (unsigned)((wid >> 1) * 16 * AW + (wid & 1) * 512 + lane * 8) * 2u;
    const int kst = skey * 128 + ((sch ^ ((skey >> 1) & 7)) << 4), vst = v_st(skey, sch * 8);
    const int rkey = 16 * (wid & 3) + (lane & 15), rch = lane >> 4;
    const unsigned roff = (unsigned)((wid & 3) * 16 * RDIM + lane * 8) * 2u;
    const int rst = 8192 + rkey * 64 + ((rch ^ ((rkey >> 2) & 3)) << 4);
    int ka[ND];
#pragma unroll
    for (int d0 = 0; d0 < ND; ++d0) ka[d0] = (d0 < 4) ? r32 * 128 + (((2 * d0 + hi) ^ ((r32 >> 1) & 7)) << 4) : 8192 + r32 * 64 + (((2 * (d0 - 4) + hi) ^ ((r32 >> 2) & 3)) << 4);
    const int vb0 = (int)(unsigned)(uintptr_t)V_lds + v_rd_base(lane);
    const int qrel = wid * 32 + r32;
    ATT_QLOAD(qb);
    float m_ref = 0.f, lsum = 0.f; f32x16 o[2], ol, negm; o[0] = f32x16{}; o[1] = f32x16{}; ol = f32x16{}; negm = f32x16{};
    unsigned sel = 0xffu;
    if (MOBA && qb > 3) {
        ALDS const float* km = (ALDS const float*)(lds + L_KM); float g[8];
#pragma unroll
        for (int n = 0; n < 8; ++n) { float s = 0.f;
#pragma unroll
            for (int d0 = 0; d0 < ND; ++d0)
#pragma unroll
                for (int j = 0; j < 8; ++j) s += bf2f(qr[d0][j]) * km[n * 64 + d0 * 16 + hi * 8 + j];
            g[n] = s; }
#pragma unroll
        for (int n = 0; n < 8; ++n) g[n] += __shfl_xor(g[n], 32);
        sel = 0u;
#pragma unroll
        for (int n = 0; n < 8; ++n) { int rank = 0;
#pragma unroll
            for (int mm = 0; mm < 8; ++mm) if (mm != n) rank += (mm < qb && (g[mm] > g[n] || (g[mm] == g[n] && mm < n))) ? 1 : 0;
            if (n < qb && rank < 3) sel |= 1u << n; }
    }
#define ATT_RESC(a) do { if (__any((a) < 1.f)) { lsum *= (a); if (hi == 0) al_l[r32] = (a); asm volatile("s_waitcnt lgkmcnt(0)" ::: "memory"); \
    _Pragma("unroll") for (int r = 0; r < 16; ++r) { const float f_ = al_l[crow(r, hi)]; o[0][r] *= f_; o[1][r] *= f_; ol[r] *= f_; } } } while (0)
    f32x16 pA0, pA1, pB0, pB1; float alA, alB; bf16x8 pa0, pa1, pa2, pa3; const int NT = 4 * (qb + 1), NP = 4 * qb;
    f32x16 cm = negm; const bool gated = MOBA && qb > 3;
#define ATT_CM(t) do { if (gated) { if ((t) < NP) { const float v_ = ((sel >> ((t) >> 2)) & 1u) ? -m_ref : -INFINITY; _Pragma("unroll") for (int r = 0; r < 16; ++r) cm[r] = v_; } else cm = negm; } else cm = negm; } while (0)
#define ATT_SCORE(P0, P1, t) do { ATT_CM(t); qkt<ND>(P0, P1, K_lds + sc * KTB, ka, qr, cm); if ((t) >= NP) cmask(P0, P1, (t) - NP, qrel, hi); } while (0)
    int sp = 0, sc = 0, sn = 1;
#define ATT_ROT() do { sp = sc; sc = sn; sn = (sn == NSLOT - 1) ? 0 : sn + 1; } while (0)
    ATT_SWRITE(0, 0); ATT_SLOAD(0, 128);
    __syncthreads(); ATT_SWRITE(sn, 1); ATT_SLOAD(1, 192);
    ATT_SCORE(pA0, pA1, 0); partialSM(pA0, pA1, m_ref, negm, alA);
    ATT_ROT();
    for (int t = 1; t + 1 < NT; t += 2) {
        __syncthreads(); ATT_SWRITE(sn, 0); if (t + 3 < NT) ATT_SLOAD(0, (t + 3) * 64);
        ASBAR(); ATT_SCORE(pB0, pB1, t);
        finishSM(pA0, pA1, pa0, pa1, pa2, pa3, lsum); ASBAR();
        pv_all(o, ol, vb0 + sp * VTB, pa0, pa1, pa2, pa3); partialSM(pB0, pB1, m_ref, negm, alB);
        ATT_RESC(alB); ATT_ROT();
        __syncthreads(); ATT_SWRITE(sn, 1); if (t + 4 < NT) ATT_SLOAD(1, (t + 4) * 64);
        ASBAR(); ATT_SCORE(pA0, pA1, t + 1);
        finishSM(pB0, pB1, pa0, pa1, pa2, pa3, lsum); ASBAR();
        pv_all(o, ol, vb0 + sp * VTB, pa0, pa1, pa2, pa3); partialSM(pA0, pA1, m_ref, negm, alA);
        ATT_RESC(alA); ATT_ROT();
    }
    __syncthreads();
    ASBAR(); ATT_SCORE(pB0, pB1, NT - 1);
    if (qb < 7) { ATT_SLOAD(0, 0); ATT_SLOAD(1, 64); }
    finishSM(pA0, pA1, pa0, pa1, pa2, pa3, lsum); ASBAR();
    pv_all(o, ol, vb0 + sp * VTB, pa0, pa1, pa2, pa3); partialSM(pB0, pB1, m_ref, negm, alB);
    ATT_RESC(alB);
    finishSM(pB0, pB1, pa0, pa1, pa2, pa3, lsum); ASBAR();
    pv_all(o, ol, vb0 + sc * VTB, pa0, pa1, pa2, pa3);
#undef ATT_ROT
#undef ATT_SCORE
#undef ATT_CM
    float rli[16];
#if ATT_LSUM_MFMA
#pragma unroll
    for (int r = 0; r < 16; ++r) rli[r] = __builtin_amdgcn_rcpf(ol[r]);
#else
    { auto rr = __builtin_amdgcn_permlane32_swap(__float_as_uint(lsum), __float_as_uint(lsum), false, false); lsum = __uint_as_float(rr[0]) + __uint_as_float(rr[1]); }
    if (hi == 0) al_l[32 + r32] = lsum; asm volatile("s_waitcnt lgkmcnt(0)" ::: "memory");
#pragma unroll
    for (int r = 0; r < 16; ++r) rli[r] = __builtin_amdgcn_rcpf(al_l[32 + crow(r, hi)]);
#endif
    { ALDS unsigned short* stg = (ALDS unsigned short*)(lds + L_OST) + wid * 2048;
#pragma unroll
      for (int r = 0; r < 16; ++r) { const int orow = crow(r, hi);
#pragma unroll
          for (int d0 = 0; d0 < 2; ++d0) stg[orow * 64 + d0 * 32 + r32] = (unsigned short)(cvtpk(o[d0][r] * rli[r], 0.f) & 0xffffu); }
      asm volatile("s_waitcnt lgkmcnt(0)" ::: "memory");
      bf16_t* Ow = Op + (size_t)(qb * 256 + wid * 32) * ldo;
#pragma unroll
      for (int i = 0; i < 4; ++i) { const int row = i * 8 + (lane >> 3), ch = lane & 7; const u32x4 v = *(ALDS const u32x4*)(stg + row * 64 + ch * 8); *(u32x4*)(Ow + (size_t)row * ldo + ch * 8) = v; } }
    __syncthreads();
  }
#undef ATT_SLOAD
#undef ATT_SWRITE
#undef ATT_QLOAD
#undef ATT_RESC
}

constexpr int MSLOT = 8192, M_K = 0, M_V = 3 * MSLOT, M_WS = 6 * MSLOT, M_OST = M_WS + 8 * 256, M_END = M_OST + 8 * 4096;
static_assert(M_END <= L_KM, "MoBA LDS map");
#define MPIN(x) asm volatile("" : "+v"(x))
#define MMFMA(a, b, c) __builtin_amdgcn_mfma_f32_32x32x16_bf16(a, b, c, 0, 0, 0)
#define MWAIT_BAR(N) asm volatile("s_waitcnt vmcnt(" #N ") lgkmcnt(0)\n\ts_barrier" ::: "memory")
__device__ __forceinline__ void m_kload2(bf16x8* kf, ALDS const char* kp, int d0) { kf[2 * d0] = *(ALDS const bf16x8*)(kp + d0 * 2048); kf[2 * d0 + 1] = *(ALDS const bf16x8*)(kp + d0 * 2048 + 512); }
__device__ __forceinline__ void m_glds16(const void* g, unsigned lds_base) {
    unsigned sv; asm volatile("s_mov_b32 %0, m0\n\ts_mov_b32 m0, %2\n\ts_nop 0\n\tglobal_load_lds_dwordx4 %1, off\n\ts_mov_b32 m0, %0" : "=&s"(sv) : "v"(g), "s"(lds_base) : "memory"); }
typedef ALDS s16x4 lds_s16x4_t;
__device__ __forceinline__ s16x4 m_vtr(ALDS const char* p) { return __builtin_amdgcn_ds_read_tr16_b64_v4i16((lds_s16x4_t*)p); }
#define MMX3(a, b, c) __builtin_fmaxf(__builtin_fmaxf((a), (b)), (c))
__device__ __forceinline__ float m_rowmax(const f32x16& p0, const f32x16& p1) {
    float a = MMX3(p0[0], p0[1], p1[0]), b = MMX3(p0[2], p0[3], p1[1]); a = MMX3(a, p1[2], p1[3]);
#pragma unroll
    for (int r = 4; r < 16; r += 4) { a = MMX3(a, p0[r], p0[r + 1]); b = MMX3(b, p0[r + 2], p0[r + 3]); a = MMX3(a, p1[r], p1[r + 1]); b = MMX3(b, p1[r + 2], p1[r + 3]); }
    float m = __builtin_fmaxf(a, b); auto rr = __builtin_amdgcn_permlane32_swap(__float_as_uint(m), __float_as_uint(m), false, false);
    return __builtin_fmaxf(__uint_as_float(rr[0]), __uint_as_float(rr[1])); }
__device__ __forceinline__ void moba_unit(const bf16_t* Qp, const bf16_t* Kp, const bf16_t* Vp, bf16_t* Op, int ldo, int qb, ALDS char* lds) {
    int tid_ = threadIdx.x; asm volatile("" : "+v"(tid_));
    const int tid = tid_, lane = tid & 63, r32 = lane & 31, hi = lane >> 5; const int wid = __builtin_amdgcn_readfirstlane(tid >> 6);
    const int NT = 4 * qb + 4, NP = 4 * qb;
    ALDS float* wsf = (ALDS float*)(lds + M_WS) + wid * 64;
    const bf16_t* ksrc = Kp + (size_t)(lane >> 4) * 16 * AW + (wid >> 2) * 512 + (wid & 3) * 128 + (lane & 15) * 8;
    const bf16_t* vsrc = Vp + (size_t)(wid & 3) * 16 * AW + (wid >> 2) * 512 + (lane & 3) * 128 + (lane >> 2) * 8;
    const unsigned lds0 = (unsigned)(uintptr_t)lds, kdst = lds0 + M_K + wid * 1024, vdst = lds0 + M_V + wid * 1024;
#define MDMA_K(t, slot) m_glds16(ksrc + (size_t)(t) * 64 * AW, (unsigned)__builtin_amdgcn_readfirstlane(kdst + (slot)))
#define MDMA_V(t, slot) m_glds16(vsrc + (size_t)(t) * 64 * AW, (unsigned)__builtin_amdgcn_readfirstlane(vdst + (slot)))
    ALDS const char* vp0 = lds + M_V + ((lane >> 4) & 1) * 32 + (lane & 3) * 8 + (4 * hi + ((lane & 15) >> 2)) * 64;
    ALDS const char* kp0 = lds + M_K + hi * 1024 + r32 * 16;
    MDMA_K(0, 0); MDMA_V(0, 0); MDMA_K(1, MSLOT);
    bf16x8 qr[4];
    { const bf16_t* Qw = Qp + (size_t)(qb * 256 + wid * 32 + (r32 & 16)) * AW + (r32 & 15) * 8 + hi * 128;
#pragma unroll
      for (int d0 = 0; d0 < 4; ++d0) qr[d0] = *(const bf16x8*)(Qw + (d0 >> 1) * 512 + (d0 & 1) * 256); }
    MDMA_K(2, 2 * MSLOT);
    float mhat = 0.f, l_reg = 0.f; f32x16 o[2]; o[0] = f32x16{}; o[1] = f32x16{};
    const int qrel = wid * 32 + r32; bool resc = false, moved = false;
    unsigned sel = 0xffu; const bool gated = qb > 3;
    if (gated) {
        ALDS const float* km = (ALDS const float*)(lds + L_KM); float g[8];
#pragma unroll
        for (int n = 0; n < 8; ++n) { float sg = 0.f;
#pragma unroll
            for (int d0 = 0; d0 < 4; ++d0)
#pragma unroll
                for (int j = 0; j < 8; ++j) sg += bf2f(qr[d0][j]) * km[n * 64 + d0 * 16 + hi * 8 + j];
            g[n] = sg; }
#pragma unroll
        for (int n = 0; n < 8; ++n) g[n] += __shfl_xor(g[n], 32);
        sel = 0u;
#pragma unroll
        for (int n = 0; n < 8; ++n) { int rank = 0;
#pragma unroll
            for (int mm = 0; mm < 8; ++mm) if (mm != n) rank += (mm < qb && (g[mm] > g[n] || (g[mm] == g[n] && mm < n))) ? 1 : 0;
            if (n < qb && rank < 3) sel |= 1u << n; }
    }
    f32x16 cm;
#define MCM(t) do { const float v_ = (gated && (t) < NP && !((sel >> ((t) >> 2)) & 1u)) ? -INFINITY : -mhat; _Pragma("unroll") for (int r = 0; r < 16; ++r) cm[r] = v_; MPIN(cm); } while (0)
    MCM(0);
    f32x16 pA0, pA1, pB0, pB1; bf16x8 kf[8]; s16x4 vlo[8], vhi[8]; u32x4 pw0, pw1, pw2, pw3;
    int sl_prev = 0, sl_cur = 0, sl_next = MSLOT;
#define MROT() do { sl_prev = sl_cur; sl_cur = sl_next; sl_next = (sl_next == 2 * MSLOT) ? 0 : sl_next + MSLOT; } while (0)
#define MEX(v) __builtin_amdgcn_exp2f(v)
#define MRESC(tn) do { if (moved) { moved = false; MCM(tn); } if (resc) { _Pragma("unroll") for (int d_ = 0; d_ < 2; ++d_) _Pragma("unroll") for (int r = 0; r < 16; ++r) o[d_][r] *= wsf[crow(r, hi)]; } } while (0)
#define MDECIDE(C0, C1) do { const float rm = m_rowmax(C0, C1); resc = false; \
      if (__builtin_expect(__any(rm > THR), 0)) { const float dl = __builtin_fmaxf(rm, 0.f); mhat += dl; const float f = __builtin_amdgcn_exp2f(-dl); l_reg *= f; if (hi == 0) wsf[r32] = f; resc = true; \
          _Pragma("unroll") for (int r = 0; r < 16; ++r) { C0[r] -= dl; C1[r] -= dl; } moved = true; } } while (0)
    MWAIT_BAR(3);
#pragma unroll
    for (int d0 = 0; d0 < 4; ++d0) m_kload2(kf, kp0, d0);
    pA0 = MMFMA(kf[0], qr[0], cm); pA1 = MMFMA(kf[1], qr[0], cm); pA0 = MMFMA(kf[2], qr[1], pA0); pA1 = MMFMA(kf[3], qr[1], pA1);
    pA0 = MMFMA(kf[4], qr[2], pA0); pA1 = MMFMA(kf[5], qr[2], pA1); pA0 = MMFMA(kf[6], qr[3], pA0); pA1 = MMFMA(kf[7], qr[3], pA1);
    if (NT == 4) cmask(pA0, pA1, 0, qrel, hi);
    MDECIDE(pA0, pA1);
    if (moved) { moved = false; MCM(1); }
#pragma unroll
    for (int r = 0; r < 16; ++r) { pA0[r] = MEX(pA0[r]); pA1[r] = MEX(pA1[r]); }
    MWAIT_BAR(0);
    MDMA_K(3, 0); MDMA_V(1, MSLOT); MROT();
#pragma unroll
    for (int d0 = 0; d0 < 4; ++d0) m_kload2(kf, kp0 + sl_cur, d0);
    MWAIT_BAR(2);
#define MPKW(P, i) cvtpk(P[i], P[i + 1])
#define MPAF(k) __builtin_bit_cast(bf16x8, pw##k)
#define MVFR(i) (bf16x8){vlo[i][0], vlo[i][1], vlo[i][2], vlo[i][3], vhi[i][0], vhi[i][1], vhi[i][2], vhi[i][3]}
#define MVRD(i) do { vlo[i] = m_vtr(vp_ + (((i) >> 2) * 4096 + ((i) & 3) * 1024)); vhi[i] = m_vtr(vp_ + (((i) >> 2) * 4096 + ((i) & 3) * 1024 + 512)); } while (0)
#define MKRD(G, d0) do { if (G) { m_kload2(kf, kp0 + sl_next, d0); ASBAR(); } } while (0)
#define MGAPA(MF, a0, a1, a2, a3, W0, W1, PW) do { MF; sacc += a0; sacc += a1; sacc += a2; sacc += a3; W0; W1; MPIN(PW); MPIN(sacc); ASBAR(); } while (0)
#define MGAPB(MF, X, i) do { MF; X[i] = MEX(X[i]); X[i + 1] = MEX(X[i + 1]); X[i + 2] = MEX(X[i + 2]); X[i + 3] = MEX(X[i + 3]); MPIN(X); ASBAR(); } while (0)
#define MSTEP(C0, C1, P0, P1, t, MASK, GK, GV, GL) do { ASBAR(); \
    const ALDS char* vp_ = vp0 + sl_prev; if (gated && ((t) & 3) == 0) MCM(t); \
    MVRD(0); ASBAR(); float sacc = P0[0] + P0[1]; \
                     MGAPA(C0 = MMFMA(kf[0], qr[0], cm), P0[2], P0[3], P0[4], P0[5],     pw0[0] = MPKW(P0, 0),  pw0[1] = MPKW(P0, 2),  pw0); \
    MVRD(4); ASBAR(); MGAPA(C1 = MMFMA(kf[1], qr[0], cm), P0[6], P0[7], P0[8], P0[9],     pw0[2] = MPKW(P0, 4),  pw0[3] = MPKW(P0, 6),  pw0); \
    MVRD(1); ASBAR(); MGAPA(C0 = MMFMA(kf[2], qr[1], C0), P0[10], P0[11], P0[12], P0[13], pw1[0] = MPKW(P0, 8),  pw1[1] = MPKW(P0, 10), pw1); \
    MVRD(5); ASBAR(); MGAPA(C1 = MMFMA(kf[3], qr[1], C1), P0[14], P0[15], P1[0], P1[1],   pw1[2] = MPKW(P0, 12), pw1[3] = MPKW(P0, 14), pw1); \
    MVRD(2); ASBAR(); MGAPA(C0 = MMFMA(kf[4], qr[2], C0), P1[2], P1[3], P1[4], P1[5],     pw2[0] = MPKW(P1, 0),  pw2[1] = MPKW(P1, 2),  pw2); \
    MVRD(6); ASBAR(); MGAPA(C1 = MMFMA(kf[5], qr[2], C1), P1[6], P1[7], P1[8], P1[9],     pw2[2] = MPKW(P1, 4),  pw2[3] = MPKW(P1, 6),  pw2); \
    MVRD(3); ASBAR(); MGAPA(C0 = MMFMA(kf[6], qr[3], C0), P1[10], P1[11], P1[12], P1[13], pw3[0] = MPKW(P1, 8),  pw3[1] = MPKW(P1, 10), pw3); \
    MVRD(7); ASBAR(); MGAPA(C1 = MMFMA(kf[7], qr[3], C1), P1[14], P1[15], 0.f, 0.f,       pw3[2] = MPKW(P1, 12), pw3[3] = MPKW(P1, 14), pw3); \
    l_reg += sacc; \
    if (GK) MDMA_K((t) + 3, sl_cur); if (GV) MDMA_V((t) + 1, sl_next); \
    if (MASK) cmask(C0, C1, (t) - NP, qrel, hi); \
    MDECIDE(C0, C1); ASBAR(); \
    MGAPB(o[0] = MMFMA(MPAF(0), MVFR(0), o[0]), C0, 0);               MGAPB(o[1] = MMFMA(MPAF(0), MVFR(4), o[1]), C0, 4); \
    MKRD(GL, 0); MGAPB(o[0] = MMFMA(MPAF(1), MVFR(1), o[0]), C0, 8);  MKRD(GL, 1); MGAPB(o[1] = MMFMA(MPAF(1), MVFR(5), o[1]), C0, 12); \
    MKRD(GL, 2); MGAPB(o[0] = MMFMA(MPAF(2), MVFR(2), o[0]), C1, 0);  MKRD(GL, 3); MGAPB(o[1] = MMFMA(MPAF(2), MVFR(6), o[1]), C1, 4); \
    MGAPB(o[0] = MMFMA(MPAF(3), MVFR(3), o[0]), C1, 8);               MGAPB(o[1] = MMFMA(MPAF(3), MVFR(7), o[1]), C1, 12); \
    } while (0)
    int t = 1;
    for (; t + 5 < NT; t += 2) {
        MSTEP(pB0, pB1, pA0, pA1, t, false, true, true, true);     MWAIT_BAR(2); MRESC(t + 1); MROT();
        MSTEP(pA0, pA1, pB0, pB1, t + 1, false, true, true, true); MWAIT_BAR(2); MRESC(t + 2); MROT();
    }
#define MENDW(tt) do { if ((tt) + 3 < NT) { MWAIT_BAR(2); } else if ((tt) + 2 < NT) { MWAIT_BAR(1); } else { MWAIT_BAR(0); } } while (0)
    for (; t + 1 < NT; t += 2) {
        MSTEP(pB0, pB1, pA0, pA1, t, true, (t + 3 < NT), (t + 1 < NT), (t + 1 < NT));         MENDW(t);     MRESC(t + 1); MROT();
        MSTEP(pA0, pA1, pB0, pB1, t + 1, true, (t + 4 < NT), (t + 2 < NT), (t + 2 < NT));     MENDW(t + 1); MRESC(t + 2); MROT();
    }
    MSTEP(pB0, pB1, pA0, pA1, NT - 1, true, false, false, false); MRESC(NT - 1);
    { float sacc = pB0[0] + pB0[1];
#pragma unroll
      for (int r = 2; r < 16; ++r) sacc += pB0[r];
#pragma unroll
      for (int r = 0; r < 16; ++r) sacc += pB1[r];
      l_reg += sacc;
      pw0 = (u32x4){MPKW(pB0, 0), MPKW(pB0, 2), MPKW(pB0, 4), MPKW(pB0, 6)}; pw1 = (u32x4){MPKW(pB0, 8), MPKW(pB0, 10), MPKW(pB0, 12), MPKW(pB0, 14)};
      pw2 = (u32x4){MPKW(pB1, 0), MPKW(pB1, 2), MPKW(pB1, 4), MPKW(pB1, 6)}; pw3 = (u32x4){MPKW(pB1, 8), MPKW(pB1, 10), MPKW(pB1, 12), MPKW(pB1, 14)};
      const ALDS char* vp_ = vp0 + sl_cur;
#pragma unroll
      for (int i = 0; i < 8; ++i) MVRD(i);
      o[0] = MMFMA(MPAF(0), MVFR(0), o[0]); o[1] = MMFMA(MPAF(0), MVFR(4), o[1]); o[0] = MMFMA(MPAF(1), MVFR(1), o[0]); o[1] = MMFMA(MPAF(1), MVFR(5), o[1]);
      o[0] = MMFMA(MPAF(2), MVFR(2), o[0]); o[1] = MMFMA(MPAF(2), MVFR(6), o[1]); o[0] = MMFMA(MPAF(3), MVFR(3), o[0]); o[1] = MMFMA(MPAF(3), MVFR(7), o[1]); }
    { auto rr = __builtin_amdgcn_permlane32_swap(__float_as_uint(l_reg), __float_as_uint(l_reg), false, false); l_reg = __uint_as_float(rr[0]) + __uint_as_float(rr[1]); }
    if (hi == 0) wsf[32 + r32] = l_reg; asm volatile("s_waitcnt lgkmcnt(0)" ::: "memory");
    float rli[16];
#pragma unroll
    for (int r = 0; r < 16; ++r) rli[r] = __builtin_amdgcn_rcpf(wsf[32 + crow(r, hi)]);
    { ALDS unsigned short* stg = (ALDS unsigned short*)(lds + M_OST) + wid * 2048;
#pragma unroll
      for (int r = 0; r < 16; ++r) { const int orow = crow(r, hi);
#pragma unroll
          for (int d0 = 0; d0 < 2; ++d0) stg[orow * 64 + d0 * 32 + r32] = (unsigned short)(cvtpk(o[d0][r] * rli[r], 0.f) & 0xffffu); }
      asm volatile("s_waitcnt lgkmcnt(0)" ::: "memory");
      bf16_t* Ow = Op + (size_t)(qb * 256 + wid * 32) * ldo;
#pragma unroll
      for (int i = 0; i < 4; ++i) { const int row = i * 8 + (lane >> 3), ch = lane & 7; const u32x4 v = *(ALDS const u32x4*)(stg + row * 64 + ch * 8); *(u32x4*)(Ow + (size_t)row * ldo + ch * 8) = v; } }
    asm volatile("s_waitcnt lgkmcnt(0)\n\ts_barrier" ::: "memory");
#undef MDMA_K
#undef MDMA_V
#undef MCM
#undef MROT
#undef MEX
#undef MRESC
#undef MDECIDE
#undef MPKW
#undef MPAF
#undef MVFR
#undef MVRD
#undef MKRD
#undef MGAPA
#undef MGAPB
#undef MSTEP
#undef MENDW
}
__device__ __forceinline__ void mla_unit(const bf16_t* Qp, const bf16_t* Kp, const bf16_t* KRp, const bf16_t* Vp, bf16_t* Op, int ldo, int qb, ALDS char* lds) {
    constexpr int KSL = 12288, N_K = 0, N_V = 3 * KSL, N_WS = N_V + 3 * MSLOT, N_OST = N_WS + 8 * 256;
    int tid_ = threadIdx.x; asm volatile("" : "+v"(tid_));
    const int tid = tid_, lane = tid & 63, r32 = lane & 31, hi = lane >> 5; const int wid = __builtin_amdgcn_readfirstlane(tid >> 6);
    const int NT = 4 * qb + 4, NP = 4 * qb;
    ALDS float* wsf = (ALDS float*)(lds + N_WS) + wid * 64;
    const bf16_t* ksrc = Kp + (size_t)(lane >> 4) * 16 * AW + (wid >> 2) * 512 + (wid & 3) * 128 + (lane & 15) * 8;
    const bf16_t* vsrc = Vp + (size_t)(wid & 3) * 16 * AW + (wid >> 2) * 512 + (lane & 3) * 128 + (lane >> 2) * 8;
    const bf16_t* rsrc = KRp + (size_t)(lane >> 4) * 16 * RDIM + (wid & 3) * 128 + (lane & 15) * 8;
    const unsigned lds0 = (unsigned)(uintptr_t)lds, kdst = lds0 + N_K + wid * 1024, vdst = lds0 + N_V + wid * 1024, rdst = lds0 + N_K + (8 + (wid & 3)) * 1024;
#define MDMA_K(t, slot) do { m_glds16(ksrc + (size_t)(t) * 64 * AW, (unsigned)__builtin_amdgcn_readfirstlane(kdst + (slot) * KSL)); m_glds16(rsrc + (size_t)(t) * 64 * RDIM, (unsigned)__builtin_amdgcn_readfirstlane(rdst + (slot) * KSL)); } while (0)
#define MDMA_V(t, slot) m_glds16(vsrc + (size_t)(t) * 64 * AW, (unsigned)__builtin_amdgcn_readfirstlane(vdst + (slot) * MSLOT))
    ALDS const char* vp0 = lds + N_V + ((lane >> 4) & 1) * 32 + (lane & 3) * 8 + (4 * hi + ((lane & 15) >> 2)) * 64;
    ALDS const char* kp0 = lds + N_K + hi * 1024 + r32 * 16;
    MDMA_K(0, 0); MDMA_V(0, 0); MDMA_K(1, 1);
    bf16x8 qr[6];
    { const bf16_t* Qw = Qp + (size_t)(qb * 256 + wid * 32 + (r32 & 16)) * (NHEAD * QKB) + (r32 & 15) * 8 + hi * 128;
#pragma unroll
      for (int d0 = 0; d0 < 6; ++d0) qr[d0] = *(const bf16x8*)(Qw + (d0 >> 1) * 512 + (d0 & 1) * 256); }
    MDMA_K(2, 2);
    float mhat = 0.f, l_reg = 0.f; f32x16 o[2]; o[0] = f32x16{}; o[1] = f32x16{};
    const int qrel = wid * 32 + r32; bool resc = false, moved = false;
    constexpr bool gated = false; constexpr unsigned sel = 0xffu;
#define MCM(t) do { } while (0)
#define MREL(C0, C1) do { if (__builtin_expect(__any(mhat != 0.f), 0)) { _Pragma("unroll") for (int r = 0; r < 16; ++r) { C0[r] -= mhat; C1[r] -= mhat; } } } while (0)
    f32x16 pA0, pA1, pB0, pB1; bf16x8 kf[12]; s16x4 vlo[8], vhi[8]; u32x4 pw0, pw1, pw2, pw3;
    int sl_prev = 0, sl_cur = 0, sl_next = 1;
#define MROT() do { sl_prev = sl_cur; sl_cur = sl_next; sl_next = (sl_next == 2) ? 0 : sl_next + 1; } while (0)
#define MEX(v) __builtin_amdgcn_exp2f(v)
#define MRESC(tn) do { if (resc) { _Pragma("unroll") for (int d_ = 0; d_ < 2; ++d_) _Pragma("unroll") for (int r = 0; r < 16; ++r) o[d_][r] *= wsf[crow(r, hi)]; } } while (0)
#define MDECIDE(C0, C1) do { const float rm = m_rowmax(C0, C1); resc = false; \
      if (__builtin_expect(__any(rm > THR), 0)) { const float dl = __builtin_fmaxf(rm, 0.f); mhat += dl; const float f = __builtin_amdgcn_exp2f(-dl); l_reg *= f; if (hi == 0) wsf[r32] = f; resc = true; \
          _Pragma("unroll") for (int r = 0; r < 16; ++r) { C0[r] -= dl; C1[r] -= dl; } moved = true; } } while (0)
    MWAIT_BAR(5);
#pragma unroll
    for (int d0 = 0; d0 < 6; ++d0) m_kload2(kf, kp0, d0);
    pA0 = MMFMA(kf[0], qr[0], (f32x16){}); pA1 = MMFMA(kf[1], qr[0], (f32x16){}); pA0 = MMFMA(kf[2], qr[1], pA0); pA1 = MMFMA(kf[3], qr[1], pA1);
    pA0 = MMFMA(kf[4], qr[2], pA0); pA1 = MMFMA(kf[5], qr[2], pA1); pA0 = MMFMA(kf[6], qr[3], pA0); pA1 = MMFMA(kf[7], qr[3], pA1);
    pA0 = MMFMA(kf[8], qr[4], pA0); pA1 = MMFMA(kf[9], qr[4], pA1); pA0 = MMFMA(kf[10], qr[5], pA0); pA1 = MMFMA(kf[11], qr[5], pA1);
    if (NT == 4) cmask(pA0, pA1, 0, qrel, hi);
    MREL(pA0, pA1); MDECIDE(pA0, pA1);
#pragma unroll
    for (int r = 0; r < 16; ++r) { pA0[r] = MEX(pA0[r]); pA1[r] = MEX(pA1[r]); }
    MWAIT_BAR(0);
    MDMA_K(3, 0); MDMA_V(1, 1); MROT();
#pragma unroll
    for (int d0 = 0; d0 < 6; ++d0) m_kload2(kf, kp0 + sl_cur * KSL, d0);
    MWAIT_BAR(3);
#define MPKW(P, i) cvtpk(P[i], P[i + 1])
#define MPAF(k) __builtin_bit_cast(bf16x8, pw##k)
#define MVFR(i) (bf16x8){vlo[i][0], vlo[i][1], vlo[i][2], vlo[i][3], vhi[i][0], vhi[i][1], vhi[i][2], vhi[i][3]}
#define MVRD(i) do { vlo[i] = m_vtr(vp_ + (((i) >> 2) * 4096 + ((i) & 3) * 1024)); vhi[i] = m_vtr(vp_ + (((i) >> 2) * 4096 + ((i) & 3) * 1024 + 512)); } while (0)
#define MKRD(G, d0) do { if (G) { m_kload2(kf, kp0 + sl_next * KSL, d0); ASBAR(); } } while (0)
#define MGAPA(MF, a0, a1, a2, a3, W0, W1, PW) do { MF; sacc += a0; sacc += a1; sacc += a2; sacc += a3; W0; W1; MPIN(PW); MPIN(sacc); ASBAR(); } while (0)
#define MGAPB(MF, X, i) do { MF; X[i] = MEX(X[i]); X[i + 1] = MEX(X[i + 1]); X[i + 2] = MEX(X[i + 2]); X[i + 3] = MEX(X[i + 3]); MPIN(X); ASBAR(); } while (0)
#define MGAPA2(MF, a0, a1, W0, PW) do { MF; sacc += a0; sacc += a1; W0; MPIN(PW); MPIN(sacc); ASBAR(); } while (0)
#define MSTEP(C0, C1, P0, P1, t, MASK, GK, GV, GL) do { ASBAR(); \
    const ALDS char* vp_ = vp0 + sl_prev * MSLOT; \
    MVRD(0); ASBAR(); float sacc = P0[0] + P0[1]; \
                     MGAPA(C0 = MMFMA(kf[0], qr[0], (f32x16){}), P0[2], P0[3], P0[4], P0[5],     pw0[0] = MPKW(P0, 0),  pw0[1] = MPKW(P0, 2),  pw0); \
    MVRD(4); ASBAR(); MGAPA(C1 = MMFMA(kf[1], qr[0], (f32x16){}), P0[6], P0[7], P0[8], P0[9],     pw0[2] = MPKW(P0, 4),  pw0[3] = MPKW(P0, 6),  pw0); \
    MVRD(1); ASBAR(); MGAPA2(C0 = MMFMA(kf[2], qr[1], C0), P0[10], P0[11], pw1[0] = MPKW(P0, 8),  pw1); \
    MVRD(5); ASBAR(); MGAPA2(C1 = MMFMA(kf[3], qr[1], C1), P0[12], P0[13], pw1[1] = MPKW(P0, 10), pw1); \
                     MGAPA2(C0 = MMFMA(kf[4], qr[2], C0), P0[14], P0[15], pw1[2] = MPKW(P0, 12), pw1); \
                     MGAPA2(C1 = MMFMA(kf[5], qr[2], C1), P1[0], P1[1],   pw1[3] = MPKW(P0, 14), pw1); \
                     MGAPA2(C0 = MMFMA(kf[6], qr[3], C0), P1[2], P1[3],   pw2[0] = MPKW(P1, 0),  pw2); \
                     MGAPA2(C1 = MMFMA(kf[7], qr[3], C1), P1[4], P1[5],   pw2[1] = MPKW(P1, 2),  pw2); \
                     MGAPA(C0 = MMFMA(kf[8], qr[4], C0), P1[6], P1[7], P1[8], P1[9],     pw2[2] = MPKW(P1, 4),  pw2[3] = MPKW(P1, 6),  pw2); \
                     MGAPA(C1 = MMFMA(kf[9], qr[4], C1), P1[10], P1[11], P1[12], P1[13], pw3[0] = MPKW(P1, 8),  pw3[1] = MPKW(P1, 10), pw3); \
                     MGAPA2(C0 = MMFMA(kf[10], qr[5], C0), P1[14], P1[15], pw3[2] = MPKW(P1, 12), pw3); \
                     MGAPA2(C1 = MMFMA(kf[11], qr[5], C1), 0.f, 0.f,       pw3[3] = MPKW(P1, 14), pw3); \
    l_reg += sacc; \
    if (GK) MDMA_K((t) + 3, sl_cur); if (GV) MDMA_V((t) + 1, sl_next); \
    if (MASK) cmask(C0, C1, (t) - NP, qrel, hi); \
    MREL(C0, C1); MDECIDE(C0, C1); ASBAR(); \
    MVRD(2); MKRD(GL, 4); ASBAR(); MGAPB(o[0] = MMFMA(MPAF(0), MVFR(0), o[0]), C0, 0);  MVRD(6); MKRD(GL, 5); ASBAR(); MGAPB(o[1] = MMFMA(MPAF(0), MVFR(4), o[1]), C0, 4); \
    MVRD(3); MKRD(GL, 0); ASBAR(); MGAPB(o[0] = MMFMA(MPAF(1), MVFR(1), o[0]), C0, 8);  MVRD(7); MKRD(GL, 1); ASBAR(); MGAPB(o[1] = MMFMA(MPAF(1), MVFR(5), o[1]), C0, 12); \
    MKRD(GL, 2); MGAPB(o[0] = MMFMA(MPAF(2), MVFR(2), o[0]), C1, 0);  MKRD(GL, 3); MGAPB(o[1] = MMFMA(MPAF(2), MVFR(6), o[1]), C1, 4); \
    MGAPB(o[0] = MMFMA(MPAF(3), MVFR(3), o[0]), C1, 8);               MGAPB(o[1] = MMFMA(MPAF(3), MVFR(7), o[1]), C1, 12); \
    } while (0)
    int t = 1;
    for (; t + 5 < NT; t += 2) {
        MSTEP(pB0, pB1, pA0, pA1, t, false, true, true, true);     MWAIT_BAR(3); MRESC(t + 1); MROT();
        MSTEP(pA0, pA1, pB0, pB1, t + 1, false, true, true, true); MWAIT_BAR(3); MRESC(t + 2); MROT();
    }
#define MENDW(tt) do { if ((tt) + 3 < NT) { MWAIT_BAR(3); } else if ((tt) + 2 < NT) { MWAIT_BAR(1); } else { MWAIT_BAR(0); } } while (0)
    for (; t + 1 < NT; t += 2) {
        MSTEP(pB0, pB1, pA0, pA1, t, true, (t + 3 < NT), (t + 1 < NT), (t + 1 < NT));         MENDW(t);     MRESC(t + 1); MROT();
        MSTEP(pA0, pA1, pB0, pB1, t + 1, true, (t + 4 < NT), (t + 2 < NT), (t + 2 < NT));     MENDW(t + 1); MRESC(t + 2); MROT();
    }
    MSTEP(pB0, pB1, pA0, pA1, NT - 1, true, false, false, false); MRESC(NT - 1);
    { float sacc = pB0[0] + pB0[1];
#pragma unroll
      for (int r = 2; r < 16; ++r) sacc += pB0[r];
#pragma unroll
      for (int r = 0; r < 16; ++r) sacc += pB1[r];
      l_reg += sacc;
      pw0 = (u32x4){MPKW(pB0, 0), MPKW(pB0, 2), MPKW(pB0, 4), MPKW(pB0, 6)}; pw1 = (u32x4){MPKW(pB0, 8), MPKW(pB0, 10), MPKW(pB0, 12), MPKW(pB0, 14)};
      pw2 = (u32x4){MPKW(pB1, 0), MPKW(pB1, 2), MPKW(pB1, 4), MPKW(pB1, 6)}; pw3 = (u32x4){MPKW(pB1, 8), MPKW(pB1, 10), MPKW(pB1, 12), MPKW(pB1, 14)};
      const ALDS char* vp_ = vp0 + sl_cur * MSLOT;
#pragma unroll
      for (int i = 0; i < 8; ++i) MVRD(i);
      o[0] = MMFMA(MPAF(0), MVFR(0), o[0]); o[1] = MMFMA(MPAF(0), MVFR(4), o[1]); o[0] = MMFMA(MPAF(1), MVFR(1), o[0]); o[1] = MMFMA(MPAF(1), MVFR(5), o[1]);
      o[0] = MMFMA(MPAF(2), MVFR(2), o[0]); o[1] = MMFMA(MPAF(2), MVFR(6), o[1]); o[0] = MMFMA(MPAF(3), MVFR(3), o[0]); o[1] = MMFMA(MPAF(3), MVFR(7), o[1]); }
    { auto rr = __builtin_amdgcn_permlane32_swap(__float_as_uint(l_reg), __float_as_uint(l_reg), false, false); l_reg = __uint_as_float(rr[0]) + __uint_as_float(rr[1]); }
    if (hi == 0) wsf[32 + r32] = l_reg; asm volatile("s_waitcnt lgkmcnt(0)" ::: "memory");
    float rli[16];
#pragma unroll
    for (int r = 0; r < 16; ++r) rli[r] = __builtin_amdgcn_rcpf(wsf[32 + crow(r, hi)]);
    { ALDS unsigned short* stg = (ALDS unsigned short*)(lds + N_OST) + wid * 2048;
#pragma unroll
      for (int r = 0; r < 16; ++r) { const int orow = crow(r, hi);
#pragma unroll
          for (int d0 = 0; d0 < 2; ++d0) stg[orow * 64 + d0 * 32 + r32] = (unsigned short)(cvtpk(o[d0][r] * rli[r], 0.f) & 0xffffu); }
      asm volatile("s_waitcnt lgkmcnt(0)" ::: "memory");
      bf16_t* Ow = Op + (size_t)(qb * 256 + wid * 32) * ldo;
#pragma unroll
      for (int i = 0; i < 4; ++i) { const int row = i * 8 + (lane >> 3), ch = lane & 7; const u32x4 v = *(ALDS const u32x4*)(stg + row * 64 + ch * 8); *(u32x4*)(Ow + (size_t)row * ldo + ch * 8) = v; } }
    asm volatile("s_waitcnt lgkmcnt(0)\n\ts_barrier" ::: "memory");
#undef MDMA_K
#undef MDMA_V
#undef MCM
#undef MROT
#undef MEX
#undef MRESC
#undef MDECIDE
#undef MPKW
#undef MPAF
#undef MVFR
#undef MVRD
#undef MKRD
#undef MGAPA
#undef MGAPB
#undef MSTEP
#undef MENDW
#undef MGAPA2
#undef MREL
}
#undef ASBAR
}
#define GAS __attribute__((address_space(1)))
#define LAS __attribute__((address_space(3)))
typedef unsigned short bf16;
typedef unsigned v4u __attribute__((ext_vector_type(4)));
typedef float f32x4 __attribute__((ext_vector_type(4)));
typedef short bf16x8 __attribute__((ext_vector_type(8)));
typedef GAS unsigned gu32;
typedef GAS unsigned long long gu64;
#define RLX_AGENT __ATOMIC_RELAXED, __HIP_MEMORY_SCOPE_AGENT
#define LDS_WAIT() asm volatile("s_waitcnt lgkmcnt(0)" ::: "memory")
#define VM_WAIT() asm volatile("s_waitcnt vmcnt(0)" ::: "memory")
__device__ __forceinline__ unsigned long long rt() { return __builtin_amdgcn_s_memrealtime(); }
__device__ __forceinline__ unsigned f2bf(float f) { unsigned u = __builtin_bit_cast(unsigned, f); return (u + 0x7fffu + ((u >> 16) & 1u)) >> 16; }
__device__ __forceinline__ unsigned pk2(float lo, float hi) { return f2bf(lo) | (f2bf(hi) << 16); }

#define XB_TMO      128
#define XB_XCNT(j)  (256  + 64 * (j))
#define XB_XSUB(j)  (1280 + 64 * (j))
#define XB_XGEN(j)  (2304 + 64 * (j))
#define XB_TOP      3328
#define XB_TOPGEN   3392
#define XCD_BAR_WORDS 3456
#define XB_SPIN_CAP (1u << 18)

__device__ __forceinline__ unsigned xb_ld(unsigned* p)              { return __hip_atomic_load(p, __ATOMIC_RELAXED, __HIP_MEMORY_SCOPE_AGENT); }
__device__ __forceinline__ unsigned xb_add(unsigned* p, unsigned v) { return __hip_atomic_fetch_add(p, v, __ATOMIC_RELAXED, __HIP_MEMORY_SCOPE_AGENT); }
__device__ __forceinline__ unsigned xb_xcc_id() { return (unsigned)__builtin_amdgcn_s_getreg((3 << 11) | 20) & 0xFu; }
#define XB_SPIN(cond, bar) do { unsigned _sp = 0; while (cond) { __builtin_amdgcn_s_sleep(1); \
    if ((++_sp & 255u) == 0u) { if (xb_ld(&(bar)[XB_TMO])) break; if (_sp > XB_SPIN_CAP) { atomicAdd(&(bar)[XB_TMO], 1u); break; } } } } while (0)

struct XcdBarrier {
    unsigned* bar; unsigned x;
    volatile LAS unsigned* st;
};

__device__ __forceinline__ XcdBarrier xcd_barrier_post(unsigned* bar, volatile LAS unsigned* st) {
    XcdBarrier b; b.bar = bar; b.x = xb_xcc_id(); b.st = st;
    if (threadIdx.x == 0) (void)xb_add(&bar[XB_XCNT(b.x)], 1u);
    return b;
}
__device__ __forceinline__ void xcd_barrier_complete(unsigned* bar, unsigned x, unsigned& nloc, unsigned& nx) {
    const unsigned G = gridDim.x * gridDim.y * gridDim.z;
    unsigned sum, cnt, mine, sp = 0u;
    for (;;) {
        sum = 0u; cnt = 0u; mine = 0u;
#pragma unroll
        for (unsigned j = 0; j < 16; ++j) { const unsigned c = xb_ld(&bar[XB_XCNT(j)]); sum += c; cnt += (c > 0u) ? 1u : 0u; mine = (j == x) ? c : mine; }
        if (sum == G) break;
        __builtin_amdgcn_s_sleep(1);
        if ((++sp & 255u) == 0u) { if (xb_ld(&bar[XB_TMO])) break; if (sp > XB_SPIN_CAP) { atomicAdd(&bar[XB_TMO], 1u); break; } }
    }
    nloc = mine > 0u ? mine : 1u; nx = cnt > 0u ? cnt : 1u;
}

__device__ __forceinline__ void xcd_barrier(const XcdBarrier& b) {
    asm volatile("s_waitcnt vmcnt(0)" ::: "memory");
    __syncthreads();
    if (threadIdx.x == 0) {
        unsigned* bar = b.bar;
        __builtin_amdgcn_s_waitcnt(0);
        unsigned nloc = b.st[0], nx = b.st[1];
        if (nloc == 0u) { xcd_barrier_complete(bar, b.x, nloc, nx); b.st[0] = nloc; b.st[1] = nx; }
        const unsigned old = xb_add(&bar[XB_XSUB(b.x)], 1u);
        const unsigned gen = old / nloc;
        if (old + 1u == (gen + 1u) * nloc) {
            __builtin_amdgcn_fence(__ATOMIC_RELEASE, "agent");
            asm volatile("s_waitcnt vmcnt(0)" ::: "memory");
            const unsigned og = xb_add(&bar[XB_TOP], 1u);
            const unsigned tg = og / nx;
            if (og + 1u == (tg + 1u) * nx) xb_add(&bar[XB_TOPGEN], 1u);
            else XB_SPIN(xb_ld(&bar[XB_TOPGEN]) == tg, bar);
            __builtin_amdgcn_fence(__ATOMIC_ACQUIRE, "agent");
            xb_add(&bar[XB_XGEN(b.x)], 1u);
            asm volatile("s_waitcnt vmcnt(0)" ::: "memory");
        } else {
            XB_SPIN(xb_ld(&bar[XB_XGEN(b.x)]) == gen, bar);
            __builtin_amdgcn_fence(__ATOMIC_ACQUIRE, "agent");
            asm volatile("s_waitcnt vmcnt(0)" ::: "memory");
        }
    }
    __syncthreads();
}

constexpr size_t MiB = 1u << 20;
constexpr size_t WS_CTL = 0, CTL_ZERO_BYTES = 64 * 1024;
constexpr size_t WS_ROPEA = 1 * MiB, WS_ROPEB = 5 * MiB;
constexpr size_t WS_SS = 13 * MiB, WS_SS2 = 16 * MiB, WS_SS3 = 20 * MiB;
constexpr size_t WS_WIN = 24 * MiB, WS_WUQ = 34 * MiB, WS_WUKV = 35 * MiB, WS_WA = 36 * MiB, WS_WOUT = 39 * MiB, WS_WUP = 42 * MiB, WS_WDN = 51 * MiB;
constexpr size_t WS_H = 64 * MiB;
constexpr size_t WS_G = 208 * MiB;
constexpr size_t WS_QA = 464 * MiB, WS_KA = 528 * MiB, WS_VA = 592 * MiB;
constexpr size_t WS_T = WS_KA;
constexpr size_t WS_CQ = 672 * MiB, WS_CKV = 720 * MiB;
constexpr size_t WS_KR = 760 * MiB;
constexpr size_t WS_QB = 768 * MiB, WS_KB = 864 * MiB, WS_VB = 928 * MiB;
constexpr size_t WS_Y = WS_QB;
constexpr size_t WS_X1 = 896 * MiB;
constexpr size_t WS_H8 = WS_QB;
constexpr size_t WS_WG8 = 60 * MiB;
constexpr size_t WS_U = 208 * MiB;
constexpr size_t WS_END = 1024 * MiB;
static_assert(WS_H + (size_t)MTOK * LDH * 2 <= WS_G && WS_G + (size_t)MTOK * 2 * DM * 2 <= WS_QA && WS_T + (size_t)MTOK * LDH * 2 <= WS_CQ && WS_CQ + (size_t)MTOK * QLORA * 2 <= WS_CKV && WS_CKV + (size_t)MTOK * LDKV * 2 <= WS_KR, "d_ws map");
static_assert(WS_U + (size_t)MTOK * LDU * 2 <= WS_KR && WS_Y + (size_t)MTOK * DM * 2 <= WS_X1 && WS_X1 + (size_t)MTOK * DM * 2 <= WS_END && WS_VB + (size_t)MTOK * AW * 2 <= WS_END && WS_KR + (size_t)MTOK * RDIM * 2 <= WS_QB, "d_ws map");
static_assert(WS_WIN + (size_t)INWP * LDH * 2 <= WS_WUQ && WS_WUKV + (size_t)1024 * LDKV * 2 <= WS_WA && WS_WA + (size_t)DM * LDH * 2 <= WS_WOUT && WS_WOUT + (size_t)DM * LDH * 2 <= WS_WUP && WS_WUP + (size_t)DFF * LDH * 2 <= WS_WDN && WS_WDN + (size_t)DM * LDU * 2 <= WS_H, "d_ws map");
constexpr int CW_BAR = 0;
constexpr int NWAVES = 8;
constexpr int RING_OFF = 0, RING_BYTES = 131072;
constexpr int LDSCTL_OFF = RING_BYTES, MISC_OFF = LDSCTL_OFF + 320;
constexpr int LDS_BYTES = 147456;
static_assert(att::L_END <= RING_BYTES, "attention LDS map");

struct Frame {
    LAS unsigned char* lds;
    volatile LAS unsigned* MISC;
    gu32* ctl;
    int tid, lane, wave, vcu, G;
};

__device__ __forceinline__ float wave_sum(float v) {
#pragma unroll
    for (int o = 1; o < 64; o <<= 1) v += __shfl_xor(v, o);
    return v;
}
__device__ __forceinline__ int srccol(int mat, int n) {
    if (mat == 0) {
        if (n < 1024) { const int sect = n >> 9, c = n & 511, head = c >> 6, p = c & 63; const int d = (p < 16) ? ((p >> 1) + 8 * (p & 1)) : p; return sect * 512 + head * 64 + d; }
        if (n < 1920) return n;
        if (n < 1952) { const int pr = n - 1920; return 2176 + (pr >> 1) + 16 * (pr & 1); }
        if (n < 2048) return -1;
        if (n < 2304) return 1920 + (n - 2048);
        return 2208 + (n - 2304);
    }
    if (mat == 1) { const int head = n / QKB, p = n - head * QKB; if (p < 64) return n; const int pr = p - 64; return head * QKB + 64 + (pr >> 1) + 16 * (pr & 1); }
    return n;
}
__device__ __forceinline__ void p0_transpose_item(const float* W, int K, int Nsrc, int Ndst, bf16* WT, int ldw, int koff, const float* gs, int mat, LAS float* scr, int item, int lane) {
    const int nblk = Ndst / 32, kb = item / nblk, nb = item % nblk, k0 = 64 * kb, n0 = 32 * nb;
    const int sc = srccol(mat, n0 + (lane & 31));
#pragma unroll
    for (int i = 0; i < 32; ++i) { const int kk = 2 * i + (lane >> 5); float v = (sc >= 0) ? W[(size_t)(k0 + kk) * Nsrc + sc] : 0.f; if (gs) v *= gs[k0 + kk]; scr[kk * 33 + (lane & 31)] = v; }
    LDS_WAIT(); asm volatile("" ::: "memory");
    const int c = lane & 7;
#pragma unroll
    for (int j = 0; j < 4; ++j) { const int n = (lane >> 3) + 8 * j; const LAS float* s = scr + (8 * c) * 33 + n;
        v4u o; o.x = pk2(s[0 * 33], s[1 * 33]); o.y = pk2(s[2 * 33], s[3 * 33]); o.z = pk2(s[4 * 33], s[5 * 33]); o.w = pk2(s[6 * 33], s[7 * 33]);
        *(GAS v4u*)(WT + (size_t)(n0 + n) * ldw + koff + k0 + 8 * c) = o; }
    LDS_WAIT(); asm volatile("" ::: "memory");
}
__device__ __forceinline__ int ppos_dn(int c) { return (c & ~255) | (((c >> 5) & 3) << 6) | (((c >> 3) & 3) << 4) | (((c >> 7) & 1) << 3) | (c & 7); }
template <bool KPERM = false>
__device__ __forceinline__ void p0_transpose_item_f8(const float* W, int K, int N, int Nsrc, int coff, unsigned char* WT, float scale, LAS float* scr, int item, int lane) {
    const int nblk = N / 32, kb = item / nblk, nb = item % nblk, k0 = 64 * kb, n0 = 32 * nb;
#pragma unroll
    for (int i = 0; i < 32; ++i) { const int kk = 2 * i + (lane >> 5); scr[kk * 33 + (lane & 31)] = W[(size_t)(k0 + kk) * Nsrc + coff + n0 + (lane & 31)] * scale; }
    LDS_WAIT(); asm volatile("" ::: "memory");
    const int c = lane & 7;
#pragma unroll
    for (int j = 0; j < 4; ++j) { const int n = (lane >> 3) + 8 * j; const LAS float* s = scr + (8 * c) * 33 + n;
        int w0 = 0, w1 = 0;
        w0 = __builtin_amdgcn_cvt_pk_fp8_f32(s[0 * 33], s[1 * 33], w0, false); w0 = __builtin_amdgcn_cvt_pk_fp8_f32(s[2 * 33], s[3 * 33], w0, true);
        w1 = __builtin_amdgcn_cvt_pk_fp8_f32(s[4 * 33], s[5 * 33], w1, false); w1 = __builtin_amdgcn_cvt_pk_fp8_f32(s[6 * 33], s[7 * 33], w1, true);
        typedef int i32x2_ __attribute__((ext_vector_type(2)));
        *(GAS i32x2_*)(WT + (size_t)(n0 + n) * K + (KPERM ? ppos_dn(k0 + 8 * c) : k0 + 8 * c)) = (i32x2_){w0, w1}; }
    LDS_WAIT(); asm volatile("" ::: "memory");
}
__device__ __forceinline__ void rms_row_to_bf16(int lane, const f32x4 (&v)[4], const f32x4 (&g)[4], bf16* orow, unsigned char* orow8) {
    float s = 0.f;
#pragma unroll
    for (int j = 0; j < 4; ++j) s += (v[j].x * v[j].x + v[j].y * v[j].y) + (v[j].z * v[j].z + v[j].w * v[j].w);
    const float rstd = 1.f / sqrtf(wave_sum(s) * (1.f / DM) + EPS);
    GAS unsigned long long* o8 = (GAS unsigned long long*)orow + lane;
#pragma unroll
    for (int j = 0; j < 4; ++j) { const f32x4 y = v[j] * rstd * g[j]; o8[64 * j] = (unsigned long long)pk2(y.x, y.y) | ((unsigned long long)pk2(y.z, y.w) << 32);
        int w = 0; w = __builtin_amdgcn_cvt_pk_fp8_f32(y.x, y.y, w, false); w = __builtin_amdgcn_cvt_pk_fp8_f32(y.z, y.w, w, true); ((GAS int*)orow8)[lane + 64 * j] = w; }
}

struct Args { const float* in[17]; float* out; unsigned char* ws; int ph_lo, ph_hi, li, pad; };

__global__ void __launch_bounds__(NWAVES * 64, 2) block_fwd(Args args) {
    extern __shared__ __attribute__((aligned(16))) unsigned char lds[];
    Frame F;
    F.lds = (LAS unsigned char*)lds;
    F.MISC = (volatile LAS unsigned*)(F.lds + MISC_OFF);
    F.tid = threadIdx.x; F.lane = F.tid & 63; F.wave = __builtin_amdgcn_readfirstlane(F.tid >> 6);
    F.G = gridDim.x; { const int bx = blockIdx.x; F.vcu = (F.G % 8 == 0) ? (bx % 8) * (F.G / 8) + bx / 8 : bx; }
    unsigned char* ws = args.ws;
    F.ctl = (gu32*)(ws + WS_CTL);
    const float* x = args.in[0]; const int* positions = (const int*)args.in[1];
    const float *g_pre_mix = args.in[2], *w_in = args.in[3], *b_gate = args.in[4], *g_q = args.in[5], *w_uq = args.in[6], *g_kv = args.in[7], *w_ukv = args.in[8], *w_a = args.in[9], *w_b = args.in[10],
                *w_out = args.in[11], *g_post_mix = args.in[12], *g_pre_mlp = args.in[13], *w_up = args.in[14], *w_dn = args.in[15], *g_post_mlp = args.in[16];
    float* out = args.out;
    float* ropeA = (float*)(ws + WS_ROPEA); float* ropeB = (float*)(ws + WS_ROPEB);
    float* SS = (float*)(ws + WS_SS); float* SS2 = (float*)(ws + WS_SS2); float* SS3 = (float*)(ws + WS_SS3);
    bf16 *WIN = (bf16*)(ws + WS_WIN), *WUQ = (bf16*)(ws + WS_WUQ), *WUKV = (bf16*)(ws + WS_WUKV), *WA = (bf16*)(ws + WS_WA), *WOUT = (bf16*)(ws + WS_WOUT), *WUP = (bf16*)(ws + WS_WUP), *WDN = (bf16*)(ws + WS_WDN);
    bf16 *H = (bf16*)(ws + WS_H), *Gt = (bf16*)(ws + WS_G), *QA = (bf16*)(ws + WS_QA), *KA = (bf16*)(ws + WS_KA), *VA = (bf16*)(ws + WS_VA), *T = (bf16*)(ws + WS_T), *CQ = (bf16*)(ws + WS_CQ), *CKV = (bf16*)(ws + WS_CKV),
         *KR = (bf16*)(ws + WS_KR), *QB = (bf16*)(ws + WS_QB), *KB = (bf16*)(ws + WS_KB), *VB = (bf16*)(ws + WS_VB), *Y = (bf16*)(ws + WS_Y), *U = (bf16*)(ws + WS_U), *X1B = (bf16*)(ws + WS_X1); unsigned char *H8 = ws + WS_H8, *WG8 = ws + WS_WG8;
    for (int u = F.tid; u < (LDS_BYTES - LDSCTL_OFF) / 4; u += NWAVES * 64) ((LAS unsigned*)(F.lds + LDSCTL_OFF))[u] = 0u;
    __syncthreads();
    XcdBarrier bar = xcd_barrier_post((unsigned*)(F.ctl + CW_BAR) + args.li * XCD_BAR_WORDS, F.MISC + 8);
    const int lo = args.ph_lo, hi = args.ph_hi;
#define IN(k) (lo <= (k) && (k) < hi)
#define SEAM(k) do { if (IN(k) && IN((k) + 1)) xcd_barrier(bar); } while (0)
    const int gw = F.vcu * NWAVES + F.wave, NGW = F.G * NWAVES;

#if !defined(SKIP_P0)
    if (IN(0))
    {
        LAS float* scr = (LAS float*)(F.lds + RING_OFF + F.wave * 16384);
        constexpr int NBF = 2304, IG = (DM / 64) * (2 * DM / 32);
        constexpr int I0 = (DM / 64) * (NBF / 32), I1 = (QLORA / 64) * (768 / 32), I2 = (KVLORA / 64) * (1024 / 32), I3 = (AW / 64) * (DM / 32), I5 = (DM / 64) * (DM / 32), I6 = (DM / 64) * (DFF / 32), I7 = (DFF / 64) * (DM / 32);
        constexpr int NITEMS = I0 + I1 + I2 + 2 * I3 + I5 + I6 + I7 + IG;
        constexpr int TW = 4, RW = NWAVES - TW;
        if (F.wave >= RW)
        for (int it = F.vcu * TW + (F.wave - RW); it < NITEMS; it += F.G * TW) {
            int r = it;
            if (r < I0) { p0_transpose_item(w_in, DM, INW, NBF, WIN, LDH, 0, nullptr, 0, scr, r, F.lane); continue; } r -= I0;
            if (r < IG) { p0_transpose_item_f8(w_in, DM, 2 * DM, INW, 2208, WG8, 32.f, scr, r, F.lane); continue; } r -= IG;
            if (r < I1) { p0_transpose_item(w_uq, QLORA, 768, 768, WUQ, QLORA, 0, g_q, 1, scr, r, F.lane); continue; } r -= I1;
            if (r < I2) { p0_transpose_item(w_ukv, KVLORA, 1024, 1024, WUKV, LDKV, 0, g_kv, 2, scr, r, F.lane); continue; } r -= I2;
            if (r < I3) { p0_transpose_item(w_a, AW, DM, DM, WA, LDH, 0, nullptr, 2, scr, r, F.lane); continue; } r -= I3;
            if (r < I3) { p0_transpose_item(w_b, AW, DM, DM, WA, LDH, AW, nullptr, 2, scr, r, F.lane); continue; } r -= I3;
            if (r < I5) { p0_transpose_item_f8<true>(w_out, DM, DM, DM, 0, (unsigned char*)WOUT, 32.f, scr, r, F.lane); continue; } r -= I5;
            if (r < I6) { p0_transpose_item_f8(w_up, DM, DFF, DFF, 0, (unsigned char*)WUP, 32.f, scr, r, F.lane); continue; } r -= I6;
            p0_transpose_item_f8<true>(w_dn, DFF, DM, DM, 0, (unsigned char*)WDN, 64.f, scr, r, F.lane);
        }
        if (F.wave >= RW)
        for (int idx = (int)blockIdx.x * (TW * 64) + (F.tid - RW * 64); idx < MTOK * 24; idx += F.G * TW * 64) {
            const int m = idx / 24, i = idx - m * 24;
            const float invf = (i < 8) ? __builtin_amdgcn_exp2f(-(float)i * 2.3664460711655217f) : __builtin_amdgcn_exp2f(-(float)(i - 8) * 1.1832230355827609f);
            const float ang = (float)positions[m] * invf;
            double t = (double)ang * 0.15915494309189535; t -= floor(t);
            const float tf = (float)t; const float c = __builtin_amdgcn_cosf(tf), s = __builtin_amdgcn_sinf(tf);
            float* dst = (i < 8) ? ropeA + (size_t)m * 16 + 2 * i : ropeB + (size_t)m * 32 + 2 * (i - 8);
            *(f32x2g*)dst = (f32x2g){c, s};
        }
        f32x4 g[4];
#pragma unroll
        for (int j = 0; j < 4; ++j) g[j] = ((const GAS f32x4*)g_pre_mix)[F.lane + 64 * j];
        {
            f32x4 cv[4], n1[4], n2[4];
            const int rw0 = (F.wave < RW) ? F.vcu * RW + F.wave : MTOK, RST = F.G * RW;
#define P0_LOADROW(V, mm) do { _Pragma("unroll") for (int j = 0; j < 4; ++j) V[j] = ((const GAS f32x4*)(x + (size_t)(mm) * DM) + F.lane)[64 * j]; } while (0)
            if (rw0 < MTOK) P0_LOADROW(cv, rw0);
            if (rw0 + RST < MTOK) P0_LOADROW(n1, rw0 + RST);
            for (int m = rw0; m < MTOK; m += RST) {
                if (m + 2 * RST < MTOK) P0_LOADROW(n2, m + 2 * RST);
                rms_row_to_bf16(F.lane, cv, g, H + (size_t)m * LDH, H8 + (size_t)m * DM);
#pragma unroll
                for (int j = 0; j < 4; ++j) { cv[j] = n1[j]; n1[j] = n2[j]; }
            }
#undef P0_LOADROW
        }
    }
#endif
    SEAM(0);

#if !defined(SKIP_P1)
    if (IN(1))
    {
        { pg8::Gemm g{H, WIN, MTOK, 2304, DM, LDH, LDH}; pg8::StaticOrder S; S.init(MTOK, 2304, F.G, (int)blockIdx.x);
          pg8::EpiIn E{QA, KA, VA, CQ, CKV, KR, Gt, SS, ropeA, ropeB, b_gate};
          pg8::gemm_phase<pg8::EpiIn, pg8::StaticOrder, true, true>(F.lds + RING_OFF, g, S, E); }
        { pg8::Gemm g{(const bf16*)H8, (const bf16*)WG8, MTOK, 2 * DM, DM, DM, DM}; pg8::StaticOrder S; S.init(MTOK, 2 * DM, F.G, (int)blockIdx.x);
          pg8::EpiGates E{Gt, b_gate};
          pg8::gemm_phase<pg8::EpiGates, pg8::StaticOrder, true, true, 1>(F.lds + RING_OFF, g, S, E); }
    }
#endif
    SEAM(1);

#if !defined(SKIP_P2)
    if (IN(2)) {
    {
        pg8::Gemm g{CQ, WUQ, MTOK, NHEAD * QKB, QLORA}; pg8::StaticOrder S; S.init(MTOK, NHEAD * QKB, F.G, (int)blockIdx.x);
        pg8::EpiQ E{QB, SS, ropeB};
        pg8::gemm_phase<pg8::EpiQ, pg8::StaticOrder, true, true, 2, true>(F.lds + RING_OFF, g, S, E);
    }
    {
        pg8::Gemm g{CKV, WUKV, MTOK, 2 * AW, KVLORA, LDKV, LDKV}; pg8::StaticOrder S; S.init(MTOK, 2 * AW, F.G, (int)blockIdx.x);
        pg8::EpiKV E{KB, VB, SS};
        pg8::gemm_phase<pg8::EpiKV, pg8::StaticOrder, true, true, 2, true>(F.lds + RING_OFF, g, S, E);
    }
    }
#endif
    SEAM(2);

#if !defined(SKIP_P3)
    if (IN(3))
    {
        LAS char* al = (LAS char*)(F.lds + RING_OFF);
#if !defined(SKIP_MOBA)
        for (int bh = F.vcu; bh < NB * NHEAD; bh += F.G) {
            const int b = bh >> 3, h = bh & 7; const size_t r0 = (size_t)b * SEQ;
            att::kmean_blocks(KA + r0 * AW + h * HD * 16, al);
#pragma unroll 1
            for (int qb = 0; qb < 8; ++qb) att::moba_unit(QA + r0 * AW + h * HD * 16, KA + r0 * AW + h * HD * 16, VA + r0 * AW + h * HD * 16, H + r0 * LDH + h * HD, LDH, qb, al);
        }
#endif
#if !defined(SKIP_MLA)
        for (int bh = F.vcu; bh < NB * NHEAD; bh += F.G) {
            const int b = bh >> 3, h = bh & 7; const size_t r0 = (size_t)b * SEQ;
#pragma unroll 1
            for (int qb = 0; qb < 8; ++qb) att::mla_unit(QB + r0 * (NHEAD * QKB) + h * QKB * 16, KB + r0 * AW + h * HD * 16, KR + r0 * RDIM, VB + r0 * AW + h * HD * 16, H + r0 * LDH + AW + h * HD, LDH, qb, al);
        }
#endif
    }
#endif
    SEAM(3);

#if !defined(SKIP_P4)
    if (IN(4))
    {
        pg8::Gemm g{H, WA, MTOK, DM, DM, LDH, LDH}; pg8::StaticOrder S; S.init(MTOK, DM, F.G, (int)blockIdx.x);
        pg8::EpiMerge E{Gt, T};
        pg8::gemm_phase<pg8::EpiMerge, pg8::StaticOrder, true, true>(F.lds + RING_OFF, g, S, E);
    }
#endif
    SEAM(4);

#if !defined(SKIP_P5)
    if (IN(5))
    {
        pg8::Gemm g{T, WOUT, MTOK, DM, DM, DM, DM}; pg8::StaticOrder S; S.init(MTOK, DM, F.G, (int)blockIdx.x);
        pg8::EpiSS E{Y, SS2, DM, 1.0f / 2048.0f};
        pg8::gemm_phase<pg8::EpiSS, pg8::StaticOrder, true, true, 1, true>(F.lds + RING_OFF, g, S, E);
    }
#endif
    SEAM(5);

#if !defined(SKIP_P6)
    if (IN(6))
    {
        f32x4 g1[4], g2[4];
#pragma unroll
        for (int j = 0; j < 4; ++j) { g1[j] = ((const GAS f32x4*)g_post_mix)[F.lane + 64 * j]; g2[j] = ((const GAS f32x4*)g_pre_mlp)[F.lane + 64 * j]; }
        f32x4 ca, cb, cc, cd, cx[4]; unsigned long long cy[4];
#define P6_LOAD(A, B, C, D, X, Yv, mm) do { const GAS f32x4* sp_ = (const GAS f32x4*)(SS2 + (size_t)(mm) * 16); A = sp_[0]; B = sp_[1]; C = sp_[2]; D = sp_[3]; \
            const GAS f32x4* xr_ = (const GAS f32x4*)(x + (size_t)(mm) * DM) + F.lane; const GAS unsigned long long* yr_ = (const GAS unsigned long long*)(Y + (size_t)(mm) * DM) + F.lane; \
            _Pragma("unroll") for (int j = 0; j < 4; ++j) { X[j] = xr_[64 * j]; Yv[j] = yr_[64 * j]; } } while (0)
        if (gw < MTOK) P6_LOAD(ca, cb, cc, cd, cx, cy, gw);
        for (int m = gw; m < MTOK; m += NGW) {
            f32x4 na, nb, nc, nd, nx[4]; unsigned long long ny[4];
            const bool more = m + NGW < MTOK;
            if (more) P6_LOAD(na, nb, nc, nd, nx, ny, m + NGW);
            const f32x4 a = ca, b = cb, c = cc, d = cd;
            const float ssy = (((a.x + a.y) + (a.z + a.w)) + ((b.x + b.y) + (b.z + b.w))) + (((c.x + c.y) + (c.z + c.w)) + ((d.x + d.y) + (d.z + d.w)));
            const float rsy = 1.f / sqrtf(ssy * (1.f / DM) + EPS);
            GAS unsigned long long* x8 = (GAS unsigned long long*)(X1B + (size_t)m * DM) + F.lane;
            f32x4 v[4]; float s = 0.f;
#pragma unroll
            for (int j = 0; j < 4; ++j) { const unsigned long long yw = cy[j]; const unsigned lo = (unsigned)yw, hi = (unsigned)(yw >> 32);
                const f32x4 yv = (f32x4){__uint_as_float(lo << 16), __uint_as_float(lo & 0xffff0000u), __uint_as_float(hi << 16), __uint_as_float(hi & 0xffff0000u)};
                v[j] = cx[j] + yv * rsy * g1[j]; x8[64 * j] = (unsigned long long)pk2(v[j].x, v[j].y) | ((unsigned long long)pk2(v[j].z, v[j].w) << 32);
                s += (v[j].x * v[j].x + v[j].y * v[j].y) + (v[j].z * v[j].z + v[j].w * v[j].w); }
            const float rstd = 1.f / sqrtf(wave_sum(s) * (1.f / DM) + EPS);
            GAS int* o8 = (GAS int*)((unsigned char*)H + (size_t)m * DM) + F.lane;
#pragma unroll
            for (int j = 0; j < 4; ++j) { const f32x4 y2 = v[j] * rstd * g2[j]; int w = 0; w = __builtin_amdgcn_cvt_pk_fp8_f32(y2.x, y2.y, w, false); w = __builtin_amdgcn_cvt_pk_fp8_f32(y2.z, y2.w, w, true); o8[64 * j] = w; }
            if (more) { ca = na; cb = nb; cc = nc; cd = nd;
#pragma unroll
                for (int j = 0; j < 4; ++j) { cx[j] = nx[j]; cy[j] = ny[j]; } }
        }
#undef P6_LOAD
    }
#endif
    SEAM(6);

#if !defined(SKIP_P7)
    if (IN(7))
    {
        pg8::Gemm g{H, WUP, MTOK, DFF, DM, DM, DM}; pg8::StaticOrder S; S.init(MTOK, DFF, F.G, (int)blockIdx.x);
        pg8::EpiRelu2F8 E{(unsigned char*)U, 1.0f / 32.0f};
        pg8::gemm_phase<pg8::EpiRelu2F8, pg8::StaticOrder, true, true, 1>(F.lds + RING_OFF, g, S, E);
    }
#endif
    SEAM(7);

#if !defined(SKIP_P8)
    if (IN(8))
    {
        pg8::Gemm g{U, WDN, MTOK, DM, DFF, DFF, DFF}; pg8::StaticOrder S; S.init(MTOK, DM, F.G, (int)blockIdx.x);
        pg8::EpiSS E{H, SS3, LDH, 1.0f / 64.0f};
        pg8::gemm_phase<pg8::EpiSS, pg8::StaticOrder, true, true, 1, true>(F.lds + RING_OFF, g, S, E);
    }
#endif
    SEAM(8);

#if !defined(SKIP_P9)
    if (IN(9))
    {
        f32x4 g1[4];
#pragma unroll
        for (int j = 0; j < 4; ++j) g1[j] = ((const GAS f32x4*)g_post_mlp)[F.lane + 64 * j];
        f32x4 ca, cb, cc, cd; unsigned long long cy[4], cq[4];
#define P9_LOAD(A, B, C, D, Yv, Q, mm) do { const GAS f32x4* sp_ = (const GAS f32x4*)(SS3 + (size_t)(mm) * 16); A = sp_[0]; B = sp_[1]; C = sp_[2]; D = sp_[3]; \
            const GAS unsigned long long* yr_ = (const GAS unsigned long long*)(H + (size_t)(mm) * LDH) + F.lane; const GAS unsigned long long* xq_ = (const GAS unsigned long long*)(X1B + (size_t)(mm) * DM) + F.lane; \
            _Pragma("unroll") for (int j = 0; j < 4; ++j) { Yv[j] = yr_[64 * j]; Q[j] = xq_[64 * j]; } } while (0)
        if (gw < MTOK) P9_LOAD(ca, cb, cc, cd, cy, cq, gw);
        for (int m = gw; m < MTOK; m += NGW) {
            f32x4 na, nb, nc, nd; unsigned long long ny[4], nq[4];
            const bool more = m + NGW < MTOK;
            if (more) P9_LOAD(na, nb, nc, nd, ny, nq, m + NGW);
            const f32x4 a = ca, b = cb, c = cc, d = cd;
            const float ssy = (((a.x + a.y) + (a.z + a.w)) + ((b.x + b.y) + (b.z + b.w))) + (((c.x + c.y) + (c.z + c.w)) + ((d.x + d.y) + (d.z + d.w)));
            const float rsy = 1.f / sqrtf(ssy * (1.f / DM) + EPS);
            GAS f32x4* o4 = (GAS f32x4*)(out + (size_t)m * DM) + F.lane;
#pragma unroll
            for (int j = 0; j < 4; ++j) { const unsigned long long yw = cy[j]; const unsigned lo = (unsigned)yw, hi = (unsigned)(yw >> 32);
                const f32x4 yv = (f32x4){__uint_as_float(lo << 16), __uint_as_float(lo & 0xffff0000u), __uint_as_float(hi << 16), __uint_as_float(hi & 0xffff0000u)};
                const unsigned long long xw = cq[j]; const unsigned xl = (unsigned)xw, xh = (unsigned)(xw >> 32);
                const f32x4 xv = (f32x4){__uint_as_float(xl << 16), __uint_as_float(xl & 0xffff0000u), __uint_as_float(xh << 16), __uint_as_float(xh & 0xffff0000u)};
                o4[64 * j] = xv + yv * rsy * g1[j]; }
            if (more) { ca = na; cb = nb; cc = nc; cd = nd;
#pragma unroll
                for (int j = 0; j < 4; ++j) { cy[j] = ny[j]; cq[j] = nq[j]; } }
        }
#undef P9_LOAD
    }
#endif
}

extern "C" void kernel_launch(void* const* d_in, const int* in_sizes, int n_in, void* d_out, int out_size, void* d_ws, size_t ws_size, hipStream_t stream) {
    static int grid = 0;
    if (grid == 0) {
        if (n_in != 17 || in_sizes[0] != MTOK * DM || out_size != MTOK * DM || ws_size < WS_END) { fprintf(stderr, "kernel_launch: unexpected shapes (n_in %d, in0 %d, out %d, ws %zu); nothing launched\n", n_in, n_in > 0 ? in_sizes[0] : -1, out_size, ws_size); grid = -1; return; }
        int dev = 0, cus = 0, per_cu = 0;
        if (hipGetDevice(&dev) != hipSuccess || hipDeviceGetAttribute(&cus, hipDeviceAttributeMultiprocessorCount, dev) != hipSuccess) { fprintf(stderr, "kernel_launch: device query failed\n"); grid = -1; return; }
        if (hipFuncSetAttribute((const void*)block_fwd, hipFuncAttributeMaxDynamicSharedMemorySize, LDS_BYTES) != hipSuccess) { fprintf(stderr, "kernel_launch: hipFuncSetAttribute failed\n"); grid = -1; return; }
        if (hipOccupancyMaxActiveBlocksPerMultiprocessor(&per_cu, (const void*)block_fwd, NWAVES * 64, LDS_BYTES) != hipSuccess || per_cu < 1) { fprintf(stderr, "kernel_launch: occupancy query reports %d workgroups per CU\n", per_cu); }
        (void)hipGetLastError();
        grid = cus;
    }
    if (grid < 0) return;
    if (hipMemsetAsync((char*)d_ws + WS_CTL, 0, CTL_ZERO_BYTES, stream) != hipSuccess) { fprintf(stderr, "kernel_launch: hipMemsetAsync failed\n"); return; }
    Args a{};
    for (int i = 0; i < 17; ++i) a.in[i] = (const float*)d_in[i];
    a.out = (float*)d_out; a.ws = (unsigned char*)d_ws;
    a.ph_lo = 0; a.ph_hi = 10; a.li = 0;
    hipLaunchKernelGGL(block_fwd, dim3(grid), dim3(NWAVES * 64), LDS_BYTES, stream, a);
    const hipError_t le = hipPeekAtLastError();
    if (le != hipSuccess) fprintf(stderr, "kernel_launch: launch failed: %s\n", hipGetErrorName(le));
}
```

```cpp
#include <hip/hip_runtime.h>
#include <hip/hip_bf16.h>
#include <cstdio>
#include <cstdint>
#include <cmath>
constexpr int NB = 32, SEQ = 2048, DM = 1024, MTOK = NB * SEQ;
constexpr int NHEAD = 8, HD = 64, AW = NHEAD * HD;
constexpr int QLORA = 384, KVLORA = 256, RDIM = 32, QKB = 96;
constexpr int DFF = 4096, INW = 4256, INWP = 4352;
constexpr int LDH = DM, LDU = DFF, LDKV = KVLORA;
constexpr float EPS = 1e-6f;
constexpr float LOG2E = 1.4426950408889634f;
constexpr float C2A = 0.125f * LOG2E;
constexpr float C2B = 0.10206207261596575f * LOG2E;
typedef float f32x2g __attribute__((ext_vector_type(2)));
namespace pg8 {
#define PG8_LAS __attribute__((address_space(3)))
typedef unsigned short bf16_t;
typedef short bf16x8 __attribute__((ext_vector_type(8)));
typedef float f32x4 __attribute__((ext_vector_type(4)));
typedef unsigned u32x4 __attribute__((ext_vector_type(4)));
constexpr int BM = 256, BK = 64, HALF = 128, HTB = HALF * BK * 2  , STAGE_BYTES = 8 * HTB, NXCD = 8, WGM = 8;

__host__ __device__ __forceinline__ int lds_byte(int r, int c) { const int st = (r >> 4) * 2 + (c >> 5), rr = r & 15, cc = c & 31, ob = rr * 64 + cc * 2; return st * 1024 + (ob ^ (((ob >> 9) & 1) << 5)); }
__host__ __device__ __forceinline__ void stage_rc(int b, int& R, int& C) { const int st = b / 1024, sb = b % 1024, swz = sb ^ (((sb >> 9) & 1) << 5); R = (st >> 1) * 16 + swz / 64; C = (st & 1) * 32 + (swz % 64) / 2; }
__host__ __device__ __forceinline__ int perm32(int rho) { const int n = rho >> 4, i = rho & 15; return 8 * (i >> 2) + 4 * n + (i & 3); }

struct Unit { int pm, pn; };
struct Gemm { const bf16_t* A; const bf16_t* Bt; int M, N, K, lda, ldb; };

struct StaticOrder {
    int nM, nN, nwg, G, c;
    __host__ __device__ void init(int M, int N, int G_, int c_) { nM = M / BM; nN = N / BM; nwg = nM * nN; G = G_; c = c_; }
    __host__ __device__ bool next(int i, Unit& u) const {
        const long L = (long)i * G + c; if (L >= nwg) return false;
        int wgid = (int)L; { const int q = nwg / NXCD, r = nwg % NXCD, xcd = wgid % NXCD, off = wgid / NXCD; wgid = (xcd < r ? xcd * (q + 1) : r * (q + 1) + (xcd - r) * q) + off; }
        const int nig = WGM * nN, gid = wgid / nig, fm = gid * WGM, gsz = (nM - fm) < WGM ? (nM - fm) : WGM;
        u.pm = fm + ((wgid % nig) % gsz); u.pn = (wgid % nig) / gsz; return true;
    }
    __device__ __forceinline__ void a_ready(const Unit&) const {}
    __device__ __forceinline__ void done(const Unit&) const {}
};

__device__ __forceinline__ unsigned cvt_pk_bf16(float lo, float hi) { unsigned r; asm volatile("v_cvt_pk_bf16_f32 %0, %1, %2" : "=v"(r) : "v"(lo), "v"(hi)); return r; }
__device__ __forceinline__ void ld8(float (&v)[8], const f32x4& a, const f32x4& b) { v[0] = a[0]; v[1] = a[1]; v[2] = a[2]; v[3] = a[3]; v[4] = b[0]; v[5] = b[1]; v[6] = b[2]; v[7] = b[3]; }
typedef float f32x2c_t __attribute__((ext_vector_type(2))); typedef __bf16 bf16x2c_t __attribute__((ext_vector_type(2)));
__device__ __forceinline__ unsigned cvtpk_c(float lo, float hi) { const f32x2c_t v = {lo, hi}; const bf16x2c_t b = __builtin_convertvector(v, bf16x2c_t); return __builtin_bit_cast(unsigned, b); }
__device__ __forceinline__ u32x4 pack8(const float (&v)[8]) { u32x4 w; w.x = cvtpk_c(v[0], v[1]); w.y = cvtpk_c(v[2], v[3]); w.z = cvtpk_c(v[4], v[5]); w.w = cvtpk_c(v[6], v[7]); return w; }
__device__ __forceinline__ void unpack8(const u32x4 w, float (&v)[8]) {
    v[0] = __uint_as_float(w.x << 16); v[1] = __uint_as_float(w.x & 0xffff0000u); v[2] = __uint_as_float(w.y << 16); v[3] = __uint_as_float(w.y & 0xffff0000u);
    v[4] = __uint_as_float(w.z << 16); v[5] = __uint_as_float(w.z & 0xffff0000u); v[6] = __uint_as_float(w.w << 16); v[7] = __uint_as_float(w.w & 0xffff0000u); }
__device__ __forceinline__ void rope4(float (&v)[8], const f32x4 a, const f32x4 b) {
    float x1, x2;
    x1 = v[0]; x2 = v[1]; v[0] = x1 * a[0] - x2 * a[1]; v[1] = x2 * a[0] + x1 * a[1];
    x1 = v[2]; x2 = v[3]; v[2] = x1 * a[2] - x2 * a[3]; v[3] = x2 * a[2] + x1 * a[3];
    x1 = v[4]; x2 = v[5]; v[4] = x1 * b[0] - x2 * b[1]; v[5] = x2 * b[0] + x1 * b[1];
    x1 = v[6]; x2 = v[7]; v[6] = x1 * b[2] - x2 * b[3]; v[7] = x2 * b[2] + x1 * b[3];
}
__device__ __forceinline__ float sumsq8(const float (&v)[8]) { return ((v[0] * v[0] + v[1] * v[1]) + (v[2] * v[2] + v[3] * v[3])) + ((v[4] * v[4] + v[5] * v[5]) + (v[6] * v[6] + v[7] * v[7])); }
__device__ __forceinline__ float red_fq(float s) { s += __shfl_xor(s, 16); s += __shfl_xor(s, 32); return s; }

__device__ __forceinline__ size_t chk_off(int r16, int c32, int ld) { return (size_t)r16 * ld + (size_t)c32 * 16; }
__device__ __forceinline__ size_t gfrag_off(int pm, int t8, int wid, int grp, int lane) { return ((((size_t)(pm * 8 + t8) * 8 + wid) * 16 + grp) * 64 + lane) * 8; }
struct EpiIn {
    static constexpr bool PERM = true, AFTER_DRAIN = false; static constexpr int MIDT = 0;
    bf16_t *QA, *KA, *VA, *CQ, *CKV, *KR, *G; float* SS; const float* ropeA; const float* ropeB; const float* bgate;
    __device__ __forceinline__ void operator()(const f32x4 (&acc)[2][2][4][2], const Unit& u, int wr, int wc, int fr, int fq) const {
        asm volatile("" : "+v"(fr), "+v"(fq));
        const int row0 = u.pm * BM + wr * 64 + fr, pn = u.pn, cl = wc * 32 + 8 * fq;
        if (pn < 4) {
            bf16_t* dst = (pn < 2) ? QA : KA; const float sc = (pn < 2) ? C2A : 1.f; const int cb = (pn & 1) * 256 + wc * 32, l8 = (fq * 16 + fr) * 8;
            if ((wc & 1) == 0) {
                const bool rp = fq < 2;
#pragma unroll
                for (int ai = 0; ai < 2; ++ai)
#pragma unroll
                    for (int m = 0; m < 4; ++m) { const int row = row0 + ai * HALF + m * 16;
                        const f32x4* t = (const f32x4*)(ropeA + (size_t)row * 16 + (rp ? fq * 8 : 0));
                        f32x4 ca = t[0], cc = t[1]; if (!rp) { ca = (f32x4){1.f, 0.f, 1.f, 0.f}; cc = ca; }
#pragma unroll
                        for (int bj = 0; bj < 2; ++bj) { float v[8]; ld8(v, acc[ai][bj][m][0], acc[ai][bj][m][1]); rope4(v, ca, cc);
#pragma unroll
                            for (int j = 0; j < 8; ++j) v[j] *= sc;
                            *(u32x4*)(dst + chk_off(row - fr, cb + bj * HALF, AW) + l8) = pack8(v); } }
            } else {
#pragma unroll
                for (int ai = 0; ai < 2; ++ai)
#pragma unroll
                    for (int m = 0; m < 4; ++m) { const int row = row0 + ai * HALF + m * 16;
#pragma unroll
                        for (int bj = 0; bj < 2; ++bj) { float v[8]; ld8(v, acc[ai][bj][m][0], acc[ai][bj][m][1]);
#pragma unroll
                            for (int j = 0; j < 8; ++j) v[j] *= sc;
                            *(u32x4*)(dst + chk_off(row - fr, cb + bj * HALF, AW) + l8) = pack8(v); } }
            }
        } else if (pn < 6) {
            const int cb = (pn - 4) * 256 + wc * 32, l8 = (fq * 16 + fr) * 8;
#pragma unroll
            for (int ai = 0; ai < 2; ++ai)
#pragma unroll
                for (int m = 0; m < 4; ++m) { const int row = row0 + ai * HALF + m * 16;
#pragma unroll
                    for (int bj = 0; bj < 2; ++bj) { float v[8]; ld8(v, acc[ai][bj][m][0], acc[ai][bj][m][1]); *(u32x4*)(VA + chk_off(row - fr, cb + bj * HALF, AW) + l8) = pack8(v); } }
        } else if (pn == 6 || pn == 8) {
            bf16_t* dst = (pn == 6) ? CQ : CKV; const int ld = (pn == 6) ? QLORA : LDKV, slot = ((pn == 6) ? 0 : 8) + wc;
#pragma unroll
            for (int ai = 0; ai < 2; ++ai)
#pragma unroll
                for (int m = 0; m < 4; ++m) { const int row = row0 + ai * HALF + m * 16; float s = 0.f;
#pragma unroll
                    for (int bj = 0; bj < 2; ++bj) { float v[8]; ld8(v, acc[ai][bj][m][0], acc[ai][bj][m][1]); s += sumsq8(v); *(u32x4*)(dst + chk_off(row - fr, wc * 32 + bj * HALF, ld) + (fq * 16 + fr) * 8) = pack8(v); }
                    s = red_fq(s); if (fq == 0) SS[(size_t)row * 12 + slot] = s; }
        } else if (pn == 7) {
#pragma unroll
            for (int ai = 0; ai < 2; ++ai)
#pragma unroll
                for (int m = 0; m < 4; ++m) { const int row = row0 + ai * HALF + m * 16;
                    { float v[8]; ld8(v, acc[ai][0][m][0], acc[ai][0][m][1]); float s = red_fq(sumsq8(v)); *(u32x4*)(CQ + chk_off(row - fr, 256 + wc * 32, QLORA) + (fq * 16 + fr) * 8) = pack8(v); if (fq == 0) SS[(size_t)row * 12 + 4 + wc] = s; }
                    if (wc == 0) { float v[8]; ld8(v, acc[ai][1][m][0], acc[ai][1][m][1]); const f32x4* t = (const f32x4*)(ropeB + (size_t)row * 32 + fq * 8); rope4(v, t[0], t[1]);
                        *(u32x4*)(KR + chk_off(row - fr, 0, RDIM) + (fq * 16 + fr) * 8) = pack8(v); } }
        }
    }
};
struct EpiGates {
    static constexpr bool PERM = true, AFTER_DRAIN = false; static constexpr int MIDT = 0;
    bf16_t* G; const float* bgate;
    __device__ __forceinline__ void operator()(const f32x4 (&acc)[2][2][4][2], const Unit& u, int wr, int wc, int fr, int fq) const {
        asm volatile("" : "+v"(fr), "+v"(fq));
        const int gc = u.pn * 256 + wc * 32 + 8 * fq;
        f32x4 bv[2][2];
#pragma unroll
        for (int bj = 0; bj < 2; ++bj)
#pragma unroll
            for (int n = 0; n < 2; ++n) bv[bj][n] = *(const f32x4*)(bgate + gc + bj * HALF + 4 * n);
#pragma unroll
        for (int ai = 0; ai < 2; ++ai)
#pragma unroll
            for (int m = 0; m < 4; ++m) {
#pragma unroll
                for (int bj = 0; bj < 2; ++bj) { float v[8]; ld8(v, acc[ai][bj][m][0] * (1.0f / 32.0f) + bv[bj][0], acc[ai][bj][m][1] * (1.0f / 32.0f) + bv[bj][1]);
#pragma unroll
                    for (int j = 0; j < 8; ++j) v[j] = __builtin_amdgcn_rcpf(1.f + __builtin_amdgcn_exp2f(-LOG2E * v[j]));
                    *(u32x4*)(G + gfrag_off(u.pm, u.pn, wr * 4 + wc, ai * 8 + m * 2 + bj, fq * 16 + fr)) = pack8(v); } }
    }
};
struct EpiQ {
    static constexpr bool PERM = true, AFTER_DRAIN = false; static constexpr int MIDT = 0;
    bf16_t* QB; const float* SS; const float* ropeB;
    __device__ __forceinline__ void operator()(const f32x4 (&acc)[2][2][4][2], const Unit& u, int wr, int wc, int fr, int fq) const {
        asm volatile("" : "+v"(fr), "+v"(fq));
        const int row0 = u.pm * BM + wr * 64 + fr, cl = u.pn * BM + wc * 32 + 8 * fq;
        const int c0 = cl, c1 = cl + HALF, h0 = c0 / QKB, h1 = c1 / QKB, p0 = c0 - h0 * QKB, p1 = c1 - h1 * QKB;
        const bool r0 = p0 >= 64, r1 = p1 >= 64; const int roff = r0 ? p0 - 64 : (r1 ? p1 - 64 : 0);
#pragma unroll
        for (int b = 0; b < 2; ++b) {
            f32x4 s0[4], s1[4], ta[4], tb[4];
#pragma unroll
            for (int m = 0; m < 4; ++m) { const int row = row0 + b * HALF + m * 16;
                const f32x4* sp = (const f32x4*)(SS + (size_t)row * 12); s0[m] = sp[0]; s1[m] = sp[1];
                const f32x4* t = (const f32x4*)(ropeB + (size_t)row * 32 + roff); ta[m] = t[0]; tb[m] = t[1]; }
            asm volatile("" ::: "memory");
#pragma unroll
            for (int m = 0; m < 4; ++m) { const int row = row0 + b * HALF + m * 16;
                const float ss = ((s0[m][0] + s0[m][1]) + (s0[m][2] + s0[m][3])) + ((s1[m][0] + s1[m][1]) + (s1[m][2] + s1[m][3]));
                const float rs = __builtin_amdgcn_rsqf(ss * (1.0f / QLORA) + EPS) * C2B;
#pragma unroll
                for (int bj = 0; bj < 2; ++bj) { float v[8]; ld8(v, acc[b][bj][m][0], acc[b][bj][m][1]);
#pragma unroll
                    for (int j = 0; j < 8; ++j) v[j] *= rs;
                    if (bj == 0 ? r0 : r1) rope4(v, ta[m], tb[m]);
                    *(u32x4*)(QB + chk_off(row - fr, (bj == 0 ? c0 : c1) - 8 * fq, NHEAD * QKB) + (fq * 16 + fr) * 8) = pack8(v); } }
        }
    }
};
struct EpiKV {
    static constexpr bool PERM = true, AFTER_DRAIN = false; static constexpr int MIDT = 0;
    bf16_t *KB, *VB; const float* SS;
    __device__ __forceinline__ void operator()(const f32x4 (&acc)[2][2][4][2], const Unit& u, int wr, int wc, int fr, int fq) const {
        asm volatile("" : "+v"(fr), "+v"(fq));
        const int row0 = u.pm * BM + wr * 64 + fr;
        bf16_t* dst = (wc < 2) ? KB : VB; const int pc = (wc & 1) * 32, l8 = (fq * 16 + fr) * 8;
        f32x4 s0[2][4];
#pragma unroll
        for (int ai = 0; ai < 2; ++ai)
#pragma unroll
            for (int m = 0; m < 4; ++m) s0[ai][m] = *(const f32x4*)(SS + (size_t)(row0 + ai * HALF + m * 16) * 12 + 8);
#pragma unroll
        for (int ai = 0; ai < 2; ++ai)
#pragma unroll
            for (int m = 0; m < 4; ++m) { const int row = row0 + ai * HALF + m * 16; const f32x4 sv = s0[ai][m];
                const float rs = __builtin_amdgcn_rsqf(((sv[0] + sv[1]) + (sv[2] + sv[3])) * (1.0f / KVLORA) + EPS);
#pragma unroll
                for (int bj = 0; bj < 2; ++bj) { const int hd = u.pn * 2 + bj;
                    float v[8]; ld8(v, acc[ai][bj][m][0], acc[ai][bj][m][1]);
#pragma unroll
                    for (int j = 0; j < 8; ++j) v[j] *= rs;
                    *(u32x4*)(dst + chk_off(row - fr, hd * HD + pc, AW) + l8) = pack8(v); } }
    }
};
struct EpiMerge {
    static constexpr bool PERM = true, AFTER_DRAIN = false; static constexpr int MIDT = 8;
    const bf16_t* G; bf16_t* T;
    __device__ __forceinline__ void mid(f32x4 (&acc)[2][2][4][2], const Unit& u, int wr, int wc, int fr, int fq) const {
        asm volatile("" : "+v"(fr), "+v"(fq));
        const bf16_t* pa = G + gfrag_off(u.pm, u.pn, wr * 4 + wc, 0, fq * 16 + fr); const bf16_t* pb = G + gfrag_off(u.pm, 4 + u.pn, wr * 4 + wc, 0, fq * 16 + fr);
        u32x4 ca[4], cb[4], na[4], nb[4];
#pragma unroll
        for (int i = 0; i < 4; ++i) { ca[i] = *(const u32x4*)(pa + (size_t)i * 512); cb[i] = *(const u32x4*)(pb + (size_t)i * 512); }
#pragma unroll
        for (int b = 0; b < 4; ++b) {
            if (b < 3) {
#pragma unroll
                for (int i = 0; i < 4; ++i) { na[i] = *(const u32x4*)(pa + (size_t)((b + 1) * 4 + i) * 512); nb[i] = *(const u32x4*)(pb + (size_t)((b + 1) * 4 + i) * 512); } }
            asm volatile("" ::: "memory");
#pragma unroll
            for (int i = 0; i < 4; ++i) { const int grp = b * 4 + i, ai = grp >> 3, m = (grp >> 1) & 3, bj = grp & 1; float ga[8], gb[8]; unpack8(ca[i], ga); unpack8(cb[i], gb);
#pragma unroll
                for (int j = 0; j < 8; ++j) ga[j] *= __builtin_amdgcn_rcpf(__builtin_fmaxf(gb[j], 1e-30f));
                acc[ai][bj][m][0] *= (f32x4){ga[0], ga[1], ga[2], ga[3]}; acc[ai][bj][m][1] *= (f32x4){ga[4], ga[5], ga[6], ga[7]}; }
#pragma unroll
            for (int i = 0; i < 4; ++i) { ca[i] = na[i]; cb[i] = nb[i]; }
        }
    }
    __device__ __forceinline__ void operator()(const f32x4 (&acc)[2][2][4][2], const Unit& u, int wr, int wc, int fr, int fq) const {
        asm volatile("" : "+v"(fr), "+v"(fq));
        unsigned char* base = (unsigned char*)T + ((size_t)(u.pm * 16 + wr * 4) * 16 + u.pn * 4 + wc) * 1024 + (unsigned)(fq * 16 + fr) * 16u;
        const bf16_t* pb = G + gfrag_off(u.pm, 4 + u.pn, wr * 4 + wc, 0, fq * 16 + fr);
        u32x4 cb[8], nb[8];
#pragma unroll
        for (int i = 0; i < 8; ++i) cb[i] = *(const u32x4*)(pb + (size_t)i * 512);
#pragma unroll
        for (int b = 0; b < 2; ++b) {
            if (b < 1) {
#pragma unroll
                for (int i = 0; i < 8; ++i) nb[i] = *(const u32x4*)(pb + (size_t)(8 + i) * 512); }
            asm volatile("" ::: "memory");
#pragma unroll
            for (int i2 = 0; i2 < 4; ++i2) { int w[4];
#pragma unroll
                for (int bj = 0; bj < 2; ++bj) { const int i = 2 * i2 + bj, grp = b * 8 + i, ai = grp >> 3, m = (grp >> 1) & 3; float v[8], gb[8]; ld8(v, acc[ai][bj][m][0], acc[ai][bj][m][1]); unpack8(cb[i], gb);
#pragma unroll
                    for (int j = 0; j < 8; ++j) v[j] = __builtin_fminf(__builtin_fmaxf(v[j] * (64.f * __builtin_fmaxf(gb[j], 1e-30f)), -448.f), 448.f);
                    int w0 = 0, w1 = 0;
                    w0 = __builtin_amdgcn_cvt_pk_fp8_f32(v[0], v[1], w0, false); w0 = __builtin_amdgcn_cvt_pk_fp8_f32(v[2], v[3], w0, true);
                    w1 = __builtin_amdgcn_cvt_pk_fp8_f32(v[4], v[5], w1, false); w1 = __builtin_amdgcn_cvt_pk_fp8_f32(v[6], v[7], w1, true);
                    w[2 * bj] = w0; w[2 * bj + 1] = w1; }
                typedef int i32x4m_ __attribute__((ext_vector_type(4)));
                *(i32x4m_*)(base + (size_t)(b * 8 + i2) * 16384) = (i32x4m_){w[0], w[1], w[2], w[3]}; }
#pragma unroll
            for (int i = 0; i < 8; ++i) cb[i] = nb[i];
        }
    }
};
struct EpiSS {
    static constexpr bool PERM = true, AFTER_DRAIN = false; static constexpr int MIDT = 0;
    bf16_t* Y; float* SSY; int ldy; float scale;
    __device__ __forceinline__ void operator()(const f32x4 (&acc)[2][2][4][2], const Unit& u, int wr, int wc, int fr, int fq) const {
        asm volatile("" : "+v"(fr), "+v"(fq));
        const int row0 = u.pm * BM + wr * 64 + fr, cl = u.pn * BM + wc * 32 + 8 * fq;
        const int lane_ = fq * 16 + fr, bpa = ((lane_ & 3) * 16 + (lane_ >> 2)) * 4; bf16_t* yst = Y + (size_t)(u.pm * BM + wr * 64 + (lane_ >> 2)) * ldy + u.pn * BM + wc * 32 + 8 * (lane_ & 3);
#pragma unroll
        for (int ai = 0; ai < 2; ++ai)
#pragma unroll
            for (int m = 0; m < 4; ++m) { const int row = row0 + ai * HALF + m * 16; float s = 0.f;
#pragma unroll
                for (int bj = 0; bj < 2; ++bj) { float v[8]; ld8(v, acc[ai][bj][m][0] * scale, acc[ai][bj][m][1] * scale); s += sumsq8(v); const u32x4 w_ = pack8(v); u32x4 t_;
                    t_.x = (unsigned)__builtin_amdgcn_ds_bpermute(bpa, (int)w_.x); t_.y = (unsigned)__builtin_amdgcn_ds_bpermute(bpa, (int)w_.y); t_.z = (unsigned)__builtin_amdgcn_ds_bpermute(bpa, (int)w_.z); t_.w = (unsigned)__builtin_amdgcn_ds_bpermute(bpa, (int)w_.w);
                    *(u32x4*)(yst + (size_t)(ai * HALF + m * 16) * ldy + bj * HALF) = t_; }
                s = red_fq(s); if (fq == 0) SSY[(size_t)row * 16 + u.pn * 4 + wc] = s; }
    }
};
struct EpiRelu2F8 {
    static constexpr bool PERM = true, AFTER_DRAIN = false; static constexpr int MIDT = 0;
    unsigned char* U; float scale;
    __device__ __forceinline__ void operator()(const f32x4 (&acc)[2][2][4][2], const Unit& u, int wr, int wc, int fr, int fq) const {
        asm volatile("" : "+v"(fr), "+v"(fq));
        unsigned char* base = U + ((size_t)(u.pm * 16 + wr * 4) * 64 + u.pn * 4 + wc) * 1024 + (unsigned)(fq * 16 + fr) * 16u;
#pragma unroll
        for (int ai = 0; ai < 2; ++ai)
#pragma unroll
            for (int m = 0; m < 4; ++m) { int w[4];
#pragma unroll
                for (int bj = 0; bj < 2; ++bj) { float v[8]; ld8(v, acc[ai][bj][m][0], acc[ai][bj][m][1]);
#pragma unroll
                    for (int j = 0; j < 8; ++j) { const float r = __builtin_fmaxf(v[j] * scale, 0.f); v[j] = __builtin_fminf(r * r, 440.f); }
                    int w0 = 0, w1 = 0;
                    w0 = __builtin_amdgcn_cvt_pk_fp8_f32(v[0], v[1], w0, false); w0 = __builtin_amdgcn_cvt_pk_fp8_f32(v[2], v[3], w0, true);
                    w1 = __builtin_amdgcn_cvt_pk_fp8_f32(v[4], v[5], w1, false); w1 = __builtin_amdgcn_cvt_pk_fp8_f32(v[6], v[7], w1, true);
                    w[2 * bj] = w0; w[2 * bj + 1] = w1; }
                typedef int i32x4e_ __attribute__((ext_vector_type(4)));
                *(i32x4e_*)(base + (size_t)(ai * 8 + m) * 65536) = (i32x4e_){w[0], w[1], w[2], w[3]}; }
    }
};
struct EpiRelu2 {
    static constexpr bool PERM = true, AFTER_DRAIN = false; static constexpr int MIDT = 0;
    bf16_t* U;
    __device__ __forceinline__ void operator()(const f32x4 (&acc)[2][2][4][2], const Unit& u, int wr, int wc, int fr, int fq) const {
        asm volatile("" : "+v"(fr), "+v"(fq));
        const int row0 = u.pm * BM + wr * 64 + fr, cl = u.pn * BM + wc * 32 + 8 * fq;
#pragma unroll
        for (int ai = 0; ai < 2; ++ai)
#pragma unroll
            for (int m = 0; m < 4; ++m) { const int row = row0 + ai * HALF + m * 16;
#pragma unroll
                for (int bj = 0; bj < 2; ++bj) { float v[8]; ld8(v, acc[ai][bj][m][0], acc[ai][bj][m][1]);
#pragma unroll
                    for (int j = 0; j < 8; ++j) { const float r = __builtin_fmaxf(v[j], 0.f); v[j] = r * r; }
                    *(u32x4*)(U + (size_t)row * LDU + cl + bj * HALF) = pack8(v); } }
    }
};
template <class Epi, class Sched, bool ALIGN_EPI = false, bool SP2 = false, int ESZ = 2, bool ACH = false>
__device__ __forceinline__ void gemm_phase(PG8_LAS unsigned char* lds, const Gemm g, const Sched& S, const Epi& E) {
    int tid_ = threadIdx.x; asm volatile("" : "+v"(tid_));
    const int tid = tid_, wid = __builtin_amdgcn_readfirstlane(tid >> 6), lane = tid & 63, wr = wid >> 2, wc = wid & 3, fr = lane & 15, fq = lane >> 4;
    const int K = g.K, nt = K * ESZ / (BK * 2), lda = g.lda ? g.lda : K, ldb = g.ldb ? g.ldb : K;
    unsigned voffA[2], voffB[2];
#pragma unroll
    for (int i = 0; i < 2; ++i) { int R, C; stage_rc(tid * 16 + i * 8192, R, C); const int Rb = Epi::PERM ? ((R & ~31) + perm32(R & 31)) : R;
        if constexpr (ACH) { const int st_ = (tid >> 6) + 8 * i; voffA[i] = (unsigned)((st_ >> 1) * 16 * lda * ESZ + (st_ & 1) * 1024 + (tid & 63) * 16); } else voffA[i] = (unsigned)(R * lda * ESZ + C * 2);
        voffB[i] = (unsigned)(Rb * ldb * ESZ + C * 2); }
    const size_t kstepB = (size_t)(BK * 2), kstepA = ACH ? (size_t)2048 : kstepB;
    const size_t hstepA = (size_t)HALF * lda * ESZ, hstepB = (size_t)HALF * ldb * ESZ;
    const size_t tstepA = 2 * hstepA, tstepB = 2 * hstepB;
    const unsigned ldsw = (unsigned)wid * 1024u;
    const int aoff = ACH ? wr * 8192 + lane * 16 : lds_byte(wr * 64 + fr, fq * 8), boff = lds_byte(wc * 32 + fr, fq * 8);
#define PG8_SA(b, h) (((b) * 2 + (h)) * HTB)
#define PG8_SB(b, h) ((4 + (b) * 2 + (h)) * HTB)
#define PG8_STAGE(bufoff, gbase, voff) do { _Pragma("unroll") for (int _i = 0; _i < 2; ++_i) \
        __builtin_amdgcn_global_load_lds((const unsigned*)((const char*)(gbase) + (voff)[_i]), (PG8_LAS unsigned*)(lds + (bufoff) + ldsw + _i * 8192), 16, 0, 0); } while (0)
#define PG8_LDA(dst, b, h) do { if constexpr (ESZ == 2) { _Pragma("unroll") for (int m = 0; m < 4; ++m) _Pragma("unroll") for (int k = 0; k < 2; ++k) dst[m][k] = *(const PG8_LAS bf16x8*)(lds + PG8_SA(b, h) + aoff + m * 2048 + k * 1024); } \
        else { _Pragma("unroll") for (int m = 0; m < 4; ++m) { dst##8[m].lo = *(const PG8_LAS i32x4_*)(lds + PG8_SA(b, h) + aoff + m * 2048); dst##8[m].hi = *(const PG8_LAS i32x4_*)(lds + PG8_SA(b, h) + aoff + m * 2048 + 1024); } } } while (0)
#define PG8_LDB(dst, b, h) do { if constexpr (ESZ == 2) { _Pragma("unroll") for (int n = 0; n < 2; ++n) _Pragma("unroll") for (int k = 0; k < 2; ++k) dst[n][k] = *(const PG8_LAS bf16x8*)(lds + PG8_SB(b, h) + boff + n * 2048 + k * 1024); } \
        else { _Pragma("unroll") for (int n = 0; n < 2; ++n) { dst##8[n].lo = *(const PG8_LAS i32x4_*)(lds + PG8_SB(b, h) + boff + n * 2048); dst##8[n].hi = *(const PG8_LAS i32x4_*)(lds + PG8_SB(b, h) + boff + n * 2048 + 1024); } } } while (0)
#define PG8_MMA(ai, bj, At, Bt) do { __builtin_amdgcn_s_setprio(1); \
        if constexpr (ESZ == 2) { _Pragma("unroll") for (int m = 0; m < 4; ++m) _Pragma("unroll") for (int n = 0; n < 2; ++n) _Pragma("unroll") for (int k = 0; k < 2; ++k) \
            acc[ai][bj][m][n] = __builtin_amdgcn_mfma_f32_16x16x32_bf16(Bt[n][k], At[m][k], acc[ai][bj][m][n], 0, 0, 0); } \
        else {   \
            _Pragma("unroll") for (int m = 0; m < 4; ++m) _Pragma("unroll") for (int n = 0; n < 2; ++n) \
                asm volatile("v_mfma_scale_f32_16x16x128_f8f6f4 %0, %1, %2, %0, %3, %3 op_sel_hi:[0,0,0]" : "+v"(acc[ai][bj][m][n]) : "v"(Bt##8[n]), "v"(At##8[m]), "v"(scl_)); } \
        __builtin_amdgcn_s_setprio(0); } while (0)
#define PG8_WAIT_V(n) asm volatile("s_waitcnt vmcnt(" #n ")" ::: "memory")
#define PG8_WAIT_L(n) asm volatile("s_waitcnt lgkmcnt(" #n ")" ::: "memory")
#define PG8_BAR __builtin_amdgcn_s_barrier()
#define PG8_SCHED __builtin_amdgcn_sched_barrier(0)
    Unit cur, nxt; int ui = 0;
    if (!S.next(0, cur)) return;
    f32x4 acc[2][2][4][2];
#pragma unroll
    for (int a = 0; a < 2; ++a)
#pragma unroll
        for (int b = 0; b < 2; ++b)
#pragma unroll
            for (int m = 0; m < 4; ++m)
#pragma unroll
                for (int n = 0; n < 2; ++n) acc[a][b][m][n] = (f32x4){0.f, 0.f, 0.f, 0.f};
    bf16x8 At[4][2], B0[2][2], B1[2][2];
    typedef int i32x4_ __attribute__((ext_vector_type(4))); typedef int i32x8_ __attribute__((ext_vector_type(8)));
    const int scl_ = 0x7F7F7F7F;
    i32x8_ At8[4], B08[2], B18[2];
    const char* cA = (const char*)g.A + (size_t)cur.pm * tstepA; const char* cB = (const char*)g.Bt + (size_t)cur.pn * tstepB;
    S.a_ready(cur);
    if constexpr (SP2) {
        PG8_STAGE(PG8_SB(0, 0), cB, voffB); PG8_STAGE(PG8_SB(0, 1), cB + hstepB, voffB); PG8_STAGE(PG8_SA(0, 0), cA, voffA); PG8_STAGE(PG8_SA(0, 1), cA + hstepA, voffA);
        if (wr == 1) PG8_BAR;
        PG8_WAIT_V(2); PG8_BAR;
        PG8_STAGE(PG8_SB(1, 0), cB + kstepB, voffB); PG8_STAGE(PG8_SA(1, 0), cA + kstepA, voffA); PG8_STAGE(PG8_SB(1, 1), cB + hstepB + kstepB, voffB);
        PG8_WAIT_V(6); PG8_BAR;
    } else {
        PG8_STAGE(PG8_SB(0, 0), cB, voffB); PG8_STAGE(PG8_SA(0, 0), cA, voffA); PG8_STAGE(PG8_SB(0, 1), cB + hstepB, voffB); PG8_STAGE(PG8_SA(0, 1), cA + hstepA, voffA);
        if (wr == 1) PG8_BAR;
        PG8_WAIT_V(4); PG8_BAR;
        PG8_STAGE(PG8_SB(1, 0), cB + kstepB, voffB); PG8_STAGE(PG8_SA(1, 0), cA + kstepA, voffA); PG8_STAGE(PG8_SB(1, 1), cB + hstepB + kstepB, voffB);
        PG8_WAIT_V(6); PG8_BAR;
    }
    for (;;) {
        const bool has_next = S.next(ui + 1, nxt);
        const char* nA = has_next ? (const char*)g.A + (size_t)nxt.pm * tstepA : cA; const char* nB = has_next ? (const char*)g.Bt + (size_t)nxt.pn * tstepB : cB;
#pragma unroll 1
        for (int t = 0; t < nt; t += 2) {
            if constexpr (Epi::MIDT > 0) { if (t == Epi::MIDT) E.mid(acc, cur, wr, wc, fr, fq); }
            const bool last = (t == nt - 2);
            const char* a1 = cA + (size_t)(t + 1) * kstepA;
            const char* a2 = last ? nA : cA + (size_t)(t + 2) * kstepA; const char* b2 = last ? nB : cB + (size_t)(t + 2) * kstepB;
            const char* a3 = a2 + kstepA; const char* b3 = b2 + kstepB;
            if (last && has_next) S.a_ready(nxt);
            if constexpr (SP2) {
            PG8_LDB(B0, 0, 0); PG8_LDB(B1, 0, 1); PG8_SCHED; PG8_LDA(At, 0, 0); PG8_STAGE(PG8_SA(1, 1), a1 + hstepA, voffA);
            PG8_WAIT_V(8); PG8_WAIT_L(0); PG8_BAR; PG8_MMA(0, 0, At, B0); PG8_MMA(0, 1, At, B1); PG8_BAR; PG8_SCHED;
            PG8_LDA(At, 0, 1); PG8_STAGE(PG8_SB(0, 0), b2, voffB); PG8_STAGE(PG8_SB(0, 1), b2 + hstepB, voffB); PG8_STAGE(PG8_SA(0, 0), a2, voffA);
            PG8_WAIT_V(8); PG8_WAIT_L(0); PG8_BAR; PG8_MMA(1, 0, At, B0); PG8_MMA(1, 1, At, B1); PG8_BAR; PG8_SCHED;
            PG8_LDB(B0, 1, 0); PG8_LDB(B1, 1, 1); PG8_SCHED; PG8_LDA(At, 1, 0); PG8_STAGE(PG8_SA(0, 1), a2 + hstepA, voffA);
            PG8_WAIT_V(8); PG8_WAIT_L(0); PG8_BAR; PG8_MMA(0, 0, At, B0); PG8_MMA(0, 1, At, B1); PG8_BAR; PG8_SCHED;
            PG8_LDA(At, 1, 1); PG8_STAGE(PG8_SB(1, 0), b3, voffB); PG8_STAGE(PG8_SB(1, 1), b3 + hstepB, voffB); PG8_STAGE(PG8_SA(1, 0), a3, voffA);
            PG8_WAIT_V(8); PG8_WAIT_L(0); PG8_BAR; PG8_MMA(1, 0, At, B0); PG8_MMA(1, 1, At, B1); PG8_BAR; PG8_SCHED;
            } else {
            PG8_LDB(B0, 0, 0); PG8_SCHED; PG8_LDA(At, 0, 0); PG8_STAGE(PG8_SA(1, 1), a1 + hstepA, voffA);
            PG8_WAIT_L(8); PG8_BAR; PG8_WAIT_L(0); PG8_MMA(0, 0, At, B0); PG8_BAR; PG8_SCHED;
            PG8_LDB(B1, 0, 1); PG8_STAGE(PG8_SB(0, 0), b2, voffB);
            PG8_BAR; PG8_WAIT_L(0); PG8_MMA(0, 1, At, B1); PG8_BAR;
            PG8_LDA(At, 0, 1); PG8_STAGE(PG8_SA(0, 0), a2, voffA);
            PG8_BAR; PG8_WAIT_L(0); PG8_MMA(1, 0, At, B0); PG8_BAR; PG8_SCHED;
            PG8_STAGE(PG8_SB(0, 1), b2 + hstepB, voffB);
            PG8_WAIT_V(6); PG8_BAR; PG8_MMA(1, 1, At, B1); PG8_BAR;
            PG8_LDB(B0, 1, 0); PG8_SCHED; PG8_LDA(At, 1, 0); PG8_STAGE(PG8_SA(0, 1), a2 + hstepA, voffA);
            PG8_WAIT_L(8); PG8_BAR; PG8_WAIT_L(0); PG8_MMA(0, 0, At, B0); PG8_BAR; PG8_SCHED;
            PG8_LDB(B1, 1, 1); PG8_STAGE(PG8_SB(1, 0), b3, voffB);
            PG8_BAR; PG8_WAIT_L(0); PG8_MMA(0, 1, At, B1); PG8_BAR;
            PG8_LDA(At, 1, 1); PG8_STAGE(PG8_SA(1, 0), a3, voffA);
            PG8_BAR; PG8_WAIT_L(0); PG8_MMA(1, 0, At, B0); PG8_BAR; PG8_SCHED;
            PG8_STAGE(PG8_SB(1, 1), b3 + hstepB, voffB);
            PG8_WAIT_V(6); PG8_BAR; PG8_MMA(1, 1, At, B1); PG8_BAR;
            }
        }
        if constexpr (ALIGN_EPI) { if (wr == 0) PG8_BAR; }
        if constexpr (ESZ == 1) asm volatile("s_nop 15\n\ts_nop 15" ::: "memory");
        if constexpr (!Epi::AFTER_DRAIN) { E(acc, cur, wr, wc, fr, fq); S.done(cur); }
        if (!has_next) break;
#pragma unroll
        for (int a = 0; a < 2; ++a)
#pragma unroll
            for (int b = 0; b < 2; ++b)
#pragma unroll
                for (int m = 0; m < 4; ++m)
#pragma unroll
                    for (int n = 0; n < 2; ++n) acc[a][b][m][n] = (f32x4){0.f, 0.f, 0.f, 0.f};
        cur = nxt; cA = nA; cB = nB; ++ui;
        if constexpr (ALIGN_EPI) { if (wr == 1) PG8_BAR; }
    }
    PG8_WAIT_V(0);
    if constexpr (!ALIGN_EPI) { if (wr == 0) PG8_BAR; }
    PG8_BAR;
    if constexpr (Epi::AFTER_DRAIN) { E.fused(acc, cur, wr, wc, fr, fq, lds, wid, lane); S.done(cur); }
#undef PG8_SA
#undef PG8_SB
#undef PG8_STAGE
#undef PG8_LDA
#undef PG8_LDB
#undef PG8_MMA
#undef PG8_WAIT_V
#undef PG8_WAIT_L
#undef PG8_BAR
#undef PG8_SCHED
}
}
#ifndef ATT_LSUM_MFMA
#define ATT_LSUM_MFMA 1
#endif
namespace att {
typedef unsigned short bf16_t;
typedef short bf16x8 __attribute__((ext_vector_type(8)));
typedef short s16x4 __attribute__((ext_vector_type(4)));
typedef float f32x16 __attribute__((ext_vector_type(16)));
typedef float f32x4 __attribute__((ext_vector_type(4)));
typedef unsigned u32x4 __attribute__((ext_vector_type(4)));
#define ALDS __attribute__((address_space(3)))
#define ASBAR() __builtin_amdgcn_sched_barrier(0)
constexpr int KTB = 12288, VTB = 8192;
constexpr int NSLOT = 3;
constexpr int L_K = 0, L_V = NSLOT * KTB, L_WS = L_V + NSLOT * VTB, L_OST = L_WS + 8 * 256, L_KM = L_OST + 8 * 4096, L_RED = L_KM + 2048, L_END = L_RED + 16384;
constexpr float THR = 8.f;
__device__ __forceinline__ int crow(int r, int hi) { return (r & 3) + 8 * (r >> 2) + 4 * hi; }
typedef float f32x2a_t __attribute__((ext_vector_type(2))); typedef __bf16 bf16x2a_t __attribute__((ext_vector_type(2)));
__device__ __forceinline__ unsigned cvtpk(float lo, float hi) { const f32x2a_t v = {lo, hi}; const bf16x2a_t b = __builtin_convertvector(v, bf16x2a_t); return __builtin_bit_cast(unsigned, b); }
__device__ __forceinline__ float bf2f(short s) { return __uint_as_float(((unsigned)(unsigned short)s) << 16); }
__device__ __forceinline__ int v_st(int k, int c) { const int kk = (k & ~0xC) | ((k & 4) << 1) | ((k & 8) >> 1); return ((kk >> 3) * 2 + (c >> 5)) * 512 + ((kk & 7) * 32 + (c & 31)) * 2; }
__device__ __forceinline__ int v_rd_base(int lane) { return ((lane & 3) << 3) | (((lane >> 2) & 3) << 6) | (((lane >> 4) & 1) << 5) | (((lane >> 5) & 1) << 8); }
constexpr int v_rd_off(int d0, int ks, int half) { return ks * 2048 + half * 1024 + d0 * 512; }
template <int OFF> __device__ __forceinline__ s16x4 tr_read(int vb) { s16x4 r; asm volatile("ds_read_b64_tr_b16 %0, %1 offset:%2" : "=&v"(r) : "v"(vb), "i"(OFF) : "memory"); return r; }
template <int D0> __device__ __forceinline__ void pv_one(f32x16& od, int vb, bf16x8 pa0, bf16x8 pa1, bf16x8 pa2, bf16x8 pa3) {
    const s16x4 l0 = tr_read<v_rd_off(D0, 0, 0)>(vb), h0 = tr_read<v_rd_off(D0, 0, 1)>(vb), l1 = tr_read<v_rd_off(D0, 1, 0)>(vb), h1 = tr_read<v_rd_off(D0, 1, 1)>(vb);
    const s16x4 l2 = tr_read<v_rd_off(D0, 2, 0)>(vb), h2 = tr_read<v_rd_off(D0, 2, 1)>(vb), l3 = tr_read<v_rd_off(D0, 3, 0)>(vb), h3 = tr_read<v_rd_off(D0, 3, 1)>(vb);
    asm volatile("s_waitcnt lgkmcnt(0)" ::: "memory"); ASBAR();
#define ATT_PK(L, H) (bf16x8){L[0], L[1], L[2], L[3], H[0], H[1], H[2], H[3]}
    od = __builtin_amdgcn_mfma_f32_32x32x16_bf16(pa0, ATT_PK(l0, h0), od, 0, 0, 0);
    od = __builtin_amdgcn_mfma_f32_32x32x16_bf16(pa1, ATT_PK(l1, h1), od, 0, 0, 0);
    od = __builtin_amdgcn_mfma_f32_32x32x16_bf16(pa2, ATT_PK(l2, h2), od, 0, 0, 0);
    od = __builtin_amdgcn_mfma_f32_32x32x16_bf16(pa3, ATT_PK(l3, h3), od, 0, 0, 0);
#undef ATT_PK
}
__device__ __forceinline__ void pv_all(f32x16* o, f32x16& ol, int vb, bf16x8 pa0, bf16x8 pa1, bf16x8 pa2, bf16x8 pa3) {
    pv_one<0>(o[0], vb, pa0, pa1, pa2, pa3); pv_one<1>(o[1], vb, pa0, pa1, pa2, pa3);
#if ATT_LSUM_MFMA
    const bf16x8 ones = (bf16x8){0x3F80, 0x3F80, 0x3F80, 0x3F80, 0x3F80, 0x3F80, 0x3F80, 0x3F80};
    ol = __builtin_amdgcn_mfma_f32_32x32x16_bf16(pa0, ones, ol, 0, 0, 0); ol = __builtin_amdgcn_mfma_f32_32x32x16_bf16(pa1, ones, ol, 0, 0, 0);
    ol = __builtin_amdgcn_mfma_f32_32x32x16_bf16(pa2, ones, ol, 0, 0, 0); ol = __builtin_amdgcn_mfma_f32_32x32x16_bf16(pa3, ones, ol, 0, 0, 0);
#endif
}
__device__ __forceinline__ void partialSM(f32x16& p0, f32x16& p1, float& m_ref, f32x16& negm, float& alpha) {
    float pmax = p0[0];
#pragma unroll
    for (int r = 1; r < 16; ++r) pmax = fmaxf(pmax, p0[r]);
#pragma unroll
    for (int r = 0; r < 16; ++r) pmax = fmaxf(pmax, p1[r]);
    { auto rr = __builtin_amdgcn_permlane32_swap(__float_as_uint(pmax), __float_as_uint(pmax), false, false); pmax = fmaxf(__uint_as_float(rr[0]), __uint_as_float(rr[1])); }
    alpha = 1.f;
    if (__builtin_expect(!__all(pmax <= THR), 0)) { const float dl = (pmax > THR) ? pmax : 0.f; m_ref += dl; alpha = __builtin_amdgcn_exp2f(-dl);
#pragma unroll
        for (int r = 0; r < 16; ++r) { p0[r] -= dl; p1[r] -= dl; negm[r] = -m_ref; } }
#pragma unroll
    for (int r = 0; r < 16; ++r) p0[r] = __builtin_amdgcn_exp2f(p0[r]);
}
__device__ __forceinline__ void finishSM(f32x16& p0, f32x16& p1, bf16x8& pa0, bf16x8& pa1, bf16x8& pa2, bf16x8& pa3, float& lsum) {
#pragma unroll
    for (int r = 0; r < 16; ++r) p1[r] = __builtin_amdgcn_exp2f(p1[r]);
#if !ATT_LSUM_MFMA
    { float ps = 0.f;
#pragma unroll
      for (int r = 0; r < 16; ++r) ps += p0[r];
#pragma unroll
      for (int r = 0; r < 16; ++r) ps += p1[r];
      lsum += ps; }
#endif
#define ATT_PK4(P, BASE, OUT) do { unsigned a0 = cvtpk(P[BASE + 0], P[BASE + 1]), a1 = cvtpk(P[BASE + 2], P[BASE + 3]);   \
    unsigned b0 = cvtpk(P[BASE + 4], P[BASE + 5]), b1 = cvtpk(P[BASE + 6], P[BASE + 7]);                              \
    auto r0 = __builtin_amdgcn_permlane32_swap(a0, b0, false, false); auto r1 = __builtin_amdgcn_permlane32_swap(a1, b1, false, false); \
    u32x4 w = {r0[0], r1[0], r0[1], r1[1]}; OUT = __builtin_bit_cast(bf16x8, w); } while (0)
    ATT_PK4(p0, 0, pa0); ATT_PK4(p0, 8, pa1); ATT_PK4(p1, 0, pa2); ATT_PK4(p1, 8, pa3);
#undef ATT_PK4
}
template <int ND> __device__ __forceinline__ void qkt(f32x16& p0, f32x16& p1, ALDS const char* Kb, const int (&ka)[ND], const bf16x8 (&qr)[ND], const f32x16& cinit) {
#pragma unroll
    for (int d0 = 0; d0 < ND; ++d0) {
        const bf16x8 b0 = *(ALDS const bf16x8*)(Kb + ka[d0]);
        const bf16x8 b1 = *(ALDS const bf16x8*)(Kb + ka[d0] + (d0 < 4 ? 4096 : 2048));
        p0 = __builtin_amdgcn_mfma_f32_32x32x16_bf16(b0, qr[d0], d0 == 0 ? cinit : p0, 0, 0, 0);
        p1 = __builtin_amdgcn_mfma_f32_32x32x16_bf16(b1, qr[d0], d0 == 0 ? cinit : p1, 0, 0, 0);
        if (ND > 4 && d0 == 2) asm volatile("" ::: "memory"); }
}
__device__ __forceinline__ void cmask(f32x16& p0, f32x16& p1, int jt, int qrel, int hi) {
    const float NEG = -INFINITY; const int thr = qrel - 64 * jt - 4 * hi;
#pragma unroll
    for (int r = 0; r < 16; ++r) { if ((r & 3) + 8 * (r >> 2) > thr) p0[r] = NEG; if ((r & 3) + 8 * (r >> 2) + 32 > thr) p1[r] = NEG; }
}
__device__ __forceinline__ void kmean_blocks(const bf16_t* Kp, ALDS char* lds) {
    int tid_ = threadIdx.x; asm volatile("" : "+v"(tid_));
    const int tid = tid_, lane = tid & 63, wid = tid >> 6;
    ALDS float* red = (ALDS float*)(lds + L_RED); ALDS float* km = (ALDS float*)(lds + L_KM);
#pragma unroll 1
    for (int n = 0; n < 8; ++n) {
        float a[16];
#pragma unroll
        for (int j = 0; j < 16; ++j) a[j] = 0.f;
#pragma unroll
        for (int i = 0; i < 2; ++i)
#pragma unroll
            for (int cc = 0; cc < 2; ++cc) { const bf16x8 kx = *(const bf16x8*)(Kp + (size_t)(n * 256 + 128 * i + 16 * wid) * AW + cc * 512 + lane * 8);
#pragma unroll
                for (int j = 0; j < 8; ++j) a[cc * 8 + j] += bf2f(kx[j]); }
#pragma unroll
        for (int j = 0; j < 16; ++j) { a[j] += __shfl_xor(a[j], 1); a[j] += __shfl_xor(a[j], 2); a[j] += __shfl_xor(a[j], 4); a[j] += __shfl_xor(a[j], 8); }
        if ((lane & 15) == 0) {
#pragma unroll
            for (int j = 0; j < 16; ++j) red[(n * 8 + wid) * 64 + (j >> 3) * 32 + (lane >> 4) * 8 + (j & 7)] = a[j]; }
    }
    __syncthreads();
    { const int n = tid >> 6, d = tid & 63; float s = 0.f;
#pragma unroll
        for (int w = 0; w < 8; ++w) s += red[(n * 8 + w) * 64 + d];
        km[n * 64 + d] = s * (1.0f / 256.0f); }
    __syncthreads();
}
template <int DQK, bool MOBA>
__device__ __forceinline__ void attn_bh(const bf16_t* Qp, int ldq, const bf16_t* Kp, const bf16_t* KRp, const bf16_t* Vp, bf16_t* Op, int ldo, ALDS char* lds) {
    constexpr int ND = DQK / 16;
    ALDS char* K_lds = lds + L_K; ALDS char* V_lds = lds + L_V;
    bf16x8 sk0, sv0, sr0, sk1, sv1, sr1;
#define ATT_SLOAD(S, k0) do { sk##S = *(const bf16x8*)((const char*)(Kp + (size_t)(k0) * AW) + koff); sv##S = *(const bf16x8*)((const char*)(Vp + (size_t)(k0) * AW) + koff); if (DQK == 96) sr##S = *(const bf16x8*)((const char*)(KRp + (size_t)(k0) * RDIM) + roff); } while (0)
#define ATT_SWRITE(b, S) do { *(ALDS bf16x8*)(K_lds + (b) * KTB + kst) = sk##S; *(ALDS bf16x8*)(V_lds + (b) * VTB + vst) = sv##S; if (DQK == 96) { if (tid < 256) *(ALDS bf16x8*)(K_lds + (b) * KTB + rst) = sr##S; } } while (0)
#define ATT_QLOAD(q_) do { const bf16_t* Qw = Qp + (size_t)((q_) * 256 + wid * 32 + (r32 & 16)) * ldq + (r32 & 15) * 8 + hi * 128; _Pragma("unroll") for (int d0 = 0; d0 < ND; ++d0) qr[d0] = *(const bf16x8*)(Qw + (d0 >> 1) * 512 + (d0 & 1) * 256); } while (0)
    bf16x8 qr[ND];
    {
        const int tid = threadIdx.x, w_ = tid >> 6, l_ = tid & 63;
        const unsigned koff = (unsigned)((w_ >> 1) * 16 * AW + (w_ & 1) * 512 + l_ * 8) * 2u, roff = (unsigned)((w_ & 3) * 16 * RDIM + l_ * 8) * 2u;
        ATT_SLOAD(0, 0); ATT_SLOAD(1, 64); }
#pragma unroll 1
  for (int qb = 0; qb < 8; ++qb) {
    int tid_ = threadIdx.x; asm volatile("" : "+v"(tid_));
    const int tid = tid_, lane = tid & 63, r32 = lane & 31, hi = lane >> 5; const int wid = __builtin_amdgcn_readfirstlane(tid >> 6);
    ALDS float* al_l = (ALDS float*)(lds + L_WS) + wid * 64;
    const int skey = 16 * (wid >> 1) + (lane & 15), sch = 4 * (wid & 1) + (lane >> 4);
    const unsigned koff = (unsigned)((wid >> 1) * 16 * AW + (wid & 1) * 512 + lane * 8) * 2u;
    const int kst = skey * 128 + ((sch ^ ((skey >> 1) & 7)) << 4), vst = v_st(skey, sch * 8);
    const int rkey = 16 * (wid & 3) + (lane & 15), rch = lane >> 4;
    const unsigned roff = (unsigned)((wid & 3) * 16 * RDIM + lane * 8) * 2u;
    const int rst = 8192 + rkey * 64 + ((rch ^ ((rkey >> 2) & 3)) << 4);
    int ka[ND];
#pragma unroll
    for (int d0 = 0; d0 < ND; ++d0) ka[d0] = (d0 < 4) ? r32 * 128 + (((2 * d0 + hi) ^ ((r32 >> 1) & 7)) << 4) : 8192 + r32 * 64 + (((2 * (d0 - 4) + hi) ^ ((r32 >> 2) & 3)) << 4);
    const int vb0 = (int)(unsigned)(uintptr_t)V_lds + v_rd_base(lane);
    const int qrel = wid * 32 + r32;
    ATT_QLOAD(qb);
    float m_ref = 0.f, lsum = 0.f; f32x16 o[2], ol, negm; o[0] = f32x16{}; o[1] = f32x16{}; ol = f32x16{}; negm = f32x16{};
    unsigned sel = 0xffu;
    if (MOBA && qb > 3) {
        ALDS const float* km = (ALDS const float*)(lds + L_KM); float g[8];
#pragma unroll
        for (int n = 0; n < 8; ++n) { float s = 0.f;
#pragma unroll
            for (int d0 = 0; d0 < ND; ++d0)
#pragma unroll
                for (int j = 0; j < 8; ++j) s += bf2f(qr[d0][j]) * km[n * 64 + d0 * 16 + hi * 8 + j];
            g[n] = s; }
#pragma unroll
        for (int n = 0; n < 8; ++n) g[n] += __shfl_xor(g[n], 32);
        sel = 0u;
#pragma unroll
        for (int n = 0; n < 8; ++n) { int rank = 0;
#pragma unroll
            for (int mm = 0; mm < 8; ++mm) if (mm != n) rank += (mm < qb && (g[mm] > g[n] || (g[mm] == g[n] && mm < n))) ? 1 : 0;
            if (n < qb && rank < 3) sel |= 1u << n; }
    }
#define ATT_RESC(a) do { if (__any((a) < 1.f)) { lsum *= (a); if (hi == 0) al_l[r32] = (a); asm volatile("s_waitcnt lgkmcnt(0)" ::: "memory"); \
    _Pragma("unroll") for (int r = 0; r < 16; ++r) { const float f_ = al_l[crow(r, hi)]; o[0][r] *= f_; o[1][r] *= f_; ol[r] *= f_; } } } while (0)
    f32x16 pA0, pA1, pB0, pB1; float alA, alB; bf16x8 pa0, pa1, pa2, pa3; const int NT = 4 * (qb + 1), NP = 4 * qb;
    f32x16 cm = negm; const bool gated = MOBA && qb > 3;
#define ATT_CM(t) do { if (gated) { if ((t) < NP) { const float v_ = ((sel >> ((t) >> 2)) & 1u) ? -m_ref : -INFINITY; _Pragma("unroll") for (int r = 0; r < 16; ++r) cm[r] = v_; } else cm = negm; } else cm = negm; } while (0)
#define ATT_SCORE(P0, P1, t) do { ATT_CM(t); qkt<ND>(P0, P1, K_lds + sc * KTB, ka, qr, cm); if ((t) >= NP) cmask(P0, P1, (t) - NP, qrel, hi); } while (0)
    int sp = 0, sc = 0, sn = 1;
#define ATT_ROT() do { sp = sc; sc = sn; sn = (sn == NSLOT - 1) ? 0 : sn + 1; } while (0)
    ATT_SWRITE(0, 0); ATT_SLOAD(0, 128);
    __syncthreads(); ATT_SWRITE(sn, 1); ATT_SLOAD(1, 192);
    ATT_SCORE(pA0, pA1, 0); partialSM(pA0, pA1, m_ref, negm, alA);
    ATT_ROT();
    for (int t = 1; t + 1 < NT; t += 2) {
        __syncthreads(); ATT_SWRITE(sn, 0); if (t + 3 < NT) ATT_SLOAD(0, (t + 3) * 64);
        ASBAR(); ATT_SCORE(pB0, pB1, t);
        finishSM(pA0, pA1, pa0, pa1, pa2, pa3, lsum); ASBAR();
        pv_all(o, ol, vb0 + sp * VTB, pa0, pa1, pa2, pa3); partialSM(pB0, pB1, m_ref, negm, alB);
        ATT_RESC(alB); ATT_ROT();
        __syncthreads(); ATT_SWRITE(sn, 1); if (t + 4 < NT) ATT_SLOAD(1, (t + 4) * 64);
        ASBAR(); ATT_SCORE(pA0, pA1, t + 1);
        finishSM(pB0, pB1, pa0, pa1, pa2, pa3, lsum); ASBAR();
        pv_all(o, ol, vb0 + sp * VTB, pa0, pa1, pa2, pa3); partialSM(pA0, pA1, m_ref, negm, alA);
        ATT_RESC(alA); ATT_ROT();
    }
    __syncthreads();
    ASBAR(); ATT_SCORE(pB0, pB1, NT - 1);
    if (qb < 7) { ATT_SLOAD(0, 0); ATT_SLOAD(1, 64); }
    finishSM(pA0, pA1, pa0, pa1, pa2, pa3, lsum); ASBAR();
    pv_all(o, ol, vb0 + sp * VTB, pa0, pa1, pa2, pa3); partialSM(pB0, pB1, m_ref, negm, alB);
    ATT_RESC(alB);
    finishSM(pB0, pB1, pa0, pa1, pa2, pa3, lsum); ASBAR();
    pv_all(o, ol, vb0 + sc * VTB, pa0, pa1, pa2, pa3);
#undef ATT_ROT
#undef ATT_SCORE
#undef ATT_CM
    float rli[16];
#if ATT_LSUM_MFMA
#pragma unroll
    for (int r = 0; r < 16; ++r) rli[r] = __builtin_amdgcn_rcpf(ol[r]);
#else
    { auto rr = __builtin_amdgcn_permlane32_swap(__float_as_uint(lsum), __float_as_uint(lsum), false, false); lsum = __uint_as_float(rr[0]) + __uint_as_float(rr[1]); }
    if (hi == 0) al_l[32 + r32] = lsum; asm volatile("s_waitcnt lgkmcnt(0)" ::: "memory");
#pragma unroll
    for (int r = 0; r < 16; ++r) rli[r] = __builtin_amdgcn_rcpf(al_l[32 + crow(r, hi)]);
#endif
    { ALDS unsigned short* stg = (ALDS unsigned short*)(lds + L_OST) + wid * 2048;
#pragma unroll
      for (int r = 0; r < 16; ++r) { const int orow = crow(r, hi);
#pragma unroll
          for (int d0 = 0; d0 < 2; ++d0) stg[orow * 64 + d0 * 32 + r32] = (unsigned short)(cvtpk(o[d0][r] * rli[r], 0.f) & 0xffffu); }
      asm volatile("s_waitcnt lgkmcnt(0)" ::: "memory");
      bf16_t* Ow = Op + (size_t)(qb * 256 + wid * 32) * ldo;
#pragma unroll
      for (int i = 0; i < 4; ++i) { const int row = i * 8 + (lane >> 3), ch = lane & 7; const u32x4 v = *(ALDS const u32x4*)(stg + row * 64 + ch * 8); *(u32x4*)(Ow + (size_t)row * ldo + ch * 8) = v; } }
    __syncthreads();
  }
#undef ATT_SLOAD
#undef ATT_SWRITE
#undef ATT_QLOAD
#undef ATT_RESC
}

constexpr int MSLOT = 8192, M_K = 0, M_V = 3 * MSLOT, M_WS = 6 * MSLOT, M_OST = M_WS + 8 * 256, M_END = M_OST + 8 * 4096;
static_assert(M_END <= L_KM, "MoBA LDS map");
#define MPIN(x) asm volatile("" : "+v"(x))
#define MMFMA(a, b, c) __builtin_amdgcn_mfma_f32_32x32x16_bf16(a, b, c, 0, 0, 0)
#define MWAIT_BAR(N) asm volatile("s_waitcnt vmcnt(" #N ") lgkmcnt(0)\n\ts_barrier" ::: "memory")
__device__ __forceinline__ void m_kload2(bf16x8* kf, ALDS const char* kp, int d0) { kf[2 * d0] = *(ALDS const bf16x8*)(kp + d0 * 2048); kf[2 * d0 + 1] = *(ALDS const bf16x8*)(kp + d0 * 2048 + 512); }
__device__ __forceinline__ void m_glds16(const void* g, unsigned lds_base) {
    unsigned sv; asm volatile("s_mov_b32 %0, m0\n\ts_mov_b32 m0, %2\n\ts_nop 0\n\tglobal_load_lds_dwordx4 %1, off\n\ts_mov_b32 m0, %0" : "=&s"(sv) : "v"(g), "s"(lds_base) : "memory"); }
typedef ALDS s16x4 lds_s16x4_t;
__device__ __forceinline__ s16x4 m_vtr(ALDS const char* p) { return __builtin_amdgcn_ds_read_tr16_b64_v4i16((lds_s16x4_t*)p); }
#define MMX3(a, b, c) __builtin_fmaxf(__builtin_fmaxf((a), (b)), (c))
__device__ __forceinline__ float m_rowmax(const f32x16& p0, const f32x16& p1) {
    float a = MMX3(p0[0], p0[1], p1[0]), b = MMX3(p0[2], p0[3], p1[1]); a = MMX3(a, p1[2], p1[3]);
#pragma unroll
    for (int r = 4; r < 16; r += 4) { a = MMX3(a, p0[r], p0[r + 1]); b = MMX3(b, p0[r + 2], p0[r + 3]); a = MMX3(a, p1[r], p1[r + 1]); b = MMX3(b, p1[r + 2], p1[r + 3]); }
    float m = __builtin_fmaxf(a, b); auto rr = __builtin_amdgcn_permlane32_swap(__float_as_uint(m), __float_as_uint(m), false, false);
    return __builtin_fmaxf(__uint_as_float(rr[0]), __uint_as_float(rr[1])); }
__device__ __forceinline__ void moba_unit(const bf16_t* Qp, const bf16_t* Kp, const bf16_t* Vp, bf16_t* Op, int ldo, int qb, ALDS char* lds) {
    int tid_ = threadIdx.x; asm volatile("" : "+v"(tid_));
    const int tid = tid_, lane = tid & 63, r32 = lane & 31, hi = lane >> 5; const int wid = __builtin_amdgcn_readfirstlane(tid >> 6);
    const int NT = 4 * qb + 4, NP = 4 * qb;
    ALDS float* wsf = (ALDS float*)(lds + M_WS) + wid * 64;
    const bf16_t* ksrc = Kp + (size_t)(lane >> 4) * 16 * AW + (wid >> 2) * 512 + (wid & 3) * 128 + (lane & 15) * 8;
    const bf16_t* vsrc = Vp + (size_t)(wid & 3) * 16 * AW + (wid >> 2) * 512 + (lane & 3) * 128 + (lane >> 2) * 8;
    const unsigned lds0 = (unsigned)(uintptr_t)lds, kdst = lds0 + M_K + wid * 1024, vdst = lds0 + M_V + wid * 1024;
#define MDMA_K(t, slot) m_glds16(ksrc + (size_t)(t) * 64 * AW, (unsigned)__builtin_amdgcn_readfirstlane(kdst + (slot)))
#define MDMA_V(t, slot) m_glds16(vsrc + (size_t)(t) * 64 * AW, (unsigned)__builtin_amdgcn_readfirstlane(vdst + (slot)))
    ALDS const char* vp0 = lds + M_V + ((lane >> 4) & 1) * 32 + (lane & 3) * 8 + (4 * hi + ((lane & 15) >> 2)) * 64;
    ALDS const char* kp0 = lds + M_K + hi * 1024 + r32 * 16;
    MDMA_K(0, 0); MDMA_V(0, 0); MDMA_K(1, MSLOT);
    bf16x8 qr[4];
    { const bf16_t* Qw = Qp + (size_t)(qb * 256 + wid * 32 + (r32 & 16)) * AW + (r32 & 15) * 8 + hi * 128;
#pragma unroll
      for (int d0 = 0; d0 < 4; ++d0) qr[d0] = *(const bf16x8*)(Qw + (d0 >> 1) * 512 + (d0 & 1) * 256); }
    MDMA_K(2, 2 * MSLOT);
    float mhat = 0.f, l_reg = 0.f; f32x16 o[2]; o[0] = f32x16{}; o[1] = f32x16{};
    const int qrel = wid * 32 + r32; bool resc = false, moved = false;
    unsigned sel = 0xffu; const bool gated = qb > 3;
    if (gated) {
        ALDS const float* km = (ALDS const float*)(lds + L_KM); float g[8];
#pragma unroll
        for (int n = 0; n < 8; ++n) { float sg = 0.f;
#pragma unroll
            for (int d0 = 0; d0 < 4; ++d0)
#pragma unroll
                for (int j = 0; j < 8; ++j) sg += bf2f(qr[d0][j]) * km[n * 64 + d0 * 16 + hi * 8 + j];
            g[n] = sg; }
#pragma unroll
        for (int n = 0; n < 8; ++n) g[n] += __shfl_xor(g[n], 32);
        sel = 0u;
#pragma unroll
        for (int n = 0; n < 8; ++n) { int rank = 0;
#pragma unroll
            for (int mm = 0; mm < 8; ++mm) if (mm != n) rank += (mm < qb && (g[mm] > g[n] || (g[mm] == g[n] && mm < n))) ? 1 : 0;
            if (n < qb && rank < 3) sel |= 1u << n; }
    }
    f32x16 cm;
#define MCM(t) do { const float v_ = (gated && (t) < NP && !((sel >> ((t) >> 2)) & 1u)) ? -INFINITY : -mhat; _Pragma("unroll") for (int r = 0; r < 16; ++r) cm[r] = v_; MPIN(cm); } while (0)
    MCM(0);
    f32x16 pA0, pA1, pB0, pB1; bf16x8 kf[8]; s16x4 vlo[8], vhi[8]; u32x4 pw0, pw1, pw2, pw3;
    int sl_prev = 0, sl_cur = 0, sl_next = MSLOT;
#define MROT() do { sl_prev = sl_cur; sl_cur = sl_next; sl_next = (sl_next == 2 * MSLOT) ? 0 : sl_next + MSLOT; } while (0)
#define MEX(v) __builtin_amdgcn_exp2f(v)
#define MRESC(tn) do { if (moved) { moved = false; MCM(tn); } if (resc) { _Pragma("unroll") for (int d_ = 0; d_ < 2; ++d_) _Pragma("unroll") for (int r = 0; r < 16; ++r) o[d_][r] *= wsf[crow(r, hi)]; } } while (0)
#define MDECIDE(C0, C1) do { const float rm = m_rowmax(C0, C1); resc = false; \
      if (__builtin_expect(__any(rm > THR), 0)) { const float dl = __builtin_fmaxf(rm, 0.f); mhat += dl; const float f = __builtin_amdgcn_exp2f(-dl); l_reg *= f; if (hi == 0) wsf[r32] = f; resc = true; \
          _Pragma("unroll") for (int r = 0; r < 16; ++r) { C0[r] -= dl; C1[r] -= dl; } moved = true; } } while (0)
    MWAIT_BAR(3);
#pragma unroll
    for (int d0 = 0; d0 < 4; ++d0) m_kload2(kf, kp0, d0);
    pA0 = MMFMA(kf[0], qr[0], cm); pA1 = MMFMA(kf[1], qr[0], cm); pA0 = MMFMA(kf[2], qr[1], pA0); pA1 = MMFMA(kf[3], qr[1], pA1);
    pA0 = MMFMA(kf[4], qr[2], pA0); pA1 = MMFMA(kf[5], qr[2], pA1); pA0 = MMFMA(kf[6], qr[3], pA0); pA1 = MMFMA(kf[7], qr[3], pA1);
    if (NT == 4) cmask(pA0, pA1, 0, qrel, hi);
    MDECIDE(pA0, pA1);
    if (moved) { moved = false; MCM(1); }
#pragma unroll
    for (int r = 0; r < 16; ++r) { pA0[r] = MEX(pA0[r]); pA1[r] = MEX(pA1[r]); }
    MWAIT_BAR(0);
    MDMA_K(3, 0); MDMA_V(1, MSLOT); MROT();
#pragma unroll
    for (int d0 = 0; d0 < 4; ++d0) m_kload2(kf, kp0 + sl_cur, d0);
    MWAIT_BAR(2);
#define MPKW(P, i) cvtpk(P[i], P[i + 1])
#define MPAF(k) __builtin_bit_cast(bf16x8, pw##k)
#define MVFR(i) (bf16x8){vlo[i][0], vlo[i][1], vlo[i][2], vlo[i][3], vhi[i][0], vhi[i][1], vhi[i][2], vhi[i][3]}
#define MVRD(i) do { vlo[i] = m_vtr(vp_ + (((i) >> 2) * 4096 + ((i) & 3) * 1024)); vhi[i] = m_vtr(vp_ + (((i) >> 2) * 4096 + ((i) & 3) * 1024 + 512)); } while (0)
#define MKRD(G, d0) do { if (G) { m_kload2(kf, kp0 + sl_next, d0); ASBAR(); } } while (0)
#define MGAPA(MF, a0, a1, a2, a3, W0, W1, PW) do { MF; sacc += a0; sacc += a1; sacc += a2; sacc += a3; W0; W1; MPIN(PW); MPIN(sacc); ASBAR(); } while (0)
#define MGAPB(MF, X, i) do { MF; X[i] = MEX(X[i]); X[i + 1] = MEX(X[i + 1]); X[i + 2] = MEX(X[i + 2]); X[i + 3] = MEX(X[i + 3]); MPIN(X); ASBAR(); } while (0)
#define MSTEP(C0, C1, P0, P1, t, MASK, GK, GV, GL) do { ASBAR(); \
    const ALDS char* vp_ = vp0 + sl_prev; if (gated && ((t) & 3) == 0) MCM(t); \
    MVRD(0); ASBAR(); float sacc = P0[0] + P0[1]; \
                     MGAPA(C0 = MMFMA(kf[0], qr[0], cm), P0[2], P0[3], P0[4], P0[5],     pw0[0] = MPKW(P0, 0),  pw0[1] = MPKW(P0, 2),  pw0); \
    MVRD(4); ASBAR(); MGAPA(C1 = MMFMA(kf[1], qr[0], cm), P0[6], P0[7], P0[8], P0[9],     pw0[2] = MPKW(P0, 4),  pw0[3] = MPKW(P0, 6),  pw0); \
    MVRD(1); ASBAR(); MGAPA(C0 = MMFMA(kf[2], qr[1], C0), P0[10], P0[11], P0[12], P0[13], pw1[0] = MPKW(P0, 8),  pw1[1] = MPKW(P0, 10), pw1); \
    MVRD(5); ASBAR(); MGAPA(C1 = MMFMA(kf[3], qr[1], C1), P0[14], P0[15], P1[0], P1[1],   pw1[2] = MPKW(P0, 12), pw1[3] = MPKW(P0, 14), pw1); \
    MVRD(2); ASBAR(); MGAPA(C0 = MMFMA(kf[4], qr[2], C0), P1[2], P1[3], P1[4], P1[5],     pw2[0] = MPKW(P1, 0),  pw2[1] = MPKW(P1, 2),  pw2); \
    MVRD(6); ASBAR(); MGAPA(C1 = MMFMA(kf[5], qr[2], C1), P1[6], P1[7], P1[8], P1[9],     pw2[2] = MPKW(P1, 4),  pw2[3] = MPKW(P1, 6),  pw2); \
    MVRD(3); ASBAR(); MGAPA(C0 = MMFMA(kf[6], qr[3], C0), P1[10], P1[11], P1[12], P1[13], pw3[0] = MPKW(P1, 8),  pw3[1] = MPKW(P1, 10), pw3); \
    MVRD(7); ASBAR(); MGAPA(C1 = MMFMA(kf[7], qr[3], C1), P1[14], P1[15], 0.f, 0.f,       pw3[2] = MPKW(P1, 12), pw3[3] = MPKW(P1, 14), pw3); \
    l_reg += sacc; \
    if (GK) MDMA_K((t) + 3, sl_cur); if (GV) MDMA_V((t) + 1, sl_next); \
    if (MASK) cmask(C0, C1, (t) - NP, qrel, hi); \
    MDECIDE(C0, C1); ASBAR(); \
    MGAPB(o[0] = MMFMA(MPAF(0), MVFR(0), o[0]), C0, 0);               MGAPB(o[1] = MMFMA(MPAF(0), MVFR(4), o[1]), C0, 4); \
    MKRD(GL, 0); MGAPB(o[0] = MMFMA(MPAF(1), MVFR(1), o[0]), C0, 8);  MKRD(GL, 1); MGAPB(o[1] = MMFMA(MPAF(1), MVFR(5), o[1]), C0, 12); \
    MKRD(GL, 2); MGAPB(o[0] = MMFMA(MPAF(2), MVFR(2), o[0]), C1, 0);  MKRD(GL, 3); MGAPB(o[1] = MMFMA(MPAF(2), MVFR(6), o[1]), C1, 4); \
    MGAPB(o[0] = MMFMA(MPAF(3), MVFR(3), o[0]), C1, 8);               MGAPB(o[1] = MMFMA(MPAF(3), MVFR(7), o[1]), C1, 12); \
    } while (0)
    int t = 1;
    for (; t + 5 < NT; t += 2) {
        MSTEP(pB0, pB1, pA0, pA1, t, false, true, true, true);     MWAIT_BAR(2); MRESC(t + 1); MROT();
        MSTEP(pA0, pA1, pB0, pB1, t + 1, false, true, true, true); MWAIT_BAR(2); MRESC(t + 2); MROT();
    }
#define MENDW(tt) do { if ((tt) + 3 < NT) { MWAIT_BAR(2); } else if ((tt) + 2 < NT) { MWAIT_BAR(1); } else { MWAIT_BAR(0); } } while (0)
    for (; t + 1 < NT; t += 2) {
        MSTEP(pB0, pB1, pA0, pA1, t, true, (t + 3 < NT), (t + 1 < NT), (t + 1 < NT));         MENDW(t);     MRESC(t + 1); MROT();
        MSTEP(pA0, pA1, pB0, pB1, t + 1, true, (t + 4 < NT), (t + 2 < NT), (t + 2 < NT));     MENDW(t + 1); MRESC(t + 2); MROT();
    }
    MSTEP(pB0, pB1, pA0, pA1, NT - 1, true, false, false, false); MRESC(NT - 1);
    { float sacc = pB0[0] + pB0[1];
#pragma unroll
      for (int r = 2; r < 16; ++r) sacc += pB0[r];
#pragma unroll
      for (int r = 0; r < 16; ++r) sacc += pB1[r];
      l_reg += sacc;
      pw0 = (u32x4){MPKW(pB0, 0), MPKW(pB0, 2), MPKW(pB0, 4), MPKW(pB0, 6)}; pw1 = (u32x4){MPKW(pB0, 8), MPKW(pB0, 10), MPKW(pB0, 12), MPKW(pB0, 14)};
      pw2 = (u32x4){MPKW(pB1, 0), MPKW(pB1, 2), MPKW(pB1, 4), MPKW(pB1, 6)}; pw3 = (u32x4){MPKW(pB1, 8), MPKW(pB1, 10), MPKW(pB1, 12), MPKW(pB1, 14)};
      const ALDS char* vp_ = vp0 + sl_cur;
#pragma unroll
      for (int i = 0; i < 8; ++i) MVRD(i);
      o[0] = MMFMA(MPAF(0), MVFR(0), o[0]); o[1] = MMFMA(MPAF(0), MVFR(4), o[1]); o[0] = MMFMA(MPAF(1), MVFR(1), o[0]); o[1] = MMFMA(MPAF(1), MVFR(5), o[1]);
      o[0] = MMFMA(MPAF(2), MVFR(2), o[0]); o[1] = MMFMA(MPAF(2), MVFR(6), o[1]); o[0] = MMFMA(MPAF(3), MVFR(3), o[0]); o[1] = MMFMA(MPAF(3), MVFR(7), o[1]); }
    { auto rr = __builtin_amdgcn_permlane32_swap(__float_as_uint(l_reg), __float_as_uint(l_reg), false, false); l_reg = __uint_as_float(rr[0]) + __uint_as_float(rr[1]); }
    if (hi == 0) wsf[32 + r32] = l_reg; asm volatile("s_waitcnt lgkmcnt(0)" ::: "memory");
    float rli[16];
#pragma unroll
    for (int r = 0; r < 16; ++r) rli[r] = __builtin_amdgcn_rcpf(wsf[32 + crow(r, hi)]);
    { ALDS unsigned short* stg = (ALDS unsigned short*)(lds + M_OST) + wid * 2048;
#pragma unroll
      for (int r = 0; r < 16; ++r) { const int orow = crow(r, hi);
#pragma unroll
          for (int d0 = 0; d0 < 2; ++d0) stg[orow * 64 + d0 * 32 + r32] = (unsigned short)(cvtpk(o[d0][r] * rli[r], 0.f) & 0xffffu); }
      asm volatile("s_waitcnt lgkmcnt(0)" ::: "memory");
      bf16_t* Ow = Op + (size_t)(qb * 256 + wid * 32) * ldo;
#pragma unroll
      for (int i = 0; i < 4; ++i) { const int row = i * 8 + (lane >> 3), ch = lane & 7; const u32x4 v = *(ALDS const u32x4*)(stg + row * 64 + ch * 8); *(u32x4*)(Ow + (size_t)row * ldo + ch * 8) = v; } }
    asm volatile("s_waitcnt lgkmcnt(0)\n\ts_barrier" ::: "memory");
#undef MDMA_K
#undef MDMA_V
#undef MCM
#undef MROT
#undef MEX
#undef MRESC
#undef MDECIDE
#undef MPKW
#undef MPAF
#undef MVFR
#undef MVRD
#undef MKRD
#undef MGAPA
#undef MGAPB
#undef MSTEP
#undef MENDW
}
__device__ __forceinline__ void mla_unit(const bf16_t* Qp, const bf16_t* Kp, const bf16_t* KRp, const bf16_t* Vp, bf16_t* Op, int ldo, int qb, ALDS char* lds) {
    constexpr int KSL = 12288, N_K = 0, N_V = 3 * KSL, N_WS = N_V + 3 * MSLOT, N_OST = N_WS + 8 * 256;
    int tid_ = threadIdx.x; asm volatile("" : "+v"(tid_));
    const int tid = tid_, lane = tid & 63, r32 = lane & 31, hi = lane >> 5; const int wid = __builtin_amdgcn_readfirstlane(tid >> 6);
    const int NT = 4 * qb + 4, NP = 4 * qb;
    ALDS float* wsf = (ALDS float*)(lds + N_WS) + wid * 64;
    const bf16_t* ksrc = Kp + (size_t)(lane >> 4) * 16 * AW + (wid >> 2) * 512 + (wid & 3) * 128 + (lane & 15) * 8;
    const bf16_t* vsrc = Vp + (size_t)(wid & 3) * 16 * AW + (wid >> 2) * 512 + (lane & 3) * 128 + (lane >> 2) * 8;
    const bf16_t* rsrc = KRp + (size_t)(lane >> 4) * 16 * RDIM + (wid & 3) * 128 + (lane & 15) * 8;
    const unsigned lds0 = (unsigned)(uintptr_t)lds, kdst = lds0 + N_K + wid * 1024, vdst = lds0 + N_V + wid * 1024, rdst = lds0 + N_K + (8 + (wid & 3)) * 1024;
#define MDMA_K(t, slot) do { m_glds16(ksrc + (size_t)(t) * 64 * AW, (unsigned)__builtin_amdgcn_readfirstlane(kdst + (slot) * KSL)); m_glds16(rsrc + (size_t)(t) * 64 * RDIM, (unsigned)__builtin_amdgcn_readfirstlane(rdst + (slot) * KSL)); } while (0)
#define MDMA_V(t, slot) m_glds16(vsrc + (size_t)(t) * 64 * AW, (unsigned)__builtin_amdgcn_readfirstlane(vdst + (slot) * MSLOT))
    ALDS const char* vp0 = lds + N_V + ((lane >> 4) & 1) * 32 + (lane & 3) * 8 + (4 * hi + ((lane & 15) >> 2)) * 64;
    ALDS const char* kp0 = lds + N_K + hi * 1024 + r32 * 16;
    MDMA_K(0, 0); MDMA_V(0, 0); MDMA_K(1, 1);
    bf16x8 qr[6];
    { const bf16_t* Qw = Qp + (size_t)(qb * 256 + wid * 32 + (r32 & 16)) * (NHEAD * QKB) + (r32 & 15) * 8 + hi * 128;
#pragma unroll
      for (int d0 = 0; d0 < 6; ++d0) qr[d0] = *(const bf16x8*)(Qw + (d0 >> 1) * 512 + (d0 & 1) * 256); }
    MDMA_K(2, 2);
    float mhat = 0.f, l_reg = 0.f; f32x16 o[2]; o[0] = f32x16{}; o[1] = f32x16{};
    const int qrel = wid * 32 + r32; bool resc = false, moved = false;
    constexpr bool gated = false; constexpr unsigned sel = 0xffu;
#define MCM(t) do { } while (0)
#define MREL(C0, C1) do { if (__builtin_expect(__any(mhat != 0.f), 0)) { _Pragma("unroll") for (int r = 0; r < 16; ++r) { C0[r] -= mhat; C1[r] -= mhat; } } } while (0)
    f32x16 pA0, pA1, pB0, pB1; bf16x8 kf[12]; s16x4 vlo[8], vhi[8]; u32x4 pw0, pw1, pw2, pw3;
    int sl_prev = 0, sl_cur = 0, sl_next = 1;
#define MROT() do { sl_prev = sl_cur; sl_cur = sl_next; sl_next = (sl_next == 2) ? 0 : sl_next + 1; } while (0)
#define MEX(v) __builtin_amdgcn_exp2f(v)
#define MRESC(tn) do { if (resc) { _Pragma("unroll") for (int d_ = 0; d_ < 2; ++d_) _Pragma("unroll") for (int r = 0; r < 16; ++r) o[d_][r] *= wsf[crow(r, hi)]; } } while (0)
#define MDECIDE(C0, C1) do { const float rm = m_rowmax(C0, C1); resc = false; \
      if (__builtin_expect(__any(rm > THR), 0)) { const float dl = __builtin_fmaxf(rm, 0.f); mhat += dl; const float f = __builtin_amdgcn_exp2f(-dl); l_reg *= f; if (hi == 0) wsf[r32] = f; resc = true; \
          _Pragma("unroll") for (int r = 0; r < 16; ++r) { C0[r] -= dl; C1[r] -= dl; } moved = true; } } while (0)
    MWAIT_BAR(5);
#pragma unroll
    for (int d0 = 0; d0 < 6; ++d0) m_kload2(kf, kp0, d0);
    pA0 = MMFMA(kf[0], qr[0], (f32x16){}); pA1 = MMFMA(kf[1], qr[0], (f32x16){}); pA0 = MMFMA(kf[2], qr[1], pA0); pA1 = MMFMA(kf[3], qr[1], pA1);
    pA0 = MMFMA(kf[4], qr[2], pA0); pA1 = MMFMA(kf[5], qr[2], pA1); pA0 = MMFMA(kf[6], qr[3], pA0); pA1 = MMFMA(kf[7], qr[3], pA1);
    pA0 = MMFMA(kf[8], qr[4], pA0); pA1 = MMFMA(kf[9], qr[4], pA1); pA0 = MMFMA(kf[10], qr[5], pA0); pA1 = MMFMA(kf[11], qr[5], pA1);
    if (NT == 4) cmask(pA0, pA1, 0, qrel, hi);
    MREL(pA0, pA1); MDECIDE(pA0, pA1);
#pragma unroll
    for (int r = 0; r < 16; ++r) { pA0[r] = MEX(pA0[r]); pA1[r] = MEX(pA1[r]); }
    MWAIT_BAR(0);
    MDMA_K(3, 0); MDMA_V(1, 1); MROT();
#pragma unroll
    for (int d0 = 0; d0 < 6; ++d0) m_kload2(kf, kp0 + sl_cur * KSL, d0);
    MWAIT_BAR(3);
#define MPKW(P, i) cvtpk(P[i], P[i + 1])
#define MPAF(k) __builtin_bit_cast(bf16x8, pw##k)
#define MVFR(i) (bf16x8){vlo[i][0], vlo[i][1], vlo[i][2], vlo[i][3], vhi[i][0], vhi[i][1], vhi[i][2], vhi[i][3]}
#define MVRD(i) do { vlo[i] = m_vtr(vp_ + (((i) >> 2) * 4096 + ((i) & 3) * 1024)); vhi[i] = m_vtr(vp_ + (((i) >> 2) * 4096 + ((i) & 3) * 1024 + 512)); } while (0)
#define MKRD(G, d0) do { if (G) { m_kload2(kf, kp0 + sl_next * KSL, d0); ASBAR(); } } while (0)
#define MGAPA(MF, a0, a1, a2, a3, W0, W1, PW) do { MF; sacc += a0; sacc += a1; sacc += a2; sacc += a3; W0; W1; MPIN(PW); MPIN(sacc); ASBAR(); } while (0)
#define MGAPB(MF, X, i) do { MF; X[i] = MEX(X[i]); X[i + 1] = MEX(X[i + 1]); X[i + 2] = MEX(X[i + 2]); X[i + 3] = MEX(X[i + 3]); MPIN(X); ASBAR(); } while (0)
#define MGAPA2(MF, a0, a1, W0, PW) do { MF; sacc += a0; sacc += a1; W0; MPIN(PW); MPIN(sacc); ASBAR(); } while (0)
#define MSTEP(C0, C1, P0, P1, t, MASK, GK, GV, GL) do { ASBAR(); \
    const ALDS char* vp_ = vp0 + sl_prev * MSLOT; \
    MVRD(0); ASBAR(); float sacc = P0[0] + P0[1]; \
                     MGAPA(C0 = MMFMA(kf[0], qr[0], (f32x16){}), P0[2], P0[3], P0[4], P0[5],     pw0[0] = MPKW(P0, 0),  pw0[1] = MPKW(P0, 2),  pw0); \
    MVRD(4); ASBAR(); MGAPA(C1 = MMFMA(kf[1], qr[0], (f32x16){}), P0[6], P0[7], P0[8], P0[9],     pw0[2] = MPKW(P0, 4),  pw0[3] = MPKW(P0, 6),  pw0); \
    MVRD(1); ASBAR(); MGAPA2(C0 = MMFMA(kf[2], qr[1], C0), P0[10], P0[11], pw1[0] = MPKW(P0, 8),  pw1); \
    MVRD(5); ASBAR(); MGAPA2(C1 = MMFMA(kf[3], qr[1], C1), P0[12], P0[13], pw1[1] = MPKW(P0, 10), pw1); \
                     MGAPA2(C0 = MMFMA(kf[4], qr[2], C0), P0[14], P0[15], pw1[2] = MPKW(P0, 12), pw1); \
                     MGAPA2(C1 = MMFMA(kf[5], qr[2], C1), P1[0], P1[1],   pw1[3] = MPKW(P0, 14), pw1); \
                     MGAPA2(C0 = MMFMA(kf[6], qr[3], C0), P1[2], P1[3],   pw2[0] = MPKW(P1, 0),  pw2); \
                     MGAPA2(C1 = MMFMA(kf[7], qr[3], C1), P1[4], P1[5],   pw2[1] = MPKW(P1, 2),  pw2); \
                     MGAPA(C0 = MMFMA(kf[8], qr[4], C0), P1[6], P1[7], P1[8], P1[9],     pw2[2] = MPKW(P1, 4),  pw2[3] = MPKW(P1, 6),  pw2); \
                     MGAPA(C1 = MMFMA(kf[9], qr[4], C1), P1[10], P1[11], P1[12], P1[13], pw3[0] = MPKW(P1, 8),  pw3[1] = MPKW(P1, 10), pw3); \
                     MGAPA2(C0 = MMFMA(kf[10], qr[5], C0), P1[14], P1[15], pw3[2] = MPKW(P1, 12), pw3); \
                     MGAPA2(C1 = MMFMA(kf[11], qr[5], C1), 0.f, 0.f,       pw3[3] = MPKW(P1, 14), pw3); \
    l_reg += sacc; \
    if (GK) MDMA_K((t) + 3, sl_cur); if (GV) MDMA_V((t) + 1, sl_next); \
    if (MASK) cmask(C0, C1, (t) - NP, qrel, hi); \
    MREL(C0, C1); MDECIDE(C0, C1); ASBAR(); \
    MVRD(2); MKRD(GL, 4); ASBAR(); MGAPB(o[0] = MMFMA(MPAF(0), MVFR(0), o[0]), C0, 0);  MVRD(6); MKRD(GL, 5); ASBAR(); MGAPB(o[1] = MMFMA(MPAF(0), MVFR(4), o[1]), C0, 4); \
    MVRD(3); MKRD(GL, 0); ASBAR(); MGAPB(o[0] = MMFMA(MPAF(1), MVFR(1), o[0]), C0, 8);  MVRD(7); MKRD(GL, 1); ASBAR(); MGAPB(o[1] = MMFMA(MPAF(1), MVFR(5), o[1]), C0, 12); \
    MKRD(GL, 2); MGAPB(o[0] = MMFMA(MPAF(2), MVFR(2), o[0]), C1, 0);  MKRD(GL, 3); MGAPB(o[1] = MMFMA(MPAF(2), MVFR(6), o[1]), C1, 4); \
    MGAPB(o[0] = MMFMA(MPAF(3), MVFR(3), o[0]), C1, 8);               MGAPB(o[1] = MMFMA(MPAF(3), MVFR(7), o[1]), C1, 12); \
    } while (0)
    int t = 1;
    for (; t + 5 < NT; t += 2) {
        MSTEP(pB0, pB1, pA0, pA1, t, false, true, true, true);     MWAIT_BAR(3); MRESC(t + 1); MROT();
        MSTEP(pA0, pA1, pB0, pB1, t + 1, false, true, true, true); MWAIT_BAR(3); MRESC(t + 2); MROT();
    }
#define MENDW(tt) do { if ((tt) + 3 < NT) { MWAIT_BAR(3); } else if ((tt) + 2 < NT) { MWAIT_BAR(1); } else { MWAIT_BAR(0); } } while (0)
    for (; t + 1 < NT; t += 2) {
        MSTEP(pB0, pB1, pA0, pA1, t, true, (t + 3 < NT), (t + 1 < NT), (t + 1 < NT));         MENDW(t);     MRESC(t + 1); MROT();
        MSTEP(pA0, pA1, pB0, pB1, t + 1, true, (t + 4 < NT), (t + 2 < NT), (t + 2 < NT));     MENDW(t + 1); MRESC(t + 2); MROT();
    }
    MSTEP(pB0, pB1, pA0, pA1, NT - 1, true, false, false, false); MRESC(NT - 1);
    { float sacc = pB0[0] + pB0[1];
#pragma unroll
      for (int r = 2; r < 16; ++r) sacc += pB0[r];
#pragma unroll
      for (int r = 0; r < 16; ++r) sacc += pB1[r];
      l_reg += sacc;
      pw0 = (u32x4){MPKW(pB0, 0), MPKW(pB0, 2), MPKW(pB0, 4), MPKW(pB0, 6)}; pw1 = (u32x4){MPKW(pB0, 8), MPKW(pB0, 10), MPKW(pB0, 12), MPKW(pB0, 14)};
      pw2 = (u32x4){MPKW(pB1, 0), MPKW(pB1, 2), MPKW(pB1, 4), MPKW(pB1, 6)}; pw3 = (u32x4){MPKW(pB1, 8), MPKW(pB1, 10), MPKW(pB1, 12), MPKW(pB1, 14)};
      const ALDS char* vp_ = vp0 + sl_cur * MSLOT;
#pragma unroll
      for (int i = 0; i < 8; ++i) MVRD(i);
      o[0] = MMFMA(MPAF(0), MVFR(0), o[0]); o[1] = MMFMA(MPAF(0), MVFR(4), o[1]); o[0] = MMFMA(MPAF(1), MVFR(1), o[0]); o[1] = MMFMA(MPAF(1), MVFR(5), o[1]);
      o[0] = MMFMA(MPAF(2), MVFR(2), o[0]); o[1] = MMFMA(MPAF(2), MVFR(6), o[1]); o[0] = MMFMA(MPAF(3), MVFR(3), o[0]); o[1] = MMFMA(MPAF(3), MVFR(7), o[1]); }
    { auto rr = __builtin_amdgcn_permlane32_swap(__float_as_uint(l_reg), __float_as_uint(l_reg), false, false); l_reg = __uint_as_float(rr[0]) + __uint_as_float(rr[1]); }
    if (hi == 0) wsf[32 + r32] = l_reg; asm volatile("s_waitcnt lgkmcnt(0)" ::: "memory");
    float rli[16];
#pragma unroll
    for (int r = 0; r < 16; ++r) rli[r] = __builtin_amdgcn_rcpf(wsf[32 + crow(r, hi)]);
    { ALDS unsigned short* stg = (ALDS unsigned short*)(lds + N_OST) + wid * 2048;
#pragma unroll
      for (int r = 0; r < 16; ++r) { const int orow = crow(r, hi);
#pragma unroll
          for (int d0 = 0; d0 < 2; ++d0) stg[orow * 64 + d0 * 32 + r32] = (unsigned short)(cvtpk(o[d0][r] * rli[r], 0.f) & 0xffffu); }
      asm volatile("s_waitcnt lgkmcnt(0)" ::: "memory");
      bf16_t* Ow = Op + (size_t)(qb * 256 + wid * 32) * ldo;
#pragma unroll
      for (int i = 0; i < 4; ++i) { const int row = i * 8 + (lane >> 3), ch = lane & 7; const u32x4 v = *(ALDS const u32x4*)(stg + row * 64 + ch * 8); *(u32x4*)(Ow + (size_t)row * ldo + ch * 8) = v; } }
    asm volatile("s_waitcnt lgkmcnt(0)\n\ts_barrier" ::: "memory");
#undef MDMA_K
#undef MDMA_V
#undef MCM
#undef MROT
#undef MEX
#undef MRESC
#undef MDECIDE
#undef MPKW
#undef MPAF
#undef MVFR
#undef MVRD
#undef MKRD
#undef MGAPA
#undef MGAPB
#undef MSTEP
#undef MENDW
#undef MGAPA2
#undef MREL
}
#undef ASBAR
}
#define GAS __attribute__((address_space(1)))
#define LAS __attribute__((address_space(3)))
typedef unsigned short bf16;
typedef unsigned v4u __attribute__((ext_vector_type(4)));
typedef float f32x4 __attribute__((ext_vector_type(4)));
typedef short bf16x8 __attribute__((ext_vector_type(8)));
typedef GAS unsigned gu32;
typedef GAS unsigned long long gu64;
#define RLX_AGENT __ATOMIC_RELAXED, __HIP_MEMORY_SCOPE_AGENT
#define LDS_WAIT() asm volatile("s_waitcnt lgkmcnt(0)" ::: "memory")
#define VM_WAIT() asm volatile("s_waitcnt vmcnt(0)" ::: "memory")
__device__ __forceinline__ unsigned long long rt() { return __builtin_amdgcn_s_memrealtime(); }
__device__ __forceinline__ unsigned f2bf(float f) { unsigned u = __builtin_bit_cast(unsigned, f); return (u + 0x7fffu + ((u >> 16) & 1u)) >> 16; }
__device__ __forceinline__ unsigned pk2(float lo, float hi) { return f2bf(lo) | (f2bf(hi) << 16); }

#define XB_TMO      128
#define XB_XCNT(j)  (256  + 64 * (j))
#define XB_XSUB(j)  (1280 + 64 * (j))
#define XB_XGEN(j)  (2304 + 64 * (j))
#define XB_TOP      3328
#define XB_TOPGEN   3392
#define XCD_BAR_WORDS 3456
#define XB_SPIN_CAP (1u << 18)

__device__ __forceinline__ unsigned xb_ld(unsigned* p)              { return __hip_atomic_load(p, __ATOMIC_RELAXED, __HIP_MEMORY_SCOPE_AGENT); }
__device__ __forceinline__ unsigned xb_add(unsigned* p, unsigned v) { return __hip_atomic_fetch_add(p, v, __ATOMIC_RELAXED, __HIP_MEMORY_SCOPE_AGENT); }
__device__ __forceinline__ unsigned xb_xcc_id() { return (unsigned)__builtin_amdgcn_s_getreg((3 << 11) | 20) & 0xFu; }
#define XB_SPIN(cond, bar) do { unsigned _sp = 0; while (cond) { __builtin_amdgcn_s_sleep(1); \
    if ((++_sp & 255u) == 0u) { if (xb_ld(&(bar)[XB_TMO])) break; if (_sp > XB_SPIN_CAP) { atomicAdd(&(bar)[XB_TMO], 1u); break; } } } } while (0)

struct XcdBarrier {
    unsigned* bar; unsigned x;
    volatile LAS unsigned* st;
};

__device__ __forceinline__ XcdBarrier xcd_barrier_post(unsigned* bar, volatile LAS unsigned* st) {
    XcdBarrier b; b.bar = bar; b.x = xb_xcc_id(); b.st = st;
    if (threadIdx.x == 0) (void)xb_add(&bar[XB_XCNT(b.x)], 1u);
    return b;
}
__device__ __forceinline__ void xcd_barrier_complete(unsigned* bar, unsigned x, unsigned& nloc, unsigned& nx) {
    const unsigned G = gridDim.x * gridDim.y * gridDim.z;
    unsigned sum, cnt, mine, sp = 0u;
    for (;;) {
        sum = 0u; cnt = 0u; mine = 0u;
#pragma unroll
        for (unsigned j = 0; j < 16; ++j) { const unsigned c = xb_ld(&bar[XB_XCNT(j)]); sum += c; cnt += (c > 0u) ? 1u : 0u; mine = (j == x) ? c : mine; }
        if (sum == G) break;
        __builtin_amdgcn_s_sleep(1);
        if ((++sp & 255u) == 0u) { if (xb_ld(&bar[XB_TMO])) break; if (sp > XB_SPIN_CAP) { atomicAdd(&bar[XB_TMO], 1u); break; } }
    }
    nloc = mine > 0u ? mine : 1u; nx = cnt > 0u ? cnt : 1u;
}

__device__ __forceinline__ void xcd_barrier(const XcdBarrier& b) {
    asm volatile("s_waitcnt vmcnt(0)" ::: "memory");
    __syncthreads();
    if (threadIdx.x == 0) {
        unsigned* bar = b.bar;
        __builtin_amdgcn_s_waitcnt(0);
        unsigned nloc = b.st[0], nx = b.st[1];
        if (nloc == 0u) { xcd_barrier_complete(bar, b.x, nloc, nx); b.st[0] = nloc; b.st[1] = nx; }
        const unsigned old = xb_add(&bar[XB_XSUB(b.x)], 1u);
        const unsigned gen = old / nloc;
        if (old + 1u == (gen + 1u) * nloc) {
            __builtin_amdgcn_fence(__ATOMIC_RELEASE, "agent");
            asm volatile("s_waitcnt vmcnt(0)" ::: "memory");
            const unsigned og = xb_add(&bar[XB_TOP], 1u);
            const unsigned tg = og / nx;
            if (og + 1u == (tg + 1u) * nx) xb_add(&bar[XB_TOPGEN], 1u);
            else XB_SPIN(xb_ld(&bar[XB_TOPGEN]) == tg, bar);
            __builtin_amdgcn_fence(__ATOMIC_ACQUIRE, "agent");
            xb_add(&bar[XB_XGEN(b.x)], 1u);
            asm volatile("s_waitcnt vmcnt(0)" ::: "memory");
        } else {
            XB_SPIN(xb_ld(&bar[XB_XGEN(b.x)]) == gen, bar);
            __builtin_amdgcn_fence(__ATOMIC_ACQUIRE, "agent");
            asm volatile("s_waitcnt vmcnt(0)" ::: "memory");
        }
    }
    __syncthreads();
}

constexpr size_t MiB = 1u << 20;
constexpr size_t WS_CTL = 0, CTL_ZERO_BYTES = 64 * 1024;
constexpr size_t WS_ROPEA = 1 * MiB, WS_ROPEB = 5 * MiB;
constexpr size_t WS_SS = 13 * MiB, WS_SS2 = 16 * MiB, WS_SS3 = 20 * MiB;
constexpr size_t WS_WIN = 24 * MiB, WS_WUQ = 34 * MiB, WS_WUKV = 35 * MiB, WS_WA = 36 * MiB, WS_WOUT = 39 * MiB, WS_WUP = 42 * MiB, WS_WDN = 51 * MiB;
constexpr size_t WS_H = 64 * MiB;
constexpr size_t WS_G = 208 * MiB;
constexpr size_t WS_QA = 464 * MiB, WS_KA = 528 * MiB, WS_VA = 592 * MiB;
constexpr size_t WS_T = WS_KA;
constexpr size_t WS_CQ = 672 * MiB, WS_CKV = 720 * MiB;
constexpr size_t WS_KR = 760 * MiB;
constexpr size_t WS_QB = 768 * MiB, WS_KB = 864 * MiB, WS_VB = 928 * MiB;
constexpr size_t WS_Y = WS_QB;
constexpr size_t WS_X1 = 896 * MiB;
constexpr size_t WS_H8 = WS_QB;
constexpr size_t WS_WG8 = 60 * MiB;
constexpr size_t WS_U = 208 * MiB;
constexpr size_t WS_END = 1024 * MiB;
static_assert(WS_H + (size_t)MTOK * LDH * 2 <= WS_G && WS_G + (size_t)MTOK * 2 * DM * 2 <= WS_QA && WS_T + (size_t)MTOK * LDH * 2 <= WS_CQ && WS_CQ + (size_t)MTOK * QLORA * 2 <= WS_CKV && WS_CKV + (size_t)MTOK * LDKV * 2 <= WS_KR, "d_ws map");
static_assert(WS_U + (size_t)MTOK * LDU * 2 <= WS_KR && WS_Y + (size_t)MTOK * DM * 2 <= WS_X1 && WS_X1 + (size_t)MTOK * DM * 2 <= WS_END && WS_VB + (size_t)MTOK * AW * 2 <= WS_END && WS_KR + (size_t)MTOK * RDIM * 2 <= WS_QB, "d_ws map");
static_assert(WS_WIN + (size_t)INWP * LDH * 2 <= WS_WUQ && WS_WUKV + (size_t)1024 * LDKV * 2 <= WS_WA && WS_WA + (size_t)DM * LDH * 2 <= WS_WOUT && WS_WOUT + (size_t)DM * LDH * 2 <= WS_WUP && WS_WUP + (size_t)DFF * LDH * 2 <= WS_WDN && WS_WDN + (size_t)DM * LDU * 2 <= WS_H, "d_ws map");
constexpr int CW_BAR = 0;
constexpr int NWAVES = 8;
constexpr int RING_OFF = 0, RING_BYTES = 131072;
constexpr int LDSCTL_OFF = RING_BYTES, MISC_OFF = LDSCTL_OFF + 320;
constexpr int LDS_BYTES = 147456;
static_assert(att::L_END <= RING_BYTES, "attention LDS map");

struct Frame {
    LAS unsigned char* lds;
    volatile LAS unsigned* MISC;
    gu32* ctl;
    int tid, lane, wave, vcu, G;
};

__device__ __forceinline__ float wave_sum(float v) {
#pragma unroll
    for (int o = 1; o < 64; o <<= 1) v += __shfl_xor(v, o);
    return v;
}
__device__ __forceinline__ int srccol(int mat, int n) {
    if (mat == 0) {
        if (n < 1024) { const int sect = n >> 9, c = n & 511, head = c >> 6, p = c & 63; const int d = (p < 16) ? ((p >> 1) + 8 * (p & 1)) : p; return sect * 512 + head * 64 + d; }
        if (n < 1920) return n;
        if (n < 1952) { const int pr = n - 1920; return 2176 + (pr >> 1) + 16 * (pr & 1); }
        if (n < 2048) return -1;
        if (n < 2304) return 1920 + (n - 2048);
        return 2208 + (n - 2304);
    }
    if (mat == 1) { const int head = n / QKB, p = n - head * QKB; if (p < 64) return n; const int pr = p - 64; return head * QKB + 64 + (pr >> 1) + 16 * (pr & 1); }
    return n;
}
__device__ __forceinline__ void p0_transpose_item(const float* W, int K, int Nsrc, int Ndst, bf16* WT, int ldw, int koff, const float* gs, int mat, LAS float* scr, int item, int lane) {
    const int nblk = Ndst / 32, kb = item / nblk, nb = item % nblk, k0 = 64 * kb, n0 = 32 * nb;
    const int sc = srccol(mat, n0 + (lane & 31));
#pragma unroll
    for (int i = 0; i < 32; ++i) { const int kk = 2 * i + (lane >> 5); float v = (sc >= 0) ? W[(size_t)(k0 + kk) * Nsrc + sc] : 0.f; if (gs) v *= gs[k0 + kk]; scr[kk * 33 + (lane & 31)] = v; }
    LDS_WAIT(); asm volatile("" ::: "memory");
    const int c = lane & 7;
#pragma unroll
    for (int j = 0; j < 4; ++j) { const int n = (lane >> 3) + 8 * j; const LAS float* s = scr + (8 * c) * 33 + n;
        v4u o; o.x = pk2(s[0 * 33], s[1 * 33]); o.y = pk2(s[2 * 33], s[3 * 33]); o.z = pk2(s[4 * 33], s[5 * 33]); o.w = pk2(s[6 * 33], s[7 * 33]);
        *(GAS v4u*)(WT + (size_t)(n0 + n) * ldw + koff + k0 + 8 * c) = o; }
    LDS_WAIT(); asm volatile("" ::: "memory");
}
__device__ __forceinline__ int ppos_dn(int c) { return (c & ~255) | (((c >> 5) & 3) << 6) | (((c >> 3) & 3) << 4) | (((c >> 7) & 1) << 3) | (c & 7); }
template <bool KPERM = false>
__device__ __forceinline__ void p0_transpose_item_f8(const float* W, int K, int N, int Nsrc, int coff, unsigned char* WT, float scale, LAS float* scr, int item, int lane) {
    const int nblk = N / 32, kb = item / nblk, nb = item % nblk, k0 = 64 * kb, n0 = 32 * nb;
#pragma unroll
    for (int i = 0; i < 32; ++i) { const int kk = 2 * i + (lane >> 5); scr[kk * 33 + (lane & 31)] = W[(size_t)(k0 + kk) * Nsrc + coff + n0 + (lane & 31)] * scale; }
    LDS_WAIT(); asm volatile("" ::: "memory");
    const int c = lane & 7;
#pragma unroll
    for (int j = 0; j < 4; ++j) { const int n = (lane >> 3) + 8 * j; const LAS float* s = scr + (8 * c) * 33 + n;
        int w0 = 0, w1 = 0;
        w0 = __builtin_amdgcn_cvt_pk_fp8_f32(s[0 * 33], s[1 * 33], w0, false); w0 = __builtin_amdgcn_cvt_pk_fp8_f32(s[2 * 33], s[3 * 33], w0, true);
        w1 = __builtin_amdgcn_cvt_pk_fp8_f32(s[4 * 33], s[5 * 33], w1, false); w1 = __builtin_amdgcn_cvt_pk_fp8_f32(s[6 * 33], s[7 * 33], w1, true);
        typedef int i32x2_ __attribute__((ext_vector_type(2)));
        *(GAS i32x2_*)(WT + (size_t)(n0 + n) * K + (KPERM ? ppos_dn(k0 + 8 * c) : k0 + 8 * c)) = (i32x2_){w0, w1}; }
    LDS_WAIT(); asm volatile("" ::: "memory");
}
__device__ __forceinline__ void rms_row_to_bf16(int lane, const f32x4 (&v)[4], const f32x4 (&g)[4], bf16* orow, unsigned char* orow8) {
    float s = 0.f;
#pragma unroll
    for (int j = 0; j < 4; ++j) s += (v[j].x * v[j].x + v[j].y * v[j].y) + (v[j].z * v[j].z + v[j].w * v[j].w);
    const float rstd = 1.f / sqrtf(wave_sum(s) * (1.f / DM) + EPS);
    GAS unsigned long long* o8 = (GAS unsigned long long*)orow + lane;
#pragma unroll
    for (int j = 0; j < 4; ++j) { const f32x4 y = v[j] * rstd * g[j]; o8[64 * j] = (unsigned long long)pk2(y.x, y.y) | ((unsigned long long)pk2(y.z, y.w) << 32);
        int w = 0; w = __builtin_amdgcn_cvt_pk_fp8_f32(y.x, y.y, w, false); w = __builtin_amdgcn_cvt_pk_fp8_f32(y.z, y.w, w, true); ((GAS int*)orow8)[lane + 64 * j] = w; }
}

struct Args { const float* in[17]; float* out; unsigned char* ws; int ph_lo, ph_hi, li, pad; };

__global__ void __launch_bounds__(NWAVES * 64, 2) block_fwd(Args args) {
    extern __shared__ __attribute__((aligned(16))) unsigned char lds[];
    Frame F;
    F.lds = (LAS unsigned char*)lds;
    F.MISC = (volatile LAS unsigned*)(F.lds + MISC_OFF);
    F.tid = threadIdx.x; F.lane = F.tid & 63; F.wave = __builtin_amdgcn_readfirstlane(F.tid >> 6);
    F.G = gridDim.x; { const int bx = blockIdx.x; F.vcu = (F.G % 8 == 0) ? (bx % 8) * (F.G / 8) + bx / 8 : bx; }
    unsigned char* ws = args.ws;
    F.ctl = (gu32*)(ws + WS_CTL);
    const float* x = args.in[0]; const int* positions = (const int*)args.in[1];
    const float *g_pre_mix = args.in[2], *w_in = args.in[3], *b_gate = args.in[4], *g_q = args.in[5], *w_uq = args.in[6], *g_kv = args.in[7], *w_ukv = args.in[8], *w_a = args.in[9], *w_b = args.in[10],
                *w_out = args.in[11], *g_post_mix = args.in[12], *g_pre_mlp = args.in[13], *w_up = args.in[14], *w_dn = args.in[15], *g_post_mlp = args.in[16];
    float* out = args.out;
    float* ropeA = (float*)(ws + WS_ROPEA); float* ropeB = (float*)(ws + WS_ROPEB);
    float* SS = (float*)(ws + WS_SS); float* SS2 = (float*)(ws + WS_SS2); float* SS3 = (float*)(ws + WS_SS3);
    bf16 *WIN = (bf16*)(ws + WS_WIN), *WUQ = (bf16*)(ws + WS_WUQ), *WUKV = (bf16*)(ws + WS_WUKV), *WA = (bf16*)(ws + WS_WA), *WOUT = (bf16*)(ws + WS_WOUT), *WUP = (bf16*)(ws + WS_WUP), *WDN = (bf16*)(ws + WS_WDN);
    bf16 *H = (bf16*)(ws + WS_H), *Gt = (bf16*)(ws + WS_G), *QA = (bf16*)(ws + WS_QA), *KA = (bf16*)(ws + WS_KA), *VA = (bf16*)(ws + WS_VA), *T = (bf16*)(ws + WS_T), *CQ = (bf16*)(ws + WS_CQ), *CKV = (bf16*)(ws + WS_CKV),
         *KR = (bf16*)(ws + WS_KR), *QB = (bf16*)(ws + WS_QB), *KB = (bf16*)(ws + WS_KB), *VB = (bf16*)(ws + WS_VB), *Y = (bf16*)(ws + WS_Y), *U = (bf16*)(ws + WS_U), *X1B = (bf16*)(ws + WS_X1); unsigned char *H8 = ws + WS_H8, *WG8 = ws + WS_WG8;
    for (int u = F.tid; u < (LDS_BYTES - LDSCTL_OFF) / 4; u += NWAVES * 64) ((LAS unsigned*)(F.lds + LDSCTL_OFF))[u] = 0u;
    __syncthreads();
    XcdBarrier bar = xcd_barrier_post((unsigned*)(F.ctl + CW_BAR) + args.li * XCD_BAR_WORDS, F.MISC + 8);
    const int lo = args.ph_lo, hi = args.ph_hi;
#define IN(k) (lo <= (k) && (k) < hi)
#define SEAM(k) do { if (IN(k) && IN((k) + 1)) xcd_barrier(bar); } while (0)
    const int gw = F.vcu * NWAVES + F.wave, NGW = F.G * NWAVES;

#if !defined(SKIP_P0)
    if (IN(0))
    {
        LAS float* scr = (LAS float*)(F.lds + RING_OFF + F.wave * 16384);
        constexpr int NBF = 2304, IG = (DM / 64) * (2 * DM / 32);
        constexpr int I0 = (DM / 64) * (NBF / 32), I1 = (QLORA / 64) * (768 / 32), I2 = (KVLORA / 64) * (1024 / 32), I3 = (AW / 64) * (DM / 32), I5 = (DM / 64) * (DM / 32), I6 = (DM / 64) * (DFF / 32), I7 = (DFF / 64) * (DM / 32);
        constexpr int NITEMS = I0 + I1 + I2 + 2 * I3 + I5 + I6 + I7 + IG;
        constexpr int TW = 4, RW = NWAVES - TW;
        if (F.wave >= RW)
        for (int it = F.vcu * TW + (F.wave - RW); it < NITEMS; it += F.G * TW) {
            int r = it;
            if (r < I0) { p0_transpose_item(w_in, DM, INW, NBF, WIN, LDH, 0, nullptr, 0, scr, r, F.lane); continue; } r -= I0;
            if (r < IG) { p0_transpose_item_f8(w_in, DM, 2 * DM, INW, 2208, WG8, 32.f, scr, r, F.lane); continue; } r -= IG;
            if (r < I1) { p0_transpose_item(w_uq, QLORA, 768, 768, WUQ, QLORA, 0, g_q, 1, scr, r, F.lane); continue; } r -= I1;
            if (r < I2) { p0_transpose_item(w_ukv, KVLORA, 1024, 1024, WUKV, LDKV, 0, g_kv, 2, scr, r, F.lane); continue; } r -= I2;
            if (r < I3) { p0_transpose_item(w_a, AW, DM, DM, WA, LDH, 0, nullptr, 2, scr, r, F.lane); continue; } r -= I3;
            if (r < I3) { p0_transpose_item(w_b, AW, DM, DM, WA, LDH, AW, nullptr, 2, scr, r, F.lane); continue; } r -= I3;
            if (r < I5) { p0_transpose_item_f8<true>(w_out, DM, DM, DM, 0, (unsigned char*)WOUT, 32.f, scr, r, F.lane); continue; } r -= I5;
            if (r < I6) { p0_transpose_item_f8(w_up, DM, DFF, DFF, 0, (unsigned char*)WUP, 32.f, scr, r, F.lane); continue; } r -= I6;
            p0_transpose_item_f8<true>(w_dn, DFF, DM, DM, 0, (unsigned char*)WDN, 64.f, scr, r, F.lane);
        }
        if (F.wave >= RW)
        for (int idx = (int)blockIdx.x * (TW * 64) + (F.tid - RW * 64); idx < MTOK * 24; idx += F.G * TW * 64) {
            const int m = idx / 24, i = idx - m * 24;
            const float invf = (i < 8) ? __builtin_amdgcn_exp2f(-(float)i * 2.3664460711655217f) : __builtin_amdgcn_exp2f(-(float)(i - 8) * 1.1832230355827609f);
            const float ang = (float)positions[m] * invf;
            double t = (double)ang * 0.15915494309189535; t -= floor(t);
            const float tf = (float)t; const float c = __builtin_amdgcn_cosf(tf), s = __builtin_amdgcn_sinf(tf);
            float* dst = (i < 8) ? ropeA + (size_t)m * 16 + 2 * i : ropeB + (size_t)m * 32 + 2 * (i - 8);
            *(f32x2g*)dst = (f32x2g){c, s};
        }
        f32x4 g[4];
#pragma unroll
        for (int j = 0; j < 4; ++j) g[j] = ((const GAS f32x4*)g_pre_mix)[F.lane + 64 * j];
        {
            f32x4 cv[4], n1[4], n2[4];
            const int rw0 = (F.wave < RW) ? F.vcu * RW + F.wave : MTOK, RST = F.G * RW;
#define P0_LOADROW(V, mm) do { _Pragma("unroll") for (int j = 0; j < 4; ++j) V[j] = ((const GAS f32x4*)(x + (size_t)(mm) * DM) + F.lane)[64 * j]; } while (0)
            if (rw0 < MTOK) P0_LOADROW(cv, rw0);
            if (rw0 + RST < MTOK) P0_LOADROW(n1, rw0 + RST);
            for (int m = rw0; m < MTOK; m += RST) {
                if (m + 2 * RST < MTOK) P0_LOADROW(n2, m + 2 * RST);
                rms_row_to_bf16(F.lane, cv, g, H + (size_t)m * LDH, H8 + (size_t)m * DM);
#pragma unroll
                for (int j = 0; j < 4; ++j) { cv[j] = n1[j]; n1[j] = n2[j]; }
            }
#undef P0_LOADROW
        }
    }
#endif
    SEAM(0);

#if !defined(SKIP_P1)
    if (IN(1))
    {
        { pg8::Gemm g{H, WIN, MTOK, 2304, DM, LDH, LDH}; pg8::StaticOrder S; S.init(MTOK, 2304, F.G, (int)blockIdx.x);
          pg8::EpiIn E{QA, KA, VA, CQ, CKV, KR, Gt, SS, ropeA, ropeB, b_gate};
          pg8::gemm_phase<pg8::EpiIn, pg8::StaticOrder, true, true>(F.lds + RING_OFF, g, S, E); }
        { pg8::Gemm g{(const bf16*)H8, (const bf16*)WG8, MTOK, 2 * DM, DM, DM, DM}; pg8::StaticOrder S; S.init(MTOK, 2 * DM, F.G, (int)blockIdx.x);
          pg8::EpiGates E{Gt, b_gate};
          pg8::gemm_phase<pg8::EpiGates, pg8::StaticOrder, true, true, 1>(F.lds + RING_OFF, g, S, E); }
    }
#endif
    SEAM(1);

#if !defined(SKIP_P2)
    if (IN(2)) {
    {
        pg8::Gemm g{CQ, WUQ, MTOK, NHEAD * QKB, QLORA}; pg8::StaticOrder S; S.init(MTOK, NHEAD * QKB, F.G, (int)blockIdx.x);
        pg8::EpiQ E{QB, SS, ropeB};
        pg8::gemm_phase<pg8::EpiQ, pg8::StaticOrder, true, true, 2, true>(F.lds + RING_OFF, g, S, E);
    }
    {
        pg8::Gemm g{CKV, WUKV, MTOK, 2 * AW, KVLORA, LDKV, LDKV}; pg8::StaticOrder S; S.init(MTOK, 2 * AW, F.G, (int)blockIdx.x);
        pg8::EpiKV E{KB, VB, SS};
        pg8::gemm_phase<pg8::EpiKV, pg8::StaticOrder, true, true, 2, true>(F.lds + RING_OFF, g, S, E);
    }
    }
#endif
    SEAM(2);

#if !defined(SKIP_P3)
    if (IN(3))
    {
        LAS char* al = (LAS char*)(F.lds + RING_OFF);
#if !defined(SKIP_MOBA)
        for (int bh = F.vcu; bh < NB * NHEAD; bh += F.G) {
            const int b = bh >> 3, h = bh & 7; const size_t r0 = (size_t)b * SEQ;
            att::kmean_blocks(KA + r0 * AW + h * HD * 16, al);
#pragma unroll 1
            for (int qb = 0; qb < 8; ++qb) att::moba_unit(QA + r0 * AW + h * HD * 16, KA + r0 * AW + h * HD * 16, VA + r0 * AW + h * HD * 16, H + r0 * LDH + h * HD, LDH, qb, al);
        }
#endif
#if !defined(SKIP_MLA)
        for (int bh = F.vcu; bh < NB * NHEAD; bh += F.G) {
            const int b = bh >> 3, h = bh & 7; const size_t r0 = (size_t)b * SEQ;
#pragma unroll 1
            for (int qb = 0; qb < 8; ++qb) att::mla_unit(QB + r0 * (NHEAD * QKB) + h * QKB * 16, KB + r0 * AW + h * HD * 16, KR + r0 * RDIM, VB + r0 * AW + h * HD * 16, H + r0 * LDH + AW + h * HD, LDH, qb, al);
        }
#endif
    }
#endif
    SEAM(3);

#if !defined(SKIP_P4)
    if (IN(4))
    {
        pg8::Gemm g{H, WA, MTOK, DM, DM, LDH, LDH}; pg8::StaticOrder S; S.init(MTOK, DM, F.G, (int)blockIdx.x);
        pg8::EpiMerge E{Gt, T};
        pg8::gemm_phase<pg8::EpiMerge, pg8::StaticOrder, true, true>(F.lds + RING_OFF, g, S, E);
    }
#endif
    SEAM(4);

#if !defined(SKIP_P5)
    if (IN(5))
    {
        pg8::Gemm g{T, WOUT, MTOK, DM, DM, DM, DM}; pg8::StaticOrder S; S.init(MTOK, DM, F.G, (int)blockIdx.x);
        pg8::EpiSS E{Y, SS2, DM, 1.0f / 2048.0f};
        pg8::gemm_phase<pg8::EpiSS, pg8::StaticOrder, true, true, 1, true>(F.lds + RING_OFF, g, S, E);
    }
#endif
    SEAM(5);

#if !defined(SKIP_P6)
    if (IN(6))
    {
        f32x4 g1[4], g2[4];
#pragma unroll
        for (int j = 0; j < 4; ++j) { g1[j] = ((const GAS f32x4*)g_post_mix)[F.lane + 64 * j]; g2[j] = ((const GAS f32x4*)g_pre_mlp)[F.lane + 64 * j]; }
        f32x4 ca, cb, cc, cd, cx[4]; unsigned long long cy[4];
#define P6_LOAD(A, B, C, D, X, Yv, mm) do { const GAS f32x4* sp_ = (const GAS f32x4*)(SS2 + (size_t)(mm) * 16); A = sp_[0]; B = sp_[1]; C = sp_[2]; D = sp_[3]; \
            const GAS f32x4* xr_ = (const GAS f32x4*)(x + (size_t)(mm) * DM) + F.lane; const GAS unsigned long long* yr_ = (const GAS unsigned long long*)(Y + (size_t)(mm) * DM) + F.lane; \
            _Pragma("unroll") for (int j = 0; j < 4; ++j) { X[j] = xr_[64 * j]; Yv[j] = yr_[64 * j]; } } while (0)
        if (gw < MTOK) P6_LOAD(ca, cb, cc, cd, cx, cy, gw);
        for (int m = gw; m < MTOK; m += NGW) {
            f32x4 na, nb, nc, nd, nx[4]; unsigned long long ny[4];
            const bool more = m + NGW < MTOK;
            if (more) P6_LOAD(na, nb, nc, nd, nx, ny, m + NGW);
            const f32x4 a = ca, b = cb, c = cc, d = cd;
            const float ssy = (((a.x + a.y) + (a.z + a.w)) + ((b.x + b.y) + (b.z + b.w))) + (((c.x + c.y) + (c.z + c.w)) + ((d.x + d.y) + (d.z + d.w)));
            const float rsy = 1.f / sqrtf(ssy * (1.f / DM) + EPS);
            GAS unsigned long long* x8 = (GAS unsigned long long*)(X1B + (size_t)m * DM) + F.lane;
            f32x4 v[4]; float s = 0.f;
#pragma unroll
            for (int j = 0; j < 4; ++j) { const unsigned long long yw = cy[j]; const unsigned lo = (unsigned)yw, hi = (unsigned)(yw >> 32);
                const f32x4 yv = (f32x4){__uint_as_float(lo << 16), __uint_as_float(lo & 0xffff0000u), __uint_as_float(hi << 16), __uint_as_float(hi & 0xffff0000u)};
                v[j] = cx[j] + yv * rsy * g1[j]; x8[64 * j] = (unsigned long long)pk2(v[j].x, v[j].y) | ((unsigned long long)pk2(v[j].z, v[j].w) << 32);
                s += (v[j].x * v[j].x + v[j].y * v[j].y) + (v[j].z * v[j].z + v[j].w * v[j].w); }
            const float rstd = 1.f / sqrtf(wave_sum(s) * (1.f / DM) + EPS);
            GAS int* o8 = (GAS int*)((unsigned char*)H + (size_t)m * DM) + F.lane;
#pragma unroll
            for (int j = 0; j < 4; ++j) { const f32x4 y2 = v[j] * rstd * g2[j]; int w = 0; w = __builtin_amdgcn_cvt_pk_fp8_f32(y2.x, y2.y, w, false); w = __builtin_amdgcn_cvt_pk_fp8_f32(y2.z, y2.w, w, true); o8[64 * j] = w; }
            if (more) { ca = na; cb = nb; cc = nc; cd = nd;
#pragma unroll
                for (int j = 0; j < 4; ++j) { cx[j] = nx[j]; cy[j] = ny[j]; } }
        }
#undef P6_LOAD
    }
#endif
    SEAM(6);

#if !defined(SKIP_P7)
    if (IN(7))
    {
        pg8::Gemm g{H, WUP, MTOK, DFF, DM, DM, DM}; pg8::StaticOrder S; S.init(MTOK, DFF, F.G, (int)blockIdx.x);
        pg8::EpiRelu2F8 E{(unsigned char*)U, 1.0f / 32.0f};
        pg8::gemm_phase<pg8::EpiRelu2F8, pg8::StaticOrder, true, true, 1>(F.lds + RING_OFF, g, S, E);
    }
#endif
    SEAM(7);

#if !defined(SKIP_P8)
    if (IN(8))
    {
        pg8::Gemm g{U, WDN, MTOK, DM, DFF, DFF, DFF}; pg8::StaticOrder S; S.init(MTOK, DM, F.G, (int)blockIdx.x);
        pg8::EpiSS E{H, SS3, LDH, 1.0f / 64.0f};
        pg8::gemm_phase<pg8::EpiSS, pg8::StaticOrder, true, true, 1, true>(F.lds + RING_OFF, g, S, E);
    }
#endif
    SEAM(8);

#if !defined(SKIP_P9)
    if (IN(9))
    {
        f32x4 g1[4];
#pragma unroll
        for (int j = 0; j < 4; ++j) g1[j] = ((const GAS f32x4*)g_post_mlp)[F.lane + 64 * j];
        f32x4 ca, cb, cc, cd; unsigned long long cy[4], cq[4];
#define P9_LOAD(A, B, C, D, Yv, Q, mm) do { const GAS f32x4* sp_ = (const GAS f32x4*)(SS3 + (size_t)(mm) * 16); A = sp_[0]; B = sp_[1]; C = sp_[2]; D = sp_[3]; \
            const GAS unsigned long long* yr_ = (const GAS unsigned long long*)(H + (size_t)(mm) * LDH) + F.lane; const GAS unsigned long long* xq_ = (const GAS unsigned long long*)(X1B + (size_t)(mm) * DM) + F.lane; \
            _Pragma("unroll") for (int j = 0; j < 4; ++j) { Yv[j] = yr_[64 * j]; Q[j] = xq_[64 * j]; } } while (0)
        if (gw < MTOK) P9_LOAD(ca, cb, cc, cd, cy, cq, gw);
        for (int m = gw; m < MTOK; m += NGW) {
            f32x4 na, nb, nc, nd; unsigned long long ny[4], nq[4];
            const bool more = m + NGW < MTOK;
            if (more) P9_LOAD(na, nb, nc, nd, ny, nq, m + NGW);
            const f32x4 a = ca, b = cb, c = cc, d = cd;
            const float ssy = (((a.x + a.y) + (a.z + a.w)) + ((b.x + b.y) + (b.z + b.w))) + (((c.x + c.y) + (c.z + c.w)) + ((d.x + d.y) + (d.z + d.w)));
            const float rsy = 1.f / sqrtf(ssy * (1.f / DM) + EPS);
            GAS f32x4* o4 = (GAS f32x4*)(out + (size_t)m * DM) + F.lane;
#pragma unroll
            for (int j = 0; j < 4; ++j) { const unsigned long long yw = cy[j]; const unsigned lo = (unsigned)yw, hi = (unsigned)(yw >> 32);
                const f32x4 yv = (f32x4){__uint_as_float(lo << 16), __uint_as_float(lo & 0xffff0000u), __uint_as_float(hi << 16), __uint_as_float(hi & 0xffff0000u)};
                const unsigned long long xw = cq[j]; const unsigned xl = (unsigned)xw, xh = (unsigned)(xw >> 32);
                const f32x4 xv = (f32x4){__uint_as_float(xl << 16), __uint_as_float(xl & 0xffff0000u), __uint_as_float(xh << 16), __uint_as_float(xh & 0xffff0000u)};
                o4[64 * j] = xv + yv * rsy * g1[j]; }
            if (more) { ca = na; cb = nb; cc = nc; cd = nd;
#pragma unroll
                for (int j = 0; j < 4; ++j) { cy[j] = ny[j]; cq[j] = nq[j]; } }
        }
#undef P9_LOAD
    }
#endif
}

extern "C" void kernel_launch(void* const* d_in, const int* in_sizes, int n_in, void* d_out, int out_size, void* d_ws, size_t ws_size, hipStream_t stream) {
    static int grid = 0;
    if (grid == 0) {
        if (n_in != 17 || in_sizes[0] != MTOK * DM || out_size != MTOK * DM || ws_size < WS_END) { fprintf(stderr, "kernel_launch: unexpected shapes (n_in %d, in0 %d, out %d, ws %zu); nothing launched\n", n_in, n_in > 0 ? in_sizes[0] : -1, out_size, ws_size); grid = -1; return; }
        int dev = 0, cus = 0, per_cu = 0;
        if (hipGetDevice(&dev) != hipSuccess || hipDeviceGetAttribute(&cus, hipDeviceAttributeMultiprocessorCount, dev) != hipSuccess) { fprintf(stderr, "kernel_launch: device query failed\n"); grid = -1; return; }
        if (hipFuncSetAttribute((const void*)block_fwd, hipFuncAttributeMaxDynamicSharedMemorySize, LDS_BYTES) != hipSuccess) { fprintf(stderr, "kernel_launch: hipFuncSetAttribute failed\n"); grid = -1; return; }
        if (hipOccupancyMaxActiveBlocksPerMultiprocessor(&per_cu, (const void*)block_fwd, NWAVES * 64, LDS_BYTES) != hipSuccess || per_cu < 1) { fprintf(stderr, "kernel_launch: occupancy query reports %d workgroups per CU\n", per_cu); }
        (void)hipGetLastError();
        grid = cus;
    }
    if (grid < 0) return;
    if (hipMemsetAsync((char*)d_ws + WS_CTL, 0, CTL_ZERO_BYTES, stream) != hipSuccess) { fprintf(stderr, "kernel_launch: hipMemsetAsync failed\n"); return; }
    Args a{};
    for (int i = 0; i < 17; ++i) a.in[i] = (const float*)d_in[i];
    a.out = (float*)d_out; a.ws = (unsigned char*)d_ws;
    a.ph_lo = 0; a.ph_hi = 10; a.li = 0;
    hipLaunchKernelGGL(block_fwd, dim3(grid), dim3(NWAVES * 64), LDS_BYTES, stream, a);
    const hipError_t le = hipPeekAtLastError();
    if (le != hipSuccess) fprintf(stderr, "kernel_launch: launch failed: %s\n", hipGetErrorName(le));
}
```

```cpp
#include <hip/hip_runtime.h>
#include <hip/hip_bf16.h>
#include <cstdio>
#include <cstdint>
#include <cmath>
constexpr int NB = 32, SEQ = 2048, DM = 1024, MTOK = NB * SEQ;
constexpr int NHEAD = 8, HD = 64, AW = NHEAD * HD;
constexpr int QLORA = 384, KVLORA = 256, RDIM = 32, QKB = 96;
constexpr int DFF = 4096, INW = 4256, INWP = 4352;
constexpr int LDH = DM, LDU = DFF, LDKV = KVLORA;
constexpr float EPS = 1e-6f;
constexpr float LOG2E = 1.4426950408889634f;
constexpr float C2A = 0.125f * LOG2E;
constexpr float C2B = 0.10206207261596575f * LOG2E;
typedef float f32x2g __attribute__((ext_vector_type(2)));
namespace pg8 {
#define PG8_LAS __attribute__((address_space(3)))
typedef unsigned short bf16_t;
typedef short bf16x8 __attribute__((ext_vector_type(8)));
typedef float f32x4 __attribute__((ext_vector_type(4)));
typedef unsigned u32x4 __attribute__((ext_vector_type(4)));
constexpr int BM = 256, BK = 64, HALF = 128, HTB = HALF * BK * 2  , STAGE_BYTES = 8 * HTB, NXCD = 8, WGM = 8;

__host__ __device__ __forceinline__ int lds_byte(int r, int c) { const int st = (r >> 4) * 2 + (c >> 5), rr = r & 15, cc = c & 31, ob = rr * 64 + cc * 2; return st * 1024 + (ob ^ (((ob >> 9) & 1) << 5)); }
__host__ __device__ __forceinline__ void stage_rc(int b, int& R, int& C) { const int st = b / 1024, sb = b % 1024, swz = sb ^ (((sb >> 9) & 1) << 5); R = (st >> 1) * 16 + swz / 64; C = (st & 1) * 32 + (swz % 64) / 2; }
__host__ __device__ __forceinline__ int perm32(int rho) { const int n = rho >> 4, i = rho & 15; return 8 * (i >> 2) + 4 * n + (i & 3); }

struct Unit { int pm, pn; };
struct Gemm { const bf16_t* A; const bf16_t* Bt; int M, N, K, lda, ldb; };

struct StaticOrder {
    int nM, nN, nwg, G, c;
    __host__ __device__ void init(int M, int N, int G_, int c_) { nM = M / BM; nN = N / BM; nwg = nM * nN; G = G_; c = c_; }
    __host__ __device__ bool next(int i, Unit& u) const {
        const long L = (long)i * G + c; if (L >= nwg) return false;
        int wgid = (int)L; { const int q = nwg / NXCD, r = nwg % NXCD, xcd = wgid % NXCD, off = wgid / NXCD; wgid = (xcd < r ? xcd * (q + 1) : r * (q + 1) + (xcd - r) * q) + off; }
        const int nig = WGM * nN, gid = wgid / nig, fm = gid * WGM, gsz = (nM - fm) < WGM ? (nM - fm) : WGM;
        u.pm = fm + ((wgid % nig) % gsz); u.pn = (wgid % nig) / gsz; return true;
    }
    __device__ __forceinline__ void a_ready(const Unit&) const {}
    __device__ __forceinline__ void done(const Unit&) const {}
};

__device__ __forceinline__ unsigned cvt_pk_bf16(float lo, float hi) { unsigned r; asm volatile("v_cvt_pk_bf16_f32 %0, %1, %2" : "=v"(r) : "v"(lo), "v"(hi)); return r; }
__device__ __forceinline__ void ld8(float (&v)[8], const f32x4& a, const f32x4& b) { v[0] = a[0]; v[1] = a[1]; v[2] = a[2]; v[3] = a[3]; v[4] = b[0]; v[5] = b[1]; v[6] = b[2]; v[7] = b[3]; }
typedef float f32x2c_t __attribute__((ext_vector_type(2))); typedef __bf16 bf16x2c_t __attribute__((ext_vector_type(2)));
__device__ __forceinline__ unsigned cvtpk_c(float lo, float hi) { const f32x2c_t v = {lo, hi}; const bf16x2c_t b = __builtin_convertvector(v, bf16x2c_t); return __builtin_bit_cast(unsigned, b); }
__device__ __forceinline__ u32x4 pack8(const float (&v)[8]) { u32x4 w; w.x = cvtpk_c(v[0], v[1]); w.y = cvtpk_c(v[2], v[3]); w.z = cvtpk_c(v[4], v[5]); w.w = cvtpk_c(v[6], v[7]); return w; }
__device__ __forceinline__ void unpack8(const u32x4 w, float (&v)[8]) {
    v[0] = __uint_as_float(w.x << 16); v[1] = __uint_as_float(w.x & 0xffff0000u); v[2] = __uint_as_float(w.y << 16); v[3] = __uint_as_float(w.y & 0xffff0000u);
    v[4] = __uint_as_float(w.z << 16); v[5] = __uint_as_float(w.z & 0xffff0000u); v[6] = __uint_as_float(w.w << 16); v[7] = __uint_as_float(w.w & 0xffff0000u); }
__device__ __forceinline__ void rope4(float (&v)[8], const f32x4 a, const f32x4 b) {
    float x1, x2;
    x1 = v[0]; x2 = v[1]; v[0] = x1 * a[0] - x2 * a[1]; v[1] = x2 * a[0] + x1 * a[1];
    x1 = v[2]; x2 = v[3]; v[2] = x1 * a[2] - x2 * a[3]; v[3] = x2 * a[2] + x1 * a[3];
    x1 = v[4]; x2 = v[5]; v[4] = x1 * b[0] - x2 * b[1]; v[5] = x2 * b[0] + x1 * b[1];
    x1 = v[6]; x2 = v[7]; v[6] = x1 * b[2] - x2 * b[3]; v[7] = x2 * b[2] + x1 * b[3];
}
__device__ __forceinline__ float sumsq8(const float (&v)[8]) { return ((v[0] * v[0] + v[1] * v[1]) + (v[2] * v[2] + v[3] * v[3])) + ((v[4] * v[4] + v[5] * v[5]) + (v[6] * v[6] + v[7] * v[7])); }
__device__ __forceinline__ float red_fq(float s) { s += __shfl_xor(s, 16); s += __shfl_xor(s, 32); return s; }

__device__ __forceinline__ size_t chk_off(int r16, int c32, int ld) { return (size_t)r16 * ld + (size_t)c32 * 16; }
__device__ __forceinline__ size_t gfrag_off(int pm, int t8, int wid, int grp, int lane) { return ((((size_t)(pm * 8 + t8) * 8 + wid) * 16 + grp) * 64 + lane) * 8; }
struct EpiIn {
    static constexpr bool PERM = true, AFTER_DRAIN = false; static constexpr int MIDT = 0;
    bf16_t *QA, *KA, *VA, *CQ, *CKV, *KR, *G; float* SS; const float* ropeA; const float* ropeB; const float* bgate;
    __device__ __forceinline__ void operator()(const f32x4 (&acc)[2][2][4][2], const Unit& u, int wr, int wc, int fr, int fq) const {
        asm volatile("" : "+v"(fr), "+v"(fq));
        const int row0 = u.pm * BM + wr * 64 + fr, pn = u.pn, cl = wc * 32 + 8 * fq;
        if (pn < 4) {
            bf16_t* dst = (pn < 2) ? QA : KA; const float sc = (pn < 2) ? C2A : 1.f; const int cb = (pn & 1) * 256 + wc * 32, l8 = (fq * 16 + fr) * 8;
            if ((wc & 1) == 0) {
                const bool rp = fq < 2;
                f32x4 ta[2][4], tb[2][4];
#pragma unroll
                for (int m = 0; m < 4; ++m) { const f32x4* t = (const f32x4*)(ropeA + (size_t)(row0 + m * 16) * 16 + (rp ? fq * 8 : 0)); ta[0][m] = t[0]; tb[0][m] = t[1]; }
#pragma unroll
                for (int ai = 0; ai < 2; ++ai) {
                    if (ai == 0) {
#pragma unroll
                        for (int m = 0; m < 4; ++m) { const f32x4* t = (const f32x4*)(ropeA + (size_t)(row0 + HALF + m * 16) * 16 + (rp ? fq * 8 : 0)); ta[1][m] = t[0]; tb[1][m] = t[1]; } }
                    asm volatile("" ::: "memory");
#pragma unroll
                    for (int m = 0; m < 4; ++m) { const int row = row0 + ai * HALF + m * 16;
                        f32x4 ca = ta[ai][m], cc = tb[ai][m]; if (!rp) { ca = (f32x4){1.f, 0.f, 1.f, 0.f}; cc = ca; }
#pragma unroll
                        for (int bj = 0; bj < 2; ++bj) { float v[8]; ld8(v, acc[ai][bj][m][0], acc[ai][bj][m][1]); rope4(v, ca, cc);
#pragma unroll
                            for (int j = 0; j < 8; ++j) v[j] *= sc;
                            *(u32x4*)(dst + chk_off(row - fr, cb + bj * HALF, AW) + l8) = pack8(v); } } }
            } else {
#pragma unroll
                for (int ai = 0; ai < 2; ++ai)
#pragma unroll
                    for (int m = 0; m < 4; ++m) { const int row = row0 + ai * HALF + m * 16;
#pragma unroll
                        for (int bj = 0; bj < 2; ++bj) { float v[8]; ld8(v, acc[ai][bj][m][0], acc[ai][bj][m][1]);
#pragma unroll
                            for (int j = 0; j < 8; ++j) v[j] *= sc;
                            *(u32x4*)(dst + chk_off(row - fr, cb + bj * HALF, AW) + l8) = pack8(v); } }
            }
        } else if (pn < 6) {
            const int cb = (pn - 4) * 256 + wc * 32, l8 = (fq * 16 + fr) * 8;
#pragma unroll
            for (int ai = 0; ai < 2; ++ai)
#pragma unroll
                for (int m = 0; m < 4; ++m) { const int row = row0 + ai * HALF + m * 16;
#pragma unroll
                    for (int bj = 0; bj < 2; ++bj) { float v[8]; ld8(v, acc[ai][bj][m][0], acc[ai][bj][m][1]); *(u32x4*)(VA + chk_off(row - fr, cb + bj * HALF, AW) + l8) = pack8(v); } }
        } else if (pn == 6 || pn == 8) {
            bf16_t* dst = (pn == 6) ? CQ : CKV; const int ld = (pn == 6) ? QLORA : LDKV, slot = ((pn == 6) ? 0 : 8) + wc;
#pragma unroll
            for (int ai = 0; ai < 2; ++ai)
#pragma unroll
                for (int m = 0; m < 4; ++m) { const int row = row0 + ai * HALF + m * 16; float s = 0.f;
#pragma unroll
                    for (int bj = 0; bj < 2; ++bj) { float v[8]; ld8(v, acc[ai][bj][m][0], acc[ai][bj][m][1]); s += sumsq8(v); *(u32x4*)(dst + chk_off(row - fr, wc * 32 + bj * HALF, ld) + (fq * 16 + fr) * 8) = pack8(v); }
                    s = red_fq(s); if (fq == 0) SS[(size_t)row * 12 + slot] = s; }
        } else if (pn == 7) {
            f32x4 ta[2][4], tb[2][4];
            if (wc == 0) {
#pragma unroll
                for (int ai = 0; ai < 2; ++ai)
#pragma unroll
                    for (int m = 0; m < 4; ++m) { const f32x4* t = (const f32x4*)(ropeB + (size_t)(row0 + ai * HALF + m * 16) * 32 + fq * 8); ta[ai][m] = t[0]; tb[ai][m] = t[1]; } }
            asm volatile("" ::: "memory");
#pragma unroll
            for (int ai = 0; ai < 2; ++ai)
#pragma unroll
                for (int m = 0; m < 4; ++m) { const int row = row0 + ai * HALF + m * 16;
                    { float v[8]; ld8(v, acc[ai][0][m][0], acc[ai][0][m][1]); float s = red_fq(sumsq8(v)); *(u32x4*)(CQ + chk_off(row - fr, 256 + wc * 32, QLORA) + (fq * 16 + fr) * 8) = pack8(v); if (fq == 0) SS[(size_t)row * 12 + 4 + wc] = s; }
                    if (wc == 0) { float v[8]; ld8(v, acc[ai][1][m][0], acc[ai][1][m][1]); rope4(v, ta[ai][m], tb[ai][m]);
                        *(u32x4*)(KR + chk_off(row - fr, 0, RDIM) + (fq * 16 + fr) * 8) = pack8(v); } }
        }
    }
};
struct EpiGates {
    static constexpr bool PERM = true, AFTER_DRAIN = false; static constexpr int MIDT = 0;
    bf16_t* G; const float* bgate;
    __device__ __forceinline__ void operator()(const f32x4 (&acc)[2][2][4][2], const Unit& u, int wr, int wc, int fr, int fq) const {
        asm volatile("" : "+v"(fr), "+v"(fq));
        const int gc = u.pn * 256 + wc * 32 + 8 * fq;
        f32x4 bv[2][2];
#pragma unroll
        for (int bj = 0; bj < 2; ++bj)
#pragma unroll
            for (int n = 0; n < 2; ++n) bv[bj][n] = *(const f32x4*)(bgate + gc + bj * HALF + 4 * n);
#pragma unroll
        for (int ai = 0; ai < 2; ++ai)
#pragma unroll
            for (int m = 0; m < 4; ++m) {
#pragma unroll
                for (int bj = 0; bj < 2; ++bj) { float v[8]; ld8(v, acc[ai][bj][m][0] * (1.0f / 32.0f) + bv[bj][0], acc[ai][bj][m][1] * (1.0f / 32.0f) + bv[bj][1]);
#pragma unroll
                    for (int j = 0; j < 8; ++j) v[j] = __builtin_amdgcn_rcpf(1.f + __builtin_amdgcn_exp2f(-LOG2E * v[j]));
                    *(u32x4*)(G + gfrag_off(u.pm, u.pn, wr * 4 + wc, ai * 8 + m * 2 + bj, fq * 16 + fr)) = pack8(v); } }
    }
};
struct EpiQ {
    static constexpr bool PERM = true, AFTER_DRAIN = false; static constexpr int MIDT = 0;
    bf16_t* QB; const float* SS; const float* ropeB;
    __device__ __forceinline__ void operator()(const f32x4 (&acc)[2][2][4][2], const Unit& u, int wr, int wc, int fr, int fq) const {
        asm volatile("" : "+v"(fr), "+v"(fq));
        const int row0 = u.pm * BM + wr * 64 + fr, cl = u.pn * BM + wc * 32 + 8 * fq;
        const int c0 = cl, c1 = cl + HALF, h0 = c0 / QKB, h1 = c1 / QKB, p0 = c0 - h0 * QKB, p1 = c1 - h1 * QKB;
        const bool r0 = p0 >= 64, r1 = p1 >= 64; const int roff = r0 ? p0 - 64 : (r1 ? p1 - 64 : 0);
#pragma unroll
        for (int b = 0; b < 2; ++b) {
            f32x4 s0[4], s1[4], ta[4], tb[4];
#pragma unroll
            for (int m = 0; m < 4; ++m) { const int row = row0 + b * HALF + m * 16;
                const f32x4* sp = (const f32x4*)(SS + (size_t)row * 12); s0[m] = sp[0]; s1[m] = sp[1];
                const f32x4* t = (const f32x4*)(ropeB + (size_t)row * 32 + roff); ta[m] = t[0]; tb[m] = t[1]; }
            asm volatile("" ::: "memory");
#pragma unroll
            for (int m = 0; m < 4; ++m) { const int row = row0 + b * HALF + m * 16;
                const float ss = ((s0[m][0] + s0[m][1]) + (s0[m][2] + s0[m][3])) + ((s1[m][0] + s1[m][1]) + (s1[m][2] + s1[m][3]));
                const float rs = __builtin_amdgcn_rsqf(ss * (1.0f / QLORA) + EPS) * C2B;
#pragma unroll
                for (int bj = 0; bj < 2; ++bj) { float v[8]; ld8(v, acc[b][bj][m][0], acc[b][bj][m][1]);
#pragma unroll
                    for (int j = 0; j < 8; ++j) v[j] *= rs;
                    if (bj == 0 ? r0 : r1) rope4(v, ta[m], tb[m]);
                    *(u32x4*)(QB + chk_off(row - fr, (bj == 0 ? c0 : c1) - 8 * fq, NHEAD * QKB) + (fq * 16 + fr) * 8) = pack8(v); } }
        }
    }
};
struct EpiKV {
    static constexpr bool PERM = true, AFTER_DRAIN = false; static constexpr int MIDT = 0;
    bf16_t *KB, *VB; const float* SS;
    __device__ __forceinline__ void operator()(const f32x4 (&acc)[2][2][4][2], const Unit& u, int wr, int wc, int fr, int fq) const {
        asm volatile("" : "+v"(fr), "+v"(fq));
        const int row0 = u.pm * BM + wr * 64 + fr;
        bf16_t* dst = (wc < 2) ? KB : VB; const int pc = (wc & 1) * 32, l8 = (fq * 16 + fr) * 8;
        f32x4 s0[2][4];
#pragma unroll
        for (int ai = 0; ai < 2; ++ai)
#pragma unroll
            for (int m = 0; m < 4; ++m) s0[ai][m] = *(const f32x4*)(SS + (size_t)(row0 + ai * HALF + m * 16) * 12 + 8);
#pragma unroll
        for (int ai = 0; ai < 2; ++ai)
#pragma unroll
            for (int m = 0; m < 4; ++m) { const int row = row0 + ai * HALF + m * 16; const f32x4 sv = s0[ai][m];
                const float rs = __builtin_amdgcn_rsqf(((sv[0] + sv[1]) + (sv[2] + sv[3])) * (1.0f / KVLORA) + EPS);
#pragma unroll
                for (int bj = 0; bj < 2; ++bj) { const int hd = u.pn * 2 + bj;
                    float v[8]; ld8(v, acc[ai][bj][m][0], acc[ai][bj][m][1]);
#pragma unroll
                    for (int j = 0; j < 8; ++j) v[j] *= rs;
                    *(u32x4*)(dst + chk_off(row - fr, hd * HD + pc, AW) + l8) = pack8(v); } }
    }
};
struct EpiMerge {
    static constexpr bool PERM = true, AFTER_DRAIN = false; static constexpr int MIDT = 8;
    const bf16_t* G; bf16_t* T;
    __device__ __forceinline__ void mid(f32x4 (&acc)[2][2][4][2], const Unit& u, int wr, int wc, int fr, int fq) const {
        asm volatile("" : "+v"(fr), "+v"(fq));
        const bf16_t* pa = G + gfrag_off(u.pm, u.pn, wr * 4 + wc, 0, fq * 16 + fr); const bf16_t* pb = G + gfrag_off(u.pm, 4 + u.pn, wr * 4 + wc, 0, fq * 16 + fr);
        u32x4 ca[4], cb[4], na[4], nb[4];
#pragma unroll
        for (int i = 0; i < 4; ++i) { ca[i] = *(const u32x4*)(pa + (size_t)i * 512); cb[i] = *(const u32x4*)(pb + (size_t)i * 512); }
#pragma unroll
        for (int b = 0; b < 4; ++b) {
            if (b < 3) {
#pragma unroll
                for (int i = 0; i < 4; ++i) { na[i] = *(const u32x4*)(pa + (size_t)((b + 1) * 4 + i) * 512); nb[i] = *(const u32x4*)(pb + (size_t)((b + 1) * 4 + i) * 512); } }
            asm volatile("" ::: "memory");
#pragma unroll
            for (int i = 0; i < 4; ++i) { const int grp = b * 4 + i, ai = grp >> 3, m = (grp >> 1) & 3, bj = grp & 1; float ga[8], gb[8]; unpack8(ca[i], ga); unpack8(cb[i], gb);
#pragma unroll
                for (int j = 0; j < 8; ++j) ga[j] *= __builtin_amdgcn_rcpf(__builtin_fmaxf(gb[j], 1e-30f));
                acc[ai][bj][m][0] *= (f32x4){ga[0], ga[1], ga[2], ga[3]}; acc[ai][bj][m][1] *= (f32x4){ga[4], ga[5], ga[6], ga[7]}; }
#pragma unroll
            for (int i = 0; i < 4; ++i) { ca[i] = na[i]; cb[i] = nb[i]; }
        }
    }
    __device__ __forceinline__ void operator()(const f32x4 (&acc)[2][2][4][2], const Unit& u, int wr, int wc, int fr, int fq) const {
        asm volatile("" : "+v"(fr), "+v"(fq));
        unsigned char* base = (unsigned char*)T + ((size_t)(u.pm * 16 + wr * 4) * 16 + u.pn * 4 + wc) * 1024 + (unsigned)(fq * 16 + fr) * 16u;
        const bf16_t* pb = G + gfrag_off(u.pm, 4 + u.pn, wr * 4 + wc, 0, fq * 16 + fr);
        u32x4 cb[8], nb[8];
#pragma unroll
        for (int i = 0; i < 8; ++i) cb[i] = *(const u32x4*)(pb + (size_t)i * 512);
#pragma unroll
        for (int b = 0; b < 2; ++b) {
            if (b < 1) {
#pragma unroll
                for (int i = 0; i < 8; ++i) nb[i] = *(const u32x4*)(pb + (size_t)(8 + i) * 512); }
            asm volatile("" ::: "memory");
#pragma unroll
            for (int i2 = 0; i2 < 4; ++i2) { int w[4];
#pragma unroll
                for (int bj = 0; bj < 2; ++bj) { const int i = 2 * i2 + bj, grp = b * 8 + i, ai = grp >> 3, m = (grp >> 1) & 3; float v[8], gb[8]; ld8(v, acc[ai][bj][m][0], acc[ai][bj][m][1]); unpack8(cb[i], gb);
#pragma unroll
                    for (int j = 0; j < 8; ++j) v[j] = __builtin_fminf(__builtin_fmaxf(v[j] * (64.f * __builtin_fmaxf(gb[j], 1e-30f)), -448.f), 448.f);
                    int w0 = 0, w1 = 0;
                    w0 = __builtin_amdgcn_cvt_pk_fp8_f32(v[0], v[1], w0, false); w0 = __builtin_amdgcn_cvt_pk_fp8_f32(v[2], v[3], w0, true);
                    w1 = __builtin_amdgcn_cvt_pk_fp8_f32(v[4], v[5], w1, false); w1 = __builtin_amdgcn_cvt_pk_fp8_f32(v[6], v[7], w1, true);
                    w[2 * bj] = w0; w[2 * bj + 1] = w1; }
                typedef int i32x4m_ __attribute__((ext_vector_type(4)));
                *(i32x4m_*)(base + (size_t)(b * 8 + i2) * 16384) = (i32x4m_){w[0], w[1], w[2], w[3]}; }
#pragma unroll
            for (int i = 0; i < 8; ++i) cb[i] = nb[i];
        }
    }
};
struct EpiSS {
    static constexpr bool PERM = true, AFTER_DRAIN = false; static constexpr int MIDT = 0;
    bf16_t* Y; float* SSY; int ldy; float scale;
    __device__ __forceinline__ void operator()(const f32x4 (&acc)[2][2][4][2], const Unit& u, int wr, int wc, int fr, int fq) const {
        asm volatile("" : "+v"(fr), "+v"(fq));
        const int row0 = u.pm * BM + wr * 64 + fr, cl = u.pn * BM + wc * 32 + 8 * fq;
        const int lane_ = fq * 16 + fr, bpa = ((lane_ & 3) * 16 + (lane_ >> 2)) * 4; bf16_t* yst = Y + (size_t)(u.pm * BM + wr * 64 + (lane_ >> 2)) * ldy + u.pn * BM + wc * 32 + 8 * (lane_ & 3);
#pragma unroll
        for (int ai = 0; ai < 2; ++ai)
#pragma unroll
            for (int m = 0; m < 4; ++m) { const int row = row0 + ai * HALF + m * 16; float s = 0.f;
#pragma unroll
                for (int bj = 0; bj < 2; ++bj) { float v[8]; ld8(v, acc[ai][bj][m][0] * scale, acc[ai][bj][m][1] * scale); s += sumsq8(v); const u32x4 w_ = pack8(v); u32x4 t_;
                    t_.x = (unsigned)__builtin_amdgcn_ds_bpermute(bpa, (int)w_.x); t_.y = (unsigned)__builtin_amdgcn_ds_bpermute(bpa, (int)w_.y); t_.z = (unsigned)__builtin_amdgcn_ds_bpermute(bpa, (int)w_.z); t_.w = (unsigned)__builtin_amdgcn_ds_bpermute(bpa, (int)w_.w);
                    *(u32x4*)(yst + (size_t)(ai * HALF + m * 16) * ldy + bj * HALF) = t_; }
                s = red_fq(s); if (fq == 0) SSY[(size_t)row * 16 + u.pn * 4 + wc] = s; }
    }
};
struct EpiRelu2F8 {
    static constexpr bool PERM = true, AFTER_DRAIN = false; static constexpr int MIDT = 0;
    unsigned char* U; float scale;
    __device__ __forceinline__ void operator()(const f32x4 (&acc)[2][2][4][2], const Unit& u, int wr, int wc, int fr, int fq) const {
        asm volatile("" : "+v"(fr), "+v"(fq));
        unsigned char* base = U + ((size_t)(u.pm * 16 + wr * 4) * 64 + u.pn * 4 + wc) * 1024 + (unsigned)(fq * 16 + fr) * 16u;
#pragma unroll
        for (int ai = 0; ai < 2; ++ai)
#pragma unroll
            for (int m = 0; m < 4; ++m) { int w[4];
#pragma unroll
                for (int bj = 0; bj < 2; ++bj) { float v[8]; ld8(v, acc[ai][bj][m][0], acc[ai][bj][m][1]);
#pragma unroll
                    for (int j = 0; j < 8; ++j) { const float r = __builtin_fmaxf(v[j] * scale, 0.f); v[j] = __builtin_fminf(r * r, 440.f); }
                    int w0 = 0, w1 = 0;
                    w0 = __builtin_amdgcn_cvt_pk_fp8_f32(v[0], v[1], w0, false); w0 = __builtin_amdgcn_cvt_pk_fp8_f32(v[2], v[3], w0, true);
                    w1 = __builtin_amdgcn_cvt_pk_fp8_f32(v[4], v[5], w1, false); w1 = __builtin_amdgcn_cvt_pk_fp8_f32(v[6], v[7], w1, true);
                    w[2 * bj] = w0; w[2 * bj + 1] = w1; }
                typedef int i32x4e_ __attribute__((ext_vector_type(4)));
                *(i32x4e_*)(base + (size_t)(ai * 8 + m) * 65536) = (i32x4e_){w[0], w[1], w[2], w[3]}; }
    }
};
struct EpiRelu2 {
    static constexpr bool PERM = true, AFTER_DRAIN = false; static constexpr int MIDT = 0;
    bf16_t* U;
    __device__ __forceinline__ void operator()(const f32x4 (&acc)[2][2][4][2], const Unit& u, int wr, int wc, int fr, int fq) const {
        asm volatile("" : "+v"(fr), "+v"(fq));
        const int row0 = u.pm * BM + wr * 64 + fr, cl = u.pn * BM + wc * 32 + 8 * fq;
#pragma unroll
        for (int ai = 0; ai < 2; ++ai)
#pragma unroll
            for (int m = 0; m < 4; ++m) { const int row = row0 + ai * HALF + m * 16;
#pragma unroll
                for (int bj = 0; bj < 2; ++bj) { float v[8]; ld8(v, acc[ai][bj][m][0], acc[ai][bj][m][1]);
#pragma unroll
                    for (int j = 0; j < 8; ++j) { const float r = __builtin_fmaxf(v[j], 0.f); v[j] = r * r; }
                    *(u32x4*)(U + (size_t)row * LDU + cl + bj * HALF) = pack8(v); } }
    }
};
template <class Epi, class Sched, bool ALIGN_EPI = false, bool SP2 = false, int ESZ = 2, bool ACH = false>
__device__ __forceinline__ void gemm_phase(PG8_LAS unsigned char* lds, const Gemm g, const Sched& S, const Epi& E) {
    int tid_ = threadIdx.x; asm volatile("" : "+v"(tid_));
    const int tid = tid_, wid = __builtin_amdgcn_readfirstlane(tid >> 6), lane = tid & 63, wr = wid >> 2, wc = wid & 3, fr = lane & 15, fq = lane >> 4;
    const int K = g.K, nt = K * ESZ / (BK * 2), lda = g.lda ? g.lda : K, ldb = g.ldb ? g.ldb : K;
    unsigned voffA[2], voffB[2];
#pragma unroll
    for (int i = 0; i < 2; ++i) { int R, C; stage_rc(tid * 16 + i * 8192, R, C); const int Rb = Epi::PERM ? ((R & ~31) + perm32(R & 31)) : R;
        if constexpr (ACH) { const int st_ = (tid >> 6) + 8 * i; voffA[i] = (unsigned)((st_ >> 1) * 16 * lda * ESZ + (st_ & 1) * 1024 + (tid & 63) * 16); } else voffA[i] = (unsigned)(R * lda * ESZ + C * 2);
        voffB[i] = (unsigned)(Rb * ldb * ESZ + C * 2); }
    const size_t kstepB = (size_t)(BK * 2), kstepA = ACH ? (size_t)2048 : kstepB;
    const size_t hstepA = (size_t)HALF * lda * ESZ, hstepB = (size_t)HALF * ldb * ESZ;
    const size_t tstepA = 2 * hstepA, tstepB = 2 * hstepB;
    const unsigned ldsw = (unsigned)wid * 1024u;
    const int aoff = ACH ? wr * 8192 + lane * 16 : lds_byte(wr * 64 + fr, fq * 8), boff = lds_byte(wc * 32 + fr, fq * 8);
#define PG8_SA(b, h) (((b) * 2 + (h)) * HTB)
#define PG8_SB(b, h) ((4 + (b) * 2 + (h)) * HTB)
#define PG8_STAGE(bufoff, gbase, voff) do { _Pragma("unroll") for (int _i = 0; _i < 2; ++_i) \
        __builtin_amdgcn_global_load_lds((const unsigned*)((const char*)(gbase) + (voff)[_i]), (PG8_LAS unsigned*)(lds + (bufoff) + ldsw + _i * 8192), 16, 0, 0); } while (0)
#define PG8_LDA(dst, b, h) do { if constexpr (ESZ == 2) { _Pragma("unroll") for (int m = 0; m < 4; ++m) _Pragma("unroll") for (int k = 0; k < 2; ++k) dst[m][k] = *(const PG8_LAS bf16x8*)(lds + PG8_SA(b, h) + aoff + m * 2048 + k * 1024); } \
        else { _Pragma("unroll") for (int m = 0; m < 4; ++m) { dst##8[m].lo = *(const PG8_LAS i32x4_*)(lds + PG8_SA(b, h) + aoff + m * 2048); dst##8[m].hi = *(const PG8_LAS i32x4_*)(lds + PG8_SA(b, h) + aoff + m * 2048 + 1024); } } } while (0)
#define PG8_LDB(dst, b, h) do { if constexpr (ESZ == 2) { _Pragma("unroll") for (int n = 0; n < 2; ++n) _Pragma("unroll") for (int k = 0; k < 2; ++k) dst[n][k] = *(const PG8_LAS bf16x8*)(lds + PG8_SB(b, h) + boff + n * 2048 + k * 1024); } \
        else { _Pragma("unroll") for (int n = 0; n < 2; ++n) { dst##8[n].lo = *(const PG8_LAS i32x4_*)(lds + PG8_SB(b, h) + boff + n * 2048); dst##8[n].hi = *(const PG8_LAS i32x4_*)(lds + PG8_SB(b, h) + boff + n * 2048 + 1024); } } } while (0)
#define PG8_MMA(ai, bj, At, Bt) do { __builtin_amdgcn_s_setprio(1); \
        if constexpr (ESZ == 2) { _Pragma("unroll") for (int m = 0; m < 4; ++m) _Pragma("unroll") for (int n = 0; n < 2; ++n) _Pragma("unroll") for (int k = 0; k < 2; ++k) \
            acc[ai][bj][m][n] = __builtin_amdgcn_mfma_f32_16x16x32_bf16(Bt[n][k], At[m][k], acc[ai][bj][m][n], 0, 0, 0); } \
        else {   \
            _Pragma("unroll") for (int m = 0; m < 4; ++m) _Pragma("unroll") for (int n = 0; n < 2; ++n) \
                asm volatile("v_mfma_scale_f32_16x16x128_f8f6f4 %0, %1, %2, %0, %3, %3 op_sel_hi:[0,0,0]" : "+v"(acc[ai][bj][m][n]) : "v"(Bt##8[n]), "v"(At##8[m]), "v"(scl_)); } \
        __builtin_amdgcn_s_setprio(0); } while (0)
#define PG8_WAIT_V(n) asm volatile("s_waitcnt vmcnt(" #n ")" ::: "memory")
#define PG8_WAIT_L(n) asm volatile("s_waitcnt lgkmcnt(" #n ")" ::: "memory")
#define PG8_BAR __builtin_amdgcn_s_barrier()
#define PG8_SCHED __builtin_amdgcn_sched_barrier(0)
    Unit cur, nxt; int ui = 0;
    if (!S.next(0, cur)) return;
    f32x4 acc[2][2][4][2];
#pragma unroll
    for (int a = 0; a < 2; ++a)
#pragma unroll
        for (int b = 0; b < 2; ++b)
#pragma unroll
            for (int m = 0; m < 4; ++m)
#pragma unroll
                for (int n = 0; n < 2; ++n) acc[a][b][m][n] = (f32x4){0.f, 0.f, 0.f, 0.f};
    bf16x8 At[4][2], B0[2][2], B1[2][2];
    typedef int i32x4_ __attribute__((ext_vector_type(4))); typedef int i32x8_ __attribute__((ext_vector_type(8)));
    const int scl_ = 0x7F7F7F7F;
    i32x8_ At8[4], B08[2], B18[2];
    const char* cA = (const char*)g.A + (size_t)cur.pm * tstepA; const char* cB = (const char*)g.Bt + (size_t)cur.pn * tstepB;
    S.a_ready(cur);
    if constexpr (SP2) {
        PG8_STAGE(PG8_SB(0, 0), cB, voffB); PG8_STAGE(PG8_SB(0, 1), cB + hstepB, voffB); PG8_STAGE(PG8_SA(0, 0), cA, voffA); PG8_STAGE(PG8_SA(0, 1), cA + hstepA, voffA);
        if (wr == 1) PG8_BAR;
        PG8_WAIT_V(2); PG8_BAR;
        PG8_STAGE(PG8_SB(1, 0), cB + kstepB, voffB); PG8_STAGE(PG8_SA(1, 0), cA + kstepA, voffA); PG8_STAGE(PG8_SB(1, 1), cB + hstepB + kstepB, voffB);
        PG8_WAIT_V(6); PG8_BAR;
    } else {
        PG8_STAGE(PG8_SB(0, 0), cB, voffB); PG8_STAGE(PG8_SA(0, 0), cA, voffA); PG8_STAGE(PG8_SB(0, 1), cB + hstepB, voffB); PG8_STAGE(PG8_SA(0, 1), cA + hstepA, voffA);
        if (wr == 1) PG8_BAR;
        PG8_WAIT_V(4); PG8_BAR;
        PG8_STAGE(PG8_SB(1, 0), cB + kstepB, voffB); PG8_STAGE(PG8_SA(1, 0), cA + kstepA, voffA); PG8_STAGE(PG8_SB(1, 1), cB + hstepB + kstepB, voffB);
        PG8_WAIT_V(6); PG8_BAR;
    }
    for (;;) {
        const bool has_next = S.next(ui + 1, nxt);
        const char* nA = has_next ? (const char*)g.A + (size_t)nxt.pm * tstepA : cA; const char* nB = has_next ? (const char*)g.Bt + (size_t)nxt.pn * tstepB : cB;
#pragma unroll 1
        for (int t = 0; t < nt; t += 2) {
            if constexpr (Epi::MIDT > 0) { if (t == Epi::MIDT) E.mid(acc, cur, wr, wc, fr, fq); }
            const bool last = (t == nt - 2);
            const char* a1 = cA + (size_t)(t + 1) * kstepA;
            const char* a2 = last ? nA : cA + (size_t)(t + 2) * kstepA; const char* b2 = last ? nB : cB + (size_t)(t + 2) * kstepB;
            const char* a3 = a2 + kstepA; const char* b3 = b2 + kstepB;
            if (last && has_next) S.a_ready(nxt);
            if constexpr (SP2) {
            PG8_LDB(B0, 0, 0); PG8_LDB(B1, 0, 1); PG8_SCHED; PG8_LDA(At, 0, 0); PG8_STAGE(PG8_SA(1, 1), a1 + hstepA, voffA);
            PG8_WAIT_V(8); PG8_WAIT_L(0); PG8_BAR; PG8_MMA(0, 0, At, B0); PG8_MMA(0, 1, At, B1); PG8_BAR; PG8_SCHED;
            PG8_LDA(At, 0, 1); PG8_STAGE(PG8_SB(0, 0), b2, voffB); PG8_STAGE(PG8_SB(0, 1), b2 + hstepB, voffB); PG8_STAGE(PG8_SA(0, 0), a2, voffA);
            PG8_WAIT_V(8); PG8_WAIT_L(0); PG8_BAR; PG8_MMA(1, 0, At, B0); PG8_MMA(1, 1, At, B1); PG8_BAR; PG8_SCHED;
            PG8_LDB(B0, 1, 0); PG8_LDB(B1, 1, 1); PG8_SCHED; PG8_LDA(At, 1, 0); PG8_STAGE(PG8_SA(0, 1), a2 + hstepA, voffA);
            PG8_WAIT_V(8); PG8_WAIT_L(0); PG8_BAR; PG8_MMA(0, 0, At, B0); PG8_MMA(0, 1, At, B1); PG8_BAR; PG8_SCHED;
            PG8_LDA(At, 1, 1); PG8_STAGE(PG8_SB(1, 0), b3, voffB); PG8_STAGE(PG8_SB(1, 1), b3 + hstepB, voffB); PG8_STAGE(PG8_SA(1, 0), a3, voffA);
            PG8_WAIT_V(8); PG8_WAIT_L(0); PG8_BAR; PG8_MMA(1, 0, At, B0); PG8_MMA(1, 1, At, B1); PG8_BAR; PG8_SCHED;
            } else {
            PG8_LDB(B0, 0, 0); PG8_SCHED; PG8_LDA(At, 0, 0); PG8_STAGE(PG8_SA(1, 1), a1 + hstepA, voffA);
            PG8_WAIT_L(8); PG8_BAR; PG8_WAIT_L(0); PG8_MMA(0, 0, At, B0); PG8_BAR; PG8_SCHED;
            PG8_LDB(B1, 0, 1); PG8_STAGE(PG8_SB(0, 0), b2, voffB);
            PG8_BAR; PG8_WAIT_L(0); PG8_MMA(0, 1, At, B1); PG8_BAR;
            PG8_LDA(At, 0, 1); PG8_STAGE(PG8_SA(0, 0), a2, voffA);
            PG8_BAR; PG8_WAIT_L(0); PG8_MMA(1, 0, At, B0); PG8_BAR; PG8_SCHED;
            PG8_STAGE(PG8_SB(0, 1), b2 + hstepB, voffB);
            PG8_WAIT_V(6); PG8_BAR; PG8_MMA(1, 1, At, B1); PG8_BAR;
            PG8_LDB(B0, 1, 0); PG8_SCHED; PG8_LDA(At, 1, 0); PG8_STAGE(PG8_SA(0, 1), a2 + hstepA, voffA);
            PG8_WAIT_L(8); PG8_BAR; PG8_WAIT_L(0); PG8_MMA(0, 0, At, B0); PG8_BAR; PG8_SCHED;
            PG8_LDB(B1, 1, 1); PG8_STAGE(PG8_SB(1, 0), b3, voffB);
            PG8_BAR; PG8_WAIT_L(0); PG8_MMA(0, 1, At, B1); PG8_BAR;
            PG8_LDA(At, 1, 1); PG8_STAGE(PG8_SA(1, 0), a3, voffA);
            PG8_BAR; PG8_WAIT_L(0); PG8_MMA(1, 0, At, B0); PG8_BAR; PG8_SCHED;
            PG8_STAGE(PG8_SB(1, 1), b3 + hstepB, voffB);
            PG8_WAIT_V(6); PG8_BAR; PG8_MMA(1, 1, At, B1); PG8_BAR;
            }
        }
        if constexpr (ALIGN_EPI) { if (wr == 0) PG8_BAR; }
        if constexpr (ESZ == 1) asm volatile("s_nop 15\n\ts_nop 15" ::: "memory");
        if constexpr (!Epi::AFTER_DRAIN) { E(acc, cur, wr, wc, fr, fq); S.done(cur); }
        if (!has_next) break;
#pragma unroll
        for (int a = 0; a < 2; ++a)
#pragma unroll
            for (int b = 0; b < 2; ++b)
#pragma unroll
                for (int m = 0; m < 4; ++m)
#pragma unroll
                    for (int n = 0; n < 2; ++n) acc[a][b][m][n] = (f32x4){0.f, 0.f, 0.f, 0.f};
        cur = nxt; cA = nA; cB = nB; ++ui;
        if constexpr (ALIGN_EPI) { if (wr == 1) PG8_BAR; }
    }
    PG8_WAIT_V(0);
    if constexpr (!ALIGN_EPI) { if (wr == 0) PG8_BAR; }
    PG8_BAR;
    if constexpr (Epi::AFTER_DRAIN) { E.fused(acc, cur, wr, wc, fr, fq, lds, wid, lane); S.done(cur); }
#undef PG8_SA
#undef PG8_SB
#undef PG8_STAGE
#undef PG8_LDA
#undef PG8_LDB
#undef PG8_MMA
#undef PG8_WAIT_V
#undef PG8_WAIT_L
#undef PG8_BAR
#undef PG8_SCHED
}
}
#ifndef ATT_LSUM_MFMA
#define ATT_LSUM_MFMA 1
#endif
namespace att {
typedef unsigned short bf16_t;
typedef short bf16x8 __attribute__((ext_vector_type(8)));
typedef short s16x4 __attribute__((ext_vector_type(4)));
typedef float f32x16 __attribute__((ext_vector_type(16)));
typedef float f32x4 __attribute__((ext_vector_type(4)));
typedef unsigned u32x4 __attribute__((ext_vector_type(4)));
#define ALDS __attribute__((address_space(3)))
#define ASBAR() __builtin_amdgcn_sched_barrier(0)
constexpr int KTB = 12288, VTB = 8192;
constexpr int NSLOT = 3;
constexpr int L_K = 0, L_V = NSLOT * KTB, L_WS = L_V + NSLOT * VTB, L_OST = L_WS + 8 * 256, L_KM = L_OST + 8 * 4096, L_RED = L_KM + 2048, L_END = L_RED + 16384;
constexpr float THR = 8.f;
__device__ __forceinline__ int crow(int r, int hi) { return (r & 3) + 8 * (r >> 2) + 4 * hi; }
typedef float f32x2a_t __attribute__((ext_vector_type(2))); typedef __bf16 bf16x2a_t __attribute__((ext_vector_type(2)));
__device__ __forceinline__ unsigned cvtpk(float lo, float hi) { const f32x2a_t v = {lo, hi}; const bf16x2a_t b = __builtin_convertvector(v, bf16x2a_t); return __builtin_bit_cast(unsigned, b); }
__device__ __forceinline__ float bf2f(short s) { return __uint_as_float(((unsigned)(unsigned short)s) << 16); }
__device__ __forceinline__ int v_st(int k, int c) { const int kk = (k & ~0xC) | ((k & 4) << 1) | ((k & 8) >> 1); return ((kk >> 3) * 2 + (c >> 5)) * 512 + ((kk & 7) * 32 + (c & 31)) * 2; }
__device__ __forceinline__ int v_rd_base(int lane) { return ((lane & 3) << 3) | (((lane >> 2) & 3) << 6) | (((lane >> 4) & 1) << 5) | (((lane >> 5) & 1) << 8); }
constexpr int v_rd_off(int d0, int ks, int half) { return ks * 2048 + half * 1024 + d0 * 512; }
template <int OFF> __device__ __forceinline__ s16x4 tr_read(int vb) { s16x4 r; asm volatile("ds_read_b64_tr_b16 %0, %1 offset:%2" : "=&v"(r) : "v"(vb), "i"(OFF) : "memory"); return r; }
template <int D0> __device__ __forceinline__ void pv_one(f32x16& od, int vb, bf16x8 pa0, bf16x8 pa1, bf16x8 pa2, bf16x8 pa3) {
    const s16x4 l0 = tr_read<v_rd_off(D0, 0, 0)>(vb), h0 = tr_read<v_rd_off(D0, 0, 1)>(vb), l1 = tr_read<v_rd_off(D0, 1, 0)>(vb), h1 = tr_read<v_rd_off(D0, 1, 1)>(vb);
    const s16x4 l2 = tr_read<v_rd_off(D0, 2, 0)>(vb), h2 = tr_read<v_rd_off(D0, 2, 1)>(vb), l3 = tr_read<v_rd_off(D0, 3, 0)>(vb), h3 = tr_read<v_rd_off(D0, 3, 1)>(vb);
    asm volatile("s_waitcnt lgkmcnt(0)" ::: "memory"); ASBAR();
#define ATT_PK(L, H) (bf16x8){L[0], L[1], L[2], L[3], H[0], H[1], H[2], H[3]}
    od = __builtin_amdgcn_mfma_f32_32x32x16_bf16(pa0, ATT_PK(l0, h0), od, 0, 0, 0);
    od = __builtin_amdgcn_mfma_f32_32x32x16_bf16(pa1, ATT_PK(l1, h1), od, 0, 0, 0);
    od = __builtin_amdgcn_mfma_f32_32x32x16_bf16(pa2, ATT_PK(l2, h2), od, 0, 0, 0);
    od = __builtin_amdgcn_mfma_f32_32x32x16_bf16(pa3, ATT_PK(l3, h3), od, 0, 0, 0);
#undef ATT_PK
}
__device__ __forceinline__ void pv_all(f32x16* o, f32x16& ol, int vb, bf16x8 pa0, bf16x8 pa1, bf16x8 pa2, bf16x8 pa3) {
    pv_one<0>(o[0], vb, pa0, pa1, pa2, pa3); pv_one<1>(o[1], vb, pa0, pa1, pa2, pa3);
#if ATT_LSUM_MFMA
    const bf16x8 ones = (bf16x8){0x3F80, 0x3F80, 0x3F80, 0x3F80, 0x3F80, 0x3F80, 0x3F80, 0x3F80};
    ol = __builtin_amdgcn_mfma_f32_32x32x16_bf16(pa0, ones, ol, 0, 0, 0); ol = __builtin_amdgcn_mfma_f32_32x32x16_bf16(pa1, ones, ol, 0, 0, 0);
    ol = __builtin_amdgcn_mfma_f32_32x32x16_bf16(pa2, ones, ol, 0, 0, 0); ol = __builtin_amdgcn_mfma_f32_32x32x16_bf16(pa3, ones, ol, 0, 0, 0);
#endif
}
__device__ __forceinline__ void partialSM(f32x16& p0, f32x16& p1, float& m_ref, f32x16& negm, float& alpha) {
    float pmax = p0[0];
#pragma unroll
    for (int r = 1; r < 16; ++r) pmax = fmaxf(pmax, p0[r]);
#pragma unroll
    for (int r = 0; r < 16; ++r) pmax = fmaxf(pmax, p1[r]);
    { auto rr = __builtin_amdgcn_permlane32_swap(__float_as_uint(pmax), __float_as_uint(pmax), false, false); pmax = fmaxf(__uint_as_float(rr[0]), __uint_as_float(rr[1])); }
    alpha = 1.f;
    if (__builtin_expect(!__all(pmax <= THR), 0)) { const float dl = (pmax > THR) ? pmax : 0.f; m_ref += dl; alpha = __builtin_amdgcn_exp2f(-dl);
#pragma unroll
        for (int r = 0; r < 16; ++r) { p0[r] -= dl; p1[r] -= dl; negm[r] = -m_ref; } }
#pragma unroll
    for (int r = 0; r < 16; ++r) p0[r] = __builtin_amdgcn_exp2f(p0[r]);
}
__device__ __forceinline__ void finishSM(f32x16& p0, f32x16& p1, bf16x8& pa0, bf16x8& pa1, bf16x8& pa2, bf16x8& pa3, float& lsum) {
#pragma unroll
    for (int r = 0; r < 16; ++r) p1[r] = __builtin_amdgcn_exp2f(p1[r]);
#if !ATT_LSUM_MFMA
    { float ps = 0.f;
#pragma unroll
      for (int r = 0; r < 16; ++r) ps += p0[r];
#pragma unroll
      for (int r = 0; r < 16; ++r) ps += p1[r];
      lsum += ps; }
#endif
#define ATT_PK4(P, BASE, OUT) do { unsigned a0 = cvtpk(P[BASE + 0], P[BASE + 1]), a1 = cvtpk(P[BASE + 2], P[BASE + 3]);   \
    unsigned b0 = cvtpk(P[BASE + 4], P[BASE + 5]), b1 = cvtpk(P[BASE + 6], P[BASE + 7]);                              \
    auto r0 = __builtin_amdgcn_permlane32_swap(a0, b0, false, false); auto r1 = __builtin_amdgcn_permlane32_swap(a1, b1, false, false); \
    u32x4 w = {r0[0], r1[0], r0[1], r1[1]}; OUT = __builtin_bit_cast(bf16x8, w); } while (0)
    ATT_PK4(p0, 0, pa0); ATT_PK4(p0, 8, pa1); ATT_PK4(p1, 0, pa2); ATT_PK4(p1, 8, pa3);
#undef ATT_PK4
}
template <int ND> __device__ __forceinline__ void qkt(f32x16& p0, f32x16& p1, ALDS const char* Kb, const int (&ka)[ND], const bf16x8 (&qr)[ND], const f32x16& cinit) {
#pragma unroll
    for (int d0 = 0; d0 < ND; ++d0) {
        const bf16x8 b0 = *(ALDS const bf16x8*)(Kb + ka[d0]);
        const bf16x8 b1 = *(ALDS const bf16x8*)(Kb + ka[d0] + (d0 < 4 ? 4096 : 2048));
        p0 = __builtin_amdgcn_mfma_f32_32x32x16_bf16(b0, qr[d0], d0 == 0 ? cinit : p0, 0, 0, 0);
        p1 = __builtin_amdgcn_mfma_f32_32x32x16_bf16(b1, qr[d0], d0 == 0 ? cinit : p1, 0, 0, 0);
        if (ND > 4 && d0 == 2) asm volatile("" ::: "memory"); }
}
__device__ __forceinline__ void cmask(f32x16& p0, f32x16& p1, int jt, int qrel, int hi) {
    const float NEG = -INFINITY; const int thr = qrel - 64 * jt - 4 * hi;
#pragma unroll
    for (int r = 0; r < 16; ++r) { if ((r & 3) + 8 * (r >> 2) > thr) p0[r] = NEG; if ((r & 3) + 8 * (r >> 2) + 32 > thr) p1[r] = NEG; }
}
__device__ __forceinline__ void kmean_blocks(const bf16_t* Kp, ALDS char* lds) {
    int tid_ = threadIdx.x; asm volatile("" : "+v"(tid_));
    const int tid = tid_, lane = tid & 63, wid = tid >> 6;
    ALDS float* red = (ALDS float*)(lds + L_RED); ALDS float* km = (ALDS float*)(lds + L_KM);
#pragma unroll 1
    for (int n = 0; n < 8; ++n) {
        float a[16];
#pragma unroll
        for (int j = 0; j < 16; ++j) a[j] = 0.f;
#pragma unroll
        for (int i = 0; i < 2; ++i)
#pragma unroll
            for (int cc = 0; cc < 2; ++cc) { const bf16x8 kx = *(const bf16x8*)(Kp + (size_t)(n * 256 + 128 * i + 16 * wid) * AW + cc * 512 + lane * 8);
#pragma unroll
                for (int j = 0; j < 8; ++j) a[cc * 8 + j] += bf2f(kx[j]); }
#pragma unroll
        for (int j = 0; j < 16; ++j) { a[j] += __shfl_xor(a[j], 1); a[j] += __shfl_xor(a[j], 2); a[j] += __shfl_xor(a[j], 4); a[j] += __shfl_xor(a[j], 8); }
        if ((lane & 15) == 0) {
#pragma unroll
            for (int j = 0; j < 16; ++j) red[(n * 8 + wid) * 64 + (j >> 3) * 32 + (lane >> 4) * 8 + (j & 7)] = a[j]; }
    }
    __syncthreads();
    { const int n = tid >> 6, d = tid & 63; float s = 0.f;
#pragma unroll
        for (int w = 0; w < 8; ++w) s += red[(n * 8 + w) * 64 + d];
        km[n * 64 + d] = s * (1.0f / 256.0f); }
    __syncthreads();
}
template <int DQK, bool MOBA>
__device__ __forceinline__ void attn_bh(const bf16_t* Qp, int ldq, const bf16_t* Kp, const bf16_t* KRp, const bf16_t* Vp, bf16_t* Op, int ldo, ALDS char* lds) {
    constexpr int ND = DQK / 16;
    ALDS char* K_lds = lds + L_K; ALDS char* V_lds = lds + L_V;
    bf16x8 sk0, sv0, sr0, sk1, sv1, sr1;
#define ATT_SLOAD(S, k0) do { sk##S = *(const bf16x8*)((const char*)(Kp + (size_t)(k0) * AW) + koff); sv##S = *(const bf16x8*)((const char*)(Vp + (size_t)(k0) * AW) + koff); if (DQK == 96) sr##S = *(const bf16x8*)((const char*)(KRp + (size_t)(k0) * RDIM) + roff); } while (0)
#define ATT_SWRITE(b, S) do { *(ALDS bf16x8*)(K_lds + (b) * KTB + kst) = sk##S; *(ALDS bf16x8*)(V_lds + (b) * VTB + vst) = sv##S; if (DQK == 96) { if (tid < 256) *(ALDS bf16x8*)(K_lds + (b) * KTB + rst) = sr##S; } } while (0)
#define ATT_QLOAD(q_) do { const bf16_t* Qw = Qp + (size_t)((q_) * 256 + wid * 32 + (r32 & 16)) * ldq + (r32 & 15) * 8 + hi * 128; _Pragma("unroll") for (int d0 = 0; d0 < ND; ++d0) qr[d0] = *(const bf16x8*)(Qw + (d0 >> 1) * 512 + (d0 & 1) * 256); } while (0)
    bf16x8 qr[ND];
    {
        const int tid = threadIdx.x, w_ = tid >> 6, l_ = tid & 63;
        const unsigned koff = (unsigned)((w_ >> 1) * 16 * AW + (w_ & 1) * 512 + l_ * 8) * 2u, roff = (unsigned)((w_ & 3) * 16 * RDIM + l_ * 8) * 2u;
        ATT_SLOAD(0, 0); ATT_SLOAD(1, 64); }
#pragma unroll 1
  for (int qb = 0; qb < 8; ++qb) {
    int tid_ = threadIdx.x; asm volatile("" : "+v"(tid_));
    const int tid = tid_, lane = tid & 63, r32 = lane & 31, hi = lane >> 5; const int wid = __builtin_amdgcn_readfirstlane(tid >> 6);
    ALDS float* al_l = (ALDS float*)(lds + L_WS) + wid * 64;
    const int skey = 16 * (wid >> 1) + (lane & 15), sch = 4 * (wid & 1) + (lane >> 4);
    const unsigned koff = (unsigned)((wid >> 1) * 16 * AW + (wid & 1) * 512 + lane * 8) * 2u;
    const int kst = skey * 128 + ((sch ^ ((skey >> 1) & 7)) << 4), vst = v_st(skey, sch * 8);
    const int rkey = 16 * (wid & 3) + (lane & 15), rch = lane >> 4;
    const unsigned roff = (unsigned)((wid & 3) * 16 * RDIM + lane * 8) * 2u;
    const int rst = 8192 + rkey * 64 + ((rch ^ ((rkey >> 2) & 3)) << 4);
    int ka[ND];
#pragma unroll
    for (int d0 = 0; d0 < ND; ++d0) ka[d0] = (d0 < 4) ? r32 * 128 + (((2 * d0 + hi) ^ ((r32 >> 1) & 7)) << 4) : 8192 + r32 * 64 + (((2 * (d0 - 4) + hi) ^ ((r32 >> 2) & 3)) << 4);
    const int vb0 = (int)(unsigned)(uintptr_t)V_lds + v_rd_base(lane);
    const int qrel = wid * 32 + r32;
    ATT_QLOAD(qb);
    float m_ref = 0.f, lsum = 0.f; f32x16 o[2], ol, negm; o[0] = f32x16{}; o[1] = f32x16{}; ol = f32x16{}; negm = f32x16{};
    unsigned sel = 0xffu;
    if (MOBA && qb > 3) {
        ALDS const float* km = (ALDS const float*)(lds + L_KM); float g[8];
#pragma unroll
        for (int n = 0; n < 8; ++n) { float s = 0.f;
#pragma unroll
            for (int d0 = 0; d0 < ND; ++d0)
#pragma unroll
                for (int j = 0; j < 8; ++j) s += bf2f(qr[d0][j]) * km[n * 64 + d0 * 16 + hi * 8 + j];
            g[n] = s; }
#pragma unroll
        for (int n = 0; n < 8; ++n) g[n] += __shfl_xor(g[n], 32);
        sel = 0u;
#pragma unroll
        for (int n = 0; n < 8; ++n) { int rank = 0;
#pragma unroll
            for (int mm = 0; mm < 8; ++mm) if (mm != n) rank += (mm < qb && (g[mm] > g[n] || (g[mm] == g[n] && mm < n))) ? 1 : 0;
            if (n < qb && rank < 3) sel |= 1u << n; }
    }
#define ATT_RESC(a) do { if (__any((a) < 1.f)) { lsum *= (a); if (hi == 0) al_l[r32] = (a); asm volatile("s_waitcnt lgkmcnt(0)" ::: "memory"); \
    _Pragma("unroll") for (int r = 0; r < 16; ++r) { const float f_ = al_l[crow(r, hi)]; o[0][r] *= f_; o[1][r] *= f_; ol[r] *= f_; } } } while (0)
    f32x16 pA0, pA1, pB0, pB1; float alA, alB; bf16x8 pa0, pa1, pa2, pa3; const int NT = 4 * (qb + 1), NP = 4 * qb;
    f32x16 cm = negm; const bool gated = MOBA && qb > 3;
#define ATT_CM(t) do { if (gated) { if ((t) < NP) { const float v_ = ((sel >> ((t) >> 2)) & 1u) ? -m_ref : -INFINITY; _Pragma("unroll") for (int r = 0; r < 16; ++r) cm[r] = v_; } else cm = negm; } else cm = negm; } while (0)
#define ATT_SCORE(P0, P1, t) do { ATT_CM(t); qkt<ND>(P0, P1, K_lds + sc * KTB, ka, qr, cm); if ((t) >= NP) cmask(P0, P1, (t) - NP, qrel, hi); } while (0)
    int sp = 0, sc = 0, sn = 1;
#define ATT_ROT() do { sp = sc; sc = sn; sn = (sn == NSLOT - 1) ? 0 : sn + 1; } while (0)
    ATT_SWRITE(0, 0); ATT_SLOAD(0, 128);
    __syncthreads(); ATT_SWRITE(sn, 1); ATT_SLOAD(1, 192);
    ATT_SCORE(pA0, pA1, 0); partialSM(pA0, pA1, m_ref, negm, alA);
    ATT_ROT();
    for (int t = 1; t + 1 < NT; t += 2) {
        __syncthreads(); ATT_SWRITE(sn, 0); if (t + 3 < NT) ATT_SLOAD(0, (t + 3) * 64);
        ASBAR(); ATT_SCORE(pB0, pB1, t);
        finishSM(pA0, pA1, pa0, pa1, pa2, pa3, lsum); ASBAR();
        pv_all(o, ol, vb0 + sp * VTB, pa0, pa1, pa2, pa3); partialSM(pB0, pB1, m_ref, negm, alB);
        ATT_RESC(alB); ATT_ROT();
        __syncthreads(); ATT_SWRITE(sn, 1); if (t + 4 < NT) ATT_SLOAD(1, (t + 4) * 64);
        ASBAR(); ATT_SCORE(pA0, pA1, t + 1);
        finishSM(pB0, pB1, pa0, pa1, pa2, pa3, lsum); ASBAR();
        pv_all(o, ol, vb0 + sp * VTB, pa0, pa1, pa2, pa3); partialSM(pA0, pA1, m_ref, negm, alA);
        ATT_RESC(alA); ATT_ROT();
    }
    __syncthreads();
    ASBAR(); ATT_SCORE(pB0, pB1, NT - 1);
    if (qb < 7) { ATT_SLOAD(0, 0); ATT_SLOAD(1, 64); }
    finishSM(pA0, pA1, pa0, pa1, pa2, pa3, lsum); ASBAR();
    pv_all(o, ol, vb0 + sp * VTB, pa0, pa1, pa2, pa3); partialSM(pB0, pB1, m_ref, negm, alB);
    ATT_RESC(alB);
    finishSM(pB0, pB1, pa0, pa1, pa2, pa3, lsum); ASBAR();
    pv_all(o, ol, vb0 + sc * VTB, pa0, pa1, pa2, pa3);
#undef ATT_ROT
#undef ATT_SCORE
#undef ATT_CM
    float rli[16];
#if ATT_LSUM_MFMA
#pragma unroll
    for (int r = 0; r < 16; ++r) rli[r] = __builtin_amdgcn_rcpf(ol[r]);
#else
    { auto rr = __builtin_amdgcn_permlane32_swap(__float_as_uint(lsum), __float_as_uint(lsum), false, false); lsum = __uint_as_float(rr[0]) + __uint_as_float(rr[1]); }
    if (hi == 0) al_l[32 + r32] = lsum; asm volatile("s_waitcnt lgkmcnt(0)" ::: "memory");
#pragma unroll
    for (int r = 0; r < 16; ++r) rli[r] = __builtin_amdgcn_rcpf(al_l[32 + crow(r, hi)]);
#endif
    { ALDS unsigned short* stg = (ALDS unsigned short*)(lds + L_OST) + wid * 2048;
#pragma unroll
      for (int r = 0; r < 16; ++r) { const int orow = crow(r, hi);
#pragma unroll
          for (int d0 = 0; d0 < 2; ++d0) stg[orow * 64 + d0 * 32 + r32] = (unsigned short)(cvtpk(o[d0][r] * rli[r], 0.f) & 0xffffu); }
      asm volatile("s_waitcnt lgkmcnt(0)" ::: "memory");
      bf16_t* Ow = Op + (size_t)(qb * 256 + wid * 32) * ldo;
#pragma unroll
      for (int i = 0; i < 4; ++i) { const int row = i * 8 + (lane >> 3), ch = lane & 7; const u32x4 v = *(ALDS const u32x4*)(stg + row * 64 + ch * 8); *(u32x4*)(Ow + (size_t)row * ldo + ch * 8) = v; } }
    __syncthreads();
  }
#undef ATT_SLOAD
#undef ATT_SWRITE
#undef ATT_QLOAD
#undef ATT_RESC
}

constexpr int MSLOT = 8192, M_K = 0, M_V = 3 * MSLOT, M_WS = 6 * MSLOT, M_OST = M_WS + 8 * 256, M_END = M_OST + 8 * 4096;
static_assert(M_END <= L_KM, "MoBA LDS map");
#define MPIN(x) asm volatile("" : "+v"(x))
#define MMFMA(a, b, c) __builtin_amdgcn_mfma_f32_32x32x16_bf16(a, b, c, 0, 0, 0)
#define MWAIT_BAR(N) asm volatile("s_waitcnt vmcnt(" #N ") lgkmcnt(0)\n\ts_barrier" ::: "memory")
__device__ __forceinline__ void m_kload2(bf16x8* kf, ALDS const char* kp, int d0) { kf[2 * d0] = *(ALDS const bf16x8*)(kp + d0 * 2048); kf[2 * d0 + 1] = *(ALDS const bf16x8*)(kp + d0 * 2048 + 512); }
__device__ __forceinline__ void m_glds16(const void* g, unsigned lds_base) {
    unsigned sv; asm volatile("s_mov_b32 %0, m0\n\ts_mov_b32 m0, %2\n\ts_nop 0\n\tglobal_load_lds_dwordx4 %1, off\n\ts_mov_b32 m0, %0" : "=&s"(sv) : "v"(g), "s"(lds_base) : "memory"); }
typedef ALDS s16x4 lds_s16x4_t;
__device__ __forceinline__ s16x4 m_vtr(ALDS const char* p) { return __builtin_amdgcn_ds_read_tr16_b64_v4i16((lds_s16x4_t*)p); }
#define MMX3(a, b, c) __builtin_fmaxf(__builtin_fmaxf((a), (b)), (c))
__device__ __forceinline__ float m_rowmax(const f32x16& p0, const f32x16& p1) {
    float a = MMX3(p0[0], p0[1], p1[0]), b = MMX3(p0[2], p0[3], p1[1]); a = MMX3(a, p1[2], p1[3]);
#pragma unroll
    for (int r = 4; r < 16; r += 4) { a = MMX3(a, p0[r], p0[r + 1]); b = MMX3(b, p0[r + 2], p0[r + 3]); a = MMX3(a, p1[r], p1[r + 1]); b = MMX3(b, p1[r + 2], p1[r + 3]); }
    float m = __builtin_fmaxf(a, b); auto rr = __builtin_amdgcn_permlane32_swap(__float_as_uint(m), __float_as_uint(m), false, false);
    return __builtin_fmaxf(__uint_as_float(rr[0]), __uint_as_float(rr[1])); }
__device__ __forceinline__ void moba_unit(const bf16_t* Qp, const bf16_t* Kp, const bf16_t* Vp, bf16_t* Op, int ldo, int qb, ALDS char* lds) {
    int tid_ = threadIdx.x; asm volatile("" : "+v"(tid_));
    const int tid = tid_, lane = tid & 63, r32 = lane & 31, hi = lane >> 5; const int wid = __builtin_amdgcn_readfirstlane(tid >> 6);
    const int NT = 4 * qb + 4, NP = 4 * qb;
    ALDS float* wsf = (ALDS float*)(lds + M_WS) + wid * 64;
    const bf16_t* ksrc = Kp + (size_t)(lane >> 4) * 16 * AW + (wid >> 2) * 512 + (wid & 3) * 128 + (lane & 15) * 8;
    const bf16_t* vsrc = Vp + (size_t)(wid & 3) * 16 * AW + (wid >> 2) * 512 + (lane & 3) * 128 + (lane >> 2) * 8;
    const unsigned lds0 = (unsigned)(uintptr_t)lds, kdst = lds0 + M_K + wid * 1024, vdst = lds0 + M_V + wid * 1024;
#define MDMA_K(t, slot) m_glds16(ksrc + (size_t)(t) * 64 * AW, (unsigned)__builtin_amdgcn_readfirstlane(kdst + (slot)))
#define MDMA_V(t, slot) m_glds16(vsrc + (size_t)(t) * 64 * AW, (unsigned)__builtin_amdgcn_readfirstlane(vdst + (slot)))
    ALDS const char* vp0 = lds + M_V + ((lane >> 4) & 1) * 32 + (lane & 3) * 8 + (4 * hi + ((lane & 15) >> 2)) * 64;
    ALDS const char* kp0 = lds + M_K + hi * 1024 + r32 * 16;
    MDMA_K(0, 0); MDMA_V(0, 0); MDMA_K(1, MSLOT);
    bf16x8 qr[4];
    { const bf16_t* Qw = Qp + (size_t)(qb * 256 + wid * 32 + (r32 & 16)) * AW + (r32 & 15) * 8 + hi * 128;
#pragma unroll
      for (int d0 = 0; d0 < 4; ++d0) qr[d0] = *(const bf16x8*)(Qw + (d0 >> 1) * 512 + (d0 & 1) * 256); }
    MDMA_K(2, 2 * MSLOT);
    float mhat = 0.f, l_reg = 0.f; f32x16 o[2]; o[0] = f32x16{}; o[1] = f32x16{};
    const int qrel = wid * 32 + r32; bool resc = false, moved = false;
    unsigned sel = 0xffu; const bool gated = qb > 3;
    if (gated) {
        ALDS const float* km = (ALDS const float*)(lds + L_KM); float g[8];
#pragma unroll
        for (int n = 0; n < 8; ++n) { float sg = 0.f;
#pragma unroll
            for (int d0 = 0; d0 < 4; ++d0)
#pragma unroll
                for (int j = 0; j < 8; ++j) sg += bf2f(qr[d0][j]) * km[n * 64 + d0 * 16 + hi * 8 + j];
            g[n] = sg; }
#pragma unroll
        for (int n = 0; n < 8; ++n) g[n] += __shfl_xor(g[n], 32);
        sel = 0u;
#pragma unroll
        for (int n = 0; n < 8; ++n) { int rank = 0;
#pragma unroll
            for (int mm = 0; mm < 8; ++mm) if (mm != n) rank += (mm < qb && (g[mm] > g[n] || (g[mm] == g[n] && mm < n))) ? 1 : 0;
            if (n < qb && rank < 3) sel |= 1u << n; }
    }
    f32x16 cm;
#define MCM(t) do { const float v_ = (gated && (t) < NP && !((sel >> ((t) >> 2)) & 1u)) ? -INFINITY : -mhat; _Pragma("unroll") for (int r = 0; r < 16; ++r) cm[r] = v_; MPIN(cm); } while (0)
    MCM(0);
    f32x16 pA0, pA1, pB0, pB1; bf16x8 kf[8]; s16x4 vlo[8], vhi[8]; u32x4 pw0, pw1, pw2, pw3;
    int sl_prev = 0, sl_cur = 0, sl_next = MSLOT;
#define MROT() do { sl_prev = sl_cur; sl_cur = sl_next; sl_next = (sl_next == 2 * MSLOT) ? 0 : sl_next + MSLOT; } while (0)
#define MEX(v) __builtin_amdgcn_exp2f(v)
#define MRESC(tn) do { if (moved) { moved = false; MCM(tn); } if (resc) { _Pragma("unroll") for (int d_ = 0; d_ < 2; ++d_) _Pragma("unroll") for (int r = 0; r < 16; ++r) o[d_][r] *= wsf[crow(r, hi)]; } } while (0)
#define MDECIDE(C0, C1) do { const float rm = m_rowmax(C0, C1); resc = false; \
      if (__builtin_expect(__any(rm > THR), 0)) { const float dl = __builtin_fmaxf(rm, 0.f); mhat += dl; const float f = __builtin_amdgcn_exp2f(-dl); l_reg *= f; if (hi == 0) wsf[r32] = f; resc = true; \
          _Pragma("unroll") for (int r = 0; r < 16; ++r) { C0[r] -= dl; C1[r] -= dl; } moved = true; } } while (0)
    MWAIT_BAR(3);
#pragma unroll
    for (int d0 = 0; d0 < 4; ++d0) m_kload2(kf, kp0, d0);
    pA0 = MMFMA(kf[0], qr[0], cm); pA1 = MMFMA(kf[1], qr[0], cm); pA0 = MMFMA(kf[2], qr[1], pA0); pA1 = MMFMA(kf[3], qr[1], pA1);
    pA0 = MMFMA(kf[4], qr[2], pA0); pA1 = MMFMA(kf[5], qr[2], pA1); pA0 = MMFMA(kf[6], qr[3], pA0); pA1 = MMFMA(kf[7], qr[3], pA1);
    if (NT == 4) cmask(pA0, pA1, 0, qrel, hi);
    MDECIDE(pA0, pA1);
    if (moved) { moved = false; MCM(1); }
#pragma unroll
    for (int r = 0; r < 16; ++r) { pA0[r] = MEX(pA0[r]); pA1[r] = MEX(pA1[r]); }
    MWAIT_BAR(0);
    MDMA_K(3, 0); MDMA_V(1, MSLOT); MROT();
#pragma unroll
    for (int d0 = 0; d0 < 4; ++d0) m_kload2(kf, kp0 + sl_cur, d0);
    MWAIT_BAR(2);
#define MPKW(P, i) cvtpk(P[i], P[i + 1])
#define MPAF(k) __builtin_bit_cast(bf16x8, pw##k)
#define MVFR(i) (bf16x8){vlo[i][0], vlo[i][1], vlo[i][2], vlo[i][3], vhi[i][0], vhi[i][1], vhi[i][2], vhi[i][3]}
#define MVRD(i) do { vlo[i] = m_vtr(vp_ + (((i) >> 2) * 4096 + ((i) & 3) * 1024)); vhi[i] = m_vtr(vp_ + (((i) >> 2) * 4096 + ((i) & 3) * 1024 + 512)); } while (0)
#define MKRD(G, d0) do { if (G) { m_kload2(kf, kp0 + sl_next, d0); ASBAR(); } } while (0)
#define MGAPA(MF, a0, a1, a2, a3, W0, W1, PW) do { MF; sacc += a0; sacc += a1; sacc += a2; sacc += a3; W0; W1; MPIN(PW); MPIN(sacc); ASBAR(); } while (0)
#define MGAPB(MF, X, i) do { MF; X[i] = MEX(X[i]); X[i + 1] = MEX(X[i + 1]); X[i + 2] = MEX(X[i + 2]); X[i + 3] = MEX(X[i + 3]); MPIN(X); ASBAR(); } while (0)
#define MSTEP(C0, C1, P0, P1, t, MASK, GK, GV, GL) do { ASBAR(); \
    const ALDS char* vp_ = vp0 + sl_prev; if (gated && ((t) & 3) == 0) MCM(t); \
    MVRD(0); ASBAR(); float sacc = P0[0] + P0[1]; \
                     MGAPA(C0 = MMFMA(kf[0], qr[0], cm), P0[2], P0[3], P0[4], P0[5],     pw0[0] = MPKW(P0, 0),  pw0[1] = MPKW(P0, 2),  pw0); \
    MVRD(4); ASBAR(); MGAPA(C1 = MMFMA(kf[1], qr[0], cm), P0[6], P0[7], P0[8], P0[9],     pw0[2] = MPKW(P0, 4),  pw0[3] = MPKW(P0, 6),  pw0); \
    MVRD(1); ASBAR(); MGAPA(C0 = MMFMA(kf[2], qr[1], C0), P0[10], P0[11], P0[12], P0[13], pw1[0] = MPKW(P0, 8),  pw1[1] = MPKW(P0, 10), pw1); \
    MVRD(5); ASBAR(); MGAPA(C1 = MMFMA(kf[3], qr[1], C1), P0[14], P0[15], P1[0], P1[1],   pw1[2] = MPKW(P0, 12), pw1[3] = MPKW(P0, 14), pw1); \
    MVRD(2); ASBAR(); MGAPA(C0 = MMFMA(kf[4], qr[2], C0), P1[2], P1[3], P1[4], P1[5],     pw2[0] = MPKW(P1, 0),  pw2[1] = MPKW(P1, 2),  pw2); \
    MVRD(6); ASBAR(); MGAPA(C1 = MMFMA(kf[5], qr[2], C1), P1[6], P1[7], P1[8], P1[9],     pw2[2] = MPKW(P1, 4),  pw2[3] = MPKW(P1, 6),  pw2); \
    MVRD(3); ASBAR(); MGAPA(C0 = MMFMA(kf[6], qr[3], C0), P1[10], P1[11], P1[12], P1[13], pw3[0] = MPKW(P1, 8),  pw3[1] = MPKW(P1, 10), pw3); \
    MVRD(7); ASBAR(); MGAPA(C1 = MMFMA(kf[7], qr[3], C1), P1[14], P1[15], 0.f, 0.f,       pw3[2] = MPKW(P1, 12), pw3[3] = MPKW(P1, 14), pw3); \
    l_reg += sacc; \
    if (GK) MDMA_K((t) + 3, sl_cur); if (GV) MDMA_V((t) + 1, sl_next); \
    if (MASK) cmask(C0, C1, (t) - NP, qrel, hi); \
    MDECIDE(C0, C1); ASBAR(); \
    MGAPB(o[0] = MMFMA(MPAF(0), MVFR(0), o[0]), C0, 0);               MGAPB(o[1] = MMFMA(MPAF(0), MVFR(4), o[1]), C0, 4); \
    MKRD(GL, 0); MGAPB(o[0] = MMFMA(MPAF(1), MVFR(1), o[0]), C0, 8);  MKRD(GL, 1); MGAPB(o[1] = MMFMA(MPAF(1), MVFR(5), o[1]), C0, 12); \
    MKRD(GL, 2); MGAPB(o[0] = MMFMA(MPAF(2), MVFR(2), o[0]), C1, 0);  MKRD(GL, 3); MGAPB(o[1] = MMFMA(MPAF(2), MVFR(6), o[1]), C1, 4); \
    MGAPB(o[0] = MMFMA(MPAF(3), MVFR(3), o[0]), C1, 8);               MGAPB(o[1] = MMFMA(MPAF(3), MVFR(7), o[1]), C1, 12); \
    } while (0)
    int t = 1;
    for (; t + 5 < NT; t += 2) {
        MSTEP(pB0, pB1, pA0, pA1, t, false, true, true, true);     MWAIT_BAR(2); MRESC(t + 1); MROT();
        MSTEP(pA0, pA1, pB0, pB1, t + 1, false, true, true, true); MWAIT_BAR(2); MRESC(t + 2); MROT();
    }
#define MENDW(tt) do { if ((tt) + 3 < NT) { MWAIT_BAR(2); } else if ((tt) + 2 < NT) { MWAIT_BAR(1); } else { MWAIT_BAR(0); } } while (0)
    for (; t + 1 < NT; t += 2) {
        MSTEP(pB0, pB1, pA0, pA1, t, true, (t + 3 < NT), (t + 1 < NT), (t + 1 < NT));         MENDW(t);     MRESC(t + 1); MROT();
        MSTEP(pA0, pA1, pB0, pB1, t + 1, true, (t + 4 < NT), (t + 2 < NT), (t + 2 < NT));     MENDW(t + 1); MRESC(t + 2); MROT();
    }
    MSTEP(pB0, pB1, pA0, pA1, NT - 1, true, false, false, false); MRESC(NT - 1);
    { float sacc = pB0[0] + pB0[1];
#pragma unroll
      for (int r = 2; r < 16; ++r) sacc += pB0[r];
#pragma unroll
      for (int r = 0; r < 16; ++r) sacc += pB1[r];
      l_reg += sacc;
      pw0 = (u32x4){MPKW(pB0, 0), MPKW(pB0, 2), MPKW(pB0, 4), MPKW(pB0, 6)}; pw1 = (u32x4){MPKW(pB0, 8), MPKW(pB0, 10), MPKW(pB0, 12), MPKW(pB0, 14)};
      pw2 = (u32x4){MPKW(pB1, 0), MPKW(pB1, 2), MPKW(pB1, 4), MPKW(pB1, 6)}; pw3 = (u32x4){MPKW(pB1, 8), MPKW(pB1, 10), MPKW(pB1, 12), MPKW(pB1, 14)};
      const ALDS char* vp_ = vp0 + sl_cur;
#pragma unroll
      for (int i = 0; i < 8; ++i) MVRD(i);
      o[0] = MMFMA(MPAF(0), MVFR(0), o[0]); o[1] = MMFMA(MPAF(0), MVFR(4), o[1]); o[0] = MMFMA(MPAF(1), MVFR(1), o[0]); o[1] = MMFMA(MPAF(1), MVFR(5), o[1]);
      o[0] = MMFMA(MPAF(2), MVFR(2), o[0]); o[1] = MMFMA(MPAF(2), MVFR(6), o[1]); o[0] = MMFMA(MPAF(3), MVFR(3), o[0]); o[1] = MMFMA(MPAF(3), MVFR(7), o[1]); }
    { auto rr = __builtin_amdgcn_permlane32_swap(__float_as_uint(l_reg), __float_as_uint(l_reg), false, false); l_reg = __uint_as_float(rr[0]) + __uint_as_float(rr[1]); }
    if (hi == 0) wsf[32 + r32] = l_reg; asm volatile("s_waitcnt lgkmcnt(0)" ::: "memory");
    float rli[16];
#pragma unroll
    for (int r = 0; r < 16; ++r) rli[r] = __builtin_amdgcn_rcpf(wsf[32 + crow(r, hi)]);
    { ALDS unsigned short* stg = (ALDS unsigned short*)(lds + M_OST) + wid * 2048;
#pragma unroll
      for (int r = 0; r < 16; ++r) { const int orow = crow(r, hi);
#pragma unroll
          for (int d0 = 0; d0 < 2; ++d0) stg[orow * 64 + d0 * 32 + r32] = (unsigned short)(cvtpk(o[d0][r] * rli[r], 0.f) & 0xffffu); }
      asm volatile("s_waitcnt lgkmcnt(0)" ::: "memory");
      bf16_t* Ow = Op + (size_t)(qb * 256 + wid * 32) * ldo;
#pragma unroll
      for (int i = 0; i < 4; ++i) { const int row = i * 8 + (lane >> 3), ch = lane & 7; const u32x4 v = *(ALDS const u32x4*)(stg + row * 64 + ch * 8); *(u32x4*)(Ow + (size_t)row * ldo + ch * 8) = v; } }
    asm volatile("s_waitcnt lgkmcnt(0)\n\ts_barrier" ::: "memory");
#undef MDMA_K
#undef MDMA_V
#undef MCM
#undef MROT
#undef MEX
#undef MRESC
#undef MDECIDE
#undef MPKW
#undef MPAF
#undef MVFR
#undef MVRD
#undef MKRD
#undef MGAPA
#undef MGAPB
#undef MSTEP
#undef MENDW
}
__device__ __forceinline__ void mla_unit(const bf16_t* Qp, const bf16_t* Kp, const bf16_t* KRp, const bf16_t* Vp, bf16_t* Op, int ldo, int qb, ALDS char* lds) {
    constexpr int KSL = 12288, N_K = 0, N_V = 3 * KSL, N_WS = N_V + 3 * MSLOT, N_OST = N_WS + 8 * 256;
    int tid_ = threadIdx.x; asm volatile("" : "+v"(tid_));
    const int tid = tid_, lane = tid & 63, r32 = lane & 31, hi = lane >> 5; const int wid = __builtin_amdgcn_readfirstlane(tid >> 6);
    const int NT = 4 * qb + 4, NP = 4 * qb;
    ALDS float* wsf = (ALDS float*)(lds + N_WS) + wid * 64;
    const bf16_t* ksrc = Kp + (size_t)(lane >> 4) * 16 * AW + (wid >> 2) * 512 + (wid & 3) * 128 + (lane & 15) * 8;
    const bf16_t* vsrc = Vp + (size_t)(wid & 3) * 16 * AW + (wid >> 2) * 512 + (lane & 3) * 128 + (lane >> 2) * 8;
    const bf16_t* rsrc = KRp + (size_t)(lane >> 4) * 16 * RDIM + (wid & 3) * 128 + (lane & 15) * 8;
    const unsigned lds0 = (unsigned)(uintptr_t)lds, kdst = lds0 + N_K + wid * 1024, vdst = lds0 + N_V + wid * 1024, rdst = lds0 + N_K + (8 + (wid & 3)) * 1024;
#define MDMA_K(t, slot) do { m_glds16(ksrc + (size_t)(t) * 64 * AW, (unsigned)__builtin_amdgcn_readfirstlane(kdst + (slot) * KSL)); m_glds16(rsrc + (size_t)(t) * 64 * RDIM, (unsigned)__builtin_amdgcn_readfirstlane(rdst + (slot) * KSL)); } while (0)
#define MDMA_V(t, slot) m_glds16(vsrc + (size_t)(t) * 64 * AW, (unsigned)__builtin_amdgcn_readfirstlane(vdst + (slot) * MSLOT))
    ALDS const char* vp0 = lds + N_V + ((lane >> 4) & 1) * 32 + (lane & 3) * 8 + (4 * hi + ((lane & 15) >> 2)) * 64;
    ALDS const char* kp0 = lds + N_K + hi * 1024 + r32 * 16;
    MDMA_K(0, 0); MDMA_V(0, 0); MDMA_K(1, 1);
    bf16x8 qr[6];
    { const bf16_t* Qw = Qp + (size_t)(qb * 256 + wid * 32 + (r32 & 16)) * (NHEAD * QKB) + (r32 & 15) * 8 + hi * 128;
#pragma unroll
      for (int d0 = 0; d0 < 6; ++d0) qr[d0] = *(const bf16x8*)(Qw + (d0 >> 1) * 512 + (d0 & 1) * 256); }
    MDMA_K(2, 2);
    float mhat = 0.f, l_reg = 0.f; f32x16 o[2]; o[0] = f32x16{}; o[1] = f32x16{};
    const int qrel = wid * 32 + r32; bool resc = false, moved = false;
    constexpr bool gated = false; constexpr unsigned sel = 0xffu;
#define MCM(t) do { } while (0)
#define MREL(C0, C1) do { if (__builtin_expect(__any(mhat != 0.f), 0)) { _Pragma("unroll") for (int r = 0; r < 16; ++r) { C0[r] -= mhat; C1[r] -= mhat; } } } while (0)
    f32x16 pA0, pA1, pB0, pB1; bf16x8 kf[12]; s16x4 vlo[8], vhi[8]; u32x4 pw0, pw1, pw2, pw3;
    int sl_prev = 0, sl_cur = 0, sl_next = 1;
#define MROT() do { sl_prev = sl_cur; sl_cur = sl_next; sl_next = (sl_next == 2) ? 0 : sl_next + 1; } while (0)
#define MEX(v) __builtin_amdgcn_exp2f(v)
#define MRESC(tn) do { if (resc) { _Pragma("unroll") for (int d_ = 0; d_ < 2; ++d_) _Pragma("unroll") for (int r = 0; r < 16; ++r) o[d_][r] *= wsf[crow(r, hi)]; } } while (0)
#define MDECIDE(C0, C1) do { const float rm = m_rowmax(C0, C1); resc = false; \
      if (__builtin_expect(__any(rm > THR), 0)) { const float dl = __builtin_fmaxf(rm, 0.f); mhat += dl; const float f = __builtin_amdgcn_exp2f(-dl); l_reg *= f; if (hi == 0) wsf[r32] = f; resc = true; \
          _Pragma("unroll") for (int r = 0; r < 16; ++r) { C0[r] -= dl; C1[r] -= dl; } moved = true; } } while (0)
    MWAIT_BAR(5);
#pragma unroll
    for (int d0 = 0; d0 < 6; ++d0) m_kload2(kf, kp0, d0);
    pA0 = MMFMA(kf[0], qr[0], (f32x16){}); pA1 = MMFMA(kf[1], qr[0], (f32x16){}); pA0 = MMFMA(kf[2], qr[1], pA0); pA1 = MMFMA(kf[3], qr[1], pA1);
    pA0 = MMFMA(kf[4], qr[2], pA0); pA1 = MMFMA(kf[5], qr[2], pA1); pA0 = MMFMA(kf[6], qr[3], pA0); pA1 = MMFMA(kf[7], qr[3], pA1);
    pA0 = MMFMA(kf[8], qr[4], pA0); pA1 = MMFMA(kf[9], qr[4], pA1); pA0 = MMFMA(kf[10], qr[5], pA0); pA1 = MMFMA(kf[11], qr[5], pA1);
    if (NT == 4) cmask(pA0, pA1, 0, qrel, hi);
    MREL(pA0, pA1); MDECIDE(pA0, pA1);
#pragma unroll
    for (int r = 0; r < 16; ++r) { pA0[r] = MEX(pA0[r]); pA1[r] = MEX(pA1[r]); }
    MWAIT_BAR(0);
    MDMA_K(3, 0); MDMA_V(1, 1); MROT();
#pragma unroll
    for (int d0 = 0; d0 < 6; ++d0) m_kload2(kf, kp0 + sl_cur * KSL, d0);
    MWAIT_BAR(3);
#define MPKW(P, i) cvtpk(P[i], P[i + 1])
#define MPAF(k) __builtin_bit_cast(bf16x8, pw##k)
#define MVFR(i) (bf16x8){vlo[i][0], vlo[i][1], vlo[i][2], vlo[i][3], vhi[i][0], vhi[i][1], vhi[i][2], vhi[i][3]}
#define MVRD(i) do { vlo[i] = m_vtr(vp_ + (((i) >> 2) * 4096 + ((i) & 3) * 1024)); vhi[i] = m_vtr(vp_ + (((i) >> 2) * 4096 + ((i) & 3) * 1024 + 512)); } while (0)
#define MKRD(G, d0) do { if (G) { m_kload2(kf, kp0 + sl_next * KSL, d0); ASBAR(); } } while (0)
#define MGAPA(MF, a0, a1, a2, a3, W0, W1, PW) do { MF; sacc += a0; sacc += a1; sacc += a2; sacc += a3; W0; W1; MPIN(PW); MPIN(sacc); ASBAR(); } while (0)
#define MGAPB(MF, X, i) do { MF; X[i] = MEX(X[i]); X[i + 1] = MEX(X[i + 1]); X[i + 2] = MEX(X[i + 2]); X[i + 3] = MEX(X[i + 3]); MPIN(X); ASBAR(); } while (0)
#define MGAPA2(MF, a0, a1, W0, PW) do { MF; sacc += a0; sacc += a1; W0; MPIN(PW); MPIN(sacc); ASBAR(); } while (0)
#define MSTEP(C0, C1, P0, P1, t, MASK, GK, GV, GL) do { ASBAR(); \
    const ALDS char* vp_ = vp0 + sl_prev * MSLOT; \
    MVRD(0); ASBAR(); float sacc = P0[0] + P0[1]; \
                     MGAPA(C0 = MMFMA(kf[0], qr[0], (f32x16){}), P0[2], P0[3], P0[4], P0[5],     pw0[0] = MPKW(P0, 0),  pw0[1] = MPKW(P0, 2),  pw0); \
    MVRD(4); ASBAR(); MGAPA(C1 = MMFMA(kf[1], qr[0], (f32x16){}), P0[6], P0[7], P0[8], P0[9],     pw0[2] = MPKW(P0, 4),  pw0[3] = MPKW(P0, 6),  pw0); \
    MVRD(1); ASBAR(); MGAPA2(C0 = MMFMA(kf[2], qr[1], C0), P0[10], P0[11], pw1[0] = MPKW(P0, 8),  pw1); \
    MVRD(5); ASBAR(); MGAPA2(C1 = MMFMA(kf[3], qr[1], C1), P0[12], P0[13], pw1[1] = MPKW(P0, 10), pw1); \
                     MGAPA2(C0 = MMFMA(kf[4], qr[2], C0), P0[14], P0[15], pw1[2] = MPKW(P0, 12), pw1); \
                     MGAPA2(C1 = MMFMA(kf[5], qr[2], C1), P1[0], P1[1],   pw1[3] = MPKW(P0, 14), pw1); \
                     MGAPA2(C0 = MMFMA(kf[6], qr[3], C0), P1[2], P1[3],   pw2[0] = MPKW(P1, 0),  pw2); \
                     MGAPA2(C1 = MMFMA(kf[7], qr[3], C1), P1[4], P1[5],   pw2[1] = MPKW(P1, 2),  pw2); \
                     MGAPA(C0 = MMFMA(kf[8], qr[4], C0), P1[6], P1[7], P1[8], P1[9],     pw2[2] = MPKW(P1, 4),  pw2[3] = MPKW(P1, 6),  pw2); \
                     MGAPA(C1 = MMFMA(kf[9], qr[4], C1), P1[10], P1[11], P1[12], P1[13], pw3[0] = MPKW(P1, 8),  pw3[1] = MPKW(P1, 10), pw3); \
                     MGAPA2(C0 = MMFMA(kf[10], qr[5], C0), P1[14], P1[15], pw3[2] = MPKW(P1, 12), pw3); \
                     MGAPA2(C1 = MMFMA(kf[11], qr[5], C1), 0.f, 0.f,       pw3[3] = MPKW(P1, 14), pw3); \
    l_reg += sacc; \
    if (GK) MDMA_K((t) + 3, sl_cur); if (GV) MDMA_V((t) + 1, sl_next); \
    if (MASK) cmask(C0, C1, (t) - NP, qrel, hi); \
    MREL(C0, C1); MDECIDE(C0, C1); ASBAR(); \
    MVRD(2); MKRD(GL, 4); ASBAR(); MGAPB(o[0] = MMFMA(MPAF(0), MVFR(0), o[0]), C0, 0);  MVRD(6); MKRD(GL, 5); ASBAR(); MGAPB(o[1] = MMFMA(MPAF(0), MVFR(4), o[1]), C0, 4); \
    MVRD(3); MKRD(GL, 0); ASBAR(); MGAPB(o[0] = MMFMA(MPAF(1), MVFR(1), o[0]), C0, 8);  MVRD(7); MKRD(GL, 1); ASBAR(); MGAPB(o[1] = MMFMA(MPAF(1), MVFR(5), o[1]), C0, 12); \
    MKRD(GL, 2); MGAPB(o[0] = MMFMA(MPAF(2), MVFR(2), o[0]), C1, 0);  MKRD(GL, 3); MGAPB(o[1] = MMFMA(MPAF(2), MVFR(6), o[1]), C1, 4); \
    MGAPB(o[0] = MMFMA(MPAF(3), MVFR(3), o[0]), C1, 8);               MGAPB(o[1] = MMFMA(MPAF(3), MVFR(7), o[1]), C1, 12); \
    } while (0)
    int t = 1;
    for (; t + 5 < NT; t += 2) {
        MSTEP(pB0, pB1, pA0, pA1, t, false, true, true, true);     MWAIT_BAR(3); MRESC(t + 1); MROT();
        MSTEP(pA0, pA1, pB0, pB1, t + 1, false, true, true, true); MWAIT_BAR(3); MRESC(t + 2); MROT();
    }
#define MENDW(tt) do { if ((tt) + 3 < NT) { MWAIT_BAR(3); } else if ((tt) + 2 < NT) { MWAIT_BAR(1); } else { MWAIT_BAR(0); } } while (0)
    for (; t + 1 < NT; t += 2) {
        MSTEP(pB0, pB1, pA0, pA1, t, true, (t + 3 < NT), (t + 1 < NT), (t + 1 < NT));         MENDW(t);     MRESC(t + 1); MROT();
        MSTEP(pA0, pA1, pB0, pB1, t + 1, true, (t + 4 < NT), (t + 2 < NT), (t + 2 < NT));     MENDW(t + 1); MRESC(t + 2); MROT();
    }
    MSTEP(pB0, pB1, pA0, pA1, NT - 1, true, false, false, false); MRESC(NT - 1);
    { float sacc = pB0[0] + pB0[1];
#pragma unroll
      for (int r = 2; r < 16; ++r) sacc += pB0[r];
#pragma unroll
      for (int r = 0; r < 16; ++r) sacc += pB1[r];
      l_reg += sacc;
      pw0 = (u32x4){MPKW(pB0, 0), MPKW(pB0, 2), MPKW(pB0, 4), MPKW(pB0, 6)}; pw1 = (u32x4){MPKW(pB0, 8), MPKW(pB0, 10), MPKW(pB0, 12), MPKW(pB0, 14)};
      pw2 = (u32x4){MPKW(pB1, 0), MPKW(pB1, 2), MPKW(pB1, 4), MPKW(pB1, 6)}; pw3 = (u32x4){MPKW(pB1, 8), MPKW(pB1, 10), MPKW(pB1, 12), MPKW(pB1, 14)};
      const ALDS char* vp_ = vp0 + sl_cur * MSLOT;
#pragma unroll
      for (int i = 0; i < 8; ++i) MVRD(i);
      o[0] = MMFMA(MPAF(0), MVFR(0), o[0]); o[1] = MMFMA(MPAF(0), MVFR(4), o[1]); o[0] = MMFMA(MPAF(1), MVFR(1), o[0]); o[1] = MMFMA(MPAF(1), MVFR(5), o[1]);
      o[0] = MMFMA(MPAF(2), MVFR(2), o[0]); o[1] = MMFMA(MPAF(2), MVFR(6), o[1]); o[0] = MMFMA(MPAF(3), MVFR(3), o[0]); o[1] = MMFMA(MPAF(3), MVFR(7), o[1]); }
    { auto rr = __builtin_amdgcn_permlane32_swap(__float_as_uint(l_reg), __float_as_uint(l_reg), false, false); l_reg = __uint_as_float(rr[0]) + __uint_as_float(rr[1]); }
    if (hi == 0) wsf[32 + r32] = l_reg; asm volatile("s_waitcnt lgkmcnt(0)" ::: "memory");
    float rli[16];
#pragma unroll
    for (int r = 0; r < 16; ++r) rli[r] = __builtin_amdgcn_rcpf(wsf[32 + crow(r, hi)]);
    { ALDS unsigned short* stg = (ALDS unsigned short*)(lds + N_OST) + wid * 2048;
#pragma unroll
      for (int r = 0; r < 16; ++r) { const int orow = crow(r, hi);
#pragma unroll
          for (int d0 = 0; d0 < 2; ++d0) stg[orow * 64 + d0 * 32 + r32] = (unsigned short)(cvtpk(o[d0][r] * rli[r], 0.f) & 0xffffu); }
      asm volatile("s_waitcnt lgkmcnt(0)" ::: "memory");
      bf16_t* Ow = Op + (size_t)(qb * 256 + wid * 32) * ldo;
#pragma unroll
      for (int i = 0; i < 4; ++i) { const int row = i * 8 + (lane >> 3), ch = lane & 7; const u32x4 v = *(ALDS const u32x4*)(stg + row * 64 + ch * 8); *(u32x4*)(Ow + (size_t)row * ldo + ch * 8) = v; } }
    asm volatile("s_waitcnt lgkmcnt(0)\n\ts_barrier" ::: "memory");
#undef MDMA_K
#undef MDMA_V
#undef MCM
#undef MROT
#undef MEX
#undef MRESC
#undef MDECIDE
#undef MPKW
#undef MPAF
#undef MVFR
#undef MVRD
#undef MKRD
#undef MGAPA
#undef MGAPB
#undef MSTEP
#undef MENDW
#undef MGAPA2
#undef MREL
}
#undef ASBAR
}
#define GAS __attribute__((address_space(1)))
#define LAS __attribute__((address_space(3)))
typedef unsigned short bf16;
typedef unsigned v4u __attribute__((ext_vector_type(4)));
typedef float f32x4 __attribute__((ext_vector_type(4)));
typedef short bf16x8 __attribute__((ext_vector_type(8)));
typedef GAS unsigned gu32;
typedef GAS unsigned long long gu64;
#define RLX_AGENT __ATOMIC_RELAXED, __HIP_MEMORY_SCOPE_AGENT
#define LDS_WAIT() asm volatile("s_waitcnt lgkmcnt(0)" ::: "memory")
#define VM_WAIT() asm volatile("s_waitcnt vmcnt(0)" ::: "memory")
__device__ __forceinline__ unsigned long long rt() { return __builtin_amdgcn_s_memrealtime(); }
__device__ __forceinline__ unsigned f2bf(float f) { unsigned u = __builtin_bit_cast(unsigned, f); return (u + 0x7fffu + ((u >> 16) & 1u)) >> 16; }
__device__ __forceinline__ unsigned pk2(float lo, float hi) { return f2bf(lo) | (f2bf(hi) << 16); }

#define XB_TMO      128
#define XB_XCNT(j)  (256  + 64 * (j))
#define XB_XSUB(j)  (1280 + 64 * (j))
#define XB_XGEN(j)  (2304 + 64 * (j))
#define XB_TOP      3328
#define XB_TOPGEN   3392
#define XCD_BAR_WORDS 3456
#define XB_SPIN_CAP (1u << 18)

__device__ __forceinline__ unsigned xb_ld(unsigned* p)              { return __hip_atomic_load(p, __ATOMIC_RELAXED, __HIP_MEMORY_SCOPE_AGENT); }
__device__ __forceinline__ unsigned xb_add(unsigned* p, unsigned v) { return __hip_atomic_fetch_add(p, v, __ATOMIC_RELAXED, __HIP_MEMORY_SCOPE_AGENT); }
__device__ __forceinline__ unsigned xb_xcc_id() { return (unsigned)__builtin_amdgcn_s_getreg((3 << 11) | 20) & 0xFu; }
#define XB_SPIN(cond, bar) do { unsigned _sp = 0; while (cond) { __builtin_amdgcn_s_sleep(1); \
    if ((++_sp & 255u) == 0u) { if (xb_ld(&(bar)[XB_TMO])) break; if (_sp > XB_SPIN_CAP) { atomicAdd(&(bar)[XB_TMO], 1u); break; } } } } while (0)

struct XcdBarrier {
    unsigned* bar; unsigned x;
    volatile LAS unsigned* st;
};

__device__ __forceinline__ XcdBarrier xcd_barrier_post(unsigned* bar, volatile LAS unsigned* st) {
    XcdBarrier b; b.bar = bar; b.x = xb_xcc_id(); b.st = st;
    if (threadIdx.x == 0) (void)xb_add(&bar[XB_XCNT(b.x)], 1u);
    return b;
}
__device__ __forceinline__ void xcd_barrier_complete(unsigned* bar, unsigned x, unsigned& nloc, unsigned& nx) {
    const unsigned G = gridDim.x * gridDim.y * gridDim.z;
    unsigned sum, cnt, mine, sp = 0u;
    for (;;) {
        sum = 0u; cnt = 0u; mine = 0u;
#pragma unroll
        for (unsigned j = 0; j < 16; ++j) { const unsigned c = xb_ld(&bar[XB_XCNT(j)]); sum += c; cnt += (c > 0u) ? 1u : 0u; mine = (j == x) ? c : mine; }
        if (sum == G) break;
        __builtin_amdgcn_s_sleep(1);
        if ((++sp & 255u) == 0u) { if (xb_ld(&bar[XB_TMO])) break; if (sp > XB_SPIN_CAP) { atomicAdd(&bar[XB_TMO], 1u); break; } }
    }
    nloc = mine > 0u ? mine : 1u; nx = cnt > 0u ? cnt : 1u;
}

__device__ __forceinline__ void xcd_barrier(const XcdBarrier& b) {
    asm volatile("s_waitcnt vmcnt(0)" ::: "memory");
    __syncthreads();
    if (threadIdx.x == 0) {
        unsigned* bar = b.bar;
        __builtin_amdgcn_s_waitcnt(0);
        unsigned nloc = b.st[0], nx = b.st[1];
        if (nloc == 0u) { xcd_barrier_complete(bar, b.x, nloc, nx); b.st[0] = nloc; b.st[1] = nx; }
        const unsigned old = xb_add(&bar[XB_XSUB(b.x)], 1u);
        const unsigned gen = old / nloc;
        if (old + 1u == (gen + 1u) * nloc) {
            __builtin_amdgcn_fence(__ATOMIC_RELEASE, "agent");
            asm volatile("s_waitcnt vmcnt(0)" ::: "memory");
            const unsigned og = xb_add(&bar[XB_TOP], 1u);
            const unsigned tg = og / nx;
            if (og + 1u == (tg + 1u) * nx) xb_add(&bar[XB_TOPGEN], 1u);
            else XB_SPIN(xb_ld(&bar[XB_TOPGEN]) == tg, bar);
            __builtin_amdgcn_fence(__ATOMIC_ACQUIRE, "agent");
            xb_add(&bar[XB_XGEN(b.x)], 1u);
            asm volatile("s_waitcnt vmcnt(0)" ::: "memory");
        } else {
            XB_SPIN(xb_ld(&bar[XB_XGEN(b.x)]) == gen, bar);
            __builtin_amdgcn_fence(__ATOMIC_ACQUIRE, "agent");
            asm volatile("s_waitcnt vmcnt(0)" ::: "memory");
        }
    }
    __syncthreads();
}

constexpr size_t MiB = 1u << 20;
constexpr size_t WS_CTL = 0, CTL_ZERO_BYTES = 64 * 1024;
constexpr size_t WS_ROPEA = 1 * MiB, WS_ROPEB = 5 * MiB;
constexpr size_t WS_SS = 13 * MiB, WS_SS2 = 16 * MiB, WS_SS3 = 20 * MiB;
constexpr size_t WS_WIN = 24 * MiB, WS_WUQ = 34 * MiB, WS_WUKV = 35 * MiB, WS_WA = 36 * MiB, WS_WOUT = 39 * MiB, WS_WUP = 42 * MiB, WS_WDN = 51 * MiB;
constexpr size_t WS_H = 64 * MiB;
constexpr size_t WS_G = 208 * MiB;
constexpr size_t WS_QA = 464 * MiB, WS_KA = 528 * MiB, WS_VA = 592 * MiB;
constexpr size_t WS_T = WS_KA;
constexpr size_t WS_CQ = 672 * MiB, WS_CKV = 720 * MiB;
constexpr size_t WS_KR = 760 * MiB;
constexpr size_t WS_QB = 768 * MiB, WS_KB = 864 * MiB, WS_VB = 928 * MiB;
constexpr size_t WS_Y = WS_QB;
constexpr size_t WS_X1 = 896 * MiB;
constexpr size_t WS_H8 = WS_QB;
constexpr size_t WS_WG8 = 60 * MiB;
constexpr size_t WS_U = 208 * MiB;
constexpr size_t WS_END = 1024 * MiB;
static_assert(WS_H + (size_t)MTOK * LDH * 2 <= WS_G && WS_G + (size_t)MTOK * 2 * DM * 2 <= WS_QA && WS_T + (size_t)MTOK * LDH * 2 <= WS_CQ && WS_CQ + (size_t)MTOK * QLORA * 2 <= WS_CKV && WS_CKV + (size_t)MTOK * LDKV * 2 <= WS_KR, "d_ws map");
static_assert(WS_U + (size_t)MTOK * LDU * 2 <= WS_KR && WS_Y + (size_t)MTOK * DM * 2 <= WS_X1 && WS_X1 + (size_t)MTOK * DM * 2 <= WS_END && WS_VB + (size_t)MTOK * AW * 2 <= WS_END && WS_KR + (size_t)MTOK * RDIM * 2 <= WS_QB, "d_ws map");
static_assert(WS_WIN + (size_t)INWP * LDH * 2 <= WS_WUQ && WS_WUKV + (size_t)1024 * LDKV * 2 <= WS_WA && WS_WA + (size_t)DM * LDH * 2 <= WS_WOUT && WS_WOUT + (size_t)DM * LDH * 2 <= WS_WUP && WS_WUP + (size_t)DFF * LDH * 2 <= WS_WDN && WS_WDN + (size_t)DM * LDU * 2 <= WS_H, "d_ws map");
constexpr int CW_BAR = 0;
constexpr int NWAVES = 8;
constexpr int RING_OFF = 0, RING_BYTES = 131072;
constexpr int LDSCTL_OFF = RING_BYTES, MISC_OFF = LDSCTL_OFF + 320;
constexpr int LDS_BYTES = 147456;
static_assert(att::L_END <= RING_BYTES, "attention LDS map");

struct Frame {
    LAS unsigned char* lds;
    volatile LAS unsigned* MISC;
    gu32* ctl;
    int tid, lane, wave, vcu, G;
};

__device__ __forceinline__ float wave_sum(float v) {
#pragma unroll
    for (int o = 1; o < 64; o <<= 1) v += __shfl_xor(v, o);
    return v;
}
__device__ __forceinline__ int srccol(int mat, int n) {
    if (mat == 0) {
        if (n < 1024) { const int sect = n >> 9, c = n & 511, head = c >> 6, p = c & 63; const int d = (p < 16) ? ((p >> 1) + 8 * (p & 1)) : p; return sect * 512 + head * 64 + d; }
        if (n < 1920) return n;
        if (n < 1952) { const int pr = n - 1920; return 2176 + (pr >> 1) + 16 * (pr & 1); }
        if (n < 2048) return -1;
        if (n < 2304) return 1920 + (n - 2048);
        return 2208 + (n - 2304);
    }
    if (mat == 1) { const int head = n / QKB, p = n - head * QKB; if (p < 64) return n; const int pr = p - 64; return head * QKB + 64 + (pr >> 1) + 16 * (pr & 1); }
    return n;
}
__device__ __forceinline__ void p0_transpose_item(const float* W, int K, int Nsrc, int Ndst, bf16* WT, int ldw, int koff, const float* gs, int mat, LAS float* scr, int item, int lane) {
    const int nblk = Ndst / 32, kb = item / nblk, nb = item % nblk, k0 = 64 * kb, n0 = 32 * nb;
    const int sc = srccol(mat, n0 + (lane & 31));
#pragma unroll
    for (int i = 0; i < 32; ++i) { const int kk = 2 * i + (lane >> 5); float v = (sc >= 0) ? W[(size_t)(k0 + kk) * Nsrc + sc] : 0.f; if (gs) v *= gs[k0 + kk]; scr[kk * 33 + (lane & 31)] = v; }
    LDS_WAIT(); asm volatile("" ::: "memory");
    const int c = lane & 7;
#pragma unroll
    for (int j = 0; j < 4; ++j) { const int n = (lane >> 3) + 8 * j; const LAS float* s = scr + (8 * c) * 33 + n;
        v4u o; o.x = pk2(s[0 * 33], s[1 * 33]); o.y = pk2(s[2 * 33], s[3 * 33]); o.z = pk2(s[4 * 33], s[5 * 33]); o.w = pk2(s[6 * 33], s[7 * 33]);
        *(GAS v4u*)(WT + (size_t)(n0 + n) * ldw + koff + k0 + 8 * c) = o; }
    LDS_WAIT(); asm volatile("" ::: "memory");
}
__device__ __forceinline__ int ppos_dn(int c) { return (c & ~255) | (((c >> 5) & 3) << 6) | (((c >> 3) & 3) << 4) | (((c >> 7) & 1) << 3) | (c & 7); }
template <bool KPERM = false>
__device__ __forceinline__ void p0_transpose_item_f8(const float* W, int K, int N, int Nsrc, int coff, unsigned char* WT, float scale, LAS float* scr, int item, int lane) {
    const int nblk = N / 32, kb = item / nblk, nb = item % nblk, k0 = 64 * kb, n0 = 32 * nb;
#pragma unroll
    for (int i = 0; i < 32; ++i) { const int kk = 2 * i + (lane >> 5); scr[kk * 33 + (lane & 31)] = W[(size_t)(k0 + kk) * Nsrc + coff + n0 + (lane & 31)] * scale; }
    LDS_WAIT(); asm volatile("" ::: "memory");
    const int c = lane & 7;
#pragma unroll
    for (int j = 0; j < 4; ++j) { const int n = (lane >> 3) + 8 * j; const LAS float* s = scr + (8 * c) * 33 + n;
        int w0 = 0, w1 = 0;
        w0 = __builtin_amdgcn_cvt_pk_fp8_f32(s[0 * 33], s[1 * 33], w0, false); w0 = __builtin_amdgcn_cvt_pk_fp8_f32(s[2 * 33], s[3 * 33], w0, true);
        w1 = __builtin_amdgcn_cvt_pk_fp8_f32(s[4 * 33], s[5 * 33], w1, false); w1 = __builtin_amdgcn_cvt_pk_fp8_f32(s[6 * 33], s[7 * 33], w1, true);
        typedef int i32x2_ __attribute__((ext_vector_type(2)));
        *(GAS i32x2_*)(WT + (size_t)(n0 + n) * K + (KPERM ? ppos_dn(k0 + 8 * c) : k0 + 8 * c)) = (i32x2_){w0, w1}; }
    LDS_WAIT(); asm volatile("" ::: "memory");
}
__device__ __forceinline__ void rms_row_to_bf16(int lane, const f32x4 (&v)[4], const f32x4 (&g)[4], bf16* orow, unsigned char* orow8) {
    float s = 0.f;
#pragma unroll
    for (int j = 0; j < 4; ++j) s += (v[j].x * v[j].x + v[j].y * v[j].y) + (v[j].z * v[j].z + v[j].w * v[j].w);
    const float rstd = 1.f / sqrtf(wave_sum(s) * (1.f / DM) + EPS);
    GAS unsigned long long* o8 = (GAS unsigned long long*)orow + lane;
#pragma unroll
    for (int j = 0; j < 4; ++j) { const f32x4 y = v[j] * rstd * g[j]; o8[64 * j] = (unsigned long long)pk2(y.x, y.y) | ((unsigned long long)pk2(y.z, y.w) << 32);
        int w = 0; w = __builtin_amdgcn_cvt_pk_fp8_f32(y.x, y.y, w, false); w = __builtin_amdgcn_cvt_pk_fp8_f32(y.z, y.w, w, true); ((GAS int*)orow8)[lane + 64 * j] = w; }
}

struct Args { const float* in[17]; float* out; unsigned char* ws; int ph_lo, ph_hi, li, pad; };

__global__ void __launch_bounds__(NWAVES * 64, 2) block_fwd(Args args) {
    extern __shared__ __attribute__((aligned(16))) unsigned char lds[];
    Frame F;
    F.lds = (LAS unsigned char*)lds;
    F.MISC = (volatile LAS unsigned*)(F.lds + MISC_OFF);
    F.tid = threadIdx.x; F.lane = F.tid & 63; F.wave = __builtin_amdgcn_readfirstlane(F.tid >> 6);
    F.G = gridDim.x; { const int bx = blockIdx.x; F.vcu = (F.G % 8 == 0) ? (bx % 8) * (F.G / 8) + bx / 8 : bx; }
    unsigned char* ws = args.ws;
    F.ctl = (gu32*)(ws + WS_CTL);
    const float* x = args.in[0]; const int* positions = (const int*)args.in[1];
    const float *g_pre_mix = args.in[2], *w_in = args.in[3], *b_gate = args.in[4], *g_q = args.in[5], *w_uq = args.in[6], *g_kv = args.in[7], *w_ukv = args.in[8], *w_a = args.in[9], *w_b = args.in[10],
                *w_out = args.in[11], *g_post_mix = args.in[12], *g_pre_mlp = args.in[13], *w_up = args.in[14], *w_dn = args.in[15], *g_post_mlp = args.in[16];
    float* out = args.out;
    float* ropeA = (float*)(ws + WS_ROPEA); float* ropeB = (float*)(ws + WS_ROPEB);
    float* SS = (float*)(ws + WS_SS); float* SS2 = (float*)(ws + WS_SS2); float* SS3 = (float*)(ws + WS_SS3);
    bf16 *WIN = (bf16*)(ws + WS_WIN), *WUQ = (bf16*)(ws + WS_WUQ), *WUKV = (bf16*)(ws + WS_WUKV), *WA = (bf16*)(ws + WS_WA), *WOUT = (bf16*)(ws + WS_WOUT), *WUP = (bf16*)(ws + WS_WUP), *WDN = (bf16*)(ws + WS_WDN);
    bf16 *H = (bf16*)(ws + WS_H), *Gt = (bf16*)(ws + WS_G), *QA = (bf16*)(ws + WS_QA), *KA = (bf16*)(ws + WS_KA), *VA = (bf16*)(ws + WS_VA), *T = (bf16*)(ws + WS_T), *CQ = (bf16*)(ws + WS_CQ), *CKV = (bf16*)(ws + WS_CKV),
         *KR = (bf16*)(ws + WS_KR), *QB = (bf16*)(ws + WS_QB), *KB = (bf16*)(ws + WS_KB), *VB = (bf16*)(ws + WS_VB), *Y = (bf16*)(ws + WS_Y), *U = (bf16*)(ws + WS_U), *X1B = (bf16*)(ws + WS_X1); unsigned char *H8 = ws + WS_H8, *WG8 = ws + WS_WG8;
    for (int u = F.tid; u < (LDS_BYTES - LDSCTL_OFF) / 4; u += NWAVES * 64) ((LAS unsigned*)(F.lds + LDSCTL_OFF))[u] = 0u;
    __syncthreads();
    XcdBarrier bar = xcd_barrier_post((unsigned*)(F.ctl + CW_BAR) + args.li * XCD_BAR_WORDS, F.MISC + 8);
    const int lo = args.ph_lo, hi = args.ph_hi;
#define IN(k) (lo <= (k) && (k) < hi)
#define SEAM(k) do { if (IN(k) && IN((k) + 1)) xcd_barrier(bar); } while (0)
    const int gw = F.vcu * NWAVES + F.wave, NGW = F.G * NWAVES;

#if !defined(SKIP_P0)
    if (IN(0))
    {
        LAS float* scr = (LAS float*)(F.lds + RING_OFF + F.wave * 16384);
        constexpr int NBF = 2304, IG = (DM / 64) * (2 * DM / 32);
        constexpr int I0 = (DM / 64) * (NBF / 32), I1 = (QLORA / 64) * (768 / 32), I2 = (KVLORA / 64) * (1024 / 32), I3 = (AW / 64) * (DM / 32), I5 = (DM / 64) * (DM / 32), I6 = (DM / 64) * (DFF / 32), I7 = (DFF / 64) * (DM / 32);
        constexpr int NITEMS = I0 + I1 + I2 + 2 * I3 + I5 + I6 + I7 + IG;
        constexpr int TW = 4, RW = NWAVES - TW;
        if (F.wave >= RW)
        for (int it = F.vcu * TW + (F.wave - RW); it < NITEMS; it += F.G * TW) {
            int r = it;
            if (r < I0) { p0_transpose_item(w_in, DM, INW, NBF, WIN, LDH, 0, nullptr, 0, scr, r, F.lane); continue; } r -= I0;
            if (r < IG) { p0_transpose_item_f8(w_in, DM, 2 * DM, INW, 2208, WG8, 32.f, scr, r, F.lane); continue; } r -= IG;
            if (r < I1) { p0_transpose_item(w_uq, QLORA, 768, 768, WUQ, QLORA, 0, g_q, 1, scr, r, F.lane); continue; } r -= I1;
            if (r < I2) { p0_transpose_item(w_ukv, KVLORA, 1024, 1024, WUKV, LDKV, 0, g_kv, 2, scr, r, F.lane); continue; } r -= I2;
            if (r < I3) { p0_transpose_item(w_a, AW, DM, DM, WA, LDH, 0, nullptr, 2, scr, r, F.lane); continue; } r -= I3;
            if (r < I3) { p0_transpose_item(w_b, AW, DM, DM, WA, LDH, AW, nullptr, 2, scr, r, F.lane); continue; } r -= I3;
            if (r < I5) { p0_transpose_item_f8<true>(w_out, DM, DM, DM, 0, (unsigned char*)WOUT, 32.f, scr, r, F.lane); continue; } r -= I5;
            if (r < I6) { p0_transpose_item_f8(w_up, DM, DFF, DFF, 0, (unsigned char*)WUP, 32.f, scr, r, F.lane); continue; } r -= I6;
            p0_transpose_item_f8<true>(w_dn, DFF, DM, DM, 0, (unsigned char*)WDN, 64.f, scr, r, F.lane);
        }
        if (F.wave >= RW)
        for (int idx = (int)blockIdx.x * (TW * 64) + (F.tid - RW * 64); idx < MTOK * 24; idx += F.G * TW * 64) {
            const int m = idx / 24, i = idx - m * 24;
            const float invf = (i < 8) ? __builtin_amdgcn_exp2f(-(float)i * 2.3664460711655217f) : __builtin_amdgcn_exp2f(-(float)(i - 8) * 1.1832230355827609f);
            const float ang = (float)positions[m] * invf;
            double t = (double)ang * 0.15915494309189535; t -= floor(t);
            const float tf = (float)t; const float c = __builtin_amdgcn_cosf(tf), s = __builtin_amdgcn_sinf(tf);
            float* dst = (i < 8) ? ropeA + (size_t)m * 16 + 2 * i : ropeB + (size_t)m * 32 + 2 * (i - 8);
            *(f32x2g*)dst = (f32x2g){c, s};
        }
        f32x4 g[4];
#pragma unroll
        for (int j = 0; j < 4; ++j) g[j] = ((const GAS f32x4*)g_pre_mix)[F.lane + 64 * j];
        {
            f32x4 cv[4], n1[4], n2[4];
            const int rw0 = (F.wave < RW) ? F.vcu * RW + F.wave : MTOK, RST = F.G * RW;
#define P0_LOADROW(V, mm) do { _Pragma("unroll") for (int j = 0; j < 4; ++j) V[j] = ((const GAS f32x4*)(x + (size_t)(mm) * DM) + F.lane)[64 * j]; } while (0)
            if (rw0 < MTOK) P0_LOADROW(cv, rw0);
            if (rw0 + RST < MTOK) P0_LOADROW(n1, rw0 + RST);
            for (int m = rw0; m < MTOK; m += RST) {
                if (m + 2 * RST < MTOK) P0_LOADROW(n2, m + 2 * RST);
                rms_row_to_bf16(F.lane, cv, g, H + (size_t)m * LDH, H8 + (size_t)m * DM);
#pragma unroll
                for (int j = 0; j < 4; ++j) { cv[j] = n1[j]; n1[j] = n2[j]; }
            }
#undef P0_LOADROW
        }
    }
#endif
    SEAM(0);

#if !defined(SKIP_P1)
    if (IN(1))
    {
        { pg8::Gemm g{H, WIN, MTOK, 2304, DM, LDH, LDH}; pg8::StaticOrder S; S.init(MTOK, 2304, F.G, (int)blockIdx.x);
          pg8::EpiIn E{QA, KA, VA, CQ, CKV, KR, Gt, SS, ropeA, ropeB, b_gate};
          pg8::gemm_phase<pg8::EpiIn, pg8::StaticOrder, true, true>(F.lds + RING_OFF, g, S, E); }
        { pg8::Gemm g{(const bf16*)H8, (const bf16*)WG8, MTOK, 2 * DM, DM, DM, DM}; pg8::StaticOrder S; S.init(MTOK, 2 * DM, F.G, (int)blockIdx.x);
          pg8::EpiGates E{Gt, b_gate};
          pg8::gemm_phase<pg8::EpiGates, pg8::StaticOrder, true, true, 1>(F.lds + RING_OFF, g, S, E); }
    }
#endif
    SEAM(1);

#if !defined(SKIP_P2)
    if (IN(2)) {
    {
        pg8::Gemm g{CQ, WUQ, MTOK, NHEAD * QKB, QLORA}; pg8::StaticOrder S; S.init(MTOK, NHEAD * QKB, F.G, (int)blockIdx.x);
        pg8::EpiQ E{QB, SS, ropeB};
        pg8::gemm_phase<pg8::EpiQ, pg8::StaticOrder, true, true, 2, true>(F.lds + RING_OFF, g, S, E);
    }
    {
        pg8::Gemm g{CKV, WUKV, MTOK, 2 * AW, KVLORA, LDKV, LDKV}; pg8::StaticOrder S; S.init(MTOK, 2 * AW, F.G, (int)blockIdx.x);
        pg8::EpiKV E{KB, VB, SS};
        pg8::gemm_phase<pg8::EpiKV, pg8::StaticOrder, true, true, 2, true>(F.lds + RING_OFF, g, S, E);
    }
    }
#endif
    SEAM(2);

#if !defined(SKIP_P3)
    if (IN(3))
    {
        LAS char* al = (LAS char*)(F.lds + RING_OFF);
#if !defined(SKIP_MOBA)
        for (int bh = F.vcu; bh < NB * NHEAD; bh += F.G) {
            const int b = bh >> 3, h = bh & 7; const size_t r0 = (size_t)b * SEQ;
            att::kmean_blocks(KA + r0 * AW + h * HD * 16, al);
#pragma unroll 1
            for (int qb = 0; qb < 8; ++qb) att::moba_unit(QA + r0 * AW + h * HD * 16, KA + r0 * AW + h * HD * 16, VA + r0 * AW + h * HD * 16, H + r0 * LDH + h * HD, LDH, qb, al);
        }
#endif
#if !defined(SKIP_MLA)
        for (int bh = F.vcu; bh < NB * NHEAD; bh += F.G) {
            const int b = bh >> 3, h = bh & 7; const size_t r0 = (size_t)b * SEQ;
#pragma unroll 1
            for (int qb = 0; qb < 8; ++qb) att::mla_unit(QB + r0 * (NHEAD * QKB) + h * QKB * 16, KB + r0 * AW + h * HD * 16, KR + r0 * RDIM, VB + r0 * AW + h * HD * 16, H + r0 * LDH + AW + h * HD, LDH, qb, al);
        }
#endif
    }
#endif
    SEAM(3);

#if !defined(SKIP_P4)
    if (IN(4))
    {
        pg8::Gemm g{H, WA, MTOK, DM, DM, LDH, LDH}; pg8::StaticOrder S; S.init(MTOK, DM, F.G, (int)blockIdx.x);
        pg8::EpiMerge E{Gt, T};
        pg8::gemm_phase<pg8::EpiMerge, pg8::StaticOrder, true, true>(F.lds + RING_OFF, g, S, E);
    }
#endif
    SEAM(4);

#if !defined(SKIP_P5)
    if (IN(5))
    {
        pg8::Gemm g{T, WOUT, MTOK, DM, DM, DM, DM}; pg8::StaticOrder S; S.init(MTOK, DM, F.G, (int)blockIdx.x);
        pg8::EpiSS E{Y, SS2, DM, 1.0f / 2048.0f};
        pg8::gemm_phase<pg8::EpiSS, pg8::StaticOrder, true, true, 1, true>(F.lds + RING_OFF, g, S, E);
    }
#endif
    SEAM(5);

#if !defined(SKIP_P6)
    if (IN(6))
    {
        f32x4 g1[4], g2[4];
#pragma unroll
        for (int j = 0; j < 4; ++j) { g1[j] = ((const GAS f32x4*)g_post_mix)[F.lane + 64 * j]; g2[j] = ((const GAS f32x4*)g_pre_mlp)[F.lane + 64 * j]; }
        f32x4 ca, cb, cc, cd, cx[4]; unsigned long long cy[4];
#define P6_LOAD(A, B, C, D, X, Yv, mm) do { const GAS f32x4* sp_ = (const GAS f32x4*)(SS2 + (size_t)(mm) * 16); A = sp_[0]; B = sp_[1]; C = sp_[2]; D = sp_[3]; \
            const GAS f32x4* xr_ = (const GAS f32x4*)(x + (size_t)(mm) * DM) + F.lane; const GAS unsigned long long* yr_ = (const GAS unsigned long long*)(Y + (size_t)(mm) * DM) + F.lane; \
            _Pragma("unroll") for (int j = 0; j < 4; ++j) { X[j] = xr_[64 * j]; Yv[j] = yr_[64 * j]; } } while (0)
        if (gw < MTOK) P6_LOAD(ca, cb, cc, cd, cx, cy, gw);
        for (int m = gw; m < MTOK; m += NGW) {
            f32x4 na, nb, nc, nd, nx[4]; unsigned long long ny[4];
            const bool more = m + NGW < MTOK;
            if (more) P6_LOAD(na, nb, nc, nd, nx, ny, m + NGW);
            const f32x4 a = ca, b = cb, c = cc, d = cd;
            const float ssy = (((a.x + a.y) + (a.z + a.w)) + ((b.x + b.y) + (b.z + b.w))) + (((c.x + c.y) + (c.z + c.w)) + ((d.x + d.y) + (d.z + d.w)));
            const float rsy = 1.f / sqrtf(ssy * (1.f / DM) + EPS);
            GAS unsigned long long* x8 = (GAS unsigned long long*)(X1B + (size_t)m * DM) + F.lane;
            f32x4 v[4]; float s = 0.f;
#pragma unroll
            for (int j = 0; j < 4; ++j) { const unsigned long long yw = cy[j]; const unsigned lo = (unsigned)yw, hi = (unsigned)(yw >> 32);
                const f32x4 yv = (f32x4){__uint_as_float(lo << 16), __uint_as_float(lo & 0xffff0000u), __uint_as_float(hi << 16), __uint_as_float(hi & 0xffff0000u)};
                v[j] = cx[j] + yv * rsy * g1[j]; x8[64 * j] = (unsigned long long)pk2(v[j].x, v[j].y) | ((unsigned long long)pk2(v[j].z, v[j].w) << 32);
                s += (v[j].x * v[j].x + v[j].y * v[j].y) + (v[j].z * v[j].z + v[j].w * v[j].w); }
            const float rstd = 1.f / sqrtf(wave_sum(s) * (1.f / DM) + EPS);
            GAS int* o8 = (GAS int*)((unsigned char*)H + (size_t)m * DM) + F.lane;
#pragma unroll
            for (int j = 0; j < 4; ++j) { const f32x4 y2 = v[j] * rstd * g2[j]; int w = 0; w = __builtin_amdgcn_cvt_pk_fp8_f32(y2.x, y2.y, w, false); w = __builtin_amdgcn_cvt_pk_fp8_f32(y2.z, y2.w, w, true); o8[64 * j] = w; }
            if (more) { ca = na; cb = nb; cc = nc; cd = nd;
#pragma unroll
                for (int j = 0; j < 4; ++j) { cx[j] = nx[j]; cy[j] = ny[j]; } }
        }
#undef P6_LOAD
    }
#endif
    SEAM(6);

#if !defined(SKIP_P7)
    if (IN(7))
    {
        pg8::Gemm g{H, WUP, MTOK, DFF, DM, DM, DM}; pg8::StaticOrder S; S.init(MTOK, DFF, F.G, (int)blockIdx.x);
        pg8::EpiRelu2F8 E{(unsigned char*)U, 1.0f / 32.0f};
        pg8::gemm_phase<pg8::EpiRelu2F8, pg8::StaticOrder, true, true, 1>(F.lds + RING_OFF, g, S, E);
    }
#endif
    SEAM(7);

#if !defined(SKIP_P8)
    if (IN(8))
    {
        pg8::Gemm g{U, WDN, MTOK, DM, DFF, DFF, DFF}; pg8::StaticOrder S; S.init(MTOK, DM, F.G, (int)blockIdx.x);
        pg8::EpiSS E{H, SS3, LDH, 1.0f / 64.0f};
        pg8::gemm_phase<pg8::EpiSS, pg8::StaticOrder, true, true, 1, true>(F.lds + RING_OFF, g, S, E);
    }
#endif
    SEAM(8);

#if !defined(SKIP_P9)
    if (IN(9))
    {
        f32x4 g1[4];
#pragma unroll
        for (int j = 0; j < 4; ++j) g1[j] = ((const GAS f32x4*)g_post_mlp)[F.lane + 64 * j];
        f32x4 ca, cb, cc, cd; unsigned long long cy[4], cq[4];
#define P9_LOAD(A, B, C, D, Yv, Q, mm) do { const GAS f32x4* sp_ = (const GAS f32x4*)(SS3 + (size_t)(mm) * 16); A = sp_[0]; B = sp_[1]; C = sp_[2]; D = sp_[3]; \
            const GAS unsigned long long* yr_ = (const GAS unsigned long long*)(H + (size_t)(mm) * LDH) + F.lane; const GAS unsigned long long* xq_ = (const GAS unsigned long long*)(X1B + (size_t)(mm) * DM) + F.lane; \
            _Pragma("unroll") for (int j = 0; j < 4; ++j) { Yv[j] = yr_[64 * j]; Q[j] = xq_[64 * j]; } } while (0)
        if (gw < MTOK) P9_LOAD(ca, cb, cc, cd, cy, cq, gw);
        for (int m = gw; m < MTOK; m += NGW) {
            f32x4 na, nb, nc, nd; unsigned long long ny[4], nq[4];
            const bool more = m + NGW < MTOK;
            if (more) P9_LOAD(na, nb, nc, nd, ny, nq, m + NGW);
            const f32x4 a = ca, b = cb, c = cc, d = cd;
            const float ssy = (((a.x + a.y) + (a.z + a.w)) + ((b.x + b.y) + (b.z + b.w))) + (((c.x + c.y) + (c.z + c.w)) + ((d.x + d.y) + (d.z + d.w)));
            const float rsy = 1.f / sqrtf(ssy * (1.f / DM) + EPS);
            GAS f32x4* o4 = (GAS f32x4*)(out + (size_t)m * DM) + F.lane;
#pragma unroll
            for (int j = 0; j < 4; ++j) { const unsigned long long yw = cy[j]; const unsigned lo = (unsigned)yw, hi = (unsigned)(yw >> 32);
                const f32x4 yv = (f32x4){__uint_as_float(lo << 16), __uint_as_float(lo & 0xffff0000u), __uint_as_float(hi << 16), __uint_as_float(hi & 0xffff0000u)};
                const unsigned long long xw = cq[j]; const unsigned xl = (unsigned)xw, xh = (unsigned)(xw >> 32);
                const f32x4 xv = (f32x4){__uint_as_float(xl << 16), __uint_as_float(xl & 0xffff0000u), __uint_as_float(xh << 16), __uint_as_float(xh & 0xffff0000u)};
                o4[64 * j] = xv + yv * rsy * g1[j]; }
            if (more) { ca = na; cb = nb; cc = nc; cd = nd;
#pragma unroll
                for (int j = 0; j < 4; ++j) { cy[j] = ny[j]; cq[j] = nq[j]; } }
        }
#undef P9_LOAD
    }
#endif
}

extern "C" void kernel_launch(void* const* d_in, const int* in_sizes, int n_in, void* d_out, int out_size, void* d_ws, size_t ws_size, hipStream_t stream) {
    static int grid = 0;
    if (grid == 0) {
        if (n_in != 17 || in_sizes[0] != MTOK * DM || out_size != MTOK * DM || ws_size < WS_END) { fprintf(stderr, "kernel_launch: unexpected shapes (n_in %d, in0 %d, out %d, ws %zu); nothing launched\n", n_in, n_in > 0 ? in_sizes[0] : -1, out_size, ws_size); grid = -1; return; }
        int dev = 0, cus = 0, per_cu = 0;
        if (hipGetDevice(&dev) != hipSuccess || hipDeviceGetAttribute(&cus, hipDeviceAttributeMultiprocessorCount, dev) != hipSuccess) { fprintf(stderr, "kernel_launch: device query failed\n"); grid = -1; return; }
        if (hipFuncSetAttribute((const void*)block_fwd, hipFuncAttributeMaxDynamicSharedMemorySize, LDS_BYTES) != hipSuccess) { fprintf(stderr, "kernel_launch: hipFuncSetAttribute failed\n"); grid = -1; return; }
        if (hipOccupancyMaxActiveBlocksPerMultiprocessor(&per_cu, (const void*)block_fwd, NWAVES * 64, LDS_BYTES) != hipSuccess || per_cu < 1) { fprintf(stderr, "kernel_launch: occupancy query reports %d workgroups per CU\n", per_cu); }
        (void)hipGetLastError();
        grid = cus;
    }
    if (grid < 0) return;
    if (hipMemsetAsync((char*)d_ws + WS_CTL, 0, CTL_ZERO_BYTES, stream) != hipSuccess) { fprintf(stderr, "kernel_launch: hipMemsetAsync failed\n"); return; }
    Args a{};
    for (int i = 0; i < 17; ++i) a.in[i] = (const float*)d_in[i];
    a.out = (float*)d_out; a.ws = (unsigned char*)d_ws;
    a.ph_lo = 0; a.ph_hi = 10; a.li = 0;
    hipLaunchKernelGGL(block_fwd, dim3(grid), dim3(NWAVES * 64), LDS_BYTES, stream, a);
    const hipError_t le = hipPeekAtLastError();
    if (le != hipSuccess) fprintf(stderr, "kernel_launch: launch failed: %s\n", hipGetErrorName(le));
}
```

```cpp
#include <hip/hip_runtime.h>
#include <hip/hip_bf16.h>
#include <cstdio>
#include <cstdint>
#include <cmath>
constexpr int NB = 32, SEQ = 2048, DM = 1024, MTOK = NB * SEQ;
constexpr int NHEAD = 8, HD = 64, AW = NHEAD * HD;
constexpr int QLORA = 384, KVLORA = 256, RDIM = 32, QKB = 96;
constexpr int DFF = 4096, INW = 4256, INWP = 4352;
constexpr int LDH = DM, LDU = DFF, LDKV = KVLORA;
constexpr float EPS = 1e-6f;
constexpr float LOG2E = 1.4426950408889634f;
constexpr float C2A = 0.125f * LOG2E;
constexpr float C2B = 0.10206207261596575f * LOG2E;
typedef float f32x2g __attribute__((ext_vector_type(2)));
namespace pg8 {
#define PG8_LAS __attribute__((address_space(3)))
typedef unsigned short bf16_t;
typedef short bf16x8 __attribute__((ext_vector_type(8)));
typedef float f32x4 __attribute__((ext_vector_type(4)));
typedef unsigned u32x4 __attribute__((ext_vector_type(4)));
constexpr int BM = 256, BK = 64, HALF = 128, HTB = HALF * BK * 2  , STAGE_BYTES = 8 * HTB, NXCD = 8, WGM = 8;

__host__ __device__ __forceinline__ int lds_byte(int r, int c) { const int st = (r >> 4) * 2 + (c >> 5), rr = r & 15, cc = c & 31, ob = rr * 64 + cc * 2; return st * 1024 + (ob ^ (((ob >> 9) & 1) << 5)); }
__host__ __device__ __forceinline__ void stage_rc(int b, int& R, int& C) { const int st = b / 1024, sb = b % 1024, swz = sb ^ (((sb >> 9) & 1) << 5); R = (st >> 1) * 16 + swz / 64; C = (st & 1) * 32 + (swz % 64) / 2; }
__host__ __device__ __forceinline__ int perm32(int rho) { const int n = rho >> 4, i = rho & 15; return 8 * (i >> 2) + 4 * n + (i & 3); }

struct Unit { int pm, pn; };
struct Gemm { const bf16_t* A; const bf16_t* Bt; int M, N, K, lda, ldb; };

struct StaticOrder {
    int nM, nN, nwg, G, c;
    __host__ __device__ void init(int M, int N, int G_, int c_) { nM = M / BM; nN = N / BM; nwg = nM * nN; G = G_; c = c_; }
    __host__ __device__ bool next(int i, Unit& u) const {
        const long L = (long)i * G + c; if (L >= nwg) return false;
        int wgid = (int)L; { const int q = nwg / NXCD, r = nwg % NXCD, xcd = wgid % NXCD, off = wgid / NXCD; wgid = (xcd < r ? xcd * (q + 1) : r * (q + 1) + (xcd - r) * q) + off; }
        const int nig = WGM * nN, gid = wgid / nig, fm = gid * WGM, gsz = (nM - fm) < WGM ? (nM - fm) : WGM;
        u.pm = fm + ((wgid % nig) % gsz); u.pn = (wgid % nig) / gsz; return true;
    }
    __device__ __forceinline__ void a_ready(const Unit&) const {}
    __device__ __forceinline__ void done(const Unit&) const {}
};

__device__ __forceinline__ unsigned cvt_pk_bf16(float lo, float hi) { unsigned r; asm volatile("v_cvt_pk_bf16_f32 %0, %1, %2" : "=v"(r) : "v"(lo), "v"(hi)); return r; }
__device__ __forceinline__ void ld8(float (&v)[8], const f32x4& a, const f32x4& b) { v[0] = a[0]; v[1] = a[1]; v[2] = a[2]; v[3] = a[3]; v[4] = b[0]; v[5] = b[1]; v[6] = b[2]; v[7] = b[3]; }
typedef float f32x2c_t __attribute__((ext_vector_type(2))); typedef __bf16 bf16x2c_t __attribute__((ext_vector_type(2)));
__device__ __forceinline__ unsigned cvtpk_c(float lo, float hi) { const f32x2c_t v = {lo, hi}; const bf16x2c_t b = __builtin_convertvector(v, bf16x2c_t); return __builtin_bit_cast(unsigned, b); }
__device__ __forceinline__ u32x4 pack8(const float (&v)[8]) { u32x4 w; w.x = cvtpk_c(v[0], v[1]); w.y = cvtpk_c(v[2], v[3]); w.z = cvtpk_c(v[4], v[5]); w.w = cvtpk_c(v[6], v[7]); return w; }
__device__ __forceinline__ void unpack8(const u32x4 w, float (&v)[8]) {
    v[0] = __uint_as_float(w.x << 16); v[1] = __uint_as_float(w.x & 0xffff0000u); v[2] = __uint_as_float(w.y << 16); v[3] = __uint_as_float(w.y & 0xffff0000u);
    v[4] = __uint_as_float(w.z << 16); v[5] = __uint_as_float(w.z & 0xffff0000u); v[6] = __uint_as_float(w.w << 16); v[7] = __uint_as_float(w.w & 0xffff0000u); }
__device__ __forceinline__ void rope4(float (&v)[8], const f32x4 a, const f32x4 b) {
    float x1, x2;
    x1 = v[0]; x2 = v[1]; v[0] = x1 * a[0] - x2 * a[1]; v[1] = x2 * a[0] + x1 * a[1];
    x1 = v[2]; x2 = v[3]; v[2] = x1 * a[2] - x2 * a[3]; v[3] = x2 * a[2] + x1 * a[3];
    x1 = v[4]; x2 = v[5]; v[4] = x1 * b[0] - x2 * b[1]; v[5] = x2 * b[0] + x1 * b[1];
    x1 = v[6]; x2 = v[7]; v[6] = x1 * b[2] - x2 * b[3]; v[7] = x2 * b[2] + x1 * b[3];
}
__device__ __forceinline__ float sumsq8(const float (&v)[8]) { return ((v[0] * v[0] + v[1] * v[1]) + (v[2] * v[2] + v[3] * v[3])) + ((v[4] * v[4] + v[5] * v[5]) + (v[6] * v[6] + v[7] * v[7])); }
__device__ __forceinline__ float red_fq(float s) { s += __shfl_xor(s, 16); s += __shfl_xor(s, 32); return s; }

__device__ __forceinline__ size_t chk_off(int r16, int c32, int ld) { return (size_t)r16 * ld + (size_t)c32 * 16; }
__device__ __forceinline__ size_t gfrag_off(int pm, int t8, int wid, int grp, int lane) { return ((((size_t)(pm * 8 + t8) * 8 + wid) * 16 + grp) * 64 + lane) * 8; }
struct EpiIn {
    static constexpr bool PERM = true, AFTER_DRAIN = false; static constexpr int MIDT = 0;
    bf16_t *QA, *KA, *VA, *CQ, *CKV, *KR, *G; float* SS; const float* ropeA; const float* ropeB; const float* bgate;
    __device__ __forceinline__ void operator()(const f32x4 (&acc)[2][2][4][2], const Unit& u, int wr, int wc, int fr, int fq) const {
        asm volatile("" : "+v"(fr), "+v"(fq));
        const int row0 = u.pm * BM + wr * 64 + fr, pn = u.pn, cl = wc * 32 + 8 * fq;
        if (pn < 4) {
            bf16_t* dst = (pn < 2) ? QA : KA; const float sc = (pn < 2) ? C2A : 1.f; const int cb = (pn & 1) * 256 + wc * 32, l8 = (fq * 16 + fr) * 8;
            if ((wc & 1) == 0) {
                const bool rp = fq < 2;
                f32x4 ta[2][4], tb[2][4];
#pragma unroll
                for (int m = 0; m < 4; ++m) { const f32x4* t = (const f32x4*)(ropeA + (size_t)(row0 + m * 16) * 16 + (rp ? fq * 8 : 0)); ta[0][m] = t[0]; tb[0][m] = t[1]; }
#pragma unroll
                for (int ai = 0; ai < 2; ++ai) {
                    if (ai == 0) {
#pragma unroll
                        for (int m = 0; m < 4; ++m) { const f32x4* t = (const f32x4*)(ropeA + (size_t)(row0 + HALF + m * 16) * 16 + (rp ? fq * 8 : 0)); ta[1][m] = t[0]; tb[1][m] = t[1]; } }
                    asm volatile("" ::: "memory");
#pragma unroll
                    for (int m = 0; m < 4; ++m) { const int row = row0 + ai * HALF + m * 16;
                        f32x4 ca = ta[ai][m], cc = tb[ai][m]; if (!rp) { ca = (f32x4){1.f, 0.f, 1.f, 0.f}; cc = ca; }
#pragma unroll
                        for (int bj = 0; bj < 2; ++bj) { float v[8]; ld8(v, acc[ai][bj][m][0], acc[ai][bj][m][1]); rope4(v, ca, cc);
#pragma unroll
                            for (int j = 0; j < 8; ++j) v[j] *= sc;
                            *(u32x4*)(dst + chk_off(row - fr, cb + bj * HALF, AW) + l8) = pack8(v); } } }
            } else {
#pragma unroll
                for (int ai = 0; ai < 2; ++ai)
#pragma unroll
                    for (int m = 0; m < 4; ++m) { const int row = row0 + ai * HALF + m * 16;
#pragma unroll
                        for (int bj = 0; bj < 2; ++bj) { float v[8]; ld8(v, acc[ai][bj][m][0], acc[ai][bj][m][1]);
#pragma unroll
                            for (int j = 0; j < 8; ++j) v[j] *= sc;
                            *(u32x4*)(dst + chk_off(row - fr, cb + bj * HALF, AW) + l8) = pack8(v); } }
            }
        } else if (pn < 6) {
            const int cb = (pn - 4) * 256 + wc * 32, l8 = (fq * 16 + fr) * 8;
#pragma unroll
            for (int ai = 0; ai < 2; ++ai)
#pragma unroll
                for (int m = 0; m < 4; ++m) { const int row = row0 + ai * HALF + m * 16;
#pragma unroll
                    for (int bj = 0; bj < 2; ++bj) { float v[8]; ld8(v, acc[ai][bj][m][0], acc[ai][bj][m][1]); *(u32x4*)(VA + chk_off(row - fr, cb + bj * HALF, AW) + l8) = pack8(v); } }
        } else if (pn == 6 || pn == 8) {
            bf16_t* dst = (pn == 6) ? CQ : CKV; const int ld = (pn == 6) ? QLORA : LDKV, slot = ((pn == 6) ? 0 : 8) + wc;
#pragma unroll
            for (int ai = 0; ai < 2; ++ai)
#pragma unroll
                for (int m = 0; m < 4; ++m) { const int row = row0 + ai * HALF + m * 16; float s = 0.f;
#pragma unroll
                    for (int bj = 0; bj < 2; ++bj) { float v[8]; ld8(v, acc[ai][bj][m][0], acc[ai][bj][m][1]); s += sumsq8(v); *(u32x4*)(dst + chk_off(row - fr, wc * 32 + bj * HALF, ld) + (fq * 16 + fr) * 8) = pack8(v); }
                    s = red_fq(s); if (fq == 0) SS[(size_t)row * 12 + slot] = s; }
        } else if (pn == 7) {
            f32x4 ta[2][4], tb[2][4];
            if (wc == 0) {
#pragma unroll
                for (int ai = 0; ai < 2; ++ai)
#pragma unroll
                    for (int m = 0; m < 4; ++m) { const f32x4* t = (const f32x4*)(ropeB + (size_t)(row0 + ai * HALF + m * 16) * 32 + fq * 8); ta[ai][m] = t[0]; tb[ai][m] = t[1]; } }
            asm volatile("" ::: "memory");
#pragma unroll
            for (int ai = 0; ai < 2; ++ai)
#pragma unroll
                for (int m = 0; m < 4; ++m) { const int row = row0 + ai * HALF + m * 16;
                    { float v[8]; ld8(v, acc[ai][0][m][0], acc[ai][0][m][1]); float s = red_fq(sumsq8(v)); *(u32x4*)(CQ + chk_off(row - fr, 256 + wc * 32, QLORA) + (fq * 16 + fr) * 8) = pack8(v); if (fq == 0) SS[(size_t)row * 12 + 4 + wc] = s; }
                    if (wc == 0) { float v[8]; ld8(v, acc[ai][1][m][0], acc[ai][1][m][1]); rope4(v, ta[ai][m], tb[ai][m]);
                        *(u32x4*)(KR + chk_off(row - fr, 0, RDIM) + (fq * 16 + fr) * 8) = pack8(v); } }
        }
    }
};
struct EpiGates {
    static constexpr bool PERM = true, AFTER_DRAIN = false; static constexpr int MIDT = 0;
    bf16_t* G; const float* bgate;
    __device__ __forceinline__ void operator()(const f32x4 (&acc)[2][2][4][2], const Unit& u, int wr, int wc, int fr, int fq) const {
        asm volatile("" : "+v"(fr), "+v"(fq));
        const int gc = u.pn * 256 + wc * 32 + 8 * fq;
        f32x4 bv[2][2];
#pragma unroll
        for (int bj = 0; bj < 2; ++bj)
#pragma unroll
            for (int n = 0; n < 2; ++n) bv[bj][n] = *(const f32x4*)(bgate + gc + bj * HALF + 4 * n);
#pragma unroll
        for (int ai = 0; ai < 2; ++ai)
#pragma unroll
            for (int m = 0; m < 4; ++m) {
#pragma unroll
                for (int bj = 0; bj < 2; ++bj) { float v[8]; ld8(v, acc[ai][bj][m][0] * (1.0f / 32.0f) + bv[bj][0], acc[ai][bj][m][1] * (1.0f / 32.0f) + bv[bj][1]);
#pragma unroll
                    for (int j = 0; j < 8; ++j) v[j] = __builtin_amdgcn_rcpf(1.f + __builtin_amdgcn_exp2f(-LOG2E * v[j]));
                    *(u32x4*)(G + gfrag_off(u.pm, u.pn, wr * 4 + wc, ai * 8 + m * 2 + bj, fq * 16 + fr)) = pack8(v); } }
    }
};
struct EpiQ {
    static constexpr bool PERM = true, AFTER_DRAIN = false; static constexpr int MIDT = 0;
    bf16_t* QB; const float* SS; const float* ropeB;
    __device__ __forceinline__ void operator()(const f32x4 (&acc)[2][2][4][2], const Unit& u, int wr, int wc, int fr, int fq) const {
        asm volatile("" : "+v"(fr), "+v"(fq));
        const int row0 = u.pm * BM + wr * 64 + fr, cl = u.pn * BM + wc * 32 + 8 * fq;
        const int c0 = cl, c1 = cl + HALF, h0 = c0 / QKB, h1 = c1 / QKB, p0 = c0 - h0 * QKB, p1 = c1 - h1 * QKB;
        const bool r0 = p0 >= 64, r1 = p1 >= 64; const int roff = r0 ? p0 - 64 : (r1 ? p1 - 64 : 0);
#pragma unroll
        for (int b = 0; b < 2; ++b) {
            f32x4 s0[4], s1[4], ta[4], tb[4];
#pragma unroll
            for (int m = 0; m < 4; ++m) { const int row = row0 + b * HALF + m * 16;
                const f32x4* sp = (const f32x4*)(SS + (size_t)row * 12); s0[m] = sp[0]; s1[m] = sp[1];
                const f32x4* t = (const f32x4*)(ropeB + (size_t)row * 32 + roff); ta[m] = t[0]; tb[m] = t[1]; }
            asm volatile("" ::: "memory");
#pragma unroll
            for (int m = 0; m < 4; ++m) { const int row = row0 + b * HALF + m * 16;
                const float ss = ((s0[m][0] + s0[m][1]) + (s0[m][2] + s0[m][3])) + ((s1[m][0] + s1[m][1]) + (s1[m][2] + s1[m][3]));
                const float rs = __builtin_amdgcn_rsqf(ss * (1.0f / QLORA) + EPS) * C2B;
#pragma unroll
                for (int bj = 0; bj < 2; ++bj) { float v[8]; ld8(v, acc[b][bj][m][0], acc[b][bj][m][1]);
#pragma unroll
                    for (int j = 0; j < 8; ++j) v[j] *= rs;
                    if (bj == 0 ? r0 : r1) rope4(v, ta[m], tb[m]);
                    *(u32x4*)(QB + chk_off(row - fr, (bj == 0 ? c0 : c1) - 8 * fq, NHEAD * QKB) + (fq * 16 + fr) * 8) = pack8(v); } }
        }
    }
};
struct EpiKV {
    static constexpr bool PERM = true, AFTER_DRAIN = false; static constexpr int MIDT = 0;
    bf16_t *KB, *VB; const float* SS;
    __device__ __forceinline__ void operator()(const f32x4 (&acc)[2][2][4][2], const Unit& u, int wr, int wc, int fr, int fq) const {
        asm volatile("" : "+v"(fr), "+v"(fq));
        const int row0 = u.pm * BM + wr * 64 + fr;
        bf16_t* dst = (wc < 2) ? KB : VB; const int pc = (wc & 1) * 32, l8 = (fq * 16 + fr) * 8;
        f32x4 s0[2][4];
#pragma unroll
        for (int ai = 0; ai < 2; ++ai)
#pragma unroll
            for (int m = 0; m < 4; ++m) s0[ai][m] = *(const f32x4*)(SS + (size_t)(row0 + ai * HALF + m * 16) * 12 + 8);
#pragma unroll
        for (int ai = 0; ai < 2; ++ai)
#pragma unroll
            for (int m = 0; m < 4; ++m) { const int row = row0 + ai * HALF + m * 16; const f32x4 sv = s0[ai][m];
                const float rs = __builtin_amdgcn_rsqf(((sv[0] + sv[1]) + (sv[2] + sv[3])) * (1.0f / KVLORA) + EPS);
#pragma unroll
                for (int bj = 0; bj < 2; ++bj) { const int hd = u.pn * 2 + bj;
                    float v[8]; ld8(v, acc[ai][bj][m][0], acc[ai][bj][m][1]);
#pragma unroll
                    for (int j = 0; j < 8; ++j) v[j] *= rs;
                    *(u32x4*)(dst + chk_off(row - fr, hd * HD + pc, AW) + l8) = pack8(v); } }
    }
};
struct EpiMerge {
    static constexpr bool PERM = true, AFTER_DRAIN = false; static constexpr int MIDT = 8;
    const bf16_t* G; bf16_t* T;
    __device__ __forceinline__ void mid(f32x4 (&acc)[2][2][4][2], const Unit& u, int wr, int wc, int fr, int fq) const {
        asm volatile("" : "+v"(fr), "+v"(fq));
        const bf16_t* pa = G + gfrag_off(u.pm, u.pn, wr * 4 + wc, 0, fq * 16 + fr); const bf16_t* pb = G + gfrag_off(u.pm, 4 + u.pn, wr * 4 + wc, 0, fq * 16 + fr);
        u32x4 ca[4], cb[4], na[4], nb[4];
#pragma unroll
        for (int i = 0; i < 4; ++i) { ca[i] = *(const u32x4*)(pa + (size_t)i * 512); cb[i] = *(const u32x4*)(pb + (size_t)i * 512); }
#pragma unroll
        for (int b = 0; b < 4; ++b) {
            if (b < 3) {
#pragma unroll
                for (int i = 0; i < 4; ++i) { na[i] = *(const u32x4*)(pa + (size_t)((b + 1) * 4 + i) * 512); nb[i] = *(const u32x4*)(pb + (size_t)((b + 1) * 4 + i) * 512); } }
            asm volatile("" ::: "memory");
#pragma unroll
            for (int i = 0; i < 4; ++i) { const int grp = b * 4 + i, ai = grp >> 3, m = (grp >> 1) & 3, bj = grp & 1; float ga[8], gb[8]; unpack8(ca[i], ga); unpack8(cb[i], gb);
#pragma unroll
                for (int j = 0; j < 8; ++j) ga[j] *= __builtin_amdgcn_rcpf(__builtin_fmaxf(gb[j], 1e-30f));
                acc[ai][bj][m][0] *= (f32x4){ga[0], ga[1], ga[2], ga[3]}; acc[ai][bj][m][1] *= (f32x4){ga[4], ga[5], ga[6], ga[7]}; }
#pragma unroll
            for (int i = 0; i < 4; ++i) { ca[i] = na[i]; cb[i] = nb[i]; }
        }
    }
    __device__ __forceinline__ void operator()(const f32x4 (&acc)[2][2][4][2], const Unit& u, int wr, int wc, int fr, int fq) const {
        asm volatile("" : "+v"(fr), "+v"(fq));
        unsigned char* base = (unsigned char*)T + ((size_t)(u.pm * 16 + wr * 4) * 16 + u.pn * 4 + wc) * 1024 + (unsigned)(fq * 16 + fr) * 16u;
        const bf16_t* pb = G + gfrag_off(u.pm, 4 + u.pn, wr * 4 + wc, 0, fq * 16 + fr);
        u32x4 cb[8], nb[8];
#pragma unroll
        for (int i = 0; i < 8; ++i) cb[i] = *(const u32x4*)(pb + (size_t)i * 512);
#pragma unroll
        for (int b = 0; b < 2; ++b) {
            if (b < 1) {
#pragma unroll
                for (int i = 0; i < 8; ++i) nb[i] = *(const u32x4*)(pb + (size_t)(8 + i) * 512); }
            asm volatile("" ::: "memory");
#pragma unroll
            for (int i2 = 0; i2 < 4; ++i2) { int w[4];
#pragma unroll
                for (int bj = 0; bj < 2; ++bj) { const int i = 2 * i2 + bj, grp = b * 8 + i, ai = grp >> 3, m = (grp >> 1) & 3; float v[8], gb[8]; ld8(v, acc[ai][bj][m][0], acc[ai][bj][m][1]); unpack8(cb[i], gb);
#pragma unroll
                    for (int j = 0; j < 8; ++j) v[j] = __builtin_fminf(__builtin_fmaxf(v[j] * (64.f * __builtin_fmaxf(gb[j], 1e-30f)), -448.f), 448.f);
                    int w0 = 0, w1 = 0;
                    w0 = __builtin_amdgcn_cvt_pk_fp8_f32(v[0], v[1], w0, false); w0 = __builtin_amdgcn_cvt_pk_fp8_f32(v[2], v[3], w0, true);
                    w1 = __builtin_amdgcn_cvt_pk_fp8_f32(v[4], v[5], w1, false); w1 = __builtin_amdgcn_cvt_pk_fp8_f32(v[6], v[7], w1, true);
                    w[2 * bj] = w0; w[2 * bj + 1] = w1; }
                typedef int i32x4m_ __attribute__((ext_vector_type(4)));
                *(i32x4m_*)(base + (size_t)(b * 8 + i2) * 16384) = (i32x4m_){w[0], w[1], w[2], w[3]}; }
#pragma unroll
            for (int i = 0; i < 8; ++i) cb[i] = nb[i];
        }
    }
};
struct EpiSS {
    static constexpr bool PERM = true, AFTER_DRAIN = false; static constexpr int MIDT = 0;
    bf16_t* Y; float* SSY; int ldy; float scale;
    __device__ __forceinline__ void operator()(const f32x4 (&acc)[2][2][4][2], const Unit& u, int wr, int wc, int fr, int fq) const {
        asm volatile("" : "+v"(fr), "+v"(fq));
        const int row0 = u.pm * BM + wr * 64 + fr, cl = u.pn * BM + wc * 32 + 8 * fq;
        const int lane_ = fq * 16 + fr, bpa = ((lane_ & 3) * 16 + (lane_ >> 2)) * 4; bf16_t* yst = Y + (size_t)(u.pm * BM + wr * 64 + (lane_ >> 2)) * ldy + u.pn * BM + wc * 32 + 8 * (lane_ & 3);
#pragma unroll
        for (int ai = 0; ai < 2; ++ai)
#pragma unroll
            for (int m = 0; m < 4; ++m) { const int row = row0 + ai * HALF + m * 16; float s = 0.f;
#pragma unroll
                for (int bj = 0; bj < 2; ++bj) { float v[8]; ld8(v, acc[ai][bj][m][0] * scale, acc[ai][bj][m][1] * scale); s += sumsq8(v); const u32x4 w_ = pack8(v); u32x4 t_;
                    t_.x = (unsigned)__builtin_amdgcn_ds_bpermute(bpa, (int)w_.x); t_.y = (unsigned)__builtin_amdgcn_ds_bpermute(bpa, (int)w_.y); t_.z = (unsigned)__builtin_amdgcn_ds_bpermute(bpa, (int)w_.z); t_.w = (unsigned)__builtin_amdgcn_ds_bpermute(bpa, (int)w_.w);
                    *(u32x4*)(yst + (size_t)(ai * HALF + m * 16) * ldy + bj * HALF) = t_; }
                s = red_fq(s); if (fq == 0) SSY[(size_t)row * 16 + u.pn * 4 + wc] = s; }
    }
};
struct EpiRelu2F8 {
    static constexpr bool PERM = true, AFTER_DRAIN = false; static constexpr int MIDT = 0;
    unsigned char* U; float scale;
    __device__ __forceinline__ void operator()(const f32x4 (&acc)[2][2][4][2], const Unit& u, int wr, int wc, int fr, int fq) const {
        asm volatile("" : "+v"(fr), "+v"(fq));
        unsigned char* base = U + ((size_t)(u.pm * 16 + wr * 4) * 64 + u.pn * 4 + wc) * 1024 + (unsigned)(fq * 16 + fr) * 16u;
#pragma unroll
        for (int ai = 0; ai < 2; ++ai)
#pragma unroll
            for (int m = 0; m < 4; ++m) { int w[4];
#pragma unroll
                for (int bj = 0; bj < 2; ++bj) { float v[8]; ld8(v, acc[ai][bj][m][0], acc[ai][bj][m][1]);
#pragma unroll
                    for (int j = 0; j < 8; ++j) { const float r = __builtin_fmaxf(v[j] * scale, 0.f); v[j] = __builtin_fminf(r * r, 440.f); }
                    int w0 = 0, w1 = 0;
                    w0 = __builtin_amdgcn_cvt_pk_fp8_f32(v[0], v[1], w0, false); w0 = __builtin_amdgcn_cvt_pk_fp8_f32(v[2], v[3], w0, true);
                    w1 = __builtin_amdgcn_cvt_pk_fp8_f32(v[4], v[5], w1, false); w1 = __builtin_amdgcn_cvt_pk_fp8_f32(v[6], v[7], w1, true);
                    w[2 * bj] = w0; w[2 * bj + 1] = w1; }
                typedef int i32x4e_ __attribute__((ext_vector_type(4)));
                *(i32x4e_*)(base + (size_t)(ai * 8 + m) * 65536) = (i32x4e_){w[0], w[1], w[2], w[3]}; }
    }
};
struct EpiRelu2 {
    static constexpr bool PERM = true, AFTER_DRAIN = false; static constexpr int MIDT = 0;
    bf16_t* U;
    __device__ __forceinline__ void operator()(const f32x4 (&acc)[2][2][4][2], const Unit& u, int wr, int wc, int fr, int fq) const {
        asm volatile("" : "+v"(fr), "+v"(fq));
        const int row0 = u.pm * BM + wr * 64 + fr, cl = u.pn * BM + wc * 32 + 8 * fq;
#pragma unroll
        for (int ai = 0; ai < 2; ++ai)
#pragma unroll
            for (int m = 0; m < 4; ++m) { const int row = row0 + ai * HALF + m * 16;
#pragma unroll
                for (int bj = 0; bj < 2; ++bj) { float v[8]; ld8(v, acc[ai][bj][m][0], acc[ai][bj][m][1]);
#pragma unroll
                    for (int j = 0; j < 8; ++j) { const float r = __builtin_fmaxf(v[j], 0.f); v[j] = r * r; }
                    *(u32x4*)(U + (size_t)row * LDU + cl + bj * HALF) = pack8(v); } }
    }
};
template <class Epi, class Sched, bool ALIGN_EPI = false, bool SP2 = false, int ESZ = 2, bool ACH = false>
__device__ __forceinline__ void gemm_phase(PG8_LAS unsigned char* lds, const Gemm g, const Sched& S, const Epi& E) {
    int tid_ = threadIdx.x; asm volatile("" : "+v"(tid_));
    const int tid = tid_, wid = __builtin_amdgcn_readfirstlane(tid >> 6), lane = tid & 63, wr = wid >> 2, wc = wid & 3, fr = lane & 15, fq = lane >> 4;
    const int K = g.K, nt = K * ESZ / (BK * 2), lda = g.lda ? g.lda : K, ldb = g.ldb ? g.ldb : K;
    unsigned voffA[2], voffB[2];
#pragma unroll
    for (int i = 0; i < 2; ++i) { int R, C; stage_rc(tid * 16 + i * 8192, R, C); const int Rb = Epi::PERM ? ((R & ~31) + perm32(R & 31)) : R;
        if constexpr (ACH) { const int st_ = (tid >> 6) + 8 * i; voffA[i] = (unsigned)((st_ >> 1) * 16 * lda * ESZ + (st_ & 1) * 1024 + (tid & 63) * 16); } else voffA[i] = (unsigned)(R * lda * ESZ + C * 2);
        voffB[i] = (unsigned)(Rb * ldb * ESZ + C * 2); }
    const size_t kstepB = (size_t)(BK * 2), kstepA = ACH ? (size_t)2048 : kstepB;
    const size_t hstepA = (size_t)HALF * lda * ESZ, hstepB = (size_t)HALF * ldb * ESZ;
    const size_t tstepA = 2 * hstepA, tstepB = 2 * hstepB;
    const unsigned ldsw = (unsigned)wid * 1024u;
    const int aoff = ACH ? wr * 8192 + lane * 16 : lds_byte(wr * 64 + fr, fq * 8), boff = lds_byte(wc * 32 + fr, fq * 8);
#define PG8_SA(b, h) (((b) * 2 + (h)) * HTB)
#define PG8_SB(b, h) ((4 + (b) * 2 + (h)) * HTB)
#define PG8_STAGE(bufoff, gbase, voff) do { _Pragma("unroll") for (int _i = 0; _i < 2; ++_i) \
        __builtin_amdgcn_global_load_lds((const unsigned*)((const char*)(gbase) + (voff)[_i]), (PG8_LAS unsigned*)(lds + (bufoff) + ldsw + _i * 8192), 16, 0, 0); } while (0)
#define PG8_LDA(dst, b, h) do { if constexpr (ESZ == 2) { _Pragma("unroll") for (int m = 0; m < 4; ++m) _Pragma("unroll") for (int k = 0; k < 2; ++k) dst[m][k] = *(const PG8_LAS bf16x8*)(lds + PG8_SA(b, h) + aoff + m * 2048 + k * 1024); } \
        else { _Pragma("unroll") for (int m = 0; m < 4; ++m) { dst##8[m].lo = *(const PG8_LAS i32x4_*)(lds + PG8_SA(b, h) + aoff + m * 2048); dst##8[m].hi = *(const PG8_LAS i32x4_*)(lds + PG8_SA(b, h) + aoff + m * 2048 + 1024); } } } while (0)
#define PG8_LDB(dst, b, h) do { if constexpr (ESZ == 2) { _Pragma("unroll") for (int n = 0; n < 2; ++n) _Pragma("unroll") for (int k = 0; k < 2; ++k) dst[n][k] = *(const PG8_LAS bf16x8*)(lds + PG8_SB(b, h) + boff + n * 2048 + k * 1024); } \
        else { _Pragma("unroll") for (int n = 0; n < 2; ++n) { dst##8[n].lo = *(const PG8_LAS i32x4_*)(lds + PG8_SB(b, h) + boff + n * 2048); dst##8[n].hi = *(const PG8_LAS i32x4_*)(lds + PG8_SB(b, h) + boff + n * 2048 + 1024); } } } while (0)
#define PG8_MMA(ai, bj, At, Bt) do { __builtin_amdgcn_s_setprio(1); \
        if constexpr (ESZ == 2) { _Pragma("unroll") for (int m = 0; m < 4; ++m) _Pragma("unroll") for (int n = 0; n < 2; ++n) _Pragma("unroll") for (int k = 0; k < 2; ++k) \
            acc[ai][bj][m][n] = __builtin_amdgcn_mfma_f32_16x16x32_bf16(Bt[n][k], At[m][k], acc[ai][bj][m][n], 0, 0, 0); } \
        else {   \
            _Pragma("unroll") for (int m = 0; m < 4; ++m) _Pragma("unroll") for (int n = 0; n < 2; ++n) \
                asm volatile("v_mfma_scale_f32_16x16x128_f8f6f4 %0, %1, %2, %0, %3, %3 op_sel_hi:[0,0,0]" : "+v"(acc[ai][bj][m][n]) : "v"(Bt##8[n]), "v"(At##8[m]), "v"(scl_)); } \
        __builtin_amdgcn_s_setprio(0); } while (0)
#define PG8_WAIT_V(n) asm volatile("s_waitcnt vmcnt(" #n ")" ::: "memory")
#define PG8_WAIT_L(n) asm volatile("s_waitcnt lgkmcnt(" #n ")" ::: "memory")
#define PG8_BAR __builtin_amdgcn_s_barrier()
#define PG8_SCHED __builtin_amdgcn_sched_barrier(0)
    Unit cur, nxt; int ui = 0;
    if (!S.next(0, cur)) return;
    f32x4 acc[2][2][4][2];
#pragma unroll
    for (int a = 0; a < 2; ++a)
#pragma unroll
        for (int b = 0; b < 2; ++b)
#pragma unroll
            for (int m = 0; m < 4; ++m)
#pragma unroll
                for (int n = 0; n < 2; ++n) acc[a][b][m][n] = (f32x4){0.f, 0.f, 0.f, 0.f};
    bf16x8 At[4][2], B0[2][2], B1[2][2];
    typedef int i32x4_ __attribute__((ext_vector_type(4))); typedef int i32x8_ __attribute__((ext_vector_type(8)));
    const int scl_ = 0x7F7F7F7F;
    i32x8_ At8[4], B08[2], B18[2];
    const char* cA = (const char*)g.A + (size_t)cur.pm * tstepA; const char* cB = (const char*)g.Bt + (size_t)cur.pn * tstepB;
    S.a_ready(cur);
    if constexpr (SP2) {
        PG8_STAGE(PG8_SB(0, 0), cB, voffB); PG8_STAGE(PG8_SB(0, 1), cB + hstepB, voffB); PG8_STAGE(PG8_SA(0, 0), cA, voffA); PG8_STAGE(PG8_SA(0, 1), cA + hstepA, voffA);
        if (wr == 1) PG8_BAR;
        PG8_WAIT_V(2); PG8_BAR;
        PG8_STAGE(PG8_SB(1, 0), cB + kstepB, voffB); PG8_STAGE(PG8_SA(1, 0), cA + kstepA, voffA); PG8_STAGE(PG8_SB(1, 1), cB + hstepB + kstepB, voffB);
        PG8_WAIT_V(6); PG8_BAR;
    } else {
        PG8_STAGE(PG8_SB(0, 0), cB, voffB); PG8_STAGE(PG8_SA(0, 0), cA, voffA); PG8_STAGE(PG8_SB(0, 1), cB + hstepB, voffB); PG8_STAGE(PG8_SA(0, 1), cA + hstepA, voffA);
        if (wr == 1) PG8_BAR;
        PG8_WAIT_V(4); PG8_BAR;
        PG8_STAGE(PG8_SB(1, 0), cB + kstepB, voffB); PG8_STAGE(PG8_SA(1, 0), cA + kstepA, voffA); PG8_STAGE(PG8_SB(1, 1), cB + hstepB + kstepB, voffB);
        PG8_WAIT_V(6); PG8_BAR;
    }
    for (;;) {
        const bool has_next = S.next(ui + 1, nxt);
        const char* nA = has_next ? (const char*)g.A + (size_t)nxt.pm * tstepA : cA; const char* nB = has_next ? (const char*)g.Bt + (size_t)nxt.pn * tstepB : cB;
#pragma unroll 1
        for (int t = 0; t < nt; t += 2) {
            if constexpr (Epi::MIDT > 0) { if (t == Epi::MIDT) E.mid(acc, cur, wr, wc, fr, fq); }
            const bool last = (t == nt - 2);
            const char* a1 = cA + (size_t)(t + 1) * kstepA;
            const char* a2 = last ? nA : cA + (size_t)(t + 2) * kstepA; const char* b2 = last ? nB : cB + (size_t)(t + 2) * kstepB;
            const char* a3 = a2 + kstepA; const char* b3 = b2 + kstepB;
            if (last && has_next) S.a_ready(nxt);
            if constexpr (SP2) {
            PG8_LDB(B0, 0, 0); PG8_LDB(B1, 0, 1); PG8_SCHED; PG8_LDA(At, 0, 0); PG8_STAGE(PG8_SA(1, 1), a1 + hstepA, voffA);
            PG8_WAIT_V(8); PG8_WAIT_L(0); PG8_BAR; PG8_MMA(0, 0, At, B0); PG8_MMA(0, 1, At, B1); PG8_BAR; PG8_SCHED;
            PG8_LDA(At, 0, 1); PG8_STAGE(PG8_SB(0, 0), b2, voffB); PG8_STAGE(PG8_SB(0, 1), b2 + hstepB, voffB); PG8_STAGE(PG8_SA(0, 0), a2, voffA);
            PG8_WAIT_V(8); PG8_WAIT_L(0); PG8_BAR; PG8_MMA(1, 0, At, B0); PG8_MMA(1, 1, At, B1); PG8_BAR; PG8_SCHED;
            PG8_LDB(B0, 1, 0); PG8_LDB(B1, 1, 1); PG8_SCHED; PG8_LDA(At, 1, 0); PG8_STAGE(PG8_SA(0, 1), a2 + hstepA, voffA);
            PG8_WAIT_V(8); PG8_WAIT_L(0); PG8_BAR; PG8_MMA(0, 0, At, B0); PG8_MMA(0, 1, At, B1); PG8_BAR; PG8_SCHED;
            PG8_LDA(At, 1, 1); PG8_STAGE(PG8_SB(1, 0), b3, voffB); PG8_STAGE(PG8_SB(1, 1), b3 + hstepB, voffB); PG8_STAGE(PG8_SA(1, 0), a3, voffA);
            PG8_WAIT_V(8); PG8_WAIT_L(0); PG8_BAR; PG8_MMA(1, 0, At, B0); PG8_MMA(1, 1, At, B1); PG8_BAR; PG8_SCHED;
            } else {
            PG8_LDB(B0, 0, 0); PG8_SCHED; PG8_LDA(At, 0, 0); PG8_STAGE(PG8_SA(1, 1), a1 + hstepA, voffA);
            PG8_WAIT_L(8); PG8_BAR; PG8_WAIT_L(0); PG8_MMA(0, 0, At, B0); PG8_BAR; PG8_SCHED;
            PG8_LDB(B1, 0, 1); PG8_STAGE(PG8_SB(0, 0), b2, voffB);
            PG8_BAR; PG8_WAIT_L(0); PG8_MMA(0, 1, At, B1); PG8_BAR;
            PG8_LDA(At, 0, 1); PG8_STAGE(PG8_SA(0, 0), a2, voffA);
            PG8_BAR; PG8_WAIT_L(0); PG8_MMA(1, 0, At, B0); PG8_BAR; PG8_SCHED;
            PG8_STAGE(PG8_SB(0, 1), b2 + hstepB, voffB);
            PG8_WAIT_V(6); PG8_BAR; PG8_MMA(1, 1, At, B1); PG8_BAR;
            PG8_LDB(B0, 1, 0); PG8_SCHED; PG8_LDA(At, 1, 0); PG8_STAGE(PG8_SA(0, 1), a2 + hstepA, voffA);
            PG8_WAIT_L(8); PG8_BAR; PG8_WAIT_L(0); PG8_MMA(0, 0, At, B0); PG8_BAR; PG8_SCHED;
            PG8_LDB(B1, 1, 1); PG8_STAGE(PG8_SB(1, 0), b3, voffB);
            PG8_BAR; PG8_WAIT_L(0); PG8_MMA(0, 1, At, B1); PG8_BAR;
            PG8_LDA(At, 1, 1); PG8_STAGE(PG8_SA(1, 0), a3, voffA);
            PG8_BAR; PG8_WAIT_L(0); PG8_MMA(1, 0, At, B0); PG8_BAR; PG8_SCHED;
            PG8_STAGE(PG8_SB(1, 1), b3 + hstepB, voffB);
            PG8_WAIT_V(6); PG8_BAR; PG8_MMA(1, 1, At, B1); PG8_BAR;
            }
        }
        if constexpr (ALIGN_EPI) { if (wr == 0) PG8_BAR; }
        if constexpr (ESZ == 1) asm volatile("s_nop 15\n\ts_nop 15" ::: "memory");
        if constexpr (!Epi::AFTER_DRAIN) { E(acc, cur, wr, wc, fr, fq); S.done(cur); }
        if (!has_next) break;
#pragma unroll
        for (int a = 0; a < 2; ++a)
#pragma unroll
            for (int b = 0; b < 2; ++b)
#pragma unroll
                for (int m = 0; m < 4; ++m)
#pragma unroll
                    for (int n = 0; n < 2; ++n) acc[a][b][m][n] = (f32x4){0.f, 0.f, 0.f, 0.f};
        cur = nxt; cA = nA; cB = nB; ++ui;
        if constexpr (ALIGN_EPI) { if (wr == 1) PG8_BAR; }
    }
    PG8_WAIT_V(0);
    if constexpr (!ALIGN_EPI) { if (wr == 0) PG8_BAR; }
    PG8_BAR;
    if constexpr (Epi::AFTER_DRAIN) { E.fused(acc, cur, wr, wc, fr, fq, lds, wid, lane); S.done(cur); }
#undef PG8_SA
#undef PG8_SB
#undef PG8_STAGE
#undef PG8_LDA
#undef PG8_LDB
#undef PG8_MMA
#undef PG8_WAIT_V
#undef PG8_WAIT_L
#undef PG8_BAR
#undef PG8_SCHED
}
}
#ifndef ATT_LSUM_MFMA
#define ATT_LSUM_MFMA 1
#endif
namespace att {
typedef unsigned short bf16_t;
typedef short bf16x8 __attribute__((ext_vector_type(8)));
typedef short s16x4 __attribute__((ext_vector_type(4)));
typedef float f32x16 __attribute__((ext_vector_type(16)));
typedef float f32x4 __attribute__((ext_vector_type(4)));
typedef unsigned u32x4 __attribute__((ext_vector_type(4)));
#define ALDS __attribute__((address_space(3)))
#define ASBAR() __builtin_amdgcn_sched_barrier(0)
constexpr int KTB = 12288, VTB = 8192;
constexpr int NSLOT = 3;
constexpr int L_K = 0, L_V = NSLOT * KTB, L_WS = L_V + NSLOT * VTB, L_OST = L_WS + 8 * 256, L_KM = L_OST + 8 * 4096, L_RED = L_KM + 2048, L_END = L_RED + 16384;
constexpr float THR = 8.f;
__device__ __forceinline__ int crow(int r, int hi) { return (r & 3) + 8 * (r >> 2) + 4 * hi; }
typedef float f32x2a_t __attribute__((ext_vector_type(2))); typedef __bf16 bf16x2a_t __attribute__((ext_vector_type(2)));
__device__ __forceinline__ unsigned cvtpk(float lo, float hi) { const f32x2a_t v = {lo, hi}; const bf16x2a_t b = __builtin_convertvector(v, bf16x2a_t); return __builtin_bit_cast(unsigned, b); }
__device__ __forceinline__ float bf2f(short s) { return __uint_as_float(((unsigned)(unsigned short)s) << 16); }
__device__ __forceinline__ int v_st(int k, int c) { const int kk = (k & ~0xC) | ((k & 4) << 1) | ((k & 8) >> 1); return ((kk >> 3) * 2 + (c >> 5)) * 512 + ((kk & 7) * 32 + (c & 31)) * 2; }
__device__ __forceinline__ int v_rd_base(int lane) { return ((lane & 3) << 3) | (((lane >> 2) & 3) << 6) | (((lane >> 4) & 1) << 5) | (((lane >> 5) & 1) << 8); }
constexpr int v_rd_off(int d0, int ks, int half) { return ks * 2048 + half * 1024 + d0 * 512; }
template <int OFF> __device__ __forceinline__ s16x4 tr_read(int vb) { s16x4 r; asm volatile("ds_read_b64_tr_b16 %0, %1 offset:%2" : "=&v"(r) : "v"(vb), "i"(OFF) : "memory"); return r; }
template <int D0> __device__ __forceinline__ void pv_one(f32x16& od, int vb, bf16x8 pa0, bf16x8 pa1, bf16x8 pa2, bf16x8 pa3) {
    const s16x4 l0 = tr_read<v_rd_off(D0, 0, 0)>(vb), h0 = tr_read<v_rd_off(D0, 0, 1)>(vb), l1 = tr_read<v_rd_off(D0, 1, 0)>(vb), h1 = tr_read<v_rd_off(D0, 1, 1)>(vb);
    const s16x4 l2 = tr_read<v_rd_off(D0, 2, 0)>(vb), h2 = tr_read<v_rd_off(D0, 2, 1)>(vb), l3 = tr_read<v_rd_off(D0, 3, 0)>(vb), h3 = tr_read<v_rd_off(D0, 3, 1)>(vb);
    asm volatile("s_waitcnt lgkmcnt(0)" ::: "memory"); ASBAR();
#define ATT_PK(L, H) (bf16x8){L[0], L[1], L[2], L[3], H[0], H[1], H[2], H[3]}
    od = __builtin_amdgcn_mfma_f32_32x32x16_bf16(pa0, ATT_PK(l0, h0), od, 0, 0, 0);
    od = __builtin_amdgcn_mfma_f32_32x32x16_bf16(pa1, ATT_PK(l1, h1), od, 0, 0, 0);
    od = __builtin_amdgcn_mfma_f32_32x32x16_bf16(pa2, ATT_PK(l2, h2), od, 0, 0, 0);
    od = __builtin_amdgcn_mfma_f32_32x32x16_bf16(pa3, ATT_PK(l3, h3), od, 0, 0, 0);
#undef ATT_PK
}
__device__ __forceinline__ void pv_all(f32x16* o, f32x16& ol, int vb, bf16x8 pa0, bf16x8 pa1, bf16x8 pa2, bf16x8 pa3) {
    pv_one<0>(o[0], vb, pa0, pa1, pa2, pa3); pv_one<1>(o[1], vb, pa0, pa1, pa2, pa3);
#if ATT_LSUM_MFMA
    const bf16x8 ones = (bf16x8){0x3F80, 0x3F80, 0x3F80, 0x3F80, 0x3F80, 0x3F80, 0x3F80, 0x3F80};
    ol = __builtin_amdgcn_mfma_f32_32x32x16_bf16(pa0, ones, ol, 0, 0, 0); ol = __builtin_amdgcn_mfma_f32_32x32x16_bf16(pa1, ones, ol, 0, 0, 0);
    ol = __builtin_amdgcn_mfma_f32_32x32x16_bf16(pa2, ones, ol, 0, 0, 0); ol = __builtin_amdgcn_mfma_f32_32x32x16_bf16(pa3, ones, ol, 0, 0, 0);
#endif
}
__device__ __forceinline__ void partialSM(f32x16& p0, f32x16& p1, float& m_ref, f32x16& negm, float& alpha) {
    float pmax = p0[0];
#pragma unroll
    for (int r = 1; r < 16; ++r) pmax = fmaxf(pmax, p0[r]);
#pragma unroll
    for (int r = 0; r < 16; ++r) pmax = fmaxf(pmax, p1[r]);
    { auto rr = __builtin_amdgcn_permlane32_swap(__float_as_uint(pmax), __float_as_uint(pmax), false, false); pmax = fmaxf(__uint_as_float(rr[0]), __uint_as_float(rr[1])); }
    alpha = 1.f;
    if (__builtin_expect(!__all(pmax <= THR), 0)) { const float dl = (pmax > THR) ? pmax : 0.f; m_ref += dl; alpha = __builtin_amdgcn_exp2f(-dl);
#pragma unroll
        for (int r = 0; r < 16; ++r) { p0[r] -= dl; p1[r] -= dl; negm[r] = -m_ref; } }
#pragma unroll
    for (int r = 0; r < 16; ++r) p0[r] = __builtin_amdgcn_exp2f(p0[r]);
}
__device__ __forceinline__ void finishSM(f32x16& p0, f32x16& p1, bf16x8& pa0, bf16x8& pa1, bf16x8& pa2, bf16x8& pa3, float& lsum) {
#pragma unroll
    for (int r = 0; r < 16; ++r) p1[r] = __builtin_amdgcn_exp2f(p1[r]);
#if !ATT_LSUM_MFMA
    { float ps = 0.f;
#pragma unroll
      for (int r = 0; r < 16; ++r) ps += p0[r];
#pragma unroll
      for (int r = 0; r < 16; ++r) ps += p1[r];
      lsum += ps; }
#endif
#define ATT_PK4(P, BASE, OUT) do { unsigned a0 = cvtpk(P[BASE + 0], P[BASE + 1]), a1 = cvtpk(P[BASE + 2], P[BASE + 3]);   \
    unsigned b0 = cvtpk(P[BASE + 4], P[BASE + 5]), b1 = cvtpk(P[BASE + 6], P[BASE + 7]);                              \
    auto r0 = __builtin_amdgcn_permlane32_swap(a0, b0, false, false); auto r1 = __builtin_amdgcn_permlane32_swap(a1, b1, false, false); \
    u32x4 w = {r0[0], r1[0], r0[1], r1[1]}; OUT = __builtin_bit_cast(bf16x8, w); } while (0)
    ATT_PK4(p0, 0, pa0); ATT_PK4(p0, 8, pa1); ATT_PK4(p1, 0, pa2); ATT_PK4(p1, 8, pa3);
#undef ATT_PK4
}
template <int ND> __device__ __forceinline__ void qkt(f32x16& p0, f32x16& p1, ALDS const char* Kb, const int (&ka)[ND], const bf16x8 (&qr)[ND], const f32x16& cinit) {
#pragma unroll
    for (int d0 = 0; d0 < ND; ++d0) {
        const bf16x8 b0 = *(ALDS const bf16x8*)(Kb + ka[d0]);
        const bf16x8 b1 = *(ALDS const bf16x8*)(Kb + ka[d0] + (d0 < 4 ? 4096 : 2048));
        p0 = __builtin_amdgcn_mfma_f32_32x32x16_bf16(b0, qr[d0], d0 == 0 ? cinit : p0, 0, 0, 0);
        p1 = __builtin_amdgcn_mfma_f32_32x32x16_bf16(b1, qr[d0], d0 == 0 ? cinit : p1, 0, 0, 0);
        if (ND > 4 && d0 == 2) asm volatile("" ::: "memory"); }
}
__device__ __forceinline__ void cmask(f32x16& p0, f32x16& p1, int jt, int qrel, int hi) {
    const float NEG = -INFINITY; const int thr = qrel - 64 * jt - 4 * hi;
#pragma unroll
    for (int r = 0; r < 16; ++r) { if ((r & 3) + 8 * (r >> 2) > thr) p0[r] = NEG; if ((r & 3) + 8 * (r >> 2) + 32 > thr) p1[r] = NEG; }
}
__device__ __forceinline__ void kmean_blocks(const bf16_t* Kp, ALDS char* lds) {
    int tid_ = threadIdx.x; asm volatile("" : "+v"(tid_));
    const int tid = tid_, lane = tid & 63, wid = tid >> 6;
    ALDS float* red = (ALDS float*)(lds + L_RED); ALDS float* km = (ALDS float*)(lds + L_KM);
    bf16x8 kq[8][4];
#pragma unroll
    for (int n = 0; n < 8; ++n)
#pragma unroll
        for (int i = 0; i < 2; ++i)
#pragma unroll
            for (int cc = 0; cc < 2; ++cc) kq[n][i * 2 + cc] = *(const bf16x8*)(Kp + (size_t)(n * 256 + 128 * i + 16 * wid) * AW + cc * 512 + lane * 8);
#pragma unroll
    for (int n = 0; n < 8; ++n) {
        float a[16];
#pragma unroll
        for (int j = 0; j < 16; ++j) a[j] = 0.f;
#pragma unroll
        for (int i = 0; i < 2; ++i)
#pragma unroll
            for (int cc = 0; cc < 2; ++cc) { const bf16x8 kx = kq[n][i * 2 + cc];
#pragma unroll
                for (int j = 0; j < 8; ++j) a[cc * 8 + j] += bf2f(kx[j]); }
#pragma unroll
        for (int j = 0; j < 16; ++j) { a[j] += __shfl_xor(a[j], 1); a[j] += __shfl_xor(a[j], 2); a[j] += __shfl_xor(a[j], 4); a[j] += __shfl_xor(a[j], 8); }
        if ((lane & 15) == 0) {
#pragma unroll
            for (int j = 0; j < 16; ++j) red[(n * 8 + wid) * 64 + (j >> 3) * 32 + (lane >> 4) * 8 + (j & 7)] = a[j]; }
    }
    __syncthreads();
    { const int n = tid >> 6, d = tid & 63; float s = 0.f;
#pragma unroll
        for (int w = 0; w < 8; ++w) s += red[(n * 8 + w) * 64 + d];
        km[n * 64 + d] = s * (1.0f / 256.0f); }
    __syncthreads();
}
template <int DQK, bool MOBA>
__device__ __forceinline__ void attn_bh(const bf16_t* Qp, int ldq, const bf16_t* Kp, const bf16_t* KRp, const bf16_t* Vp, bf16_t* Op, int ldo, ALDS char* lds) {
    constexpr int ND = DQK / 16;
    ALDS char* K_lds = lds + L_K; ALDS char* V_lds = lds + L_V;
    bf16x8 sk0, sv0, sr0, sk1, sv1, sr1;
#define ATT_SLOAD(S, k0) do { sk##S = *(const bf16x8*)((const char*)(Kp + (size_t)(k0) * AW) + koff); sv##S = *(const bf16x8*)((const char*)(Vp + (size_t)(k0) * AW) + koff); if (DQK == 96) sr##S = *(const bf16x8*)((const char*)(KRp + (size_t)(k0) * RDIM) + roff); } while (0)
#define ATT_SWRITE(b, S) do { *(ALDS bf16x8*)(K_lds + (b) * KTB + kst) = sk##S; *(ALDS bf16x8*)(V_lds + (b) * VTB + vst) = sv##S; if (DQK == 96) { if (tid < 256) *(ALDS bf16x8*)(K_lds + (b) * KTB + rst) = sr##S; } } while (0)
#define ATT_QLOAD(q_) do { const bf16_t* Qw = Qp + (size_t)((q_) * 256 + wid * 32 + (r32 & 16)) * ldq + (r32 & 15) * 8 + hi * 128; _Pragma("unroll") for (int d0 = 0; d0 < ND; ++d0) qr[d0] = *(const bf16x8*)(Qw + (d0 >> 1) * 512 + (d0 & 1) * 256); } while (0)
    bf16x8 qr[ND];
    {
        const int tid = threadIdx.x, w_ = tid >> 6, l_ = tid & 63;
        const unsigned koff = (unsigned)((w_ >> 1) * 16 * AW + (w_ & 1) * 512 + l_ * 8) * 2u, roff = (unsigned)((w_ & 3) * 16 * RDIM + l_ * 8) * 2u;
        ATT_SLOAD(0, 0); ATT_SLOAD(1, 64); }
#pragma unroll 1
  for (int qb = 0; qb < 8; ++qb) {
    int tid_ = threadIdx.x; asm volatile("" : "+v"(tid_));
    const int tid = tid_, lane = tid & 63, r32 = lane & 31, hi = lane >> 5; const int wid = __builtin_amdgcn_readfirstlane(tid >> 6);
    ALDS float* al_l = (ALDS float*)(lds + L_WS) + wid * 64;
    const int skey = 16 * (wid >> 1) + (lane & 15), sch = 4 * (wid & 1) + (lane >> 4);
    const unsigned koff = (unsigned)((wid >> 1) * 16 * AW + (wid & 1) * 512 + lane * 8) * 2u;
    const int kst = skey * 128 + ((sch ^ ((skey >> 1) & 7)) << 4), vst = v_st(skey, sch * 8);
    const int rkey = 16 * (wid & 3) + (lane & 15), rch = lane >> 4;
    const unsigned roff = (unsigned)((wid & 3) * 16 * RDIM + lane * 8) * 2u;
    const int rst = 8192 + rkey * 64 + ((rch ^ ((rkey >> 2) & 3)) << 4);
    int ka[ND];
#pragma unroll
    for (int d0 = 0; d0 < ND; ++d0) ka[d0] = (d0 < 4) ? r32 * 128 + (((2 * d0 + hi) ^ ((r32 >> 1) & 7)) << 4) : 8192 + r32 * 64 + (((2 * (d0 - 4) + hi) ^ ((r32 >> 2) & 3)) << 4);
    const int vb0 = (int)(unsigned)(uintptr_t)V_lds + v_rd_base(lane);
    const int qrel = wid * 32 + r32;
    ATT_QLOAD(qb);
    float m_ref = 0.f, lsum = 0.f; f32x16 o[2], ol, negm; o[0] = f32x16{}; o[1] = f32x16{}; ol = f32x16{}; negm = f32x16{};
    unsigned sel = 0xffu;
    if (MOBA && qb > 3) {
        ALDS const float* km = (ALDS const float*)(lds + L_KM); float g[8];
#pragma unroll
        for (int n = 0; n < 8; ++n) { float s = 0.f;
#pragma unroll
            for (int d0 = 0; d0 < ND; ++d0)
#pragma unroll
                for (int j = 0; j < 8; ++j) s += bf2f(qr[d0][j]) * km[n * 64 + d0 * 16 + hi * 8 + j];
            g[n] = s; }
#pragma unroll
        for (int n = 0; n < 8; ++n) g[n] += __shfl_xor(g[n], 32);
        sel = 0u;
#pragma unroll
        for (int n = 0; n < 8; ++n) { int rank = 0;
#pragma unroll
            for (int mm = 0; mm < 8; ++mm) if (mm != n) rank += (mm < qb && (g[mm] > g[n] || (g[mm] == g[n] && mm < n))) ? 1 : 0;
            if (n < qb && rank < 3) sel |= 1u << n; }
    }
#define ATT_RESC(a) do { if (__any((a) < 1.f)) { lsum *= (a); if (hi == 0) al_l[r32] = (a); asm volatile("s_waitcnt lgkmcnt(0)" ::: "memory"); \
    _Pragma("unroll") for (int r = 0; r < 16; ++r) { const float f_ = al_l[crow(r, hi)]; o[0][r] *= f_; o[1][r] *= f_; ol[r] *= f_; } } } while (0)
    f32x16 pA0, pA1, pB0, pB1; float alA, alB; bf16x8 pa0, pa1, pa2, pa3; const int NT = 4 * (qb + 1), NP = 4 * qb;
    f32x16 cm = negm; const bool gated = MOBA && qb > 3;
#define ATT_CM(t) do { if (gated) { if ((t) < NP) { const float v_ = ((sel >> ((t) >> 2)) & 1u) ? -m_ref : -INFINITY; _Pragma("unroll") for (int r = 0; r < 16; ++r) cm[r] = v_; } else cm = negm; } else cm = negm; } while (0)
#define ATT_SCORE(P0, P1, t) do { ATT_CM(t); qkt<ND>(P0, P1, K_lds + sc * KTB, ka, qr, cm); if ((t) >= NP) cmask(P0, P1, (t) - NP, qrel, hi); } while (0)
    int sp = 0, sc = 0, sn = 1;
#define ATT_ROT() do { sp = sc; sc = sn; sn = (sn == NSLOT - 1) ? 0 : sn + 1; } while (0)
    ATT_SWRITE(0, 0); ATT_SLOAD(0, 128);
    __syncthreads(); ATT_SWRITE(sn, 1); ATT_SLOAD(1, 192);
    ATT_SCORE(pA0, pA1, 0); partialSM(pA0, pA1, m_ref, negm, alA);
    ATT_ROT();
    for (int t = 1; t + 1 < NT; t += 2) {
        __syncthreads(); ATT_SWRITE(sn, 0); if (t + 3 < NT) ATT_SLOAD(0, (t + 3) * 64);
        ASBAR(); ATT_SCORE(pB0, pB1, t);
        finishSM(pA0, pA1, pa0, pa1, pa2, pa3, lsum); ASBAR();
        pv_all(o, ol, vb0 + sp * VTB, pa0, pa1, pa2, pa3); partialSM(pB0, pB1, m_ref, negm, alB);
        ATT_RESC(alB); ATT_ROT();
        __syncthreads(); ATT_SWRITE(sn, 1); if (t + 4 < NT) ATT_SLOAD(1, (t + 4) * 64);
        ASBAR(); ATT_SCORE(pA0, pA1, t + 1);
        finishSM(pB0, pB1, pa0, pa1, pa2, pa3, lsum); ASBAR();
        pv_all(o, ol, vb0 + sp * VTB, pa0, pa1, pa2, pa3); partialSM(pA0, pA1, m_ref, negm, alA);
        ATT_RESC(alA); ATT_ROT();
    }
    __syncthreads();
    ASBAR(); ATT_SCORE(pB0, pB1, NT - 1);
    if (qb < 7) { ATT_SLOAD(0, 0); ATT_SLOAD(1, 64); }
    finishSM(pA0, pA1, pa0, pa1, pa2, pa3, lsum); ASBAR();
    pv_all(o, ol, vb0 + sp * VTB, pa0, pa1, pa2, pa3); partialSM(pB0, pB1, m_ref, negm, alB);
    ATT_RESC(alB);
    finishSM(pB0, pB1, pa0, pa1, pa2, pa3, lsum); ASBAR();
    pv_all(o, ol, vb0 + sc * VTB, pa0, pa1, pa2, pa3);
#undef ATT_ROT
#undef ATT_SCORE
#undef ATT_CM
    float rli[16];
#if ATT_LSUM_MFMA
#pragma unroll
    for (int r = 0; r < 16; ++r) rli[r] = __builtin_amdgcn_rcpf(ol[r]);
#else
    { auto rr = __builtin_amdgcn_permlane32_swap(__float_as_uint(lsum), __float_as_uint(lsum), false, false); lsum = __uint_as_float(rr[0]) + __uint_as_float(rr[1]); }
    if (hi == 0) al_l[32 + r32] = lsum; asm volatile("s_waitcnt lgkmcnt(0)" ::: "memory");
#pragma unroll
    for (int r = 0; r < 16; ++r) rli[r] = __builtin_amdgcn_rcpf(al_l[32 + crow(r, hi)]);
#endif
    { ALDS unsigned short* stg = (ALDS unsigned short*)(lds + L_OST) + wid * 2048;
#pragma unroll
      for (int r = 0; r < 16; ++r) { const int orow = crow(r, hi);
#pragma unroll
          for (int d0 = 0; d0 < 2; ++d0) stg[orow * 64 + d0 * 32 + r32] = (unsigned short)(cvtpk(o[d0][r] * rli[r], 0.f) & 0xffffu); }
      asm volatile("s_waitcnt lgkmcnt(0)" ::: "memory");
      bf16_t* Ow = Op + (size_t)(qb * 256 + wid * 32) * ldo;
#pragma unroll
      for (int i = 0; i < 4; ++i) { const int row = i * 8 + (lane >> 3), ch = lane & 7; const u32x4 v = *(ALDS const u32x4*)(stg + row * 64 + ch * 8); *(u32x4*)(Ow + (size_t)row * ldo + ch * 8) = v; } }
    __syncthreads();
  }
#undef ATT_SLOAD
#undef ATT_SWRITE
#undef ATT_QLOAD
#undef ATT_RESC
}

constexpr int MSLOT = 8192, M_K = 0, M_V = 3 * MSLOT, M_WS = 6 * MSLOT, M_OST = M_WS + 8 * 256, M_END = M_OST + 8 * 4096;
static_assert(M_END <= L_KM, "MoBA LDS map");
#define MPIN(x) asm volatile("" : "+v"(x))
#define MMFMA(a, b, c) __builtin_amdgcn_mfma_f32_32x32x16_bf16(a, b, c, 0, 0, 0)
#define MWAIT_BAR(N) asm volatile("s_waitcnt vmcnt(" #N ") lgkmcnt(0)\n\ts_barrier" ::: "memory")
__device__ __forceinline__ void m_kload2(bf16x8* kf, ALDS const char* kp, int d0) { kf[2 * d0] = *(ALDS const bf16x8*)(kp + d0 * 2048); kf[2 * d0 + 1] = *(ALDS const bf16x8*)(kp + d0 * 2048 + 512); }
__device__ __forceinline__ void m_glds16(const void* g, unsigned lds_base) {
    unsigned sv; asm volatile("s_mov_b32 %0, m0\n\ts_mov_b32 m0, %2\n\ts_nop 0\n\tglobal_load_lds_dwordx4 %1, off\n\ts_mov_b32 m0, %0" : "=&s"(sv) : "v"(g), "s"(lds_base) : "memory"); }
typedef ALDS s16x4 lds_s16x4_t;
__device__ __forceinline__ s16x4 m_vtr(ALDS const char* p) { return __builtin_amdgcn_ds_read_tr16_b64_v4i16((lds_s16x4_t*)p); }
#define MMX3(a, b, c) __builtin_fmaxf(__builtin_fmaxf((a), (b)), (c))
__device__ __forceinline__ float m_rowmax(const f32x16& p0, const f32x16& p1) {
    float a = MMX3(p0[0], p0[1], p1[0]), b = MMX3(p0[2], p0[3], p1[1]); a = MMX3(a, p1[2], p1[3]);
#pragma unroll
    for (int r = 4; r < 16; r += 4) { a = MMX3(a, p0[r], p0[r + 1]); b = MMX3(b, p0[r + 2], p0[r + 3]); a = MMX3(a, p1[r], p1[r + 1]); b = MMX3(b, p1[r + 2], p1[r + 3]); }
    float m = __builtin_fmaxf(a, b); auto rr = __builtin_amdgcn_permlane32_swap(__float_as_uint(m), __float_as_uint(m), false, false);
    return __builtin_fmaxf(__uint_as_float(rr[0]), __uint_as_float(rr[1])); }
__device__ __forceinline__ void moba_unit(const bf16_t* Qp, const bf16_t* Kp, const bf16_t* Vp, bf16_t* Op, int ldo, int qb, ALDS char* lds) {
    int tid_ = threadIdx.x; asm volatile("" : "+v"(tid_));
    const int tid = tid_, lane = tid & 63, r32 = lane & 31, hi = lane >> 5; const int wid = __builtin_amdgcn_readfirstlane(tid >> 6);
    const int NT = 4 * qb + 4, NP = 4 * qb;
    ALDS float* wsf = (ALDS float*)(lds + M_WS) + wid * 64;
    const bf16_t* ksrc = Kp + (size_t)(lane >> 4) * 16 * AW + (wid >> 2) * 512 + (wid & 3) * 128 + (lane & 15) * 8;
    const bf16_t* vsrc = Vp + (size_t)(wid & 3) * 16 * AW + (wid >> 2) * 512 + (lane & 3) * 128 + (lane >> 2) * 8;
    const unsigned lds0 = (unsigned)(uintptr_t)lds, kdst = lds0 + M_K + wid * 1024, vdst = lds0 + M_V + wid * 1024;
#define MDMA_K(t, slot) m_glds16(ksrc + (size_t)(t) * 64 * AW, (unsigned)__builtin_amdgcn_readfirstlane(kdst + (slot)))
#define MDMA_V(t, slot) m_glds16(vsrc + (size_t)(t) * 64 * AW, (unsigned)__builtin_amdgcn_readfirstlane(vdst + (slot)))
    ALDS const char* vp0 = lds + M_V + ((lane >> 4) & 1) * 32 + (lane & 3) * 8 + (4 * hi + ((lane & 15) >> 2)) * 64;
    ALDS const char* kp0 = lds + M_K + hi * 1024 + r32 * 16;
    MDMA_K(0, 0); MDMA_V(0, 0); MDMA_K(1, MSLOT);
    bf16x8 qr[4];
    { const bf16_t* Qw = Qp + (size_t)(qb * 256 + wid * 32 + (r32 & 16)) * AW + (r32 & 15) * 8 + hi * 128;
#pragma unroll
      for (int d0 = 0; d0 < 4; ++d0) qr[d0] = *(const bf16x8*)(Qw + (d0 >> 1) * 512 + (d0 & 1) * 256); }
    MDMA_K(2, 2 * MSLOT);
    float mhat = 0.f, l_reg = 0.f; f32x16 o[2]; o[0] = f32x16{}; o[1] = f32x16{};
    const int qrel = wid * 32 + r32; bool resc = false, moved = false;
    unsigned sel = 0xffu; const bool gated = qb > 3;
    if (gated) {
        ALDS const float* km = (ALDS const float*)(lds + L_KM); float g[8];
#pragma unroll
        for (int n = 0; n < 8; ++n) { float sg = 0.f;
#pragma unroll
            for (int d0 = 0; d0 < 4; ++d0)
#pragma unroll
                for (int j = 0; j < 8; ++j) sg += bf2f(qr[d0][j]) * km[n * 64 + d0 * 16 + hi * 8 + j];
            g[n] = sg; }
#pragma unroll
        for (int n = 0; n < 8; ++n) g[n] += __shfl_xor(g[n], 32);
        sel = 0u;
#pragma unroll
        for (int n = 0; n < 8; ++n) { int rank = 0;
#pragma unroll
            for (int mm = 0; mm < 8; ++mm) if (mm != n) rank += (mm < qb && (g[mm] > g[n] || (g[mm] == g[n] && mm < n))) ? 1 : 0;
            if (n < qb && rank < 3) sel |= 1u << n; }
    }
    f32x16 cm;
#define MCM(t) do { const float v_ = (gated && (t) < NP && !((sel >> ((t) >> 2)) & 1u)) ? -INFINITY : -mhat; _Pragma("unroll") for (int r = 0; r < 16; ++r) cm[r] = v_; MPIN(cm); } while (0)
    MCM(0);
    f32x16 pA0, pA1, pB0, pB1; bf16x8 kf[8]; s16x4 vlo[8], vhi[8]; u32x4 pw0, pw1, pw2, pw3;
    int sl_prev = 0, sl_cur = 0, sl_next = MSLOT;
#define MROT() do { sl_prev = sl_cur; sl_cur = sl_next; sl_next = (sl_next == 2 * MSLOT) ? 0 : sl_next + MSLOT; } while (0)
#define MEX(v) __builtin_amdgcn_exp2f(v)
#define MRESC(tn) do { if (moved) { moved = false; MCM(tn); } if (resc) { _Pragma("unroll") for (int d_ = 0; d_ < 2; ++d_) _Pragma("unroll") for (int r = 0; r < 16; ++r) o[d_][r] *= wsf[crow(r, hi)]; } } while (0)
#define MDECIDE(C0, C1) do { const float rm = m_rowmax(C0, C1); resc = false; \
      if (__builtin_expect(__any(rm > THR), 0)) { const float dl = __builtin_fmaxf(rm, 0.f); mhat += dl; const float f = __builtin_amdgcn_exp2f(-dl); l_reg *= f; if (hi == 0) wsf[r32] = f; resc = true; \
          _Pragma("unroll") for (int r = 0; r < 16; ++r) { C0[r] -= dl; C1[r] -= dl; } moved = true; } } while (0)
    MWAIT_BAR(3);
#pragma unroll
    for (int d0 = 0; d0 < 4; ++d0) m_kload2(kf, kp0, d0);
    pA0 = MMFMA(kf[0], qr[0], cm); pA1 = MMFMA(kf[1], qr[0], cm); pA0 = MMFMA(kf[2], qr[1], pA0); pA1 = MMFMA(kf[3], qr[1], pA1);
    pA0 = MMFMA(kf[4], qr[2], pA0); pA1 = MMFMA(kf[5], qr[2], pA1); pA0 = MMFMA(kf[6], qr[3], pA0); pA1 = MMFMA(kf[7], qr[3], pA1);
    if (NT == 4) cmask(pA0, pA1, 0, qrel, hi);
    MDECIDE(pA0, pA1);
    if (moved) { moved = false; MCM(1); }
#pragma unroll
    for (int r = 0; r < 16; ++r) { pA0[r] = MEX(pA0[r]); pA1[r] = MEX(pA1[r]); }
    MWAIT_BAR(0);
    MDMA_K(3, 0); MDMA_V(1, MSLOT); MROT();
#pragma unroll
    for (int d0 = 0; d0 < 4; ++d0) m_kload2(kf, kp0 + sl_cur, d0);
    MWAIT_BAR(2);
#define MPKW(P, i) cvtpk(P[i], P[i + 1])
#define MPAF(k) __builtin_bit_cast(bf16x8, pw##k)
#define MVFR(i) (bf16x8){vlo[i][0], vlo[i][1], vlo[i][2], vlo[i][3], vhi[i][0], vhi[i][1], vhi[i][2], vhi[i][3]}
#define MVRD(i) do { vlo[i] = m_vtr(vp_ + (((i) >> 2) * 4096 + ((i) & 3) * 1024)); vhi[i] = m_vtr(vp_ + (((i) >> 2) * 4096 + ((i) & 3) * 1024 + 512)); } while (0)
#define MKRD(G, d0) do { if (G) { m_kload2(kf, kp0 + sl_next, d0); ASBAR(); } } while (0)
#define MGAPA(MF, a0, a1, a2, a3, W0, W1, PW) do { MF; sacc += a0; sacc += a1; sacc += a2; sacc += a3; W0; W1; MPIN(PW); MPIN(sacc); ASBAR(); } while (0)
#define MGAPB(MF, X, i) do { MF; X[i] = MEX(X[i]); X[i + 1] = MEX(X[i + 1]); X[i + 2] = MEX(X[i + 2]); X[i + 3] = MEX(X[i + 3]); MPIN(X); ASBAR(); } while (0)
#define MSTEP(C0, C1, P0, P1, t, MASK, GK, GV, GL) do { ASBAR(); \
    const ALDS char* vp_ = vp0 + sl_prev; if (gated && ((t) & 3) == 0) MCM(t); \
    MVRD(0); ASBAR(); float sacc = P0[0] + P0[1]; \
                     MGAPA(C0 = MMFMA(kf[0], qr[0], cm), P0[2], P0[3], P0[4], P0[5],     pw0[0] = MPKW(P0, 0),  pw0[1] = MPKW(P0, 2),  pw0); \
    MVRD(4); ASBAR(); MGAPA(C1 = MMFMA(kf[1], qr[0], cm), P0[6], P0[7], P0[8], P0[9],     pw0[2] = MPKW(P0, 4),  pw0[3] = MPKW(P0, 6),  pw0); \
    MVRD(1); ASBAR(); MGAPA(C0 = MMFMA(kf[2], qr[1], C0), P0[10], P0[11], P0[12], P0[13], pw1[0] = MPKW(P0, 8),  pw1[1] = MPKW(P0, 10), pw1); \
    MVRD(5); ASBAR(); MGAPA(C1 = MMFMA(kf[3], qr[1], C1), P0[14], P0[15], P1[0], P1[1],   pw1[2] = MPKW(P0, 12), pw1[3] = MPKW(P0, 14), pw1); \
    MVRD(2); ASBAR(); MGAPA(C0 = MMFMA(kf[4], qr[2], C0), P1[2], P1[3], P1[4], P1[5],     pw2[0] = MPKW(P1, 0),  pw2[1] = MPKW(P1, 2),  pw2); \
    MVRD(6); ASBAR(); MGAPA(C1 = MMFMA(kf[5], qr[2], C1), P1[6], P1[7], P1[8], P1[9],     pw2[2] = MPKW(P1, 4),  pw2[3] = MPKW(P1, 6),  pw2); \
    MVRD(3); ASBAR(); MGAPA(C0 = MMFMA(kf[6], qr[3], C0), P1[10], P1[11], P1[12], P1[13], pw3[0] = MPKW(P1, 8),  pw3[1] = MPKW(P1, 10), pw3); \
    MVRD(7); ASBAR(); MGAPA(C1 = MMFMA(kf[7], qr[3], C1), P1[14], P1[15], 0.f, 0.f,       pw3[2] = MPKW(P1, 12), pw3[3] = MPKW(P1, 14), pw3); \
    l_reg += sacc; \
    if (GK) MDMA_K((t) + 3, sl_cur); if (GV) MDMA_V((t) + 1, sl_next); \
    if (MASK) cmask(C0, C1, (t) - NP, qrel, hi); \
    MDECIDE(C0, C1); ASBAR(); \
    MGAPB(o[0] = MMFMA(MPAF(0), MVFR(0), o[0]), C0, 0);               MGAPB(o[1] = MMFMA(MPAF(0), MVFR(4), o[1]), C0, 4); \
    MKRD(GL, 0); MGAPB(o[0] = MMFMA(MPAF(1), MVFR(1), o[0]), C0, 8);  MKRD(GL, 1); MGAPB(o[1] = MMFMA(MPAF(1), MVFR(5), o[1]), C0, 12); \
    MKRD(GL, 2); MGAPB(o[0] = MMFMA(MPAF(2), MVFR(2), o[0]), C1, 0);  MKRD(GL, 3); MGAPB(o[1] = MMFMA(MPAF(2), MVFR(6), o[1]), C1, 4); \
    MGAPB(o[0] = MMFMA(MPAF(3), MVFR(3), o[0]), C1, 8);               MGAPB(o[1] = MMFMA(MPAF(3), MVFR(7), o[1]), C1, 12); \
    } while (0)
    int t = 1;
    for (; t + 5 < NT; t += 2) {
        MSTEP(pB0, pB1, pA0, pA1, t, false, true, true, true);     MWAIT_BAR(2); MRESC(t + 1); MROT();
        MSTEP(pA0, pA1, pB0, pB1, t + 1, false, true, true, true); MWAIT_BAR(2); MRESC(t + 2); MROT();
    }
#define MENDW(tt) do { if ((tt) + 3 < NT) { MWAIT_BAR(2); } else if ((tt) + 2 < NT) { MWAIT_BAR(1); } else { MWAIT_BAR(0); } } while (0)
    for (; t + 1 < NT; t += 2) {
        MSTEP(pB0, pB1, pA0, pA1, t, true, (t + 3 < NT), (t + 1 < NT), (t + 1 < NT));         MENDW(t);     MRESC(t + 1); MROT();
        MSTEP(pA0, pA1, pB0, pB1, t + 1, true, (t + 4 < NT), (t + 2 < NT), (t + 2 < NT));     MENDW(t + 1); MRESC(t + 2); MROT();
    }
    MSTEP(pB0, pB1, pA0, pA1, NT - 1, true, false, false, false); MRESC(NT - 1);
    { float sacc = pB0[0] + pB0[1];
#pragma unroll
      for (int r = 2; r < 16; ++r) sacc += pB0[r];
#pragma unroll
      for (int r = 0; r < 16; ++r) sacc += pB1[r];
      l_reg += sacc;
      pw0 = (u32x4){MPKW(pB0, 0), MPKW(pB0, 2), MPKW(pB0, 4), MPKW(pB0, 6)}; pw1 = (u32x4){MPKW(pB0, 8), MPKW(pB0, 10), MPKW(pB0, 12), MPKW(pB0, 14)};
      pw2 = (u32x4){MPKW(pB1, 0), MPKW(pB1, 2), MPKW(pB1, 4), MPKW(pB1, 6)}; pw3 = (u32x4){MPKW(pB1, 8), MPKW(pB1, 10), MPKW(pB1, 12), MPKW(pB1, 14)};
      const ALDS char* vp_ = vp0 + sl_cur;
#pragma unroll
      for (int i = 0; i < 8; ++i) MVRD(i);
      o[0] = MMFMA(MPAF(0), MVFR(0), o[0]); o[1] = MMFMA(MPAF(0), MVFR(4), o[1]); o[0] = MMFMA(MPAF(1), MVFR(1), o[0]); o[1] = MMFMA(MPAF(1), MVFR(5), o[1]);
      o[0] = MMFMA(MPAF(2), MVFR(2), o[0]); o[1] = MMFMA(MPAF(2), MVFR(6), o[1]); o[0] = MMFMA(MPAF(3), MVFR(3), o[0]); o[1] = MMFMA(MPAF(3), MVFR(7), o[1]); }
    { auto rr = __builtin_amdgcn_permlane32_swap(__float_as_uint(l_reg), __float_as_uint(l_reg), false, false); l_reg = __uint_as_float(rr[0]) + __uint_as_float(rr[1]); }
    if (hi == 0) wsf[32 + r32] = l_reg; asm volatile("s_waitcnt lgkmcnt(0)" ::: "memory");
    float rli[16];
#pragma unroll
    for (int r = 0; r < 16; ++r) rli[r] = __builtin_amdgcn_rcpf(wsf[32 + crow(r, hi)]);
    { ALDS unsigned short* stg = (ALDS unsigned short*)(lds + M_OST) + wid * 2048;
#pragma unroll
      for (int r = 0; r < 16; ++r) { const int orow = crow(r, hi);
#pragma unroll
          for (int d0 = 0; d0 < 2; ++d0) stg[orow * 64 + d0 * 32 + r32] = (unsigned short)(cvtpk(o[d0][r] * rli[r], 0.f) & 0xffffu); }
      asm volatile("s_waitcnt lgkmcnt(0)" ::: "memory");
      bf16_t* Ow = Op + (size_t)(qb * 256 + wid * 32) * ldo;
#pragma unroll
      for (int i = 0; i < 4; ++i) { const u32x4 v = *(ALDS const u32x4*)(stg + ((i >> 1) * 16 + (lane & 15)) * 64 + (i & 1) * 32 + (lane >> 4) * 8); *(u32x4*)(Ow + (size_t)((i >> 1) * 16) * ldo + (i & 1) * 512 + lane * 8) = v; } }
    asm volatile("s_waitcnt lgkmcnt(0)\n\ts_barrier" ::: "memory");
#undef MDMA_K
#undef MDMA_V
#undef MCM
#undef MROT
#undef MEX
#undef MRESC
#undef MDECIDE
#undef MPKW
#undef MPAF
#undef MVFR
#undef MVRD
#undef MKRD
#undef MGAPA
#undef MGAPB
#undef MSTEP
#undef MENDW
}
__device__ __forceinline__ void mla_unit(const bf16_t* Qp, const bf16_t* Kp, const bf16_t* KRp, const bf16_t* Vp, bf16_t* Op, int ldo, int qb, ALDS char* lds) {
    constexpr int KSL = 12288, N_K = 0, N_V = 3 * KSL, N_WS = N_V + 3 * MSLOT, N_OST = N_WS + 8 * 256;
    int tid_ = threadIdx.x; asm volatile("" : "+v"(tid_));
    const int tid = tid_, lane = tid & 63, r32 = lane & 31, hi = lane >> 5; const int wid = __builtin_amdgcn_readfirstlane(tid >> 6);
    const int NT = 4 * qb + 4, NP = 4 * qb;
    ALDS float* wsf = (ALDS float*)(lds + N_WS) + wid * 64;
    const bf16_t* ksrc = Kp + (size_t)(lane >> 4) * 16 * AW + (wid >> 2) * 512 + (wid & 3) * 128 + (lane & 15) * 8;
    const bf16_t* vsrc = Vp + (size_t)(wid & 3) * 16 * AW + (wid >> 2) * 512 + (lane & 3) * 128 + (lane >> 2) * 8;
    const bf16_t* rsrc = KRp + (size_t)(lane >> 4) * 16 * RDIM + (wid & 3) * 128 + (lane & 15) * 8;
    const unsigned lds0 = (unsigned)(uintptr_t)lds, kdst = lds0 + N_K + wid * 1024, vdst = lds0 + N_V + wid * 1024, rdst = lds0 + N_K + (8 + (wid & 3)) * 1024;
#define MDMA_K(t, slot) do { m_glds16(ksrc + (size_t)(t) * 64 * AW, (unsigned)__builtin_amdgcn_readfirstlane(kdst + (slot) * KSL)); m_glds16(rsrc + (size_t)(t) * 64 * RDIM, (unsigned)__builtin_amdgcn_readfirstlane(rdst + (slot) * KSL)); } while (0)
#define MDMA_V(t, slot) m_glds16(vsrc + (size_t)(t) * 64 * AW, (unsigned)__builtin_amdgcn_readfirstlane(vdst + (slot) * MSLOT))
    ALDS const char* vp0 = lds + N_V + ((lane >> 4) & 1) * 32 + (lane & 3) * 8 + (4 * hi + ((lane & 15) >> 2)) * 64;
    ALDS const char* kp0 = lds + N_K + hi * 1024 + r32 * 16;
    MDMA_K(0, 0); MDMA_V(0, 0); MDMA_K(1, 1);
    bf16x8 qr[6];
    { const bf16_t* Qw = Qp + (size_t)(qb * 256 + wid * 32 + (r32 & 16)) * (NHEAD * QKB) + (r32 & 15) * 8 + hi * 128;
#pragma unroll
      for (int d0 = 0; d0 < 6; ++d0) qr[d0] = *(const bf16x8*)(Qw + (d0 >> 1) * 512 + (d0 & 1) * 256); }
    MDMA_K(2, 2);
    float mhat = 0.f, l_reg = 0.f; f32x16 o[2]; o[0] = f32x16{}; o[1] = f32x16{};
    const int qrel = wid * 32 + r32; bool resc = false, moved = false;
    constexpr bool gated = false; constexpr unsigned sel = 0xffu;
#define MCM(t) do { } while (0)
#define MREL(C0, C1) do { if (__builtin_expect(__any(mhat != 0.f), 0)) { _Pragma("unroll") for (int r = 0; r < 16; ++r) { C0[r] -= mhat; C1[r] -= mhat; } } } while (0)
    f32x16 pA0, pA1, pB0, pB1; bf16x8 kf[12]; s16x4 vlo[8], vhi[8]; u32x4 pw0, pw1, pw2, pw3;
    int sl_prev = 0, sl_cur = 0, sl_next = 1;
#define MROT() do { sl_prev = sl_cur; sl_cur = sl_next; sl_next = (sl_next == 2) ? 0 : sl_next + 1; } while (0)
#define MEX(v) __builtin_amdgcn_exp2f(v)
#define MRESC(tn) do { if (resc) { _Pragma("unroll") for (int d_ = 0; d_ < 2; ++d_) _Pragma("unroll") for (int r = 0; r < 16; ++r) o[d_][r] *= wsf[crow(r, hi)]; } } while (0)
#define MDECIDE(C0, C1) do { const float rm = m_rowmax(C0, C1); resc = false; \
      if (__builtin_expect(__any(rm > THR), 0)) { const float dl = __builtin_fmaxf(rm, 0.f); mhat += dl; const float f = __builtin_amdgcn_exp2f(-dl); l_reg *= f; if (hi == 0) wsf[r32] = f; resc = true; \
          _Pragma("unroll") for (int r = 0; r < 16; ++r) { C0[r] -= dl; C1[r] -= dl; } moved = true; } } while (0)
    MWAIT_BAR(5);
#pragma unroll
    for (int d0 = 0; d0 < 6; ++d0) m_kload2(kf, kp0, d0);
    pA0 = MMFMA(kf[0], qr[0], (f32x16){}); pA1 = MMFMA(kf[1], qr[0], (f32x16){}); pA0 = MMFMA(kf[2], qr[1], pA0); pA1 = MMFMA(kf[3], qr[1], pA1);
    pA0 = MMFMA(kf[4], qr[2], pA0); pA1 = MMFMA(kf[5], qr[2], pA1); pA0 = MMFMA(kf[6], qr[3], pA0); pA1 = MMFMA(kf[7], qr[3], pA1);
    pA0 = MMFMA(kf[8], qr[4], pA0); pA1 = MMFMA(kf[9], qr[4], pA1); pA0 = MMFMA(kf[10], qr[5], pA0); pA1 = MMFMA(kf[11], qr[5], pA1);
    if (NT == 4) cmask(pA0, pA1, 0, qrel, hi);
    MREL(pA0, pA1); MDECIDE(pA0, pA1);
#pragma unroll
    for (int r = 0; r < 16; ++r) { pA0[r] = MEX(pA0[r]); pA1[r] = MEX(pA1[r]); }
    MWAIT_BAR(0);
    MDMA_K(3, 0); MDMA_V(1, 1); MROT();
#pragma unroll
    for (int d0 = 0; d0 < 6; ++d0) m_kload2(kf, kp0 + sl_cur * KSL, d0);
    MWAIT_BAR(3);
#define MPKW(P, i) cvtpk(P[i], P[i + 1])
#define MPAF(k) __builtin_bit_cast(bf16x8, pw##k)
#define MVFR(i) (bf16x8){vlo[i][0], vlo[i][1], vlo[i][2], vlo[i][3], vhi[i][0], vhi[i][1], vhi[i][2], vhi[i][3]}
#define MVRD(i) do { vlo[i] = m_vtr(vp_ + (((i) >> 2) * 4096 + ((i) & 3) * 1024)); vhi[i] = m_vtr(vp_ + (((i) >> 2) * 4096 + ((i) & 3) * 1024 + 512)); } while (0)
#define MKRD(G, d0) do { if (G) { m_kload2(kf, kp0 + sl_next * KSL, d0); ASBAR(); } } while (0)
#define MGAPA(MF, a0, a1, a2, a3, W0, W1, PW) do { MF; sacc += a0; sacc += a1; sacc += a2; sacc += a3; W0; W1; MPIN(PW); MPIN(sacc); ASBAR(); } while (0)
#define MGAPB(MF, X, i) do { MF; X[i] = MEX(X[i]); X[i + 1] = MEX(X[i + 1]); X[i + 2] = MEX(X[i + 2]); X[i + 3] = MEX(X[i + 3]); MPIN(X); ASBAR(); } while (0)
#define MGAPA2(MF, a0, a1, W0, PW) do { MF; sacc += a0; sacc += a1; W0; MPIN(PW); MPIN(sacc); ASBAR(); } while (0)
#define MSTEP(C0, C1, P0, P1, t, MASK, GK, GV, GL) do { ASBAR(); \
    const ALDS char* vp_ = vp0 + sl_prev * MSLOT; \
    MVRD(0); ASBAR(); float sacc = P0[0] + P0[1]; \
                     MGAPA(C0 = MMFMA(kf[0], qr[0], (f32x16){}), P0[2], P0[3], P0[4], P0[5],     pw0[0] = MPKW(P0, 0),  pw0[1] = MPKW(P0, 2),  pw0); \
    MVRD(4); ASBAR(); MGAPA(C1 = MMFMA(kf[1], qr[0], (f32x16){}), P0[6], P0[7], P0[8], P0[9],     pw0[2] = MPKW(P0, 4),  pw0[3] = MPKW(P0, 6),  pw0); \
    MVRD(1); ASBAR(); MGAPA2(C0 = MMFMA(kf[2], qr[1], C0), P0[10], P0[11], pw1[0] = MPKW(P0, 8),  pw1); \
    MVRD(5); ASBAR(); MGAPA2(C1 = MMFMA(kf[3], qr[1], C1), P0[12], P0[13], pw1[1] = MPKW(P0, 10), pw1); \
                     MGAPA2(C0 = MMFMA(kf[4], qr[2], C0), P0[14], P0[15], pw1[2] = MPKW(P0, 12), pw1); \
                     MGAPA2(C1 = MMFMA(kf[5], qr[2], C1), P1[0], P1[1],   pw1[3] = MPKW(P0, 14), pw1); \
                     MGAPA2(C0 = MMFMA(kf[6], qr[3], C0), P1[2], P1[3],   pw2[0] = MPKW(P1, 0),  pw2); \
                     MGAPA2(C1 = MMFMA(kf[7], qr[3], C1), P1[4], P1[5],   pw2[1] = MPKW(P1, 2),  pw2); \
                     MGAPA(C0 = MMFMA(kf[8], qr[4], C0), P1[6], P1[7], P1[8], P1[9],     pw2[2] = MPKW(P1, 4),  pw2[3] = MPKW(P1, 6),  pw2); \
                     MGAPA(C1 = MMFMA(kf[9], qr[4], C1), P1[10], P1[11], P1[12], P1[13], pw3[0] = MPKW(P1, 8),  pw3[1] = MPKW(P1, 10), pw3); \
                     MGAPA2(C0 = MMFMA(kf[10], qr[5], C0), P1[14], P1[15], pw3[2] = MPKW(P1, 12), pw3); \
                     MGAPA2(C1 = MMFMA(kf[11], qr[5], C1), 0.f, 0.f,       pw3[3] = MPKW(P1, 14), pw3); \
    l_reg += sacc; \
    if (GK) MDMA_K((t) + 3, sl_cur); if (GV) MDMA_V((t) + 1, sl_next); \
    if (MASK) cmask(C0, C1, (t) - NP, qrel, hi); \
    MREL(C0, C1); MDECIDE(C0, C1); ASBAR(); \
    MVRD(2); MKRD(GL, 4); ASBAR(); MGAPB(o[0] = MMFMA(MPAF(0), MVFR(0), o[0]), C0, 0);  MVRD(6); MKRD(GL, 5); ASBAR(); MGAPB(o[1] = MMFMA(MPAF(0), MVFR(4), o[1]), C0, 4); \
    MVRD(3); MKRD(GL, 0); ASBAR(); MGAPB(o[0] = MMFMA(MPAF(1), MVFR(1), o[0]), C0, 8);  MVRD(7); MKRD(GL, 1); ASBAR(); MGAPB(o[1] = MMFMA(MPAF(1), MVFR(5), o[1]), C0, 12); \
    MKRD(GL, 2); MGAPB(o[0] = MMFMA(MPAF(2), MVFR(2), o[0]), C1, 0);  MKRD(GL, 3); MGAPB(o[1] = MMFMA(MPAF(2), MVFR(6), o[1]), C1, 4); \
    MGAPB(o[0] = MMFMA(MPAF(3), MVFR(3), o[0]), C1, 8);               MGAPB(o[1] = MMFMA(MPAF(3), MVFR(7), o[1]), C1, 12); \
    } while (0)
    int t = 1;
    for (; t + 5 < NT; t += 2) {
        MSTEP(pB0, pB1, pA0, pA1, t, false, true, true, true);     MWAIT_BAR(3); MRESC(t + 1); MROT();
        MSTEP(pA0, pA1, pB0, pB1, t + 1, false, true, true, true); MWAIT_BAR(3); MRESC(t + 2); MROT();
    }
#define MENDW(tt) do { if ((tt) + 3 < NT) { MWAIT_BAR(3); } else if ((tt) + 2 < NT) { MWAIT_BAR(1); } else { MWAIT_BAR(0); } } while (0)
    for (; t + 1 < NT; t += 2) {
        MSTEP(pB0, pB1, pA0, pA1, t, true, (t + 3 < NT), (t + 1 < NT), (t + 1 < NT));         MENDW(t);     MRESC(t + 1); MROT();
        MSTEP(pA0, pA1, pB0, pB1, t + 1, true, (t + 4 < NT), (t + 2 < NT), (t + 2 < NT));     MENDW(t + 1); MRESC(t + 2); MROT();
    }
    MSTEP(pB0, pB1, pA0, pA1, NT - 1, true, false, false, false); MRESC(NT - 1);
    { float sacc = pB0[0] + pB0[1];
#pragma unroll
      for (int r = 2; r < 16; ++r) sacc += pB0[r];
#pragma unroll
      for (int r = 0; r < 16; ++r) sacc += pB1[r];
      l_reg += sacc;
      pw0 = (u32x4){MPKW(pB0, 0), MPKW(pB0, 2), MPKW(pB0, 4), MPKW(pB0, 6)}; pw1 = (u32x4){MPKW(pB0, 8), MPKW(pB0, 10), MPKW(pB0, 12), MPKW(pB0, 14)};
      pw2 = (u32x4){MPKW(pB1, 0), MPKW(pB1, 2), MPKW(pB1, 4), MPKW(pB1, 6)}; pw3 = (u32x4){MPKW(pB1, 8), MPKW(pB1, 10), MPKW(pB1, 12), MPKW(pB1, 14)};
      const ALDS char* vp_ = vp0 + sl_cur * MSLOT;
#pragma unroll
      for (int i = 0; i < 8; ++i) MVRD(i);
      o[0] = MMFMA(MPAF(0), MVFR(0), o[0]); o[1] = MMFMA(MPAF(0), MVFR(4), o[1]); o[0] = MMFMA(MPAF(1), MVFR(1), o[0]); o[1] = MMFMA(MPAF(1), MVFR(5), o[1]);
      o[0] = MMFMA(MPAF(2), MVFR(2), o[0]); o[1] = MMFMA(MPAF(2), MVFR(6), o[1]); o[0] = MMFMA(MPAF(3), MVFR(3), o[0]); o[1] = MMFMA(MPAF(3), MVFR(7), o[1]); }
    { auto rr = __builtin_amdgcn_permlane32_swap(__float_as_uint(l_reg), __float_as_uint(l_reg), false, false); l_reg = __uint_as_float(rr[0]) + __uint_as_float(rr[1]); }
    if (hi == 0) wsf[32 + r32] = l_reg; asm volatile("s_waitcnt lgkmcnt(0)" ::: "memory");
    float rli[16];
#pragma unroll
    for (int r = 0; r < 16; ++r) rli[r] = __builtin_amdgcn_rcpf(wsf[32 + crow(r, hi)]);
    { ALDS unsigned short* stg = (ALDS unsigned short*)(lds + N_OST) + wid * 2048;
#pragma unroll
      for (int r = 0; r < 16; ++r) { const int orow = crow(r, hi);
#pragma unroll
          for (int d0 = 0; d0 < 2; ++d0) stg[orow * 64 + d0 * 32 + r32] = (unsigned short)(cvtpk(o[d0][r] * rli[r], 0.f) & 0xffffu); }
      asm volatile("s_waitcnt lgkmcnt(0)" ::: "memory");
      bf16_t* Ow = Op + (size_t)(qb * 256 + wid * 32) * ldo;
#pragma unroll
      for (int i = 0; i < 4; ++i) { const u32x4 v = *(ALDS const u32x4*)(stg + ((i >> 1) * 16 + (lane & 15)) * 64 + (i & 1) * 32 + (lane >> 4) * 8); *(u32x4*)(Ow + (size_t)((i >> 1) * 16) * ldo + (i & 1) * 512 + lane * 8) = v; } }
    asm volatile("s_waitcnt lgkmcnt(0)\n\ts_barrier" ::: "memory");
#undef MDMA_K
#undef MDMA_V
#undef MCM
#undef MROT
#undef MEX
#undef MRESC
#undef MDECIDE
#undef MPKW
#undef MPAF
#undef MVFR
#undef MVRD
#undef MKRD
#undef MGAPA
#undef MGAPB
#undef MSTEP
#undef MENDW
#undef MGAPA2
#undef MREL
}
#undef ASBAR
}
#define GAS __attribute__((address_space(1)))
#define LAS __attribute__((address_space(3)))
typedef unsigned short bf16;
typedef unsigned v4u __attribute__((ext_vector_type(4)));
typedef float f32x4 __attribute__((ext_vector_type(4)));
typedef short bf16x8 __attribute__((ext_vector_type(8)));
typedef GAS unsigned gu32;
typedef GAS unsigned long long gu64;
#define RLX_AGENT __ATOMIC_RELAXED, __HIP_MEMORY_SCOPE_AGENT
#define LDS_WAIT() asm volatile("s_waitcnt lgkmcnt(0)" ::: "memory")
#define VM_WAIT() asm volatile("s_waitcnt vmcnt(0)" ::: "memory")
__device__ __forceinline__ unsigned long long rt() { return __builtin_amdgcn_s_memrealtime(); }
__device__ __forceinline__ unsigned f2bf(float f) { unsigned u = __builtin_bit_cast(unsigned, f); return (u + 0x7fffu + ((u >> 16) & 1u)) >> 16; }
__device__ __forceinline__ unsigned pk2(float lo, float hi) { return f2bf(lo) | (f2bf(hi) << 16); }

#define XB_TMO      128
#define XB_XCNT(j)  (256  + 64 * (j))
#define XB_XSUB(j)  (1280 + 64 * (j))
#define XB_XGEN(j)  (2304 + 64 * (j))
#define XB_TOP      3328
#define XB_TOPGEN   3392
#define XCD_BAR_WORDS 3456
#define XB_SPIN_CAP (1u << 18)

__device__ __forceinline__ unsigned xb_ld(unsigned* p)              { return __hip_atomic_load(p, __ATOMIC_RELAXED, __HIP_MEMORY_SCOPE_AGENT); }
__device__ __forceinline__ unsigned xb_add(unsigned* p, unsigned v) { return __hip_atomic_fetch_add(p, v, __ATOMIC_RELAXED, __HIP_MEMORY_SCOPE_AGENT); }
__device__ __forceinline__ unsigned xb_xcc_id() { return (unsigned)__builtin_amdgcn_s_getreg((3 << 11) | 20) & 0xFu; }
#define XB_SPIN(cond, bar) do { unsigned _sp = 0; while (cond) { __builtin_amdgcn_s_sleep(1); \
    if ((++_sp & 255u) == 0u) { if (xb_ld(&(bar)[XB_TMO])) break; if (_sp > XB_SPIN_CAP) { atomicAdd(&(bar)[XB_TMO], 1u); break; } } } } while (0)

struct XcdBarrier {
    unsigned* bar; unsigned x;
    volatile LAS unsigned* st;
};

__device__ __forceinline__ XcdBarrier xcd_barrier_post(unsigned* bar, volatile LAS unsigned* st) {
    XcdBarrier b; b.bar = bar; b.x = xb_xcc_id(); b.st = st;
    if (threadIdx.x == 0) (void)xb_add(&bar[XB_XCNT(b.x)], 1u);
    return b;
}
__device__ __forceinline__ void xcd_barrier_complete(unsigned* bar, unsigned x, unsigned& nloc, unsigned& nx) {
    const unsigned G = gridDim.x * gridDim.y * gridDim.z;
    unsigned sum, cnt, mine, sp = 0u;
    for (;;) {
        sum = 0u; cnt = 0u; mine = 0u;
#pragma unroll
        for (unsigned j = 0; j < 16; ++j) { const unsigned c = xb_ld(&bar[XB_XCNT(j)]); sum += c; cnt += (c > 0u) ? 1u : 0u; mine = (j == x) ? c : mine; }
        if (sum == G) break;
        __builtin_amdgcn_s_sleep(1);
        if ((++sp & 255u) == 0u) { if (xb_ld(&bar[XB_TMO])) break; if (sp > XB_SPIN_CAP) { atomicAdd(&bar[XB_TMO], 1u); break; } }
    }
    nloc = mine > 0u ? mine : 1u; nx = cnt > 0u ? cnt : 1u;
}

__device__ __forceinline__ void xcd_barrier(const XcdBarrier& b) {
    asm volatile("s_waitcnt vmcnt(0)" ::: "memory");
    __syncthreads();
    if (threadIdx.x == 0) {
        unsigned* bar = b.bar;
        __builtin_amdgcn_s_waitcnt(0);
        unsigned nloc = b.st[0], nx = b.st[1];
        if (nloc == 0u) { xcd_barrier_complete(bar, b.x, nloc, nx); b.st[0] = nloc; b.st[1] = nx; }
        const unsigned old = xb_add(&bar[XB_XSUB(b.x)], 1u);
        const unsigned gen = old / nloc;
        if (old + 1u == (gen + 1u) * nloc) {
            __builtin_amdgcn_fence(__ATOMIC_RELEASE, "agent");
            asm volatile("s_waitcnt vmcnt(0)" ::: "memory");
            const unsigned og = xb_add(&bar[XB_TOP], 1u);
            const unsigned tg = og / nx;
            if (og + 1u == (tg + 1u) * nx) xb_add(&bar[XB_TOPGEN], 1u);
            else XB_SPIN(xb_ld(&bar[XB_TOPGEN]) == tg, bar);
            __builtin_amdgcn_fence(__ATOMIC_ACQUIRE, "agent");
            xb_add(&bar[XB_XGEN(b.x)], 1u);
            asm volatile("s_waitcnt vmcnt(0)" ::: "memory");
        } else {
            XB_SPIN(xb_ld(&bar[XB_XGEN(b.x)]) == gen, bar);
            __builtin_amdgcn_fence(__ATOMIC_ACQUIRE, "agent");
            asm volatile("s_waitcnt vmcnt(0)" ::: "memory");
        }
    }
    __syncthreads();
}

constexpr size_t MiB = 1u << 20;
constexpr size_t WS_CTL = 0, CTL_ZERO_BYTES = 64 * 1024;
constexpr size_t WS_ROPEA = 1 * MiB, WS_ROPEB = 5 * MiB;
constexpr size_t WS_SS = 13 * MiB, WS_SS2 = 16 * MiB, WS_SS3 = 20 * MiB;
constexpr size_t WS_WIN = 24 * MiB, WS_WUQ = 34 * MiB, WS_WUKV = 35 * MiB, WS_WA = 36 * MiB, WS_WOUT = 39 * MiB, WS_WUP = 42 * MiB, WS_WDN = 51 * MiB;
constexpr size_t WS_H = 64 * MiB;
constexpr size_t WS_G = 208 * MiB;
constexpr size_t WS_QA = 464 * MiB, WS_KA = 528 * MiB, WS_VA = 592 * MiB;
constexpr size_t WS_T = WS_KA;
constexpr size_t WS_CQ = 672 * MiB, WS_CKV = 720 * MiB;
constexpr size_t WS_KR = 760 * MiB;
constexpr size_t WS_QB = 768 * MiB, WS_KB = 864 * MiB, WS_VB = 928 * MiB;
constexpr size_t WS_Y = WS_QB;
constexpr size_t WS_X1 = 896 * MiB;
constexpr size_t WS_H8 = WS_QB;
constexpr size_t WS_WG8 = 60 * MiB;
constexpr size_t WS_U = 208 * MiB;
constexpr size_t WS_END = 1024 * MiB;
static_assert(WS_H + (size_t)MTOK * LDH * 2 <= WS_G && WS_G + (size_t)MTOK * 2 * DM * 2 <= WS_QA && WS_T + (size_t)MTOK * LDH * 2 <= WS_CQ && WS_CQ + (size_t)MTOK * QLORA * 2 <= WS_CKV && WS_CKV + (size_t)MTOK * LDKV * 2 <= WS_KR, "d_ws map");
static_assert(WS_U + (size_t)MTOK * LDU * 2 <= WS_KR && WS_Y + (size_t)MTOK * DM * 2 <= WS_X1 && WS_X1 + (size_t)MTOK * DM * 2 <= WS_END && WS_VB + (size_t)MTOK * AW * 2 <= WS_END && WS_KR + (size_t)MTOK * RDIM * 2 <= WS_QB, "d_ws map");
static_assert(WS_WIN + (size_t)INWP * LDH * 2 <= WS_WUQ && WS_WUKV + (size_t)1024 * LDKV * 2 <= WS_WA && WS_WA + (size_t)DM * LDH * 2 <= WS_WOUT && WS_WOUT + (size_t)DM * LDH * 2 <= WS_WUP && WS_WUP + (size_t)DFF * LDH * 2 <= WS_WDN && WS_WDN + (size_t)DM * LDU * 2 <= WS_H, "d_ws map");
constexpr int CW_BAR = 0;
constexpr int NWAVES = 8;
constexpr int RING_OFF = 0, RING_BYTES = 131072;
constexpr int LDSCTL_OFF = RING_BYTES, MISC_OFF = LDSCTL_OFF + 320;
constexpr int LDS_BYTES = 147456;
static_assert(att::L_END <= RING_BYTES, "attention LDS map");

struct Frame {
    LAS unsigned char* lds;
    volatile LAS unsigned* MISC;
    gu32* ctl;
    int tid, lane, wave, vcu, G;
};

__device__ __forceinline__ float wave_sum(float v) {
#pragma unroll
    for (int o = 1; o < 64; o <<= 1) v += __shfl_xor(v, o);
    return v;
}
__device__ __forceinline__ int srccol(int mat, int n) {
    if (mat == 0) {
        if (n < 1024) { const int sect = n >> 9, c = n & 511, head = c >> 6, p = c & 63; const int d = (p < 16) ? ((p >> 1) + 8 * (p & 1)) : p; return sect * 512 + head * 64 + d; }
        if (n < 1920) return n;
        if (n < 1952) { const int pr = n - 1920; return 2176 + (pr >> 1) + 16 * (pr & 1); }
        if (n < 2048) return -1;
        if (n < 2304) return 1920 + (n - 2048);
        return 2208 + (n - 2304);
    }
    if (mat == 1) { const int head = n / QKB, p = n - head * QKB; if (p < 64) return n; const int pr = p - 64; return head * QKB + 64 + (pr >> 1) + 16 * (pr & 1); }
    return n;
}
__device__ __forceinline__ void p0_transpose_item(const float* W, int K, int Nsrc, int Ndst, bf16* WT, int ldw, int koff, const float* gs, int mat, LAS float* scr, int item, int lane) {
    const int nblk = Ndst / 32, kb = item / nblk, nb = item % nblk, k0 = 64 * kb, n0 = 32 * nb;
    const int sc = srccol(mat, n0 + (lane & 31));
#pragma unroll
    for (int i = 0; i < 32; ++i) { const int kk = 2 * i + (lane >> 5); float v = (sc >= 0) ? W[(size_t)(k0 + kk) * Nsrc + sc] : 0.f; if (gs) v *= gs[k0 + kk]; scr[kk * 33 + (lane & 31)] = v; }
    LDS_WAIT(); asm volatile("" ::: "memory");
    const int c = lane & 7;
#pragma unroll
    for (int j = 0; j < 4; ++j) { const int n = (lane >> 3) + 8 * j; const LAS float* s = scr + (8 * c) * 33 + n;
        v4u o; o.x = pk2(s[0 * 33], s[1 * 33]); o.y = pk2(s[2 * 33], s[3 * 33]); o.z = pk2(s[4 * 33], s[5 * 33]); o.w = pk2(s[6 * 33], s[7 * 33]);
        *(GAS v4u*)(WT + (size_t)(n0 + n) * ldw + koff + k0 + 8 * c) = o; }
    LDS_WAIT(); asm volatile("" ::: "memory");
}
__device__ __forceinline__ int ppos_dn(int c) { return (c & ~255) | (((c >> 5) & 3) << 6) | (((c >> 3) & 3) << 4) | (((c >> 7) & 1) << 3) | (c & 7); }
template <bool KPERM = false>
__device__ __forceinline__ void p0_transpose_item_f8(const float* W, int K, int N, int Nsrc, int coff, unsigned char* WT, float scale, LAS float* scr, int item, int lane) {
    const int nblk = N / 32, kb = item / nblk, nb = item % nblk, k0 = 64 * kb, n0 = 32 * nb;
#pragma unroll
    for (int i = 0; i < 32; ++i) { const int kk = 2 * i + (lane >> 5); scr[kk * 33 + (lane & 31)] = W[(size_t)(k0 + kk) * Nsrc + coff + n0 + (lane & 31)] * scale; }
    LDS_WAIT(); asm volatile("" ::: "memory");
    const int c = lane & 7;
#pragma unroll
    for (int j = 0; j < 4; ++j) { const int n = (lane >> 3) + 8 * j; const LAS float* s = scr + (8 * c) * 33 + n;
        int w0 = 0, w1 = 0;
        w0 = __builtin_amdgcn_cvt_pk_fp8_f32(s[0 * 33], s[1 * 33], w0, false); w0 = __builtin_amdgcn_cvt_pk_fp8_f32(s[2 * 33], s[3 * 33], w0, true);
        w1 = __builtin_amdgcn_cvt_pk_fp8_f32(s[4 * 33], s[5 * 33], w1, false); w1 = __builtin_amdgcn_cvt_pk_fp8_f32(s[6 * 33], s[7 * 33], w1, true);
        typedef int i32x2_ __attribute__((ext_vector_type(2)));
        *(GAS i32x2_*)(WT + (size_t)(n0 + n) * K + (KPERM ? ppos_dn(k0 + 8 * c) : k0 + 8 * c)) = (i32x2_){w0, w1}; }
    LDS_WAIT(); asm volatile("" ::: "memory");
}
__device__ __forceinline__ void rms_row_to_bf16(int lane, const f32x4 (&v)[4], const f32x4 (&g)[4], bf16* orow, unsigned char* orow8) {
    float s = 0.f;
#pragma unroll
    for (int j = 0; j < 4; ++j) s += (v[j].x * v[j].x + v[j].y * v[j].y) + (v[j].z * v[j].z + v[j].w * v[j].w);
    const float rstd = 1.f / sqrtf(wave_sum(s) * (1.f / DM) + EPS);
    GAS unsigned long long* o8 = (GAS unsigned long long*)orow + lane;
#pragma unroll
    for (int j = 0; j < 4; ++j) { const f32x4 y = v[j] * rstd * g[j]; o8[64 * j] = (unsigned long long)pk2(y.x, y.y) | ((unsigned long long)pk2(y.z, y.w) << 32);
        int w = 0; w = __builtin_amdgcn_cvt_pk_fp8_f32(y.x, y.y, w, false); w = __builtin_amdgcn_cvt_pk_fp8_f32(y.z, y.w, w, true); ((GAS int*)orow8)[lane + 64 * j] = w; }
}

struct Args { const float* in[17]; float* out; unsigned char* ws; int ph_lo, ph_hi, li, pad; };

__global__ void __launch_bounds__(NWAVES * 64, 2) block_fwd(Args args) {
    extern __shared__ __attribute__((aligned(16))) unsigned char lds[];
    Frame F;
    F.lds = (LAS unsigned char*)lds;
    F.MISC = (volatile LAS unsigned*)(F.lds + MISC_OFF);
    F.tid = threadIdx.x; F.lane = F.tid & 63; F.wave = __builtin_amdgcn_readfirstlane(F.tid >> 6);
    F.G = gridDim.x; { const int bx = blockIdx.x; F.vcu = (F.G % 8 == 0) ? (bx % 8) * (F.G / 8) + bx / 8 : bx; }
    unsigned char* ws = args.ws;
    F.ctl = (gu32*)(ws + WS_CTL);
    const float* x = args.in[0]; const int* positions = (const int*)args.in[1];
    const float *g_pre_mix = args.in[2], *w_in = args.in[3], *b_gate = args.in[4], *g_q = args.in[5], *w_uq = args.in[6], *g_kv = args.in[7], *w_ukv = args.in[8], *w_a = args.in[9], *w_b = args.in[10],
                *w_out = args.in[11], *g_post_mix = args.in[12], *g_pre_mlp = args.in[13], *w_up = args.in[14], *w_dn = args.in[15], *g_post_mlp = args.in[16];
    float* out = args.out;
    float* ropeA = (float*)(ws + WS_ROPEA); float* ropeB = (float*)(ws + WS_ROPEB);
    float* SS = (float*)(ws + WS_SS); float* SS2 = (float*)(ws + WS_SS2); float* SS3 = (float*)(ws + WS_SS3);
    bf16 *WIN = (bf16*)(ws + WS_WIN), *WUQ = (bf16*)(ws + WS_WUQ), *WUKV = (bf16*)(ws + WS_WUKV), *WA = (bf16*)(ws + WS_WA), *WOUT = (bf16*)(ws + WS_WOUT), *WUP = (bf16*)(ws + WS_WUP), *WDN = (bf16*)(ws + WS_WDN);
    bf16 *H = (bf16*)(ws + WS_H), *Gt = (bf16*)(ws + WS_G), *QA = (bf16*)(ws + WS_QA), *KA = (bf16*)(ws + WS_KA), *VA = (bf16*)(ws + WS_VA), *T = (bf16*)(ws + WS_T), *CQ = (bf16*)(ws + WS_CQ), *CKV = (bf16*)(ws + WS_CKV),
         *KR = (bf16*)(ws + WS_KR), *QB = (bf16*)(ws + WS_QB), *KB = (bf16*)(ws + WS_KB), *VB = (bf16*)(ws + WS_VB), *Y = (bf16*)(ws + WS_Y), *U = (bf16*)(ws + WS_U), *X1B = (bf16*)(ws + WS_X1); unsigned char *H8 = ws + WS_H8, *WG8 = ws + WS_WG8;
    for (int u = F.tid; u < (LDS_BYTES - LDSCTL_OFF) / 4; u += NWAVES * 64) ((LAS unsigned*)(F.lds + LDSCTL_OFF))[u] = 0u;
    __syncthreads();
    XcdBarrier bar = xcd_barrier_post((unsigned*)(F.ctl + CW_BAR) + args.li * XCD_BAR_WORDS, F.MISC + 8);
    const int lo = args.ph_lo, hi = args.ph_hi;
#define IN(k) (lo <= (k) && (k) < hi)
#define SEAM(k) do { if (IN(k) && IN((k) + 1)) xcd_barrier(bar); } while (0)
    const int gw = F.vcu * NWAVES + F.wave, NGW = F.G * NWAVES;

#if !defined(SKIP_P0)
    if (IN(0))
    {
        LAS float* scr = (LAS float*)(F.lds + RING_OFF + F.wave * 16384);
        constexpr int NBF = 2304, IG = (DM / 64) * (2 * DM / 32);
        constexpr int I0 = (DM / 64) * (NBF / 32), I1 = (QLORA / 64) * (768 / 32), I2 = (KVLORA / 64) * (1024 / 32), I3 = (AW / 64) * (DM / 32), I5 = (DM / 64) * (DM / 32), I6 = (DM / 64) * (DFF / 32), I7 = (DFF / 64) * (DM / 32);
        constexpr int NITEMS = I0 + I1 + I2 + 2 * I3 + I5 + I6 + I7 + IG;
        constexpr int TW = 4, RW = NWAVES - TW;
        if (F.wave >= RW)
        for (int it = F.vcu * TW + (F.wave - RW); it < NITEMS; it += F.G * TW) {
            int r = it;
            if (r < I0) { p0_transpose_item(w_in, DM, INW, NBF, WIN, LDH, 0, nullptr, 0, scr, r, F.lane); continue; } r -= I0;
            if (r < IG) { p0_transpose_item_f8(w_in, DM, 2 * DM, INW, 2208, WG8, 32.f, scr, r, F.lane); continue; } r -= IG;
            if (r < I1) { p0_transpose_item(w_uq, QLORA, 768, 768, WUQ, QLORA, 0, g_q, 1, scr, r, F.lane); continue; } r -= I1;
            if (r < I2) { p0_transpose_item(w_ukv, KVLORA, 1024, 1024, WUKV, LDKV, 0, g_kv, 2, scr, r, F.lane); continue; } r -= I2;
            if (r < I3) { p0_transpose_item(w_a, AW, DM, DM, WA, LDH, 0, nullptr, 2, scr, r, F.lane); continue; } r -= I3;
            if (r < I3) { p0_transpose_item(w_b, AW, DM, DM, WA, LDH, AW, nullptr, 2, scr, r, F.lane); continue; } r -= I3;
            if (r < I5) { p0_transpose_item_f8<true>(w_out, DM, DM, DM, 0, (unsigned char*)WOUT, 32.f, scr, r, F.lane); continue; } r -= I5;
            if (r < I6) { p0_transpose_item_f8(w_up, DM, DFF, DFF, 0, (unsigned char*)WUP, 32.f, scr, r, F.lane); continue; } r -= I6;
            p0_transpose_item_f8<true>(w_dn, DFF, DM, DM, 0, (unsigned char*)WDN, 64.f, scr, r, F.lane);
        }
        if (F.wave >= RW)
        for (int idx = (int)blockIdx.x * (TW * 64) + (F.tid - RW * 64); idx < MTOK * 24; idx += F.G * TW * 64) {
            const int m = idx / 24, i = idx - m * 24;
            const float invf = (i < 8) ? __builtin_amdgcn_exp2f(-(float)i * 2.3664460711655217f) : __builtin_amdgcn_exp2f(-(float)(i - 8) * 1.1832230355827609f);
            const float ang = (float)positions[m] * invf;
            double t = (double)ang * 0.15915494309189535; t -= floor(t);
            const float tf = (float)t; const float c = __builtin_amdgcn_cosf(tf), s = __builtin_amdgcn_sinf(tf);
            float* dst = (i < 8) ? ropeA + (size_t)m * 16 + 2 * i : ropeB + (size_t)m * 32 + 2 * (i - 8);
            *(f32x2g*)dst = (f32x2g){c, s};
        }
        f32x4 g[4];
#pragma unroll
        for (int j = 0; j < 4; ++j) g[j] = ((const GAS f32x4*)g_pre_mix)[F.lane + 64 * j];
        {
            f32x4 cv[4], n1[4], n2[4];
            const int rw0 = (F.wave < RW) ? F.vcu * RW + F.wave : MTOK, RST = F.G * RW;
#define P0_LOADROW(V, mm) do { _Pragma("unroll") for (int j = 0; j < 4; ++j) V[j] = ((const GAS f32x4*)(x + (size_t)(mm) * DM) + F.lane)[64 * j]; } while (0)
            if (rw0 < MTOK) P0_LOADROW(cv, rw0);
            if (rw0 + RST < MTOK) P0_LOADROW(n1, rw0 + RST);
            for (int m = rw0; m < MTOK; m += RST) {
                if (m + 2 * RST < MTOK) P0_LOADROW(n2, m + 2 * RST);
                rms_row_to_bf16(F.lane, cv, g, H + (size_t)m * LDH, H8 + (size_t)m * DM);
#pragma unroll
                for (int j = 0; j < 4; ++j) { cv[j] = n1[j]; n1[j] = n2[j]; }
            }
#undef P0_LOADROW
        }
    }
#endif
    SEAM(0);

#if !defined(SKIP_P1)
    if (IN(1))
    {
        { pg8::Gemm g{H, WIN, MTOK, 2304, DM, LDH, LDH}; pg8::StaticOrder S; S.init(MTOK, 2304, F.G, (int)blockIdx.x);
          pg8::EpiIn E{QA, KA, VA, CQ, CKV, KR, Gt, SS, ropeA, ropeB, b_gate};
          pg8::gemm_phase<pg8::EpiIn, pg8::StaticOrder, true, true>(F.lds + RING_OFF, g, S, E); }
        { pg8::Gemm g{(const bf16*)H8, (const bf16*)WG8, MTOK, 2 * DM, DM, DM, DM}; pg8::StaticOrder S; S.init(MTOK, 2 * DM, F.G, (int)blockIdx.x);
          pg8::EpiGates E{Gt, b_gate};
          pg8::gemm_phase<pg8::EpiGates, pg8::StaticOrder, true, true, 1>(F.lds + RING_OFF, g, S, E); }
    }
#endif
    SEAM(1);

#if !defined(SKIP_P2)
    if (IN(2)) {
    {
        pg8::Gemm g{CQ, WUQ, MTOK, NHEAD * QKB, QLORA}; pg8::StaticOrder S; S.init(MTOK, NHEAD * QKB, F.G, (int)blockIdx.x);
        pg8::EpiQ E{QB, SS, ropeB};
        pg8::gemm_phase<pg8::EpiQ, pg8::StaticOrder, true, true, 2, true>(F.lds + RING_OFF, g, S, E);
    }
    {
        pg8::Gemm g{CKV, WUKV, MTOK, 2 * AW, KVLORA, LDKV, LDKV}; pg8::StaticOrder S; S.init(MTOK, 2 * AW, F.G, (int)blockIdx.x);
        pg8::EpiKV E{KB, VB, SS};
        pg8::gemm_phase<pg8::EpiKV, pg8::StaticOrder, true, true, 2, true>(F.lds + RING_OFF, g, S, E);
    }
    }
#endif
    SEAM(2);

#if !defined(SKIP_P3)
    if (IN(3))
    {
        LAS char* al = (LAS char*)(F.lds + RING_OFF);
#if !defined(SKIP_MOBA)
        for (int bh = F.vcu; bh < NB * NHEAD; bh += F.G) {
            const int b = bh >> 3, h = bh & 7; const size_t r0 = (size_t)b * SEQ;
            att::kmean_blocks(KA + r0 * AW + h * HD * 16, al);
#pragma unroll 1
            for (int qb = 0; qb < 8; ++qb) att::moba_unit(QA + r0 * AW + h * HD * 16, KA + r0 * AW + h * HD * 16, VA + r0 * AW + h * HD * 16, H + r0 * LDH + h * HD * 16, LDH, qb, al);
        }
#endif
#if !defined(SKIP_MLA)
        for (int bh = F.vcu; bh < NB * NHEAD; bh += F.G) {
            const int b = bh >> 3, h = bh & 7; const size_t r0 = (size_t)b * SEQ;
#pragma unroll 1
            for (int qb = 0; qb < 8; ++qb) att::mla_unit(QB + r0 * (NHEAD * QKB) + h * QKB * 16, KB + r0 * AW + h * HD * 16, KR + r0 * RDIM, VB + r0 * AW + h * HD * 16, H + r0 * LDH + (AW + h * HD) * 16, LDH, qb, al);
        }
#endif
    }
#endif
    SEAM(3);

#if !defined(SKIP_P4)
    if (IN(4))
    {
        pg8::Gemm g{H, WA, MTOK, DM, DM, LDH, LDH}; pg8::StaticOrder S; S.init(MTOK, DM, F.G, (int)blockIdx.x);
        pg8::EpiMerge E{Gt, T};
        pg8::gemm_phase<pg8::EpiMerge, pg8::StaticOrder, true, true, 2, true>(F.lds + RING_OFF, g, S, E);
    }
#endif
    SEAM(4);

#if !defined(SKIP_P5)
    if (IN(5))
    {
        pg8::Gemm g{T, WOUT, MTOK, DM, DM, DM, DM}; pg8::StaticOrder S; S.init(MTOK, DM, F.G, (int)blockIdx.x);
        pg8::EpiSS E{Y, SS2, DM, 1.0f / 2048.0f};
        pg8::gemm_phase<pg8::EpiSS, pg8::StaticOrder, true, true, 1, true>(F.lds + RING_OFF, g, S, E);
    }
#endif
    SEAM(5);

#if !defined(SKIP_P6)
    if (IN(6))
    {
        f32x4 g1[4], g2[4];
#pragma unroll
        for (int j = 0; j < 4; ++j) { g1[j] = ((const GAS f32x4*)g_post_mix)[F.lane + 64 * j]; g2[j] = ((const GAS f32x4*)g_pre_mlp)[F.lane + 64 * j]; }
        f32x4 ca, cb, cc, cd, cx[4]; unsigned long long cy[4];
#define P6_LOAD(A, B, C, D, X, Yv, mm) do { const GAS f32x4* sp_ = (const GAS f32x4*)(SS2 + (size_t)(mm) * 16); A = sp_[0]; B = sp_[1]; C = sp_[2]; D = sp_[3]; \
            const GAS f32x4* xr_ = (const GAS f32x4*)(x + (size_t)(mm) * DM) + F.lane; const GAS unsigned long long* yr_ = (const GAS unsigned long long*)(Y + (size_t)(mm) * DM) + F.lane; \
            _Pragma("unroll") for (int j = 0; j < 4; ++j) { X[j] = xr_[64 * j]; Yv[j] = yr_[64 * j]; } } while (0)
        if (gw < MTOK) P6_LOAD(ca, cb, cc, cd, cx, cy, gw);
        for (int m = gw; m < MTOK; m += NGW) {
            f32x4 na, nb, nc, nd, nx[4]; unsigned long long ny[4];
            const bool more = m + NGW < MTOK;
            if (more) P6_LOAD(na, nb, nc, nd, nx, ny, m + NGW);
            const f32x4 a = ca, b = cb, c = cc, d = cd;
            const float ssy = (((a.x + a.y) + (a.z + a.w)) + ((b.x + b.y) + (b.z + b.w))) + (((c.x + c.y) + (c.z + c.w)) + ((d.x + d.y) + (d.z + d.w)));
            const float rsy = 1.f / sqrtf(ssy * (1.f / DM) + EPS);
            GAS unsigned long long* x8 = (GAS unsigned long long*)(X1B + (size_t)m * DM) + F.lane;
            f32x4 v[4]; float s = 0.f;
#pragma unroll
            for (int j = 0; j < 4; ++j) { const unsigned long long yw = cy[j]; const unsigned lo = (unsigned)yw, hi = (unsigned)(yw >> 32);
                const f32x4 yv = (f32x4){__uint_as_float(lo << 16), __uint_as_float(lo & 0xffff0000u), __uint_as_float(hi << 16), __uint_as_float(hi & 0xffff0000u)};
                v[j] = cx[j] + yv * rsy * g1[j]; x8[64 * j] = (unsigned long long)pk2(v[j].x, v[j].y) | ((unsigned long long)pk2(v[j].z, v[j].w) << 32);
                s += (v[j].x * v[j].x + v[j].y * v[j].y) + (v[j].z * v[j].z + v[j].w * v[j].w); }
            const float rstd = 1.f / sqrtf(wave_sum(s) * (1.f / DM) + EPS);
            GAS int* o8 = (GAS int*)((unsigned char*)H + (size_t)m * DM) + F.lane;
#pragma unroll
            for (int j = 0; j < 4; ++j) { const f32x4 y2 = v[j] * rstd * g2[j]; int w = 0; w = __builtin_amdgcn_cvt_pk_fp8_f32(y2.x, y2.y, w, false); w = __builtin_amdgcn_cvt_pk_fp8_f32(y2.z, y2.w, w, true); o8[64 * j] = w; }
            if (more) { ca = na; cb = nb; cc = nc; cd = nd;
#pragma unroll
                for (int j = 0; j < 4; ++j) { cx[j] = nx[j]; cy[j] = ny[j]; } }
        }
#undef P6_LOAD
    }
#endif
    SEAM(6);

#if !defined(SKIP_P7)
    if (IN(7))
    {
        pg8::Gemm g{H, WUP, MTOK, DFF, DM, DM, DM}; pg8::StaticOrder S; S.init(MTOK, DFF, F.G, (int)blockIdx.x);
        pg8::EpiRelu2F8 E{(unsigned char*)U, 1.0f / 32.0f};
        pg8::gemm_phase<pg8::EpiRelu2F8, pg8::StaticOrder, true, true, 1>(F.lds + RING_OFF, g, S, E);
    }
#endif
    SEAM(7);

#if !defined(SKIP_P8)
    if (IN(8))
    {
        pg8::Gemm g{U, WDN, MTOK, DM, DFF, DFF, DFF}; pg8::StaticOrder S; S.init(MTOK, DM, F.G, (int)blockIdx.x);
        pg8::EpiSS E{H, SS3, LDH, 1.0f / 64.0f};
        pg8::gemm_phase<pg8::EpiSS, pg8::StaticOrder, true, true, 1, true>(F.lds + RING_OFF, g, S, E);
    }
#endif
    SEAM(8);

#if !defined(SKIP_P9)
    if (IN(9))
    {
        f32x4 g1[4];
#pragma unroll
        for (int j = 0; j < 4; ++j) g1[j] = ((const GAS f32x4*)g_post_mlp)[F.lane + 64 * j];
        f32x4 ca, cb, cc, cd; unsigned long long cy[4], cq[4];
#define P9_LOAD(A, B, C, D, Yv, Q, mm) do { const GAS f32x4* sp_ = (const GAS f32x4*)(SS3 + (size_t)(mm) * 16); A = sp_[0]; B = sp_[1]; C = sp_[2]; D = sp_[3]; \
            const GAS unsigned long long* yr_ = (const GAS unsigned long long*)(H + (size_t)(mm) * LDH) + F.lane; const GAS unsigned long long* xq_ = (const GAS unsigned long long*)(X1B + (size_t)(mm) * DM) + F.lane; \
            _Pragma("unroll") for (int j = 0; j < 4; ++j) { Yv[j] = yr_[64 * j]; Q[j] = xq_[64 * j]; } } while (0)
        if (gw < MTOK) P9_LOAD(ca, cb, cc, cd, cy, cq, gw);
        for (int m = gw; m < MTOK; m += NGW) {
            f32x4 na, nb, nc, nd; unsigned long long ny[4], nq[4];
            const bool more = m + NGW < MTOK;
            if (more) P9_LOAD(na, nb, nc, nd, ny, nq, m + NGW);
            const f32x4 a = ca, b = cb, c = cc, d = cd;
            const float ssy = (((a.x + a.y) + (a.z + a.w)) + ((b.x + b.y) + (b.z + b.w))) + (((c.x + c.y) + (c.z + c.w)) + ((d.x + d.y) + (d.z + d.w)));
            const float rsy = 1.f / sqrtf(ssy * (1.f / DM) + EPS);
            GAS f32x4* o4 = (GAS f32x4*)(out + (size_t)m * DM) + F.lane;
#pragma unroll
            for (int j = 0; j < 4; ++j) { const unsigned long long yw = cy[j]; const unsigned lo = (unsigned)yw, hi = (unsigned)(yw >> 32);
                const f32x4 yv = (f32x4){__uint_as_float(lo << 16), __uint_as_float(lo & 0xffff0000u), __uint_as_float(hi << 16), __uint_as_float(hi & 0xffff0000u)};
                const unsigned long long xw = cq[j]; const unsigned xl = (unsigned)xw, xh = (unsigned)(xw >> 32);
                const f32x4 xv = (f32x4){__uint_as_float(xl << 16), __uint_as_float(xl & 0xffff0000u), __uint_as_float(xh << 16), __uint_as_float(xh & 0xffff0000u)};
                o4[64 * j] = xv + yv * rsy * g1[j]; }
            if (more) { ca = na; cb = nb; cc = nc; cd = nd;
#pragma unroll
                for (int j = 0; j < 4; ++j) { cy[j] = ny[j]; cq[j] = nq[j]; } }
        }
#undef P9_LOAD
    }
#endif
}

extern "C" void kernel_launch(void* const* d_in, const int* in_sizes, int n_in, void* d_out, int out_size, void* d_ws, size_t ws_size, hipStream_t stream) {
    static int grid = 0;
    if (grid == 0) {
        if (n_in != 17 || in_sizes[0] != MTOK * DM || out_size != MTOK * DM || ws_size < WS_END) { fprintf(stderr, "kernel_launch: unexpected shapes (n_in %d, in0 %d, out %d, ws %zu); nothing launched\n", n_in, n_in > 0 ? in_sizes[0] : -1, out_size, ws_size); grid = -1; return; }
        int dev = 0, cus = 0, per_cu = 0;
        if (hipGetDevice(&dev) != hipSuccess || hipDeviceGetAttribute(&cus, hipDeviceAttributeMultiprocessorCount, dev) != hipSuccess) { fprintf(stderr, "kernel_launch: device query failed\n"); grid = -1; return; }
        if (hipFuncSetAttribute((const void*)block_fwd, hipFuncAttributeMaxDynamicSharedMemorySize, LDS_BYTES) != hipSuccess) { fprintf(stderr, "kernel_launch: hipFuncSetAttribute failed\n"); grid = -1; return; }
        if (hipOccupancyMaxActiveBlocksPerMultiprocessor(&per_cu, (const void*)block_fwd, NWAVES * 64, LDS_BYTES) != hipSuccess || per_cu < 1) { fprintf(stderr, "kernel_launch: occupancy query reports %d workgroups per CU\n", per_cu); }
        (void)hipGetLastError();
        grid = cus;
    }
    if (grid < 0) return;
    if (hipMemsetAsync((char*)d_ws + WS_CTL, 0, CTL_ZERO_BYTES, stream) != hipSuccess) { fprintf(stderr, "kernel_launch: hipMemsetAsync failed\n"); return; }
    Args a{};
    for (int i = 0; i < 17; ++i) a.in[i] = (const float*)d_in[i];
    a.out = (float*)d_out; a.ws = (unsigned char*)d_ws;
    a.ph_lo = 0; a.ph_hi = 10; a.li = 0;
    hipLaunchKernelGGL(block_fwd, dim3(grid), dim3(NWAVES * 64), LDS_BYTES, stream, a);
    const hipError_t le = hipPeekAtLastError();
    if (le != hipSuccess) fprintf(stderr, "kernel_launch: launch failed: %s\n", hipGetErrorName(le));
}
```

```cpp
#include <hip/hip_runtime.h>
#include <hip/hip_bf16.h>
#include <cstdio>
#include <cstdint>
#include <cmath>
constexpr int NB = 32, SEQ = 2048, DM = 1024, MTOK = NB * SEQ;
constexpr int NHEAD = 8, HD = 64, AW = NHEAD * HD;
constexpr int QLORA = 384, KVLORA = 256, RDIM = 32, QKB = 96;
constexpr int DFF = 4096, INW = 4256, INWP = 4352;
constexpr int LDH = DM, LDU = DFF, LDKV = KVLORA;
constexpr float EPS = 1e-6f;
constexpr float LOG2E = 1.4426950408889634f;
constexpr float C2A = 0.125f * LOG2E;
constexpr float C2B = 0.10206207261596575f * LOG2E;
typedef float f32x2g __attribute__((ext_vector_type(2)));
namespace pg8 {
#define PG8_LAS __attribute__((address_space(3)))
typedef unsigned short bf16_t;
typedef short bf16x8 __attribute__((ext_vector_type(8)));
typedef float f32x4 __attribute__((ext_vector_type(4)));
typedef unsigned u32x4 __attribute__((ext_vector_type(4)));
constexpr int BM = 256, BK = 64, HALF = 128, HTB = HALF * BK * 2  , STAGE_BYTES = 8 * HTB, NXCD = 8, WGM = 8;

__host__ __device__ __forceinline__ int lds_byte(int r, int c) { const int st = (r >> 4) * 2 + (c >> 5), rr = r & 15, cc = c & 31, ob = rr * 64 + cc * 2; return st * 1024 + (ob ^ (((ob >> 9) & 1) << 5)); }
__host__ __device__ __forceinline__ void stage_rc(int b, int& R, int& C) { const int st = b / 1024, sb = b % 1024, swz = sb ^ (((sb >> 9) & 1) << 5); R = (st >> 1) * 16 + swz / 64; C = (st & 1) * 32 + (swz % 64) / 2; }
__host__ __device__ __forceinline__ int perm32(int rho) { const int n = rho >> 4, i = rho & 15; return 8 * (i >> 2) + 4 * n + (i & 3); }

struct Unit { int pm, pn; };
struct Gemm { const bf16_t* A; const bf16_t* Bt; int M, N, K, lda, ldb; };

struct StaticOrder {
    int nM, nN, nwg, G, c;
    __host__ __device__ void init(int M, int N, int G_, int c_) { nM = M / BM; nN = N / BM; nwg = nM * nN; G = G_; c = c_; }
    __host__ __device__ bool next(int i, Unit& u) const {
        const long L = (long)i * G + c; if (L >= nwg) return false;
        int wgid = (int)L; { const int q = nwg / NXCD, r = nwg % NXCD, xcd = wgid % NXCD, off = wgid / NXCD; wgid = (xcd < r ? xcd * (q + 1) : r * (q + 1) + (xcd - r) * q) + off; }
        const int nig = WGM * nN, gid = wgid / nig, fm = gid * WGM, gsz = (nM - fm) < WGM ? (nM - fm) : WGM;
        u.pm = fm + ((wgid % nig) % gsz); u.pn = (wgid % nig) / gsz; return true;
    }
    __device__ __forceinline__ void a_ready(const Unit&) const {}
    __device__ __forceinline__ void done(const Unit&) const {}
};

__device__ __forceinline__ unsigned cvt_pk_bf16(float lo, float hi) { unsigned r; asm volatile("v_cvt_pk_bf16_f32 %0, %1, %2" : "=v"(r) : "v"(lo), "v"(hi)); return r; }
__device__ __forceinline__ void ld8(float (&v)[8], const f32x4& a, const f32x4& b) { v[0] = a[0]; v[1] = a[1]; v[2] = a[2]; v[3] = a[3]; v[4] = b[0]; v[5] = b[1]; v[6] = b[2]; v[7] = b[3]; }
typedef float f32x2c_t __attribute__((ext_vector_type(2))); typedef __bf16 bf16x2c_t __attribute__((ext_vector_type(2)));
__device__ __forceinline__ unsigned cvtpk_c(float lo, float hi) { const f32x2c_t v = {lo, hi}; const bf16x2c_t b = __builtin_convertvector(v, bf16x2c_t); return __builtin_bit_cast(unsigned, b); }
__device__ __forceinline__ u32x4 pack8(const float (&v)[8]) { u32x4 w; w.x = cvtpk_c(v[0], v[1]); w.y = cvtpk_c(v[2], v[3]); w.z = cvtpk_c(v[4], v[5]); w.w = cvtpk_c(v[6], v[7]); return w; }
__device__ __forceinline__ void unpack8(const u32x4 w, float (&v)[8]) {
    v[0] = __uint_as_float(w.x << 16); v[1] = __uint_as_float(w.x & 0xffff0000u); v[2] = __uint_as_float(w.y << 16); v[3] = __uint_as_float(w.y & 0xffff0000u);
    v[4] = __uint_as_float(w.z << 16); v[5] = __uint_as_float(w.z & 0xffff0000u); v[6] = __uint_as_float(w.w << 16); v[7] = __uint_as_float(w.w & 0xffff0000u); }
__device__ __forceinline__ void rope4(float (&v)[8], const f32x4 a, const f32x4 b) {
    float x1, x2;
    x1 = v[0]; x2 = v[1]; v[0] = x1 * a[0] - x2 * a[1]; v[1] = x2 * a[0] + x1 * a[1];
    x1 = v[2]; x2 = v[3]; v[2] = x1 * a[2] - x2 * a[3]; v[3] = x2 * a[2] + x1 * a[3];
    x1 = v[4]; x2 = v[5]; v[4] = x1 * b[0] - x2 * b[1]; v[5] = x2 * b[0] + x1 * b[1];
    x1 = v[6]; x2 = v[7]; v[6] = x1 * b[2] - x2 * b[3]; v[7] = x2 * b[2] + x1 * b[3];
}
__device__ __forceinline__ float sumsq8(const float (&v)[8]) { return ((v[0] * v[0] + v[1] * v[1]) + (v[2] * v[2] + v[3] * v[3])) + ((v[4] * v[4] + v[5] * v[5]) + (v[6] * v[6] + v[7] * v[7])); }
__device__ __forceinline__ float red_fq(float s) { s += __shfl_xor(s, 16); s += __shfl_xor(s, 32); return s; }

__device__ __forceinline__ size_t chk_off(int r16, int c32, int ld) { return (size_t)r16 * ld + (size_t)c32 * 16; }
__device__ __forceinline__ size_t gfrag_off(int pm, int t8, int wid, int grp, int lane) { return ((((size_t)(pm * 8 + t8) * 8 + wid) * 16 + grp) * 64 + lane) * 8; }
struct EpiIn {
    static constexpr bool PERM = true, AFTER_DRAIN = false; static constexpr int MIDT = 0;
    bf16_t *QA, *KA, *VA, *CQ, *CKV, *KR, *G; float* SS; const float* ropeA; const float* ropeB; const float* bgate;
    __device__ __forceinline__ void operator()(const f32x4 (&acc)[2][2][4][2], const Unit& u, int wr, int wc, int fr, int fq) const {
        asm volatile("" : "+v"(fr), "+v"(fq));
        const int row0 = u.pm * BM + wr * 64 + fr, pn = u.pn, cl = wc * 32 + 8 * fq;
        if (pn < 4) {
            bf16_t* dst = (pn < 2) ? QA : KA; const float sc = (pn < 2) ? C2A : 1.f; const int cb = (pn & 1) * 256 + wc * 32, l8 = (fq * 16 + fr) * 8;
            if ((wc & 1) == 0) {
                const bool rp = fq < 2;
                f32x4 ta[2][4], tb[2][4];
#pragma unroll
                for (int m = 0; m < 4; ++m) { const f32x4* t = (const f32x4*)(ropeA + (size_t)(row0 + m * 16) * 16 + (rp ? fq * 8 : 0)); ta[0][m] = t[0]; tb[0][m] = t[1]; }
#pragma unroll
                for (int ai = 0; ai < 2; ++ai) {
                    if (ai == 0) {
#pragma unroll
                        for (int m = 0; m < 4; ++m) { const f32x4* t = (const f32x4*)(ropeA + (size_t)(row0 + HALF + m * 16) * 16 + (rp ? fq * 8 : 0)); ta[1][m] = t[0]; tb[1][m] = t[1]; } }
                    asm volatile("" ::: "memory");
#pragma unroll
                    for (int m = 0; m < 4; ++m) { const int row = row0 + ai * HALF + m * 16;
                        f32x4 ca = ta[ai][m], cc = tb[ai][m]; if (!rp) { ca = (f32x4){1.f, 0.f, 1.f, 0.f}; cc = ca; }
#pragma unroll
                        for (int bj = 0; bj < 2; ++bj) { float v[8]; ld8(v, acc[ai][bj][m][0], acc[ai][bj][m][1]); rope4(v, ca, cc);
#pragma unroll
                            for (int j = 0; j < 8; ++j) v[j] *= sc;
                            *(u32x4*)(dst + chk_off(row - fr, cb + bj * HALF, AW) + l8) = pack8(v); } } }
            } else {
#pragma unroll
                for (int ai = 0; ai < 2; ++ai)
#pragma unroll
                    for (int m = 0; m < 4; ++m) { const int row = row0 + ai * HALF + m * 16;
#pragma unroll
                        for (int bj = 0; bj < 2; ++bj) { float v[8]; ld8(v, acc[ai][bj][m][0], acc[ai][bj][m][1]);
#pragma unroll
                            for (int j = 0; j < 8; ++j) v[j] *= sc;
                            *(u32x4*)(dst + chk_off(row - fr, cb + bj * HALF, AW) + l8) = pack8(v); } }
            }
        } else if (pn < 6) {
            const int cb = (pn - 4) * 256 + wc * 32, l8 = (fq * 16 + fr) * 8;
#pragma unroll
            for (int ai = 0; ai < 2; ++ai)
#pragma unroll
                for (int m = 0; m < 4; ++m) { const int row = row0 + ai * HALF + m * 16;
#pragma unroll
                    for (int bj = 0; bj < 2; ++bj) { float v[8]; ld8(v, acc[ai][bj][m][0], acc[ai][bj][m][1]); *(u32x4*)(VA + chk_off(row - fr, cb + bj * HALF, AW) + l8) = pack8(v); } }
        } else if (pn == 6 || pn == 8) {
            bf16_t* dst = (pn == 6) ? CQ : CKV; const int ld = (pn == 6) ? QLORA : LDKV, slot = ((pn == 6) ? 0 : 8) + wc;
#pragma unroll
            for (int ai = 0; ai < 2; ++ai)
#pragma unroll
                for (int m = 0; m < 4; ++m) { const int row = row0 + ai * HALF + m * 16; float s = 0.f;
#pragma unroll
                    for (int bj = 0; bj < 2; ++bj) { float v[8]; ld8(v, acc[ai][bj][m][0], acc[ai][bj][m][1]); s += sumsq8(v); *(u32x4*)(dst + chk_off(row - fr, wc * 32 + bj * HALF, ld) + (fq * 16 + fr) * 8) = pack8(v); }
                    s = red_fq(s); if (fq == 0) SS[(size_t)row * 12 + slot] = s; }
        } else if (pn == 7) {
            f32x4 ta[2][4], tb[2][4];
            if (wc == 0) {
#pragma unroll
                for (int ai = 0; ai < 2; ++ai)
#pragma unroll
                    for (int m = 0; m < 4; ++m) { const f32x4* t = (const f32x4*)(ropeB + (size_t)(row0 + ai * HALF + m * 16) * 32 + fq * 8); ta[ai][m] = t[0]; tb[ai][m] = t[1]; } }
            asm volatile("" ::: "memory");
#pragma unroll
            for (int ai = 0; ai < 2; ++ai)
#pragma unroll
                for (int m = 0; m < 4; ++m) { const int row = row0 + ai * HALF + m * 16;
                    { float v[8]; ld8(v, acc[ai][0][m][0], acc[ai][0][m][1]); float s = red_fq(sumsq8(v)); *(u32x4*)(CQ + chk_off(row - fr, 256 + wc * 32, QLORA) + (fq * 16 + fr) * 8) = pack8(v); if (fq == 0) SS[(size_t)row * 12 + 4 + wc] = s; }
                    if (wc == 0) { float v[8]; ld8(v, acc[ai][1][m][0], acc[ai][1][m][1]); rope4(v, ta[ai][m], tb[ai][m]);
                        *(u32x4*)(KR + chk_off(row - fr, 0, RDIM) + (fq * 16 + fr) * 8) = pack8(v); } }
        }
    }
};
struct EpiGates {
    static constexpr bool PERM = true, AFTER_DRAIN = false; static constexpr int MIDT = 0;
    bf16_t* G; const float* bgate;
    __device__ __forceinline__ void operator()(const f32x4 (&acc)[2][2][4][2], const Unit& u, int wr, int wc, int fr, int fq) const {
        asm volatile("" : "+v"(fr), "+v"(fq));
        const int gc = u.pn * 256 + wc * 32 + 8 * fq;
        f32x4 bv[2][2];
#pragma unroll
        for (int bj = 0; bj < 2; ++bj)
#pragma unroll
            for (int n = 0; n < 2; ++n) bv[bj][n] = *(const f32x4*)(bgate + gc + bj * HALF + 4 * n);
#pragma unroll
        for (int ai = 0; ai < 2; ++ai)
#pragma unroll
            for (int m = 0; m < 4; ++m) {
#pragma unroll
                for (int bj = 0; bj < 2; ++bj) { float v[8];
                    ld8(v, acc[ai][bj][m][0] * (-LOG2E / 32.0f) + bv[bj][0] * -LOG2E, acc[ai][bj][m][1] * (-LOG2E / 32.0f) + bv[bj][1] * -LOG2E);
#pragma unroll
                    for (int j = 0; j < 8; ++j) v[j] = __builtin_amdgcn_rcpf(1.f + __builtin_amdgcn_exp2f(v[j]));
                    *(u32x4*)(G + gfrag_off(u.pm, u.pn, wr * 4 + wc, ai * 8 + m * 2 + bj, fq * 16 + fr)) = pack8(v); } }
    }
};
struct EpiQ {
    static constexpr bool PERM = true, AFTER_DRAIN = false; static constexpr int MIDT = 0;
    bf16_t* QB; const float* SS; const float* ropeB;
    __device__ __forceinline__ void operator()(const f32x4 (&acc)[2][2][4][2], const Unit& u, int wr, int wc, int fr, int fq) const {
        asm volatile("" : "+v"(fr), "+v"(fq));
        const int row0 = u.pm * BM + wr * 64 + fr, cl = u.pn * BM + wc * 32 + 8 * fq;
        const int c0 = cl, c1 = cl + HALF, h0 = c0 / QKB, h1 = c1 / QKB, p0 = c0 - h0 * QKB, p1 = c1 - h1 * QKB;
        const bool r0 = p0 >= 64, r1 = p1 >= 64; const int roff = r0 ? p0 - 64 : (r1 ? p1 - 64 : 0);
#pragma unroll
        for (int b = 0; b < 2; ++b) {
            f32x4 s0[4], s1[4], ta[4], tb[4];
#pragma unroll
            for (int m = 0; m < 4; ++m) { const int row = row0 + b * HALF + m * 16;
                const f32x4* sp = (const f32x4*)(SS + (size_t)row * 12); s0[m] = sp[0]; s1[m] = sp[1];
                const f32x4* t = (const f32x4*)(ropeB + (size_t)row * 32 + roff); ta[m] = t[0]; tb[m] = t[1]; }
            asm volatile("" ::: "memory");
#pragma unroll
            for (int m = 0; m < 4; ++m) { const int row = row0 + b * HALF + m * 16;
                const float ss = ((s0[m][0] + s0[m][1]) + (s0[m][2] + s0[m][3])) + ((s1[m][0] + s1[m][1]) + (s1[m][2] + s1[m][3]));
                const float rs = __builtin_amdgcn_rsqf(ss * (1.0f / QLORA) + EPS) * C2B;
#pragma unroll
                for (int bj = 0; bj < 2; ++bj) { float v[8]; ld8(v, acc[b][bj][m][0], acc[b][bj][m][1]);
#pragma unroll
                    for (int j = 0; j < 8; ++j) v[j] *= rs;
                    if (bj == 0 ? r0 : r1) rope4(v, ta[m], tb[m]);
                    *(u32x4*)(QB + chk_off(row - fr, (bj == 0 ? c0 : c1) - 8 * fq, NHEAD * QKB) + (fq * 16 + fr) * 8) = pack8(v); } }
        }
    }
};
struct EpiKV {
    static constexpr bool PERM = true, AFTER_DRAIN = false; static constexpr int MIDT = 0;
    bf16_t *KB, *VB; const float* SS;
    __device__ __forceinline__ void operator()(const f32x4 (&acc)[2][2][4][2], const Unit& u, int wr, int wc, int fr, int fq) const {
        asm volatile("" : "+v"(fr), "+v"(fq));
        const int row0 = u.pm * BM + wr * 64 + fr;
        bf16_t* dst = (wc < 2) ? KB : VB; const int pc = (wc & 1) * 32, l8 = (fq * 16 + fr) * 8;
        f32x4 s0[2][4];
#pragma unroll
        for (int ai = 0; ai < 2; ++ai)
#pragma unroll
            for (int m = 0; m < 4; ++m) s0[ai][m] = *(const f32x4*)(SS + (size_t)(row0 + ai * HALF + m * 16) * 12 + 8);
#pragma unroll
        for (int ai = 0; ai < 2; ++ai)
#pragma unroll
            for (int m = 0; m < 4; ++m) { const int row = row0 + ai * HALF + m * 16; const f32x4 sv = s0[ai][m];
                const float rs = __builtin_amdgcn_rsqf(((sv[0] + sv[1]) + (sv[2] + sv[3])) * (1.0f / KVLORA) + EPS);
#pragma unroll
                for (int bj = 0; bj < 2; ++bj) { const int hd = u.pn * 2 + bj;
                    float v[8]; ld8(v, acc[ai][bj][m][0], acc[ai][bj][m][1]);
#pragma unroll
                    for (int j = 0; j < 8; ++j) v[j] *= rs;
                    *(u32x4*)(dst + chk_off(row - fr, hd * HD + pc, AW) + l8) = pack8(v); } }
    }
};
struct EpiMerge {
    static constexpr bool PERM = true, AFTER_DRAIN = false; static constexpr int MIDT = 8;
    const bf16_t* G; bf16_t* T;
    __device__ __forceinline__ void mid(f32x4 (&acc)[2][2][4][2], const Unit& u, int wr, int wc, int fr, int fq) const {
        asm volatile("" : "+v"(fr), "+v"(fq));
        const bf16_t* pa = G + gfrag_off(u.pm, u.pn, wr * 4 + wc, 0, fq * 16 + fr); const bf16_t* pb = G + gfrag_off(u.pm, 4 + u.pn, wr * 4 + wc, 0, fq * 16 + fr);
        u32x4 ca[4], cb[4], na[4], nb[4];
#pragma unroll
        for (int i = 0; i < 4; ++i) { ca[i] = *(const u32x4*)(pa + (size_t)i * 512); cb[i] = *(const u32x4*)(pb + (size_t)i * 512); }
#pragma unroll
        for (int b = 0; b < 4; ++b) {
            if (b < 3) {
#pragma unroll
                for (int i = 0; i < 4; ++i) { na[i] = *(const u32x4*)(pa + (size_t)((b + 1) * 4 + i) * 512); nb[i] = *(const u32x4*)(pb + (size_t)((b + 1) * 4 + i) * 512); } }
            asm volatile("" ::: "memory");
#pragma unroll
            for (int i = 0; i < 4; ++i) { const int grp = b * 4 + i, ai = grp >> 3, m = (grp >> 1) & 3, bj = grp & 1; float ga[8], gb[8]; unpack8(ca[i], ga); unpack8(cb[i], gb);
#pragma unroll
                for (int j = 0; j < 8; ++j) ga[j] *= __builtin_amdgcn_rcpf(__builtin_fmaxf(gb[j], 1e-30f));
                acc[ai][bj][m][0] *= (f32x4){ga[0], ga[1], ga[2], ga[3]}; acc[ai][bj][m][1] *= (f32x4){ga[4], ga[5], ga[6], ga[7]}; }
#pragma unroll
            for (int i = 0; i < 4; ++i) { ca[i] = na[i]; cb[i] = nb[i]; }
        }
    }
    __device__ __forceinline__ void operator()(const f32x4 (&acc)[2][2][4][2], const Unit& u, int wr, int wc, int fr, int fq) const {
        asm volatile("" : "+v"(fr), "+v"(fq));
        unsigned char* base = (unsigned char*)T + ((size_t)(u.pm * 16 + wr * 4) * 16 + u.pn * 4 + wc) * 1024 + (unsigned)(fq * 16 + fr) * 16u;
        const bf16_t* pb = G + gfrag_off(u.pm, 4 + u.pn, wr * 4 + wc, 0, fq * 16 + fr);
        u32x4 cb[8], nb[8];
#pragma unroll
        for (int i = 0; i < 8; ++i) cb[i] = *(const u32x4*)(pb + (size_t)i * 512);
#pragma unroll
        for (int b = 0; b < 2; ++b) {
            if (b < 1) {
#pragma unroll
                for (int i = 0; i < 8; ++i) nb[i] = *(const u32x4*)(pb + (size_t)(8 + i) * 512); }
            asm volatile("" ::: "memory");
#pragma unroll
            for (int i2 = 0; i2 < 4; ++i2) { int w[4];
#pragma unroll
                for (int bj = 0; bj < 2; ++bj) { const int i = 2 * i2 + bj, grp = b * 8 + i, ai = grp >> 3, m = (grp >> 1) & 3; float v[8], gb[8]; ld8(v, acc[ai][bj][m][0], acc[ai][bj][m][1]); unpack8(cb[i], gb);
#pragma unroll
                    for (int j = 0; j < 8; ++j) v[j] = __builtin_fminf(__builtin_fmaxf(v[j] * (64.f * __builtin_fmaxf(gb[j], 1e-30f)), -448.f), 448.f);
                    int w0 = 0, w1 = 0;
                    w0 = __builtin_amdgcn_cvt_pk_fp8_f32(v[0], v[1], w0, false); w0 = __builtin_amdgcn_cvt_pk_fp8_f32(v[2], v[3], w0, true);
                    w1 = __builtin_amdgcn_cvt_pk_fp8_f32(v[4], v[5], w1, false); w1 = __builtin_amdgcn_cvt_pk_fp8_f32(v[6], v[7], w1, true);
                    w[2 * bj] = w0; w[2 * bj + 1] = w1; }
                typedef int i32x4m_ __attribute__((ext_vector_type(4)));
                *(i32x4m_*)(base + (size_t)(b * 8 + i2) * 16384) = (i32x4m_){w[0], w[1], w[2], w[3]}; }
#pragma unroll
            for (int i = 0; i < 8; ++i) cb[i] = nb[i];
        }
    }
};
struct EpiSS {
    static constexpr bool PERM = true, AFTER_DRAIN = false; static constexpr int MIDT = 0;
    bf16_t* Y; float* SSY; int ldy; float scale;
    __device__ __forceinline__ void operator()(const f32x4 (&acc)[2][2][4][2], const Unit& u, int wr, int wc, int fr, int fq) const {
        asm volatile("" : "+v"(fr), "+v"(fq));
        const int row0 = u.pm * BM + wr * 64 + fr, cl = u.pn * BM + wc * 32 + 8 * fq;
        const int lane_ = fq * 16 + fr, bpa = ((lane_ & 3) * 16 + (lane_ >> 2)) * 4; bf16_t* yst = Y + (size_t)(u.pm * BM + wr * 64 + (lane_ >> 2)) * ldy + u.pn * BM + wc * 32 + 8 * (lane_ & 3);
#pragma unroll
        for (int ai = 0; ai < 2; ++ai)
#pragma unroll
            for (int m = 0; m < 4; ++m) { const int row = row0 + ai * HALF + m * 16; float s = 0.f;
#pragma unroll
                for (int bj = 0; bj < 2; ++bj) { float v[8]; ld8(v, acc[ai][bj][m][0] * scale, acc[ai][bj][m][1] * scale); s += sumsq8(v); const u32x4 w_ = pack8(v); u32x4 t_;
                    t_.x = (unsigned)__builtin_amdgcn_ds_bpermute(bpa, (int)w_.x); t_.y = (unsigned)__builtin_amdgcn_ds_bpermute(bpa, (int)w_.y); t_.z = (unsigned)__builtin_amdgcn_ds_bpermute(bpa, (int)w_.z); t_.w = (unsigned)__builtin_amdgcn_ds_bpermute(bpa, (int)w_.w);
                    *(u32x4*)(yst + (size_t)(ai * HALF + m * 16) * ldy + bj * HALF) = t_; }
                s = red_fq(s); if (fq == 0) SSY[(size_t)row * 16 + u.pn * 4 + wc] = s; }
    }
};
struct EpiRelu2F8 {
    static constexpr bool PERM = true, AFTER_DRAIN = false; static constexpr int MIDT = 0;
    unsigned char* U; float scale;
    __device__ __forceinline__ void operator()(const f32x4 (&acc)[2][2][4][2], const Unit& u, int wr, int wc, int fr, int fq) const {
        asm volatile("" : "+v"(fr), "+v"(fq));
        unsigned char* base = U + ((size_t)(u.pm * 16 + wr * 4) * 64 + u.pn * 4 + wc) * 1024 + (unsigned)(fq * 16 + fr) * 16u;
#pragma unroll
        for (int ai = 0; ai < 2; ++ai)
#pragma unroll
            for (int m = 0; m < 4; ++m) { int w[4];
#pragma unroll
                for (int bj = 0; bj < 2; ++bj) { float v[8];
                    { typedef float f32x2e_ __attribute__((ext_vector_type(2)));
#pragma unroll
                      for (int n = 0; n < 2; ++n)
#pragma unroll
                          for (int q = 0; q < 2; ++q) { const f32x4 a = acc[ai][bj][m][n]; f32x2e_ r = {a[2 * q], a[2 * q + 1]}; r = r * scale; r[0] = __builtin_fmaxf(r[0], 0.f); r[1] = __builtin_fmaxf(r[1], 0.f); r = r * r;
                              v[4 * n + 2 * q] = __builtin_fminf(r[0], 440.f); v[4 * n + 2 * q + 1] = __builtin_fminf(r[1], 440.f); } }
                    int w0 = 0, w1 = 0;
                    w0 = __builtin_amdgcn_cvt_pk_fp8_f32(v[0], v[1], w0, false); w0 = __builtin_amdgcn_cvt_pk_fp8_f32(v[2], v[3], w0, true);
                    w1 = __builtin_amdgcn_cvt_pk_fp8_f32(v[4], v[5], w1, false); w1 = __builtin_amdgcn_cvt_pk_fp8_f32(v[6], v[7], w1, true);
                    w[2 * bj] = w0; w[2 * bj + 1] = w1; }
                typedef int i32x4e_ __attribute__((ext_vector_type(4)));
                *(i32x4e_*)(base + (size_t)(ai * 8 + m) * 65536) = (i32x4e_){w[0], w[1], w[2], w[3]}; }
    }
};
struct EpiRelu2 {
    static constexpr bool PERM = true, AFTER_DRAIN = false; static constexpr int MIDT = 0;
    bf16_t* U;
    __device__ __forceinline__ void operator()(const f32x4 (&acc)[2][2][4][2], const Unit& u, int wr, int wc, int fr, int fq) const {
        asm volatile("" : "+v"(fr), "+v"(fq));
        const int row0 = u.pm * BM + wr * 64 + fr, cl = u.pn * BM + wc * 32 + 8 * fq;
#pragma unroll
        for (int ai = 0; ai < 2; ++ai)
#pragma unroll
            for (int m = 0; m < 4; ++m) { const int row = row0 + ai * HALF + m * 16;
#pragma unroll
                for (int bj = 0; bj < 2; ++bj) { float v[8]; ld8(v, acc[ai][bj][m][0], acc[ai][bj][m][1]);
#pragma unroll
                    for (int j = 0; j < 8; ++j) { const float r = __builtin_fmaxf(v[j], 0.f); v[j] = r * r; }
                    *(u32x4*)(U + (size_t)row * LDU + cl + bj * HALF) = pack8(v); } }
    }
};
template <class Epi, class Sched, bool ALIGN_EPI = false, bool SP2 = false, int ESZ = 2, bool ACH = false>
__device__ __forceinline__ void gemm_phase(PG8_LAS unsigned char* lds, const Gemm g, const Sched& S, const Epi& E) {
    int tid_ = threadIdx.x; asm volatile("" : "+v"(tid_));
    const int tid = tid_, wid = __builtin_amdgcn_readfirstlane(tid >> 6), lane = tid & 63, wr = wid >> 2, wc = wid & 3, fr = lane & 15, fq = lane >> 4;
    const int K = g.K, nt = K * ESZ / (BK * 2), lda = g.lda ? g.lda : K, ldb = g.ldb ? g.ldb : K;
    unsigned voffA[2], voffB[2];
#pragma unroll
    for (int i = 0; i < 2; ++i) { int R, C; stage_rc(tid * 16 + i * 8192, R, C); const int Rb = Epi::PERM ? ((R & ~31) + perm32(R & 31)) : R;
        if constexpr (ACH) { const int st_ = (tid >> 6) + 8 * i; voffA[i] = (unsigned)((st_ >> 1) * 16 * lda * ESZ + (st_ & 1) * 1024 + (tid & 63) * 16); } else voffA[i] = (unsigned)(R * lda * ESZ + C * 2);
        voffB[i] = (unsigned)(Rb * ldb * ESZ + C * 2); }
    const size_t kstepB = (size_t)(BK * 2), kstepA = ACH ? (size_t)2048 : kstepB;
    const size_t hstepA = (size_t)HALF * lda * ESZ, hstepB = (size_t)HALF * ldb * ESZ;
    const size_t tstepA = 2 * hstepA, tstepB = 2 * hstepB;
    const unsigned ldsw = (unsigned)wid * 1024u;
    const int aoff = ACH ? wr * 8192 + lane * 16 : lds_byte(wr * 64 + fr, fq * 8), boff = lds_byte(wc * 32 + fr, fq * 8);
#define PG8_SA(b, h) (((b) * 2 + (h)) * HTB)
#define PG8_SB(b, h) ((4 + (b) * 2 + (h)) * HTB)
#define PG8_STAGE(bufoff, gbase, voff) do { _Pragma("unroll") for (int _i = 0; _i < 2; ++_i) \
        __builtin_amdgcn_global_load_lds((const unsigned*)((const char*)(gbase) + (voff)[_i]), (PG8_LAS unsigned*)(lds + (bufoff) + ldsw + _i * 8192), 16, 0, 0); } while (0)
#define PG8_LDA(dst, b, h) do { if constexpr (ESZ == 2) { _Pragma("unroll") for (int m = 0; m < 4; ++m) _Pragma("unroll") for (int k = 0; k < 2; ++k) dst[m][k] = *(const PG8_LAS bf16x8*)(lds + PG8_SA(b, h) + aoff + m * 2048 + k * 1024); } \
        else { _Pragma("unroll") for (int m = 0; m < 4; ++m) { dst##8[m].lo = *(const PG8_LAS i32x4_*)(lds + PG8_SA(b, h) + aoff + m * 2048); dst##8[m].hi = *(const PG8_LAS i32x4_*)(lds + PG8_SA(b, h) + aoff + m * 2048 + 1024); } } } while (0)
#define PG8_LDB(dst, b, h) do { if constexpr (ESZ == 2) { _Pragma("unroll") for (int n = 0; n < 2; ++n) _Pragma("unroll") for (int k = 0; k < 2; ++k) dst[n][k] = *(const PG8_LAS bf16x8*)(lds + PG8_SB(b, h) + boff + n * 2048 + k * 1024); } \
        else { _Pragma("unroll") for (int n = 0; n < 2; ++n) { dst##8[n].lo = *(const PG8_LAS i32x4_*)(lds + PG8_SB(b, h) + boff + n * 2048); dst##8[n].hi = *(const PG8_LAS i32x4_*)(lds + PG8_SB(b, h) + boff + n * 2048 + 1024); } } } while (0)
#define PG8_MMA(ai, bj, At, Bt) do { __builtin_amdgcn_s_setprio(1); \
        if constexpr (ESZ == 2) { _Pragma("unroll") for (int m = 0; m < 4; ++m) _Pragma("unroll") for (int n = 0; n < 2; ++n) _Pragma("unroll") for (int k = 0; k < 2; ++k) \
            acc[ai][bj][m][n] = __builtin_amdgcn_mfma_f32_16x16x32_bf16(Bt[n][k], At[m][k], acc[ai][bj][m][n], 0, 0, 0); } \
        else {   \
            _Pragma("unroll") for (int m = 0; m < 4; ++m) _Pragma("unroll") for (int n = 0; n < 2; ++n) \
                asm volatile("v_mfma_scale_f32_16x16x128_f8f6f4 %0, %1, %2, %0, %3, %3 op_sel_hi:[0,0,0]" : "+v"(acc[ai][bj][m][n]) : "v"(Bt##8[n]), "v"(At##8[m]), "v"(scl_)); } \
        __builtin_amdgcn_s_setprio(0); } while (0)
#define PG8_WAIT_V(n) asm volatile("s_waitcnt vmcnt(" #n ")" ::: "memory")
#define PG8_WAIT_L(n) asm volatile("s_waitcnt lgkmcnt(" #n ")" ::: "memory")
#define PG8_BAR __builtin_amdgcn_s_barrier()
#define PG8_SCHED __builtin_amdgcn_sched_barrier(0)
    Unit cur, nxt; int ui = 0;
    if (!S.next(0, cur)) return;
    f32x4 acc[2][2][4][2];
#pragma unroll
    for (int a = 0; a < 2; ++a)
#pragma unroll
        for (int b = 0; b < 2; ++b)
#pragma unroll
            for (int m = 0; m < 4; ++m)
#pragma unroll
                for (int n = 0; n < 2; ++n) acc[a][b][m][n] = (f32x4){0.f, 0.f, 0.f, 0.f};
    bf16x8 At[4][2], B0[2][2], B1[2][2];
    typedef int i32x4_ __attribute__((ext_vector_type(4))); typedef int i32x8_ __attribute__((ext_vector_type(8)));
    const int scl_ = 0x7F7F7F7F;
    i32x8_ At8[4], B08[2], B18[2];
    const char* cA = (const char*)g.A + (size_t)cur.pm * tstepA; const char* cB = (const char*)g.Bt + (size_t)cur.pn * tstepB;
    S.a_ready(cur);
    if constexpr (SP2) {
        PG8_STAGE(PG8_SB(0, 0), cB, voffB); PG8_STAGE(PG8_SB(0, 1), cB + hstepB, voffB); PG8_STAGE(PG8_SA(0, 0), cA, voffA); PG8_STAGE(PG8_SA(0, 1), cA + hstepA, voffA);
        if (wr == 1) PG8_BAR;
        PG8_WAIT_V(2); PG8_BAR;
        PG8_STAGE(PG8_SB(1, 0), cB + kstepB, voffB); PG8_STAGE(PG8_SA(1, 0), cA + kstepA, voffA); PG8_STAGE(PG8_SB(1, 1), cB + hstepB + kstepB, voffB);
        PG8_WAIT_V(6); PG8_BAR;
    } else {
        PG8_STAGE(PG8_SB(0, 0), cB, voffB); PG8_STAGE(PG8_SA(0, 0), cA, voffA); PG8_STAGE(PG8_SB(0, 1), cB + hstepB, voffB); PG8_STAGE(PG8_SA(0, 1), cA + hstepA, voffA);
        if (wr == 1) PG8_BAR;
        PG8_WAIT_V(4); PG8_BAR;
        PG8_STAGE(PG8_SB(1, 0), cB + kstepB, voffB); PG8_STAGE(PG8_SA(1, 0), cA + kstepA, voffA); PG8_STAGE(PG8_SB(1, 1), cB + hstepB + kstepB, voffB);
        PG8_WAIT_V(6); PG8_BAR;
    }
    for (;;) {
        const bool has_next = S.next(ui + 1, nxt);
        const char* nA = has_next ? (const char*)g.A + (size_t)nxt.pm * tstepA : cA; const char* nB = has_next ? (const char*)g.Bt + (size_t)nxt.pn * tstepB : cB;
#pragma unroll 1
        for (int t = 0; t < nt; t += 2) {
            if constexpr (Epi::MIDT > 0) { if (t == Epi::MIDT) E.mid(acc, cur, wr, wc, fr, fq); }
            const bool last = (t == nt - 2);
            const char* a1 = cA + (size_t)(t + 1) * kstepA;
            const char* a2 = last ? nA : cA + (size_t)(t + 2) * kstepA; const char* b2 = last ? nB : cB + (size_t)(t + 2) * kstepB;
            const char* a3 = a2 + kstepA; const char* b3 = b2 + kstepB;
            if (last && has_next) S.a_ready(nxt);
            if constexpr (SP2) {
            PG8_LDB(B0, 0, 0); PG8_LDB(B1, 0, 1); PG8_SCHED; PG8_LDA(At, 0, 0); PG8_STAGE(PG8_SA(1, 1), a1 + hstepA, voffA);
            PG8_WAIT_V(8); PG8_WAIT_L(0); PG8_BAR; PG8_MMA(0, 0, At, B0); PG8_MMA(0, 1, At, B1); PG8_BAR; PG8_SCHED;
            PG8_LDA(At, 0, 1); PG8_STAGE(PG8_SB(0, 0), b2, voffB); PG8_STAGE(PG8_SB(0, 1), b2 + hstepB, voffB); PG8_STAGE(PG8_SA(0, 0), a2, voffA);
            PG8_WAIT_V(8); PG8_WAIT_L(0); PG8_BAR; PG8_MMA(1, 0, At, B0); PG8_MMA(1, 1, At, B1); PG8_BAR; PG8_SCHED;
            PG8_LDB(B0, 1, 0); PG8_LDB(B1, 1, 1); PG8_SCHED; PG8_LDA(At, 1, 0); PG8_STAGE(PG8_SA(0, 1), a2 + hstepA, voffA);
            PG8_WAIT_V(8); PG8_WAIT_L(0); PG8_BAR; PG8_MMA(0, 0, At, B0); PG8_MMA(0, 1, At, B1); PG8_BAR; PG8_SCHED;
            PG8_LDA(At, 1, 1); PG8_STAGE(PG8_SB(1, 0), b3, voffB); PG8_STAGE(PG8_SB(1, 1), b3 + hstepB, voffB); PG8_STAGE(PG8_SA(1, 0), a3, voffA);
            PG8_WAIT_V(8); PG8_WAIT_L(0); PG8_BAR; PG8_MMA(1, 0, At, B0); PG8_MMA(1, 1, At, B1); PG8_BAR; PG8_SCHED;
            } else {
            PG8_LDB(B0, 0, 0); PG8_SCHED; PG8_LDA(At, 0, 0); PG8_STAGE(PG8_SA(1, 1), a1 + hstepA, voffA);
            PG8_WAIT_L(8); PG8_BAR; PG8_WAIT_L(0); PG8_MMA(0, 0, At, B0); PG8_BAR; PG8_SCHED;
            PG8_LDB(B1, 0, 1); PG8_STAGE(PG8_SB(0, 0), b2, voffB);
            PG8_BAR; PG8_WAIT_L(0); PG8_MMA(0, 1, At, B1); PG8_BAR;
            PG8_LDA(At, 0, 1); PG8_STAGE(PG8_SA(0, 0), a2, voffA);
            PG8_BAR; PG8_WAIT_L(0); PG8_MMA(1, 0, At, B0); PG8_BAR; PG8_SCHED;
            PG8_STAGE(PG8_SB(0, 1), b2 + hstepB, voffB);
            PG8_WAIT_V(6); PG8_BAR; PG8_MMA(1, 1, At, B1); PG8_BAR;
            PG8_LDB(B0, 1, 0); PG8_SCHED; PG8_LDA(At, 1, 0); PG8_STAGE(PG8_SA(0, 1), a2 + hstepA, voffA);
            PG8_WAIT_L(8); PG8_BAR; PG8_WAIT_L(0); PG8_MMA(0, 0, At, B0); PG8_BAR; PG8_SCHED;
            PG8_LDB(B1, 1, 1); PG8_STAGE(PG8_SB(1, 0), b3, voffB);
            PG8_BAR; PG8_WAIT_L(0); PG8_MMA(0, 1, At, B1); PG8_BAR;
            PG8_LDA(At, 1, 1); PG8_STAGE(PG8_SA(1, 0), a3, voffA);
            PG8_BAR; PG8_WAIT_L(0); PG8_MMA(1, 0, At, B0); PG8_BAR; PG8_SCHED;
            PG8_STAGE(PG8_SB(1, 1), b3 + hstepB, voffB);
            PG8_WAIT_V(6); PG8_BAR; PG8_MMA(1, 1, At, B1); PG8_BAR;
            }
        }
        if constexpr (ALIGN_EPI) { if (wr == 0) PG8_BAR; }
        if constexpr (ESZ == 1) asm volatile("s_nop 15\n\ts_nop 15" ::: "memory");
        if constexpr (!Epi::AFTER_DRAIN) { E(acc, cur, wr, wc, fr, fq); S.done(cur); }
        if (!has_next) break;
#pragma unroll
        for (int a = 0; a < 2; ++a)
#pragma unroll
            for (int b = 0; b < 2; ++b)
#pragma unroll
                for (int m = 0; m < 4; ++m)
#pragma unroll
                    for (int n = 0; n < 2; ++n) acc[a][b][m][n] = (f32x4){0.f, 0.f, 0.f, 0.f};
        cur = nxt; cA = nA; cB = nB; ++ui;
        if constexpr (ALIGN_EPI) { if (wr == 1) PG8_BAR; }
    }
    PG8_WAIT_V(0);
    if constexpr (!ALIGN_EPI) { if (wr == 0) PG8_BAR; }
    PG8_BAR;
    if constexpr (Epi::AFTER_DRAIN) { E.fused(acc, cur, wr, wc, fr, fq, lds, wid, lane); S.done(cur); }
#undef PG8_SA
#undef PG8_SB
#undef PG8_STAGE
#undef PG8_LDA
#undef PG8_LDB
#undef PG8_MMA
#undef PG8_WAIT_V
#undef PG8_WAIT_L
#undef PG8_BAR
#undef PG8_SCHED
}
}
#ifndef ATT_LSUM_MFMA
#define ATT_LSUM_MFMA 1
#endif
namespace att {
typedef unsigned short bf16_t;
typedef short bf16x8 __attribute__((ext_vector_type(8)));
typedef short s16x4 __attribute__((ext_vector_type(4)));
typedef float f32x16 __attribute__((ext_vector_type(16)));
typedef float f32x4 __attribute__((ext_vector_type(4)));
typedef unsigned u32x4 __attribute__((ext_vector_type(4)));
#define ALDS __attribute__((address_space(3)))
#define ASBAR() __builtin_amdgcn_sched_barrier(0)
constexpr int KTB = 12288, VTB = 8192;
constexpr int NSLOT = 3;
constexpr int L_K = 0, L_V = NSLOT * KTB, L_WS = L_V + NSLOT * VTB, L_OST = L_WS + 8 * 256, L_KM = L_OST + 8 * 4096, L_RED = L_KM + 2048, L_END = L_RED + 16384;
constexpr float THR = 8.f;
__device__ __forceinline__ int crow(int r, int hi) { return (r & 3) + 8 * (r >> 2) + 4 * hi; }
typedef float f32x2a_t __attribute__((ext_vector_type(2))); typedef __bf16 bf16x2a_t __attribute__((ext_vector_type(2)));
__device__ __forceinline__ unsigned cvtpk(float lo, float hi) { const f32x2a_t v = {lo, hi}; const bf16x2a_t b = __builtin_convertvector(v, bf16x2a_t); return __builtin_bit_cast(unsigned, b); }
__device__ __forceinline__ float bf2f(short s) { return __uint_as_float(((unsigned)(unsigned short)s) << 16); }
__device__ __forceinline__ int v_st(int k, int c) { const int kk = (k & ~0xC) | ((k & 4) << 1) | ((k & 8) >> 1); return ((kk >> 3) * 2 + (c >> 5)) * 512 + ((kk & 7) * 32 + (c & 31)) * 2; }
__device__ __forceinline__ int v_rd_base(int lane) { return ((lane & 3) << 3) | (((lane >> 2) & 3) << 6) | (((lane >> 4) & 1) << 5) | (((lane >> 5) & 1) << 8); }
constexpr int v_rd_off(int d0, int ks, int half) { return ks * 2048 + half * 1024 + d0 * 512; }
template <int OFF> __device__ __forceinline__ s16x4 tr_read(int vb) { s16x4 r; asm volatile("ds_read_b64_tr_b16 %0, %1 offset:%2" : "=&v"(r) : "v"(vb), "i"(OFF) : "memory"); return r; }
template <int D0> __device__ __forceinline__ void pv_one(f32x16& od, int vb, bf16x8 pa0, bf16x8 pa1, bf16x8 pa2, bf16x8 pa3) {
    const s16x4 l0 = tr_read<v_rd_off(D0, 0, 0)>(vb), h0 = tr_read<v_rd_off(D0, 0, 1)>(vb), l1 = tr_read<v_rd_off(D0, 1, 0)>(vb), h1 = tr_read<v_rd_off(D0, 1, 1)>(vb);
    const s16x4 l2 = tr_read<v_rd_off(D0, 2, 0)>(vb), h2 = tr_read<v_rd_off(D0, 2, 1)>(vb), l3 = tr_read<v_rd_off(D0, 3, 0)>(vb), h3 = tr_read<v_rd_off(D0, 3, 1)>(vb);
    asm volatile("s_waitcnt lgkmcnt(0)" ::: "memory"); ASBAR();
#define ATT_PK(L, H) (bf16x8){L[0], L[1], L[2], L[3], H[0], H[1], H[2], H[3]}
    od = __builtin_amdgcn_mfma_f32_32x32x16_bf16(pa0, ATT_PK(l0, h0), od, 0, 0, 0);
    od = __builtin_amdgcn_mfma_f32_32x32x16_bf16(pa1, ATT_PK(l1, h1), od, 0, 0, 0);
    od = __builtin_amdgcn_mfma_f32_32x32x16_bf16(pa2, ATT_PK(l2, h2), od, 0, 0, 0);
    od = __builtin_amdgcn_mfma_f32_32x32x16_bf16(pa3, ATT_PK(l3, h3), od, 0, 0, 0);
#undef ATT_PK
}
__device__ __forceinline__ void pv_all(f32x16* o, f32x16& ol, int vb, bf16x8 pa0, bf16x8 pa1, bf16x8 pa2, bf16x8 pa3) {
    pv_one<0>(o[0], vb, pa0, pa1, pa2, pa3); pv_one<1>(o[1], vb, pa0, pa1, pa2, pa3);
#if ATT_LSUM_MFMA
    const bf16x8 ones = (bf16x8){0x3F80, 0x3F80, 0x3F80, 0x3F80, 0x3F80, 0x3F80, 0x3F80, 0x3F80};
    ol = __builtin_amdgcn_mfma_f32_32x32x16_bf16(pa0, ones, ol, 0, 0, 0); ol = __builtin_amdgcn_mfma_f32_32x32x16_bf16(pa1, ones, ol, 0, 0, 0);
    ol = __builtin_amdgcn_mfma_f32_32x32x16_bf16(pa2, ones, ol, 0, 0, 0); ol = __builtin_amdgcn_mfma_f32_32x32x16_bf16(pa3, ones, ol, 0, 0, 0);
#endif
}
__device__ __forceinline__ void partialSM(f32x16& p0, f32x16& p1, float& m_ref, f32x16& negm, float& alpha) {
    float pmax = p0[0];
#pragma unroll
    for (int r = 1; r < 16; ++r) pmax = fmaxf(pmax, p0[r]);
#pragma unroll
    for (int r = 0; r < 16; ++r) pmax = fmaxf(pmax, p1[r]);
    { auto rr = __builtin_amdgcn_permlane32_swap(__float_as_uint(pmax), __float_as_uint(pmax), false, false); pmax = fmaxf(__uint_as_float(rr[0]), __uint_as_float(rr[1])); }
    alpha = 1.f;
    if (__builtin_expect(!__all(pmax <= THR), 0)) { const float dl = (pmax > THR) ? pmax : 0.f; m_ref += dl; alpha = __builtin_amdgcn_exp2f(-dl);
#pragma unroll
        for (int r = 0; r < 16; ++r) { p0[r] -= dl; p1[r] -= dl; negm[r] = -m_ref; } }
#pragma unroll
    for (int r = 0; r < 16; ++r) p0[r] = __builtin_amdgcn_exp2f(p0[r]);
}
__device__ __forceinline__ void finishSM(f32x16& p0, f32x16& p1, bf16x8& pa0, bf16x8& pa1, bf16x8& pa2, bf16x8& pa3, float& lsum) {
#pragma unroll
    for (int r = 0; r < 16; ++r) p1[r] = __builtin_amdgcn_exp2f(p1[r]);
#if !ATT_LSUM_MFMA
    { float ps = 0.f;
#pragma unroll
      for (int r = 0; r < 16; ++r) ps += p0[r];
#pragma unroll
      for (int r = 0; r < 16; ++r) ps += p1[r];
      lsum += ps; }
#endif
#define ATT_PK4(P, BASE, OUT) do { unsigned a0 = cvtpk(P[BASE + 0], P[BASE + 1]), a1 = cvtpk(P[BASE + 2], P[BASE + 3]);   \
    unsigned b0 = cvtpk(P[BASE + 4], P[BASE + 5]), b1 = cvtpk(P[BASE + 6], P[BASE + 7]);                              \
    auto r0 = __builtin_amdgcn_permlane32_swap(a0, b0, false, false); auto r1 = __builtin_amdgcn_permlane32_swap(a1, b1, false, false); \
    u32x4 w = {r0[0], r1[0], r0[1], r1[1]}; OUT = __builtin_bit_cast(bf16x8, w); } while (0)
    ATT_PK4(p0, 0, pa0); ATT_PK4(p0, 8, pa1); ATT_PK4(p1, 0, pa2); ATT_PK4(p1, 8, pa3);
#undef ATT_PK4
}
template <int ND> __device__ __forceinline__ void qkt(f32x16& p0, f32x16& p1, ALDS const char* Kb, const int (&ka)[ND], const bf16x8 (&qr)[ND], const f32x16& cinit) {
#pragma unroll
    for (int d0 = 0; d0 < ND; ++d0) {
        const bf16x8 b0 = *(ALDS const bf16x8*)(Kb + ka[d0]);
        const bf16x8 b1 = *(ALDS const bf16x8*)(Kb + ka[d0] + (d0 < 4 ? 4096 : 2048));
        p0 = __builtin_amdgcn_mfma_f32_32x32x16_bf16(b0, qr[d0], d0 == 0 ? cinit : p0, 0, 0, 0);
        p1 = __builtin_amdgcn_mfma_f32_32x32x16_bf16(b1, qr[d0], d0 == 0 ? cinit : p1, 0, 0, 0);
        if (ND > 4 && d0 == 2) asm volatile("" ::: "memory"); }
}
__device__ __forceinline__ void cmask(f32x16& p0, f32x16& p1, int jt, int qrel, int hi) {
    const float NEG = -INFINITY; const int thr = qrel - 64 * jt - 4 * hi;
#pragma unroll
    for (int r = 0; r < 16; ++r) { if ((r & 3) + 8 * (r >> 2) > thr) p0[r] = NEG; if ((r & 3) + 8 * (r >> 2) + 32 > thr) p1[r] = NEG; }
}
__device__ __forceinline__ void kmean_blocks(const bf16_t* Kp, ALDS char* lds) {
    int tid_ = threadIdx.x; asm volatile("" : "+v"(tid_));
    const int tid = tid_, lane = tid & 63, wid = tid >> 6;
    ALDS float* red = (ALDS float*)(lds + L_RED); ALDS float* km = (ALDS float*)(lds + L_KM);
    bf16x8 kq[8][4];
#pragma unroll
    for (int n = 0; n < 8; ++n)
#pragma unroll
        for (int i = 0; i < 2; ++i)
#pragma unroll
            for (int cc = 0; cc < 2; ++cc) kq[n][i * 2 + cc] = *(const bf16x8*)(Kp + (size_t)(n * 256 + 128 * i + 16 * wid) * AW + cc * 512 + lane * 8);
#pragma unroll
    for (int n = 0; n < 8; ++n) {
        float a[16];
#pragma unroll
        for (int j = 0; j < 16; ++j) a[j] = 0.f;
#pragma unroll
        for (int i = 0; i < 2; ++i)
#pragma unroll
            for (int cc = 0; cc < 2; ++cc) { const bf16x8 kx = kq[n][i * 2 + cc];
#pragma unroll
                for (int j = 0; j < 8; ++j) a[cc * 8 + j] += bf2f(kx[j]); }
#pragma unroll
        for (int j = 0; j < 16; ++j) { a[j] += __shfl_xor(a[j], 1); a[j] += __shfl_xor(a[j], 2); a[j] += __shfl_xor(a[j], 4); a[j] += __shfl_xor(a[j], 8); }
        if ((lane & 15) == 0) {
#pragma unroll
            for (int j = 0; j < 16; ++j) red[(n * 8 + wid) * 64 + (j >> 3) * 32 + (lane >> 4) * 8 + (j & 7)] = a[j]; }
    }
    __syncthreads();
    { const int n = tid >> 6, d = tid & 63; float s = 0.f;
#pragma unroll
        for (int w = 0; w < 8; ++w) s += red[(n * 8 + w) * 64 + d];
        km[n * 64 + d] = s * (1.0f / 256.0f); }
    __syncthreads();
}
template <int DQK, bool MOBA>
__device__ __forceinline__ void attn_bh(const bf16_t* Qp, int ldq, const bf16_t* Kp, const bf16_t* KRp, const bf16_t* Vp, bf16_t* Op, int ldo, ALDS char* lds) {
    constexpr int ND = DQK / 16;
    ALDS char* K_lds = lds + L_K; ALDS char* V_lds = lds + L_V;
    bf16x8 sk0, sv0, sr0, sk1, sv1, sr1;
#define ATT_SLOAD(S, k0) do { sk##S = *(const bf16x8*)((const char*)(Kp + (size_t)(k0) * AW) + koff); sv##S = *(const bf16x8*)((const char*)(Vp + (size_t)(k0) * AW) + koff); if (DQK == 96) sr##S = *(const bf16x8*)((const char*)(KRp + (size_t)(k0) * RDIM) + roff); } while (0)
#define ATT_SWRITE(b, S) do { *(ALDS bf16x8*)(K_lds + (b) * KTB + kst) = sk##S; *(ALDS bf16x8*)(V_lds + (b) * VTB + vst) = sv##S; if (DQK == 96) { if (tid < 256) *(ALDS bf16x8*)(K_lds + (b) * KTB + rst) = sr##S; } } while (0)
#define ATT_QLOAD(q_) do { const bf16_t* Qw = Qp + (size_t)((q_) * 256 + wid * 32 + (r32 & 16)) * ldq + (r32 & 15) * 8 + hi * 128; _Pragma("unroll") for (int d0 = 0; d0 < ND; ++d0) qr[d0] = *(const bf16x8*)(Qw + (d0 >> 1) * 512 + (d0 & 1) * 256); } while (0)
    bf16x8 qr[ND];
    {
        const int tid = threadIdx.x, w_ = tid >> 6, l_ = tid & 63;
        const unsigned koff = (unsigned)((w_ >> 1) * 16 * AW + (w_ & 1) * 512 + l_ * 8) * 2u, roff = (unsigned)((w_ & 3) * 16 * RDIM + l_ * 8) * 2u;
        ATT_SLOAD(0, 0); ATT_SLOAD(1, 64); }
#pragma unroll 1
  for (int qb = 0; qb < 8; ++qb) {
    int tid_ = threadIdx.x; asm volatile("" : "+v"(tid_));
    const int tid = tid_, lane = tid & 63, r32 = lane & 31, hi = lane >> 5; const int wid = __builtin_amdgcn_readfirstlane(tid >> 6);
    ALDS float* al_l = (ALDS float*)(lds + L_WS) + wid * 64;
    const int skey = 16 * (wid >> 1) + (lane & 15), sch = 4 * (wid & 1) + (lane >> 4);
    const unsigned koff = (unsigned)((wid >> 1) * 16 * AW + (wid & 1) * 512 + lane * 8) * 2u;
    const int kst = skey * 128 + ((sch ^ ((skey >> 1) & 7)) << 4), vst = v_st(skey, sch * 8);
    const int rkey = 16 * (wid & 3) + (lane & 15), rch = lane >> 4;
    const unsigned roff = (unsigned)((wid & 3) * 16 * RDIM + lane * 8) * 2u;
    const int rst = 8192 + rkey * 64 + ((rch ^ ((rkey >> 2) & 3)) << 4);
    int ka[ND];
#pragma unroll
    for (int d0 = 0; d0 < ND; ++d0) ka[d0] = (d0 < 4) ? r32 * 128 + (((2 * d0 + hi) ^ ((r32 >> 1) & 7)) << 4) : 8192 + r32 * 64 + (((2 * (d0 - 4) + hi) ^ ((r32 >> 2) & 3)) << 4);
    const int vb0 = (int)(unsigned)(uintptr_t)V_lds + v_rd_base(lane);
    const int qrel = wid * 32 + r32;
    ATT_QLOAD(qb);
    float m_ref = 0.f, lsum = 0.f; f32x16 o[2], ol, negm; o[0] = f32x16{}; o[1] = f32x16{}; ol = f32x16{}; negm = f32x16{};
    unsigned sel = 0xffu;
    if (MOBA && qb > 3) {
        ALDS const float* km = (ALDS const float*)(lds + L_KM); float g[8];
#pragma unroll
        for (int n = 0; n < 8; ++n) { float s = 0.f;
#pragma unroll
            for (int d0 = 0; d0 < ND; ++d0)
#pragma unroll
                for (int j = 0; j < 8; ++j) s += bf2f(qr[d0][j]) * km[n * 64 + d0 * 16 + hi * 8 + j];
            g[n] = s; }
#pragma unroll
        for (int n = 0; n < 8; ++n) g[n] += __shfl_xor(g[n], 32);
        sel = 0u;
#pragma unroll
        for (int n = 0; n < 8; ++n) { int rank = 0;
#pragma unroll
            for (int mm = 0; mm < 8; ++mm) if (mm != n) rank += (mm < qb && (g[mm] > g[n] || (g[mm] == g[n] && mm < n))) ? 1 : 0;
            if (n < qb && rank < 3) sel |= 1u << n; }
    }
#define ATT_RESC(a) do { if (__any((a) < 1.f)) { lsum *= (a); if (hi == 0) al_l[r32] = (a); asm volatile("s_waitcnt lgkmcnt(0)" ::: "memory"); \
    _Pragma("unroll") for (int r = 0; r < 16; ++r) { const float f_ = al_l[crow(r, hi)]; o[0][r] *= f_; o[1][r] *= f_; ol[r] *= f_; } } } while (0)
    f32x16 pA0, pA1, pB0, pB1; float alA, alB; bf16x8 pa0, pa1, pa2, pa3; const int NT = 4 * (qb + 1), NP = 4 * qb;
    f32x16 cm = negm; const bool gated = MOBA && qb > 3;
#define ATT_CM(t) do { if (gated) { if ((t) < NP) { const float v_ = ((sel >> ((t) >> 2)) & 1u) ? -m_ref : -INFINITY; _Pragma("unroll") for (int r = 0; r < 16; ++r) cm[r] = v_; } else cm = negm; } else cm = negm; } while (0)
#define ATT_SCORE(P0, P1, t) do { ATT_CM(t); qkt<ND>(P0, P1, K_lds + sc * KTB, ka, qr, cm); if ((t) >= NP) cmask(P0, P1, (t) - NP, qrel, hi); } while (0)
    int sp = 0, sc = 0, sn = 1;
#define ATT_ROT() do { sp = sc; sc = sn; sn = (sn == NSLOT - 1) ? 0 : sn + 1; } while (0)
    ATT_SWRITE(0, 0); ATT_SLOAD(0, 128);
    __syncthreads(); ATT_SWRITE(sn, 1); ATT_SLOAD(1, 192);
    ATT_SCORE(pA0, pA1, 0); partialSM(pA0, pA1, m_ref, negm, alA);
    ATT_ROT();
    for (int t = 1; t + 1 < NT; t += 2) {
        __syncthreads(); ATT_SWRITE(sn, 0); if (t + 3 < NT) ATT_SLOAD(0, (t + 3) * 64);
        ASBAR(); ATT_SCORE(pB0, pB1, t);
        finishSM(pA0, pA1, pa0, pa1, pa2, pa3, lsum); ASBAR();
        pv_all(o, ol, vb0 + sp * VTB, pa0, pa1, pa2, pa3); partialSM(pB0, pB1, m_ref, negm, alB);
        ATT_RESC(alB); ATT_ROT();
        __syncthreads(); ATT_SWRITE(sn, 1); if (t + 4 < NT) ATT_SLOAD(1, (t + 4) * 64);
        ASBAR(); ATT_SCORE(pA0, pA1, t + 1);
        finishSM(pB0, pB1, pa0, pa1, pa2, pa3, lsum); ASBAR();
        pv_all(o, ol, vb0 + sp * VTB, pa0, pa1, pa2, pa3); partialSM(pA0, pA1, m_ref, negm, alA);
        ATT_RESC(alA); ATT_ROT();
    }
    __syncthreads();
    ASBAR(); ATT_SCORE(pB0, pB1, NT - 1);
    if (qb < 7) { ATT_SLOAD(0, 0); ATT_SLOAD(1, 64); }
    finishSM(pA0, pA1, pa0, pa1, pa2, pa3, lsum); ASBAR();
    pv_all(o, ol, vb0 + sp * VTB, pa0, pa1, pa2, pa3); partialSM(pB0, pB1, m_ref, negm, alB);
    ATT_RESC(alB);
    finishSM(pB0, pB1, pa0, pa1, pa2, pa3, lsum); ASBAR();
    pv_all(o, ol, vb0 + sc * VTB, pa0, pa1, pa2, pa3);
#undef ATT_ROT
#undef ATT_SCORE
#undef ATT_CM
    float rli[16];
#if ATT_LSUM_MFMA
#pragma unroll
    for (int r = 0; r < 16; ++r) rli[r] = __builtin_amdgcn_rcpf(ol[r]);
#else
    { auto rr = __builtin_amdgcn_permlane32_swap(__float_as_uint(lsum), __float_as_uint(lsum), false, false); lsum = __uint_as_float(rr[0]) + __uint_as_float(rr[1]); }
    if (hi == 0) al_l[32 + r32] = lsum; asm volatile("s_waitcnt lgkmcnt(0)" ::: "memory");
#pragma unroll
    for (int r = 0; r < 16; ++r) rli[r] = __builtin_amdgcn_rcpf(al_l[32 + crow(r, hi)]);
#endif
    { ALDS unsigned short* stg = (ALDS unsigned short*)(lds + L_OST) + wid * 2048;
#pragma unroll
      for (int r = 0; r < 16; ++r) { const int orow = crow(r, hi);
#pragma unroll
          for (int d0 = 0; d0 < 2; ++d0) stg[orow * 64 + d0 * 32 + r32] = (unsigned short)(cvtpk(o[d0][r] * rli[r], 0.f) & 0xffffu); }
      asm volatile("s_waitcnt lgkmcnt(0)" ::: "memory");
      bf16_t* Ow = Op + (size_t)(qb * 256 + wid * 32) * ldo;
#pragma unroll
      for (int i = 0; i < 4; ++i) { const int row = i * 8 + (lane >> 3), ch = lane & 7; const u32x4 v = *(ALDS const u32x4*)(stg + row * 64 + ch * 8); *(u32x4*)(Ow + (size_t)row * ldo + ch * 8) = v; } }
    __syncthreads();
  }
#undef ATT_SLOAD
#undef ATT_SWRITE
#undef ATT_QLOAD
#undef ATT_RESC
}

constexpr int MSLOT = 8192, M_K = 0, M_V = 3 * MSLOT, M_WS = 6 * MSLOT, M_OST = M_WS + 8 * 256, M_END = M_OST + 8 * 4096;
static_assert(M_END <= L_KM, "MoBA LDS map");
#define MPIN(x) asm volatile("" : "+v"(x))
#define MMFMA(a, b, c) __builtin_amdgcn_mfma_f32_32x32x16_bf16(a, b, c, 0, 0, 0)
#define MWAIT_BAR(N) asm volatile("s_waitcnt vmcnt(" #N ") lgkmcnt(0)\n\ts_barrier" ::: "memory")
__device__ __forceinline__ void m_kload2(bf16x8* kf, ALDS const char* kp, int d0) { kf[2 * d0] = *(ALDS const bf16x8*)(kp + d0 * 2048); kf[2 * d0 + 1] = *(ALDS const bf16x8*)(kp + d0 * 2048 + 512); }
__device__ __forceinline__ void m_glds16(const void* g, unsigned lds_base) {
    unsigned sv; asm volatile("s_mov_b32 %0, m0\n\ts_mov_b32 m0, %2\n\ts_nop 0\n\tglobal_load_lds_dwordx4 %1, off\n\ts_mov_b32 m0, %0" : "=&s"(sv) : "v"(g), "s"(lds_base) : "memory"); }
typedef ALDS s16x4 lds_s16x4_t;
__device__ __forceinline__ s16x4 m_vtr(ALDS const char* p) { return __builtin_amdgcn_ds_read_tr16_b64_v4i16((lds_s16x4_t*)p); }
#define MMX3(a, b, c) __builtin_fmaxf(__builtin_fmaxf((a), (b)), (c))
__device__ __forceinline__ float m_rowmax(const f32x16& p0, const f32x16& p1) {
    float a = MMX3(p0[0], p0[1], p1[0]), b = MMX3(p0[2], p0[3], p1[1]); a = MMX3(a, p1[2], p1[3]);
#pragma unroll
    for (int r = 4; r < 16; r += 4) { a = MMX3(a, p0[r], p0[r + 1]); b = MMX3(b, p0[r + 2], p0[r + 3]); a = MMX3(a, p1[r], p1[r + 1]); b = MMX3(b, p1[r + 2], p1[r + 3]); }
    float m = __builtin_fmaxf(a, b); auto rr = __builtin_amdgcn_permlane32_swap(__float_as_uint(m), __float_as_uint(m), false, false);
    return __builtin_fmaxf(__uint_as_float(rr[0]), __uint_as_float(rr[1])); }
__device__ __forceinline__ void moba_unit(const bf16_t* Qp, const bf16_t* Kp, const bf16_t* Vp, bf16_t* Op, int ldo, int qb, ALDS char* lds) {
    int tid_ = threadIdx.x; asm volatile("" : "+v"(tid_));
    const int tid = tid_, lane = tid & 63, r32 = lane & 31, hi = lane >> 5; const int wid = __builtin_amdgcn_readfirstlane(tid >> 6);
    const int NT = 4 * qb + 4, NP = 4 * qb;
    ALDS float* wsf = (ALDS float*)(lds + M_WS) + wid * 64;
    const bf16_t* ksrc = Kp + (size_t)(lane >> 4) * 16 * AW + (wid >> 2) * 512 + (wid & 3) * 128 + (lane & 15) * 8;
    const bf16_t* vsrc = Vp + (size_t)(wid & 3) * 16 * AW + (wid >> 2) * 512 + (lane & 3) * 128 + (lane >> 2) * 8;
    const unsigned lds0 = (unsigned)(uintptr_t)lds, kdst = lds0 + M_K + wid * 1024, vdst = lds0 + M_V + wid * 1024;
#define MDMA_K(t, slot) m_glds16(ksrc + (size_t)(t) * 64 * AW, (unsigned)__builtin_amdgcn_readfirstlane(kdst + (slot)))
#define MDMA_V(t, slot) m_glds16(vsrc + (size_t)(t) * 64 * AW, (unsigned)__builtin_amdgcn_readfirstlane(vdst + (slot)))
    ALDS const char* vp0 = lds + M_V + ((lane >> 4) & 1) * 32 + (lane & 3) * 8 + (4 * hi + ((lane & 15) >> 2)) * 64;
    ALDS const char* kp0 = lds + M_K + hi * 1024 + r32 * 16;
    MDMA_K(0, 0); MDMA_V(0, 0); MDMA_K(1, MSLOT);
    bf16x8 qr[4];
    { const bf16_t* Qw = Qp + (size_t)(qb * 256 + wid * 32 + (r32 & 16)) * AW + (r32 & 15) * 8 + hi * 128;
#pragma unroll
      for (int d0 = 0; d0 < 4; ++d0) qr[d0] = *(const bf16x8*)(Qw + (d0 >> 1) * 512 + (d0 & 1) * 256); }
    MDMA_K(2, 2 * MSLOT);
    float mhat = 0.f, l_reg = 0.f; f32x16 o[2]; o[0] = f32x16{}; o[1] = f32x16{};
    const int qrel = wid * 32 + r32; bool resc = false, moved = false;
    unsigned sel = 0xffu; const bool gated = qb > 3;
    if (gated) {
        ALDS const float* km = (ALDS const float*)(lds + L_KM); float g[8];
#pragma unroll
        for (int n = 0; n < 8; ++n) { float sg = 0.f;
#pragma unroll
            for (int d0 = 0; d0 < 4; ++d0)
#pragma unroll
                for (int j = 0; j < 8; ++j) sg += bf2f(qr[d0][j]) * km[n * 64 + d0 * 16 + hi * 8 + j];
            g[n] = sg; }
#pragma unroll
        for (int n = 0; n < 8; ++n) g[n] += __shfl_xor(g[n], 32);
        sel = 0u;
#pragma unroll
        for (int n = 0; n < 8; ++n) { int rank = 0;
#pragma unroll
            for (int mm = 0; mm < 8; ++mm) if (mm != n) rank += (mm < qb && (g[mm] > g[n] || (g[mm] == g[n] && mm < n))) ? 1 : 0;
            if (n < qb && rank < 3) sel |= 1u << n; }
    }
    f32x16 cm;
#define MCM(t) do { const float v_ = (gated && (t) < NP && !((sel >> ((t) >> 2)) & 1u)) ? -INFINITY : -mhat; _Pragma("unroll") for (int r = 0; r < 16; ++r) cm[r] = v_; MPIN(cm); } while (0)
    MCM(0);
    f32x16 pA0, pA1, pB0, pB1; bf16x8 kf[8]; s16x4 vlo[8], vhi[8]; u32x4 pw0, pw1, pw2, pw3;
    int sl_prev = 0, sl_cur = 0, sl_next = MSLOT;
#define MROT() do { sl_prev = sl_cur; sl_cur = sl_next; sl_next = (sl_next == 2 * MSLOT) ? 0 : sl_next + MSLOT; } while (0)
#define MEX(v) __builtin_amdgcn_exp2f(v)
#define MRESC(tn) do { if (moved) { moved = false; MCM(tn); } if (resc) { _Pragma("unroll") for (int d_ = 0; d_ < 2; ++d_) _Pragma("unroll") for (int r = 0; r < 16; ++r) o[d_][r] *= wsf[crow(r, hi)]; } } while (0)
#define MDECIDE(C0, C1) do { const float rm = m_rowmax(C0, C1); resc = false; \
      if (__builtin_expect(__any(rm > THR), 0)) { const float dl = __builtin_fmaxf(rm, 0.f); mhat += dl; const float f = __builtin_amdgcn_exp2f(-dl); l_reg *= f; if (hi == 0) wsf[r32] = f; resc = true; \
          _Pragma("unroll") for (int r = 0; r < 16; ++r) { C0[r] -= dl; C1[r] -= dl; } moved = true; } } while (0)
    MWAIT_BAR(3);
#pragma unroll
    for (int d0 = 0; d0 < 4; ++d0) m_kload2(kf, kp0, d0);
    pA0 = MMFMA(kf[0], qr[0], cm); pA1 = MMFMA(kf[1], qr[0], cm); pA0 = MMFMA(kf[2], qr[1], pA0); pA1 = MMFMA(kf[3], qr[1], pA1);
    pA0 = MMFMA(kf[4], qr[2], pA0); pA1 = MMFMA(kf[5], qr[2], pA1); pA0 = MMFMA(kf[6], qr[3], pA0); pA1 = MMFMA(kf[7], qr[3], pA1);
    if (NT == 4) cmask(pA0, pA1, 0, qrel, hi);
    MDECIDE(pA0, pA1);
    if (moved) { moved = false; MCM(1); }
#pragma unroll
    for (int r = 0; r < 16; ++r) { pA0[r] = MEX(pA0[r]); pA1[r] = MEX(pA1[r]); }
    MWAIT_BAR(0);
    MDMA_K(3, 0); MDMA_V(1, MSLOT); MROT();
#pragma unroll
    for (int d0 = 0; d0 < 4; ++d0) m_kload2(kf, kp0 + sl_cur, d0);
    MWAIT_BAR(2);
#define MPKW(P, i) cvtpk(P[i], P[i + 1])
#define MPAF(k) __builtin_bit_cast(bf16x8, pw##k)
#define MVFR(i) (bf16x8){vlo[i][0], vlo[i][1], vlo[i][2], vlo[i][3], vhi[i][0], vhi[i][1], vhi[i][2], vhi[i][3]}
#define MVRD(i) do { vlo[i] = m_vtr(vp_ + (((i) >> 2) * 4096 + ((i) & 3) * 1024)); vhi[i] = m_vtr(vp_ + (((i) >> 2) * 4096 + ((i) & 3) * 1024 + 512)); } while (0)
#define MKRD(G, d0) do { if (G) { m_kload2(kf, kp0 + sl_next, d0); ASBAR(); } } while (0)
#define MGAPA(MF, a0, a1, a2, a3, W0, W1, PW) do { MF; sacc += a0; sacc += a1; sacc += a2; sacc += a3; W0; W1; MPIN(PW); MPIN(sacc); ASBAR(); } while (0)
#define MGAPB(MF, X, i) do { MF; X[i] = MEX(X[i]); X[i + 1] = MEX(X[i + 1]); X[i + 2] = MEX(X[i + 2]); X[i + 3] = MEX(X[i + 3]); MPIN(X); ASBAR(); } while (0)
#define MSTEP(C0, C1, P0, P1, t, MASK, GK, GV, GL) do { ASBAR(); \
    const ALDS char* vp_ = vp0 + sl_prev; if (gated && ((t) & 3) == 0) MCM(t); \
    MVRD(0); ASBAR(); float sacc = P0[0] + P0[1]; \
                     MGAPA(C0 = MMFMA(kf[0], qr[0], cm), P0[2], P0[3], P0[4], P0[5],     pw0[0] = MPKW(P0, 0),  pw0[1] = MPKW(P0, 2),  pw0); \
    MVRD(4); ASBAR(); MGAPA(C1 = MMFMA(kf[1], qr[0], cm), P0[6], P0[7], P0[8], P0[9],     pw0[2] = MPKW(P0, 4),  pw0[3] = MPKW(P0, 6),  pw0); \
    MVRD(1); ASBAR(); MGAPA(C0 = MMFMA(kf[2], qr[1], C0), P0[10], P0[11], P0[12], P0[13], pw1[0] = MPKW(P0, 8),  pw1[1] = MPKW(P0, 10), pw1); \
    MVRD(5); ASBAR(); MGAPA(C1 = MMFMA(kf[3], qr[1], C1), P0[14], P0[15], P1[0], P1[1],   pw1[2] = MPKW(P0, 12), pw1[3] = MPKW(P0, 14), pw1); \
    MVRD(2); ASBAR(); MGAPA(C0 = MMFMA(kf[4], qr[2], C0), P1[2], P1[3], P1[4], P1[5],     pw2[0] = MPKW(P1, 0),  pw2[1] = MPKW(P1, 2),  pw2); \
    MVRD(6); ASBAR(); MGAPA(C1 = MMFMA(kf[5], qr[2], C1), P1[6], P1[7], P1[8], P1[9],     pw2[2] = MPKW(P1, 4),  pw2[3] = MPKW(P1, 6),  pw2); \
    MVRD(3); ASBAR(); MGAPA(C0 = MMFMA(kf[6], qr[3], C0), P1[10], P1[11], P1[12], P1[13], pw3[0] = MPKW(P1, 8),  pw3[1] = MPKW(P1, 10), pw3); \
    MVRD(7); ASBAR(); MGAPA(C1 = MMFMA(kf[7], qr[3], C1), P1[14], P1[15], 0.f, 0.f,       pw3[2] = MPKW(P1, 12), pw3[3] = MPKW(P1, 14), pw3); \
    l_reg += sacc; \
    if (GK) MDMA_K((t) + 3, sl_cur); if (GV) MDMA_V((t) + 1, sl_next); \
    if (MASK) cmask(C0, C1, (t) - NP, qrel, hi); \
    MDECIDE(C0, C1); ASBAR(); \
    MGAPB(o[0] = MMFMA(MPAF(0), MVFR(0), o[0]), C0, 0);               MGAPB(o[1] = MMFMA(MPAF(0), MVFR(4), o[1]), C0, 4); \
    MKRD(GL, 0); MGAPB(o[0] = MMFMA(MPAF(1), MVFR(1), o[0]), C0, 8);  MKRD(GL, 1); MGAPB(o[1] = MMFMA(MPAF(1), MVFR(5), o[1]), C0, 12); \
    MKRD(GL, 2); MGAPB(o[0] = MMFMA(MPAF(2), MVFR(2), o[0]), C1, 0);  MKRD(GL, 3); MGAPB(o[1] = MMFMA(MPAF(2), MVFR(6), o[1]), C1, 4); \
    MGAPB(o[0] = MMFMA(MPAF(3), MVFR(3), o[0]), C1, 8);               MGAPB(o[1] = MMFMA(MPAF(3), MVFR(7), o[1]), C1, 12); \
    } while (0)
    int t = 1;
    for (; t + 5 < NT; t += 2) {
        MSTEP(pB0, pB1, pA0, pA1, t, false, true, true, true);     MWAIT_BAR(2); MRESC(t + 1); MROT();
        MSTEP(pA0, pA1, pB0, pB1, t + 1, false, true, true, true); MWAIT_BAR(2); MRESC(t + 2); MROT();
    }
#define MENDW(tt) do { if ((tt) + 3 < NT) { MWAIT_BAR(2); } else if ((tt) + 2 < NT) { MWAIT_BAR(1); } else { MWAIT_BAR(0); } } while (0)
    for (; t + 1 < NT; t += 2) {
        MSTEP(pB0, pB1, pA0, pA1, t, true, (t + 3 < NT), (t + 1 < NT), (t + 1 < NT));         MENDW(t);     MRESC(t + 1); MROT();
        MSTEP(pA0, pA1, pB0, pB1, t + 1, true, (t + 4 < NT), (t + 2 < NT), (t + 2 < NT));     MENDW(t + 1); MRESC(t + 2); MROT();
    }
    MSTEP(pB0, pB1, pA0, pA1, NT - 1, true, false, false, false); MRESC(NT - 1);
    { float sacc = pB0[0] + pB0[1];
#pragma unroll
      for (int r = 2; r < 16; ++r) sacc += pB0[r];
#pragma unroll
      for (int r = 0; r < 16; ++r) sacc += pB1[r];
      l_reg += sacc;
      pw0 = (u32x4){MPKW(pB0, 0), MPKW(pB0, 2), MPKW(pB0, 4), MPKW(pB0, 6)}; pw1 = (u32x4){MPKW(pB0, 8), MPKW(pB0, 10), MPKW(pB0, 12), MPKW(pB0, 14)};
      pw2 = (u32x4){MPKW(pB1, 0), MPKW(pB1, 2), MPKW(pB1, 4), MPKW(pB1, 6)}; pw3 = (u32x4){MPKW(pB1, 8), MPKW(pB1, 10), MPKW(pB1, 12), MPKW(pB1, 14)};
      const ALDS char* vp_ = vp0 + sl_cur;
#pragma unroll
      for (int i = 0; i < 8; ++i) MVRD(i);
      o[0] = MMFMA(MPAF(0), MVFR(0), o[0]); o[1] = MMFMA(MPAF(0), MVFR(4), o[1]); o[0] = MMFMA(MPAF(1), MVFR(1), o[0]); o[1] = MMFMA(MPAF(1), MVFR(5), o[1]);
      o[0] = MMFMA(MPAF(2), MVFR(2), o[0]); o[1] = MMFMA(MPAF(2), MVFR(6), o[1]); o[0] = MMFMA(MPAF(3), MVFR(3), o[0]); o[1] = MMFMA(MPAF(3), MVFR(7), o[1]); }
    { auto rr = __builtin_amdgcn_permlane32_swap(__float_as_uint(l_reg), __float_as_uint(l_reg), false, false); l_reg = __uint_as_float(rr[0]) + __uint_as_float(rr[1]); }
    if (hi == 0) wsf[32 + r32] = l_reg; asm volatile("s_waitcnt lgkmcnt(0)" ::: "memory");
    float rli[16];
#pragma unroll
    for (int r = 0; r < 16; ++r) rli[r] = __builtin_amdgcn_rcpf(wsf[32 + crow(r, hi)]);
    { ALDS unsigned short* stg = (ALDS unsigned short*)(lds + M_OST) + wid * 2048;
#pragma unroll
      for (int r = 0; r < 16; ++r) { const int orow = crow(r, hi);
#pragma unroll
          for (int d0 = 0; d0 < 2; ++d0) stg[orow * 64 + d0 * 32 + r32] = (unsigned short)(cvtpk(o[d0][r] * rli[r], 0.f) & 0xffffu); }
      asm volatile("s_waitcnt lgkmcnt(0)" ::: "memory");
      bf16_t* Ow = Op + (size_t)(qb * 256 + wid * 32) * ldo;
#pragma unroll
      for (int i = 0; i < 4; ++i) { const u32x4 v = *(ALDS const u32x4*)(stg + ((i >> 1) * 16 + (lane & 15)) * 64 + (i & 1) * 32 + (lane >> 4) * 8); *(u32x4*)(Ow + (size_t)((i >> 1) * 16) * ldo + (i & 1) * 512 + lane * 8) = v; } }
    asm volatile("s_waitcnt lgkmcnt(0)\n\ts_barrier" ::: "memory");
#undef MDMA_K
#undef MDMA_V
#undef MCM
#undef MROT
#undef MEX
#undef MRESC
#undef MDECIDE
#undef MPKW
#undef MPAF
#undef MVFR
#undef MVRD
#undef MKRD
#undef MGAPA
#undef MGAPB
#undef MSTEP
#undef MENDW
}
__device__ __forceinline__ void mla_unit(const bf16_t* Qp, const bf16_t* Kp, const bf16_t* KRp, const bf16_t* Vp, bf16_t* Op, int ldo, int qb, ALDS char* lds) {
    constexpr int KSL = 12288, N_K = 0, N_V = 3 * KSL, N_WS = N_V + 3 * MSLOT, N_OST = N_WS + 8 * 256;
    int tid_ = threadIdx.x; asm volatile("" : "+v"(tid_));
    const int tid = tid_, lane = tid & 63, r32 = lane & 31, hi = lane >> 5; const int wid = __builtin_amdgcn_readfirstlane(tid >> 6);
    const int NT = 4 * qb + 4, NP = 4 * qb;
    ALDS float* wsf = (ALDS float*)(lds + N_WS) + wid * 64;
    const bf16_t* ksrc = Kp + (size_t)(lane >> 4) * 16 * AW + (wid >> 2) * 512 + (wid & 3) * 128 + (lane & 15) * 8;
    const bf16_t* vsrc = Vp + (size_t)(wid & 3) * 16 * AW + (wid >> 2) * 512 + (lane & 3) * 128 + (lane >> 2) * 8;
    const bf16_t* rsrc = KRp + (size_t)(lane >> 4) * 16 * RDIM + (wid & 3) * 128 + (lane & 15) * 8;
    const unsigned lds0 = (unsigned)(uintptr_t)lds, kdst = lds0 + N_K + wid * 1024, vdst = lds0 + N_V + wid * 1024, rdst = lds0 + N_K + (8 + (wid & 3)) * 1024;
#define MDMA_K(t, slot) do { m_glds16(ksrc + (size_t)(t) * 64 * AW, (unsigned)__builtin_amdgcn_readfirstlane(kdst + (slot) * KSL)); m_glds16(rsrc + (size_t)(t) * 64 * RDIM, (unsigned)__builtin_amdgcn_readfirstlane(rdst + (slot) * KSL)); } while (0)
#define MDMA_V(t, slot) m_glds16(vsrc + (size_t)(t) * 64 * AW, (unsigned)__builtin_amdgcn_readfirstlane(vdst + (slot) * MSLOT))
    ALDS const char* vp0 = lds + N_V + ((lane >> 4) & 1) * 32 + (lane & 3) * 8 + (4 * hi + ((lane & 15) >> 2)) * 64;
    ALDS const char* kp0 = lds + N_K + hi * 1024 + r32 * 16;
    MDMA_K(0, 0); MDMA_V(0, 0); MDMA_K(1, 1);
    bf16x8 qr[6];
    { const bf16_t* Qw = Qp + (size_t)(qb * 256 + wid * 32 + (r32 & 16)) * (NHEAD * QKB) + (r32 & 15) * 8 + hi * 128;
#pragma unroll
      for (int d0 = 0; d0 < 6; ++d0) qr[d0] = *(const bf16x8*)(Qw + (d0 >> 1) * 512 + (d0 & 1) * 256); }
    MDMA_K(2, 2);
    float mhat = 0.f, l_reg = 0.f; f32x16 o[2]; o[0] = f32x16{}; o[1] = f32x16{};
    const int qrel = wid * 32 + r32; bool resc = false, moved = false;
    constexpr bool gated = false; constexpr unsigned sel = 0xffu;
#define MCM(t) do { } while (0)
#define MREL(C0, C1) do { if (__builtin_expect(__any(mhat != 0.f), 0)) { _Pragma("unroll") for (int r = 0; r < 16; ++r) { C0[r] -= mhat; C1[r] -= mhat; } } } while (0)
    f32x16 pA0, pA1, pB0, pB1; bf16x8 kf[12]; s16x4 vlo[8], vhi[8]; u32x4 pw0, pw1, pw2, pw3;
    int sl_prev = 0, sl_cur = 0, sl_next = 1;
#define MROT() do { sl_prev = sl_cur; sl_cur = sl_next; sl_next = (sl_next == 2) ? 0 : sl_next + 1; } while (0)
#define MEX(v) __builtin_amdgcn_exp2f(v)
#define MRESC(tn) do { if (resc) { _Pragma("unroll") for (int d_ = 0; d_ < 2; ++d_) _Pragma("unroll") for (int r = 0; r < 16; ++r) o[d_][r] *= wsf[crow(r, hi)]; } } while (0)
#define MDECIDE(C0, C1) do { const float rm = m_rowmax(C0, C1); resc = false; \
      if (__builtin_expect(__any(rm > THR), 0)) { const float dl = __builtin_fmaxf(rm, 0.f); mhat += dl; const float f = __builtin_amdgcn_exp2f(-dl); l_reg *= f; if (hi == 0) wsf[r32] = f; resc = true; \
          _Pragma("unroll") for (int r = 0; r < 16; ++r) { C0[r] -= dl; C1[r] -= dl; } moved = true; } } while (0)
    MWAIT_BAR(5);
#pragma unroll
    for (int d0 = 0; d0 < 6; ++d0) m_kload2(kf, kp0, d0);
    pA0 = MMFMA(kf[0], qr[0], (f32x16){}); pA1 = MMFMA(kf[1], qr[0], (f32x16){}); pA0 = MMFMA(kf[2], qr[1], pA0); pA1 = MMFMA(kf[3], qr[1], pA1);
    pA0 = MMFMA(kf[4], qr[2], pA0); pA1 = MMFMA(kf[5], qr[2], pA1); pA0 = MMFMA(kf[6], qr[3], pA0); pA1 = MMFMA(kf[7], qr[3], pA1);
    pA0 = MMFMA(kf[8], qr[4], pA0); pA1 = MMFMA(kf[9], qr[4], pA1); pA0 = MMFMA(kf[10], qr[5], pA0); pA1 = MMFMA(kf[11], qr[5], pA1);
    if (NT == 4) cmask(pA0, pA1, 0, qrel, hi);
    MREL(pA0, pA1); MDECIDE(pA0, pA1);
#pragma unroll
    for (int r = 0; r < 16; ++r) { pA0[r] = MEX(pA0[r]); pA1[r] = MEX(pA1[r]); }
    MWAIT_BAR(0);
    MDMA_K(3, 0); MDMA_V(1, 1); MROT();
#pragma unroll
    for (int d0 = 0; d0 < 6; ++d0) m_kload2(kf, kp0 + sl_cur * KSL, d0);
    MWAIT_BAR(3);
#define MPKW(P, i) cvtpk(P[i], P[i + 1])
#define MPAF(k) __builtin_bit_cast(bf16x8, pw##k)
#define MVFR(i) (bf16x8){vlo[i][0], vlo[i][1], vlo[i][2], vlo[i][3], vhi[i][0], vhi[i][1], vhi[i][2], vhi[i][3]}
#define MVRD(i) do { vlo[i] = m_vtr(vp_ + (((i) >> 2) * 4096 + ((i) & 3) * 1024)); vhi[i] = m_vtr(vp_ + (((i) >> 2) * 4096 + ((i) & 3) * 1024 + 512)); } while (0)
#define MKRD(G, d0) do { if (G) { m_kload2(kf, kp0 + sl_next * KSL, d0); ASBAR(); } } while (0)
#define MGAPA(MF, a0, a1, a2, a3, W0, W1, PW) do { MF; sacc += a0; sacc += a1; sacc += a2; sacc += a3; W0; W1; MPIN(PW); MPIN(sacc); ASBAR(); } while (0)
#define MGAPB(MF, X, i) do { MF; X[i] = MEX(X[i]); X[i + 1] = MEX(X[i + 1]); X[i + 2] = MEX(X[i + 2]); X[i + 3] = MEX(X[i + 3]); MPIN(X); ASBAR(); } while (0)
#define MGAPA2(MF, a0, a1, W0, PW) do { MF; sacc += a0; sacc += a1; W0; MPIN(PW); MPIN(sacc); ASBAR(); } while (0)
#define MSTEP(C0, C1, P0, P1, t, MASK, GK, GV, GL) do { ASBAR(); \
    const ALDS char* vp_ = vp0 + sl_prev * MSLOT; \
    MVRD(0); ASBAR(); float sacc = P0[0] + P0[1]; \
                     MGAPA(C0 = MMFMA(kf[0], qr[0], (f32x16){}), P0[2], P0[3], P0[4], P0[5],     pw0[0] = MPKW(P0, 0),  pw0[1] = MPKW(P0, 2),  pw0); \
    MVRD(4); ASBAR(); MGAPA(C1 = MMFMA(kf[1], qr[0], (f32x16){}), P0[6], P0[7], P0[8], P0[9],     pw0[2] = MPKW(P0, 4),  pw0[3] = MPKW(P0, 6),  pw0); \
    MVRD(1); ASBAR(); MGAPA2(C0 = MMFMA(kf[2], qr[1], C0), P0[10], P0[11], pw1[0] = MPKW(P0, 8),  pw1); \
    MVRD(5); ASBAR(); MGAPA2(C1 = MMFMA(kf[3], qr[1], C1), P0[12], P0[13], pw1[1] = MPKW(P0, 10), pw1); \
                     MGAPA2(C0 = MMFMA(kf[4], qr[2], C0), P0[14], P0[15], pw1[2] = MPKW(P0, 12), pw1); \
                     MGAPA2(C1 = MMFMA(kf[5], qr[2], C1), P1[0], P1[1],   pw1[3] = MPKW(P0, 14), pw1); \
                     MGAPA2(C0 = MMFMA(kf[6], qr[3], C0), P1[2], P1[3],   pw2[0] = MPKW(P1, 0),  pw2); \
                     MGAPA2(C1 = MMFMA(kf[7], qr[3], C1), P1[4], P1[5],   pw2[1] = MPKW(P1, 2),  pw2); \
                     MGAPA(C0 = MMFMA(kf[8], qr[4], C0), P1[6], P1[7], P1[8], P1[9],     pw2[2] = MPKW(P1, 4),  pw2[3] = MPKW(P1, 6),  pw2); \
                     MGAPA(C1 = MMFMA(kf[9], qr[4], C1), P1[10], P1[11], P1[12], P1[13], pw3[0] = MPKW(P1, 8),  pw3[1] = MPKW(P1, 10), pw3); \
                     MGAPA2(C0 = MMFMA(kf[10], qr[5], C0), P1[14], P1[15], pw3[2] = MPKW(P1, 12), pw3); \
                     MGAPA2(C1 = MMFMA(kf[11], qr[5], C1), 0.f, 0.f,       pw3[3] = MPKW(P1, 14), pw3); \
    l_reg += sacc; \
    if (GK) MDMA_K((t) + 3, sl_cur); if (GV) MDMA_V((t) + 1, sl_next); \
    if (MASK) cmask(C0, C1, (t) - NP, qrel, hi); \
    MREL(C0, C1); MDECIDE(C0, C1); ASBAR(); \
    MVRD(2); MKRD(GL, 4); ASBAR(); MGAPB(o[0] = MMFMA(MPAF(0), MVFR(0), o[0]), C0, 0);  MVRD(6); MKRD(GL, 5); ASBAR(); MGAPB(o[1] = MMFMA(MPAF(0), MVFR(4), o[1]), C0, 4); \
    MVRD(3); MKRD(GL, 0); ASBAR(); MGAPB(o[0] = MMFMA(MPAF(1), MVFR(1), o[0]), C0, 8);  MVRD(7); MKRD(GL, 1); ASBAR(); MGAPB(o[1] = MMFMA(MPAF(1), MVFR(5), o[1]), C0, 12); \
    MKRD(GL, 2); MGAPB(o[0] = MMFMA(MPAF(2), MVFR(2), o[0]), C1, 0);  MKRD(GL, 3); MGAPB(o[1] = MMFMA(MPAF(2), MVFR(6), o[1]), C1, 4); \
    MGAPB(o[0] = MMFMA(MPAF(3), MVFR(3), o[0]), C1, 8);               MGAPB(o[1] = MMFMA(MPAF(3), MVFR(7), o[1]), C1, 12); \
    } while (0)
    int t = 1;
    for (; t + 5 < NT; t += 2) {
        MSTEP(pB0, pB1, pA0, pA1, t, false, true, true, true);     MWAIT_BAR(3); MRESC(t + 1); MROT();
        MSTEP(pA0, pA1, pB0, pB1, t + 1, false, true, true, true); MWAIT_BAR(3); MRESC(t + 2); MROT();
    }
#define MENDW(tt) do { if ((tt) + 3 < NT) { MWAIT_BAR(3); } else if ((tt) + 2 < NT) { MWAIT_BAR(1); } else { MWAIT_BAR(0); } } while (0)
    for (; t + 1 < NT; t += 2) {
        MSTEP(pB0, pB1, pA0, pA1, t, true, (t + 3 < NT), (t + 1 < NT), (t + 1 < NT));         MENDW(t);     MRESC(t + 1); MROT();
        MSTEP(pA0, pA1, pB0, pB1, t + 1, true, (t + 4 < NT), (t + 2 < NT), (t + 2 < NT));     MENDW(t + 1); MRESC(t + 2); MROT();
    }
    MSTEP(pB0, pB1, pA0, pA1, NT - 1, true, false, false, false); MRESC(NT - 1);
    { float sacc = pB0[0] + pB0[1];
#pragma unroll
      for (int r = 2; r < 16; ++r) sacc += pB0[r];
#pragma unroll
      for (int r = 0; r < 16; ++r) sacc += pB1[r];
      l_reg += sacc;
      pw0 = (u32x4){MPKW(pB0, 0), MPKW(pB0, 2), MPKW(pB0, 4), MPKW(pB0, 6)}; pw1 = (u32x4){MPKW(pB0, 8), MPKW(pB0, 10), MPKW(pB0, 12), MPKW(pB0, 14)};
      pw2 = (u32x4){MPKW(pB1, 0), MPKW(pB1, 2), MPKW(pB1, 4), MPKW(pB1, 6)}; pw3 = (u32x4){MPKW(pB1, 8), MPKW(pB1, 10), MPKW(pB1, 12), MPKW(pB1, 14)};
      const ALDS char* vp_ = vp0 + sl_cur * MSLOT;
#pragma unroll
      for (int i = 0; i < 8; ++i) MVRD(i);
      o[0] = MMFMA(MPAF(0), MVFR(0), o[0]); o[1] = MMFMA(MPAF(0), MVFR(4), o[1]); o[0] = MMFMA(MPAF(1), MVFR(1), o[0]); o[1] = MMFMA(MPAF(1), MVFR(5), o[1]);
      o[0] = MMFMA(MPAF(2), MVFR(2), o[0]); o[1] = MMFMA(MPAF(2), MVFR(6), o[1]); o[0] = MMFMA(MPAF(3), MVFR(3), o[0]); o[1] = MMFMA(MPAF(3), MVFR(7), o[1]); }
    { auto rr = __builtin_amdgcn_permlane32_swap(__float_as_uint(l_reg), __float_as_uint(l_reg), false, false); l_reg = __uint_as_float(rr[0]) + __uint_as_float(rr[1]); }
    if (hi == 0) wsf[32 + r32] = l_reg; asm volatile("s_waitcnt lgkmcnt(0)" ::: "memory");
    float rli[16];
#pragma unroll
    for (int r = 0; r < 16; ++r) rli[r] = __builtin_amdgcn_rcpf(wsf[32 + crow(r, hi)]);
    { ALDS unsigned short* stg = (ALDS unsigned short*)(lds + N_OST) + wid * 2048;
#pragma unroll
      for (int r = 0; r < 16; ++r) { const int orow = crow(r, hi);
#pragma unroll
          for (int d0 = 0; d0 < 2; ++d0) stg[orow * 64 + d0 * 32 + r32] = (unsigned short)(cvtpk(o[d0][r] * rli[r], 0.f) & 0xffffu); }
      asm volatile("s_waitcnt lgkmcnt(0)" ::: "memory");
      bf16_t* Ow = Op + (size_t)(qb * 256 + wid * 32) * ldo;
#pragma unroll
      for (int i = 0; i < 4; ++i) { const u32x4 v = *(ALDS const u32x4*)(stg + ((i >> 1) * 16 + (lane & 15)) * 64 + (i & 1) * 32 + (lane >> 4) * 8); *(u32x4*)(Ow + (size_t)((i >> 1) * 16) * ldo + (i & 1) * 512 + lane * 8) = v; } }
    asm volatile("s_waitcnt lgkmcnt(0)\n\ts_barrier" ::: "memory");
#undef MDMA_K
#undef MDMA_V
#undef MCM
#undef MROT
#undef MEX
#undef MRESC
#undef MDECIDE
#undef MPKW
#undef MPAF
#undef MVFR
#undef MVRD
#undef MKRD
#undef MGAPA
#undef MGAPB
#undef MSTEP
#undef MENDW
#undef MGAPA2
#undef MREL
}
#undef ASBAR
}
#define GAS __attribute__((address_space(1)))
#define LAS __attribute__((address_space(3)))
typedef unsigned short bf16;
typedef unsigned v4u __attribute__((ext_vector_type(4)));
typedef float f32x4 __attribute__((ext_vector_type(4)));
typedef short bf16x8 __attribute__((ext_vector_type(8)));
typedef GAS unsigned gu32;
typedef GAS unsigned long long gu64;
#define RLX_AGENT __ATOMIC_RELAXED, __HIP_MEMORY_SCOPE_AGENT
#define LDS_WAIT() asm volatile("s_waitcnt lgkmcnt(0)" ::: "memory")
#define VM_WAIT() asm volatile("s_waitcnt vmcnt(0)" ::: "memory")
__device__ __forceinline__ unsigned long long rt() { return __builtin_amdgcn_s_memrealtime(); }
__device__ __forceinline__ unsigned f2bf(float f) { unsigned u = __builtin_bit_cast(unsigned, f); return (u + 0x7fffu + ((u >> 16) & 1u)) >> 16; }
__device__ __forceinline__ unsigned pk2(float lo, float hi) { return f2bf(lo) | (f2bf(hi) << 16); }

#define XB_TMO      128
#define XB_XCNT(j)  (256  + 64 * (j))
#define XB_XSUB(j)  (1280 + 64 * (j))
#define XB_XGEN(j)  (2304 + 64 * (j))
#define XB_TOP      3328
#define XB_TOPGEN   3392
#define XCD_BAR_WORDS 3456
#define XB_SPIN_CAP (1u << 18)

__device__ __forceinline__ unsigned xb_ld(unsigned* p)              { return __hip_atomic_load(p, __ATOMIC_RELAXED, __HIP_MEMORY_SCOPE_AGENT); }
__device__ __forceinline__ unsigned xb_add(unsigned* p, unsigned v) { return __hip_atomic_fetch_add(p, v, __ATOMIC_RELAXED, __HIP_MEMORY_SCOPE_AGENT); }
__device__ __forceinline__ unsigned xb_xcc_id() { return (unsigned)__builtin_amdgcn_s_getreg((3 << 11) | 20) & 0xFu; }
#define XB_SPIN(cond, bar) do { unsigned _sp = 0; while (cond) { __builtin_amdgcn_s_sleep(1); \
    if ((++_sp & 255u) == 0u) { if (xb_ld(&(bar)[XB_TMO])) break; if (_sp > XB_SPIN_CAP) { atomicAdd(&(bar)[XB_TMO], 1u); break; } } } } while (0)

struct XcdBarrier {
    unsigned* bar; unsigned x;
    volatile LAS unsigned* st;
};

__device__ __forceinline__ XcdBarrier xcd_barrier_post(unsigned* bar, volatile LAS unsigned* st) {
    XcdBarrier b; b.bar = bar; b.x = xb_xcc_id(); b.st = st;
    if (threadIdx.x == 0) (void)xb_add(&bar[XB_XCNT(b.x)], 1u);
    return b;
}
__device__ __forceinline__ void xcd_barrier_complete(unsigned* bar, unsigned x, unsigned& nloc, unsigned& nx) {
    const unsigned G = gridDim.x * gridDim.y * gridDim.z;
    unsigned sum, cnt, mine, sp = 0u;
    for (;;) {
        sum = 0u; cnt = 0u; mine = 0u;
#pragma unroll
        for (unsigned j = 0; j < 16; ++j) { const unsigned c = xb_ld(&bar[XB_XCNT(j)]); sum += c; cnt += (c > 0u) ? 1u : 0u; mine = (j == x) ? c : mine; }
        if (sum == G) break;
        __builtin_amdgcn_s_sleep(1);
        if ((++sp & 255u) == 0u) { if (xb_ld(&bar[XB_TMO])) break; if (sp > XB_SPIN_CAP) { atomicAdd(&bar[XB_TMO], 1u); break; } }
    }
    nloc = mine > 0u ? mine : 1u; nx = cnt > 0u ? cnt : 1u;
}

__device__ __forceinline__ void xcd_barrier(const XcdBarrier& b) {
    asm volatile("s_waitcnt vmcnt(0)" ::: "memory");
    __syncthreads();
    if (threadIdx.x == 0) {
        unsigned* bar = b.bar;
        __builtin_amdgcn_s_waitcnt(0);
        unsigned nloc = b.st[0], nx = b.st[1];
        if (nloc == 0u) { xcd_barrier_complete(bar, b.x, nloc, nx); b.st[0] = nloc; b.st[1] = nx; }
        const unsigned old = xb_add(&bar[XB_XSUB(b.x)], 1u);
        const unsigned gen = old / nloc;
        if (old + 1u == (gen + 1u) * nloc) {
            __builtin_amdgcn_fence(__ATOMIC_RELEASE, "agent");
            asm volatile("s_waitcnt vmcnt(0)" ::: "memory");
            const unsigned og = xb_add(&bar[XB_TOP], 1u);
            const unsigned tg = og / nx;
            if (og + 1u == (tg + 1u) * nx) xb_add(&bar[XB_TOPGEN], 1u);
            else XB_SPIN(xb_ld(&bar[XB_TOPGEN]) == tg, bar);
            __builtin_amdgcn_fence(__ATOMIC_ACQUIRE, "agent");
            xb_add(&bar[XB_XGEN(b.x)], 1u);
            asm volatile("s_waitcnt vmcnt(0)" ::: "memory");
        } else {
            XB_SPIN(xb_ld(&bar[XB_XGEN(b.x)]) == gen, bar);
            __builtin_amdgcn_fence(__ATOMIC_ACQUIRE, "agent");
            asm volatile("s_waitcnt vmcnt(0)" ::: "memory");
        }
    }
    __syncthreads();
}

constexpr size_t MiB = 1u << 20;
constexpr size_t WS_CTL = 0, CTL_ZERO_BYTES = 64 * 1024;
constexpr size_t WS_ROPEA = 1 * MiB, WS_ROPEB = 5 * MiB;
constexpr size_t WS_SS = 13 * MiB, WS_SS2 = 16 * MiB, WS_SS3 = 20 * MiB;
constexpr size_t WS_WIN = 24 * MiB, WS_WUQ = 34 * MiB, WS_WUKV = 35 * MiB, WS_WA = 36 * MiB, WS_WOUT = 39 * MiB, WS_WUP = 42 * MiB, WS_WDN = 51 * MiB;
constexpr size_t WS_H = 64 * MiB;
constexpr size_t WS_G = 208 * MiB;
constexpr size_t WS_QA = 464 * MiB, WS_KA = 528 * MiB, WS_VA = 592 * MiB;
constexpr size_t WS_T = WS_KA;
constexpr size_t WS_CQ = 672 * MiB, WS_CKV = 720 * MiB;
constexpr size_t WS_KR = 760 * MiB;
constexpr size_t WS_QB = 768 * MiB, WS_KB = 864 * MiB, WS_VB = 928 * MiB;
constexpr size_t WS_Y = WS_QB;
constexpr size_t WS_X1 = 896 * MiB;
constexpr size_t WS_H8 = WS_QB;
constexpr size_t WS_WG8 = 60 * MiB;
constexpr size_t WS_U = 208 * MiB;
constexpr size_t WS_END = 1024 * MiB;
static_assert(WS_H + (size_t)MTOK * LDH * 2 <= WS_G && WS_G + (size_t)MTOK * 2 * DM * 2 <= WS_QA && WS_T + (size_t)MTOK * LDH * 2 <= WS_CQ && WS_CQ + (size_t)MTOK * QLORA * 2 <= WS_CKV && WS_CKV + (size_t)MTOK * LDKV * 2 <= WS_KR, "d_ws map");
static_assert(WS_U + (size_t)MTOK * LDU * 2 <= WS_KR && WS_Y + (size_t)MTOK * DM * 2 <= WS_X1 && WS_X1 + (size_t)MTOK * DM * 2 <= WS_END && WS_VB + (size_t)MTOK * AW * 2 <= WS_END && WS_KR + (size_t)MTOK * RDIM * 2 <= WS_QB, "d_ws map");
static_assert(WS_WIN + (size_t)INWP * LDH * 2 <= WS_WUQ && WS_WUKV + (size_t)1024 * LDKV * 2 <= WS_WA && WS_WA + (size_t)DM * LDH * 2 <= WS_WOUT && WS_WOUT + (size_t)DM * LDH * 2 <= WS_WUP && WS_WUP + (size_t)DFF * LDH * 2 <= WS_WDN && WS_WDN + (size_t)DM * LDU * 2 <= WS_H, "d_ws map");
constexpr int CW_BAR = 0;
constexpr int NWAVES = 8;
constexpr int RING_OFF = 0, RING_BYTES = 131072;
constexpr int LDSCTL_OFF = RING_BYTES, MISC_OFF = LDSCTL_OFF + 320;
constexpr int LDS_BYTES = 147456;
static_assert(att::L_END <= RING_BYTES, "attention LDS map");

struct Frame {
    LAS unsigned char* lds;
    volatile LAS unsigned* MISC;
    gu32* ctl;
    int tid, lane, wave, vcu, G;
};

__device__ __forceinline__ float wave_sum(float v) {
#pragma unroll
    for (int o = 1; o < 64; o <<= 1) v += __shfl_xor(v, o);
    return v;
}
__device__ __forceinline__ int srccol(int mat, int n) {
    if (mat == 0) {
        if (n < 1024) { const int sect = n >> 9, c = n & 511, head = c >> 6, p = c & 63; const int d = (p < 16) ? ((p >> 1) + 8 * (p & 1)) : p; return sect * 512 + head * 64 + d; }
        if (n < 1920) return n;
        if (n < 1952) { const int pr = n - 1920; return 2176 + (pr >> 1) + 16 * (pr & 1); }
        if (n < 2048) return -1;
        if (n < 2304) return 1920 + (n - 2048);
        return 2208 + (n - 2304);
    }
    if (mat == 1) { const int head = n / QKB, p = n - head * QKB; if (p < 64) return n; const int pr = p - 64; return head * QKB + 64 + (pr >> 1) + 16 * (pr & 1); }
    return n;
}
__device__ __forceinline__ void p0_transpose_item(const float* W, int K, int Nsrc, int Ndst, bf16* WT, int ldw, int koff, const float* gs, int mat, LAS float* scr, int item, int lane) {
    const int nblk = Ndst / 32, kb = item / nblk, nb = item % nblk, k0 = 64 * kb, n0 = 32 * nb;
    const int sc = srccol(mat, n0 + (lane & 31));
#pragma unroll
    for (int i = 0; i < 32; ++i) { const int kk = 2 * i + (lane >> 5); float v = (sc >= 0) ? W[(size_t)(k0 + kk) * Nsrc + sc] : 0.f; if (gs) v *= gs[k0 + kk]; scr[kk * 33 + (lane & 31)] = v; }
    LDS_WAIT(); asm volatile("" ::: "memory");
    const int c = lane & 7;
#pragma unroll
    for (int j = 0; j < 4; ++j) { const int n = (lane >> 3) + 8 * j; const LAS float* s = scr + (8 * c) * 33 + n;
        v4u o; o.x = pk2(s[0 * 33], s[1 * 33]); o.y = pk2(s[2 * 33], s[3 * 33]); o.z = pk2(s[4 * 33], s[5 * 33]); o.w = pk2(s[6 * 33], s[7 * 33]);
        *(GAS v4u*)(WT + (size_t)(n0 + n) * ldw + koff + k0 + 8 * c) = o; }
    LDS_WAIT(); asm volatile("" ::: "memory");
}
__device__ __forceinline__ int ppos_dn(int c) { return (c & ~255) | (((c >> 5) & 3) << 6) | (((c >> 3) & 3) << 4) | (((c >> 7) & 1) << 3) | (c & 7); }
template <bool KPERM = false>
__device__ __forceinline__ void p0_transpose_item_f8(const float* W, int K, int N, int Nsrc, int coff, unsigned char* WT, float scale, LAS float* scr, int item, int lane) {
    const int nblk = N / 32, kb = item / nblk, nb = item % nblk, k0 = 64 * kb, n0 = 32 * nb;
#pragma unroll
    for (int i = 0; i < 32; ++i) { const int kk = 2 * i + (lane >> 5); scr[kk * 33 + (lane & 31)] = W[(size_t)(k0 + kk) * Nsrc + coff + n0 + (lane & 31)] * scale; }
    LDS_WAIT(); asm volatile("" ::: "memory");
    const int c = lane & 7;
#pragma unroll
    for (int j = 0; j < 4; ++j) { const int n = (lane >> 3) + 8 * j; const LAS float* s = scr + (8 * c) * 33 + n;
        int w0 = 0, w1 = 0;
        w0 = __builtin_amdgcn_cvt_pk_fp8_f32(s[0 * 33], s[1 * 33], w0, false); w0 = __builtin_amdgcn_cvt_pk_fp8_f32(s[2 * 33], s[3 * 33], w0, true);
        w1 = __builtin_amdgcn_cvt_pk_fp8_f32(s[4 * 33], s[5 * 33], w1, false); w1 = __builtin_amdgcn_cvt_pk_fp8_f32(s[6 * 33], s[7 * 33], w1, true);
        typedef int i32x2_ __attribute__((ext_vector_type(2)));
        *(GAS i32x2_*)(WT + (size_t)(n0 + n) * K + (KPERM ? ppos_dn(k0 + 8 * c) : k0 + 8 * c)) = (i32x2_){w0, w1}; }
    LDS_WAIT(); asm volatile("" ::: "memory");
}
__device__ __forceinline__ void rms_row_to_bf16(int lane, const f32x4 (&v)[4], const f32x4 (&g)[4], bf16* orow, unsigned char* orow8) {
    float s = 0.f;
#pragma unroll
    for (int j = 0; j < 4; ++j) s += (v[j].x * v[j].x + v[j].y * v[j].y) + (v[j].z * v[j].z + v[j].w * v[j].w);
    const float rstd = 1.f / sqrtf(wave_sum(s) * (1.f / DM) + EPS);
    GAS unsigned long long* o8 = (GAS unsigned long long*)orow + lane;
#pragma unroll
    for (int j = 0; j < 4; ++j) { const f32x4 y = v[j] * rstd * g[j]; o8[64 * j] = (unsigned long long)pk2(y.x, y.y) | ((unsigned long long)pk2(y.z, y.w) << 32);
        int w = 0; w = __builtin_amdgcn_cvt_pk_fp8_f32(y.x, y.y, w, false); w = __builtin_amdgcn_cvt_pk_fp8_f32(y.z, y.w, w, true); ((GAS int*)orow8)[lane + 64 * j] = w; }
}

struct Args { const float* in[17]; float* out; unsigned char* ws; int ph_lo, ph_hi, li, pad; };

__global__ void __launch_bounds__(NWAVES * 64, 2) block_fwd(Args args) {
    extern __shared__ __attribute__((aligned(16))) unsigned char lds[];
    Frame F;
    F.lds = (LAS unsigned char*)lds;
    F.MISC = (volatile LAS unsigned*)(F.lds + MISC_OFF);
    F.tid = threadIdx.x; F.lane = F.tid & 63; F.wave = __builtin_amdgcn_readfirstlane(F.tid >> 6);
    F.G = gridDim.x; { const int bx = blockIdx.x; F.vcu = (F.G % 8 == 0) ? (bx % 8) * (F.G / 8) + bx / 8 : bx; }
    unsigned char* ws = args.ws;
    F.ctl = (gu32*)(ws + WS_CTL);
    const float* x = args.in[0]; const int* positions = (const int*)args.in[1];
    const float *g_pre_mix = args.in[2], *w_in = args.in[3], *b_gate = args.in[4], *g_q = args.in[5], *w_uq = args.in[6], *g_kv = args.in[7], *w_ukv = args.in[8], *w_a = args.in[9], *w_b = args.in[10],
                *w_out = args.in[11], *g_post_mix = args.in[12], *g_pre_mlp = args.in[13], *w_up = args.in[14], *w_dn = args.in[15], *g_post_mlp = args.in[16];
    float* out = args.out;
    float* ropeA = (float*)(ws + WS_ROPEA); float* ropeB = (float*)(ws + WS_ROPEB);
    float* SS = (float*)(ws + WS_SS); float* SS2 = (float*)(ws + WS_SS2); float* SS3 = (float*)(ws + WS_SS3);
    bf16 *WIN = (bf16*)(ws + WS_WIN), *WUQ = (bf16*)(ws + WS_WUQ), *WUKV = (bf16*)(ws + WS_WUKV), *WA = (bf16*)(ws + WS_WA), *WOUT = (bf16*)(ws + WS_WOUT), *WUP = (bf16*)(ws + WS_WUP), *WDN = (bf16*)(ws + WS_WDN);
    bf16 *H = (bf16*)(ws + WS_H), *Gt = (bf16*)(ws + WS_G), *QA = (bf16*)(ws + WS_QA), *KA = (bf16*)(ws + WS_KA), *VA = (bf16*)(ws + WS_VA), *T = (bf16*)(ws + WS_T), *CQ = (bf16*)(ws + WS_CQ), *CKV = (bf16*)(ws + WS_CKV),
         *KR = (bf16*)(ws + WS_KR), *QB = (bf16*)(ws + WS_QB), *KB = (bf16*)(ws + WS_KB), *VB = (bf16*)(ws + WS_VB), *Y = (bf16*)(ws + WS_Y), *U = (bf16*)(ws + WS_U), *X1B = (bf16*)(ws + WS_X1); unsigned char *H8 = ws + WS_H8, *WG8 = ws + WS_WG8;
    for (int u = F.tid; u < (LDS_BYTES - LDSCTL_OFF) / 4; u += NWAVES * 64) ((LAS unsigned*)(F.lds + LDSCTL_OFF))[u] = 0u;
    __syncthreads();
    XcdBarrier bar = xcd_barrier_post((unsigned*)(F.ctl + CW_BAR) + args.li * XCD_BAR_WORDS, F.MISC + 8);
    const int lo = args.ph_lo, hi = args.ph_hi;
#define IN(k) (lo <= (k) && (k) < hi)
#define SEAM(k) do { if (IN(k) && IN((k) + 1)) xcd_barrier(bar); } while (0)
    const int gw = F.vcu * NWAVES + F.wave, NGW = F.G * NWAVES;

#if !defined(SKIP_P0)
    if (IN(0))
    {
        LAS float* scr = (LAS float*)(F.lds + RING_OFF + F.wave * 16384);
        constexpr int NBF = 2304, IG = (DM / 64) * (2 * DM / 32);
        constexpr int I0 = (DM / 64) * (NBF / 32), I1 = (QLORA / 64) * (768 / 32), I2 = (KVLORA / 64) * (1024 / 32), I3 = (AW / 64) * (DM / 32), I5 = (DM / 64) * (DM / 32), I6 = (DM / 64) * (DFF / 32), I7 = (DFF / 64) * (DM / 32);
        constexpr int NITEMS = I0 + I1 + I2 + 2 * I3 + I5 + I6 + I7 + IG;
        constexpr int TW = 4, RW = NWAVES - TW;
        if (F.wave >= RW)
        for (int it = F.vcu * TW + (F.wave - RW); it < NITEMS; it += F.G * TW) {
            int r = it;
            if (r < I0) { p0_transpose_item(w_in, DM, INW, NBF, WIN, LDH, 0, nullptr, 0, scr, r, F.lane); continue; } r -= I0;
            if (r < IG) { p0_transpose_item_f8(w_in, DM, 2 * DM, INW, 2208, WG8, 32.f, scr, r, F.lane); continue; } r -= IG;
            if (r < I1) { p0_transpose_item(w_uq, QLORA, 768, 768, WUQ, QLORA, 0, g_q, 1, scr, r, F.lane); continue; } r -= I1;
            if (r < I2) { p0_transpose_item(w_ukv, KVLORA, 1024, 1024, WUKV, LDKV, 0, g_kv, 2, scr, r, F.lane); continue; } r -= I2;
            if (r < I3) { p0_transpose_item(w_a, AW, DM, DM, WA, LDH, 0, nullptr, 2, scr, r, F.lane); continue; } r -= I3;
            if (r < I3) { p0_transpose_item(w_b, AW, DM, DM, WA, LDH, AW, nullptr, 2, scr, r, F.lane); continue; } r -= I3;
            if (r < I5) { p0_transpose_item_f8<true>(w_out, DM, DM, DM, 0, (unsigned char*)WOUT, 32.f, scr, r, F.lane); continue; } r -= I5;
            if (r < I6) { p0_transpose_item_f8(w_up, DM, DFF, DFF, 0, (unsigned char*)WUP, 32.f, scr, r, F.lane); continue; } r -= I6;
            p0_transpose_item_f8<true>(w_dn, DFF, DM, DM, 0, (unsigned char*)WDN, 64.f, scr, r, F.lane);
        }
        if (F.wave >= RW)
        for (int idx = (int)blockIdx.x * (TW * 64) + (F.tid - RW * 64); idx < MTOK * 24; idx += F.G * TW * 64) {
            const int m = idx / 24, i = idx - m * 24;
            const float invf = (i < 8) ? __builtin_amdgcn_exp2f(-(float)i * 2.3664460711655217f) : __builtin_amdgcn_exp2f(-(float)(i - 8) * 1.1832230355827609f);
            const float ang = (float)positions[m] * invf;
            double t = (double)ang * 0.15915494309189535; t -= floor(t);
            const float tf = (float)t; const float c = __builtin_amdgcn_cosf(tf), s = __builtin_amdgcn_sinf(tf);
            float* dst = (i < 8) ? ropeA + (size_t)m * 16 + 2 * i : ropeB + (size_t)m * 32 + 2 * (i - 8);
            *(f32x2g*)dst = (f32x2g){c, s};
        }
        f32x4 g[4];
#pragma unroll
        for (int j = 0; j < 4; ++j) g[j] = ((const GAS f32x4*)g_pre_mix)[F.lane + 64 * j];
        {
            f32x4 cv[4], n1[4], n2[4];
            const int rw0 = (F.wave < RW) ? F.vcu * RW + F.wave : MTOK, RST = F.G * RW;
#define P0_LOADROW(V, mm) do { _Pragma("unroll") for (int j = 0; j < 4; ++j) V[j] = ((const GAS f32x4*)(x + (size_t)(mm) * DM) + F.lane)[64 * j]; } while (0)
            if (rw0 < MTOK) P0_LOADROW(cv, rw0);
            if (rw0 + RST < MTOK) P0_LOADROW(n1, rw0 + RST);
            for (int m = rw0; m < MTOK; m += RST) {
                if (m + 2 * RST < MTOK) P0_LOADROW(n2, m + 2 * RST);
                rms_row_to_bf16(F.lane, cv, g, H + (size_t)m * LDH, H8 + (size_t)m * DM);
#pragma unroll
                for (int j = 0; j < 4; ++j) { cv[j] = n1[j]; n1[j] = n2[j]; }
            }
#undef P0_LOADROW
        }
    }
#endif
    SEAM(0);

#if !defined(SKIP_P1)
    if (IN(1))
    {
        { pg8::Gemm g{H, WIN, MTOK, 2304, DM, LDH, LDH}; pg8::StaticOrder S; S.init(MTOK, 2304, F.G, (int)blockIdx.x);
          pg8::EpiIn E{QA, KA, VA, CQ, CKV, KR, Gt, SS, ropeA, ropeB, b_gate};
          pg8::gemm_phase<pg8::EpiIn, pg8::StaticOrder, true, true>(F.lds + RING_OFF, g, S, E); }
        { pg8::Gemm g{(const bf16*)H8, (const bf16*)WG8, MTOK, 2 * DM, DM, DM, DM}; pg8::StaticOrder S; S.init(MTOK, 2 * DM, F.G, (int)blockIdx.x);
          pg8::EpiGates E{Gt, b_gate};
          pg8::gemm_phase<pg8::EpiGates, pg8::StaticOrder, true, true, 1>(F.lds + RING_OFF, g, S, E); }
    }
#endif
    SEAM(1);

#if !defined(SKIP_P2)
    if (IN(2)) {
    {
        pg8::Gemm g{CQ, WUQ, MTOK, NHEAD * QKB, QLORA}; pg8::StaticOrder S; S.init(MTOK, NHEAD * QKB, F.G, (int)blockIdx.x);
        pg8::EpiQ E{QB, SS, ropeB};
        pg8::gemm_phase<pg8::EpiQ, pg8::StaticOrder, true, true, 2, true>(F.lds + RING_OFF, g, S, E);
    }
    {
        pg8::Gemm g{CKV, WUKV, MTOK, 2 * AW, KVLORA, LDKV, LDKV}; pg8::StaticOrder S; S.init(MTOK, 2 * AW, F.G, (int)blockIdx.x);
        pg8::EpiKV E{KB, VB, SS};
        pg8::gemm_phase<pg8::EpiKV, pg8::StaticOrder, true, true, 2, true>(F.lds + RING_OFF, g, S, E);
    }
    }
#endif
    SEAM(2);

#if !defined(SKIP_P3)
    if (IN(3))
    {
        LAS char* al = (LAS char*)(F.lds + RING_OFF);
#if !defined(SKIP_MOBA)
        for (int bh = F.vcu; bh < NB * NHEAD; bh += F.G) {
            const int b = bh >> 3, h = bh & 7; const size_t r0 = (size_t)b * SEQ;
            att::kmean_blocks(KA + r0 * AW + h * HD * 16, al);
#pragma unroll 1
            for (int qb = 0; qb < 8; ++qb) att::moba_unit(QA + r0 * AW + h * HD * 16, KA + r0 * AW + h * HD * 16, VA + r0 * AW + h * HD * 16, H + r0 * LDH + h * HD * 16, LDH, qb, al);
        }
#endif
#if !defined(SKIP_MLA)
        for (int bh = F.vcu; bh < NB * NHEAD; bh += F.G) {
            const int b = bh >> 3, h = bh & 7; const size_t r0 = (size_t)b * SEQ;
#pragma unroll 1
            for (int qb = 0; qb < 8; ++qb) att::mla_unit(QB + r0 * (NHEAD * QKB) + h * QKB * 16, KB + r0 * AW + h * HD * 16, KR + r0 * RDIM, VB + r0 * AW + h * HD * 16, H + r0 * LDH + (AW + h * HD) * 16, LDH, qb, al);
        }
#endif
    }
#endif
    SEAM(3);

#if !defined(SKIP_P4)
    if (IN(4))
    {
        pg8::Gemm g{H, WA, MTOK, DM, DM, LDH, LDH}; pg8::StaticOrder S; S.init(MTOK, DM, F.G, (int)blockIdx.x);
        pg8::EpiMerge E{Gt, T};
        pg8::gemm_phase<pg8::EpiMerge, pg8::StaticOrder, true, true, 2, true>(F.lds + RING_OFF, g, S, E);
    }
#endif
    SEAM(4);

#if !defined(SKIP_P5)
    if (IN(5))
    {
        pg8::Gemm g{T, WOUT, MTOK, DM, DM, DM, DM}; pg8::StaticOrder S; S.init(MTOK, DM, F.G, (int)blockIdx.x);
        pg8::EpiSS E{Y, SS2, DM, 1.0f / 2048.0f};
        pg8::gemm_phase<pg8::EpiSS, pg8::StaticOrder, true, true, 1, true>(F.lds + RING_OFF, g, S, E);
    }
#endif
    SEAM(5);

#if !defined(SKIP_P6)
    if (IN(6))
    {
        f32x4 g1[4], g2[4];
#pragma unroll
        for (int j = 0; j < 4; ++j) { g1[j] = ((const GAS f32x4*)g_post_mix)[F.lane + 64 * j]; g2[j] = ((const GAS f32x4*)g_pre_mlp)[F.lane + 64 * j]; }
        f32x4 ca, cb, cc, cd, cx[4]; unsigned long long cy[4];
#define P6_LOAD(A, B, C, D, X, Yv, mm) do { const GAS f32x4* sp_ = (const GAS f32x4*)(SS2 + (size_t)(mm) * 16); A = sp_[0]; B = sp_[1]; C = sp_[2]; D = sp_[3]; \
            const GAS f32x4* xr_ = (const GAS f32x4*)(x + (size_t)(mm) * DM) + F.lane; const GAS unsigned long long* yr_ = (const GAS unsigned long long*)(Y + (size_t)(mm) * DM) + F.lane; \
            _Pragma("unroll") for (int j = 0; j < 4; ++j) { X[j] = xr_[64 * j]; Yv[j] = yr_[64 * j]; } } while (0)
        if (gw < MTOK) P6_LOAD(ca, cb, cc, cd, cx, cy, gw);
        for (int m = gw; m < MTOK; m += NGW) {
            f32x4 na, nb, nc, nd, nx[4]; unsigned long long ny[4];
            const bool more = m + NGW < MTOK;
            if (more) P6_LOAD(na, nb, nc, nd, nx, ny, m + NGW);
            const f32x4 a = ca, b = cb, c = cc, d = cd;
            const float ssy = (((a.x + a.y) + (a.z + a.w)) + ((b.x + b.y) + (b.z + b.w))) + (((c.x + c.y) + (c.z + c.w)) + ((d.x + d.y) + (d.z + d.w)));
            const float rsy = 1.f / sqrtf(ssy * (1.f / DM) + EPS);
            GAS unsigned long long* x8 = (GAS unsigned long long*)(X1B + (size_t)m * DM) + F.lane;
            f32x4 v[4]; float s = 0.f;
#pragma unroll
            for (int j = 0; j < 4; ++j) { const unsigned long long yw = cy[j]; const unsigned lo = (unsigned)yw, hi = (unsigned)(yw >> 32);
                const f32x4 yv = (f32x4){__uint_as_float(lo << 16), __uint_as_float(lo & 0xffff0000u), __uint_as_float(hi << 16), __uint_as_float(hi & 0xffff0000u)};
                v[j] = cx[j] + yv * rsy * g1[j]; x8[64 * j] = (unsigned long long)pk2(v[j].x, v[j].y) | ((unsigned long long)pk2(v[j].z, v[j].w) << 32);
                s += (v[j].x * v[j].x + v[j].y * v[j].y) + (v[j].z * v[j].z + v[j].w * v[j].w); }
            const float rstd = 1.f / sqrtf(wave_sum(s) * (1.f / DM) + EPS);
            GAS int* o8 = (GAS int*)((unsigned char*)H + (size_t)m * DM) + F.lane;
#pragma unroll
            for (int j = 0; j < 4; ++j) { const f32x4 y2 = v[j] * rstd * g2[j]; int w = 0; w = __builtin_amdgcn_cvt_pk_fp8_f32(y2.x, y2.y, w, false); w = __builtin_amdgcn_cvt_pk_fp8_f32(y2.z, y2.w, w, true); o8[64 * j] = w; }
            if (more) { ca = na; cb = nb; cc = nc; cd = nd;
#pragma unroll
                for (int j = 0; j < 4; ++j) { cx[j] = nx[j]; cy[j] = ny[j]; } }
        }
#undef P6_LOAD
    }
#endif
    SEAM(6);

#if !defined(SKIP_P7)
    if (IN(7))
    {
        pg8::Gemm g{H, WUP, MTOK, DFF, DM, DM, DM}; pg8::StaticOrder S; S.init(MTOK, DFF, F.G, (int)blockIdx.x);
        pg8::EpiRelu2F8 E{(unsigned char*)U, 1.0f / 32.0f};
        pg8::gemm_phase<pg8::EpiRelu2F8, pg8::StaticOrder, true, true, 1>(F.lds + RING_OFF, g, S, E);
    }
#endif
    SEAM(7);

#if !defined(SKIP_P8)
    if (IN(8))
    {
        pg8::Gemm g{U, WDN, MTOK, DM, DFF, DFF, DFF}; pg8::StaticOrder S; S.init(MTOK, DM, F.G, (int)blockIdx.x);
        pg8::EpiSS E{H, SS3, LDH, 1.0f / 64.0f};
        pg8::gemm_phase<pg8::EpiSS, pg8::StaticOrder, true, true, 1, true>(F.lds + RING_OFF, g, S, E);
    }
#endif
    SEAM(8);

#if !defined(SKIP_P9)
    if (IN(9))
    {
        f32x4 g1[4];
#pragma unroll
        for (int j = 0; j < 4; ++j) g1[j] = ((const GAS f32x4*)g_post_mlp)[F.lane + 64 * j];
        f32x4 ca, cb, cc, cd; unsigned long long cy[4], cq[4];
#define P9_LOAD(A, B, C, D, Yv, Q, mm) do { const GAS f32x4* sp_ = (const GAS f32x4*)(SS3 + (size_t)(mm) * 16); A = sp_[0]; B = sp_[1]; C = sp_[2]; D = sp_[3]; \
            const GAS unsigned long long* yr_ = (const GAS unsigned long long*)(H + (size_t)(mm) * LDH) + F.lane; const GAS unsigned long long* xq_ = (const GAS unsigned long long*)(X1B + (size_t)(mm) * DM) + F.lane; \
            _Pragma("unroll") for (int j = 0; j < 4; ++j) { Yv[j] = yr_[64 * j]; Q[j] = xq_[64 * j]; } } while (0)
        if (gw < MTOK) P9_LOAD(ca, cb, cc, cd, cy, cq, gw);
        for (int m = gw; m < MTOK; m += NGW) {
            f32x4 na, nb, nc, nd; unsigned long long ny[4], nq[4];
            const bool more = m + NGW < MTOK;
            if (more) P9_LOAD(na, nb, nc, nd, ny, nq, m + NGW);
            const f32x4 a = ca, b = cb, c = cc, d = cd;
            const float ssy = (((a.x + a.y) + (a.z + a.w)) + ((b.x + b.y) + (b.z + b.w))) + (((c.x + c.y) + (c.z + c.w)) + ((d.x + d.y) + (d.z + d.w)));
            const float rsy = 1.f / sqrtf(ssy * (1.f / DM) + EPS);
            GAS f32x4* o4 = (GAS f32x4*)(out + (size_t)m * DM) + F.lane;
#pragma unroll
            for (int j = 0; j < 4; ++j) { const unsigned long long yw = cy[j]; const unsigned lo = (unsigned)yw, hi = (unsigned)(yw >> 32);
                const f32x4 yv = (f32x4){__uint_as_float(lo << 16), __uint_as_float(lo & 0xffff0000u), __uint_as_float(hi << 16), __uint_as_float(hi & 0xffff0000u)};
                const unsigned long long xw = cq[j]; const unsigned xl = (unsigned)xw, xh = (unsigned)(xw >> 32);
                const f32x4 xv = (f32x4){__uint_as_float(xl << 16), __uint_as_float(xl & 0xffff0000u), __uint_as_float(xh << 16), __uint_as_float(xh & 0xffff0000u)};
                o4[64 * j] = xv + yv * rsy * g1[j]; }
            if (more) { ca = na; cb = nb; cc = nc; cd = nd;
#pragma unroll
                for (int j = 0; j < 4; ++j) { cy[j] = ny[j]; cq[j] = nq[j]; } }
        }
#undef P9_LOAD
    }
#endif
}

extern "C" void kernel_launch(void* const* d_in, const int* in_sizes, int n_in, void* d_out, int out_size, void* d_ws, size_t ws_size, hipStream_t stream) {
    static int grid = 0;
    if (grid == 0) {
        if (n_in != 17 || in_sizes[0] != MTOK * DM || out_size != MTOK * DM || ws_size < WS_END) { fprintf(stderr, "kernel_launch: unexpected shapes (n_in %d, in0 %d, out %d, ws %zu); nothing launched\n", n_in, n_in > 0 ? in_sizes[0] : -1, out_size, ws_size); grid = -1; return; }
        int dev = 0, cus = 0, per_cu = 0;
        if (hipGetDevice(&dev) != hipSuccess || hipDeviceGetAttribute(&cus, hipDeviceAttributeMultiprocessorCount, dev) != hipSuccess) { fprintf(stderr, "kernel_launch: device query failed\n"); grid = -1; return; }
        if (hipFuncSetAttribute((const void*)block_fwd, hipFuncAttributeMaxDynamicSharedMemorySize, LDS_BYTES) != hipSuccess) { fprintf(stderr, "kernel_launch: hipFuncSetAttribute failed\n"); grid = -1; return; }
        if (hipOccupancyMaxActiveBlocksPerMultiprocessor(&per_cu, (const void*)block_fwd, NWAVES * 64, LDS_BYTES) != hipSuccess || per_cu < 1) { fprintf(stderr, "kernel_launch: occupancy query reports %d workgroups per CU\n", per_cu); }
        (void)hipGetLastError();
        grid = cus;
    }
    if (grid < 0) return;
    if (hipMemsetAsync((char*)d_ws + WS_CTL, 0, CTL_ZERO_BYTES, stream) != hipSuccess) { fprintf(stderr, "kernel_launch: hipMemsetAsync failed\n"); return; }
    Args a{};
    for (int i = 0; i < 17; ++i) a.in[i] = (const float*)d_in[i];
    a.out = (float*)d_out; a.ws = (unsigned char*)d_ws;
    a.ph_lo = 0; a.ph_hi = 10; a.li = 0;
    hipLaunchKernelGGL(block_fwd, dim3(grid), dim3(NWAVES * 64), LDS_BYTES, stream, a);
    const hipError_t le = hipPeekAtLastError();
    if (le != hipSuccess) fprintf(stderr, "kernel_launch: launch failed: %s\n", hipGetErrorName(le));
}
```
